# Optimizing an MI355X kernel written in HIP

```python
import jax, jax.numpy as jnp
from jax import lax
import numpy as np

D_MODEL = 1024
BATCH = 4
SEQ = 4096
DEPTH = 1
DEC_BATCH = 128
DEC_SEQ = 8
PAST_LEN = 2048
PAGE_SIZE = 128

MIX_WIDTH = D_MODEL
SB_HEADS = 8
SB_HEAD_DIM = (MIX_WIDTH // 2) // SB_HEADS
SB_WIDTH = SB_HEADS * SB_HEAD_DIM
SB_BLOCK = 128
SB_BIAS_HI = -5.0
SB_BIAS_LO = -9.0
DN_HEADS = 4
DN_HEAD_DIM = (MIX_WIDTH - SB_WIDTH) // DN_HEADS
DN_WIDTH = DN_HEADS * DN_HEAD_DIM
DN_CONV = 4
DN_CHUNK = 64
D_FF = 256 * ((8 * D_MODEL // 3 + 255) // 256)
FFN_CONV = 3
NORM_EPS = 1e-6
N_MOD = 6
IN_COLS = 3 * SB_WIDTH + 3 * DN_WIDTH + 2 * DN_HEADS + DN_WIDTH

kernel_name = 'hybrid_stickbreak_gdn_convffn_adaln_step'


def rms_norm(x, g):
    xf = x.astype(jnp.float32)
    y = xf * lax.rsqrt(jnp.mean(xf * xf, axis=-1, keepdims=True) + NORM_EPS)
    return (y * g.astype(jnp.float32)).astype(x.dtype)


def l2_norm(x):
    xf = x.astype(jnp.float32)
    return xf * lax.rsqrt(jnp.sum(xf * xf, axis=-1, keepdims=True) + NORM_EPS)


def causal_dwconv(x, buf, w):
    width = w.shape[0]
    t = x.shape[1]
    xp = jnp.concatenate([buf.astype(x.dtype), x], axis=1)
    y = w[0] * xp[:, 0:t]
    for i in range(1, width):
        y = y + w[i] * xp[:, i:i + t]
    return y, xp[:, t:]


def sb_block(q, k, v, bias, q_pos, k_pos):
    f32 = jnp.float32
    z = jnp.einsum('bqhd,bkhd->bhqk', q.astype(f32), k.astype(f32)) * (SB_HEAD_DIM ** -0.5)
    z = z + bias.astype(f32)[None, :, None, None]
    mask = k_pos[None, :] < q_pos[:, None]
    log_beta = jax.nn.log_sigmoid(z)
    log_one_minus = jnp.where(mask, jax.nn.log_sigmoid(-z), 0.0)
    later = lax.cumsum(log_one_minus, axis=3, reverse=True) - log_one_minus
    att = jnp.where(mask, jnp.exp(log_beta + later), 0.0)
    out = jnp.einsum('bhqk,bkhd->bqhd', att, v.astype(f32))
    return out.astype(q.dtype)


def sb_attention(q, k, v, bias, q_offset):
    tq = q.shape[1]
    outs = []
    for start in range(0, tq, SB_BLOCK):
        end = min(start + SB_BLOCK, tq)
        kend = q_offset + end
        q_pos = q_offset + jnp.arange(start, end)
        k_pos = jnp.arange(kend)
        outs.append(sb_block(q[:, start:end], k[:, :kend], v[:, :kend], bias, q_pos, k_pos))
    return jnp.concatenate(outs, axis=1)


def gated_delta_rule(q, k, v, beta, log_a, s0):
    f32 = jnp.float32
    bsz, t, h, dk = q.shape
    dv = v.shape[-1]
    c = min(DN_CHUNK, t)
    pad = (-t) % c
    n = (t + pad) // c

    def to_chunks(a):
        a = a.astype(f32)
        if pad:
            a = jnp.pad(a, [(0, 0), (0, pad)] + [(0, 0)] * (a.ndim - 2))
        a = a.reshape((bsz, n, c) + a.shape[2:])
        return a.transpose(1, 0, 3, 2, 4) if a.ndim == 5 else a.transpose(1, 0, 3, 2)

    qc, kc, vc = to_chunks(q), to_chunks(k), to_chunks(v)
    bc, ac = to_chunks(beta), to_chunks(log_a)
    g = jnp.cumsum(ac, axis=-1)
    idx = jnp.arange(c)
    lower_incl = idx[:, None] >= idx[None, :]
    strict = idx[:, None] > idx[None, :]
    decay = jnp.exp(jnp.where(lower_incl, g[..., :, None] - g[..., None, :], -jnp.inf))
    kb = kc * bc[..., None]
    a_mat = jnp.where(strict, jnp.einsum('nbhid,nbhjd->nbhij', kb, kc) * decay, 0.0)
    rhs = jnp.concatenate([vc * bc[..., None], kb * jnp.exp(g)[..., None]], axis=-1)
    sol = lax.linalg.triangular_solve(a_mat + jnp.eye(c, dtype=f32), rhs,
                                      left_side=True, lower=True, unit_diagonal=True)
    u_val, k_cum = sol[..., :dv], sol[..., dv:]
    intra = jnp.einsum('nbhid,nbhjd->nbhij', qc, kc) * decay
    q_dec = qc * jnp.exp(g)[..., None]
    k_dec = kc * jnp.exp(g[..., -1:] - g)[..., None]
    g_last = jnp.exp(g[..., -1])

    def step(s, inp):
        u, kcum, intra_c, qd, kd, gl = inp
        v_new = u - jnp.einsum('bhcd,bhde->bhce', kcum, s)
        o = jnp.einsum('bhcd,bhde->bhce', qd, s) + jnp.einsum('bhij,bhje->bhie', intra_c, v_new)
        s = s * gl[..., None, None] + jnp.einsum('bhcd,bhce->bhde', kd, v_new)
        return s, o

    s_fin, o = lax.scan(step, s0.astype(f32), (u_val, k_cum, intra, q_dec, k_dec, g_last))
    o = o.transpose(1, 0, 3, 2, 4).reshape(bsz, n * c, h, dv)[:, :t]
    return o, s_fin


def hybrid_layer(x, c, past_k, past_v, s0, dn_buf, ffn_buf,
                 w_ada, b_ada, g_attn_norm, w_in, g_q, g_k, sb_bias, g_sb_out, w_dn_conv,
                 a_log, dt_bias, g_dn_out, w_out, g_ffn_norm, w_up, w_ffn_conv, w_down):
    bsz, t, _ = x.shape
    mod = (jax.nn.silu(c) @ w_ada + b_ada)[:, None, :]
    sh1, sc1, gt1, sh2, sc2, gt2 = jnp.split(mod, N_MOD, axis=-1)

    h = rms_norm(x, g_attn_norm) * (1.0 + sc1) + sh1
    proj = h @ w_in
    o1 = 3 * SB_WIDTH
    o2 = o1 + 3 * DN_WIDTH
    o3 = o2 + DN_HEADS
    o4 = o3 + DN_HEADS
    q_sb, k_sb, v_sb = jnp.split(proj[..., :o1], 3, axis=-1)
    qkv_dn = proj[..., o1:o2]
    b_raw = proj[..., o2:o3]
    a_raw = proj[..., o3:o4]
    z_gate = proj[..., o4:]

    hs = (bsz, t, SB_HEADS, SB_HEAD_DIM)
    q = rms_norm(q_sb.reshape(hs), g_q)
    k = rms_norm(k_sb.reshape(hs), g_k)
    v = v_sb.reshape(hs)
    if past_k is None:
        k_all, v_all, q_offset = k, v, 0
    else:
        k_all = jnp.concatenate([past_k.astype(k.dtype), k], axis=1)
        v_all = jnp.concatenate([past_v.astype(v.dtype), v], axis=1)
        q_offset = past_k.shape[1]
    o_sb = rms_norm(sb_attention(q, k_all, v_all, sb_bias, q_offset), g_sb_out)

    qkv_c, new_dn_buf = causal_dwconv(qkv_dn, dn_buf, w_dn_conv)
    qkv_c = jax.nn.silu(qkv_c)
    qd, kd, vd = jnp.split(qkv_c, 3, axis=-1)
    hd = (bsz, t, DN_HEADS, DN_HEAD_DIM)
    qd = l2_norm(qd.reshape(hd)) * (DN_HEAD_DIM ** -0.5)
    kd = l2_norm(kd.reshape(hd))
    vd = vd.reshape(hd)
    beta = jax.nn.sigmoid(b_raw.astype(jnp.float32))
    log_a = -jnp.exp(a_log.astype(jnp.float32)) * jax.nn.softplus(
        a_raw.astype(jnp.float32) + dt_bias.astype(jnp.float32))
    o_dn, s_new = gated_delta_rule(qd, kd, vd, beta, log_a, s0)
    zg = jax.nn.silu(z_gate.astype(jnp.float32)).reshape(hd)
    o_dn = (rms_norm(o_dn, g_dn_out) * zg).astype(x.dtype)

    mixed = jnp.concatenate([o_sb.reshape(bsz, t, SB_WIDTH), o_dn.reshape(bsz, t, DN_WIDTH)], axis=-1)
    x = x + gt1 * (mixed @ w_out)

    h2 = rms_norm(x, g_ffn_norm) * (1.0 + sc2) + sh2
    up, new_ffn_buf = causal_dwconv(h2 @ w_up, ffn_buf, w_ffn_conv)
    u, gate = jnp.split(up, 2, axis=-1)
    x = x + gt2 * ((jax.nn.silu(gate) * u) @ w_down)
    return x, k, v, s_new.astype(s0.dtype), new_dn_buf, new_ffn_buf


def setup_inputs(seed: int = 0) -> dict:
    key = jax.random.key(seed)
    ks = jax.random.split(key, 32)
    f32 = jnp.float32
    n_pages = PAST_LEN // PAGE_SIZE
    n_used = DEC_BATCH * n_pages
    n_phys = n_used + n_used // 4

    def nrm(k, shape, scale):
        return jax.random.normal(k, shape, f32) * scale

    page_table = jax.random.permutation(ks[0], n_phys)[:n_used].reshape(DEC_BATCH, n_pages).astype(jnp.int32)
    dt = jnp.exp(jax.random.uniform(ks[1], (DEPTH, DN_HEADS), f32, np.log(1e-3), np.log(1e-1)))
    sb_bias = jnp.linspace(SB_BIAS_HI, SB_BIAS_LO, SB_HEADS, dtype=f32)[None, :] + nrm(ks[26], (DEPTH, SB_HEADS), 0.1)
    return {
        'x_prompt': nrm(ks[2], (BATCH, SEQ, D_MODEL), 1.0),
        'x_sample': nrm(ks[3], (DEC_BATCH, DEC_SEQ, D_MODEL), 1.0),
        'c_prompt': nrm(ks[4], (BATCH, D_MODEL), 1.0),
        'c_sample': nrm(ks[5], (DEC_BATCH, D_MODEL), 1.0),
        'cache_k': nrm(ks[6], (DEPTH, n_phys, PAGE_SIZE, SB_HEADS, SB_HEAD_DIM), 1.0),
        'cache_v': nrm(ks[7], (DEPTH, n_phys, PAGE_SIZE, SB_HEADS, SB_HEAD_DIM), 1.0),
        'page_table': page_table,
        'state_delta': nrm(ks[8], (DEPTH, DEC_BATCH, DN_HEADS, DN_HEAD_DIM, DN_HEAD_DIM), 0.05),
        'state_dn_conv': nrm(ks[9], (DEPTH, DEC_BATCH, DN_CONV - 1, 3 * DN_WIDTH), 1.0),
        'state_ffn_conv': nrm(ks[10], (DEPTH, DEC_BATCH, FFN_CONV - 1, 2 * D_FF), 1.0),
        'w_ada': nrm(ks[11], (DEPTH, D_MODEL, N_MOD * D_MODEL), 0.5 * D_MODEL ** -0.5),
        'b_ada': nrm(ks[12], (DEPTH, N_MOD * D_MODEL), 0.01),
        'g_attn_norm': 1.0 + nrm(ks[13], (DEPTH, D_MODEL), 0.02),
        'w_in': nrm(ks[14], (DEPTH, D_MODEL, IN_COLS), D_MODEL ** -0.5),
        'g_q': 1.0 + nrm(ks[15], (DEPTH, SB_HEAD_DIM), 0.02),
        'g_k': 1.0 + nrm(ks[16], (DEPTH, SB_HEAD_DIM), 0.02),
        'sb_bias': sb_bias,
        'g_sb_out': 1.0 + nrm(ks[17], (DEPTH, SB_HEAD_DIM), 0.02),
        'w_dn_conv': nrm(ks[18], (DEPTH, DN_CONV, 3 * DN_WIDTH), DN_CONV ** -0.5),
        'a_log': jnp.log(jax.random.uniform(ks[19], (DEPTH, DN_HEADS), f32, 1.0, 16.0)),
        'dt_bias': dt + jnp.log(-jnp.expm1(-dt)),
        'g_dn_out': 1.0 + nrm(ks[20], (DEPTH, DN_HEAD_DIM), 0.02),
        'w_out': nrm(ks[21], (DEPTH, MIX_WIDTH, D_MODEL), MIX_WIDTH ** -0.5),
        'g_ffn_norm': 1.0 + nrm(ks[22], (DEPTH, D_MODEL), 0.02),
        'w_up': nrm(ks[23], (DEPTH, D_MODEL, 2 * D_FF), D_MODEL ** -0.5),
        'w_ffn_conv': nrm(ks[24], (DEPTH, FFN_CONV, 2 * D_FF), FFN_CONV ** -0.5),
        'w_down': nrm(ks[25], (DEPTH, D_FF, D_MODEL), D_FF ** -0.5),
    }


def reference(x_prompt, x_sample, c_prompt, c_sample, cache_k, cache_v, page_table,
              state_delta, state_dn_conv, state_ffn_conv,
              w_ada, b_ada, g_attn_norm, w_in, g_q, g_k, sb_bias, g_sb_out, w_dn_conv,
              a_log, dt_bias, g_dn_out, w_out, g_ffn_norm, w_up, w_ffn_conv, w_down):
    bp = x_prompt.shape[0]
    bs = x_sample.shape[0]
    past_len = page_table.shape[1] * PAGE_SIZE
    yp, ys = x_prompt, x_sample
    kp_l, vp_l, ks_l, vs_l, sp_l, ss_l, dcp_l, dcs_l, fcp_l, fcs_l = ([] for _ in range(10))
    for l in range(DEPTH):
        p = (w_ada[l], b_ada[l], g_attn_norm[l], w_in[l], g_q[l], g_k[l], sb_bias[l], g_sb_out[l],
             w_dn_conv[l], a_log[l], dt_bias[l], g_dn_out[l], w_out[l], g_ffn_norm[l], w_up[l],
             w_ffn_conv[l], w_down[l])
        s0 = jnp.zeros((bp, DN_HEADS, DN_HEAD_DIM, DN_HEAD_DIM), state_delta.dtype)
        dn0 = jnp.zeros((bp, DN_CONV - 1, 3 * DN_WIDTH), x_prompt.dtype)
        ff0 = jnp.zeros((bp, FFN_CONV - 1, 2 * D_FF), x_prompt.dtype)
        yp, kp, vp, sp, dcp, fcp = hybrid_layer(yp, c_prompt, None, None, s0, dn0, ff0, *p)
        past_k = cache_k[l][page_table].reshape(bs, past_len, SB_HEADS, SB_HEAD_DIM)
        past_v = cache_v[l][page_table].reshape(bs, past_len, SB_HEADS, SB_HEAD_DIM)
        ys, ksm, vsm, ss, dcs, fcs = hybrid_layer(ys, c_sample, past_k, past_v, state_delta[l],
                                                  state_dn_conv[l], state_ffn_conv[l], *p)
        kp_l.append(kp); vp_l.append(vp); ks_l.append(ksm); vs_l.append(vsm)
        sp_l.append(sp); ss_l.append(ss); dcp_l.append(dcp); dcs_l.append(dcs)
        fcp_l.append(fcp); fcs_l.append(fcs)
    return (yp, ys, jnp.stack(kp_l), jnp.stack(vp_l), jnp.stack(ks_l), jnp.stack(vs_l),
            jnp.stack(sp_l), jnp.stack(ss_l), jnp.stack(dcp_l), jnp.stack(dcs_l),
            jnp.stack(fcp_l), jnp.stack(fcs_l))
```

```cpp
#include <hip/hip_runtime.h>
#include <cstdio>
#include <cstdint>
namespace pg8 {
#define PG8_LAS __attribute__((address_space(3)))
typedef unsigned short bf16_t;
typedef short bf16x8 __attribute__((ext_vector_type(8)));
typedef float f32x4 __attribute__((ext_vector_type(4)));
typedef unsigned u32x4 __attribute__((ext_vector_type(4)));
constexpr int BM = 256, BK = 64, HALF = 128, HTB = HALF * BK * 2  , STAGE_BYTES = 8 * HTB, NXCD = 8, WGM = 8;

__host__ __device__ __forceinline__ int lds_byte(int r, int c) { const int st = (r >> 4) * 2 + (c >> 5), rr = r & 15, cc = c & 31, ob = rr * 64 + cc * 2; return st * 1024 + (ob ^ (((ob >> 9) & 1) << 5)); }
__host__ __device__ __forceinline__ void stage_rc(int b, int& R, int& C) { const int st = b / 1024, sb = b % 1024, swz = sb ^ (((sb >> 9) & 1) << 5); R = (st >> 1) * 16 + swz / 64; C = (st & 1) * 32 + (swz % 64) / 2; }
__host__ __device__ __forceinline__ int perm32(int rho) { const int n = rho >> 4, i = rho & 15; return 8 * (i >> 2) + 4 * n + (i & 3); }

struct Unit { int pm, pn; };
struct Gemm { const bf16_t* A; const bf16_t* Bt; int M, N, K; };

struct StaticOrder {
    int nM, nN, nwg, G, c;
    __host__ __device__ void init(int M, int N, int G_, int c_) { nM = M / BM; nN = N / BM; nwg = nM * nN; G = G_; c = c_; }
    __host__ __device__ bool next(int i, Unit& u) const {
        const long L = (long)i * G + c; if (L >= nwg) return false;
        int wgid = (int)L; { const int q = nwg / NXCD, r = nwg % NXCD, xcd = wgid % NXCD, off = wgid / NXCD; wgid = (xcd < r ? xcd * (q + 1) : r * (q + 1) + (xcd - r) * q) + off; }
        const int nig = WGM * nN, gid = wgid / nig, fm = gid * WGM, gsz = (nM - fm) < WGM ? (nM - fm) : WGM;
        u.pm = fm + ((wgid % nig) % gsz); u.pn = (wgid % nig) / gsz; return true;
    }
    __device__ __forceinline__ void a_ready(const Unit&) const {}
    __device__ __forceinline__ void done(const Unit&) const {}
};

__device__ __forceinline__ unsigned cvt_pk_bf16(float lo, float hi) { unsigned r; asm volatile("v_cvt_pk_bf16_f32 %0, %1, %2" : "=v"(r) : "v"(lo), "v"(hi)); return r; }
typedef float f32x2 __attribute__((ext_vector_type(2)));
__device__ __forceinline__ f32x2 gelu_pk(f32x2 v) {
    const f32x2 av = __builtin_elementwise_abs(v), d = av * 0.2316418882f + 1.0f;
    f32x2 t; t.x = __builtin_amdgcn_rcpf(d.x); t.y = __builtin_amdgcn_rcpf(d.y);
    f32x2 q = t * 0.5307027145f + (-0.7265760135f); q = q * t + 0.7107068705f; q = q * t + (-0.142248368f); q = q * t + 0.127414796f; q = q * t;
    const f32x2 s = (v * v) * (-0.72134752044f);
    f32x2 e; e.x = __builtin_amdgcn_exp2f(s.x); e.y = __builtin_amdgcn_exp2f(s.y);
    const f32x2 m = v * (q * e), r = v - m;
    f32x2 o; o.x = v.x < 0.f ? m.x : r.x; o.y = v.y < 0.f ? m.y : r.y; return o;
}

template <int ACT  > struct EpiBf16 {
    static constexpr bool PERM = true, AFTER_DRAIN = false; static_assert(ACT == 0 || ACT == 1, "EpiBf16: ACT is 0 (none) or 1 (gelu_pk)");
    bf16_t* O; int ldc; const float* bias; int split_cols; size_t split_stride; float scale0;
    __device__ __forceinline__ void operator()(const f32x4 (&acc)[2][2][4][2], const Unit& u, int wr, int wc, int fr, int fq) const {
        const int row0 = u.pm * BM + wr * 64 + fr; int colt = u.pn * BM; bf16_t* base = O;
        float sc = 1.f; if (split_cols) { const int t = colt / split_cols; base += (size_t)t * split_stride; colt -= t * split_cols; if (t == 0) sc = scale0; }
        const int col0 = colt + wc * 32 + 8 * fq, bcol0 = u.pn * BM + wc * 32 + 8 * fq;
        f32x4 bv[2][2];
#pragma unroll
        for (int bj = 0; bj < 2; ++bj)
#pragma unroll
            for (int n = 0; n < 2; ++n) bv[bj][n] = bias ? *(const f32x4*)(bias + bcol0 + bj * HALF + 4 * n) : (f32x4){0.f, 0.f, 0.f, 0.f};
#pragma unroll
        for (int ai = 0; ai < 2; ++ai)
#pragma unroll
            for (int m = 0; m < 4; ++m) { bf16_t* rowp = base + (size_t)(row0 + ai * HALF + m * 16) * ldc + col0;
#pragma unroll
                for (int bj = 0; bj < 2; ++bj) { f32x4 v0 = acc[ai][bj][m][0] + bv[bj][0], v1 = acc[ai][bj][m][1] + bv[bj][1];
                    if (ACT == 1) { f32x2 a = gelu_pk((f32x2){v0[0], v0[1]}), b = gelu_pk((f32x2){v0[2], v0[3]}), c = gelu_pk((f32x2){v1[0], v1[1]}), d = gelu_pk((f32x2){v1[2], v1[3]});
                        v0 = (f32x4){a.x, a.y, b.x, b.y}; v1 = (f32x4){c.x, c.y, d.x, d.y}; }
                    v0 = v0 * sc; v1 = v1 * sc; u32x4 w; w.x = cvt_pk_bf16(v0[0], v0[1]); w.y = cvt_pk_bf16(v0[2], v0[3]); w.z = cvt_pk_bf16(v1[0], v1[1]); w.w = cvt_pk_bf16(v1[2], v1[3]);
                    *(u32x4*)(rowp + bj * HALF) = w; } }
    }
};

struct PanelStats {
    unsigned* xbuf;
    unsigned* cnt;
    unsigned* tmo;
    int ntn; float eps;
    unsigned code;
    __device__ __forceinline__ bool run(const f32x4 (&v)[2][2][4][2], const Unit& u, int wr, int wc, int fr, int fq, PG8_LAS unsigned char* lds, int wid, int lane) const {
        typedef float f32x2v __attribute__((ext_vector_type(2)));
        PG8_LAS f32x2v* P = (PG8_LAS f32x2v*)lds;
        PG8_LAS f32x2v* S = (PG8_LAS f32x2v*)(lds + 8192);
        PG8_LAS unsigned* flag = (PG8_LAS unsigned*)(lds + 8192 + 2048);
#pragma unroll
        for (int ai = 0; ai < 2; ++ai)
#pragma unroll
            for (int m = 0; m < 4; ++m) {
                float s = 0.f;
#pragma unroll
                for (int bj = 0; bj < 2; ++bj)
#pragma unroll
                    for (int n = 0; n < 2; ++n) { const f32x4 x = v[ai][bj][m][n]; s += (x[0] + x[1]) + (x[2] + x[3]); }
                s += __shfl_xor(s, 16); s += __shfl_xor(s, 32);
                const float mw = s * (1.0f / 64.0f); float q = 0.f;
#pragma unroll
                for (int bj = 0; bj < 2; ++bj)
#pragma unroll
                    for (int n = 0; n < 2; ++n) { const f32x4 d = v[ai][bj][m][n] - mw; q += (d[0] * d[0] + d[1] * d[1]) + (d[2] * d[2] + d[3] * d[3]); }
                q += __shfl_xor(q, 16); q += __shfl_xor(q, 32);
                if (fq == 0) P[(ai * HALF + wr * 64 + m * 16 + fr) * 4 + wc] = (f32x2v){mw, q};
            }
        asm volatile("s_waitcnt lgkmcnt(0)" ::: "memory"); __builtin_amdgcn_s_barrier(); asm volatile("" ::: "memory");
#if defined(BROKEN_EXCHANGE_NO_WAIT)
#warning BROKEN CONTROL BUILD: the row-statistics exchange does not wait; results are wrong by design
        if (blockIdx.x >= 64) { const long long t0_ = clock64(); while (clock64() - t0_ < 60000) __builtin_amdgcn_s_sleep(8); }
#endif
        const int row = wid * 32 + (lane & 31);
        if (lane < 32) {
            const f32x2v a = P[row * 4 + 0], b = P[row * 4 + 1], c = P[row * 4 + 2], d = P[row * 4 + 3];
            const float mt = (a.x + b.x + c.x + d.x) * 0.25f;
            const float da = a.x - mt, db = b.x - mt, dc = c.x - mt, dd = d.x - mt;
            const float m2 = (a.y + b.y) + (c.y + d.y) + 64.0f * ((da * da + db * db) + (dc * dc + dd * dd));
            unsigned long long* slot = (unsigned long long*)xbuf + ((size_t)(u.pm * BM + row) * 4 + u.pn);
            __hip_atomic_store(slot, ((unsigned long long)__float_as_uint(m2) << 32) | __float_as_uint(mt), __ATOMIC_RELAXED, __HIP_MEMORY_SCOPE_AGENT);
        }
        asm volatile("s_waitcnt vmcnt(0)" ::: "memory");
        if (lane == 0) __hip_atomic_fetch_add(cnt + 64 * u.pm, 1u, __ATOMIC_RELAXED, __HIP_MEMORY_SCOPE_AGENT);
        if (wid == 0) {
            bool dead = false; const unsigned long long t0 = __builtin_amdgcn_s_memrealtime(); const unsigned want = 8u * (unsigned)ntn;
            for (;;) {
#if defined(BROKEN_EXCHANGE_NO_WAIT)
                break;
#endif
                if ((unsigned)__builtin_amdgcn_readfirstlane(__hip_atomic_load(cnt + 64 * u.pm, __ATOMIC_RELAXED, __HIP_MEMORY_SCOPE_AGENT)) >= want) break;
                if (__builtin_amdgcn_s_memrealtime() - t0 > 2000000ull) {
                    if (lane == 0) { unsigned expect = 0u; __hip_atomic_compare_exchange_strong(tmo + 1, &expect, code | (unsigned)(u.pm & 0xff), __ATOMIC_RELAXED, __ATOMIC_RELAXED, __HIP_MEMORY_SCOPE_AGENT);
                                     __hip_atomic_store(tmo, 1u, __ATOMIC_RELAXED, __HIP_MEMORY_SCOPE_AGENT); }
                    dead = true; break; }
                __builtin_amdgcn_s_sleep(2);
            }
            __builtin_amdgcn_fence(__ATOMIC_ACQUIRE, "agent");
            if (lane == 0) flag[0] = dead ? 1u : 0u;
        }
        asm volatile("s_waitcnt vmcnt(0) lgkmcnt(0)" ::: "memory"); __builtin_amdgcn_s_barrier(); asm volatile("" ::: "memory");
        const bool bad = flag[0] != 0u;
        if (lane < 32) {
            const unsigned long long* slot = (const unsigned long long*)xbuf + (size_t)(u.pm * BM + row) * 4; float mt[4], m2[4]; float ms = 0.f;
#pragma unroll
            for (int t = 0; t < 4; ++t) { if (t < ntn) { const unsigned long long w = __hip_atomic_load(slot + t, __ATOMIC_RELAXED, __HIP_MEMORY_SCOPE_AGENT); mt[t] = __uint_as_float((unsigned)w); m2[t] = __uint_as_float((unsigned)(w >> 32)); } else { mt[t] = 0.f; m2[t] = 0.f; } ms += mt[t]; }
            const float mean = ms / (float)ntn; float q = 0.f;
#pragma unroll
            for (int t = 0; t < 4; ++t) if (t < ntn) { const float dm = mt[t] - mean; q += m2[t] + 256.0f * dm * dm; }
            S[row] = (f32x2v){mean, 1.0f / sqrtf(q / (256.0f * (float)ntn) + eps)};
        }
        asm volatile("s_waitcnt lgkmcnt(0)" ::: "memory"); __builtin_amdgcn_s_barrier(); asm volatile("" ::: "memory");
        return bad;
    }
};
struct EpiLnRes {
    static constexpr bool PERM = false, AFTER_DRAIN = true;
    const float* base; float* out; int ldc; const float* bias; PanelStats st; unsigned poison;
    __device__ __forceinline__ void fused(f32x4 (&acc)[2][2][4][2], const Unit& u, int wr, int wc, int fr, int fq, PG8_LAS unsigned char* lds, int wid, int lane) const {
        typedef float f32x2v __attribute__((ext_vector_type(2)));
        const PG8_LAS f32x2v* S = (const PG8_LAS f32x2v*)(lds + 8192);
        const int col0 = u.pn * BM + wc * 32 + 4 * fq;
#pragma unroll
        for (int bj = 0; bj < 2; ++bj)
#pragma unroll
            for (int n = 0; n < 2; ++n) { const f32x4 bv = bias ? *(const f32x4*)(bias + col0 + bj * HALF + n * 16) : (f32x4){0.f, 0.f, 0.f, 0.f};
#pragma unroll
                for (int ai = 0; ai < 2; ++ai)
#pragma unroll
                    for (int m = 0; m < 4; ++m) acc[ai][bj][m][n] += bv; }
        f32x4 pre[4][2][2];
#pragma unroll
        for (int m = 0; m < 4; ++m) { const size_t off = (size_t)(u.pm * BM + wr * 64 + m * 16 + fr) * ldc + col0;
#pragma unroll
            for (int bj = 0; bj < 2; ++bj)
#pragma unroll
                for (int n = 0; n < 2; ++n) pre[m][bj][n] = *(const f32x4*)(base + off + bj * HALF + n * 16); }
        const bool bad = st.run(acc, u, wr, wc, fr, fq, lds, wid, lane) || poison != 0u;
        const float qnan = __builtin_nanf("");
#pragma unroll
        for (int ai = 0; ai < 2; ++ai)
#pragma unroll
            for (int m = 0; m < 4; ++m) { const int r = ai * HALF + wr * 64 + m * 16 + fr; const f32x2v sr = S[r]; const size_t off = (size_t)(u.pm * BM + r) * ldc + col0;
#pragma unroll
                for (int bj = 0; bj < 2; ++bj)
#pragma unroll
                    for (int n = 0; n < 2; ++n) { const f32x4 bs = ai == 0 ? pre[m][bj][n] : *(const f32x4*)(base + off + bj * HALF + n * 16); f32x4 o = bs + (acc[ai][bj][m][n] - sr.x) * sr.y;
                        if (bad) o = (f32x4){qnan, qnan, qnan, qnan}; *(f32x4*)(out + off + bj * HALF + n * 16) = o; }
                if (m & 1) asm volatile("" ::: "memory"); }
    }
};
struct EpiLnResLn {
    static constexpr bool PERM = false, AFTER_DRAIN = true;
    const float* base; float* out; bf16_t* xn; int ldc; const float* bias; PanelStats st1, st2; unsigned poison;
    __device__ __forceinline__ void fused(f32x4 (&acc)[2][2][4][2], const Unit& u, int wr, int wc, int fr, int fq, PG8_LAS unsigned char* lds, int wid, int lane) const {
        typedef float f32x2v __attribute__((ext_vector_type(2))); typedef unsigned u32x2v __attribute__((ext_vector_type(2)));
        const PG8_LAS f32x2v* S = (const PG8_LAS f32x2v*)(lds + 8192);
        const int col0 = u.pn * BM + wc * 32 + 4 * fq;
#pragma unroll
        for (int bj = 0; bj < 2; ++bj)
#pragma unroll
            for (int n = 0; n < 2; ++n) { const f32x4 bv = bias ? *(const f32x4*)(bias + col0 + bj * HALF + n * 16) : (f32x4){0.f, 0.f, 0.f, 0.f};
#pragma unroll
                for (int ai = 0; ai < 2; ++ai)
#pragma unroll
                    for (int m = 0; m < 4; ++m) acc[ai][bj][m][n] += bv; }
        bool bad = st1.run(acc, u, wr, wc, fr, fq, lds, wid, lane) || poison != 0u;
        const float qnan = __builtin_nanf("");
#pragma unroll
        for (int ai = 0; ai < 2; ++ai)
#pragma unroll
            for (int m = 0; m < 4; ++m) { const int r = ai * HALF + wr * 64 + m * 16 + fr; const f32x2v sr = S[r]; const size_t off = (size_t)(u.pm * BM + r) * ldc + col0;
#pragma unroll
                for (int bj = 0; bj < 2; ++bj)
#pragma unroll
                    for (int n = 0; n < 2; ++n) { const f32x4 bs = *(const f32x4*)(base + off + bj * HALF + n * 16); acc[ai][bj][m][n] = bs + (acc[ai][bj][m][n] - sr.x) * sr.y; }
                asm volatile("" : "+v"(acc[ai][0][m][0]), "+v"(acc[ai][0][m][1]), "+v"(acc[ai][1][m][0]), "+v"(acc[ai][1][m][1]));
                if (m & 1) asm volatile("" ::: "memory"); }
        const bool bad1 = bad;
        bad = st2.run(acc, u, wr, wc, fr, fq, lds, wid, lane) || bad;
#pragma unroll
        for (int ai = 0; ai < 2; ++ai)
#pragma unroll
            for (int m = 0; m < 4; ++m) { const int r = ai * HALF + wr * 64 + m * 16 + fr; const f32x2v sr = S[r]; const size_t off = (size_t)(u.pm * BM + r) * ldc + col0;
#pragma unroll
                for (int bj = 0; bj < 2; ++bj)
#pragma unroll
                    for (int n = 0; n < 2; ++n) { const f32x4 x1 = acc[ai][bj][m][n]; *(f32x4*)(out + off + bj * HALF + n * 16) = bad1 ? (f32x4){qnan, qnan, qnan, qnan} : x1;
                        const f32x4 o = (x1 - sr.x) * sr.y; u32x2v w; w.x = cvt_pk_bf16(o[0], o[1]); w.y = cvt_pk_bf16(o[2], o[3]);
                        if (bad) { w.x = 0x7fc07fc0u; w.y = 0x7fc07fc0u; } *(u32x2v*)(xn + off + bj * HALF + n * 16) = w; }
                asm volatile("" ::: "memory"); }
    }
};

template <class Epi, class Sched, bool ALIGN_EPI = false, bool SP2 = false>
__device__ __forceinline__ void gemm_phase(PG8_LAS unsigned char* lds, const Gemm g, const Sched& S, const Epi& E) {
    const int tid = threadIdx.x, wid = __builtin_amdgcn_readfirstlane(tid >> 6), lane = tid & 63, wr = wid >> 2, wc = wid & 3, fr = lane & 15, fq = lane >> 4;
    const int K = g.K, nt = K / BK;
    unsigned voffA[2], voffB[2];
#pragma unroll
    for (int i = 0; i < 2; ++i) { int R, C; stage_rc(tid * 16 + i * 8192, R, C); const int Rb = Epi::PERM ? ((R & ~31) + perm32(R & 31)) : R;
        voffA[i] = (unsigned)(R * K + C) * 2u; voffB[i] = (unsigned)(Rb * K + C) * 2u; }
    const size_t kstep = (size_t)(BK * 2);
    const size_t hstep = (size_t)HALF * K * 2;
    const size_t tstep = 2 * hstep;
    const unsigned ldsw = (unsigned)wid * 1024u;
    const int aoff = lds_byte(wr * 64 + fr, fq * 8), boff = lds_byte(wc * 32 + fr, fq * 8);
#define PG8_SA(b, h) (((b) * 2 + (h)) * HTB)
#define PG8_SB(b, h) ((4 + (b) * 2 + (h)) * HTB)
#define PG8_STAGE(bufoff, gbase, voff) do { _Pragma("unroll") for (int _i = 0; _i < 2; ++_i) \
        __builtin_amdgcn_global_load_lds((const unsigned*)((const char*)(gbase) + (voff)[_i]), (PG8_LAS unsigned*)(lds + (bufoff) + ldsw + _i * 8192), 16, 0, 0); } while (0)
#define PG8_LDA(dst, b, h) do { _Pragma("unroll") for (int m = 0; m < 4; ++m) _Pragma("unroll") for (int k = 0; k < 2; ++k) dst[m][k] = *(const PG8_LAS bf16x8*)(lds + PG8_SA(b, h) + aoff + m * 2048 + k * 1024); } while (0)
#define PG8_LDB(dst, b, h) do { _Pragma("unroll") for (int n = 0; n < 2; ++n) _Pragma("unroll") for (int k = 0; k < 2; ++k) dst[n][k] = *(const PG8_LAS bf16x8*)(lds + PG8_SB(b, h) + boff + n * 2048 + k * 1024); } while (0)
#define PG8_MMA(ai, bj, At, Bt) do { __builtin_amdgcn_s_setprio(1); _Pragma("unroll") for (int m = 0; m < 4; ++m) _Pragma("unroll") for (int n = 0; n < 2; ++n) _Pragma("unroll") for (int k = 0; k < 2; ++k) \
        acc[ai][bj][m][n] = __builtin_amdgcn_mfma_f32_16x16x32_bf16(Bt[n][k], At[m][k], acc[ai][bj][m][n], 0, 0, 0); __builtin_amdgcn_s_setprio(0); } while (0)
#define PG8_WAIT_V(n) asm volatile("s_waitcnt vmcnt(" #n ")" ::: "memory")
#define PG8_WAIT_L(n) asm volatile("s_waitcnt lgkmcnt(" #n ")" ::: "memory")
#define PG8_BAR __builtin_amdgcn_s_barrier()
#define PG8_SCHED __builtin_amdgcn_sched_barrier(0)
    Unit cur, nxt; int ui = 0;
    if (!S.next(0, cur)) return;
    f32x4 acc[2][2][4][2];
#pragma unroll
    for (int a = 0; a < 2; ++a)
#pragma unroll
        for (int b = 0; b < 2; ++b)
#pragma unroll
            for (int m = 0; m < 4; ++m)
#pragma unroll
                for (int n = 0; n < 2; ++n) acc[a][b][m][n] = (f32x4){0.f, 0.f, 0.f, 0.f};
    bf16x8 At[4][2], B0[2][2], B1[2][2];
    const char* cA = (const char*)g.A + (size_t)cur.pm * tstep; const char* cB = (const char*)g.Bt + (size_t)cur.pn * tstep;
    S.a_ready(cur);
    if constexpr (SP2) {
        PG8_STAGE(PG8_SB(0, 0), cB, voffB); PG8_STAGE(PG8_SB(0, 1), cB + hstep, voffB); PG8_STAGE(PG8_SA(0, 0), cA, voffA); PG8_STAGE(PG8_SA(0, 1), cA + hstep, voffA);
        if (wr == 1) PG8_BAR;
        PG8_WAIT_V(2); PG8_BAR;
        PG8_STAGE(PG8_SB(1, 0), cB + kstep, voffB); PG8_STAGE(PG8_SA(1, 0), cA + kstep, voffA); PG8_STAGE(PG8_SB(1, 1), cB + hstep + kstep, voffB);
        PG8_WAIT_V(6); PG8_BAR;
    } else {
        PG8_STAGE(PG8_SB(0, 0), cB, voffB); PG8_STAGE(PG8_SA(0, 0), cA, voffA); PG8_STAGE(PG8_SB(0, 1), cB + hstep, voffB); PG8_STAGE(PG8_SA(0, 1), cA + hstep, voffA);
        if (wr == 1) PG8_BAR;
        PG8_WAIT_V(4); PG8_BAR;
        PG8_STAGE(PG8_SB(1, 0), cB + kstep, voffB); PG8_STAGE(PG8_SA(1, 0), cA + kstep, voffA); PG8_STAGE(PG8_SB(1, 1), cB + hstep + kstep, voffB);
        PG8_WAIT_V(6); PG8_BAR;
    }
    for (;;) {
        const bool has_next = S.next(ui + 1, nxt);
        const char* nA = has_next ? (const char*)g.A + (size_t)nxt.pm * tstep : cA; const char* nB = has_next ? (const char*)g.Bt + (size_t)nxt.pn * tstep : cB;
        for (int t = 0; t < nt; t += 2) {
            const bool last = (t == nt - 2);
            const char* a1 = cA + (size_t)(t + 1) * kstep;
            const char* a2 = last ? nA : cA + (size_t)(t + 2) * kstep; const char* b2 = last ? nB : cB + (size_t)(t + 2) * kstep;
            const char* a3 = a2 + kstep; const char* b3 = b2 + kstep;
            if (last && has_next) S.a_ready(nxt);
            if constexpr (SP2) {
            PG8_LDB(B0, 0, 0); PG8_LDB(B1, 0, 1); PG8_SCHED; PG8_LDA(At, 0, 0); PG8_STAGE(PG8_SA(1, 1), a1 + hstep, voffA);
            PG8_WAIT_V(8); PG8_WAIT_L(0); PG8_BAR; PG8_MMA(0, 0, At, B0); PG8_MMA(0, 1, At, B1); PG8_BAR; PG8_SCHED;
            PG8_LDA(At, 0, 1); PG8_STAGE(PG8_SB(0, 0), b2, voffB); PG8_STAGE(PG8_SB(0, 1), b2 + hstep, voffB); PG8_STAGE(PG8_SA(0, 0), a2, voffA);
            PG8_WAIT_V(8); PG8_WAIT_L(0); PG8_BAR; PG8_MMA(1, 0, At, B0); PG8_MMA(1, 1, At, B1); PG8_BAR; PG8_SCHED;
            PG8_LDB(B0, 1, 0); PG8_LDB(B1, 1, 1); PG8_SCHED; PG8_LDA(At, 1, 0); PG8_STAGE(PG8_SA(0, 1), a2 + hstep, voffA);
            PG8_WAIT_V(8); PG8_WAIT_L(0); PG8_BAR; PG8_MMA(0, 0, At, B0); PG8_MMA(0, 1, At, B1); PG8_BAR; PG8_SCHED;
            PG8_LDA(At, 1, 1); PG8_STAGE(PG8_SB(1, 0), b3, voffB); PG8_STAGE(PG8_SB(1, 1), b3 + hstep, voffB); PG8_STAGE(PG8_SA(1, 0), a3, voffA);
            PG8_WAIT_V(8); PG8_WAIT_L(0); PG8_BAR; PG8_MMA(1, 0, At, B0); PG8_MMA(1, 1, At, B1); PG8_BAR; PG8_SCHED;
            } else {
            PG8_LDB(B0, 0, 0); PG8_SCHED; PG8_LDA(At, 0, 0); PG8_STAGE(PG8_SA(1, 1), a1 + hstep, voffA);
            PG8_WAIT_L(8); PG8_BAR; PG8_WAIT_L(0); PG8_MMA(0, 0, At, B0); PG8_BAR; PG8_SCHED;
            PG8_LDB(B1, 0, 1); PG8_STAGE(PG8_SB(0, 0), b2, voffB);
            PG8_BAR; PG8_WAIT_L(0); PG8_MMA(0, 1, At, B1); PG8_BAR;
            PG8_LDA(At, 0, 1); PG8_STAGE(PG8_SA(0, 0), a2, voffA);
            PG8_BAR; PG8_WAIT_L(0); PG8_MMA(1, 0, At, B0); PG8_BAR; PG8_SCHED;
            PG8_STAGE(PG8_SB(0, 1), b2 + hstep, voffB);
            PG8_WAIT_V(6); PG8_BAR; PG8_MMA(1, 1, At, B1); PG8_BAR;
            PG8_LDB(B0, 1, 0); PG8_SCHED; PG8_LDA(At, 1, 0); PG8_STAGE(PG8_SA(0, 1), a2 + hstep, voffA);
            PG8_WAIT_L(8); PG8_BAR; PG8_WAIT_L(0); PG8_MMA(0, 0, At, B0); PG8_BAR; PG8_SCHED;
            PG8_LDB(B1, 1, 1); PG8_STAGE(PG8_SB(1, 0), b3, voffB);
            PG8_BAR; PG8_WAIT_L(0); PG8_MMA(0, 1, At, B1); PG8_BAR;
            PG8_LDA(At, 1, 1); PG8_STAGE(PG8_SA(1, 0), a3, voffA);
            PG8_BAR; PG8_WAIT_L(0); PG8_MMA(1, 0, At, B0); PG8_BAR; PG8_SCHED;
            PG8_STAGE(PG8_SB(1, 1), b3 + hstep, voffB);
            PG8_WAIT_V(6); PG8_BAR; PG8_MMA(1, 1, At, B1); PG8_BAR;
            }
        }
        if constexpr (ALIGN_EPI) { if (wr == 0) PG8_BAR; }
        if constexpr (!Epi::AFTER_DRAIN) { E(acc, cur, wr, wc, fr, fq); S.done(cur); }
        if (!has_next) break;
#pragma unroll
        for (int a = 0; a < 2; ++a)
#pragma unroll
            for (int b = 0; b < 2; ++b)
#pragma unroll
                for (int m = 0; m < 4; ++m)
#pragma unroll
                    for (int n = 0; n < 2; ++n) acc[a][b][m][n] = (f32x4){0.f, 0.f, 0.f, 0.f};
        cur = nxt; cA = nA; cB = nB; ++ui;
        if constexpr (ALIGN_EPI) { if (wr == 1) PG8_BAR; }
    }
    PG8_WAIT_V(0);
    if constexpr (!ALIGN_EPI) { if (wr == 0) PG8_BAR; }
    PG8_BAR;
    if constexpr (Epi::AFTER_DRAIN) { E.fused(acc, cur, wr, wc, fr, fq, lds, wid, lane); S.done(cur); }
#undef PG8_SA
#undef PG8_SB
#undef PG8_STAGE
#undef PG8_LDA
#undef PG8_LDB
#undef PG8_MMA
#undef PG8_WAIT_V
#undef PG8_WAIT_L
#undef PG8_BAR
#undef PG8_SCHED
}
}

#define GAS __attribute__((address_space(1)))
#define LAS __attribute__((address_space(3)))
typedef unsigned short bf16;
typedef float f32x4 __attribute__((ext_vector_type(4)));
typedef float f32x16 __attribute__((ext_vector_type(16)));
typedef short bf16x8 __attribute__((ext_vector_type(8)));
typedef short s16x4 __attribute__((ext_vector_type(4)));
typedef unsigned u32x4 __attribute__((ext_vector_type(4)));
typedef unsigned u32x2 __attribute__((ext_vector_type(2)));
typedef float f32x2_t __attribute__((ext_vector_type(2)));
typedef __bf16 bf16x2_t __attribute__((ext_vector_type(2)));
typedef GAS unsigned gu32;
#define RLX_AGENT __ATOMIC_RELAXED, __HIP_MEMORY_SCOPE_AGENT

constexpr int D = 1024, BP = 4, TP = 4096, MP = BP * TP, BS = 128, TS = 8, MS = BS * TS, M = MP + MS;
constexpr int SBH = 8, HD = 64, SBW = 512, DNH = 4, DND = 128, DNW = 512;
constexpr int IN_COLS = 3592, NPROJ = 3584;
constexpr int DFF = 2816, DFF2 = 5632, NMOD = 6144, NC = BP + BS;
constexpr int PAST = 2048, NPAGES = 16, PAGE = 128;
constexpr float EPS = 1e-6f, LOG2E = 1.4426950408889634f;
constexpr float QSCALE = 0.125f * LOG2E;
constexpr int NSPLIT = 4, NPART = 5;

constexpr size_t O_YP = 0, O_KP = 17825792, O_VP = 26214400, O_KS = 34603008, O_VS = 35127296, O_SP = 35651584, O_SS = 35913728,
                 O_DCP = 44302336, O_DCS = 44320768, O_FCP = 44910592, O_FCS = 44955648, O_END = 46397440;

constexpr size_t MiB = 1u << 20;
constexpr size_t WS_CTL = 0, CTL_ZERO_BYTES = MiB;
constexpr size_t WS_MOD = 1 * MiB, WS_SC = 5 * MiB, WS_WINX = 6 * MiB, WS_WIN_T = 7 * MiB, WS_WOUT_T = 14 * MiB, WS_WUP_T = 16 * MiB, WS_WDN_T = 27 * MiB,
                 WS_EXTRA = 33 * MiB, WS_H = 34 * MiB, WS_PROJ = 68 * MiB, WS_QB = 306 * MiB, WS_KB = 323 * MiB, WS_VT = 340 * MiB, WS_QD = 357 * MiB, WS_KD = 391 * MiB,
                 WS_VD = 425 * MiB, WS_BETA = 459 * MiB, WS_LOGA = 460 * MiB, WS_ODN = 461 * MiB, WS_MIXED = 495 * MiB, WS_X1 = 529 * MiB, WS_UP = 597 * MiB,
                 WS_ACT = 784 * MiB, WS_U = 878 * MiB, WS_KCUM = 910 * MiB, WS_QDEC = 926 * MiB, WS_KDECT = 942 * MiB, WS_INTRA = 958 * MiB, WS_GL = 966 * MiB,
                 WS_OPART = 967 * MiB, WS_LPART = 978 * MiB, WS_END = 979 * MiB;
constexpr int CW_QUEUE = 64;
constexpr int CW_BAR = 4096;

constexpr int RING_BYTES = 131072, MISC_OFF = RING_BYTES + 320, LDS_BYTES = 147456;

__device__ __forceinline__ unsigned cvtpk(float lo, float hi) { f32x2_t v = {lo, hi}; bf16x2_t b = __builtin_convertvector(v, bf16x2_t); return __builtin_bit_cast(unsigned, b); }
__device__ __forceinline__ bf16 f2bf(float f) { return (bf16)(cvtpk(f, 0.f) & 0xffffu); }
__device__ __forceinline__ float wave_sum(float v) {
#pragma unroll
    for (int o = 1; o < 64; o <<= 1) v += __shfl_xor(v, o);
    return v;
}
__device__ __forceinline__ float siluf(float x) { return x / (1.f + __expf(-x)); }
__device__ __forceinline__ u32x4 pack8(const f32x4 a, const f32x4 b) { u32x4 w; w.x = cvtpk(a.x, a.y); w.y = cvtpk(a.z, a.w); w.z = cvtpk(b.x, b.y); w.w = cvtpk(b.z, b.w); return w; }
__device__ __forceinline__ float bf2f(unsigned short h) { return __uint_as_float((unsigned)h << 16); }

#define XB_TMO      128
#define XB_XCNT(j)  (256  + 64 * (j))
#define XB_XSUB(j)  (1280 + 64 * (j))
#define XB_XGEN(j)  (2304 + 64 * (j))
#define XB_TOP      3328
#define XB_TOPGEN   3392
#define XCD_BAR_WORDS 3456
#define XB_SPIN_CAP (1u << 18)
__device__ __forceinline__ unsigned xb_ld(unsigned* p)              { return __hip_atomic_load(p, __ATOMIC_RELAXED, __HIP_MEMORY_SCOPE_AGENT); }
__device__ __forceinline__ unsigned xb_add(unsigned* p, unsigned v) { return __hip_atomic_fetch_add(p, v, __ATOMIC_RELAXED, __HIP_MEMORY_SCOPE_AGENT); }
__device__ __forceinline__ unsigned xb_xcc_id() { return (unsigned)__builtin_amdgcn_s_getreg((3 << 11) | 20) & 0xFu; }
#define XB_SPIN(cond, bar) do { unsigned _sp = 0; while (cond) { __builtin_amdgcn_s_sleep(1); \
    if ((++_sp & 255u) == 0u) { if (xb_ld(&(bar)[XB_TMO])) break; if (_sp > XB_SPIN_CAP) { atomicAdd(&(bar)[XB_TMO], 1u); break; } } } } while (0)
struct XcdBarrier { unsigned* bar; unsigned x; volatile LAS unsigned* st; };
__device__ __forceinline__ XcdBarrier xcd_barrier_post(unsigned* bar, volatile LAS unsigned* st) {
    XcdBarrier b; b.bar = bar; b.x = xb_xcc_id(); b.st = st;
    if (threadIdx.x == 0) (void)xb_add(&bar[XB_XCNT(b.x)], 1u);
    return b;
}
__device__ __forceinline__ void xcd_barrier_complete(unsigned* bar, unsigned x, unsigned& nloc, unsigned& nx) {
    const unsigned G = gridDim.x * gridDim.y * gridDim.z;
    unsigned sum, cnt, mine, sp = 0u;
    for (;;) {
        sum = 0u; cnt = 0u; mine = 0u;
#pragma unroll
        for (unsigned j = 0; j < 16; ++j) { const unsigned c = xb_ld(&bar[XB_XCNT(j)]); sum += c; cnt += (c > 0u) ? 1u : 0u; mine = (j == x) ? c : mine; }
        if (sum == G) break;
        __builtin_amdgcn_s_sleep(1);
        if ((++sp & 255u) == 0u) { if (xb_ld(&bar[XB_TMO])) break; if (sp > XB_SPIN_CAP) { atomicAdd(&bar[XB_TMO], 1u); break; } }
    }
    nloc = mine > 0u ? mine : 1u; nx = cnt > 0u ? cnt : 1u;
}
__device__ __forceinline__ void xcd_barrier(const XcdBarrier& b) {
    asm volatile("s_waitcnt vmcnt(0)" ::: "memory");
    __syncthreads();
    if (threadIdx.x == 0) {
        unsigned* bar = b.bar;
        __builtin_amdgcn_s_waitcnt(0);
        unsigned nloc = b.st[0], nx = b.st[1];
        if (nloc == 0u) { xcd_barrier_complete(bar, b.x, nloc, nx); b.st[0] = nloc; b.st[1] = nx; }
        const unsigned old = xb_add(&bar[XB_XSUB(b.x)], 1u);
        const unsigned gen = old / nloc;
        if (old + 1u == (gen + 1u) * nloc) {
            __builtin_amdgcn_fence(__ATOMIC_RELEASE, "agent");
            asm volatile("s_waitcnt vmcnt(0)" ::: "memory");
            const unsigned og = xb_add(&bar[XB_TOP], 1u);
            const unsigned tg = og / nx;
            if (og + 1u == (tg + 1u) * nx) xb_add(&bar[XB_TOPGEN], 1u);
            else XB_SPIN(xb_ld(&bar[XB_TOPGEN]) == tg, bar);
            __builtin_amdgcn_fence(__ATOMIC_ACQUIRE, "agent");
            xb_add(&bar[XB_XGEN(b.x)], 1u);
            asm volatile("s_waitcnt vmcnt(0)" ::: "memory");
        } else {
            XB_SPIN(xb_ld(&bar[XB_XGEN(b.x)]) == gen, bar);
            __builtin_amdgcn_fence(__ATOMIC_ACQUIRE, "agent");
            asm volatile("s_waitcnt vmcnt(0)" ::: "memory");
        }
    }
    __syncthreads();
}

struct Args { const void* in[27]; float* out; unsigned char* ws; int lo, hi; };
enum { I_XP = 0, I_XS, I_CP, I_CS, I_CK, I_CV, I_PT, I_SD, I_SDC, I_SFC, I_WADA, I_BADA, I_GATT, I_WIN, I_GQ, I_GK, I_SBB, I_GSBO, I_WDNC, I_ALOG, I_DTB, I_GDNO, I_WOUT, I_GFFN, I_WUP, I_WFC, I_WDN };

__device__ __forceinline__ int mod_row(int m) { return m < MP ? (m >> 12) : BP + ((m - MP) >> 3); }

struct EpiF32 {
    static constexpr bool PERM = false, AFTER_DRAIN = false;
    float* O; int ldc;
    __device__ __forceinline__ void operator()(const pg8::f32x4 (&acc)[2][2][4][2], const pg8::Unit& u, int wr, int wc, int fr, int fq) const {
        const int row0 = u.pm * 256 + wr * 64 + fr, col0 = u.pn * 256 + wc * 32 + 4 * fq;
#pragma unroll
        for (int ai = 0; ai < 2; ++ai)
#pragma unroll
            for (int m = 0; m < 4; ++m) { float* rowp = O + (size_t)(row0 + ai * 128 + m * 16) * ldc + col0;
#pragma unroll
                for (int bj = 0; bj < 2; ++bj)
#pragma unroll
                    for (int n = 0; n < 2; ++n) *(pg8::f32x4*)(rowp + bj * 128 + n * 16) = acc[ai][bj][m][n]; }
    }
};
struct EpiResGate {
    static constexpr bool PERM = false, AFTER_DRAIN = false;
    const float* base0; const float* base1; const float* mod; int goff; float* out;
    __device__ __forceinline__ void operator()(const pg8::f32x4 (&acc)[2][2][4][2], const pg8::Unit& u, int wr, int wc, int fr, int fq) const {
        const int row0 = u.pm * 256 + wr * 64 + fr, col0 = u.pn * 256 + wc * 32 + 4 * fq;
#pragma unroll
        for (int ai = 0; ai < 2; ++ai)
#pragma unroll
            for (int m = 0; m < 4; ++m) { const int r = row0 + ai * 128 + m * 16;
                const float* bp = (r < MP ? base0 + (size_t)r * D : base1 + (size_t)(r - MP) * D) + col0;
                const float* gp = mod + (size_t)mod_row(r) * NMOD + goff + col0; float* op = out + (size_t)r * D + col0;
#pragma unroll
                for (int bj = 0; bj < 2; ++bj)
#pragma unroll
                    for (int n = 0; n < 2; ++n) { const pg8::f32x4 b = *(const pg8::f32x4*)(bp + bj * 128 + n * 16), g = *(const pg8::f32x4*)(gp + bj * 128 + n * 16);
                        *(pg8::f32x4*)(op + bj * 128 + n * 16) = b + g * acc[ai][bj][m][n]; } }
    }
};

__device__ __forceinline__ void transpose_item(const float* W, int ldw, int src_col0, bf16* WT, int Kdst, int dst_row0, int k0, LAS float* scr, int lane) {
#pragma unroll 8
    for (int i = 0; i < 32; ++i) { const int kk = 2 * i + (lane >> 5); scr[kk * 33 + (lane & 31)] = W[(size_t)(k0 + kk) * ldw + src_col0 + (lane & 31)]; }
    asm volatile("s_waitcnt lgkmcnt(0)" ::: "memory");
    const int c = lane & 7;
#pragma unroll
    for (int j = 0; j < 4; ++j) { const int n = (lane >> 3) + 8 * j; const LAS float* s = scr + (8 * c) * 33 + n;
        u32x4 o; o.x = cvtpk(s[0 * 33], s[1 * 33]); o.y = cvtpk(s[2 * 33], s[3 * 33]); o.z = cvtpk(s[4 * 33], s[5 * 33]); o.w = cvtpk(s[6 * 33], s[7 * 33]);
        *(u32x4*)(WT + (size_t)(dst_row0 + n) * Kdst + k0 + 8 * c) = o; }
    asm volatile("s_waitcnt lgkmcnt(0)" ::: "memory");
}
__device__ __forceinline__ void phase_prologue(const Args& A, LAS unsigned char* lds, int gw, int NGW, int wave, int lane, int gtid, int NGT) {
    unsigned char* ws = A.ws;
    LAS float* scr = (LAS float*)(lds + wave * 16384);
    const float* w_in = (const float*)A.in[I_WIN]; const float* w_out = (const float*)A.in[I_WOUT]; const float* w_up = (const float*)A.in[I_WUP]; const float* w_dn = (const float*)A.in[I_WDN];
    constexpr int I_IN = 16 * (NPROJ / 32), I_OUT = 16 * 32, I_UP = 16 * (DFF2 / 32), I_DN = (DFF / 64) * 32, NIT = I_IN + I_OUT + I_UP + I_DN;
    for (int it = gw; it < NIT; it += NGW) {
        int r = it;
        if (r < I_IN) { const int nb = r % (NPROJ / 32), kb = r / (NPROJ / 32); const int n0 = nb * 32; transpose_item(w_in, IN_COLS, n0 < 3072 ? n0 : n0 + 8, (bf16*)(ws + WS_WIN_T), D, n0, kb * 64, scr, lane); continue; } r -= I_IN;
        if (r < I_OUT) { const int nb = r % 32, kb = r / 32; transpose_item(w_out, D, nb * 32, (bf16*)(ws + WS_WOUT_T), D, nb * 32, kb * 64, scr, lane); continue; } r -= I_OUT;
        if (r < I_UP) { const int nb = r % (DFF2 / 32), kb = r / (DFF2 / 32); transpose_item(w_up, DFF2, nb * 32, (bf16*)(ws + WS_WUP_T), D, nb * 32, kb * 64, scr, lane); continue; } r -= I_UP;
        { const int nb = r % 32, kb = r / 32; transpose_item(w_dn, D, nb * 32, (bf16*)(ws + WS_WDN_T), DFF, nb * 32, kb * 64, scr, lane); }
    }
    bf16* SC = (bf16*)(ws + WS_SC); const float* cp = (const float*)A.in[I_CP]; const float* cs = (const float*)A.in[I_CS];
    for (int i = gtid; i < 144 * D; i += NGT) { const int r = i >> 10, k = i & 1023; float v = 0.f; if (r < BP) v = cp[r * D + k]; else if (r < NC) v = cs[(r - BP) * D + k]; SC[i] = (r < NC) ? f2bf(siluf(v)) : (bf16)0; }
    float* WX = (float*)(ws + WS_WINX);
    for (int i = gtid; i < 8 * D; i += NGT) { const int j = i >> 10, k = i & 1023; WX[i] = w_in[(size_t)k * IN_COLS + 3072 + j]; }
}

__device__ __forceinline__ void phase_mod(const Args& A, int gw, int NGW, int lane) {
    const float* w_ada = (const float*)A.in[I_WADA]; const float* b_ada = (const float*)A.in[I_BADA];
    const bf16* SC = (const bf16*)(A.ws + WS_SC); float* MOD = (float*)(A.ws + WS_MOD);
    const int lr = lane & 15, q = lane >> 4;
    for (int it = gw; it < NMOD / 16; it += NGW) {
        const int col = it * 16 + lr;
        pg8::f32x4 acc[9];
#pragma unroll
        for (int i = 0; i < 9; ++i) acc[i] = (pg8::f32x4){0.f, 0.f, 0.f, 0.f};
#pragma unroll 2
        for (int s = 0; s < 32; ++s) {
            const float* wp = w_ada + (size_t)(32 * s + 8 * q) * NMOD + col;
            float w[8];
#pragma unroll
            for (int j = 0; j < 8; ++j) w[j] = wp[(size_t)j * NMOD];
            u32x4 bw; bw.x = cvtpk(w[0], w[1]); bw.y = cvtpk(w[2], w[3]); bw.z = cvtpk(w[4], w[5]); bw.w = cvtpk(w[6], w[7]);
            const bf16x8 bfr = __builtin_bit_cast(bf16x8, bw);
#pragma unroll
            for (int i = 0; i < 9; ++i) { const bf16x8 a = *(const bf16x8*)(SC + (size_t)(16 * i + lr) * D + 32 * s + 8 * q); acc[i] = __builtin_amdgcn_mfma_f32_16x16x32_bf16(a, bfr, acc[i], 0, 0, 0); }
        }
        const float bb = b_ada[col];
#pragma unroll
        for (int i = 0; i < 9; ++i)
#pragma unroll
            for (int r = 0; r < 4; ++r) { const int row = 16 * i + 4 * q + r; if (row < NC) MOD[(size_t)row * NMOD + col] = acc[i][r] + bb; }
    }
}

template <bool EXTRAS>
__device__ __forceinline__ void phase_norm(const float* x0, const float* x1, const float* g, const float* MOD, int sh_off, int sc_off, bf16* H, const float* WX, float* EXTRA, int gw, int NGW, int lane) {
    for (int m = gw; m < M; m += NGW) {
        const float* xr = m < MP ? x0 + (size_t)m * D : x1 + (size_t)(m - MP) * D;
        const float* mod = MOD + (size_t)mod_row(m) * NMOD;
        f32x4 v[4]; float ss = 0.f;
#pragma unroll
        for (int j = 0; j < 4; ++j) { v[j] = *(const f32x4*)(xr + 4 * (lane + 64 * j)); ss += (v[j].x * v[j].x + v[j].y * v[j].y) + (v[j].z * v[j].z + v[j].w * v[j].w); }
        ss = wave_sum(ss);
        const float rstd = 1.0f / sqrtf(ss * (1.f / D) + EPS);
        float ex[8];
#pragma unroll
        for (int e = 0; e < 8; ++e) ex[e] = 0.f;
#pragma unroll
        for (int j = 0; j < 4; ++j) { const int c = 4 * (lane + 64 * j);
            const f32x4 gg = *(const f32x4*)(g + c), sc = *(const f32x4*)(mod + sc_off + c), sh = *(const f32x4*)(mod + sh_off + c);
            const f32x4 h = (v[j] * rstd) * gg * (sc + 1.0f) + sh;
            u32x2 w; w.x = cvtpk(h.x, h.y); w.y = cvtpk(h.z, h.w); *(u32x2*)(H + (size_t)m * D + c) = w;
            if (EXTRAS) {
#pragma unroll
                for (int e = 0; e < 8; ++e) { const f32x4 wx = *(const f32x4*)(WX + e * D + c); ex[e] += (h.x * wx.x + h.y * wx.y) + (h.z * wx.z + h.w * wx.w); }
            }
        }
        if (EXTRAS) {
#pragma unroll
            for (int e = 0; e < 8; ++e) ex[e] = wave_sum(ex[e]);
            float mine = ex[0];
#pragma unroll
            for (int e = 1; e < 8; ++e) mine = (lane == e) ? ex[e] : mine;
            if (lane < 8) EXTRA[(size_t)m * 8 + lane] = mine;
        }
    }
}

__device__ __forceinline__ void phase_post(const Args& A, int gw, int NGW, int lane) {
    unsigned char* ws = A.ws; const float* PROJ = (const float*)(ws + WS_PROJ); float* out = A.out;
    const float* g_q = (const float*)A.in[I_GQ]; const float* g_k = (const float*)A.in[I_GK]; const float* wc = (const float*)A.in[I_WDNC];
    const float* sdc = (const float*)A.in[I_SDC]; const float* a_log = (const float*)A.in[I_ALOG]; const float* dtb = (const float*)A.in[I_DTB];
    bf16* QB = (bf16*)(ws + WS_QB); bf16* KB = (bf16*)(ws + WS_KB);
    float* QD = (float*)(ws + WS_QD); float* KD = (float*)(ws + WS_KD); float* VD = (float*)(ws + WS_VD);
    float* BETA = (float*)(ws + WS_BETA); float* LOGA = (float*)(ws + WS_LOGA); const float* EXTRA = (const float*)(ws + WS_EXTRA);
    const int c8 = 8 * lane;
    for (int m = gw; m < M; m += NGW) {
        const bool prompt = m < MP; const int b = prompt ? (m >> 12) : ((m - MP) >> 3), t = prompt ? (m & 4095) : ((m - MP) & 7);
        const float* pr = PROJ + (size_t)m * NPROJ;
        {
            f32x4 a0 = *(const f32x4*)(pr + c8), a1 = *(const f32x4*)(pr + c8 + 4);
            float ss = (a0.x * a0.x + a0.y * a0.y) + (a0.z * a0.z + a0.w * a0.w) + (a1.x * a1.x + a1.y * a1.y) + (a1.z * a1.z + a1.w * a1.w);
            ss += __shfl_xor(ss, 1); ss += __shfl_xor(ss, 2); ss += __shfl_xor(ss, 4);
            const float rs = QSCALE / sqrtf(ss * (1.f / HD) + EPS);
            const f32x4 g0 = *(const f32x4*)(g_q + (c8 & 63)), g1 = *(const f32x4*)(g_q + (c8 & 63) + 4);
            *(u32x4*)(QB + (size_t)m * SBW + c8) = pack8(a0 * rs * g0, a1 * rs * g1);
        }
        {
            f32x4 a0 = *(const f32x4*)(pr + 512 + c8), a1 = *(const f32x4*)(pr + 512 + c8 + 4);
            float ss = (a0.x * a0.x + a0.y * a0.y) + (a0.z * a0.z + a0.w * a0.w) + (a1.x * a1.x + a1.y * a1.y) + (a1.z * a1.z + a1.w * a1.w);
            ss += __shfl_xor(ss, 1); ss += __shfl_xor(ss, 2); ss += __shfl_xor(ss, 4);
            const float rs = 1.0f / sqrtf(ss * (1.f / HD) + EPS);
            const f32x4 g0 = *(const f32x4*)(g_k + (c8 & 63)), g1 = *(const f32x4*)(g_k + (c8 & 63) + 4);
            a0 = a0 * rs * g0; a1 = a1 * rs * g1;
            float* ko = prompt ? out + O_KP + (size_t)m * SBW + c8 : out + O_KS + (size_t)(m - MP) * SBW + c8;
            *(f32x4*)ko = a0; *(f32x4*)(ko + 4) = a1;
            *(u32x4*)(KB + (size_t)m * SBW + c8) = pack8(a0, a1);
        }
        {
            const f32x4 a0 = *(const f32x4*)(pr + 1024 + c8), a1 = *(const f32x4*)(pr + 1024 + c8 + 4);
            float* vo = prompt ? out + O_VP + (size_t)m * SBW + c8 : out + O_VS + (size_t)(m - MP) * SBW + c8;
            *(f32x4*)vo = a0; *(f32x4*)(vo + 4) = a1;
        }
#pragma unroll
        for (int part = 0; part < 3; ++part) {
            const int ch = part * 512 + c8;
            f32x4 y0 = (f32x4){0.f, 0.f, 0.f, 0.f}, y1 = y0;
#pragma unroll
            for (int i = 0; i < 4; ++i) {
                const int tt = t - 3 + i;
                f32x4 x0, x1;
                if (tt >= 0) { const float* p = pr - (size_t)(3 - i) * NPROJ + 1536 + ch; x0 = *(const f32x4*)p; x1 = *(const f32x4*)(p + 4); }
                else if (!prompt) { const float* p = sdc + ((size_t)b * 3 + (3 + tt)) * 1536 + ch; x0 = *(const f32x4*)p; x1 = *(const f32x4*)(p + 4); }
                else { x0 = (f32x4){0.f, 0.f, 0.f, 0.f}; x1 = x0; }
                const f32x4 w0 = *(const f32x4*)(wc + i * 1536 + ch), w1 = *(const f32x4*)(wc + i * 1536 + ch + 4);
                y0 += w0 * x0; y1 += w1 * x1;
                if (i == 3) {
                    const int idx = prompt ? t - (TP - 3) : t - (TS - 3);
                    if (idx >= 0) { float* o = prompt ? out + O_DCP + ((size_t)b * 3 + idx) * 1536 + ch : out + O_DCS + ((size_t)b * 3 + idx) * 1536 + ch; *(f32x4*)o = x0; *(f32x4*)(o + 4) = x1; }
                }
            }
            y0.x = siluf(y0.x); y0.y = siluf(y0.y); y0.z = siluf(y0.z); y0.w = siluf(y0.w); y1.x = siluf(y1.x); y1.y = siluf(y1.y); y1.z = siluf(y1.z); y1.w = siluf(y1.w);
            if (part < 2) {
                float ss = (y0.x * y0.x + y0.y * y0.y) + (y0.z * y0.z + y0.w * y0.w) + (y1.x * y1.x + y1.y * y1.y) + (y1.z * y1.z + y1.w * y1.w);
                ss += __shfl_xor(ss, 1); ss += __shfl_xor(ss, 2); ss += __shfl_xor(ss, 4); ss += __shfl_xor(ss, 8);
                const float rs = (part == 0 ? 0.08838834764831845f : 1.0f) / sqrtf(ss + EPS);
                y0 = y0 * rs; y1 = y1 * rs;
            }
            float* dst = (part == 0 ? QD : part == 1 ? KD : VD) + (size_t)m * DNW + c8;
            *(f32x4*)dst = y0; *(f32x4*)(dst + 4) = y1;
        }
        if (lane < 8) {
            const float x = EXTRA[(size_t)m * 8 + lane];
            if (lane < 4) BETA[(size_t)m * 4 + lane] = 1.f / (1.f + __expf(-x));
            else { const int h = lane - 4; const float z = x + dtb[h]; const float sp = fmaxf(z, 0.f) + log1pf(__expf(-fabsf(z))); LOGA[(size_t)m * 4 + h] = -__expf(a_log[h]) * sp; }
        }
    }
}

__device__ __forceinline__ void dn_prescan_unit(const Args& A, LAS unsigned char* lds, int unit, int tid, int wave, int lane) {
    unsigned char* ws = A.ws;
    const float* QD = (const float*)(ws + WS_QD); const float* KD = (const float*)(ws + WS_KD); const float* VD = (const float*)(ws + WS_VD);
    const float* BETA = (const float*)(ws + WS_BETA); const float* LOGA = (const float*)(ws + WS_LOGA);
    const int hp = unit & 1, n = (unit >> 1) & 63, b = unit >> 7;
    const int half = tid >> 8, ht = tid & 255, h = 2 * hp + half, item = (b * 64 + n) * 4 + h;
    const int m0 = b * TP + n * 64;
    LAS float* Am = (LAS float*)lds + half * 4096;
    LAS float* gs = (LAS float*)(lds + 32768) + half * 128;
    if (ht < 64) {
        float v = LOGA[(size_t)(m0 + ht) * 4 + h];
#pragma unroll
        for (int o = 1; o < 64; o <<= 1) { const float u = __shfl_up(v, o); if (ht >= o) v += u; }
        gs[ht] = v; gs[64 + ht] = BETA[(size_t)(m0 + ht) * 4 + h];
    }
    __syncthreads();
    {
        const int wl = wave & 3, lr = lane & 15, q = lane >> 4;
        pg8::f32x4 kk[4], qk[4];
#pragma unroll
        for (int j = 0; j < 4; ++j) { kk[j] = (pg8::f32x4){0.f, 0.f, 0.f, 0.f}; qk[j] = kk[j]; }
#pragma unroll
        for (int s = 0; s < 4; ++s) {
            const float* kp = KD + (size_t)(m0 + 16 * wl + lr) * DNW + h * 128 + 32 * s + 8 * q; const float* qp = QD + (size_t)(m0 + 16 * wl + lr) * DNW + h * 128 + 32 * s + 8 * q;
            const bf16x8 ak = __builtin_bit_cast(bf16x8, pack8(*(const f32x4*)kp, *(const f32x4*)(kp + 4))), aq = __builtin_bit_cast(bf16x8, pack8(*(const f32x4*)qp, *(const f32x4*)(qp + 4)));
#pragma unroll
            for (int j = 0; j < 4; ++j) { const float* bp = KD + (size_t)(m0 + 16 * j + lr) * DNW + h * 128 + 32 * s + 8 * q;
                const bf16x8 bk = __builtin_bit_cast(bf16x8, pack8(*(const f32x4*)bp, *(const f32x4*)(bp + 4)));
                kk[j] = __builtin_amdgcn_mfma_f32_16x16x32_bf16(ak, bk, kk[j], 0, 0, 0); qk[j] = __builtin_amdgcn_mfma_f32_16x16x32_bf16(aq, bk, qk[j], 0, 0, 0); }
        }
        bf16* INTRA = (bf16*)(ws + WS_INTRA) + (size_t)item * 4096;
#pragma unroll
        for (int j = 0; j < 4; ++j)
#pragma unroll
            for (int r = 0; r < 4; ++r) { const int i = 16 * wl + 4 * q + r, jj = 16 * j + lr;
                const float dec = (i >= jj) ? __expf(gs[i] - gs[jj]) : 0.f;
                Am[i * 64 + jj] = (i > jj) ? gs[64 + i] * kk[j][r] * dec : 0.f;
                INTRA[i * 64 + jj] = f2bf(qk[j][r] * dec); }
    }
    __syncthreads();
    {
        const int c = ht; float x[64];
        float* U = (float*)(ws + WS_U) + (size_t)item * 8192; bf16* KC = (bf16*)(ws + WS_KCUM) + (size_t)item * 8192;
#pragma unroll
        for (int i = 0; i < 64; ++i) {
            const float bi = gs[64 + i];
            float r = (c < 128) ? VD[(size_t)(m0 + i) * DNW + h * 128 + c] * bi : KD[(size_t)(m0 + i) * DNW + h * 128 + (c - 128)] * bi * __expf(gs[i]);
#pragma unroll
            for (int j = 0; j < i; ++j) r -= Am[i * 64 + j] * x[j];
            x[i] = r;
            if (c < 128) U[i * 128 + c] = r; else KC[i * 128 + (c - 128)] = f2bf(r);
        }
    }
    {
        const float glast = gs[63];
        bf16* QDc = (bf16*)(ws + WS_QDEC) + (size_t)item * 8192; bf16* KT = (bf16*)(ws + WS_KDECT) + (size_t)item * 8192;
        for (int e = ht; e < 64 * 128; e += 256) { const int i = e >> 7, d = e & 127; QDc[e] = f2bf(QD[(size_t)(m0 + i) * DNW + h * 128 + d] * __expf(gs[i])); }
        { const int d = ht & 127, ig = ht >> 7;
#pragma unroll
            for (int i8 = 0; i8 < 4; ++i8) { float v[8];
#pragma unroll
                for (int k = 0; k < 8; ++k) { const int i = 32 * ig + 8 * i8 + k; v[k] = KD[(size_t)(m0 + i) * DNW + h * 128 + d] * __expf(glast - gs[i]); }
                u32x4 w; w.x = cvtpk(v[0], v[1]); w.y = cvtpk(v[2], v[3]); w.z = cvtpk(v[4], v[5]); w.w = cvtpk(v[6], v[7]);
                *(u32x4*)(KT + d * 64 + 32 * ig + 8 * i8) = w; } }
        if (ht == 0) ((float*)(ws + WS_GL))[item] = __expf(glast);
    }
    __syncthreads();
}
__device__ __forceinline__ void dn_sample_unit(const Args& A, LAS unsigned char* lds, int unit, int tid) {
    unsigned char* ws = A.ws;
    const float* QD = (const float*)(ws + WS_QD); const float* KD = (const float*)(ws + WS_KD); const float* VD = (const float*)(ws + WS_VD);
    const float* BETA = (const float*)(ws + WS_BETA); const float* LOGA = (const float*)(ws + WS_LOGA); float* ODN = (float*)(ws + WS_ODN);
    const int h = unit & 3, b = unit >> 2, e = tid & 127, dq = tid >> 7;
    const float* s0 = (const float*)A.in[I_SD] + ((size_t)(b * 4 + h) * 128 + 32 * dq) * 128 + e;
    float S[32];
#pragma unroll
    for (int d = 0; d < 32; ++d) S[d] = s0[(size_t)d * 128];
    LAS float* red = (LAS float*)lds; LAS float* red2 = red + 512;
    for (int t = 0; t < TS; ++t) {
        const int m = MP + b * TS + t;
        const float a = __expf(LOGA[(size_t)m * 4 + h]), bt = BETA[(size_t)m * 4 + h];
        const float* kp = KD + (size_t)m * DNW + h * 128 + 32 * dq; const float* qp = QD + (size_t)m * DNW + h * 128 + 32 * dq;
        float kd[32], qd[32];
#pragma unroll
        for (int d4 = 0; d4 < 8; ++d4) { const f32x4 kv = *(const f32x4*)(kp + 4 * d4), qv = *(const f32x4*)(qp + 4 * d4);
            kd[4 * d4] = kv.x; kd[4 * d4 + 1] = kv.y; kd[4 * d4 + 2] = kv.z; kd[4 * d4 + 3] = kv.w; qd[4 * d4] = qv.x; qd[4 * d4 + 1] = qv.y; qd[4 * d4 + 2] = qv.z; qd[4 * d4 + 3] = qv.w; }
        float p = 0.f;
#pragma unroll
        for (int d = 0; d < 32; ++d) p += kd[d] * S[d];
        red[dq * 128 + e] = p;
        __syncthreads();
        const float kS = (red[e] + red[128 + e]) + (red[256 + e] + red[384 + e]);
        const float dl = bt * (VD[(size_t)m * DNW + h * 128 + e] - a * kS);
        float po = 0.f;
#pragma unroll
        for (int d = 0; d < 32; ++d) { S[d] = a * S[d] + kd[d] * dl; po += qd[d] * S[d]; }
        red2[dq * 128 + e] = po;
        __syncthreads();
        if (dq == 0) ODN[(size_t)m * DNW + h * 128 + e] = (red2[e] + red2[128 + e]) + (red2[256 + e] + red2[384 + e]);
    }
    float* so = A.out + O_SS + ((size_t)(b * 4 + h) * 128 + 32 * dq) * 128 + e;
#pragma unroll
    for (int d = 0; d < 32; ++d) so[(size_t)d * 128] = S[d];
    __syncthreads();
}

__device__ __forceinline__ void dn_scan_chain(const Args& A, int chain, int wave, int lane) {
    unsigned char* ws = A.ws;
    const float* Ub = (const float*)(ws + WS_U); const bf16* KCb = (const bf16*)(ws + WS_KCUM); const bf16* QDb = (const bf16*)(ws + WS_QDEC);
    const bf16* KTb = (const bf16*)(ws + WS_KDECT); const bf16* INb = (const bf16*)(ws + WS_INTRA); const float* GL = (const float*)(ws + WS_GL); float* ODN = (float*)(ws + WS_ODN);
    const int b = chain >> 2, h = chain & 3, lr = lane & 15, q = lane >> 4, e = 16 * wave + lr;
    pg8::f32x4 S[8];
#pragma unroll
    for (int i = 0; i < 8; ++i) S[i] = (pg8::f32x4){0.f, 0.f, 0.f, 0.f};
    for (int n = 0; n < 64; ++n) {
        const int item = (b * 64 + n) * 4 + h;
        const float* U = Ub + (size_t)item * 8192; const bf16* KC = KCb + (size_t)item * 8192; const bf16* QDc = QDb + (size_t)item * 8192;
        const bf16* KT = KTb + (size_t)item * 8192; const bf16* IN = INb + (size_t)item * 4096; const float gl = GL[item];
        bf16x8 Sb[4];
#pragma unroll
        for (int s = 0; s < 4; ++s) { u32x4 w; w.x = cvtpk(S[2 * s][0], S[2 * s][1]); w.y = cvtpk(S[2 * s][2], S[2 * s][3]); w.z = cvtpk(S[2 * s + 1][0], S[2 * s + 1][1]); w.w = cvtpk(S[2 * s + 1][2], S[2 * s + 1][3]); Sb[s] = __builtin_bit_cast(bf16x8, w); }
        pg8::f32x4 vn[4], o[4];
#pragma unroll
        for (int i = 0; i < 4; ++i) {
            pg8::f32x4 ak = (pg8::f32x4){0.f, 0.f, 0.f, 0.f}, aq = ak;
#pragma unroll
            for (int s = 0; s < 4; ++s) {
                const bf16* kp = KC + (16 * i + lr) * 128 + 32 * s + 4 * q; const bf16* qp = QDc + (16 * i + lr) * 128 + 32 * s + 4 * q;
                const u32x2 k0 = *(const u32x2*)kp, k1 = *(const u32x2*)(kp + 16), q0 = *(const u32x2*)qp, q1 = *(const u32x2*)(qp + 16);
                const bf16x8 fk = __builtin_bit_cast(bf16x8, (u32x4){k0.x, k0.y, k1.x, k1.y}), fq_ = __builtin_bit_cast(bf16x8, (u32x4){q0.x, q0.y, q1.x, q1.y});
                ak = __builtin_amdgcn_mfma_f32_16x16x32_bf16(fk, Sb[s], ak, 0, 0, 0); aq = __builtin_amdgcn_mfma_f32_16x16x32_bf16(fq_, Sb[s], aq, 0, 0, 0);
            }
#pragma unroll
            for (int r = 0; r < 4; ++r) vn[i][r] = U[(16 * i + 4 * q + r) * 128 + e] - ak[r];
            o[i] = aq;
            __builtin_amdgcn_sched_barrier(0);
        }
        bf16x8 Vb[2];
#pragma unroll
        for (int s = 0; s < 2; ++s) { u32x4 w; w.x = cvtpk(vn[2 * s][0], vn[2 * s][1]); w.y = cvtpk(vn[2 * s][2], vn[2 * s][3]); w.z = cvtpk(vn[2 * s + 1][0], vn[2 * s + 1][1]); w.w = cvtpk(vn[2 * s + 1][2], vn[2 * s + 1][3]); Vb[s] = __builtin_bit_cast(bf16x8, w); }
#pragma unroll
        for (int i = 0; i < 4; ++i) {
#pragma unroll
            for (int s = 0; s < 2; ++s) { const bf16* ip = IN + (16 * i + lr) * 64 + 32 * s + 4 * q; const u32x2 a0 = *(const u32x2*)ip, a1 = *(const u32x2*)(ip + 16);
                o[i] = __builtin_amdgcn_mfma_f32_16x16x32_bf16(__builtin_bit_cast(bf16x8, (u32x4){a0.x, a0.y, a1.x, a1.y}), Vb[s], o[i], 0, 0, 0); }
#pragma unroll
            for (int r = 0; r < 4; ++r) ODN[(size_t)(b * TP + 64 * n + 16 * i + 4 * q + r) * DNW + h * 128 + e] = o[i][r];
            __builtin_amdgcn_sched_barrier(0);
        }
#pragma unroll
        for (int i = 0; i < 8; ++i) {
            pg8::f32x4 acc = S[i] * gl;
#pragma unroll
            for (int s = 0; s < 2; ++s) { const bf16* tp = KT + (16 * i + lr) * 64 + 32 * s + 4 * q; const u32x2 a0 = *(const u32x2*)tp, a1 = *(const u32x2*)(tp + 16);
                acc = __builtin_amdgcn_mfma_f32_16x16x32_bf16(__builtin_bit_cast(bf16x8, (u32x4){a0.x, a0.y, a1.x, a1.y}), Vb[s], acc, 0, 0, 0); }
            S[i] = acc;
            if (i & 1) __builtin_amdgcn_sched_barrier(0);
        }
    }
    float* so = A.out + O_SP + (size_t)(b * 4 + h) * 16384;
#pragma unroll
    for (int i = 0; i < 8; ++i)
#pragma unroll
        for (int r = 0; r < 4; ++r) so[(16 * i + 4 * q + r) * 128 + e] = S[i][r];
}

__device__ __forceinline__ int crow(int r, int hi) { return (r & 3) + 8 * (r >> 2) + 4 * hi; }
__device__ __forceinline__ void sb_core(f32x16& p, float& carry, int hi) {
    float s[16];
#pragma unroll
    for (int r = 0; r < 16; ++r) { const float e = __builtin_amdgcn_exp2f(p[r]); s[r] = -__builtin_amdgcn_logf(1.0f + e); }
    float tt[4], uu[4];
#pragma unroll
    for (int i = 0; i < 4; ++i) { s[4 * i + 2] += s[4 * i + 3]; s[4 * i + 1] += s[4 * i + 2]; s[4 * i] += s[4 * i + 1]; tt[i] = s[4 * i]; }
#pragma unroll
    for (int i = 0; i < 4; ++i) uu[i] = __shfl_xor(tt[i], 32);
    const float w3 = tt[3] + uu[3], w2 = tt[2] + uu[2], w1 = tt[1] + uu[1], w0 = tt[0] + uu[0];
    float off[4];
    off[3] = carry; off[2] = carry + w3; off[1] = off[2] + w2; off[0] = off[1] + w1;
    carry = off[0] + w0;
    if (hi == 0) {
#pragma unroll
        for (int i = 0; i < 4; ++i) off[i] += uu[i];
    }
#pragma unroll
    for (int r = 0; r < 16; ++r) p[r] = __builtin_amdgcn_exp2f(p[r] + s[r] + off[r >> 2]);
}
__device__ __forceinline__ bf16x8 pack_p(const f32x16& p, int s) {
    u32x4 w; w.x = cvtpk(p[8 * s], p[8 * s + 1]); w.y = cvtpk(p[8 * s + 2], p[8 * s + 3]); w.z = cvtpk(p[8 * s + 4], p[8 * s + 5]); w.w = cvtpk(p[8 * s + 6], p[8 * s + 7]); return __builtin_bit_cast(bf16x8, w);
}
__device__ __forceinline__ void attn_prompt_item(const Args& A, int b, int h, int q0, int lane) {
    unsigned char* ws = A.ws;
    const bf16* QB = (const bf16*)(ws + WS_QB); const bf16* KB = (const bf16*)(ws + WS_KB); const bf16* VT = (const bf16*)(ws + WS_VT); bf16* MIXED = (bf16*)(ws + WS_MIXED);
    const int r32 = lane & 31, hi = lane >> 5, qpos = q0 + r32;
    const float bias2 = ((const float*)A.in[I_SBB])[h] * LOG2E;
    bf16x8 qf[4];
#pragma unroll
    for (int d0 = 0; d0 < 4; ++d0) qf[d0] = *(const bf16x8*)(QB + (size_t)(b * TP + qpos) * SBW + h * HD + 16 * d0 + 8 * hi);
    f32x16 o[2]; o[0] = (f32x16){}; o[1] = (f32x16){};
    float carry = 0.f;
    const int last = q0 + 30;
    for (int ht = last >> 5; ht >= 0; --ht) {
        const int kv0 = 32 * ht;
        f32x16 p;
#pragma unroll
        for (int r = 0; r < 16; ++r) p[r] = bias2;
        const bf16* kp = KB + (size_t)(b * TP + kv0 + r32) * SBW + h * HD + 8 * hi;
#pragma unroll
        for (int d0 = 0; d0 < 4; ++d0) { const bf16x8 kf = *(const bf16x8*)(kp + 16 * d0); p = __builtin_amdgcn_mfma_f32_32x32x16_bf16(kf, qf[d0], p, 0, 0, 0); }
        if (kv0 + 31 >= q0) {
#pragma unroll
            for (int r = 0; r < 16; ++r) if (kv0 + crow(r, hi) >= qpos) p[r] = -INFINITY;
        }
        sb_core(p, carry, hi);
        const bf16x8 p0 = pack_p(p, 0), p1 = pack_p(p, 1);
#pragma unroll
        for (int dt = 0; dt < 2; ++dt) {
            const bf16* vp = VT + (size_t)(h * HD + 32 * dt + r32) * M + b * TP + kv0 + 4 * hi;
            const u32x2 a0 = *(const u32x2*)vp, a1 = *(const u32x2*)(vp + 8), a2 = *(const u32x2*)(vp + 16), a3 = *(const u32x2*)(vp + 24);
            o[dt] = __builtin_amdgcn_mfma_f32_32x32x16_bf16(__builtin_bit_cast(bf16x8, (u32x4){a0.x, a0.y, a1.x, a1.y}), p0, o[dt], 0, 0, 0);
            o[dt] = __builtin_amdgcn_mfma_f32_32x32x16_bf16(__builtin_bit_cast(bf16x8, (u32x4){a2.x, a2.y, a3.x, a3.y}), p1, o[dt], 0, 0, 0);
        }
    }
    float ss = 0.f;
#pragma unroll
    for (int dt = 0; dt < 2; ++dt)
#pragma unroll
        for (int r = 0; r < 16; ++r) ss += o[dt][r] * o[dt][r];
    ss += __shfl_xor(ss, 32);
    const float rs = 1.0f / sqrtf(ss * (1.f / HD) + EPS);
    const float* gso = (const float*)A.in[I_GSBO];
    bf16* op = MIXED + (size_t)(b * TP + qpos) * D + h * HD;
#pragma unroll
    for (int dt = 0; dt < 2; ++dt)
#pragma unroll
        for (int g = 0; g < 4; ++g) { const int d = 32 * dt + 8 * g + 4 * hi; const f32x4 gg = *(const f32x4*)(gso + d);
            u32x2 w; w.x = cvtpk(o[dt][4 * g] * rs * gg.x, o[dt][4 * g + 1] * rs * gg.y); w.y = cvtpk(o[dt][4 * g + 2] * rs * gg.z, o[dt][4 * g + 3] * rs * gg.w); *(u32x2*)(op + d) = w; }
}

constexpr int KPITCH = 1040, VPITCH = 1088, LDS_KT = 0, LDS_VT = 32 * KPITCH;
__device__ __forceinline__ void attn_sample_tile(LAS unsigned char* lds, int h, int lane, const bf16x8 (&qf)[4], float bias2, f32x16 (&o)[2], float& carry, bool newtok) {
    const int r32 = lane & 31, hi = lane >> 5;
    f32x16 p;
#pragma unroll
    for (int r = 0; r < 16; ++r) p[r] = bias2;
    const LAS unsigned char* kp = lds + LDS_KT + r32 * KPITCH + (h * HD + 8 * hi) * 2;
#pragma unroll
    for (int d0 = 0; d0 < 4; ++d0) { const bf16x8 kf = *(const LAS bf16x8*)(kp + 32 * d0); p = __builtin_amdgcn_mfma_f32_32x32x16_bf16(kf, qf[d0], p, 0, 0, 0); }
    if (newtok) {
#pragma unroll
        for (int r = 0; r < 16; ++r) if (crow(r, hi) >= r32) p[r] = -INFINITY;
    }
    sb_core(p, carry, hi);
    const bf16x8 p0 = pack_p(p, 0), p1 = pack_p(p, 1);
    const LAS unsigned char* vb = lds + LDS_VT + (4 * hi + ((lane & 15) >> 2)) * VPITCH + (h * HD + ((lane >> 4) & 1) * 16 + (lane & 3) * 4) * 2;
#pragma unroll
    for (int dt = 0; dt < 2; ++dt) {
        s16x4 t0 = __builtin_bit_cast(s16x4, __builtin_amdgcn_ds_read_tr16_b64_v4i16((LAS s16x4*)(vb + dt * 64)));
        s16x4 t1 = __builtin_bit_cast(s16x4, __builtin_amdgcn_ds_read_tr16_b64_v4i16((LAS s16x4*)(vb + dt * 64 + 8 * VPITCH)));
        s16x4 t2 = __builtin_bit_cast(s16x4, __builtin_amdgcn_ds_read_tr16_b64_v4i16((LAS s16x4*)(vb + dt * 64 + 16 * VPITCH)));
        s16x4 t3 = __builtin_bit_cast(s16x4, __builtin_amdgcn_ds_read_tr16_b64_v4i16((LAS s16x4*)(vb + dt * 64 + 24 * VPITCH)));
        o[dt] = __builtin_amdgcn_mfma_f32_32x32x16_bf16((bf16x8){t0[0], t0[1], t0[2], t0[3], t1[0], t1[1], t1[2], t1[3]}, p0, o[dt], 0, 0, 0);
        o[dt] = __builtin_amdgcn_mfma_f32_32x32x16_bf16((bf16x8){t2[0], t2[1], t2[2], t2[3], t3[0], t3[1], t3[2], t3[3]}, p1, o[dt], 0, 0, 0);
    }
}
__device__ __forceinline__ void attn_sample_store(const Args& A, int b, int h, int part, int lane, const f32x16 (&o)[2], float carry) {
    float* OP = (float*)(A.ws + WS_OPART) + (size_t)((b * SBH + h) * NPART + part) * 512; float* LP = (float*)(A.ws + WS_LPART) + (size_t)((b * SBH + h) * NPART + part) * 8;
    const int r32 = lane & 31, hi = lane >> 5;
    if (r32 < 8) {
#pragma unroll
        for (int dt = 0; dt < 2; ++dt)
#pragma unroll
            for (int r = 0; r < 16; ++r) OP[(32 * dt + crow(r, hi)) * 8 + r32] = o[dt][r];
        if (hi == 0) LP[r32] = carry;
    }
}
__device__ __forceinline__ void attn_sample_unit(const Args& A, LAS unsigned char* lds, int unit, int tid, int wave, int lane) {
    unsigned char* ws = A.ws;
    const int sp = unit & 3, b = unit >> 2, h = wave, r32 = lane & 31, hi = lane >> 5;
    const float* ck = (const float*)A.in[I_CK]; const float* cv = (const float*)A.in[I_CV]; const int* pt = (const int*)A.in[I_PT] + b * NPAGES;
    const bf16* QB = (const bf16*)(ws + WS_QB);
    const float bias2 = ((const float*)A.in[I_SBB])[h] * LOG2E;
    bf16x8 qf[4];
#pragma unroll
    for (int d0 = 0; d0 < 4; ++d0) { qf[d0] = (bf16x8){0, 0, 0, 0, 0, 0, 0, 0}; if (r32 < TS) qf[d0] = *(const bf16x8*)(QB + (size_t)(MP + b * TS + r32) * SBW + h * HD + 16 * d0 + 8 * hi); }
    f32x16 o[2]; float carry;
    if (sp == NSPLIT - 1) {
        __syncthreads();
        for (int i = tid; i < 32 * 64; i += 512) { const int row = i >> 6, c8 = (i & 63) * 8;
            u32x4 kw = (u32x4){0u, 0u, 0u, 0u}, vw = kw;
            if (row < TS) { const size_t m = (size_t)(MP + b * TS + row); kw = *(const u32x4*)((const bf16*)(ws + WS_KB) + m * SBW + c8);
                const float* vp = (const float*)(ws + WS_PROJ) + m * NPROJ + 1024 + c8; vw = pack8(*(const f32x4*)vp, *(const f32x4*)(vp + 4)); }
            *(LAS u32x4*)(lds + LDS_KT + row * KPITCH + c8 * 2) = kw; *(LAS u32x4*)(lds + LDS_VT + row * VPITCH + c8 * 2) = vw; }
        __syncthreads();
        o[0] = (f32x16){}; o[1] = (f32x16){}; carry = 0.f;
        attn_sample_tile(lds, h, lane, qf, bias2, o, carry, true);
        attn_sample_store(A, b, h, NPART - 1, lane, o, carry);
    }
    o[0] = (f32x16){}; o[1] = (f32x16){}; carry = 0.f;
    const int tok_hi = (PAST / NSPLIT) * (sp + 1);
    f32x4 kr[8], vr[8];
#define SAMPLE_LOAD(j) do { const int tok0_ = tok_hi - 32 * ((j) + 1); const size_t base_ = ((size_t)pt[tok0_ >> 7] * PAGE + (tok0_ & 127)) * 512; \
        _Pragma("unroll") for (int i_ = 0; i_ < 8; ++i_) { kr[i_] = *(const f32x4*)(ck + base_ + 4 * (tid + 512 * i_)); vr[i_] = *(const f32x4*)(cv + base_ + 4 * (tid + 512 * i_)); } } while (0)
    SAMPLE_LOAD(0);
    constexpr int NT = PAST / NSPLIT / 32;
    for (int j = 0; j < NT; ++j) {
        __syncthreads();
#pragma unroll
        for (int i = 0; i < 8; ++i) { const int f = tid + 512 * i, row = f >> 7, c4 = (f & 127) * 4;
            u32x2 kw, vw; kw.x = cvtpk(kr[i].x, kr[i].y); kw.y = cvtpk(kr[i].z, kr[i].w); vw.x = cvtpk(vr[i].x, vr[i].y); vw.y = cvtpk(vr[i].z, vr[i].w);
            *(LAS u32x2*)(lds + LDS_KT + row * KPITCH + c4 * 2) = kw; *(LAS u32x2*)(lds + LDS_VT + row * VPITCH + c4 * 2) = vw; }
        if (j + 1 < NT) SAMPLE_LOAD(j + 1);
        __syncthreads();
        attn_sample_tile(lds, h, lane, qf, bias2, o, carry, false);
    }
#undef SAMPLE_LOAD
    attn_sample_store(A, b, h, sp, lane, o, carry);
    __syncthreads();
}

__device__ __forceinline__ void phase_outnorm(const Args& A, int gw, int NGW, int lane) {
    unsigned char* ws = A.ws; const float* ODN = (const float*)(ws + WS_ODN); const float* PROJ = (const float*)(ws + WS_PROJ); bf16* MIXED = (bf16*)(ws + WS_MIXED);
    const float* gdn = (const float*)A.in[I_GDNO]; const float* gso = (const float*)A.in[I_GSBO];
    const float* OPb = (const float*)(ws + WS_OPART); const float* LPb = (const float*)(ws + WS_LPART);
    const int c8 = 8 * lane;
    for (int m = gw; m < M; m += NGW) {
        {
            const float* op = ODN + (size_t)m * DNW + c8; f32x4 a0 = *(const f32x4*)op, a1 = *(const f32x4*)(op + 4);
            float ss = (a0.x * a0.x + a0.y * a0.y) + (a0.z * a0.z + a0.w * a0.w) + (a1.x * a1.x + a1.y * a1.y) + (a1.z * a1.z + a1.w * a1.w);
            ss += __shfl_xor(ss, 1); ss += __shfl_xor(ss, 2); ss += __shfl_xor(ss, 4); ss += __shfl_xor(ss, 8);
            const float rs = 1.0f / sqrtf(ss * (1.f / DND) + EPS);
            const f32x4 g0 = *(const f32x4*)(gdn + (c8 & 127)), g1 = *(const f32x4*)(gdn + (c8 & 127) + 4);
            const float* zp = PROJ + (size_t)m * NPROJ + 3072 + c8; f32x4 z0 = *(const f32x4*)zp, z1 = *(const f32x4*)(zp + 4);
            z0.x = siluf(z0.x); z0.y = siluf(z0.y); z0.z = siluf(z0.z); z0.w = siluf(z0.w); z1.x = siluf(z1.x); z1.y = siluf(z1.y); z1.z = siluf(z1.z); z1.w = siluf(z1.w);
            *(u32x4*)(MIXED + (size_t)m * D + SBW + c8) = pack8(a0 * rs * g0 * z0, a1 * rs * g1 * z1);
        }
        if (m >= MP) {
            const int b = (m - MP) >> 3, t = (m - MP) & 7, h = lane >> 3, d0 = c8 & 63;
            const float* OP = OPb + (size_t)(b * SBH + h) * NPART * 512; const float* LP = LPb + (size_t)(b * SBH + h) * NPART * 8;
            float v[8];
#pragma unroll
            for (int k = 0; k < 8; ++k) v[k] = 0.f;
            float suf = 0.f;
#pragma unroll
            for (int part = NPART - 1; part >= 0; --part) { const float w = __builtin_amdgcn_exp2f(suf);
#pragma unroll
                for (int k = 0; k < 8; ++k) v[k] += w * OP[part * 512 + (d0 + k) * 8 + t];
                suf += LP[part * 8 + t]; }
            float ss = 0.f;
#pragma unroll
            for (int k = 0; k < 8; ++k) ss += v[k] * v[k];
            ss += __shfl_xor(ss, 1); ss += __shfl_xor(ss, 2); ss += __shfl_xor(ss, 4);
            const float rs = 1.0f / sqrtf(ss * (1.f / HD) + EPS);
            const f32x4 g0 = *(const f32x4*)(gso + d0), g1 = *(const f32x4*)(gso + d0 + 4);
            *(u32x4*)(MIXED + (size_t)m * D + c8) = pack8((f32x4){v[0], v[1], v[2], v[3]} * rs * g0, (f32x4){v[4], v[5], v[6], v[7]} * rs * g1);
        }
    }
}

__device__ __forceinline__ f32x4 bf4lo(u32x4 w) { return (f32x4){__uint_as_float(w.x << 16), __uint_as_float(w.x & 0xffff0000u), __uint_as_float(w.y << 16), __uint_as_float(w.y & 0xffff0000u)}; }
__device__ __forceinline__ f32x4 bf4hi(u32x4 w) { return (f32x4){__uint_as_float(w.z << 16), __uint_as_float(w.z & 0xffff0000u), __uint_as_float(w.w << 16), __uint_as_float(w.w & 0xffff0000u)}; }
__device__ __forceinline__ void phase_convgate(const Args& A, int gw, int NGW, int lane) {
    unsigned char* ws = A.ws; const bf16* UP = (const bf16*)(ws + WS_UP); bf16* ACT = (bf16*)(ws + WS_ACT); float* out = A.out;
    const float* wf = (const float*)A.in[I_WFC]; const float* sfc = (const float*)A.in[I_SFC];
    for (int m = gw; m < M; m += NGW) {
        const bool prompt = m < MP; const int b = prompt ? (m >> 12) : ((m - MP) >> 3), t = prompt ? (m & 4095) : ((m - MP) & 7);
        const bf16* ur = UP + (size_t)m * DFF2;
        const int oidx = prompt ? t - (TP - 2) : t - (TS - 2);
        float* fo = oidx >= 0 ? (prompt ? out + O_FCP + ((size_t)b * 2 + oidx) * DFF2 : out + O_FCS + ((size_t)b * 2 + oidx) * DFF2) : nullptr;
        for (int ch = lane; ch < DFF / 8; ch += 64) {
            const int c = 8 * ch;
            f32x4 u0 = (f32x4){0.f, 0.f, 0.f, 0.f}, u1 = u0, g0 = u0, g1 = u0;
#pragma unroll
            for (int i = 0; i < 3; ++i) {
                const int tt = t - 2 + i;
                f32x4 xu0, xu1, xg0, xg1;
                if (tt >= 0) { const u32x4 wu = *(const u32x4*)(ur - (size_t)(2 - i) * DFF2 + c), wg = *(const u32x4*)(ur - (size_t)(2 - i) * DFF2 + DFF + c); xu0 = bf4lo(wu); xu1 = bf4hi(wu); xg0 = bf4lo(wg); xg1 = bf4hi(wg); }
                else if (!prompt) { const float* p = sfc + ((size_t)b * 2 + (2 + tt)) * DFF2 + c; xu0 = *(const f32x4*)p; xu1 = *(const f32x4*)(p + 4); xg0 = *(const f32x4*)(p + DFF); xg1 = *(const f32x4*)(p + DFF + 4); }
                else { xu0 = (f32x4){0.f, 0.f, 0.f, 0.f}; xu1 = xu0; xg0 = xu0; xg1 = xu0; }
                const float* wp = wf + (size_t)i * DFF2 + c;
                u0 += *(const f32x4*)wp * xu0; u1 += *(const f32x4*)(wp + 4) * xu1; g0 += *(const f32x4*)(wp + DFF) * xg0; g1 += *(const f32x4*)(wp + DFF + 4) * xg1;
                if (i == 2 && fo) { *(f32x4*)(fo + c) = xu0; *(f32x4*)(fo + c + 4) = xu1; *(f32x4*)(fo + DFF + c) = xg0; *(f32x4*)(fo + DFF + c + 4) = xg1; }
            }
            g0.x = siluf(g0.x); g0.y = siluf(g0.y); g0.z = siluf(g0.z); g0.w = siluf(g0.w); g1.x = siluf(g1.x); g1.y = siluf(g1.y); g1.z = siluf(g1.z); g1.w = siluf(g1.w);
            *(u32x4*)(ACT + (size_t)m * DFF + c) = pack8(g0 * u0, g1 * u1);
        }
    }
}

constexpr int NPHASE = 13;
__global__ void __launch_bounds__(512, 2) fwd_kernel(Args A) {
    extern __shared__ __attribute__((aligned(16))) unsigned char lds_raw[];
    LAS unsigned char* lds = (LAS unsigned char*)lds_raw;
    const int tid = threadIdx.x, lane = tid & 63, wave = __builtin_amdgcn_readfirstlane(tid >> 6);
    const int G = gridDim.x, bx = blockIdx.x;
    const int gw = bx * 8 + wave, NGW = G * 8, gtid = bx * 512 + tid, NGT = G * 512;
    unsigned char* ws = A.ws;
    gu32* ctl = (gu32*)(ws + WS_CTL);
    volatile LAS unsigned* MISC = (volatile LAS unsigned*)(lds + MISC_OFF);
    for (int u = tid; u < (LDS_BYTES - RING_BYTES) / 4; u += 512) ((LAS unsigned*)(lds + RING_BYTES))[u] = 0u;
    __syncthreads();
    const int lo = A.lo, hi = A.hi;
    const bool multi = (hi - lo) > 1;
    XcdBarrier bar; bar.bar = (unsigned*)(ctl + CW_BAR); bar.x = 0; bar.st = nullptr;
    if (multi) bar = xcd_barrier_post((unsigned*)(ctl + CW_BAR), MISC + 8);
#define IN(k) (lo <= (k) && (k) < hi)
#define SEAM(k) do { if (IN(k) && IN((k) + 1)) xcd_barrier(bar); } while (0)
    float* MOD = (float*)(ws + WS_MOD);

    if (IN(0)) { phase_prologue(A, lds, gw, NGW, wave, lane, gtid, NGT); }
    SEAM(0);
    if (IN(1)) { phase_mod(A, gw, NGW, lane); }
    SEAM(1);
    if (IN(2)) { phase_norm<true>((const float*)A.in[I_XP], (const float*)A.in[I_XS], (const float*)A.in[I_GATT], MOD, 0, 1024, (bf16*)(ws + WS_H), (const float*)(ws + WS_WINX), (float*)(ws + WS_EXTRA), gw, NGW, lane); }
    SEAM(2);
    if (IN(3)) {
        { pg8::Gemm g{(const pg8::bf16_t*)(ws + WS_H), (const pg8::bf16_t*)(ws + WS_WIN_T), M, NPROJ, D}; pg8::StaticOrder S; S.init(M, NPROJ, G, bx);
          EpiF32 E{(float*)(ws + WS_PROJ), NPROJ};
          pg8::gemm_phase<EpiF32, pg8::StaticOrder, true, true>(lds, g, S, E); }
        __syncthreads();
        { pg8::Gemm g{(const pg8::bf16_t*)(ws + WS_WIN_T) + (size_t)1024 * D, (const pg8::bf16_t*)(ws + WS_H), SBW, M, D}; pg8::StaticOrder S; S.init(SBW, M, G, bx);
          pg8::EpiBf16<0> E{(pg8::bf16_t*)(ws + WS_VT), M, nullptr, 0, 0, 1.f};
          pg8::gemm_phase<pg8::EpiBf16<0>, pg8::StaticOrder, true, true>(lds, g, S, E); }
    }
    SEAM(3);
    if (IN(4)) { phase_post(A, gw, NGW, lane); }
    SEAM(4);
    if (IN(5)) {
        for (int u = bx; u < 1024; u += G) { if (u < 512) dn_prescan_unit(A, lds, u, tid, wave, lane); else dn_sample_unit(A, lds, u - 512, tid); }
    }
    SEAM(5);
    if (IN(6)) {
        if (bx < 16) dn_scan_chain(A, bx, wave, lane);
        for (;;) {
            __syncthreads();
            if (tid == 0) MISC[0] = __hip_atomic_fetch_add(ctl + CW_QUEUE, 1u, RLX_AGENT);
            __syncthreads();
            const int job = (int)MISC[0];
            if (job >= 1024) break;
            if (job & 1) attn_sample_unit(A, lds, job >> 1, tid, wave, lane);
            else { const int j = job >> 1, qb = 15 - (j >> 5), bh = j & 31; attn_prompt_item(A, bh >> 3, bh & 7, qb * 256 + wave * 32, lane); }
        }
    }
    SEAM(6);
    if (IN(7)) { phase_outnorm(A, gw, NGW, lane); }
    SEAM(7);
    if (IN(8)) {
        pg8::Gemm g{(const pg8::bf16_t*)(ws + WS_MIXED), (const pg8::bf16_t*)(ws + WS_WOUT_T), M, D, D}; pg8::StaticOrder S; S.init(M, D, G, bx);
        EpiResGate E{(const float*)A.in[I_XP], (const float*)A.in[I_XS], MOD, 2048, (float*)(ws + WS_X1)};
        pg8::gemm_phase<EpiResGate, pg8::StaticOrder, true, true>(lds, g, S, E);
    }
    SEAM(8);
    if (IN(9)) { phase_norm<false>((const float*)(ws + WS_X1), (const float*)(ws + WS_X1) + (size_t)MP * D, (const float*)A.in[I_GFFN], MOD, 3072, 4096, (bf16*)(ws + WS_H), nullptr, nullptr, gw, NGW, lane); }
    SEAM(9);
    if (IN(10)) {
        pg8::Gemm g{(const pg8::bf16_t*)(ws + WS_H), (const pg8::bf16_t*)(ws + WS_WUP_T), M, DFF2, D}; pg8::StaticOrder S; S.init(M, DFF2, G, bx);
        pg8::EpiBf16<0> E{(pg8::bf16_t*)(ws + WS_UP), DFF2, nullptr, 0, 0, 1.f};
        pg8::gemm_phase<pg8::EpiBf16<0>, pg8::StaticOrder, true, true>(lds, g, S, E);
    }
    SEAM(10);
    if (IN(11)) { phase_convgate(A, gw, NGW, lane); }
    SEAM(11);
    if (IN(12)) {
        pg8::Gemm g{(const pg8::bf16_t*)(ws + WS_ACT), (const pg8::bf16_t*)(ws + WS_WDN_T), M, D, DFF}; pg8::StaticOrder S; S.init(M, D, G, bx);
        EpiResGate E{(const float*)(ws + WS_X1), (const float*)(ws + WS_X1) + (size_t)MP * D, MOD, 5120, A.out};
        pg8::gemm_phase<EpiResGate, pg8::StaticOrder, true, true>(lds, g, S, E);
    }
#undef IN
#undef SEAM
}

#ifndef N_LAUNCHES
#define N_LAUNCHES 1
#endif
extern "C" void kernel_launch(void* const* d_in, const int* in_sizes, int n_in, void* d_out, int out_size, void* d_ws, size_t ws_size, hipStream_t stream) {
    static int grid = 0;
    if (grid == 0) {
        if (n_in != 27 || (size_t)out_size != O_END || ws_size < WS_END) { fprintf(stderr, "kernel_launch: unexpected shapes: n_in %d out %d ws %zu\n", n_in, out_size, ws_size); grid = -1; return; }
        int dev = 0, cus = 0, per_cu = 0;
        if (hipGetDevice(&dev) != hipSuccess || hipDeviceGetAttribute(&cus, hipDeviceAttributeMultiprocessorCount, dev) != hipSuccess) { grid = -1; return; }
        if (hipFuncSetAttribute((const void*)fwd_kernel, hipFuncAttributeMaxDynamicSharedMemorySize, LDS_BYTES) != hipSuccess) { fprintf(stderr, "kernel_launch: hipFuncSetAttribute failed\n"); grid = -1; return; }
        if (hipOccupancyMaxActiveBlocksPerMultiprocessor(&per_cu, (const void*)fwd_kernel, 512, LDS_BYTES) != hipSuccess || per_cu < 1) fprintf(stderr, "kernel_launch: occupancy query says %d\n", per_cu);
        (void)hipGetLastError();
        grid = cus;
    }
    if (grid < 0) return;
    (void)hipMemsetAsync((char*)d_ws + WS_CTL, 0, CTL_ZERO_BYTES, stream);
    Args a{};
    for (int i = 0; i < 27; ++i) a.in[i] = d_in[i];
    a.out = (float*)d_out; a.ws = (unsigned char*)d_ws;
    if (N_LAUNCHES == 1) { a.lo = 0; a.hi = NPHASE; hipLaunchKernelGGL(fwd_kernel, dim3(grid), dim3(512), LDS_BYTES, stream, a); }
    else for (int p = 0; p < NPHASE; ++p) { a.lo = p; a.hi = p + 1; hipLaunchKernelGGL(fwd_kernel, dim3(grid), dim3(512), LDS_BYTES, stream, a); }
}
```

```cpp
#include <hip/hip_runtime.h>
#include <cstdio>
#include <cstdint>
#define REP_MASK 0
namespace pg8 {
#define PG8_LAS __attribute__((address_space(3)))
typedef unsigned short bf16_t;
typedef short bf16x8 __attribute__((ext_vector_type(8)));
typedef float f32x4 __attribute__((ext_vector_type(4)));
typedef unsigned u32x4 __attribute__((ext_vector_type(4)));
constexpr int BM = 256, BK = 64, HALF = 128, HTB = HALF * BK * 2  , STAGE_BYTES = 8 * HTB, NXCD = 8, WGM = 8;

__host__ __device__ __forceinline__ int lds_byte(int r, int c) { const int st = (r >> 4) * 2 + (c >> 5), rr = r & 15, cc = c & 31, ob = rr * 64 + cc * 2; return st * 1024 + (ob ^ (((ob >> 9) & 1) << 5)); }
__host__ __device__ __forceinline__ void stage_rc(int b, int& R, int& C) { const int st = b / 1024, sb = b % 1024, swz = sb ^ (((sb >> 9) & 1) << 5); R = (st >> 1) * 16 + swz / 64; C = (st & 1) * 32 + (swz % 64) / 2; }
__host__ __device__ __forceinline__ int perm32(int rho) { const int n = rho >> 4, i = rho & 15; return 8 * (i >> 2) + 4 * n + (i & 3); }

struct Unit { int pm, pn; };
struct Gemm { const bf16_t* A; const bf16_t* Bt; int M, N, K; };

struct StaticOrder {
    int nM, nN, nwg, G, c;
    __host__ __device__ void init(int M, int N, int G_, int c_) { nM = M / BM; nN = N / BM; nwg = nM * nN; G = G_; c = c_; }
    __host__ __device__ bool next(int i, Unit& u) const {
        const long L = (long)i * G + c; if (L >= nwg) return false;
        int wgid = (int)L; { const int q = nwg / NXCD, r = nwg % NXCD, xcd = wgid % NXCD, off = wgid / NXCD; wgid = (xcd < r ? xcd * (q + 1) : r * (q + 1) + (xcd - r) * q) + off; }
        const int nig = WGM * nN, gid = wgid / nig, fm = gid * WGM, gsz = (nM - fm) < WGM ? (nM - fm) : WGM;
        u.pm = fm + ((wgid % nig) % gsz); u.pn = (wgid % nig) / gsz; return true;
    }
    __device__ __forceinline__ void a_ready(const Unit&) const {}
    __device__ __forceinline__ void done(const Unit&) const {}
};

__device__ __forceinline__ unsigned cvt_pk_bf16(float lo, float hi) { unsigned r; asm volatile("v_cvt_pk_bf16_f32 %0, %1, %2" : "=v"(r) : "v"(lo), "v"(hi)); return r; }
typedef float f32x2 __attribute__((ext_vector_type(2)));
__device__ __forceinline__ f32x2 gelu_pk(f32x2 v) {
    const f32x2 av = __builtin_elementwise_abs(v), d = av * 0.2316418882f + 1.0f;
    f32x2 t; t.x = __builtin_amdgcn_rcpf(d.x); t.y = __builtin_amdgcn_rcpf(d.y);
    f32x2 q = t * 0.5307027145f + (-0.7265760135f); q = q * t + 0.7107068705f; q = q * t + (-0.142248368f); q = q * t + 0.127414796f; q = q * t;
    const f32x2 s = (v * v) * (-0.72134752044f);
    f32x2 e; e.x = __builtin_amdgcn_exp2f(s.x); e.y = __builtin_amdgcn_exp2f(s.y);
    const f32x2 m = v * (q * e), r = v - m;
    f32x2 o; o.x = v.x < 0.f ? m.x : r.x; o.y = v.y < 0.f ? m.y : r.y; return o;
}

template <int ACT  > struct EpiBf16 {
    static constexpr bool PERM = true, AFTER_DRAIN = false; static_assert(ACT == 0 || ACT == 1, "EpiBf16: ACT is 0 (none) or 1 (gelu_pk)");
    bf16_t* O; int ldc; const float* bias; int split_cols; size_t split_stride; float scale0;
    __device__ __forceinline__ void operator()(const f32x4 (&acc)[2][2][4][2], const Unit& u, int wr, int wc, int fr, int fq) const {
        const int row0 = u.pm * BM + wr * 64 + fr; int colt = u.pn * BM; bf16_t* base = O;
        float sc = 1.f; if (split_cols) { const int t = colt / split_cols; base += (size_t)t * split_stride; colt -= t * split_cols; if (t == 0) sc = scale0; }
        const int col0 = colt + wc * 32 + 8 * fq, bcol0 = u.pn * BM + wc * 32 + 8 * fq;
        f32x4 bv[2][2];
#pragma unroll
        for (int bj = 0; bj < 2; ++bj)
#pragma unroll
            for (int n = 0; n < 2; ++n) bv[bj][n] = bias ? *(const f32x4*)(bias + bcol0 + bj * HALF + 4 * n) : (f32x4){0.f, 0.f, 0.f, 0.f};
#pragma unroll
        for (int ai = 0; ai < 2; ++ai)
#pragma unroll
            for (int m = 0; m < 4; ++m) { bf16_t* rowp = base + (size_t)(row0 + ai * HALF + m * 16) * ldc + col0;
#pragma unroll
                for (int bj = 0; bj < 2; ++bj) { f32x4 v0 = acc[ai][bj][m][0] + bv[bj][0], v1 = acc[ai][bj][m][1] + bv[bj][1];
                    if (ACT == 1) { f32x2 a = gelu_pk((f32x2){v0[0], v0[1]}), b = gelu_pk((f32x2){v0[2], v0[3]}), c = gelu_pk((f32x2){v1[0], v1[1]}), d = gelu_pk((f32x2){v1[2], v1[3]});
                        v0 = (f32x4){a.x, a.y, b.x, b.y}; v1 = (f32x4){c.x, c.y, d.x, d.y}; }
                    v0 = v0 * sc; v1 = v1 * sc; u32x4 w; w.x = cvt_pk_bf16(v0[0], v0[1]); w.y = cvt_pk_bf16(v0[2], v0[3]); w.z = cvt_pk_bf16(v1[0], v1[1]); w.w = cvt_pk_bf16(v1[2], v1[3]);
                    *(u32x4*)(rowp + bj * HALF) = w; } }
    }
};

struct PanelStats {
    unsigned* xbuf;
    unsigned* cnt;
    unsigned* tmo;
    int ntn; float eps;
    unsigned code;
    __device__ __forceinline__ bool run(const f32x4 (&v)[2][2][4][2], const Unit& u, int wr, int wc, int fr, int fq, PG8_LAS unsigned char* lds, int wid, int lane) const {
        typedef float f32x2v __attribute__((ext_vector_type(2)));
        PG8_LAS f32x2v* P = (PG8_LAS f32x2v*)lds;
        PG8_LAS f32x2v* S = (PG8_LAS f32x2v*)(lds + 8192);
        PG8_LAS unsigned* flag = (PG8_LAS unsigned*)(lds + 8192 + 2048);
#pragma unroll
        for (int ai = 0; ai < 2; ++ai)
#pragma unroll
            for (int m = 0; m < 4; ++m) {
                float s = 0.f;
#pragma unroll
                for (int bj = 0; bj < 2; ++bj)
#pragma unroll
                    for (int n = 0; n < 2; ++n) { const f32x4 x = v[ai][bj][m][n]; s += (x[0] + x[1]) + (x[2] + x[3]); }
                s += __shfl_xor(s, 16); s += __shfl_xor(s, 32);
                const float mw = s * (1.0f / 64.0f); float q = 0.f;
#pragma unroll
                for (int bj = 0; bj < 2; ++bj)
#pragma unroll
                    for (int n = 0; n < 2; ++n) { const f32x4 d = v[ai][bj][m][n] - mw; q += (d[0] * d[0] + d[1] * d[1]) + (d[2] * d[2] + d[3] * d[3]); }
                q += __shfl_xor(q, 16); q += __shfl_xor(q, 32);
                if (fq == 0) P[(ai * HALF + wr * 64 + m * 16 + fr) * 4 + wc] = (f32x2v){mw, q};
            }
        asm volatile("s_waitcnt lgkmcnt(0)" ::: "memory"); __builtin_amdgcn_s_barrier(); asm volatile("" ::: "memory");
#if defined(BROKEN_EXCHANGE_NO_WAIT)
#warning BROKEN CONTROL BUILD: the row-statistics exchange does not wait; results are wrong by design
        if (blockIdx.x >= 64) { const long long t0_ = clock64(); while (clock64() - t0_ < 60000) __builtin_amdgcn_s_sleep(8); }
#endif
        const int row = wid * 32 + (lane & 31);
        if (lane < 32) {
            const f32x2v a = P[row * 4 + 0], b = P[row * 4 + 1], c = P[row * 4 + 2], d = P[row * 4 + 3];
            const float mt = (a.x + b.x + c.x + d.x) * 0.25f;
            const float da = a.x - mt, db = b.x - mt, dc = c.x - mt, dd = d.x - mt;
            const float m2 = (a.y + b.y) + (c.y + d.y) + 64.0f * ((da * da + db * db) + (dc * dc + dd * dd));
            unsigned long long* slot = (unsigned long long*)xbuf + ((size_t)(u.pm * BM + row) * 4 + u.pn);
            __hip_atomic_store(slot, ((unsigned long long)__float_as_uint(m2) << 32) | __float_as_uint(mt), __ATOMIC_RELAXED, __HIP_MEMORY_SCOPE_AGENT);
        }
        asm volatile("s_waitcnt vmcnt(0)" ::: "memory");
        if (lane == 0) __hip_atomic_fetch_add(cnt + 64 * u.pm, 1u, __ATOMIC_RELAXED, __HIP_MEMORY_SCOPE_AGENT);
        if (wid == 0) {
            bool dead = false; const unsigned long long t0 = __builtin_amdgcn_s_memrealtime(); const unsigned want = 8u * (unsigned)ntn;
            for (;;) {
#if defined(BROKEN_EXCHANGE_NO_WAIT)
                break;
#endif
                if ((unsigned)__builtin_amdgcn_readfirstlane(__hip_atomic_load(cnt + 64 * u.pm, __ATOMIC_RELAXED, __HIP_MEMORY_SCOPE_AGENT)) >= want) break;
                if (__builtin_amdgcn_s_memrealtime() - t0 > 2000000ull) {
                    if (lane == 0) { unsigned expect = 0u; __hip_atomic_compare_exchange_strong(tmo + 1, &expect, code | (unsigned)(u.pm & 0xff), __ATOMIC_RELAXED, __ATOMIC_RELAXED, __HIP_MEMORY_SCOPE_AGENT);
                                     __hip_atomic_store(tmo, 1u, __ATOMIC_RELAXED, __HIP_MEMORY_SCOPE_AGENT); }
                    dead = true; break; }
                __builtin_amdgcn_s_sleep(2);
            }
            __builtin_amdgcn_fence(__ATOMIC_ACQUIRE, "agent");
            if (lane == 0) flag[0] = dead ? 1u : 0u;
        }
        asm volatile("s_waitcnt vmcnt(0) lgkmcnt(0)" ::: "memory"); __builtin_amdgcn_s_barrier(); asm volatile("" ::: "memory");
        const bool bad = flag[0] != 0u;
        if (lane < 32) {
            const unsigned long long* slot = (const unsigned long long*)xbuf + (size_t)(u.pm * BM + row) * 4; float mt[4], m2[4]; float ms = 0.f;
#pragma unroll
            for (int t = 0; t < 4; ++t) { if (t < ntn) { const unsigned long long w = __hip_atomic_load(slot + t, __ATOMIC_RELAXED, __HIP_MEMORY_SCOPE_AGENT); mt[t] = __uint_as_float((unsigned)w); m2[t] = __uint_as_float((unsigned)(w >> 32)); } else { mt[t] = 0.f; m2[t] = 0.f; } ms += mt[t]; }
            const float mean = ms / (float)ntn; float q = 0.f;
#pragma unroll
            for (int t = 0; t < 4; ++t) if (t < ntn) { const float dm = mt[t] - mean; q += m2[t] + 256.0f * dm * dm; }
            S[row] = (f32x2v){mean, 1.0f / sqrtf(q / (256.0f * (float)ntn) + eps)};
        }
        asm volatile("s_waitcnt lgkmcnt(0)" ::: "memory"); __builtin_amdgcn_s_barrier(); asm volatile("" ::: "memory");
        return bad;
    }
};
struct EpiLnRes {
    static constexpr bool PERM = false, AFTER_DRAIN = true;
    const float* base; float* out; int ldc; const float* bias; PanelStats st; unsigned poison;
    __device__ __forceinline__ void fused(f32x4 (&acc)[2][2][4][2], const Unit& u, int wr, int wc, int fr, int fq, PG8_LAS unsigned char* lds, int wid, int lane) const {
        typedef float f32x2v __attribute__((ext_vector_type(2)));
        const PG8_LAS f32x2v* S = (const PG8_LAS f32x2v*)(lds + 8192);
        const int col0 = u.pn * BM + wc * 32 + 4 * fq;
#pragma unroll
        for (int bj = 0; bj < 2; ++bj)
#pragma unroll
            for (int n = 0; n < 2; ++n) { const f32x4 bv = bias ? *(const f32x4*)(bias + col0 + bj * HALF + n * 16) : (f32x4){0.f, 0.f, 0.f, 0.f};
#pragma unroll
                for (int ai = 0; ai < 2; ++ai)
#pragma unroll
                    for (int m = 0; m < 4; ++m) acc[ai][bj][m][n] += bv; }
        f32x4 pre[4][2][2];
#pragma unroll
        for (int m = 0; m < 4; ++m) { const size_t off = (size_t)(u.pm * BM + wr * 64 + m * 16 + fr) * ldc + col0;
#pragma unroll
            for (int bj = 0; bj < 2; ++bj)
#pragma unroll
                for (int n = 0; n < 2; ++n) pre[m][bj][n] = *(const f32x4*)(base + off + bj * HALF + n * 16); }
        const bool bad = st.run(acc, u, wr, wc, fr, fq, lds, wid, lane) || poison != 0u;
        const float qnan = __builtin_nanf("");
#pragma unroll
        for (int ai = 0; ai < 2; ++ai)
#pragma unroll
            for (int m = 0; m < 4; ++m) { const int r = ai * HALF + wr * 64 + m * 16 + fr; const f32x2v sr = S[r]; const size_t off = (size_t)(u.pm * BM + r) * ldc + col0;
#pragma unroll
                for (int bj = 0; bj < 2; ++bj)
#pragma unroll
                    for (int n = 0; n < 2; ++n) { const f32x4 bs = ai == 0 ? pre[m][bj][n] : *(const f32x4*)(base + off + bj * HALF + n * 16); f32x4 o = bs + (acc[ai][bj][m][n] - sr.x) * sr.y;
                        if (bad) o = (f32x4){qnan, qnan, qnan, qnan}; *(f32x4*)(out + off + bj * HALF + n * 16) = o; }
                if (m & 1) asm volatile("" ::: "memory"); }
    }
};
struct EpiLnResLn {
    static constexpr bool PERM = false, AFTER_DRAIN = true;
    const float* base; float* out; bf16_t* xn; int ldc; const float* bias; PanelStats st1, st2; unsigned poison;
    __device__ __forceinline__ void fused(f32x4 (&acc)[2][2][4][2], const Unit& u, int wr, int wc, int fr, int fq, PG8_LAS unsigned char* lds, int wid, int lane) const {
        typedef float f32x2v __attribute__((ext_vector_type(2))); typedef unsigned u32x2v __attribute__((ext_vector_type(2)));
        const PG8_LAS f32x2v* S = (const PG8_LAS f32x2v*)(lds + 8192);
        const int col0 = u.pn * BM + wc * 32 + 4 * fq;
#pragma unroll
        for (int bj = 0; bj < 2; ++bj)
#pragma unroll
            for (int n = 0; n < 2; ++n) { const f32x4 bv = bias ? *(const f32x4*)(bias + col0 + bj * HALF + n * 16) : (f32x4){0.f, 0.f, 0.f, 0.f};
#pragma unroll
                for (int ai = 0; ai < 2; ++ai)
#pragma unroll
                    for (int m = 0; m < 4; ++m) acc[ai][bj][m][n] += bv; }
        bool bad = st1.run(acc, u, wr, wc, fr, fq, lds, wid, lane) || poison != 0u;
        const float qnan = __builtin_nanf("");
#pragma unroll
        for (int ai = 0; ai < 2; ++ai)
#pragma unroll
            for (int m = 0; m < 4; ++m) { const int r = ai * HALF + wr * 64 + m * 16 + fr; const f32x2v sr = S[r]; const size_t off = (size_t)(u.pm * BM + r) * ldc + col0;
#pragma unroll
                for (int bj = 0; bj < 2; ++bj)
#pragma unroll
                    for (int n = 0; n < 2; ++n) { const f32x4 bs = *(const f32x4*)(base + off + bj * HALF + n * 16); acc[ai][bj][m][n] = bs + (acc[ai][bj][m][n] - sr.x) * sr.y; }
                asm volatile("" : "+v"(acc[ai][0][m][0]), "+v"(acc[ai][0][m][1]), "+v"(acc[ai][1][m][0]), "+v"(acc[ai][1][m][1]));
                if (m & 1) asm volatile("" ::: "memory"); }
        const bool bad1 = bad;
        bad = st2.run(acc, u, wr, wc, fr, fq, lds, wid, lane) || bad;
#pragma unroll
        for (int ai = 0; ai < 2; ++ai)
#pragma unroll
            for (int m = 0; m < 4; ++m) { const int r = ai * HALF + wr * 64 + m * 16 + fr; const f32x2v sr = S[r]; const size_t off = (size_t)(u.pm * BM + r) * ldc + col0;
#pragma unroll
                for (int bj = 0; bj < 2; ++bj)
#pragma unroll
                    for (int n = 0; n < 2; ++n) { const f32x4 x1 = acc[ai][bj][m][n]; *(f32x4*)(out + off + bj * HALF + n * 16) = bad1 ? (f32x4){qnan, qnan, qnan, qnan} : x1;
                        const f32x4 o = (x1 - sr.x) * sr.y; u32x2v w; w.x = cvt_pk_bf16(o[0], o[1]); w.y = cvt_pk_bf16(o[2], o[3]);
                        if (bad) { w.x = 0x7fc07fc0u; w.y = 0x7fc07fc0u; } *(u32x2v*)(xn + off + bj * HALF + n * 16) = w; }
                asm volatile("" ::: "memory"); }
    }
};

template <class Epi, class Sched, bool ALIGN_EPI = false, bool SP2 = false>
__device__ __forceinline__ void gemm_phase(PG8_LAS unsigned char* lds, const Gemm g, const Sched& S, const Epi& E) {
    const int tid = threadIdx.x, wid = __builtin_amdgcn_readfirstlane(tid >> 6), lane = tid & 63, wr = wid >> 2, wc = wid & 3, fr = lane & 15, fq = lane >> 4;
    const int K = g.K, nt = K / BK;
    unsigned voffA[2], voffB[2];
#pragma unroll
    for (int i = 0; i < 2; ++i) { int R, C; stage_rc(tid * 16 + i * 8192, R, C); const int Rb = Epi::PERM ? ((R & ~31) + perm32(R & 31)) : R;
        voffA[i] = (unsigned)(R * K + C) * 2u; voffB[i] = (unsigned)(Rb * K + C) * 2u; }
    const size_t kstep = (size_t)(BK * 2);
    const size_t hstep = (size_t)HALF * K * 2;
    const size_t tstep = 2 * hstep;
    const unsigned ldsw = (unsigned)wid * 1024u;
    const int aoff = lds_byte(wr * 64 + fr, fq * 8), boff = lds_byte(wc * 32 + fr, fq * 8);
#define PG8_SA(b, h) (((b) * 2 + (h)) * HTB)
#define PG8_SB(b, h) ((4 + (b) * 2 + (h)) * HTB)
#define PG8_STAGE(bufoff, gbase, voff) do { _Pragma("unroll") for (int _i = 0; _i < 2; ++_i) \
        __builtin_amdgcn_global_load_lds((const unsigned*)((const char*)(gbase) + (voff)[_i]), (PG8_LAS unsigned*)(lds + (bufoff) + ldsw + _i * 8192), 16, 0, 0); } while (0)
#define PG8_LDA(dst, b, h) do { _Pragma("unroll") for (int m = 0; m < 4; ++m) _Pragma("unroll") for (int k = 0; k < 2; ++k) dst[m][k] = *(const PG8_LAS bf16x8*)(lds + PG8_SA(b, h) + aoff + m * 2048 + k * 1024); } while (0)
#define PG8_LDB(dst, b, h) do { _Pragma("unroll") for (int n = 0; n < 2; ++n) _Pragma("unroll") for (int k = 0; k < 2; ++k) dst[n][k] = *(const PG8_LAS bf16x8*)(lds + PG8_SB(b, h) + boff + n * 2048 + k * 1024); } while (0)
#define PG8_MMA(ai, bj, At, Bt) do { __builtin_amdgcn_s_setprio(1); _Pragma("unroll") for (int m = 0; m < 4; ++m) _Pragma("unroll") for (int n = 0; n < 2; ++n) _Pragma("unroll") for (int k = 0; k < 2; ++k) \
        acc[ai][bj][m][n] = __builtin_amdgcn_mfma_f32_16x16x32_bf16(Bt[n][k], At[m][k], acc[ai][bj][m][n], 0, 0, 0); __builtin_amdgcn_s_setprio(0); } while (0)
#define PG8_WAIT_V(n) asm volatile("s_waitcnt vmcnt(" #n ")" ::: "memory")
#define PG8_WAIT_L(n) asm volatile("s_waitcnt lgkmcnt(" #n ")" ::: "memory")
#define PG8_BAR __builtin_amdgcn_s_barrier()
#define PG8_SCHED __builtin_amdgcn_sched_barrier(0)
    Unit cur, nxt; int ui = 0;
    if (!S.next(0, cur)) return;
    f32x4 acc[2][2][4][2];
#pragma unroll
    for (int a = 0; a < 2; ++a)
#pragma unroll
        for (int b = 0; b < 2; ++b)
#pragma unroll
            for (int m = 0; m < 4; ++m)
#pragma unroll
                for (int n = 0; n < 2; ++n) acc[a][b][m][n] = (f32x4){0.f, 0.f, 0.f, 0.f};
    bf16x8 At[4][2], B0[2][2], B1[2][2];
    const char* cA = (const char*)g.A + (size_t)cur.pm * tstep; const char* cB = (const char*)g.Bt + (size_t)cur.pn * tstep;
    S.a_ready(cur);
    if constexpr (SP2) {
        PG8_STAGE(PG8_SB(0, 0), cB, voffB); PG8_STAGE(PG8_SB(0, 1), cB + hstep, voffB); PG8_STAGE(PG8_SA(0, 0), cA, voffA); PG8_STAGE(PG8_SA(0, 1), cA + hstep, voffA);
        if (wr == 1) PG8_BAR;
        PG8_WAIT_V(2); PG8_BAR;
        PG8_STAGE(PG8_SB(1, 0), cB + kstep, voffB); PG8_STAGE(PG8_SA(1, 0), cA + kstep, voffA); PG8_STAGE(PG8_SB(1, 1), cB + hstep + kstep, voffB);
        PG8_WAIT_V(6); PG8_BAR;
    } else {
        PG8_STAGE(PG8_SB(0, 0), cB, voffB); PG8_STAGE(PG8_SA(0, 0), cA, voffA); PG8_STAGE(PG8_SB(0, 1), cB + hstep, voffB); PG8_STAGE(PG8_SA(0, 1), cA + hstep, voffA);
        if (wr == 1) PG8_BAR;
        PG8_WAIT_V(4); PG8_BAR;
        PG8_STAGE(PG8_SB(1, 0), cB + kstep, voffB); PG8_STAGE(PG8_SA(1, 0), cA + kstep, voffA); PG8_STAGE(PG8_SB(1, 1), cB + hstep + kstep, voffB);
        PG8_WAIT_V(6); PG8_BAR;
    }
    for (;;) {
        const bool has_next = S.next(ui + 1, nxt);
        const char* nA = has_next ? (const char*)g.A + (size_t)nxt.pm * tstep : cA; const char* nB = has_next ? (const char*)g.Bt + (size_t)nxt.pn * tstep : cB;
        for (int t = 0; t < nt; t += 2) {
            const bool last = (t == nt - 2);
            const char* a1 = cA + (size_t)(t + 1) * kstep;
            const char* a2 = last ? nA : cA + (size_t)(t + 2) * kstep; const char* b2 = last ? nB : cB + (size_t)(t + 2) * kstep;
            const char* a3 = a2 + kstep; const char* b3 = b2 + kstep;
            if (last && has_next) S.a_ready(nxt);
            if constexpr (SP2) {
            PG8_LDB(B0, 0, 0); PG8_LDB(B1, 0, 1); PG8_SCHED; PG8_LDA(At, 0, 0); PG8_STAGE(PG8_SA(1, 1), a1 + hstep, voffA);
            PG8_WAIT_V(8); PG8_WAIT_L(0); PG8_BAR; PG8_MMA(0, 0, At, B0); PG8_MMA(0, 1, At, B1); PG8_BAR; PG8_SCHED;
            PG8_LDA(At, 0, 1); PG8_STAGE(PG8_SB(0, 0), b2, voffB); PG8_STAGE(PG8_SB(0, 1), b2 + hstep, voffB); PG8_STAGE(PG8_SA(0, 0), a2, voffA);
            PG8_WAIT_V(8); PG8_WAIT_L(0); PG8_BAR; PG8_MMA(1, 0, At, B0); PG8_MMA(1, 1, At, B1); PG8_BAR; PG8_SCHED;
            PG8_LDB(B0, 1, 0); PG8_LDB(B1, 1, 1); PG8_SCHED; PG8_LDA(At, 1, 0); PG8_STAGE(PG8_SA(0, 1), a2 + hstep, voffA);
            PG8_WAIT_V(8); PG8_WAIT_L(0); PG8_BAR; PG8_MMA(0, 0, At, B0); PG8_MMA(0, 1, At, B1); PG8_BAR; PG8_SCHED;
            PG8_LDA(At, 1, 1); PG8_STAGE(PG8_SB(1, 0), b3, voffB); PG8_STAGE(PG8_SB(1, 1), b3 + hstep, voffB); PG8_STAGE(PG8_SA(1, 0), a3, voffA);
            PG8_WAIT_V(8); PG8_WAIT_L(0); PG8_BAR; PG8_MMA(1, 0, At, B0); PG8_MMA(1, 1, At, B1); PG8_BAR; PG8_SCHED;
            } else {
            PG8_LDB(B0, 0, 0); PG8_SCHED; PG8_LDA(At, 0, 0); PG8_STAGE(PG8_SA(1, 1), a1 + hstep, voffA);
            PG8_WAIT_L(8); PG8_BAR; PG8_WAIT_L(0); PG8_MMA(0, 0, At, B0); PG8_BAR; PG8_SCHED;
            PG8_LDB(B1, 0, 1); PG8_STAGE(PG8_SB(0, 0), b2, voffB);
            PG8_BAR; PG8_WAIT_L(0); PG8_MMA(0, 1, At, B1); PG8_BAR;
            PG8_LDA(At, 0, 1); PG8_STAGE(PG8_SA(0, 0), a2, voffA);
            PG8_BAR; PG8_WAIT_L(0); PG8_MMA(1, 0, At, B0); PG8_BAR; PG8_SCHED;
            PG8_STAGE(PG8_SB(0, 1), b2 + hstep, voffB);
            PG8_WAIT_V(6); PG8_BAR; PG8_MMA(1, 1, At, B1); PG8_BAR;
            PG8_LDB(B0, 1, 0); PG8_SCHED; PG8_LDA(At, 1, 0); PG8_STAGE(PG8_SA(0, 1), a2 + hstep, voffA);
            PG8_WAIT_L(8); PG8_BAR; PG8_WAIT_L(0); PG8_MMA(0, 0, At, B0); PG8_BAR; PG8_SCHED;
            PG8_LDB(B1, 1, 1); PG8_STAGE(PG8_SB(1, 0), b3, voffB);
            PG8_BAR; PG8_WAIT_L(0); PG8_MMA(0, 1, At, B1); PG8_BAR;
            PG8_LDA(At, 1, 1); PG8_STAGE(PG8_SA(1, 0), a3, voffA);
            PG8_BAR; PG8_WAIT_L(0); PG8_MMA(1, 0, At, B0); PG8_BAR; PG8_SCHED;
            PG8_STAGE(PG8_SB(1, 1), b3 + hstep, voffB);
            PG8_WAIT_V(6); PG8_BAR; PG8_MMA(1, 1, At, B1); PG8_BAR;
            }
        }
        if constexpr (ALIGN_EPI) { if (wr == 0) PG8_BAR; }
        if constexpr (!Epi::AFTER_DRAIN) { E(acc, cur, wr, wc, fr, fq); S.done(cur); }
        if (!has_next) break;
#pragma unroll
        for (int a = 0; a < 2; ++a)
#pragma unroll
            for (int b = 0; b < 2; ++b)
#pragma unroll
                for (int m = 0; m < 4; ++m)
#pragma unroll
                    for (int n = 0; n < 2; ++n) acc[a][b][m][n] = (f32x4){0.f, 0.f, 0.f, 0.f};
        cur = nxt; cA = nA; cB = nB; ++ui;
        if constexpr (ALIGN_EPI) { if (wr == 1) PG8_BAR; }
    }
    PG8_WAIT_V(0);
    if constexpr (!ALIGN_EPI) { if (wr == 0) PG8_BAR; }
    PG8_BAR;
    if constexpr (Epi::AFTER_DRAIN) { E.fused(acc, cur, wr, wc, fr, fq, lds, wid, lane); S.done(cur); }
#undef PG8_SA
#undef PG8_SB
#undef PG8_STAGE
#undef PG8_LDA
#undef PG8_LDB
#undef PG8_MMA
#undef PG8_WAIT_V
#undef PG8_WAIT_L
#undef PG8_BAR
#undef PG8_SCHED
}
}

#define GAS __attribute__((address_space(1)))
#define LAS __attribute__((address_space(3)))
typedef unsigned short bf16;
typedef float f32x4 __attribute__((ext_vector_type(4)));
typedef float f32x16 __attribute__((ext_vector_type(16)));
typedef short bf16x8 __attribute__((ext_vector_type(8)));
typedef short s16x4 __attribute__((ext_vector_type(4)));
typedef unsigned u32x4 __attribute__((ext_vector_type(4)));
typedef unsigned u32x2 __attribute__((ext_vector_type(2)));
typedef float f32x2_t __attribute__((ext_vector_type(2)));
typedef __bf16 bf16x2_t __attribute__((ext_vector_type(2)));
typedef GAS unsigned gu32;
#define RLX_AGENT __ATOMIC_RELAXED, __HIP_MEMORY_SCOPE_AGENT

constexpr int D = 1024, BP = 4, TP = 4096, MP = BP * TP, BS = 128, TS = 8, MS = BS * TS, M = MP + MS;
constexpr int SBH = 8, HD = 64, SBW = 512, DNH = 4, DND = 128, DNW = 512;
constexpr int IN_COLS = 3592, NPROJ = 3584;
constexpr int DFF = 2816, DFF2 = 5632, NMOD = 6144, NC = BP + BS;
constexpr int PAST = 2048, NPAGES = 16, PAGE = 128;
constexpr float EPS = 1e-6f, LOG2E = 1.4426950408889634f;
constexpr float QSCALE = 0.125f * LOG2E;
constexpr int NSPLIT = 4, NPART = 5;

constexpr size_t O_YP = 0, O_KP = 17825792, O_VP = 26214400, O_KS = 34603008, O_VS = 35127296, O_SP = 35651584, O_SS = 35913728,
                 O_DCP = 44302336, O_DCS = 44320768, O_FCP = 44910592, O_FCS = 44955648, O_END = 46397440;

constexpr size_t MiB = 1u << 20;
constexpr size_t WS_CTL = 0, CTL_ZERO_BYTES = MiB;
constexpr size_t WS_MOD = 1 * MiB, WS_SC = 5 * MiB, WS_WINX = 6 * MiB, WS_WIN_T = 7 * MiB, WS_WOUT_T = 14 * MiB, WS_WUP_T = 16 * MiB, WS_WDN_T = 27 * MiB,
                 WS_EXTRA = 33 * MiB, WS_H = 34 * MiB, WS_PROJ = 68 * MiB, WS_QB = 306 * MiB, WS_KB = 323 * MiB, WS_VT = 340 * MiB, WS_QD = 357 * MiB, WS_KD = 391 * MiB,
                 WS_VD = 425 * MiB, WS_BETA = 459 * MiB, WS_LOGA = 460 * MiB, WS_ODN = 461 * MiB, WS_MIXED = 495 * MiB, WS_X1 = 529 * MiB, WS_UP = 597 * MiB,
                 WS_ACT = 784 * MiB, WS_U = 878 * MiB, WS_KCUM = 910 * MiB, WS_QDEC = 926 * MiB, WS_KDECT = 942 * MiB, WS_INTRA = 958 * MiB, WS_GL = 966 * MiB,
                 WS_OPART = 967 * MiB, WS_LPART = 978 * MiB, WS_END = 979 * MiB;
constexpr int CW_QUEUE = 64;
constexpr int CW_BAR = 4096;

constexpr int RING_BYTES = 131072, MISC_OFF = RING_BYTES + 320, LDS_BYTES = 147456;

__device__ __forceinline__ unsigned cvtpk(float lo, float hi) { f32x2_t v = {lo, hi}; bf16x2_t b = __builtin_convertvector(v, bf16x2_t); return __builtin_bit_cast(unsigned, b); }
__device__ __forceinline__ bf16 f2bf(float f) { return (bf16)(cvtpk(f, 0.f) & 0xffffu); }
__device__ __forceinline__ float wave_sum(float v) {
#pragma unroll
    for (int o = 1; o < 64; o <<= 1) v += __shfl_xor(v, o);
    return v;
}
__device__ __forceinline__ float siluf(float x) { return x / (1.f + __expf(-x)); }
__device__ __forceinline__ u32x4 pack8(const f32x4 a, const f32x4 b) { u32x4 w; w.x = cvtpk(a.x, a.y); w.y = cvtpk(a.z, a.w); w.z = cvtpk(b.x, b.y); w.w = cvtpk(b.z, b.w); return w; }
__device__ __forceinline__ float bf2f(unsigned short h) { return __uint_as_float((unsigned)h << 16); }

#define XB_TMO      128
#define XB_XCNT(j)  (256  + 64 * (j))
#define XB_XSUB(j)  (1280 + 64 * (j))
#define XB_XGEN(j)  (2304 + 64 * (j))
#define XB_TOP      3328
#define XB_TOPGEN   3392
#define XCD_BAR_WORDS 3456
#define XB_SPIN_CAP (1u << 18)
__device__ __forceinline__ unsigned xb_ld(unsigned* p)              { return __hip_atomic_load(p, __ATOMIC_RELAXED, __HIP_MEMORY_SCOPE_AGENT); }
__device__ __forceinline__ unsigned xb_add(unsigned* p, unsigned v) { return __hip_atomic_fetch_add(p, v, __ATOMIC_RELAXED, __HIP_MEMORY_SCOPE_AGENT); }
__device__ __forceinline__ unsigned xb_xcc_id() { return (unsigned)__builtin_amdgcn_s_getreg((3 << 11) | 20) & 0xFu; }
#define XB_SPIN(cond, bar) do { unsigned _sp = 0; while (cond) { __builtin_amdgcn_s_sleep(1); \
    if ((++_sp & 255u) == 0u) { if (xb_ld(&(bar)[XB_TMO])) break; if (_sp > XB_SPIN_CAP) { atomicAdd(&(bar)[XB_TMO], 1u); break; } } } } while (0)
struct XcdBarrier { unsigned* bar; unsigned x; volatile LAS unsigned* st; };
__device__ __forceinline__ XcdBarrier xcd_barrier_post(unsigned* bar, volatile LAS unsigned* st) {
    XcdBarrier b; b.bar = bar; b.x = xb_xcc_id(); b.st = st;
    if (threadIdx.x == 0) (void)xb_add(&bar[XB_XCNT(b.x)], 1u);
    return b;
}
__device__ __forceinline__ void xcd_barrier_complete(unsigned* bar, unsigned x, unsigned& nloc, unsigned& nx) {
    const unsigned G = gridDim.x * gridDim.y * gridDim.z;
    unsigned sum, cnt, mine, sp = 0u;
    for (;;) {
        sum = 0u; cnt = 0u; mine = 0u;
#pragma unroll
        for (unsigned j = 0; j < 16; ++j) { const unsigned c = xb_ld(&bar[XB_XCNT(j)]); sum += c; cnt += (c > 0u) ? 1u : 0u; mine = (j == x) ? c : mine; }
        if (sum == G) break;
        __builtin_amdgcn_s_sleep(1);
        if ((++sp & 255u) == 0u) { if (xb_ld(&bar[XB_TMO])) break; if (sp > XB_SPIN_CAP) { atomicAdd(&bar[XB_TMO], 1u); break; } }
    }
    nloc = mine > 0u ? mine : 1u; nx = cnt > 0u ? cnt : 1u;
}
__device__ __forceinline__ void xcd_barrier(const XcdBarrier& b) {
    asm volatile("s_waitcnt vmcnt(0)" ::: "memory");
    __syncthreads();
    if (threadIdx.x == 0) {
        unsigned* bar = b.bar;
        __builtin_amdgcn_s_waitcnt(0);
        unsigned nloc = b.st[0], nx = b.st[1];
        if (nloc == 0u) { xcd_barrier_complete(bar, b.x, nloc, nx); b.st[0] = nloc; b.st[1] = nx; }
        const unsigned old = xb_add(&bar[XB_XSUB(b.x)], 1u);
        const unsigned gen = old / nloc;
        if (old + 1u == (gen + 1u) * nloc) {
            __builtin_amdgcn_fence(__ATOMIC_RELEASE, "agent");
            asm volatile("s_waitcnt vmcnt(0)" ::: "memory");
            const unsigned og = xb_add(&bar[XB_TOP], 1u);
            const unsigned tg = og / nx;
            if (og + 1u == (tg + 1u) * nx) xb_add(&bar[XB_TOPGEN], 1u);
            else XB_SPIN(xb_ld(&bar[XB_TOPGEN]) == tg, bar);
            __builtin_amdgcn_fence(__ATOMIC_ACQUIRE, "agent");
            xb_add(&bar[XB_XGEN(b.x)], 1u);
            asm volatile("s_waitcnt vmcnt(0)" ::: "memory");
        } else {
            XB_SPIN(xb_ld(&bar[XB_XGEN(b.x)]) == gen, bar);
            __builtin_amdgcn_fence(__ATOMIC_ACQUIRE, "agent");
            asm volatile("s_waitcnt vmcnt(0)" ::: "memory");
        }
    }
    __syncthreads();
}

struct Args { const void* in[27]; float* out; unsigned char* ws; int lo, hi; };
enum { I_XP = 0, I_XS, I_CP, I_CS, I_CK, I_CV, I_PT, I_SD, I_SDC, I_SFC, I_WADA, I_BADA, I_GATT, I_WIN, I_GQ, I_GK, I_SBB, I_GSBO, I_WDNC, I_ALOG, I_DTB, I_GDNO, I_WOUT, I_GFFN, I_WUP, I_WFC, I_WDN };

__device__ __forceinline__ int mod_row(int m) { return m < MP ? (m >> 12) : BP + ((m - MP) >> 3); }

struct EpiF32 {
    static constexpr bool PERM = false, AFTER_DRAIN = false;
    float* O; int ldc;
    __device__ __forceinline__ void operator()(const pg8::f32x4 (&acc)[2][2][4][2], const pg8::Unit& u, int wr, int wc, int fr, int fq) const {
        const int row0 = u.pm * 256 + wr * 64 + fr, col0 = u.pn * 256 + wc * 32 + 4 * fq;
#pragma unroll
        for (int ai = 0; ai < 2; ++ai)
#pragma unroll
            for (int m = 0; m < 4; ++m) { float* rowp = O + (size_t)(row0 + ai * 128 + m * 16) * ldc + col0;
#pragma unroll
                for (int bj = 0; bj < 2; ++bj)
#pragma unroll
                    for (int n = 0; n < 2; ++n) *(pg8::f32x4*)(rowp + bj * 128 + n * 16) = acc[ai][bj][m][n]; }
    }
};
struct EpiResGate {
    static constexpr bool PERM = false, AFTER_DRAIN = false;
    const float* base0; const float* base1; const float* mod; int goff; float* out;
    __device__ __forceinline__ void operator()(const pg8::f32x4 (&acc)[2][2][4][2], const pg8::Unit& u, int wr, int wc, int fr, int fq) const {
        const int row0 = u.pm * 256 + wr * 64 + fr, col0 = u.pn * 256 + wc * 32 + 4 * fq;
#pragma unroll
        for (int ai = 0; ai < 2; ++ai)
#pragma unroll
            for (int m = 0; m < 4; ++m) { const int r = row0 + ai * 128 + m * 16;
                const float* bp = (r < MP ? base0 + (size_t)r * D : base1 + (size_t)(r - MP) * D) + col0;
                const float* gp = mod + (size_t)mod_row(r) * NMOD + goff + col0; float* op = out + (size_t)r * D + col0;
#pragma unroll
                for (int bj = 0; bj < 2; ++bj)
#pragma unroll
                    for (int n = 0; n < 2; ++n) { const pg8::f32x4 b = *(const pg8::f32x4*)(bp + bj * 128 + n * 16), g = *(const pg8::f32x4*)(gp + bj * 128 + n * 16);
                        *(pg8::f32x4*)(op + bj * 128 + n * 16) = b + g * acc[ai][bj][m][n]; } }
    }
};

__device__ __forceinline__ void transpose_item(const float* W, int ldw, int src_col0, bf16* WT, int Kdst, int dst_row0, int k0, LAS float* scr, int lane) {
#pragma unroll 8
    for (int i = 0; i < 32; ++i) { const int kk = 2 * i + (lane >> 5); scr[kk * 33 + (lane & 31)] = W[(size_t)(k0 + kk) * ldw + src_col0 + (lane & 31)]; }
    asm volatile("s_waitcnt lgkmcnt(0)" ::: "memory");
    const int c = lane & 7;
#pragma unroll
    for (int j = 0; j < 4; ++j) { const int n = (lane >> 3) + 8 * j; const LAS float* s = scr + (8 * c) * 33 + n;
        u32x4 o; o.x = cvtpk(s[0 * 33], s[1 * 33]); o.y = cvtpk(s[2 * 33], s[3 * 33]); o.z = cvtpk(s[4 * 33], s[5 * 33]); o.w = cvtpk(s[6 * 33], s[7 * 33]);
        *(u32x4*)(WT + (size_t)(dst_row0 + n) * Kdst + k0 + 8 * c) = o; }
    asm volatile("s_waitcnt lgkmcnt(0)" ::: "memory");
}
__device__ __forceinline__ void phase_prologue(const Args& A, LAS unsigned char* lds, int gw, int NGW, int wave, int lane, int gtid, int NGT) {
    unsigned char* ws = A.ws;
    LAS float* scr = (LAS float*)(lds + wave * 16384);
    const float* w_in = (const float*)A.in[I_WIN]; const float* w_out = (const float*)A.in[I_WOUT]; const float* w_up = (const float*)A.in[I_WUP]; const float* w_dn = (const float*)A.in[I_WDN];
    constexpr int I_IN = 16 * (NPROJ / 32), I_OUT = 16 * 32, I_UP = 16 * (DFF2 / 32), I_DN = (DFF / 64) * 32, NIT = I_IN + I_OUT + I_UP + I_DN;
    for (int it = gw; it < NIT; it += NGW) {
        int r = it;
        if (r < I_IN) { const int nb = r % (NPROJ / 32), kb = r / (NPROJ / 32); const int n0 = nb * 32; transpose_item(w_in, IN_COLS, n0 < 3072 ? n0 : n0 + 8, (bf16*)(ws + WS_WIN_T), D, n0, kb * 64, scr, lane); continue; } r -= I_IN;
        if (r < I_OUT) { const int nb = r % 32, kb = r / 32; transpose_item(w_out, D, nb * 32, (bf16*)(ws + WS_WOUT_T), D, nb * 32, kb * 64, scr, lane); continue; } r -= I_OUT;
        if (r < I_UP) { const int nb = r % (DFF2 / 32), kb = r / (DFF2 / 32); transpose_item(w_up, DFF2, nb * 32, (bf16*)(ws + WS_WUP_T), D, nb * 32, kb * 64, scr, lane); continue; } r -= I_UP;
        { const int nb = r % 32, kb = r / 32; transpose_item(w_dn, D, nb * 32, (bf16*)(ws + WS_WDN_T), DFF, nb * 32, kb * 64, scr, lane); }
    }
    bf16* SC = (bf16*)(ws + WS_SC); const float* cp = (const float*)A.in[I_CP]; const float* cs = (const float*)A.in[I_CS];
    for (int i = gtid; i < 144 * D; i += NGT) { const int r = i >> 10, k = i & 1023; float v = 0.f; if (r < BP) v = cp[r * D + k]; else if (r < NC) v = cs[(r - BP) * D + k]; SC[i] = (r < NC) ? f2bf(siluf(v)) : (bf16)0; }
    float* WX = (float*)(ws + WS_WINX);
    for (int i = gtid; i < 8 * D; i += NGT) { const int j = i >> 10, k = i & 1023; WX[i] = w_in[(size_t)k * IN_COLS + 3072 + j]; }
}

__device__ __forceinline__ void phase_mod(const Args& A, int gw, int NGW, int lane) {
    const float* w_ada = (const float*)A.in[I_WADA]; const float* b_ada = (const float*)A.in[I_BADA];
    const bf16* SC = (const bf16*)(A.ws + WS_SC); float* MOD = (float*)(A.ws + WS_MOD);
    const int lr = lane & 15, q = lane >> 4;
    for (int it = gw; it < NMOD / 16; it += NGW) {
        const int col = it * 16 + lr;
        pg8::f32x4 acc[9];
#pragma unroll
        for (int i = 0; i < 9; ++i) acc[i] = (pg8::f32x4){0.f, 0.f, 0.f, 0.f};
#pragma unroll 2
        for (int s = 0; s < 32; ++s) {
            const float* wp = w_ada + (size_t)(32 * s + 8 * q) * NMOD + col;
            float w[8];
#pragma unroll
            for (int j = 0; j < 8; ++j) w[j] = wp[(size_t)j * NMOD];
            u32x4 bw; bw.x = cvtpk(w[0], w[1]); bw.y = cvtpk(w[2], w[3]); bw.z = cvtpk(w[4], w[5]); bw.w = cvtpk(w[6], w[7]);
            const bf16x8 bfr = __builtin_bit_cast(bf16x8, bw);
#pragma unroll
            for (int i = 0; i < 9; ++i) { const bf16x8 a = *(const bf16x8*)(SC + (size_t)(16 * i + lr) * D + 32 * s + 8 * q); acc[i] = __builtin_amdgcn_mfma_f32_16x16x32_bf16(a, bfr, acc[i], 0, 0, 0); }
        }
        const float bb = b_ada[col];
#pragma unroll
        for (int i = 0; i < 9; ++i)
#pragma unroll
            for (int r = 0; r < 4; ++r) { const int row = 16 * i + 4 * q + r; if (row < NC) MOD[(size_t)row * NMOD + col] = acc[i][r] + bb; }
    }
}

template <bool EXTRAS>
__device__ __forceinline__ void phase_norm(const float* x0, const float* x1, const float* g, const float* MOD, int sh_off, int sc_off, bf16* H, const float* WX, float* EXTRA, int gw, int NGW, int lane) {
    for (int m = gw; m < M; m += NGW) {
        const float* xr = m < MP ? x0 + (size_t)m * D : x1 + (size_t)(m - MP) * D;
        const float* mod = MOD + (size_t)mod_row(m) * NMOD;
        f32x4 v[4]; float ss = 0.f;
#pragma unroll
        for (int j = 0; j < 4; ++j) { v[j] = *(const f32x4*)(xr + 4 * (lane + 64 * j)); ss += (v[j].x * v[j].x + v[j].y * v[j].y) + (v[j].z * v[j].z + v[j].w * v[j].w); }
        ss = wave_sum(ss);
        const float rstd = 1.0f / sqrtf(ss * (1.f / D) + EPS);
        float ex[8];
#pragma unroll
        for (int e = 0; e < 8; ++e) ex[e] = 0.f;
#pragma unroll
        for (int j = 0; j < 4; ++j) { const int c = 4 * (lane + 64 * j);
            const f32x4 gg = *(const f32x4*)(g + c), sc = *(const f32x4*)(mod + sc_off + c), sh = *(const f32x4*)(mod + sh_off + c);
            const f32x4 h = (v[j] * rstd) * gg * (sc + 1.0f) + sh;
            u32x2 w; w.x = cvtpk(h.x, h.y); w.y = cvtpk(h.z, h.w); *(u32x2*)(H + (size_t)m * D + c) = w;
            if (EXTRAS) {
#pragma unroll
                for (int e = 0; e < 8; ++e) { const f32x4 wx = *(const f32x4*)(WX + e * D + c); ex[e] += (h.x * wx.x + h.y * wx.y) + (h.z * wx.z + h.w * wx.w); }
            }
        }
        if (EXTRAS) {
#pragma unroll
            for (int e = 0; e < 8; ++e) ex[e] = wave_sum(ex[e]);
            float mine = ex[0];
#pragma unroll
            for (int e = 1; e < 8; ++e) mine = (lane == e) ? ex[e] : mine;
            if (lane < 8) EXTRA[(size_t)m * 8 + lane] = mine;
        }
    }
}

__device__ __forceinline__ void phase_post(const Args& A, int gw, int NGW, int lane) {
    unsigned char* ws = A.ws; const float* PROJ = (const float*)(ws + WS_PROJ); float* out = A.out;
    const float* g_q = (const float*)A.in[I_GQ]; const float* g_k = (const float*)A.in[I_GK]; const float* wc = (const float*)A.in[I_WDNC];
    const float* sdc = (const float*)A.in[I_SDC]; const float* a_log = (const float*)A.in[I_ALOG]; const float* dtb = (const float*)A.in[I_DTB];
    bf16* QB = (bf16*)(ws + WS_QB); bf16* KB = (bf16*)(ws + WS_KB);
    float* QD = (float*)(ws + WS_QD); float* KD = (float*)(ws + WS_KD); float* VD = (float*)(ws + WS_VD);
    float* BETA = (float*)(ws + WS_BETA); float* LOGA = (float*)(ws + WS_LOGA); const float* EXTRA = (const float*)(ws + WS_EXTRA);
    const int c8 = 8 * lane;
    for (int m = gw; m < M; m += NGW) {
        const bool prompt = m < MP; const int b = prompt ? (m >> 12) : ((m - MP) >> 3), t = prompt ? (m & 4095) : ((m - MP) & 7);
        const float* pr = PROJ + (size_t)m * NPROJ;
        {
            f32x4 a0 = *(const f32x4*)(pr + c8), a1 = *(const f32x4*)(pr + c8 + 4);
            float ss = (a0.x * a0.x + a0.y * a0.y) + (a0.z * a0.z + a0.w * a0.w) + (a1.x * a1.x + a1.y * a1.y) + (a1.z * a1.z + a1.w * a1.w);
            ss += __shfl_xor(ss, 1); ss += __shfl_xor(ss, 2); ss += __shfl_xor(ss, 4);
            const float rs = QSCALE / sqrtf(ss * (1.f / HD) + EPS);
            const f32x4 g0 = *(const f32x4*)(g_q + (c8 & 63)), g1 = *(const f32x4*)(g_q + (c8 & 63) + 4);
            *(u32x4*)(QB + (size_t)m * SBW + c8) = pack8(a0 * rs * g0, a1 * rs * g1);
        }
        {
            f32x4 a0 = *(const f32x4*)(pr + 512 + c8), a1 = *(const f32x4*)(pr + 512 + c8 + 4);
            float ss = (a0.x * a0.x + a0.y * a0.y) + (a0.z * a0.z + a0.w * a0.w) + (a1.x * a1.x + a1.y * a1.y) + (a1.z * a1.z + a1.w * a1.w);
            ss += __shfl_xor(ss, 1); ss += __shfl_xor(ss, 2); ss += __shfl_xor(ss, 4);
            const float rs = 1.0f / sqrtf(ss * (1.f / HD) + EPS);
            const f32x4 g0 = *(const f32x4*)(g_k + (c8 & 63)), g1 = *(const f32x4*)(g_k + (c8 & 63) + 4);
            a0 = a0 * rs * g0; a1 = a1 * rs * g1;
            float* ko = prompt ? out + O_KP + (size_t)m * SBW + c8 : out + O_KS + (size_t)(m - MP) * SBW + c8;
            *(f32x4*)ko = a0; *(f32x4*)(ko + 4) = a1;
            *(u32x4*)(KB + (size_t)m * SBW + c8) = pack8(a0, a1);
        }
        {
            const f32x4 a0 = *(const f32x4*)(pr + 1024 + c8), a1 = *(const f32x4*)(pr + 1024 + c8 + 4);
            float* vo = prompt ? out + O_VP + (size_t)m * SBW + c8 : out + O_VS + (size_t)(m - MP) * SBW + c8;
            *(f32x4*)vo = a0; *(f32x4*)(vo + 4) = a1;
        }
#pragma unroll
        for (int part = 0; part < 3; ++part) {
            const int ch = part * 512 + c8;
            f32x4 y0 = (f32x4){0.f, 0.f, 0.f, 0.f}, y1 = y0;
#pragma unroll
            for (int i = 0; i < 4; ++i) {
                const int tt = t - 3 + i;
                f32x4 x0, x1;
                if (tt >= 0) { const float* p = pr - (size_t)(3 - i) * NPROJ + 1536 + ch; x0 = *(const f32x4*)p; x1 = *(const f32x4*)(p + 4); }
                else if (!prompt) { const float* p = sdc + ((size_t)b * 3 + (3 + tt)) * 1536 + ch; x0 = *(const f32x4*)p; x1 = *(const f32x4*)(p + 4); }
                else { x0 = (f32x4){0.f, 0.f, 0.f, 0.f}; x1 = x0; }
                const f32x4 w0 = *(const f32x4*)(wc + i * 1536 + ch), w1 = *(const f32x4*)(wc + i * 1536 + ch + 4);
                y0 += w0 * x0; y1 += w1 * x1;
                if (i == 3) {
                    const int idx = prompt ? t - (TP - 3) : t - (TS - 3);
                    if (idx >= 0) { float* o = prompt ? out + O_DCP + ((size_t)b * 3 + idx) * 1536 + ch : out + O_DCS + ((size_t)b * 3 + idx) * 1536 + ch; *(f32x4*)o = x0; *(f32x4*)(o + 4) = x1; }
                }
            }
            y0.x = siluf(y0.x); y0.y = siluf(y0.y); y0.z = siluf(y0.z); y0.w = siluf(y0.w); y1.x = siluf(y1.x); y1.y = siluf(y1.y); y1.z = siluf(y1.z); y1.w = siluf(y1.w);
            if (part < 2) {
                float ss = (y0.x * y0.x + y0.y * y0.y) + (y0.z * y0.z + y0.w * y0.w) + (y1.x * y1.x + y1.y * y1.y) + (y1.z * y1.z + y1.w * y1.w);
                ss += __shfl_xor(ss, 1); ss += __shfl_xor(ss, 2); ss += __shfl_xor(ss, 4); ss += __shfl_xor(ss, 8);
                const float rs = (part == 0 ? 0.08838834764831845f : 1.0f) / sqrtf(ss + EPS);
                y0 = y0 * rs; y1 = y1 * rs;
            }
            float* dst = (part == 0 ? QD : part == 1 ? KD : VD) + (size_t)m * DNW + c8;
            *(f32x4*)dst = y0; *(f32x4*)(dst + 4) = y1;
        }
        if (lane < 8) {
            const float x = EXTRA[(size_t)m * 8 + lane];
            if (lane < 4) BETA[(size_t)m * 4 + lane] = 1.f / (1.f + __expf(-x));
            else { const int h = lane - 4; const float z = x + dtb[h]; const float sp = fmaxf(z, 0.f) + log1pf(__expf(-fabsf(z))); LOGA[(size_t)m * 4 + h] = -__expf(a_log[h]) * sp; }
        }
    }
}

__device__ __forceinline__ void dn_prescan_unit(const Args& A, LAS unsigned char* lds, int unit, int tid, int wave, int lane) {
    unsigned char* ws = A.ws;
    const float* QD = (const float*)(ws + WS_QD); const float* KD = (const float*)(ws + WS_KD); const float* VD = (const float*)(ws + WS_VD);
    const float* BETA = (const float*)(ws + WS_BETA); const float* LOGA = (const float*)(ws + WS_LOGA);
    const int hp = unit & 1, n = (unit >> 1) & 63, b = unit >> 7;
    const int half = tid >> 8, ht = tid & 255, h = 2 * hp + half, item = (b * 64 + n) * 4 + h;
    const int m0 = b * TP + n * 64;
    LAS float* Am = (LAS float*)lds + half * 4096;
    LAS float* gs = (LAS float*)(lds + 32768) + half * 128;
    if (ht < 64) {
        float v = LOGA[(size_t)(m0 + ht) * 4 + h];
#pragma unroll
        for (int o = 1; o < 64; o <<= 1) { const float u = __shfl_up(v, o); if (ht >= o) v += u; }
        gs[ht] = v; gs[64 + ht] = BETA[(size_t)(m0 + ht) * 4 + h];
    }
    __syncthreads();
    {
        const int wl = wave & 3, lr = lane & 15, q = lane >> 4;
        pg8::f32x4 kk[4], qk[4];
#pragma unroll
        for (int j = 0; j < 4; ++j) { kk[j] = (pg8::f32x4){0.f, 0.f, 0.f, 0.f}; qk[j] = kk[j]; }
#pragma unroll
        for (int s = 0; s < 4; ++s) {
            const float* kp = KD + (size_t)(m0 + 16 * wl + lr) * DNW + h * 128 + 32 * s + 8 * q; const float* qp = QD + (size_t)(m0 + 16 * wl + lr) * DNW + h * 128 + 32 * s + 8 * q;
            const bf16x8 ak = __builtin_bit_cast(bf16x8, pack8(*(const f32x4*)kp, *(const f32x4*)(kp + 4))), aq = __builtin_bit_cast(bf16x8, pack8(*(const f32x4*)qp, *(const f32x4*)(qp + 4)));
#pragma unroll
            for (int j = 0; j < 4; ++j) { const float* bp = KD + (size_t)(m0 + 16 * j + lr) * DNW + h * 128 + 32 * s + 8 * q;
                const bf16x8 bk = __builtin_bit_cast(bf16x8, pack8(*(const f32x4*)bp, *(const f32x4*)(bp + 4)));
                kk[j] = __builtin_amdgcn_mfma_f32_16x16x32_bf16(ak, bk, kk[j], 0, 0, 0); qk[j] = __builtin_amdgcn_mfma_f32_16x16x32_bf16(aq, bk, qk[j], 0, 0, 0); }
        }
        bf16* INTRA = (bf16*)(ws + WS_INTRA) + (size_t)item * 4096;
#pragma unroll
        for (int j = 0; j < 4; ++j)
#pragma unroll
            for (int r = 0; r < 4; ++r) { const int i = 16 * wl + 4 * q + r, jj = 16 * j + lr;
                const float dec = (i >= jj) ? __expf(gs[i] - gs[jj]) : 0.f;
                Am[i * 64 + jj] = (i > jj) ? gs[64 + i] * kk[j][r] * dec : 0.f;
                INTRA[i * 64 + jj] = f2bf(qk[j][r] * dec); }
    }
    __syncthreads();
    {
        const int c = ht; float x[64];
        float* U = (float*)(ws + WS_U) + (size_t)item * 8192; bf16* KC = (bf16*)(ws + WS_KCUM) + (size_t)item * 8192;
#pragma unroll
        for (int i = 0; i < 64; ++i) {
            const float bi = gs[64 + i];
            float r = (c < 128) ? VD[(size_t)(m0 + i) * DNW + h * 128 + c] * bi : KD[(size_t)(m0 + i) * DNW + h * 128 + (c - 128)] * bi * __expf(gs[i]);
#pragma unroll
            for (int j = 0; j < i; ++j) r -= Am[i * 64 + j] * x[j];
            x[i] = r;
            if (c < 128) U[i * 128 + c] = r; else KC[i * 128 + (c - 128)] = f2bf(r);
        }
    }
    {
        const float glast = gs[63];
        bf16* QDc = (bf16*)(ws + WS_QDEC) + (size_t)item * 8192; bf16* KT = (bf16*)(ws + WS_KDECT) + (size_t)item * 8192;
        for (int e = ht; e < 64 * 128; e += 256) { const int i = e >> 7, d = e & 127; QDc[e] = f2bf(QD[(size_t)(m0 + i) * DNW + h * 128 + d] * __expf(gs[i])); }
        { const int d = ht & 127, ig = ht >> 7;
#pragma unroll
            for (int i8 = 0; i8 < 4; ++i8) { float v[8];
#pragma unroll
                for (int k = 0; k < 8; ++k) { const int i = 32 * ig + 8 * i8 + k; v[k] = KD[(size_t)(m0 + i) * DNW + h * 128 + d] * __expf(glast - gs[i]); }
                u32x4 w; w.x = cvtpk(v[0], v[1]); w.y = cvtpk(v[2], v[3]); w.z = cvtpk(v[4], v[5]); w.w = cvtpk(v[6], v[7]);
                *(u32x4*)(KT + d * 64 + 32 * ig + 8 * i8) = w; } }
        if (ht == 0) ((float*)(ws + WS_GL))[item] = __expf(glast);
    }
    __syncthreads();
}
__device__ __forceinline__ void dn_sample_unit(const Args& A, LAS unsigned char* lds, int unit, int tid) {
    unsigned char* ws = A.ws;
    const float* QD = (const float*)(ws + WS_QD); const float* KD = (const float*)(ws + WS_KD); const float* VD = (const float*)(ws + WS_VD);
    const float* BETA = (const float*)(ws + WS_BETA); const float* LOGA = (const float*)(ws + WS_LOGA); float* ODN = (float*)(ws + WS_ODN);
    const int h = unit & 3, b = unit >> 2, e = tid & 127, dq = tid >> 7;
    const float* s0 = (const float*)A.in[I_SD] + ((size_t)(b * 4 + h) * 128 + 32 * dq) * 128 + e;
    float S[32];
#pragma unroll
    for (int d = 0; d < 32; ++d) S[d] = s0[(size_t)d * 128];
    LAS float* red = (LAS float*)lds; LAS float* red2 = red + 512;
    for (int t = 0; t < TS; ++t) {
        const int m = MP + b * TS + t;
        const float a = __expf(LOGA[(size_t)m * 4 + h]), bt = BETA[(size_t)m * 4 + h];
        const float* kp = KD + (size_t)m * DNW + h * 128 + 32 * dq; const float* qp = QD + (size_t)m * DNW + h * 128 + 32 * dq;
        float kd[32], qd[32];
#pragma unroll
        for (int d4 = 0; d4 < 8; ++d4) { const f32x4 kv = *(const f32x4*)(kp + 4 * d4), qv = *(const f32x4*)(qp + 4 * d4);
            kd[4 * d4] = kv.x; kd[4 * d4 + 1] = kv.y; kd[4 * d4 + 2] = kv.z; kd[4 * d4 + 3] = kv.w; qd[4 * d4] = qv.x; qd[4 * d4 + 1] = qv.y; qd[4 * d4 + 2] = qv.z; qd[4 * d4 + 3] = qv.w; }
        float p = 0.f;
#pragma unroll
        for (int d = 0; d < 32; ++d) p += kd[d] * S[d];
        red[dq * 128 + e] = p;
        __syncthreads();
        const float kS = (red[e] + red[128 + e]) + (red[256 + e] + red[384 + e]);
        const float dl = bt * (VD[(size_t)m * DNW + h * 128 + e] - a * kS);
        float po = 0.f;
#pragma unroll
        for (int d = 0; d < 32; ++d) { S[d] = a * S[d] + kd[d] * dl; po += qd[d] * S[d]; }
        red2[dq * 128 + e] = po;
        __syncthreads();
        if (dq == 0) ODN[(size_t)m * DNW + h * 128 + e] = (red2[e] + red2[128 + e]) + (red2[256 + e] + red2[384 + e]);
    }
    float* so = A.out + O_SS + ((size_t)(b * 4 + h) * 128 + 32 * dq) * 128 + e;
#pragma unroll
    for (int d = 0; d < 32; ++d) so[(size_t)d * 128] = S[d];
    __syncthreads();
}

constexpr int SC_KC = 0, SC_QD = 17408, SC_KT = 34816, SC_IN = 53248, SC_BUF = 62464;
__device__ __forceinline__ void dn_scan_chain(const Args& A, LAS unsigned char* lds, int chain, int tid, int wave, int lane) {
    unsigned char* ws = A.ws;
    const float* Ub = (const float*)(ws + WS_U); const float* GL = (const float*)(ws + WS_GL); float* ODN = (float*)(ws + WS_ODN);
    const int b = chain >> 2, h = chain & 3, lr = lane & 15, q = lane >> 4, e = 16 * wave + lr;
    const unsigned char* gsrc[4]; int ldst[7];
    { const int c0 = tid, c1 = tid + 512;
      ldst[0] = SC_KC + (c0 >> 4) * 272 + (c0 & 15) * 16; ldst[1] = SC_KC + (c1 >> 4) * 272 + (c1 & 15) * 16;
      ldst[2] = SC_QD + (c0 >> 4) * 272 + (c0 & 15) * 16; ldst[3] = SC_QD + (c1 >> 4) * 272 + (c1 & 15) * 16;
      ldst[4] = SC_KT + (c0 >> 3) * 144 + (c0 & 7) * 16;  ldst[5] = SC_KT + (c1 >> 3) * 144 + (c1 & 7) * 16;
      ldst[6] = SC_IN + (c0 >> 3) * 144 + (c0 & 7) * 16; }
    const size_t item0 = (size_t)(b * 64) * 4 + h;
    gsrc[0] = ws + WS_KCUM + item0 * 16384 + tid * 16; gsrc[1] = ws + WS_QDEC + item0 * 16384 + tid * 16; gsrc[2] = ws + WS_KDECT + item0 * 16384 + tid * 16; gsrc[3] = ws + WS_INTRA + item0 * 8192 + tid * 16;
    u32x4 R[7]; float un[16];
#define SC_GLOAD(n_) do { const size_t o16_ = (size_t)(n_) * 4 * 16384, o8_ = (size_t)(n_) * 4 * 8192; \
        R[0] = *(const u32x4*)(gsrc[0] + o16_); R[1] = *(const u32x4*)(gsrc[0] + o16_ + 8192); R[2] = *(const u32x4*)(gsrc[1] + o16_); R[3] = *(const u32x4*)(gsrc[1] + o16_ + 8192); \
        R[4] = *(const u32x4*)(gsrc[2] + o16_); R[5] = *(const u32x4*)(gsrc[2] + o16_ + 8192); R[6] = *(const u32x4*)(gsrc[3] + o8_); \
        const float* U_ = Ub + (item0 + 4 * (size_t)(n_)) * 8192 + e; \
        _Pragma("unroll") for (int i_ = 0; i_ < 4; ++i_) _Pragma("unroll") for (int r_ = 0; r_ < 4; ++r_) un[4 * i_ + r_] = U_[(16 * i_ + 4 * q + r_) * 128]; } while (0)
#define SC_LWRITE(buf_) do { _Pragma("unroll") for (int k_ = 0; k_ < 7; ++k_) *(LAS u32x4*)(lds + (buf_) * SC_BUF + ldst[k_]) = R[k_]; } while (0)
    pg8::f32x4 S[8];
#pragma unroll
    for (int i = 0; i < 8; ++i) S[i] = (pg8::f32x4){0.f, 0.f, 0.f, 0.f};
    __syncthreads();
    SC_GLOAD(0); SC_LWRITE(0);
    float uc[16];
#pragma unroll
    for (int k = 0; k < 16; ++k) uc[k] = un[k];
    __syncthreads();
    for (int n = 0; n < 64; ++n) {
        const float gl = GL[item0 + 4 * n];
        if (n + 1 < 64) SC_GLOAD(n + 1);
        const LAS unsigned char* B = lds + (n & 1) * SC_BUF;
        bf16x8 Sb[4];
#pragma unroll
        for (int s = 0; s < 4; ++s) { u32x4 w; w.x = cvtpk(S[2 * s][0], S[2 * s][1]); w.y = cvtpk(S[2 * s][2], S[2 * s][3]); w.z = cvtpk(S[2 * s + 1][0], S[2 * s + 1][1]); w.w = cvtpk(S[2 * s + 1][2], S[2 * s + 1][3]); Sb[s] = __builtin_bit_cast(bf16x8, w); }
        pg8::f32x4 vn[4], o[4];
#pragma unroll
        for (int i = 0; i < 4; ++i) {
            pg8::f32x4 ak = (pg8::f32x4){0.f, 0.f, 0.f, 0.f}, aq = ak;
#pragma unroll
            for (int s = 0; s < 4; ++s) {
                const LAS unsigned char* kp = B + SC_KC + (16 * i + lr) * 272 + (32 * s + 4 * q) * 2; const LAS unsigned char* qp = B + SC_QD + (16 * i + lr) * 272 + (32 * s + 4 * q) * 2;
                const u32x2 k0 = *(const LAS u32x2*)kp, k1 = *(const LAS u32x2*)(kp + 32), q0 = *(const LAS u32x2*)qp, q1 = *(const LAS u32x2*)(qp + 32);
                ak = __builtin_amdgcn_mfma_f32_16x16x32_bf16(__builtin_bit_cast(bf16x8, (u32x4){k0.x, k0.y, k1.x, k1.y}), Sb[s], ak, 0, 0, 0);
                aq = __builtin_amdgcn_mfma_f32_16x16x32_bf16(__builtin_bit_cast(bf16x8, (u32x4){q0.x, q0.y, q1.x, q1.y}), Sb[s], aq, 0, 0, 0);
            }
#pragma unroll
            for (int r = 0; r < 4; ++r) vn[i][r] = uc[4 * i + r] - ak[r];
            o[i] = aq;
        }
        bf16x8 Vb[2];
#pragma unroll
        for (int s = 0; s < 2; ++s) { u32x4 w; w.x = cvtpk(vn[2 * s][0], vn[2 * s][1]); w.y = cvtpk(vn[2 * s][2], vn[2 * s][3]); w.z = cvtpk(vn[2 * s + 1][0], vn[2 * s + 1][1]); w.w = cvtpk(vn[2 * s + 1][2], vn[2 * s + 1][3]); Vb[s] = __builtin_bit_cast(bf16x8, w); }
#pragma unroll
        for (int i = 0; i < 4; ++i) {
#pragma unroll
            for (int s = 0; s < 2; ++s) { const LAS unsigned char* ip = B + SC_IN + (16 * i + lr) * 144 + (32 * s + 4 * q) * 2; const u32x2 a0 = *(const LAS u32x2*)ip, a1 = *(const LAS u32x2*)(ip + 32);
                o[i] = __builtin_amdgcn_mfma_f32_16x16x32_bf16(__builtin_bit_cast(bf16x8, (u32x4){a0.x, a0.y, a1.x, a1.y}), Vb[s], o[i], 0, 0, 0); }
#pragma unroll
            for (int r = 0; r < 4; ++r) ODN[(size_t)(b * TP + 64 * n + 16 * i + 4 * q + r) * DNW + h * 128 + e] = o[i][r];
        }
#pragma unroll
        for (int i = 0; i < 8; ++i) {
            pg8::f32x4 acc = S[i] * gl;
#pragma unroll
            for (int s = 0; s < 2; ++s) { const LAS unsigned char* tp = B + SC_KT + (16 * i + lr) * 144 + (32 * s + 4 * q) * 2; const u32x2 a0 = *(const LAS u32x2*)tp, a1 = *(const LAS u32x2*)(tp + 32);
                acc = __builtin_amdgcn_mfma_f32_16x16x32_bf16(__builtin_bit_cast(bf16x8, (u32x4){a0.x, a0.y, a1.x, a1.y}), Vb[s], acc, 0, 0, 0); }
            S[i] = acc;
        }
        if (n + 1 < 64) {
            SC_LWRITE((n + 1) & 1);
#pragma unroll
            for (int k = 0; k < 16; ++k) uc[k] = un[k];
        }
        __syncthreads();
    }
#undef SC_GLOAD
#undef SC_LWRITE
    float* so = A.out + O_SP + (size_t)(b * 4 + h) * 16384;
#pragma unroll
    for (int i = 0; i < 8; ++i)
#pragma unroll
        for (int r = 0; r < 4; ++r) so[(16 * i + 4 * q + r) * 128 + e] = S[i][r];
}

__device__ __forceinline__ int crow(int r, int hi) { return (r & 3) + 8 * (r >> 2) + 4 * hi; }
__device__ __forceinline__ void sb_core(f32x16& p, float& carry, int hi) {
    float s[16];
#pragma unroll
    for (int r = 0; r < 16; ++r) { const float e = __builtin_amdgcn_exp2f(p[r]); s[r] = -__builtin_amdgcn_logf(1.0f + e); }
    float tt[4], uu[4];
#pragma unroll
    for (int i = 0; i < 4; ++i) { s[4 * i + 2] += s[4 * i + 3]; s[4 * i + 1] += s[4 * i + 2]; s[4 * i] += s[4 * i + 1]; tt[i] = s[4 * i]; }
#pragma unroll
    for (int i = 0; i < 4; ++i) uu[i] = __shfl_xor(tt[i], 32);
    const float w3 = tt[3] + uu[3], w2 = tt[2] + uu[2], w1 = tt[1] + uu[1], w0 = tt[0] + uu[0];
    float off[4];
    off[3] = carry; off[2] = carry + w3; off[1] = off[2] + w2; off[0] = off[1] + w1;
    carry = off[0] + w0;
    if (hi == 0) {
#pragma unroll
        for (int i = 0; i < 4; ++i) off[i] += uu[i];
    }
#pragma unroll
    for (int r = 0; r < 16; ++r) p[r] = __builtin_amdgcn_exp2f(p[r] + s[r] + off[r >> 2]);
}
__device__ __forceinline__ bf16x8 pack_p(const f32x16& p, int s) {
    u32x4 w; w.x = cvtpk(p[8 * s], p[8 * s + 1]); w.y = cvtpk(p[8 * s + 2], p[8 * s + 3]); w.z = cvtpk(p[8 * s + 4], p[8 * s + 5]); w.w = cvtpk(p[8 * s + 6], p[8 * s + 7]); return __builtin_bit_cast(bf16x8, w);
}
__device__ __forceinline__ void attn_prompt_item(const Args& A, int b, int h, int q0, int lane) {
    unsigned char* ws = A.ws;
    const bf16* QB = (const bf16*)(ws + WS_QB); const bf16* KB = (const bf16*)(ws + WS_KB); const bf16* VT = (const bf16*)(ws + WS_VT); bf16* MIXED = (bf16*)(ws + WS_MIXED);
    const int r32 = lane & 31, hi = lane >> 5, qpos = q0 + r32;
    const float bias2 = ((const float*)A.in[I_SBB])[h] * LOG2E;
    bf16x8 qf[4];
#pragma unroll
    for (int d0 = 0; d0 < 4; ++d0) qf[d0] = *(const bf16x8*)(QB + (size_t)(b * TP + qpos) * SBW + h * HD + 16 * d0 + 8 * hi);
    f32x16 o[2]; o[0] = (f32x16){}; o[1] = (f32x16){};
    float carry = 0.f;
    const int last = q0 + 30;
    for (int ht = last >> 5; ht >= 0; --ht) {
        const int kv0 = 32 * ht;
        f32x16 p;
#pragma unroll
        for (int r = 0; r < 16; ++r) p[r] = bias2;
        const bf16* kp = KB + (size_t)(b * TP + kv0 + r32) * SBW + h * HD + 8 * hi;
#pragma unroll
        for (int d0 = 0; d0 < 4; ++d0) { const bf16x8 kf = *(const bf16x8*)(kp + 16 * d0); p = __builtin_amdgcn_mfma_f32_32x32x16_bf16(kf, qf[d0], p, 0, 0, 0); }
        if (kv0 + 31 >= q0) {
#pragma unroll
            for (int r = 0; r < 16; ++r) if (kv0 + crow(r, hi) >= qpos) p[r] = -INFINITY;
        }
        sb_core(p, carry, hi);
        const bf16x8 p0 = pack_p(p, 0), p1 = pack_p(p, 1);
#pragma unroll
        for (int dt = 0; dt < 2; ++dt) {
            const bf16* vp = VT + (size_t)(h * HD + 32 * dt + r32) * M + b * TP + kv0 + 4 * hi;
            const u32x2 a0 = *(const u32x2*)vp, a1 = *(const u32x2*)(vp + 8), a2 = *(const u32x2*)(vp + 16), a3 = *(const u32x2*)(vp + 24);
            o[dt] = __builtin_amdgcn_mfma_f32_32x32x16_bf16(__builtin_bit_cast(bf16x8, (u32x4){a0.x, a0.y, a1.x, a1.y}), p0, o[dt], 0, 0, 0);
            o[dt] = __builtin_amdgcn_mfma_f32_32x32x16_bf16(__builtin_bit_cast(bf16x8, (u32x4){a2.x, a2.y, a3.x, a3.y}), p1, o[dt], 0, 0, 0);
        }
    }
    float ss = 0.f;
#pragma unroll
    for (int dt = 0; dt < 2; ++dt)
#pragma unroll
        for (int r = 0; r < 16; ++r) ss += o[dt][r] * o[dt][r];
    ss += __shfl_xor(ss, 32);
    const float rs = 1.0f / sqrtf(ss * (1.f / HD) + EPS);
    const float* gso = (const float*)A.in[I_GSBO];
    bf16* op = MIXED + (size_t)(b * TP + qpos) * D + h * HD;
#pragma unroll
    for (int dt = 0; dt < 2; ++dt)
#pragma unroll
        for (int g = 0; g < 4; ++g) { const int d = 32 * dt + 8 * g + 4 * hi; const f32x4 gg = *(const f32x4*)(gso + d);
            u32x2 w; w.x = cvtpk(o[dt][4 * g] * rs * gg.x, o[dt][4 * g + 1] * rs * gg.y); w.y = cvtpk(o[dt][4 * g + 2] * rs * gg.z, o[dt][4 * g + 3] * rs * gg.w); *(u32x2*)(op + d) = w; }
}

constexpr int KPITCH = 1040, VPITCH = 1088, LDS_KT = 0, LDS_VT = 32 * KPITCH;
__device__ __forceinline__ void attn_sample_tile(LAS unsigned char* lds, int h, int lane, const bf16x8 (&qf)[4], float bias2, f32x16 (&o)[2], float& carry, bool newtok) {
    const int r32 = lane & 31, hi = lane >> 5;
    f32x16 p;
#pragma unroll
    for (int r = 0; r < 16; ++r) p[r] = bias2;
    const LAS unsigned char* kp = lds + LDS_KT + r32 * KPITCH + (h * HD + 8 * hi) * 2;
#pragma unroll
    for (int d0 = 0; d0 < 4; ++d0) { const bf16x8 kf = *(const LAS bf16x8*)(kp + 32 * d0); p = __builtin_amdgcn_mfma_f32_32x32x16_bf16(kf, qf[d0], p, 0, 0, 0); }
    if (newtok) {
#pragma unroll
        for (int r = 0; r < 16; ++r) if (crow(r, hi) >= r32) p[r] = -INFINITY;
    }
    sb_core(p, carry, hi);
    const bf16x8 p0 = pack_p(p, 0), p1 = pack_p(p, 1);
    const LAS unsigned char* vb = lds + LDS_VT + (4 * hi + ((lane & 15) >> 2)) * VPITCH + (h * HD + ((lane >> 4) & 1) * 16 + (lane & 3) * 4) * 2;
#pragma unroll
    for (int dt = 0; dt < 2; ++dt) {
        s16x4 t0 = __builtin_bit_cast(s16x4, __builtin_amdgcn_ds_read_tr16_b64_v4i16((LAS s16x4*)(vb + dt * 64)));
        s16x4 t1 = __builtin_bit_cast(s16x4, __builtin_amdgcn_ds_read_tr16_b64_v4i16((LAS s16x4*)(vb + dt * 64 + 8 * VPITCH)));
        s16x4 t2 = __builtin_bit_cast(s16x4, __builtin_amdgcn_ds_read_tr16_b64_v4i16((LAS s16x4*)(vb + dt * 64 + 16 * VPITCH)));
        s16x4 t3 = __builtin_bit_cast(s16x4, __builtin_amdgcn_ds_read_tr16_b64_v4i16((LAS s16x4*)(vb + dt * 64 + 24 * VPITCH)));
        o[dt] = __builtin_amdgcn_mfma_f32_32x32x16_bf16((bf16x8){t0[0], t0[1], t0[2], t0[3], t1[0], t1[1], t1[2], t1[3]}, p0, o[dt], 0, 0, 0);
        o[dt] = __builtin_amdgcn_mfma_f32_32x32x16_bf16((bf16x8){t2[0], t2[1], t2[2], t2[3], t3[0], t3[1], t3[2], t3[3]}, p1, o[dt], 0, 0, 0);
    }
}
__device__ __forceinline__ void attn_sample_store(const Args& A, int b, int h, int part, int lane, const f32x16 (&o)[2], float carry) {
    float* OP = (float*)(A.ws + WS_OPART) + (size_t)((b * SBH + h) * NPART + part) * 512; float* LP = (float*)(A.ws + WS_LPART) + (size_t)((b * SBH + h) * NPART + part) * 8;
    const int r32 = lane & 31, hi = lane >> 5;
    if (r32 < 8) {
#pragma unroll
        for (int dt = 0; dt < 2; ++dt)
#pragma unroll
            for (int r = 0; r < 16; ++r) OP[(32 * dt + crow(r, hi)) * 8 + r32] = o[dt][r];
        if (hi == 0) LP[r32] = carry;
    }
}
__device__ __forceinline__ void attn_sample_unit(const Args& A, LAS unsigned char* lds, int unit, int tid, int wave, int lane) {
    unsigned char* ws = A.ws;
    const int sp = unit & 3, b = unit >> 2, h = wave, r32 = lane & 31, hi = lane >> 5;
    const float* ck = (const float*)A.in[I_CK]; const float* cv = (const float*)A.in[I_CV]; const int* pt = (const int*)A.in[I_PT] + b * NPAGES;
    const bf16* QB = (const bf16*)(ws + WS_QB);
    const float bias2 = ((const float*)A.in[I_SBB])[h] * LOG2E;
    bf16x8 qf[4];
#pragma unroll
    for (int d0 = 0; d0 < 4; ++d0) { qf[d0] = (bf16x8){0, 0, 0, 0, 0, 0, 0, 0}; if (r32 < TS) qf[d0] = *(const bf16x8*)(QB + (size_t)(MP + b * TS + r32) * SBW + h * HD + 16 * d0 + 8 * hi); }
    f32x16 o[2]; float carry;
    if (sp == NSPLIT - 1) {
        __syncthreads();
        for (int i = tid; i < 32 * 64; i += 512) { const int row = i >> 6, c8 = (i & 63) * 8;
            u32x4 kw = (u32x4){0u, 0u, 0u, 0u}, vw = kw;
            if (row < TS) { const size_t m = (size_t)(MP + b * TS + row); kw = *(const u32x4*)((const bf16*)(ws + WS_KB) + m * SBW + c8);
                const float* vp = (const float*)(ws + WS_PROJ) + m * NPROJ + 1024 + c8; vw = pack8(*(const f32x4*)vp, *(const f32x4*)(vp + 4)); }
            *(LAS u32x4*)(lds + LDS_KT + row * KPITCH + c8 * 2) = kw; *(LAS u32x4*)(lds + LDS_VT + row * VPITCH + c8 * 2) = vw; }
        __syncthreads();
        o[0] = (f32x16){}; o[1] = (f32x16){}; carry = 0.f;
        attn_sample_tile(lds, h, lane, qf, bias2, o, carry, true);
        attn_sample_store(A, b, h, NPART - 1, lane, o, carry);
    }
    o[0] = (f32x16){}; o[1] = (f32x16){}; carry = 0.f;
    const int tok_hi = (PAST / NSPLIT) * (sp + 1);
    f32x4 kr[8], vr[8];
#define SAMPLE_LOAD(j) do { const int tok0_ = tok_hi - 32 * ((j) + 1); const size_t base_ = ((size_t)pt[tok0_ >> 7] * PAGE + (tok0_ & 127)) * 512; \
        _Pragma("unroll") for (int i_ = 0; i_ < 8; ++i_) { kr[i_] = *(const f32x4*)(ck + base_ + 4 * (tid + 512 * i_)); vr[i_] = *(const f32x4*)(cv + base_ + 4 * (tid + 512 * i_)); } } while (0)
    SAMPLE_LOAD(0);
    constexpr int NT = PAST / NSPLIT / 32;
    for (int j = 0; j < NT; ++j) {
        __syncthreads();
#pragma unroll
        for (int i = 0; i < 8; ++i) { const int f = tid + 512 * i, row = f >> 7, c4 = (f & 127) * 4;
            u32x2 kw, vw; kw.x = cvtpk(kr[i].x, kr[i].y); kw.y = cvtpk(kr[i].z, kr[i].w); vw.x = cvtpk(vr[i].x, vr[i].y); vw.y = cvtpk(vr[i].z, vr[i].w);
            *(LAS u32x2*)(lds + LDS_KT + row * KPITCH + c4 * 2) = kw; *(LAS u32x2*)(lds + LDS_VT + row * VPITCH + c4 * 2) = vw; }
        if (j + 1 < NT) SAMPLE_LOAD(j + 1);
        __syncthreads();
        attn_sample_tile(lds, h, lane, qf, bias2, o, carry, false);
    }
#undef SAMPLE_LOAD
    attn_sample_store(A, b, h, sp, lane, o, carry);
    __syncthreads();
}

__device__ __forceinline__ void phase_outnorm(const Args& A, int gw, int NGW, int lane) {
    unsigned char* ws = A.ws; const float* ODN = (const float*)(ws + WS_ODN); const float* PROJ = (const float*)(ws + WS_PROJ); bf16* MIXED = (bf16*)(ws + WS_MIXED);
    const float* gdn = (const float*)A.in[I_GDNO]; const float* gso = (const float*)A.in[I_GSBO];
    const float* OPb = (const float*)(ws + WS_OPART); const float* LPb = (const float*)(ws + WS_LPART);
    const int c8 = 8 * lane;
    for (int m = gw; m < M; m += NGW) {
        {
            const float* op = ODN + (size_t)m * DNW + c8; f32x4 a0 = *(const f32x4*)op, a1 = *(const f32x4*)(op + 4);
            float ss = (a0.x * a0.x + a0.y * a0.y) + (a0.z * a0.z + a0.w * a0.w) + (a1.x * a1.x + a1.y * a1.y) + (a1.z * a1.z + a1.w * a1.w);
            ss += __shfl_xor(ss, 1); ss += __shfl_xor(ss, 2); ss += __shfl_xor(ss, 4); ss += __shfl_xor(ss, 8);
            const float rs = 1.0f / sqrtf(ss * (1.f / DND) + EPS);
            const f32x4 g0 = *(const f32x4*)(gdn + (c8 & 127)), g1 = *(const f32x4*)(gdn + (c8 & 127) + 4);
            const float* zp = PROJ + (size_t)m * NPROJ + 3072 + c8; f32x4 z0 = *(const f32x4*)zp, z1 = *(const f32x4*)(zp + 4);
            z0.x = siluf(z0.x); z0.y = siluf(z0.y); z0.z = siluf(z0.z); z0.w = siluf(z0.w); z1.x = siluf(z1.x); z1.y = siluf(z1.y); z1.z = siluf(z1.z); z1.w = siluf(z1.w);
            *(u32x4*)(MIXED + (size_t)m * D + SBW + c8) = pack8(a0 * rs * g0 * z0, a1 * rs * g1 * z1);
        }
        if (m >= MP) {
            const int b = (m - MP) >> 3, t = (m - MP) & 7, h = lane >> 3, d0 = c8 & 63;
            const float* OP = OPb + (size_t)(b * SBH + h) * NPART * 512; const float* LP = LPb + (size_t)(b * SBH + h) * NPART * 8;
            float v[8];
#pragma unroll
            for (int k = 0; k < 8; ++k) v[k] = 0.f;
            float suf = 0.f;
#pragma unroll
            for (int part = NPART - 1; part >= 0; --part) { const float w = __builtin_amdgcn_exp2f(suf);
#pragma unroll
                for (int k = 0; k < 8; ++k) v[k] += w * OP[part * 512 + (d0 + k) * 8 + t];
                suf += LP[part * 8 + t]; }
            float ss = 0.f;
#pragma unroll
            for (int k = 0; k < 8; ++k) ss += v[k] * v[k];
            ss += __shfl_xor(ss, 1); ss += __shfl_xor(ss, 2); ss += __shfl_xor(ss, 4);
            const float rs = 1.0f / sqrtf(ss * (1.f / HD) + EPS);
            const f32x4 g0 = *(const f32x4*)(gso + d0), g1 = *(const f32x4*)(gso + d0 + 4);
            *(u32x4*)(MIXED + (size_t)m * D + c8) = pack8((f32x4){v[0], v[1], v[2], v[3]} * rs * g0, (f32x4){v[4], v[5], v[6], v[7]} * rs * g1);
        }
    }
}

__device__ __forceinline__ f32x4 bf4lo(u32x4 w) { return (f32x4){__uint_as_float(w.x << 16), __uint_as_float(w.x & 0xffff0000u), __uint_as_float(w.y << 16), __uint_as_float(w.y & 0xffff0000u)}; }
__device__ __forceinline__ f32x4 bf4hi(u32x4 w) { return (f32x4){__uint_as_float(w.z << 16), __uint_as_float(w.z & 0xffff0000u), __uint_as_float(w.w << 16), __uint_as_float(w.w & 0xffff0000u)}; }
__device__ __forceinline__ void phase_convgate(const Args& A, int gw, int NGW, int lane) {
    unsigned char* ws = A.ws; const bf16* UP = (const bf16*)(ws + WS_UP); bf16* ACT = (bf16*)(ws + WS_ACT); float* out = A.out;
    const float* wf = (const float*)A.in[I_WFC]; const float* sfc = (const float*)A.in[I_SFC];
    for (int m = gw; m < M; m += NGW) {
        const bool prompt = m < MP; const int b = prompt ? (m >> 12) : ((m - MP) >> 3), t = prompt ? (m & 4095) : ((m - MP) & 7);
        const bf16* ur = UP + (size_t)m * DFF2;
        const int oidx = prompt ? t - (TP - 2) : t - (TS - 2);
        float* fo = oidx >= 0 ? (prompt ? out + O_FCP + ((size_t)b * 2 + oidx) * DFF2 : out + O_FCS + ((size_t)b * 2 + oidx) * DFF2) : nullptr;
        for (int ch = lane; ch < DFF / 8; ch += 64) {
            const int c = 8 * ch;
            f32x4 u0 = (f32x4){0.f, 0.f, 0.f, 0.f}, u1 = u0, g0 = u0, g1 = u0;
#pragma unroll
            for (int i = 0; i < 3; ++i) {
                const int tt = t - 2 + i;
                f32x4 xu0, xu1, xg0, xg1;
                if (tt >= 0) { const u32x4 wu = *(const u32x4*)(ur - (size_t)(2 - i) * DFF2 + c), wg = *(const u32x4*)(ur - (size_t)(2 - i) * DFF2 + DFF + c); xu0 = bf4lo(wu); xu1 = bf4hi(wu); xg0 = bf4lo(wg); xg1 = bf4hi(wg); }
                else if (!prompt) { const float* p = sfc + ((size_t)b * 2 + (2 + tt)) * DFF2 + c; xu0 = *(const f32x4*)p; xu1 = *(const f32x4*)(p + 4); xg0 = *(const f32x4*)(p + DFF); xg1 = *(const f32x4*)(p + DFF + 4); }
                else { xu0 = (f32x4){0.f, 0.f, 0.f, 0.f}; xu1 = xu0; xg0 = xu0; xg1 = xu0; }
                const float* wp = wf + (size_t)i * DFF2 + c;
                u0 += *(const f32x4*)wp * xu0; u1 += *(const f32x4*)(wp + 4) * xu1; g0 += *(const f32x4*)(wp + DFF) * xg0; g1 += *(const f32x4*)(wp + DFF + 4) * xg1;
                if (i == 2 && fo) { *(f32x4*)(fo + c) = xu0; *(f32x4*)(fo + c + 4) = xu1; *(f32x4*)(fo + DFF + c) = xg0; *(f32x4*)(fo + DFF + c + 4) = xg1; }
            }
            g0.x = siluf(g0.x); g0.y = siluf(g0.y); g0.z = siluf(g0.z); g0.w = siluf(g0.w); g1.x = siluf(g1.x); g1.y = siluf(g1.y); g1.z = siluf(g1.z); g1.w = siluf(g1.w);
            *(u32x4*)(ACT + (size_t)m * DFF + c) = pack8(g0 * u0, g1 * u1);
        }
    }
}

constexpr int NPHASE = 13;
#ifndef REP_MASK
#define REP_MASK 0
#endif

__global__ void __launch_bounds__(512, 2) fwd_kernel(Args A) {
    extern __shared__ __attribute__((aligned(16))) unsigned char lds_raw[];
    LAS unsigned char* lds = (LAS unsigned char*)lds_raw;
    const int tid = threadIdx.x, lane = tid & 63, wave = __builtin_amdgcn_readfirstlane(tid >> 6);
    const int G = gridDim.x, bx = blockIdx.x;
    const int gw = bx * 8 + wave, NGW = G * 8, gtid = bx * 512 + tid, NGT = G * 512;
    unsigned char* ws = A.ws;
    gu32* ctl = (gu32*)(ws + WS_CTL);
    volatile LAS unsigned* MISC = (volatile LAS unsigned*)(lds + MISC_OFF);
    for (int u = tid; u < (LDS_BYTES - RING_BYTES) / 4; u += 512) ((LAS unsigned*)(lds + RING_BYTES))[u] = 0u;
    __syncthreads();
    const int lo = A.lo, hi = A.hi;
    const bool multi = (hi - lo) > 1;
    XcdBarrier bar; bar.bar = (unsigned*)(ctl + CW_BAR); bar.x = 0; bar.st = nullptr;
    if (multi) bar = xcd_barrier_post((unsigned*)(ctl + CW_BAR), MISC + 8);
#define IN(k) (lo <= (k) && (k) < hi)
#define SEAM(k) do { if (IN(k) && IN((k) + 1)) xcd_barrier(bar); } while (0)
    float* MOD = (float*)(ws + WS_MOD);

#define PH0(rep_) phase_prologue(A, lds, gw, NGW, wave, lane, gtid, NGT);
#define PH1(rep_) phase_mod(A, gw, NGW, lane);
#define PH2(rep_) phase_norm<true>((const float*)A.in[I_XP], (const float*)A.in[I_XS], (const float*)A.in[I_GATT], MOD, 0, 1024, (bf16*)(ws + WS_H), (const float*)(ws + WS_WINX), (float*)(ws + WS_EXTRA), gw, NGW, lane);
#define PH3(rep_) { { pg8::Gemm g{(const pg8::bf16_t*)(ws + WS_H), (const pg8::bf16_t*)(ws + WS_WIN_T), M, NPROJ, D}; pg8::StaticOrder S; S.init(M, NPROJ, G, bx); \
          EpiF32 E{(float*)(ws + WS_PROJ), NPROJ}; \
          pg8::gemm_phase<EpiF32, pg8::StaticOrder, true, true>(lds, g, S, E); } \
        __syncthreads(); \
        { pg8::Gemm g{(const pg8::bf16_t*)(ws + WS_WIN_T) + (size_t)1024 * D, (const pg8::bf16_t*)(ws + WS_H), SBW, M, D}; pg8::StaticOrder S; S.init(SBW, M, G, bx);     \
          pg8::EpiBf16<0> E{(pg8::bf16_t*)(ws + WS_VT), M, nullptr, 0, 0, 1.f}; \
          pg8::gemm_phase<pg8::EpiBf16<0>, pg8::StaticOrder, true, true>(lds, g, S, E); } }
#define PH4(rep_) phase_post(A, gw, NGW, lane);
#define PH5(rep_) for (int u = bx; u < 1024; u += G) { if (u < 512) dn_prescan_unit(A, lds, u, tid, wave, lane); else dn_sample_unit(A, lds, u - 512, tid); }
#define PH6(rep_) PH6X(rep_, true, true, true)
#define PH6X(rep_, DS_, DP_, DA_) { if ((DS_) && bx < 16) dn_scan_chain(A, lds, bx, tid, wave, lane); \
          \
        for (;;) { \
            __syncthreads(); \
            if (tid == 0) MISC[0] = __hip_atomic_fetch_add(ctl + CW_QUEUE + 64 * (rep_), 1u, RLX_AGENT); \
            __syncthreads(); \
            const int job = (int)MISC[0]; \
            if (job >= 1024) break; \
            if (job & 1) { if (DA_) attn_sample_unit(A, lds, job >> 1, tid, wave, lane); } \
            else if (DP_) { const int j = job >> 1, qb = 15 - (j >> 5), bh = j & 31; attn_prompt_item(A, bh >> 3, bh & 7, qb * 256 + wave * 32, lane); } \
        } }
#define PH7(rep_) phase_outnorm(A, gw, NGW, lane);
#define PH8(rep_) { pg8::Gemm g{(const pg8::bf16_t*)(ws + WS_MIXED), (const pg8::bf16_t*)(ws + WS_WOUT_T), M, D, D}; pg8::StaticOrder S; S.init(M, D, G, bx); \
        EpiResGate E{(const float*)A.in[I_XP], (const float*)A.in[I_XS], MOD, 2048, (float*)(ws + WS_X1)}; \
        pg8::gemm_phase<EpiResGate, pg8::StaticOrder, true, true>(lds, g, S, E); }
#define PH9(rep_) phase_norm<false>((const float*)(ws + WS_X1), (const float*)(ws + WS_X1) + (size_t)MP * D, (const float*)A.in[I_GFFN], MOD, 3072, 4096, (bf16*)(ws + WS_H), nullptr, nullptr, gw, NGW, lane);
#define PH10(rep_) { pg8::Gemm g{(const pg8::bf16_t*)(ws + WS_H), (const pg8::bf16_t*)(ws + WS_WUP_T), M, DFF2, D}; pg8::StaticOrder S; S.init(M, DFF2, G, bx); \
        pg8::EpiBf16<0> E{(pg8::bf16_t*)(ws + WS_UP), DFF2, nullptr, 0, 0, 1.f}; \
        pg8::gemm_phase<pg8::EpiBf16<0>, pg8::StaticOrder, true, true>(lds, g, S, E); }
#define PH11(rep_) phase_convgate(A, gw, NGW, lane);
#define PH12(rep_) { pg8::Gemm g{(const pg8::bf16_t*)(ws + WS_ACT), (const pg8::bf16_t*)(ws + WS_WDN_T), M, D, DFF}; pg8::StaticOrder S; S.init(M, D, G, bx); \
        EpiResGate E{(const float*)(ws + WS_X1), (const float*)(ws + WS_X1) + (size_t)MP * D, MOD, 5120, A.out}; \
        pg8::gemm_phase<EpiResGate, pg8::StaticOrder, true, true>(lds, g, S, E); }
#define RUNPH(k) do { if (IN(k)) { PH##k(0) if constexpr (((REP_MASK) >> (k)) & 1) { xcd_barrier(bar); PH##k(1) } } } while (0)
    RUNPH(0); SEAM(0);
    RUNPH(1); SEAM(1);
    RUNPH(2); SEAM(2);
    RUNPH(3); SEAM(3);
    RUNPH(4); SEAM(4);
    RUNPH(5); SEAM(5);
    RUNPH(6);
    if constexpr (((REP_MASK) >> 13) & 1) { xcd_barrier(bar); PH6X(2, true, false, false) }
    if constexpr (((REP_MASK) >> 14) & 1) { xcd_barrier(bar); PH6X(3, false, true, false) }
    if constexpr (((REP_MASK) >> 15) & 1) { xcd_barrier(bar); PH6X(4, false, false, true) }
    SEAM(6);
    RUNPH(7); SEAM(7);
    RUNPH(8); SEAM(8);
    RUNPH(9); SEAM(9);
    RUNPH(10); SEAM(10);
    RUNPH(11); SEAM(11);
    RUNPH(12);
#undef IN
#undef SEAM
}

#ifndef N_LAUNCHES
#define N_LAUNCHES 1
#endif
extern "C" void kernel_launch(void* const* d_in, const int* in_sizes, int n_in, void* d_out, int out_size, void* d_ws, size_t ws_size, hipStream_t stream) {
    static int grid = 0;
    if (grid == 0) {
        if (n_in != 27 || (size_t)out_size != O_END || ws_size < WS_END) { fprintf(stderr, "kernel_launch: unexpected shapes: n_in %d out %d ws %zu\n", n_in, out_size, ws_size); grid = -1; return; }
        int dev = 0, cus = 0, per_cu = 0;
        if (hipGetDevice(&dev) != hipSuccess || hipDeviceGetAttribute(&cus, hipDeviceAttributeMultiprocessorCount, dev) != hipSuccess) { grid = -1; return; }
        if (hipFuncSetAttribute((const void*)fwd_kernel, hipFuncAttributeMaxDynamicSharedMemorySize, LDS_BYTES) != hipSuccess) { fprintf(stderr, "kernel_launch: hipFuncSetAttribute failed\n"); grid = -1; return; }
        if (hipOccupancyMaxActiveBlocksPerMultiprocessor(&per_cu, (const void*)fwd_kernel, 512, LDS_BYTES) != hipSuccess || per_cu < 1) fprintf(stderr, "kernel_launch: occupancy query says %d\n", per_cu);
        (void)hipGetLastError();
        grid = cus;
    }
    if (grid < 0) return;
    (void)hipMemsetAsync((char*)d_ws + WS_CTL, 0, CTL_ZERO_BYTES, stream);
    Args a{};
    for (int i = 0; i < 27; ++i) a.in[i] = d_in[i];
    a.out = (float*)d_out; a.ws = (unsigned char*)d_ws;
    if (N_LAUNCHES == 1) { a.lo = 0; a.hi = NPHASE; hipLaunchKernelGGL(fwd_kernel, dim3(grid), dim3(512), LDS_BYTES, stream, a); }
    else for (int p = 0; p < NPHASE; ++p) { a.lo = p; a.hi = p + 1; hipLaunchKernelGGL(fwd_kernel, dim3(grid), dim3(512), LDS_BYTES, stream, a); }
}
```

```cpp
#include <hip/hip_runtime.h>
#include <cstdio>
#include <cstdint>
#define REP_MASK 0
namespace pg8 {
#define PG8_LAS __attribute__((address_space(3)))
typedef unsigned short bf16_t;
typedef short bf16x8 __attribute__((ext_vector_type(8)));
typedef float f32x4 __attribute__((ext_vector_type(4)));
typedef unsigned u32x4 __attribute__((ext_vector_type(4)));
constexpr int BM = 256, BK = 64, HALF = 128, HTB = HALF * BK * 2  , STAGE_BYTES = 8 * HTB, NXCD = 8, WGM = 8;

__host__ __device__ __forceinline__ int lds_byte(int r, int c) { const int st = (r >> 4) * 2 + (c >> 5), rr = r & 15, cc = c & 31, ob = rr * 64 + cc * 2; return st * 1024 + (ob ^ (((ob >> 9) & 1) << 5)); }
__host__ __device__ __forceinline__ void stage_rc(int b, int& R, int& C) { const int st = b / 1024, sb = b % 1024, swz = sb ^ (((sb >> 9) & 1) << 5); R = (st >> 1) * 16 + swz / 64; C = (st & 1) * 32 + (swz % 64) / 2; }
__host__ __device__ __forceinline__ int perm32(int rho) { const int n = rho >> 4, i = rho & 15; return 8 * (i >> 2) + 4 * n + (i & 3); }

struct Unit { int pm, pn; };
struct Gemm { const bf16_t* A; const bf16_t* Bt; int M, N, K; };

struct StaticOrder {
    int nM, nN, nwg, G, c;
    __host__ __device__ void init(int M, int N, int G_, int c_) { nM = M / BM; nN = N / BM; nwg = nM * nN; G = G_; c = c_; }
    __host__ __device__ bool next(int i, Unit& u) const {
        const long L = (long)i * G + c; if (L >= nwg) return false;
        int wgid = (int)L; { const int q = nwg / NXCD, r = nwg % NXCD, xcd = wgid % NXCD, off = wgid / NXCD; wgid = (xcd < r ? xcd * (q + 1) : r * (q + 1) + (xcd - r) * q) + off; }
        const int nig = WGM * nN, gid = wgid / nig, fm = gid * WGM, gsz = (nM - fm) < WGM ? (nM - fm) : WGM;
        u.pm = fm + ((wgid % nig) % gsz); u.pn = (wgid % nig) / gsz; return true;
    }
    __device__ __forceinline__ void a_ready(const Unit&) const {}
    __device__ __forceinline__ void done(const Unit&) const {}
};

__device__ __forceinline__ unsigned cvt_pk_bf16(float lo, float hi) { unsigned r; asm volatile("v_cvt_pk_bf16_f32 %0, %1, %2" : "=v"(r) : "v"(lo), "v"(hi)); return r; }
typedef float f32x2 __attribute__((ext_vector_type(2)));
__device__ __forceinline__ f32x2 gelu_pk(f32x2 v) {
    const f32x2 av = __builtin_elementwise_abs(v), d = av * 0.2316418882f + 1.0f;
    f32x2 t; t.x = __builtin_amdgcn_rcpf(d.x); t.y = __builtin_amdgcn_rcpf(d.y);
    f32x2 q = t * 0.5307027145f + (-0.7265760135f); q = q * t + 0.7107068705f; q = q * t + (-0.142248368f); q = q * t + 0.127414796f; q = q * t;
    const f32x2 s = (v * v) * (-0.72134752044f);
    f32x2 e; e.x = __builtin_amdgcn_exp2f(s.x); e.y = __builtin_amdgcn_exp2f(s.y);
    const f32x2 m = v * (q * e), r = v - m;
    f32x2 o; o.x = v.x < 0.f ? m.x : r.x; o.y = v.y < 0.f ? m.y : r.y; return o;
}

template <int ACT  > struct EpiBf16 {
    static constexpr bool PERM = true, AFTER_DRAIN = false; static_assert(ACT == 0 || ACT == 1, "EpiBf16: ACT is 0 (none) or 1 (gelu_pk)");
    bf16_t* O; int ldc; const float* bias; int split_cols; size_t split_stride; float scale0;
    __device__ __forceinline__ void operator()(const f32x4 (&acc)[2][2][4][2], const Unit& u, int wr, int wc, int fr, int fq) const {
        const int row0 = u.pm * BM + wr * 64 + fr; int colt = u.pn * BM; bf16_t* base = O;
        float sc = 1.f; if (split_cols) { const int t = colt / split_cols; base += (size_t)t * split_stride; colt -= t * split_cols; if (t == 0) sc = scale0; }
        const int col0 = colt + wc * 32 + 8 * fq, bcol0 = u.pn * BM + wc * 32 + 8 * fq;
        f32x4 bv[2][2];
#pragma unroll
        for (int bj = 0; bj < 2; ++bj)
#pragma unroll
            for (int n = 0; n < 2; ++n) bv[bj][n] = bias ? *(const f32x4*)(bias + bcol0 + bj * HALF + 4 * n) : (f32x4){0.f, 0.f, 0.f, 0.f};
#pragma unroll
        for (int ai = 0; ai < 2; ++ai)
#pragma unroll
            for (int m = 0; m < 4; ++m) { bf16_t* rowp = base + (size_t)(row0 + ai * HALF + m * 16) * ldc + col0;
#pragma unroll
                for (int bj = 0; bj < 2; ++bj) { f32x4 v0 = acc[ai][bj][m][0] + bv[bj][0], v1 = acc[ai][bj][m][1] + bv[bj][1];
                    if (ACT == 1) { f32x2 a = gelu_pk((f32x2){v0[0], v0[1]}), b = gelu_pk((f32x2){v0[2], v0[3]}), c = gelu_pk((f32x2){v1[0], v1[1]}), d = gelu_pk((f32x2){v1[2], v1[3]});
                        v0 = (f32x4){a.x, a.y, b.x, b.y}; v1 = (f32x4){c.x, c.y, d.x, d.y}; }
                    v0 = v0 * sc; v1 = v1 * sc; u32x4 w; w.x = cvt_pk_bf16(v0[0], v0[1]); w.y = cvt_pk_bf16(v0[2], v0[3]); w.z = cvt_pk_bf16(v1[0], v1[1]); w.w = cvt_pk_bf16(v1[2], v1[3]);
                    *(u32x4*)(rowp + bj * HALF) = w; } }
    }
};

struct PanelStats {
    unsigned* xbuf;
    unsigned* cnt;
    unsigned* tmo;
    int ntn; float eps;
    unsigned code;
    __device__ __forceinline__ bool run(const f32x4 (&v)[2][2][4][2], const Unit& u, int wr, int wc, int fr, int fq, PG8_LAS unsigned char* lds, int wid, int lane) const {
        typedef float f32x2v __attribute__((ext_vector_type(2)));
        PG8_LAS f32x2v* P = (PG8_LAS f32x2v*)lds;
        PG8_LAS f32x2v* S = (PG8_LAS f32x2v*)(lds + 8192);
        PG8_LAS unsigned* flag = (PG8_LAS unsigned*)(lds + 8192 + 2048);
#pragma unroll
        for (int ai = 0; ai < 2; ++ai)
#pragma unroll
            for (int m = 0; m < 4; ++m) {
                float s = 0.f;
#pragma unroll
                for (int bj = 0; bj < 2; ++bj)
#pragma unroll
                    for (int n = 0; n < 2; ++n) { const f32x4 x = v[ai][bj][m][n]; s += (x[0] + x[1]) + (x[2] + x[3]); }
                s += __shfl_xor(s, 16); s += __shfl_xor(s, 32);
                const float mw = s * (1.0f / 64.0f); float q = 0.f;
#pragma unroll
                for (int bj = 0; bj < 2; ++bj)
#pragma unroll
                    for (int n = 0; n < 2; ++n) { const f32x4 d = v[ai][bj][m][n] - mw; q += (d[0] * d[0] + d[1] * d[1]) + (d[2] * d[2] + d[3] * d[3]); }
                q += __shfl_xor(q, 16); q += __shfl_xor(q, 32);
                if (fq == 0) P[(ai * HALF + wr * 64 + m * 16 + fr) * 4 + wc] = (f32x2v){mw, q};
            }
        asm volatile("s_waitcnt lgkmcnt(0)" ::: "memory"); __builtin_amdgcn_s_barrier(); asm volatile("" ::: "memory");
#if defined(BROKEN_EXCHANGE_NO_WAIT)
#warning BROKEN CONTROL BUILD: the row-statistics exchange does not wait; results are wrong by design
        if (blockIdx.x >= 64) { const long long t0_ = clock64(); while (clock64() - t0_ < 60000) __builtin_amdgcn_s_sleep(8); }
#endif
        const int row = wid * 32 + (lane & 31);
        if (lane < 32) {
            const f32x2v a = P[row * 4 + 0], b = P[row * 4 + 1], c = P[row * 4 + 2], d = P[row * 4 + 3];
            const float mt = (a.x + b.x + c.x + d.x) * 0.25f;
            const float da = a.x - mt, db = b.x - mt, dc = c.x - mt, dd = d.x - mt;
            const float m2 = (a.y + b.y) + (c.y + d.y) + 64.0f * ((da * da + db * db) + (dc * dc + dd * dd));
            unsigned long long* slot = (unsigned long long*)xbuf + ((size_t)(u.pm * BM + row) * 4 + u.pn);
            __hip_atomic_store(slot, ((unsigned long long)__float_as_uint(m2) << 32) | __float_as_uint(mt), __ATOMIC_RELAXED, __HIP_MEMORY_SCOPE_AGENT);
        }
        asm volatile("s_waitcnt vmcnt(0)" ::: "memory");
        if (lane == 0) __hip_atomic_fetch_add(cnt + 64 * u.pm, 1u, __ATOMIC_RELAXED, __HIP_MEMORY_SCOPE_AGENT);
        if (wid == 0) {
            bool dead = false; const unsigned long long t0 = __builtin_amdgcn_s_memrealtime(); const unsigned want = 8u * (unsigned)ntn;
            for (;;) {
#if defined(BROKEN_EXCHANGE_NO_WAIT)
                break;
#endif
                if ((unsigned)__builtin_amdgcn_readfirstlane(__hip_atomic_load(cnt + 64 * u.pm, __ATOMIC_RELAXED, __HIP_MEMORY_SCOPE_AGENT)) >= want) break;
                if (__builtin_amdgcn_s_memrealtime() - t0 > 2000000ull) {
                    if (lane == 0) { unsigned expect = 0u; __hip_atomic_compare_exchange_strong(tmo + 1, &expect, code | (unsigned)(u.pm & 0xff), __ATOMIC_RELAXED, __ATOMIC_RELAXED, __HIP_MEMORY_SCOPE_AGENT);
                                     __hip_atomic_store(tmo, 1u, __ATOMIC_RELAXED, __HIP_MEMORY_SCOPE_AGENT); }
                    dead = true; break; }
                __builtin_amdgcn_s_sleep(2);
            }
            __builtin_amdgcn_fence(__ATOMIC_ACQUIRE, "agent");
            if (lane == 0) flag[0] = dead ? 1u : 0u;
        }
        asm volatile("s_waitcnt vmcnt(0) lgkmcnt(0)" ::: "memory"); __builtin_amdgcn_s_barrier(); asm volatile("" ::: "memory");
        const bool bad = flag[0] != 0u;
        if (lane < 32) {
            const unsigned long long* slot = (const unsigned long long*)xbuf + (size_t)(u.pm * BM + row) * 4; float mt[4], m2[4]; float ms = 0.f;
#pragma unroll
            for (int t = 0; t < 4; ++t) { if (t < ntn) { const unsigned long long w = __hip_atomic_load(slot + t, __ATOMIC_RELAXED, __HIP_MEMORY_SCOPE_AGENT); mt[t] = __uint_as_float((unsigned)w); m2[t] = __uint_as_float((unsigned)(w >> 32)); } else { mt[t] = 0.f; m2[t] = 0.f; } ms += mt[t]; }
            const float mean = ms / (float)ntn; float q = 0.f;
#pragma unroll
            for (int t = 0; t < 4; ++t) if (t < ntn) { const float dm = mt[t] - mean; q += m2[t] + 256.0f * dm * dm; }
            S[row] = (f32x2v){mean, 1.0f / sqrtf(q / (256.0f * (float)ntn) + eps)};
        }
        asm volatile("s_waitcnt lgkmcnt(0)" ::: "memory"); __builtin_amdgcn_s_barrier(); asm volatile("" ::: "memory");
        return bad;
    }
};
struct EpiLnRes {
    static constexpr bool PERM = false, AFTER_DRAIN = true;
    const float* base; float* out; int ldc; const float* bias; PanelStats st; unsigned poison;
    __device__ __forceinline__ void fused(f32x4 (&acc)[2][2][4][2], const Unit& u, int wr, int wc, int fr, int fq, PG8_LAS unsigned char* lds, int wid, int lane) const {
        typedef float f32x2v __attribute__((ext_vector_type(2)));
        const PG8_LAS f32x2v* S = (const PG8_LAS f32x2v*)(lds + 8192);
        const int col0 = u.pn * BM + wc * 32 + 4 * fq;
#pragma unroll
        for (int bj = 0; bj < 2; ++bj)
#pragma unroll
            for (int n = 0; n < 2; ++n) { const f32x4 bv = bias ? *(const f32x4*)(bias + col0 + bj * HALF + n * 16) : (f32x4){0.f, 0.f, 0.f, 0.f};
#pragma unroll
                for (int ai = 0; ai < 2; ++ai)
#pragma unroll
                    for (int m = 0; m < 4; ++m) acc[ai][bj][m][n] += bv; }
        f32x4 pre[4][2][2];
#pragma unroll
        for (int m = 0; m < 4; ++m) { const size_t off = (size_t)(u.pm * BM + wr * 64 + m * 16 + fr) * ldc + col0;
#pragma unroll
            for (int bj = 0; bj < 2; ++bj)
#pragma unroll
                for (int n = 0; n < 2; ++n) pre[m][bj][n] = *(const f32x4*)(base + off + bj * HALF + n * 16); }
        const bool bad = st.run(acc, u, wr, wc, fr, fq, lds, wid, lane) || poison != 0u;
        const float qnan = __builtin_nanf("");
#pragma unroll
        for (int ai = 0; ai < 2; ++ai)
#pragma unroll
            for (int m = 0; m < 4; ++m) { const int r = ai * HALF + wr * 64 + m * 16 + fr; const f32x2v sr = S[r]; const size_t off = (size_t)(u.pm * BM + r) * ldc + col0;
#pragma unroll
                for (int bj = 0; bj < 2; ++bj)
#pragma unroll
                    for (int n = 0; n < 2; ++n) { const f32x4 bs = ai == 0 ? pre[m][bj][n] : *(const f32x4*)(base + off + bj * HALF + n * 16); f32x4 o = bs + (acc[ai][bj][m][n] - sr.x) * sr.y;
                        if (bad) o = (f32x4){qnan, qnan, qnan, qnan}; *(f32x4*)(out + off + bj * HALF + n * 16) = o; }
                if (m & 1) asm volatile("" ::: "memory"); }
    }
};
struct EpiLnResLn {
    static constexpr bool PERM = false, AFTER_DRAIN = true;
    const float* base; float* out; bf16_t* xn; int ldc; const float* bias; PanelStats st1, st2; unsigned poison;
    __device__ __forceinline__ void fused(f32x4 (&acc)[2][2][4][2], const Unit& u, int wr, int wc, int fr, int fq, PG8_LAS unsigned char* lds, int wid, int lane) const {
        typedef float f32x2v __attribute__((ext_vector_type(2))); typedef unsigned u32x2v __attribute__((ext_vector_type(2)));
        const PG8_LAS f32x2v* S = (const PG8_LAS f32x2v*)(lds + 8192);
        const int col0 = u.pn * BM + wc * 32 + 4 * fq;
#pragma unroll
        for (int bj = 0; bj < 2; ++bj)
#pragma unroll
            for (int n = 0; n < 2; ++n) { const f32x4 bv = bias ? *(const f32x4*)(bias + col0 + bj * HALF + n * 16) : (f32x4){0.f, 0.f, 0.f, 0.f};
#pragma unroll
                for (int ai = 0; ai < 2; ++ai)
#pragma unroll
                    for (int m = 0; m < 4; ++m) acc[ai][bj][m][n] += bv; }
        bool bad = st1.run(acc, u, wr, wc, fr, fq, lds, wid, lane) || poison != 0u;
        const float qnan = __builtin_nanf("");
#pragma unroll
        for (int ai = 0; ai < 2; ++ai)
#pragma unroll
            for (int m = 0; m < 4; ++m) { const int r = ai * HALF + wr * 64 + m * 16 + fr; const f32x2v sr = S[r]; const size_t off = (size_t)(u.pm * BM + r) * ldc + col0;
#pragma unroll
                for (int bj = 0; bj < 2; ++bj)
#pragma unroll
                    for (int n = 0; n < 2; ++n) { const f32x4 bs = *(const f32x4*)(base + off + bj * HALF + n * 16); acc[ai][bj][m][n] = bs + (acc[ai][bj][m][n] - sr.x) * sr.y; }
                asm volatile("" : "+v"(acc[ai][0][m][0]), "+v"(acc[ai][0][m][1]), "+v"(acc[ai][1][m][0]), "+v"(acc[ai][1][m][1]));
                if (m & 1) asm volatile("" ::: "memory"); }
        const bool bad1 = bad;
        bad = st2.run(acc, u, wr, wc, fr, fq, lds, wid, lane) || bad;
#pragma unroll
        for (int ai = 0; ai < 2; ++ai)
#pragma unroll
            for (int m = 0; m < 4; ++m) { const int r = ai * HALF + wr * 64 + m * 16 + fr; const f32x2v sr = S[r]; const size_t off = (size_t)(u.pm * BM + r) * ldc + col0;
#pragma unroll
                for (int bj = 0; bj < 2; ++bj)
#pragma unroll
                    for (int n = 0; n < 2; ++n) { const f32x4 x1 = acc[ai][bj][m][n]; *(f32x4*)(out + off + bj * HALF + n * 16) = bad1 ? (f32x4){qnan, qnan, qnan, qnan} : x1;
                        const f32x4 o = (x1 - sr.x) * sr.y; u32x2v w; w.x = cvt_pk_bf16(o[0], o[1]); w.y = cvt_pk_bf16(o[2], o[3]);
                        if (bad) { w.x = 0x7fc07fc0u; w.y = 0x7fc07fc0u; } *(u32x2v*)(xn + off + bj * HALF + n * 16) = w; }
                asm volatile("" ::: "memory"); }
    }
};

template <class Epi, class Sched, bool ALIGN_EPI = false, bool SP2 = false>
__device__ __forceinline__ void gemm_phase(PG8_LAS unsigned char* lds, const Gemm g, const Sched& S, const Epi& E) {
    const int tid = threadIdx.x, wid = __builtin_amdgcn_readfirstlane(tid >> 6), lane = tid & 63, wr = wid >> 2, wc = wid & 3, fr = lane & 15, fq = lane >> 4;
    const int K = g.K, nt = K / BK;
    unsigned voffA[2], voffB[2];
#pragma unroll
    for (int i = 0; i < 2; ++i) { int R, C; stage_rc(tid * 16 + i * 8192, R, C); const int Rb = Epi::PERM ? ((R & ~31) + perm32(R & 31)) : R;
        voffA[i] = (unsigned)(R * K + C) * 2u; voffB[i] = (unsigned)(Rb * K + C) * 2u; }
    const size_t kstep = (size_t)(BK * 2);
    const size_t hstep = (size_t)HALF * K * 2;
    const size_t tstep = 2 * hstep;
    const unsigned ldsw = (unsigned)wid * 1024u;
    const int aoff = lds_byte(wr * 64 + fr, fq * 8), boff = lds_byte(wc * 32 + fr, fq * 8);
#define PG8_SA(b, h) (((b) * 2 + (h)) * HTB)
#define PG8_SB(b, h) ((4 + (b) * 2 + (h)) * HTB)
#define PG8_STAGE(bufoff, gbase, voff) do { _Pragma("unroll") for (int _i = 0; _i < 2; ++_i) \
        __builtin_amdgcn_global_load_lds((const unsigned*)((const char*)(gbase) + (voff)[_i]), (PG8_LAS unsigned*)(lds + (bufoff) + ldsw + _i * 8192), 16, 0, 0); } while (0)
#define PG8_LDA(dst, b, h) do { _Pragma("unroll") for (int m = 0; m < 4; ++m) _Pragma("unroll") for (int k = 0; k < 2; ++k) dst[m][k] = *(const PG8_LAS bf16x8*)(lds + PG8_SA(b, h) + aoff + m * 2048 + k * 1024); } while (0)
#define PG8_LDB(dst, b, h) do { _Pragma("unroll") for (int n = 0; n < 2; ++n) _Pragma("unroll") for (int k = 0; k < 2; ++k) dst[n][k] = *(const PG8_LAS bf16x8*)(lds + PG8_SB(b, h) + boff + n * 2048 + k * 1024); } while (0)
#define PG8_MMA(ai, bj, At, Bt) do { __builtin_amdgcn_s_setprio(1); _Pragma("unroll") for (int m = 0; m < 4; ++m) _Pragma("unroll") for (int n = 0; n < 2; ++n) _Pragma("unroll") for (int k = 0; k < 2; ++k) \
        acc[ai][bj][m][n] = __builtin_amdgcn_mfma_f32_16x16x32_bf16(Bt[n][k], At[m][k], acc[ai][bj][m][n], 0, 0, 0); __builtin_amdgcn_s_setprio(0); } while (0)
#define PG8_WAIT_V(n) asm volatile("s_waitcnt vmcnt(" #n ")" ::: "memory")
#define PG8_WAIT_L(n) asm volatile("s_waitcnt lgkmcnt(" #n ")" ::: "memory")
#define PG8_BAR __builtin_amdgcn_s_barrier()
#define PG8_SCHED __builtin_amdgcn_sched_barrier(0)
    Unit cur, nxt; int ui = 0;
    if (!S.next(0, cur)) return;
    f32x4 acc[2][2][4][2];
#pragma unroll
    for (int a = 0; a < 2; ++a)
#pragma unroll
        for (int b = 0; b < 2; ++b)
#pragma unroll
            for (int m = 0; m < 4; ++m)
#pragma unroll
                for (int n = 0; n < 2; ++n) acc[a][b][m][n] = (f32x4){0.f, 0.f, 0.f, 0.f};
    bf16x8 At[4][2], B0[2][2], B1[2][2];
    const char* cA = (const char*)g.A + (size_t)cur.pm * tstep; const char* cB = (const char*)g.Bt + (size_t)cur.pn * tstep;
    S.a_ready(cur);
    if constexpr (SP2) {
        PG8_STAGE(PG8_SB(0, 0), cB, voffB); PG8_STAGE(PG8_SB(0, 1), cB + hstep, voffB); PG8_STAGE(PG8_SA(0, 0), cA, voffA); PG8_STAGE(PG8_SA(0, 1), cA + hstep, voffA);
        if (wr == 1) PG8_BAR;
        PG8_WAIT_V(2); PG8_BAR;
        PG8_STAGE(PG8_SB(1, 0), cB + kstep, voffB); PG8_STAGE(PG8_SA(1, 0), cA + kstep, voffA); PG8_STAGE(PG8_SB(1, 1), cB + hstep + kstep, voffB);
        PG8_WAIT_V(6); PG8_BAR;
    } else {
        PG8_STAGE(PG8_SB(0, 0), cB, voffB); PG8_STAGE(PG8_SA(0, 0), cA, voffA); PG8_STAGE(PG8_SB(0, 1), cB + hstep, voffB); PG8_STAGE(PG8_SA(0, 1), cA + hstep, voffA);
        if (wr == 1) PG8_BAR;
        PG8_WAIT_V(4); PG8_BAR;
        PG8_STAGE(PG8_SB(1, 0), cB + kstep, voffB); PG8_STAGE(PG8_SA(1, 0), cA + kstep, voffA); PG8_STAGE(PG8_SB(1, 1), cB + hstep + kstep, voffB);
        PG8_WAIT_V(6); PG8_BAR;
    }
    for (;;) {
        const bool has_next = S.next(ui + 1, nxt);
        const char* nA = has_next ? (const char*)g.A + (size_t)nxt.pm * tstep : cA; const char* nB = has_next ? (const char*)g.Bt + (size_t)nxt.pn * tstep : cB;
        for (int t = 0; t < nt; t += 2) {
            const bool last = (t == nt - 2);
            const char* a1 = cA + (size_t)(t + 1) * kstep;
            const char* a2 = last ? nA : cA + (size_t)(t + 2) * kstep; const char* b2 = last ? nB : cB + (size_t)(t + 2) * kstep;
            const char* a3 = a2 + kstep; const char* b3 = b2 + kstep;
            if (last && has_next) S.a_ready(nxt);
            if constexpr (SP2) {
            PG8_LDB(B0, 0, 0); PG8_LDB(B1, 0, 1); PG8_SCHED; PG8_LDA(At, 0, 0); PG8_STAGE(PG8_SA(1, 1), a1 + hstep, voffA);
            PG8_WAIT_V(8); PG8_WAIT_L(0); PG8_BAR; PG8_MMA(0, 0, At, B0); PG8_MMA(0, 1, At, B1); PG8_BAR; PG8_SCHED;
            PG8_LDA(At, 0, 1); PG8_STAGE(PG8_SB(0, 0), b2, voffB); PG8_STAGE(PG8_SB(0, 1), b2 + hstep, voffB); PG8_STAGE(PG8_SA(0, 0), a2, voffA);
            PG8_WAIT_V(8); PG8_WAIT_L(0); PG8_BAR; PG8_MMA(1, 0, At, B0); PG8_MMA(1, 1, At, B1); PG8_BAR; PG8_SCHED;
            PG8_LDB(B0, 1, 0); PG8_LDB(B1, 1, 1); PG8_SCHED; PG8_LDA(At, 1, 0); PG8_STAGE(PG8_SA(0, 1), a2 + hstep, voffA);
            PG8_WAIT_V(8); PG8_WAIT_L(0); PG8_BAR; PG8_MMA(0, 0, At, B0); PG8_MMA(0, 1, At, B1); PG8_BAR; PG8_SCHED;
            PG8_LDA(At, 1, 1); PG8_STAGE(PG8_SB(1, 0), b3, voffB); PG8_STAGE(PG8_SB(1, 1), b3 + hstep, voffB); PG8_STAGE(PG8_SA(1, 0), a3, voffA);
            PG8_WAIT_V(8); PG8_WAIT_L(0); PG8_BAR; PG8_MMA(1, 0, At, B0); PG8_MMA(1, 1, At, B1); PG8_BAR; PG8_SCHED;
            } else {
            PG8_LDB(B0, 0, 0); PG8_SCHED; PG8_LDA(At, 0, 0); PG8_STAGE(PG8_SA(1, 1), a1 + hstep, voffA);
            PG8_WAIT_L(8); PG8_BAR; PG8_WAIT_L(0); PG8_MMA(0, 0, At, B0); PG8_BAR; PG8_SCHED;
            PG8_LDB(B1, 0, 1); PG8_STAGE(PG8_SB(0, 0), b2, voffB);
            PG8_BAR; PG8_WAIT_L(0); PG8_MMA(0, 1, At, B1); PG8_BAR;
            PG8_LDA(At, 0, 1); PG8_STAGE(PG8_SA(0, 0), a2, voffA);
            PG8_BAR; PG8_WAIT_L(0); PG8_MMA(1, 0, At, B0); PG8_BAR; PG8_SCHED;
            PG8_STAGE(PG8_SB(0, 1), b2 + hstep, voffB);
            PG8_WAIT_V(6); PG8_BAR; PG8_MMA(1, 1, At, B1); PG8_BAR;
            PG8_LDB(B0, 1, 0); PG8_SCHED; PG8_LDA(At, 1, 0); PG8_STAGE(PG8_SA(0, 1), a2 + hstep, voffA);
            PG8_WAIT_L(8); PG8_BAR; PG8_WAIT_L(0); PG8_MMA(0, 0, At, B0); PG8_BAR; PG8_SCHED;
            PG8_LDB(B1, 1, 1); PG8_STAGE(PG8_SB(1, 0), b3, voffB);
            PG8_BAR; PG8_WAIT_L(0); PG8_MMA(0, 1, At, B1); PG8_BAR;
            PG8_LDA(At, 1, 1); PG8_STAGE(PG8_SA(1, 0), a3, voffA);
            PG8_BAR; PG8_WAIT_L(0); PG8_MMA(1, 0, At, B0); PG8_BAR; PG8_SCHED;
            PG8_STAGE(PG8_SB(1, 1), b3 + hstep, voffB);
            PG8_WAIT_V(6); PG8_BAR; PG8_MMA(1, 1, At, B1); PG8_BAR;
            }
        }
        if constexpr (ALIGN_EPI) { if (wr == 0) PG8_BAR; }
        if constexpr (!Epi::AFTER_DRAIN) { E(acc, cur, wr, wc, fr, fq); S.done(cur); }
        if (!has_next) break;
#pragma unroll
        for (int a = 0; a < 2; ++a)
#pragma unroll
            for (int b = 0; b < 2; ++b)
#pragma unroll
                for (int m = 0; m < 4; ++m)
#pragma unroll
                    for (int n = 0; n < 2; ++n) acc[a][b][m][n] = (f32x4){0.f, 0.f, 0.f, 0.f};
        cur = nxt; cA = nA; cB = nB; ++ui;
        if constexpr (ALIGN_EPI) { if (wr == 1) PG8_BAR; }
    }
    PG8_WAIT_V(0);
    if constexpr (!ALIGN_EPI) { if (wr == 0) PG8_BAR; }
    PG8_BAR;
    if constexpr (Epi::AFTER_DRAIN) { E.fused(acc, cur, wr, wc, fr, fq, lds, wid, lane); S.done(cur); }
#undef PG8_SA
#undef PG8_SB
#undef PG8_STAGE
#undef PG8_LDA
#undef PG8_LDB
#undef PG8_MMA
#undef PG8_WAIT_V
#undef PG8_WAIT_L
#undef PG8_BAR
#undef PG8_SCHED
}
}

#define GAS __attribute__((address_space(1)))
#define LAS __attribute__((address_space(3)))
typedef unsigned short bf16;
typedef float f32x4 __attribute__((ext_vector_type(4)));
typedef float f32x16 __attribute__((ext_vector_type(16)));
typedef short bf16x8 __attribute__((ext_vector_type(8)));
typedef short s16x4 __attribute__((ext_vector_type(4)));
typedef unsigned u32x4 __attribute__((ext_vector_type(4)));
typedef unsigned u32x2 __attribute__((ext_vector_type(2)));
typedef float f32x2_t __attribute__((ext_vector_type(2)));
typedef __bf16 bf16x2_t __attribute__((ext_vector_type(2)));
typedef GAS unsigned gu32;
#define RLX_AGENT __ATOMIC_RELAXED, __HIP_MEMORY_SCOPE_AGENT

constexpr int D = 1024, BP = 4, TP = 4096, MP = BP * TP, BS = 128, TS = 8, MS = BS * TS, M = MP + MS;
constexpr int SBH = 8, HD = 64, SBW = 512, DNH = 4, DND = 128, DNW = 512;
constexpr int IN_COLS = 3592, NPROJ = 3584;
constexpr int DFF = 2816, DFF2 = 5632, NMOD = 6144, NC = BP + BS;
constexpr int PAST = 2048, NPAGES = 16, PAGE = 128;
constexpr float EPS = 1e-6f, LOG2E = 1.4426950408889634f;
constexpr float QSCALE = 0.125f * LOG2E;
constexpr int NSPLIT = 4, NPART = 5;

constexpr size_t O_YP = 0, O_KP = 17825792, O_VP = 26214400, O_KS = 34603008, O_VS = 35127296, O_SP = 35651584, O_SS = 35913728,
                 O_DCP = 44302336, O_DCS = 44320768, O_FCP = 44910592, O_FCS = 44955648, O_END = 46397440;

constexpr size_t MiB = 1u << 20;
constexpr size_t WS_CTL = 0, CTL_ZERO_BYTES = MiB;
constexpr size_t WS_MOD = 1 * MiB, WS_SC = 5 * MiB, WS_WINX = 6 * MiB, WS_WIN_T = 7 * MiB, WS_WOUT_T = 14 * MiB, WS_WUP_T = 16 * MiB, WS_WDN_T = 27 * MiB,
                 WS_EXTRA = 33 * MiB, WS_H = 34 * MiB, WS_PROJ = 68 * MiB, WS_QB = 306 * MiB, WS_KB = 323 * MiB, WS_VT = 340 * MiB, WS_QD = 357 * MiB, WS_KD = 391 * MiB,
                 WS_VD = 425 * MiB, WS_BETA = 459 * MiB, WS_LOGA = 460 * MiB, WS_ODN = 461 * MiB, WS_MIXED = 495 * MiB, WS_X1 = 529 * MiB, WS_UP = 597 * MiB,
                 WS_ACT = 784 * MiB, WS_U = 878 * MiB, WS_KCUM = 910 * MiB, WS_QDEC = 926 * MiB, WS_KDECT = 942 * MiB, WS_INTRA = 958 * MiB, WS_GL = 966 * MiB,
                 WS_OPART = 967 * MiB, WS_LPART = 978 * MiB, WS_END = 979 * MiB;
constexpr int CW_QUEUE = 64;
constexpr int CW_BAR = 4096;

constexpr int RING_BYTES = 131072, MISC_OFF = RING_BYTES + 320, LDS_BYTES = 147456;

__device__ __forceinline__ unsigned cvtpk(float lo, float hi) { f32x2_t v = {lo, hi}; bf16x2_t b = __builtin_convertvector(v, bf16x2_t); return __builtin_bit_cast(unsigned, b); }
__device__ __forceinline__ bf16 f2bf(float f) { return (bf16)(cvtpk(f, 0.f) & 0xffffu); }
__device__ __forceinline__ float wave_sum(float v) {
#pragma unroll
    for (int o = 1; o < 64; o <<= 1) v += __shfl_xor(v, o);
    return v;
}
__device__ __forceinline__ float siluf(float x) { return x / (1.f + __expf(-x)); }
__device__ __forceinline__ u32x4 pack8(const f32x4 a, const f32x4 b) { u32x4 w; w.x = cvtpk(a.x, a.y); w.y = cvtpk(a.z, a.w); w.z = cvtpk(b.x, b.y); w.w = cvtpk(b.z, b.w); return w; }
__device__ __forceinline__ float bf2f(unsigned short h) { return __uint_as_float((unsigned)h << 16); }

#define XB_TMO      128
#define XB_XCNT(j)  (256  + 64 * (j))
#define XB_XSUB(j)  (1280 + 64 * (j))
#define XB_XGEN(j)  (2304 + 64 * (j))
#define XB_TOP      3328
#define XB_TOPGEN   3392
#define XCD_BAR_WORDS 3456
#define XB_SPIN_CAP (1u << 18)
__device__ __forceinline__ unsigned xb_ld(unsigned* p)              { return __hip_atomic_load(p, __ATOMIC_RELAXED, __HIP_MEMORY_SCOPE_AGENT); }
__device__ __forceinline__ unsigned xb_add(unsigned* p, unsigned v) { return __hip_atomic_fetch_add(p, v, __ATOMIC_RELAXED, __HIP_MEMORY_SCOPE_AGENT); }
__device__ __forceinline__ unsigned xb_xcc_id() { return (unsigned)__builtin_amdgcn_s_getreg((3 << 11) | 20) & 0xFu; }
#define XB_SPIN(cond, bar) do { unsigned _sp = 0; while (cond) { __builtin_amdgcn_s_sleep(1); \
    if ((++_sp & 255u) == 0u) { if (xb_ld(&(bar)[XB_TMO])) break; if (_sp > XB_SPIN_CAP) { atomicAdd(&(bar)[XB_TMO], 1u); break; } } } } while (0)
struct XcdBarrier { unsigned* bar; unsigned x; volatile LAS unsigned* st; };
__device__ __forceinline__ XcdBarrier xcd_barrier_post(unsigned* bar, volatile LAS unsigned* st) {
    XcdBarrier b; b.bar = bar; b.x = xb_xcc_id(); b.st = st;
    if (threadIdx.x == 0) (void)xb_add(&bar[XB_XCNT(b.x)], 1u);
    return b;
}
__device__ __forceinline__ void xcd_barrier_complete(unsigned* bar, unsigned x, unsigned& nloc, unsigned& nx) {
    const unsigned G = gridDim.x * gridDim.y * gridDim.z;
    unsigned sum, cnt, mine, sp = 0u;
    for (;;) {
        sum = 0u; cnt = 0u; mine = 0u;
#pragma unroll
        for (unsigned j = 0; j < 16; ++j) { const unsigned c = xb_ld(&bar[XB_XCNT(j)]); sum += c; cnt += (c > 0u) ? 1u : 0u; mine = (j == x) ? c : mine; }
        if (sum == G) break;
        __builtin_amdgcn_s_sleep(1);
        if ((++sp & 255u) == 0u) { if (xb_ld(&bar[XB_TMO])) break; if (sp > XB_SPIN_CAP) { atomicAdd(&bar[XB_TMO], 1u); break; } }
    }
    nloc = mine > 0u ? mine : 1u; nx = cnt > 0u ? cnt : 1u;
}
__device__ __forceinline__ void xcd_barrier(const XcdBarrier& b) {
    asm volatile("s_waitcnt vmcnt(0)" ::: "memory");
    __syncthreads();
    if (threadIdx.x == 0) {
        unsigned* bar = b.bar;
        __builtin_amdgcn_s_waitcnt(0);
        unsigned nloc = b.st[0], nx = b.st[1];
        if (nloc == 0u) { xcd_barrier_complete(bar, b.x, nloc, nx); b.st[0] = nloc; b.st[1] = nx; }
        const unsigned old = xb_add(&bar[XB_XSUB(b.x)], 1u);
        const unsigned gen = old / nloc;
        if (old + 1u == (gen + 1u) * nloc) {
            __builtin_amdgcn_fence(__ATOMIC_RELEASE, "agent");
            asm volatile("s_waitcnt vmcnt(0)" ::: "memory");
            const unsigned og = xb_add(&bar[XB_TOP], 1u);
            const unsigned tg = og / nx;
            if (og + 1u == (tg + 1u) * nx) xb_add(&bar[XB_TOPGEN], 1u);
            else XB_SPIN(xb_ld(&bar[XB_TOPGEN]) == tg, bar);
            __builtin_amdgcn_fence(__ATOMIC_ACQUIRE, "agent");
            xb_add(&bar[XB_XGEN(b.x)], 1u);
            asm volatile("s_waitcnt vmcnt(0)" ::: "memory");
        } else {
            XB_SPIN(xb_ld(&bar[XB_XGEN(b.x)]) == gen, bar);
            __builtin_amdgcn_fence(__ATOMIC_ACQUIRE, "agent");
            asm volatile("s_waitcnt vmcnt(0)" ::: "memory");
        }
    }
    __syncthreads();
}

struct Args { const void* in[27]; float* out; unsigned char* ws; int lo, hi; };
enum { I_XP = 0, I_XS, I_CP, I_CS, I_CK, I_CV, I_PT, I_SD, I_SDC, I_SFC, I_WADA, I_BADA, I_GATT, I_WIN, I_GQ, I_GK, I_SBB, I_GSBO, I_WDNC, I_ALOG, I_DTB, I_GDNO, I_WOUT, I_GFFN, I_WUP, I_WFC, I_WDN };

__device__ __forceinline__ int mod_row(int m) { return m < MP ? (m >> 12) : BP + ((m - MP) >> 3); }

struct EpiF32 {
    static constexpr bool PERM = false, AFTER_DRAIN = false;
    float* O; int ldc;
    __device__ __forceinline__ void operator()(const pg8::f32x4 (&acc)[2][2][4][2], const pg8::Unit& u, int wr, int wc, int fr, int fq) const {
        const int row0 = u.pm * 256 + wr * 64 + fr, col0 = u.pn * 256 + wc * 32 + 4 * fq;
#pragma unroll
        for (int ai = 0; ai < 2; ++ai)
#pragma unroll
            for (int m = 0; m < 4; ++m) { float* rowp = O + (size_t)(row0 + ai * 128 + m * 16) * ldc + col0;
#pragma unroll
                for (int bj = 0; bj < 2; ++bj)
#pragma unroll
                    for (int n = 0; n < 2; ++n) *(pg8::f32x4*)(rowp + bj * 128 + n * 16) = acc[ai][bj][m][n]; }
    }
};
struct EpiResGate {
    static constexpr bool PERM = false, AFTER_DRAIN = false;
    const float* base0; const float* base1; const float* mod; int goff; float* out;
    __device__ __forceinline__ void operator()(const pg8::f32x4 (&acc)[2][2][4][2], const pg8::Unit& u, int wr, int wc, int fr, int fq) const {
        const int row0 = u.pm * 256 + wr * 64 + fr, col0 = u.pn * 256 + wc * 32 + 4 * fq;
#pragma unroll
        for (int ai = 0; ai < 2; ++ai)
#pragma unroll
            for (int m = 0; m < 4; ++m) { const int r = row0 + ai * 128 + m * 16;
                const float* bp = (r < MP ? base0 + (size_t)r * D : base1 + (size_t)(r - MP) * D) + col0;
                const float* gp = mod + (size_t)mod_row(r) * NMOD + goff + col0; float* op = out + (size_t)r * D + col0;
#pragma unroll
                for (int bj = 0; bj < 2; ++bj)
#pragma unroll
                    for (int n = 0; n < 2; ++n) { const pg8::f32x4 b = *(const pg8::f32x4*)(bp + bj * 128 + n * 16), g = *(const pg8::f32x4*)(gp + bj * 128 + n * 16);
                        *(pg8::f32x4*)(op + bj * 128 + n * 16) = b + g * acc[ai][bj][m][n]; } }
    }
};

__device__ __forceinline__ void transpose_item(const float* W, int ldw, int src_col0, bf16* WT, int Kdst, int dst_row0, int k0, LAS float* scr, int lane) {
#pragma unroll 8
    for (int i = 0; i < 32; ++i) { const int kk = 2 * i + (lane >> 5); scr[kk * 33 + (lane & 31)] = W[(size_t)(k0 + kk) * ldw + src_col0 + (lane & 31)]; }
    asm volatile("s_waitcnt lgkmcnt(0)" ::: "memory");
    const int c = lane & 7;
#pragma unroll
    for (int j = 0; j < 4; ++j) { const int n = (lane >> 3) + 8 * j; const LAS float* s = scr + (8 * c) * 33 + n;
        u32x4 o; o.x = cvtpk(s[0 * 33], s[1 * 33]); o.y = cvtpk(s[2 * 33], s[3 * 33]); o.z = cvtpk(s[4 * 33], s[5 * 33]); o.w = cvtpk(s[6 * 33], s[7 * 33]);
        *(u32x4*)(WT + (size_t)(dst_row0 + n) * Kdst + k0 + 8 * c) = o; }
    asm volatile("s_waitcnt lgkmcnt(0)" ::: "memory");
}
__device__ __forceinline__ void phase_prologue(const Args& A, LAS unsigned char* lds, int gw, int NGW, int wave, int lane, int gtid, int NGT) {
    unsigned char* ws = A.ws;
    LAS float* scr = (LAS float*)(lds + wave * 16384);
    const float* w_in = (const float*)A.in[I_WIN]; const float* w_out = (const float*)A.in[I_WOUT]; const float* w_up = (const float*)A.in[I_WUP]; const float* w_dn = (const float*)A.in[I_WDN];
    constexpr int I_IN = 16 * (NPROJ / 32), I_OUT = 16 * 32, I_UP = 16 * (DFF2 / 32), I_DN = (DFF / 64) * 32, NIT = I_IN + I_OUT + I_UP + I_DN;
    for (int it = gw; it < NIT; it += NGW) {
        int r = it;
        if (r < I_IN) { const int nb = r % (NPROJ / 32), kb = r / (NPROJ / 32); const int n0 = nb * 32; transpose_item(w_in, IN_COLS, n0 < 3072 ? n0 : n0 + 8, (bf16*)(ws + WS_WIN_T), D, n0, kb * 64, scr, lane); continue; } r -= I_IN;
        if (r < I_OUT) { const int nb = r % 32, kb = r / 32; transpose_item(w_out, D, nb * 32, (bf16*)(ws + WS_WOUT_T), D, nb * 32, kb * 64, scr, lane); continue; } r -= I_OUT;
        if (r < I_UP) { const int nb = r % (DFF2 / 32), kb = r / (DFF2 / 32); transpose_item(w_up, DFF2, nb * 32, (bf16*)(ws + WS_WUP_T), D, nb * 32, kb * 64, scr, lane); continue; } r -= I_UP;
        { const int nb = r % 32, kb = r / 32; transpose_item(w_dn, D, nb * 32, (bf16*)(ws + WS_WDN_T), DFF, nb * 32, kb * 64, scr, lane); }
    }
    bf16* SC = (bf16*)(ws + WS_SC); const float* cp = (const float*)A.in[I_CP]; const float* cs = (const float*)A.in[I_CS];
    for (int i = gtid; i < 144 * D; i += NGT) { const int r = i >> 10, k = i & 1023; float v = 0.f; if (r < BP) v = cp[r * D + k]; else if (r < NC) v = cs[(r - BP) * D + k]; SC[i] = (r < NC) ? f2bf(siluf(v)) : (bf16)0; }
    float* WX = (float*)(ws + WS_WINX);
    for (int i = gtid; i < 8 * D; i += NGT) { const int j = i >> 10, k = i & 1023; WX[i] = w_in[(size_t)k * IN_COLS + 3072 + j]; }
}

__device__ __forceinline__ void phase_mod(const Args& A, int gw, int NGW, int lane) {
    const float* w_ada = (const float*)A.in[I_WADA]; const float* b_ada = (const float*)A.in[I_BADA];
    const bf16* SC = (const bf16*)(A.ws + WS_SC); float* MOD = (float*)(A.ws + WS_MOD);
    const int lr = lane & 15, q = lane >> 4;
    for (int it = gw; it < NMOD / 16; it += NGW) {
        const int col = it * 16 + lr;
        pg8::f32x4 acc[9];
#pragma unroll
        for (int i = 0; i < 9; ++i) acc[i] = (pg8::f32x4){0.f, 0.f, 0.f, 0.f};
#pragma unroll 2
        for (int s = 0; s < 32; ++s) {
            const float* wp = w_ada + (size_t)(32 * s + 8 * q) * NMOD + col;
            float w[8];
#pragma unroll
            for (int j = 0; j < 8; ++j) w[j] = wp[(size_t)j * NMOD];
            u32x4 bw; bw.x = cvtpk(w[0], w[1]); bw.y = cvtpk(w[2], w[3]); bw.z = cvtpk(w[4], w[5]); bw.w = cvtpk(w[6], w[7]);
            const bf16x8 bfr = __builtin_bit_cast(bf16x8, bw);
#pragma unroll
            for (int i = 0; i < 9; ++i) { const bf16x8 a = *(const bf16x8*)(SC + (size_t)(16 * i + lr) * D + 32 * s + 8 * q); acc[i] = __builtin_amdgcn_mfma_f32_16x16x32_bf16(a, bfr, acc[i], 0, 0, 0); }
        }
        const float bb = b_ada[col];
#pragma unroll
        for (int i = 0; i < 9; ++i)
#pragma unroll
            for (int r = 0; r < 4; ++r) { const int row = 16 * i + 4 * q + r; if (row < NC) MOD[(size_t)row * NMOD + col] = acc[i][r] + bb; }
    }
}

template <bool EXTRAS>
__device__ __forceinline__ void phase_norm(const float* x0, const float* x1, const float* g, const float* MOD, int sh_off, int sc_off, bf16* H, const float* WX, float* EXTRA, int gw, int NGW, int lane) {
    for (int m = gw; m < M; m += NGW) {
        const float* xr = m < MP ? x0 + (size_t)m * D : x1 + (size_t)(m - MP) * D;
        const float* mod = MOD + (size_t)mod_row(m) * NMOD;
        f32x4 v[4]; float ss = 0.f;
#pragma unroll
        for (int j = 0; j < 4; ++j) { v[j] = *(const f32x4*)(xr + 4 * (lane + 64 * j)); ss += (v[j].x * v[j].x + v[j].y * v[j].y) + (v[j].z * v[j].z + v[j].w * v[j].w); }
        ss = wave_sum(ss);
        const float rstd = 1.0f / sqrtf(ss * (1.f / D) + EPS);
        float ex[8];
#pragma unroll
        for (int e = 0; e < 8; ++e) ex[e] = 0.f;
#pragma unroll
        for (int j = 0; j < 4; ++j) { const int c = 4 * (lane + 64 * j);
            const f32x4 gg = *(const f32x4*)(g + c), sc = *(const f32x4*)(mod + sc_off + c), sh = *(const f32x4*)(mod + sh_off + c);
            const f32x4 h = (v[j] * rstd) * gg * (sc + 1.0f) + sh;
            u32x2 w; w.x = cvtpk(h.x, h.y); w.y = cvtpk(h.z, h.w); *(u32x2*)(H + (size_t)m * D + c) = w;
            if (EXTRAS) {
#pragma unroll
                for (int e = 0; e < 8; ++e) { const f32x4 wx = *(const f32x4*)(WX + e * D + c); ex[e] += (h.x * wx.x + h.y * wx.y) + (h.z * wx.z + h.w * wx.w); }
            }
        }
        if (EXTRAS) {
#pragma unroll
            for (int e = 0; e < 8; ++e) ex[e] = wave_sum(ex[e]);
            float mine = ex[0];
#pragma unroll
            for (int e = 1; e < 8; ++e) mine = (lane == e) ? ex[e] : mine;
            if (lane < 8) EXTRA[(size_t)m * 8 + lane] = mine;
        }
    }
}

__device__ __forceinline__ void phase_post(const Args& A, int gw, int NGW, int lane) {
    unsigned char* ws = A.ws; const float* PROJ = (const float*)(ws + WS_PROJ); float* out = A.out;
    const float* g_q = (const float*)A.in[I_GQ]; const float* g_k = (const float*)A.in[I_GK]; const float* wc = (const float*)A.in[I_WDNC];
    const float* sdc = (const float*)A.in[I_SDC]; const float* a_log = (const float*)A.in[I_ALOG]; const float* dtb = (const float*)A.in[I_DTB];
    bf16* QB = (bf16*)(ws + WS_QB); bf16* KB = (bf16*)(ws + WS_KB);
    float* QD = (float*)(ws + WS_QD); float* KD = (float*)(ws + WS_KD); float* VD = (float*)(ws + WS_VD);
    float* BETA = (float*)(ws + WS_BETA); float* LOGA = (float*)(ws + WS_LOGA); const float* EXTRA = (const float*)(ws + WS_EXTRA);
    const int c8 = 8 * lane;
    for (int m = gw; m < M; m += NGW) {
        const bool prompt = m < MP; const int b = prompt ? (m >> 12) : ((m - MP) >> 3), t = prompt ? (m & 4095) : ((m - MP) & 7);
        const float* pr = PROJ + (size_t)m * NPROJ;
        {
            f32x4 a0 = *(const f32x4*)(pr + c8), a1 = *(const f32x4*)(pr + c8 + 4);
            float ss = (a0.x * a0.x + a0.y * a0.y) + (a0.z * a0.z + a0.w * a0.w) + (a1.x * a1.x + a1.y * a1.y) + (a1.z * a1.z + a1.w * a1.w);
            ss += __shfl_xor(ss, 1); ss += __shfl_xor(ss, 2); ss += __shfl_xor(ss, 4);
            const float rs = QSCALE / sqrtf(ss * (1.f / HD) + EPS);
            const f32x4 g0 = *(const f32x4*)(g_q + (c8 & 63)), g1 = *(const f32x4*)(g_q + (c8 & 63) + 4);
            *(u32x4*)(QB + (size_t)m * SBW + c8) = pack8(a0 * rs * g0, a1 * rs * g1);
        }
        {
            f32x4 a0 = *(const f32x4*)(pr + 512 + c8), a1 = *(const f32x4*)(pr + 512 + c8 + 4);
            float ss = (a0.x * a0.x + a0.y * a0.y) + (a0.z * a0.z + a0.w * a0.w) + (a1.x * a1.x + a1.y * a1.y) + (a1.z * a1.z + a1.w * a1.w);
            ss += __shfl_xor(ss, 1); ss += __shfl_xor(ss, 2); ss += __shfl_xor(ss, 4);
            const float rs = 1.0f / sqrtf(ss * (1.f / HD) + EPS);
            const f32x4 g0 = *(const f32x4*)(g_k + (c8 & 63)), g1 = *(const f32x4*)(g_k + (c8 & 63) + 4);
            a0 = a0 * rs * g0; a1 = a1 * rs * g1;
            float* ko = prompt ? out + O_KP + (size_t)m * SBW + c8 : out + O_KS + (size_t)(m - MP) * SBW + c8;
            *(f32x4*)ko = a0; *(f32x4*)(ko + 4) = a1;
            *(u32x4*)(KB + (size_t)m * SBW + c8) = pack8(a0, a1);
        }
        {
            const f32x4 a0 = *(const f32x4*)(pr + 1024 + c8), a1 = *(const f32x4*)(pr + 1024 + c8 + 4);
            float* vo = prompt ? out + O_VP + (size_t)m * SBW + c8 : out + O_VS + (size_t)(m - MP) * SBW + c8;
            *(f32x4*)vo = a0; *(f32x4*)(vo + 4) = a1;
        }
#pragma unroll
        for (int part = 0; part < 3; ++part) {
            const int ch = part * 512 + c8;
            f32x4 y0 = (f32x4){0.f, 0.f, 0.f, 0.f}, y1 = y0;
#pragma unroll
            for (int i = 0; i < 4; ++i) {
                const int tt = t - 3 + i;
                f32x4 x0, x1;
                if (tt >= 0) { const float* p = pr - (size_t)(3 - i) * NPROJ + 1536 + ch; x0 = *(const f32x4*)p; x1 = *(const f32x4*)(p + 4); }
                else if (!prompt) { const float* p = sdc + ((size_t)b * 3 + (3 + tt)) * 1536 + ch; x0 = *(const f32x4*)p; x1 = *(const f32x4*)(p + 4); }
                else { x0 = (f32x4){0.f, 0.f, 0.f, 0.f}; x1 = x0; }
                const f32x4 w0 = *(const f32x4*)(wc + i * 1536 + ch), w1 = *(const f32x4*)(wc + i * 1536 + ch + 4);
                y0 += w0 * x0; y1 += w1 * x1;
                if (i == 3) {
                    const int idx = prompt ? t - (TP - 3) : t - (TS - 3);
                    if (idx >= 0) { float* o = prompt ? out + O_DCP + ((size_t)b * 3 + idx) * 1536 + ch : out + O_DCS + ((size_t)b * 3 + idx) * 1536 + ch; *(f32x4*)o = x0; *(f32x4*)(o + 4) = x1; }
                }
            }
            y0.x = siluf(y0.x); y0.y = siluf(y0.y); y0.z = siluf(y0.z); y0.w = siluf(y0.w); y1.x = siluf(y1.x); y1.y = siluf(y1.y); y1.z = siluf(y1.z); y1.w = siluf(y1.w);
            if (part < 2) {
                float ss = (y0.x * y0.x + y0.y * y0.y) + (y0.z * y0.z + y0.w * y0.w) + (y1.x * y1.x + y1.y * y1.y) + (y1.z * y1.z + y1.w * y1.w);
                ss += __shfl_xor(ss, 1); ss += __shfl_xor(ss, 2); ss += __shfl_xor(ss, 4); ss += __shfl_xor(ss, 8);
                const float rs = (part == 0 ? 0.08838834764831845f : 1.0f) / sqrtf(ss + EPS);
                y0 = y0 * rs; y1 = y1 * rs;
            }
            float* dst = (part == 0 ? QD : part == 1 ? KD : VD) + (size_t)m * DNW + c8;
            *(f32x4*)dst = y0; *(f32x4*)(dst + 4) = y1;
        }
        if (lane < 8) {
            const float x = EXTRA[(size_t)m * 8 + lane];
            if (lane < 4) BETA[(size_t)m * 4 + lane] = 1.f / (1.f + __expf(-x));
            else { const int h = lane - 4; const float z = x + dtb[h]; const float sp = fmaxf(z, 0.f) + log1pf(__expf(-fabsf(z))); LOGA[(size_t)m * 4 + h] = -__expf(a_log[h]) * sp; }
        }
    }
}

template <int I0, int I1> __device__ __forceinline__ void subst_rows(float (&x)[64], const LAS float* Am, const LAS float* gs, bool kpart) {
#pragma unroll
    for (int i = I0; i < I1; ++i) {
        float r = x[i];
#pragma unroll
        for (int j4 = 0; j4 < (i & ~3); j4 += 4) { const f32x4 a = *(const LAS f32x4*)(Am + i * 64 + j4); r -= a.x * x[j4]; r -= a.y * x[j4 + 1]; r -= a.z * x[j4 + 2]; r -= a.w * x[j4 + 3]; }
#pragma unroll
        for (int j = (i & ~3); j < i; ++j) r -= Am[i * 64 + j] * x[j];
        x[i] = r;
    }
}
__device__ __forceinline__ void dn_prescan_unit(const Args& A, LAS unsigned char* lds, int unit, int tid, int wave, int lane) {
    unsigned char* ws = A.ws;
    const float* QD = (const float*)(ws + WS_QD); const float* KD = (const float*)(ws + WS_KD); const float* VD = (const float*)(ws + WS_VD);
    const float* BETA = (const float*)(ws + WS_BETA); const float* LOGA = (const float*)(ws + WS_LOGA);
    const int hp = unit & 1, n = (unit >> 1) & 63, b = unit >> 7;
    const int half = tid >> 8, ht = tid & 255, h = 2 * hp + half, item = (b * 64 + n) * 4 + h;
    const int m0 = b * TP + n * 64;
    LAS float* Am = (LAS float*)lds + half * 4096;
    LAS float* gs = (LAS float*)(lds + 32768) + half * 128;
    if (ht < 64) {
        float v = LOGA[(size_t)(m0 + ht) * 4 + h];
#pragma unroll
        for (int o = 1; o < 64; o <<= 1) { const float u = __shfl_up(v, o); if (ht >= o) v += u; }
        gs[ht] = v; gs[64 + ht] = BETA[(size_t)(m0 + ht) * 4 + h];
    }
    __syncthreads();
    {
        const int wl = wave & 3, lr = lane & 15, q = lane >> 4;
        pg8::f32x4 kk[4], qk[4];
#pragma unroll
        for (int j = 0; j < 4; ++j) { kk[j] = (pg8::f32x4){0.f, 0.f, 0.f, 0.f}; qk[j] = kk[j]; }
#pragma unroll
        for (int s = 0; s < 4; ++s) {
            const float* kp = KD + (size_t)(m0 + 16 * wl + lr) * DNW + h * 128 + 32 * s + 8 * q; const float* qp = QD + (size_t)(m0 + 16 * wl + lr) * DNW + h * 128 + 32 * s + 8 * q;
            const bf16x8 ak = __builtin_bit_cast(bf16x8, pack8(*(const f32x4*)kp, *(const f32x4*)(kp + 4))), aq = __builtin_bit_cast(bf16x8, pack8(*(const f32x4*)qp, *(const f32x4*)(qp + 4)));
#pragma unroll
            for (int j = 0; j < 4; ++j) { const float* bp = KD + (size_t)(m0 + 16 * j + lr) * DNW + h * 128 + 32 * s + 8 * q;
                const bf16x8 bk = __builtin_bit_cast(bf16x8, pack8(*(const f32x4*)bp, *(const f32x4*)(bp + 4)));
                kk[j] = __builtin_amdgcn_mfma_f32_16x16x32_bf16(ak, bk, kk[j], 0, 0, 0); qk[j] = __builtin_amdgcn_mfma_f32_16x16x32_bf16(aq, bk, qk[j], 0, 0, 0); }
        }
        bf16* INTRA = (bf16*)(ws + WS_INTRA) + (size_t)item * 4096;
#pragma unroll
        for (int j = 0; j < 4; ++j)
#pragma unroll
            for (int r = 0; r < 4; ++r) { const int i = 16 * wl + 4 * q + r, jj = 16 * j + lr;
                const float dec = (i >= jj) ? __expf(gs[i] - gs[jj]) : 0.f;
                Am[i * 64 + jj] = (i > jj) ? gs[64 + i] * kk[j][r] * dec : 0.f;
                INTRA[i * 64 + jj] = f2bf(qk[j][r] * dec); }
    }
    __syncthreads();
    {
        const int c = ht; float x[64];
        float* U = (float*)(ws + WS_U) + (size_t)item * 8192; bf16* KC = (bf16*)(ws + WS_KCUM) + (size_t)item * 8192;
        const float* rsrc = (c < 128 ? VD : KD) + (size_t)m0 * DNW + h * 128 + (c & 127);
#pragma unroll
        for (int i = 0; i < 64; ++i) x[i] = rsrc[(size_t)i * DNW];
#pragma unroll
        for (int i = 0; i < 64; ++i) { const float eg = __expf(gs[i]); x[i] *= gs[64 + i] * (c >= 128 ? eg : 1.0f); }
        subst_rows<0, 16>(x, Am, gs, c >= 128); subst_rows<16, 32>(x, Am, gs, c >= 128); subst_rows<32, 48>(x, Am, gs, c >= 128); subst_rows<48, 64>(x, Am, gs, c >= 128);
        if (c < 128) {
#pragma unroll
            for (int i = 0; i < 64; ++i) U[i * 128 + c] = x[i];
        } else {
#pragma unroll
            for (int i = 0; i < 64; ++i) KC[i * 128 + (c - 128)] = f2bf(x[i]);
        }
    }
    {
        const float glast = gs[63];
        bf16* QDc = (bf16*)(ws + WS_QDEC) + (size_t)item * 8192; bf16* KT = (bf16*)(ws + WS_KDECT) + (size_t)item * 8192;
        for (int e = ht; e < 64 * 128; e += 256) { const int i = e >> 7, d = e & 127; QDc[e] = f2bf(QD[(size_t)(m0 + i) * DNW + h * 128 + d] * __expf(gs[i])); }
        { const int d = ht & 127, ig = ht >> 7;
#pragma unroll
            for (int i8 = 0; i8 < 4; ++i8) { float v[8];
#pragma unroll
                for (int k = 0; k < 8; ++k) { const int i = 32 * ig + 8 * i8 + k; v[k] = KD[(size_t)(m0 + i) * DNW + h * 128 + d] * __expf(glast - gs[i]); }
                u32x4 w; w.x = cvtpk(v[0], v[1]); w.y = cvtpk(v[2], v[3]); w.z = cvtpk(v[4], v[5]); w.w = cvtpk(v[6], v[7]);
                *(u32x4*)(KT + d * 64 + 32 * ig + 8 * i8) = w; } }
        if (ht == 0) ((float*)(ws + WS_GL))[item] = __expf(glast);
    }
    __syncthreads();
}
__device__ __forceinline__ void dn_sample_unit(const Args& A, LAS unsigned char* lds, int unit, int tid) {
    unsigned char* ws = A.ws;
    const float* QD = (const float*)(ws + WS_QD); const float* KD = (const float*)(ws + WS_KD); const float* VD = (const float*)(ws + WS_VD);
    const float* BETA = (const float*)(ws + WS_BETA); const float* LOGA = (const float*)(ws + WS_LOGA); float* ODN = (float*)(ws + WS_ODN);
    const int h = unit & 3, b = unit >> 2, e = tid & 127, dq = tid >> 7;
    const float* s0 = (const float*)A.in[I_SD] + ((size_t)(b * 4 + h) * 128 + 32 * dq) * 128 + e;
    float S[32];
#pragma unroll
    for (int d = 0; d < 32; ++d) S[d] = s0[(size_t)d * 128];
    LAS float* red = (LAS float*)lds; LAS float* red2 = red + 512;
    for (int t = 0; t < TS; ++t) {
        const int m = MP + b * TS + t;
        const float a = __expf(LOGA[(size_t)m * 4 + h]), bt = BETA[(size_t)m * 4 + h];
        const float* kp = KD + (size_t)m * DNW + h * 128 + 32 * dq; const float* qp = QD + (size_t)m * DNW + h * 128 + 32 * dq;
        float kd[32], qd[32];
#pragma unroll
        for (int d4 = 0; d4 < 8; ++d4) { const f32x4 kv = *(const f32x4*)(kp + 4 * d4), qv = *(const f32x4*)(qp + 4 * d4);
            kd[4 * d4] = kv.x; kd[4 * d4 + 1] = kv.y; kd[4 * d4 + 2] = kv.z; kd[4 * d4 + 3] = kv.w; qd[4 * d4] = qv.x; qd[4 * d4 + 1] = qv.y; qd[4 * d4 + 2] = qv.z; qd[4 * d4 + 3] = qv.w; }
        float p = 0.f;
#pragma unroll
        for (int d = 0; d < 32; ++d) p += kd[d] * S[d];
        red[dq * 128 + e] = p;
        __syncthreads();
        const float kS = (red[e] + red[128 + e]) + (red[256 + e] + red[384 + e]);
        const float dl = bt * (VD[(size_t)m * DNW + h * 128 + e] - a * kS);
        float po = 0.f;
#pragma unroll
        for (int d = 0; d < 32; ++d) { S[d] = a * S[d] + kd[d] * dl; po += qd[d] * S[d]; }
        red2[dq * 128 + e] = po;
        __syncthreads();
        if (dq == 0) ODN[(size_t)m * DNW + h * 128 + e] = (red2[e] + red2[128 + e]) + (red2[256 + e] + red2[384 + e]);
    }
    float* so = A.out + O_SS + ((size_t)(b * 4 + h) * 128 + 32 * dq) * 128 + e;
#pragma unroll
    for (int d = 0; d < 32; ++d) so[(size_t)d * 128] = S[d];
    __syncthreads();
}

constexpr int SC_KC = 0, SC_QD = 17408, SC_KT = 34816, SC_IN = 53248, SC_BUF = 62464;
__device__ __forceinline__ void dn_scan_chain(const Args& A, LAS unsigned char* lds, int chain, int tid, int wave, int lane) {
    unsigned char* ws = A.ws;
    const float* Ub = (const float*)(ws + WS_U); const float* GL = (const float*)(ws + WS_GL); float* ODN = (float*)(ws + WS_ODN);
    const int b = chain >> 2, h = chain & 3, lr = lane & 15, q = lane >> 4, e = 16 * wave + lr;
    const unsigned char* gsrc[4]; int ldst[7];
    { const int c0 = tid, c1 = tid + 512;
      ldst[0] = SC_KC + (c0 >> 4) * 272 + (c0 & 15) * 16; ldst[1] = SC_KC + (c1 >> 4) * 272 + (c1 & 15) * 16;
      ldst[2] = SC_QD + (c0 >> 4) * 272 + (c0 & 15) * 16; ldst[3] = SC_QD + (c1 >> 4) * 272 + (c1 & 15) * 16;
      ldst[4] = SC_KT + (c0 >> 3) * 144 + (c0 & 7) * 16;  ldst[5] = SC_KT + (c1 >> 3) * 144 + (c1 & 7) * 16;
      ldst[6] = SC_IN + (c0 >> 3) * 144 + (c0 & 7) * 16; }
    const size_t item0 = (size_t)(b * 64) * 4 + h;
    gsrc[0] = ws + WS_KCUM + item0 * 16384 + tid * 16; gsrc[1] = ws + WS_QDEC + item0 * 16384 + tid * 16; gsrc[2] = ws + WS_KDECT + item0 * 16384 + tid * 16; gsrc[3] = ws + WS_INTRA + item0 * 8192 + tid * 16;
    u32x4 R[7]; float un[16];
#define SC_GLOAD(n_) do { const size_t o16_ = (size_t)(n_) * 4 * 16384, o8_ = (size_t)(n_) * 4 * 8192; \
        R[0] = *(const u32x4*)(gsrc[0] + o16_); R[1] = *(const u32x4*)(gsrc[0] + o16_ + 8192); R[2] = *(const u32x4*)(gsrc[1] + o16_); R[3] = *(const u32x4*)(gsrc[1] + o16_ + 8192); \
        R[4] = *(const u32x4*)(gsrc[2] + o16_); R[5] = *(const u32x4*)(gsrc[2] + o16_ + 8192); R[6] = *(const u32x4*)(gsrc[3] + o8_); \
        const float* U_ = Ub + (item0 + 4 * (size_t)(n_)) * 8192 + e; \
        _Pragma("unroll") for (int i_ = 0; i_ < 4; ++i_) _Pragma("unroll") for (int r_ = 0; r_ < 4; ++r_) un[4 * i_ + r_] = U_[(16 * i_ + 4 * q + r_) * 128]; } while (0)
#define SC_LWRITE(buf_) do { _Pragma("unroll") for (int k_ = 0; k_ < 7; ++k_) *(LAS u32x4*)(lds + (buf_) * SC_BUF + ldst[k_]) = R[k_]; } while (0)
    pg8::f32x4 S[8];
#pragma unroll
    for (int i = 0; i < 8; ++i) S[i] = (pg8::f32x4){0.f, 0.f, 0.f, 0.f};
    __syncthreads();
    SC_GLOAD(0); SC_LWRITE(0);
    float uc[16];
#pragma unroll
    for (int k = 0; k < 16; ++k) uc[k] = un[k];
    __syncthreads();
    for (int n = 0; n < 64; ++n) {
        const float gl = GL[item0 + 4 * n];
        if (n + 1 < 64) SC_GLOAD(n + 1);
        const LAS unsigned char* B = lds + (n & 1) * SC_BUF;
        bf16x8 Sb[4];
#pragma unroll
        for (int s = 0; s < 4; ++s) { u32x4 w; w.x = cvtpk(S[2 * s][0], S[2 * s][1]); w.y = cvtpk(S[2 * s][2], S[2 * s][3]); w.z = cvtpk(S[2 * s + 1][0], S[2 * s + 1][1]); w.w = cvtpk(S[2 * s + 1][2], S[2 * s + 1][3]); Sb[s] = __builtin_bit_cast(bf16x8, w); }
        pg8::f32x4 vn[4], o[4];
#pragma unroll
        for (int i = 0; i < 4; ++i) {
            pg8::f32x4 ak = (pg8::f32x4){0.f, 0.f, 0.f, 0.f}, aq = ak;
#pragma unroll
            for (int s = 0; s < 4; ++s) {
                const LAS unsigned char* kp = B + SC_KC + (16 * i + lr) * 272 + (32 * s + 4 * q) * 2; const LAS unsigned char* qp = B + SC_QD + (16 * i + lr) * 272 + (32 * s + 4 * q) * 2;
                const u32x2 k0 = *(const LAS u32x2*)kp, k1 = *(const LAS u32x2*)(kp + 32), q0 = *(const LAS u32x2*)qp, q1 = *(const LAS u32x2*)(qp + 32);
                ak = __builtin_amdgcn_mfma_f32_16x16x32_bf16(__builtin_bit_cast(bf16x8, (u32x4){k0.x, k0.y, k1.x, k1.y}), Sb[s], ak, 0, 0, 0);
                aq = __builtin_amdgcn_mfma_f32_16x16x32_bf16(__builtin_bit_cast(bf16x8, (u32x4){q0.x, q0.y, q1.x, q1.y}), Sb[s], aq, 0, 0, 0);
            }
#pragma unroll
            for (int r = 0; r < 4; ++r) vn[i][r] = uc[4 * i + r] - ak[r];
            o[i] = aq;
        }
        bf16x8 Vb[2];
#pragma unroll
        for (int s = 0; s < 2; ++s) { u32x4 w; w.x = cvtpk(vn[2 * s][0], vn[2 * s][1]); w.y = cvtpk(vn[2 * s][2], vn[2 * s][3]); w.z = cvtpk(vn[2 * s + 1][0], vn[2 * s + 1][1]); w.w = cvtpk(vn[2 * s + 1][2], vn[2 * s + 1][3]); Vb[s] = __builtin_bit_cast(bf16x8, w); }
#pragma unroll
        for (int i = 0; i < 4; ++i) {
#pragma unroll
            for (int s = 0; s < 2; ++s) { const LAS unsigned char* ip = B + SC_IN + (16 * i + lr) * 144 + (32 * s + 4 * q) * 2; const u32x2 a0 = *(const LAS u32x2*)ip, a1 = *(const LAS u32x2*)(ip + 32);
                o[i] = __builtin_amdgcn_mfma_f32_16x16x32_bf16(__builtin_bit_cast(bf16x8, (u32x4){a0.x, a0.y, a1.x, a1.y}), Vb[s], o[i], 0, 0, 0); }
#pragma unroll
            for (int r = 0; r < 4; ++r) ODN[(size_t)(b * TP + 64 * n + 16 * i + 4 * q + r) * DNW + h * 128 + e] = o[i][r];
        }
#pragma unroll
        for (int i = 0; i < 8; ++i) {
            pg8::f32x4 acc = S[i] * gl;
#pragma unroll
            for (int s = 0; s < 2; ++s) { const LAS unsigned char* tp = B + SC_KT + (16 * i + lr) * 144 + (32 * s + 4 * q) * 2; const u32x2 a0 = *(const LAS u32x2*)tp, a1 = *(const LAS u32x2*)(tp + 32);
                acc = __builtin_amdgcn_mfma_f32_16x16x32_bf16(__builtin_bit_cast(bf16x8, (u32x4){a0.x, a0.y, a1.x, a1.y}), Vb[s], acc, 0, 0, 0); }
            S[i] = acc;
        }
        if (n + 1 < 64) {
            SC_LWRITE((n + 1) & 1);
#pragma unroll
            for (int k = 0; k < 16; ++k) uc[k] = un[k];
        }
        __syncthreads();
    }
#undef SC_GLOAD
#undef SC_LWRITE
    float* so = A.out + O_SP + (size_t)(b * 4 + h) * 16384;
#pragma unroll
    for (int i = 0; i < 8; ++i)
#pragma unroll
        for (int r = 0; r < 4; ++r) so[(16 * i + 4 * q + r) * 128 + e] = S[i][r];
}

__device__ __forceinline__ int crow(int r, int hi) { return (r & 3) + 8 * (r >> 2) + 4 * hi; }
__device__ __forceinline__ void sb_core(f32x16& p, float& carry, int hi) {
    float s[16];
#pragma unroll
    for (int r = 0; r < 16; ++r) { const float e = __builtin_amdgcn_exp2f(p[r]); s[r] = -__builtin_amdgcn_logf(1.0f + e); }
    float tt[4], uu[4];
#pragma unroll
    for (int i = 0; i < 4; ++i) { s[4 * i + 2] += s[4 * i + 3]; s[4 * i + 1] += s[4 * i + 2]; s[4 * i] += s[4 * i + 1]; tt[i] = s[4 * i]; }
#pragma unroll
    for (int i = 0; i < 4; ++i) uu[i] = __shfl_xor(tt[i], 32);
    const float w3 = tt[3] + uu[3], w2 = tt[2] + uu[2], w1 = tt[1] + uu[1], w0 = tt[0] + uu[0];
    float off[4];
    off[3] = carry; off[2] = carry + w3; off[1] = off[2] + w2; off[0] = off[1] + w1;
    carry = off[0] + w0;
    if (hi == 0) {
#pragma unroll
        for (int i = 0; i < 4; ++i) off[i] += uu[i];
    }
#pragma unroll
    for (int r = 0; r < 16; ++r) p[r] = __builtin_amdgcn_exp2f(p[r] + s[r] + off[r >> 2]);
}
__device__ __forceinline__ bf16x8 pack_p(const f32x16& p, int s) {
    u32x4 w; w.x = cvtpk(p[8 * s], p[8 * s + 1]); w.y = cvtpk(p[8 * s + 2], p[8 * s + 3]); w.z = cvtpk(p[8 * s + 4], p[8 * s + 5]); w.w = cvtpk(p[8 * s + 6], p[8 * s + 7]); return __builtin_bit_cast(bf16x8, w);
}
__device__ __forceinline__ void load_k_prompt(bf16x8 (&k)[4], const bf16* KB, int b, int h, int kv0, int r32, int hi) {
    const bf16* kp = KB + (size_t)(b * TP + kv0 + r32) * SBW + h * HD + 8 * hi;
#pragma unroll
    for (int d0 = 0; d0 < 4; ++d0) k[d0] = *(const bf16x8*)(kp + 16 * d0);
}
__device__ __forceinline__ void load_v_prompt(u32x2 (&v)[8], const bf16* VT, int b, int h, int kv0, int r32, int hi) {
#pragma unroll
    for (int dt = 0; dt < 2; ++dt) { const bf16* vp = VT + (size_t)(h * HD + 32 * dt + r32) * M + b * TP + kv0 + 4 * hi;
#pragma unroll
        for (int g = 0; g < 4; ++g) v[4 * dt + g] = *(const u32x2*)(vp + 8 * g); }
}
template <int MASK>
__device__ __forceinline__ void sb_qk(f32x16& p, const bf16x8 (&kf)[4], const bf16x8 (&qf)[4], float bias2, int kv0, int qpos, int hi) {
#pragma unroll
    for (int r = 0; r < 16; ++r) p[r] = bias2;
#pragma unroll
    for (int d0 = 0; d0 < 4; ++d0) p = __builtin_amdgcn_mfma_f32_32x32x16_bf16(kf[d0], qf[d0], p, 0, 0, 0);
    if (MASK) {
#pragma unroll
        for (int r = 0; r < 16; ++r) if (kv0 + crow(r, hi) >= qpos) p[r] = -INFINITY;
    }
}
__device__ __forceinline__ void sb_pv(f32x16& p, const bf16x8 (&vf)[4], f32x16 (&o)[2], float& carry, int hi) {
    sb_core(p, carry, hi);
    const bf16x8 p0 = pack_p(p, 0), p1 = pack_p(p, 1);
#pragma unroll
    for (int dt = 0; dt < 2; ++dt) { o[dt] = __builtin_amdgcn_mfma_f32_32x32x16_bf16(vf[2 * dt], p0, o[dt], 0, 0, 0); o[dt] = __builtin_amdgcn_mfma_f32_32x32x16_bf16(vf[2 * dt + 1], p1, o[dt], 0, 0, 0); }
}
template <int MASK>
__device__ __forceinline__ void sb_tile(const bf16x8 (&kf)[4], const bf16x8 (&vf)[4], const bf16x8 (&qf)[4], float bias2, f32x16 (&o)[2], float& carry, int kv0, int qpos, int hi) {
    f32x16 p; sb_qk<MASK>(p, kf, qf, bias2, kv0, qpos, hi); sb_pv(p, vf, o, carry, hi);
}
__device__ __forceinline__ void sb_store_prompt(const Args& A, const f32x16 (&o)[2], int b, int h, int qpos, int hi) {
    float ss = 0.f;
#pragma unroll
    for (int dt = 0; dt < 2; ++dt)
#pragma unroll
        for (int r = 0; r < 16; ++r) ss += o[dt][r] * o[dt][r];
    ss += __shfl_xor(ss, 32);
    const float rs = 1.0f / sqrtf(ss * (1.f / HD) + EPS);
    const float* gso = (const float*)A.in[I_GSBO];
    bf16* op = (bf16*)(A.ws + WS_MIXED) + (size_t)(b * TP + qpos) * D + h * HD;
#pragma unroll
    for (int dt = 0; dt < 2; ++dt)
#pragma unroll
        for (int g = 0; g < 4; ++g) { const int d = 32 * dt + 8 * g + 4 * hi; const f32x4 gg = *(const f32x4*)(gso + d);
            u32x2 w; w.x = cvtpk(o[dt][4 * g] * rs * gg.x, o[dt][4 * g + 1] * rs * gg.y); w.y = cvtpk(o[dt][4 * g + 2] * rs * gg.z, o[dt][4 * g + 3] * rs * gg.w); *(u32x2*)(op + d) = w; }
}
#define VFRAGS(v_) { __builtin_bit_cast(bf16x8, (u32x4){v_[0].x, v_[0].y, v_[1].x, v_[1].y}), __builtin_bit_cast(bf16x8, (u32x4){v_[2].x, v_[2].y, v_[3].x, v_[3].y}), \
                     __builtin_bit_cast(bf16x8, (u32x4){v_[4].x, v_[4].y, v_[5].x, v_[5].y}), __builtin_bit_cast(bf16x8, (u32x4){v_[6].x, v_[6].y, v_[7].x, v_[7].y}) }
__device__ __forceinline__ void attn_prompt_item(const Args& A, int b, int h, int q0, int lane) {
    unsigned char* ws = A.ws;
    const bf16* QB = (const bf16*)(ws + WS_QB); const bf16* KB = (const bf16*)(ws + WS_KB); const bf16* VT = (const bf16*)(ws + WS_VT);
    const int r32 = lane & 31, hi = lane >> 5, qa = q0 + r32, qb = q0 + 32 + r32;
    const float bias2 = ((const float*)A.in[I_SBB])[h] * LOG2E;
    bf16x8 qfa[4], qfb[4];
#pragma unroll
    for (int d0 = 0; d0 < 4; ++d0) { qfa[d0] = *(const bf16x8*)(QB + (size_t)(b * TP + qa) * SBW + h * HD + 16 * d0 + 8 * hi); qfb[d0] = *(const bf16x8*)(QB + (size_t)(b * TP + qb) * SBW + h * HD + 16 * d0 + 8 * hi); }
    f32x16 oa[2], ob[2]; oa[0] = (f32x16){}; oa[1] = (f32x16){}; ob[0] = (f32x16){}; ob[1] = (f32x16){};
    float ca = 0.f, cb = 0.f;
    bf16x8 kc[4]; u32x2 vv[8];
    const int top = (q0 >> 5) + 1;
    load_k_prompt(kc, KB, b, h, 32 * top, r32, hi);
    { load_v_prompt(vv, VT, b, h, 32 * top, r32, hi);
      f32x16 p; sb_qk<1>(p, kc, qfb, bias2, 32 * top, qb, hi);
      load_k_prompt(kc, KB, b, h, 32 * (top - 1), r32, hi);
      const bf16x8 vf[4] = VFRAGS(vv);
      sb_pv(p, vf, ob, cb, hi); }
    { load_v_prompt(vv, VT, b, h, 32 * (top - 1), r32, hi);
      const bf16x8 vf[4] = VFRAGS(vv);
      sb_tile<1>(kc, vf, qfa, bias2, oa, ca, 32 * (top - 1), qa, hi);
      f32x16 p; sb_qk<0>(p, kc, qfb, bias2, 0, 0, hi);
      if (top >= 2) load_k_prompt(kc, KB, b, h, 32 * (top - 2), r32, hi);
      sb_pv(p, vf, ob, cb, hi); }
    for (int ht = top - 2; ht >= 0; --ht) {
        load_v_prompt(vv, VT, b, h, 32 * ht, r32, hi);
        const bf16x8 vf[4] = VFRAGS(vv);
        sb_tile<0>(kc, vf, qfa, bias2, oa, ca, 0, 0, hi);
        f32x16 p; sb_qk<0>(p, kc, qfb, bias2, 0, 0, hi);
        if (ht > 0) load_k_prompt(kc, KB, b, h, 32 * (ht - 1), r32, hi);
        sb_pv(p, vf, ob, cb, hi);
    }
    sb_store_prompt(A, oa, b, h, qa, hi); sb_store_prompt(A, ob, b, h, qb, hi);
}

struct RawKV { f32x4 k[8]; float v[32]; };
__device__ __forceinline__ void load_kv_sample(RawKV& f, const float* ck, const float* cv, size_t base, int h, int r32, int hi) {
    const float* kp = ck + base + (size_t)r32 * 512 + h * HD + 8 * hi;
#pragma unroll
    for (int d0 = 0; d0 < 4; ++d0) { f.k[2 * d0] = *(const f32x4*)(kp + 16 * d0); f.k[2 * d0 + 1] = *(const f32x4*)(kp + 16 * d0 + 4); }
    const float* vp = cv + base + (size_t)(4 * hi) * 512 + h * HD + r32;
#pragma unroll
    for (int dt = 0; dt < 2; ++dt)
#pragma unroll
        for (int g = 0; g < 4; ++g)
#pragma unroll
            for (int j = 0; j < 4; ++j) f.v[16 * dt + 4 * g + j] = vp[(size_t)(8 * g + j) * 512 + 32 * dt];
}
__device__ __forceinline__ void cvt_kv_sample(const RawKV& f, bf16x8 (&kf)[4], bf16x8 (&vf)[4]) {
#pragma unroll
    for (int d0 = 0; d0 < 4; ++d0) kf[d0] = __builtin_bit_cast(bf16x8, pack8(f.k[2 * d0], f.k[2 * d0 + 1]));
#pragma unroll
    for (int i = 0; i < 4; ++i) { u32x4 w; w.x = cvtpk(f.v[8 * i], f.v[8 * i + 1]); w.y = cvtpk(f.v[8 * i + 2], f.v[8 * i + 3]); w.z = cvtpk(f.v[8 * i + 4], f.v[8 * i + 5]); w.w = cvtpk(f.v[8 * i + 6], f.v[8 * i + 7]); vf[i] = __builtin_bit_cast(bf16x8, w); }
}
__device__ __forceinline__ void attn_sample_store(const Args& A, int b, int h, int part, int lane, const f32x16 (&o)[2], float carry) {
    float* OP = (float*)(A.ws + WS_OPART) + (size_t)((b * SBH + h) * NPART + part) * 512; float* LP = (float*)(A.ws + WS_LPART) + (size_t)((b * SBH + h) * NPART + part) * 8;
    const int r32 = lane & 31, hi = lane >> 5;
    if (r32 < 8) {
#pragma unroll
        for (int dt = 0; dt < 2; ++dt)
#pragma unroll
            for (int r = 0; r < 16; ++r) OP[(32 * dt + crow(r, hi)) * 8 + r32] = o[dt][r];
        if (hi == 0) LP[r32] = carry;
    }
}
__device__ __forceinline__ void attn_sample_job(const Args& A, int b, int h, int sp, int lane) {
    unsigned char* ws = A.ws;
    const int r32 = lane & 31, hi = lane >> 5;
    const float* ck = (const float*)A.in[I_CK]; const float* cv = (const float*)A.in[I_CV]; const int* pt = (const int*)A.in[I_PT] + b * NPAGES;
    const bf16* QB = (const bf16*)(ws + WS_QB);
    const float bias2 = ((const float*)A.in[I_SBB])[h] * LOG2E;
    bf16x8 qf[4];
#pragma unroll
    for (int d0 = 0; d0 < 4; ++d0) { qf[d0] = (bf16x8){0, 0, 0, 0, 0, 0, 0, 0}; if (r32 < TS) qf[d0] = *(const bf16x8*)(QB + (size_t)(MP + b * TS + r32) * SBW + h * HD + 16 * d0 + 8 * hi); }
    f32x16 o[2]; float carry;
    bf16x8 kf[4], vf[4];
    const int tok_hi = (PAST / NSPLIT) * (sp + 1);
    constexpr int NT = PAST / NSPLIT / 32;
    RawKV raw;
#define SAMPLE_BASE(j) (((size_t)pt[(tok_hi - 32 * ((j) + 1)) >> 7] * PAGE + ((tok_hi - 32 * ((j) + 1)) & 127)) * 512)
    load_kv_sample(raw, ck, cv, SAMPLE_BASE(0), h, r32, hi);
    if (sp == NSPLIT - 1) {
        const bf16* KBn = (const bf16*)(ws + WS_KB) + (size_t)(MP + b * TS) * SBW + h * HD; const float* PV = (const float*)(ws + WS_PROJ) + (size_t)(MP + b * TS) * NPROJ + 1024 + h * HD;
#pragma unroll
        for (int d0 = 0; d0 < 4; ++d0) { kf[d0] = (bf16x8){0, 0, 0, 0, 0, 0, 0, 0}; if (r32 < TS) kf[d0] = *(const bf16x8*)(KBn + (size_t)r32 * SBW + 16 * d0 + 8 * hi); }
#pragma unroll
        for (int dt = 0; dt < 2; ++dt) { float v[4];
#pragma unroll
            for (int j = 0; j < 4; ++j) v[j] = PV[(size_t)(4 * hi + j) * NPROJ + 32 * dt + r32];
            u32x4 w; w.x = cvtpk(v[0], v[1]); w.y = cvtpk(v[2], v[3]); w.z = 0u; w.w = 0u; vf[2 * dt] = __builtin_bit_cast(bf16x8, w); vf[2 * dt + 1] = (bf16x8){0, 0, 0, 0, 0, 0, 0, 0}; }
        o[0] = (f32x16){}; o[1] = (f32x16){}; carry = 0.f;
        sb_tile<1>(kf, vf, qf, bias2, o, carry, 0, r32, hi);
        attn_sample_store(A, b, h, NPART - 1, lane, o, carry);
    }
    o[0] = (f32x16){}; o[1] = (f32x16){}; carry = 0.f;
    for (int j = 0; j < NT; ++j) {
        cvt_kv_sample(raw, kf, vf);
        if (j + 1 < NT) load_kv_sample(raw, ck, cv, SAMPLE_BASE(j + 1), h, r32, hi);
        sb_tile<0>(kf, vf, qf, bias2, o, carry, 0, 0, hi);
    }
#undef SAMPLE_BASE
    attn_sample_store(A, b, h, sp, lane, o, carry);
}

__device__ __forceinline__ void phase_outnorm(const Args& A, int gw, int NGW, int lane) {
    unsigned char* ws = A.ws; const float* ODN = (const float*)(ws + WS_ODN); const float* PROJ = (const float*)(ws + WS_PROJ); bf16* MIXED = (bf16*)(ws + WS_MIXED);
    const float* gdn = (const float*)A.in[I_GDNO]; const float* gso = (const float*)A.in[I_GSBO];
    const float* OPb = (const float*)(ws + WS_OPART); const float* LPb = (const float*)(ws + WS_LPART);
    const int c8 = 8 * lane;
    for (int m = gw; m < M; m += NGW) {
        {
            const float* op = ODN + (size_t)m * DNW + c8; f32x4 a0 = *(const f32x4*)op, a1 = *(const f32x4*)(op + 4);
            float ss = (a0.x * a0.x + a0.y * a0.y) + (a0.z * a0.z + a0.w * a0.w) + (a1.x * a1.x + a1.y * a1.y) + (a1.z * a1.z + a1.w * a1.w);
            ss += __shfl_xor(ss, 1); ss += __shfl_xor(ss, 2); ss += __shfl_xor(ss, 4); ss += __shfl_xor(ss, 8);
            const float rs = 1.0f / sqrtf(ss * (1.f / DND) + EPS);
            const f32x4 g0 = *(const f32x4*)(gdn + (c8 & 127)), g1 = *(const f32x4*)(gdn + (c8 & 127) + 4);
            const float* zp = PROJ + (size_t)m * NPROJ + 3072 + c8; f32x4 z0 = *(const f32x4*)zp, z1 = *(const f32x4*)(zp + 4);
            z0.x = siluf(z0.x); z0.y = siluf(z0.y); z0.z = siluf(z0.z); z0.w = siluf(z0.w); z1.x = siluf(z1.x); z1.y = siluf(z1.y); z1.z = siluf(z1.z); z1.w = siluf(z1.w);
            *(u32x4*)(MIXED + (size_t)m * D + SBW + c8) = pack8(a0 * rs * g0 * z0, a1 * rs * g1 * z1);
        }
        if (m >= MP) {
            const int b = (m - MP) >> 3, t = (m - MP) & 7, h = lane >> 3, d0 = c8 & 63;
            const float* OP = OPb + (size_t)(b * SBH + h) * NPART * 512; const float* LP = LPb + (size_t)(b * SBH + h) * NPART * 8;
            float v[8];
#pragma unroll
            for (int k = 0; k < 8; ++k) v[k] = 0.f;
            float suf = 0.f;
#pragma unroll
            for (int part = NPART - 1; part >= 0; --part) { const float w = __builtin_amdgcn_exp2f(suf);
#pragma unroll
                for (int k = 0; k < 8; ++k) v[k] += w * OP[part * 512 + (d0 + k) * 8 + t];
                suf += LP[part * 8 + t]; }
            float ss = 0.f;
#pragma unroll
            for (int k = 0; k < 8; ++k) ss += v[k] * v[k];
            ss += __shfl_xor(ss, 1); ss += __shfl_xor(ss, 2); ss += __shfl_xor(ss, 4);
            const float rs = 1.0f / sqrtf(ss * (1.f / HD) + EPS);
            const f32x4 g0 = *(const f32x4*)(gso + d0), g1 = *(const f32x4*)(gso + d0 + 4);
            *(u32x4*)(MIXED + (size_t)m * D + c8) = pack8((f32x4){v[0], v[1], v[2], v[3]} * rs * g0, (f32x4){v[4], v[5], v[6], v[7]} * rs * g1);
        }
    }
}

__device__ __forceinline__ f32x4 bf4lo(u32x4 w) { return (f32x4){__uint_as_float(w.x << 16), __uint_as_float(w.x & 0xffff0000u), __uint_as_float(w.y << 16), __uint_as_float(w.y & 0xffff0000u)}; }
__device__ __forceinline__ f32x4 bf4hi(u32x4 w) { return (f32x4){__uint_as_float(w.z << 16), __uint_as_float(w.z & 0xffff0000u), __uint_as_float(w.w << 16), __uint_as_float(w.w & 0xffff0000u)}; }
__device__ __forceinline__ void phase_convgate(const Args& A, int gw, int NGW, int lane) {
    unsigned char* ws = A.ws; const bf16* UP = (const bf16*)(ws + WS_UP); bf16* ACT = (bf16*)(ws + WS_ACT); float* out = A.out;
    const float* wf = (const float*)A.in[I_WFC]; const float* sfc = (const float*)A.in[I_SFC];
    for (int m = gw; m < M; m += NGW) {
        const bool prompt = m < MP; const int b = prompt ? (m >> 12) : ((m - MP) >> 3), t = prompt ? (m & 4095) : ((m - MP) & 7);
        const bf16* ur = UP + (size_t)m * DFF2;
        const int oidx = prompt ? t - (TP - 2) : t - (TS - 2);
        float* fo = oidx >= 0 ? (prompt ? out + O_FCP + ((size_t)b * 2 + oidx) * DFF2 : out + O_FCS + ((size_t)b * 2 + oidx) * DFF2) : nullptr;
        for (int ch = lane; ch < DFF / 8; ch += 64) {
            const int c = 8 * ch;
            f32x4 u0 = (f32x4){0.f, 0.f, 0.f, 0.f}, u1 = u0, g0 = u0, g1 = u0;
#pragma unroll
            for (int i = 0; i < 3; ++i) {
                const int tt = t - 2 + i;
                f32x4 xu0, xu1, xg0, xg1;
                if (tt >= 0) { const u32x4 wu = *(const u32x4*)(ur - (size_t)(2 - i) * DFF2 + c), wg = *(const u32x4*)(ur - (size_t)(2 - i) * DFF2 + DFF + c); xu0 = bf4lo(wu); xu1 = bf4hi(wu); xg0 = bf4lo(wg); xg1 = bf4hi(wg); }
                else if (!prompt) { const float* p = sfc + ((size_t)b * 2 + (2 + tt)) * DFF2 + c; xu0 = *(const f32x4*)p; xu1 = *(const f32x4*)(p + 4); xg0 = *(const f32x4*)(p + DFF); xg1 = *(const f32x4*)(p + DFF + 4); }
                else { xu0 = (f32x4){0.f, 0.f, 0.f, 0.f}; xu1 = xu0; xg0 = xu0; xg1 = xu0; }
                const float* wp = wf + (size_t)i * DFF2 + c;
                u0 += *(const f32x4*)wp * xu0; u1 += *(const f32x4*)(wp + 4) * xu1; g0 += *(const f32x4*)(wp + DFF) * xg0; g1 += *(const f32x4*)(wp + DFF + 4) * xg1;
                if (i == 2 && fo) { *(f32x4*)(fo + c) = xu0; *(f32x4*)(fo + c + 4) = xu1; *(f32x4*)(fo + DFF + c) = xg0; *(f32x4*)(fo + DFF + c + 4) = xg1; }
            }
            g0.x = siluf(g0.x); g0.y = siluf(g0.y); g0.z = siluf(g0.z); g0.w = siluf(g0.w); g1.x = siluf(g1.x); g1.y = siluf(g1.y); g1.z = siluf(g1.z); g1.w = siluf(g1.w);
            *(u32x4*)(ACT + (size_t)m * DFF + c) = pack8(g0 * u0, g1 * u1);
        }
    }
}

constexpr int NPHASE = 13;
#ifndef REP_MASK
#define REP_MASK 0
#endif

__global__ void __launch_bounds__(512, 2) fwd_kernel(Args A) {
    extern __shared__ __attribute__((aligned(16))) unsigned char lds_raw[];
    LAS unsigned char* lds = (LAS unsigned char*)lds_raw;
    const int tid = threadIdx.x, lane = tid & 63, wave = __builtin_amdgcn_readfirstlane(tid >> 6);
    const int G = gridDim.x, bx = blockIdx.x;
    const int gw = bx * 8 + wave, NGW = G * 8, gtid = bx * 512 + tid, NGT = G * 512;
    unsigned char* ws = A.ws;
    gu32* ctl = (gu32*)(ws + WS_CTL);
    volatile LAS unsigned* MISC = (volatile LAS unsigned*)(lds + MISC_OFF);
    for (int u = tid; u < (LDS_BYTES - RING_BYTES) / 4; u += 512) ((LAS unsigned*)(lds + RING_BYTES))[u] = 0u;
    __syncthreads();
    const int lo = A.lo, hi = A.hi;
    const bool multi = (hi - lo) > 1;
    XcdBarrier bar; bar.bar = (unsigned*)(ctl + CW_BAR); bar.x = 0; bar.st = nullptr;
    if (multi) bar = xcd_barrier_post((unsigned*)(ctl + CW_BAR), MISC + 8);
#define IN(k) (lo <= (k) && (k) < hi)
#define SEAM(k) do { if (IN(k) && IN((k) + 1)) xcd_barrier(bar); } while (0)
    float* MOD = (float*)(ws + WS_MOD);

#define PH0(rep_) phase_prologue(A, lds, gw, NGW, wave, lane, gtid, NGT);
#define PH1(rep_) phase_mod(A, gw, NGW, lane);
#define PH2(rep_) phase_norm<true>((const float*)A.in[I_XP], (const float*)A.in[I_XS], (const float*)A.in[I_GATT], MOD, 0, 1024, (bf16*)(ws + WS_H), (const float*)(ws + WS_WINX), (float*)(ws + WS_EXTRA), gw, NGW, lane);
#define PH3(rep_) { { pg8::Gemm g{(const pg8::bf16_t*)(ws + WS_H), (const pg8::bf16_t*)(ws + WS_WIN_T), M, NPROJ, D}; pg8::StaticOrder S; S.init(M, NPROJ, G, bx); \
          EpiF32 E{(float*)(ws + WS_PROJ), NPROJ}; \
          pg8::gemm_phase<EpiF32, pg8::StaticOrder, true, true>(lds, g, S, E); } \
        __syncthreads(); \
        { pg8::Gemm g{(const pg8::bf16_t*)(ws + WS_WIN_T) + (size_t)1024 * D, (const pg8::bf16_t*)(ws + WS_H), SBW, M, D}; pg8::StaticOrder S; S.init(SBW, M, G, bx);     \
          pg8::EpiBf16<0> E{(pg8::bf16_t*)(ws + WS_VT), M, nullptr, 0, 0, 1.f}; \
          pg8::gemm_phase<pg8::EpiBf16<0>, pg8::StaticOrder, true, true>(lds, g, S, E); } }
#define PH4(rep_) phase_post(A, gw, NGW, lane);
#define PH5(rep_) for (int u = bx; u < 1024; u += G) { if (u < 512) dn_prescan_unit(A, lds, u, tid, wave, lane); else dn_sample_unit(A, lds, u - 512, tid); }
#define PH6(rep_) PH6X(rep_, true, true, true)
#define PH6X(rep_, DS_, DP_, DA_) { if ((DS_) && bx < 16) dn_scan_chain(A, lds, bx, tid, wave, lane); \
          \
        bool moreP = (DP_), moreS = (DA_); const bool pfirst = wave < 4; \
        for (;;) { \
            int job = -1; bool isP = false; \
            if (pfirst && moreP) { unsigned j_ = 0; if (lane == 0) j_ = __hip_atomic_fetch_add(ctl + CW_QUEUE + 128 * (rep_), 1u, RLX_AGENT); j_ = __builtin_amdgcn_readfirstlane(j_); if (j_ < 2048u) { job = (int)j_; isP = true; } else moreP = false; } \
            if (job < 0 && moreS) { unsigned j_ = 0; if (lane == 0) j_ = __hip_atomic_fetch_add(ctl + CW_QUEUE + 128 * (rep_) + 64, 1u, RLX_AGENT); j_ = __builtin_amdgcn_readfirstlane(j_); if (j_ < 4096u) { job = (int)j_; } else moreS = false; } \
            if (job < 0 && !pfirst && moreP) { unsigned j_ = 0; if (lane == 0) j_ = __hip_atomic_fetch_add(ctl + CW_QUEUE + 128 * (rep_), 1u, RLX_AGENT); j_ = __builtin_amdgcn_readfirstlane(j_); if (j_ < 2048u) { job = (int)j_; isP = true; } else moreP = false; } \
            if (job < 0) { if (!moreP && !moreS) break; else continue; } \
            if (isP) { const int qb = 63 - (job >> 5), bh = job & 31; attn_prompt_item(A, bh >> 3, bh & 7, qb * 64, lane); } \
            else { const int h_ = job & 7, bs_ = job >> 3; attn_sample_job(A, bs_ >> 2, h_, bs_ & 3, lane); } \
        } }
#define PH7(rep_) phase_outnorm(A, gw, NGW, lane);
#define PH8(rep_) { pg8::Gemm g{(const pg8::bf16_t*)(ws + WS_MIXED), (const pg8::bf16_t*)(ws + WS_WOUT_T), M, D, D}; pg8::StaticOrder S; S.init(M, D, G, bx); \
        EpiResGate E{(const float*)A.in[I_XP], (const float*)A.in[I_XS], MOD, 2048, (float*)(ws + WS_X1)}; \
        pg8::gemm_phase<EpiResGate, pg8::StaticOrder, true, true>(lds, g, S, E); }
#define PH9(rep_) phase_norm<false>((const float*)(ws + WS_X1), (const float*)(ws + WS_X1) + (size_t)MP * D, (const float*)A.in[I_GFFN], MOD, 3072, 4096, (bf16*)(ws + WS_H), nullptr, nullptr, gw, NGW, lane);
#define PH10(rep_) { pg8::Gemm g{(const pg8::bf16_t*)(ws + WS_H), (const pg8::bf16_t*)(ws + WS_WUP_T), M, DFF2, D}; pg8::StaticOrder S; S.init(M, DFF2, G, bx); \
        pg8::EpiBf16<0> E{(pg8::bf16_t*)(ws + WS_UP), DFF2, nullptr, 0, 0, 1.f}; \
        pg8::gemm_phase<pg8::EpiBf16<0>, pg8::StaticOrder, true, true>(lds, g, S, E); }
#define PH11(rep_) phase_convgate(A, gw, NGW, lane);
#define PH12(rep_) { pg8::Gemm g{(const pg8::bf16_t*)(ws + WS_ACT), (const pg8::bf16_t*)(ws + WS_WDN_T), M, D, DFF}; pg8::StaticOrder S; S.init(M, D, G, bx); \
        EpiResGate E{(const float*)(ws + WS_X1), (const float*)(ws + WS_X1) + (size_t)MP * D, MOD, 5120, A.out}; \
        pg8::gemm_phase<EpiResGate, pg8::StaticOrder, true, true>(lds, g, S, E); }
#define RUNPH(k) do { if (IN(k)) { PH##k(0) if constexpr (((REP_MASK) >> (k)) & 1) { xcd_barrier(bar); PH##k(1) } } } while (0)
    RUNPH(0); SEAM(0);
    RUNPH(1); SEAM(1);
    RUNPH(2); SEAM(2);
    RUNPH(3); SEAM(3);
    RUNPH(4); SEAM(4);
    RUNPH(5); SEAM(5);
    RUNPH(6);
    if constexpr (((REP_MASK) >> 13) & 1) { xcd_barrier(bar); PH6X(2, true, false, false) }
    if constexpr (((REP_MASK) >> 14) & 1) { xcd_barrier(bar); PH6X(3, false, true, false) }
    if constexpr (((REP_MASK) >> 15) & 1) { xcd_barrier(bar); PH6X(4, false, false, true) }
    SEAM(6);
    RUNPH(7); SEAM(7);
    RUNPH(8); SEAM(8);
    RUNPH(9); SEAM(9);
    RUNPH(10); SEAM(10);
    RUNPH(11); SEAM(11);
    RUNPH(12);
#undef IN
#undef SEAM
}

#ifndef N_LAUNCHES
#define N_LAUNCHES 1
#endif
extern "C" void kernel_launch(void* const* d_in, const int* in_sizes, int n_in, void* d_out, int out_size, void* d_ws, size_t ws_size, hipStream_t stream) {
    static int grid = 0;
    if (grid == 0) {
        if (n_in != 27 || (size_t)out_size != O_END || ws_size < WS_END) { fprintf(stderr, "kernel_launch: unexpected shapes: n_in %d out %d ws %zu\n", n_in, out_size, ws_size); grid = -1; return; }
        int dev = 0, cus = 0, per_cu = 0;
        if (hipGetDevice(&dev) != hipSuccess || hipDeviceGetAttribute(&cus, hipDeviceAttributeMultiprocessorCount, dev) != hipSuccess) { grid = -1; return; }
        if (hipFuncSetAttribute((const void*)fwd_kernel, hipFuncAttributeMaxDynamicSharedMemorySize, LDS_BYTES) != hipSuccess) { fprintf(stderr, "kernel_launch: hipFuncSetAttribute failed\n"); grid = -1; return; }
        if (hipOccupancyMaxActiveBlocksPerMultiprocessor(&per_cu, (const void*)fwd_kernel, 512, LDS_BYTES) != hipSuccess || per_cu < 1) fprintf(stderr, "kernel_launch: occupancy query says %d\n", per_cu);
        (void)hipGetLastError();
        grid = cus;
    }
    if (grid < 0) return;
    (void)hipMemsetAsync((char*)d_ws + WS_CTL, 0, CTL_ZERO_BYTES, stream);
    Args a{};
    for (int i = 0; i < 27; ++i) a.in[i] = d_in[i];
    a.out = (float*)d_out; a.ws = (unsigned char*)d_ws;
    if (N_LAUNCHES == 1) { a.lo = 0; a.hi = NPHASE; hipLaunchKernelGGL(fwd_kernel, dim3(grid), dim3(512), LDS_BYTES, stream, a); }
    else for (int p = 0; p < NPHASE; ++p) { a.lo = p; a.hi = p + 1; hipLaunchKernelGGL(fwd_kernel, dim3(grid), dim3(512), LDS_BYTES, stream, a); }
}
```

```cpp
#include <hip/hip_runtime.h>
#include <cstdio>
#include <cstdint>
#define REP_MASK 0
namespace pg8 {
#define PG8_LAS __attribute__((address_space(3)))
typedef unsigned short bf16_t;
typedef short bf16x8 __attribute__((ext_vector_type(8)));
typedef float f32x4 __attribute__((ext_vector_type(4)));
typedef unsigned u32x4 __attribute__((ext_vector_type(4)));
constexpr int BM = 256, BK = 64, HALF = 128, HTB = HALF * BK * 2  , STAGE_BYTES = 8 * HTB, NXCD = 8, WGM = 8;

__host__ __device__ __forceinline__ int lds_byte(int r, int c) { const int st = (r >> 4) * 2 + (c >> 5), rr = r & 15, cc = c & 31, ob = rr * 64 + cc * 2; return st * 1024 + (ob ^ (((ob >> 9) & 1) << 5)); }
__host__ __device__ __forceinline__ void stage_rc(int b, int& R, int& C) { const int st = b / 1024, sb = b % 1024, swz = sb ^ (((sb >> 9) & 1) << 5); R = (st >> 1) * 16 + swz / 64; C = (st & 1) * 32 + (swz % 64) / 2; }
__host__ __device__ __forceinline__ int perm32(int rho) { const int n = rho >> 4, i = rho & 15; return 8 * (i >> 2) + 4 * n + (i & 3); }

struct Unit { int pm, pn; };
struct Gemm { const bf16_t* A; const bf16_t* Bt; int M, N, K; };

struct StaticOrder {
    int nM, nN, nwg, G, c;
    __host__ __device__ void init(int M, int N, int G_, int c_) { nM = M / BM; nN = N / BM; nwg = nM * nN; G = G_; c = c_; }
    __host__ __device__ bool next(int i, Unit& u) const {
        const long L = (long)i * G + c; if (L >= nwg) return false;
        int wgid = (int)L; { const int q = nwg / NXCD, r = nwg % NXCD, xcd = wgid % NXCD, off = wgid / NXCD; wgid = (xcd < r ? xcd * (q + 1) : r * (q + 1) + (xcd - r) * q) + off; }
        const int nig = WGM * nN, gid = wgid / nig, fm = gid * WGM, gsz = (nM - fm) < WGM ? (nM - fm) : WGM;
        u.pm = fm + ((wgid % nig) % gsz); u.pn = (wgid % nig) / gsz; return true;
    }
    __device__ __forceinline__ void a_ready(const Unit&) const {}
    __device__ __forceinline__ void done(const Unit&) const {}
};

__device__ __forceinline__ unsigned cvt_pk_bf16(float lo, float hi) { unsigned r; asm volatile("v_cvt_pk_bf16_f32 %0, %1, %2" : "=v"(r) : "v"(lo), "v"(hi)); return r; }
typedef float f32x2 __attribute__((ext_vector_type(2)));
__device__ __forceinline__ f32x2 gelu_pk(f32x2 v) {
    const f32x2 av = __builtin_elementwise_abs(v), d = av * 0.2316418882f + 1.0f;
    f32x2 t; t.x = __builtin_amdgcn_rcpf(d.x); t.y = __builtin_amdgcn_rcpf(d.y);
    f32x2 q = t * 0.5307027145f + (-0.7265760135f); q = q * t + 0.7107068705f; q = q * t + (-0.142248368f); q = q * t + 0.127414796f; q = q * t;
    const f32x2 s = (v * v) * (-0.72134752044f);
    f32x2 e; e.x = __builtin_amdgcn_exp2f(s.x); e.y = __builtin_amdgcn_exp2f(s.y);
    const f32x2 m = v * (q * e), r = v - m;
    f32x2 o; o.x = v.x < 0.f ? m.x : r.x; o.y = v.y < 0.f ? m.y : r.y; return o;
}

template <int ACT  > struct EpiBf16 {
    static constexpr bool PERM = true, AFTER_DRAIN = false; static_assert(ACT == 0 || ACT == 1, "EpiBf16: ACT is 0 (none) or 1 (gelu_pk)");
    bf16_t* O; int ldc; const float* bias; int split_cols; size_t split_stride; float scale0;
    __device__ __forceinline__ void operator()(const f32x4 (&acc)[2][2][4][2], const Unit& u, int wr, int wc, int fr, int fq) const {
        const int row0 = u.pm * BM + wr * 64 + fr; int colt = u.pn * BM; bf16_t* base = O;
        float sc = 1.f; if (split_cols) { const int t = colt / split_cols; base += (size_t)t * split_stride; colt -= t * split_cols; if (t == 0) sc = scale0; }
        const int col0 = colt + wc * 32 + 8 * fq, bcol0 = u.pn * BM + wc * 32 + 8 * fq;
        f32x4 bv[2][2];
#pragma unroll
        for (int bj = 0; bj < 2; ++bj)
#pragma unroll
            for (int n = 0; n < 2; ++n) bv[bj][n] = bias ? *(const f32x4*)(bias + bcol0 + bj * HALF + 4 * n) : (f32x4){0.f, 0.f, 0.f, 0.f};
#pragma unroll
        for (int ai = 0; ai < 2; ++ai)
#pragma unroll
            for (int m = 0; m < 4; ++m) { bf16_t* rowp = base + (size_t)(row0 + ai * HALF + m * 16) * ldc + col0;
#pragma unroll
                for (int bj = 0; bj < 2; ++bj) { f32x4 v0 = acc[ai][bj][m][0] + bv[bj][0], v1 = acc[ai][bj][m][1] + bv[bj][1];
                    if (ACT == 1) { f32x2 a = gelu_pk((f32x2){v0[0], v0[1]}), b = gelu_pk((f32x2){v0[2], v0[3]}), c = gelu_pk((f32x2){v1[0], v1[1]}), d = gelu_pk((f32x2){v1[2], v1[3]});
                        v0 = (f32x4){a.x, a.y, b.x, b.y}; v1 = (f32x4){c.x, c.y, d.x, d.y}; }
                    v0 = v0 * sc; v1 = v1 * sc; u32x4 w; w.x = cvt_pk_bf16(v0[0], v0[1]); w.y = cvt_pk_bf16(v0[2], v0[3]); w.z = cvt_pk_bf16(v1[0], v1[1]); w.w = cvt_pk_bf16(v1[2], v1[3]);
                    *(u32x4*)(rowp + bj * HALF) = w; } }
    }
};

struct PanelStats {
    unsigned* xbuf;
    unsigned* cnt;
    unsigned* tmo;
    int ntn; float eps;
    unsigned code;
    __device__ __forceinline__ bool run(const f32x4 (&v)[2][2][4][2], const Unit& u, int wr, int wc, int fr, int fq, PG8_LAS unsigned char* lds, int wid, int lane) const {
        typedef float f32x2v __attribute__((ext_vector_type(2)));
        PG8_LAS f32x2v* P = (PG8_LAS f32x2v*)lds;
        PG8_LAS f32x2v* S = (PG8_LAS f32x2v*)(lds + 8192);
        PG8_LAS unsigned* flag = (PG8_LAS unsigned*)(lds + 8192 + 2048);
#pragma unroll
        for (int ai = 0; ai < 2; ++ai)
#pragma unroll
            for (int m = 0; m < 4; ++m) {
                float s = 0.f;
#pragma unroll
                for (int bj = 0; bj < 2; ++bj)
#pragma unroll
                    for (int n = 0; n < 2; ++n) { const f32x4 x = v[ai][bj][m][n]; s += (x[0] + x[1]) + (x[2] + x[3]); }
                s += __shfl_xor(s, 16); s += __shfl_xor(s, 32);
                const float mw = s * (1.0f / 64.0f); float q = 0.f;
#pragma unroll
                for (int bj = 0; bj < 2; ++bj)
#pragma unroll
                    for (int n = 0; n < 2; ++n) { const f32x4 d = v[ai][bj][m][n] - mw; q += (d[0] * d[0] + d[1] * d[1]) + (d[2] * d[2] + d[3] * d[3]); }
                q += __shfl_xor(q, 16); q += __shfl_xor(q, 32);
                if (fq == 0) P[(ai * HALF + wr * 64 + m * 16 + fr) * 4 + wc] = (f32x2v){mw, q};
            }
        asm volatile("s_waitcnt lgkmcnt(0)" ::: "memory"); __builtin_amdgcn_s_barrier(); asm volatile("" ::: "memory");
#if defined(BROKEN_EXCHANGE_NO_WAIT)
#warning BROKEN CONTROL BUILD: the row-statistics exchange does not wait; results are wrong by design
        if (blockIdx.x >= 64) { const long long t0_ = clock64(); while (clock64() - t0_ < 60000) __builtin_amdgcn_s_sleep(8); }
#endif
        const int row = wid * 32 + (lane & 31);
        if (lane < 32) {
            const f32x2v a = P[row * 4 + 0], b = P[row * 4 + 1], c = P[row * 4 + 2], d = P[row * 4 + 3];
            const float mt = (a.x + b.x + c.x + d.x) * 0.25f;
            const float da = a.x - mt, db = b.x - mt, dc = c.x - mt, dd = d.x - mt;
            const float m2 = (a.y + b.y) + (c.y + d.y) + 64.0f * ((da * da + db * db) + (dc * dc + dd * dd));
            unsigned long long* slot = (unsigned long long*)xbuf + ((size_t)(u.pm * BM + row) * 4 + u.pn);
            __hip_atomic_store(slot, ((unsigned long long)__float_as_uint(m2) << 32) | __float_as_uint(mt), __ATOMIC_RELAXED, __HIP_MEMORY_SCOPE_AGENT);
        }
        asm volatile("s_waitcnt vmcnt(0)" ::: "memory");
        if (lane == 0) __hip_atomic_fetch_add(cnt + 64 * u.pm, 1u, __ATOMIC_RELAXED, __HIP_MEMORY_SCOPE_AGENT);
        if (wid == 0) {
            bool dead = false; const unsigned long long t0 = __builtin_amdgcn_s_memrealtime(); const unsigned want = 8u * (unsigned)ntn;
            for (;;) {
#if defined(BROKEN_EXCHANGE_NO_WAIT)
                break;
#endif
                if ((unsigned)__builtin_amdgcn_readfirstlane(__hip_atomic_load(cnt + 64 * u.pm, __ATOMIC_RELAXED, __HIP_MEMORY_SCOPE_AGENT)) >= want) break;
                if (__builtin_amdgcn_s_memrealtime() - t0 > 2000000ull) {
                    if (lane == 0) { unsigned expect = 0u; __hip_atomic_compare_exchange_strong(tmo + 1, &expect, code | (unsigned)(u.pm & 0xff), __ATOMIC_RELAXED, __ATOMIC_RELAXED, __HIP_MEMORY_SCOPE_AGENT);
                                     __hip_atomic_store(tmo, 1u, __ATOMIC_RELAXED, __HIP_MEMORY_SCOPE_AGENT); }
                    dead = true; break; }
                __builtin_amdgcn_s_sleep(2);
            }
            __builtin_amdgcn_fence(__ATOMIC_ACQUIRE, "agent");
            if (lane == 0) flag[0] = dead ? 1u : 0u;
        }
        asm volatile("s_waitcnt vmcnt(0) lgkmcnt(0)" ::: "memory"); __builtin_amdgcn_s_barrier(); asm volatile("" ::: "memory");
        const bool bad = flag[0] != 0u;
        if (lane < 32) {
            const unsigned long long* slot = (const unsigned long long*)xbuf + (size_t)(u.pm * BM + row) * 4; float mt[4], m2[4]; float ms = 0.f;
#pragma unroll
            for (int t = 0; t < 4; ++t) { if (t < ntn) { const unsigned long long w = __hip_atomic_load(slot + t, __ATOMIC_RELAXED, __HIP_MEMORY_SCOPE_AGENT); mt[t] = __uint_as_float((unsigned)w); m2[t] = __uint_as_float((unsigned)(w >> 32)); } else { mt[t] = 0.f; m2[t] = 0.f; } ms += mt[t]; }
            const float mean = ms / (float)ntn; float q = 0.f;
#pragma unroll
            for (int t = 0; t < 4; ++t) if (t < ntn) { const float dm = mt[t] - mean; q += m2[t] + 256.0f * dm * dm; }
            S[row] = (f32x2v){mean, 1.0f / sqrtf(q / (256.0f * (float)ntn) + eps)};
        }
        asm volatile("s_waitcnt lgkmcnt(0)" ::: "memory"); __builtin_amdgcn_s_barrier(); asm volatile("" ::: "memory");
        return bad;
    }
};
struct EpiLnRes {
    static constexpr bool PERM = false, AFTER_DRAIN = true;
    const float* base; float* out; int ldc; const float* bias; PanelStats st; unsigned poison;
    __device__ __forceinline__ void fused(f32x4 (&acc)[2][2][4][2], const Unit& u, int wr, int wc, int fr, int fq, PG8_LAS unsigned char* lds, int wid, int lane) const {
        typedef float f32x2v __attribute__((ext_vector_type(2)));
        const PG8_LAS f32x2v* S = (const PG8_LAS f32x2v*)(lds + 8192);
        const int col0 = u.pn * BM + wc * 32 + 4 * fq;
#pragma unroll
        for (int bj = 0; bj < 2; ++bj)
#pragma unroll
            for (int n = 0; n < 2; ++n) { const f32x4 bv = bias ? *(const f32x4*)(bias + col0 + bj * HALF + n * 16) : (f32x4){0.f, 0.f, 0.f, 0.f};
#pragma unroll
                for (int ai = 0; ai < 2; ++ai)
#pragma unroll
                    for (int m = 0; m < 4; ++m) acc[ai][bj][m][n] += bv; }
        f32x4 pre[4][2][2];
#pragma unroll
        for (int m = 0; m < 4; ++m) { const size_t off = (size_t)(u.pm * BM + wr * 64 + m * 16 + fr) * ldc + col0;
#pragma unroll
            for (int bj = 0; bj < 2; ++bj)
#pragma unroll
                for (int n = 0; n < 2; ++n) pre[m][bj][n] = *(const f32x4*)(base + off + bj * HALF + n * 16); }
        const bool bad = st.run(acc, u, wr, wc, fr, fq, lds, wid, lane) || poison != 0u;
        const float qnan = __builtin_nanf("");
#pragma unroll
        for (int ai = 0; ai < 2; ++ai)
#pragma unroll
            for (int m = 0; m < 4; ++m) { const int r = ai * HALF + wr * 64 + m * 16 + fr; const f32x2v sr = S[r]; const size_t off = (size_t)(u.pm * BM + r) * ldc + col0;
#pragma unroll
                for (int bj = 0; bj < 2; ++bj)
#pragma unroll
                    for (int n = 0; n < 2; ++n) { const f32x4 bs = ai == 0 ? pre[m][bj][n] : *(const f32x4*)(base + off + bj * HALF + n * 16); f32x4 o = bs + (acc[ai][bj][m][n] - sr.x) * sr.y;
                        if (bad) o = (f32x4){qnan, qnan, qnan, qnan}; *(f32x4*)(out + off + bj * HALF + n * 16) = o; }
                if (m & 1) asm volatile("" ::: "memory"); }
    }
};
struct EpiLnResLn {
    static constexpr bool PERM = false, AFTER_DRAIN = true;
    const float* base; float* out; bf16_t* xn; int ldc; const float* bias; PanelStats st1, st2; unsigned poison;
    __device__ __forceinline__ void fused(f32x4 (&acc)[2][2][4][2], const Unit& u, int wr, int wc, int fr, int fq, PG8_LAS unsigned char* lds, int wid, int lane) const {
        typedef float f32x2v __attribute__((ext_vector_type(2))); typedef unsigned u32x2v __attribute__((ext_vector_type(2)));
        const PG8_LAS f32x2v* S = (const PG8_LAS f32x2v*)(lds + 8192);
        const int col0 = u.pn * BM + wc * 32 + 4 * fq;
#pragma unroll
        for (int bj = 0; bj < 2; ++bj)
#pragma unroll
            for (int n = 0; n < 2; ++n) { const f32x4 bv = bias ? *(const f32x4*)(bias + col0 + bj * HALF + n * 16) : (f32x4){0.f, 0.f, 0.f, 0.f};
#pragma unroll
                for (int ai = 0; ai < 2; ++ai)
#pragma unroll
                    for (int m = 0; m < 4; ++m) acc[ai][bj][m][n] += bv; }
        bool bad = st1.run(acc, u, wr, wc, fr, fq, lds, wid, lane) || poison != 0u;
        const float qnan = __builtin_nanf("");
#pragma unroll
        for (int ai = 0; ai < 2; ++ai)
#pragma unroll
            for (int m = 0; m < 4; ++m) { const int r = ai * HALF + wr * 64 + m * 16 + fr; const f32x2v sr = S[r]; const size_t off = (size_t)(u.pm * BM + r) * ldc + col0;
#pragma unroll
                for (int bj = 0; bj < 2; ++bj)
#pragma unroll
                    for (int n = 0; n < 2; ++n) { const f32x4 bs = *(const f32x4*)(base + off + bj * HALF + n * 16); acc[ai][bj][m][n] = bs + (acc[ai][bj][m][n] - sr.x) * sr.y; }
                asm volatile("" : "+v"(acc[ai][0][m][0]), "+v"(acc[ai][0][m][1]), "+v"(acc[ai][1][m][0]), "+v"(acc[ai][1][m][1]));
                if (m & 1) asm volatile("" ::: "memory"); }
        const bool bad1 = bad;
        bad = st2.run(acc, u, wr, wc, fr, fq, lds, wid, lane) || bad;
#pragma unroll
        for (int ai = 0; ai < 2; ++ai)
#pragma unroll
            for (int m = 0; m < 4; ++m) { const int r = ai * HALF + wr * 64 + m * 16 + fr; const f32x2v sr = S[r]; const size_t off = (size_t)(u.pm * BM + r) * ldc + col0;
#pragma unroll
                for (int bj = 0; bj < 2; ++bj)
#pragma unroll
                    for (int n = 0; n < 2; ++n) { const f32x4 x1 = acc[ai][bj][m][n]; *(f32x4*)(out + off + bj * HALF + n * 16) = bad1 ? (f32x4){qnan, qnan, qnan, qnan} : x1;
                        const f32x4 o = (x1 - sr.x) * sr.y; u32x2v w; w.x = cvt_pk_bf16(o[0], o[1]); w.y = cvt_pk_bf16(o[2], o[3]);
                        if (bad) { w.x = 0x7fc07fc0u; w.y = 0x7fc07fc0u; } *(u32x2v*)(xn + off + bj * HALF + n * 16) = w; }
                asm volatile("" ::: "memory"); }
    }
};

template <class Epi, class Sched, bool ALIGN_EPI = false, bool SP2 = false>
__device__ __forceinline__ void gemm_phase(PG8_LAS unsigned char* lds, const Gemm g, const Sched& S, const Epi& E, const int tid) {
    const int wid = __builtin_amdgcn_readfirstlane(tid >> 6), lane = tid & 63, wr = wid >> 2, wc = wid & 3, fr = lane & 15, fq = lane >> 4;
    const int K = g.K, nt = K / BK;
    unsigned voffA[2], voffB[2];
#pragma unroll
    for (int i = 0; i < 2; ++i) { int R, C; stage_rc(tid * 16 + i * 8192, R, C); const int Rb = Epi::PERM ? ((R & ~31) + perm32(R & 31)) : R;
        voffA[i] = (unsigned)(R * K + C) * 2u; voffB[i] = (unsigned)(Rb * K + C) * 2u; }
    const size_t kstep = (size_t)(BK * 2);
    const size_t hstep = (size_t)HALF * K * 2;
    const size_t tstep = 2 * hstep;
    const unsigned ldsw = (unsigned)wid * 1024u;
    const int aoff = lds_byte(wr * 64 + fr, fq * 8), boff = lds_byte(wc * 32 + fr, fq * 8);
#define PG8_SA(b, h) (((b) * 2 + (h)) * HTB)
#define PG8_SB(b, h) ((4 + (b) * 2 + (h)) * HTB)
#define PG8_STAGE(bufoff, gbase, voff) do { _Pragma("unroll") for (int _i = 0; _i < 2; ++_i) \
        __builtin_amdgcn_global_load_lds((const unsigned*)((const char*)(gbase) + (voff)[_i]), (PG8_LAS unsigned*)(lds + (bufoff) + ldsw + _i * 8192), 16, 0, 0); } while (0)
#define PG8_LDA(dst, b, h) do { _Pragma("unroll") for (int m = 0; m < 4; ++m) _Pragma("unroll") for (int k = 0; k < 2; ++k) dst[m][k] = *(const PG8_LAS bf16x8*)(lds + PG8_SA(b, h) + aoff + m * 2048 + k * 1024); } while (0)
#define PG8_LDB(dst, b, h) do { _Pragma("unroll") for (int n = 0; n < 2; ++n) _Pragma("unroll") for (int k = 0; k < 2; ++k) dst[n][k] = *(const PG8_LAS bf16x8*)(lds + PG8_SB(b, h) + boff + n * 2048 + k * 1024); } while (0)
#define PG8_MMA(ai, bj, At, Bt) do { __builtin_amdgcn_s_setprio(1); _Pragma("unroll") for (int m = 0; m < 4; ++m) _Pragma("unroll") for (int n = 0; n < 2; ++n) _Pragma("unroll") for (int k = 0; k < 2; ++k) \
        acc[ai][bj][m][n] = __builtin_amdgcn_mfma_f32_16x16x32_bf16(Bt[n][k], At[m][k], acc[ai][bj][m][n], 0, 0, 0); __builtin_amdgcn_s_setprio(0); } while (0)
#define PG8_WAIT_V(n) asm volatile("s_waitcnt vmcnt(" #n ")" ::: "memory")
#define PG8_WAIT_L(n) asm volatile("s_waitcnt lgkmcnt(" #n ")" ::: "memory")
#define PG8_BAR __builtin_amdgcn_s_barrier()
#define PG8_SCHED __builtin_amdgcn_sched_barrier(0)
    Unit cur, nxt; int ui = 0;
    if (!S.next(0, cur)) return;
    f32x4 acc[2][2][4][2];
#pragma unroll
    for (int a = 0; a < 2; ++a)
#pragma unroll
        for (int b = 0; b < 2; ++b)
#pragma unroll
            for (int m = 0; m < 4; ++m)
#pragma unroll
                for (int n = 0; n < 2; ++n) acc[a][b][m][n] = (f32x4){0.f, 0.f, 0.f, 0.f};
    bf16x8 At[4][2], B0[2][2], B1[2][2];
    const char* cA = (const char*)g.A + (size_t)cur.pm * tstep; const char* cB = (const char*)g.Bt + (size_t)cur.pn * tstep;
    S.a_ready(cur);
    if constexpr (SP2) {
        PG8_STAGE(PG8_SB(0, 0), cB, voffB); PG8_STAGE(PG8_SB(0, 1), cB + hstep, voffB); PG8_STAGE(PG8_SA(0, 0), cA, voffA); PG8_STAGE(PG8_SA(0, 1), cA + hstep, voffA);
        if (wr == 1) PG8_BAR;
        PG8_WAIT_V(2); PG8_BAR;
        PG8_STAGE(PG8_SB(1, 0), cB + kstep, voffB); PG8_STAGE(PG8_SA(1, 0), cA + kstep, voffA); PG8_STAGE(PG8_SB(1, 1), cB + hstep + kstep, voffB);
        PG8_WAIT_V(6); PG8_BAR;
    } else {
        PG8_STAGE(PG8_SB(0, 0), cB, voffB); PG8_STAGE(PG8_SA(0, 0), cA, voffA); PG8_STAGE(PG8_SB(0, 1), cB + hstep, voffB); PG8_STAGE(PG8_SA(0, 1), cA + hstep, voffA);
        if (wr == 1) PG8_BAR;
        PG8_WAIT_V(4); PG8_BAR;
        PG8_STAGE(PG8_SB(1, 0), cB + kstep, voffB); PG8_STAGE(PG8_SA(1, 0), cA + kstep, voffA); PG8_STAGE(PG8_SB(1, 1), cB + hstep + kstep, voffB);
        PG8_WAIT_V(6); PG8_BAR;
    }
    for (;;) {
        const bool has_next = S.next(ui + 1, nxt);
        const char* nA = has_next ? (const char*)g.A + (size_t)nxt.pm * tstep : cA; const char* nB = has_next ? (const char*)g.Bt + (size_t)nxt.pn * tstep : cB;
        for (int t = 0; t < nt; t += 2) {
            const bool last = (t == nt - 2);
            const char* a1 = cA + (size_t)(t + 1) * kstep;
            const char* a2 = last ? nA : cA + (size_t)(t + 2) * kstep; const char* b2 = last ? nB : cB + (size_t)(t + 2) * kstep;
            const char* a3 = a2 + kstep; const char* b3 = b2 + kstep;
            if (last && has_next) S.a_ready(nxt);
            if constexpr (SP2) {
            PG8_LDB(B0, 0, 0); PG8_LDB(B1, 0, 1); PG8_SCHED; PG8_LDA(At, 0, 0); PG8_STAGE(PG8_SA(1, 1), a1 + hstep, voffA);
            PG8_WAIT_V(8); PG8_WAIT_L(0); PG8_BAR; PG8_MMA(0, 0, At, B0); PG8_MMA(0, 1, At, B1); PG8_BAR; PG8_SCHED;
            PG8_LDA(At, 0, 1); PG8_STAGE(PG8_SB(0, 0), b2, voffB); PG8_STAGE(PG8_SB(0, 1), b2 + hstep, voffB); PG8_STAGE(PG8_SA(0, 0), a2, voffA);
            PG8_WAIT_V(8); PG8_WAIT_L(0); PG8_BAR; PG8_MMA(1, 0, At, B0); PG8_MMA(1, 1, At, B1); PG8_BAR; PG8_SCHED;
            PG8_LDB(B0, 1, 0); PG8_LDB(B1, 1, 1); PG8_SCHED; PG8_LDA(At, 1, 0); PG8_STAGE(PG8_SA(0, 1), a2 + hstep, voffA);
            PG8_WAIT_V(8); PG8_WAIT_L(0); PG8_BAR; PG8_MMA(0, 0, At, B0); PG8_MMA(0, 1, At, B1); PG8_BAR; PG8_SCHED;
            PG8_LDA(At, 1, 1); PG8_STAGE(PG8_SB(1, 0), b3, voffB); PG8_STAGE(PG8_SB(1, 1), b3 + hstep, voffB); PG8_STAGE(PG8_SA(1, 0), a3, voffA);
            PG8_WAIT_V(8); PG8_WAIT_L(0); PG8_BAR; PG8_MMA(1, 0, At, B0); PG8_MMA(1, 1, At, B1); PG8_BAR; PG8_SCHED;
            } else {
            PG8_LDB(B0, 0, 0); PG8_SCHED; PG8_LDA(At, 0, 0); PG8_STAGE(PG8_SA(1, 1), a1 + hstep, voffA);
            PG8_WAIT_L(8); PG8_BAR; PG8_WAIT_L(0); PG8_MMA(0, 0, At, B0); PG8_BAR; PG8_SCHED;
            PG8_LDB(B1, 0, 1); PG8_STAGE(PG8_SB(0, 0), b2, voffB);
            PG8_BAR; PG8_WAIT_L(0); PG8_MMA(0, 1, At, B1); PG8_BAR;
            PG8_LDA(At, 0, 1); PG8_STAGE(PG8_SA(0, 0), a2, voffA);
            PG8_BAR; PG8_WAIT_L(0); PG8_MMA(1, 0, At, B0); PG8_BAR; PG8_SCHED;
            PG8_STAGE(PG8_SB(0, 1), b2 + hstep, voffB);
            PG8_WAIT_V(6); PG8_BAR; PG8_MMA(1, 1, At, B1); PG8_BAR;
            PG8_LDB(B0, 1, 0); PG8_SCHED; PG8_LDA(At, 1, 0); PG8_STAGE(PG8_SA(0, 1), a2 + hstep, voffA);
            PG8_WAIT_L(8); PG8_BAR; PG8_WAIT_L(0); PG8_MMA(0, 0, At, B0); PG8_BAR; PG8_SCHED;
            PG8_LDB(B1, 1, 1); PG8_STAGE(PG8_SB(1, 0), b3, voffB);
            PG8_BAR; PG8_WAIT_L(0); PG8_MMA(0, 1, At, B1); PG8_BAR;
            PG8_LDA(At, 1, 1); PG8_STAGE(PG8_SA(1, 0), a3, voffA);
            PG8_BAR; PG8_WAIT_L(0); PG8_MMA(1, 0, At, B0); PG8_BAR; PG8_SCHED;
            PG8_STAGE(PG8_SB(1, 1), b3 + hstep, voffB);
            PG8_WAIT_V(6); PG8_BAR; PG8_MMA(1, 1, At, B1); PG8_BAR;
            }
        }
        if constexpr (ALIGN_EPI) { if (wr == 0) PG8_BAR; }
        if constexpr (!Epi::AFTER_DRAIN) { E(acc, cur, wr, wc, fr, fq); S.done(cur); }
        if (!has_next) break;
#pragma unroll
        for (int a = 0; a < 2; ++a)
#pragma unroll
            for (int b = 0; b < 2; ++b)
#pragma unroll
                for (int m = 0; m < 4; ++m)
#pragma unroll
                    for (int n = 0; n < 2; ++n) acc[a][b][m][n] = (f32x4){0.f, 0.f, 0.f, 0.f};
        cur = nxt; cA = nA; cB = nB; ++ui;
        if constexpr (ALIGN_EPI) { if (wr == 1) PG8_BAR; }
    }
    PG8_WAIT_V(0);
    if constexpr (!ALIGN_EPI) { if (wr == 0) PG8_BAR; }
    PG8_BAR;
    if constexpr (Epi::AFTER_DRAIN) { E.fused(acc, cur, wr, wc, fr, fq, lds, wid, lane); S.done(cur); }
#undef PG8_SA
#undef PG8_SB
#undef PG8_STAGE
#undef PG8_LDA
#undef PG8_LDB
#undef PG8_MMA
#undef PG8_WAIT_V
#undef PG8_WAIT_L
#undef PG8_BAR
#undef PG8_SCHED
}
}

#define GAS __attribute__((address_space(1)))
#define LAS __attribute__((address_space(3)))
typedef unsigned short bf16;
typedef float f32x4 __attribute__((ext_vector_type(4)));
typedef float f32x16 __attribute__((ext_vector_type(16)));
typedef short bf16x8 __attribute__((ext_vector_type(8)));
typedef short s16x4 __attribute__((ext_vector_type(4)));
typedef unsigned u32x4 __attribute__((ext_vector_type(4)));
typedef unsigned u32x2 __attribute__((ext_vector_type(2)));
typedef float f32x2_t __attribute__((ext_vector_type(2)));
typedef __bf16 bf16x2_t __attribute__((ext_vector_type(2)));
typedef GAS unsigned gu32;
#define RLX_AGENT __ATOMIC_RELAXED, __HIP_MEMORY_SCOPE_AGENT

constexpr int D = 1024, BP = 4, TP = 4096, MP = BP * TP, BS = 128, TS = 8, MS = BS * TS, M = MP + MS;
constexpr int SBH = 8, HD = 64, SBW = 512, DNH = 4, DND = 128, DNW = 512;
constexpr int IN_COLS = 3592, NPROJ = 3584;
constexpr int DFF = 2816, DFF2 = 5632, NMOD = 6144, NC = BP + BS;
constexpr int PAST = 2048, NPAGES = 16, PAGE = 128;
constexpr float EPS = 1e-6f, LOG2E = 1.4426950408889634f;
constexpr float QSCALE = 0.125f * LOG2E;
constexpr int NSPLIT = 4, NPART = 5;

constexpr size_t O_YP = 0, O_KP = 17825792, O_VP = 26214400, O_KS = 34603008, O_VS = 35127296, O_SP = 35651584, O_SS = 35913728,
                 O_DCP = 44302336, O_DCS = 44320768, O_FCP = 44910592, O_FCS = 44955648, O_END = 46397440;

constexpr size_t MiB = 1u << 20;
constexpr size_t WS_CTL = 0, CTL_ZERO_BYTES = MiB;
constexpr size_t WS_MOD = 1 * MiB, WS_SC = 5 * MiB, WS_WINX = 6 * MiB, WS_WIN_T = 7 * MiB, WS_WOUT_T = 14 * MiB, WS_WUP_T = 16 * MiB, WS_WDN_T = 27 * MiB,
                 WS_EXTRA = 33 * MiB, WS_H = 34 * MiB, WS_DNRAW = 68 * MiB, WS_ZG = 120 * MiB, WS_QB = 306 * MiB, WS_KB = 323 * MiB, WS_VB = 340 * MiB, WS_QD = 357 * MiB, WS_KD = 391 * MiB,
                 WS_VD = 425 * MiB, WS_BETA = 459 * MiB, WS_LOGA = 460 * MiB, WS_ODN = 461 * MiB, WS_MIXED = 495 * MiB, WS_X1 = 529 * MiB, WS_UP = 597 * MiB,
                 WS_ACT = 784 * MiB, WS_U = 878 * MiB, WS_KCUM = 910 * MiB, WS_QDEC = 926 * MiB, WS_KDECT = 942 * MiB, WS_INTRA = 958 * MiB, WS_GL = 966 * MiB,
                 WS_OPART = 967 * MiB, WS_LPART = 978 * MiB, WS_END = 979 * MiB;
constexpr int CW_QUEUE = 64;
constexpr int CW_BAR = 4096;

constexpr int RING_BYTES = 131072, MISC_OFF = RING_BYTES + 320, LDS_BYTES = 147456;

__device__ __forceinline__ unsigned cvtpk(float lo, float hi) { f32x2_t v = {lo, hi}; bf16x2_t b = __builtin_convertvector(v, bf16x2_t); return __builtin_bit_cast(unsigned, b); }
__device__ __forceinline__ bf16 f2bf(float f) { return (bf16)(cvtpk(f, 0.f) & 0xffffu); }
__device__ __forceinline__ float wave_sum(float v) {
#pragma unroll
    for (int o = 1; o < 64; o <<= 1) v += __shfl_xor(v, o);
    return v;
}
__device__ __forceinline__ float siluf(float x) { return x / (1.f + __expf(-x)); }
__device__ __forceinline__ u32x4 pack8(const f32x4 a, const f32x4 b) { u32x4 w; w.x = cvtpk(a.x, a.y); w.y = cvtpk(a.z, a.w); w.z = cvtpk(b.x, b.y); w.w = cvtpk(b.z, b.w); return w; }
__device__ __forceinline__ float bf2f(unsigned short h) { return __uint_as_float((unsigned)h << 16); }

#define XB_TMO      128
#define XB_XCNT(j)  (256  + 64 * (j))
#define XB_XSUB(j)  (1280 + 64 * (j))
#define XB_XGEN(j)  (2304 + 64 * (j))
#define XB_TOP      3328
#define XB_TOPGEN   3392
#define XCD_BAR_WORDS 3456
#define XB_SPIN_CAP (1u << 18)
__device__ __forceinline__ unsigned xb_ld(unsigned* p)              { return __hip_atomic_load(p, __ATOMIC_RELAXED, __HIP_MEMORY_SCOPE_AGENT); }
__device__ __forceinline__ unsigned xb_add(unsigned* p, unsigned v) { return __hip_atomic_fetch_add(p, v, __ATOMIC_RELAXED, __HIP_MEMORY_SCOPE_AGENT); }
__device__ __forceinline__ unsigned xb_xcc_id() { return (unsigned)__builtin_amdgcn_s_getreg((3 << 11) | 20) & 0xFu; }
#define XB_SPIN(cond, bar) do { unsigned _sp = 0; while (cond) { __builtin_amdgcn_s_sleep(1); \
    if ((++_sp & 255u) == 0u) { if (xb_ld(&(bar)[XB_TMO])) break; if (_sp > XB_SPIN_CAP) { atomicAdd(&(bar)[XB_TMO], 1u); break; } } } } while (0)
struct XcdBarrier { unsigned* bar; unsigned x; volatile LAS unsigned* st; };
__device__ __forceinline__ XcdBarrier xcd_barrier_post(unsigned* bar, volatile LAS unsigned* st, int tid) {
    XcdBarrier b; b.bar = bar; b.x = xb_xcc_id(); b.st = st;
    if (tid == 0) (void)xb_add(&bar[XB_XCNT(b.x)], 1u);
    return b;
}
__device__ __forceinline__ void xcd_barrier_complete(unsigned* bar, unsigned x, unsigned& nloc, unsigned& nx) {
    const unsigned G = gridDim.x * gridDim.y * gridDim.z;
    unsigned sum, cnt, mine, sp = 0u;
    for (;;) {
        sum = 0u; cnt = 0u; mine = 0u;
#pragma unroll
        for (unsigned j = 0; j < 16; ++j) { const unsigned c = xb_ld(&bar[XB_XCNT(j)]); sum += c; cnt += (c > 0u) ? 1u : 0u; mine = (j == x) ? c : mine; }
        if (sum == G) break;
        __builtin_amdgcn_s_sleep(1);
        if ((++sp & 255u) == 0u) { if (xb_ld(&bar[XB_TMO])) break; if (sp > XB_SPIN_CAP) { atomicAdd(&bar[XB_TMO], 1u); break; } }
    }
    nloc = mine > 0u ? mine : 1u; nx = cnt > 0u ? cnt : 1u;
}
__device__ __forceinline__ void xcd_barrier(const XcdBarrier& b, int tid) {
    asm volatile("s_waitcnt vmcnt(0)" ::: "memory");
    __syncthreads();
    if (tid == 0) {
        unsigned* bar = b.bar;
        __builtin_amdgcn_s_waitcnt(0);
        unsigned nloc = b.st[0], nx = b.st[1];
        if (nloc == 0u) { xcd_barrier_complete(bar, b.x, nloc, nx); b.st[0] = nloc; b.st[1] = nx; }
        const unsigned old = xb_add(&bar[XB_XSUB(b.x)], 1u);
        const unsigned gen = old / nloc;
        if (old + 1u == (gen + 1u) * nloc) {
            __builtin_amdgcn_fence(__ATOMIC_RELEASE, "agent");
            asm volatile("s_waitcnt vmcnt(0)" ::: "memory");
            const unsigned og = xb_add(&bar[XB_TOP], 1u);
            const unsigned tg = og / nx;
            if (og + 1u == (tg + 1u) * nx) xb_add(&bar[XB_TOPGEN], 1u);
            else XB_SPIN(xb_ld(&bar[XB_TOPGEN]) == tg, bar);
            __builtin_amdgcn_fence(__ATOMIC_ACQUIRE, "agent");
            xb_add(&bar[XB_XGEN(b.x)], 1u);
            asm volatile("s_waitcnt vmcnt(0)" ::: "memory");
        } else {
            XB_SPIN(xb_ld(&bar[XB_XGEN(b.x)]) == gen, bar);
            __builtin_amdgcn_fence(__ATOMIC_ACQUIRE, "agent");
            asm volatile("s_waitcnt vmcnt(0)" ::: "memory");
        }
    }
    __syncthreads();
}

__device__ __forceinline__ int lane_now() { int l; asm volatile("v_mbcnt_lo_u32_b32 %0, -1, 0\n\tv_mbcnt_hi_u32_b32 %0, -1, %0" : "=v"(l)); return l; }
struct Args { const void* in[27]; float* out; unsigned char* ws; int lo, hi; };
enum { I_XP = 0, I_XS, I_CP, I_CS, I_CK, I_CV, I_PT, I_SD, I_SDC, I_SFC, I_WADA, I_BADA, I_GATT, I_WIN, I_GQ, I_GK, I_SBB, I_GSBO, I_WDNC, I_ALOG, I_DTB, I_GDNO, I_WOUT, I_GFFN, I_WUP, I_WFC, I_WDN };

__device__ __forceinline__ int mod_row(int m) { return m < MP ? (m >> 12) : BP + ((m - MP) >> 3); }

struct EpiF32 {
    static constexpr bool PERM = false, AFTER_DRAIN = false;
    float* O; int ldc;
    __device__ __forceinline__ void operator()(const pg8::f32x4 (&acc)[2][2][4][2], const pg8::Unit& u, int wr, int wc, int fr, int fq) const {
        const int row0 = u.pm * 256 + wr * 64 + fr, col0 = u.pn * 256 + wc * 32 + 4 * fq;
#pragma unroll
        for (int ai = 0; ai < 2; ++ai)
#pragma unroll
            for (int m = 0; m < 4; ++m) { float* rowp = O + (size_t)(row0 + ai * 128 + m * 16) * ldc + col0;
#pragma unroll
                for (int bj = 0; bj < 2; ++bj)
#pragma unroll
                    for (int n = 0; n < 2; ++n) *(pg8::f32x4*)(rowp + bj * 128 + n * 16) = acc[ai][bj][m][n]; }
    }
};
struct EpiResGate {
    static constexpr bool PERM = false, AFTER_DRAIN = false;
    const float* base0; const float* base1; const float* mod; int goff; float* out;
    __device__ __forceinline__ void operator()(const pg8::f32x4 (&acc)[2][2][4][2], const pg8::Unit& u, int wr, int wc, int fr, int fq) const {
        const int row0 = u.pm * 256 + wr * 64 + fr, col0 = u.pn * 256 + wc * 32 + 4 * fq;
#pragma unroll
        for (int ai = 0; ai < 2; ++ai)
#pragma unroll
            for (int m = 0; m < 4; ++m) { const int r = row0 + ai * 128 + m * 16;
                const float* bp = (r < MP ? base0 + (size_t)r * D : base1 + (size_t)(r - MP) * D) + col0;
                const float* gp = mod + (size_t)mod_row(r) * NMOD + goff + col0; float* op = out + (size_t)r * D + col0;
#pragma unroll
                for (int bj = 0; bj < 2; ++bj)
#pragma unroll
                    for (int n = 0; n < 2; ++n) { const pg8::f32x4 b = *(const pg8::f32x4*)(bp + bj * 128 + n * 16), g = *(const pg8::f32x4*)(gp + bj * 128 + n * 16);
                        *(pg8::f32x4*)(op + bj * 128 + n * 16) = b + g * acc[ai][bj][m][n]; } }
    }
};

__device__ __forceinline__ void st16(void* base, unsigned off, u32x4 v) { *(u32x4*)((unsigned char*)base + off) = v; }
__device__ __forceinline__ void st16f(void* base, unsigned off, pg8::f32x4 v) { *(pg8::f32x4*)((unsigned char*)base + off) = v; }
struct EpiProj {
    static constexpr bool PERM = true, AFTER_DRAIN = false;
    float* out; bf16* QB; bf16* KB; bf16* VB; bf16* DNRAW; bf16* ZG; const float* g_q; const float* g_k; LAS float* xl;
    __device__ __forceinline__ void operator()(const pg8::f32x4 (&acc)[2][2][4][2], const pg8::Unit& u, int wr, int wc, int fr, int fq) const {
        const int pn = u.pn, rl0 = wr * 64 + fr, c0 = wc * 32 + 8 * fq;
        const unsigned row0 = (unsigned)u.pm * 256u + (unsigned)rl0;
        const bool prompt_tile = u.pm < MP / 256;
        if (pn < 4) {
            int xb = (rl0 * 8 + wc) * 4, xb2 = (rl0 * 8 + (wc ^ 1)) * 4; asm volatile("" : "+v"(xb), "+v"(xb2));
            LAS float* xw = (LAS float*)((LAS unsigned char*)xl + xb); const LAS float* xr = (const LAS float*)((LAS unsigned char*)xl + xb2);
#pragma unroll
            for (int ai = 0; ai < 2; ++ai)
#pragma unroll
                for (int m = 0; m < 4; ++m)
#pragma unroll
                    for (int bj = 0; bj < 2; ++bj) { const pg8::f32x4 a = acc[ai][bj][m][0], b = acc[ai][bj][m][1];
                        float ss = (a[0] * a[0] + a[1] * a[1]) + (a[2] * a[2] + a[3] * a[3]) + (b[0] * b[0] + b[1] * b[1]) + (b[2] * b[2] + b[3] * b[3]);
                        ss += __shfl_xor(ss, 16); ss += __shfl_xor(ss, 32);
                        if (fq == 0) xw[(ai * 128 + m * 16) * 8 + bj * 4] = ss; }
            asm volatile("s_waitcnt lgkmcnt(0)" ::: "memory"); __builtin_amdgcn_s_barrier(); asm volatile("" ::: "memory");
            const bool isq = pn < 2; const float* g = isq ? g_q : g_k; const int dloc = 32 * (wc & 1) + 8 * fq;
            const pg8::f32x4 g0 = *(const pg8::f32x4*)(g + dloc), g1 = *(const pg8::f32x4*)(g + dloc + 4);
            bf16* dstb = isq ? QB : KB; float* dstf = prompt_tile ? out + O_KP : out + O_KS - (size_t)MP * SBW;
#pragma unroll
            for (int ai = 0; ai < 2; ++ai)
#pragma unroll
                for (int m = 0; m < 4; ++m) { const unsigned row = row0 + ai * 128 + m * 16;
#pragma unroll
                    for (int bj = 0; bj < 2; ++bj) { const float tot = xw[(ai * 128 + m * 16) * 8 + bj * 4] + xr[(ai * 128 + m * 16) * 8 + bj * 4];
                        const float rs = (isq ? QSCALE : 1.0f) / sqrtf(tot * (1.f / HD) + EPS);
                        const pg8::f32x4 a = acc[ai][bj][m][0] * rs * g0, b = acc[ai][bj][m][1] * rs * g1;
                        const unsigned e = row * SBW + (unsigned)((pn & 1) * 256 + bj * 128 + c0);
                        st16(dstb, e * 2u, pack8(a, b));
                        if (!isq) { st16f(dstf, e * 4u, a); st16f(dstf, e * 4u + 16u, b); } }
                    asm volatile("" ::: "memory"); }
            asm volatile("s_waitcnt lgkmcnt(0)" ::: "memory"); __builtin_amdgcn_s_barrier(); asm volatile("" ::: "memory");
        } else if (pn < 6) {
            float* dstf = prompt_tile ? out + O_VP : out + O_VS - (size_t)MP * SBW;
#pragma unroll
            for (int ai = 0; ai < 2; ++ai)
#pragma unroll
                for (int m = 0; m < 4; ++m) { const unsigned row = row0 + ai * 128 + m * 16;
#pragma unroll
                    for (int bj = 0; bj < 2; ++bj) { const pg8::f32x4 a = acc[ai][bj][m][0], b = acc[ai][bj][m][1]; const unsigned e = row * SBW + (unsigned)((pn & 1) * 256 + bj * 128 + c0);
                        st16(VB, e * 2u, pack8(a, b)); st16f(dstf, e * 4u, a); st16f(dstf, e * 4u + 16u, b); }
                    asm volatile("" ::: "memory"); }
        } else if (pn < 12) {
#pragma unroll
            for (int ai = 0; ai < 2; ++ai)
#pragma unroll
                for (int m = 0; m < 4; ++m) { const unsigned row = row0 + ai * 128 + m * 16;
                    const int b = prompt_tile ? (int)(row >> 12) : (int)((row - MP) >> 3), t = prompt_tile ? (int)(row & 4095) : (int)((row - MP) & 7), idx = prompt_tile ? t - (TP - 3) : t - (TS - 3);
#pragma unroll
                    for (int bj = 0; bj < 2; ++bj) { const pg8::f32x4 a = acc[ai][bj][m][0], b2 = acc[ai][bj][m][1]; const unsigned ch = (unsigned)((pn - 6) * 256 + bj * 128 + c0);
                        st16(DNRAW, (row * 1536u + ch) * 2u, pack8(a, b2));
                        if (idx >= 0) { float* o = prompt_tile ? out + O_DCP : out + O_DCS; const unsigned eo = ((unsigned)(b * 3 + idx) * 1536u + ch) * 4u; st16f(o, eo, a); st16f(o, eo + 16u, b2); } }
                    asm volatile("" ::: "memory"); }
        } else {
#pragma unroll
            for (int ai = 0; ai < 2; ++ai)
#pragma unroll
                for (int m = 0; m < 4; ++m) { const unsigned row = row0 + ai * 128 + m * 16;
#pragma unroll
                    for (int bj = 0; bj < 2; ++bj) { pg8::f32x4 a = acc[ai][bj][m][0], b = acc[ai][bj][m][1]; const unsigned e = row * DNW + (unsigned)((pn - 12) * 256 + bj * 128 + c0);
                        a[0] = siluf(a[0]); a[1] = siluf(a[1]); a[2] = siluf(a[2]); a[3] = siluf(a[3]); b[0] = siluf(b[0]); b[1] = siluf(b[1]); b[2] = siluf(b[2]); b[3] = siluf(b[3]);
                        st16(ZG, e * 2u, pack8(a, b)); }
                    asm volatile("" ::: "memory"); }
        }
    }
};

__device__ __forceinline__ void transpose_item(const float* W, int ldw, int src_col0, bf16* WT, int Kdst, int dst_row0, int k0, LAS float* scr, int lane) {
#pragma unroll 8
    for (int i = 0; i < 32; ++i) { const int kk = 2 * i + (lane >> 5); scr[kk * 33 + (lane & 31)] = W[(size_t)(k0 + kk) * ldw + src_col0 + (lane & 31)]; }
    asm volatile("s_waitcnt lgkmcnt(0)" ::: "memory");
    const int c = lane & 7;
#pragma unroll
    for (int j = 0; j < 4; ++j) { const int n = (lane >> 3) + 8 * j; const LAS float* s = scr + (8 * c) * 33 + n;
        u32x4 o; o.x = cvtpk(s[0 * 33], s[1 * 33]); o.y = cvtpk(s[2 * 33], s[3 * 33]); o.z = cvtpk(s[4 * 33], s[5 * 33]); o.w = cvtpk(s[6 * 33], s[7 * 33]);
        *(u32x4*)(WT + (size_t)(dst_row0 + n) * Kdst + k0 + 8 * c) = o; }
    asm volatile("s_waitcnt lgkmcnt(0)" ::: "memory");
}
__device__ __forceinline__ void phase_prologue(const Args& A, LAS unsigned char* lds, int gw, int NGW, int wave, int lane, int gtid, int NGT) {
    unsigned char* ws = A.ws;
    LAS float* scr = (LAS float*)(lds + wave * 16384);
    const float* w_in = (const float*)A.in[I_WIN]; const float* w_out = (const float*)A.in[I_WOUT]; const float* w_up = (const float*)A.in[I_WUP]; const float* w_dn = (const float*)A.in[I_WDN];
    constexpr int I_IN = 16 * (NPROJ / 32), I_OUT = 16 * 32, I_UP = 16 * (DFF2 / 32), I_DN = (DFF / 64) * 32, NIT = I_IN + I_OUT + I_UP + I_DN;
    for (int it = gw; it < NIT; it += NGW) {
        int r = it;
        if (r < I_IN) { const int nb = r % (NPROJ / 32), kb = r / (NPROJ / 32); const int n0 = nb * 32; transpose_item(w_in, IN_COLS, n0 < 3072 ? n0 : n0 + 8, (bf16*)(ws + WS_WIN_T), D, n0, kb * 64, scr, lane); continue; } r -= I_IN;
        if (r < I_OUT) { const int nb = r % 32, kb = r / 32; transpose_item(w_out, D, nb * 32, (bf16*)(ws + WS_WOUT_T), D, nb * 32, kb * 64, scr, lane); continue; } r -= I_OUT;
        if (r < I_UP) { const int nb = r % (DFF2 / 32), kb = r / (DFF2 / 32); transpose_item(w_up, DFF2, nb * 32, (bf16*)(ws + WS_WUP_T), D, nb * 32, kb * 64, scr, lane); continue; } r -= I_UP;
        { const int nb = r % 32, kb = r / 32; transpose_item(w_dn, D, nb * 32, (bf16*)(ws + WS_WDN_T), DFF, nb * 32, kb * 64, scr, lane); }
    }
    bf16* SC = (bf16*)(ws + WS_SC); const float* cp = (const float*)A.in[I_CP]; const float* cs = (const float*)A.in[I_CS];
    for (int i = gtid; i < 144 * D; i += NGT) { const int r = i >> 10, k = i & 1023; float v = 0.f; if (r < BP) v = cp[r * D + k]; else if (r < NC) v = cs[(r - BP) * D + k]; SC[i] = (r < NC) ? f2bf(siluf(v)) : (bf16)0; }
    float* WX = (float*)(ws + WS_WINX);
    for (int i = gtid; i < 8 * D; i += NGT) { const int j = i >> 10, k = i & 1023; WX[i] = w_in[(size_t)k * IN_COLS + 3072 + j]; }
}

__device__ __forceinline__ void phase_mod(const Args& A, int gw, int NGW, int lane) {
    const float* w_ada = (const float*)A.in[I_WADA]; const float* b_ada = (const float*)A.in[I_BADA];
    const bf16* SC = (const bf16*)(A.ws + WS_SC); float* MOD = (float*)(A.ws + WS_MOD);
    const int lr = lane & 15, q = lane >> 4;
    for (int it = gw; it < NMOD / 16; it += NGW) {
        const int col = it * 16 + lr;
        pg8::f32x4 acc[9];
#pragma unroll
        for (int i = 0; i < 9; ++i) acc[i] = (pg8::f32x4){0.f, 0.f, 0.f, 0.f};
#pragma unroll 2
        for (int s = 0; s < 32; ++s) {
            const float* wp = w_ada + (size_t)(32 * s + 8 * q) * NMOD + col;
            float w[8];
#pragma unroll
            for (int j = 0; j < 8; ++j) w[j] = wp[(size_t)j * NMOD];
            u32x4 bw; bw.x = cvtpk(w[0], w[1]); bw.y = cvtpk(w[2], w[3]); bw.z = cvtpk(w[4], w[5]); bw.w = cvtpk(w[6], w[7]);
            const bf16x8 bfr = __builtin_bit_cast(bf16x8, bw);
#pragma unroll
            for (int i = 0; i < 9; ++i) { const bf16x8 a = *(const bf16x8*)(SC + (size_t)(16 * i + lr) * D + 32 * s + 8 * q); acc[i] = __builtin_amdgcn_mfma_f32_16x16x32_bf16(a, bfr, acc[i], 0, 0, 0); }
        }
        const float bb = b_ada[col];
#pragma unroll
        for (int i = 0; i < 9; ++i)
#pragma unroll
            for (int r = 0; r < 4; ++r) { const int row = 16 * i + 4 * q + r; if (row < NC) MOD[(size_t)row * NMOD + col] = acc[i][r] + bb; }
    }
}

template <bool EXTRAS>
__device__ __forceinline__ void phase_norm(const float* x0, const float* x1, const float* g, const float* MOD, int sh_off, int sc_off, bf16* H, const float* WX, float* EXTRA, int gw, int NGW, int lane) {
    for (int m = gw; m < M; m += NGW) {
        const float* xr = m < MP ? x0 + (size_t)m * D : x1 + (size_t)(m - MP) * D;
        const float* mod = MOD + (size_t)mod_row(m) * NMOD;
        f32x4 v[4]; float ss = 0.f;
#pragma unroll
        for (int j = 0; j < 4; ++j) { v[j] = *(const f32x4*)(xr + 4 * (lane + 64 * j)); ss += (v[j].x * v[j].x + v[j].y * v[j].y) + (v[j].z * v[j].z + v[j].w * v[j].w); }
        ss = wave_sum(ss);
        const float rstd = 1.0f / sqrtf(ss * (1.f / D) + EPS);
        float ex[8];
#pragma unroll
        for (int e = 0; e < 8; ++e) ex[e] = 0.f;
#pragma unroll
        for (int j = 0; j < 4; ++j) { const int c = 4 * (lane + 64 * j);
            const f32x4 gg = *(const f32x4*)(g + c), sc = *(const f32x4*)(mod + sc_off + c), sh = *(const f32x4*)(mod + sh_off + c);
            const f32x4 h = (v[j] * rstd) * gg * (sc + 1.0f) + sh;
            u32x2 w; w.x = cvtpk(h.x, h.y); w.y = cvtpk(h.z, h.w); *(u32x2*)(H + (size_t)m * D + c) = w;
            if (EXTRAS) {
#pragma unroll
                for (int e = 0; e < 8; ++e) { const f32x4 wx = *(const f32x4*)(WX + e * D + c); ex[e] += (h.x * wx.x + h.y * wx.y) + (h.z * wx.z + h.w * wx.w); }
            }
        }
        if (EXTRAS) {
#pragma unroll
            for (int e = 0; e < 8; ++e) ex[e] = wave_sum(ex[e]);
            float mine = ex[0];
#pragma unroll
            for (int e = 1; e < 8; ++e) mine = (lane == e) ? ex[e] : mine;
            if (lane < 8) EXTRA[(size_t)m * 8 + lane] = mine;
        }
    }
}

__device__ __forceinline__ f32x4 bf4lo(u32x4 w) { return (f32x4){__uint_as_float(w.x << 16), __uint_as_float(w.x & 0xffff0000u), __uint_as_float(w.y << 16), __uint_as_float(w.y & 0xffff0000u)}; }
__device__ __forceinline__ f32x4 bf4hi(u32x4 w) { return (f32x4){__uint_as_float(w.z << 16), __uint_as_float(w.z & 0xffff0000u), __uint_as_float(w.w << 16), __uint_as_float(w.w & 0xffff0000u)}; }
__device__ __forceinline__ void phase_post(const Args& A, int gw, int NGW, int lane) {
    unsigned char* ws = A.ws; const bf16* DNRAW = (const bf16*)(ws + WS_DNRAW);
    const float* wc = (const float*)A.in[I_WDNC];
    const float* sdc = (const float*)A.in[I_SDC]; const float* a_log = (const float*)A.in[I_ALOG]; const float* dtb = (const float*)A.in[I_DTB];
    float* QD = (float*)(ws + WS_QD); float* KD = (float*)(ws + WS_KD); float* VD = (float*)(ws + WS_VD);
    float* BETA = (float*)(ws + WS_BETA); float* LOGA = (float*)(ws + WS_LOGA); const float* EXTRA = (const float*)(ws + WS_EXTRA);
    const int c8 = 8 * lane;
    for (int m = gw; m < M; m += NGW) {
        const bool prompt = m < MP; const int b = prompt ? (m >> 12) : ((m - MP) >> 3), t = prompt ? (m & 4095) : ((m - MP) & 7);
        const bf16* pr = DNRAW + (size_t)m * 1536;
#pragma unroll
        for (int part = 0; part < 3; ++part) {
            const int ch = part * 512 + c8;
            f32x4 y0 = (f32x4){0.f, 0.f, 0.f, 0.f}, y1 = y0;
#pragma unroll
            for (int i = 0; i < 4; ++i) {
                const int tt = t - 3 + i;
                f32x4 x0, x1;
                if (tt >= 0) { const u32x4 w = *(const u32x4*)(pr - (size_t)(3 - i) * 1536 + ch); x0 = bf4lo(w); x1 = bf4hi(w); }
                else if (!prompt) { const float* p = sdc + ((size_t)b * 3 + (3 + tt)) * 1536 + ch; x0 = *(const f32x4*)p; x1 = *(const f32x4*)(p + 4); }
                else { x0 = (f32x4){0.f, 0.f, 0.f, 0.f}; x1 = x0; }
                const f32x4 w0 = *(const f32x4*)(wc + i * 1536 + ch), w1 = *(const f32x4*)(wc + i * 1536 + ch + 4);
                y0 += w0 * x0; y1 += w1 * x1;
            }
            y0.x = siluf(y0.x); y0.y = siluf(y0.y); y0.z = siluf(y0.z); y0.w = siluf(y0.w); y1.x = siluf(y1.x); y1.y = siluf(y1.y); y1.z = siluf(y1.z); y1.w = siluf(y1.w);
            if (part < 2) {
                float ss = (y0.x * y0.x + y0.y * y0.y) + (y0.z * y0.z + y0.w * y0.w) + (y1.x * y1.x + y1.y * y1.y) + (y1.z * y1.z + y1.w * y1.w);
                ss += __shfl_xor(ss, 1); ss += __shfl_xor(ss, 2); ss += __shfl_xor(ss, 4); ss += __shfl_xor(ss, 8);
                const float rs = (part == 0 ? 0.08838834764831845f : 1.0f) / sqrtf(ss + EPS);
                y0 = y0 * rs; y1 = y1 * rs;
            }
            float* dst = (part == 0 ? QD : part == 1 ? KD : VD) + (size_t)m * DNW + c8;
            *(f32x4*)dst = y0; *(f32x4*)(dst + 4) = y1;
        }
        if (lane < 8) {
            const float x = EXTRA[(size_t)m * 8 + lane];
            if (lane < 4) BETA[(size_t)m * 4 + lane] = 1.f / (1.f + __expf(-x));
            else { const int h = lane - 4; const float z = x + dtb[h]; const float sp = fmaxf(z, 0.f) + log1pf(__expf(-fabsf(z))); LOGA[(size_t)m * 4 + h] = -__expf(a_log[h]) * sp; }
        }
    }
}

template <int I0, int I1> __device__ __forceinline__ void subst_rows(float (&x)[64], const LAS float* Am, const LAS float* gs, bool kpart) {
#pragma unroll
    for (int i = I0; i < I1; ++i) {
        float r = x[i];
#pragma unroll
        for (int j4 = 0; j4 < (i & ~3); j4 += 4) { const f32x4 a = *(const LAS f32x4*)(Am + i * 64 + j4); r -= a.x * x[j4]; r -= a.y * x[j4 + 1]; r -= a.z * x[j4 + 2]; r -= a.w * x[j4 + 3]; }
#pragma unroll
        for (int j = (i & ~3); j < i; ++j) r -= Am[i * 64 + j] * x[j];
        x[i] = r;
    }
}
__device__ __forceinline__ void dn_prescan_unit(const Args& A, LAS unsigned char* lds, int unit, int tid, int wave, int lane) {
    unsigned char* ws = A.ws;
    const float* QD = (const float*)(ws + WS_QD); const float* KD = (const float*)(ws + WS_KD); const float* VD = (const float*)(ws + WS_VD);
    const float* BETA = (const float*)(ws + WS_BETA); const float* LOGA = (const float*)(ws + WS_LOGA);
    const int hp = unit & 1, n = (unit >> 1) & 63, b = unit >> 7;
    const int half = tid >> 8, ht = tid & 255, h = 2 * hp + half, item = (b * 64 + n) * 4 + h;
    const int m0 = b * TP + n * 64;
    LAS float* Am = (LAS float*)lds + half * 4096;
    LAS float* gs = (LAS float*)(lds + 32768) + half * 128;
    if (ht < 64) {
        float v = LOGA[(size_t)(m0 + ht) * 4 + h];
#pragma unroll
        for (int o = 1; o < 64; o <<= 1) { const float u = __shfl_up(v, o); if (ht >= o) v += u; }
        gs[ht] = v; gs[64 + ht] = BETA[(size_t)(m0 + ht) * 4 + h];
    }
    __syncthreads();
    {
        const int wl = wave & 3, lr = lane & 15, q = lane >> 4;
        pg8::f32x4 kk[4], qk[4];
#pragma unroll
        for (int j = 0; j < 4; ++j) { kk[j] = (pg8::f32x4){0.f, 0.f, 0.f, 0.f}; qk[j] = kk[j]; }
#pragma unroll
        for (int s = 0; s < 4; ++s) {
            const float* kp = KD + (size_t)(m0 + 16 * wl + lr) * DNW + h * 128 + 32 * s + 8 * q; const float* qp = QD + (size_t)(m0 + 16 * wl + lr) * DNW + h * 128 + 32 * s + 8 * q;
            const bf16x8 ak = __builtin_bit_cast(bf16x8, pack8(*(const f32x4*)kp, *(const f32x4*)(kp + 4))), aq = __builtin_bit_cast(bf16x8, pack8(*(const f32x4*)qp, *(const f32x4*)(qp + 4)));
#pragma unroll
            for (int j = 0; j < 4; ++j) { const float* bp = KD + (size_t)(m0 + 16 * j + lr) * DNW + h * 128 + 32 * s + 8 * q;
                const bf16x8 bk = __builtin_bit_cast(bf16x8, pack8(*(const f32x4*)bp, *(const f32x4*)(bp + 4)));
                kk[j] = __builtin_amdgcn_mfma_f32_16x16x32_bf16(ak, bk, kk[j], 0, 0, 0); qk[j] = __builtin_amdgcn_mfma_f32_16x16x32_bf16(aq, bk, qk[j], 0, 0, 0); }
        }
        bf16* INTRA = (bf16*)(ws + WS_INTRA) + (size_t)item * 4096;
#pragma unroll
        for (int j = 0; j < 4; ++j)
#pragma unroll
            for (int r = 0; r < 4; ++r) { const int i = 16 * wl + 4 * q + r, jj = 16 * j + lr;
                const float dec = (i >= jj) ? __expf(gs[i] - gs[jj]) : 0.f;
                Am[i * 64 + jj] = (i > jj) ? gs[64 + i] * kk[j][r] * dec : 0.f;
                INTRA[i * 64 + jj] = f2bf(qk[j][r] * dec); }
    }
    __syncthreads();
    {
        const int c = ht; float x[64];
        float* U = (float*)(ws + WS_U) + (size_t)item * 8192; bf16* KC = (bf16*)(ws + WS_KCUM) + (size_t)item * 8192;
        const float* rsrc = (c < 128 ? VD : KD) + (size_t)m0 * DNW + h * 128 + (c & 127);
#pragma unroll
        for (int i = 0; i < 64; ++i) x[i] = rsrc[(size_t)i * DNW];
#pragma unroll
        for (int i = 0; i < 64; ++i) { const float eg = __expf(gs[i]); x[i] *= gs[64 + i] * (c >= 128 ? eg : 1.0f); }
        subst_rows<0, 16>(x, Am, gs, c >= 128); subst_rows<16, 32>(x, Am, gs, c >= 128); subst_rows<32, 48>(x, Am, gs, c >= 128); subst_rows<48, 64>(x, Am, gs, c >= 128);
        if (c < 128) {
#pragma unroll
            for (int i = 0; i < 64; ++i) U[i * 128 + c] = x[i];
        } else {
#pragma unroll
            for (int i = 0; i < 64; ++i) KC[i * 128 + (c - 128)] = f2bf(x[i]);
        }
    }
    {
        const float glast = gs[63];
        bf16* QDc = (bf16*)(ws + WS_QDEC) + (size_t)item * 8192; bf16* KT = (bf16*)(ws + WS_KDECT) + (size_t)item * 8192;
        for (int e = ht; e < 64 * 128; e += 256) { const int i = e >> 7, d = e & 127; QDc[e] = f2bf(QD[(size_t)(m0 + i) * DNW + h * 128 + d] * __expf(gs[i])); }
        { const int d = ht & 127, ig = ht >> 7;
#pragma unroll
            for (int i8 = 0; i8 < 4; ++i8) { float v[8];
#pragma unroll
                for (int k = 0; k < 8; ++k) { const int i = 32 * ig + 8 * i8 + k; v[k] = KD[(size_t)(m0 + i) * DNW + h * 128 + d] * __expf(glast - gs[i]); }
                u32x4 w; w.x = cvtpk(v[0], v[1]); w.y = cvtpk(v[2], v[3]); w.z = cvtpk(v[4], v[5]); w.w = cvtpk(v[6], v[7]);
                *(u32x4*)(KT + d * 64 + 32 * ig + 8 * i8) = w; } }
        if (ht == 0) ((float*)(ws + WS_GL))[item] = __expf(glast);
    }
    __syncthreads();
}
__device__ __forceinline__ void dn_sample_unit(const Args& A, LAS unsigned char* lds, int unit, int tid) {
    unsigned char* ws = A.ws;
    const float* QD = (const float*)(ws + WS_QD); const float* KD = (const float*)(ws + WS_KD); const float* VD = (const float*)(ws + WS_VD);
    const float* BETA = (const float*)(ws + WS_BETA); const float* LOGA = (const float*)(ws + WS_LOGA); float* ODN = (float*)(ws + WS_ODN);
    const int h = unit & 3, b = unit >> 2, e = tid & 127, dq = tid >> 7;
    const float* s0 = (const float*)A.in[I_SD] + ((size_t)(b * 4 + h) * 128 + 32 * dq) * 128 + e;
    float S[32];
#pragma unroll
    for (int d = 0; d < 32; ++d) S[d] = s0[(size_t)d * 128];
    LAS float* red = (LAS float*)lds; LAS float* red2 = red + 512;
    for (int t = 0; t < TS; ++t) {
        const int m = MP + b * TS + t;
        const float a = __expf(LOGA[(size_t)m * 4 + h]), bt = BETA[(size_t)m * 4 + h];
        const float* kp = KD + (size_t)m * DNW + h * 128 + 32 * dq; const float* qp = QD + (size_t)m * DNW + h * 128 + 32 * dq;
        float kd[32], qd[32];
#pragma unroll
        for (int d4 = 0; d4 < 8; ++d4) { const f32x4 kv = *(const f32x4*)(kp + 4 * d4), qv = *(const f32x4*)(qp + 4 * d4);
            kd[4 * d4] = kv.x; kd[4 * d4 + 1] = kv.y; kd[4 * d4 + 2] = kv.z; kd[4 * d4 + 3] = kv.w; qd[4 * d4] = qv.x; qd[4 * d4 + 1] = qv.y; qd[4 * d4 + 2] = qv.z; qd[4 * d4 + 3] = qv.w; }
        float p = 0.f;
#pragma unroll
        for (int d = 0; d < 32; ++d) p += kd[d] * S[d];
        red[dq * 128 + e] = p;
        __syncthreads();
        const float kS = (red[e] + red[128 + e]) + (red[256 + e] + red[384 + e]);
        const float dl = bt * (VD[(size_t)m * DNW + h * 128 + e] - a * kS);
        float po = 0.f;
#pragma unroll
        for (int d = 0; d < 32; ++d) { S[d] = a * S[d] + kd[d] * dl; po += qd[d] * S[d]; }
        red2[dq * 128 + e] = po;
        __syncthreads();
        if (dq == 0) ODN[(size_t)m * DNW + h * 128 + e] = (red2[e] + red2[128 + e]) + (red2[256 + e] + red2[384 + e]);
    }
    float* so = A.out + O_SS + ((size_t)(b * 4 + h) * 128 + 32 * dq) * 128 + e;
#pragma unroll
    for (int d = 0; d < 32; ++d) so[(size_t)d * 128] = S[d];
    __syncthreads();
}

constexpr int SC_KC = 0, SC_QD = 17408, SC_KT = 34816, SC_IN = 53248, SC_BUF = 62464;
__device__ __forceinline__ void dn_scan_chain(const Args& A, LAS unsigned char* lds, int chain, int tid, int wave, int lane) {
    unsigned char* ws = A.ws;
    const float* Ub = (const float*)(ws + WS_U); const float* GL = (const float*)(ws + WS_GL); float* ODN = (float*)(ws + WS_ODN);
    const int b = chain >> 2, h = chain & 3, lr = lane & 15, q = lane >> 4, e = 16 * wave + lr;
    int ldst[7];
    { const int c0 = tid, c1 = tid + 512;
      ldst[0] = SC_KC + (c0 >> 4) * 272 + (c0 & 15) * 16; ldst[1] = SC_KC + (c1 >> 4) * 272 + (c1 & 15) * 16;
      ldst[2] = SC_QD + (c0 >> 4) * 272 + (c0 & 15) * 16; ldst[3] = SC_QD + (c1 >> 4) * 272 + (c1 & 15) * 16;
      ldst[4] = SC_KT + (c0 >> 3) * 144 + (c0 & 7) * 16;  ldst[5] = SC_KT + (c1 >> 3) * 144 + (c1 & 7) * 16;
      ldst[6] = SC_IN + (c0 >> 3) * 144 + (c0 & 7) * 16; }
    const size_t item0 = (size_t)(b * 64) * 4 + h;
    const unsigned char* gKC = ws + WS_KCUM + item0 * 16384; const unsigned char* gQD = ws + WS_QDEC + item0 * 16384; const unsigned char* gKT = ws + WS_KDECT + item0 * 16384; const unsigned char* gIN = ws + WS_INTRA + item0 * 8192;
    const int t16 = tid * 16, uoff = (4 * q) * 128 + e;
    u32x4 R[7]; float un[16];
#define SC_GLOAD(n_) do { const size_t o16_ = (size_t)(n_) * 4 * 16384, o8_ = (size_t)(n_) * 4 * 8192; \
        R[0] = *(const u32x4*)(gKC + o16_ + t16); R[1] = *(const u32x4*)(gKC + o16_ + 8192 + t16); R[2] = *(const u32x4*)(gQD + o16_ + t16); R[3] = *(const u32x4*)(gQD + o16_ + 8192 + t16); \
        R[4] = *(const u32x4*)(gKT + o16_ + t16); R[5] = *(const u32x4*)(gKT + o16_ + 8192 + t16); R[6] = *(const u32x4*)(gIN + o8_ + t16); \
        const float* U_ = Ub + (item0 + 4 * (size_t)(n_)) * 8192; \
        _Pragma("unroll") for (int i_ = 0; i_ < 4; ++i_) _Pragma("unroll") for (int r_ = 0; r_ < 4; ++r_) un[4 * i_ + r_] = U_[uoff + (16 * i_ + r_) * 128]; } while (0)
#define SC_LWRITE(buf_) do { _Pragma("unroll") for (int k_ = 0; k_ < 7; ++k_) *(LAS u32x4*)(lds + (buf_) * SC_BUF + ldst[k_]) = R[k_]; } while (0)
    pg8::f32x4 S[8];
#pragma unroll
    for (int i = 0; i < 8; ++i) S[i] = (pg8::f32x4){0.f, 0.f, 0.f, 0.f};
    __syncthreads();
    SC_GLOAD(0); SC_LWRITE(0);
    float uc[16];
#pragma unroll
    for (int k = 0; k < 16; ++k) uc[k] = un[k];
    __syncthreads();
    for (int n = 0; n < 64; ++n) {
        const float gl = GL[item0 + 4 * n];
        if (n + 1 < 64) SC_GLOAD(n + 1);
        const LAS unsigned char* B = lds + (n & 1) * SC_BUF;
        bf16x8 Sb[4];
#pragma unroll
        for (int s = 0; s < 4; ++s) { u32x4 w; w.x = cvtpk(S[2 * s][0], S[2 * s][1]); w.y = cvtpk(S[2 * s][2], S[2 * s][3]); w.z = cvtpk(S[2 * s + 1][0], S[2 * s + 1][1]); w.w = cvtpk(S[2 * s + 1][2], S[2 * s + 1][3]); Sb[s] = __builtin_bit_cast(bf16x8, w); }
        pg8::f32x4 vn[4], o[4];
#pragma unroll
        for (int i = 0; i < 4; ++i) {
            pg8::f32x4 ak = (pg8::f32x4){0.f, 0.f, 0.f, 0.f}, aq = ak;
#pragma unroll
            for (int s = 0; s < 4; ++s) {
                const LAS unsigned char* kp = B + SC_KC + (16 * i + lr) * 272 + (32 * s + 4 * q) * 2; const LAS unsigned char* qp = B + SC_QD + (16 * i + lr) * 272 + (32 * s + 4 * q) * 2;
                const u32x2 k0 = *(const LAS u32x2*)kp, k1 = *(const LAS u32x2*)(kp + 32), q0 = *(const LAS u32x2*)qp, q1 = *(const LAS u32x2*)(qp + 32);
                ak = __builtin_amdgcn_mfma_f32_16x16x32_bf16(__builtin_bit_cast(bf16x8, (u32x4){k0.x, k0.y, k1.x, k1.y}), Sb[s], ak, 0, 0, 0);
                aq = __builtin_amdgcn_mfma_f32_16x16x32_bf16(__builtin_bit_cast(bf16x8, (u32x4){q0.x, q0.y, q1.x, q1.y}), Sb[s], aq, 0, 0, 0);
            }
#pragma unroll
            for (int r = 0; r < 4; ++r) vn[i][r] = uc[4 * i + r] - ak[r];
            o[i] = aq;
        }
        bf16x8 Vb[2];
#pragma unroll
        for (int s = 0; s < 2; ++s) { u32x4 w; w.x = cvtpk(vn[2 * s][0], vn[2 * s][1]); w.y = cvtpk(vn[2 * s][2], vn[2 * s][3]); w.z = cvtpk(vn[2 * s + 1][0], vn[2 * s + 1][1]); w.w = cvtpk(vn[2 * s + 1][2], vn[2 * s + 1][3]); Vb[s] = __builtin_bit_cast(bf16x8, w); }
#pragma unroll
        for (int i = 0; i < 4; ++i) {
#pragma unroll
            for (int s = 0; s < 2; ++s) { const LAS unsigned char* ip = B + SC_IN + (16 * i + lr) * 144 + (32 * s + 4 * q) * 2; const u32x2 a0 = *(const LAS u32x2*)ip, a1 = *(const LAS u32x2*)(ip + 32);
                o[i] = __builtin_amdgcn_mfma_f32_16x16x32_bf16(__builtin_bit_cast(bf16x8, (u32x4){a0.x, a0.y, a1.x, a1.y}), Vb[s], o[i], 0, 0, 0); }
#pragma unroll
            for (int r = 0; r < 4; ++r) ODN[(size_t)(b * TP + 64 * n + 16 * i + 4 * q + r) * DNW + h * 128 + e] = o[i][r];
        }
#pragma unroll
        for (int i = 0; i < 8; ++i) {
            pg8::f32x4 acc = S[i] * gl;
#pragma unroll
            for (int s = 0; s < 2; ++s) { const LAS unsigned char* tp = B + SC_KT + (16 * i + lr) * 144 + (32 * s + 4 * q) * 2; const u32x2 a0 = *(const LAS u32x2*)tp, a1 = *(const LAS u32x2*)(tp + 32);
                acc = __builtin_amdgcn_mfma_f32_16x16x32_bf16(__builtin_bit_cast(bf16x8, (u32x4){a0.x, a0.y, a1.x, a1.y}), Vb[s], acc, 0, 0, 0); }
            S[i] = acc;
        }
        if (n + 1 < 64) {
            SC_LWRITE((n + 1) & 1);
#pragma unroll
            for (int k = 0; k < 16; ++k) uc[k] = un[k];
        }
        __syncthreads();
    }
#undef SC_GLOAD
#undef SC_LWRITE
    float* so = A.out + O_SP + (size_t)(b * 4 + h) * 16384;
#pragma unroll
    for (int i = 0; i < 8; ++i)
#pragma unroll
        for (int r = 0; r < 4; ++r) so[(16 * i + 4 * q + r) * 128 + e] = S[i][r];
}

__device__ __forceinline__ int crow(int r, int hi) { return (r & 3) + 8 * (r >> 2) + 4 * hi; }
__device__ __forceinline__ void sb_core(f32x16& p, float& carry, int hi) {
    float s[16];
#pragma unroll
    for (int r = 0; r < 16; ++r) { const float e = __builtin_amdgcn_exp2f(p[r]); s[r] = -__builtin_amdgcn_logf(1.0f + e); }
    float tt[4], uu[4];
#pragma unroll
    for (int i = 0; i < 4; ++i) { s[4 * i + 2] += s[4 * i + 3]; s[4 * i + 1] += s[4 * i + 2]; s[4 * i] += s[4 * i + 1]; tt[i] = s[4 * i]; }
#pragma unroll
    for (int i = 0; i < 4; ++i) uu[i] = __shfl_xor(tt[i], 32);
    const float w3 = tt[3] + uu[3], w2 = tt[2] + uu[2], w1 = tt[1] + uu[1], w0 = tt[0] + uu[0];
    float off[4];
    off[3] = carry; off[2] = carry + w3; off[1] = off[2] + w2; off[0] = off[1] + w1;
    carry = off[0] + w0;
    if (hi == 0) {
#pragma unroll
        for (int i = 0; i < 4; ++i) off[i] += uu[i];
    }
#pragma unroll
    for (int r = 0; r < 16; ++r) p[r] = __builtin_amdgcn_exp2f(p[r] + s[r] + off[r >> 2]);
}
__device__ __forceinline__ bf16x8 pack_p(const f32x16& p, int s) {
    u32x4 w; w.x = cvtpk(p[8 * s], p[8 * s + 1]); w.y = cvtpk(p[8 * s + 2], p[8 * s + 3]); w.z = cvtpk(p[8 * s + 4], p[8 * s + 5]); w.w = cvtpk(p[8 * s + 6], p[8 * s + 7]); return __builtin_bit_cast(bf16x8, w);
}
constexpr int AW_BYTES = 16384, AW_V = 0, VPI = 192, AW_K = 6144, KPI = 144, AW_Q = 6144;
__device__ __forceinline__ void read_vfrags(bf16x8 (&vf)[4], const LAS unsigned char* wl, int lane) {
    const int hi = lane >> 5;
    const LAS unsigned char* vb = wl + AW_V + (4 * hi + ((lane & 15) >> 2)) * VPI + (((lane >> 4) & 1) * 16 + (lane & 3) * 4) * 2;
#pragma unroll
    for (int dt = 0; dt < 2; ++dt) {
        const s16x4 t0 = __builtin_bit_cast(s16x4, __builtin_amdgcn_ds_read_tr16_b64_v4i16((LAS s16x4*)(vb + dt * 64)));
        const s16x4 t1 = __builtin_bit_cast(s16x4, __builtin_amdgcn_ds_read_tr16_b64_v4i16((LAS s16x4*)(vb + dt * 64 + 8 * VPI)));
        const s16x4 t2 = __builtin_bit_cast(s16x4, __builtin_amdgcn_ds_read_tr16_b64_v4i16((LAS s16x4*)(vb + dt * 64 + 16 * VPI)));
        const s16x4 t3 = __builtin_bit_cast(s16x4, __builtin_amdgcn_ds_read_tr16_b64_v4i16((LAS s16x4*)(vb + dt * 64 + 24 * VPI)));
        vf[2 * dt] = (bf16x8){t0[0], t0[1], t0[2], t0[3], t1[0], t1[1], t1[2], t1[3]}; vf[2 * dt + 1] = (bf16x8){t2[0], t2[1], t2[2], t2[3], t3[0], t3[1], t3[2], t3[3]};
    }
}
__device__ __forceinline__ void load_k_prompt(bf16x8 (&k)[4], const bf16* KB, int b, int h, int kv0, int r32, int hi) {
    const bf16* kp = KB + (size_t)(b * TP + kv0 + r32) * SBW + h * HD + 8 * hi;
#pragma unroll
    for (int d0 = 0; d0 < 4; ++d0) k[d0] = *(const bf16x8*)(kp + 16 * d0);
}
__device__ __forceinline__ void load_v_prompt(u32x4 (&v)[4], const bf16* VB, int b, int h, int kv0, int lane) {
    const bf16* vp = VB + (size_t)(b * TP + kv0 + (lane >> 3)) * SBW + h * HD + (lane & 7) * 8;
#pragma unroll
    for (int i = 0; i < 4; ++i) v[i] = *(const u32x4*)(vp + (size_t)(8 * i) * SBW);
}
__device__ __forceinline__ void write_v_lds(LAS unsigned char* wl, const u32x4 (&v)[4], int lane) {
#pragma unroll
    for (int i = 0; i < 4; ++i) *(LAS u32x4*)(wl + AW_V + (8 * i + (lane >> 3)) * VPI + (lane & 7) * 16) = v[i];
}
template <int MASK>
__device__ __forceinline__ void sb_qk(f32x16& p, const bf16x8 (&kf)[4], const bf16x8 (&qf)[4], float bias2, int kv0, int qpos, int hi) {
#pragma unroll
    for (int r = 0; r < 16; ++r) p[r] = bias2;
#pragma unroll
    for (int d0 = 0; d0 < 4; ++d0) p = __builtin_amdgcn_mfma_f32_32x32x16_bf16(kf[d0], qf[d0], p, 0, 0, 0);
    if (MASK) {
#pragma unroll
        for (int r = 0; r < 16; ++r) if (kv0 + crow(r, hi) >= qpos) p[r] = -INFINITY;
    }
}
__device__ __forceinline__ void sb_pvonly(const f32x16& p, const bf16x8 (&vf)[4], f32x16 (&o)[2]) {
    const bf16x8 p0 = pack_p(p, 0), p1 = pack_p(p, 1);
#pragma unroll
    for (int dt = 0; dt < 2; ++dt) { o[dt] = __builtin_amdgcn_mfma_f32_32x32x16_bf16(vf[2 * dt], p0, o[dt], 0, 0, 0); o[dt] = __builtin_amdgcn_mfma_f32_32x32x16_bf16(vf[2 * dt + 1], p1, o[dt], 0, 0, 0); }
}
__device__ __forceinline__ void sb_pv(f32x16& p, const bf16x8 (&vf)[4], f32x16 (&o)[2], float& carry, int hi) {
    sb_core(p, carry, hi);
    const bf16x8 p0 = pack_p(p, 0), p1 = pack_p(p, 1);
#pragma unroll
    for (int dt = 0; dt < 2; ++dt) { o[dt] = __builtin_amdgcn_mfma_f32_32x32x16_bf16(vf[2 * dt], p0, o[dt], 0, 0, 0); o[dt] = __builtin_amdgcn_mfma_f32_32x32x16_bf16(vf[2 * dt + 1], p1, o[dt], 0, 0, 0); }
}
template <int MASK>
__device__ __forceinline__ void sb_tile(const bf16x8 (&kf)[4], const bf16x8 (&vf)[4], const bf16x8 (&qf)[4], float bias2, f32x16 (&o)[2], float& carry, int kv0, int qpos, int hi) {
    f32x16 p; sb_qk<MASK>(p, kf, qf, bias2, kv0, qpos, hi); sb_pv(p, vf, o, carry, hi);
}
__device__ __forceinline__ void sb_store_prompt(const Args& A, const f32x16 (&o)[2], int b, int h, int qpos, int hi) {
    float ss = 0.f;
#pragma unroll
    for (int dt = 0; dt < 2; ++dt)
#pragma unroll
        for (int r = 0; r < 16; ++r) ss += o[dt][r] * o[dt][r];
    ss += __shfl_xor(ss, 32);
    const float rs = 1.0f / sqrtf(ss * (1.f / HD) + EPS);
    const float* gso = (const float*)A.in[I_GSBO];
    bf16* op = (bf16*)(A.ws + WS_MIXED) + (size_t)(b * TP + qpos) * D + h * HD;
#pragma unroll
    for (int dt = 0; dt < 2; ++dt)
#pragma unroll
        for (int g = 0; g < 4; ++g) { const int d = 32 * dt + 8 * g + 4 * hi; const f32x4 gg = *(const f32x4*)(gso + d);
            u32x2 w; w.x = cvtpk(o[dt][4 * g] * rs * gg.x, o[dt][4 * g + 1] * rs * gg.y); w.y = cvtpk(o[dt][4 * g + 2] * rs * gg.z, o[dt][4 * g + 3] * rs * gg.w); *(u32x2*)(op + d) = w; }
}
__device__ __forceinline__ void attn_prompt_item(const Args& A, LAS unsigned char* wl, int b, int h, int q0, int lane) {
    unsigned char* ws = A.ws;
    const bf16* QB = (const bf16*)(ws + WS_QB); const bf16* KB = (const bf16*)(ws + WS_KB); const bf16* VB = (const bf16*)(ws + WS_VB);
    const int r32 = lane & 31, hi = lane >> 5, qa = q0 + r32, qb = q0 + 32 + r32;
    const float bias2 = ((const float*)A.in[I_SBB])[h] * LOG2E;
#pragma unroll
    for (int d0 = 0; d0 < 4; ++d0) { *(LAS bf16x8*)(wl + AW_Q + (d0 * 64 + lane) * 16) = *(const bf16x8*)(QB + (size_t)(b * TP + qa) * SBW + h * HD + 16 * d0 + 8 * hi);
        *(LAS bf16x8*)(wl + AW_Q + 4096 + (d0 * 64 + lane) * 16) = *(const bf16x8*)(QB + (size_t)(b * TP + qb) * SBW + h * HD + 16 * d0 + 8 * hi); }
#define QFA_LOAD bf16x8 qfa[4]; _Pragma("unroll") for (int d0_ = 0; d0_ < 4; ++d0_) qfa[d0_] = *(const LAS bf16x8*)(wl + AW_Q + (d0_ * 64 + lane) * 16);
#define QFB_LOAD bf16x8 qfb[4]; _Pragma("unroll") for (int d0_ = 0; d0_ < 4; ++d0_) qfb[d0_] = *(const LAS bf16x8*)(wl + AW_Q + 4096 + (d0_ * 64 + lane) * 16);
    f32x16 oa[2], ob[2]; oa[0] = (f32x16){}; oa[1] = (f32x16){}; ob[0] = (f32x16){}; ob[1] = (f32x16){};
    float ca = 0.f, cb = 0.f;
    bf16x8 kc[4], vf[4]; u32x4 vr[4];
    const int top = (q0 >> 5) + 1;
    load_k_prompt(kc, KB, b, h, 32 * top, r32, hi); load_v_prompt(vr, VB, b, h, 32 * top, lane);
    { write_v_lds(wl, vr, lane); load_v_prompt(vr, VB, b, h, 32 * (top - 1), lane);
      f32x16 p; { QFB_LOAD sb_qk<1>(p, kc, qfb, bias2, 32 * top, qb, hi); }
      load_k_prompt(kc, KB, b, h, 32 * (top - 1), r32, hi);
      read_vfrags(vf, wl, lane);
      sb_pv(p, vf, ob, cb, hi); }
    { write_v_lds(wl, vr, lane); if (top >= 2) load_v_prompt(vr, VB, b, h, 32 * (top - 2), lane);
      f32x16 p; { QFA_LOAD sb_qk<1>(p, kc, qfa, bias2, 32 * (top - 1), qa, hi); }
      read_vfrags(vf, wl, lane);
      sb_pv(p, vf, oa, ca, hi);
      { QFB_LOAD sb_qk<0>(p, kc, qfb, bias2, 0, 0, hi); }
      if (top >= 2) load_k_prompt(kc, KB, b, h, 32 * (top - 2), r32, hi);
      sb_pv(p, vf, ob, cb, hi); }
    for (int ht = top - 2; ht >= 0; --ht) {
        write_v_lds(wl, vr, lane); if (ht > 0) load_v_prompt(vr, VB, b, h, 32 * (ht - 1), lane);
        f32x16 p; { QFA_LOAD sb_qk<0>(p, kc, qfa, bias2, 0, 0, hi); }
        read_vfrags(vf, wl, lane);
        sb_pv(p, vf, oa, ca, hi);
        { QFB_LOAD sb_qk<0>(p, kc, qfb, bias2, 0, 0, hi); }
        if (ht > 0) load_k_prompt(kc, KB, b, h, 32 * (ht - 1), r32, hi);
        sb_pv(p, vf, ob, cb, hi);
    }
    sb_store_prompt(A, oa, b, h, qa, hi); sb_store_prompt(A, ob, b, h, qb, hi);
#undef QFA_LOAD
#undef QFB_LOAD
}

__device__ __forceinline__ void load_raw_sample(f32x4 (&r)[8], const float* c, size_t base, int h, int lane) {
    const float* p = c + base + (size_t)(lane >> 4) * 512 + h * HD + (lane & 15) * 4;
#pragma unroll
    for (int i = 0; i < 8; ++i) r[i] = *(const f32x4*)(p + (size_t)(4 * i) * 512);
}
__device__ __forceinline__ void write_raw_sample(LAS unsigned char* wl, int off, int pitch, const f32x4 (&r)[8], int lane) {
#pragma unroll
    for (int i = 0; i < 8; ++i) { const int row = 4 * i + (lane >> 4); u32x2 w; w.x = cvtpk(r[i].x, r[i].y); w.y = cvtpk(r[i].z, r[i].w); *(LAS u32x2*)(wl + off + row * pitch + (lane & 15) * 8) = w; }
}
__device__ __forceinline__ void read_kfrags(bf16x8 (&kf)[4], const LAS unsigned char* wl, int r32, int hi) {
#pragma unroll
    for (int d0 = 0; d0 < 4; ++d0) kf[d0] = *(const LAS bf16x8*)(wl + AW_K + r32 * KPI + (16 * d0 + 8 * hi) * 2);
}
__device__ __forceinline__ void attn_sample_store(const Args& A, int b, int h, int part, int lane, const f32x16 (&o)[2], float carry) {
    float* OP = (float*)(A.ws + WS_OPART) + (size_t)((b * SBH + h) * NPART + part) * 512; float* LP = (float*)(A.ws + WS_LPART) + (size_t)((b * SBH + h) * NPART + part) * 8;
    const int r32 = lane & 31, hi = lane >> 5;
    if (r32 < 8) {
#pragma unroll
        for (int dt = 0; dt < 2; ++dt)
#pragma unroll
            for (int r = 0; r < 16; ++r) OP[(32 * dt + crow(r, hi)) * 8 + r32] = o[dt][r];
        if (hi == 0) LP[r32] = carry;
    }
}
__device__ __forceinline__ void attn_sample_job(const Args& A, LAS unsigned char* wl, int b, int h, int sp, int lane) {
    unsigned char* ws = A.ws;
    const int r32 = lane & 31, hi = lane >> 5;
    const float* ck = (const float*)A.in[I_CK]; const float* cv = (const float*)A.in[I_CV]; const int* pt = (const int*)A.in[I_PT] + b * NPAGES;
    const bf16* QB = (const bf16*)(ws + WS_QB);
    const float bias2 = ((const float*)A.in[I_SBB])[h] * LOG2E;
    bf16x8 qf[4];
#pragma unroll
    for (int d0 = 0; d0 < 4; ++d0) { qf[d0] = (bf16x8){0, 0, 0, 0, 0, 0, 0, 0}; if (r32 < TS) qf[d0] = *(const bf16x8*)(QB + (size_t)(MP + b * TS + r32) * SBW + h * HD + 16 * d0 + 8 * hi); }
    f32x16 o[2]; float carry;
    bf16x8 kf[4], vf[4];
    const int tok_hi = (PAST / NSPLIT) * (sp + 1);
    constexpr int NT = PAST / NSPLIT / 32;
    f32x4 rk[8], rv[8];
#define SAMPLE_BASE(j) (((size_t)pt[(tok_hi - 32 * ((j) + 1)) >> 7] * PAGE + ((tok_hi - 32 * ((j) + 1)) & 127)) * 512)
    if (sp == NSPLIT - 1) {
        const bf16* KBn = (const bf16*)(ws + WS_KB) + (size_t)(MP + b * TS) * SBW + h * HD;
#pragma unroll
        for (int d0 = 0; d0 < 4; ++d0) { kf[d0] = (bf16x8){0, 0, 0, 0, 0, 0, 0, 0}; if (r32 < TS) kf[d0] = *(const bf16x8*)(KBn + (size_t)r32 * SBW + 16 * d0 + 8 * hi); }
        u32x4 vr[4];
        vr[0] = *(const u32x4*)((const bf16*)(ws + WS_VB) + (size_t)(MP + b * TS + (lane >> 3)) * SBW + h * HD + (lane & 7) * 8);
        vr[1] = (u32x4){0u, 0u, 0u, 0u}; vr[2] = vr[1]; vr[3] = vr[1];
        write_v_lds(wl, vr, lane);
        read_vfrags(vf, wl, lane);
        o[0] = (f32x16){}; o[1] = (f32x16){}; carry = 0.f;
        sb_tile<1>(kf, vf, qf, bias2, o, carry, 0, r32, hi);
        attn_sample_store(A, b, h, NPART - 1, lane, o, carry);
    }
    load_raw_sample(rk, ck, SAMPLE_BASE(0), h, lane); load_raw_sample(rv, cv, SAMPLE_BASE(0), h, lane);
    o[0] = (f32x16){}; o[1] = (f32x16){}; carry = 0.f;
    for (int j = 0; j < NT; ++j) {
        write_raw_sample(wl, AW_K, KPI, rk, lane); write_raw_sample(wl, AW_V, VPI, rv, lane);
        if (j + 1 < NT) load_raw_sample(rk, ck, SAMPLE_BASE(j + 1), h, lane);
        read_kfrags(kf, wl, r32, hi); read_vfrags(vf, wl, lane);
        f32x16 p; sb_qk<0>(p, kf, qf, bias2, 0, 0, hi);
        sb_core(p, carry, hi);
        __builtin_amdgcn_sched_barrier(0);
        if (j + 1 < NT) load_raw_sample(rv, cv, SAMPLE_BASE(j + 1), h, lane);
        sb_pvonly(p, vf, o);
    }
#undef SAMPLE_BASE
    attn_sample_store(A, b, h, sp, lane, o, carry);
}

__device__ __forceinline__ void phase_outnorm(const Args& A, int gw, int NGW, int lane) {
    unsigned char* ws = A.ws; const float* ODN = (const float*)(ws + WS_ODN); bf16* MIXED = (bf16*)(ws + WS_MIXED);
    const float* gdn = (const float*)A.in[I_GDNO]; const float* gso = (const float*)A.in[I_GSBO];
    const float* OPb = (const float*)(ws + WS_OPART); const float* LPb = (const float*)(ws + WS_LPART);
    const int c8 = 8 * lane;
    for (int m = gw; m < M; m += NGW) {
        {
            const float* op = ODN + (size_t)m * DNW + c8; f32x4 a0 = *(const f32x4*)op, a1 = *(const f32x4*)(op + 4);
            float ss = (a0.x * a0.x + a0.y * a0.y) + (a0.z * a0.z + a0.w * a0.w) + (a1.x * a1.x + a1.y * a1.y) + (a1.z * a1.z + a1.w * a1.w);
            ss += __shfl_xor(ss, 1); ss += __shfl_xor(ss, 2); ss += __shfl_xor(ss, 4); ss += __shfl_xor(ss, 8);
            const float rs = 1.0f / sqrtf(ss * (1.f / DND) + EPS);
            const f32x4 g0 = *(const f32x4*)(gdn + (c8 & 127)), g1 = *(const f32x4*)(gdn + (c8 & 127) + 4);
            const u32x4 zw = *(const u32x4*)((const bf16*)(ws + WS_ZG) + (size_t)m * DNW + c8); const f32x4 z0 = bf4lo(zw), z1 = bf4hi(zw);
            *(u32x4*)(MIXED + (size_t)m * D + SBW + c8) = pack8(a0 * rs * g0 * z0, a1 * rs * g1 * z1);
        }
        if (m >= MP) {
            const int b = (m - MP) >> 3, t = (m - MP) & 7, h = lane >> 3, d0 = c8 & 63;
            const float* OP = OPb + (size_t)(b * SBH + h) * NPART * 512; const float* LP = LPb + (size_t)(b * SBH + h) * NPART * 8;
            float v[8];
#pragma unroll
            for (int k = 0; k < 8; ++k) v[k] = 0.f;
            float suf = 0.f;
#pragma unroll
            for (int part = NPART - 1; part >= 0; --part) { const float w = __builtin_amdgcn_exp2f(suf);
#pragma unroll
                for (int k = 0; k < 8; ++k) v[k] += w * OP[part * 512 + (d0 + k) * 8 + t];
                suf += LP[part * 8 + t]; }
            float ss = 0.f;
#pragma unroll
            for (int k = 0; k < 8; ++k) ss += v[k] * v[k];
            ss += __shfl_xor(ss, 1); ss += __shfl_xor(ss, 2); ss += __shfl_xor(ss, 4);
            const float rs = 1.0f / sqrtf(ss * (1.f / HD) + EPS);
            const f32x4 g0 = *(const f32x4*)(gso + d0), g1 = *(const f32x4*)(gso + d0 + 4);
            *(u32x4*)(MIXED + (size_t)m * D + c8) = pack8((f32x4){v[0], v[1], v[2], v[3]} * rs * g0, (f32x4){v[4], v[5], v[6], v[7]} * rs * g1);
        }
    }
}

__device__ __forceinline__ void phase_convgate(const Args& A, int gw, int NGW, int lane) {
    unsigned char* ws = A.ws; const bf16* UP = (const bf16*)(ws + WS_UP); bf16* ACT = (bf16*)(ws + WS_ACT); float* out = A.out;
    const float* wf = (const float*)A.in[I_WFC]; const float* sfc = (const float*)A.in[I_SFC];
    for (int m = gw; m < M; m += NGW) {
        const bool prompt = m < MP; const int b = prompt ? (m >> 12) : ((m - MP) >> 3), t = prompt ? (m & 4095) : ((m - MP) & 7);
        const bf16* ur = UP + (size_t)m * DFF2;
        const int oidx = prompt ? t - (TP - 2) : t - (TS - 2);
        float* fo = oidx >= 0 ? (prompt ? out + O_FCP + ((size_t)b * 2 + oidx) * DFF2 : out + O_FCS + ((size_t)b * 2 + oidx) * DFF2) : nullptr;
        for (int ch = lane; ch < DFF / 8; ch += 64) {
            const int c = 8 * ch;
            f32x4 u0 = (f32x4){0.f, 0.f, 0.f, 0.f}, u1 = u0, g0 = u0, g1 = u0;
#pragma unroll
            for (int i = 0; i < 3; ++i) {
                const int tt = t - 2 + i;
                f32x4 xu0, xu1, xg0, xg1;
                if (tt >= 0) { const u32x4 wu = *(const u32x4*)(ur - (size_t)(2 - i) * DFF2 + c), wg = *(const u32x4*)(ur - (size_t)(2 - i) * DFF2 + DFF + c); xu0 = bf4lo(wu); xu1 = bf4hi(wu); xg0 = bf4lo(wg); xg1 = bf4hi(wg); }
                else if (!prompt) { const float* p = sfc + ((size_t)b * 2 + (2 + tt)) * DFF2 + c; xu0 = *(const f32x4*)p; xu1 = *(const f32x4*)(p + 4); xg0 = *(const f32x4*)(p + DFF); xg1 = *(const f32x4*)(p + DFF + 4); }
                else { xu0 = (f32x4){0.f, 0.f, 0.f, 0.f}; xu1 = xu0; xg0 = xu0; xg1 = xu0; }
                const float* wp = wf + (size_t)i * DFF2 + c;
                u0 += *(const f32x4*)wp * xu0; u1 += *(const f32x4*)(wp + 4) * xu1; g0 += *(const f32x4*)(wp + DFF) * xg0; g1 += *(const f32x4*)(wp + DFF + 4) * xg1;
                if (i == 2 && fo) { *(f32x4*)(fo + c) = xu0; *(f32x4*)(fo + c + 4) = xu1; *(f32x4*)(fo + DFF + c) = xg0; *(f32x4*)(fo + DFF + c + 4) = xg1; }
            }
            g0.x = siluf(g0.x); g0.y = siluf(g0.y); g0.z = siluf(g0.z); g0.w = siluf(g0.w); g1.x = siluf(g1.x); g1.y = siluf(g1.y); g1.z = siluf(g1.z); g1.w = siluf(g1.w);
            *(u32x4*)(ACT + (size_t)m * DFF + c) = pack8(g0 * u0, g1 * u1);
        }
    }
}

constexpr int NPHASE = 13;
#ifndef REP_MASK
#define REP_MASK 0
#endif

__global__ void __launch_bounds__(512, 2) fwd_kernel(Args A) {
    extern __shared__ __attribute__((aligned(16))) unsigned char lds_raw[];
    LAS unsigned char* lds = (LAS unsigned char*)lds_raw;
    const int wave = __builtin_amdgcn_readfirstlane((int)threadIdx.x >> 6);
    const int G = gridDim.x, bx = blockIdx.x;
    const int gw = bx * 8 + wave, NGW = G * 8, NGT = G * 512;
    unsigned char* ws = A.ws;
    gu32* ctl = (gu32*)(ws + WS_CTL);
    volatile LAS unsigned* MISC = (volatile LAS unsigned*)(lds + MISC_OFF);
    { const int t0 = wave * 64 + lane_now(); for (int u = t0; u < (LDS_BYTES - RING_BYTES) / 4; u += 512) ((LAS unsigned*)(lds + RING_BYTES))[u] = 0u; }
    __syncthreads();
    const int lo = A.lo, hi = A.hi;
    const bool multi = (hi - lo) > 1;
    XcdBarrier bar; bar.bar = (unsigned*)(ctl + CW_BAR); bar.x = 0; bar.st = nullptr;
    if (multi) bar = xcd_barrier_post((unsigned*)(ctl + CW_BAR), MISC + 8, wave * 64 + lane_now());
#define IN(k) (lo <= (k) && (k) < hi)
#define GBAR() xcd_barrier(bar, wave * 64 + lane_now())
#define SEAM(k) do { if (IN(k) && IN((k) + 1)) GBAR(); } while (0)
    float* MOD = (float*)(ws + WS_MOD);

#define PH0(rep_) phase_prologue(A, lds, gw, NGW, wave, lane, gtid, NGT);
#define PH1(rep_) phase_mod(A, gw, NGW, lane);
#define PH2(rep_) phase_norm<true>((const float*)A.in[I_XP], (const float*)A.in[I_XS], (const float*)A.in[I_GATT], MOD, 0, 1024, (bf16*)(ws + WS_H), (const float*)(ws + WS_WINX), (float*)(ws + WS_EXTRA), gw, NGW, lane);
#define PH3(rep_) { pg8::Gemm g{(const pg8::bf16_t*)(ws + WS_H), (const pg8::bf16_t*)(ws + WS_WIN_T), M, NPROJ, D}; pg8::StaticOrder S; S.init(M, NPROJ, G, bx); \
          EpiProj E{A.out, (bf16*)(ws + WS_QB), (bf16*)(ws + WS_KB), (bf16*)(ws + WS_VB), (bf16*)(ws + WS_DNRAW), (bf16*)(ws + WS_ZG), (const float*)A.in[I_GQ], (const float*)A.in[I_GK], (LAS float*)(lds + RING_BYTES + 1024)}; \
          pg8::gemm_phase<EpiProj, pg8::StaticOrder, true, true>(lds, g, S, E, tid); }
#define PH4(rep_) phase_post(A, gw, NGW, lane);
#define PH5(rep_) for (int u = bx; u < 1024; u += G) { if (u < 512) dn_prescan_unit(A, lds, u, tid, wave, lane); else dn_sample_unit(A, lds, u - 512, tid); }
#define PH6(rep_) PH6X(rep_, true, true, true)
#define PH6X(rep_, DS_, DP_, DA_) { if ((DS_) && bx < 16) dn_scan_chain(A, lds, bx, tid, wave, lane); \
          \
        bool moreP = (DP_), moreS = (DA_); const bool pfirst = wave < 4; \
        for (;;) { \
            int job = -1; bool isP = false; \
            if (pfirst && moreP) { unsigned j_ = 0; if (lane == 0) j_ = __hip_atomic_fetch_add(ctl + CW_QUEUE + 128 * (rep_), 1u, RLX_AGENT); j_ = __builtin_amdgcn_readfirstlane(j_); if (j_ < 2048u) { job = (int)j_; isP = true; } else moreP = false; } \
            if (job < 0 && moreS) { unsigned j_ = 0; if (lane == 0) j_ = __hip_atomic_fetch_add(ctl + CW_QUEUE + 128 * (rep_) + 64, 1u, RLX_AGENT); j_ = __builtin_amdgcn_readfirstlane(j_); if (j_ < 4096u) { job = (int)j_; } else moreS = false; } \
            if (job < 0 && !pfirst && moreP) { unsigned j_ = 0; if (lane == 0) j_ = __hip_atomic_fetch_add(ctl + CW_QUEUE + 128 * (rep_), 1u, RLX_AGENT); j_ = __builtin_amdgcn_readfirstlane(j_); if (j_ < 2048u) { job = (int)j_; isP = true; } else moreP = false; } \
            if (job < 0) { if (!moreP && !moreS) break; else continue; } \
            if (isP) { const int qb = 63 - (job >> 5), bh = job & 31; attn_prompt_item(A, lds + wave * AW_BYTES, bh >> 3, bh & 7, qb * 64, lane); } \
            else { const int h_ = job & 7, bs_ = job >> 3; attn_sample_job(A, lds + wave * AW_BYTES, bs_ >> 2, h_, bs_ & 3, lane); } \
        } }
#define PH7(rep_) phase_outnorm(A, gw, NGW, lane);
#define PH8(rep_) { pg8::Gemm g{(const pg8::bf16_t*)(ws + WS_MIXED), (const pg8::bf16_t*)(ws + WS_WOUT_T), M, D, D}; pg8::StaticOrder S; S.init(M, D, G, bx); \
        EpiResGate E{(const float*)A.in[I_XP], (const float*)A.in[I_XS], MOD, 2048, (float*)(ws + WS_X1)}; \
        pg8::gemm_phase<EpiResGate, pg8::StaticOrder, true, true>(lds, g, S, E, tid); }
#define PH9(rep_) phase_norm<false>((const float*)(ws + WS_X1), (const float*)(ws + WS_X1) + (size_t)MP * D, (const float*)A.in[I_GFFN], MOD, 3072, 4096, (bf16*)(ws + WS_H), nullptr, nullptr, gw, NGW, lane);
#define PH10(rep_) { pg8::Gemm g{(const pg8::bf16_t*)(ws + WS_H), (const pg8::bf16_t*)(ws + WS_WUP_T), M, DFF2, D}; pg8::StaticOrder S; S.init(M, DFF2, G, bx); \
        pg8::EpiBf16<0> E{(pg8::bf16_t*)(ws + WS_UP), DFF2, nullptr, 0, 0, 1.f}; \
        pg8::gemm_phase<pg8::EpiBf16<0>, pg8::StaticOrder, true, true>(lds, g, S, E, tid); }
#define PH11(rep_) phase_convgate(A, gw, NGW, lane);
#define PH12(rep_) { pg8::Gemm g{(const pg8::bf16_t*)(ws + WS_ACT), (const pg8::bf16_t*)(ws + WS_WDN_T), M, D, DFF}; pg8::StaticOrder S; S.init(M, D, G, bx); \
        EpiResGate E{(const float*)(ws + WS_X1), (const float*)(ws + WS_X1) + (size_t)MP * D, MOD, 5120, A.out}; \
        pg8::gemm_phase<EpiResGate, pg8::StaticOrder, true, true>(lds, g, S, E, tid); }
#define RUNPH(k) do { if (IN(k)) { const int lane = lane_now(), tid = wave * 64 + lane, gtid = bx * 512 + tid; (void)gtid; PH##k(0) if constexpr (((REP_MASK) >> (k)) & 1) { GBAR(); PH##k(1) } } } while (0)
    RUNPH(0); SEAM(0);
    RUNPH(1); SEAM(1);
    RUNPH(2); SEAM(2);
    RUNPH(3); SEAM(3);
    RUNPH(4); SEAM(4);
    RUNPH(5); SEAM(5);
    RUNPH(6);
    if constexpr (((REP_MASK) >> 13) & 1) { GBAR(); const int lane = lane_now(), tid = wave * 64 + lane; PH6X(2, true, false, false) }
    if constexpr (((REP_MASK) >> 14) & 1) { GBAR(); const int lane = lane_now(), tid = wave * 64 + lane; PH6X(3, false, true, false) }
    if constexpr (((REP_MASK) >> 15) & 1) { GBAR(); const int lane = lane_now(), tid = wave * 64 + lane; PH6X(4, false, false, true) }
    SEAM(6);
    RUNPH(7); SEAM(7);
    RUNPH(8); SEAM(8);
    RUNPH(9); SEAM(9);
    RUNPH(10); SEAM(10);
    RUNPH(11); SEAM(11);
    RUNPH(12);
#undef IN
#undef SEAM
}

#ifndef N_LAUNCHES
#define N_LAUNCHES 1
#endif
extern "C" void kernel_launch(void* const* d_in, const int* in_sizes, int n_in, void* d_out, int out_size, void* d_ws, size_t ws_size, hipStream_t stream) {
    static int grid = 0;
    if (grid == 0) {
        if (n_in != 27 || (size_t)out_size != O_END || ws_size < WS_END) { fprintf(stderr, "kernel_launch: unexpected shapes: n_in %d out %d ws %zu\n", n_in, out_size, ws_size); grid = -1; return; }
        int dev = 0, cus = 0, per_cu = 0;
        if (hipGetDevice(&dev) != hipSuccess || hipDeviceGetAttribute(&cus, hipDeviceAttributeMultiprocessorCount, dev) != hipSuccess) { grid = -1; return; }
        if (hipFuncSetAttribute((const void*)fwd_kernel, hipFuncAttributeMaxDynamicSharedMemorySize, LDS_BYTES) != hipSuccess) { fprintf(stderr, "kernel_launch: hipFuncSetAttribute failed\n"); grid = -1; return; }
        if (hipOccupancyMaxActiveBlocksPerMultiprocessor(&per_cu, (const void*)fwd_kernel, 512, LDS_BYTES) != hipSuccess || per_cu < 1) fprintf(stderr, "kernel_launch: occupancy query says %d\n", per_cu);
        (void)hipGetLastError();
        grid = cus;
    }
    if (grid < 0) return;
    (void)hipMemsetAsync((char*)d_ws + WS_CTL, 0, CTL_ZERO_BYTES, stream);
    Args a{};
    for (int i = 0; i < 27; ++i) a.in[i] = d_in[i];
    a.out = (float*)d_out; a.ws = (unsigned char*)d_ws;
    if (N_LAUNCHES == 1) { a.lo = 0; a.hi = NPHASE; hipLaunchKernelGGL(fwd_kernel, dim3(grid), dim3(512), LDS_BYTES, stream, a); }
    else for (int p = 0; p < NPHASE; ++p) { a.lo = p; a.hi = p + 1; hipLaunchKernelGGL(fwd_kernel, dim3(grid), dim3(512), LDS_BYTES, stream, a); }
}
```

```cpp
#include <hip/hip_runtime.h>
#include <cstdio>
#include <cstdint>
#define REP_MASK 0
namespace pg8 {
#define PG8_LAS __attribute__((address_space(3)))
typedef unsigned short bf16_t;
typedef short bf16x8 __attribute__((ext_vector_type(8)));
typedef float f32x4 __attribute__((ext_vector_type(4)));
typedef unsigned u32x4 __attribute__((ext_vector_type(4)));
constexpr int BM = 256, BK = 64, HALF = 128, HTB = HALF * BK * 2  , STAGE_BYTES = 8 * HTB, NXCD = 8, WGM = 8;

__host__ __device__ __forceinline__ int lds_byte(int r, int c) { const int st = (r >> 4) * 2 + (c >> 5), rr = r & 15, cc = c & 31, ob = rr * 64 + cc * 2; return st * 1024 + (ob ^ (((ob >> 9) & 1) << 5)); }
__host__ __device__ __forceinline__ void stage_rc(int b, int& R, int& C) { const int st = b / 1024, sb = b % 1024, swz = sb ^ (((sb >> 9) & 1) << 5); R = (st >> 1) * 16 + swz / 64; C = (st & 1) * 32 + (swz % 64) / 2; }
__host__ __device__ __forceinline__ int perm32(int rho) { const int n = rho >> 4, i = rho & 15; return 8 * (i >> 2) + 4 * n + (i & 3); }

struct Unit { int pm, pn; };
struct Gemm { const bf16_t* A; const bf16_t* Bt; int M, N, K; };

struct StaticOrder {
    int nM, nN, nwg, G, c;
    __host__ __device__ void init(int M, int N, int G_, int c_) { nM = M / BM; nN = N / BM; nwg = nM * nN; G = G_; c = c_; }
    __host__ __device__ bool next(int i, Unit& u) const {
        const long L = (long)i * G + c; if (L >= nwg) return false;
        int wgid = (int)L; { const int q = nwg / NXCD, r = nwg % NXCD, xcd = wgid % NXCD, off = wgid / NXCD; wgid = (xcd < r ? xcd * (q + 1) : r * (q + 1) + (xcd - r) * q) + off; }
        const int nig = WGM * nN, gid = wgid / nig, fm = gid * WGM, gsz = (nM - fm) < WGM ? (nM - fm) : WGM;
        u.pm = fm + ((wgid % nig) % gsz); u.pn = (wgid % nig) / gsz; return true;
    }
    __device__ __forceinline__ void a_ready(const Unit&) const {}
    __device__ __forceinline__ void done(const Unit&) const {}
};

__device__ __forceinline__ unsigned cvt_pk_bf16(float lo, float hi) { unsigned r; asm volatile("v_cvt_pk_bf16_f32 %0, %1, %2" : "=v"(r) : "v"(lo), "v"(hi)); return r; }
typedef float f32x2 __attribute__((ext_vector_type(2)));
__device__ __forceinline__ f32x2 gelu_pk(f32x2 v) {
    const f32x2 av = __builtin_elementwise_abs(v), d = av * 0.2316418882f + 1.0f;
    f32x2 t; t.x = __builtin_amdgcn_rcpf(d.x); t.y = __builtin_amdgcn_rcpf(d.y);
    f32x2 q = t * 0.5307027145f + (-0.7265760135f); q = q * t + 0.7107068705f; q = q * t + (-0.142248368f); q = q * t + 0.127414796f; q = q * t;
    const f32x2 s = (v * v) * (-0.72134752044f);
    f32x2 e; e.x = __builtin_amdgcn_exp2f(s.x); e.y = __builtin_amdgcn_exp2f(s.y);
    const f32x2 m = v * (q * e), r = v - m;
    f32x2 o; o.x = v.x < 0.f ? m.x : r.x; o.y = v.y < 0.f ? m.y : r.y; return o;
}

template <int ACT  > struct EpiBf16 {
    static constexpr bool PERM = true, AFTER_DRAIN = false; static_assert(ACT == 0 || ACT == 1, "EpiBf16: ACT is 0 (none) or 1 (gelu_pk)");
    bf16_t* O; int ldc; const float* bias; int split_cols; size_t split_stride; float scale0;
    __device__ __forceinline__ void operator()(const f32x4 (&acc)[2][2][4][2], const Unit& u, int wr, int wc, int fr, int fq) const {
        const int row0 = u.pm * BM + wr * 64 + fr; int colt = u.pn * BM; bf16_t* base = O;
        float sc = 1.f; if (split_cols) { const int t = colt / split_cols; base += (size_t)t * split_stride; colt -= t * split_cols; if (t == 0) sc = scale0; }
        const int col0 = colt + wc * 32 + 8 * fq, bcol0 = u.pn * BM + wc * 32 + 8 * fq;
        f32x4 bv[2][2];
#pragma unroll
        for (int bj = 0; bj < 2; ++bj)
#pragma unroll
            for (int n = 0; n < 2; ++n) bv[bj][n] = bias ? *(const f32x4*)(bias + bcol0 + bj * HALF + 4 * n) : (f32x4){0.f, 0.f, 0.f, 0.f};
#pragma unroll
        for (int ai = 0; ai < 2; ++ai)
#pragma unroll
            for (int m = 0; m < 4; ++m) { bf16_t* rowp = base + (size_t)(row0 + ai * HALF + m * 16) * ldc + col0;
#pragma unroll
                for (int bj = 0; bj < 2; ++bj) { f32x4 v0 = acc[ai][bj][m][0] + bv[bj][0], v1 = acc[ai][bj][m][1] + bv[bj][1];
                    if (ACT == 1) { f32x2 a = gelu_pk((f32x2){v0[0], v0[1]}), b = gelu_pk((f32x2){v0[2], v0[3]}), c = gelu_pk((f32x2){v1[0], v1[1]}), d = gelu_pk((f32x2){v1[2], v1[3]});
                        v0 = (f32x4){a.x, a.y, b.x, b.y}; v1 = (f32x4){c.x, c.y, d.x, d.y}; }
                    v0 = v0 * sc; v1 = v1 * sc; u32x4 w; w.x = cvt_pk_bf16(v0[0], v0[1]); w.y = cvt_pk_bf16(v0[2], v0[3]); w.z = cvt_pk_bf16(v1[0], v1[1]); w.w = cvt_pk_bf16(v1[2], v1[3]);
                    *(u32x4*)(rowp + bj * HALF) = w; } }
    }
};

struct PanelStats {
    unsigned* xbuf;
    unsigned* cnt;
    unsigned* tmo;
    int ntn; float eps;
    unsigned code;
    __device__ __forceinline__ bool run(const f32x4 (&v)[2][2][4][2], const Unit& u, int wr, int wc, int fr, int fq, PG8_LAS unsigned char* lds, int wid, int lane) const {
        typedef float f32x2v __attribute__((ext_vector_type(2)));
        PG8_LAS f32x2v* P = (PG8_LAS f32x2v*)lds;
        PG8_LAS f32x2v* S = (PG8_LAS f32x2v*)(lds + 8192);
        PG8_LAS unsigned* flag = (PG8_LAS unsigned*)(lds + 8192 + 2048);
#pragma unroll
        for (int ai = 0; ai < 2; ++ai)
#pragma unroll
            for (int m = 0; m < 4; ++m) {
                float s = 0.f;
#pragma unroll
                for (int bj = 0; bj < 2; ++bj)
#pragma unroll
                    for (int n = 0; n < 2; ++n) { const f32x4 x = v[ai][bj][m][n]; s += (x[0] + x[1]) + (x[2] + x[3]); }
                s += __shfl_xor(s, 16); s += __shfl_xor(s, 32);
                const float mw = s * (1.0f / 64.0f); float q = 0.f;
#pragma unroll
                for (int bj = 0; bj < 2; ++bj)
#pragma unroll
                    for (int n = 0; n < 2; ++n) { const f32x4 d = v[ai][bj][m][n] - mw; q += (d[0] * d[0] + d[1] * d[1]) + (d[2] * d[2] + d[3] * d[3]); }
                q += __shfl_xor(q, 16); q += __shfl_xor(q, 32);
                if (fq == 0) P[(ai * HALF + wr * 64 + m * 16 + fr) * 4 + wc] = (f32x2v){mw, q};
            }
        asm volatile("s_waitcnt lgkmcnt(0)" ::: "memory"); __builtin_amdgcn_s_barrier(); asm volatile("" ::: "memory");
#if defined(BROKEN_EXCHANGE_NO_WAIT)
#warning BROKEN CONTROL BUILD: the row-statistics exchange does not wait; results are wrong by design
        if (blockIdx.x >= 64) { const long long t0_ = clock64(); while (clock64() - t0_ < 60000) __builtin_amdgcn_s_sleep(8); }
#endif
        const int row = wid * 32 + (lane & 31);
        if (lane < 32) {
            const f32x2v a = P[row * 4 + 0], b = P[row * 4 + 1], c = P[row * 4 + 2], d = P[row * 4 + 3];
            const float mt = (a.x + b.x + c.x + d.x) * 0.25f;
            const float da = a.x - mt, db = b.x - mt, dc = c.x - mt, dd = d.x - mt;
            const float m2 = (a.y + b.y) + (c.y + d.y) + 64.0f * ((da * da + db * db) + (dc * dc + dd * dd));
            unsigned long long* slot = (unsigned long long*)xbuf + ((size_t)(u.pm * BM + row) * 4 + u.pn);
            __hip_atomic_store(slot, ((unsigned long long)__float_as_uint(m2) << 32) | __float_as_uint(mt), __ATOMIC_RELAXED, __HIP_MEMORY_SCOPE_AGENT);
        }
        asm volatile("s_waitcnt vmcnt(0)" ::: "memory");
        if (lane == 0) __hip_atomic_fetch_add(cnt + 64 * u.pm, 1u, __ATOMIC_RELAXED, __HIP_MEMORY_SCOPE_AGENT);
        if (wid == 0) {
            bool dead = false; const unsigned long long t0 = __builtin_amdgcn_s_memrealtime(); const unsigned want = 8u * (unsigned)ntn;
            for (;;) {
#if defined(BROKEN_EXCHANGE_NO_WAIT)
                break;
#endif
                if ((unsigned)__builtin_amdgcn_readfirstlane(__hip_atomic_load(cnt + 64 * u.pm, __ATOMIC_RELAXED, __HIP_MEMORY_SCOPE_AGENT)) >= want) break;
                if (__builtin_amdgcn_s_memrealtime() - t0 > 2000000ull) {
                    if (lane == 0) { unsigned expect = 0u; __hip_atomic_compare_exchange_strong(tmo + 1, &expect, code | (unsigned)(u.pm & 0xff), __ATOMIC_RELAXED, __ATOMIC_RELAXED, __HIP_MEMORY_SCOPE_AGENT);
                                     __hip_atomic_store(tmo, 1u, __ATOMIC_RELAXED, __HIP_MEMORY_SCOPE_AGENT); }
                    dead = true; break; }
                __builtin_amdgcn_s_sleep(2);
            }
            __builtin_amdgcn_fence(__ATOMIC_ACQUIRE, "agent");
            if (lane == 0) flag[0] = dead ? 1u : 0u;
        }
        asm volatile("s_waitcnt vmcnt(0) lgkmcnt(0)" ::: "memory"); __builtin_amdgcn_s_barrier(); asm volatile("" ::: "memory");
        const bool bad = flag[0] != 0u;
        if (lane < 32) {
            const unsigned long long* slot = (const unsigned long long*)xbuf + (size_t)(u.pm * BM + row) * 4; float mt[4], m2[4]; float ms = 0.f;
#pragma unroll
            for (int t = 0; t < 4; ++t) { if (t < ntn) { const unsigned long long w = __hip_atomic_load(slot + t, __ATOMIC_RELAXED, __HIP_MEMORY_SCOPE_AGENT); mt[t] = __uint_as_float((unsigned)w); m2[t] = __uint_as_float((unsigned)(w >> 32)); } else { mt[t] = 0.f; m2[t] = 0.f; } ms += mt[t]; }
            const float mean = ms / (float)ntn; float q = 0.f;
#pragma unroll
            for (int t = 0; t < 4; ++t) if (t < ntn) { const float dm = mt[t] - mean; q += m2[t] + 256.0f * dm * dm; }
            S[row] = (f32x2v){mean, 1.0f / sqrtf(q / (256.0f * (float)ntn) + eps)};
        }
        asm volatile("s_waitcnt lgkmcnt(0)" ::: "memory"); __builtin_amdgcn_s_barrier(); asm volatile("" ::: "memory");
        return bad;
    }
};
struct EpiLnRes {
    static constexpr bool PERM = false, AFTER_DRAIN = true;
    const float* base; float* out; int ldc; const float* bias; PanelStats st; unsigned poison;
    __device__ __forceinline__ void fused(f32x4 (&acc)[2][2][4][2], const Unit& u, int wr, int wc, int fr, int fq, PG8_LAS unsigned char* lds, int wid, int lane) const {
        typedef float f32x2v __attribute__((ext_vector_type(2)));
        const PG8_LAS f32x2v* S = (const PG8_LAS f32x2v*)(lds + 8192);
        const int col0 = u.pn * BM + wc * 32 + 4 * fq;
#pragma unroll
        for (int bj = 0; bj < 2; ++bj)
#pragma unroll
            for (int n = 0; n < 2; ++n) { const f32x4 bv = bias ? *(const f32x4*)(bias + col0 + bj * HALF + n * 16) : (f32x4){0.f, 0.f, 0.f, 0.f};
#pragma unroll
                for (int ai = 0; ai < 2; ++ai)
#pragma unroll
                    for (int m = 0; m < 4; ++m) acc[ai][bj][m][n] += bv; }
        f32x4 pre[4][2][2];
#pragma unroll
        for (int m = 0; m < 4; ++m) { const size_t off = (size_t)(u.pm * BM + wr * 64 + m * 16 + fr) * ldc + col0;
#pragma unroll
            for (int bj = 0; bj < 2; ++bj)
#pragma unroll
                for (int n = 0; n < 2; ++n) pre[m][bj][n] = *(const f32x4*)(base + off + bj * HALF + n * 16); }
        const bool bad = st.run(acc, u, wr, wc, fr, fq, lds, wid, lane) || poison != 0u;
        const float qnan = __builtin_nanf("");
#pragma unroll
        for (int ai = 0; ai < 2; ++ai)
#pragma unroll
            for (int m = 0; m < 4; ++m) { const int r = ai * HALF + wr * 64 + m * 16 + fr; const f32x2v sr = S[r]; const size_t off = (size_t)(u.pm * BM + r) * ldc + col0;
#pragma unroll
                for (int bj = 0; bj < 2; ++bj)
#pragma unroll
                    for (int n = 0; n < 2; ++n) { const f32x4 bs = ai == 0 ? pre[m][bj][n] : *(const f32x4*)(base + off + bj * HALF + n * 16); f32x4 o = bs + (acc[ai][bj][m][n] - sr.x) * sr.y;
                        if (bad) o = (f32x4){qnan, qnan, qnan, qnan}; *(f32x4*)(out + off + bj * HALF + n * 16) = o; }
                if (m & 1) asm volatile("" ::: "memory"); }
    }
};
struct EpiLnResLn {
    static constexpr bool PERM = false, AFTER_DRAIN = true;
    const float* base; float* out; bf16_t* xn; int ldc; const float* bias; PanelStats st1, st2; unsigned poison;
    __device__ __forceinline__ void fused(f32x4 (&acc)[2][2][4][2], const Unit& u, int wr, int wc, int fr, int fq, PG8_LAS unsigned char* lds, int wid, int lane) const {
        typedef float f32x2v __attribute__((ext_vector_type(2))); typedef unsigned u32x2v __attribute__((ext_vector_type(2)));
        const PG8_LAS f32x2v* S = (const PG8_LAS f32x2v*)(lds + 8192);
        const int col0 = u.pn * BM + wc * 32 + 4 * fq;
#pragma unroll
        for (int bj = 0; bj < 2; ++bj)
#pragma unroll
            for (int n = 0; n < 2; ++n) { const f32x4 bv = bias ? *(const f32x4*)(bias + col0 + bj * HALF + n * 16) : (f32x4){0.f, 0.f, 0.f, 0.f};
#pragma unroll
                for (int ai = 0; ai < 2; ++ai)
#pragma unroll
                    for (int m = 0; m < 4; ++m) acc[ai][bj][m][n] += bv; }
        bool bad = st1.run(acc, u, wr, wc, fr, fq, lds, wid, lane) || poison != 0u;
        const float qnan = __builtin_nanf("");
#pragma unroll
        for (int ai = 0; ai < 2; ++ai)
#pragma unroll
            for (int m = 0; m < 4; ++m) { const int r = ai * HALF + wr * 64 + m * 16 + fr; const f32x2v sr = S[r]; const size_t off = (size_t)(u.pm * BM + r) * ldc + col0;
#pragma unroll
                for (int bj = 0; bj < 2; ++bj)
#pragma unroll
                    for (int n = 0; n < 2; ++n) { const f32x4 bs = *(const f32x4*)(base + off + bj * HALF + n * 16); acc[ai][bj][m][n] = bs + (acc[ai][bj][m][n] - sr.x) * sr.y; }
                asm volatile("" : "+v"(acc[ai][0][m][0]), "+v"(acc[ai][0][m][1]), "+v"(acc[ai][1][m][0]), "+v"(acc[ai][1][m][1]));
                if (m & 1) asm volatile("" ::: "memory"); }
        const bool bad1 = bad;
        bad = st2.run(acc, u, wr, wc, fr, fq, lds, wid, lane) || bad;
#pragma unroll
        for (int ai = 0; ai < 2; ++ai)
#pragma unroll
            for (int m = 0; m < 4; ++m) { const int r = ai * HALF + wr * 64 + m * 16 + fr; const f32x2v sr = S[r]; const size_t off = (size_t)(u.pm * BM + r) * ldc + col0;
#pragma unroll
                for (int bj = 0; bj < 2; ++bj)
#pragma unroll
                    for (int n = 0; n < 2; ++n) { const f32x4 x1 = acc[ai][bj][m][n]; *(f32x4*)(out + off + bj * HALF + n * 16) = bad1 ? (f32x4){qnan, qnan, qnan, qnan} : x1;
                        const f32x4 o = (x1 - sr.x) * sr.y; u32x2v w; w.x = cvt_pk_bf16(o[0], o[1]); w.y = cvt_pk_bf16(o[2], o[3]);
                        if (bad) { w.x = 0x7fc07fc0u; w.y = 0x7fc07fc0u; } *(u32x2v*)(xn + off + bj * HALF + n * 16) = w; }
                asm volatile("" ::: "memory"); }
    }
};

template <class Epi, class Sched, bool ALIGN_EPI = false, bool SP2 = false>
__device__ __forceinline__ void gemm_phase(PG8_LAS unsigned char* lds, const Gemm g, const Sched& S, const Epi& E, const int tid) {
    const int wid = __builtin_amdgcn_readfirstlane(tid >> 6), lane = tid & 63, wr = wid >> 2, wc = wid & 3, fr = lane & 15, fq = lane >> 4;
    const int K = g.K, nt = K / BK;
    unsigned voffA[2], voffB[2];
#pragma unroll
    for (int i = 0; i < 2; ++i) { int R, C; stage_rc(tid * 16 + i * 8192, R, C); const int Rb = Epi::PERM ? ((R & ~31) + perm32(R & 31)) : R;
        voffA[i] = (unsigned)(R * K + C) * 2u; voffB[i] = (unsigned)(Rb * K + C) * 2u; }
    const size_t kstep = (size_t)(BK * 2);
    const size_t hstep = (size_t)HALF * K * 2;
    const size_t tstep = 2 * hstep;
    const unsigned ldsw = (unsigned)wid * 1024u;
    const int aoff = lds_byte(wr * 64 + fr, fq * 8), boff = lds_byte(wc * 32 + fr, fq * 8);
#define PG8_SA(b, h) (((b) * 2 + (h)) * HTB)
#define PG8_SB(b, h) ((4 + (b) * 2 + (h)) * HTB)
#define PG8_STAGE(bufoff, gbase, voff) do { _Pragma("unroll") for (int _i = 0; _i < 2; ++_i) \
        __builtin_amdgcn_global_load_lds((const unsigned*)((const char*)(gbase) + (voff)[_i]), (PG8_LAS unsigned*)(lds + (bufoff) + ldsw + _i * 8192), 16, 0, 0); } while (0)
#define PG8_LDA(dst, b, h) do { _Pragma("unroll") for (int m = 0; m < 4; ++m) _Pragma("unroll") for (int k = 0; k < 2; ++k) dst[m][k] = *(const PG8_LAS bf16x8*)(lds + PG8_SA(b, h) + aoff + m * 2048 + k * 1024); } while (0)
#define PG8_LDB(dst, b, h) do { _Pragma("unroll") for (int n = 0; n < 2; ++n) _Pragma("unroll") for (int k = 0; k < 2; ++k) dst[n][k] = *(const PG8_LAS bf16x8*)(lds + PG8_SB(b, h) + boff + n * 2048 + k * 1024); } while (0)
#define PG8_MMA(ai, bj, At, Bt) do { __builtin_amdgcn_s_setprio(1); _Pragma("unroll") for (int m = 0; m < 4; ++m) _Pragma("unroll") for (int n = 0; n < 2; ++n) _Pragma("unroll") for (int k = 0; k < 2; ++k) \
        acc[ai][bj][m][n] = __builtin_amdgcn_mfma_f32_16x16x32_bf16(Bt[n][k], At[m][k], acc[ai][bj][m][n], 0, 0, 0); __builtin_amdgcn_s_setprio(0); } while (0)
#define PG8_WAIT_V(n) asm volatile("s_waitcnt vmcnt(" #n ")" ::: "memory")
#define PG8_WAIT_L(n) asm volatile("s_waitcnt lgkmcnt(" #n ")" ::: "memory")
#define PG8_BAR __builtin_amdgcn_s_barrier()
#define PG8_SCHED __builtin_amdgcn_sched_barrier(0)
    Unit cur, nxt; int ui = 0;
    if (!S.next(0, cur)) return;
    f32x4 acc[2][2][4][2];
#pragma unroll
    for (int a = 0; a < 2; ++a)
#pragma unroll
        for (int b = 0; b < 2; ++b)
#pragma unroll
            for (int m = 0; m < 4; ++m)
#pragma unroll
                for (int n = 0; n < 2; ++n) acc[a][b][m][n] = (f32x4){0.f, 0.f, 0.f, 0.f};
    bf16x8 At[4][2], B0[2][2], B1[2][2];
    const char* cA = (const char*)g.A + (size_t)cur.pm * tstep; const char* cB = (const char*)g.Bt + (size_t)cur.pn * tstep;
    S.a_ready(cur);
    if constexpr (SP2) {
        PG8_STAGE(PG8_SB(0, 0), cB, voffB); PG8_STAGE(PG8_SB(0, 1), cB + hstep, voffB); PG8_STAGE(PG8_SA(0, 0), cA, voffA); PG8_STAGE(PG8_SA(0, 1), cA + hstep, voffA);
        if (wr == 1) PG8_BAR;
        PG8_WAIT_V(2); PG8_BAR;
        PG8_STAGE(PG8_SB(1, 0), cB + kstep, voffB); PG8_STAGE(PG8_SA(1, 0), cA + kstep, voffA); PG8_STAGE(PG8_SB(1, 1), cB + hstep + kstep, voffB);
        PG8_WAIT_V(6); PG8_BAR;
    } else {
        PG8_STAGE(PG8_SB(0, 0), cB, voffB); PG8_STAGE(PG8_SA(0, 0), cA, voffA); PG8_STAGE(PG8_SB(0, 1), cB + hstep, voffB); PG8_STAGE(PG8_SA(0, 1), cA + hstep, voffA);
        if (wr == 1) PG8_BAR;
        PG8_WAIT_V(4); PG8_BAR;
        PG8_STAGE(PG8_SB(1, 0), cB + kstep, voffB); PG8_STAGE(PG8_SA(1, 0), cA + kstep, voffA); PG8_STAGE(PG8_SB(1, 1), cB + hstep + kstep, voffB);
        PG8_WAIT_V(6); PG8_BAR;
    }
    for (;;) {
        const bool has_next = S.next(ui + 1, nxt);
        const char* nA = has_next ? (const char*)g.A + (size_t)nxt.pm * tstep : cA; const char* nB = has_next ? (const char*)g.Bt + (size_t)nxt.pn * tstep : cB;
        for (int t = 0; t < nt; t += 2) {
            const bool last = (t == nt - 2);
            const char* a1 = cA + (size_t)(t + 1) * kstep;
            const char* a2 = last ? nA : cA + (size_t)(t + 2) * kstep; const char* b2 = last ? nB : cB + (size_t)(t + 2) * kstep;
            const char* a3 = a2 + kstep; const char* b3 = b2 + kstep;
            if (last && has_next) S.a_ready(nxt);
            if constexpr (SP2) {
            PG8_LDB(B0, 0, 0); PG8_LDB(B1, 0, 1); PG8_SCHED; PG8_LDA(At, 0, 0); PG8_STAGE(PG8_SA(1, 1), a1 + hstep, voffA);
            PG8_WAIT_V(8); PG8_WAIT_L(0); PG8_BAR; PG8_MMA(0, 0, At, B0); PG8_MMA(0, 1, At, B1); PG8_BAR; PG8_SCHED;
            PG8_LDA(At, 0, 1); PG8_STAGE(PG8_SB(0, 0), b2, voffB); PG8_STAGE(PG8_SB(0, 1), b2 + hstep, voffB); PG8_STAGE(PG8_SA(0, 0), a2, voffA);
            PG8_WAIT_V(8); PG8_WAIT_L(0); PG8_BAR; PG8_MMA(1, 0, At, B0); PG8_MMA(1, 1, At, B1); PG8_BAR; PG8_SCHED;
            PG8_LDB(B0, 1, 0); PG8_LDB(B1, 1, 1); PG8_SCHED; PG8_LDA(At, 1, 0); PG8_STAGE(PG8_SA(0, 1), a2 + hstep, voffA);
            PG8_WAIT_V(8); PG8_WAIT_L(0); PG8_BAR; PG8_MMA(0, 0, At, B0); PG8_MMA(0, 1, At, B1); PG8_BAR; PG8_SCHED;
            PG8_LDA(At, 1, 1); PG8_STAGE(PG8_SB(1, 0), b3, voffB); PG8_STAGE(PG8_SB(1, 1), b3 + hstep, voffB); PG8_STAGE(PG8_SA(1, 0), a3, voffA);
            PG8_WAIT_V(8); PG8_WAIT_L(0); PG8_BAR; PG8_MMA(1, 0, At, B0); PG8_MMA(1, 1, At, B1); PG8_BAR; PG8_SCHED;
            } else {
            PG8_LDB(B0, 0, 0); PG8_SCHED; PG8_LDA(At, 0, 0); PG8_STAGE(PG8_SA(1, 1), a1 + hstep, voffA);
            PG8_WAIT_L(8); PG8_BAR; PG8_WAIT_L(0); PG8_MMA(0, 0, At, B0); PG8_BAR; PG8_SCHED;
            PG8_LDB(B1, 0, 1); PG8_STAGE(PG8_SB(0, 0), b2, voffB);
            PG8_BAR; PG8_WAIT_L(0); PG8_MMA(0, 1, At, B1); PG8_BAR;
            PG8_LDA(At, 0, 1); PG8_STAGE(PG8_SA(0, 0), a2, voffA);
            PG8_BAR; PG8_WAIT_L(0); PG8_MMA(1, 0, At, B0); PG8_BAR; PG8_SCHED;
            PG8_STAGE(PG8_SB(0, 1), b2 + hstep, voffB);
            PG8_WAIT_V(6); PG8_BAR; PG8_MMA(1, 1, At, B1); PG8_BAR;
            PG8_LDB(B0, 1, 0); PG8_SCHED; PG8_LDA(At, 1, 0); PG8_STAGE(PG8_SA(0, 1), a2 + hstep, voffA);
            PG8_WAIT_L(8); PG8_BAR; PG8_WAIT_L(0); PG8_MMA(0, 0, At, B0); PG8_BAR; PG8_SCHED;
            PG8_LDB(B1, 1, 1); PG8_STAGE(PG8_SB(1, 0), b3, voffB);
            PG8_BAR; PG8_WAIT_L(0); PG8_MMA(0, 1, At, B1); PG8_BAR;
            PG8_LDA(At, 1, 1); PG8_STAGE(PG8_SA(1, 0), a3, voffA);
            PG8_BAR; PG8_WAIT_L(0); PG8_MMA(1, 0, At, B0); PG8_BAR; PG8_SCHED;
            PG8_STAGE(PG8_SB(1, 1), b3 + hstep, voffB);
            PG8_WAIT_V(6); PG8_BAR; PG8_MMA(1, 1, At, B1); PG8_BAR;
            }
        }
        if constexpr (ALIGN_EPI) { if (wr == 0) PG8_BAR; }
        if constexpr (!Epi::AFTER_DRAIN) { E(acc, cur, wr, wc, fr, fq); S.done(cur); }
        if (!has_next) break;
#pragma unroll
        for (int a = 0; a < 2; ++a)
#pragma unroll
            for (int b = 0; b < 2; ++b)
#pragma unroll
                for (int m = 0; m < 4; ++m)
#pragma unroll
                    for (int n = 0; n < 2; ++n) acc[a][b][m][n] = (f32x4){0.f, 0.f, 0.f, 0.f};
        cur = nxt; cA = nA; cB = nB; ++ui;
        if constexpr (ALIGN_EPI) { if (wr == 1) PG8_BAR; }
    }
    PG8_WAIT_V(0);
    if constexpr (!ALIGN_EPI) { if (wr == 0) PG8_BAR; }
    PG8_BAR;
    if constexpr (Epi::AFTER_DRAIN) { E.fused(acc, cur, wr, wc, fr, fq, lds, wid, lane); S.done(cur); }
#undef PG8_SA
#undef PG8_SB
#undef PG8_STAGE
#undef PG8_LDA
#undef PG8_LDB
#undef PG8_MMA
#undef PG8_WAIT_V
#undef PG8_WAIT_L
#undef PG8_BAR
#undef PG8_SCHED
}
}

#define GAS __attribute__((address_space(1)))
#define LAS __attribute__((address_space(3)))
typedef unsigned short bf16;
typedef float f32x4 __attribute__((ext_vector_type(4)));
typedef float f32x16 __attribute__((ext_vector_type(16)));
typedef short bf16x8 __attribute__((ext_vector_type(8)));
typedef short s16x4 __attribute__((ext_vector_type(4)));
typedef unsigned u32x4 __attribute__((ext_vector_type(4)));
typedef unsigned u32x2 __attribute__((ext_vector_type(2)));
typedef float f32x2_t __attribute__((ext_vector_type(2)));
typedef __bf16 bf16x2_t __attribute__((ext_vector_type(2)));
typedef GAS unsigned gu32;
#define RLX_AGENT __ATOMIC_RELAXED, __HIP_MEMORY_SCOPE_AGENT

constexpr int D = 1024, BP = 4, TP = 4096, MP = BP * TP, BS = 128, TS = 8, MS = BS * TS, M = MP + MS;
constexpr int SBH = 8, HD = 64, SBW = 512, DNH = 4, DND = 128, DNW = 512;
constexpr int IN_COLS = 3592, NPROJ = 3584;
constexpr int DFF = 2816, DFF2 = 5632, NMOD = 6144, NC = BP + BS;
constexpr int PAST = 2048, NPAGES = 16, PAGE = 128;
constexpr float EPS = 1e-6f, LOG2E = 1.4426950408889634f;
constexpr float QSCALE = 0.125f * LOG2E;
constexpr int NSPLIT = 4, NPART = 5;

constexpr size_t O_YP = 0, O_KP = 17825792, O_VP = 26214400, O_KS = 34603008, O_VS = 35127296, O_SP = 35651584, O_SS = 35913728,
                 O_DCP = 44302336, O_DCS = 44320768, O_FCP = 44910592, O_FCS = 44955648, O_END = 46397440;

constexpr size_t MiB = 1u << 20;
constexpr size_t WS_CTL = 0, CTL_ZERO_BYTES = MiB;
constexpr size_t WS_MOD = 1 * MiB, WS_SC = 5 * MiB, WS_WINX = 6 * MiB, WS_WIN_T = 7 * MiB, WS_WOUT_T = 14 * MiB, WS_WUP_T = 16 * MiB, WS_WDN_T = 27 * MiB,
                 WS_EXTRA = 33 * MiB, WS_H = 34 * MiB, WS_DNRAW = 68 * MiB, WS_ZG = 120 * MiB, WS_QB = 306 * MiB, WS_KB = 323 * MiB, WS_VB = 340 * MiB, WS_QD = 357 * MiB, WS_KD = 391 * MiB,
                 WS_VD = 425 * MiB, WS_BETA = 459 * MiB, WS_LOGA = 460 * MiB, WS_ODN = 461 * MiB, WS_MIXED = 495 * MiB, WS_X1 = 529 * MiB, WS_UP = 597 * MiB,
                 WS_ACT = 784 * MiB, WS_U = 878 * MiB, WS_KCUM = 910 * MiB, WS_QDEC = 926 * MiB, WS_KDECT = 942 * MiB, WS_INTRA = 958 * MiB, WS_GL = 966 * MiB,
                 WS_OPART = 967 * MiB, WS_LPART = 978 * MiB, WS_END = 979 * MiB;
constexpr int CW_QUEUE = 64;
constexpr int CW_BAR = 4096;

constexpr int RING_BYTES = 131072, MISC_OFF = RING_BYTES + 320, LDS_BYTES = 147456;

__device__ __forceinline__ unsigned cvtpk(float lo, float hi) { f32x2_t v = {lo, hi}; bf16x2_t b = __builtin_convertvector(v, bf16x2_t); return __builtin_bit_cast(unsigned, b); }
__device__ __forceinline__ bf16 f2bf(float f) { return (bf16)(cvtpk(f, 0.f) & 0xffffu); }
__device__ __forceinline__ float wave_sum(float v) {
#pragma unroll
    for (int o = 1; o < 64; o <<= 1) v += __shfl_xor(v, o);
    return v;
}
__device__ __forceinline__ float siluf(float x) { return x / (1.f + __expf(-x)); }
__device__ __forceinline__ u32x4 pack8(const f32x4 a, const f32x4 b) { u32x4 w; w.x = cvtpk(a.x, a.y); w.y = cvtpk(a.z, a.w); w.z = cvtpk(b.x, b.y); w.w = cvtpk(b.z, b.w); return w; }
__device__ __forceinline__ float bf2f(unsigned short h) { return __uint_as_float((unsigned)h << 16); }

#define XB_TMO      128
#define XB_XCNT(j)  (256  + 64 * (j))
#define XB_XSUB(j)  (1280 + 64 * (j))
#define XB_XGEN(j)  (2304 + 64 * (j))
#define XB_TOP      3328
#define XB_TOPGEN   3392
#define XCD_BAR_WORDS 3456
#define XB_SPIN_CAP (1u << 18)
__device__ __forceinline__ unsigned xb_ld(unsigned* p)              { return __hip_atomic_load(p, __ATOMIC_RELAXED, __HIP_MEMORY_SCOPE_AGENT); }
__device__ __forceinline__ unsigned xb_add(unsigned* p, unsigned v) { return __hip_atomic_fetch_add(p, v, __ATOMIC_RELAXED, __HIP_MEMORY_SCOPE_AGENT); }
__device__ __forceinline__ unsigned xb_xcc_id() { return (unsigned)__builtin_amdgcn_s_getreg((3 << 11) | 20) & 0xFu; }
#define XB_SPIN(cond, bar) do { unsigned _sp = 0; while (cond) { __builtin_amdgcn_s_sleep(1); \
    if ((++_sp & 255u) == 0u) { if (xb_ld(&(bar)[XB_TMO])) break; if (_sp > XB_SPIN_CAP) { atomicAdd(&(bar)[XB_TMO], 1u); break; } } } } while (0)
struct XcdBarrier { unsigned* bar; unsigned x; volatile LAS unsigned* st; };
__device__ __forceinline__ XcdBarrier xcd_barrier_post(unsigned* bar, volatile LAS unsigned* st, int tid) {
    XcdBarrier b; b.bar = bar; b.x = xb_xcc_id(); b.st = st;
    if (tid == 0) (void)xb_add(&bar[XB_XCNT(b.x)], 1u);
    return b;
}
__device__ __forceinline__ void xcd_barrier_complete(unsigned* bar, unsigned x, unsigned& nloc, unsigned& nx) {
    const unsigned G = gridDim.x * gridDim.y * gridDim.z;
    unsigned sum, cnt, mine, sp = 0u;
    for (;;) {
        sum = 0u; cnt = 0u; mine = 0u;
#pragma unroll
        for (unsigned j = 0; j < 16; ++j) { const unsigned c = xb_ld(&bar[XB_XCNT(j)]); sum += c; cnt += (c > 0u) ? 1u : 0u; mine = (j == x) ? c : mine; }
        if (sum == G) break;
        __builtin_amdgcn_s_sleep(1);
        if ((++sp & 255u) == 0u) { if (xb_ld(&bar[XB_TMO])) break; if (sp > XB_SPIN_CAP) { atomicAdd(&bar[XB_TMO], 1u); break; } }
    }
    nloc = mine > 0u ? mine : 1u; nx = cnt > 0u ? cnt : 1u;
}
__device__ __forceinline__ void xcd_barrier(const XcdBarrier& b, int tid) {
    asm volatile("s_waitcnt vmcnt(0)" ::: "memory");
    __syncthreads();
    if (tid == 0) {
        unsigned* bar = b.bar;
        __builtin_amdgcn_s_waitcnt(0);
        unsigned nloc = b.st[0], nx = b.st[1];
        if (nloc == 0u) { xcd_barrier_complete(bar, b.x, nloc, nx); b.st[0] = nloc; b.st[1] = nx; }
        const unsigned old = xb_add(&bar[XB_XSUB(b.x)], 1u);
        const unsigned gen = old / nloc;
        if (old + 1u == (gen + 1u) * nloc) {
            __builtin_amdgcn_fence(__ATOMIC_RELEASE, "agent");
            asm volatile("s_waitcnt vmcnt(0)" ::: "memory");
            const unsigned og = xb_add(&bar[XB_TOP], 1u);
            const unsigned tg = og / nx;
            if (og + 1u == (tg + 1u) * nx) xb_add(&bar[XB_TOPGEN], 1u);
            else XB_SPIN(xb_ld(&bar[XB_TOPGEN]) == tg, bar);
            __builtin_amdgcn_fence(__ATOMIC_ACQUIRE, "agent");
            xb_add(&bar[XB_XGEN(b.x)], 1u);
            asm volatile("s_waitcnt vmcnt(0)" ::: "memory");
        } else {
            XB_SPIN(xb_ld(&bar[XB_XGEN(b.x)]) == gen, bar);
            __builtin_amdgcn_fence(__ATOMIC_ACQUIRE, "agent");
            asm volatile("s_waitcnt vmcnt(0)" ::: "memory");
        }
    }
    __syncthreads();
}

__device__ __forceinline__ int lane_now() { int l; asm volatile("v_mbcnt_lo_u32_b32 %0, -1, 0\n\tv_mbcnt_hi_u32_b32 %0, -1, %0" : "=v"(l)); return l; }
struct Args { const void* in[27]; float* out; unsigned char* ws; int lo, hi; };
enum { I_XP = 0, I_XS, I_CP, I_CS, I_CK, I_CV, I_PT, I_SD, I_SDC, I_SFC, I_WADA, I_BADA, I_GATT, I_WIN, I_GQ, I_GK, I_SBB, I_GSBO, I_WDNC, I_ALOG, I_DTB, I_GDNO, I_WOUT, I_GFFN, I_WUP, I_WFC, I_WDN };

__device__ __forceinline__ int mod_row(int m) { return m < MP ? (m >> 12) : BP + ((m - MP) >> 3); }

struct EpiF32 {
    static constexpr bool PERM = false, AFTER_DRAIN = false;
    float* O; int ldc;
    __device__ __forceinline__ void operator()(const pg8::f32x4 (&acc)[2][2][4][2], const pg8::Unit& u, int wr, int wc, int fr, int fq) const {
        const int row0 = u.pm * 256 + wr * 64 + fr, col0 = u.pn * 256 + wc * 32 + 4 * fq;
#pragma unroll
        for (int ai = 0; ai < 2; ++ai)
#pragma unroll
            for (int m = 0; m < 4; ++m) { float* rowp = O + (size_t)(row0 + ai * 128 + m * 16) * ldc + col0;
#pragma unroll
                for (int bj = 0; bj < 2; ++bj)
#pragma unroll
                    for (int n = 0; n < 2; ++n) *(pg8::f32x4*)(rowp + bj * 128 + n * 16) = acc[ai][bj][m][n]; }
    }
};
struct EpiResGate {
    static constexpr bool PERM = false, AFTER_DRAIN = false;
    const float* base0; const float* base1; const float* mod; int goff; float* out;
    __device__ __forceinline__ void operator()(const pg8::f32x4 (&acc)[2][2][4][2], const pg8::Unit& u, int wr, int wc, int fr, int fq) const {
        const int row0 = u.pm * 256 + wr * 64 + fr, col0 = u.pn * 256 + wc * 32 + 4 * fq;
#pragma unroll
        for (int ai = 0; ai < 2; ++ai)
#pragma unroll
            for (int m = 0; m < 4; ++m) { const int r = row0 + ai * 128 + m * 16;
                const float* bp = (r < MP ? base0 + (size_t)r * D : base1 + (size_t)(r - MP) * D) + col0;
                const float* gp = mod + (size_t)mod_row(r) * NMOD + goff + col0; float* op = out + (size_t)r * D + col0;
#pragma unroll
                for (int bj = 0; bj < 2; ++bj)
#pragma unroll
                    for (int n = 0; n < 2; ++n) { const pg8::f32x4 b = *(const pg8::f32x4*)(bp + bj * 128 + n * 16), g = *(const pg8::f32x4*)(gp + bj * 128 + n * 16);
                        *(pg8::f32x4*)(op + bj * 128 + n * 16) = b + g * acc[ai][bj][m][n]; } }
    }
};

__device__ __forceinline__ void st16(void* base, unsigned off, u32x4 v) { *(u32x4*)((unsigned char*)base + off) = v; }
__device__ __forceinline__ void st16f(void* base, unsigned off, pg8::f32x4 v) { *(pg8::f32x4*)((unsigned char*)base + off) = v; }
struct EpiProj {
    static constexpr bool PERM = true, AFTER_DRAIN = false;
    float* out; bf16* QB; bf16* KB; bf16* VB; bf16* DNRAW; bf16* ZG; const float* g_q; const float* g_k; LAS float* xl;
    __device__ __forceinline__ void operator()(const pg8::f32x4 (&acc)[2][2][4][2], const pg8::Unit& u, int wr, int wc, int fr, int fq) const {
        const int pn = u.pn, rl0 = wr * 64 + fr, c0 = wc * 32 + 8 * fq;
        const unsigned row0 = (unsigned)u.pm * 256u + (unsigned)rl0;
        const bool prompt_tile = u.pm < MP / 256;
        if (pn < 4) {
            int xb = (rl0 * 8 + wc) * 4, xb2 = (rl0 * 8 + (wc ^ 1)) * 4; asm volatile("" : "+v"(xb), "+v"(xb2));
            LAS float* xw = (LAS float*)((LAS unsigned char*)xl + xb); const LAS float* xr = (const LAS float*)((LAS unsigned char*)xl + xb2);
#pragma unroll
            for (int ai = 0; ai < 2; ++ai)
#pragma unroll
                for (int m = 0; m < 4; ++m)
#pragma unroll
                    for (int bj = 0; bj < 2; ++bj) { const pg8::f32x4 a = acc[ai][bj][m][0], b = acc[ai][bj][m][1];
                        float ss = (a[0] * a[0] + a[1] * a[1]) + (a[2] * a[2] + a[3] * a[3]) + (b[0] * b[0] + b[1] * b[1]) + (b[2] * b[2] + b[3] * b[3]);
                        ss += __shfl_xor(ss, 16); ss += __shfl_xor(ss, 32);
                        if (fq == 0) xw[(ai * 128 + m * 16) * 8 + bj * 4] = ss; }
            asm volatile("s_waitcnt lgkmcnt(0)" ::: "memory"); __builtin_amdgcn_s_barrier(); asm volatile("" ::: "memory");
            const bool isq = pn < 2; const float* g = isq ? g_q : g_k; const int dloc = 32 * (wc & 1) + 8 * fq;
            const pg8::f32x4 g0 = *(const pg8::f32x4*)(g + dloc), g1 = *(const pg8::f32x4*)(g + dloc + 4);
            bf16* dstb = isq ? QB : KB; float* dstf = prompt_tile ? out + O_KP : out + O_KS - (size_t)MP * SBW;
#pragma unroll
            for (int ai = 0; ai < 2; ++ai)
#pragma unroll
                for (int m = 0; m < 4; ++m) { const unsigned row = row0 + ai * 128 + m * 16;
#pragma unroll
                    for (int bj = 0; bj < 2; ++bj) { const float tot = xw[(ai * 128 + m * 16) * 8 + bj * 4] + xr[(ai * 128 + m * 16) * 8 + bj * 4];
                        const float rs = (isq ? QSCALE : 1.0f) / sqrtf(tot * (1.f / HD) + EPS);
                        const pg8::f32x4 a = acc[ai][bj][m][0] * rs * g0, b = acc[ai][bj][m][1] * rs * g1;
                        const unsigned e = row * SBW + (unsigned)((pn & 1) * 256 + bj * 128 + c0);
                        st16(dstb, e * 2u, pack8(a, b));
                        if (!isq) { st16f(dstf, e * 4u, a); st16f(dstf, e * 4u + 16u, b); } }
                    asm volatile("" ::: "memory"); }
            asm volatile("s_waitcnt lgkmcnt(0)" ::: "memory"); __builtin_amdgcn_s_barrier(); asm volatile("" ::: "memory");
        } else if (pn < 6) {
            float* dstf = prompt_tile ? out + O_VP : out + O_VS - (size_t)MP * SBW;
#pragma unroll
            for (int ai = 0; ai < 2; ++ai)
#pragma unroll
                for (int m = 0; m < 4; ++m) { const unsigned row = row0 + ai * 128 + m * 16;
#pragma unroll
                    for (int bj = 0; bj < 2; ++bj) { const pg8::f32x4 a = acc[ai][bj][m][0], b = acc[ai][bj][m][1]; const unsigned e = row * SBW + (unsigned)((pn & 1) * 256 + bj * 128 + c0);
                        st16(VB, e * 2u, pack8(a, b)); st16f(dstf, e * 4u, a); st16f(dstf, e * 4u + 16u, b); }
                    asm volatile("" ::: "memory"); }
        } else if (pn < 12) {
#pragma unroll
            for (int ai = 0; ai < 2; ++ai)
#pragma unroll
                for (int m = 0; m < 4; ++m) { const unsigned row = row0 + ai * 128 + m * 16;
                    const int b = prompt_tile ? (int)(row >> 12) : (int)((row - MP) >> 3), t = prompt_tile ? (int)(row & 4095) : (int)((row - MP) & 7), idx = prompt_tile ? t - (TP - 3) : t - (TS - 3);
#pragma unroll
                    for (int bj = 0; bj < 2; ++bj) { const pg8::f32x4 a = acc[ai][bj][m][0], b2 = acc[ai][bj][m][1]; const unsigned ch = (unsigned)((pn - 6) * 256 + bj * 128 + c0);
                        st16(DNRAW, (row * 1536u + ch) * 2u, pack8(a, b2));
                        if (idx >= 0) { float* o = prompt_tile ? out + O_DCP : out + O_DCS; const unsigned eo = ((unsigned)(b * 3 + idx) * 1536u + ch) * 4u; st16f(o, eo, a); st16f(o, eo + 16u, b2); } }
                    asm volatile("" ::: "memory"); }
        } else {
#pragma unroll
            for (int ai = 0; ai < 2; ++ai)
#pragma unroll
                for (int m = 0; m < 4; ++m) { const unsigned row = row0 + ai * 128 + m * 16;
#pragma unroll
                    for (int bj = 0; bj < 2; ++bj) { pg8::f32x4 a = acc[ai][bj][m][0], b = acc[ai][bj][m][1]; const unsigned e = row * DNW + (unsigned)((pn - 12) * 256 + bj * 128 + c0);
                        a[0] = siluf(a[0]); a[1] = siluf(a[1]); a[2] = siluf(a[2]); a[3] = siluf(a[3]); b[0] = siluf(b[0]); b[1] = siluf(b[1]); b[2] = siluf(b[2]); b[3] = siluf(b[3]);
                        st16(ZG, e * 2u, pack8(a, b)); }
                    asm volatile("" ::: "memory"); }
        }
    }
};

__device__ __forceinline__ void transpose_item(const float* W, int ldw, int src_col0, bf16* WT, int Kdst, int dst_row0, int k0, LAS float* scr, int lane) {
#pragma unroll 8
    for (int i = 0; i < 32; ++i) { const int kk = 2 * i + (lane >> 5); scr[kk * 33 + (lane & 31)] = W[(size_t)(k0 + kk) * ldw + src_col0 + (lane & 31)]; }
    asm volatile("s_waitcnt lgkmcnt(0)" ::: "memory");
    const int c = lane & 7;
#pragma unroll
    for (int j = 0; j < 4; ++j) { const int n = (lane >> 3) + 8 * j; const LAS float* s = scr + (8 * c) * 33 + n;
        u32x4 o; o.x = cvtpk(s[0 * 33], s[1 * 33]); o.y = cvtpk(s[2 * 33], s[3 * 33]); o.z = cvtpk(s[4 * 33], s[5 * 33]); o.w = cvtpk(s[6 * 33], s[7 * 33]);
        *(u32x4*)(WT + (size_t)(dst_row0 + n) * Kdst + k0 + 8 * c) = o; }
    asm volatile("s_waitcnt lgkmcnt(0)" ::: "memory");
}
__device__ __forceinline__ void phase_prologue(const Args& A, LAS unsigned char* lds, int gw, int NGW, int wave, int lane, int gtid, int NGT) {
    unsigned char* ws = A.ws;
    LAS float* scr = (LAS float*)(lds + wave * 16384);
    const float* w_in = (const float*)A.in[I_WIN]; const float* w_out = (const float*)A.in[I_WOUT]; const float* w_up = (const float*)A.in[I_WUP]; const float* w_dn = (const float*)A.in[I_WDN];
    constexpr int I_IN = 16 * (NPROJ / 32), I_OUT = 16 * 32, I_UP = 16 * (DFF2 / 32), I_DN = (DFF / 64) * 32, NIT = I_IN + I_OUT + I_UP + I_DN;
    for (int it = gw; it < NIT; it += NGW) {
        int r = it;
        if (r < I_IN) { const int nb = r % (NPROJ / 32), kb = r / (NPROJ / 32); const int n0 = nb * 32; transpose_item(w_in, IN_COLS, n0 < 3072 ? n0 : n0 + 8, (bf16*)(ws + WS_WIN_T), D, n0, kb * 64, scr, lane); continue; } r -= I_IN;
        if (r < I_OUT) { const int nb = r % 32, kb = r / 32; transpose_item(w_out, D, nb * 32, (bf16*)(ws + WS_WOUT_T), D, nb * 32, kb * 64, scr, lane); continue; } r -= I_OUT;
        if (r < I_UP) { const int nb = r % (DFF2 / 32), kb = r / (DFF2 / 32); transpose_item(w_up, DFF2, nb * 32, (bf16*)(ws + WS_WUP_T), D, nb * 32, kb * 64, scr, lane); continue; } r -= I_UP;
        { const int nb = r % 32, kb = r / 32; transpose_item(w_dn, D, nb * 32, (bf16*)(ws + WS_WDN_T), DFF, nb * 32, kb * 64, scr, lane); }
    }
    bf16* SC = (bf16*)(ws + WS_SC); const float* cp = (const float*)A.in[I_CP]; const float* cs = (const float*)A.in[I_CS];
    for (int i = gtid; i < 144 * D; i += NGT) { const int r = i >> 10, k = i & 1023; float v = 0.f; if (r < BP) v = cp[r * D + k]; else if (r < NC) v = cs[(r - BP) * D + k]; SC[i] = (r < NC) ? f2bf(siluf(v)) : (bf16)0; }
    float* WX = (float*)(ws + WS_WINX);
    for (int i = gtid; i < 8 * D; i += NGT) { const int j = i >> 10, k = i & 1023; WX[i] = w_in[(size_t)k * IN_COLS + 3072 + j]; }
}

__device__ __forceinline__ void phase_mod(const Args& A, int gw, int NGW, int lane) {
    const float* w_ada = (const float*)A.in[I_WADA]; const float* b_ada = (const float*)A.in[I_BADA];
    const bf16* SC = (const bf16*)(A.ws + WS_SC); float* MOD = (float*)(A.ws + WS_MOD);
    const int lr = lane & 15, q = lane >> 4;
    for (int it = gw; it < NMOD / 16; it += NGW) {
        const int col = it * 16 + lr;
        pg8::f32x4 acc[9];
#pragma unroll
        for (int i = 0; i < 9; ++i) acc[i] = (pg8::f32x4){0.f, 0.f, 0.f, 0.f};
#pragma unroll 2
        for (int s = 0; s < 32; ++s) {
            const float* wp = w_ada + (size_t)(32 * s + 8 * q) * NMOD + col;
            float w[8];
#pragma unroll
            for (int j = 0; j < 8; ++j) w[j] = wp[(size_t)j * NMOD];
            u32x4 bw; bw.x = cvtpk(w[0], w[1]); bw.y = cvtpk(w[2], w[3]); bw.z = cvtpk(w[4], w[5]); bw.w = cvtpk(w[6], w[7]);
            const bf16x8 bfr = __builtin_bit_cast(bf16x8, bw);
#pragma unroll
            for (int i = 0; i < 9; ++i) { const bf16x8 a = *(const bf16x8*)(SC + (size_t)(16 * i + lr) * D + 32 * s + 8 * q); acc[i] = __builtin_amdgcn_mfma_f32_16x16x32_bf16(a, bfr, acc[i], 0, 0, 0); }
        }
        const float bb = b_ada[col];
#pragma unroll
        for (int i = 0; i < 9; ++i)
#pragma unroll
            for (int r = 0; r < 4; ++r) { const int row = 16 * i + 4 * q + r; if (row < NC) MOD[(size_t)row * NMOD + col] = acc[i][r] + bb; }
    }
}

template <bool EXTRAS>
__device__ __forceinline__ void phase_norm(const float* x0, const float* x1, const float* g, const float* MOD, int sh_off, int sc_off, bf16* H, const float* WX, float* EXTRA, int gw, int NGW, int lane) {
    for (int m = gw; m < M; m += NGW) {
        const float* xr = m < MP ? x0 + (size_t)m * D : x1 + (size_t)(m - MP) * D;
        const float* mod = MOD + (size_t)mod_row(m) * NMOD;
        f32x4 v[4]; float ss = 0.f;
#pragma unroll
        for (int j = 0; j < 4; ++j) { v[j] = *(const f32x4*)(xr + 4 * (lane + 64 * j)); ss += (v[j].x * v[j].x + v[j].y * v[j].y) + (v[j].z * v[j].z + v[j].w * v[j].w); }
        ss = wave_sum(ss);
        const float rstd = 1.0f / sqrtf(ss * (1.f / D) + EPS);
        float ex[8];
#pragma unroll
        for (int e = 0; e < 8; ++e) ex[e] = 0.f;
#pragma unroll
        for (int j = 0; j < 4; ++j) { const int c = 4 * (lane + 64 * j);
            const f32x4 gg = *(const f32x4*)(g + c), sc = *(const f32x4*)(mod + sc_off + c), sh = *(const f32x4*)(mod + sh_off + c);
            const f32x4 h = (v[j] * rstd) * gg * (sc + 1.0f) + sh;
            u32x2 w; w.x = cvtpk(h.x, h.y); w.y = cvtpk(h.z, h.w); *(u32x2*)(H + (size_t)m * D + c) = w;
            if (EXTRAS) {
#pragma unroll
                for (int e = 0; e < 8; ++e) { const f32x4 wx = *(const f32x4*)(WX + e * D + c); ex[e] += (h.x * wx.x + h.y * wx.y) + (h.z * wx.z + h.w * wx.w); }
            }
        }
        if (EXTRAS) {
#pragma unroll
            for (int e = 0; e < 8; ++e) ex[e] = wave_sum(ex[e]);
            float mine = ex[0];
#pragma unroll
            for (int e = 1; e < 8; ++e) mine = (lane == e) ? ex[e] : mine;
            if (lane < 8) EXTRA[(size_t)m * 8 + lane] = mine;
        }
    }
}

__device__ __forceinline__ f32x4 bf4lo(u32x4 w) { return (f32x4){__uint_as_float(w.x << 16), __uint_as_float(w.x & 0xffff0000u), __uint_as_float(w.y << 16), __uint_as_float(w.y & 0xffff0000u)}; }
__device__ __forceinline__ f32x4 bf4hi(u32x4 w) { return (f32x4){__uint_as_float(w.z << 16), __uint_as_float(w.z & 0xffff0000u), __uint_as_float(w.w << 16), __uint_as_float(w.w & 0xffff0000u)}; }
__device__ __forceinline__ void post_strip(const Args& A, int m0, int R, int part, int lane) {
    unsigned char* ws = A.ws; const bf16* DNRAW = (const bf16*)(ws + WS_DNRAW);
    const float* wc = (const float*)A.in[I_WDNC]; const float* sdc = (const float*)A.in[I_SDC];
    float* dstb = (part == 0 ? (float*)(ws + WS_QD) : part == 1 ? (float*)(ws + WS_KD) : (float*)(ws + WS_VD));
    const bool prompt = m0 < MP; const int b = prompt ? (m0 >> 12) : ((m0 - MP) >> 3), t0 = prompt ? (m0 & 4095) : ((m0 - MP) & 7);
    const int ch = part * 512 + 8 * lane;
    f32x4 w[4][2];
#pragma unroll
    for (int i = 0; i < 4; ++i) { w[i][0] = *(const f32x4*)(wc + i * 1536 + ch); w[i][1] = *(const f32x4*)(wc + i * 1536 + ch + 4); }
    f32x4 x[3][2];
#pragma unroll
    for (int j = 0; j < 3; ++j) { const int tt = t0 - 3 + j;
        if (tt >= 0) { const u32x4 r = *(const u32x4*)(DNRAW + (size_t)(m0 - 3 + j) * 1536 + ch); x[j][0] = bf4lo(r); x[j][1] = bf4hi(r); }
        else if (!prompt) { const float* p = sdc + ((size_t)b * 3 + (3 + tt)) * 1536 + ch; x[j][0] = *(const f32x4*)p; x[j][1] = *(const f32x4*)(p + 4); }
        else { x[j][0] = (f32x4){0.f, 0.f, 0.f, 0.f}; x[j][1] = x[j][0]; } }
    const bf16* src = DNRAW + (size_t)m0 * 1536 + ch;
    u32x4 nx = *(const u32x4*)src;
    for (int r = 0; r < R; ++r) {
        const u32x4 cw = nx;
        if (r + 1 < R) nx = *(const u32x4*)(src + (size_t)(r + 1) * 1536);
        const f32x4 c0 = bf4lo(cw), c1 = bf4hi(cw);
        f32x4 y0 = w[0][0] * x[0][0] + w[1][0] * x[1][0] + w[2][0] * x[2][0] + w[3][0] * c0;
        f32x4 y1 = w[0][1] * x[0][1] + w[1][1] * x[1][1] + w[2][1] * x[2][1] + w[3][1] * c1;
        x[0][0] = x[1][0]; x[0][1] = x[1][1]; x[1][0] = x[2][0]; x[1][1] = x[2][1]; x[2][0] = c0; x[2][1] = c1;
        y0.x = siluf(y0.x); y0.y = siluf(y0.y); y0.z = siluf(y0.z); y0.w = siluf(y0.w); y1.x = siluf(y1.x); y1.y = siluf(y1.y); y1.z = siluf(y1.z); y1.w = siluf(y1.w);
        if (part < 2) {
            float ss = (y0.x * y0.x + y0.y * y0.y) + (y0.z * y0.z + y0.w * y0.w) + (y1.x * y1.x + y1.y * y1.y) + (y1.z * y1.z + y1.w * y1.w);
            ss += __shfl_xor(ss, 1); ss += __shfl_xor(ss, 2); ss += __shfl_xor(ss, 4); ss += __shfl_xor(ss, 8);
            const float rs = (part == 0 ? 0.08838834764831845f : 1.0f) / sqrtf(ss + EPS);
            y0 = y0 * rs; y1 = y1 * rs;
        }
        float* dst = dstb + (size_t)(m0 + r) * DNW + 8 * lane;
        *(f32x4*)dst = y0; *(f32x4*)(dst + 4) = y1;
    }
}
__device__ __forceinline__ void phase_post(const Args& A, int gw, int NGW, int lane, int gtid, int NGT) {
    constexpr int NPI = (MP / 16) * 3, NSI = BS * 3;
    for (int it = gw; it < NPI + NSI; it += NGW) {
        if (it < NPI) post_strip(A, (it / 3) * 16, 16, it % 3, lane);
        else { const int j = it - NPI; post_strip(A, MP + (j / 3) * 8, 8, j % 3, lane); }
    }
    unsigned char* ws = A.ws; const float* a_log = (const float*)A.in[I_ALOG]; const float* dtb = (const float*)A.in[I_DTB];
    float* BETA = (float*)(ws + WS_BETA); float* LOGA = (float*)(ws + WS_LOGA); const float* EXTRA = (const float*)(ws + WS_EXTRA);
    for (int i = gtid; i < M * 8; i += NGT) { const int m = i >> 3, j = i & 7; const float x = EXTRA[i];
        if (j < 4) BETA[m * 4 + j] = 1.f / (1.f + __expf(-x));
        else { const int h = j - 4; const float z = x + dtb[h]; const float sp = fmaxf(z, 0.f) + log1pf(__expf(-fabsf(z))); LOGA[m * 4 + h] = -__expf(a_log[h]) * sp; } }
}

template <int I0, int I1> __device__ __forceinline__ void subst_rows(float (&x)[64], const LAS float* Am, const LAS float* gs, bool kpart) {
#pragma unroll
    for (int i = I0; i < I1; ++i) {
        float r = x[i];
#pragma unroll
        for (int j4 = 0; j4 < (i & ~3); j4 += 4) { const f32x4 a = *(const LAS f32x4*)(Am + i * 64 + j4); r -= a.x * x[j4]; r -= a.y * x[j4 + 1]; r -= a.z * x[j4 + 2]; r -= a.w * x[j4 + 3]; }
#pragma unroll
        for (int j = (i & ~3); j < i; ++j) r -= Am[i * 64 + j] * x[j];
        x[i] = r;
    }
}
__device__ __forceinline__ void dn_prescan_unit(const Args& A, LAS unsigned char* lds, int unit, int tid, int wave, int lane) {
    unsigned char* ws = A.ws;
    const float* QD = (const float*)(ws + WS_QD); const float* KD = (const float*)(ws + WS_KD); const float* VD = (const float*)(ws + WS_VD);
    const float* BETA = (const float*)(ws + WS_BETA); const float* LOGA = (const float*)(ws + WS_LOGA);
    const int hp = unit & 1, n = (unit >> 1) & 63, b = unit >> 7;
    const int half = tid >> 8, ht = tid & 255, h = 2 * hp + half, item = (b * 64 + n) * 4 + h;
    const int m0 = b * TP + n * 64;
    LAS float* Am = (LAS float*)lds + half * 4096;
    LAS float* gs = (LAS float*)(lds + 32768) + half * 128;
    if (ht < 64) {
        float v = LOGA[(size_t)(m0 + ht) * 4 + h];
#pragma unroll
        for (int o = 1; o < 64; o <<= 1) { const float u = __shfl_up(v, o); if (ht >= o) v += u; }
        gs[ht] = v; gs[64 + ht] = BETA[(size_t)(m0 + ht) * 4 + h];
    }
    __syncthreads();
    {
        const int wl = wave & 3, lr = lane & 15, q = lane >> 4;
        pg8::f32x4 kk[4], qk[4];
#pragma unroll
        for (int j = 0; j < 4; ++j) { kk[j] = (pg8::f32x4){0.f, 0.f, 0.f, 0.f}; qk[j] = kk[j]; }
#pragma unroll
        for (int s = 0; s < 4; ++s) {
            const float* kp = KD + (size_t)(m0 + 16 * wl + lr) * DNW + h * 128 + 32 * s + 8 * q; const float* qp = QD + (size_t)(m0 + 16 * wl + lr) * DNW + h * 128 + 32 * s + 8 * q;
            const bf16x8 ak = __builtin_bit_cast(bf16x8, pack8(*(const f32x4*)kp, *(const f32x4*)(kp + 4))), aq = __builtin_bit_cast(bf16x8, pack8(*(const f32x4*)qp, *(const f32x4*)(qp + 4)));
#pragma unroll
            for (int j = 0; j < 4; ++j) { const float* bp = KD + (size_t)(m0 + 16 * j + lr) * DNW + h * 128 + 32 * s + 8 * q;
                const bf16x8 bk = __builtin_bit_cast(bf16x8, pack8(*(const f32x4*)bp, *(const f32x4*)(bp + 4)));
                kk[j] = __builtin_amdgcn_mfma_f32_16x16x32_bf16(ak, bk, kk[j], 0, 0, 0); qk[j] = __builtin_amdgcn_mfma_f32_16x16x32_bf16(aq, bk, qk[j], 0, 0, 0); }
        }
        bf16* INTRA = (bf16*)(ws + WS_INTRA) + (size_t)item * 4096;
#pragma unroll
        for (int j = 0; j < 4; ++j)
#pragma unroll
            for (int r = 0; r < 4; ++r) { const int i = 16 * wl + 4 * q + r, jj = 16 * j + lr;
                const float dec = (i >= jj) ? __expf(gs[i] - gs[jj]) : 0.f;
                Am[i * 64 + jj] = (i > jj) ? gs[64 + i] * kk[j][r] * dec : 0.f;
                INTRA[i * 64 + jj] = f2bf(qk[j][r] * dec); }
    }
    __syncthreads();
    {
        const int c = ht; float x[64];
        float* U = (float*)(ws + WS_U) + (size_t)item * 8192; bf16* KC = (bf16*)(ws + WS_KCUM) + (size_t)item * 8192;
        const float* rsrc = (c < 128 ? VD : KD) + (size_t)m0 * DNW + h * 128 + (c & 127);
#pragma unroll
        for (int i = 0; i < 64; ++i) x[i] = rsrc[(size_t)i * DNW];
#pragma unroll
        for (int i = 0; i < 64; ++i) { const float eg = __expf(gs[i]); x[i] *= gs[64 + i] * (c >= 128 ? eg : 1.0f); }
        subst_rows<0, 16>(x, Am, gs, c >= 128); subst_rows<16, 32>(x, Am, gs, c >= 128); subst_rows<32, 48>(x, Am, gs, c >= 128); subst_rows<48, 64>(x, Am, gs, c >= 128);
        if (c < 128) {
#pragma unroll
            for (int i = 0; i < 64; ++i) U[i * 128 + c] = x[i];
        } else {
#pragma unroll
            for (int i = 0; i < 64; ++i) KC[i * 128 + (c - 128)] = f2bf(x[i]);
        }
    }
    {
        const float glast = gs[63];
        bf16* QDc = (bf16*)(ws + WS_QDEC) + (size_t)item * 8192; bf16* KT = (bf16*)(ws + WS_KDECT) + (size_t)item * 8192;
        for (int e = ht; e < 64 * 128; e += 256) { const int i = e >> 7, d = e & 127; QDc[e] = f2bf(QD[(size_t)(m0 + i) * DNW + h * 128 + d] * __expf(gs[i])); }
        { const int d = ht & 127, ig = ht >> 7;
#pragma unroll
            for (int i8 = 0; i8 < 4; ++i8) { float v[8];
#pragma unroll
                for (int k = 0; k < 8; ++k) { const int i = 32 * ig + 8 * i8 + k; v[k] = KD[(size_t)(m0 + i) * DNW + h * 128 + d] * __expf(glast - gs[i]); }
                u32x4 w; w.x = cvtpk(v[0], v[1]); w.y = cvtpk(v[2], v[3]); w.z = cvtpk(v[4], v[5]); w.w = cvtpk(v[6], v[7]);
                *(u32x4*)(KT + d * 64 + 32 * ig + 8 * i8) = w; } }
        if (ht == 0) ((float*)(ws + WS_GL))[item] = __expf(glast);
    }
    __syncthreads();
}
__device__ __forceinline__ void dn_sample_unit(const Args& A, LAS unsigned char* lds, int unit, int tid) {
    unsigned char* ws = A.ws;
    const float* QD = (const float*)(ws + WS_QD); const float* KD = (const float*)(ws + WS_KD); const float* VD = (const float*)(ws + WS_VD);
    const float* BETA = (const float*)(ws + WS_BETA); const float* LOGA = (const float*)(ws + WS_LOGA); float* ODN = (float*)(ws + WS_ODN);
    const int h = unit & 3, b = unit >> 2, e = tid & 127, dq = tid >> 7;
    const float* s0 = (const float*)A.in[I_SD] + ((size_t)(b * 4 + h) * 128 + 32 * dq) * 128 + e;
    float S[32];
#pragma unroll
    for (int d = 0; d < 32; ++d) S[d] = s0[(size_t)d * 128];
    LAS float* red = (LAS float*)lds; LAS float* red2 = red + 512;
    for (int t = 0; t < TS; ++t) {
        const int m = MP + b * TS + t;
        const float a = __expf(LOGA[(size_t)m * 4 + h]), bt = BETA[(size_t)m * 4 + h];
        const float* kp = KD + (size_t)m * DNW + h * 128 + 32 * dq; const float* qp = QD + (size_t)m * DNW + h * 128 + 32 * dq;
        float kd[32], qd[32];
#pragma unroll
        for (int d4 = 0; d4 < 8; ++d4) { const f32x4 kv = *(const f32x4*)(kp + 4 * d4), qv = *(const f32x4*)(qp + 4 * d4);
            kd[4 * d4] = kv.x; kd[4 * d4 + 1] = kv.y; kd[4 * d4 + 2] = kv.z; kd[4 * d4 + 3] = kv.w; qd[4 * d4] = qv.x; qd[4 * d4 + 1] = qv.y; qd[4 * d4 + 2] = qv.z; qd[4 * d4 + 3] = qv.w; }
        float p = 0.f;
#pragma unroll
        for (int d = 0; d < 32; ++d) p += kd[d] * S[d];
        red[dq * 128 + e] = p;
        __syncthreads();
        const float kS = (red[e] + red[128 + e]) + (red[256 + e] + red[384 + e]);
        const float dl = bt * (VD[(size_t)m * DNW + h * 128 + e] - a * kS);
        float po = 0.f;
#pragma unroll
        for (int d = 0; d < 32; ++d) { S[d] = a * S[d] + kd[d] * dl; po += qd[d] * S[d]; }
        red2[dq * 128 + e] = po;
        __syncthreads();
        if (dq == 0) ODN[(size_t)m * DNW + h * 128 + e] = (red2[e] + red2[128 + e]) + (red2[256 + e] + red2[384 + e]);
    }
    float* so = A.out + O_SS + ((size_t)(b * 4 + h) * 128 + 32 * dq) * 128 + e;
#pragma unroll
    for (int d = 0; d < 32; ++d) so[(size_t)d * 128] = S[d];
    __syncthreads();
}

constexpr int SC_KC = 0, SC_QD = 17408, SC_KT = 34816, SC_IN = 53248, SC_BUF = 62464;
__device__ __forceinline__ void dn_scan_chain(const Args& A, LAS unsigned char* lds, int chain, int tid, int wave, int lane) {
    unsigned char* ws = A.ws;
    const float* Ub = (const float*)(ws + WS_U); const float* GL = (const float*)(ws + WS_GL); float* ODN = (float*)(ws + WS_ODN);
    const int b = chain >> 2, h = chain & 3, lr = lane & 15, q = lane >> 4, e = 16 * wave + lr;
    int ldst[7];
    { const int c0 = tid, c1 = tid + 512;
      ldst[0] = SC_KC + (c0 >> 4) * 272 + (c0 & 15) * 16; ldst[1] = SC_KC + (c1 >> 4) * 272 + (c1 & 15) * 16;
      ldst[2] = SC_QD + (c0 >> 4) * 272 + (c0 & 15) * 16; ldst[3] = SC_QD + (c1 >> 4) * 272 + (c1 & 15) * 16;
      ldst[4] = SC_KT + (c0 >> 3) * 144 + (c0 & 7) * 16;  ldst[5] = SC_KT + (c1 >> 3) * 144 + (c1 & 7) * 16;
      ldst[6] = SC_IN + (c0 >> 3) * 144 + (c0 & 7) * 16; }
    const size_t item0 = (size_t)(b * 64) * 4 + h;
    const unsigned char* gKC = ws + WS_KCUM + item0 * 16384; const unsigned char* gQD = ws + WS_QDEC + item0 * 16384; const unsigned char* gKT = ws + WS_KDECT + item0 * 16384; const unsigned char* gIN = ws + WS_INTRA + item0 * 8192;
    const int t16 = tid * 16, uoff = (4 * q) * 128 + e;
    u32x4 R[7]; float un[16];
#define SC_GLOAD(n_) do { const size_t o16_ = (size_t)(n_) * 4 * 16384, o8_ = (size_t)(n_) * 4 * 8192; \
        R[0] = *(const u32x4*)(gKC + o16_ + t16); R[1] = *(const u32x4*)(gKC + o16_ + 8192 + t16); R[2] = *(const u32x4*)(gQD + o16_ + t16); R[3] = *(const u32x4*)(gQD + o16_ + 8192 + t16); \
        R[4] = *(const u32x4*)(gKT + o16_ + t16); R[5] = *(const u32x4*)(gKT + o16_ + 8192 + t16); R[6] = *(const u32x4*)(gIN + o8_ + t16); \
        const float* U_ = Ub + (item0 + 4 * (size_t)(n_)) * 8192; \
        _Pragma("unroll") for (int i_ = 0; i_ < 4; ++i_) _Pragma("unroll") for (int r_ = 0; r_ < 4; ++r_) un[4 * i_ + r_] = U_[uoff + (16 * i_ + r_) * 128]; } while (0)
#define SC_LWRITE(buf_) do { _Pragma("unroll") for (int k_ = 0; k_ < 7; ++k_) *(LAS u32x4*)(lds + (buf_) * SC_BUF + ldst[k_]) = R[k_]; } while (0)
    pg8::f32x4 S[8];
#pragma unroll
    for (int i = 0; i < 8; ++i) S[i] = (pg8::f32x4){0.f, 0.f, 0.f, 0.f};
    __syncthreads();
    SC_GLOAD(0); SC_LWRITE(0);
    float uc[16];
#pragma unroll
    for (int k = 0; k < 16; ++k) uc[k] = un[k];
    __syncthreads();
    for (int n = 0; n < 64; ++n) {
        const float gl = GL[item0 + 4 * n];
        if (n + 1 < 64) SC_GLOAD(n + 1);
        const LAS unsigned char* B = lds + (n & 1) * SC_BUF;
        bf16x8 Sb[4];
#pragma unroll
        for (int s = 0; s < 4; ++s) { u32x4 w; w.x = cvtpk(S[2 * s][0], S[2 * s][1]); w.y = cvtpk(S[2 * s][2], S[2 * s][3]); w.z = cvtpk(S[2 * s + 1][0], S[2 * s + 1][1]); w.w = cvtpk(S[2 * s + 1][2], S[2 * s + 1][3]); Sb[s] = __builtin_bit_cast(bf16x8, w); }
        pg8::f32x4 vn[4], o[4];
#pragma unroll
        for (int i = 0; i < 4; ++i) {
            pg8::f32x4 ak = (pg8::f32x4){0.f, 0.f, 0.f, 0.f}, aq = ak;
#pragma unroll
            for (int s = 0; s < 4; ++s) {
                const LAS unsigned char* kp = B + SC_KC + (16 * i + lr) * 272 + (32 * s + 4 * q) * 2; const LAS unsigned char* qp = B + SC_QD + (16 * i + lr) * 272 + (32 * s + 4 * q) * 2;
                const u32x2 k0 = *(const LAS u32x2*)kp, k1 = *(const LAS u32x2*)(kp + 32), q0 = *(const LAS u32x2*)qp, q1 = *(const LAS u32x2*)(qp + 32);
                ak = __builtin_amdgcn_mfma_f32_16x16x32_bf16(__builtin_bit_cast(bf16x8, (u32x4){k0.x, k0.y, k1.x, k1.y}), Sb[s], ak, 0, 0, 0);
                aq = __builtin_amdgcn_mfma_f32_16x16x32_bf16(__builtin_bit_cast(bf16x8, (u32x4){q0.x, q0.y, q1.x, q1.y}), Sb[s], aq, 0, 0, 0);
            }
#pragma unroll
            for (int r = 0; r < 4; ++r) vn[i][r] = uc[4 * i + r] - ak[r];
            o[i] = aq;
        }
        bf16x8 Vb[2];
#pragma unroll
        for (int s = 0; s < 2; ++s) { u32x4 w; w.x = cvtpk(vn[2 * s][0], vn[2 * s][1]); w.y = cvtpk(vn[2 * s][2], vn[2 * s][3]); w.z = cvtpk(vn[2 * s + 1][0], vn[2 * s + 1][1]); w.w = cvtpk(vn[2 * s + 1][2], vn[2 * s + 1][3]); Vb[s] = __builtin_bit_cast(bf16x8, w); }
#pragma unroll
        for (int i = 0; i < 4; ++i) {
#pragma unroll
            for (int s = 0; s < 2; ++s) { const LAS unsigned char* ip = B + SC_IN + (16 * i + lr) * 144 + (32 * s + 4 * q) * 2; const u32x2 a0 = *(const LAS u32x2*)ip, a1 = *(const LAS u32x2*)(ip + 32);
                o[i] = __builtin_amdgcn_mfma_f32_16x16x32_bf16(__builtin_bit_cast(bf16x8, (u32x4){a0.x, a0.y, a1.x, a1.y}), Vb[s], o[i], 0, 0, 0); }
#pragma unroll
            for (int r = 0; r < 4; ++r) ODN[(size_t)(b * TP + 64 * n + 16 * i + 4 * q + r) * DNW + h * 128 + e] = o[i][r];
        }
#pragma unroll
        for (int i = 0; i < 8; ++i) {
            pg8::f32x4 acc = S[i] * gl;
#pragma unroll
            for (int s = 0; s < 2; ++s) { const LAS unsigned char* tp = B + SC_KT + (16 * i + lr) * 144 + (32 * s + 4 * q) * 2; const u32x2 a0 = *(const LAS u32x2*)tp, a1 = *(const LAS u32x2*)(tp + 32);
                acc = __builtin_amdgcn_mfma_f32_16x16x32_bf16(__builtin_bit_cast(bf16x8, (u32x4){a0.x, a0.y, a1.x, a1.y}), Vb[s], acc, 0, 0, 0); }
            S[i] = acc;
        }
        if (n + 1 < 64) {
            SC_LWRITE((n + 1) & 1);
#pragma unroll
            for (int k = 0; k < 16; ++k) uc[k] = un[k];
        }
        __syncthreads();
    }
#undef SC_GLOAD
#undef SC_LWRITE
    float* so = A.out + O_SP + (size_t)(b * 4 + h) * 16384;
#pragma unroll
    for (int i = 0; i < 8; ++i)
#pragma unroll
        for (int r = 0; r < 4; ++r) so[(16 * i + 4 * q + r) * 128 + e] = S[i][r];
}

__device__ __forceinline__ int crow(int r, int hi) { return (r & 3) + 8 * (r >> 2) + 4 * hi; }
__device__ __forceinline__ void sb_core(f32x16& p, float& carry, int hi) {
    float s[16];
#pragma unroll
    for (int r = 0; r < 16; ++r) { const float e = __builtin_amdgcn_exp2f(p[r]); s[r] = -__builtin_amdgcn_logf(1.0f + e); }
    float tt[4], uu[4];
#pragma unroll
    for (int i = 0; i < 4; ++i) { s[4 * i + 2] += s[4 * i + 3]; s[4 * i + 1] += s[4 * i + 2]; s[4 * i] += s[4 * i + 1]; tt[i] = s[4 * i]; }
#pragma unroll
    for (int i = 0; i < 4; ++i) uu[i] = __shfl_xor(tt[i], 32);
    const float w3 = tt[3] + uu[3], w2 = tt[2] + uu[2], w1 = tt[1] + uu[1], w0 = tt[0] + uu[0];
    float off[4];
    off[3] = carry; off[2] = carry + w3; off[1] = off[2] + w2; off[0] = off[1] + w1;
    carry = off[0] + w0;
    if (hi == 0) {
#pragma unroll
        for (int i = 0; i < 4; ++i) off[i] += uu[i];
    }
#pragma unroll
    for (int r = 0; r < 16; ++r) p[r] = __builtin_amdgcn_exp2f(p[r] + s[r] + off[r >> 2]);
}
__device__ __forceinline__ bf16x8 pack_p(const f32x16& p, int s) {
    u32x4 w; w.x = cvtpk(p[8 * s], p[8 * s + 1]); w.y = cvtpk(p[8 * s + 2], p[8 * s + 3]); w.z = cvtpk(p[8 * s + 4], p[8 * s + 5]); w.w = cvtpk(p[8 * s + 6], p[8 * s + 7]); return __builtin_bit_cast(bf16x8, w);
}
constexpr int AW_BYTES = 16384, AW_V = 0, VPI = 192, AW_K = 6144, KPI = 144, AW_Q = 6144;
__device__ __forceinline__ void read_vfrags(bf16x8 (&vf)[4], const LAS unsigned char* wl, int lane) {
    const int hi = lane >> 5;
    const LAS unsigned char* vb = wl + AW_V + (4 * hi + ((lane & 15) >> 2)) * VPI + (((lane >> 4) & 1) * 16 + (lane & 3) * 4) * 2;
#pragma unroll
    for (int dt = 0; dt < 2; ++dt) {
        const s16x4 t0 = __builtin_bit_cast(s16x4, __builtin_amdgcn_ds_read_tr16_b64_v4i16((LAS s16x4*)(vb + dt * 64)));
        const s16x4 t1 = __builtin_bit_cast(s16x4, __builtin_amdgcn_ds_read_tr16_b64_v4i16((LAS s16x4*)(vb + dt * 64 + 8 * VPI)));
        const s16x4 t2 = __builtin_bit_cast(s16x4, __builtin_amdgcn_ds_read_tr16_b64_v4i16((LAS s16x4*)(vb + dt * 64 + 16 * VPI)));
        const s16x4 t3 = __builtin_bit_cast(s16x4, __builtin_amdgcn_ds_read_tr16_b64_v4i16((LAS s16x4*)(vb + dt * 64 + 24 * VPI)));
        vf[2 * dt] = (bf16x8){t0[0], t0[1], t0[2], t0[3], t1[0], t1[1], t1[2], t1[3]}; vf[2 * dt + 1] = (bf16x8){t2[0], t2[1], t2[2], t2[3], t3[0], t3[1], t3[2], t3[3]};
    }
}
__device__ __forceinline__ void load_k_prompt(bf16x8 (&k)[4], const bf16* KB, int b, int h, int kv0, int r32, int hi) {
    const bf16* kp = KB + (size_t)(b * TP + kv0 + r32) * SBW + h * HD + 8 * hi;
#pragma unroll
    for (int d0 = 0; d0 < 4; ++d0) k[d0] = *(const bf16x8*)(kp + 16 * d0);
}
__device__ __forceinline__ void load_v_prompt(u32x4 (&v)[4], const bf16* VB, int b, int h, int kv0, int lane) {
    const bf16* vp = VB + (size_t)(b * TP + kv0 + (lane >> 3)) * SBW + h * HD + (lane & 7) * 8;
#pragma unroll
    for (int i = 0; i < 4; ++i) v[i] = *(const u32x4*)(vp + (size_t)(8 * i) * SBW);
}
__device__ __forceinline__ void write_v_lds(LAS unsigned char* wl, const u32x4 (&v)[4], int lane) {
#pragma unroll
    for (int i = 0; i < 4; ++i) *(LAS u32x4*)(wl + AW_V + (8 * i + (lane >> 3)) * VPI + (lane & 7) * 16) = v[i];
}
template <int MASK>
__device__ __forceinline__ void sb_qk(f32x16& p, const bf16x8 (&kf)[4], const bf16x8 (&qf)[4], float bias2, int kv0, int qpos, int hi) {
#pragma unroll
    for (int r = 0; r < 16; ++r) p[r] = bias2;
#pragma unroll
    for (int d0 = 0; d0 < 4; ++d0) p = __builtin_amdgcn_mfma_f32_32x32x16_bf16(kf[d0], qf[d0], p, 0, 0, 0);
    if (MASK) {
#pragma unroll
        for (int r = 0; r < 16; ++r) if (kv0 + crow(r, hi) >= qpos) p[r] = -INFINITY;
    }
}
__device__ __forceinline__ void sb_pvonly(const f32x16& p, const bf16x8 (&vf)[4], f32x16 (&o)[2]) {
    const bf16x8 p0 = pack_p(p, 0), p1 = pack_p(p, 1);
#pragma unroll
    for (int dt = 0; dt < 2; ++dt) { o[dt] = __builtin_amdgcn_mfma_f32_32x32x16_bf16(vf[2 * dt], p0, o[dt], 0, 0, 0); o[dt] = __builtin_amdgcn_mfma_f32_32x32x16_bf16(vf[2 * dt + 1], p1, o[dt], 0, 0, 0); }
}
__device__ __forceinline__ void sb_pv(f32x16& p, const bf16x8 (&vf)[4], f32x16 (&o)[2], float& carry, int hi) {
    sb_core(p, carry, hi);
    const bf16x8 p0 = pack_p(p, 0), p1 = pack_p(p, 1);
#pragma unroll
    for (int dt = 0; dt < 2; ++dt) { o[dt] = __builtin_amdgcn_mfma_f32_32x32x16_bf16(vf[2 * dt], p0, o[dt], 0, 0, 0); o[dt] = __builtin_amdgcn_mfma_f32_32x32x16_bf16(vf[2 * dt + 1], p1, o[dt], 0, 0, 0); }
}
template <int MASK>
__device__ __forceinline__ void sb_tile(const bf16x8 (&kf)[4], const bf16x8 (&vf)[4], const bf16x8 (&qf)[4], float bias2, f32x16 (&o)[2], float& carry, int kv0, int qpos, int hi) {
    f32x16 p; sb_qk<MASK>(p, kf, qf, bias2, kv0, qpos, hi); sb_pv(p, vf, o, carry, hi);
}
__device__ __forceinline__ void sb_store_prompt(const Args& A, const f32x16 (&o)[2], int b, int h, int qpos, int hi) {
    float ss = 0.f;
#pragma unroll
    for (int dt = 0; dt < 2; ++dt)
#pragma unroll
        for (int r = 0; r < 16; ++r) ss += o[dt][r] * o[dt][r];
    ss += __shfl_xor(ss, 32);
    const float rs = 1.0f / sqrtf(ss * (1.f / HD) + EPS);
    const float* gso = (const float*)A.in[I_GSBO];
    bf16* op = (bf16*)(A.ws + WS_MIXED) + (size_t)(b * TP + qpos) * D + h * HD;
#pragma unroll
    for (int dt = 0; dt < 2; ++dt)
#pragma unroll
        for (int g = 0; g < 4; ++g) { const int d = 32 * dt + 8 * g + 4 * hi; const f32x4 gg = *(const f32x4*)(gso + d);
            u32x2 w; w.x = cvtpk(o[dt][4 * g] * rs * gg.x, o[dt][4 * g + 1] * rs * gg.y); w.y = cvtpk(o[dt][4 * g + 2] * rs * gg.z, o[dt][4 * g + 3] * rs * gg.w); *(u32x2*)(op + d) = w; }
}
__device__ __forceinline__ void attn_prompt_item(const Args& A, LAS unsigned char* wl, int b, int h, int q0, int lane) {
    unsigned char* ws = A.ws;
    const bf16* QB = (const bf16*)(ws + WS_QB); const bf16* KB = (const bf16*)(ws + WS_KB); const bf16* VB = (const bf16*)(ws + WS_VB);
    const int r32 = lane & 31, hi = lane >> 5, qa = q0 + r32, qb = q0 + 32 + r32;
    const float bias2 = ((const float*)A.in[I_SBB])[h] * LOG2E;
#pragma unroll
    for (int d0 = 0; d0 < 4; ++d0) { *(LAS bf16x8*)(wl + AW_Q + (d0 * 64 + lane) * 16) = *(const bf16x8*)(QB + (size_t)(b * TP + qa) * SBW + h * HD + 16 * d0 + 8 * hi);
        *(LAS bf16x8*)(wl + AW_Q + 4096 + (d0 * 64 + lane) * 16) = *(const bf16x8*)(QB + (size_t)(b * TP + qb) * SBW + h * HD + 16 * d0 + 8 * hi); }
#define QFA_LOAD bf16x8 qfa[4]; _Pragma("unroll") for (int d0_ = 0; d0_ < 4; ++d0_) qfa[d0_] = *(const LAS bf16x8*)(wl + AW_Q + (d0_ * 64 + lane) * 16);
#define QFB_LOAD bf16x8 qfb[4]; _Pragma("unroll") for (int d0_ = 0; d0_ < 4; ++d0_) qfb[d0_] = *(const LAS bf16x8*)(wl + AW_Q + 4096 + (d0_ * 64 + lane) * 16);
    f32x16 oa[2], ob[2]; oa[0] = (f32x16){}; oa[1] = (f32x16){}; ob[0] = (f32x16){}; ob[1] = (f32x16){};
    float ca = 0.f, cb = 0.f;
    bf16x8 kc[4], vf[4]; u32x4 vr[4];
    const int top = (q0 >> 5) + 1;
    load_k_prompt(kc, KB, b, h, 32 * top, r32, hi); load_v_prompt(vr, VB, b, h, 32 * top, lane);
    { write_v_lds(wl, vr, lane); load_v_prompt(vr, VB, b, h, 32 * (top - 1), lane);
      f32x16 p; { QFB_LOAD sb_qk<1>(p, kc, qfb, bias2, 32 * top, qb, hi); }
      load_k_prompt(kc, KB, b, h, 32 * (top - 1), r32, hi);
      read_vfrags(vf, wl, lane);
      sb_pv(p, vf, ob, cb, hi); }
    { write_v_lds(wl, vr, lane); if (top >= 2) load_v_prompt(vr, VB, b, h, 32 * (top - 2), lane);
      f32x16 p; { QFA_LOAD sb_qk<1>(p, kc, qfa, bias2, 32 * (top - 1), qa, hi); }
      read_vfrags(vf, wl, lane);
      sb_pv(p, vf, oa, ca, hi);
      { QFB_LOAD sb_qk<0>(p, kc, qfb, bias2, 0, 0, hi); }
      if (top >= 2) load_k_prompt(kc, KB, b, h, 32 * (top - 2), r32, hi);
      sb_pv(p, vf, ob, cb, hi); }
    for (int ht = top - 2; ht >= 0; --ht) {
        write_v_lds(wl, vr, lane); if (ht > 0) load_v_prompt(vr, VB, b, h, 32 * (ht - 1), lane);
        f32x16 p; { QFA_LOAD sb_qk<0>(p, kc, qfa, bias2, 0, 0, hi); }
        read_vfrags(vf, wl, lane);
        sb_pv(p, vf, oa, ca, hi);
        { QFB_LOAD sb_qk<0>(p, kc, qfb, bias2, 0, 0, hi); }
        if (ht > 0) load_k_prompt(kc, KB, b, h, 32 * (ht - 1), r32, hi);
        sb_pv(p, vf, ob, cb, hi);
    }
    sb_store_prompt(A, oa, b, h, qa, hi); sb_store_prompt(A, ob, b, h, qb, hi);
#undef QFA_LOAD
#undef QFB_LOAD
}

__device__ __forceinline__ void load_raw_sample(f32x4 (&r)[8], const float* c, size_t base, int h, int lane) {
    const float* p = c + base + (size_t)(lane >> 4) * 512 + h * HD + (lane & 15) * 4;
#pragma unroll
    for (int i = 0; i < 8; ++i) r[i] = *(const f32x4*)(p + (size_t)(4 * i) * 512);
}
__device__ __forceinline__ void write_raw_sample(LAS unsigned char* wl, int off, int pitch, const f32x4 (&r)[8], int lane) {
#pragma unroll
    for (int i = 0; i < 8; ++i) { const int row = 4 * i + (lane >> 4); u32x2 w; w.x = cvtpk(r[i].x, r[i].y); w.y = cvtpk(r[i].z, r[i].w); *(LAS u32x2*)(wl + off + row * pitch + (lane & 15) * 8) = w; }
}
__device__ __forceinline__ void read_kfrags(bf16x8 (&kf)[4], const LAS unsigned char* wl, int r32, int hi) {
#pragma unroll
    for (int d0 = 0; d0 < 4; ++d0) kf[d0] = *(const LAS bf16x8*)(wl + AW_K + r32 * KPI + (16 * d0 + 8 * hi) * 2);
}
__device__ __forceinline__ void attn_sample_store(const Args& A, int b, int h, int part, int lane, const f32x16 (&o)[2], float carry) {
    float* OP = (float*)(A.ws + WS_OPART) + (size_t)((b * SBH + h) * NPART + part) * 512; float* LP = (float*)(A.ws + WS_LPART) + (size_t)((b * SBH + h) * NPART + part) * 8;
    const int r32 = lane & 31, hi = lane >> 5;
    if (r32 < 8) {
#pragma unroll
        for (int dt = 0; dt < 2; ++dt)
#pragma unroll
            for (int r = 0; r < 16; ++r) OP[(32 * dt + crow(r, hi)) * 8 + r32] = o[dt][r];
        if (hi == 0) LP[r32] = carry;
    }
}
__device__ __forceinline__ void attn_sample_job(const Args& A, LAS unsigned char* wl, int b, int h, int sp, int lane) {
    unsigned char* ws = A.ws;
    const int r32 = lane & 31, hi = lane >> 5;
    const float* ck = (const float*)A.in[I_CK]; const float* cv = (const float*)A.in[I_CV]; const int* pt = (const int*)A.in[I_PT] + b * NPAGES;
    const bf16* QB = (const bf16*)(ws + WS_QB);
    const float bias2 = ((const float*)A.in[I_SBB])[h] * LOG2E;
    bf16x8 qf[4];
#pragma unroll
    for (int d0 = 0; d0 < 4; ++d0) { qf[d0] = (bf16x8){0, 0, 0, 0, 0, 0, 0, 0}; if (r32 < TS) qf[d0] = *(const bf16x8*)(QB + (size_t)(MP + b * TS + r32) * SBW + h * HD + 16 * d0 + 8 * hi); }
    f32x16 o[2]; float carry;
    bf16x8 kf[4], vf[4];
    const int tok_hi = (PAST / NSPLIT) * (sp + 1);
    constexpr int NT = PAST / NSPLIT / 32;
    f32x4 rk[8], rv[8];
#define SAMPLE_BASE(j) (((size_t)pt[(tok_hi - 32 * ((j) + 1)) >> 7] * PAGE + ((tok_hi - 32 * ((j) + 1)) & 127)) * 512)
    if (sp == NSPLIT - 1) {
        const bf16* KBn = (const bf16*)(ws + WS_KB) + (size_t)(MP + b * TS) * SBW + h * HD;
#pragma unroll
        for (int d0 = 0; d0 < 4; ++d0) { kf[d0] = (bf16x8){0, 0, 0, 0, 0, 0, 0, 0}; if (r32 < TS) kf[d0] = *(const bf16x8*)(KBn + (size_t)r32 * SBW + 16 * d0 + 8 * hi); }
        u32x4 vr[4];
        vr[0] = *(const u32x4*)((const bf16*)(ws + WS_VB) + (size_t)(MP + b * TS + (lane >> 3)) * SBW + h * HD + (lane & 7) * 8);
        vr[1] = (u32x4){0u, 0u, 0u, 0u}; vr[2] = vr[1]; vr[3] = vr[1];
        write_v_lds(wl, vr, lane);
        read_vfrags(vf, wl, lane);
        o[0] = (f32x16){}; o[1] = (f32x16){}; carry = 0.f;
        sb_tile<1>(kf, vf, qf, bias2, o, carry, 0, r32, hi);
        attn_sample_store(A, b, h, NPART - 1, lane, o, carry);
    }
    load_raw_sample(rk, ck, SAMPLE_BASE(0), h, lane); load_raw_sample(rv, cv, SAMPLE_BASE(0), h, lane);
    o[0] = (f32x16){}; o[1] = (f32x16){}; carry = 0.f;
    for (int j = 0; j < NT; ++j) {
        write_raw_sample(wl, AW_K, KPI, rk, lane); write_raw_sample(wl, AW_V, VPI, rv, lane);
        if (j + 1 < NT) load_raw_sample(rk, ck, SAMPLE_BASE(j + 1), h, lane);
        read_kfrags(kf, wl, r32, hi); read_vfrags(vf, wl, lane);
        f32x16 p; sb_qk<0>(p, kf, qf, bias2, 0, 0, hi);
        sb_core(p, carry, hi);
        __builtin_amdgcn_sched_barrier(0);
        if (j + 1 < NT) load_raw_sample(rv, cv, SAMPLE_BASE(j + 1), h, lane);
        sb_pvonly(p, vf, o);
    }
#undef SAMPLE_BASE
    attn_sample_store(A, b, h, sp, lane, o, carry);
}

__device__ __forceinline__ void phase_outnorm(const Args& A, int gw, int NGW, int lane) {
    unsigned char* ws = A.ws; const float* ODN = (const float*)(ws + WS_ODN); bf16* MIXED = (bf16*)(ws + WS_MIXED);
    const float* gdn = (const float*)A.in[I_GDNO]; const float* gso = (const float*)A.in[I_GSBO];
    const float* OPb = (const float*)(ws + WS_OPART); const float* LPb = (const float*)(ws + WS_LPART);
    const int c8 = 8 * lane;
    for (int m = gw; m < M; m += NGW) {
        {
            const float* op = ODN + (size_t)m * DNW + c8; f32x4 a0 = *(const f32x4*)op, a1 = *(const f32x4*)(op + 4);
            float ss = (a0.x * a0.x + a0.y * a0.y) + (a0.z * a0.z + a0.w * a0.w) + (a1.x * a1.x + a1.y * a1.y) + (a1.z * a1.z + a1.w * a1.w);
            ss += __shfl_xor(ss, 1); ss += __shfl_xor(ss, 2); ss += __shfl_xor(ss, 4); ss += __shfl_xor(ss, 8);
            const float rs = 1.0f / sqrtf(ss * (1.f / DND) + EPS);
            const f32x4 g0 = *(const f32x4*)(gdn + (c8 & 127)), g1 = *(const f32x4*)(gdn + (c8 & 127) + 4);
            const u32x4 zw = *(const u32x4*)((const bf16*)(ws + WS_ZG) + (size_t)m * DNW + c8); const f32x4 z0 = bf4lo(zw), z1 = bf4hi(zw);
            *(u32x4*)(MIXED + (size_t)m * D + SBW + c8) = pack8(a0 * rs * g0 * z0, a1 * rs * g1 * z1);
        }
        if (m >= MP) {
            const int b = (m - MP) >> 3, t = (m - MP) & 7, h = lane >> 3, d0 = c8 & 63;
            const float* OP = OPb + (size_t)(b * SBH + h) * NPART * 512; const float* LP = LPb + (size_t)(b * SBH + h) * NPART * 8;
            float v[8];
#pragma unroll
            for (int k = 0; k < 8; ++k) v[k] = 0.f;
            float suf = 0.f;
#pragma unroll
            for (int part = NPART - 1; part >= 0; --part) { const float w = __builtin_amdgcn_exp2f(suf);
#pragma unroll
                for (int k = 0; k < 8; ++k) v[k] += w * OP[part * 512 + (d0 + k) * 8 + t];
                suf += LP[part * 8 + t]; }
            float ss = 0.f;
#pragma unroll
            for (int k = 0; k < 8; ++k) ss += v[k] * v[k];
            ss += __shfl_xor(ss, 1); ss += __shfl_xor(ss, 2); ss += __shfl_xor(ss, 4);
            const float rs = 1.0f / sqrtf(ss * (1.f / HD) + EPS);
            const f32x4 g0 = *(const f32x4*)(gso + d0), g1 = *(const f32x4*)(gso + d0 + 4);
            *(u32x4*)(MIXED + (size_t)m * D + c8) = pack8((f32x4){v[0], v[1], v[2], v[3]} * rs * g0, (f32x4){v[4], v[5], v[6], v[7]} * rs * g1);
        }
    }
}

__device__ __forceinline__ void convgate_strip(const Args& A, int m0, int R, int cg, int lane) {
    unsigned char* ws = A.ws; const bf16* UP = (const bf16*)(ws + WS_UP); bf16* ACT = (bf16*)(ws + WS_ACT); float* out = A.out;
    const float* wf = (const float*)A.in[I_WFC]; const float* sfc = (const float*)A.in[I_SFC];
    const int c = (cg * 64 + lane) * 8;
    if (c >= DFF) return;
    const bool prompt = m0 < MP; const int b = prompt ? (m0 >> 12) : ((m0 - MP) >> 3), t0 = prompt ? (m0 & 4095) : ((m0 - MP) & 7), T = prompt ? TP : TS;
    f32x4 wu[3][2], wg[3][2];
#pragma unroll
    for (int i = 0; i < 3; ++i) { const float* wp = wf + (size_t)i * DFF2 + c; wu[i][0] = *(const f32x4*)wp; wu[i][1] = *(const f32x4*)(wp + 4); wg[i][0] = *(const f32x4*)(wp + DFF); wg[i][1] = *(const f32x4*)(wp + DFF + 4); }
    f32x4 xu[2][2], xg[2][2];
#pragma unroll
    for (int j = 0; j < 2; ++j) { const int tt = t0 - 2 + j;
        if (tt >= 0) { const bf16* p = UP + (size_t)(m0 - 2 + j) * DFF2 + c; const u32x4 a = *(const u32x4*)p, g = *(const u32x4*)(p + DFF); xu[j][0] = bf4lo(a); xu[j][1] = bf4hi(a); xg[j][0] = bf4lo(g); xg[j][1] = bf4hi(g); }
        else if (!prompt) { const float* p = sfc + ((size_t)b * 2 + (2 + tt)) * DFF2 + c; xu[j][0] = *(const f32x4*)p; xu[j][1] = *(const f32x4*)(p + 4); xg[j][0] = *(const f32x4*)(p + DFF); xg[j][1] = *(const f32x4*)(p + DFF + 4); }
        else { xu[j][0] = (f32x4){0.f, 0.f, 0.f, 0.f}; xu[j][1] = xu[j][0]; xg[j][0] = xu[j][0]; xg[j][1] = xu[j][0]; } }
    const bf16* src = UP + (size_t)m0 * DFF2 + c;
    u32x4 na = *(const u32x4*)src, ng = *(const u32x4*)(src + DFF);
    for (int r = 0; r < R; ++r) {
        const u32x4 ca = na, cgw = ng;
        if (r + 1 < R) { na = *(const u32x4*)(src + (size_t)(r + 1) * DFF2); ng = *(const u32x4*)(src + (size_t)(r + 1) * DFF2 + DFF); }
        const f32x4 u0 = bf4lo(ca), u1 = bf4hi(ca), g0 = bf4lo(cgw), g1 = bf4hi(cgw);
        f32x4 yu0 = wu[0][0] * xu[0][0] + wu[1][0] * xu[1][0] + wu[2][0] * u0, yu1 = wu[0][1] * xu[0][1] + wu[1][1] * xu[1][1] + wu[2][1] * u1;
        f32x4 yg0 = wg[0][0] * xg[0][0] + wg[1][0] * xg[1][0] + wg[2][0] * g0, yg1 = wg[0][1] * xg[0][1] + wg[1][1] * xg[1][1] + wg[2][1] * g1;
        xu[0][0] = xu[1][0]; xu[0][1] = xu[1][1]; xu[1][0] = u0; xu[1][1] = u1; xg[0][0] = xg[1][0]; xg[0][1] = xg[1][1]; xg[1][0] = g0; xg[1][1] = g1;
        yg0.x = siluf(yg0.x); yg0.y = siluf(yg0.y); yg0.z = siluf(yg0.z); yg0.w = siluf(yg0.w); yg1.x = siluf(yg1.x); yg1.y = siluf(yg1.y); yg1.z = siluf(yg1.z); yg1.w = siluf(yg1.w);
        *(u32x4*)(ACT + (size_t)(m0 + r) * DFF + c) = pack8(yg0 * yu0, yg1 * yu1);
        const int oidx = t0 + r - (T - 2);
        if (oidx >= 0) { float* fo = (prompt ? out + O_FCP : out + O_FCS) + ((size_t)b * 2 + oidx) * DFF2 + c; *(f32x4*)fo = u0; *(f32x4*)(fo + 4) = u1; *(f32x4*)(fo + DFF) = g0; *(f32x4*)(fo + DFF + 4) = g1; }
    }
}
__device__ __forceinline__ void phase_convgate(const Args& A, int gw, int NGW, int lane) {
    constexpr int NPI = (MP / 32) * 6, NSI = BS * 6;
    for (int it = gw; it < NPI + NSI; it += NGW) {
        if (it < NPI) convgate_strip(A, (it / 6) * 32, 32, it % 6, lane);
        else { const int j = it - NPI; convgate_strip(A, MP + (j / 6) * 8, 8, j % 6, lane); }
    }
}

constexpr int NPHASE = 13;
#ifndef REP_MASK
#define REP_MASK 0
#endif

__global__ void __launch_bounds__(512, 2) fwd_kernel(Args A) {
    extern __shared__ __attribute__((aligned(16))) unsigned char lds_raw[];
    LAS unsigned char* lds = (LAS unsigned char*)lds_raw;
    const int wave = __builtin_amdgcn_readfirstlane((int)threadIdx.x >> 6);
    const int G = gridDim.x, bx = blockIdx.x;
    const int gw = bx * 8 + wave, NGW = G * 8, NGT = G * 512;
    unsigned char* ws = A.ws;
    gu32* ctl = (gu32*)(ws + WS_CTL);
    volatile LAS unsigned* MISC = (volatile LAS unsigned*)(lds + MISC_OFF);
    { const int t0 = wave * 64 + lane_now(); for (int u = t0; u < (LDS_BYTES - RING_BYTES) / 4; u += 512) ((LAS unsigned*)(lds + RING_BYTES))[u] = 0u; }
    __syncthreads();
    const int lo = A.lo, hi = A.hi;
    const bool multi = (hi - lo) > 1;
    XcdBarrier bar; bar.bar = (unsigned*)(ctl + CW_BAR); bar.x = 0; bar.st = nullptr;
    if (multi) bar = xcd_barrier_post((unsigned*)(ctl + CW_BAR), MISC + 8, wave * 64 + lane_now());
#define IN(k) (lo <= (k) && (k) < hi)
#define GBAR() xcd_barrier(bar, wave * 64 + lane_now())
#define SEAM(k) do { if (IN(k) && IN((k) + 1)) GBAR(); } while (0)
    float* MOD = (float*)(ws + WS_MOD);

#define PH0(rep_) phase_prologue(A, lds, gw, NGW, wave, lane, gtid, NGT);
#define PH1(rep_) phase_mod(A, gw, NGW, lane);
#define PH2(rep_) phase_norm<true>((const float*)A.in[I_XP], (const float*)A.in[I_XS], (const float*)A.in[I_GATT], MOD, 0, 1024, (bf16*)(ws + WS_H), (const float*)(ws + WS_WINX), (float*)(ws + WS_EXTRA), gw, NGW, lane);
#define PH3(rep_) { pg8::Gemm g{(const pg8::bf16_t*)(ws + WS_H), (const pg8::bf16_t*)(ws + WS_WIN_T), M, NPROJ, D}; pg8::StaticOrder S; S.init(M, NPROJ, G, bx); \
          EpiProj E{A.out, (bf16*)(ws + WS_QB), (bf16*)(ws + WS_KB), (bf16*)(ws + WS_VB), (bf16*)(ws + WS_DNRAW), (bf16*)(ws + WS_ZG), (const float*)A.in[I_GQ], (const float*)A.in[I_GK], (LAS float*)(lds + RING_BYTES + 1024)}; \
          pg8::gemm_phase<EpiProj, pg8::StaticOrder, true, true>(lds, g, S, E, tid); }
#define PH4(rep_) phase_post(A, gw, NGW, lane, gtid, NGT);
#define PH5(rep_) for (int u = bx; u < 1024; u += G) { if (u < 512) dn_prescan_unit(A, lds, u, tid, wave, lane); else dn_sample_unit(A, lds, u - 512, tid); }
#define PH6(rep_) PH6X(rep_, true, true, true)
#define PH6X(rep_, DS_, DP_, DA_) { if ((DS_) && bx < 16) dn_scan_chain(A, lds, bx, tid, wave, lane); \
          \
        bool moreP = (DP_), moreS = (DA_); const bool pfirst = wave < 4; \
        for (;;) { \
            int job = -1; bool isP = false; \
            if (pfirst && moreP) { unsigned j_ = 0; if (lane == 0) j_ = __hip_atomic_fetch_add(ctl + CW_QUEUE + 128 * (rep_), 1u, RLX_AGENT); j_ = __builtin_amdgcn_readfirstlane(j_); if (j_ < 2048u) { job = (int)j_; isP = true; } else moreP = false; } \
            if (job < 0 && moreS) { unsigned j_ = 0; if (lane == 0) j_ = __hip_atomic_fetch_add(ctl + CW_QUEUE + 128 * (rep_) + 64, 1u, RLX_AGENT); j_ = __builtin_amdgcn_readfirstlane(j_); if (j_ < 4096u) { job = (int)j_; } else moreS = false; } \
            if (job < 0 && !pfirst && moreP) { unsigned j_ = 0; if (lane == 0) j_ = __hip_atomic_fetch_add(ctl + CW_QUEUE + 128 * (rep_), 1u, RLX_AGENT); j_ = __builtin_amdgcn_readfirstlane(j_); if (j_ < 2048u) { job = (int)j_; isP = true; } else moreP = false; } \
            if (job < 0) { if (!moreP && !moreS) break; else continue; } \
            if (isP) { const int qb = 63 - (job >> 5), bh = job & 31; attn_prompt_item(A, lds + wave * AW_BYTES, bh >> 3, bh & 7, qb * 64, lane); } \
            else { const int h_ = job & 7, bs_ = job >> 3; attn_sample_job(A, lds + wave * AW_BYTES, bs_ >> 2, h_, bs_ & 3, lane); } \
        } }
#define PH7(rep_) phase_outnorm(A, gw, NGW, lane);
#define PH8(rep_) { pg8::Gemm g{(const pg8::bf16_t*)(ws + WS_MIXED), (const pg8::bf16_t*)(ws + WS_WOUT_T), M, D, D}; pg8::StaticOrder S; S.init(M, D, G, bx); \
        EpiResGate E{(const float*)A.in[I_XP], (const float*)A.in[I_XS], MOD, 2048, (float*)(ws + WS_X1)}; \
        pg8::gemm_phase<EpiResGate, pg8::StaticOrder, true, true>(lds, g, S, E, tid); }
#define PH9(rep_) phase_norm<false>((const float*)(ws + WS_X1), (const float*)(ws + WS_X1) + (size_t)MP * D, (const float*)A.in[I_GFFN], MOD, 3072, 4096, (bf16*)(ws + WS_H), nullptr, nullptr, gw, NGW, lane);
#define PH10(rep_) { pg8::Gemm g{(const pg8::bf16_t*)(ws + WS_H), (const pg8::bf16_t*)(ws + WS_WUP_T), M, DFF2, D}; pg8::StaticOrder S; S.init(M, DFF2, G, bx); \
        pg8::EpiBf16<0> E{(pg8::bf16_t*)(ws + WS_UP), DFF2, nullptr, 0, 0, 1.f}; \
        pg8::gemm_phase<pg8::EpiBf16<0>, pg8::StaticOrder, true, true>(lds, g, S, E, tid); }
#define PH11(rep_) phase_convgate(A, gw, NGW, lane);
#define PH12(rep_) { pg8::Gemm g{(const pg8::bf16_t*)(ws + WS_ACT), (const pg8::bf16_t*)(ws + WS_WDN_T), M, D, DFF}; pg8::StaticOrder S; S.init(M, D, G, bx); \
        EpiResGate E{(const float*)(ws + WS_X1), (const float*)(ws + WS_X1) + (size_t)MP * D, MOD, 5120, A.out}; \
        pg8::gemm_phase<EpiResGate, pg8::StaticOrder, true, true>(lds, g, S, E, tid); }
#define RUNPH(k) do { if (IN(k)) { const int lane = lane_now(), tid = wave * 64 + lane, gtid = bx * 512 + tid; (void)gtid; PH##k(0) if constexpr (((REP_MASK) >> (k)) & 1) { GBAR(); PH##k(1) } } } while (0)
    RUNPH(0); SEAM(0);
    RUNPH(1); SEAM(1);
    RUNPH(2); SEAM(2);
    RUNPH(3); SEAM(3);
    RUNPH(4); SEAM(4);
    RUNPH(5); SEAM(5);
    RUNPH(6);
    if constexpr (((REP_MASK) >> 13) & 1) { GBAR(); const int lane = lane_now(), tid = wave * 64 + lane; PH6X(2, true, false, false) }
    if constexpr (((REP_MASK) >> 14) & 1) { GBAR(); const int lane = lane_now(), tid = wave * 64 + lane; PH6X(3, false, true, false) }
    if constexpr (((REP_MASK) >> 15) & 1) { GBAR(); const int lane = lane_now(), tid = wave * 64 + lane; PH6X(4, false, false, true) }
    SEAM(6);
    RUNPH(7); SEAM(7);
    RUNPH(8); SEAM(8);
    RUNPH(9); SEAM(9);
    RUNPH(10); SEAM(10);
    RUNPH(11); SEAM(11);
    RUNPH(12);
#undef IN
#undef SEAM
}

#ifndef N_LAUNCHES
#define N_LAUNCHES 1
#endif
extern "C" void kernel_launch(void* const* d_in, const int* in_sizes, int n_in, void* d_out, int out_size, void* d_ws, size_t ws_size, hipStream_t stream) {
    static int grid = 0;
    if (grid == 0) {
        if (n_in != 27 || (size_t)out_size != O_END || ws_size < WS_END) { fprintf(stderr, "kernel_launch: unexpected shapes: n_in %d out %d ws %zu\n", n_in, out_size, ws_size); grid = -1; return; }
        int dev = 0, cus = 0, per_cu = 0;
        if (hipGetDevice(&dev) != hipSuccess || hipDeviceGetAttribute(&cus, hipDeviceAttributeMultiprocessorCount, dev) != hipSuccess) { grid = -1; return; }
        if (hipFuncSetAttribute((const void*)fwd_kernel, hipFuncAttributeMaxDynamicSharedMemorySize, LDS_BYTES) != hipSuccess) { fprintf(stderr, "kernel_launch: hipFuncSetAttribute failed\n"); grid = -1; return; }
        if (hipOccupancyMaxActiveBlocksPerMultiprocessor(&per_cu, (const void*)fwd_kernel, 512, LDS_BYTES) != hipSuccess || per_cu < 1) fprintf(stderr, "kernel_launch: occupancy query says %d\n", per_cu);
        (void)hipGetLastError();
        grid = cus;
    }
    if (grid < 0) return;
    (void)hipMemsetAsync((char*)d_ws + WS_CTL, 0, CTL_ZERO_BYTES, stream);
    Args a{};
    for (int i = 0; i < 27; ++i) a.in[i] = d_in[i];
    a.out = (float*)d_out; a.ws = (unsigned char*)d_ws;
    if (N_LAUNCHES == 1) { a.lo = 0; a.hi = NPHASE; hipLaunchKernelGGL(fwd_kernel, dim3(grid), dim3(512), LDS_BYTES, stream, a); }
    else for (int p = 0; p < NPHASE; ++p) { a.lo = p; a.hi = p + 1; hipLaunchKernelGGL(fwd_kernel, dim3(grid), dim3(512), LDS_BYTES, stream, a); }
}
```

```cpp
#include <hip/hip_runtime.h>
#include <cstdio>
#include <cstdint>
#define REP_MASK 0
namespace pg8 {
#define PG8_LAS __attribute__((address_space(3)))
typedef unsigned short bf16_t;
typedef short bf16x8 __attribute__((ext_vector_type(8)));
typedef float f32x4 __attribute__((ext_vector_type(4)));
typedef unsigned u32x4 __attribute__((ext_vector_type(4)));
constexpr int BM = 256, BK = 64, HALF = 128, HTB = HALF * BK * 2  , STAGE_BYTES = 8 * HTB, NXCD = 8, WGM = 8;

__host__ __device__ __forceinline__ int lds_byte(int r, int c) { const int st = (r >> 4) * 2 + (c >> 5), rr = r & 15, cc = c & 31, ob = rr * 64 + cc * 2; return st * 1024 + (ob ^ (((ob >> 9) & 1) << 5)); }
__host__ __device__ __forceinline__ void stage_rc(int b, int& R, int& C) { const int st = b / 1024, sb = b % 1024, swz = sb ^ (((sb >> 9) & 1) << 5); R = (st >> 1) * 16 + swz / 64; C = (st & 1) * 32 + (swz % 64) / 2; }
__host__ __device__ __forceinline__ int perm32(int rho) { const int n = rho >> 4, i = rho & 15; return 8 * (i >> 2) + 4 * n + (i & 3); }

struct Unit { int pm, pn; };
struct Gemm { const bf16_t* A; const bf16_t* Bt; int M, N, K; };

struct StaticOrder {
    int nM, nN, nwg, G, c;
    __host__ __device__ void init(int M, int N, int G_, int c_) { nM = M / BM; nN = N / BM; nwg = nM * nN; G = G_; c = c_; }
    __host__ __device__ bool next(int i, Unit& u) const {
        const long L = (long)i * G + c; if (L >= nwg) return false;
        int wgid = (int)L; { const int q = nwg / NXCD, r = nwg % NXCD, xcd = wgid % NXCD, off = wgid / NXCD; wgid = (xcd < r ? xcd * (q + 1) : r * (q + 1) + (xcd - r) * q) + off; }
        const int nig = WGM * nN, gid = wgid / nig, fm = gid * WGM, gsz = (nM - fm) < WGM ? (nM - fm) : WGM;
        u.pm = fm + ((wgid % nig) % gsz); u.pn = (wgid % nig) / gsz; return true;
    }
    __device__ __forceinline__ void a_ready(const Unit&) const {}
    __device__ __forceinline__ void done(const Unit&) const {}
};

__device__ __forceinline__ unsigned cvt_pk_bf16(float lo, float hi) { unsigned r; asm volatile("v_cvt_pk_bf16_f32 %0, %1, %2" : "=v"(r) : "v"(lo), "v"(hi)); return r; }
typedef float f32x2 __attribute__((ext_vector_type(2)));
__device__ __forceinline__ f32x2 gelu_pk(f32x2 v) {
    const f32x2 av = __builtin_elementwise_abs(v), d = av * 0.2316418882f + 1.0f;
    f32x2 t; t.x = __builtin_amdgcn_rcpf(d.x); t.y = __builtin_amdgcn_rcpf(d.y);
    f32x2 q = t * 0.5307027145f + (-0.7265760135f); q = q * t + 0.7107068705f; q = q * t + (-0.142248368f); q = q * t + 0.127414796f; q = q * t;
    const f32x2 s = (v * v) * (-0.72134752044f);
    f32x2 e; e.x = __builtin_amdgcn_exp2f(s.x); e.y = __builtin_amdgcn_exp2f(s.y);
    const f32x2 m = v * (q * e), r = v - m;
    f32x2 o; o.x = v.x < 0.f ? m.x : r.x; o.y = v.y < 0.f ? m.y : r.y; return o;
}

template <int ACT  > struct EpiBf16 {
    static constexpr bool PERM = true, AFTER_DRAIN = false; static_assert(ACT == 0 || ACT == 1, "EpiBf16: ACT is 0 (none) or 1 (gelu_pk)");
    bf16_t* O; int ldc; const float* bias; int split_cols; size_t split_stride; float scale0;
    __device__ __forceinline__ void operator()(const f32x4 (&acc)[2][2][4][2], const Unit& u, int wr, int wc, int fr, int fq) const {
        const int row0 = u.pm * BM + wr * 64 + fr; int colt = u.pn * BM; bf16_t* base = O;
        float sc = 1.f; if (split_cols) { const int t = colt / split_cols; base += (size_t)t * split_stride; colt -= t * split_cols; if (t == 0) sc = scale0; }
        const int col0 = colt + wc * 32 + 8 * fq, bcol0 = u.pn * BM + wc * 32 + 8 * fq;
        f32x4 bv[2][2];
#pragma unroll
        for (int bj = 0; bj < 2; ++bj)
#pragma unroll
            for (int n = 0; n < 2; ++n) bv[bj][n] = bias ? *(const f32x4*)(bias + bcol0 + bj * HALF + 4 * n) : (f32x4){0.f, 0.f, 0.f, 0.f};
#pragma unroll
        for (int ai = 0; ai < 2; ++ai)
#pragma unroll
            for (int m = 0; m < 4; ++m) { bf16_t* rowp = base + (size_t)(row0 + ai * HALF + m * 16) * ldc + col0;
#pragma unroll
                for (int bj = 0; bj < 2; ++bj) { f32x4 v0 = acc[ai][bj][m][0] + bv[bj][0], v1 = acc[ai][bj][m][1] + bv[bj][1];
                    if (ACT == 1) { f32x2 a = gelu_pk((f32x2){v0[0], v0[1]}), b = gelu_pk((f32x2){v0[2], v0[3]}), c = gelu_pk((f32x2){v1[0], v1[1]}), d = gelu_pk((f32x2){v1[2], v1[3]});
                        v0 = (f32x4){a.x, a.y, b.x, b.y}; v1 = (f32x4){c.x, c.y, d.x, d.y}; }
                    v0 = v0 * sc; v1 = v1 * sc; u32x4 w; w.x = cvt_pk_bf16(v0[0], v0[1]); w.y = cvt_pk_bf16(v0[2], v0[3]); w.z = cvt_pk_bf16(v1[0], v1[1]); w.w = cvt_pk_bf16(v1[2], v1[3]);
                    *(u32x4*)(rowp + bj * HALF) = w; } }
    }
};

struct PanelStats {
    unsigned* xbuf;
    unsigned* cnt;
    unsigned* tmo;
    int ntn; float eps;
    unsigned code;
    __device__ __forceinline__ bool run(const f32x4 (&v)[2][2][4][2], const Unit& u, int wr, int wc, int fr, int fq, PG8_LAS unsigned char* lds, int wid, int lane) const {
        typedef float f32x2v __attribute__((ext_vector_type(2)));
        PG8_LAS f32x2v* P = (PG8_LAS f32x2v*)lds;
        PG8_LAS f32x2v* S = (PG8_LAS f32x2v*)(lds + 8192);
        PG8_LAS unsigned* flag = (PG8_LAS unsigned*)(lds + 8192 + 2048);
#pragma unroll
        for (int ai = 0; ai < 2; ++ai)
#pragma unroll
            for (int m = 0; m < 4; ++m) {
                float s = 0.f;
#pragma unroll
                for (int bj = 0; bj < 2; ++bj)
#pragma unroll
                    for (int n = 0; n < 2; ++n) { const f32x4 x = v[ai][bj][m][n]; s += (x[0] + x[1]) + (x[2] + x[3]); }
                s += __shfl_xor(s, 16); s += __shfl_xor(s, 32);
                const float mw = s * (1.0f / 64.0f); float q = 0.f;
#pragma unroll
                for (int bj = 0; bj < 2; ++bj)
#pragma unroll
                    for (int n = 0; n < 2; ++n) { const f32x4 d = v[ai][bj][m][n] - mw; q += (d[0] * d[0] + d[1] * d[1]) + (d[2] * d[2] + d[3] * d[3]); }
                q += __shfl_xor(q, 16); q += __shfl_xor(q, 32);
                if (fq == 0) P[(ai * HALF + wr * 64 + m * 16 + fr) * 4 + wc] = (f32x2v){mw, q};
            }
        asm volatile("s_waitcnt lgkmcnt(0)" ::: "memory"); __builtin_amdgcn_s_barrier(); asm volatile("" ::: "memory");
#if defined(BROKEN_EXCHANGE_NO_WAIT)
#warning BROKEN CONTROL BUILD: the row-statistics exchange does not wait; results are wrong by design
        if (blockIdx.x >= 64) { const long long t0_ = clock64(); while (clock64() - t0_ < 60000) __builtin_amdgcn_s_sleep(8); }
#endif
        const int row = wid * 32 + (lane & 31);
        if (lane < 32) {
            const f32x2v a = P[row * 4 + 0], b = P[row * 4 + 1], c = P[row * 4 + 2], d = P[row * 4 + 3];
            const float mt = (a.x + b.x + c.x + d.x) * 0.25f;
            const float da = a.x - mt, db = b.x - mt, dc = c.x - mt, dd = d.x - mt;
            const float m2 = (a.y + b.y) + (c.y + d.y) + 64.0f * ((da * da + db * db) + (dc * dc + dd * dd));
            unsigned long long* slot = (unsigned long long*)xbuf + ((size_t)(u.pm * BM + row) * 4 + u.pn);
            __hip_atomic_store(slot, ((unsigned long long)__float_as_uint(m2) << 32) | __float_as_uint(mt), __ATOMIC_RELAXED, __HIP_MEMORY_SCOPE_AGENT);
        }
        asm volatile("s_waitcnt vmcnt(0)" ::: "memory");
        if (lane == 0) __hip_atomic_fetch_add(cnt + 64 * u.pm, 1u, __ATOMIC_RELAXED, __HIP_MEMORY_SCOPE_AGENT);
        if (wid == 0) {
            bool dead = false; const unsigned long long t0 = __builtin_amdgcn_s_memrealtime(); const unsigned want = 8u * (unsigned)ntn;
            for (;;) {
#if defined(BROKEN_EXCHANGE_NO_WAIT)
                break;
#endif
                if ((unsigned)__builtin_amdgcn_readfirstlane(__hip_atomic_load(cnt + 64 * u.pm, __ATOMIC_RELAXED, __HIP_MEMORY_SCOPE_AGENT)) >= want) break;
                if (__builtin_amdgcn_s_memrealtime() - t0 > 2000000ull) {
                    if (lane == 0) { unsigned expect = 0u; __hip_atomic_compare_exchange_strong(tmo + 1, &expect, code | (unsigned)(u.pm & 0xff), __ATOMIC_RELAXED, __ATOMIC_RELAXED, __HIP_MEMORY_SCOPE_AGENT);
                                     __hip_atomic_store(tmo, 1u, __ATOMIC_RELAXED, __HIP_MEMORY_SCOPE_AGENT); }
                    dead = true; break; }
                __builtin_amdgcn_s_sleep(2);
            }
            __builtin_amdgcn_fence(__ATOMIC_ACQUIRE, "agent");
            if (lane == 0) flag[0] = dead ? 1u : 0u;
        }
        asm volatile("s_waitcnt vmcnt(0) lgkmcnt(0)" ::: "memory"); __builtin_amdgcn_s_barrier(); asm volatile("" ::: "memory");
        const bool bad = flag[0] != 0u;
        if (lane < 32) {
            const unsigned long long* slot = (const unsigned long long*)xbuf + (size_t)(u.pm * BM + row) * 4; float mt[4], m2[4]; float ms = 0.f;
#pragma unroll
            for (int t = 0; t < 4; ++t) { if (t < ntn) { const unsigned long long w = __hip_atomic_load(slot + t, __ATOMIC_RELAXED, __HIP_MEMORY_SCOPE_AGENT); mt[t] = __uint_as_float((unsigned)w); m2[t] = __uint_as_float((unsigned)(w >> 32)); } else { mt[t] = 0.f; m2[t] = 0.f; } ms += mt[t]; }
            const float mean = ms / (float)ntn; float q = 0.f;
#pragma unroll
            for (int t = 0; t < 4; ++t) if (t < ntn) { const float dm = mt[t] - mean; q += m2[t] + 256.0f * dm * dm; }
            S[row] = (f32x2v){mean, 1.0f / sqrtf(q / (256.0f * (float)ntn) + eps)};
        }
        asm volatile("s_waitcnt lgkmcnt(0)" ::: "memory"); __builtin_amdgcn_s_barrier(); asm volatile("" ::: "memory");
        return bad;
    }
};
struct EpiLnRes {
    static constexpr bool PERM = false, AFTER_DRAIN = true;
    const float* base; float* out; int ldc; const float* bias; PanelStats st; unsigned poison;
    __device__ __forceinline__ void fused(f32x4 (&acc)[2][2][4][2], const Unit& u, int wr, int wc, int fr, int fq, PG8_LAS unsigned char* lds, int wid, int lane) const {
        typedef float f32x2v __attribute__((ext_vector_type(2)));
        const PG8_LAS f32x2v* S = (const PG8_LAS f32x2v*)(lds + 8192);
        const int col0 = u.pn * BM + wc * 32 + 4 * fq;
#pragma unroll
        for (int bj = 0; bj < 2; ++bj)
#pragma unroll
            for (int n = 0; n < 2; ++n) { const f32x4 bv = bias ? *(const f32x4*)(bias + col0 + bj * HALF + n * 16) : (f32x4){0.f, 0.f, 0.f, 0.f};
#pragma unroll
                for (int ai = 0; ai < 2; ++ai)
#pragma unroll
                    for (int m = 0; m < 4; ++m) acc[ai][bj][m][n] += bv; }
        f32x4 pre[4][2][2];
#pragma unroll
        for (int m = 0; m < 4; ++m) { const size_t off = (size_t)(u.pm * BM + wr * 64 + m * 16 + fr) * ldc + col0;
#pragma unroll
            for (int bj = 0; bj < 2; ++bj)
#pragma unroll
                for (int n = 0; n < 2; ++n) pre[m][bj][n] = *(const f32x4*)(base + off + bj * HALF + n * 16); }
        const bool bad = st.run(acc, u, wr, wc, fr, fq, lds, wid, lane) || poison != 0u;
        const float qnan = __builtin_nanf("");
#pragma unroll
        for (int ai = 0; ai < 2; ++ai)
#pragma unroll
            for (int m = 0; m < 4; ++m) { const int r = ai * HALF + wr * 64 + m * 16 + fr; const f32x2v sr = S[r]; const size_t off = (size_t)(u.pm * BM + r) * ldc + col0;
#pragma unroll
                for (int bj = 0; bj < 2; ++bj)
#pragma unroll
                    for (int n = 0; n < 2; ++n) { const f32x4 bs = ai == 0 ? pre[m][bj][n] : *(const f32x4*)(base + off + bj * HALF + n * 16); f32x4 o = bs + (acc[ai][bj][m][n] - sr.x) * sr.y;
                        if (bad) o = (f32x4){qnan, qnan, qnan, qnan}; *(f32x4*)(out + off + bj * HALF + n * 16) = o; }
                if (m & 1) asm volatile("" ::: "memory"); }
    }
};
struct EpiLnResLn {
    static constexpr bool PERM = false, AFTER_DRAIN = true;
    const float* base; float* out; bf16_t* xn; int ldc; const float* bias; PanelStats st1, st2; unsigned poison;
    __device__ __forceinline__ void fused(f32x4 (&acc)[2][2][4][2], const Unit& u, int wr, int wc, int fr, int fq, PG8_LAS unsigned char* lds, int wid, int lane) const {
        typedef float f32x2v __attribute__((ext_vector_type(2))); typedef unsigned u32x2v __attribute__((ext_vector_type(2)));
        const PG8_LAS f32x2v* S = (const PG8_LAS f32x2v*)(lds + 8192);
        const int col0 = u.pn * BM + wc * 32 + 4 * fq;
#pragma unroll
        for (int bj = 0; bj < 2; ++bj)
#pragma unroll
            for (int n = 0; n < 2; ++n) { const f32x4 bv = bias ? *(const f32x4*)(bias + col0 + bj * HALF + n * 16) : (f32x4){0.f, 0.f, 0.f, 0.f};
#pragma unroll
                for (int ai = 0; ai < 2; ++ai)
#pragma unroll
                    for (int m = 0; m < 4; ++m) acc[ai][bj][m][n] += bv; }
        bool bad = st1.run(acc, u, wr, wc, fr, fq, lds, wid, lane) || poison != 0u;
        const float qnan = __builtin_nanf("");
#pragma unroll
        for (int ai = 0; ai < 2; ++ai)
#pragma unroll
            for (int m = 0; m < 4; ++m) { const int r = ai * HALF + wr * 64 + m * 16 + fr; const f32x2v sr = S[r]; const size_t off = (size_t)(u.pm * BM + r) * ldc + col0;
#pragma unroll
                for (int bj = 0; bj < 2; ++bj)
#pragma unroll
                    for (int n = 0; n < 2; ++n) { const f32x4 bs = *(const f32x4*)(base + off + bj * HALF + n * 16); acc[ai][bj][m][n] = bs + (acc[ai][bj][m][n] - sr.x) * sr.y; }
                asm volatile("" : "+v"(acc[ai][0][m][0]), "+v"(acc[ai][0][m][1]), "+v"(acc[ai][1][m][0]), "+v"(acc[ai][1][m][1]));
                if (m & 1) asm volatile("" ::: "memory"); }
        const bool bad1 = bad;
        bad = st2.run(acc, u, wr, wc, fr, fq, lds, wid, lane) || bad;
#pragma unroll
        for (int ai = 0; ai < 2; ++ai)
#pragma unroll
            for (int m = 0; m < 4; ++m) { const int r = ai * HALF + wr * 64 + m * 16 + fr; const f32x2v sr = S[r]; const size_t off = (size_t)(u.pm * BM + r) * ldc + col0;
#pragma unroll
                for (int bj = 0; bj < 2; ++bj)
#pragma unroll
                    for (int n = 0; n < 2; ++n) { const f32x4 x1 = acc[ai][bj][m][n]; *(f32x4*)(out + off + bj * HALF + n * 16) = bad1 ? (f32x4){qnan, qnan, qnan, qnan} : x1;
                        const f32x4 o = (x1 - sr.x) * sr.y; u32x2v w; w.x = cvt_pk_bf16(o[0], o[1]); w.y = cvt_pk_bf16(o[2], o[3]);
                        if (bad) { w.x = 0x7fc07fc0u; w.y = 0x7fc07fc0u; } *(u32x2v*)(xn + off + bj * HALF + n * 16) = w; }
                asm volatile("" ::: "memory"); }
    }
};

template <class Epi, class Sched, bool ALIGN_EPI = false, bool SP2 = false>
__device__ __forceinline__ void gemm_phase(PG8_LAS unsigned char* lds, const Gemm g, const Sched& S, const Epi& E, const int tid) {
    const int wid = __builtin_amdgcn_readfirstlane(tid >> 6), lane = tid & 63, wr = wid >> 2, wc = wid & 3, fr = lane & 15, fq = lane >> 4;
    const int K = g.K, nt = K / BK;
    unsigned voffA[2], voffB[2];
#pragma unroll
    for (int i = 0; i < 2; ++i) { int R, C; stage_rc(tid * 16 + i * 8192, R, C); const int Rb = Epi::PERM ? ((R & ~31) + perm32(R & 31)) : R;
        voffA[i] = (unsigned)(R * K + C) * 2u; voffB[i] = (unsigned)(Rb * K + C) * 2u; }
    const size_t kstep = (size_t)(BK * 2);
    const size_t hstep = (size_t)HALF * K * 2;
    const size_t tstep = 2 * hstep;
    const unsigned ldsw = (unsigned)wid * 1024u;
    const int aoff = lds_byte(wr * 64 + fr, fq * 8), boff = lds_byte(wc * 32 + fr, fq * 8);
#define PG8_SA(b, h) (((b) * 2 + (h)) * HTB)
#define PG8_SB(b, h) ((4 + (b) * 2 + (h)) * HTB)
#define PG8_STAGE(bufoff, gbase, voff) do { _Pragma("unroll") for (int _i = 0; _i < 2; ++_i) \
        __builtin_amdgcn_global_load_lds((const unsigned*)((const char*)(gbase) + (voff)[_i]), (PG8_LAS unsigned*)(lds + (bufoff) + ldsw + _i * 8192), 16, 0, 0); } while (0)
#define PG8_LDA(dst, b, h) do { _Pragma("unroll") for (int m = 0; m < 4; ++m) _Pragma("unroll") for (int k = 0; k < 2; ++k) dst[m][k] = *(const PG8_LAS bf16x8*)(lds + PG8_SA(b, h) + aoff + m * 2048 + k * 1024); } while (0)
#define PG8_LDB(dst, b, h) do { _Pragma("unroll") for (int n = 0; n < 2; ++n) _Pragma("unroll") for (int k = 0; k < 2; ++k) dst[n][k] = *(const PG8_LAS bf16x8*)(lds + PG8_SB(b, h) + boff + n * 2048 + k * 1024); } while (0)
#define PG8_MMA(ai, bj, At, Bt) do { __builtin_amdgcn_s_setprio(1); _Pragma("unroll") for (int m = 0; m < 4; ++m) _Pragma("unroll") for (int n = 0; n < 2; ++n) _Pragma("unroll") for (int k = 0; k < 2; ++k) \
        acc[ai][bj][m][n] = __builtin_amdgcn_mfma_f32_16x16x32_bf16(Bt[n][k], At[m][k], acc[ai][bj][m][n], 0, 0, 0); __builtin_amdgcn_s_setprio(0); } while (0)
#define PG8_WAIT_V(n) asm volatile("s_waitcnt vmcnt(" #n ")" ::: "memory")
#define PG8_WAIT_L(n) asm volatile("s_waitcnt lgkmcnt(" #n ")" ::: "memory")
#define PG8_BAR __builtin_amdgcn_s_barrier()
#define PG8_SCHED __builtin_amdgcn_sched_barrier(0)
    Unit cur, nxt; int ui = 0;
    if (!S.next(0, cur)) return;
    f32x4 acc[2][2][4][2];
#pragma unroll
    for (int a = 0; a < 2; ++a)
#pragma unroll
        for (int b = 0; b < 2; ++b)
#pragma unroll
            for (int m = 0; m < 4; ++m)
#pragma unroll
                for (int n = 0; n < 2; ++n) acc[a][b][m][n] = (f32x4){0.f, 0.f, 0.f, 0.f};
    bf16x8 At[4][2], B0[2][2], B1[2][2];
    const char* cA = (const char*)g.A + (size_t)cur.pm * tstep; const char* cB = (const char*)g.Bt + (size_t)cur.pn * tstep;
    S.a_ready(cur);
    if constexpr (SP2) {
        PG8_STAGE(PG8_SB(0, 0), cB, voffB); PG8_STAGE(PG8_SB(0, 1), cB + hstep, voffB); PG8_STAGE(PG8_SA(0, 0), cA, voffA); PG8_STAGE(PG8_SA(0, 1), cA + hstep, voffA);
        if (wr == 1) PG8_BAR;
        PG8_WAIT_V(2); PG8_BAR;
        PG8_STAGE(PG8_SB(1, 0), cB + kstep, voffB); PG8_STAGE(PG8_SA(1, 0), cA + kstep, voffA); PG8_STAGE(PG8_SB(1, 1), cB + hstep + kstep, voffB);
        PG8_WAIT_V(6); PG8_BAR;
    } else {
        PG8_STAGE(PG8_SB(0, 0), cB, voffB); PG8_STAGE(PG8_SA(0, 0), cA, voffA); PG8_STAGE(PG8_SB(0, 1), cB + hstep, voffB); PG8_STAGE(PG8_SA(0, 1), cA + hstep, voffA);
        if (wr == 1) PG8_BAR;
        PG8_WAIT_V(4); PG8_BAR;
        PG8_STAGE(PG8_SB(1, 0), cB + kstep, voffB); PG8_STAGE(PG8_SA(1, 0), cA + kstep, voffA); PG8_STAGE(PG8_SB(1, 1), cB + hstep + kstep, voffB);
        PG8_WAIT_V(6); PG8_BAR;
    }
    for (;;) {
        const bool has_next = S.next(ui + 1, nxt);
        const char* nA = has_next ? (const char*)g.A + (size_t)nxt.pm * tstep : cA; const char* nB = has_next ? (const char*)g.Bt + (size_t)nxt.pn * tstep : cB;
        for (int t = 0; t < nt; t += 2) {
            const bool last = (t == nt - 2);
            const char* a1 = cA + (size_t)(t + 1) * kstep;
            const char* a2 = last ? nA : cA + (size_t)(t + 2) * kstep; const char* b2 = last ? nB : cB + (size_t)(t + 2) * kstep;
            const char* a3 = a2 + kstep; const char* b3 = b2 + kstep;
            if (last && has_next) S.a_ready(nxt);
            if constexpr (SP2) {
            PG8_LDB(B0, 0, 0); PG8_LDB(B1, 0, 1); PG8_SCHED; PG8_LDA(At, 0, 0); PG8_STAGE(PG8_SA(1, 1), a1 + hstep, voffA);
            PG8_WAIT_V(8); PG8_WAIT_L(0); PG8_BAR; PG8_MMA(0, 0, At, B0); PG8_MMA(0, 1, At, B1); PG8_BAR; PG8_SCHED;
            PG8_LDA(At, 0, 1); PG8_STAGE(PG8_SB(0, 0), b2, voffB); PG8_STAGE(PG8_SB(0, 1), b2 + hstep, voffB); PG8_STAGE(PG8_SA(0, 0), a2, voffA);
            PG8_WAIT_V(8); PG8_WAIT_L(0); PG8_BAR; PG8_MMA(1, 0, At, B0); PG8_MMA(1, 1, At, B1); PG8_BAR; PG8_SCHED;
            PG8_LDB(B0, 1, 0); PG8_LDB(B1, 1, 1); PG8_SCHED; PG8_LDA(At, 1, 0); PG8_STAGE(PG8_SA(0, 1), a2 + hstep, voffA);
            PG8_WAIT_V(8); PG8_WAIT_L(0); PG8_BAR; PG8_MMA(0, 0, At, B0); PG8_MMA(0, 1, At, B1); PG8_BAR; PG8_SCHED;
            PG8_LDA(At, 1, 1); PG8_STAGE(PG8_SB(1, 0), b3, voffB); PG8_STAGE(PG8_SB(1, 1), b3 + hstep, voffB); PG8_STAGE(PG8_SA(1, 0), a3, voffA);
            PG8_WAIT_V(8); PG8_WAIT_L(0); PG8_BAR; PG8_MMA(1, 0, At, B0); PG8_MMA(1, 1, At, B1); PG8_BAR; PG8_SCHED;
            } else {
            PG8_LDB(B0, 0, 0); PG8_SCHED; PG8_LDA(At, 0, 0); PG8_STAGE(PG8_SA(1, 1), a1 + hstep, voffA);
            PG8_WAIT_L(8); PG8_BAR; PG8_WAIT_L(0); PG8_MMA(0, 0, At, B0); PG8_BAR; PG8_SCHED;
            PG8_LDB(B1, 0, 1); PG8_STAGE(PG8_SB(0, 0), b2, voffB);
            PG8_BAR; PG8_WAIT_L(0); PG8_MMA(0, 1, At, B1); PG8_BAR;
            PG8_LDA(At, 0, 1); PG8_STAGE(PG8_SA(0, 0), a2, voffA);
            PG8_BAR; PG8_WAIT_L(0); PG8_MMA(1, 0, At, B0); PG8_BAR; PG8_SCHED;
            PG8_STAGE(PG8_SB(0, 1), b2 + hstep, voffB);
            PG8_WAIT_V(6); PG8_BAR; PG8_MMA(1, 1, At, B1); PG8_BAR;
            PG8_LDB(B0, 1, 0); PG8_SCHED; PG8_LDA(At, 1, 0); PG8_STAGE(PG8_SA(0, 1), a2 + hstep, voffA);
            PG8_WAIT_L(8); PG8_BAR; PG8_WAIT_L(0); PG8_MMA(0, 0, At, B0); PG8_BAR; PG8_SCHED;
            PG8_LDB(B1, 1, 1); PG8_STAGE(PG8_SB(1, 0), b3, voffB);
            PG8_BAR; PG8_WAIT_L(0); PG8_MMA(0, 1, At, B1); PG8_BAR;
            PG8_LDA(At, 1, 1); PG8_STAGE(PG8_SA(1, 0), a3, voffA);
            PG8_BAR; PG8_WAIT_L(0); PG8_MMA(1, 0, At, B0); PG8_BAR; PG8_SCHED;
            PG8_STAGE(PG8_SB(1, 1), b3 + hstep, voffB);
            PG8_WAIT_V(6); PG8_BAR; PG8_MMA(1, 1, At, B1); PG8_BAR;
            }
        }
        if constexpr (ALIGN_EPI) { if (wr == 0) PG8_BAR; }
        if constexpr (!Epi::AFTER_DRAIN) { E(acc, cur, wr, wc, fr, fq); S.done(cur); }
        if (!has_next) break;
#pragma unroll
        for (int a = 0; a < 2; ++a)
#pragma unroll
            for (int b = 0; b < 2; ++b)
#pragma unroll
                for (int m = 0; m < 4; ++m)
#pragma unroll
                    for (int n = 0; n < 2; ++n) acc[a][b][m][n] = (f32x4){0.f, 0.f, 0.f, 0.f};
        cur = nxt; cA = nA; cB = nB; ++ui;
        if constexpr (ALIGN_EPI) { if (wr == 1) PG8_BAR; }
    }
    PG8_WAIT_V(0);
    if constexpr (!ALIGN_EPI) { if (wr == 0) PG8_BAR; }
    PG8_BAR;
    if constexpr (Epi::AFTER_DRAIN) { E.fused(acc, cur, wr, wc, fr, fq, lds, wid, lane); S.done(cur); }
#undef PG8_SA
#undef PG8_SB
#undef PG8_STAGE
#undef PG8_LDA
#undef PG8_LDB
#undef PG8_MMA
#undef PG8_WAIT_V
#undef PG8_WAIT_L
#undef PG8_BAR
#undef PG8_SCHED
}
}

#define GAS __attribute__((address_space(1)))
#define LAS __attribute__((address_space(3)))
typedef unsigned short bf16;
typedef float f32x4 __attribute__((ext_vector_type(4)));
typedef float f32x16 __attribute__((ext_vector_type(16)));
typedef short bf16x8 __attribute__((ext_vector_type(8)));
typedef short s16x4 __attribute__((ext_vector_type(4)));
typedef unsigned u32x4 __attribute__((ext_vector_type(4)));
typedef unsigned u32x2 __attribute__((ext_vector_type(2)));
typedef float f32x2_t __attribute__((ext_vector_type(2)));
typedef __bf16 bf16x2_t __attribute__((ext_vector_type(2)));
typedef GAS unsigned gu32;
#define RLX_AGENT __ATOMIC_RELAXED, __HIP_MEMORY_SCOPE_AGENT

constexpr int D = 1024, BP = 4, TP = 4096, MP = BP * TP, BS = 128, TS = 8, MS = BS * TS, M = MP + MS;
constexpr int SBH = 8, HD = 64, SBW = 512, DNH = 4, DND = 128, DNW = 512;
constexpr int IN_COLS = 3592, NPROJ = 3584;
constexpr int DFF = 2816, DFF2 = 5632, NMOD = 6144, NC = BP + BS;
constexpr int PAST = 2048, NPAGES = 16, PAGE = 128;
constexpr float EPS = 1e-6f, LOG2E = 1.4426950408889634f;
constexpr float QSCALE = 0.125f * LOG2E;
constexpr int NSPLIT = 4, NPART = 5;

constexpr size_t O_YP = 0, O_KP = 17825792, O_VP = 26214400, O_KS = 34603008, O_VS = 35127296, O_SP = 35651584, O_SS = 35913728,
                 O_DCP = 44302336, O_DCS = 44320768, O_FCP = 44910592, O_FCS = 44955648, O_END = 46397440;

constexpr size_t MiB = 1u << 20;
constexpr size_t WS_CTL = 0, CTL_ZERO_BYTES = MiB;
constexpr size_t WS_MOD = 1 * MiB, WS_SC = 5 * MiB, WS_WINX = 6 * MiB, WS_WIN_T = 7 * MiB, WS_WOUT_T = 14 * MiB, WS_WUP_T = 16 * MiB, WS_WDN_T = 27 * MiB,
                 WS_EXTRA = 33 * MiB, WS_H = 34 * MiB, WS_DNRAW = 68 * MiB, WS_ZG = 120 * MiB, WS_QB = 306 * MiB, WS_KB = 323 * MiB, WS_VB = 340 * MiB, WS_QD = 357 * MiB, WS_KD = 391 * MiB,
                 WS_VD = 425 * MiB, WS_BETA = 459 * MiB, WS_LOGA = 460 * MiB, WS_ODN = 461 * MiB, WS_MIXED = 495 * MiB, WS_X1 = 529 * MiB, WS_UP = 597 * MiB,
                 WS_ACT = 784 * MiB, WS_U = 878 * MiB, WS_KCUM = 910 * MiB, WS_QDEC = 926 * MiB, WS_KDECT = 942 * MiB, WS_INTRA = 958 * MiB, WS_GL = 966 * MiB,
                 WS_OPART = 967 * MiB, WS_LPART = 978 * MiB, WS_END = 979 * MiB;
constexpr int CW_Q0 = 1024;
constexpr int CW_QUEUE = 64;
constexpr int CW_BAR = 8192;

constexpr int RING_BYTES = 131072, MISC_OFF = RING_BYTES + 320, LDS_BYTES = 147456;

__device__ __forceinline__ unsigned cvtpk(float lo, float hi) { f32x2_t v = {lo, hi}; bf16x2_t b = __builtin_convertvector(v, bf16x2_t); return __builtin_bit_cast(unsigned, b); }
__device__ __forceinline__ bf16 f2bf(float f) { return (bf16)(cvtpk(f, 0.f) & 0xffffu); }
__device__ __forceinline__ float wave_sum(float v) {
#pragma unroll
    for (int o = 1; o < 64; o <<= 1) v += __shfl_xor(v, o);
    return v;
}
__device__ __forceinline__ float siluf(float x) { return x * __builtin_amdgcn_rcpf(1.f + __builtin_amdgcn_exp2f(-1.4426950408889634f * x)); }
__device__ __forceinline__ u32x4 pack8(const f32x4 a, const f32x4 b) { u32x4 w; w.x = cvtpk(a.x, a.y); w.y = cvtpk(a.z, a.w); w.z = cvtpk(b.x, b.y); w.w = cvtpk(b.z, b.w); return w; }
__device__ __forceinline__ float bf2f(unsigned short h) { return __uint_as_float((unsigned)h << 16); }

#define XB_TMO      128
#define XB_XCNT(j)  (256  + 64 * (j))
#define XB_XSUB(j)  (1280 + 64 * (j))
#define XB_XGEN(j)  (2304 + 64 * (j))
#define XB_TOP      3328
#define XB_TOPGEN   3392
#define XCD_BAR_WORDS 3456
#define XB_SPIN_CAP (1u << 18)
__device__ __forceinline__ unsigned xb_ld(unsigned* p)              { return __hip_atomic_load(p, __ATOMIC_RELAXED, __HIP_MEMORY_SCOPE_AGENT); }
__device__ __forceinline__ unsigned xb_add(unsigned* p, unsigned v) { return __hip_atomic_fetch_add(p, v, __ATOMIC_RELAXED, __HIP_MEMORY_SCOPE_AGENT); }
__device__ __forceinline__ unsigned xb_xcc_id() { return (unsigned)__builtin_amdgcn_s_getreg((3 << 11) | 20) & 0xFu; }
#define XB_SPIN(cond, bar) do { unsigned _sp = 0; while (cond) { __builtin_amdgcn_s_sleep(1); \
    if ((++_sp & 255u) == 0u) { if (xb_ld(&(bar)[XB_TMO])) break; if (_sp > XB_SPIN_CAP) { atomicAdd(&(bar)[XB_TMO], 1u); break; } } } } while (0)
struct XcdBarrier { unsigned* bar; unsigned x; volatile LAS unsigned* st; };
__device__ __forceinline__ XcdBarrier xcd_barrier_post(unsigned* bar, volatile LAS unsigned* st, int tid) {
    XcdBarrier b; b.bar = bar; b.x = xb_xcc_id(); b.st = st;
    if (tid == 0) (void)xb_add(&bar[XB_XCNT(b.x)], 1u);
    return b;
}
__device__ __forceinline__ void xcd_barrier_complete(unsigned* bar, unsigned x, unsigned& nloc, unsigned& nx) {
    const unsigned G = gridDim.x * gridDim.y * gridDim.z;
    unsigned sum, cnt, mine, sp = 0u;
    for (;;) {
        sum = 0u; cnt = 0u; mine = 0u;
#pragma unroll
        for (unsigned j = 0; j < 16; ++j) { const unsigned c = xb_ld(&bar[XB_XCNT(j)]); sum += c; cnt += (c > 0u) ? 1u : 0u; mine = (j == x) ? c : mine; }
        if (sum == G) break;
        __builtin_amdgcn_s_sleep(1);
        if ((++sp & 255u) == 0u) { if (xb_ld(&bar[XB_TMO])) break; if (sp > XB_SPIN_CAP) { atomicAdd(&bar[XB_TMO], 1u); break; } }
    }
    nloc = mine > 0u ? mine : 1u; nx = cnt > 0u ? cnt : 1u;
}
__device__ __forceinline__ void xcd_barrier(const XcdBarrier& b, int tid) {
    asm volatile("s_waitcnt vmcnt(0)" ::: "memory");
    __syncthreads();
    if (tid == 0) {
        unsigned* bar = b.bar;
        __builtin_amdgcn_s_waitcnt(0);
        unsigned nloc = b.st[0], nx = b.st[1];
        if (nloc == 0u) { xcd_barrier_complete(bar, b.x, nloc, nx); b.st[0] = nloc; b.st[1] = nx; }
        const unsigned old = xb_add(&bar[XB_XSUB(b.x)], 1u);
        const unsigned gen = old / nloc;
        if (old + 1u == (gen + 1u) * nloc) {
            __builtin_amdgcn_fence(__ATOMIC_RELEASE, "agent");
            asm volatile("s_waitcnt vmcnt(0)" ::: "memory");
            const unsigned og = xb_add(&bar[XB_TOP], 1u);
            const unsigned tg = og / nx;
            if (og + 1u == (tg + 1u) * nx) xb_add(&bar[XB_TOPGEN], 1u);
            else XB_SPIN(xb_ld(&bar[XB_TOPGEN]) == tg, bar);
            __builtin_amdgcn_fence(__ATOMIC_ACQUIRE, "agent");
            xb_add(&bar[XB_XGEN(b.x)], 1u);
            asm volatile("s_waitcnt vmcnt(0)" ::: "memory");
        } else {
            XB_SPIN(xb_ld(&bar[XB_XGEN(b.x)]) == gen, bar);
            __builtin_amdgcn_fence(__ATOMIC_ACQUIRE, "agent");
            asm volatile("s_waitcnt vmcnt(0)" ::: "memory");
        }
    }
    __syncthreads();
}

__device__ __forceinline__ int lane_now() { int l; asm volatile("v_mbcnt_lo_u32_b32 %0, -1, 0\n\tv_mbcnt_hi_u32_b32 %0, -1, %0" : "=v"(l)); return l; }
struct Args { const void* in[27]; float* out; unsigned char* ws; int lo, hi; };
enum { I_XP = 0, I_XS, I_CP, I_CS, I_CK, I_CV, I_PT, I_SD, I_SDC, I_SFC, I_WADA, I_BADA, I_GATT, I_WIN, I_GQ, I_GK, I_SBB, I_GSBO, I_WDNC, I_ALOG, I_DTB, I_GDNO, I_WOUT, I_GFFN, I_WUP, I_WFC, I_WDN };

__device__ __forceinline__ int mod_row(int m) { return m < MP ? (m >> 12) : BP + ((m - MP) >> 3); }

struct EpiF32 {
    static constexpr bool PERM = false, AFTER_DRAIN = false;
    float* O; int ldc;
    __device__ __forceinline__ void operator()(const pg8::f32x4 (&acc)[2][2][4][2], const pg8::Unit& u, int wr, int wc, int fr, int fq) const {
        const int row0 = u.pm * 256 + wr * 64 + fr, col0 = u.pn * 256 + wc * 32 + 4 * fq;
#pragma unroll
        for (int ai = 0; ai < 2; ++ai)
#pragma unroll
            for (int m = 0; m < 4; ++m) { float* rowp = O + (size_t)(row0 + ai * 128 + m * 16) * ldc + col0;
#pragma unroll
                for (int bj = 0; bj < 2; ++bj)
#pragma unroll
                    for (int n = 0; n < 2; ++n) *(pg8::f32x4*)(rowp + bj * 128 + n * 16) = acc[ai][bj][m][n]; }
    }
};
struct EpiResGate {
    static constexpr bool PERM = false, AFTER_DRAIN = false;
    const float* base0; const float* base1; const float* mod; int goff; float* out;
    __device__ __forceinline__ void operator()(const pg8::f32x4 (&acc)[2][2][4][2], const pg8::Unit& u, int wr, int wc, int fr, int fq) const {
        const int row0 = u.pm * 256 + wr * 64 + fr, col0 = u.pn * 256 + wc * 32 + 4 * fq;
#pragma unroll
        for (int ai = 0; ai < 2; ++ai)
#pragma unroll
            for (int m = 0; m < 4; ++m) { const int r = row0 + ai * 128 + m * 16;
                const float* bp = (r < MP ? base0 + (size_t)r * D : base1 + (size_t)(r - MP) * D) + col0;
                const float* gp = mod + (size_t)mod_row(r) * NMOD + goff + col0; float* op = out + (size_t)r * D + col0;
#pragma unroll
                for (int bj = 0; bj < 2; ++bj)
#pragma unroll
                    for (int n = 0; n < 2; ++n) { const pg8::f32x4 b = *(const pg8::f32x4*)(bp + bj * 128 + n * 16), g = *(const pg8::f32x4*)(gp + bj * 128 + n * 16);
                        *(pg8::f32x4*)(op + bj * 128 + n * 16) = b + g * acc[ai][bj][m][n]; } }
    }
};

__device__ __forceinline__ void st16(void* base, unsigned off, u32x4 v) { *(u32x4*)((unsigned char*)base + off) = v; }
__device__ __forceinline__ void st16f(void* base, unsigned off, pg8::f32x4 v) { *(pg8::f32x4*)((unsigned char*)base + off) = v; }
struct EpiProj {
    static constexpr bool PERM = true, AFTER_DRAIN = false;
    float* out; bf16* QB; bf16* KB; bf16* VB; bf16* DNRAW; bf16* ZG; const float* g_q; const float* g_k; LAS float* xl;
    __device__ __forceinline__ void operator()(const pg8::f32x4 (&acc)[2][2][4][2], const pg8::Unit& u, int wr, int wc, int fr, int fq) const {
        const int pn = u.pn, rl0 = wr * 64 + fr, c0 = wc * 32 + 8 * fq;
        const unsigned row0 = (unsigned)u.pm * 256u + (unsigned)rl0;
        const bool prompt_tile = u.pm < MP / 256;
        if (pn < 4) {
            int xb = (rl0 * 8 + wc) * 4, xb2 = (rl0 * 8 + (wc ^ 1)) * 4; asm volatile("" : "+v"(xb), "+v"(xb2));
            LAS float* xw = (LAS float*)((LAS unsigned char*)xl + xb); const LAS float* xr = (const LAS float*)((LAS unsigned char*)xl + xb2);
#pragma unroll
            for (int ai = 0; ai < 2; ++ai)
#pragma unroll
                for (int m = 0; m < 4; ++m)
#pragma unroll
                    for (int bj = 0; bj < 2; ++bj) { const pg8::f32x4 a = acc[ai][bj][m][0], b = acc[ai][bj][m][1];
                        float ss = (a[0] * a[0] + a[1] * a[1]) + (a[2] * a[2] + a[3] * a[3]) + (b[0] * b[0] + b[1] * b[1]) + (b[2] * b[2] + b[3] * b[3]);
                        ss += __shfl_xor(ss, 16); ss += __shfl_xor(ss, 32);
                        if (fq == 0) xw[(ai * 128 + m * 16) * 8 + bj * 4] = ss; }
            asm volatile("s_waitcnt lgkmcnt(0)" ::: "memory"); __builtin_amdgcn_s_barrier(); asm volatile("" ::: "memory");
            const bool isq = pn < 2; const float* g = isq ? g_q : g_k; const int dloc = 32 * (wc & 1) + 8 * fq;
            const pg8::f32x4 g0 = *(const pg8::f32x4*)(g + dloc), g1 = *(const pg8::f32x4*)(g + dloc + 4);
            bf16* dstb = isq ? QB : KB; float* dstf = prompt_tile ? out + O_KP : out + O_KS - (size_t)MP * SBW;
#pragma unroll
            for (int ai = 0; ai < 2; ++ai)
#pragma unroll
                for (int m = 0; m < 4; ++m) { const unsigned row = row0 + ai * 128 + m * 16;
#pragma unroll
                    for (int bj = 0; bj < 2; ++bj) { const float tot = xw[(ai * 128 + m * 16) * 8 + bj * 4] + xr[(ai * 128 + m * 16) * 8 + bj * 4];
                        const float rs = (isq ? QSCALE : 1.0f) / sqrtf(tot * (1.f / HD) + EPS);
                        const pg8::f32x4 a = acc[ai][bj][m][0] * rs * g0, b = acc[ai][bj][m][1] * rs * g1;
                        const unsigned e = row * SBW + (unsigned)((pn & 1) * 256 + bj * 128 + c0);
                        st16(dstb, e * 2u, pack8(a, b));
                        if (!isq) { st16f(dstf, e * 4u, a); st16f(dstf, e * 4u + 16u, b); } }
                    asm volatile("" ::: "memory"); }
            asm volatile("s_waitcnt lgkmcnt(0)" ::: "memory"); __builtin_amdgcn_s_barrier(); asm volatile("" ::: "memory");
        } else if (pn < 6) {
            float* dstf = prompt_tile ? out + O_VP : out + O_VS - (size_t)MP * SBW;
#pragma unroll
            for (int ai = 0; ai < 2; ++ai)
#pragma unroll
                for (int m = 0; m < 4; ++m) { const unsigned row = row0 + ai * 128 + m * 16;
#pragma unroll
                    for (int bj = 0; bj < 2; ++bj) { const pg8::f32x4 a = acc[ai][bj][m][0], b = acc[ai][bj][m][1]; const unsigned e = row * SBW + (unsigned)((pn & 1) * 256 + bj * 128 + c0);
                        st16(VB, e * 2u, pack8(a, b)); st16f(dstf, e * 4u, a); st16f(dstf, e * 4u + 16u, b); }
                    asm volatile("" ::: "memory"); }
        } else if (pn < 12) {
#pragma unroll
            for (int ai = 0; ai < 2; ++ai)
#pragma unroll
                for (int m = 0; m < 4; ++m) { const unsigned row = row0 + ai * 128 + m * 16;
                    const int b = prompt_tile ? (int)(row >> 12) : (int)((row - MP) >> 3), t = prompt_tile ? (int)(row & 4095) : (int)((row - MP) & 7), idx = prompt_tile ? t - (TP - 3) : t - (TS - 3);
#pragma unroll
                    for (int bj = 0; bj < 2; ++bj) { const pg8::f32x4 a = acc[ai][bj][m][0], b2 = acc[ai][bj][m][1]; const unsigned ch = (unsigned)((pn - 6) * 256 + bj * 128 + c0);
                        st16(DNRAW, (row * 1536u + ch) * 2u, pack8(a, b2));
                        if (idx >= 0) { float* o = prompt_tile ? out + O_DCP : out + O_DCS; const unsigned eo = ((unsigned)(b * 3 + idx) * 1536u + ch) * 4u; st16f(o, eo, a); st16f(o, eo + 16u, b2); } }
                    asm volatile("" ::: "memory"); }
        } else {
#pragma unroll
            for (int ai = 0; ai < 2; ++ai)
#pragma unroll
                for (int m = 0; m < 4; ++m) { const unsigned row = row0 + ai * 128 + m * 16;
#pragma unroll
                    for (int bj = 0; bj < 2; ++bj) { pg8::f32x4 a = acc[ai][bj][m][0], b = acc[ai][bj][m][1]; const unsigned e = row * DNW + (unsigned)((pn - 12) * 256 + bj * 128 + c0);
                        a[0] = siluf(a[0]); a[1] = siluf(a[1]); a[2] = siluf(a[2]); a[3] = siluf(a[3]); b[0] = siluf(b[0]); b[1] = siluf(b[1]); b[2] = siluf(b[2]); b[3] = siluf(b[3]);
                        st16(ZG, e * 2u, pack8(a, b)); }
                    asm volatile("" ::: "memory"); }
        }
    }
};

__device__ __forceinline__ void mod_tile(const Args& A, LAS unsigned char* lds, int ct, int wave, int lane) {
    const float* w_ada = (const float*)A.in[I_WADA]; const float* b_ada = (const float*)A.in[I_BADA];
    const float* cp = (const float*)A.in[I_CP]; const float* cs = (const float*)A.in[I_CS]; float* MOD = (float*)(A.ws + WS_MOD);
    const int lr = lane & 15, q = lane >> 4, col = ct * 16 + lr;
    pg8::f32x4 acc[9];
#pragma unroll
    for (int i = 0; i < 9; ++i) acc[i] = (pg8::f32x4){0.f, 0.f, 0.f, 0.f};
#pragma unroll
    for (int s4 = 0; s4 < 4; ++s4) {
        const int k0 = 128 * wave + 32 * s4 + 8 * q;
        const float* wp = w_ada + (size_t)k0 * NMOD + col;
        float w[8];
#pragma unroll
        for (int j = 0; j < 8; ++j) w[j] = wp[(size_t)j * NMOD];
        u32x4 bw; bw.x = cvtpk(w[0], w[1]); bw.y = cvtpk(w[2], w[3]); bw.z = cvtpk(w[4], w[5]); bw.w = cvtpk(w[6], w[7]);
        const bf16x8 bfr = __builtin_bit_cast(bf16x8, bw);
#pragma unroll
        for (int i = 0; i < 9; ++i) { const int row = 16 * i + lr;
            f32x4 c0 = (f32x4){0.f, 0.f, 0.f, 0.f}, c1 = c0;
            if (row < NC) { const float* crow_ = (row < BP ? cp + (size_t)row * D : cs + (size_t)(row - BP) * D) + k0; c0 = *(const f32x4*)crow_; c1 = *(const f32x4*)(crow_ + 4); }
            c0.x = siluf(c0.x); c0.y = siluf(c0.y); c0.z = siluf(c0.z); c0.w = siluf(c0.w); c1.x = siluf(c1.x); c1.y = siluf(c1.y); c1.z = siluf(c1.z); c1.w = siluf(c1.w);
            acc[i] = __builtin_amdgcn_mfma_f32_16x16x32_bf16(__builtin_bit_cast(bf16x8, pack8(c0, c1)), bfr, acc[i], 0, 0, 0); }
    }
    LAS pg8::f32x4* red = (LAS pg8::f32x4*)lds;
#pragma unroll
    for (int i = 0; i < 9; ++i) red[(wave * 9 + i) * 64 + lane] = acc[i];
    __syncthreads();
    for (int i = wave; i < 9; i += 8) {
        pg8::f32x4 t = red[i * 64 + lane];
#pragma unroll
        for (int w2 = 1; w2 < 8; ++w2) t += red[(w2 * 9 + i) * 64 + lane];
        const float bb = b_ada[col];
#pragma unroll
        for (int r = 0; r < 4; ++r) { const int row = 16 * i + 4 * q + r; if (row < NC) MOD[(size_t)row * NMOD + col] = t[r] + bb; }
    }
    __syncthreads();
}
__device__ __forceinline__ void transpose_item(const float* W, int ldw, int src_col0, bf16* WT, int Kdst, int dst_row0, int k0, LAS float* scr, int lane) {
    float v[32];
#pragma unroll
    for (int i = 0; i < 32; ++i) v[i] = W[(size_t)(k0 + 2 * i + (lane >> 5)) * ldw + src_col0 + (lane & 31)];
#pragma unroll
    for (int i = 0; i < 32; ++i) scr[(2 * i + (lane >> 5)) * 33 + (lane & 31)] = v[i];
    asm volatile("s_waitcnt lgkmcnt(0)" ::: "memory");
    const int c = lane & 7;
#pragma unroll
    for (int j = 0; j < 4; ++j) { const int n = (lane >> 3) + 8 * j; const LAS float* s = scr + (8 * c) * 33 + n;
        u32x4 o; o.x = cvtpk(s[0 * 33], s[1 * 33]); o.y = cvtpk(s[2 * 33], s[3 * 33]); o.z = cvtpk(s[4 * 33], s[5 * 33]); o.w = cvtpk(s[6 * 33], s[7 * 33]);
        *(u32x4*)(WT + (size_t)(dst_row0 + n) * Kdst + k0 + 8 * c) = o; }
    asm volatile("s_waitcnt lgkmcnt(0)" ::: "memory");
}
__device__ __forceinline__ void phase_prologue(const Args& A, LAS unsigned char* lds, gu32* qhead, int bx, int G, int wave, int lane, int gtid, int NGT) {
    unsigned char* ws = A.ws;
    const float* w_in = (const float*)A.in[I_WIN]; const float* w_out = (const float*)A.in[I_WOUT]; const float* w_up = (const float*)A.in[I_WUP]; const float* w_dn = (const float*)A.in[I_WDN];
    float* WX = (float*)(ws + WS_WINX);
    for (int i = gtid; i < 8 * D; i += NGT) { const int j = i >> 10, k = i & 1023; WX[i] = w_in[(size_t)k * IN_COLS + 3072 + j]; }
    for (int ct = bx; ct < NMOD / 16; ct += G) mod_tile(A, lds, ct, wave, lane);
    LAS float* scr = (LAS float*)(lds + wave * 16384);
    constexpr int I_IN = 16 * (NPROJ / 32), I_OUT = 16 * 32, I_UP = 16 * (DFF2 / 32), I_DN = (DFF / 64) * 32, NIT = I_IN + I_OUT + I_UP + I_DN;
    for (int it_ = bx * 8 + wave; it_ < NIT; it_ += G * 8) {
        int r = it_;
        if (r < I_IN) { const int nb = r % (NPROJ / 32), kb = r / (NPROJ / 32); const int n0 = nb * 32; transpose_item(w_in, IN_COLS, n0 < 3072 ? n0 : n0 + 8, (bf16*)(ws + WS_WIN_T), D, n0, kb * 64, scr, lane); continue; } r -= I_IN;
        if (r < I_OUT) { const int nb = r % 32, kb = r / 32; transpose_item(w_out, D, nb * 32, (bf16*)(ws + WS_WOUT_T), D, nb * 32, kb * 64, scr, lane); continue; } r -= I_OUT;
        if (r < I_UP) { const int nb = r % (DFF2 / 32), kb = r / (DFF2 / 32); transpose_item(w_up, DFF2, nb * 32, (bf16*)(ws + WS_WUP_T), D, nb * 32, kb * 64, scr, lane); continue; } r -= I_UP;
        { const int nb = r % 32, kb = r / 32; transpose_item(w_dn, D, nb * 32, (bf16*)(ws + WS_WDN_T), DFF, nb * 32, kb * 64, scr, lane); }
    }
}

template <bool EXTRAS>
__device__ __forceinline__ void phase_norm(const float* x0, const float* x1, const float* g, const float* MOD, int sh_off, int sc_off, bf16* H, const float* WX, float* EXTRA, int gw, int NGW, int lane) {
    for (int m = gw; m < M; m += NGW) {
        const float* xr = m < MP ? x0 + (size_t)m * D : x1 + (size_t)(m - MP) * D;
        const float* mod = MOD + (size_t)mod_row(m) * NMOD;
        f32x4 v[4]; float ss = 0.f;
#pragma unroll
        for (int j = 0; j < 4; ++j) { v[j] = *(const f32x4*)(xr + 4 * (lane + 64 * j)); ss += (v[j].x * v[j].x + v[j].y * v[j].y) + (v[j].z * v[j].z + v[j].w * v[j].w); }
        ss = wave_sum(ss);
        const float rstd = 1.0f / sqrtf(ss * (1.f / D) + EPS);
        float ex[8];
#pragma unroll
        for (int e = 0; e < 8; ++e) ex[e] = 0.f;
#pragma unroll
        for (int j = 0; j < 4; ++j) { const int c = 4 * (lane + 64 * j);
            const f32x4 gg = *(const f32x4*)(g + c), sc = *(const f32x4*)(mod + sc_off + c), sh = *(const f32x4*)(mod + sh_off + c);
            const f32x4 h = (v[j] * rstd) * gg * (sc + 1.0f) + sh;
            u32x2 w; w.x = cvtpk(h.x, h.y); w.y = cvtpk(h.z, h.w); *(u32x2*)(H + (size_t)m * D + c) = w;
            if (EXTRAS) {
#pragma unroll
                for (int e = 0; e < 8; ++e) { const f32x4 wx = *(const f32x4*)(WX + e * D + c); ex[e] += (h.x * wx.x + h.y * wx.y) + (h.z * wx.z + h.w * wx.w); }
            }
        }
        if (EXTRAS) {
#pragma unroll
            for (int e = 0; e < 8; ++e) ex[e] = wave_sum(ex[e]);
            float mine = ex[0];
#pragma unroll
            for (int e = 1; e < 8; ++e) mine = (lane == e) ? ex[e] : mine;
            if (lane < 8) EXTRA[(size_t)m * 8 + lane] = mine;
        }
    }
}

__device__ __forceinline__ f32x4 bf4lo(u32x4 w) { return (f32x4){__uint_as_float(w.x << 16), __uint_as_float(w.x & 0xffff0000u), __uint_as_float(w.y << 16), __uint_as_float(w.y & 0xffff0000u)}; }
__device__ __forceinline__ f32x4 bf4hi(u32x4 w) { return (f32x4){__uint_as_float(w.z << 16), __uint_as_float(w.z & 0xffff0000u), __uint_as_float(w.w << 16), __uint_as_float(w.w & 0xffff0000u)}; }
__device__ __forceinline__ void post_strip(const Args& A, int m0, int R, int part, int lane) {
    unsigned char* ws = A.ws; const bf16* DNRAW = (const bf16*)(ws + WS_DNRAW);
    const float* wc = (const float*)A.in[I_WDNC]; const float* sdc = (const float*)A.in[I_SDC];
    float* dstb = (part == 0 ? (float*)(ws + WS_QD) : part == 1 ? (float*)(ws + WS_KD) : (float*)(ws + WS_VD));
    const bool prompt = m0 < MP; const int b = prompt ? (m0 >> 12) : ((m0 - MP) >> 3), t0 = prompt ? (m0 & 4095) : ((m0 - MP) & 7);
    const int ch = part * 512 + 8 * lane;
    f32x4 w[4][2];
#pragma unroll
    for (int i = 0; i < 4; ++i) { w[i][0] = *(const f32x4*)(wc + i * 1536 + ch); w[i][1] = *(const f32x4*)(wc + i * 1536 + ch + 4); }
    f32x4 x[3][2];
#pragma unroll
    for (int j = 0; j < 3; ++j) { const int tt = t0 - 3 + j;
        if (tt >= 0) { const u32x4 r = *(const u32x4*)(DNRAW + (size_t)(m0 - 3 + j) * 1536 + ch); x[j][0] = bf4lo(r); x[j][1] = bf4hi(r); }
        else if (!prompt) { const float* p = sdc + ((size_t)b * 3 + (3 + tt)) * 1536 + ch; x[j][0] = *(const f32x4*)p; x[j][1] = *(const f32x4*)(p + 4); }
        else { x[j][0] = (f32x4){0.f, 0.f, 0.f, 0.f}; x[j][1] = x[j][0]; } }
    const bf16* src = DNRAW + (size_t)m0 * 1536 + ch;
    u32x4 nx = *(const u32x4*)src;
    for (int r = 0; r < R; ++r) {
        const u32x4 cw = nx;
        if (r + 1 < R) nx = *(const u32x4*)(src + (size_t)(r + 1) * 1536);
        const f32x4 c0 = bf4lo(cw), c1 = bf4hi(cw);
        f32x4 y0 = w[0][0] * x[0][0] + w[1][0] * x[1][0] + w[2][0] * x[2][0] + w[3][0] * c0;
        f32x4 y1 = w[0][1] * x[0][1] + w[1][1] * x[1][1] + w[2][1] * x[2][1] + w[3][1] * c1;
        x[0][0] = x[1][0]; x[0][1] = x[1][1]; x[1][0] = x[2][0]; x[1][1] = x[2][1]; x[2][0] = c0; x[2][1] = c1;
        y0.x = siluf(y0.x); y0.y = siluf(y0.y); y0.z = siluf(y0.z); y0.w = siluf(y0.w); y1.x = siluf(y1.x); y1.y = siluf(y1.y); y1.z = siluf(y1.z); y1.w = siluf(y1.w);
        if (part < 2) {
            float ss = (y0.x * y0.x + y0.y * y0.y) + (y0.z * y0.z + y0.w * y0.w) + (y1.x * y1.x + y1.y * y1.y) + (y1.z * y1.z + y1.w * y1.w);
            ss += __shfl_xor(ss, 1); ss += __shfl_xor(ss, 2); ss += __shfl_xor(ss, 4); ss += __shfl_xor(ss, 8);
            const float rs = (part == 0 ? 0.08838834764831845f : 1.0f) / sqrtf(ss + EPS);
            y0 = y0 * rs; y1 = y1 * rs;
        }
        float* dst = dstb + (size_t)(m0 + r) * DNW + 8 * lane;
        *(f32x4*)dst = y0; *(f32x4*)(dst + 4) = y1;
    }
}
__device__ __forceinline__ void phase_post(const Args& A, int gw, int NGW, int lane, int gtid, int NGT) {
    constexpr int NPI = (MP / 16) * 3, NSI = BS * 3;
    for (int it = gw; it < NPI + NSI; it += NGW) {
        if (it < NPI) post_strip(A, (it / 3) * 16, 16, it % 3, lane);
        else { const int j = it - NPI; post_strip(A, MP + (j / 3) * 8, 8, j % 3, lane); }
    }
    unsigned char* ws = A.ws; const float* a_log = (const float*)A.in[I_ALOG]; const float* dtb = (const float*)A.in[I_DTB];
    float* BETA = (float*)(ws + WS_BETA); float* LOGA = (float*)(ws + WS_LOGA); const float* EXTRA = (const float*)(ws + WS_EXTRA);
    for (int i = gtid; i < M * 8; i += NGT) { const int m = i >> 3, j = i & 7; const float x = EXTRA[i];
        if (j < 4) BETA[m * 4 + j] = 1.f / (1.f + __expf(-x));
        else { const int h = j - 4; const float z = x + dtb[h]; const float sp = fmaxf(z, 0.f) + log1pf(__expf(-fabsf(z))); LOGA[m * 4 + h] = -__expf(a_log[h]) * sp; } }
}

template <int I0, int I1> __device__ __forceinline__ void subst_rows(float (&x)[64], const LAS float* Am, const LAS float* gs, bool kpart) {
#pragma unroll
    for (int i = I0; i < I1; ++i) {
        float r = x[i];
#pragma unroll
        for (int j4 = 0; j4 < (i & ~3); j4 += 4) { const f32x4 a = *(const LAS f32x4*)(Am + i * 64 + j4); r -= a.x * x[j4]; r -= a.y * x[j4 + 1]; r -= a.z * x[j4 + 2]; r -= a.w * x[j4 + 3]; }
#pragma unroll
        for (int j = (i & ~3); j < i; ++j) r -= Am[i * 64 + j] * x[j];
        x[i] = r;
    }
}
__device__ __forceinline__ void dn_prescan_unit(const Args& A, LAS unsigned char* lds, int unit, int tid, int wave, int lane) {
    unsigned char* ws = A.ws;
    const float* QD = (const float*)(ws + WS_QD); const float* KD = (const float*)(ws + WS_KD); const float* VD = (const float*)(ws + WS_VD);
    const float* BETA = (const float*)(ws + WS_BETA); const float* LOGA = (const float*)(ws + WS_LOGA);
    const int hp = unit & 1, n = (unit >> 1) & 63, b = unit >> 7;
    const int half = tid >> 8, ht = tid & 255, h = 2 * hp + half, item = (b * 64 + n) * 4 + h;
    const int m0 = b * TP + n * 64;
    LAS float* Am = (LAS float*)lds + half * 4096;
    LAS float* gs = (LAS float*)(lds + 32768) + half * 128;
    if (ht < 64) {
        float v = LOGA[(size_t)(m0 + ht) * 4 + h];
#pragma unroll
        for (int o = 1; o < 64; o <<= 1) { const float u = __shfl_up(v, o); if (ht >= o) v += u; }
        gs[ht] = v; gs[64 + ht] = BETA[(size_t)(m0 + ht) * 4 + h];
    }
    __syncthreads();
    {
        const int wl = wave & 3, lr = lane & 15, q = lane >> 4;
        pg8::f32x4 kk[4], qk[4];
#pragma unroll
        for (int j = 0; j < 4; ++j) { kk[j] = (pg8::f32x4){0.f, 0.f, 0.f, 0.f}; qk[j] = kk[j]; }
#pragma unroll
        for (int s = 0; s < 4; ++s) {
            const float* kp = KD + (size_t)(m0 + 16 * wl + lr) * DNW + h * 128 + 32 * s + 8 * q; const float* qp = QD + (size_t)(m0 + 16 * wl + lr) * DNW + h * 128 + 32 * s + 8 * q;
            const bf16x8 ak = __builtin_bit_cast(bf16x8, pack8(*(const f32x4*)kp, *(const f32x4*)(kp + 4))), aq = __builtin_bit_cast(bf16x8, pack8(*(const f32x4*)qp, *(const f32x4*)(qp + 4)));
#pragma unroll
            for (int j = 0; j < 4; ++j) { const float* bp = KD + (size_t)(m0 + 16 * j + lr) * DNW + h * 128 + 32 * s + 8 * q;
                const bf16x8 bk = __builtin_bit_cast(bf16x8, pack8(*(const f32x4*)bp, *(const f32x4*)(bp + 4)));
                kk[j] = __builtin_amdgcn_mfma_f32_16x16x32_bf16(ak, bk, kk[j], 0, 0, 0); qk[j] = __builtin_amdgcn_mfma_f32_16x16x32_bf16(aq, bk, qk[j], 0, 0, 0); }
        }
        bf16* INTRA = (bf16*)(ws + WS_INTRA) + (size_t)item * 4096;
#pragma unroll
        for (int j = 0; j < 4; ++j)
#pragma unroll
            for (int r = 0; r < 4; ++r) { const int i = 16 * wl + 4 * q + r, jj = 16 * j + lr;
                const float dec = (i >= jj) ? __expf(gs[i] - gs[jj]) : 0.f;
                Am[i * 64 + jj] = (i > jj) ? gs[64 + i] * kk[j][r] * dec : 0.f;
                INTRA[i * 64 + jj] = f2bf(qk[j][r] * dec); }
    }
    __syncthreads();
    {
        const int c = ht; float x[64];
        float* U = (float*)(ws + WS_U) + (size_t)item * 8192; bf16* KC = (bf16*)(ws + WS_KCUM) + (size_t)item * 8192;
        const float* rsrc = (c < 128 ? VD : KD) + (size_t)m0 * DNW + h * 128 + (c & 127);
#pragma unroll
        for (int i = 0; i < 64; ++i) x[i] = rsrc[(size_t)i * DNW];
#pragma unroll
        for (int i = 0; i < 64; ++i) { const float eg = __expf(gs[i]); x[i] *= gs[64 + i] * (c >= 128 ? eg : 1.0f); }
        subst_rows<0, 16>(x, Am, gs, c >= 128); subst_rows<16, 32>(x, Am, gs, c >= 128); subst_rows<32, 48>(x, Am, gs, c >= 128); subst_rows<48, 64>(x, Am, gs, c >= 128);
        if (c < 128) {
#pragma unroll
            for (int i = 0; i < 64; ++i) U[i * 128 + c] = x[i];
        } else {
#pragma unroll
            for (int i = 0; i < 64; ++i) KC[i * 128 + (c - 128)] = f2bf(x[i]);
        }
    }
    {
        const float glast = gs[63];
        bf16* QDc = (bf16*)(ws + WS_QDEC) + (size_t)item * 8192; bf16* KT = (bf16*)(ws + WS_KDECT) + (size_t)item * 8192;
        for (int e = ht; e < 64 * 128; e += 256) { const int i = e >> 7, d = e & 127; QDc[e] = f2bf(QD[(size_t)(m0 + i) * DNW + h * 128 + d] * __expf(gs[i])); }
        { const int d = ht & 127, ig = ht >> 7;
#pragma unroll
            for (int i8 = 0; i8 < 4; ++i8) { float v[8];
#pragma unroll
                for (int k = 0; k < 8; ++k) { const int i = 32 * ig + 8 * i8 + k; v[k] = KD[(size_t)(m0 + i) * DNW + h * 128 + d] * __expf(glast - gs[i]); }
                u32x4 w; w.x = cvtpk(v[0], v[1]); w.y = cvtpk(v[2], v[3]); w.z = cvtpk(v[4], v[5]); w.w = cvtpk(v[6], v[7]);
                *(u32x4*)(KT + d * 64 + 32 * ig + 8 * i8) = w; } }
        if (ht == 0) ((float*)(ws + WS_GL))[item] = __expf(glast);
    }
    __syncthreads();
}
__device__ __forceinline__ void dn_sample_unit(const Args& A, LAS unsigned char* lds, int unit, int tid) {
    unsigned char* ws = A.ws;
    const float* QD = (const float*)(ws + WS_QD); const float* KD = (const float*)(ws + WS_KD); const float* VD = (const float*)(ws + WS_VD);
    const float* BETA = (const float*)(ws + WS_BETA); const float* LOGA = (const float*)(ws + WS_LOGA); float* ODN = (float*)(ws + WS_ODN);
    const int h = unit & 3, b = unit >> 2, e = tid & 127, dq = tid >> 7;
    const float* s0 = (const float*)A.in[I_SD] + ((size_t)(b * 4 + h) * 128 + 32 * dq) * 128 + e;
    float S[32];
#pragma unroll
    for (int d = 0; d < 32; ++d) S[d] = s0[(size_t)d * 128];
    LAS float* red = (LAS float*)lds; LAS float* red2 = red + 512;
    for (int t = 0; t < TS; ++t) {
        const int m = MP + b * TS + t;
        const float a = __expf(LOGA[(size_t)m * 4 + h]), bt = BETA[(size_t)m * 4 + h];
        const float* kp = KD + (size_t)m * DNW + h * 128 + 32 * dq; const float* qp = QD + (size_t)m * DNW + h * 128 + 32 * dq;
        float kd[32], qd[32];
#pragma unroll
        for (int d4 = 0; d4 < 8; ++d4) { const f32x4 kv = *(const f32x4*)(kp + 4 * d4), qv = *(const f32x4*)(qp + 4 * d4);
            kd[4 * d4] = kv.x; kd[4 * d4 + 1] = kv.y; kd[4 * d4 + 2] = kv.z; kd[4 * d4 + 3] = kv.w; qd[4 * d4] = qv.x; qd[4 * d4 + 1] = qv.y; qd[4 * d4 + 2] = qv.z; qd[4 * d4 + 3] = qv.w; }
        float p = 0.f;
#pragma unroll
        for (int d = 0; d < 32; ++d) p += kd[d] * S[d];
        red[dq * 128 + e] = p;
        __syncthreads();
        const float kS = (red[e] + red[128 + e]) + (red[256 + e] + red[384 + e]);
        const float dl = bt * (VD[(size_t)m * DNW + h * 128 + e] - a * kS);
        float po = 0.f;
#pragma unroll
        for (int d = 0; d < 32; ++d) { S[d] = a * S[d] + kd[d] * dl; po += qd[d] * S[d]; }
        red2[dq * 128 + e] = po;
        __syncthreads();
        if (dq == 0) ODN[(size_t)m * DNW + h * 128 + e] = (red2[e] + red2[128 + e]) + (red2[256 + e] + red2[384 + e]);
    }
    float* so = A.out + O_SS + ((size_t)(b * 4 + h) * 128 + 32 * dq) * 128 + e;
#pragma unroll
    for (int d = 0; d < 32; ++d) so[(size_t)d * 128] = S[d];
    __syncthreads();
}

constexpr int SC_KC = 0, SC_QD = 17408, SC_KT = 34816, SC_IN = 53248, SC_BUF = 62464;
__device__ __forceinline__ void dn_scan_chain(const Args& A, LAS unsigned char* lds, int chain, int tid, int wave, int lane) {
    unsigned char* ws = A.ws;
    const float* Ub = (const float*)(ws + WS_U); const float* GL = (const float*)(ws + WS_GL); float* ODN = (float*)(ws + WS_ODN);
    const int b = chain >> 2, h = chain & 3, lr = lane & 15, q = lane >> 4, e = 16 * wave + lr;
    int ldst[7];
    { const int c0 = tid, c1 = tid + 512;
      ldst[0] = SC_KC + (c0 >> 4) * 272 + (c0 & 15) * 16; ldst[1] = SC_KC + (c1 >> 4) * 272 + (c1 & 15) * 16;
      ldst[2] = SC_QD + (c0 >> 4) * 272 + (c0 & 15) * 16; ldst[3] = SC_QD + (c1 >> 4) * 272 + (c1 & 15) * 16;
      ldst[4] = SC_KT + (c0 >> 3) * 144 + (c0 & 7) * 16;  ldst[5] = SC_KT + (c1 >> 3) * 144 + (c1 & 7) * 16;
      ldst[6] = SC_IN + (c0 >> 3) * 144 + (c0 & 7) * 16; }
    const size_t item0 = (size_t)(b * 64) * 4 + h;
    const unsigned char* gKC = ws + WS_KCUM + item0 * 16384; const unsigned char* gQD = ws + WS_QDEC + item0 * 16384; const unsigned char* gKT = ws + WS_KDECT + item0 * 16384; const unsigned char* gIN = ws + WS_INTRA + item0 * 8192;
    const int t16 = tid * 16, uoff = (4 * q) * 128 + e;
    u32x4 R[7]; float un[16];
#define SC_GLOAD(n_) do { const size_t o16_ = (size_t)(n_) * 4 * 16384, o8_ = (size_t)(n_) * 4 * 8192; \
        R[0] = *(const u32x4*)(gKC + o16_ + t16); R[1] = *(const u32x4*)(gKC + o16_ + 8192 + t16); R[2] = *(const u32x4*)(gQD + o16_ + t16); R[3] = *(const u32x4*)(gQD + o16_ + 8192 + t16); \
        R[4] = *(const u32x4*)(gKT + o16_ + t16); R[5] = *(const u32x4*)(gKT + o16_ + 8192 + t16); R[6] = *(const u32x4*)(gIN + o8_ + t16); \
        const float* U_ = Ub + (item0 + 4 * (size_t)(n_)) * 8192; \
        _Pragma("unroll") for (int i_ = 0; i_ < 4; ++i_) _Pragma("unroll") for (int r_ = 0; r_ < 4; ++r_) un[4 * i_ + r_] = U_[uoff + (16 * i_ + r_) * 128]; } while (0)
#define SC_LWRITE(buf_) do { _Pragma("unroll") for (int k_ = 0; k_ < 7; ++k_) *(LAS u32x4*)(lds + (buf_) * SC_BUF + ldst[k_]) = R[k_]; } while (0)
    pg8::f32x4 S[8];
#pragma unroll
    for (int i = 0; i < 8; ++i) S[i] = (pg8::f32x4){0.f, 0.f, 0.f, 0.f};
    __syncthreads();
    SC_GLOAD(0); SC_LWRITE(0);
    float uc[16];
#pragma unroll
    for (int k = 0; k < 16; ++k) uc[k] = un[k];
    __syncthreads();
    for (int n = 0; n < 64; ++n) {
        const float gl = GL[item0 + 4 * n];
        if (n + 1 < 64) SC_GLOAD(n + 1);
        const LAS unsigned char* B = lds + (n & 1) * SC_BUF;
        bf16x8 Sb[4];
#pragma unroll
        for (int s = 0; s < 4; ++s) { u32x4 w; w.x = cvtpk(S[2 * s][0], S[2 * s][1]); w.y = cvtpk(S[2 * s][2], S[2 * s][3]); w.z = cvtpk(S[2 * s + 1][0], S[2 * s + 1][1]); w.w = cvtpk(S[2 * s + 1][2], S[2 * s + 1][3]); Sb[s] = __builtin_bit_cast(bf16x8, w); }
        pg8::f32x4 vn[4], o[4];
#pragma unroll
        for (int i = 0; i < 4; ++i) {
            pg8::f32x4 ak = (pg8::f32x4){0.f, 0.f, 0.f, 0.f}, aq = ak;
#pragma unroll
            for (int s = 0; s < 4; ++s) {
                const LAS unsigned char* kp = B + SC_KC + (16 * i + lr) * 272 + (32 * s + 4 * q) * 2; const LAS unsigned char* qp = B + SC_QD + (16 * i + lr) * 272 + (32 * s + 4 * q) * 2;
                const u32x2 k0 = *(const LAS u32x2*)kp, k1 = *(const LAS u32x2*)(kp + 32), q0 = *(const LAS u32x2*)qp, q1 = *(const LAS u32x2*)(qp + 32);
                ak = __builtin_amdgcn_mfma_f32_16x16x32_bf16(__builtin_bit_cast(bf16x8, (u32x4){k0.x, k0.y, k1.x, k1.y}), Sb[s], ak, 0, 0, 0);
                aq = __builtin_amdgcn_mfma_f32_16x16x32_bf16(__builtin_bit_cast(bf16x8, (u32x4){q0.x, q0.y, q1.x, q1.y}), Sb[s], aq, 0, 0, 0);
            }
#pragma unroll
            for (int r = 0; r < 4; ++r) vn[i][r] = uc[4 * i + r] - ak[r];
            o[i] = aq;
        }
        bf16x8 Vb[2];
#pragma unroll
        for (int s = 0; s < 2; ++s) { u32x4 w; w.x = cvtpk(vn[2 * s][0], vn[2 * s][1]); w.y = cvtpk(vn[2 * s][2], vn[2 * s][3]); w.z = cvtpk(vn[2 * s + 1][0], vn[2 * s + 1][1]); w.w = cvtpk(vn[2 * s + 1][2], vn[2 * s + 1][3]); Vb[s] = __builtin_bit_cast(bf16x8, w); }
#pragma unroll
        for (int i = 0; i < 4; ++i) {
#pragma unroll
            for (int s = 0; s < 2; ++s) { const LAS unsigned char* ip = B + SC_IN + (16 * i + lr) * 144 + (32 * s + 4 * q) * 2; const u32x2 a0 = *(const LAS u32x2*)ip, a1 = *(const LAS u32x2*)(ip + 32);
                o[i] = __builtin_amdgcn_mfma_f32_16x16x32_bf16(__builtin_bit_cast(bf16x8, (u32x4){a0.x, a0.y, a1.x, a1.y}), Vb[s], o[i], 0, 0, 0); }
#pragma unroll
            for (int r = 0; r < 4; ++r) ODN[(size_t)(b * TP + 64 * n + 16 * i + 4 * q + r) * DNW + h * 128 + e] = o[i][r];
        }
#pragma unroll
        for (int i = 0; i < 8; ++i) {
            pg8::f32x4 acc = S[i] * gl;
#pragma unroll
            for (int s = 0; s < 2; ++s) { const LAS unsigned char* tp = B + SC_KT + (16 * i + lr) * 144 + (32 * s + 4 * q) * 2; const u32x2 a0 = *(const LAS u32x2*)tp, a1 = *(const LAS u32x2*)(tp + 32);
                acc = __builtin_amdgcn_mfma_f32_16x16x32_bf16(__builtin_bit_cast(bf16x8, (u32x4){a0.x, a0.y, a1.x, a1.y}), Vb[s], acc, 0, 0, 0); }
            S[i] = acc;
        }
        if (n + 1 < 64) {
            SC_LWRITE((n + 1) & 1);
#pragma unroll
            for (int k = 0; k < 16; ++k) uc[k] = un[k];
        }
        __syncthreads();
    }
#undef SC_GLOAD
#undef SC_LWRITE
    float* so = A.out + O_SP + (size_t)(b * 4 + h) * 16384;
#pragma unroll
    for (int i = 0; i < 8; ++i)
#pragma unroll
        for (int r = 0; r < 4; ++r) so[(16 * i + 4 * q + r) * 128 + e] = S[i][r];
}

__device__ __forceinline__ int crow(int r, int hi) { return (r & 3) + 8 * (r >> 2) + 4 * hi; }
__device__ __forceinline__ void sb_core(f32x16& p, float& carry, int hi) {
    float s[16];
#pragma unroll
    for (int r = 0; r < 16; ++r) { const float e = __builtin_amdgcn_exp2f(p[r]); s[r] = -__builtin_amdgcn_logf(1.0f + e); }
    float tt[4], uu[4];
#pragma unroll
    for (int i = 0; i < 4; ++i) { s[4 * i + 2] += s[4 * i + 3]; s[4 * i + 1] += s[4 * i + 2]; s[4 * i] += s[4 * i + 1]; tt[i] = s[4 * i]; }
#pragma unroll
    for (int i = 0; i < 4; ++i) uu[i] = __shfl_xor(tt[i], 32);
    const float w3 = tt[3] + uu[3], w2 = tt[2] + uu[2], w1 = tt[1] + uu[1], w0 = tt[0] + uu[0];
    float off[4];
    off[3] = carry; off[2] = carry + w3; off[1] = off[2] + w2; off[0] = off[1] + w1;
    carry = off[0] + w0;
    if (hi == 0) {
#pragma unroll
        for (int i = 0; i < 4; ++i) off[i] += uu[i];
    }
#pragma unroll
    for (int r = 0; r < 16; ++r) p[r] = __builtin_amdgcn_exp2f(p[r] + s[r] + off[r >> 2]);
}
__device__ __forceinline__ bf16x8 pack_p(const f32x16& p, int s) {
    u32x4 w; w.x = cvtpk(p[8 * s], p[8 * s + 1]); w.y = cvtpk(p[8 * s + 2], p[8 * s + 3]); w.z = cvtpk(p[8 * s + 4], p[8 * s + 5]); w.w = cvtpk(p[8 * s + 6], p[8 * s + 7]); return __builtin_bit_cast(bf16x8, w);
}
constexpr int AW_BYTES = 16384, AW_V = 0, VPI = 192, AW_K = 6144, KPI = 144, AW_Q = 6144;
__device__ __forceinline__ void read_vfrags(bf16x8 (&vf)[4], const LAS unsigned char* wl, int lane) {
    const int hi = lane >> 5;
    const LAS unsigned char* vb = wl + AW_V + (4 * hi + ((lane & 15) >> 2)) * VPI + (((lane >> 4) & 1) * 16 + (lane & 3) * 4) * 2;
#pragma unroll
    for (int dt = 0; dt < 2; ++dt) {
        const s16x4 t0 = __builtin_bit_cast(s16x4, __builtin_amdgcn_ds_read_tr16_b64_v4i16((LAS s16x4*)(vb + dt * 64)));
        const s16x4 t1 = __builtin_bit_cast(s16x4, __builtin_amdgcn_ds_read_tr16_b64_v4i16((LAS s16x4*)(vb + dt * 64 + 8 * VPI)));
        const s16x4 t2 = __builtin_bit_cast(s16x4, __builtin_amdgcn_ds_read_tr16_b64_v4i16((LAS s16x4*)(vb + dt * 64 + 16 * VPI)));
        const s16x4 t3 = __builtin_bit_cast(s16x4, __builtin_amdgcn_ds_read_tr16_b64_v4i16((LAS s16x4*)(vb + dt * 64 + 24 * VPI)));
        vf[2 * dt] = (bf16x8){t0[0], t0[1], t0[2], t0[3], t1[0], t1[1], t1[2], t1[3]}; vf[2 * dt + 1] = (bf16x8){t2[0], t2[1], t2[2], t2[3], t3[0], t3[1], t3[2], t3[3]};
    }
}
__device__ __forceinline__ void load_k_prompt(bf16x8 (&k)[4], const bf16* KB, int b, int h, int kv0, int r32, int hi) {
    const bf16* kp = KB + (size_t)(b * TP + kv0 + r32) * SBW + h * HD + 8 * hi;
#pragma unroll
    for (int d0 = 0; d0 < 4; ++d0) k[d0] = *(const bf16x8*)(kp + 16 * d0);
}
__device__ __forceinline__ void load_v_prompt(u32x4 (&v)[4], const bf16* VB, int b, int h, int kv0, int lane) {
    const bf16* vp = VB + (size_t)(b * TP + kv0 + (lane >> 3)) * SBW + h * HD + (lane & 7) * 8;
#pragma unroll
    for (int i = 0; i < 4; ++i) v[i] = *(const u32x4*)(vp + (size_t)(8 * i) * SBW);
}
__device__ __forceinline__ void write_v_lds(LAS unsigned char* wl, const u32x4 (&v)[4], int lane) {
#pragma unroll
    for (int i = 0; i < 4; ++i) *(LAS u32x4*)(wl + AW_V + (8 * i + (lane >> 3)) * VPI + (lane & 7) * 16) = v[i];
}
template <int MASK>
__device__ __forceinline__ void sb_qk(f32x16& p, const bf16x8 (&kf)[4], const bf16x8 (&qf)[4], float bias2, int kv0, int qpos, int hi) {
#pragma unroll
    for (int r = 0; r < 16; ++r) p[r] = bias2;
#pragma unroll
    for (int d0 = 0; d0 < 4; ++d0) p = __builtin_amdgcn_mfma_f32_32x32x16_bf16(kf[d0], qf[d0], p, 0, 0, 0);
    if (MASK) {
#pragma unroll
        for (int r = 0; r < 16; ++r) if (kv0 + crow(r, hi) >= qpos) p[r] = -INFINITY;
    }
}
__device__ __forceinline__ void sb_pvonly(const f32x16& p, const bf16x8 (&vf)[4], f32x16 (&o)[2]) {
    const bf16x8 p0 = pack_p(p, 0), p1 = pack_p(p, 1);
#pragma unroll
    for (int dt = 0; dt < 2; ++dt) { o[dt] = __builtin_amdgcn_mfma_f32_32x32x16_bf16(vf[2 * dt], p0, o[dt], 0, 0, 0); o[dt] = __builtin_amdgcn_mfma_f32_32x32x16_bf16(vf[2 * dt + 1], p1, o[dt], 0, 0, 0); }
}
__device__ __forceinline__ void sb_pv(f32x16& p, const bf16x8 (&vf)[4], f32x16 (&o)[2], float& carry, int hi) {
    sb_core(p, carry, hi);
    const bf16x8 p0 = pack_p(p, 0), p1 = pack_p(p, 1);
#pragma unroll
    for (int dt = 0; dt < 2; ++dt) { o[dt] = __builtin_amdgcn_mfma_f32_32x32x16_bf16(vf[2 * dt], p0, o[dt], 0, 0, 0); o[dt] = __builtin_amdgcn_mfma_f32_32x32x16_bf16(vf[2 * dt + 1], p1, o[dt], 0, 0, 0); }
}
template <int MASK>
__device__ __forceinline__ void sb_tile(const bf16x8 (&kf)[4], const bf16x8 (&vf)[4], const bf16x8 (&qf)[4], float bias2, f32x16 (&o)[2], float& carry, int kv0, int qpos, int hi) {
    f32x16 p; sb_qk<MASK>(p, kf, qf, bias2, kv0, qpos, hi); sb_pv(p, vf, o, carry, hi);
}
__device__ __forceinline__ void sb_store_prompt(const Args& A, const f32x16 (&o)[2], int b, int h, int qpos, int hi) {
    float ss = 0.f;
#pragma unroll
    for (int dt = 0; dt < 2; ++dt)
#pragma unroll
        for (int r = 0; r < 16; ++r) ss += o[dt][r] * o[dt][r];
    ss += __shfl_xor(ss, 32);
    const float rs = 1.0f / sqrtf(ss * (1.f / HD) + EPS);
    const float* gso = (const float*)A.in[I_GSBO];
    bf16* op = (bf16*)(A.ws + WS_MIXED) + (size_t)(b * TP + qpos) * D + h * HD;
#pragma unroll
    for (int dt = 0; dt < 2; ++dt)
#pragma unroll
        for (int g = 0; g < 4; ++g) { const int d = 32 * dt + 8 * g + 4 * hi; const f32x4 gg = *(const f32x4*)(gso + d);
            u32x2 w; w.x = cvtpk(o[dt][4 * g] * rs * gg.x, o[dt][4 * g + 1] * rs * gg.y); w.y = cvtpk(o[dt][4 * g + 2] * rs * gg.z, o[dt][4 * g + 3] * rs * gg.w); *(u32x2*)(op + d) = w; }
}
__device__ __forceinline__ void attn_prompt_item(const Args& A, LAS unsigned char* wl, int b, int h, int q0, int lane) {
    unsigned char* ws = A.ws;
    const bf16* QB = (const bf16*)(ws + WS_QB); const bf16* KB = (const bf16*)(ws + WS_KB); const bf16* VB = (const bf16*)(ws + WS_VB);
    const int r32 = lane & 31, hi = lane >> 5, qa = q0 + r32, qb = q0 + 32 + r32;
    const float bias2 = ((const float*)A.in[I_SBB])[h] * LOG2E;
#pragma unroll
    for (int d0 = 0; d0 < 4; ++d0) { *(LAS bf16x8*)(wl + AW_Q + (d0 * 64 + lane) * 16) = *(const bf16x8*)(QB + (size_t)(b * TP + qa) * SBW + h * HD + 16 * d0 + 8 * hi);
        *(LAS bf16x8*)(wl + AW_Q + 4096 + (d0 * 64 + lane) * 16) = *(const bf16x8*)(QB + (size_t)(b * TP + qb) * SBW + h * HD + 16 * d0 + 8 * hi); }
#define QFA_LOAD bf16x8 qfa[4]; _Pragma("unroll") for (int d0_ = 0; d0_ < 4; ++d0_) qfa[d0_] = *(const LAS bf16x8*)(wl + AW_Q + (d0_ * 64 + lane) * 16);
#define QFB_LOAD bf16x8 qfb[4]; _Pragma("unroll") for (int d0_ = 0; d0_ < 4; ++d0_) qfb[d0_] = *(const LAS bf16x8*)(wl + AW_Q + 4096 + (d0_ * 64 + lane) * 16);
    f32x16 oa[2], ob[2]; oa[0] = (f32x16){}; oa[1] = (f32x16){}; ob[0] = (f32x16){}; ob[1] = (f32x16){};
    float ca = 0.f, cb = 0.f;
    bf16x8 kc[4], vf[4]; u32x4 vr[4];
    const int top = (q0 >> 5) + 1;
    load_k_prompt(kc, KB, b, h, 32 * top, r32, hi); load_v_prompt(vr, VB, b, h, 32 * top, lane);
    { write_v_lds(wl, vr, lane); load_v_prompt(vr, VB, b, h, 32 * (top - 1), lane);
      f32x16 p; { QFB_LOAD sb_qk<1>(p, kc, qfb, bias2, 32 * top, qb, hi); }
      load_k_prompt(kc, KB, b, h, 32 * (top - 1), r32, hi);
      read_vfrags(vf, wl, lane);
      sb_pv(p, vf, ob, cb, hi); }
    { write_v_lds(wl, vr, lane); if (top >= 2) load_v_prompt(vr, VB, b, h, 32 * (top - 2), lane);
      f32x16 p; { QFA_LOAD sb_qk<1>(p, kc, qfa, bias2, 32 * (top - 1), qa, hi); }
      read_vfrags(vf, wl, lane);
      sb_pv(p, vf, oa, ca, hi);
      { QFB_LOAD sb_qk<0>(p, kc, qfb, bias2, 0, 0, hi); }
      if (top >= 2) load_k_prompt(kc, KB, b, h, 32 * (top - 2), r32, hi);
      sb_pv(p, vf, ob, cb, hi); }
    for (int ht = top - 2; ht >= 0; --ht) {
        write_v_lds(wl, vr, lane); if (ht > 0) load_v_prompt(vr, VB, b, h, 32 * (ht - 1), lane);
        f32x16 p; { QFA_LOAD sb_qk<0>(p, kc, qfa, bias2, 0, 0, hi); }
        read_vfrags(vf, wl, lane);
        sb_pv(p, vf, oa, ca, hi);
        { QFB_LOAD sb_qk<0>(p, kc, qfb, bias2, 0, 0, hi); }
        if (ht > 0) load_k_prompt(kc, KB, b, h, 32 * (ht - 1), r32, hi);
        sb_pv(p, vf, ob, cb, hi);
    }
    sb_store_prompt(A, oa, b, h, qa, hi); sb_store_prompt(A, ob, b, h, qb, hi);
#undef QFA_LOAD
#undef QFB_LOAD
}

__device__ __forceinline__ void load_raw_sample(f32x4 (&r)[8], const float* c, size_t base, int h, int lane) {
    const float* p = c + base + (size_t)(lane >> 4) * 512 + h * HD + (lane & 15) * 4;
#pragma unroll
    for (int i = 0; i < 8; ++i) r[i] = *(const f32x4*)(p + (size_t)(4 * i) * 512);
}
__device__ __forceinline__ void write_raw_sample(LAS unsigned char* wl, int off, int pitch, const f32x4 (&r)[8], int lane) {
#pragma unroll
    for (int i = 0; i < 8; ++i) { const int row = 4 * i + (lane >> 4); u32x2 w; w.x = cvtpk(r[i].x, r[i].y); w.y = cvtpk(r[i].z, r[i].w); *(LAS u32x2*)(wl + off + row * pitch + (lane & 15) * 8) = w; }
}
__device__ __forceinline__ void read_kfrags(bf16x8 (&kf)[4], const LAS unsigned char* wl, int r32, int hi) {
#pragma unroll
    for (int d0 = 0; d0 < 4; ++d0) kf[d0] = *(const LAS bf16x8*)(wl + AW_K + r32 * KPI + (16 * d0 + 8 * hi) * 2);
}
__device__ __forceinline__ void attn_sample_store(const Args& A, int b, int h, int part, int lane, const f32x16 (&o)[2], float carry) {
    float* OP = (float*)(A.ws + WS_OPART) + (size_t)((b * SBH + h) * NPART + part) * 512; float* LP = (float*)(A.ws + WS_LPART) + (size_t)((b * SBH + h) * NPART + part) * 8;
    const int r32 = lane & 31, hi = lane >> 5;
    if (r32 < 8) {
#pragma unroll
        for (int dt = 0; dt < 2; ++dt)
#pragma unroll
            for (int r = 0; r < 16; ++r) OP[(32 * dt + crow(r, hi)) * 8 + r32] = o[dt][r];
        if (hi == 0) LP[r32] = carry;
    }
}
__device__ __forceinline__ void attn_sample_job(const Args& A, LAS unsigned char* wl, int b, int h, int sp, int lane) {
    unsigned char* ws = A.ws;
    const int r32 = lane & 31, hi = lane >> 5;
    const float* ck = (const float*)A.in[I_CK]; const float* cv = (const float*)A.in[I_CV]; const int* pt = (const int*)A.in[I_PT] + b * NPAGES;
    const bf16* QB = (const bf16*)(ws + WS_QB);
    const float bias2 = ((const float*)A.in[I_SBB])[h] * LOG2E;
    bf16x8 qf[4];
#pragma unroll
    for (int d0 = 0; d0 < 4; ++d0) { qf[d0] = (bf16x8){0, 0, 0, 0, 0, 0, 0, 0}; if (r32 < TS) qf[d0] = *(const bf16x8*)(QB + (size_t)(MP + b * TS + r32) * SBW + h * HD + 16 * d0 + 8 * hi); }
    f32x16 o[2]; float carry;
    bf16x8 kf[4], vf[4];
    const int tok_hi = (PAST / NSPLIT) * (sp + 1);
    constexpr int NT = PAST / NSPLIT / 32;
    f32x4 rk[8], rv[8];
#define SAMPLE_BASE(j) (((size_t)pt[(tok_hi - 32 * ((j) + 1)) >> 7] * PAGE + ((tok_hi - 32 * ((j) + 1)) & 127)) * 512)
    if (sp == NSPLIT - 1) {
        const bf16* KBn = (const bf16*)(ws + WS_KB) + (size_t)(MP + b * TS) * SBW + h * HD;
#pragma unroll
        for (int d0 = 0; d0 < 4; ++d0) { kf[d0] = (bf16x8){0, 0, 0, 0, 0, 0, 0, 0}; if (r32 < TS) kf[d0] = *(const bf16x8*)(KBn + (size_t)r32 * SBW + 16 * d0 + 8 * hi); }
        u32x4 vr[4];
        vr[0] = *(const u32x4*)((const bf16*)(ws + WS_VB) + (size_t)(MP + b * TS + (lane >> 3)) * SBW + h * HD + (lane & 7) * 8);
        vr[1] = (u32x4){0u, 0u, 0u, 0u}; vr[2] = vr[1]; vr[3] = vr[1];
        write_v_lds(wl, vr, lane);
        read_vfrags(vf, wl, lane);
        o[0] = (f32x16){}; o[1] = (f32x16){}; carry = 0.f;
        sb_tile<1>(kf, vf, qf, bias2, o, carry, 0, r32, hi);
        attn_sample_store(A, b, h, NPART - 1, lane, o, carry);
    }
    load_raw_sample(rk, ck, SAMPLE_BASE(0), h, lane); load_raw_sample(rv, cv, SAMPLE_BASE(0), h, lane);
    o[0] = (f32x16){}; o[1] = (f32x16){}; carry = 0.f;
    for (int j = 0; j < NT; ++j) {
        write_raw_sample(wl, AW_K, KPI, rk, lane); write_raw_sample(wl, AW_V, VPI, rv, lane);
        if (j + 1 < NT) load_raw_sample(rk, ck, SAMPLE_BASE(j + 1), h, lane);
        read_kfrags(kf, wl, r32, hi); read_vfrags(vf, wl, lane);
        f32x16 p; sb_qk<0>(p, kf, qf, bias2, 0, 0, hi);
        sb_core(p, carry, hi);
        __builtin_amdgcn_sched_barrier(0);
        if (j + 1 < NT) load_raw_sample(rv, cv, SAMPLE_BASE(j + 1), h, lane);
        sb_pvonly(p, vf, o);
    }
#undef SAMPLE_BASE
    attn_sample_store(A, b, h, sp, lane, o, carry);
}

__device__ __forceinline__ void phase_outnorm(const Args& A, int gw, int NGW, int lane) {
    unsigned char* ws = A.ws; const float* ODN = (const float*)(ws + WS_ODN); bf16* MIXED = (bf16*)(ws + WS_MIXED);
    const float* gdn = (const float*)A.in[I_GDNO]; const float* gso = (const float*)A.in[I_GSBO];
    const float* OPb = (const float*)(ws + WS_OPART); const float* LPb = (const float*)(ws + WS_LPART);
    const int c8 = 8 * lane;
    for (int m = gw; m < M; m += NGW) {
        {
            const float* op = ODN + (size_t)m * DNW + c8; f32x4 a0 = *(const f32x4*)op, a1 = *(const f32x4*)(op + 4);
            float ss = (a0.x * a0.x + a0.y * a0.y) + (a0.z * a0.z + a0.w * a0.w) + (a1.x * a1.x + a1.y * a1.y) + (a1.z * a1.z + a1.w * a1.w);
            ss += __shfl_xor(ss, 1); ss += __shfl_xor(ss, 2); ss += __shfl_xor(ss, 4); ss += __shfl_xor(ss, 8);
            const float rs = 1.0f / sqrtf(ss * (1.f / DND) + EPS);
            const f32x4 g0 = *(const f32x4*)(gdn + (c8 & 127)), g1 = *(const f32x4*)(gdn + (c8 & 127) + 4);
            const u32x4 zw = *(const u32x4*)((const bf16*)(ws + WS_ZG) + (size_t)m * DNW + c8); const f32x4 z0 = bf4lo(zw), z1 = bf4hi(zw);
            *(u32x4*)(MIXED + (size_t)m * D + SBW + c8) = pack8(a0 * rs * g0 * z0, a1 * rs * g1 * z1);
        }
        if (m >= MP) {
            const int b = (m - MP) >> 3, t = (m - MP) & 7, h = lane >> 3, d0 = c8 & 63;
            const float* OP = OPb + (size_t)(b * SBH + h) * NPART * 512; const float* LP = LPb + (size_t)(b * SBH + h) * NPART * 8;
            float v[8];
#pragma unroll
            for (int k = 0; k < 8; ++k) v[k] = 0.f;
            float suf = 0.f;
#pragma unroll
            for (int part = NPART - 1; part >= 0; --part) { const float w = __builtin_amdgcn_exp2f(suf);
#pragma unroll
                for (int k = 0; k < 8; ++k) v[k] += w * OP[part * 512 + (d0 + k) * 8 + t];
                suf += LP[part * 8 + t]; }
            float ss = 0.f;
#pragma unroll
            for (int k = 0; k < 8; ++k) ss += v[k] * v[k];
            ss += __shfl_xor(ss, 1); ss += __shfl_xor(ss, 2); ss += __shfl_xor(ss, 4);
            const float rs = 1.0f / sqrtf(ss * (1.f / HD) + EPS);
            const f32x4 g0 = *(const f32x4*)(gso + d0), g1 = *(const f32x4*)(gso + d0 + 4);
            *(u32x4*)(MIXED + (size_t)m * D + c8) = pack8((f32x4){v[0], v[1], v[2], v[3]} * rs * g0, (f32x4){v[4], v[5], v[6], v[7]} * rs * g1);
        }
    }
}

__device__ __forceinline__ void convgate_strip(const Args& A, int m0, int R, int cg, int lane) {
    unsigned char* ws = A.ws; const bf16* UP = (const bf16*)(ws + WS_UP); bf16* ACT = (bf16*)(ws + WS_ACT); float* out = A.out;
    const float* wf = (const float*)A.in[I_WFC]; const float* sfc = (const float*)A.in[I_SFC];
    const int c = (cg * 64 + lane) * 8;
    if (c >= DFF) return;
    const bool prompt = m0 < MP; const int b = prompt ? (m0 >> 12) : ((m0 - MP) >> 3), t0 = prompt ? (m0 & 4095) : ((m0 - MP) & 7), T = prompt ? TP : TS;
    f32x4 wu[3][2], wg[3][2];
#pragma unroll
    for (int i = 0; i < 3; ++i) { const float* wp = wf + (size_t)i * DFF2 + c; wu[i][0] = *(const f32x4*)wp; wu[i][1] = *(const f32x4*)(wp + 4); wg[i][0] = *(const f32x4*)(wp + DFF); wg[i][1] = *(const f32x4*)(wp + DFF + 4); }
    f32x4 xu[2][2], xg[2][2];
#pragma unroll
    for (int j = 0; j < 2; ++j) { const int tt = t0 - 2 + j;
        if (tt >= 0) { const bf16* p = UP + (size_t)(m0 - 2 + j) * DFF2 + c; const u32x4 a = *(const u32x4*)p, g = *(const u32x4*)(p + DFF); xu[j][0] = bf4lo(a); xu[j][1] = bf4hi(a); xg[j][0] = bf4lo(g); xg[j][1] = bf4hi(g); }
        else if (!prompt) { const float* p = sfc + ((size_t)b * 2 + (2 + tt)) * DFF2 + c; xu[j][0] = *(const f32x4*)p; xu[j][1] = *(const f32x4*)(p + 4); xg[j][0] = *(const f32x4*)(p + DFF); xg[j][1] = *(const f32x4*)(p + DFF + 4); }
        else { xu[j][0] = (f32x4){0.f, 0.f, 0.f, 0.f}; xu[j][1] = xu[j][0]; xg[j][0] = xu[j][0]; xg[j][1] = xu[j][0]; } }
    const bf16* src = UP + (size_t)m0 * DFF2 + c;
    u32x4 na = *(const u32x4*)src, ng = *(const u32x4*)(src + DFF);
    for (int r = 0; r < R; ++r) {
        const u32x4 ca = na, cgw = ng;
        if (r + 1 < R) { na = *(const u32x4*)(src + (size_t)(r + 1) * DFF2); ng = *(const u32x4*)(src + (size_t)(r + 1) * DFF2 + DFF); }
        const f32x4 u0 = bf4lo(ca), u1 = bf4hi(ca), g0 = bf4lo(cgw), g1 = bf4hi(cgw);
        f32x4 yu0 = wu[0][0] * xu[0][0] + wu[1][0] * xu[1][0] + wu[2][0] * u0, yu1 = wu[0][1] * xu[0][1] + wu[1][1] * xu[1][1] + wu[2][1] * u1;
        f32x4 yg0 = wg[0][0] * xg[0][0] + wg[1][0] * xg[1][0] + wg[2][0] * g0, yg1 = wg[0][1] * xg[0][1] + wg[1][1] * xg[1][1] + wg[2][1] * g1;
        xu[0][0] = xu[1][0]; xu[0][1] = xu[1][1]; xu[1][0] = u0; xu[1][1] = u1; xg[0][0] = xg[1][0]; xg[0][1] = xg[1][1]; xg[1][0] = g0; xg[1][1] = g1;
        yg0.x = siluf(yg0.x); yg0.y = siluf(yg0.y); yg0.z = siluf(yg0.z); yg0.w = siluf(yg0.w); yg1.x = siluf(yg1.x); yg1.y = siluf(yg1.y); yg1.z = siluf(yg1.z); yg1.w = siluf(yg1.w);
        *(u32x4*)(ACT + (size_t)(m0 + r) * DFF + c) = pack8(yg0 * yu0, yg1 * yu1);
        const int oidx = t0 + r - (T - 2);
        if (oidx >= 0) { float* fo = (prompt ? out + O_FCP : out + O_FCS) + ((size_t)b * 2 + oidx) * DFF2 + c; *(f32x4*)fo = u0; *(f32x4*)(fo + 4) = u1; *(f32x4*)(fo + DFF) = g0; *(f32x4*)(fo + DFF + 4) = g1; }
    }
}
__device__ __forceinline__ void phase_convgate(const Args& A, int gw, int NGW, int lane) {
    constexpr int NPI = (MP / 32) * 6, NSI = BS * 6;
    for (int it = gw; it < NPI + NSI; it += NGW) {
        if (it < NPI) convgate_strip(A, (it / 6) * 32, 32, it % 6, lane);
        else { const int j = it - NPI; convgate_strip(A, MP + (j / 6) * 8, 8, j % 6, lane); }
    }
}

constexpr int NPHASE = 13;
#ifndef REP_MASK
#define REP_MASK 0
#endif

__global__ void __launch_bounds__(512, 2) fwd_kernel(Args A) {
    extern __shared__ __attribute__((aligned(16))) unsigned char lds_raw[];
    LAS unsigned char* lds = (LAS unsigned char*)lds_raw;
    const int wave = __builtin_amdgcn_readfirstlane((int)threadIdx.x >> 6);
    const int G = gridDim.x, bx = blockIdx.x;
    const int gw = bx * 8 + wave, NGW = G * 8, NGT = G * 512;
    unsigned char* ws = A.ws;
    gu32* ctl = (gu32*)(ws + WS_CTL);
    volatile LAS unsigned* MISC = (volatile LAS unsigned*)(lds + MISC_OFF);
    { const int t0 = wave * 64 + lane_now(); for (int u = t0; u < (LDS_BYTES - RING_BYTES) / 4; u += 512) ((LAS unsigned*)(lds + RING_BYTES))[u] = 0u; }
    __syncthreads();
    const int lo = A.lo, hi = A.hi;
    const bool multi = (hi - lo) > 1;
    XcdBarrier bar; bar.bar = (unsigned*)(ctl + CW_BAR); bar.x = 0; bar.st = nullptr;
    if (multi) bar = xcd_barrier_post((unsigned*)(ctl + CW_BAR), MISC + 8, wave * 64 + lane_now());
#define IN(k) (lo <= (k) && (k) < hi)
#define GBAR() xcd_barrier(bar, wave * 64 + lane_now())
#define SEAM(k) do { if (IN(k) && IN((k) + 1)) GBAR(); } while (0)
    float* MOD = (float*)(ws + WS_MOD);

#define PH0(rep_) phase_prologue(A, lds, ctl + CW_Q0 + 64 * (rep_), bx, G, wave, lane, gtid, NGT);
#define PH1(rep_) ;
#define PH2(rep_) phase_norm<true>((const float*)A.in[I_XP], (const float*)A.in[I_XS], (const float*)A.in[I_GATT], MOD, 0, 1024, (bf16*)(ws + WS_H), (const float*)(ws + WS_WINX), (float*)(ws + WS_EXTRA), gw, NGW, lane);
#define PH3(rep_) { pg8::Gemm g{(const pg8::bf16_t*)(ws + WS_H), (const pg8::bf16_t*)(ws + WS_WIN_T), M, NPROJ, D}; pg8::StaticOrder S; S.init(M, NPROJ, G, bx); \
          EpiProj E{A.out, (bf16*)(ws + WS_QB), (bf16*)(ws + WS_KB), (bf16*)(ws + WS_VB), (bf16*)(ws + WS_DNRAW), (bf16*)(ws + WS_ZG), (const float*)A.in[I_GQ], (const float*)A.in[I_GK], (LAS float*)(lds + RING_BYTES + 1024)}; \
          pg8::gemm_phase<EpiProj, pg8::StaticOrder, true, true>(lds, g, S, E, tid); }
#define PH4(rep_) phase_post(A, gw, NGW, lane, gtid, NGT);
#define PH5(rep_) for (int u = bx; u < 1024; u += G) { if (u < 512) dn_prescan_unit(A, lds, u, tid, wave, lane); else dn_sample_unit(A, lds, u - 512, tid); }
#define PH6(rep_) PH6X(rep_, true, true, true)
#define PH6X(rep_, DS_, DP_, DA_) { if ((DS_) && bx < 16) dn_scan_chain(A, lds, bx, tid, wave, lane); \
          \
        bool moreP = (DP_), moreS = (DA_); const bool pfirst = wave < 4; \
        gu32* qbase_ = ctl + CW_QUEUE + 1024 * (rep_);     \
        const int shard0_ = (int)(xb_xcc_id() & 7u); int offP_ = 0, offS_ = 0;     \
        for (;;) { \
            int job = -1; bool isP = false; \
            if (pfirst && moreP) { const int sh_ = (shard0_ + offP_) & 7; unsigned j_ = 0; if (lane == 0) j_ = __hip_atomic_fetch_add(qbase_ + 64 * sh_, 1u, RLX_AGENT); j_ = __builtin_amdgcn_readfirstlane(j_); if (j_ < 256u) { job = (int)j_ * 8 + sh_; isP = true; } else if (++offP_ == 8) moreP = false; } \
            if (job < 0 && moreS && !(pfirst && moreP)) { const int sh_ = (shard0_ + offS_) & 7; unsigned j_ = 0; if (lane == 0) j_ = __hip_atomic_fetch_add(qbase_ + 512 + 64 * sh_, 1u, RLX_AGENT); j_ = __builtin_amdgcn_readfirstlane(j_); if (j_ < 512u) { job = (int)j_ * 8 + sh_; } else if (++offS_ == 8) moreS = false; } \
            if (job < 0 && !pfirst && !moreS && moreP) { const int sh_ = (shard0_ + offP_) & 7; unsigned j_ = 0; if (lane == 0) j_ = __hip_atomic_fetch_add(qbase_ + 64 * sh_, 1u, RLX_AGENT); j_ = __builtin_amdgcn_readfirstlane(j_); if (j_ < 256u) { job = (int)j_ * 8 + sh_; isP = true; } else if (++offP_ == 8) moreP = false; } \
            if (job < 0) { if (!moreP && !moreS) break; else continue; } \
            if (isP) { const int qb = 63 - (job >> 5), bh = job & 31; attn_prompt_item(A, lds + wave * AW_BYTES, bh >> 3, bh & 7, qb * 64, lane); } \
            else { const int h_ = job & 7, bs_ = job >> 3; attn_sample_job(A, lds + wave * AW_BYTES, bs_ >> 2, h_, bs_ & 3, lane); } \
        } }
#define PH7(rep_) phase_outnorm(A, gw, NGW, lane);
#define PH8(rep_) { pg8::Gemm g{(const pg8::bf16_t*)(ws + WS_MIXED), (const pg8::bf16_t*)(ws + WS_WOUT_T), M, D, D}; pg8::StaticOrder S; S.init(M, D, G, bx); \
        EpiResGate E{(const float*)A.in[I_XP], (const float*)A.in[I_XS], MOD, 2048, (float*)(ws + WS_X1)}; \
        pg8::gemm_phase<EpiResGate, pg8::StaticOrder, true, true>(lds, g, S, E, tid); }
#define PH9(rep_) phase_norm<false>((const float*)(ws + WS_X1), (const float*)(ws + WS_X1) + (size_t)MP * D, (const float*)A.in[I_GFFN], MOD, 3072, 4096, (bf16*)(ws + WS_H), nullptr, nullptr, gw, NGW, lane);
#define PH10(rep_) { pg8::Gemm g{(const pg8::bf16_t*)(ws + WS_H), (const pg8::bf16_t*)(ws + WS_WUP_T), M, DFF2, D}; pg8::StaticOrder S; S.init(M, DFF2, G, bx); \
        pg8::EpiBf16<0> E{(pg8::bf16_t*)(ws + WS_UP), DFF2, nullptr, 0, 0, 1.f}; \
        pg8::gemm_phase<pg8::EpiBf16<0>, pg8::StaticOrder, true, true>(lds, g, S, E, tid); }
#define PH11(rep_) phase_convgate(A, gw, NGW, lane);
#define PH12(rep_) { pg8::Gemm g{(const pg8::bf16_t*)(ws + WS_ACT), (const pg8::bf16_t*)(ws + WS_WDN_T), M, D, DFF}; pg8::StaticOrder S; S.init(M, D, G, bx); \
        EpiResGate E{(const float*)(ws + WS_X1), (const float*)(ws + WS_X1) + (size_t)MP * D, MOD, 5120, A.out}; \
        pg8::gemm_phase<EpiResGate, pg8::StaticOrder, true, true>(lds, g, S, E, tid); }
#define RUNPH(k) do { if (IN(k)) { const int lane = lane_now(), tid = wave * 64 + lane, gtid = bx * 512 + tid; (void)gtid; PH##k(0) if constexpr (((REP_MASK) >> (k)) & 1) { GBAR(); PH##k(1) } } } while (0)
    RUNPH(0); SEAM(0);
    RUNPH(2); SEAM(2);
    RUNPH(3); SEAM(3);
    RUNPH(4); SEAM(4);
    RUNPH(5); SEAM(5);
    RUNPH(6);
    if constexpr (((REP_MASK) >> 13) & 1) { GBAR(); const int lane = lane_now(), tid = wave * 64 + lane; PH6X(2, true, false, false) }
    if constexpr (((REP_MASK) >> 14) & 1) { GBAR(); const int lane = lane_now(), tid = wave * 64 + lane; PH6X(3, false, true, false) }
    if constexpr (((REP_MASK) >> 15) & 1) { GBAR(); const int lane = lane_now(), tid = wave * 64 + lane; PH6X(4, false, false, true) }
    SEAM(6);
    RUNPH(7); SEAM(7);
    RUNPH(8); SEAM(8);
    RUNPH(9); SEAM(9);
    RUNPH(10); SEAM(10);
    RUNPH(11); SEAM(11);
    RUNPH(12);
#undef IN
#undef SEAM
}

#ifndef N_LAUNCHES
#define N_LAUNCHES 1
#endif
extern "C" void kernel_launch(void* const* d_in, const int* in_sizes, int n_in, void* d_out, int out_size, void* d_ws, size_t ws_size, hipStream_t stream) {
    static int grid = 0;
    if (grid == 0) {
        if (n_in != 27 || (size_t)out_size != O_END || ws_size < WS_END) { fprintf(stderr, "kernel_launch: unexpected shapes: n_in %d out %d ws %zu\n", n_in, out_size, ws_size); grid = -1; return; }
        int dev = 0, cus = 0, per_cu = 0;
        if (hipGetDevice(&dev) != hipSuccess || hipDeviceGetAttribute(&cus, hipDeviceAttributeMultiprocessorCount, dev) != hipSuccess) { grid = -1; return; }
        if (hipFuncSetAttribute((const void*)fwd_kernel, hipFuncAttributeMaxDynamicSharedMemorySize, LDS_BYTES) != hipSuccess) { fprintf(stderr, "kernel_launch: hipFuncSetAttribute failed\n"); grid = -1; return; }
        if (hipOccupancyMaxActiveBlocksPerMultiprocessor(&per_cu, (const void*)fwd_kernel, 512, LDS_BYTES) != hipSuccess || per_cu < 1) fprintf(stderr, "kernel_launch: occupancy query says %d\n", per_cu);
        (void)hipGetLastError();
        grid = cus;
    }
    if (grid < 0) return;
    (void)hipMemsetAsync((char*)d_ws + WS_CTL, 0, CTL_ZERO_BYTES, stream);
    Args a{};
    for (int i = 0; i < 27; ++i) a.in[i] = d_in[i];
    a.out = (float*)d_out; a.ws = (unsigned char*)d_ws;
    if (N_LAUNCHES == 1) { a.lo = 0; a.hi = NPHASE; hipLaunchKernelGGL(fwd_kernel, dim3(grid), dim3(512), LDS_BYTES, stream, a); }
    else for (int p = 0; p < NPHASE; ++p) { a.lo = p; a.hi = p + 1; hipLaunchKernelGGL(fwd_kernel, dim3(grid), dim3(512), LDS_BYTES, stream, a); }
}
```

```cpp
#include <hip/hip_runtime.h>
#include <cstdio>
#include <cstdint>
#define REP_MASK 0
#define PROBE_LEVEL 0
namespace pg8 {
#define PG8_LAS __attribute__((address_space(3)))
typedef unsigned short bf16_t;
typedef short bf16x8 __attribute__((ext_vector_type(8)));
typedef float f32x4 __attribute__((ext_vector_type(4)));
typedef unsigned u32x4 __attribute__((ext_vector_type(4)));
constexpr int BM = 256, BK = 64, HALF = 128, HTB = HALF * BK * 2  , STAGE_BYTES = 8 * HTB, NXCD = 8, WGM = 8;

__host__ __device__ __forceinline__ int lds_byte(int r, int c) { const int st = (r >> 4) * 2 + (c >> 5), rr = r & 15, cc = c & 31, ob = rr * 64 + cc * 2; return st * 1024 + (ob ^ (((ob >> 9) & 1) << 5)); }
__host__ __device__ __forceinline__ void stage_rc(int b, int& R, int& C) { const int st = b / 1024, sb = b % 1024, swz = sb ^ (((sb >> 9) & 1) << 5); R = (st >> 1) * 16 + swz / 64; C = (st & 1) * 32 + (swz % 64) / 2; }
__host__ __device__ __forceinline__ int perm32(int rho) { const int n = rho >> 4, i = rho & 15; return 8 * (i >> 2) + 4 * n + (i & 3); }

struct Unit { int pm, pn; };
struct Gemm { const bf16_t* A; const bf16_t* Bt; int M, N, K; };

struct StaticOrder {
    int nM, nN, nwg, G, c;
    __host__ __device__ void init(int M, int N, int G_, int c_) { nM = M / BM; nN = N / BM; nwg = nM * nN; G = G_; c = c_; }
    __host__ __device__ bool next(int i, Unit& u) const {
        const long L = (long)i * G + c; if (L >= nwg) return false;
        int wgid = (int)L; { const int q = nwg / NXCD, r = nwg % NXCD, xcd = wgid % NXCD, off = wgid / NXCD; wgid = (xcd < r ? xcd * (q + 1) : r * (q + 1) + (xcd - r) * q) + off; }
        const int nig = WGM * nN, gid = wgid / nig, fm = gid * WGM, gsz = (nM - fm) < WGM ? (nM - fm) : WGM;
        u.pm = fm + ((wgid % nig) % gsz); u.pn = (wgid % nig) / gsz; return true;
    }
    __device__ __forceinline__ void a_ready(const Unit&) const {}
    __device__ __forceinline__ void done(const Unit&) const {}
};

__device__ __forceinline__ unsigned cvt_pk_bf16(float lo, float hi) { unsigned r; asm volatile("v_cvt_pk_bf16_f32 %0, %1, %2" : "=v"(r) : "v"(lo), "v"(hi)); return r; }
typedef float f32x2 __attribute__((ext_vector_type(2)));
__device__ __forceinline__ f32x2 gelu_pk(f32x2 v) {
    const f32x2 av = __builtin_elementwise_abs(v), d = av * 0.2316418882f + 1.0f;
    f32x2 t; t.x = __builtin_amdgcn_rcpf(d.x); t.y = __builtin_amdgcn_rcpf(d.y);
    f32x2 q = t * 0.5307027145f + (-0.7265760135f); q = q * t + 0.7107068705f; q = q * t + (-0.142248368f); q = q * t + 0.127414796f; q = q * t;
    const f32x2 s = (v * v) * (-0.72134752044f);
    f32x2 e; e.x = __builtin_amdgcn_exp2f(s.x); e.y = __builtin_amdgcn_exp2f(s.y);
    const f32x2 m = v * (q * e), r = v - m;
    f32x2 o; o.x = v.x < 0.f ? m.x : r.x; o.y = v.y < 0.f ? m.y : r.y; return o;
}

template <int ACT  > struct EpiBf16 {
    static constexpr bool PERM = true, AFTER_DRAIN = false; static_assert(ACT == 0 || ACT == 1, "EpiBf16: ACT is 0 (none) or 1 (gelu_pk)");
    bf16_t* O; int ldc; const float* bias; int split_cols; size_t split_stride; float scale0;
    __device__ __forceinline__ void operator()(const f32x4 (&acc)[2][2][4][2], const Unit& u, int wr, int wc, int fr, int fq) const {
        const int row0 = u.pm * BM + wr * 64 + fr; int colt = u.pn * BM; bf16_t* base = O;
        float sc = 1.f; if (split_cols) { const int t = colt / split_cols; base += (size_t)t * split_stride; colt -= t * split_cols; if (t == 0) sc = scale0; }
        const int col0 = colt + wc * 32 + 8 * fq, bcol0 = u.pn * BM + wc * 32 + 8 * fq;
        f32x4 bv[2][2];
#pragma unroll
        for (int bj = 0; bj < 2; ++bj)
#pragma unroll
            for (int n = 0; n < 2; ++n) bv[bj][n] = bias ? *(const f32x4*)(bias + bcol0 + bj * HALF + 4 * n) : (f32x4){0.f, 0.f, 0.f, 0.f};
#pragma unroll
        for (int ai = 0; ai < 2; ++ai)
#pragma unroll
            for (int m = 0; m < 4; ++m) { bf16_t* rowp = base + (size_t)(row0 + ai * HALF + m * 16) * ldc + col0;
#pragma unroll
                for (int bj = 0; bj < 2; ++bj) { f32x4 v0 = acc[ai][bj][m][0] + bv[bj][0], v1 = acc[ai][bj][m][1] + bv[bj][1];
                    if (ACT == 1) { f32x2 a = gelu_pk((f32x2){v0[0], v0[1]}), b = gelu_pk((f32x2){v0[2], v0[3]}), c = gelu_pk((f32x2){v1[0], v1[1]}), d = gelu_pk((f32x2){v1[2], v1[3]});
                        v0 = (f32x4){a.x, a.y, b.x, b.y}; v1 = (f32x4){c.x, c.y, d.x, d.y}; }
                    v0 = v0 * sc; v1 = v1 * sc; u32x4 w; w.x = cvt_pk_bf16(v0[0], v0[1]); w.y = cvt_pk_bf16(v0[2], v0[3]); w.z = cvt_pk_bf16(v1[0], v1[1]); w.w = cvt_pk_bf16(v1[2], v1[3]);
                    *(u32x4*)(rowp + bj * HALF) = w; } }
    }
};

struct PanelStats {
    unsigned* xbuf;
    unsigned* cnt;
    unsigned* tmo;
    int ntn; float eps;
    unsigned code;
    __device__ __forceinline__ bool run(const f32x4 (&v)[2][2][4][2], const Unit& u, int wr, int wc, int fr, int fq, PG8_LAS unsigned char* lds, int wid, int lane) const {
        typedef float f32x2v __attribute__((ext_vector_type(2)));
        PG8_LAS f32x2v* P = (PG8_LAS f32x2v*)lds;
        PG8_LAS f32x2v* S = (PG8_LAS f32x2v*)(lds + 8192);
        PG8_LAS unsigned* flag = (PG8_LAS unsigned*)(lds + 8192 + 2048);
#pragma unroll
        for (int ai = 0; ai < 2; ++ai)
#pragma unroll
            for (int m = 0; m < 4; ++m) {
                float s = 0.f;
#pragma unroll
                for (int bj = 0; bj < 2; ++bj)
#pragma unroll
                    for (int n = 0; n < 2; ++n) { const f32x4 x = v[ai][bj][m][n]; s += (x[0] + x[1]) + (x[2] + x[3]); }
                s += __shfl_xor(s, 16); s += __shfl_xor(s, 32);
                const float mw = s * (1.0f / 64.0f); float q = 0.f;
#pragma unroll
                for (int bj = 0; bj < 2; ++bj)
#pragma unroll
                    for (int n = 0; n < 2; ++n) { const f32x4 d = v[ai][bj][m][n] - mw; q += (d[0] * d[0] + d[1] * d[1]) + (d[2] * d[2] + d[3] * d[3]); }
                q += __shfl_xor(q, 16); q += __shfl_xor(q, 32);
                if (fq == 0) P[(ai * HALF + wr * 64 + m * 16 + fr) * 4 + wc] = (f32x2v){mw, q};
            }
        asm volatile("s_waitcnt lgkmcnt(0)" ::: "memory"); __builtin_amdgcn_s_barrier(); asm volatile("" ::: "memory");
#if defined(BROKEN_EXCHANGE_NO_WAIT)
#warning BROKEN CONTROL BUILD: the row-statistics exchange does not wait; results are wrong by design
        if (blockIdx.x >= 64) { const long long t0_ = clock64(); while (clock64() - t0_ < 60000) __builtin_amdgcn_s_sleep(8); }
#endif
        const int row = wid * 32 + (lane & 31);
        if (lane < 32) {
            const f32x2v a = P[row * 4 + 0], b = P[row * 4 + 1], c = P[row * 4 + 2], d = P[row * 4 + 3];
            const float mt = (a.x + b.x + c.x + d.x) * 0.25f;
            const float da = a.x - mt, db = b.x - mt, dc = c.x - mt, dd = d.x - mt;
            const float m2 = (a.y + b.y) + (c.y + d.y) + 64.0f * ((da * da + db * db) + (dc * dc + dd * dd));
            unsigned long long* slot = (unsigned long long*)xbuf + ((size_t)(u.pm * BM + row) * 4 + u.pn);
            __hip_atomic_store(slot, ((unsigned long long)__float_as_uint(m2) << 32) | __float_as_uint(mt), __ATOMIC_RELAXED, __HIP_MEMORY_SCOPE_AGENT);
        }
        asm volatile("s_waitcnt vmcnt(0)" ::: "memory");
        if (lane == 0) __hip_atomic_fetch_add(cnt + 64 * u.pm, 1u, __ATOMIC_RELAXED, __HIP_MEMORY_SCOPE_AGENT);
        if (wid == 0) {
            bool dead = false; const unsigned long long t0 = __builtin_amdgcn_s_memrealtime(); const unsigned want = 8u * (unsigned)ntn;
            for (;;) {
#if defined(BROKEN_EXCHANGE_NO_WAIT)
                break;
#endif
                if ((unsigned)__builtin_amdgcn_readfirstlane(__hip_atomic_load(cnt + 64 * u.pm, __ATOMIC_RELAXED, __HIP_MEMORY_SCOPE_AGENT)) >= want) break;
                if (__builtin_amdgcn_s_memrealtime() - t0 > 2000000ull) {
                    if (lane == 0) { unsigned expect = 0u; __hip_atomic_compare_exchange_strong(tmo + 1, &expect, code | (unsigned)(u.pm & 0xff), __ATOMIC_RELAXED, __ATOMIC_RELAXED, __HIP_MEMORY_SCOPE_AGENT);
                                     __hip_atomic_store(tmo, 1u, __ATOMIC_RELAXED, __HIP_MEMORY_SCOPE_AGENT); }
                    dead = true; break; }
                __builtin_amdgcn_s_sleep(2);
            }
            __builtin_amdgcn_fence(__ATOMIC_ACQUIRE, "agent");
            if (lane == 0) flag[0] = dead ? 1u : 0u;
        }
        asm volatile("s_waitcnt vmcnt(0) lgkmcnt(0)" ::: "memory"); __builtin_amdgcn_s_barrier(); asm volatile("" ::: "memory");
        const bool bad = flag[0] != 0u;
        if (lane < 32) {
            const unsigned long long* slot = (const unsigned long long*)xbuf + (size_t)(u.pm * BM + row) * 4; float mt[4], m2[4]; float ms = 0.f;
#pragma unroll
            for (int t = 0; t < 4; ++t) { if (t < ntn) { const unsigned long long w = __hip_atomic_load(slot + t, __ATOMIC_RELAXED, __HIP_MEMORY_SCOPE_AGENT); mt[t] = __uint_as_float((unsigned)w); m2[t] = __uint_as_float((unsigned)(w >> 32)); } else { mt[t] = 0.f; m2[t] = 0.f; } ms += mt[t]; }
            const float mean = ms / (float)ntn; float q = 0.f;
#pragma unroll
            for (int t = 0; t < 4; ++t) if (t < ntn) { const float dm = mt[t] - mean; q += m2[t] + 256.0f * dm * dm; }
            S[row] = (f32x2v){mean, 1.0f / sqrtf(q / (256.0f * (float)ntn) + eps)};
        }
        asm volatile("s_waitcnt lgkmcnt(0)" ::: "memory"); __builtin_amdgcn_s_barrier(); asm volatile("" ::: "memory");
        return bad;
    }
};
struct EpiLnRes {
    static constexpr bool PERM = false, AFTER_DRAIN = true;
    const float* base; float* out; int ldc; const float* bias; PanelStats st; unsigned poison;
    __device__ __forceinline__ void fused(f32x4 (&acc)[2][2][4][2], const Unit& u, int wr, int wc, int fr, int fq, PG8_LAS unsigned char* lds, int wid, int lane) const {
        typedef float f32x2v __attribute__((ext_vector_type(2)));
        const PG8_LAS f32x2v* S = (const PG8_LAS f32x2v*)(lds + 8192);
        const int col0 = u.pn * BM + wc * 32 + 4 * fq;
#pragma unroll
        for (int bj = 0; bj < 2; ++bj)
#pragma unroll
            for (int n = 0; n < 2; ++n) { const f32x4 bv = bias ? *(const f32x4*)(bias + col0 + bj * HALF + n * 16) : (f32x4){0.f, 0.f, 0.f, 0.f};
#pragma unroll
                for (int ai = 0; ai < 2; ++ai)
#pragma unroll
                    for (int m = 0; m < 4; ++m) acc[ai][bj][m][n] += bv; }
        f32x4 pre[4][2][2];
#pragma unroll
        for (int m = 0; m < 4; ++m) { const size_t off = (size_t)(u.pm * BM + wr * 64 + m * 16 + fr) * ldc + col0;
#pragma unroll
            for (int bj = 0; bj < 2; ++bj)
#pragma unroll
                for (int n = 0; n < 2; ++n) pre[m][bj][n] = *(const f32x4*)(base + off + bj * HALF + n * 16); }
        const bool bad = st.run(acc, u, wr, wc, fr, fq, lds, wid, lane) || poison != 0u;
        const float qnan = __builtin_nanf("");
#pragma unroll
        for (int ai = 0; ai < 2; ++ai)
#pragma unroll
            for (int m = 0; m < 4; ++m) { const int r = ai * HALF + wr * 64 + m * 16 + fr; const f32x2v sr = S[r]; const size_t off = (size_t)(u.pm * BM + r) * ldc + col0;
#pragma unroll
                for (int bj = 0; bj < 2; ++bj)
#pragma unroll
                    for (int n = 0; n < 2; ++n) { const f32x4 bs = ai == 0 ? pre[m][bj][n] : *(const f32x4*)(base + off + bj * HALF + n * 16); f32x4 o = bs + (acc[ai][bj][m][n] - sr.x) * sr.y;
                        if (bad) o = (f32x4){qnan, qnan, qnan, qnan}; *(f32x4*)(out + off + bj * HALF + n * 16) = o; }
                if (m & 1) asm volatile("" ::: "memory"); }
    }
};
struct EpiLnResLn {
    static constexpr bool PERM = false, AFTER_DRAIN = true;
    const float* base; float* out; bf16_t* xn; int ldc; const float* bias; PanelStats st1, st2; unsigned poison;
    __device__ __forceinline__ void fused(f32x4 (&acc)[2][2][4][2], const Unit& u, int wr, int wc, int fr, int fq, PG8_LAS unsigned char* lds, int wid, int lane) const {
        typedef float f32x2v __attribute__((ext_vector_type(2))); typedef unsigned u32x2v __attribute__((ext_vector_type(2)));
        const PG8_LAS f32x2v* S = (const PG8_LAS f32x2v*)(lds + 8192);
        const int col0 = u.pn * BM + wc * 32 + 4 * fq;
#pragma unroll
        for (int bj = 0; bj < 2; ++bj)
#pragma unroll
            for (int n = 0; n < 2; ++n) { const f32x4 bv = bias ? *(const f32x4*)(bias + col0 + bj * HALF + n * 16) : (f32x4){0.f, 0.f, 0.f, 0.f};
#pragma unroll
                for (int ai = 0; ai < 2; ++ai)
#pragma unroll
                    for (int m = 0; m < 4; ++m) acc[ai][bj][m][n] += bv; }
        bool bad = st1.run(acc, u, wr, wc, fr, fq, lds, wid, lane) || poison != 0u;
        const float qnan = __builtin_nanf("");
#pragma unroll
        for (int ai = 0; ai < 2; ++ai)
#pragma unroll
            for (int m = 0; m < 4; ++m) { const int r = ai * HALF + wr * 64 + m * 16 + fr; const f32x2v sr = S[r]; const size_t off = (size_t)(u.pm * BM + r) * ldc + col0;
#pragma unroll
                for (int bj = 0; bj < 2; ++bj)
#pragma unroll
                    for (int n = 0; n < 2; ++n) { const f32x4 bs = *(const f32x4*)(base + off + bj * HALF + n * 16); acc[ai][bj][m][n] = bs + (acc[ai][bj][m][n] - sr.x) * sr.y; }
                asm volatile("" : "+v"(acc[ai][0][m][0]), "+v"(acc[ai][0][m][1]), "+v"(acc[ai][1][m][0]), "+v"(acc[ai][1][m][1]));
                if (m & 1) asm volatile("" ::: "memory"); }
        const bool bad1 = bad;
        bad = st2.run(acc, u, wr, wc, fr, fq, lds, wid, lane) || bad;
#pragma unroll
        for (int ai = 0; ai < 2; ++ai)
#pragma unroll
            for (int m = 0; m < 4; ++m) { const int r = ai * HALF + wr * 64 + m * 16 + fr; const f32x2v sr = S[r]; const size_t off = (size_t)(u.pm * BM + r) * ldc + col0;
#pragma unroll
                for (int bj = 0; bj < 2; ++bj)
#pragma unroll
                    for (int n = 0; n < 2; ++n) { const f32x4 x1 = acc[ai][bj][m][n]; *(f32x4*)(out + off + bj * HALF + n * 16) = bad1 ? (f32x4){qnan, qnan, qnan, qnan} : x1;
                        const f32x4 o = (x1 - sr.x) * sr.y; u32x2v w; w.x = cvt_pk_bf16(o[0], o[1]); w.y = cvt_pk_bf16(o[2], o[3]);
                        if (bad) { w.x = 0x7fc07fc0u; w.y = 0x7fc07fc0u; } *(u32x2v*)(xn + off + bj * HALF + n * 16) = w; }
                asm volatile("" ::: "memory"); }
    }
};

template <class Epi, class Sched, bool ALIGN_EPI = false, bool SP2 = false>
__device__ __forceinline__ void gemm_phase(PG8_LAS unsigned char* lds, const Gemm g, const Sched& S, const Epi& E, const int tid) {
    const int wid = __builtin_amdgcn_readfirstlane(tid >> 6), lane = tid & 63, wr = wid >> 2, wc = wid & 3, fr = lane & 15, fq = lane >> 4;
    const int K = g.K, nt = K / BK;
    unsigned voffA[2], voffB[2];
#pragma unroll
    for (int i = 0; i < 2; ++i) { int R, C; stage_rc(tid * 16 + i * 8192, R, C); const int Rb = Epi::PERM ? ((R & ~31) + perm32(R & 31)) : R;
        voffA[i] = (unsigned)(R * K + C) * 2u; voffB[i] = (unsigned)(Rb * K + C) * 2u; }
    const size_t kstep = (size_t)(BK * 2);
    const size_t hstep = (size_t)HALF * K * 2;
    const size_t tstep = 2 * hstep;
    const unsigned ldsw = (unsigned)wid * 1024u;
    const int aoff = lds_byte(wr * 64 + fr, fq * 8), boff = lds_byte(wc * 32 + fr, fq * 8);
#define PG8_SA(b, h) (((b) * 2 + (h)) * HTB)
#define PG8_SB(b, h) ((4 + (b) * 2 + (h)) * HTB)
#define PG8_STAGE(bufoff, gbase, voff) do { _Pragma("unroll") for (int _i = 0; _i < 2; ++_i) \
        __builtin_amdgcn_global_load_lds((const unsigned*)((const char*)(gbase) + (voff)[_i]), (PG8_LAS unsigned*)(lds + (bufoff) + ldsw + _i * 8192), 16, 0, 0); } while (0)
#define PG8_LDA(dst, b, h) do { _Pragma("unroll") for (int m = 0; m < 4; ++m) _Pragma("unroll") for (int k = 0; k < 2; ++k) dst[m][k] = *(const PG8_LAS bf16x8*)(lds + PG8_SA(b, h) + aoff + m * 2048 + k * 1024); } while (0)
#define PG8_LDB(dst, b, h) do { _Pragma("unroll") for (int n = 0; n < 2; ++n) _Pragma("unroll") for (int k = 0; k < 2; ++k) dst[n][k] = *(const PG8_LAS bf16x8*)(lds + PG8_SB(b, h) + boff + n * 2048 + k * 1024); } while (0)
#define PG8_MMA(ai, bj, At, Bt) do { __builtin_amdgcn_s_setprio(1); _Pragma("unroll") for (int m = 0; m < 4; ++m) _Pragma("unroll") for (int n = 0; n < 2; ++n) _Pragma("unroll") for (int k = 0; k < 2; ++k) \
        acc[ai][bj][m][n] = __builtin_amdgcn_mfma_f32_16x16x32_bf16(Bt[n][k], At[m][k], acc[ai][bj][m][n], 0, 0, 0); __builtin_amdgcn_s_setprio(0); } while (0)
#define PG8_WAIT_V(n) asm volatile("s_waitcnt vmcnt(" #n ")" ::: "memory")
#define PG8_WAIT_L(n) asm volatile("s_waitcnt lgkmcnt(" #n ")" ::: "memory")
#define PG8_BAR __builtin_amdgcn_s_barrier()
#define PG8_SCHED __builtin_amdgcn_sched_barrier(0)
    Unit cur, nxt; int ui = 0;
    if (!S.next(0, cur)) return;
    f32x4 acc[2][2][4][2];
#pragma unroll
    for (int a = 0; a < 2; ++a)
#pragma unroll
        for (int b = 0; b < 2; ++b)
#pragma unroll
            for (int m = 0; m < 4; ++m)
#pragma unroll
                for (int n = 0; n < 2; ++n) acc[a][b][m][n] = (f32x4){0.f, 0.f, 0.f, 0.f};
    bf16x8 At[4][2], B0[2][2], B1[2][2];
    const char* cA = (const char*)g.A + (size_t)cur.pm * tstep; const char* cB = (const char*)g.Bt + (size_t)cur.pn * tstep;
    S.a_ready(cur);
    if constexpr (SP2) {
        PG8_STAGE(PG8_SB(0, 0), cB, voffB); PG8_STAGE(PG8_SB(0, 1), cB + hstep, voffB); PG8_STAGE(PG8_SA(0, 0), cA, voffA); PG8_STAGE(PG8_SA(0, 1), cA + hstep, voffA);
        if (wr == 1) PG8_BAR;
        PG8_WAIT_V(2); PG8_BAR;
        PG8_STAGE(PG8_SB(1, 0), cB + kstep, voffB); PG8_STAGE(PG8_SA(1, 0), cA + kstep, voffA); PG8_STAGE(PG8_SB(1, 1), cB + hstep + kstep, voffB);
        PG8_WAIT_V(6); PG8_BAR;
    } else {
        PG8_STAGE(PG8_SB(0, 0), cB, voffB); PG8_STAGE(PG8_SA(0, 0), cA, voffA); PG8_STAGE(PG8_SB(0, 1), cB + hstep, voffB); PG8_STAGE(PG8_SA(0, 1), cA + hstep, voffA);
        if (wr == 1) PG8_BAR;
        PG8_WAIT_V(4); PG8_BAR;
        PG8_STAGE(PG8_SB(1, 0), cB + kstep, voffB); PG8_STAGE(PG8_SA(1, 0), cA + kstep, voffA); PG8_STAGE(PG8_SB(1, 1), cB + hstep + kstep, voffB);
        PG8_WAIT_V(6); PG8_BAR;
    }
    for (;;) {
        const bool has_next = S.next(ui + 1, nxt);
        const char* nA = has_next ? (const char*)g.A + (size_t)nxt.pm * tstep : cA; const char* nB = has_next ? (const char*)g.Bt + (size_t)nxt.pn * tstep : cB;
        for (int t = 0; t < nt; t += 2) {
            const bool last = (t == nt - 2);
            const char* a1 = cA + (size_t)(t + 1) * kstep;
            const char* a2 = last ? nA : cA + (size_t)(t + 2) * kstep; const char* b2 = last ? nB : cB + (size_t)(t + 2) * kstep;
            const char* a3 = a2 + kstep; const char* b3 = b2 + kstep;
            if (last && has_next) S.a_ready(nxt);
            if constexpr (SP2) {
            PG8_LDB(B0, 0, 0); PG8_LDB(B1, 0, 1); PG8_SCHED; PG8_LDA(At, 0, 0); PG8_STAGE(PG8_SA(1, 1), a1 + hstep, voffA);
            PG8_WAIT_V(8); PG8_WAIT_L(0); PG8_BAR; PG8_MMA(0, 0, At, B0); PG8_MMA(0, 1, At, B1); PG8_BAR; PG8_SCHED;
            PG8_LDA(At, 0, 1); PG8_STAGE(PG8_SB(0, 0), b2, voffB); PG8_STAGE(PG8_SB(0, 1), b2 + hstep, voffB); PG8_STAGE(PG8_SA(0, 0), a2, voffA);
            PG8_WAIT_V(8); PG8_WAIT_L(0); PG8_BAR; PG8_MMA(1, 0, At, B0); PG8_MMA(1, 1, At, B1); PG8_BAR; PG8_SCHED;
            PG8_LDB(B0, 1, 0); PG8_LDB(B1, 1, 1); PG8_SCHED; PG8_LDA(At, 1, 0); PG8_STAGE(PG8_SA(0, 1), a2 + hstep, voffA);
            PG8_WAIT_V(8); PG8_WAIT_L(0); PG8_BAR; PG8_MMA(0, 0, At, B0); PG8_MMA(0, 1, At, B1); PG8_BAR; PG8_SCHED;
            PG8_LDA(At, 1, 1); PG8_STAGE(PG8_SB(1, 0), b3, voffB); PG8_STAGE(PG8_SB(1, 1), b3 + hstep, voffB); PG8_STAGE(PG8_SA(1, 0), a3, voffA);
            PG8_WAIT_V(8); PG8_WAIT_L(0); PG8_BAR; PG8_MMA(1, 0, At, B0); PG8_MMA(1, 1, At, B1); PG8_BAR; PG8_SCHED;
            } else {
            PG8_LDB(B0, 0, 0); PG8_SCHED; PG8_LDA(At, 0, 0); PG8_STAGE(PG8_SA(1, 1), a1 + hstep, voffA);
            PG8_WAIT_L(8); PG8_BAR; PG8_WAIT_L(0); PG8_MMA(0, 0, At, B0); PG8_BAR; PG8_SCHED;
            PG8_LDB(B1, 0, 1); PG8_STAGE(PG8_SB(0, 0), b2, voffB);
            PG8_BAR; PG8_WAIT_L(0); PG8_MMA(0, 1, At, B1); PG8_BAR;
            PG8_LDA(At, 0, 1); PG8_STAGE(PG8_SA(0, 0), a2, voffA);
            PG8_BAR; PG8_WAIT_L(0); PG8_MMA(1, 0, At, B0); PG8_BAR; PG8_SCHED;
            PG8_STAGE(PG8_SB(0, 1), b2 + hstep, voffB);
            PG8_WAIT_V(6); PG8_BAR; PG8_MMA(1, 1, At, B1); PG8_BAR;
            PG8_LDB(B0, 1, 0); PG8_SCHED; PG8_LDA(At, 1, 0); PG8_STAGE(PG8_SA(0, 1), a2 + hstep, voffA);
            PG8_WAIT_L(8); PG8_BAR; PG8_WAIT_L(0); PG8_MMA(0, 0, At, B0); PG8_BAR; PG8_SCHED;
            PG8_LDB(B1, 1, 1); PG8_STAGE(PG8_SB(1, 0), b3, voffB);
            PG8_BAR; PG8_WAIT_L(0); PG8_MMA(0, 1, At, B1); PG8_BAR;
            PG8_LDA(At, 1, 1); PG8_STAGE(PG8_SA(1, 0), a3, voffA);
            PG8_BAR; PG8_WAIT_L(0); PG8_MMA(1, 0, At, B0); PG8_BAR; PG8_SCHED;
            PG8_STAGE(PG8_SB(1, 1), b3 + hstep, voffB);
            PG8_WAIT_V(6); PG8_BAR; PG8_MMA(1, 1, At, B1); PG8_BAR;
            }
        }
        if constexpr (ALIGN_EPI) { if (wr == 0) PG8_BAR; }
        if constexpr (!Epi::AFTER_DRAIN) { E(acc, cur, wr, wc, fr, fq); S.done(cur); }
        if (!has_next) break;
#pragma unroll
        for (int a = 0; a < 2; ++a)
#pragma unroll
            for (int b = 0; b < 2; ++b)
#pragma unroll
                for (int m = 0; m < 4; ++m)
#pragma unroll
                    for (int n = 0; n < 2; ++n) acc[a][b][m][n] = (f32x4){0.f, 0.f, 0.f, 0.f};
        cur = nxt; cA = nA; cB = nB; ++ui;
        if constexpr (ALIGN_EPI) { if (wr == 1) PG8_BAR; }
    }
    PG8_WAIT_V(0);
    if constexpr (!ALIGN_EPI) { if (wr == 0) PG8_BAR; }
    PG8_BAR;
    if constexpr (Epi::AFTER_DRAIN) { E.fused(acc, cur, wr, wc, fr, fq, lds, wid, lane); S.done(cur); }
#undef PG8_SA
#undef PG8_SB
#undef PG8_STAGE
#undef PG8_LDA
#undef PG8_LDB
#undef PG8_MMA
#undef PG8_WAIT_V
#undef PG8_WAIT_L
#undef PG8_BAR
#undef PG8_SCHED
}
}

#define GAS __attribute__((address_space(1)))
#define LAS __attribute__((address_space(3)))
typedef unsigned short bf16;
typedef float f32x4 __attribute__((ext_vector_type(4)));
typedef float f32x16 __attribute__((ext_vector_type(16)));
typedef short bf16x8 __attribute__((ext_vector_type(8)));
typedef short s16x4 __attribute__((ext_vector_type(4)));
typedef unsigned u32x4 __attribute__((ext_vector_type(4)));
typedef unsigned u32x2 __attribute__((ext_vector_type(2)));
typedef float f32x2_t __attribute__((ext_vector_type(2)));
typedef __bf16 bf16x2_t __attribute__((ext_vector_type(2)));
typedef GAS unsigned gu32;
#define RLX_AGENT __ATOMIC_RELAXED, __HIP_MEMORY_SCOPE_AGENT

constexpr int D = 1024, BP = 4, TP = 4096, MP = BP * TP, BS = 128, TS = 8, MS = BS * TS, M = MP + MS;
constexpr int SBH = 8, HD = 64, SBW = 512, DNH = 4, DND = 128, DNW = 512;
constexpr int IN_COLS = 3592, NPROJ = 3584;
constexpr int DFF = 2816, DFF2 = 5632, NMOD = 6144, NC = BP + BS;
constexpr int PAST = 2048, NPAGES = 16, PAGE = 128;
constexpr float EPS = 1e-6f, LOG2E = 1.4426950408889634f;
constexpr float QSCALE = 0.125f * LOG2E;
constexpr int NSPLIT = 4, NPART = 5;

constexpr size_t O_YP = 0, O_KP = 17825792, O_VP = 26214400, O_KS = 34603008, O_VS = 35127296, O_SP = 35651584, O_SS = 35913728,
                 O_DCP = 44302336, O_DCS = 44320768, O_FCP = 44910592, O_FCS = 44955648, O_END = 46397440;

constexpr size_t MiB = 1u << 20;
constexpr size_t WS_CTL = 0, CTL_ZERO_BYTES = MiB;
constexpr size_t WS_MOD = 1 * MiB, WS_SC = 5 * MiB, WS_WINX = 6 * MiB, WS_WIN_T = 7 * MiB, WS_WOUT_T = 14 * MiB, WS_WUP_T = 16 * MiB, WS_WDN_T = 27 * MiB,
                 WS_EXTRA = 33 * MiB, WS_H = 34 * MiB, WS_DNRAW = 68 * MiB, WS_ZG = 120 * MiB, WS_QB = 306 * MiB, WS_KB = 323 * MiB, WS_VB = 340 * MiB, WS_QD = 357 * MiB, WS_KD = 391 * MiB,
                 WS_VD = 425 * MiB, WS_BETA = 459 * MiB, WS_LOGA = 460 * MiB, WS_ODN = 461 * MiB, WS_MIXED = 495 * MiB, WS_X1 = 529 * MiB, WS_UP = 597 * MiB,
                 WS_ACT = 784 * MiB, WS_U = 878 * MiB, WS_KCUM = 910 * MiB, WS_QDEC = 926 * MiB, WS_KDECT = 942 * MiB, WS_INTRA = 958 * MiB, WS_GL = 966 * MiB,
                 WS_OPART = 967 * MiB, WS_LPART = 978 * MiB, WS_END = 979 * MiB;
constexpr int CW_Q0 = 1024;
constexpr int CW_QUEUE = 64;
constexpr int CW_BAR = 8192;

constexpr int RING_BYTES = 131072, MISC_OFF = RING_BYTES + 320, LDS_BYTES = 147456;

__device__ __forceinline__ unsigned cvtpk(float lo, float hi) { f32x2_t v = {lo, hi}; bf16x2_t b = __builtin_convertvector(v, bf16x2_t); return __builtin_bit_cast(unsigned, b); }
__device__ __forceinline__ bf16 f2bf(float f) { return (bf16)(cvtpk(f, 0.f) & 0xffffu); }
__device__ __forceinline__ float wave_sum(float v) {
#pragma unroll
    for (int o = 1; o < 64; o <<= 1) v += __shfl_xor(v, o);
    return v;
}
__device__ __forceinline__ float siluf(float x) { return x * __builtin_amdgcn_rcpf(1.f + __builtin_amdgcn_exp2f(-1.4426950408889634f * x)); }
__device__ __forceinline__ u32x4 pack8(const f32x4 a, const f32x4 b) { u32x4 w; w.x = cvtpk(a.x, a.y); w.y = cvtpk(a.z, a.w); w.z = cvtpk(b.x, b.y); w.w = cvtpk(b.z, b.w); return w; }
__device__ __forceinline__ float bf2f(unsigned short h) { return __uint_as_float((unsigned)h << 16); }

#define XB_TMO      128
#define XB_XCNT(j)  (256  + 64 * (j))
#define XB_XSUB(j)  (1280 + 64 * (j))
#define XB_XGEN(j)  (2304 + 64 * (j))
#define XB_TOP      3328
#define XB_TOPGEN   3392
#define XCD_BAR_WORDS 3456
#define XB_SPIN_CAP (1u << 18)
__device__ __forceinline__ unsigned xb_ld(unsigned* p)              { return __hip_atomic_load(p, __ATOMIC_RELAXED, __HIP_MEMORY_SCOPE_AGENT); }
__device__ __forceinline__ unsigned xb_add(unsigned* p, unsigned v) { return __hip_atomic_fetch_add(p, v, __ATOMIC_RELAXED, __HIP_MEMORY_SCOPE_AGENT); }
__device__ __forceinline__ unsigned xb_xcc_id() { return (unsigned)__builtin_amdgcn_s_getreg((3 << 11) | 20) & 0xFu; }
#define XB_SPIN(cond, bar) do { unsigned _sp = 0; while (cond) { __builtin_amdgcn_s_sleep(1); \
    if ((++_sp & 255u) == 0u) { if (xb_ld(&(bar)[XB_TMO])) break; if (_sp > XB_SPIN_CAP) { atomicAdd(&(bar)[XB_TMO], 1u); break; } } } } while (0)
struct XcdBarrier { unsigned* bar; unsigned x; volatile LAS unsigned* st; };
__device__ __forceinline__ XcdBarrier xcd_barrier_post(unsigned* bar, volatile LAS unsigned* st, int tid) {
    XcdBarrier b; b.bar = bar; b.x = xb_xcc_id(); b.st = st;
    if (tid == 0) (void)xb_add(&bar[XB_XCNT(b.x)], 1u);
    return b;
}
__device__ __forceinline__ void xcd_barrier_complete(unsigned* bar, unsigned x, unsigned& nloc, unsigned& nx) {
    const unsigned G = gridDim.x * gridDim.y * gridDim.z;
    unsigned sum, cnt, mine, sp = 0u;
    for (;;) {
        sum = 0u; cnt = 0u; mine = 0u;
#pragma unroll
        for (unsigned j = 0; j < 16; ++j) { const unsigned c = xb_ld(&bar[XB_XCNT(j)]); sum += c; cnt += (c > 0u) ? 1u : 0u; mine = (j == x) ? c : mine; }
        if (sum == G) break;
        __builtin_amdgcn_s_sleep(1);
        if ((++sp & 255u) == 0u) { if (xb_ld(&bar[XB_TMO])) break; if (sp > XB_SPIN_CAP) { atomicAdd(&bar[XB_TMO], 1u); break; } }
    }
    nloc = mine > 0u ? mine : 1u; nx = cnt > 0u ? cnt : 1u;
}
__device__ __forceinline__ void xcd_barrier(const XcdBarrier& b, int tid) {
    asm volatile("s_waitcnt vmcnt(0)" ::: "memory");
    __syncthreads();
    if (tid == 0) {
        unsigned* bar = b.bar;
        __builtin_amdgcn_s_waitcnt(0);
        unsigned nloc = b.st[0], nx = b.st[1];
        if (nloc == 0u) { xcd_barrier_complete(bar, b.x, nloc, nx); b.st[0] = nloc; b.st[1] = nx; }
        const unsigned old = xb_add(&bar[XB_XSUB(b.x)], 1u);
        const unsigned gen = old / nloc;
        if (old + 1u == (gen + 1u) * nloc) {
            __builtin_amdgcn_fence(__ATOMIC_RELEASE, "agent");
            asm volatile("s_waitcnt vmcnt(0)" ::: "memory");
            const unsigned og = xb_add(&bar[XB_TOP], 1u);
            const unsigned tg = og / nx;
            if (og + 1u == (tg + 1u) * nx) xb_add(&bar[XB_TOPGEN], 1u);
            else XB_SPIN(xb_ld(&bar[XB_TOPGEN]) == tg, bar);
            __builtin_amdgcn_fence(__ATOMIC_ACQUIRE, "agent");
            xb_add(&bar[XB_XGEN(b.x)], 1u);
            asm volatile("s_waitcnt vmcnt(0)" ::: "memory");
        } else {
            XB_SPIN(xb_ld(&bar[XB_XGEN(b.x)]) == gen, bar);
            __builtin_amdgcn_fence(__ATOMIC_ACQUIRE, "agent");
            asm volatile("s_waitcnt vmcnt(0)" ::: "memory");
        }
    }
    __syncthreads();
}

__device__ __forceinline__ int lane_now() { int l; asm volatile("v_mbcnt_lo_u32_b32 %0, -1, 0\n\tv_mbcnt_hi_u32_b32 %0, -1, %0" : "=v"(l)); return l; }
struct Args { const void* in[27]; float* out; unsigned char* ws; int lo, hi; };
enum { I_XP = 0, I_XS, I_CP, I_CS, I_CK, I_CV, I_PT, I_SD, I_SDC, I_SFC, I_WADA, I_BADA, I_GATT, I_WIN, I_GQ, I_GK, I_SBB, I_GSBO, I_WDNC, I_ALOG, I_DTB, I_GDNO, I_WOUT, I_GFFN, I_WUP, I_WFC, I_WDN };

__device__ __forceinline__ int mod_row(int m) { return m < MP ? (m >> 12) : BP + ((m - MP) >> 3); }

struct EpiF32 {
    static constexpr bool PERM = false, AFTER_DRAIN = false;
    float* O; int ldc;
    __device__ __forceinline__ void operator()(const pg8::f32x4 (&acc)[2][2][4][2], const pg8::Unit& u, int wr, int wc, int fr, int fq) const {
        const int row0 = u.pm * 256 + wr * 64 + fr, col0 = u.pn * 256 + wc * 32 + 4 * fq;
#pragma unroll
        for (int ai = 0; ai < 2; ++ai)
#pragma unroll
            for (int m = 0; m < 4; ++m) { float* rowp = O + (size_t)(row0 + ai * 128 + m * 16) * ldc + col0;
#pragma unroll
                for (int bj = 0; bj < 2; ++bj)
#pragma unroll
                    for (int n = 0; n < 2; ++n) *(pg8::f32x4*)(rowp + bj * 128 + n * 16) = acc[ai][bj][m][n]; }
    }
};
struct EpiResGate {
    static constexpr bool PERM = false, AFTER_DRAIN = false;
    const float* base0; const float* base1; const float* mod; int goff; float* out;
    __device__ __forceinline__ void operator()(const pg8::f32x4 (&acc)[2][2][4][2], const pg8::Unit& u, int wr, int wc, int fr, int fq) const {
        const int row0 = u.pm * 256 + wr * 64 + fr, col0 = u.pn * 256 + wc * 32 + 4 * fq;
#pragma unroll
        for (int ai = 0; ai < 2; ++ai)
#pragma unroll
            for (int m = 0; m < 4; ++m) { const int r = row0 + ai * 128 + m * 16;
                const float* bp = (r < MP ? base0 + (size_t)r * D : base1 + (size_t)(r - MP) * D) + col0;
                const float* gp = mod + (size_t)mod_row(r) * NMOD + goff + col0; float* op = out + (size_t)r * D + col0;
#pragma unroll
                for (int bj = 0; bj < 2; ++bj)
#pragma unroll
                    for (int n = 0; n < 2; ++n) { const pg8::f32x4 b = *(const pg8::f32x4*)(bp + bj * 128 + n * 16), g = *(const pg8::f32x4*)(gp + bj * 128 + n * 16);
                        *(pg8::f32x4*)(op + bj * 128 + n * 16) = b + g * acc[ai][bj][m][n]; } }
    }
};

__device__ __forceinline__ void st16(void* base, unsigned off, u32x4 v) { *(u32x4*)((unsigned char*)base + off) = v; }
__device__ __forceinline__ void st16f(void* base, unsigned off, pg8::f32x4 v) { *(pg8::f32x4*)((unsigned char*)base + off) = v; }
struct EpiProj {
    static constexpr bool PERM = true, AFTER_DRAIN = false;
    float* out; bf16* QB; bf16* KB; bf16* VB; bf16* DNRAW; bf16* ZG; const float* g_q; const float* g_k; LAS float* xl;
    __device__ __forceinline__ void operator()(const pg8::f32x4 (&acc)[2][2][4][2], const pg8::Unit& u, int wr, int wc, int fr, int fq) const {
        const int pn = u.pn, rl0 = wr * 64 + fr, c0 = wc * 32 + 8 * fq;
        const unsigned row0 = (unsigned)u.pm * 256u + (unsigned)rl0;
        const bool prompt_tile = u.pm < MP / 256;
        if (pn < 4) {
            int xb = (rl0 * 8 + wc) * 4, xb2 = (rl0 * 8 + (wc ^ 1)) * 4; asm volatile("" : "+v"(xb), "+v"(xb2));
            LAS float* xw = (LAS float*)((LAS unsigned char*)xl + xb); const LAS float* xr = (const LAS float*)((LAS unsigned char*)xl + xb2);
#pragma unroll
            for (int ai = 0; ai < 2; ++ai)
#pragma unroll
                for (int m = 0; m < 4; ++m)
#pragma unroll
                    for (int bj = 0; bj < 2; ++bj) { const pg8::f32x4 a = acc[ai][bj][m][0], b = acc[ai][bj][m][1];
                        float ss = (a[0] * a[0] + a[1] * a[1]) + (a[2] * a[2] + a[3] * a[3]) + (b[0] * b[0] + b[1] * b[1]) + (b[2] * b[2] + b[3] * b[3]);
                        ss += __shfl_xor(ss, 16); ss += __shfl_xor(ss, 32);
                        if (fq == 0) xw[(ai * 128 + m * 16) * 8 + bj * 4] = ss; }
            asm volatile("s_waitcnt lgkmcnt(0)" ::: "memory"); __builtin_amdgcn_s_barrier(); asm volatile("" ::: "memory");
            const bool isq = pn < 2; const float* g = isq ? g_q : g_k; const int dloc = 32 * (wc & 1) + 8 * fq;
            const pg8::f32x4 g0 = *(const pg8::f32x4*)(g + dloc), g1 = *(const pg8::f32x4*)(g + dloc + 4);
            bf16* dstb = isq ? QB : KB; float* dstf = prompt_tile ? out + O_KP : out + O_KS - (size_t)MP * SBW;
#pragma unroll
            for (int ai = 0; ai < 2; ++ai)
#pragma unroll
                for (int m = 0; m < 4; ++m) { const unsigned row = row0 + ai * 128 + m * 16;
#pragma unroll
                    for (int bj = 0; bj < 2; ++bj) { const float tot = xw[(ai * 128 + m * 16) * 8 + bj * 4] + xr[(ai * 128 + m * 16) * 8 + bj * 4];
                        const float rs = (isq ? QSCALE : 1.0f) / sqrtf(tot * (1.f / HD) + EPS);
                        const pg8::f32x4 a = acc[ai][bj][m][0] * rs * g0, b = acc[ai][bj][m][1] * rs * g1;
                        const unsigned e = row * SBW + (unsigned)((pn & 1) * 256 + bj * 128 + c0);
                        st16(dstb, e * 2u, pack8(a, b));
                        if (!isq) { st16f(dstf, e * 4u, a); st16f(dstf, e * 4u + 16u, b); } }
                    asm volatile("" ::: "memory"); }
            asm volatile("s_waitcnt lgkmcnt(0)" ::: "memory"); __builtin_amdgcn_s_barrier(); asm volatile("" ::: "memory");
        } else if (pn < 6) {
            float* dstf = prompt_tile ? out + O_VP : out + O_VS - (size_t)MP * SBW;
#pragma unroll
            for (int ai = 0; ai < 2; ++ai)
#pragma unroll
                for (int m = 0; m < 4; ++m) { const unsigned row = row0 + ai * 128 + m * 16;
#pragma unroll
                    for (int bj = 0; bj < 2; ++bj) { const pg8::f32x4 a = acc[ai][bj][m][0], b = acc[ai][bj][m][1]; const unsigned e = row * SBW + (unsigned)((pn & 1) * 256 + bj * 128 + c0);
                        st16(VB, e * 2u, pack8(a, b)); st16f(dstf, e * 4u, a); st16f(dstf, e * 4u + 16u, b); }
                    asm volatile("" ::: "memory"); }
        } else if (pn < 12) {
#pragma unroll
            for (int ai = 0; ai < 2; ++ai)
#pragma unroll
                for (int m = 0; m < 4; ++m) { const unsigned row = row0 + ai * 128 + m * 16;
                    const int b = prompt_tile ? (int)(row >> 12) : (int)((row - MP) >> 3), t = prompt_tile ? (int)(row & 4095) : (int)((row - MP) & 7), idx = prompt_tile ? t - (TP - 3) : t - (TS - 3);
#pragma unroll
                    for (int bj = 0; bj < 2; ++bj) { const pg8::f32x4 a = acc[ai][bj][m][0], b2 = acc[ai][bj][m][1]; const unsigned ch = (unsigned)((pn - 6) * 256 + bj * 128 + c0);
                        st16(DNRAW, (row * 1536u + ch) * 2u, pack8(a, b2));
                        if (idx >= 0) { float* o = prompt_tile ? out + O_DCP : out + O_DCS; const unsigned eo = ((unsigned)(b * 3 + idx) * 1536u + ch) * 4u; st16f(o, eo, a); st16f(o, eo + 16u, b2); } }
                    asm volatile("" ::: "memory"); }
        } else {
#pragma unroll
            for (int ai = 0; ai < 2; ++ai)
#pragma unroll
                for (int m = 0; m < 4; ++m) { const unsigned row = row0 + ai * 128 + m * 16;
#pragma unroll
                    for (int bj = 0; bj < 2; ++bj) { pg8::f32x4 a = acc[ai][bj][m][0], b = acc[ai][bj][m][1]; const unsigned e = row * DNW + (unsigned)((pn - 12) * 256 + bj * 128 + c0);
                        a[0] = siluf(a[0]); a[1] = siluf(a[1]); a[2] = siluf(a[2]); a[3] = siluf(a[3]); b[0] = siluf(b[0]); b[1] = siluf(b[1]); b[2] = siluf(b[2]); b[3] = siluf(b[3]);
                        st16(ZG, e * 2u, pack8(a, b)); }
                    asm volatile("" ::: "memory"); }
        }
    }
};

__device__ __forceinline__ void mod_tile(const Args& A, LAS unsigned char* lds, int ct, int wave, int lane) {
    const float* w_ada = (const float*)A.in[I_WADA]; const float* b_ada = (const float*)A.in[I_BADA];
    const float* cp = (const float*)A.in[I_CP]; const float* cs = (const float*)A.in[I_CS]; float* MOD = (float*)(A.ws + WS_MOD);
    const int lr = lane & 15, q = lane >> 4, col = ct * 16 + lr;
    pg8::f32x4 acc[9];
#pragma unroll
    for (int i = 0; i < 9; ++i) acc[i] = (pg8::f32x4){0.f, 0.f, 0.f, 0.f};
#pragma unroll
    for (int s4 = 0; s4 < 4; ++s4) {
        const int k0 = 128 * wave + 32 * s4 + 8 * q;
        const float* wp = w_ada + (size_t)k0 * NMOD + col;
        float w[8];
#pragma unroll
        for (int j = 0; j < 8; ++j) w[j] = wp[(size_t)j * NMOD];
        u32x4 bw; bw.x = cvtpk(w[0], w[1]); bw.y = cvtpk(w[2], w[3]); bw.z = cvtpk(w[4], w[5]); bw.w = cvtpk(w[6], w[7]);
        const bf16x8 bfr = __builtin_bit_cast(bf16x8, bw);
#pragma unroll
        for (int i = 0; i < 9; ++i) { const int row = 16 * i + lr;
            f32x4 c0 = (f32x4){0.f, 0.f, 0.f, 0.f}, c1 = c0;
            if (row < NC) { const float* crow_ = (row < BP ? cp + (size_t)row * D : cs + (size_t)(row - BP) * D) + k0; c0 = *(const f32x4*)crow_; c1 = *(const f32x4*)(crow_ + 4); }
            c0.x = siluf(c0.x); c0.y = siluf(c0.y); c0.z = siluf(c0.z); c0.w = siluf(c0.w); c1.x = siluf(c1.x); c1.y = siluf(c1.y); c1.z = siluf(c1.z); c1.w = siluf(c1.w);
            acc[i] = __builtin_amdgcn_mfma_f32_16x16x32_bf16(__builtin_bit_cast(bf16x8, pack8(c0, c1)), bfr, acc[i], 0, 0, 0); }
    }
    LAS pg8::f32x4* red = (LAS pg8::f32x4*)lds;
#pragma unroll
    for (int i = 0; i < 9; ++i) red[(wave * 9 + i) * 64 + lane] = acc[i];
    __syncthreads();
    for (int i = wave; i < 9; i += 8) {
        pg8::f32x4 t = red[i * 64 + lane];
#pragma unroll
        for (int w2 = 1; w2 < 8; ++w2) t += red[(w2 * 9 + i) * 64 + lane];
        const float bb = b_ada[col];
#pragma unroll
        for (int r = 0; r < 4; ++r) { const int row = 16 * i + 4 * q + r; if (row < NC) MOD[(size_t)row * NMOD + col] = t[r] + bb; }
    }
    __syncthreads();
}
__device__ __forceinline__ void transpose_item(const float* W, int ldw, int src_col0, bf16* WT, int Kdst, int dst_row0, int k0, LAS float* scr, int lane) {
#pragma unroll
    for (int h2 = 0; h2 < 2; ++h2) { float v[16];
#pragma unroll
        for (int i = 0; i < 16; ++i) v[i] = W[(size_t)(k0 + 2 * (16 * h2 + i) + (lane >> 5)) * ldw + src_col0 + (lane & 31)];
#pragma unroll
        for (int i = 0; i < 16; ++i) scr[(2 * (16 * h2 + i) + (lane >> 5)) * 33 + (lane & 31)] = v[i]; }
    asm volatile("s_waitcnt lgkmcnt(0)" ::: "memory");
    const int c = lane & 7;
#pragma unroll
    for (int j = 0; j < 4; ++j) { const int n = (lane >> 3) + 8 * j; const LAS float* s = scr + (8 * c) * 33 + n;
        u32x4 o; o.x = cvtpk(s[0 * 33], s[1 * 33]); o.y = cvtpk(s[2 * 33], s[3 * 33]); o.z = cvtpk(s[4 * 33], s[5 * 33]); o.w = cvtpk(s[6 * 33], s[7 * 33]);
        *(u32x4*)(WT + (size_t)(dst_row0 + n) * Kdst + k0 + 8 * c) = o; }
    asm volatile("s_waitcnt lgkmcnt(0)" ::: "memory");
}
__device__ __forceinline__ void phase_prologue(const Args& A, LAS unsigned char* lds, gu32* qhead, int bx, int G, int wave, int lane, int gtid, int NGT) {
    unsigned char* ws = A.ws;
    const float* w_in = (const float*)A.in[I_WIN]; const float* w_out = (const float*)A.in[I_WOUT]; const float* w_up = (const float*)A.in[I_WUP]; const float* w_dn = (const float*)A.in[I_WDN];
    float* WX = (float*)(ws + WS_WINX);
    for (int i = gtid; i < 8 * D; i += NGT) { const int j = i >> 10, k = i & 1023; WX[i] = w_in[(size_t)k * IN_COLS + 3072 + j]; }
    for (int ct = bx; ct < NMOD / 16; ct += G) mod_tile(A, lds, ct, wave, lane);
    LAS float* scr = (LAS float*)(lds + wave * 16384);
    constexpr int I_IN = 16 * (NPROJ / 32), I_OUT = 16 * 32, I_UP = 16 * (DFF2 / 32), I_DN = (DFF / 64) * 32, NIT = I_IN + I_OUT + I_UP + I_DN;
    for (int it_ = bx * 8 + wave; it_ < NIT; it_ += G * 8) {
        int r = it_;
        if (r < I_IN) { const int nb = r % (NPROJ / 32), kb = r / (NPROJ / 32); const int n0 = nb * 32; transpose_item(w_in, IN_COLS, n0 < 3072 ? n0 : n0 + 8, (bf16*)(ws + WS_WIN_T), D, n0, kb * 64, scr, lane); continue; } r -= I_IN;
        if (r < I_OUT) { const int nb = r % 32, kb = r / 32; transpose_item(w_out, D, nb * 32, (bf16*)(ws + WS_WOUT_T), D, nb * 32, kb * 64, scr, lane); continue; } r -= I_OUT;
        if (r < I_UP) { const int nb = r % (DFF2 / 32), kb = r / (DFF2 / 32); transpose_item(w_up, DFF2, nb * 32, (bf16*)(ws + WS_WUP_T), D, nb * 32, kb * 64, scr, lane); continue; } r -= I_UP;
        { const int nb = r % 32, kb = r / 32; transpose_item(w_dn, D, nb * 32, (bf16*)(ws + WS_WDN_T), DFF, nb * 32, kb * 64, scr, lane); }
    }
}

template <bool EXTRAS>
__device__ __forceinline__ void phase_norm(const float* x0, const float* x1, const float* g, const float* MOD, int sh_off, int sc_off, bf16* H, const float* WX, float* EXTRA, int gw, int NGW, int lane) {
    for (int m = gw; m < M; m += NGW) {
        const float* xr = m < MP ? x0 + (size_t)m * D : x1 + (size_t)(m - MP) * D;
        const float* mod = MOD + (size_t)mod_row(m) * NMOD;
        f32x4 v[4]; float ss = 0.f;
#pragma unroll
        for (int j = 0; j < 4; ++j) { v[j] = *(const f32x4*)(xr + 4 * (lane + 64 * j)); ss += (v[j].x * v[j].x + v[j].y * v[j].y) + (v[j].z * v[j].z + v[j].w * v[j].w); }
        ss = wave_sum(ss);
        const float rstd = 1.0f / sqrtf(ss * (1.f / D) + EPS);
        float ex[8];
#pragma unroll
        for (int e = 0; e < 8; ++e) ex[e] = 0.f;
#pragma unroll
        for (int j = 0; j < 4; ++j) { const int c = 4 * (lane + 64 * j);
            const f32x4 gg = *(const f32x4*)(g + c), sc = *(const f32x4*)(mod + sc_off + c), sh = *(const f32x4*)(mod + sh_off + c);
            const f32x4 h = (v[j] * rstd) * gg * (sc + 1.0f) + sh;
            u32x2 w; w.x = cvtpk(h.x, h.y); w.y = cvtpk(h.z, h.w); *(u32x2*)(H + (size_t)m * D + c) = w;
            if (EXTRAS) {
#pragma unroll
                for (int e = 0; e < 8; ++e) { const f32x4 wx = *(const f32x4*)(WX + e * D + c); ex[e] += (h.x * wx.x + h.y * wx.y) + (h.z * wx.z + h.w * wx.w); }
            }
        }
        if (EXTRAS) {
#pragma unroll
            for (int e = 0; e < 8; ++e) ex[e] = wave_sum(ex[e]);
            float mine = ex[0];
#pragma unroll
            for (int e = 1; e < 8; ++e) mine = (lane == e) ? ex[e] : mine;
            if (lane < 8) EXTRA[(size_t)m * 8 + lane] = mine;
        }
    }
}

__device__ __forceinline__ f32x4 bf4lo(u32x4 w) { return (f32x4){__uint_as_float(w.x << 16), __uint_as_float(w.x & 0xffff0000u), __uint_as_float(w.y << 16), __uint_as_float(w.y & 0xffff0000u)}; }
__device__ __forceinline__ f32x4 bf4hi(u32x4 w) { return (f32x4){__uint_as_float(w.z << 16), __uint_as_float(w.z & 0xffff0000u), __uint_as_float(w.w << 16), __uint_as_float(w.w & 0xffff0000u)}; }
__device__ __forceinline__ void post_strip(const Args& A, int m0, int R, int part, int lane) {
    unsigned char* ws = A.ws; const bf16* DNRAW = (const bf16*)(ws + WS_DNRAW);
    const float* wc = (const float*)A.in[I_WDNC]; const float* sdc = (const float*)A.in[I_SDC];
    float* dstb = (part == 0 ? (float*)(ws + WS_QD) : part == 1 ? (float*)(ws + WS_KD) : (float*)(ws + WS_VD));
    const bool prompt = m0 < MP; const int b = prompt ? (m0 >> 12) : ((m0 - MP) >> 3), t0 = prompt ? (m0 & 4095) : ((m0 - MP) & 7);
    const int ch = part * 512 + 8 * lane;
    f32x4 w[4][2];
#pragma unroll
    for (int i = 0; i < 4; ++i) { w[i][0] = *(const f32x4*)(wc + i * 1536 + ch); w[i][1] = *(const f32x4*)(wc + i * 1536 + ch + 4); }
    f32x4 x[3][2];
#pragma unroll
    for (int j = 0; j < 3; ++j) { const int tt = t0 - 3 + j;
        if (tt >= 0) { const u32x4 r = *(const u32x4*)(DNRAW + (size_t)(m0 - 3 + j) * 1536 + ch); x[j][0] = bf4lo(r); x[j][1] = bf4hi(r); }
        else if (!prompt) { const float* p = sdc + ((size_t)b * 3 + (3 + tt)) * 1536 + ch; x[j][0] = *(const f32x4*)p; x[j][1] = *(const f32x4*)(p + 4); }
        else { x[j][0] = (f32x4){0.f, 0.f, 0.f, 0.f}; x[j][1] = x[j][0]; } }
    const bf16* src = DNRAW + (size_t)m0 * 1536 + ch;
    u32x4 nx = *(const u32x4*)src;
    for (int r = 0; r < R; ++r) {
        const u32x4 cw = nx;
        if (r + 1 < R) nx = *(const u32x4*)(src + (size_t)(r + 1) * 1536);
        const f32x4 c0 = bf4lo(cw), c1 = bf4hi(cw);
        f32x4 y0 = w[0][0] * x[0][0] + w[1][0] * x[1][0] + w[2][0] * x[2][0] + w[3][0] * c0;
        f32x4 y1 = w[0][1] * x[0][1] + w[1][1] * x[1][1] + w[2][1] * x[2][1] + w[3][1] * c1;
        x[0][0] = x[1][0]; x[0][1] = x[1][1]; x[1][0] = x[2][0]; x[1][1] = x[2][1]; x[2][0] = c0; x[2][1] = c1;
        y0.x = siluf(y0.x); y0.y = siluf(y0.y); y0.z = siluf(y0.z); y0.w = siluf(y0.w); y1.x = siluf(y1.x); y1.y = siluf(y1.y); y1.z = siluf(y1.z); y1.w = siluf(y1.w);
        if (part < 2) {
            float ss = (y0.x * y0.x + y0.y * y0.y) + (y0.z * y0.z + y0.w * y0.w) + (y1.x * y1.x + y1.y * y1.y) + (y1.z * y1.z + y1.w * y1.w);
            ss += __shfl_xor(ss, 1); ss += __shfl_xor(ss, 2); ss += __shfl_xor(ss, 4); ss += __shfl_xor(ss, 8);
            const float rs = (part == 0 ? 0.08838834764831845f : 1.0f) / sqrtf(ss + EPS);
            y0 = y0 * rs; y1 = y1 * rs;
        }
        float* dst = dstb + (size_t)(m0 + r) * DNW + 8 * lane;
        *(f32x4*)dst = y0; *(f32x4*)(dst + 4) = y1;
    }
}
__device__ __forceinline__ void phase_post(const Args& A, int gw, int NGW, int lane, int gtid, int NGT) {
    constexpr int NPI = (MP / 16) * 3, NSI = BS * 3;
    for (int it = gw; it < NPI + NSI; it += NGW) {
        if (it < NPI) post_strip(A, (it / 3) * 16, 16, it % 3, lane);
        else { const int j = it - NPI; post_strip(A, MP + (j / 3) * 8, 8, j % 3, lane); }
    }
    unsigned char* ws = A.ws; const float* a_log = (const float*)A.in[I_ALOG]; const float* dtb = (const float*)A.in[I_DTB];
    float* BETA = (float*)(ws + WS_BETA); float* LOGA = (float*)(ws + WS_LOGA); const float* EXTRA = (const float*)(ws + WS_EXTRA);
    for (int i = gtid; i < M * 8; i += NGT) { const int m = i >> 3, j = i & 7; const float x = EXTRA[i];
        if (j < 4) BETA[m * 4 + j] = 1.f / (1.f + __expf(-x));
        else { const int h = j - 4; const float z = x + dtb[h]; const float sp = fmaxf(z, 0.f) + log1pf(__expf(-fabsf(z))); LOGA[m * 4 + h] = -__expf(a_log[h]) * sp; } }
}

template <int B0, int B1> __device__ __forceinline__ void subst_rows(float (&x)[64], const LAS float* Am) {
#pragma unroll
    for (int ib = B0; ib < B1; ++ib) {
        float r[4];
#pragma unroll
        for (int rr = 0; rr < 4; ++rr) r[rr] = x[4 * ib + rr];
#pragma unroll
        for (int j4 = 0; j4 < ib; ++j4) {
#pragma unroll
            for (int rr = 0; rr < 4; ++rr) { const f32x4 a = *(const LAS f32x4*)(Am + (4 * ib + rr) * 64 + 4 * j4);
                r[rr] -= (a.x * x[4 * j4] + a.y * x[4 * j4 + 1]) + (a.z * x[4 * j4 + 2] + a.w * x[4 * j4 + 3]); }
        }
        const f32x4 d1 = *(const LAS f32x4*)(Am + (4 * ib + 1) * 64 + 4 * ib), d2 = *(const LAS f32x4*)(Am + (4 * ib + 2) * 64 + 4 * ib), d3 = *(const LAS f32x4*)(Am + (4 * ib + 3) * 64 + 4 * ib);
        r[1] -= d1.x * r[0];
        r[2] -= d2.x * r[0] + d2.y * r[1];
        r[3] -= (d3.x * r[0] + d3.y * r[1]) + d3.z * r[2];
#pragma unroll
        for (int rr = 0; rr < 4; ++rr) x[4 * ib + rr] = r[rr];
    }
}
constexpr int PS_INT = 34816, PS_STG = 53248;
template <int LEVEL = 0>
__device__ __forceinline__ void dn_prescan_unit(const Args& A, LAS unsigned char* lds, int unit, int tid, int wave, int lane) {
    unsigned char* ws = A.ws;
    const float* QD = (const float*)(ws + WS_QD); const float* KD = (const float*)(ws + WS_KD); const float* VD = (const float*)(ws + WS_VD);
    const float* BETA = (const float*)(ws + WS_BETA); const float* LOGA = (const float*)(ws + WS_LOGA);
    const int hp = unit & 1, n = (unit >> 1) & 63, b = unit >> 7;
    const int half = tid >> 8, ht = tid & 255, h = 2 * hp + half, item = (b * 64 + n) * 4 + h;
    const int m0 = b * TP + n * 64;
    LAS float* Am = (LAS float*)lds + half * 4096;
    LAS float* gs = (LAS float*)(lds + 32768) + half * 128;
    if (ht < 64) {
        float v = LOGA[(size_t)(m0 + ht) * 4 + h];
#pragma unroll
        for (int o = 1; o < 64; o <<= 1) { const float u = __shfl_up(v, o); if (ht >= o) v += u; }
        gs[ht] = v; gs[64 + ht] = BETA[(size_t)(m0 + ht) * 4 + h];
    }
    __syncthreads();
    {
        const int wl = wave & 3, lr = lane & 15, q = lane >> 4;
        pg8::f32x4 kk[4], qk[4];
#pragma unroll
        for (int j = 0; j < 4; ++j) { kk[j] = (pg8::f32x4){0.f, 0.f, 0.f, 0.f}; qk[j] = kk[j]; }
#pragma unroll
        for (int s = 0; s < 4; ++s) {
            const float* kp = KD + (size_t)(m0 + 16 * wl + lr) * DNW + h * 128 + 32 * s + 8 * q; const float* qp = QD + (size_t)(m0 + 16 * wl + lr) * DNW + h * 128 + 32 * s + 8 * q;
            const bf16x8 ak = __builtin_bit_cast(bf16x8, pack8(*(const f32x4*)kp, *(const f32x4*)(kp + 4))), aq = __builtin_bit_cast(bf16x8, pack8(*(const f32x4*)qp, *(const f32x4*)(qp + 4)));
#pragma unroll
            for (int j = 0; j < 4; ++j) { const float* bp = KD + (size_t)(m0 + 16 * j + lr) * DNW + h * 128 + 32 * s + 8 * q;
                const bf16x8 bk = __builtin_bit_cast(bf16x8, pack8(*(const f32x4*)bp, *(const f32x4*)(bp + 4)));
                kk[j] = __builtin_amdgcn_mfma_f32_16x16x32_bf16(ak, bk, kk[j], 0, 0, 0); qk[j] = __builtin_amdgcn_mfma_f32_16x16x32_bf16(aq, bk, qk[j], 0, 0, 0); }
        }
#pragma unroll
        for (int j = 0; j < 4; ++j)
#pragma unroll
            for (int r = 0; r < 4; ++r) { const int i = 16 * wl + 4 * q + r, jj = 16 * j + lr;
                const float dec = (i >= jj) ? __expf(gs[i] - gs[jj]) : 0.f;
                Am[i * 64 + jj] = (i > jj) ? gs[64 + i] * kk[j][r] * dec : 0.f;
                *(LAS bf16*)(lds + PS_INT + half * 9216 + i * 144 + jj * 2) = f2bf(qk[j][r] * dec); }
    }
    __syncthreads();
    if constexpr (LEVEL == 1) { __syncthreads(); return; }
    {
        const int c = ht;
        float* U = (float*)(ws + WS_U) + (size_t)item * 8192; bf16* KC = (bf16*)(ws + WS_KCUM) + (size_t)item * 8192;
        float x[64];
        { const float* rsrc = (ht < 128 ? VD : KD) + (size_t)m0 * DNW + h * 128 + (ht & 127);
#pragma unroll
          for (int i = 0; i < 64; ++i) x[i] = rsrc[(size_t)i * DNW]; }
#pragma unroll
        for (int i = 0; i < 64; ++i) { const float eg = __expf(gs[i]); x[i] *= gs[64 + i] * (c >= 128 ? eg : 1.0f); }
        { bf16* INTRA = (bf16*)(ws + WS_INTRA) + (size_t)item * 4096;
#pragma unroll
          for (int j = 0; j < 2; ++j) { const int k = ht + 256 * j, row = k >> 3, c8 = (k & 7) * 8; *(u32x4*)(INTRA + row * 64 + c8) = *(const LAS u32x4*)(lds + PS_INT + half * 9216 + row * 144 + c8 * 2); } }
        subst_rows<0, 6>(x, Am); subst_rows<6, 10>(x, Am); subst_rows<10, 13>(x, Am); subst_rows<13, 16>(x, Am);
        if constexpr (LEVEL == 2) { float sk = 0.f; _Pragma("unroll") for (int i = 0; i < 64; ++i) sk += x[i]; asm volatile("" :: "v"(sk)); __syncthreads(); return; }
        LAS float* stg = (LAS float*)(lds + PS_STG + half * 33280);
#pragma unroll
        for (int ps = 0; ps < 2; ++ps) {
            if (ps) __syncthreads();
#pragma unroll
            for (int i = 0; i < 32; ++i) stg[i * 260 + c] = x[32 * ps + i];
            __syncthreads();
#pragma unroll
            for (int j = 0; j < 4; ++j) { const int k = ht + 256 * j, il = k >> 9, w_ = (k >> 6) & 7, ln = k & 63, rb = 16 * il + 4 * (ln >> 4), cc = 16 * w_ + (ln & 15);
                *(f32x4*)(U + (((2 * ps + il) * 8 + w_) * 64 + ln) * 4) = (f32x4){stg[rb * 260 + cc], stg[(rb + 1) * 260 + cc], stg[(rb + 2) * 260 + cc], stg[(rb + 3) * 260 + cc]}; }
#pragma unroll
            for (int j = 0; j < 2; ++j) { const int k = ht + 256 * j, row = k >> 4, c8 = (k & 15) * 8; const LAS float* sp = stg + row * 260 + 128 + c8;
                *(u32x4*)(KC + (32 * ps + row) * 128 + c8) = pack8(*(const LAS f32x4*)sp, *(const LAS f32x4*)(sp + 4)); }
        }
    }
    if constexpr (LEVEL == 3) { __syncthreads(); return; }
    {
        const float glast = gs[63];
        bf16* QDc = (bf16*)(ws + WS_QDEC) + (size_t)item * 8192; bf16* KT = (bf16*)(ws + WS_KDECT) + (size_t)item * 8192;
#pragma unroll
        for (int j = 0; j < 4; ++j) { const int k = ht + 256 * j, row = k >> 4, c8 = (k & 15) * 8; const float* qp = QD + (size_t)(m0 + row) * DNW + h * 128 + c8; const float eg = __expf(gs[row]);
            *(u32x4*)(QDc + row * 128 + c8) = pack8(*(const f32x4*)qp * eg, *(const f32x4*)(qp + 4) * eg); }
        { const int d = ht & 127, ig = ht >> 7;
#pragma unroll
            for (int i8 = 0; i8 < 4; ++i8) { float v[8];
#pragma unroll
                for (int k = 0; k < 8; ++k) { const int i = 32 * ig + 8 * i8 + k; v[k] = KD[(size_t)(m0 + i) * DNW + h * 128 + d] * __expf(glast - gs[i]); }
                u32x4 w; w.x = cvtpk(v[0], v[1]); w.y = cvtpk(v[2], v[3]); w.z = cvtpk(v[4], v[5]); w.w = cvtpk(v[6], v[7]);
                *(u32x4*)(KT + d * 64 + 32 * ig + 8 * i8) = w; } }
        if (ht == 0) ((float*)(ws + WS_GL))[item] = __expf(glast);
    }
    __syncthreads();
}
__device__ __forceinline__ void dn_sample_unit(const Args& A, LAS unsigned char* lds, int unit, int tid) {
    unsigned char* ws = A.ws;
    const float* QD = (const float*)(ws + WS_QD); const float* KD = (const float*)(ws + WS_KD); const float* VD = (const float*)(ws + WS_VD);
    const float* BETA = (const float*)(ws + WS_BETA); const float* LOGA = (const float*)(ws + WS_LOGA); float* ODN = (float*)(ws + WS_ODN);
    const int h = unit & 3, b = unit >> 2, e = tid & 127, dq = tid >> 7;
    const float* s0 = (const float*)A.in[I_SD] + ((size_t)(b * 4 + h) * 128 + 32 * dq) * 128 + e;
    float S[32];
#pragma unroll
    for (int d = 0; d < 32; ++d) S[d] = s0[(size_t)d * 128];
    LAS float* red = (LAS float*)lds; LAS float* red2 = red + 512; LAS float* tk = red + 1024;
#pragma unroll
    for (int j = 0; j < 6; ++j) { const int i = tid + 512 * j, t = i / 384, c = i % 384, part = c >> 7; const int m = MP + b * TS + t;
        const unsigned sel = part == 0 ? 1u : part == 1 ? 0u : 2u;
        tk[i] = QD[sel * (unsigned)((WS_KD - WS_QD) / 4) + (unsigned)m * DNW + h * 128 + (c & 127)]; }
    if (tid < 16) { const size_t m = (size_t)(MP + b * TS + (tid >> 1)); tk[3072 + tid] = (tid & 1) ? BETA[m * 4 + h] : __expf(LOGA[m * 4 + h]); }
    __syncthreads();
    for (int t = 0; t < TS; ++t) {
        const int m = MP + b * TS + t;
        const float a = tk[3072 + 2 * t], bt = tk[3072 + 2 * t + 1];
        const LAS float* kp = tk + t * 384 + 32 * dq; const LAS float* qp = kp + 128;
        float kd[32], qd[32];
#pragma unroll
        for (int d4 = 0; d4 < 8; ++d4) { const f32x4 kv = *(const LAS f32x4*)(kp + 4 * d4), qv = *(const LAS f32x4*)(qp + 4 * d4);
            kd[4 * d4] = kv.x; kd[4 * d4 + 1] = kv.y; kd[4 * d4 + 2] = kv.z; kd[4 * d4 + 3] = kv.w; qd[4 * d4] = qv.x; qd[4 * d4 + 1] = qv.y; qd[4 * d4 + 2] = qv.z; qd[4 * d4 + 3] = qv.w; }
        float p0 = 0.f, p1 = 0.f;
#pragma unroll
        for (int d = 0; d < 32; d += 2) { p0 += kd[d] * S[d]; p1 += kd[d + 1] * S[d + 1]; }
        red[dq * 128 + e] = p0 + p1;
        __syncthreads();
        const float kS = (red[e] + red[128 + e]) + (red[256 + e] + red[384 + e]);
        const float dl = bt * (tk[t * 384 + 256 + e] - a * kS);
        float po0 = 0.f, po1 = 0.f;
#pragma unroll
        for (int d = 0; d < 32; d += 2) { S[d] = a * S[d] + kd[d] * dl; po0 += qd[d] * S[d]; S[d + 1] = a * S[d + 1] + kd[d + 1] * dl; po1 += qd[d + 1] * S[d + 1]; }
        red2[dq * 128 + e] = po0 + po1;
        __syncthreads();
        if (dq == 0) ODN[(size_t)m * DNW + h * 128 + e] = (red2[e] + red2[128 + e]) + (red2[256 + e] + red2[384 + e]);
    }
    float* so = A.out + O_SS + ((size_t)(b * 4 + h) * 128 + 32 * dq) * 128 + e;
#pragma unroll
    for (int d = 0; d < 32; ++d) so[(size_t)d * 128] = S[d];
    __syncthreads();
}

constexpr int SC_KC = 0, SC_QD = 17408, SC_KT = 34816, SC_IN = 53248, SC_BUF = 62464;
__device__ __forceinline__ void dn_scan_chain(const Args& A, LAS unsigned char* lds, int chain, int tid, int wave, int lane) {
    unsigned char* ws = A.ws;
    const float* Ub = (const float*)(ws + WS_U); const float* GL = (const float*)(ws + WS_GL); float* ODN = (float*)(ws + WS_ODN);
    const int b = chain >> 2, h = chain & 3, lr = lane & 15, q = lane >> 4, e = 16 * wave + lr;
    int ldst[7];
    { const int c0 = tid, c1 = tid + 512;
      ldst[0] = SC_KC + (c0 >> 4) * 272; ldst[1] = SC_KC + (c1 >> 4) * 272; ldst[2] = SC_QD + (c0 >> 4) * 272; ldst[3] = SC_QD + (c1 >> 4) * 272;
      ldst[4] = SC_KT + (c0 >> 3) * 144; ldst[5] = SC_KT + (c1 >> 3) * 144; ldst[6] = SC_IN + (c0 >> 3) * 144; }
    const int cb_ = tid & 3, hA_ = (8 * ((2 * cb_) & 3) + 4 * (cb_ >> 1)) * 2, hB_ = (8 * ((2 * cb_ + 1) & 3) + 4 * (cb_ >> 1)) * 2;
    const int o16A = ((tid & 15) >> 2) * 64 + hA_, o16B = ((tid & 15) >> 2) * 64 + hB_, o8A = ((tid & 7) >> 2) * 64 + hA_, o8B = ((tid & 7) >> 2) * 64 + hB_;
    const size_t item0 = (size_t)(b * 64) * 4 + h;
    const unsigned char* gKC = ws + WS_KCUM + item0 * 16384; const unsigned char* gQD = ws + WS_QDEC + item0 * 16384; const unsigned char* gKT = ws + WS_KDECT + item0 * 16384; const unsigned char* gIN = ws + WS_INTRA + item0 * 8192;
    const unsigned t16 = (unsigned)tid * 16u, ulane = (unsigned)(wave * 64 + lane) * 4u;
    u32x4 R[7]; float un[16], uc[16];
#define SC_GLOAD(n_) do { const size_t o16_ = (size_t)(n_) * 4 * 16384, o8_ = (size_t)(n_) * 4 * 8192; \
        R[0] = *(const u32x4*)(gKC + o16_ + t16); R[1] = *(const u32x4*)(gKC + o16_ + 8192 + t16); R[2] = *(const u32x4*)(gQD + o16_ + t16); R[3] = *(const u32x4*)(gQD + o16_ + 8192 + t16); \
        R[4] = *(const u32x4*)(gKT + o16_ + t16); R[5] = *(const u32x4*)(gKT + o16_ + 8192 + t16); R[6] = *(const u32x4*)(gIN + o8_ + t16); \
        const float* U_ = Ub + (item0 + 4 * (size_t)(n_)) * 8192; \
        _Pragma("unroll") for (int i_ = 0; i_ < 4; ++i_) { const f32x4 u_ = *(const f32x4*)(U_ + (ulane + (unsigned)(i_ * 2048))); un[4 * i_] = u_.x; un[4 * i_ + 1] = u_.y; un[4 * i_ + 2] = u_.z; un[4 * i_ + 3] = u_.w; } } while (0)
#define SC_LWRITE(buf_) do { _Pragma("unroll") for (int k_ = 0; k_ < 7; ++k_) { LAS unsigned char* d_ = lds + (buf_) * SC_BUF + ldst[k_]; \
        *(LAS u32x2*)(d_ + (k_ < 4 ? o16A : o8A)) = (u32x2){R[k_].x, R[k_].y}; *(LAS u32x2*)(d_ + (k_ < 4 ? o16B : o8B)) = (u32x2){R[k_].z, R[k_].w}; } } while (0)
#define SC_BARRIER() do { asm volatile("s_waitcnt lgkmcnt(0)" ::: "memory"); __builtin_amdgcn_s_barrier(); asm volatile("" ::: "memory"); } while (0)
#define SC_FRAG(off_, pitch_, row_, s_) (*(const LAS bf16x8*)(B + (off_) + (row_) * (pitch_) + (32 * (s_) + 8 * q) * 2))
    pg8::f32x4 S[8];
#pragma unroll
    for (int i = 0; i < 8; ++i) S[i] = (pg8::f32x4){0.f, 0.f, 0.f, 0.f};
    const float glv = GL[item0 + 4 * (size_t)lane];
    __syncthreads();
    SC_GLOAD(0); SC_LWRITE(0);
#pragma unroll
    for (int k = 0; k < 16; ++k) uc[k] = un[k];
    __syncthreads();
    for (int n = 0; n < 64; ++n) {
        const float gl = __uint_as_float(__builtin_amdgcn_readlane(__float_as_uint(glv), n));
        if (n + 1 < 64) SC_GLOAD(n + 1);
        const LAS unsigned char* B = lds + (n & 1) * SC_BUF;
        bf16x8 Sb[4];
#pragma unroll
        for (int s = 0; s < 4; ++s) { u32x4 w; w.x = cvtpk(S[2 * s][0], S[2 * s][1]); w.y = cvtpk(S[2 * s][2], S[2 * s][3]); w.z = cvtpk(S[2 * s + 1][0], S[2 * s + 1][1]); w.w = cvtpk(S[2 * s + 1][2], S[2 * s + 1][3]); Sb[s] = __builtin_bit_cast(bf16x8, w); }
        pg8::f32x4 vn[4], o[4];
#pragma unroll
        for (int ih = 0; ih < 2; ++ih) {
            bf16x8 fk[2][4], fq[2][4];
#pragma unroll
            for (int ii = 0; ii < 2; ++ii)
#pragma unroll
                for (int s = 0; s < 4; ++s) { fk[ii][s] = SC_FRAG(SC_KC, 272, 16 * (2 * ih + ii) + lr, s); fq[ii][s] = SC_FRAG(SC_QD, 272, 16 * (2 * ih + ii) + lr, s); }
#pragma unroll
            for (int ii = 0; ii < 2; ++ii) { const int i = 2 * ih + ii;
                pg8::f32x4 ak = (pg8::f32x4){0.f, 0.f, 0.f, 0.f}, aq = ak;
#pragma unroll
                for (int s = 0; s < 4; ++s) { ak = __builtin_amdgcn_mfma_f32_16x16x32_bf16(fk[ii][s], Sb[s], ak, 0, 0, 0); aq = __builtin_amdgcn_mfma_f32_16x16x32_bf16(fq[ii][s], Sb[s], aq, 0, 0, 0); }
#pragma unroll
                for (int r = 0; r < 4; ++r) vn[i][r] = uc[4 * i + r] - ak[r];
                o[i] = aq; }
        }
        bf16x8 Vb[2];
#pragma unroll
        for (int s = 0; s < 2; ++s) { u32x4 w; w.x = cvtpk(vn[2 * s][0], vn[2 * s][1]); w.y = cvtpk(vn[2 * s][2], vn[2 * s][3]); w.z = cvtpk(vn[2 * s + 1][0], vn[2 * s + 1][1]); w.w = cvtpk(vn[2 * s + 1][2], vn[2 * s + 1][3]); Vb[s] = __builtin_bit_cast(bf16x8, w); }
        {
            bf16x8 fi[4][2], ft[8][2];
#pragma unroll
            for (int i = 0; i < 4; ++i)
#pragma unroll
                for (int s = 0; s < 2; ++s) fi[i][s] = SC_FRAG(SC_IN, 144, 16 * i + lr, s);
#pragma unroll
            for (int i = 0; i < 8; ++i)
#pragma unroll
                for (int s = 0; s < 2; ++s) ft[i][s] = SC_FRAG(SC_KT, 144, 16 * i + lr, s);
#pragma unroll
            for (int i = 0; i < 4; ++i) {
#pragma unroll
                for (int s = 0; s < 2; ++s) o[i] = __builtin_amdgcn_mfma_f32_16x16x32_bf16(fi[i][s], Vb[s], o[i], 0, 0, 0);
                *(f32x4*)(ODN + ((item0 + 4 * (size_t)n) * 8192) + (ulane + (unsigned)(i * 2048))) = (f32x4){o[i][0], o[i][1], o[i][2], o[i][3]};
            }
#pragma unroll
            for (int i = 0; i < 8; ++i) {
                pg8::f32x4 acc = S[i] * gl;
#pragma unroll
                for (int s = 0; s < 2; ++s) acc = __builtin_amdgcn_mfma_f32_16x16x32_bf16(ft[i][s], Vb[s], acc, 0, 0, 0);
                S[i] = acc;
            }
        }
        if (n + 1 < 64) {
            SC_LWRITE((n + 1) & 1);
#pragma unroll
            for (int k = 0; k < 16; ++k) uc[k] = un[k];
        }
        SC_BARRIER();
    }
#undef SC_GLOAD
#undef SC_LWRITE
#undef SC_FRAG
    float* so = A.out + O_SP + (size_t)(b * 4 + h) * 16384;
#pragma unroll
    for (int i = 0; i < 8; ++i)
#pragma unroll
        for (int r = 0; r < 4; ++r) so[(unsigned)((16 * i + 4 * q + r) * 128 + e)] = S[i][r];
}

__device__ __forceinline__ int crow(int r, int hi) { return (r & 3) + 8 * (r >> 2) + 4 * hi; }
__device__ __forceinline__ void sb_core(f32x16& p, float& carry, int hi) {
    float s[16];
#pragma unroll
    for (int r = 0; r < 16; ++r) { const float e = __builtin_amdgcn_exp2f(p[r]); s[r] = -__builtin_amdgcn_logf(1.0f + e); }
    float tt[4], uu[4];
#pragma unroll
    for (int i = 0; i < 4; ++i) { s[4 * i + 2] += s[4 * i + 3]; s[4 * i + 1] += s[4 * i + 2]; s[4 * i] += s[4 * i + 1]; tt[i] = s[4 * i]; }
#pragma unroll
    for (int i = 0; i < 4; ++i) uu[i] = __shfl_xor(tt[i], 32);
    const float w3 = tt[3] + uu[3], w2 = tt[2] + uu[2], w1 = tt[1] + uu[1], w0 = tt[0] + uu[0];
    float off[4];
    off[3] = carry; off[2] = carry + w3; off[1] = off[2] + w2; off[0] = off[1] + w1;
    carry = off[0] + w0;
    if (hi == 0) {
#pragma unroll
        for (int i = 0; i < 4; ++i) off[i] += uu[i];
    }
#pragma unroll
    for (int r = 0; r < 16; ++r) p[r] = __builtin_amdgcn_exp2f(p[r] + s[r] + off[r >> 2]);
}
__device__ __forceinline__ bf16x8 pack_p(const f32x16& p, int s) {
    u32x4 w; w.x = cvtpk(p[8 * s], p[8 * s + 1]); w.y = cvtpk(p[8 * s + 2], p[8 * s + 3]); w.z = cvtpk(p[8 * s + 4], p[8 * s + 5]); w.w = cvtpk(p[8 * s + 6], p[8 * s + 7]); return __builtin_bit_cast(bf16x8, w);
}
constexpr int AW_BYTES = 16384, AW_V = 0, VPI = 192, AW_K = 6144, KPI = 144, AW_Q = 6144;
__device__ __forceinline__ void read_vfrags(bf16x8 (&vf)[4], const LAS unsigned char* wl, int lane) {
    const int hi = lane >> 5;
    const LAS unsigned char* vb = wl + AW_V + (4 * hi + ((lane & 15) >> 2)) * VPI + (((lane >> 4) & 1) * 16 + (lane & 3) * 4) * 2;
#pragma unroll
    for (int dt = 0; dt < 2; ++dt) {
        const s16x4 t0 = __builtin_bit_cast(s16x4, __builtin_amdgcn_ds_read_tr16_b64_v4i16((LAS s16x4*)(vb + dt * 64)));
        const s16x4 t1 = __builtin_bit_cast(s16x4, __builtin_amdgcn_ds_read_tr16_b64_v4i16((LAS s16x4*)(vb + dt * 64 + 8 * VPI)));
        const s16x4 t2 = __builtin_bit_cast(s16x4, __builtin_amdgcn_ds_read_tr16_b64_v4i16((LAS s16x4*)(vb + dt * 64 + 16 * VPI)));
        const s16x4 t3 = __builtin_bit_cast(s16x4, __builtin_amdgcn_ds_read_tr16_b64_v4i16((LAS s16x4*)(vb + dt * 64 + 24 * VPI)));
        vf[2 * dt] = (bf16x8){t0[0], t0[1], t0[2], t0[3], t1[0], t1[1], t1[2], t1[3]}; vf[2 * dt + 1] = (bf16x8){t2[0], t2[1], t2[2], t2[3], t3[0], t3[1], t3[2], t3[3]};
    }
}
__device__ __forceinline__ void load_k_prompt(bf16x8 (&k)[4], const bf16* KB, int b, int h, int kv0, int r32, int hi) {
    const bf16* kp = KB + (size_t)(b * TP + kv0 + r32) * SBW + h * HD + 8 * hi;
#pragma unroll
    for (int d0 = 0; d0 < 4; ++d0) k[d0] = *(const bf16x8*)(kp + 16 * d0);
}
__device__ __forceinline__ void load_v_prompt(u32x4 (&v)[4], const bf16* VB, int b, int h, int kv0, int lane) {
    const bf16* vp = VB + (size_t)(b * TP + kv0 + (lane >> 3)) * SBW + h * HD + (lane & 7) * 8;
#pragma unroll
    for (int i = 0; i < 4; ++i) v[i] = *(const u32x4*)(vp + (size_t)(8 * i) * SBW);
}
__device__ __forceinline__ void write_v_lds(LAS unsigned char* wl, const u32x4 (&v)[4], int lane) {
#pragma unroll
    for (int i = 0; i < 4; ++i) *(LAS u32x4*)(wl + AW_V + (8 * i + (lane >> 3)) * VPI + (lane & 7) * 16) = v[i];
}
template <int MASK>
__device__ __forceinline__ void sb_qk(f32x16& p, const bf16x8 (&kf)[4], const bf16x8 (&qf)[4], float bias2, int kv0, int qpos, int hi) {
#pragma unroll
    for (int r = 0; r < 16; ++r) p[r] = bias2;
#pragma unroll
    for (int d0 = 0; d0 < 4; ++d0) p = __builtin_amdgcn_mfma_f32_32x32x16_bf16(kf[d0], qf[d0], p, 0, 0, 0);
    if (MASK) {
#pragma unroll
        for (int r = 0; r < 16; ++r) if (kv0 + crow(r, hi) >= qpos) p[r] = -INFINITY;
    }
}
__device__ __forceinline__ void sb_pvonly(const f32x16& p, const bf16x8 (&vf)[4], f32x16 (&o)[2]) {
    const bf16x8 p0 = pack_p(p, 0), p1 = pack_p(p, 1);
#pragma unroll
    for (int dt = 0; dt < 2; ++dt) { o[dt] = __builtin_amdgcn_mfma_f32_32x32x16_bf16(vf[2 * dt], p0, o[dt], 0, 0, 0); o[dt] = __builtin_amdgcn_mfma_f32_32x32x16_bf16(vf[2 * dt + 1], p1, o[dt], 0, 0, 0); }
}
__device__ __forceinline__ void sb_pv(f32x16& p, const bf16x8 (&vf)[4], f32x16 (&o)[2], float& carry, int hi) {
    sb_core(p, carry, hi);
    const bf16x8 p0 = pack_p(p, 0), p1 = pack_p(p, 1);
#pragma unroll
    for (int dt = 0; dt < 2; ++dt) { o[dt] = __builtin_amdgcn_mfma_f32_32x32x16_bf16(vf[2 * dt], p0, o[dt], 0, 0, 0); o[dt] = __builtin_amdgcn_mfma_f32_32x32x16_bf16(vf[2 * dt + 1], p1, o[dt], 0, 0, 0); }
}
template <int MASK>
__device__ __forceinline__ void sb_tile(const bf16x8 (&kf)[4], const bf16x8 (&vf)[4], const bf16x8 (&qf)[4], float bias2, f32x16 (&o)[2], float& carry, int kv0, int qpos, int hi) {
    f32x16 p; sb_qk<MASK>(p, kf, qf, bias2, kv0, qpos, hi); sb_pv(p, vf, o, carry, hi);
}
__device__ __forceinline__ void sb_store_prompt(const Args& A, const f32x16 (&o)[2], int b, int h, int qpos, int hi) {
    float ss = 0.f;
#pragma unroll
    for (int dt = 0; dt < 2; ++dt)
#pragma unroll
        for (int r = 0; r < 16; ++r) ss += o[dt][r] * o[dt][r];
    ss += __shfl_xor(ss, 32);
    const float rs = 1.0f / sqrtf(ss * (1.f / HD) + EPS);
    const float* gso = (const float*)A.in[I_GSBO];
    bf16* op = (bf16*)(A.ws + WS_MIXED) + (size_t)(b * TP + qpos) * D + h * HD;
#pragma unroll
    for (int dt = 0; dt < 2; ++dt)
#pragma unroll
        for (int g = 0; g < 4; ++g) { const int d = 32 * dt + 8 * g + 4 * hi; const f32x4 gg = *(const f32x4*)(gso + d);
            u32x2 w; w.x = cvtpk(o[dt][4 * g] * rs * gg.x, o[dt][4 * g + 1] * rs * gg.y); w.y = cvtpk(o[dt][4 * g + 2] * rs * gg.z, o[dt][4 * g + 3] * rs * gg.w); *(u32x2*)(op + d) = w; }
}
__device__ __forceinline__ void attn_prompt_item(const Args& A, LAS unsigned char* wl, int b, int h, int q0, int lane) {
    unsigned char* ws = A.ws;
    const bf16* QB = (const bf16*)(ws + WS_QB); const bf16* KB = (const bf16*)(ws + WS_KB); const bf16* VB = (const bf16*)(ws + WS_VB);
    const int r32 = lane & 31, hi = lane >> 5, qa = q0 + r32, qb = q0 + 32 + r32;
    const float bias2 = ((const float*)A.in[I_SBB])[h] * LOG2E;
#pragma unroll
    for (int d0 = 0; d0 < 4; ++d0) { *(LAS bf16x8*)(wl + AW_Q + (d0 * 64 + lane) * 16) = *(const bf16x8*)(QB + (size_t)(b * TP + qa) * SBW + h * HD + 16 * d0 + 8 * hi);
        *(LAS bf16x8*)(wl + AW_Q + 4096 + (d0 * 64 + lane) * 16) = *(const bf16x8*)(QB + (size_t)(b * TP + qb) * SBW + h * HD + 16 * d0 + 8 * hi); }
#define QFA_LOAD bf16x8 qfa[4]; _Pragma("unroll") for (int d0_ = 0; d0_ < 4; ++d0_) qfa[d0_] = *(const LAS bf16x8*)(wl + AW_Q + (d0_ * 64 + lane) * 16);
#define QFB_LOAD bf16x8 qfb[4]; _Pragma("unroll") for (int d0_ = 0; d0_ < 4; ++d0_) qfb[d0_] = *(const LAS bf16x8*)(wl + AW_Q + 4096 + (d0_ * 64 + lane) * 16);
    f32x16 oa[2], ob[2]; oa[0] = (f32x16){}; oa[1] = (f32x16){}; ob[0] = (f32x16){}; ob[1] = (f32x16){};
    float ca = 0.f, cb = 0.f;
    bf16x8 kc[4], vf[4]; u32x4 vr[4];
    const int top = (q0 >> 5) + 1;
    load_k_prompt(kc, KB, b, h, 32 * top, r32, hi); load_v_prompt(vr, VB, b, h, 32 * top, lane);
    { write_v_lds(wl, vr, lane); load_v_prompt(vr, VB, b, h, 32 * (top - 1), lane);
      f32x16 p; { QFB_LOAD sb_qk<1>(p, kc, qfb, bias2, 32 * top, qb, hi); }
      load_k_prompt(kc, KB, b, h, 32 * (top - 1), r32, hi);
      read_vfrags(vf, wl, lane);
      sb_pv(p, vf, ob, cb, hi); }
    { write_v_lds(wl, vr, lane); if (top >= 2) load_v_prompt(vr, VB, b, h, 32 * (top - 2), lane);
      f32x16 p; { QFA_LOAD sb_qk<1>(p, kc, qfa, bias2, 32 * (top - 1), qa, hi); }
      read_vfrags(vf, wl, lane);
      sb_pv(p, vf, oa, ca, hi);
      { QFB_LOAD sb_qk<0>(p, kc, qfb, bias2, 0, 0, hi); }
      if (top >= 2) load_k_prompt(kc, KB, b, h, 32 * (top - 2), r32, hi);
      sb_pv(p, vf, ob, cb, hi); }
    for (int ht = top - 2; ht >= 0; --ht) {
        write_v_lds(wl, vr, lane);
        f32x16 p, p2; { QFA_LOAD sb_qk<0>(p, kc, qfa, bias2, 0, 0, hi); } { QFB_LOAD sb_qk<0>(p2, kc, qfb, bias2, 0, 0, hi); }
        if (ht > 0) load_k_prompt(kc, KB, b, h, 32 * (ht - 1), r32, hi);
        read_vfrags(vf, wl, lane);
        sb_core(p, ca, hi); sb_pvonly(p, vf, oa);
        __builtin_amdgcn_sched_barrier(0);
        if (ht > 0) load_v_prompt(vr, VB, b, h, 32 * (ht - 1), lane);
        sb_core(p2, cb, hi); sb_pvonly(p2, vf, ob);
    }
    sb_store_prompt(A, oa, b, h, qa, hi); sb_store_prompt(A, ob, b, h, qb, hi);
#undef QFA_LOAD
#undef QFB_LOAD
}

__device__ __forceinline__ void load_raw_sample(f32x4 (&r)[8], const float* c, size_t base, int h, int lane) {
    const float* p = c + base + (size_t)(lane >> 4) * 512 + h * HD + (lane & 15) * 4;
#pragma unroll
    for (int i = 0; i < 8; ++i) r[i] = *(const f32x4*)(p + (size_t)(4 * i) * 512);
}
__device__ __forceinline__ void write_raw_sample(LAS unsigned char* wl, int off, int pitch, const f32x4 (&r)[8], int lane) {
#pragma unroll
    for (int i = 0; i < 8; ++i) { const int row = 4 * i + (lane >> 4); u32x2 w; w.x = cvtpk(r[i].x, r[i].y); w.y = cvtpk(r[i].z, r[i].w); *(LAS u32x2*)(wl + off + row * pitch + (lane & 15) * 8) = w; }
}
__device__ __forceinline__ void read_kfrags(bf16x8 (&kf)[4], const LAS unsigned char* wl, int r32, int hi) {
#pragma unroll
    for (int d0 = 0; d0 < 4; ++d0) kf[d0] = *(const LAS bf16x8*)(wl + AW_K + r32 * KPI + (16 * d0 + 8 * hi) * 2);
}
__device__ __forceinline__ void attn_sample_store(const Args& A, int b, int h, int part, int lane, const f32x16 (&o)[2], float carry) {
    float* OP = (float*)(A.ws + WS_OPART) + (size_t)((b * SBH + h) * NPART + part) * 512; float* LP = (float*)(A.ws + WS_LPART) + (size_t)((b * SBH + h) * NPART + part) * 8;
    const int r32 = lane & 31, hi = lane >> 5;
    if (r32 < 8) {
#pragma unroll
        for (int dt = 0; dt < 2; ++dt)
#pragma unroll
            for (int g = 0; g < 4; ++g) *(f32x4*)(OP + r32 * 64 + 32 * dt + 8 * g + 4 * hi) = (f32x4){o[dt][4 * g], o[dt][4 * g + 1], o[dt][4 * g + 2], o[dt][4 * g + 3]};
        if (hi == 0) LP[r32] = carry;
    }
}
__device__ __forceinline__ void attn_sample_job(const Args& A, LAS unsigned char* wl, int b, int h, int sp, int lane) {
    unsigned char* ws = A.ws;
    const int r32 = lane & 31, hi = lane >> 5;
    const float* ck = (const float*)A.in[I_CK]; const float* cv = (const float*)A.in[I_CV]; const int* pt = (const int*)A.in[I_PT] + b * NPAGES;
    const bf16* QB = (const bf16*)(ws + WS_QB);
    const float bias2 = ((const float*)A.in[I_SBB])[h] * LOG2E;
    bf16x8 qf[4];
#pragma unroll
    for (int d0 = 0; d0 < 4; ++d0) { qf[d0] = (bf16x8){0, 0, 0, 0, 0, 0, 0, 0}; if (r32 < TS) qf[d0] = *(const bf16x8*)(QB + (size_t)(MP + b * TS + r32) * SBW + h * HD + 16 * d0 + 8 * hi); }
    f32x16 o[2]; float carry;
    bf16x8 kf[4], vf[4];
    const int tok_hi = (PAST / NSPLIT) * (sp + 1);
    constexpr int NT = PAST / NSPLIT / 32;
    f32x4 rk[8], rv[8];
#define SAMPLE_BASE(j) (((size_t)pt[(tok_hi - 32 * ((j) + 1)) >> 7] * PAGE + ((tok_hi - 32 * ((j) + 1)) & 127)) * 512)
    if (sp == NSPLIT - 1) {
        const bf16* KBn = (const bf16*)(ws + WS_KB) + (size_t)(MP + b * TS) * SBW + h * HD;
#pragma unroll
        for (int d0 = 0; d0 < 4; ++d0) { kf[d0] = (bf16x8){0, 0, 0, 0, 0, 0, 0, 0}; if (r32 < TS) kf[d0] = *(const bf16x8*)(KBn + (size_t)r32 * SBW + 16 * d0 + 8 * hi); }
        u32x4 vr[4];
        vr[0] = *(const u32x4*)((const bf16*)(ws + WS_VB) + (size_t)(MP + b * TS + (lane >> 3)) * SBW + h * HD + (lane & 7) * 8);
        vr[1] = (u32x4){0u, 0u, 0u, 0u}; vr[2] = vr[1]; vr[3] = vr[1];
        write_v_lds(wl, vr, lane);
        read_vfrags(vf, wl, lane);
        o[0] = (f32x16){}; o[1] = (f32x16){}; carry = 0.f;
        sb_tile<1>(kf, vf, qf, bias2, o, carry, 0, r32, hi);
        attn_sample_store(A, b, h, NPART - 1, lane, o, carry);
    }
    load_raw_sample(rk, ck, SAMPLE_BASE(0), h, lane); load_raw_sample(rv, cv, SAMPLE_BASE(0), h, lane);
    o[0] = (f32x16){}; o[1] = (f32x16){}; carry = 0.f;
    for (int j = 0; j < NT; ++j) {
        write_raw_sample(wl, AW_K, KPI, rk, lane); write_raw_sample(wl, AW_V, VPI, rv, lane);
        if (j + 1 < NT) load_raw_sample(rk, ck, SAMPLE_BASE(j + 1), h, lane);
        read_kfrags(kf, wl, r32, hi); read_vfrags(vf, wl, lane);
        f32x16 p; sb_qk<0>(p, kf, qf, bias2, 0, 0, hi);
        sb_core(p, carry, hi);
        __builtin_amdgcn_sched_barrier(0);
        if (j + 1 < NT) load_raw_sample(rv, cv, SAMPLE_BASE(j + 1), h, lane);
        sb_pvonly(p, vf, o);
    }
#undef SAMPLE_BASE
    attn_sample_store(A, b, h, sp, lane, o, carry);
}

__device__ __forceinline__ void phase_outnorm(const Args& A, int gw, int NGW, int lane) {
    unsigned char* ws = A.ws; const float* ODN = (const float*)(ws + WS_ODN); bf16* MIXED = (bf16*)(ws + WS_MIXED);
    const float* gdn = (const float*)A.in[I_GDNO]; const float* gso = (const float*)A.in[I_GSBO];
    const float* OPb = (const float*)(ws + WS_OPART); const float* LPb = (const float*)(ws + WS_LPART);
    const int c8 = 8 * lane;
    for (int m = gw; m < M; m += NGW) {
        {
            f32x4 a0, a1;
            if (m >= MP) { const float* op = ODN + (size_t)m * DNW + c8; a0 = *(const f32x4*)op; a1 = *(const f32x4*)(op + 4); }
            else { const int t = m & 4095, cch = t & 63, hh = lane >> 4; const size_t it_ = (size_t)((m >> 12) * 64 + (t >> 6)) * 4 + hh;
                const float* op = ODN + it_ * 8192 + ((((cch >> 4) * 8 + ((lane & 15) >> 1)) * 64 + ((cch >> 2) & 3) * 16 + 8 * (lane & 1)) * 4) + (cch & 3);
                a0 = (f32x4){op[0], op[4], op[8], op[12]}; a1 = (f32x4){op[16], op[20], op[24], op[28]}; }
            float ss = (a0.x * a0.x + a0.y * a0.y) + (a0.z * a0.z + a0.w * a0.w) + (a1.x * a1.x + a1.y * a1.y) + (a1.z * a1.z + a1.w * a1.w);
            ss += __shfl_xor(ss, 1); ss += __shfl_xor(ss, 2); ss += __shfl_xor(ss, 4); ss += __shfl_xor(ss, 8);
            const float rs = 1.0f / sqrtf(ss * (1.f / DND) + EPS);
            const f32x4 g0 = *(const f32x4*)(gdn + (c8 & 127)), g1 = *(const f32x4*)(gdn + (c8 & 127) + 4);
            const u32x4 zw = *(const u32x4*)((const bf16*)(ws + WS_ZG) + (size_t)m * DNW + c8); const f32x4 z0 = bf4lo(zw), z1 = bf4hi(zw);
            *(u32x4*)(MIXED + (size_t)m * D + SBW + c8) = pack8(a0 * rs * g0 * z0, a1 * rs * g1 * z1);
        }
        if (m >= MP) {
            const int b = (m - MP) >> 3, t = (m - MP) & 7, h = lane >> 3, d0 = c8 & 63;
            const float* OP = OPb + (size_t)(b * SBH + h) * NPART * 512; const float* LP = LPb + (size_t)(b * SBH + h) * NPART * 8;
            float v[8];
#pragma unroll
            for (int k = 0; k < 8; ++k) v[k] = 0.f;
            float suf = 0.f;
#pragma unroll
            for (int part = NPART - 1; part >= 0; --part) { const float w = __builtin_amdgcn_exp2f(suf);
                const f32x4 pa = *(const f32x4*)(OP + part * 512 + t * 64 + d0), pb = *(const f32x4*)(OP + part * 512 + t * 64 + d0 + 4);
                v[0] += w * pa.x; v[1] += w * pa.y; v[2] += w * pa.z; v[3] += w * pa.w; v[4] += w * pb.x; v[5] += w * pb.y; v[6] += w * pb.z; v[7] += w * pb.w;
                suf += LP[part * 8 + t]; }
            float ss = 0.f;
#pragma unroll
            for (int k = 0; k < 8; ++k) ss += v[k] * v[k];
            ss += __shfl_xor(ss, 1); ss += __shfl_xor(ss, 2); ss += __shfl_xor(ss, 4);
            const float rs = 1.0f / sqrtf(ss * (1.f / HD) + EPS);
            const f32x4 g0 = *(const f32x4*)(gso + d0), g1 = *(const f32x4*)(gso + d0 + 4);
            *(u32x4*)(MIXED + (size_t)m * D + c8) = pack8((f32x4){v[0], v[1], v[2], v[3]} * rs * g0, (f32x4){v[4], v[5], v[6], v[7]} * rs * g1);
        }
    }
}

__device__ __forceinline__ void convgate_strip(const Args& A, int m0, int R, int cg, int lane) {
    unsigned char* ws = A.ws; const bf16* UP = (const bf16*)(ws + WS_UP); bf16* ACT = (bf16*)(ws + WS_ACT); float* out = A.out;
    const float* wf = (const float*)A.in[I_WFC]; const float* sfc = (const float*)A.in[I_SFC];
    const int c = (cg * 64 + lane) * 8;
    if (c >= DFF) return;
    const bool prompt = m0 < MP; const int b = prompt ? (m0 >> 12) : ((m0 - MP) >> 3), t0 = prompt ? (m0 & 4095) : ((m0 - MP) & 7), T = prompt ? TP : TS;
    f32x4 wu[3][2], wg[3][2];
#pragma unroll
    for (int i = 0; i < 3; ++i) { const float* wp = wf + (size_t)i * DFF2 + c; wu[i][0] = *(const f32x4*)wp; wu[i][1] = *(const f32x4*)(wp + 4); wg[i][0] = *(const f32x4*)(wp + DFF); wg[i][1] = *(const f32x4*)(wp + DFF + 4); }
    f32x4 xu[2][2], xg[2][2];
#pragma unroll
    for (int j = 0; j < 2; ++j) { const int tt = t0 - 2 + j;
        if (tt >= 0) { const bf16* p = UP + (size_t)(m0 - 2 + j) * DFF2 + c; const u32x4 a = *(const u32x4*)p, g = *(const u32x4*)(p + DFF); xu[j][0] = bf4lo(a); xu[j][1] = bf4hi(a); xg[j][0] = bf4lo(g); xg[j][1] = bf4hi(g); }
        else if (!prompt) { const float* p = sfc + ((size_t)b * 2 + (2 + tt)) * DFF2 + c; xu[j][0] = *(const f32x4*)p; xu[j][1] = *(const f32x4*)(p + 4); xg[j][0] = *(const f32x4*)(p + DFF); xg[j][1] = *(const f32x4*)(p + DFF + 4); }
        else { xu[j][0] = (f32x4){0.f, 0.f, 0.f, 0.f}; xu[j][1] = xu[j][0]; xg[j][0] = xu[j][0]; xg[j][1] = xu[j][0]; } }
    const bf16* src = UP + (size_t)m0 * DFF2 + c;
    u32x4 na = *(const u32x4*)src, ng = *(const u32x4*)(src + DFF);
    for (int r = 0; r < R; ++r) {
        const u32x4 ca = na, cgw = ng;
        if (r + 1 < R) { na = *(const u32x4*)(src + (size_t)(r + 1) * DFF2); ng = *(const u32x4*)(src + (size_t)(r + 1) * DFF2 + DFF); }
        const f32x4 u0 = bf4lo(ca), u1 = bf4hi(ca), g0 = bf4lo(cgw), g1 = bf4hi(cgw);
        f32x4 yu0 = wu[0][0] * xu[0][0] + wu[1][0] * xu[1][0] + wu[2][0] * u0, yu1 = wu[0][1] * xu[0][1] + wu[1][1] * xu[1][1] + wu[2][1] * u1;
        f32x4 yg0 = wg[0][0] * xg[0][0] + wg[1][0] * xg[1][0] + wg[2][0] * g0, yg1 = wg[0][1] * xg[0][1] + wg[1][1] * xg[1][1] + wg[2][1] * g1;
        xu[0][0] = xu[1][0]; xu[0][1] = xu[1][1]; xu[1][0] = u0; xu[1][1] = u1; xg[0][0] = xg[1][0]; xg[0][1] = xg[1][1]; xg[1][0] = g0; xg[1][1] = g1;
        yg0.x = siluf(yg0.x); yg0.y = siluf(yg0.y); yg0.z = siluf(yg0.z); yg0.w = siluf(yg0.w); yg1.x = siluf(yg1.x); yg1.y = siluf(yg1.y); yg1.z = siluf(yg1.z); yg1.w = siluf(yg1.w);
        *(u32x4*)(ACT + (size_t)(m0 + r) * DFF + c) = pack8(yg0 * yu0, yg1 * yu1);
        const int oidx = t0 + r - (T - 2);
        if (oidx >= 0) { float* fo = (prompt ? out + O_FCP : out + O_FCS) + ((size_t)b * 2 + oidx) * DFF2 + c; *(f32x4*)fo = u0; *(f32x4*)(fo + 4) = u1; *(f32x4*)(fo + DFF) = g0; *(f32x4*)(fo + DFF + 4) = g1; }
    }
}
__device__ __forceinline__ void phase_convgate(const Args& A, int gw, int NGW, int lane) {
    constexpr int NPI = (MP / 32) * 6, NSI = BS * 6;
    for (int it = gw; it < NPI + NSI; it += NGW) {
        if (it < NPI) convgate_strip(A, (it / 6) * 32, 32, it % 6, lane);
        else { const int j = it - NPI; convgate_strip(A, MP + (j / 6) * 8, 8, j % 6, lane); }
    }
}

constexpr int NPHASE = 13;
#ifndef PROBE_LEVEL
#define PROBE_LEVEL 0
#endif
#ifndef REP_MASK
#define REP_MASK 0
#endif

__global__ void __launch_bounds__(512, 2) fwd_kernel(Args A) {
    extern __shared__ __attribute__((aligned(16))) unsigned char lds_raw[];
    LAS unsigned char* lds = (LAS unsigned char*)lds_raw;
    const int wave = __builtin_amdgcn_readfirstlane((int)threadIdx.x >> 6);
    const int G = gridDim.x, bx = blockIdx.x;
    const int gw = bx * 8 + wave, NGW = G * 8, NGT = G * 512;
    unsigned char* ws = A.ws;
    gu32* ctl = (gu32*)(ws + WS_CTL);
    volatile LAS unsigned* MISC = (volatile LAS unsigned*)(lds + MISC_OFF);
    { const int t0 = wave * 64 + lane_now(); for (int u = t0; u < (LDS_BYTES - RING_BYTES) / 4; u += 512) ((LAS unsigned*)(lds + RING_BYTES))[u] = 0u; }
    __syncthreads();
    const int lo = A.lo, hi = A.hi;
    const bool multi = (hi - lo) > 1;
    XcdBarrier bar; bar.bar = (unsigned*)(ctl + CW_BAR); bar.x = 0; bar.st = nullptr;
    if (multi) bar = xcd_barrier_post((unsigned*)(ctl + CW_BAR), MISC + 8, wave * 64 + lane_now());
#define IN(k) (lo <= (k) && (k) < hi)
#define GBAR() xcd_barrier(bar, wave * 64 + lane_now())
#define SEAM(k) do { if (IN(k) && IN((k) + 1)) GBAR(); } while (0)
    float* MOD = (float*)(ws + WS_MOD);

#define PH0(rep_) phase_prologue(A, lds, ctl + CW_Q0 + 64 * (rep_), bx, G, wave, lane, gtid, NGT);
#define PH1(rep_) ;
#define PH2(rep_) phase_norm<true>((const float*)A.in[I_XP], (const float*)A.in[I_XS], (const float*)A.in[I_GATT], MOD, 0, 1024, (bf16*)(ws + WS_H), (const float*)(ws + WS_WINX), (float*)(ws + WS_EXTRA), gw, NGW, lane);
#define PH3(rep_) { pg8::Gemm g{(const pg8::bf16_t*)(ws + WS_H), (const pg8::bf16_t*)(ws + WS_WIN_T), M, NPROJ, D}; pg8::StaticOrder S; S.init(M, NPROJ, G, bx); \
          EpiProj E{A.out, (bf16*)(ws + WS_QB), (bf16*)(ws + WS_KB), (bf16*)(ws + WS_VB), (bf16*)(ws + WS_DNRAW), (bf16*)(ws + WS_ZG), (const float*)A.in[I_GQ], (const float*)A.in[I_GK], (LAS float*)(lds + RING_BYTES + 1024)}; \
          pg8::gemm_phase<EpiProj, pg8::StaticOrder, true, true>(lds, g, S, E, tid); }
#define PH4(rep_) phase_post(A, gw, NGW, lane, gtid, NGT);
#define PH5(rep_) for (int u = bx; u < 1024; u += G) { if (u < 512) dn_prescan_unit(A, lds, u, tid, wave, lane); else dn_sample_unit(A, lds, u - 512, tid); }
#define PH6(rep_) PH6X(rep_, true, true, true)
#define PH6X(rep_, DS_, DP_, DA_) { if ((DS_) && bx < 16) dn_scan_chain(A, lds, bx, tid, wave, lane); \
          \
        bool moreP = (DP_), moreS = (DA_); const bool pfirst = wave < 4; \
        gu32* qbase_ = ctl + CW_QUEUE + 1024 * (rep_);     \
        const int shard0_ = (int)(xb_xcc_id() & 7u); int offP_ = 0, offS_ = 0;     \
        for (;;) { \
            int job = -1; bool isP = false; \
            if (pfirst && moreP) { const int sh_ = (shard0_ + offP_) & 7; unsigned j_ = 0; if (lane == 0) j_ = __hip_atomic_fetch_add(qbase_ + 64 * sh_, 1u, RLX_AGENT); j_ = __builtin_amdgcn_readfirstlane(j_); if (j_ < 256u) { job = (int)j_ * 8 + sh_; isP = true; } else if (++offP_ == 8) moreP = false; } \
            if (job < 0 && moreS && !(pfirst && moreP)) { const int sh_ = (shard0_ + offS_) & 7; unsigned j_ = 0; if (lane == 0) j_ = __hip_atomic_fetch_add(qbase_ + 512 + 64 * sh_, 1u, RLX_AGENT); j_ = __builtin_amdgcn_readfirstlane(j_); if (j_ < 512u) { job = (int)j_ * 8 + sh_; } else if (++offS_ == 8) moreS = false; } \
            if (job < 0 && !pfirst && !moreS && moreP) { const int sh_ = (shard0_ + offP_) & 7; unsigned j_ = 0; if (lane == 0) j_ = __hip_atomic_fetch_add(qbase_ + 64 * sh_, 1u, RLX_AGENT); j_ = __builtin_amdgcn_readfirstlane(j_); if (j_ < 256u) { job = (int)j_ * 8 + sh_; isP = true; } else if (++offP_ == 8) moreP = false; } \
            if (job < 0) { if (!moreP && !moreS) break; else continue; } \
            if (isP) { const int qb = 63 - (job >> 5), bh = job & 31; attn_prompt_item(A, lds + wave * AW_BYTES, bh >> 3, bh & 7, qb * 64, lane); } \
            else { const int h_ = job & 7, bs_ = job >> 3; attn_sample_job(A, lds + wave * AW_BYTES, bs_ >> 2, h_, bs_ & 3, lane); } \
        } }
#define PH7(rep_) phase_outnorm(A, gw, NGW, lane);
#define PH8(rep_) { pg8::Gemm g{(const pg8::bf16_t*)(ws + WS_MIXED), (const pg8::bf16_t*)(ws + WS_WOUT_T), M, D, D}; pg8::StaticOrder S; S.init(M, D, G, bx); \
        EpiResGate E{(const float*)A.in[I_XP], (const float*)A.in[I_XS], MOD, 2048, (float*)(ws + WS_X1)}; \
        pg8::gemm_phase<EpiResGate, pg8::StaticOrder, true, true>(lds, g, S, E, tid); }
#define PH9(rep_) phase_norm<false>((const float*)(ws + WS_X1), (const float*)(ws + WS_X1) + (size_t)MP * D, (const float*)A.in[I_GFFN], MOD, 3072, 4096, (bf16*)(ws + WS_H), nullptr, nullptr, gw, NGW, lane);
#define PH10(rep_) { pg8::Gemm g{(const pg8::bf16_t*)(ws + WS_H), (const pg8::bf16_t*)(ws + WS_WUP_T), M, DFF2, D}; pg8::StaticOrder S; S.init(M, DFF2, G, bx); \
        pg8::EpiBf16<0> E{(pg8::bf16_t*)(ws + WS_UP), DFF2, nullptr, 0, 0, 1.f}; \
        pg8::gemm_phase<pg8::EpiBf16<0>, pg8::StaticOrder, true, true>(lds, g, S, E, tid); }
#define PH11(rep_) phase_convgate(A, gw, NGW, lane);
#define PH12(rep_) { pg8::Gemm g{(const pg8::bf16_t*)(ws + WS_ACT), (const pg8::bf16_t*)(ws + WS_WDN_T), M, D, DFF}; pg8::StaticOrder S; S.init(M, D, G, bx); \
        EpiResGate E{(const float*)(ws + WS_X1), (const float*)(ws + WS_X1) + (size_t)MP * D, MOD, 5120, A.out}; \
        pg8::gemm_phase<EpiResGate, pg8::StaticOrder, true, true>(lds, g, S, E, tid); }
#define RUNPH(k) do { if (IN(k)) { const int lane = lane_now(), tid = wave * 64 + lane, gtid = bx * 512 + tid; (void)gtid; PH##k(0) if constexpr (((REP_MASK) >> (k)) & 1) { GBAR(); PH##k(1) } } } while (0)
    RUNPH(0); SEAM(0);
    RUNPH(2); SEAM(2);
    RUNPH(3); SEAM(3);
    RUNPH(4); SEAM(4);
    RUNPH(5);
    if constexpr (((REP_MASK) >> 17) & 1) { GBAR(); const int lane = lane_now(), tid = wave * 64 + lane; for (int u = bx; u < 512; u += G) dn_prescan_unit<PROBE_LEVEL>(A, lds, u, tid, wave, lane); }
    if constexpr (((REP_MASK) >> 18) & 1) { GBAR(); const int lane = lane_now(), tid = wave * 64 + lane; (void)lane; for (int u = bx; u < 512; u += G) dn_sample_unit(A, lds, u, tid); }
    SEAM(5);
    RUNPH(6);
    if constexpr (((REP_MASK) >> 13) & 1) { GBAR(); const int lane = lane_now(), tid = wave * 64 + lane; PH6X(2, true, false, false) }
    if constexpr (((REP_MASK) >> 14) & 1) { GBAR(); const int lane = lane_now(), tid = wave * 64 + lane; PH6X(3, false, true, false) }
    if constexpr (((REP_MASK) >> 15) & 1) { GBAR(); const int lane = lane_now(), tid = wave * 64 + lane; PH6X(4, false, false, true) }
    SEAM(6);
    RUNPH(7); SEAM(7);
    RUNPH(8); SEAM(8);
    RUNPH(9); SEAM(9);
    RUNPH(10); SEAM(10);
    RUNPH(11); SEAM(11);
    RUNPH(12);
#undef IN
#undef SEAM
}

#ifndef N_LAUNCHES
#define N_LAUNCHES 1
#endif
extern "C" void kernel_launch(void* const* d_in, const int* in_sizes, int n_in, void* d_out, int out_size, void* d_ws, size_t ws_size, hipStream_t stream) {
    static int grid = 0;
    if (grid == 0) {
        if (n_in != 27 || (size_t)out_size != O_END || ws_size < WS_END) { fprintf(stderr, "kernel_launch: unexpected shapes: n_in %d out %d ws %zu\n", n_in, out_size, ws_size); grid = -1; return; }
        int dev = 0, cus = 0, per_cu = 0;
        if (hipGetDevice(&dev) != hipSuccess || hipDeviceGetAttribute(&cus, hipDeviceAttributeMultiprocessorCount, dev) != hipSuccess) { grid = -1; return; }
        if (hipFuncSetAttribute((const void*)fwd_kernel, hipFuncAttributeMaxDynamicSharedMemorySize, LDS_BYTES) != hipSuccess) { fprintf(stderr, "kernel_launch: hipFuncSetAttribute failed\n"); grid = -1; return; }
        if (hipOccupancyMaxActiveBlocksPerMultiprocessor(&per_cu, (const void*)fwd_kernel, 512, LDS_BYTES) != hipSuccess || per_cu < 1) fprintf(stderr, "kernel_launch: occupancy query says %d\n", per_cu);
        (void)hipGetLastError();
        grid = cus;
    }
    if (grid < 0) return;
    (void)hipMemsetAsync((char*)d_ws + WS_CTL, 0, CTL_ZERO_BYTES, stream);
    Args a{};
    for (int i = 0; i < 27; ++i) a.in[i] = d_in[i];
    a.out = (float*)d_out; a.ws = (unsigned char*)d_ws;
    if (N_LAUNCHES == 1) { a.lo = 0; a.hi = NPHASE; hipLaunchKernelGGL(fwd_kernel, dim3(grid), dim3(512), LDS_BYTES, stream, a); }
    else for (int p = 0; p < NPHASE; ++p) { a.lo = p; a.hi = p + 1; hipLaunchKernelGGL(fwd_kernel, dim3(grid), dim3(512), LDS_BYTES, stream, a); }
}
```

```cpp
#include <hip/hip_runtime.h>
#include <cstdio>
#include <cstdint>
#define REP_MASK 0
#define PROBE_LEVEL 0
namespace pg8 {
#define PG8_LAS __attribute__((address_space(3)))
typedef unsigned short bf16_t;
typedef short bf16x8 __attribute__((ext_vector_type(8)));
typedef float f32x4 __attribute__((ext_vector_type(4)));
typedef unsigned u32x4 __attribute__((ext_vector_type(4)));
constexpr int BM = 256, BK = 64, HALF = 128, HTB = HALF * BK * 2  , STAGE_BYTES = 8 * HTB, NXCD = 8, WGM = 8;

__host__ __device__ __forceinline__ int lds_byte(int r, int c) { const int st = (r >> 4) * 2 + (c >> 5), rr = r & 15, cc = c & 31, ob = rr * 64 + cc * 2; return st * 1024 + (ob ^ (((ob >> 9) & 1) << 5)); }
__host__ __device__ __forceinline__ void stage_rc(int b, int& R, int& C) { const int st = b / 1024, sb = b % 1024, swz = sb ^ (((sb >> 9) & 1) << 5); R = (st >> 1) * 16 + swz / 64; C = (st & 1) * 32 + (swz % 64) / 2; }
__host__ __device__ __forceinline__ int perm32(int rho) { const int n = rho >> 4, i = rho & 15; return 8 * (i >> 2) + 4 * n + (i & 3); }

struct Unit { int pm, pn, ko; };
struct Gemm { const bf16_t* A; const bf16_t* Bt; int M, N, K, ld; };

struct StaticOrder {
    int nM, nN, nwg, G, c;
    __host__ __device__ void init(int M, int N, int G_, int c_) { nM = M / BM; nN = N / BM; nwg = nM * nN; G = G_; c = c_; }
    __host__ __device__ bool next(int i, Unit& u) const {
        const long L = (long)i * G + c; if (L >= nwg) return false;
        int wgid = (int)L; { const int q = nwg / NXCD, r = nwg % NXCD, xcd = wgid % NXCD, off = wgid / NXCD; wgid = (xcd < r ? xcd * (q + 1) : r * (q + 1) + (xcd - r) * q) + off; }
        const int nig = WGM * nN, gid = wgid / nig, fm = gid * WGM, gsz = (nM - fm) < WGM ? (nM - fm) : WGM;
        u.pm = fm + ((wgid % nig) % gsz); u.pn = (wgid % nig) / gsz; u.ko = 0; return true;
    }
    __device__ __forceinline__ void a_ready(const Unit&) const {}
    __device__ __forceinline__ void done(const Unit&) const {}
};

__device__ __forceinline__ unsigned cvt_pk_bf16(float lo, float hi) { unsigned r; asm volatile("v_cvt_pk_bf16_f32 %0, %1, %2" : "=v"(r) : "v"(lo), "v"(hi)); return r; }
typedef float f32x2 __attribute__((ext_vector_type(2)));
__device__ __forceinline__ f32x2 gelu_pk(f32x2 v) {
    const f32x2 av = __builtin_elementwise_abs(v), d = av * 0.2316418882f + 1.0f;
    f32x2 t; t.x = __builtin_amdgcn_rcpf(d.x); t.y = __builtin_amdgcn_rcpf(d.y);
    f32x2 q = t * 0.5307027145f + (-0.7265760135f); q = q * t + 0.7107068705f; q = q * t + (-0.142248368f); q = q * t + 0.127414796f; q = q * t;
    const f32x2 s = (v * v) * (-0.72134752044f);
    f32x2 e; e.x = __builtin_amdgcn_exp2f(s.x); e.y = __builtin_amdgcn_exp2f(s.y);
    const f32x2 m = v * (q * e), r = v - m;
    f32x2 o; o.x = v.x < 0.f ? m.x : r.x; o.y = v.y < 0.f ? m.y : r.y; return o;
}

template <int ACT  > struct EpiBf16 {
    static constexpr bool PERM = true, AFTER_DRAIN = false; static_assert(ACT == 0 || ACT == 1, "EpiBf16: ACT is 0 (none) or 1 (gelu_pk)");
    bf16_t* O; int ldc; const float* bias; int split_cols; size_t split_stride; float scale0;
    __device__ __forceinline__ void operator()(const f32x4 (&acc)[2][2][4][2], const Unit& u, int wr, int wc, int fr, int fq) const {
        const int row0 = u.pm * BM + wr * 64 + fr; int colt = u.pn * BM; bf16_t* base = O;
        float sc = 1.f; if (split_cols) { const int t = colt / split_cols; base += (size_t)t * split_stride; colt -= t * split_cols; if (t == 0) sc = scale0; }
        const int col0 = colt + wc * 32 + 8 * fq, bcol0 = u.pn * BM + wc * 32 + 8 * fq;
        f32x4 bv[2][2];
#pragma unroll
        for (int bj = 0; bj < 2; ++bj)
#pragma unroll
            for (int n = 0; n < 2; ++n) bv[bj][n] = bias ? *(const f32x4*)(bias + bcol0 + bj * HALF + 4 * n) : (f32x4){0.f, 0.f, 0.f, 0.f};
#pragma unroll
        for (int ai = 0; ai < 2; ++ai)
#pragma unroll
            for (int m = 0; m < 4; ++m) { bf16_t* rowp = base + (size_t)(row0 + ai * HALF + m * 16) * ldc + col0;
#pragma unroll
                for (int bj = 0; bj < 2; ++bj) { f32x4 v0 = acc[ai][bj][m][0] + bv[bj][0], v1 = acc[ai][bj][m][1] + bv[bj][1];
                    if (ACT == 1) { f32x2 a = gelu_pk((f32x2){v0[0], v0[1]}), b = gelu_pk((f32x2){v0[2], v0[3]}), c = gelu_pk((f32x2){v1[0], v1[1]}), d = gelu_pk((f32x2){v1[2], v1[3]});
                        v0 = (f32x4){a.x, a.y, b.x, b.y}; v1 = (f32x4){c.x, c.y, d.x, d.y}; }
                    v0 = v0 * sc; v1 = v1 * sc; u32x4 w; w.x = cvt_pk_bf16(v0[0], v0[1]); w.y = cvt_pk_bf16(v0[2], v0[3]); w.z = cvt_pk_bf16(v1[0], v1[1]); w.w = cvt_pk_bf16(v1[2], v1[3]);
                    *(u32x4*)(rowp + bj * HALF) = w; } }
    }
};

struct PanelStats {
    unsigned* xbuf;
    unsigned* cnt;
    unsigned* tmo;
    int ntn; float eps;
    unsigned code;
    __device__ __forceinline__ bool run(const f32x4 (&v)[2][2][4][2], const Unit& u, int wr, int wc, int fr, int fq, PG8_LAS unsigned char* lds, int wid, int lane) const {
        typedef float f32x2v __attribute__((ext_vector_type(2)));
        PG8_LAS f32x2v* P = (PG8_LAS f32x2v*)lds;
        PG8_LAS f32x2v* S = (PG8_LAS f32x2v*)(lds + 8192);
        PG8_LAS unsigned* flag = (PG8_LAS unsigned*)(lds + 8192 + 2048);
#pragma unroll
        for (int ai = 0; ai < 2; ++ai)
#pragma unroll
            for (int m = 0; m < 4; ++m) {
                float s = 0.f;
#pragma unroll
                for (int bj = 0; bj < 2; ++bj)
#pragma unroll
                    for (int n = 0; n < 2; ++n) { const f32x4 x = v[ai][bj][m][n]; s += (x[0] + x[1]) + (x[2] + x[3]); }
                s += __shfl_xor(s, 16); s += __shfl_xor(s, 32);
                const float mw = s * (1.0f / 64.0f); float q = 0.f;
#pragma unroll
                for (int bj = 0; bj < 2; ++bj)
#pragma unroll
                    for (int n = 0; n < 2; ++n) { const f32x4 d = v[ai][bj][m][n] - mw; q += (d[0] * d[0] + d[1] * d[1]) + (d[2] * d[2] + d[3] * d[3]); }
                q += __shfl_xor(q, 16); q += __shfl_xor(q, 32);
                if (fq == 0) P[(ai * HALF + wr * 64 + m * 16 + fr) * 4 + wc] = (f32x2v){mw, q};
            }
        asm volatile("s_waitcnt lgkmcnt(0)" ::: "memory"); __builtin_amdgcn_s_barrier(); asm volatile("" ::: "memory");
#if defined(BROKEN_EXCHANGE_NO_WAIT)
#warning BROKEN CONTROL BUILD: the row-statistics exchange does not wait; results are wrong by design
        if (blockIdx.x >= 64) { const long long t0_ = clock64(); while (clock64() - t0_ < 60000) __builtin_amdgcn_s_sleep(8); }
#endif
        const int row = wid * 32 + (lane & 31);
        if (lane < 32) {
            const f32x2v a = P[row * 4 + 0], b = P[row * 4 + 1], c = P[row * 4 + 2], d = P[row * 4 + 3];
            const float mt = (a.x + b.x + c.x + d.x) * 0.25f;
            const float da = a.x - mt, db = b.x - mt, dc = c.x - mt, dd = d.x - mt;
            const float m2 = (a.y + b.y) + (c.y + d.y) + 64.0f * ((da * da + db * db) + (dc * dc + dd * dd));
            unsigned long long* slot = (unsigned long long*)xbuf + ((size_t)(u.pm * BM + row) * 4 + u.pn);
            __hip_atomic_store(slot, ((unsigned long long)__float_as_uint(m2) << 32) | __float_as_uint(mt), __ATOMIC_RELAXED, __HIP_MEMORY_SCOPE_AGENT);
        }
        asm volatile("s_waitcnt vmcnt(0)" ::: "memory");
        if (lane == 0) __hip_atomic_fetch_add(cnt + 64 * u.pm, 1u, __ATOMIC_RELAXED, __HIP_MEMORY_SCOPE_AGENT);
        if (wid == 0) {
            bool dead = false; const unsigned long long t0 = __builtin_amdgcn_s_memrealtime(); const unsigned want = 8u * (unsigned)ntn;
            for (;;) {
#if defined(BROKEN_EXCHANGE_NO_WAIT)
                break;
#endif
                if ((unsigned)__builtin_amdgcn_readfirstlane(__hip_atomic_load(cnt + 64 * u.pm, __ATOMIC_RELAXED, __HIP_MEMORY_SCOPE_AGENT)) >= want) break;
                if (__builtin_amdgcn_s_memrealtime() - t0 > 2000000ull) {
                    if (lane == 0) { unsigned expect = 0u; __hip_atomic_compare_exchange_strong(tmo + 1, &expect, code | (unsigned)(u.pm & 0xff), __ATOMIC_RELAXED, __ATOMIC_RELAXED, __HIP_MEMORY_SCOPE_AGENT);
                                     __hip_atomic_store(tmo, 1u, __ATOMIC_RELAXED, __HIP_MEMORY_SCOPE_AGENT); }
                    dead = true; break; }
                __builtin_amdgcn_s_sleep(2);
            }
            __builtin_amdgcn_fence(__ATOMIC_ACQUIRE, "agent");
            if (lane == 0) flag[0] = dead ? 1u : 0u;
        }
        asm volatile("s_waitcnt vmcnt(0) lgkmcnt(0)" ::: "memory"); __builtin_amdgcn_s_barrier(); asm volatile("" ::: "memory");
        const bool bad = flag[0] != 0u;
        if (lane < 32) {
            const unsigned long long* slot = (const unsigned long long*)xbuf + (size_t)(u.pm * BM + row) * 4; float mt[4], m2[4]; float ms = 0.f;
#pragma unroll
            for (int t = 0; t < 4; ++t) { if (t < ntn) { const unsigned long long w = __hip_atomic_load(slot + t, __ATOMIC_RELAXED, __HIP_MEMORY_SCOPE_AGENT); mt[t] = __uint_as_float((unsigned)w); m2[t] = __uint_as_float((unsigned)(w >> 32)); } else { mt[t] = 0.f; m2[t] = 0.f; } ms += mt[t]; }
            const float mean = ms / (float)ntn; float q = 0.f;
#pragma unroll
            for (int t = 0; t < 4; ++t) if (t < ntn) { const float dm = mt[t] - mean; q += m2[t] + 256.0f * dm * dm; }
            S[row] = (f32x2v){mean, 1.0f / sqrtf(q / (256.0f * (float)ntn) + eps)};
        }
        asm volatile("s_waitcnt lgkmcnt(0)" ::: "memory"); __builtin_amdgcn_s_barrier(); asm volatile("" ::: "memory");
        return bad;
    }
};
struct EpiLnRes {
    static constexpr bool PERM = false, AFTER_DRAIN = true;
    const float* base; float* out; int ldc; const float* bias; PanelStats st; unsigned poison;
    __device__ __forceinline__ void fused(f32x4 (&acc)[2][2][4][2], const Unit& u, int wr, int wc, int fr, int fq, PG8_LAS unsigned char* lds, int wid, int lane) const {
        typedef float f32x2v __attribute__((ext_vector_type(2)));
        const PG8_LAS f32x2v* S = (const PG8_LAS f32x2v*)(lds + 8192);
        const int col0 = u.pn * BM + wc * 32 + 4 * fq;
#pragma unroll
        for (int bj = 0; bj < 2; ++bj)
#pragma unroll
            for (int n = 0; n < 2; ++n) { const f32x4 bv = bias ? *(const f32x4*)(bias + col0 + bj * HALF + n * 16) : (f32x4){0.f, 0.f, 0.f, 0.f};
#pragma unroll
                for (int ai = 0; ai < 2; ++ai)
#pragma unroll
                    for (int m = 0; m < 4; ++m) acc[ai][bj][m][n] += bv; }
        f32x4 pre[4][2][2];
#pragma unroll
        for (int m = 0; m < 4; ++m) { const size_t off = (size_t)(u.pm * BM + wr * 64 + m * 16 + fr) * ldc + col0;
#pragma unroll
            for (int bj = 0; bj < 2; ++bj)
#pragma unroll
                for (int n = 0; n < 2; ++n) pre[m][bj][n] = *(const f32x4*)(base + off + bj * HALF + n * 16); }
        const bool bad = st.run(acc, u, wr, wc, fr, fq, lds, wid, lane) || poison != 0u;
        const float qnan = __builtin_nanf("");
#pragma unroll
        for (int ai = 0; ai < 2; ++ai)
#pragma unroll
            for (int m = 0; m < 4; ++m) { const int r = ai * HALF + wr * 64 + m * 16 + fr; const f32x2v sr = S[r]; const size_t off = (size_t)(u.pm * BM + r) * ldc + col0;
#pragma unroll
                for (int bj = 0; bj < 2; ++bj)
#pragma unroll
                    for (int n = 0; n < 2; ++n) { const f32x4 bs = ai == 0 ? pre[m][bj][n] : *(const f32x4*)(base + off + bj * HALF + n * 16); f32x4 o = bs + (acc[ai][bj][m][n] - sr.x) * sr.y;
                        if (bad) o = (f32x4){qnan, qnan, qnan, qnan}; *(f32x4*)(out + off + bj * HALF + n * 16) = o; }
                if (m & 1) asm volatile("" ::: "memory"); }
    }
};
struct EpiLnResLn {
    static constexpr bool PERM = false, AFTER_DRAIN = true;
    const float* base; float* out; bf16_t* xn; int ldc; const float* bias; PanelStats st1, st2; unsigned poison;
    __device__ __forceinline__ void fused(f32x4 (&acc)[2][2][4][2], const Unit& u, int wr, int wc, int fr, int fq, PG8_LAS unsigned char* lds, int wid, int lane) const {
        typedef float f32x2v __attribute__((ext_vector_type(2))); typedef unsigned u32x2v __attribute__((ext_vector_type(2)));
        const PG8_LAS f32x2v* S = (const PG8_LAS f32x2v*)(lds + 8192);
        const int col0 = u.pn * BM + wc * 32 + 4 * fq;
#pragma unroll
        for (int bj = 0; bj < 2; ++bj)
#pragma unroll
            for (int n = 0; n < 2; ++n) { const f32x4 bv = bias ? *(const f32x4*)(bias + col0 + bj * HALF + n * 16) : (f32x4){0.f, 0.f, 0.f, 0.f};
#pragma unroll
                for (int ai = 0; ai < 2; ++ai)
#pragma unroll
                    for (int m = 0; m < 4; ++m) acc[ai][bj][m][n] += bv; }
        bool bad = st1.run(acc, u, wr, wc, fr, fq, lds, wid, lane) || poison != 0u;
        const float qnan = __builtin_nanf("");
#pragma unroll
        for (int ai = 0; ai < 2; ++ai)
#pragma unroll
            for (int m = 0; m < 4; ++m) { const int r = ai * HALF + wr * 64 + m * 16 + fr; const f32x2v sr = S[r]; const size_t off = (size_t)(u.pm * BM + r) * ldc + col0;
#pragma unroll
                for (int bj = 0; bj < 2; ++bj)
#pragma unroll
                    for (int n = 0; n < 2; ++n) { const f32x4 bs = *(const f32x4*)(base + off + bj * HALF + n * 16); acc[ai][bj][m][n] = bs + (acc[ai][bj][m][n] - sr.x) * sr.y; }
                asm volatile("" : "+v"(acc[ai][0][m][0]), "+v"(acc[ai][0][m][1]), "+v"(acc[ai][1][m][0]), "+v"(acc[ai][1][m][1]));
                if (m & 1) asm volatile("" ::: "memory"); }
        const bool bad1 = bad;
        bad = st2.run(acc, u, wr, wc, fr, fq, lds, wid, lane) || bad;
#pragma unroll
        for (int ai = 0; ai < 2; ++ai)
#pragma unroll
            for (int m = 0; m < 4; ++m) { const int r = ai * HALF + wr * 64 + m * 16 + fr; const f32x2v sr = S[r]; const size_t off = (size_t)(u.pm * BM + r) * ldc + col0;
#pragma unroll
                for (int bj = 0; bj < 2; ++bj)
#pragma unroll
                    for (int n = 0; n < 2; ++n) { const f32x4 x1 = acc[ai][bj][m][n]; *(f32x4*)(out + off + bj * HALF + n * 16) = bad1 ? (f32x4){qnan, qnan, qnan, qnan} : x1;
                        const f32x4 o = (x1 - sr.x) * sr.y; u32x2v w; w.x = cvt_pk_bf16(o[0], o[1]); w.y = cvt_pk_bf16(o[2], o[3]);
                        if (bad) { w.x = 0x7fc07fc0u; w.y = 0x7fc07fc0u; } *(u32x2v*)(xn + off + bj * HALF + n * 16) = w; }
                asm volatile("" ::: "memory"); }
    }
};

template <class Epi, class Sched, bool ALIGN_EPI = false, bool SP2 = false>
__device__ __forceinline__ void gemm_phase(PG8_LAS unsigned char* lds, const Gemm g, const Sched& S, const Epi& E, const int tid) {
    const int wid = __builtin_amdgcn_readfirstlane(tid >> 6), lane = tid & 63, wr = wid >> 2, wc = wid & 3, fr = lane & 15, fq = lane >> 4;
    const int K = g.K, nt = K / BK;
    unsigned voffA[2], voffB[2];
#pragma unroll
    for (int i = 0; i < 2; ++i) { int R, C; stage_rc(tid * 16 + i * 8192, R, C); const int Rb = Epi::PERM ? ((R & ~31) + perm32(R & 31)) : R;
        voffA[i] = (unsigned)(R * g.ld + C) * 2u; voffB[i] = (unsigned)(Rb * g.ld + C) * 2u; }
    const size_t kstep = (size_t)(BK * 2);
    const size_t hstep = (size_t)HALF * g.ld * 2;
    const size_t tstep = 2 * hstep;
    const unsigned ldsw = (unsigned)wid * 1024u;
    const int aoff = lds_byte(wr * 64 + fr, fq * 8), boff = lds_byte(wc * 32 + fr, fq * 8);
#define PG8_SA(b, h) (((b) * 2 + (h)) * HTB)
#define PG8_SB(b, h) ((4 + (b) * 2 + (h)) * HTB)
#define PG8_STAGE(bufoff, gbase, voff) do { _Pragma("unroll") for (int _i = 0; _i < 2; ++_i) \
        __builtin_amdgcn_global_load_lds((const unsigned*)((const char*)(gbase) + (voff)[_i]), (PG8_LAS unsigned*)(lds + (bufoff) + ldsw + _i * 8192), 16, 0, 0); } while (0)
#define PG8_LDA(dst, b, h) do { _Pragma("unroll") for (int m = 0; m < 4; ++m) _Pragma("unroll") for (int k = 0; k < 2; ++k) dst[m][k] = *(const PG8_LAS bf16x8*)(lds + PG8_SA(b, h) + aoff + m * 2048 + k * 1024); } while (0)
#define PG8_LDB(dst, b, h) do { _Pragma("unroll") for (int n = 0; n < 2; ++n) _Pragma("unroll") for (int k = 0; k < 2; ++k) dst[n][k] = *(const PG8_LAS bf16x8*)(lds + PG8_SB(b, h) + boff + n * 2048 + k * 1024); } while (0)
#define PG8_MMA(ai, bj, At, Bt) do { __builtin_amdgcn_s_setprio(1); _Pragma("unroll") for (int m = 0; m < 4; ++m) _Pragma("unroll") for (int n = 0; n < 2; ++n) _Pragma("unroll") for (int k = 0; k < 2; ++k) \
        acc[ai][bj][m][n] = __builtin_amdgcn_mfma_f32_16x16x32_bf16(Bt[n][k], At[m][k], acc[ai][bj][m][n], 0, 0, 0); __builtin_amdgcn_s_setprio(0); } while (0)
#define PG8_WAIT_V(n) asm volatile("s_waitcnt vmcnt(" #n ")" ::: "memory")
#define PG8_WAIT_L(n) asm volatile("s_waitcnt lgkmcnt(" #n ")" ::: "memory")
#define PG8_BAR __builtin_amdgcn_s_barrier()
#define PG8_SCHED __builtin_amdgcn_sched_barrier(0)
    Unit cur, nxt; int ui = 0;
    if (!S.next(0, cur)) return;
    f32x4 acc[2][2][4][2];
#pragma unroll
    for (int a = 0; a < 2; ++a)
#pragma unroll
        for (int b = 0; b < 2; ++b)
#pragma unroll
            for (int m = 0; m < 4; ++m)
#pragma unroll
                for (int n = 0; n < 2; ++n) acc[a][b][m][n] = (f32x4){0.f, 0.f, 0.f, 0.f};
    bf16x8 At[4][2], B0[2][2], B1[2][2];
    const char* cA = (const char*)g.A + (size_t)cur.pm * tstep + (size_t)cur.ko * 2; const char* cB = (const char*)g.Bt + (size_t)cur.pn * tstep + (size_t)cur.ko * 2;
    S.a_ready(cur);
    if constexpr (SP2) {
        PG8_STAGE(PG8_SB(0, 0), cB, voffB); PG8_STAGE(PG8_SB(0, 1), cB + hstep, voffB); PG8_STAGE(PG8_SA(0, 0), cA, voffA); PG8_STAGE(PG8_SA(0, 1), cA + hstep, voffA);
        if (wr == 1) PG8_BAR;
        PG8_WAIT_V(2); PG8_BAR;
        PG8_STAGE(PG8_SB(1, 0), cB + kstep, voffB); PG8_STAGE(PG8_SA(1, 0), cA + kstep, voffA); PG8_STAGE(PG8_SB(1, 1), cB + hstep + kstep, voffB);
        PG8_WAIT_V(6); PG8_BAR;
    } else {
        PG8_STAGE(PG8_SB(0, 0), cB, voffB); PG8_STAGE(PG8_SA(0, 0), cA, voffA); PG8_STAGE(PG8_SB(0, 1), cB + hstep, voffB); PG8_STAGE(PG8_SA(0, 1), cA + hstep, voffA);
        if (wr == 1) PG8_BAR;
        PG8_WAIT_V(4); PG8_BAR;
        PG8_STAGE(PG8_SB(1, 0), cB + kstep, voffB); PG8_STAGE(PG8_SA(1, 0), cA + kstep, voffA); PG8_STAGE(PG8_SB(1, 1), cB + hstep + kstep, voffB);
        PG8_WAIT_V(6); PG8_BAR;
    }
    for (;;) {
        const bool has_next = S.next(ui + 1, nxt);
        const char* nA = has_next ? (const char*)g.A + (size_t)nxt.pm * tstep + (size_t)nxt.ko * 2 : cA; const char* nB = has_next ? (const char*)g.Bt + (size_t)nxt.pn * tstep + (size_t)nxt.ko * 2 : cB;
        for (int t = 0; t < nt; t += 2) {
            const bool last = (t == nt - 2);
            const char* a1 = cA + (size_t)(t + 1) * kstep;
            const char* a2 = last ? nA : cA + (size_t)(t + 2) * kstep; const char* b2 = last ? nB : cB + (size_t)(t + 2) * kstep;
            const char* a3 = a2 + kstep; const char* b3 = b2 + kstep;
            if (last && has_next) S.a_ready(nxt);
            if constexpr (SP2) {
            PG8_LDB(B0, 0, 0); PG8_LDB(B1, 0, 1); PG8_SCHED; PG8_LDA(At, 0, 0); PG8_STAGE(PG8_SA(1, 1), a1 + hstep, voffA);
            PG8_WAIT_V(8); PG8_WAIT_L(0); PG8_BAR; PG8_MMA(0, 0, At, B0); PG8_MMA(0, 1, At, B1); PG8_BAR; PG8_SCHED;
            PG8_LDA(At, 0, 1); PG8_STAGE(PG8_SB(0, 0), b2, voffB); PG8_STAGE(PG8_SB(0, 1), b2 + hstep, voffB); PG8_STAGE(PG8_SA(0, 0), a2, voffA);
            PG8_WAIT_V(8); PG8_WAIT_L(0); PG8_BAR; PG8_MMA(1, 0, At, B0); PG8_MMA(1, 1, At, B1); PG8_BAR; PG8_SCHED;
            PG8_LDB(B0, 1, 0); PG8_LDB(B1, 1, 1); PG8_SCHED; PG8_LDA(At, 1, 0); PG8_STAGE(PG8_SA(0, 1), a2 + hstep, voffA);
            PG8_WAIT_V(8); PG8_WAIT_L(0); PG8_BAR; PG8_MMA(0, 0, At, B0); PG8_MMA(0, 1, At, B1); PG8_BAR; PG8_SCHED;
            PG8_LDA(At, 1, 1); PG8_STAGE(PG8_SB(1, 0), b3, voffB); PG8_STAGE(PG8_SB(1, 1), b3 + hstep, voffB); PG8_STAGE(PG8_SA(1, 0), a3, voffA);
            PG8_WAIT_V(8); PG8_WAIT_L(0); PG8_BAR; PG8_MMA(1, 0, At, B0); PG8_MMA(1, 1, At, B1); PG8_BAR; PG8_SCHED;
            } else {
            PG8_LDB(B0, 0, 0); PG8_SCHED; PG8_LDA(At, 0, 0); PG8_STAGE(PG8_SA(1, 1), a1 + hstep, voffA);
            PG8_WAIT_L(8); PG8_BAR; PG8_WAIT_L(0); PG8_MMA(0, 0, At, B0); PG8_BAR; PG8_SCHED;
            PG8_LDB(B1, 0, 1); PG8_STAGE(PG8_SB(0, 0), b2, voffB);
            PG8_BAR; PG8_WAIT_L(0); PG8_MMA(0, 1, At, B1); PG8_BAR;
            PG8_LDA(At, 0, 1); PG8_STAGE(PG8_SA(0, 0), a2, voffA);
            PG8_BAR; PG8_WAIT_L(0); PG8_MMA(1, 0, At, B0); PG8_BAR; PG8_SCHED;
            PG8_STAGE(PG8_SB(0, 1), b2 + hstep, voffB);
            PG8_WAIT_V(6); PG8_BAR; PG8_MMA(1, 1, At, B1); PG8_BAR;
            PG8_LDB(B0, 1, 0); PG8_SCHED; PG8_LDA(At, 1, 0); PG8_STAGE(PG8_SA(0, 1), a2 + hstep, voffA);
            PG8_WAIT_L(8); PG8_BAR; PG8_WAIT_L(0); PG8_MMA(0, 0, At, B0); PG8_BAR; PG8_SCHED;
            PG8_LDB(B1, 1, 1); PG8_STAGE(PG8_SB(1, 0), b3, voffB);
            PG8_BAR; PG8_WAIT_L(0); PG8_MMA(0, 1, At, B1); PG8_BAR;
            PG8_LDA(At, 1, 1); PG8_STAGE(PG8_SA(1, 0), a3, voffA);
            PG8_BAR; PG8_WAIT_L(0); PG8_MMA(1, 0, At, B0); PG8_BAR; PG8_SCHED;
            PG8_STAGE(PG8_SB(1, 1), b3 + hstep, voffB);
            PG8_WAIT_V(6); PG8_BAR; PG8_MMA(1, 1, At, B1); PG8_BAR;
            }
        }
        if constexpr (ALIGN_EPI) { if (wr == 0) PG8_BAR; }
        if constexpr (!Epi::AFTER_DRAIN) { E(acc, cur, wr, wc, fr, fq); S.done(cur); }
        if (!has_next) break;
#pragma unroll
        for (int a = 0; a < 2; ++a)
#pragma unroll
            for (int b = 0; b < 2; ++b)
#pragma unroll
                for (int m = 0; m < 4; ++m)
#pragma unroll
                    for (int n = 0; n < 2; ++n) acc[a][b][m][n] = (f32x4){0.f, 0.f, 0.f, 0.f};
        cur = nxt; cA = nA; cB = nB; ++ui;
        if constexpr (ALIGN_EPI) { if (wr == 1) PG8_BAR; }
    }
    PG8_WAIT_V(0);
    if constexpr (!ALIGN_EPI) { if (wr == 0) PG8_BAR; }
    PG8_BAR;
    if constexpr (Epi::AFTER_DRAIN) { E.fused(acc, cur, wr, wc, fr, fq, lds, wid, lane); S.done(cur); }
#undef PG8_SA
#undef PG8_SB
#undef PG8_STAGE
#undef PG8_LDA
#undef PG8_LDB
#undef PG8_MMA
#undef PG8_WAIT_V
#undef PG8_WAIT_L
#undef PG8_BAR
#undef PG8_SCHED
}
}

#define GAS __attribute__((address_space(1)))
#define LAS __attribute__((address_space(3)))
typedef unsigned short bf16;
typedef float f32x4 __attribute__((ext_vector_type(4)));
typedef float f32x16 __attribute__((ext_vector_type(16)));
typedef short bf16x8 __attribute__((ext_vector_type(8)));
typedef short s16x4 __attribute__((ext_vector_type(4)));
typedef unsigned u32x4 __attribute__((ext_vector_type(4)));
typedef unsigned u32x2 __attribute__((ext_vector_type(2)));
typedef float f32x2_t __attribute__((ext_vector_type(2)));
typedef __bf16 bf16x2_t __attribute__((ext_vector_type(2)));
typedef GAS unsigned gu32;
#define RLX_AGENT __ATOMIC_RELAXED, __HIP_MEMORY_SCOPE_AGENT

constexpr int D = 1024, BP = 4, TP = 4096, MP = BP * TP, BS = 128, TS = 8, MS = BS * TS, M = MP + MS;
constexpr int SBH = 8, HD = 64, SBW = 512, DNH = 4, DND = 128, DNW = 512;
constexpr int IN_COLS = 3592, NPROJ = 3584;
constexpr int DFF = 2816, DFF2 = 5632, NMOD = 6144, NC = BP + BS;
constexpr int PAST = 2048, NPAGES = 16, PAGE = 128;
constexpr float EPS = 1e-6f, LOG2E = 1.4426950408889634f;
constexpr float QSCALE = 0.125f * LOG2E;
constexpr int NSPLIT = 4, NPART = 5;

constexpr size_t O_YP = 0, O_KP = 17825792, O_VP = 26214400, O_KS = 34603008, O_VS = 35127296, O_SP = 35651584, O_SS = 35913728,
                 O_DCP = 44302336, O_DCS = 44320768, O_FCP = 44910592, O_FCS = 44955648, O_END = 46397440;

constexpr size_t MiB = 1u << 20;
constexpr size_t WS_CTL = 0, CTL_ZERO_BYTES = MiB;
constexpr size_t WS_MOD = 1 * MiB, WS_SC = 5 * MiB, WS_WINX = 6 * MiB, WS_WIN_T = 7 * MiB, WS_WOUT_T = 14 * MiB, WS_WUP_T = 16 * MiB, WS_WDN_T = 27 * MiB,
                 WS_EXTRA = 33 * MiB, WS_H = 34 * MiB, WS_DNRAW = 68 * MiB, WS_ZG = 120 * MiB, WS_QB = 306 * MiB, WS_KB = 323 * MiB, WS_VB = 340 * MiB, WS_QD = 357 * MiB, WS_KD = 391 * MiB,
                 WS_VD = 425 * MiB, WS_BETA = 459 * MiB, WS_LOGA = 460 * MiB, WS_ODN = 461 * MiB, WS_MIXED = 495 * MiB, WS_X1 = 529 * MiB, WS_UP = 597 * MiB,
                 WS_ACT = 784 * MiB, WS_U = 878 * MiB, WS_KCUM = 910 * MiB, WS_QDEC = 926 * MiB, WS_KDECT = 942 * MiB, WS_INTRA = 958 * MiB, WS_GL = 966 * MiB,
                 WS_OPART = 967 * MiB, WS_LPART = 978 * MiB, WS_SLAB = 980 * MiB, WS_END = 1024 * MiB;
constexpr int CW_Q0 = 1024;
constexpr int CW_QUEUE = 64;
constexpr int CW_BAR = 8192;

constexpr int RING_BYTES = 131072, MISC_OFF = RING_BYTES + 320, LDS_BYTES = 147456;

__device__ __forceinline__ unsigned cvtpk(float lo, float hi) { f32x2_t v = {lo, hi}; bf16x2_t b = __builtin_convertvector(v, bf16x2_t); return __builtin_bit_cast(unsigned, b); }
__device__ __forceinline__ bf16 f2bf(float f) { return (bf16)(cvtpk(f, 0.f) & 0xffffu); }
__device__ __forceinline__ float wave_sum(float v) {
#pragma unroll
    for (int o = 1; o < 64; o <<= 1) v += __shfl_xor(v, o);
    return v;
}
__device__ __forceinline__ float siluf(float x) { return x * __builtin_amdgcn_rcpf(1.f + __builtin_amdgcn_exp2f(-1.4426950408889634f * x)); }
__device__ __forceinline__ u32x4 pack8(const f32x4 a, const f32x4 b) { u32x4 w; w.x = cvtpk(a.x, a.y); w.y = cvtpk(a.z, a.w); w.z = cvtpk(b.x, b.y); w.w = cvtpk(b.z, b.w); return w; }
__device__ __forceinline__ float bf2f(unsigned short h) { return __uint_as_float((unsigned)h << 16); }

#define XB_TMO      128
#define XB_XCNT(j)  (256  + 64 * (j))
#define XB_XSUB(j)  (1280 + 64 * (j))
#define XB_XGEN(j)  (2304 + 64 * (j))
#define XB_TOP      3328
#define XB_TOPGEN   3392
#define XCD_BAR_WORDS 3456
#define XB_SPIN_CAP (1u << 18)
__device__ __forceinline__ unsigned xb_ld(unsigned* p)              { return __hip_atomic_load(p, __ATOMIC_RELAXED, __HIP_MEMORY_SCOPE_AGENT); }
__device__ __forceinline__ unsigned xb_add(unsigned* p, unsigned v) { return __hip_atomic_fetch_add(p, v, __ATOMIC_RELAXED, __HIP_MEMORY_SCOPE_AGENT); }
__device__ __forceinline__ unsigned xb_xcc_id() { return (unsigned)__builtin_amdgcn_s_getreg((3 << 11) | 20) & 0xFu; }
#define XB_SPIN(cond, bar) do { unsigned _sp = 0; while (cond) { __builtin_amdgcn_s_sleep(1); \
    if ((++_sp & 255u) == 0u) { if (xb_ld(&(bar)[XB_TMO])) break; if (_sp > XB_SPIN_CAP) { atomicAdd(&(bar)[XB_TMO], 1u); break; } } } } while (0)
struct XcdBarrier { unsigned* bar; unsigned x; volatile LAS unsigned* st; };
__device__ __forceinline__ XcdBarrier xcd_barrier_post(unsigned* bar, volatile LAS unsigned* st, int tid) {
    XcdBarrier b; b.bar = bar; b.x = xb_xcc_id(); b.st = st;
    if (tid == 0) (void)xb_add(&bar[XB_XCNT(b.x)], 1u);
    return b;
}
__device__ __forceinline__ void xcd_barrier_complete(unsigned* bar, unsigned x, unsigned& nloc, unsigned& nx) {
    const unsigned G = gridDim.x * gridDim.y * gridDim.z;
    unsigned sum, cnt, mine, sp = 0u;
    for (;;) {
        sum = 0u; cnt = 0u; mine = 0u;
#pragma unroll
        for (unsigned j = 0; j < 16; ++j) { const unsigned c = xb_ld(&bar[XB_XCNT(j)]); sum += c; cnt += (c > 0u) ? 1u : 0u; mine = (j == x) ? c : mine; }
        if (sum == G) break;
        __builtin_amdgcn_s_sleep(1);
        if ((++sp & 255u) == 0u) { if (xb_ld(&bar[XB_TMO])) break; if (sp > XB_SPIN_CAP) { atomicAdd(&bar[XB_TMO], 1u); break; } }
    }
    nloc = mine > 0u ? mine : 1u; nx = cnt > 0u ? cnt : 1u;
}
__device__ __forceinline__ void xcd_barrier(const XcdBarrier& b, int tid) {
    asm volatile("s_waitcnt vmcnt(0)" ::: "memory");
    __syncthreads();
    if (tid == 0) {
        unsigned* bar = b.bar;
        __builtin_amdgcn_s_waitcnt(0);
        unsigned nloc = b.st[0], nx = b.st[1];
        if (nloc == 0u) { xcd_barrier_complete(bar, b.x, nloc, nx); b.st[0] = nloc; b.st[1] = nx; }
        const unsigned old = xb_add(&bar[XB_XSUB(b.x)], 1u);
        const unsigned gen = old / nloc;
        if (old + 1u == (gen + 1u) * nloc) {
            __builtin_amdgcn_fence(__ATOMIC_RELEASE, "agent");
            asm volatile("s_waitcnt vmcnt(0)" ::: "memory");
            const unsigned og = xb_add(&bar[XB_TOP], 1u);
            const unsigned tg = og / nx;
            if (og + 1u == (tg + 1u) * nx) xb_add(&bar[XB_TOPGEN], 1u);
            else XB_SPIN(xb_ld(&bar[XB_TOPGEN]) == tg, bar);
            __builtin_amdgcn_fence(__ATOMIC_ACQUIRE, "agent");
            xb_add(&bar[XB_XGEN(b.x)], 1u);
            asm volatile("s_waitcnt vmcnt(0)" ::: "memory");
        } else {
            XB_SPIN(xb_ld(&bar[XB_XGEN(b.x)]) == gen, bar);
            __builtin_amdgcn_fence(__ATOMIC_ACQUIRE, "agent");
            asm volatile("s_waitcnt vmcnt(0)" ::: "memory");
        }
    }
    __syncthreads();
}

__device__ __forceinline__ int lane_now() { int l; asm volatile("v_mbcnt_lo_u32_b32 %0, -1, 0\n\tv_mbcnt_hi_u32_b32 %0, -1, %0" : "=v"(l)); return l; }
struct Args { const void* in[27]; float* out; unsigned char* ws; int lo, hi; };
enum { I_XP = 0, I_XS, I_CP, I_CS, I_CK, I_CV, I_PT, I_SD, I_SDC, I_SFC, I_WADA, I_BADA, I_GATT, I_WIN, I_GQ, I_GK, I_SBB, I_GSBO, I_WDNC, I_ALOG, I_DTB, I_GDNO, I_WOUT, I_GFFN, I_WUP, I_WFC, I_WDN };

__device__ __forceinline__ int mod_row(int m) { return m < MP ? (m >> 12) : BP + ((m - MP) >> 3); }

struct EpiF32 {
    static constexpr bool PERM = false, AFTER_DRAIN = false;
    float* O; int ldc;
    __device__ __forceinline__ void operator()(const pg8::f32x4 (&acc)[2][2][4][2], const pg8::Unit& u, int wr, int wc, int fr, int fq) const {
        const int row0 = u.pm * 256 + wr * 64 + fr, col0 = u.pn * 256 + wc * 32 + 4 * fq;
#pragma unroll
        for (int ai = 0; ai < 2; ++ai)
#pragma unroll
            for (int m = 0; m < 4; ++m) { float* rowp = O + (size_t)(row0 + ai * 128 + m * 16) * ldc + col0;
#pragma unroll
                for (int bj = 0; bj < 2; ++bj)
#pragma unroll
                    for (int n = 0; n < 2; ++n) *(pg8::f32x4*)(rowp + bj * 128 + n * 16) = acc[ai][bj][m][n]; }
    }
};
struct EpiResGate {
    static constexpr bool PERM = false, AFTER_DRAIN = false;
    const float* base0; const float* base1; const float* mod; int goff; float* out;
    __device__ __forceinline__ void operator()(const pg8::f32x4 (&acc)[2][2][4][2], const pg8::Unit& u, int wr, int wc, int fr, int fq) const {
        const int row0 = u.pm * 256 + wr * 64 + fr, col0 = u.pn * 256 + wc * 32 + 4 * fq;
#pragma unroll
        for (int ai = 0; ai < 2; ++ai)
#pragma unroll
            for (int m = 0; m < 4; ++m) { const int r = row0 + ai * 128 + m * 16;
                const float* bp = (r < MP ? base0 + (size_t)r * D : base1 + (size_t)(r - MP) * D) + col0;
                const float* gp = mod + (size_t)mod_row(r) * NMOD + goff + col0; float* op = out + (size_t)r * D + col0;
#pragma unroll
                for (int bj = 0; bj < 2; ++bj)
#pragma unroll
                    for (int n = 0; n < 2; ++n) { const pg8::f32x4 b = *(const pg8::f32x4*)(bp + bj * 128 + n * 16), g = *(const pg8::f32x4*)(gp + bj * 128 + n * 16);
                        *(pg8::f32x4*)(op + bj * 128 + n * 16) = b + g * acc[ai][bj][m][n]; } }
    }
};

struct SplitKOrder {
    int nks, G, c;
    __device__ __forceinline__ bool next(int i, pg8::Unit& u) const { const int L = i * G + c; if (L >= 16 * nks) return false; const int su = L & 15, ks = L >> 4; u.pm = MP / 256 + (su >> 2); u.pn = su & 3; u.ko = ks * 256; return true; }
    __device__ __forceinline__ void a_ready(const pg8::Unit&) const {}
    __device__ __forceinline__ void done(const pg8::Unit&) const {}
};
struct EpiSlab {
    static constexpr bool PERM = false, AFTER_DRAIN = false;
    float* slab;
    __device__ __forceinline__ void operator()(const pg8::f32x4 (&acc)[2][2][4][2], const pg8::Unit& u, int wr, int wc, int fr, int fq) const {
        float* O = slab + (size_t)(u.ko >> 8) * ((size_t)MS * D);
        const int row0 = (u.pm - MP / 256) * 256 + wr * 64 + fr, col0 = u.pn * 256 + wc * 32 + 4 * fq;
#pragma unroll
        for (int ai = 0; ai < 2; ++ai)
#pragma unroll
            for (int m = 0; m < 4; ++m) { float* rowp = O + (size_t)(row0 + ai * 128 + m * 16) * D + col0;
#pragma unroll
                for (int bj = 0; bj < 2; ++bj)
#pragma unroll
                    for (int n = 0; n < 2; ++n) *(pg8::f32x4*)(rowp + bj * 128 + n * 16) = acc[ai][bj][m][n]; }
    }
};
__device__ __forceinline__ void st16(void* base, unsigned off, u32x4 v) { *(u32x4*)((unsigned char*)base + off) = v; }
__device__ __forceinline__ void st16f(void* base, unsigned off, pg8::f32x4 v) { *(pg8::f32x4*)((unsigned char*)base + off) = v; }
struct EpiProj {
    static constexpr bool PERM = true, AFTER_DRAIN = false;
    float* out; bf16* QB; bf16* KB; bf16* VB; bf16* DNRAW; bf16* ZG; const float* g_q; const float* g_k; LAS float* xl;
    __device__ __forceinline__ void operator()(const pg8::f32x4 (&acc)[2][2][4][2], const pg8::Unit& u, int wr, int wc, int fr, int fq) const {
        const int pn = u.pn, rl0 = wr * 64 + fr, c0 = wc * 32 + 8 * fq;
        const unsigned row0 = (unsigned)u.pm * 256u + (unsigned)rl0;
        const bool prompt_tile = u.pm < MP / 256;
        if (pn < 4) {
            int xb = (rl0 * 8 + wc) * 4, xb2 = (rl0 * 8 + (wc ^ 1)) * 4; asm volatile("" : "+v"(xb), "+v"(xb2));
            LAS float* xw = (LAS float*)((LAS unsigned char*)xl + xb); const LAS float* xr = (const LAS float*)((LAS unsigned char*)xl + xb2);
#pragma unroll
            for (int ai = 0; ai < 2; ++ai)
#pragma unroll
                for (int m = 0; m < 4; ++m)
#pragma unroll
                    for (int bj = 0; bj < 2; ++bj) { const pg8::f32x4 a = acc[ai][bj][m][0], b = acc[ai][bj][m][1];
                        float ss = (a[0] * a[0] + a[1] * a[1]) + (a[2] * a[2] + a[3] * a[3]) + (b[0] * b[0] + b[1] * b[1]) + (b[2] * b[2] + b[3] * b[3]);
                        ss += __shfl_xor(ss, 16); ss += __shfl_xor(ss, 32);
                        if (fq == 0) xw[(ai * 128 + m * 16) * 8 + bj * 4] = ss; }
            asm volatile("s_waitcnt lgkmcnt(0)" ::: "memory"); __builtin_amdgcn_s_barrier(); asm volatile("" ::: "memory");
            const bool isq = pn < 2; const float* g = isq ? g_q : g_k; const int dloc = 32 * (wc & 1) + 8 * fq;
            const pg8::f32x4 g0 = *(const pg8::f32x4*)(g + dloc), g1 = *(const pg8::f32x4*)(g + dloc + 4);
            bf16* dstb = isq ? QB : KB; float* dstf = prompt_tile ? out + O_KP : out + O_KS - (size_t)MP * SBW;
#pragma unroll
            for (int ai = 0; ai < 2; ++ai)
#pragma unroll
                for (int m = 0; m < 4; ++m) { const unsigned row = row0 + ai * 128 + m * 16;
#pragma unroll
                    for (int bj = 0; bj < 2; ++bj) { const float tot = xw[(ai * 128 + m * 16) * 8 + bj * 4] + xr[(ai * 128 + m * 16) * 8 + bj * 4];
                        const float rs = (isq ? QSCALE : 1.0f) / sqrtf(tot * (1.f / HD) + EPS);
                        const pg8::f32x4 a = acc[ai][bj][m][0] * rs * g0, b = acc[ai][bj][m][1] * rs * g1;
                        const unsigned e = row * SBW + (unsigned)((pn & 1) * 256 + bj * 128 + c0);
                        st16(dstb, e * 2u, pack8(a, b));
                        if (!isq) { st16f(dstf, e * 4u, a); st16f(dstf, e * 4u + 16u, b); } }
                    asm volatile("" ::: "memory"); }
            asm volatile("s_waitcnt lgkmcnt(0)" ::: "memory"); __builtin_amdgcn_s_barrier(); asm volatile("" ::: "memory");
        } else if (pn < 6) {
            float* dstf = prompt_tile ? out + O_VP : out + O_VS - (size_t)MP * SBW;
#pragma unroll
            for (int ai = 0; ai < 2; ++ai)
#pragma unroll
                for (int m = 0; m < 4; ++m) { const unsigned row = row0 + ai * 128 + m * 16;
#pragma unroll
                    for (int bj = 0; bj < 2; ++bj) { const pg8::f32x4 a = acc[ai][bj][m][0], b = acc[ai][bj][m][1]; const unsigned e = row * SBW + (unsigned)((pn & 1) * 256 + bj * 128 + c0);
                        st16(VB, e * 2u, pack8(a, b)); st16f(dstf, e * 4u, a); st16f(dstf, e * 4u + 16u, b); }
                    asm volatile("" ::: "memory"); }
        } else if (pn < 12) {
#pragma unroll
            for (int ai = 0; ai < 2; ++ai)
#pragma unroll
                for (int m = 0; m < 4; ++m) { const unsigned row = row0 + ai * 128 + m * 16;
                    const int b = prompt_tile ? (int)(row >> 12) : (int)((row - MP) >> 3), t = prompt_tile ? (int)(row & 4095) : (int)((row - MP) & 7), idx = prompt_tile ? t - (TP - 3) : t - (TS - 3);
#pragma unroll
                    for (int bj = 0; bj < 2; ++bj) { const pg8::f32x4 a = acc[ai][bj][m][0], b2 = acc[ai][bj][m][1]; const unsigned ch = (unsigned)((pn - 6) * 256 + bj * 128 + c0);
                        st16(DNRAW, (row * 1536u + ch) * 2u, pack8(a, b2));
                        if (idx >= 0) { float* o = prompt_tile ? out + O_DCP : out + O_DCS; const unsigned eo = ((unsigned)(b * 3 + idx) * 1536u + ch) * 4u; st16f(o, eo, a); st16f(o, eo + 16u, b2); } }
                    asm volatile("" ::: "memory"); }
        } else {
#pragma unroll
            for (int ai = 0; ai < 2; ++ai)
#pragma unroll
                for (int m = 0; m < 4; ++m) { const unsigned row = row0 + ai * 128 + m * 16;
#pragma unroll
                    for (int bj = 0; bj < 2; ++bj) { pg8::f32x4 a = acc[ai][bj][m][0], b = acc[ai][bj][m][1]; const unsigned e = row * DNW + (unsigned)((pn - 12) * 256 + bj * 128 + c0);
                        a[0] = siluf(a[0]); a[1] = siluf(a[1]); a[2] = siluf(a[2]); a[3] = siluf(a[3]); b[0] = siluf(b[0]); b[1] = siluf(b[1]); b[2] = siluf(b[2]); b[3] = siluf(b[3]);
                        st16(ZG, e * 2u, pack8(a, b)); }
                    asm volatile("" ::: "memory"); }
        }
    }
};

__device__ __forceinline__ void mod_tile(const Args& A, LAS unsigned char* lds, int ct, int wave, int lane) {
    const float* w_ada = (const float*)A.in[I_WADA]; const float* b_ada = (const float*)A.in[I_BADA];
    const float* cp = (const float*)A.in[I_CP]; const float* cs = (const float*)A.in[I_CS]; float* MOD = (float*)(A.ws + WS_MOD);
    const int lr = lane & 15, q = lane >> 4, col = ct * 16 + lr;
    pg8::f32x4 acc[9];
#pragma unroll
    for (int i = 0; i < 9; ++i) acc[i] = (pg8::f32x4){0.f, 0.f, 0.f, 0.f};
#pragma unroll
    for (int s4 = 0; s4 < 4; ++s4) {
        const int k0 = 128 * wave + 32 * s4 + 8 * q;
        const float* wp = w_ada + (size_t)k0 * NMOD + col;
        float w[8];
#pragma unroll
        for (int j = 0; j < 8; ++j) w[j] = wp[(size_t)j * NMOD];
        u32x4 bw; bw.x = cvtpk(w[0], w[1]); bw.y = cvtpk(w[2], w[3]); bw.z = cvtpk(w[4], w[5]); bw.w = cvtpk(w[6], w[7]);
        const bf16x8 bfr = __builtin_bit_cast(bf16x8, bw);
#pragma unroll
        for (int i = 0; i < 9; ++i) { const int row = 16 * i + lr;
            f32x4 c0 = (f32x4){0.f, 0.f, 0.f, 0.f}, c1 = c0;
            if (row < NC) { const float* crow_ = (row < BP ? cp + (size_t)row * D : cs + (size_t)(row - BP) * D) + k0; c0 = *(const f32x4*)crow_; c1 = *(const f32x4*)(crow_ + 4); }
            c0.x = siluf(c0.x); c0.y = siluf(c0.y); c0.z = siluf(c0.z); c0.w = siluf(c0.w); c1.x = siluf(c1.x); c1.y = siluf(c1.y); c1.z = siluf(c1.z); c1.w = siluf(c1.w);
            acc[i] = __builtin_amdgcn_mfma_f32_16x16x32_bf16(__builtin_bit_cast(bf16x8, pack8(c0, c1)), bfr, acc[i], 0, 0, 0); }
    }
    LAS pg8::f32x4* red = (LAS pg8::f32x4*)lds;
#pragma unroll
    for (int i = 0; i < 9; ++i) red[(wave * 9 + i) * 64 + lane] = acc[i];
    __syncthreads();
    for (int i = wave; i < 9; i += 8) {
        pg8::f32x4 t = red[i * 64 + lane];
#pragma unroll
        for (int w2 = 1; w2 < 8; ++w2) t += red[(w2 * 9 + i) * 64 + lane];
        const float bb = b_ada[col];
#pragma unroll
        for (int r = 0; r < 4; ++r) { const int row = 16 * i + 4 * q + r; if (row < NC) MOD[(size_t)row * NMOD + col] = t[r] + bb; }
    }
    __syncthreads();
}
__device__ __forceinline__ void transpose_item(const float* W, int ldw, int src_col0, bf16* WT, int Kdst, int dst_row0, int k0, LAS float* scr, int lane) {
#pragma unroll
    for (int h2 = 0; h2 < 2; ++h2) { float v[16];
#pragma unroll
        for (int i = 0; i < 16; ++i) v[i] = W[(size_t)(k0 + 2 * (16 * h2 + i) + (lane >> 5)) * ldw + src_col0 + (lane & 31)];
#pragma unroll
        for (int i = 0; i < 16; ++i) scr[(2 * (16 * h2 + i) + (lane >> 5)) * 33 + (lane & 31)] = v[i]; }
    asm volatile("s_waitcnt lgkmcnt(0)" ::: "memory");
    const int c = lane & 7;
#pragma unroll
    for (int j = 0; j < 4; ++j) { const int n = (lane >> 3) + 8 * j; const LAS float* s = scr + (8 * c) * 33 + n;
        u32x4 o; o.x = cvtpk(s[0 * 33], s[1 * 33]); o.y = cvtpk(s[2 * 33], s[3 * 33]); o.z = cvtpk(s[4 * 33], s[5 * 33]); o.w = cvtpk(s[6 * 33], s[7 * 33]);
        *(u32x4*)(WT + (size_t)(dst_row0 + n) * Kdst + k0 + 8 * c) = o; }
    asm volatile("s_waitcnt lgkmcnt(0)" ::: "memory");
}
__device__ __forceinline__ void phase_prologue(const Args& A, LAS unsigned char* lds, gu32* qhead, int bx, int G, int wave, int lane, int gtid, int NGT) {
    unsigned char* ws = A.ws;
    const float* w_in = (const float*)A.in[I_WIN]; const float* w_out = (const float*)A.in[I_WOUT]; const float* w_up = (const float*)A.in[I_WUP]; const float* w_dn = (const float*)A.in[I_WDN];
    float* WX = (float*)(ws + WS_WINX);
    for (int i = gtid; i < 8 * D; i += NGT) { const int j = i >> 10, k = i & 1023; WX[i] = w_in[(size_t)k * IN_COLS + 3072 + j]; }
    for (int ct = bx; ct < NMOD / 16; ct += G) mod_tile(A, lds, ct, wave, lane);
    LAS float* scr = (LAS float*)(lds + wave * 16384);
    constexpr int I_IN = 16 * (NPROJ / 32), I_OUT = 16 * 32, I_UP = 16 * (DFF2 / 32), I_DN = (DFF / 64) * 32, NIT = I_IN + I_OUT + I_UP + I_DN;
    for (int it_ = bx * 8 + wave; it_ < NIT; it_ += G * 8) {
        int r = it_;
        if (r < I_IN) { const int nb = r % (NPROJ / 32), kb = r / (NPROJ / 32); const int n0 = nb * 32; transpose_item(w_in, IN_COLS, n0 < 3072 ? n0 : n0 + 8, (bf16*)(ws + WS_WIN_T), D, n0, kb * 64, scr, lane); continue; } r -= I_IN;
        if (r < I_OUT) { const int nb = r % 32, kb = r / 32; transpose_item(w_out, D, nb * 32, (bf16*)(ws + WS_WOUT_T), D, nb * 32, kb * 64, scr, lane); continue; } r -= I_OUT;
        if (r < I_UP) { const int nb = r % (DFF2 / 32), kb = r / (DFF2 / 32); transpose_item(w_up, DFF2, nb * 32, (bf16*)(ws + WS_WUP_T), D, nb * 32, kb * 64, scr, lane); continue; } r -= I_UP;
        { const int nb = r % 32, kb = r / 32; transpose_item(w_dn, D, nb * 32, (bf16*)(ws + WS_WDN_T), DFF, nb * 32, kb * 64, scr, lane); }
    }
}

template <bool EXTRAS, int NS = 0>
__device__ __forceinline__ void phase_norm(const float* x0, const float* x1, const float* g, const float* MOD, int sh_off, int sc_off, bf16* H, const float* WX, float* EXTRA, int gw, int NGW, int lane, const float* slab = nullptr, int gate_off = 0, float* x1w = nullptr) {
    f32x4 wxr[4][8];
    if (EXTRAS) {
#pragma unroll
        for (int j = 0; j < 4; ++j)
#pragma unroll
            for (int e = 0; e < 8; ++e) wxr[j][e] = *(const f32x4*)(WX + e * D + 4 * (lane + 64 * j));
    }
    for (int m = gw; m < M; m += NGW) {
        const float* xr = m < MP ? x0 + (size_t)m * D : x1 + (size_t)(m - MP) * D;
        const float* mod = MOD + (size_t)mod_row(m) * NMOD;
        f32x4 v[4]; float ss = 0.f;
#pragma unroll
        for (int j = 0; j < 4; ++j) { v[j] = *(const f32x4*)(xr + 4 * (lane + 64 * j));
            if (NS > 0 && m >= MP) { f32x4 a = (f32x4){0.f, 0.f, 0.f, 0.f};
#pragma unroll
                for (int k = 0; k < NS; ++k) a += *(const f32x4*)(slab + ((size_t)k * MS + (m - MP)) * D + 4 * (lane + 64 * j));
                v[j] += *(const f32x4*)(mod + gate_off + 4 * (lane + 64 * j)) * a;
                *(f32x4*)(x1w + (size_t)m * D + 4 * (lane + 64 * j)) = v[j]; }
            ss += (v[j].x * v[j].x + v[j].y * v[j].y) + (v[j].z * v[j].z + v[j].w * v[j].w); }
        ss = wave_sum(ss);
        const float rstd = 1.0f / sqrtf(ss * (1.f / D) + EPS);
        float ex[8];
#pragma unroll
        for (int e = 0; e < 8; ++e) ex[e] = 0.f;
#pragma unroll
        for (int j = 0; j < 4; ++j) { const int c = 4 * (lane + 64 * j);
            const f32x4 gg = *(const f32x4*)(g + c), sc = *(const f32x4*)(mod + sc_off + c), sh = *(const f32x4*)(mod + sh_off + c);
            const f32x4 h = (v[j] * rstd) * gg * (sc + 1.0f) + sh;
            u32x2 w; w.x = cvtpk(h.x, h.y); w.y = cvtpk(h.z, h.w); *(u32x2*)(H + (size_t)m * D + c) = w;
            if (EXTRAS) {
#pragma unroll
                for (int e = 0; e < 8; ++e) { const f32x4 wx = wxr[j][e]; ex[e] += (h.x * wx.x + h.y * wx.y) + (h.z * wx.z + h.w * wx.w); }
            }
        }
        if (EXTRAS) {
            float a4[4], a2[2], a1;
#pragma unroll
            for (int j = 0; j < 4; ++j) { const bool up = lane & 1; const float send = up ? ex[j] : ex[j + 4], keep = up ? ex[j + 4] : ex[j]; a4[j] = keep + __shfl_xor(send, 1); }
#pragma unroll
            for (int j = 0; j < 2; ++j) { const bool up = lane & 2; const float send = up ? a4[j] : a4[j + 2], keep = up ? a4[j + 2] : a4[j]; a2[j] = keep + __shfl_xor(send, 2); }
            { const bool up = lane & 4; const float send = up ? a2[0] : a2[1], keep = up ? a2[1] : a2[0]; a1 = keep + __shfl_xor(send, 4); }
            a1 += __shfl_xor(a1, 8); a1 += __shfl_xor(a1, 16); a1 += __shfl_xor(a1, 32);
            if (lane < 8) EXTRA[(size_t)m * 8 + (4 * (lane & 1) + 2 * ((lane >> 1) & 1) + ((lane >> 2) & 1))] = a1;
        }
    }
}

__device__ __forceinline__ f32x4 bf4lo(u32x4 w) { return (f32x4){__uint_as_float(w.x << 16), __uint_as_float(w.x & 0xffff0000u), __uint_as_float(w.y << 16), __uint_as_float(w.y & 0xffff0000u)}; }
__device__ __forceinline__ f32x4 bf4hi(u32x4 w) { return (f32x4){__uint_as_float(w.z << 16), __uint_as_float(w.z & 0xffff0000u), __uint_as_float(w.w << 16), __uint_as_float(w.w & 0xffff0000u)}; }
__device__ __forceinline__ void post_strip(const Args& A, int m0, int R, int part, int lane) {
    unsigned char* ws = A.ws; const bf16* DNRAW = (const bf16*)(ws + WS_DNRAW);
    const float* wc = (const float*)A.in[I_WDNC]; const float* sdc = (const float*)A.in[I_SDC];
    float* dstb = (part == 0 ? (float*)(ws + WS_QD) : part == 1 ? (float*)(ws + WS_KD) : (float*)(ws + WS_VD));
    const bool prompt = m0 < MP; const int b = prompt ? (m0 >> 12) : ((m0 - MP) >> 3), t0 = prompt ? (m0 & 4095) : ((m0 - MP) & 7);
    const int ch = part * 512 + 8 * lane;
    f32x4 w[4][2];
#pragma unroll
    for (int i = 0; i < 4; ++i) { w[i][0] = *(const f32x4*)(wc + i * 1536 + ch); w[i][1] = *(const f32x4*)(wc + i * 1536 + ch + 4); }
    f32x4 x[3][2];
#pragma unroll
    for (int j = 0; j < 3; ++j) { const int tt = t0 - 3 + j;
        if (tt >= 0) { const u32x4 r = *(const u32x4*)(DNRAW + (size_t)(m0 - 3 + j) * 1536 + ch); x[j][0] = bf4lo(r); x[j][1] = bf4hi(r); }
        else if (!prompt) { const float* p = sdc + ((size_t)b * 3 + (3 + tt)) * 1536 + ch; x[j][0] = *(const f32x4*)p; x[j][1] = *(const f32x4*)(p + 4); }
        else { x[j][0] = (f32x4){0.f, 0.f, 0.f, 0.f}; x[j][1] = x[j][0]; } }
    const bf16* src = DNRAW + (size_t)m0 * 1536 + ch;
    u32x4 nx = *(const u32x4*)src;
    for (int r = 0; r < R; ++r) {
        const u32x4 cw = nx;
        if (r + 1 < R) nx = *(const u32x4*)(src + (size_t)(r + 1) * 1536);
        const f32x4 c0 = bf4lo(cw), c1 = bf4hi(cw);
        f32x4 y0 = w[0][0] * x[0][0] + w[1][0] * x[1][0] + w[2][0] * x[2][0] + w[3][0] * c0;
        f32x4 y1 = w[0][1] * x[0][1] + w[1][1] * x[1][1] + w[2][1] * x[2][1] + w[3][1] * c1;
        x[0][0] = x[1][0]; x[0][1] = x[1][1]; x[1][0] = x[2][0]; x[1][1] = x[2][1]; x[2][0] = c0; x[2][1] = c1;
        y0.x = siluf(y0.x); y0.y = siluf(y0.y); y0.z = siluf(y0.z); y0.w = siluf(y0.w); y1.x = siluf(y1.x); y1.y = siluf(y1.y); y1.z = siluf(y1.z); y1.w = siluf(y1.w);
        if (part < 2) {
            float ss = (y0.x * y0.x + y0.y * y0.y) + (y0.z * y0.z + y0.w * y0.w) + (y1.x * y1.x + y1.y * y1.y) + (y1.z * y1.z + y1.w * y1.w);
            ss += __shfl_xor(ss, 1); ss += __shfl_xor(ss, 2); ss += __shfl_xor(ss, 4); ss += __shfl_xor(ss, 8);
            const float rs = (part == 0 ? 0.08838834764831845f : 1.0f) / sqrtf(ss + EPS);
            y0 = y0 * rs; y1 = y1 * rs;
        }
        float* dst = dstb + (size_t)(m0 + r) * DNW + 8 * lane;
        *(f32x4*)dst = y0; *(f32x4*)(dst + 4) = y1;
    }
}
__device__ __forceinline__ void phase_post(const Args& A, int gw, int NGW, int lane, int gtid, int NGT) {
    constexpr int NPI = (MP / 16) * 3, NSI = BS * 3;
    for (int it = gw; it < NPI + NSI; it += NGW) {
        if (it < NPI) post_strip(A, (it / 3) * 16, 16, it % 3, lane);
        else { const int j = it - NPI; post_strip(A, MP + (j / 3) * 8, 8, j % 3, lane); }
    }
    unsigned char* ws = A.ws; const float* a_log = (const float*)A.in[I_ALOG]; const float* dtb = (const float*)A.in[I_DTB];
    float* BETA = (float*)(ws + WS_BETA); float* LOGA = (float*)(ws + WS_LOGA); const float* EXTRA = (const float*)(ws + WS_EXTRA);
    for (int i = gtid; i < M * 8; i += NGT) { const int m = i >> 3, j = i & 7; const float x = EXTRA[i];
        if (j < 4) BETA[m * 4 + j] = 1.f / (1.f + __expf(-x));
        else { const int h = j - 4; const float z = x + dtb[h]; const float sp = fmaxf(z, 0.f) + log1pf(__expf(-fabsf(z))); LOGA[m * 4 + h] = -__expf(a_log[h]) * sp; } }
}

template <int B0, int B1> __device__ __forceinline__ void subst_rows(float (&x)[64], const LAS float* Am) {
#pragma unroll
    for (int ib = B0; ib < B1; ++ib) {
        float r[4];
#pragma unroll
        for (int rr = 0; rr < 4; ++rr) r[rr] = x[4 * ib + rr];
#pragma unroll
        for (int j4 = 0; j4 < ib; ++j4) {
#pragma unroll
            for (int rr = 0; rr < 4; ++rr) { const f32x4 a = *(const LAS f32x4*)(Am + (4 * ib + rr) * 64 + 4 * j4);
                r[rr] -= (a.x * x[4 * j4] + a.y * x[4 * j4 + 1]) + (a.z * x[4 * j4 + 2] + a.w * x[4 * j4 + 3]); }
        }
        const f32x4 d1 = *(const LAS f32x4*)(Am + (4 * ib + 1) * 64 + 4 * ib), d2 = *(const LAS f32x4*)(Am + (4 * ib + 2) * 64 + 4 * ib), d3 = *(const LAS f32x4*)(Am + (4 * ib + 3) * 64 + 4 * ib);
        r[1] -= d1.x * r[0];
        r[2] -= d2.x * r[0] + d2.y * r[1];
        r[3] -= (d3.x * r[0] + d3.y * r[1]) + d3.z * r[2];
#pragma unroll
        for (int rr = 0; rr < 4; ++rr) x[4 * ib + rr] = r[rr];
    }
}
constexpr int PS_INT = 34816, PS_STG = 53248;
template <int LEVEL = 0>
__device__ __forceinline__ void dn_prescan_unit(const Args& A, LAS unsigned char* lds, int unit, int tid, int wave, int lane) {
    unsigned char* ws = A.ws;
    const float* QD = (const float*)(ws + WS_QD); const float* KD = (const float*)(ws + WS_KD); const float* VD = (const float*)(ws + WS_VD);
    const float* BETA = (const float*)(ws + WS_BETA); const float* LOGA = (const float*)(ws + WS_LOGA);
    const int hp = unit & 1, n = (unit >> 1) & 63, b = unit >> 7;
    const int half = tid >> 8, ht = tid & 255, h = 2 * hp + half, item = (b * 64 + n) * 4 + h;
    const int m0 = b * TP + n * 64;
    LAS float* Am = (LAS float*)lds + half * 4096;
    LAS float* gs = (LAS float*)(lds + 32768) + half * 128;
    if (ht < 64) {
        float v = LOGA[(size_t)(m0 + ht) * 4 + h];
#pragma unroll
        for (int o = 1; o < 64; o <<= 1) { const float u = __shfl_up(v, o); if (ht >= o) v += u; }
        gs[ht] = v; gs[64 + ht] = BETA[(size_t)(m0 + ht) * 4 + h];
    }
    __syncthreads();
    {
        const int wl = wave & 3, lr = lane & 15, q = lane >> 4;
        pg8::f32x4 kk[4], qk[4];
#pragma unroll
        for (int j = 0; j < 4; ++j) { kk[j] = (pg8::f32x4){0.f, 0.f, 0.f, 0.f}; qk[j] = kk[j]; }
#pragma unroll
        for (int s = 0; s < 4; ++s) {
            const float* kp = KD + (size_t)(m0 + 16 * wl + lr) * DNW + h * 128 + 32 * s + 8 * q; const float* qp = QD + (size_t)(m0 + 16 * wl + lr) * DNW + h * 128 + 32 * s + 8 * q;
            const bf16x8 ak = __builtin_bit_cast(bf16x8, pack8(*(const f32x4*)kp, *(const f32x4*)(kp + 4))), aq = __builtin_bit_cast(bf16x8, pack8(*(const f32x4*)qp, *(const f32x4*)(qp + 4)));
#pragma unroll
            for (int j = 0; j < 4; ++j) { const float* bp = KD + (size_t)(m0 + 16 * j + lr) * DNW + h * 128 + 32 * s + 8 * q;
                const bf16x8 bk = __builtin_bit_cast(bf16x8, pack8(*(const f32x4*)bp, *(const f32x4*)(bp + 4)));
                kk[j] = __builtin_amdgcn_mfma_f32_16x16x32_bf16(ak, bk, kk[j], 0, 0, 0); qk[j] = __builtin_amdgcn_mfma_f32_16x16x32_bf16(aq, bk, qk[j], 0, 0, 0); }
        }
#pragma unroll
        for (int j = 0; j < 4; ++j)
#pragma unroll
            for (int r = 0; r < 4; ++r) { const int i = 16 * wl + 4 * q + r, jj = 16 * j + lr;
                const float dec = (i >= jj) ? __expf(gs[i] - gs[jj]) : 0.f;
                Am[i * 64 + jj] = (i > jj) ? gs[64 + i] * kk[j][r] * dec : 0.f;
                *(LAS bf16*)(lds + PS_INT + half * 9216 + i * 144 + jj * 2) = f2bf(qk[j][r] * dec); }
    }
    __syncthreads();
    if constexpr (LEVEL == 1) { __syncthreads(); return; }
    {
        const int c = ht;
        float* U = (float*)(ws + WS_U) + (size_t)item * 8192; bf16* KC = (bf16*)(ws + WS_KCUM) + (size_t)item * 8192;
        float x[64];
        { const float* rsrc = (ht < 128 ? VD : KD) + (size_t)m0 * DNW + h * 128 + (ht & 127);
#pragma unroll
          for (int i = 0; i < 64; ++i) x[i] = rsrc[(size_t)i * DNW]; }
#pragma unroll
        for (int i = 0; i < 64; ++i) { const float eg = __expf(gs[i]); x[i] *= gs[64 + i] * (c >= 128 ? eg : 1.0f); }
        { bf16* INTRA = (bf16*)(ws + WS_INTRA) + (size_t)item * 4096;
#pragma unroll
          for (int j = 0; j < 2; ++j) { const int k = ht + 256 * j, row = k >> 3, c8 = (k & 7) * 8; *(u32x4*)(INTRA + row * 64 + c8) = *(const LAS u32x4*)(lds + PS_INT + half * 9216 + row * 144 + c8 * 2); } }
        subst_rows<0, 6>(x, Am); subst_rows<6, 10>(x, Am); subst_rows<10, 13>(x, Am); subst_rows<13, 16>(x, Am);
        if constexpr (LEVEL == 2) { float sk = 0.f; _Pragma("unroll") for (int i = 0; i < 64; ++i) sk += x[i]; asm volatile("" :: "v"(sk)); __syncthreads(); return; }
        LAS float* stg = (LAS float*)(lds + PS_STG + half * 33280);
#pragma unroll
        for (int ps = 0; ps < 2; ++ps) {
            if (ps) __syncthreads();
#pragma unroll
            for (int i = 0; i < 32; ++i) stg[i * 260 + c] = x[32 * ps + i];
            __syncthreads();
#pragma unroll
            for (int j = 0; j < 4; ++j) { const int k = ht + 256 * j, il = k >> 9, w_ = (k >> 6) & 7, ln = k & 63, rb = 16 * il + 4 * (ln >> 4), cc = 16 * w_ + (ln & 15);
                *(f32x4*)(U + (((2 * ps + il) * 8 + w_) * 64 + ln) * 4) = (f32x4){stg[rb * 260 + cc], stg[(rb + 1) * 260 + cc], stg[(rb + 2) * 260 + cc], stg[(rb + 3) * 260 + cc]}; }
#pragma unroll
            for (int j = 0; j < 2; ++j) { const int k = ht + 256 * j, row = k >> 4, c8 = (k & 15) * 8; const LAS float* sp = stg + row * 260 + 128 + c8;
                *(u32x4*)(KC + (32 * ps + row) * 128 + c8) = pack8(*(const LAS f32x4*)sp, *(const LAS f32x4*)(sp + 4)); }
        }
    }
    if constexpr (LEVEL == 3) { __syncthreads(); return; }
    {
        const float glast = gs[63];
        bf16* QDc = (bf16*)(ws + WS_QDEC) + (size_t)item * 8192; bf16* KT = (bf16*)(ws + WS_KDECT) + (size_t)item * 8192;
#pragma unroll
        for (int j = 0; j < 4; ++j) { const int k = ht + 256 * j, row = k >> 4, c8 = (k & 15) * 8; const float* qp = QD + (size_t)(m0 + row) * DNW + h * 128 + c8; const float eg = __expf(gs[row]);
            *(u32x4*)(QDc + row * 128 + c8) = pack8(*(const f32x4*)qp * eg, *(const f32x4*)(qp + 4) * eg); }
        { const int d = ht & 127, ig = ht >> 7;
#pragma unroll
            for (int i8 = 0; i8 < 4; ++i8) { float v[8];
#pragma unroll
                for (int k = 0; k < 8; ++k) { const int i = 32 * ig + 8 * i8 + k; v[k] = KD[(size_t)(m0 + i) * DNW + h * 128 + d] * __expf(glast - gs[i]); }
                u32x4 w; w.x = cvtpk(v[0], v[1]); w.y = cvtpk(v[2], v[3]); w.z = cvtpk(v[4], v[5]); w.w = cvtpk(v[6], v[7]);
                *(u32x4*)(KT + d * 64 + 32 * ig + 8 * i8) = w; } }
        if (ht == 0) ((float*)(ws + WS_GL))[item] = __expf(glast);
    }
    __syncthreads();
}
__device__ __forceinline__ void dn_sample_unit(const Args& A, LAS unsigned char* lds, int unit, int tid) {
    unsigned char* ws = A.ws;
    const float* QD = (const float*)(ws + WS_QD); const float* KD = (const float*)(ws + WS_KD); const float* VD = (const float*)(ws + WS_VD);
    const float* BETA = (const float*)(ws + WS_BETA); const float* LOGA = (const float*)(ws + WS_LOGA); float* ODN = (float*)(ws + WS_ODN);
    const int h = unit & 3, b = unit >> 2, e = tid & 127, dq = tid >> 7;
    const float* s0 = (const float*)A.in[I_SD] + ((size_t)(b * 4 + h) * 128 + 32 * dq) * 128 + e;
    float S[32];
#pragma unroll
    for (int d = 0; d < 32; ++d) S[d] = s0[(size_t)d * 128];
    LAS float* red = (LAS float*)lds; LAS float* red2 = red + 512; LAS float* tk = red + 1024;
#pragma unroll
    for (int j = 0; j < 6; ++j) { const int i = tid + 512 * j, t = i / 384, c = i % 384, part = c >> 7; const int m = MP + b * TS + t;
        const unsigned sel = part == 0 ? 1u : part == 1 ? 0u : 2u;
        tk[i] = QD[sel * (unsigned)((WS_KD - WS_QD) / 4) + (unsigned)m * DNW + h * 128 + (c & 127)]; }
    if (tid < 16) { const size_t m = (size_t)(MP + b * TS + (tid >> 1)); tk[3072 + tid] = (tid & 1) ? BETA[m * 4 + h] : __expf(LOGA[m * 4 + h]); }
    __syncthreads();
    for (int t = 0; t < TS; ++t) {
        const int m = MP + b * TS + t;
        const float a = tk[3072 + 2 * t], bt = tk[3072 + 2 * t + 1];
        const LAS float* kp = tk + t * 384 + 32 * dq; const LAS float* qp = kp + 128;
        float kd[32], qd[32];
#pragma unroll
        for (int d4 = 0; d4 < 8; ++d4) { const f32x4 kv = *(const LAS f32x4*)(kp + 4 * d4), qv = *(const LAS f32x4*)(qp + 4 * d4);
            kd[4 * d4] = kv.x; kd[4 * d4 + 1] = kv.y; kd[4 * d4 + 2] = kv.z; kd[4 * d4 + 3] = kv.w; qd[4 * d4] = qv.x; qd[4 * d4 + 1] = qv.y; qd[4 * d4 + 2] = qv.z; qd[4 * d4 + 3] = qv.w; }
        float p0 = 0.f, p1 = 0.f;
#pragma unroll
        for (int d = 0; d < 32; d += 2) { p0 += kd[d] * S[d]; p1 += kd[d + 1] * S[d + 1]; }
        red[dq * 128 + e] = p0 + p1;
        __syncthreads();
        const float kS = (red[e] + red[128 + e]) + (red[256 + e] + red[384 + e]);
        const float dl = bt * (tk[t * 384 + 256 + e] - a * kS);
        float po0 = 0.f, po1 = 0.f;
#pragma unroll
        for (int d = 0; d < 32; d += 2) { S[d] = a * S[d] + kd[d] * dl; po0 += qd[d] * S[d]; S[d + 1] = a * S[d + 1] + kd[d + 1] * dl; po1 += qd[d + 1] * S[d + 1]; }
        red2[dq * 128 + e] = po0 + po1;
        __syncthreads();
        if (dq == 0) ODN[(size_t)m * DNW + h * 128 + e] = (red2[e] + red2[128 + e]) + (red2[256 + e] + red2[384 + e]);
    }
    float* so = A.out + O_SS + ((size_t)(b * 4 + h) * 128 + 32 * dq) * 128 + e;
#pragma unroll
    for (int d = 0; d < 32; ++d) so[(size_t)d * 128] = S[d];
    __syncthreads();
}

constexpr int SC_KC = 0, SC_QD = 17408, SC_KT = 34816, SC_IN = 53248, SC_BUF = 62464;
__device__ __forceinline__ void dn_scan_chain(const Args& A, LAS unsigned char* lds, int chain, int tid, int wave, int lane) {
    unsigned char* ws = A.ws;
    const float* Ub = (const float*)(ws + WS_U); const float* GL = (const float*)(ws + WS_GL); float* ODN = (float*)(ws + WS_ODN);
    const int b = chain >> 2, h = chain & 3, lr = lane & 15, q = lane >> 4, e = 16 * wave + lr;
    int ldst[7];
    { const int c0 = tid, c1 = tid + 512;
      ldst[0] = SC_KC + (c0 >> 4) * 272; ldst[1] = SC_KC + (c1 >> 4) * 272; ldst[2] = SC_QD + (c0 >> 4) * 272; ldst[3] = SC_QD + (c1 >> 4) * 272;
      ldst[4] = SC_KT + (c0 >> 3) * 144; ldst[5] = SC_KT + (c1 >> 3) * 144; ldst[6] = SC_IN + (c0 >> 3) * 144; }
    const int cb_ = tid & 3, hA_ = (8 * ((2 * cb_) & 3) + 4 * (cb_ >> 1)) * 2, hB_ = (8 * ((2 * cb_ + 1) & 3) + 4 * (cb_ >> 1)) * 2;
    const int o16A = ((tid & 15) >> 2) * 64 + hA_, o16B = ((tid & 15) >> 2) * 64 + hB_, o8A = ((tid & 7) >> 2) * 64 + hA_, o8B = ((tid & 7) >> 2) * 64 + hB_;
    const size_t item0 = (size_t)(b * 64) * 4 + h;
    const unsigned char* gKC = ws + WS_KCUM + item0 * 16384; const unsigned char* gQD = ws + WS_QDEC + item0 * 16384; const unsigned char* gKT = ws + WS_KDECT + item0 * 16384; const unsigned char* gIN = ws + WS_INTRA + item0 * 8192;
    const unsigned t16 = (unsigned)tid * 16u, ulane = (unsigned)(wave * 64 + lane) * 4u;
    u32x4 R[7]; float un[16], uc[16];
#define SC_GLOAD(n_) do { const size_t o16_ = (size_t)(n_) * 4 * 16384, o8_ = (size_t)(n_) * 4 * 8192; \
        R[0] = *(const u32x4*)(gKC + o16_ + t16); R[1] = *(const u32x4*)(gKC + o16_ + 8192 + t16); R[2] = *(const u32x4*)(gQD + o16_ + t16); R[3] = *(const u32x4*)(gQD + o16_ + 8192 + t16); \
        R[4] = *(const u32x4*)(gKT + o16_ + t16); R[5] = *(const u32x4*)(gKT + o16_ + 8192 + t16); R[6] = *(const u32x4*)(gIN + o8_ + t16); \
        const float* U_ = Ub + (item0 + 4 * (size_t)(n_)) * 8192; \
        _Pragma("unroll") for (int i_ = 0; i_ < 4; ++i_) { const f32x4 u_ = *(const f32x4*)(U_ + (ulane + (unsigned)(i_ * 2048))); un[4 * i_] = u_.x; un[4 * i_ + 1] = u_.y; un[4 * i_ + 2] = u_.z; un[4 * i_ + 3] = u_.w; } } while (0)
#define SC_LWRITE(buf_) do { _Pragma("unroll") for (int k_ = 0; k_ < 7; ++k_) { LAS unsigned char* d_ = lds + (buf_) * SC_BUF + ldst[k_]; \
        *(LAS u32x2*)(d_ + (k_ < 4 ? o16A : o8A)) = (u32x2){R[k_].x, R[k_].y}; *(LAS u32x2*)(d_ + (k_ < 4 ? o16B : o8B)) = (u32x2){R[k_].z, R[k_].w}; } } while (0)
#define SC_BARRIER() do { asm volatile("s_waitcnt lgkmcnt(0)" ::: "memory"); __builtin_amdgcn_s_barrier(); asm volatile("" ::: "memory"); } while (0)
#define SC_FRAG(off_, pitch_, row_, s_) (*(const LAS bf16x8*)(B + (off_) + (row_) * (pitch_) + (32 * (s_) + 8 * q) * 2))
    pg8::f32x4 S[8];
#pragma unroll
    for (int i = 0; i < 8; ++i) S[i] = (pg8::f32x4){0.f, 0.f, 0.f, 0.f};
    const float glv = GL[item0 + 4 * (size_t)lane];
    __syncthreads();
    SC_GLOAD(0); SC_LWRITE(0);
#pragma unroll
    for (int k = 0; k < 16; ++k) uc[k] = un[k];
    __syncthreads();
    for (int n = 0; n < 64; ++n) {
        const float gl = __uint_as_float(__builtin_amdgcn_readlane(__float_as_uint(glv), n));
        if (n + 1 < 64) SC_GLOAD(n + 1);
        const LAS unsigned char* B = lds + (n & 1) * SC_BUF;
        bf16x8 Sb[4];
#pragma unroll
        for (int s = 0; s < 4; ++s) { u32x4 w; w.x = cvtpk(S[2 * s][0], S[2 * s][1]); w.y = cvtpk(S[2 * s][2], S[2 * s][3]); w.z = cvtpk(S[2 * s + 1][0], S[2 * s + 1][1]); w.w = cvtpk(S[2 * s + 1][2], S[2 * s + 1][3]); Sb[s] = __builtin_bit_cast(bf16x8, w); }
        pg8::f32x4 vn[4], o[4];
#pragma unroll
        for (int ih = 0; ih < 2; ++ih) {
            bf16x8 fk[2][4], fq[2][4];
#pragma unroll
            for (int ii = 0; ii < 2; ++ii)
#pragma unroll
                for (int s = 0; s < 4; ++s) { fk[ii][s] = SC_FRAG(SC_KC, 272, 16 * (2 * ih + ii) + lr, s); fq[ii][s] = SC_FRAG(SC_QD, 272, 16 * (2 * ih + ii) + lr, s); }
#pragma unroll
            for (int ii = 0; ii < 2; ++ii) { const int i = 2 * ih + ii;
                pg8::f32x4 ak = (pg8::f32x4){0.f, 0.f, 0.f, 0.f}, aq = ak;
#pragma unroll
                for (int s = 0; s < 4; ++s) { ak = __builtin_amdgcn_mfma_f32_16x16x32_bf16(fk[ii][s], Sb[s], ak, 0, 0, 0); aq = __builtin_amdgcn_mfma_f32_16x16x32_bf16(fq[ii][s], Sb[s], aq, 0, 0, 0); }
#pragma unroll
                for (int r = 0; r < 4; ++r) vn[i][r] = uc[4 * i + r] - ak[r];
                o[i] = aq; }
        }
        bf16x8 Vb[2];
#pragma unroll
        for (int s = 0; s < 2; ++s) { u32x4 w; w.x = cvtpk(vn[2 * s][0], vn[2 * s][1]); w.y = cvtpk(vn[2 * s][2], vn[2 * s][3]); w.z = cvtpk(vn[2 * s + 1][0], vn[2 * s + 1][1]); w.w = cvtpk(vn[2 * s + 1][2], vn[2 * s + 1][3]); Vb[s] = __builtin_bit_cast(bf16x8, w); }
        {
            bf16x8 fi[4][2], ft[8][2];
#pragma unroll
            for (int i = 0; i < 4; ++i)
#pragma unroll
                for (int s = 0; s < 2; ++s) fi[i][s] = SC_FRAG(SC_IN, 144, 16 * i + lr, s);
#pragma unroll
            for (int i = 0; i < 8; ++i)
#pragma unroll
                for (int s = 0; s < 2; ++s) ft[i][s] = SC_FRAG(SC_KT, 144, 16 * i + lr, s);
#pragma unroll
            for (int i = 0; i < 4; ++i) {
#pragma unroll
                for (int s = 0; s < 2; ++s) o[i] = __builtin_amdgcn_mfma_f32_16x16x32_bf16(fi[i][s], Vb[s], o[i], 0, 0, 0);
                *(f32x4*)(ODN + ((item0 + 4 * (size_t)n) * 8192) + (ulane + (unsigned)(i * 2048))) = (f32x4){o[i][0], o[i][1], o[i][2], o[i][3]};
            }
#pragma unroll
            for (int i = 0; i < 8; ++i) {
                pg8::f32x4 acc = S[i] * gl;
#pragma unroll
                for (int s = 0; s < 2; ++s) acc = __builtin_amdgcn_mfma_f32_16x16x32_bf16(ft[i][s], Vb[s], acc, 0, 0, 0);
                S[i] = acc;
            }
        }
        if (n + 1 < 64) {
            SC_LWRITE((n + 1) & 1);
#pragma unroll
            for (int k = 0; k < 16; ++k) uc[k] = un[k];
        }
        SC_BARRIER();
    }
#undef SC_GLOAD
#undef SC_LWRITE
#undef SC_FRAG
    float* so = A.out + O_SP + (size_t)(b * 4 + h) * 16384;
#pragma unroll
    for (int i = 0; i < 8; ++i)
#pragma unroll
        for (int r = 0; r < 4; ++r) so[(unsigned)((16 * i + 4 * q + r) * 128 + e)] = S[i][r];
}

__device__ __forceinline__ int crow(int r, int hi) { return (r & 3) + 8 * (r >> 2) + 4 * hi; }
__device__ __forceinline__ void sb_core(f32x16& p, float& carry, int hi) {
    float s[16];
#pragma unroll
    for (int r = 0; r < 16; ++r) { const float e = __builtin_amdgcn_exp2f(p[r]); s[r] = -__builtin_amdgcn_logf(1.0f + e); }
    float tt[4], uu[4];
#pragma unroll
    for (int i = 0; i < 4; ++i) { s[4 * i + 2] += s[4 * i + 3]; s[4 * i + 1] += s[4 * i + 2]; s[4 * i] += s[4 * i + 1]; tt[i] = s[4 * i]; }
#pragma unroll
    for (int i = 0; i < 4; ++i) uu[i] = __shfl_xor(tt[i], 32);
    const float w3 = tt[3] + uu[3], w2 = tt[2] + uu[2], w1 = tt[1] + uu[1], w0 = tt[0] + uu[0];
    float off[4];
    off[3] = carry; off[2] = carry + w3; off[1] = off[2] + w2; off[0] = off[1] + w1;
    carry = off[0] + w0;
    if (hi == 0) {
#pragma unroll
        for (int i = 0; i < 4; ++i) off[i] += uu[i];
    }
#pragma unroll
    for (int r = 0; r < 16; ++r) p[r] = __builtin_amdgcn_exp2f(p[r] + s[r] + off[r >> 2]);
}
__device__ __forceinline__ bf16x8 pack_p(const f32x16& p, int s) {
    u32x4 w; w.x = cvtpk(p[8 * s], p[8 * s + 1]); w.y = cvtpk(p[8 * s + 2], p[8 * s + 3]); w.z = cvtpk(p[8 * s + 4], p[8 * s + 5]); w.w = cvtpk(p[8 * s + 6], p[8 * s + 7]); return __builtin_bit_cast(bf16x8, w);
}
constexpr int AW_BYTES = 16384, AW_V = 0, VPI = 192, AW_K = 6144, KPI = 144, AW_Q = 6144, AW_SQ = 10752;
__device__ __forceinline__ void read_vfrags(bf16x8 (&vf)[4], const LAS unsigned char* wl, int lane) {
    const int hi = lane >> 5;
    const LAS unsigned char* vb = wl + AW_V + (4 * hi + ((lane & 15) >> 2)) * VPI + (((lane >> 4) & 1) * 16 + (lane & 3) * 4) * 2;
#pragma unroll
    for (int dt = 0; dt < 2; ++dt) {
        const s16x4 t0 = __builtin_bit_cast(s16x4, __builtin_amdgcn_ds_read_tr16_b64_v4i16((LAS s16x4*)(vb + dt * 64)));
        const s16x4 t1 = __builtin_bit_cast(s16x4, __builtin_amdgcn_ds_read_tr16_b64_v4i16((LAS s16x4*)(vb + dt * 64 + 8 * VPI)));
        const s16x4 t2 = __builtin_bit_cast(s16x4, __builtin_amdgcn_ds_read_tr16_b64_v4i16((LAS s16x4*)(vb + dt * 64 + 16 * VPI)));
        const s16x4 t3 = __builtin_bit_cast(s16x4, __builtin_amdgcn_ds_read_tr16_b64_v4i16((LAS s16x4*)(vb + dt * 64 + 24 * VPI)));
        vf[2 * dt] = (bf16x8){t0[0], t0[1], t0[2], t0[3], t1[0], t1[1], t1[2], t1[3]}; vf[2 * dt + 1] = (bf16x8){t2[0], t2[1], t2[2], t2[3], t3[0], t3[1], t3[2], t3[3]};
    }
}
__device__ __forceinline__ void load_k_prompt(bf16x8 (&k)[4], const bf16* KB, int b, int h, int kv0, int r32, int hi) {
    const bf16* kp = KB + (size_t)(b * TP + kv0 + r32) * SBW + h * HD + 8 * hi;
#pragma unroll
    for (int d0 = 0; d0 < 4; ++d0) k[d0] = *(const bf16x8*)(kp + 16 * d0);
}
__device__ __forceinline__ void load_v_prompt(u32x4 (&v)[4], const bf16* VB, int b, int h, int kv0, int lane) {
    const bf16* vp = VB + (size_t)(b * TP + kv0 + (lane >> 3)) * SBW + h * HD + (lane & 7) * 8;
#pragma unroll
    for (int i = 0; i < 4; ++i) v[i] = *(const u32x4*)(vp + (size_t)(8 * i) * SBW);
}
__device__ __forceinline__ void write_v_lds(LAS unsigned char* wl, const u32x4 (&v)[4], int lane) {
#pragma unroll
    for (int i = 0; i < 4; ++i) *(LAS u32x4*)(wl + AW_V + (8 * i + (lane >> 3)) * VPI + (lane & 7) * 16) = v[i];
}
template <int MASK>
__device__ __forceinline__ void sb_qk(f32x16& p, const bf16x8 (&kf)[4], const bf16x8 (&qf)[4], float bias2, int kv0, int qpos, int hi) {
#pragma unroll
    for (int r = 0; r < 16; ++r) p[r] = bias2;
#pragma unroll
    for (int d0 = 0; d0 < 4; ++d0) p = __builtin_amdgcn_mfma_f32_32x32x16_bf16(kf[d0], qf[d0], p, 0, 0, 0);
    if (MASK) {
#pragma unroll
        for (int r = 0; r < 16; ++r) if (kv0 + crow(r, hi) >= qpos) p[r] = -INFINITY;
    }
}
__device__ __forceinline__ void sb_pvonly(const f32x16& p, const bf16x8 (&vf)[4], f32x16 (&o)[2]) {
    const bf16x8 p0 = pack_p(p, 0), p1 = pack_p(p, 1);
#pragma unroll
    for (int dt = 0; dt < 2; ++dt) { o[dt] = __builtin_amdgcn_mfma_f32_32x32x16_bf16(vf[2 * dt], p0, o[dt], 0, 0, 0); o[dt] = __builtin_amdgcn_mfma_f32_32x32x16_bf16(vf[2 * dt + 1], p1, o[dt], 0, 0, 0); }
}
__device__ __forceinline__ void sb_pv(f32x16& p, const bf16x8 (&vf)[4], f32x16 (&o)[2], float& carry, int hi) {
    sb_core(p, carry, hi);
    const bf16x8 p0 = pack_p(p, 0), p1 = pack_p(p, 1);
#pragma unroll
    for (int dt = 0; dt < 2; ++dt) { o[dt] = __builtin_amdgcn_mfma_f32_32x32x16_bf16(vf[2 * dt], p0, o[dt], 0, 0, 0); o[dt] = __builtin_amdgcn_mfma_f32_32x32x16_bf16(vf[2 * dt + 1], p1, o[dt], 0, 0, 0); }
}
template <int MASK>
__device__ __forceinline__ void sb_tile(const bf16x8 (&kf)[4], const bf16x8 (&vf)[4], const bf16x8 (&qf)[4], float bias2, f32x16 (&o)[2], float& carry, int kv0, int qpos, int hi) {
    f32x16 p; sb_qk<MASK>(p, kf, qf, bias2, kv0, qpos, hi); sb_pv(p, vf, o, carry, hi);
}
__device__ __forceinline__ void sb_store_prompt(const Args& A, const f32x16 (&o)[2], int b, int h, int qpos, int hi) {
    float ss = 0.f;
#pragma unroll
    for (int dt = 0; dt < 2; ++dt)
#pragma unroll
        for (int r = 0; r < 16; ++r) ss += o[dt][r] * o[dt][r];
    ss += __shfl_xor(ss, 32);
    const float rs = 1.0f / sqrtf(ss * (1.f / HD) + EPS);
    const float* gso = (const float*)A.in[I_GSBO];
    bf16* op = (bf16*)(A.ws + WS_MIXED) + (size_t)(b * TP + qpos) * D + h * HD;
#pragma unroll
    for (int dt = 0; dt < 2; ++dt)
#pragma unroll
        for (int g = 0; g < 4; ++g) { const int d = 32 * dt + 8 * g + 4 * hi; const f32x4 gg = *(const f32x4*)(gso + d);
            u32x2 w; w.x = cvtpk(o[dt][4 * g] * rs * gg.x, o[dt][4 * g + 1] * rs * gg.y); w.y = cvtpk(o[dt][4 * g + 2] * rs * gg.z, o[dt][4 * g + 3] * rs * gg.w); *(u32x2*)(op + d) = w; }
}
__device__ __forceinline__ void attn_prompt_item(const Args& A, LAS unsigned char* wl, int b, int h, int q0, int lane) {
    unsigned char* ws = A.ws;
    const bf16* QB = (const bf16*)(ws + WS_QB); const bf16* KB = (const bf16*)(ws + WS_KB); const bf16* VB = (const bf16*)(ws + WS_VB);
    const int r32 = lane & 31, hi = lane >> 5, qa = q0 + r32, qb = q0 + 32 + r32;
    const float bias2 = ((const float*)A.in[I_SBB])[h] * LOG2E;
#pragma unroll
    for (int d0 = 0; d0 < 4; ++d0) { *(LAS bf16x8*)(wl + AW_Q + (d0 * 64 + lane) * 16) = *(const bf16x8*)(QB + (size_t)(b * TP + qa) * SBW + h * HD + 16 * d0 + 8 * hi);
        *(LAS bf16x8*)(wl + AW_Q + 4096 + (d0 * 64 + lane) * 16) = *(const bf16x8*)(QB + (size_t)(b * TP + qb) * SBW + h * HD + 16 * d0 + 8 * hi); }
#define QFA_LOAD bf16x8 qfa[4]; _Pragma("unroll") for (int d0_ = 0; d0_ < 4; ++d0_) qfa[d0_] = *(const LAS bf16x8*)(wl + AW_Q + (d0_ * 64 + lane) * 16);
#define QFB_LOAD bf16x8 qfb[4]; _Pragma("unroll") for (int d0_ = 0; d0_ < 4; ++d0_) qfb[d0_] = *(const LAS bf16x8*)(wl + AW_Q + 4096 + (d0_ * 64 + lane) * 16);
    f32x16 oa[2], ob[2]; oa[0] = (f32x16){}; oa[1] = (f32x16){}; ob[0] = (f32x16){}; ob[1] = (f32x16){};
    float ca = 0.f, cb = 0.f;
    bf16x8 kc[4], vf[4]; u32x4 vr[4];
    const int top = (q0 >> 5) + 1;
    load_k_prompt(kc, KB, b, h, 32 * top, r32, hi); load_v_prompt(vr, VB, b, h, 32 * top, lane);
    { write_v_lds(wl, vr, lane); load_v_prompt(vr, VB, b, h, 32 * (top - 1), lane);
      f32x16 p; { QFB_LOAD sb_qk<1>(p, kc, qfb, bias2, 32 * top, qb, hi); }
      load_k_prompt(kc, KB, b, h, 32 * (top - 1), r32, hi);
      read_vfrags(vf, wl, lane);
      sb_pv(p, vf, ob, cb, hi); }
    { write_v_lds(wl, vr, lane); if (top >= 2) load_v_prompt(vr, VB, b, h, 32 * (top - 2), lane);
      f32x16 p; { QFA_LOAD sb_qk<1>(p, kc, qfa, bias2, 32 * (top - 1), qa, hi); }
      read_vfrags(vf, wl, lane);
      sb_pv(p, vf, oa, ca, hi);
      { QFB_LOAD sb_qk<0>(p, kc, qfb, bias2, 0, 0, hi); }
      if (top >= 2) load_k_prompt(kc, KB, b, h, 32 * (top - 2), r32, hi);
      sb_pv(p, vf, ob, cb, hi); }
    for (int ht = top - 2; ht >= 0; --ht) {
        write_v_lds(wl, vr, lane);
        f32x16 p, p2; { QFA_LOAD sb_qk<0>(p, kc, qfa, bias2, 0, 0, hi); } { QFB_LOAD sb_qk<0>(p2, kc, qfb, bias2, 0, 0, hi); }
        if (ht > 0) load_k_prompt(kc, KB, b, h, 32 * (ht - 1), r32, hi);
        read_vfrags(vf, wl, lane);
        sb_core(p, ca, hi); sb_pvonly(p, vf, oa);
        __builtin_amdgcn_sched_barrier(0);
        if (ht > 0) load_v_prompt(vr, VB, b, h, 32 * (ht - 1), lane);
        sb_core(p2, cb, hi); sb_pvonly(p2, vf, ob);
    }
    sb_store_prompt(A, oa, b, h, qa, hi); sb_store_prompt(A, ob, b, h, qb, hi);
#undef QFA_LOAD
#undef QFB_LOAD
}

__device__ __forceinline__ void load_raw_sample(f32x4 (&r)[8], const float* c, size_t base, int h, int lane) {
    const float* p = c + base + (size_t)(lane >> 4) * 512 + h * HD + (lane & 15) * 4;
#pragma unroll
    for (int i = 0; i < 8; ++i) r[i] = *(const f32x4*)(p + (size_t)(4 * i) * 512);
}
__device__ __forceinline__ void write_raw_sample(LAS unsigned char* wl, int off, int pitch, const f32x4 (&r)[8], int lane) {
#pragma unroll
    for (int i = 0; i < 8; ++i) { const int row = 4 * i + (lane >> 4); u32x2 w; w.x = cvtpk(r[i].x, r[i].y); w.y = cvtpk(r[i].z, r[i].w); *(LAS u32x2*)(wl + off + row * pitch + (lane & 15) * 8) = w; }
}
__device__ __forceinline__ void read_kfrags(bf16x8 (&kf)[4], const LAS unsigned char* wl, int r32, int hi) {
#pragma unroll
    for (int d0 = 0; d0 < 4; ++d0) kf[d0] = *(const LAS bf16x8*)(wl + AW_K + r32 * KPI + (16 * d0 + 8 * hi) * 2);
}
__device__ __forceinline__ void attn_sample_store(const Args& A, int b, int h, int part, int lane, const f32x16 (&o)[2], float carry) {
    float* OP = (float*)(A.ws + WS_OPART) + (size_t)((b * SBH + h) * NPART + part) * 512; float* LP = (float*)(A.ws + WS_LPART) + (size_t)((b * SBH + h) * NPART + part) * 8;
    const int r32 = lane & 31, hi = lane >> 5;
    unsigned lo = (unsigned)(r32 * 64 + 4 * hi), ll = (unsigned)r32; asm volatile("" : "+v"(lo), "+v"(ll));
    if (r32 < 8) {
#pragma unroll
        for (int dt = 0; dt < 2; ++dt)
#pragma unroll
            for (int g = 0; g < 4; ++g) *(f32x4*)(OP + (lo + (unsigned)(32 * dt + 8 * g))) = (f32x4){o[dt][4 * g], o[dt][4 * g + 1], o[dt][4 * g + 2], o[dt][4 * g + 3]};
        if (hi == 0) LP[ll] = carry;
    }
}
__device__ __forceinline__ void attn_sample_job(const Args& A, LAS unsigned char* wl, int b, int h, int sp, int lane) {
    unsigned char* ws = A.ws;
    const int r32 = lane & 31, hi = lane >> 5;
    const float* ck = (const float*)A.in[I_CK]; const float* cv = (const float*)A.in[I_CV]; const int* pt = (const int*)A.in[I_PT] + b * NPAGES;
    const bf16* QB = (const bf16*)(ws + WS_QB);
    const float bias2 = ((const float*)A.in[I_SBB])[h] * LOG2E;
    bf16x8 qf[4];
#pragma unroll
    for (int d0 = 0; d0 < 4; ++d0) { qf[d0] = (bf16x8){0, 0, 0, 0, 0, 0, 0, 0}; if (r32 < TS) qf[d0] = *(const bf16x8*)(QB + (size_t)(MP + b * TS + r32) * SBW + h * HD + 16 * d0 + 8 * hi); }
    f32x16 o[2]; float carry;
    bf16x8 kf[4], vf[4];
    const int tok_hi = (PAST / NSPLIT) * (sp + 1);
    constexpr int NT = PAST / NSPLIT / 32;
    f32x4 rk[8], rv[8];
#define SAMPLE_BASE(j) (((size_t)pt[(tok_hi - 32 * ((j) + 1)) >> 7] * PAGE + ((tok_hi - 32 * ((j) + 1)) & 127)) * 512)
    if (sp == NSPLIT - 1) {
        const bf16* KBn = (const bf16*)(ws + WS_KB) + (size_t)(MP + b * TS) * SBW + h * HD;
#pragma unroll
        for (int d0 = 0; d0 < 4; ++d0) { kf[d0] = (bf16x8){0, 0, 0, 0, 0, 0, 0, 0}; if (r32 < TS) kf[d0] = *(const bf16x8*)(KBn + (size_t)r32 * SBW + 16 * d0 + 8 * hi); }
        u32x4 vr[4];
        vr[0] = *(const u32x4*)((const bf16*)(ws + WS_VB) + (size_t)(MP + b * TS + (lane >> 3)) * SBW + h * HD + (lane & 7) * 8);
        vr[1] = (u32x4){0u, 0u, 0u, 0u}; vr[2] = vr[1]; vr[3] = vr[1];
        write_v_lds(wl, vr, lane);
        read_vfrags(vf, wl, lane);
        o[0] = (f32x16){}; o[1] = (f32x16){}; carry = 0.f;
        sb_tile<1>(kf, vf, qf, bias2, o, carry, 0, r32, hi);
        attn_sample_store(A, b, h, NPART - 1, lane, o, carry);
    }
    f32x4 rk2[8];
    load_raw_sample(rk, ck, SAMPLE_BASE(0), h, lane); load_raw_sample(rv, cv, SAMPLE_BASE(0), h, lane);
    load_raw_sample(rk2, ck, SAMPLE_BASE(1), h, lane);
#pragma unroll
    for (int d0 = 0; d0 < 4; ++d0) *(LAS bf16x8*)(wl + AW_SQ + (d0 * 64 + lane) * 16) = qf[d0];
    o[0] = (f32x16){}; o[1] = (f32x16){}; carry = 0.f;
#define SAMPLE_TILE(RK, jk_, jv_) do { \
        write_raw_sample(wl, AW_K, KPI, RK, lane); write_raw_sample(wl, AW_V, VPI, rv, lane); \
        if ((jk_) < NT) load_raw_sample(RK, ck, SAMPLE_BASE(jk_), h, lane); \
        read_kfrags(kf, wl, r32, hi); read_vfrags(vf, wl, lane); \
        bf16x8 qq[4]; _Pragma("unroll") for (int d0_ = 0; d0_ < 4; ++d0_) qq[d0_] = *(const LAS bf16x8*)(wl + AW_SQ + (d0_ * 64 + lane) * 16); \
        f32x16 p; sb_qk<0>(p, kf, qq, bias2, 0, 0, hi); \
        sb_core(p, carry, hi); \
        __builtin_amdgcn_sched_barrier(0); \
        if ((jv_) < NT) load_raw_sample(rv, cv, SAMPLE_BASE(jv_), h, lane); \
        sb_pvonly(p, vf, o); } while (0)
    for (int j = 0; j < NT; j += 2) {
        SAMPLE_TILE(rk, j + 2, j + 1);
        SAMPLE_TILE(rk2, j + 3, j + 2);
    }
#undef SAMPLE_TILE
#undef SAMPLE_BASE
    attn_sample_store(A, b, h, sp, lane, o, carry);
}

__device__ __forceinline__ void phase_outnorm(const Args& A, int gw, int NGW, int lane) {
    unsigned char* ws = A.ws; const float* ODN = (const float*)(ws + WS_ODN); bf16* MIXED = (bf16*)(ws + WS_MIXED);
    const float* gdn = (const float*)A.in[I_GDNO]; const float* gso = (const float*)A.in[I_GSBO];
    const float* OPb = (const float*)(ws + WS_OPART); const float* LPb = (const float*)(ws + WS_LPART);
    const int c8 = 8 * lane;
    for (int m = gw; m < M; m += NGW) {
        {
            f32x4 a0, a1;
            if (m >= MP) { const float* op = ODN + (size_t)m * DNW + c8; a0 = *(const f32x4*)op; a1 = *(const f32x4*)(op + 4); }
            else { const int t = m & 4095, cch = t & 63, hh = lane >> 4; const size_t it_ = (size_t)((m >> 12) * 64 + (t >> 6)) * 4 + hh;
                const float* op = ODN + it_ * 8192 + ((((cch >> 4) * 8 + ((lane & 15) >> 1)) * 64 + ((cch >> 2) & 3) * 16 + 8 * (lane & 1)) * 4) + (cch & 3);
                a0 = (f32x4){op[0], op[4], op[8], op[12]}; a1 = (f32x4){op[16], op[20], op[24], op[28]}; }
            float ss = (a0.x * a0.x + a0.y * a0.y) + (a0.z * a0.z + a0.w * a0.w) + (a1.x * a1.x + a1.y * a1.y) + (a1.z * a1.z + a1.w * a1.w);
            ss += __shfl_xor(ss, 1); ss += __shfl_xor(ss, 2); ss += __shfl_xor(ss, 4); ss += __shfl_xor(ss, 8);
            const float rs = 1.0f / sqrtf(ss * (1.f / DND) + EPS);
            const f32x4 g0 = *(const f32x4*)(gdn + (c8 & 127)), g1 = *(const f32x4*)(gdn + (c8 & 127) + 4);
            const u32x4 zw = *(const u32x4*)((const bf16*)(ws + WS_ZG) + (size_t)m * DNW + c8); const f32x4 z0 = bf4lo(zw), z1 = bf4hi(zw);
            *(u32x4*)(MIXED + (size_t)m * D + SBW + c8) = pack8(a0 * rs * g0 * z0, a1 * rs * g1 * z1);
        }
        if (m >= MP) {
            const int b = (m - MP) >> 3, t = (m - MP) & 7, h = lane >> 3, d0 = c8 & 63;
            const float* OP = OPb + (size_t)(b * SBH + h) * NPART * 512; const float* LP = LPb + (size_t)(b * SBH + h) * NPART * 8;
            float v[8];
#pragma unroll
            for (int k = 0; k < 8; ++k) v[k] = 0.f;
            float suf = 0.f;
#pragma unroll
            for (int part = NPART - 1; part >= 0; --part) { const float w = __builtin_amdgcn_exp2f(suf);
                const f32x4 pa = *(const f32x4*)(OP + part * 512 + t * 64 + d0), pb = *(const f32x4*)(OP + part * 512 + t * 64 + d0 + 4);
                v[0] += w * pa.x; v[1] += w * pa.y; v[2] += w * pa.z; v[3] += w * pa.w; v[4] += w * pb.x; v[5] += w * pb.y; v[6] += w * pb.z; v[7] += w * pb.w;
                suf += LP[part * 8 + t]; }
            float ss = 0.f;
#pragma unroll
            for (int k = 0; k < 8; ++k) ss += v[k] * v[k];
            ss += __shfl_xor(ss, 1); ss += __shfl_xor(ss, 2); ss += __shfl_xor(ss, 4);
            const float rs = 1.0f / sqrtf(ss * (1.f / HD) + EPS);
            const f32x4 g0 = *(const f32x4*)(gso + d0), g1 = *(const f32x4*)(gso + d0 + 4);
            *(u32x4*)(MIXED + (size_t)m * D + c8) = pack8((f32x4){v[0], v[1], v[2], v[3]} * rs * g0, (f32x4){v[4], v[5], v[6], v[7]} * rs * g1);
        }
    }
}

__device__ __forceinline__ void convgate_strip(const Args& A, int m0, int R, int cg, int lane) {
    unsigned char* ws = A.ws; const bf16* UP = (const bf16*)(ws + WS_UP); bf16* ACT = (bf16*)(ws + WS_ACT); float* out = A.out;
    const float* wf = (const float*)A.in[I_WFC]; const float* sfc = (const float*)A.in[I_SFC];
    const int c = (cg * 64 + lane) * 8;
    if (c >= DFF) return;
    const bool prompt = m0 < MP; const int b = prompt ? (m0 >> 12) : ((m0 - MP) >> 3), t0 = prompt ? (m0 & 4095) : ((m0 - MP) & 7), T = prompt ? TP : TS;
    f32x4 wu[3][2], wg[3][2];
#pragma unroll
    for (int i = 0; i < 3; ++i) { const float* wp = wf + (size_t)i * DFF2 + c; wu[i][0] = *(const f32x4*)wp; wu[i][1] = *(const f32x4*)(wp + 4); wg[i][0] = *(const f32x4*)(wp + DFF); wg[i][1] = *(const f32x4*)(wp + DFF + 4); }
    f32x4 xu[2][2], xg[2][2];
#pragma unroll
    for (int j = 0; j < 2; ++j) { const int tt = t0 - 2 + j;
        if (tt >= 0) { const bf16* p = UP + (size_t)(m0 - 2 + j) * DFF2 + c; const u32x4 a = *(const u32x4*)p, g = *(const u32x4*)(p + DFF); xu[j][0] = bf4lo(a); xu[j][1] = bf4hi(a); xg[j][0] = bf4lo(g); xg[j][1] = bf4hi(g); }
        else if (!prompt) { const float* p = sfc + ((size_t)b * 2 + (2 + tt)) * DFF2 + c; xu[j][0] = *(const f32x4*)p; xu[j][1] = *(const f32x4*)(p + 4); xg[j][0] = *(const f32x4*)(p + DFF); xg[j][1] = *(const f32x4*)(p + DFF + 4); }
        else { xu[j][0] = (f32x4){0.f, 0.f, 0.f, 0.f}; xu[j][1] = xu[j][0]; xg[j][0] = xu[j][0]; xg[j][1] = xu[j][0]; } }
    const bf16* src = UP + (size_t)m0 * DFF2 + c;
    u32x4 na = *(const u32x4*)src, ng = *(const u32x4*)(src + DFF);
    for (int r = 0; r < R; ++r) {
        const u32x4 ca = na, cgw = ng;
        if (r + 1 < R) { na = *(const u32x4*)(src + (size_t)(r + 1) * DFF2); ng = *(const u32x4*)(src + (size_t)(r + 1) * DFF2 + DFF); }
        const f32x4 u0 = bf4lo(ca), u1 = bf4hi(ca), g0 = bf4lo(cgw), g1 = bf4hi(cgw);
        f32x4 yu0 = wu[0][0] * xu[0][0] + wu[1][0] * xu[1][0] + wu[2][0] * u0, yu1 = wu[0][1] * xu[0][1] + wu[1][1] * xu[1][1] + wu[2][1] * u1;
        f32x4 yg0 = wg[0][0] * xg[0][0] + wg[1][0] * xg[1][0] + wg[2][0] * g0, yg1 = wg[0][1] * xg[0][1] + wg[1][1] * xg[1][1] + wg[2][1] * g1;
        xu[0][0] = xu[1][0]; xu[0][1] = xu[1][1]; xu[1][0] = u0; xu[1][1] = u1; xg[0][0] = xg[1][0]; xg[0][1] = xg[1][1]; xg[1][0] = g0; xg[1][1] = g1;
        yg0.x = siluf(yg0.x); yg0.y = siluf(yg0.y); yg0.z = siluf(yg0.z); yg0.w = siluf(yg0.w); yg1.x = siluf(yg1.x); yg1.y = siluf(yg1.y); yg1.z = siluf(yg1.z); yg1.w = siluf(yg1.w);
        *(u32x4*)(ACT + (size_t)(m0 + r) * DFF + c) = pack8(yg0 * yu0, yg1 * yu1);
        const int oidx = t0 + r - (T - 2);
        if (oidx >= 0) { float* fo = (prompt ? out + O_FCP : out + O_FCS) + ((size_t)b * 2 + oidx) * DFF2 + c; *(f32x4*)fo = u0; *(f32x4*)(fo + 4) = u1; *(f32x4*)(fo + DFF) = g0; *(f32x4*)(fo + DFF + 4) = g1; }
    }
}
__device__ __forceinline__ void phase_convgate(const Args& A, int gw, int NGW, int lane) {
    constexpr int NPI = (MP / 32) * 6, NSI = BS * 6;
    for (int it = gw; it < NPI + NSI; it += NGW) {
        if (it < NPI) convgate_strip(A, (it / 6) * 32, 32, it % 6, lane);
        else { const int j = it - NPI; convgate_strip(A, MP + (j / 6) * 8, 8, j % 6, lane); }
    }
}

__device__ __forceinline__ void phase_slabsum(const Args& A, int gw, int NGW, int lane) {
    unsigned char* ws = A.ws; const float* slab = (const float*)(ws + WS_SLAB); const float* X1 = (const float*)(ws + WS_X1); const float* MOD = (const float*)(ws + WS_MOD);
    for (int r = gw; r < MS; r += NGW) {
        const int m = MP + r; const float* mod = MOD + (size_t)mod_row(m) * NMOD + 5120;
#pragma unroll
        for (int j = 0; j < 4; ++j) { const int c = 4 * (lane + 64 * j); f32x4 a = (f32x4){0.f, 0.f, 0.f, 0.f};
#pragma unroll
            for (int k = 0; k < DFF / 256; ++k) a += *(const f32x4*)(slab + ((size_t)k * MS + r) * D + c);
            *(f32x4*)(A.out + (size_t)m * D + c) = *(const f32x4*)(X1 + (size_t)m * D + c) + *(const f32x4*)(mod + c) * a; }
    }
}

constexpr int NPHASE = 14;
#ifndef PROBE_LEVEL
#define PROBE_LEVEL 0
#endif
#ifndef REP_MASK
#define REP_MASK 0
#endif

__global__ void __launch_bounds__(512, 2) fwd_kernel(Args A) {
    extern __shared__ __attribute__((aligned(16))) unsigned char lds_raw[];
    LAS unsigned char* lds = (LAS unsigned char*)lds_raw;
    const int wave = __builtin_amdgcn_readfirstlane((int)threadIdx.x >> 6);
    const int G = gridDim.x, bx = blockIdx.x;
    const int gw = bx * 8 + wave, NGW = G * 8, NGT = G * 512;
    unsigned char* ws = A.ws;
    gu32* ctl = (gu32*)(ws + WS_CTL);
    volatile LAS unsigned* MISC = (volatile LAS unsigned*)(lds + MISC_OFF);
    { const int t0 = wave * 64 + lane_now(); for (int u = t0; u < (LDS_BYTES - RING_BYTES) / 4; u += 512) ((LAS unsigned*)(lds + RING_BYTES))[u] = 0u; }
    __syncthreads();
    const int lo = A.lo, hi = A.hi;
    const bool multi = (hi - lo) > 1;
    XcdBarrier bar; bar.bar = (unsigned*)(ctl + CW_BAR); bar.x = 0; bar.st = nullptr;
    if (multi) bar = xcd_barrier_post((unsigned*)(ctl + CW_BAR), MISC + 8, wave * 64 + lane_now());
#define IN(k) (lo <= (k) && (k) < hi)
#define GBAR() xcd_barrier(bar, wave * 64 + lane_now())
#define SEAM(k) do { if (IN(k) && IN((k) + 1)) GBAR(); } while (0)
    float* MOD = (float*)(ws + WS_MOD);

#define PH0(rep_) phase_prologue(A, lds, ctl + CW_Q0 + 64 * (rep_), bx, G, wave, lane, gtid, NGT);
#define PH1(rep_) ;
#define PH2(rep_) phase_norm<true>((const float*)A.in[I_XP], (const float*)A.in[I_XS], (const float*)A.in[I_GATT], MOD, 0, 1024, (bf16*)(ws + WS_H), (const float*)(ws + WS_WINX), (float*)(ws + WS_EXTRA), gw, NGW, lane);
#define PH3(rep_) { pg8::Gemm g{(const pg8::bf16_t*)(ws + WS_H), (const pg8::bf16_t*)(ws + WS_WIN_T), M, NPROJ, D, D}; pg8::StaticOrder S; S.init(M, NPROJ, G, bx); \
          EpiProj E{A.out, (bf16*)(ws + WS_QB), (bf16*)(ws + WS_KB), (bf16*)(ws + WS_VB), (bf16*)(ws + WS_DNRAW), (bf16*)(ws + WS_ZG), (const float*)A.in[I_GQ], (const float*)A.in[I_GK], (LAS float*)(lds + RING_BYTES + 1024)}; \
          pg8::gemm_phase<EpiProj, pg8::StaticOrder, true, true>(lds, g, S, E, tid); }
#define PH4(rep_) phase_post(A, gw, NGW, lane, gtid, NGT);
#define PH5(rep_) for (int u = bx; u < 1024; u += G) { if (u < 512) dn_prescan_unit(A, lds, u, tid, wave, lane); else dn_sample_unit(A, lds, u - 512, tid); }
#define PH6(rep_) PH6X(rep_, true, true, true)
#define PH6X(rep_, DS_, DP_, DA_) { if ((DS_) && bx < 16) dn_scan_chain(A, lds, bx, tid, wave, lane); \
          \
        bool moreP = (DP_), moreS = (DA_); const bool pfirst = wave < 4; \
        gu32* qbase_ = ctl + CW_QUEUE + 1024 * (rep_);     \
        const int shard0_ = (int)(xb_xcc_id() & 7u); int offP_ = 0, offS_ = 0;     \
        for (;;) { \
            int job = -1; bool isP = false; \
            if (pfirst && moreP) { const int sh_ = (shard0_ + offP_) & 7; unsigned j_ = 0; if (lane == 0) j_ = __hip_atomic_fetch_add(qbase_ + 64 * sh_, 1u, RLX_AGENT); j_ = __builtin_amdgcn_readfirstlane(j_); if (j_ < 256u) { job = (int)j_ * 8 + sh_; isP = true; } else if (++offP_ == 8) moreP = false; } \
            if (job < 0 && moreS && !(pfirst && moreP)) { const int sh_ = (shard0_ + offS_) & 7; unsigned j_ = 0; if (lane == 0) j_ = __hip_atomic_fetch_add(qbase_ + 512 + 64 * sh_, 1u, RLX_AGENT); j_ = __builtin_amdgcn_readfirstlane(j_); if (j_ < 512u) { job = (int)j_ * 8 + sh_; } else if (++offS_ == 8) moreS = false; } \
            if (job < 0 && !pfirst && !moreS && moreP) { const int sh_ = (shard0_ + offP_) & 7; unsigned j_ = 0; if (lane == 0) j_ = __hip_atomic_fetch_add(qbase_ + 64 * sh_, 1u, RLX_AGENT); j_ = __builtin_amdgcn_readfirstlane(j_); if (j_ < 256u) { job = (int)j_ * 8 + sh_; isP = true; } else if (++offP_ == 8) moreP = false; } \
            if (job < 0) { if (!moreP && !moreS) break; else continue; } \
            if (isP) { const int qb = 63 - (job >> 5), bh = job & 31; attn_prompt_item(A, lds + wave * AW_BYTES, bh >> 3, bh & 7, qb * 64, lane); } \
            else { const int h_ = job & 7, bs_ = job >> 3; attn_sample_job(A, lds + wave * AW_BYTES, bs_ >> 2, h_, bs_ & 3, lane); } \
        } }
#define PH7(rep_) phase_outnorm(A, gw, NGW, lane);
#define PH8(rep_) { { pg8::Gemm g{(const pg8::bf16_t*)(ws + WS_MIXED), (const pg8::bf16_t*)(ws + WS_WOUT_T), MP, D, D, D}; pg8::StaticOrder S; S.init(MP, D, G, bx); \
        EpiResGate E{(const float*)A.in[I_XP], (const float*)A.in[I_XS], MOD, 2048, (float*)(ws + WS_X1)}; \
        pg8::gemm_phase<EpiResGate, pg8::StaticOrder, true, true>(lds, g, S, E, tid); } \
        __syncthreads(); \
        { pg8::Gemm g{(const pg8::bf16_t*)(ws + WS_MIXED), (const pg8::bf16_t*)(ws + WS_WOUT_T), M, D, 256, D}; SplitKOrder S{D / 256, G, bx};     \
        EpiSlab E{(float*)(ws + WS_SLAB)}; \
        pg8::gemm_phase<EpiSlab, SplitKOrder, true, true>(lds, g, S, E, tid); } }
#define PH9(rep_) phase_norm<false, 4>((const float*)(ws + WS_X1), (const float*)A.in[I_XS], (const float*)A.in[I_GFFN], MOD, 3072, 4096, (bf16*)(ws + WS_H), nullptr, nullptr, gw, NGW, lane, (const float*)(ws + WS_SLAB), 2048, (float*)(ws + WS_X1));
#define PH10(rep_) { pg8::Gemm g{(const pg8::bf16_t*)(ws + WS_H), (const pg8::bf16_t*)(ws + WS_WUP_T), M, DFF2, D, D}; pg8::StaticOrder S; S.init(M, DFF2, G, bx); \
        pg8::EpiBf16<0> E{(pg8::bf16_t*)(ws + WS_UP), DFF2, nullptr, 0, 0, 1.f}; \
        pg8::gemm_phase<pg8::EpiBf16<0>, pg8::StaticOrder, true, true>(lds, g, S, E, tid); }
#define PH11(rep_) phase_convgate(A, gw, NGW, lane);
#define PH12(rep_) { { pg8::Gemm g{(const pg8::bf16_t*)(ws + WS_ACT), (const pg8::bf16_t*)(ws + WS_WDN_T), MP, D, DFF, DFF}; pg8::StaticOrder S; S.init(MP, D, G, bx); \
        EpiResGate E{(const float*)(ws + WS_X1), (const float*)(ws + WS_X1) + (size_t)MP * D, MOD, 5120, A.out}; \
        pg8::gemm_phase<EpiResGate, pg8::StaticOrder, true, true>(lds, g, S, E, tid); } \
        __syncthreads(); \
        { pg8::Gemm g{(const pg8::bf16_t*)(ws + WS_ACT), (const pg8::bf16_t*)(ws + WS_WDN_T), M, D, 256, DFF}; SplitKOrder S{DFF / 256, G, bx}; \
        EpiSlab E{(float*)(ws + WS_SLAB)}; \
        pg8::gemm_phase<EpiSlab, SplitKOrder, true, true>(lds, g, S, E, tid); } }
#define PH13(rep_) phase_slabsum(A, gw, NGW, lane);
#define RUNPH(k) do { if (IN(k)) { const int lane = lane_now(), tid = wave * 64 + lane, gtid = bx * 512 + tid; (void)gtid; PH##k(0) if constexpr (((REP_MASK) >> (k)) & 1) { GBAR(); PH##k(1) } } } while (0)
    RUNPH(0); SEAM(0);
    RUNPH(2); SEAM(2);
    RUNPH(3); SEAM(3);
    RUNPH(4); SEAM(4);
    RUNPH(5);
    if constexpr (((REP_MASK) >> 17) & 1) { GBAR(); const int lane = lane_now(), tid = wave * 64 + lane; for (int u = bx; u < 512; u += G) dn_prescan_unit<PROBE_LEVEL>(A, lds, u, tid, wave, lane); }
    if constexpr (((REP_MASK) >> 18) & 1) { GBAR(); const int lane = lane_now(), tid = wave * 64 + lane; (void)lane; for (int u = bx; u < 512; u += G) dn_sample_unit(A, lds, u, tid); }
    SEAM(5);
    RUNPH(6);
    if constexpr (((REP_MASK) >> 13) & 1) { GBAR(); const int lane = lane_now(), tid = wave * 64 + lane; PH6X(2, true, false, false) }
    if constexpr (((REP_MASK) >> 14) & 1) { GBAR(); const int lane = lane_now(), tid = wave * 64 + lane; PH6X(3, false, true, false) }
    if constexpr (((REP_MASK) >> 15) & 1) { GBAR(); const int lane = lane_now(), tid = wave * 64 + lane; PH6X(4, false, false, true) }
    SEAM(6);
    RUNPH(7); SEAM(7);
    if constexpr (((REP_MASK) >> 19) & 1) { _Pragma("unroll 1") for (int i_ = 0; i_ < 20; ++i_) GBAR(); }
    RUNPH(8); SEAM(8);
    RUNPH(9); SEAM(9);
    RUNPH(10); SEAM(10);
    RUNPH(11); SEAM(11);
    RUNPH(12); SEAM(12);
    RUNPH(13);
#undef IN
#undef SEAM
}

#ifndef N_LAUNCHES
#define N_LAUNCHES 1
#endif
extern "C" void kernel_launch(void* const* d_in, const int* in_sizes, int n_in, void* d_out, int out_size, void* d_ws, size_t ws_size, hipStream_t stream) {
    static int grid = 0;
    if (grid == 0) {
        if (n_in != 27 || (size_t)out_size != O_END || ws_size < WS_END) { fprintf(stderr, "kernel_launch: unexpected shapes: n_in %d out %d ws %zu\n", n_in, out_size, ws_size); grid = -1; return; }
        int dev = 0, cus = 0, per_cu = 0;
        if (hipGetDevice(&dev) != hipSuccess || hipDeviceGetAttribute(&cus, hipDeviceAttributeMultiprocessorCount, dev) != hipSuccess) { grid = -1; return; }
        if (hipFuncSetAttribute((const void*)fwd_kernel, hipFuncAttributeMaxDynamicSharedMemorySize, LDS_BYTES) != hipSuccess) { fprintf(stderr, "kernel_launch: hipFuncSetAttribute failed\n"); grid = -1; return; }
        if (hipOccupancyMaxActiveBlocksPerMultiprocessor(&per_cu, (const void*)fwd_kernel, 512, LDS_BYTES) != hipSuccess || per_cu < 1) fprintf(stderr, "kernel_launch: occupancy query says %d\n", per_cu);
        (void)hipGetLastError();
        grid = cus;
    }
    if (grid < 0) return;
    (void)hipMemsetAsync((char*)d_ws + WS_CTL, 0, CTL_ZERO_BYTES, stream);
    Args a{};
    for (int i = 0; i < 27; ++i) a.in[i] = d_in[i];
    a.out = (float*)d_out; a.ws = (unsigned char*)d_ws;
    if (N_LAUNCHES == 1) { a.lo = 0; a.hi = NPHASE; hipLaunchKernelGGL(fwd_kernel, dim3(grid), dim3(512), LDS_BYTES, stream, a); }
    else for (int p = 0; p < NPHASE; ++p) { a.lo = p; a.hi = p + 1; hipLaunchKernelGGL(fwd_kernel, dim3(grid), dim3(512), LDS_BYTES, stream, a); }
}
```

```cpp
#include <hip/hip_runtime.h>
#include <cstdio>
#include <cstdint>
#define REP_MASK 0
#define PROBE_LEVEL 0
namespace pg8 {
#define PG8_LAS __attribute__((address_space(3)))
typedef unsigned short bf16_t;
typedef short bf16x8 __attribute__((ext_vector_type(8)));
typedef float f32x4 __attribute__((ext_vector_type(4)));
typedef unsigned u32x4 __attribute__((ext_vector_type(4)));
constexpr int BM = 256, BK = 64, HALF = 128, HTB = HALF * BK * 2  , STAGE_BYTES = 8 * HTB, NXCD = 8, WGM = 8;

__host__ __device__ __forceinline__ int lds_byte(int r, int c) { const int st = (r >> 4) * 2 + (c >> 5), rr = r & 15, cc = c & 31, ob = rr * 64 + cc * 2; return st * 1024 + (ob ^ (((ob >> 9) & 1) << 5)); }
__host__ __device__ __forceinline__ void stage_rc(int b, int& R, int& C) { const int st = b / 1024, sb = b % 1024, swz = sb ^ (((sb >> 9) & 1) << 5); R = (st >> 1) * 16 + swz / 64; C = (st & 1) * 32 + (swz % 64) / 2; }
__host__ __device__ __forceinline__ int perm32(int rho) { const int n = rho >> 4, i = rho & 15; return 8 * (i >> 2) + 4 * n + (i & 3); }

struct Unit { int pm, pn, ko; };
struct Gemm { const bf16_t* A; const bf16_t* Bt; int M, N, K, ld; };

struct StaticOrder {
    int nM, nN, nwg, G, c;
    __host__ __device__ void init(int M, int N, int G_, int c_) { nM = M / BM; nN = N / BM; nwg = nM * nN; G = G_; c = c_; }
    __host__ __device__ bool next(int i, Unit& u) const {
        const long L = (long)i * G + c; if (L >= nwg) return false;
        int wgid = (int)L; { const int q = nwg / NXCD, r = nwg % NXCD, xcd = wgid % NXCD, off = wgid / NXCD; wgid = (xcd < r ? xcd * (q + 1) : r * (q + 1) + (xcd - r) * q) + off; }
        const int nig = WGM * nN, gid = wgid / nig, fm = gid * WGM, gsz = (nM - fm) < WGM ? (nM - fm) : WGM;
        u.pm = fm + ((wgid % nig) % gsz); u.pn = (wgid % nig) / gsz; u.ko = 0; return true;
    }
    __device__ __forceinline__ void a_ready(const Unit&) const {}
    __device__ __forceinline__ void done(const Unit&) const {}
};

__device__ __forceinline__ unsigned cvt_pk_bf16(float lo, float hi) { unsigned r; asm volatile("v_cvt_pk_bf16_f32 %0, %1, %2" : "=v"(r) : "v"(lo), "v"(hi)); return r; }
typedef float f32x2 __attribute__((ext_vector_type(2)));
__device__ __forceinline__ f32x2 gelu_pk(f32x2 v) {
    const f32x2 av = __builtin_elementwise_abs(v), d = av * 0.2316418882f + 1.0f;
    f32x2 t; t.x = __builtin_amdgcn_rcpf(d.x); t.y = __builtin_amdgcn_rcpf(d.y);
    f32x2 q = t * 0.5307027145f + (-0.7265760135f); q = q * t + 0.7107068705f; q = q * t + (-0.142248368f); q = q * t + 0.127414796f; q = q * t;
    const f32x2 s = (v * v) * (-0.72134752044f);
    f32x2 e; e.x = __builtin_amdgcn_exp2f(s.x); e.y = __builtin_amdgcn_exp2f(s.y);
    const f32x2 m = v * (q * e), r = v - m;
    f32x2 o; o.x = v.x < 0.f ? m.x : r.x; o.y = v.y < 0.f ? m.y : r.y; return o;
}

template <int ACT  > struct EpiBf16 {
    static constexpr bool PERM = true, AFTER_DRAIN = false; static_assert(ACT == 0 || ACT == 1, "EpiBf16: ACT is 0 (none) or 1 (gelu_pk)");
    bf16_t* O; int ldc; const float* bias; int split_cols; size_t split_stride; float scale0;
    __device__ __forceinline__ void operator()(const f32x4 (&acc)[2][2][4][2], const Unit& u, int wr, int wc, int fr, int fq) const {
        const int row0 = u.pm * BM + wr * 64 + fr; int colt = u.pn * BM; bf16_t* base = O;
        float sc = 1.f; if (split_cols) { const int t = colt / split_cols; base += (size_t)t * split_stride; colt -= t * split_cols; if (t == 0) sc = scale0; }
        const int col0 = colt + wc * 32 + 8 * fq, bcol0 = u.pn * BM + wc * 32 + 8 * fq;
        f32x4 bv[2][2];
#pragma unroll
        for (int bj = 0; bj < 2; ++bj)
#pragma unroll
            for (int n = 0; n < 2; ++n) bv[bj][n] = bias ? *(const f32x4*)(bias + bcol0 + bj * HALF + 4 * n) : (f32x4){0.f, 0.f, 0.f, 0.f};
#pragma unroll
        for (int ai = 0; ai < 2; ++ai)
#pragma unroll
            for (int m = 0; m < 4; ++m) { bf16_t* rowp = base + (size_t)(row0 + ai * HALF + m * 16) * ldc + col0;
#pragma unroll
                for (int bj = 0; bj < 2; ++bj) { f32x4 v0 = acc[ai][bj][m][0] + bv[bj][0], v1 = acc[ai][bj][m][1] + bv[bj][1];
                    if (ACT == 1) { f32x2 a = gelu_pk((f32x2){v0[0], v0[1]}), b = gelu_pk((f32x2){v0[2], v0[3]}), c = gelu_pk((f32x2){v1[0], v1[1]}), d = gelu_pk((f32x2){v1[2], v1[3]});
                        v0 = (f32x4){a.x, a.y, b.x, b.y}; v1 = (f32x4){c.x, c.y, d.x, d.y}; }
                    v0 = v0 * sc; v1 = v1 * sc; u32x4 w; w.x = cvt_pk_bf16(v0[0], v0[1]); w.y = cvt_pk_bf16(v0[2], v0[3]); w.z = cvt_pk_bf16(v1[0], v1[1]); w.w = cvt_pk_bf16(v1[2], v1[3]);
                    *(u32x4*)(rowp + bj * HALF) = w; } }
    }
};

struct PanelStats {
    unsigned* xbuf;
    unsigned* cnt;
    unsigned* tmo;
    int ntn; float eps;
    unsigned code;
    __device__ __forceinline__ bool run(const f32x4 (&v)[2][2][4][2], const Unit& u, int wr, int wc, int fr, int fq, PG8_LAS unsigned char* lds, int wid, int lane) const {
        typedef float f32x2v __attribute__((ext_vector_type(2)));
        PG8_LAS f32x2v* P = (PG8_LAS f32x2v*)lds;
        PG8_LAS f32x2v* S = (PG8_LAS f32x2v*)(lds + 8192);
        PG8_LAS unsigned* flag = (PG8_LAS unsigned*)(lds + 8192 + 2048);
#pragma unroll
        for (int ai = 0; ai < 2; ++ai)
#pragma unroll
            for (int m = 0; m < 4; ++m) {
                float s = 0.f;
#pragma unroll
                for (int bj = 0; bj < 2; ++bj)
#pragma unroll
                    for (int n = 0; n < 2; ++n) { const f32x4 x = v[ai][bj][m][n]; s += (x[0] + x[1]) + (x[2] + x[3]); }
                s += __shfl_xor(s, 16); s += __shfl_xor(s, 32);
                const float mw = s * (1.0f / 64.0f); float q = 0.f;
#pragma unroll
                for (int bj = 0; bj < 2; ++bj)
#pragma unroll
                    for (int n = 0; n < 2; ++n) { const f32x4 d = v[ai][bj][m][n] - mw; q += (d[0] * d[0] + d[1] * d[1]) + (d[2] * d[2] + d[3] * d[3]); }
                q += __shfl_xor(q, 16); q += __shfl_xor(q, 32);
                if (fq == 0) P[(ai * HALF + wr * 64 + m * 16 + fr) * 4 + wc] = (f32x2v){mw, q};
            }
        asm volatile("s_waitcnt lgkmcnt(0)" ::: "memory"); __builtin_amdgcn_s_barrier(); asm volatile("" ::: "memory");
#if defined(BROKEN_EXCHANGE_NO_WAIT)
#warning BROKEN CONTROL BUILD: the row-statistics exchange does not wait; results are wrong by design
        if (blockIdx.x >= 64) { const long long t0_ = clock64(); while (clock64() - t0_ < 60000) __builtin_amdgcn_s_sleep(8); }
#endif
        const int row = wid * 32 + (lane & 31);
        if (lane < 32) {
            const f32x2v a = P[row * 4 + 0], b = P[row * 4 + 1], c = P[row * 4 + 2], d = P[row * 4 + 3];
            const float mt = (a.x + b.x + c.x + d.x) * 0.25f;
            const float da = a.x - mt, db = b.x - mt, dc = c.x - mt, dd = d.x - mt;
            const float m2 = (a.y + b.y) + (c.y + d.y) + 64.0f * ((da * da + db * db) + (dc * dc + dd * dd));
            unsigned long long* slot = (unsigned long long*)xbuf + ((size_t)(u.pm * BM + row) * 4 + u.pn);
            __hip_atomic_store(slot, ((unsigned long long)__float_as_uint(m2) << 32) | __float_as_uint(mt), __ATOMIC_RELAXED, __HIP_MEMORY_SCOPE_AGENT);
        }
        asm volatile("s_waitcnt vmcnt(0)" ::: "memory");
        if (lane == 0) __hip_atomic_fetch_add(cnt + 64 * u.pm, 1u, __ATOMIC_RELAXED, __HIP_MEMORY_SCOPE_AGENT);
        if (wid == 0) {
            bool dead = false; const unsigned long long t0 = __builtin_amdgcn_s_memrealtime(); const unsigned want = 8u * (unsigned)ntn;
            for (;;) {
#if defined(BROKEN_EXCHANGE_NO_WAIT)
                break;
#endif
                if ((unsigned)__builtin_amdgcn_readfirstlane(__hip_atomic_load(cnt + 64 * u.pm, __ATOMIC_RELAXED, __HIP_MEMORY_SCOPE_AGENT)) >= want) break;
                if (__builtin_amdgcn_s_memrealtime() - t0 > 2000000ull) {
                    if (lane == 0) { unsigned expect = 0u; __hip_atomic_compare_exchange_strong(tmo + 1, &expect, code | (unsigned)(u.pm & 0xff), __ATOMIC_RELAXED, __ATOMIC_RELAXED, __HIP_MEMORY_SCOPE_AGENT);
                                     __hip_atomic_store(tmo, 1u, __ATOMIC_RELAXED, __HIP_MEMORY_SCOPE_AGENT); }
                    dead = true; break; }
                __builtin_amdgcn_s_sleep(2);
            }
            __builtin_amdgcn_fence(__ATOMIC_ACQUIRE, "agent");
            if (lane == 0) flag[0] = dead ? 1u : 0u;
        }
        asm volatile("s_waitcnt vmcnt(0) lgkmcnt(0)" ::: "memory"); __builtin_amdgcn_s_barrier(); asm volatile("" ::: "memory");
        const bool bad = flag[0] != 0u;
        if (lane < 32) {
            const unsigned long long* slot = (const unsigned long long*)xbuf + (size_t)(u.pm * BM + row) * 4; float mt[4], m2[4]; float ms = 0.f;
#pragma unroll
            for (int t = 0; t < 4; ++t) { if (t < ntn) { const unsigned long long w = __hip_atomic_load(slot + t, __ATOMIC_RELAXED, __HIP_MEMORY_SCOPE_AGENT); mt[t] = __uint_as_float((unsigned)w); m2[t] = __uint_as_float((unsigned)(w >> 32)); } else { mt[t] = 0.f; m2[t] = 0.f; } ms += mt[t]; }
            const float mean = ms / (float)ntn; float q = 0.f;
#pragma unroll
            for (int t = 0; t < 4; ++t) if (t < ntn) { const float dm = mt[t] - mean; q += m2[t] + 256.0f * dm * dm; }
            S[row] = (f32x2v){mean, 1.0f / sqrtf(q / (256.0f * (float)ntn) + eps)};
        }
        asm volatile("s_waitcnt lgkmcnt(0)" ::: "memory"); __builtin_amdgcn_s_barrier(); asm volatile("" ::: "memory");
        return bad;
    }
};
struct EpiLnRes {
    static constexpr bool PERM = false, AFTER_DRAIN = true;
    const float* base; float* out; int ldc; const float* bias; PanelStats st; unsigned poison;
    __device__ __forceinline__ void fused(f32x4 (&acc)[2][2][4][2], const Unit& u, int wr, int wc, int fr, int fq, PG8_LAS unsigned char* lds, int wid, int lane) const {
        typedef float f32x2v __attribute__((ext_vector_type(2)));
        const PG8_LAS f32x2v* S = (const PG8_LAS f32x2v*)(lds + 8192);
        const int col0 = u.pn * BM + wc * 32 + 4 * fq;
#pragma unroll
        for (int bj = 0; bj < 2; ++bj)
#pragma unroll
            for (int n = 0; n < 2; ++n) { const f32x4 bv = bias ? *(const f32x4*)(bias + col0 + bj * HALF + n * 16) : (f32x4){0.f, 0.f, 0.f, 0.f};
#pragma unroll
                for (int ai = 0; ai < 2; ++ai)
#pragma unroll
                    for (int m = 0; m < 4; ++m) acc[ai][bj][m][n] += bv; }
        f32x4 pre[4][2][2];
#pragma unroll
        for (int m = 0; m < 4; ++m) { const size_t off = (size_t)(u.pm * BM + wr * 64 + m * 16 + fr) * ldc + col0;
#pragma unroll
            for (int bj = 0; bj < 2; ++bj)
#pragma unroll
                for (int n = 0; n < 2; ++n) pre[m][bj][n] = *(const f32x4*)(base + off + bj * HALF + n * 16); }
        const bool bad = st.run(acc, u, wr, wc, fr, fq, lds, wid, lane) || poison != 0u;
        const float qnan = __builtin_nanf("");
#pragma unroll
        for (int ai = 0; ai < 2; ++ai)
#pragma unroll
            for (int m = 0; m < 4; ++m) { const int r = ai * HALF + wr * 64 + m * 16 + fr; const f32x2v sr = S[r]; const size_t off = (size_t)(u.pm * BM + r) * ldc + col0;
#pragma unroll
                for (int bj = 0; bj < 2; ++bj)
#pragma unroll
                    for (int n = 0; n < 2; ++n) { const f32x4 bs = ai == 0 ? pre[m][bj][n] : *(const f32x4*)(base + off + bj * HALF + n * 16); f32x4 o = bs + (acc[ai][bj][m][n] - sr.x) * sr.y;
                        if (bad) o = (f32x4){qnan, qnan, qnan, qnan}; *(f32x4*)(out + off + bj * HALF + n * 16) = o; }
                if (m & 1) asm volatile("" ::: "memory"); }
    }
};
struct EpiLnResLn {
    static constexpr bool PERM = false, AFTER_DRAIN = true;
    const float* base; float* out; bf16_t* xn; int ldc; const float* bias; PanelStats st1, st2; unsigned poison;
    __device__ __forceinline__ void fused(f32x4 (&acc)[2][2][4][2], const Unit& u, int wr, int wc, int fr, int fq, PG8_LAS unsigned char* lds, int wid, int lane) const {
        typedef float f32x2v __attribute__((ext_vector_type(2))); typedef unsigned u32x2v __attribute__((ext_vector_type(2)));
        const PG8_LAS f32x2v* S = (const PG8_LAS f32x2v*)(lds + 8192);
        const int col0 = u.pn * BM + wc * 32 + 4 * fq;
#pragma unroll
        for (int bj = 0; bj < 2; ++bj)
#pragma unroll
            for (int n = 0; n < 2; ++n) { const f32x4 bv = bias ? *(const f32x4*)(bias + col0 + bj * HALF + n * 16) : (f32x4){0.f, 0.f, 0.f, 0.f};
#pragma unroll
                for (int ai = 0; ai < 2; ++ai)
#pragma unroll
                    for (int m = 0; m < 4; ++m) acc[ai][bj][m][n] += bv; }
        bool bad = st1.run(acc, u, wr, wc, fr, fq, lds, wid, lane) || poison != 0u;
        const float qnan = __builtin_nanf("");
#pragma unroll
        for (int ai = 0; ai < 2; ++ai)
#pragma unroll
            for (int m = 0; m < 4; ++m) { const int r = ai * HALF + wr * 64 + m * 16 + fr; const f32x2v sr = S[r]; const size_t off = (size_t)(u.pm * BM + r) * ldc + col0;
#pragma unroll
                for (int bj = 0; bj < 2; ++bj)
#pragma unroll
                    for (int n = 0; n < 2; ++n) { const f32x4 bs = *(const f32x4*)(base + off + bj * HALF + n * 16); acc[ai][bj][m][n] = bs + (acc[ai][bj][m][n] - sr.x) * sr.y; }
                asm volatile("" : "+v"(acc[ai][0][m][0]), "+v"(acc[ai][0][m][1]), "+v"(acc[ai][1][m][0]), "+v"(acc[ai][1][m][1]));
                if (m & 1) asm volatile("" ::: "memory"); }
        const bool bad1 = bad;
        bad = st2.run(acc, u, wr, wc, fr, fq, lds, wid, lane) || bad;
#pragma unroll
        for (int ai = 0; ai < 2; ++ai)
#pragma unroll
            for (int m = 0; m < 4; ++m) { const int r = ai * HALF + wr * 64 + m * 16 + fr; const f32x2v sr = S[r]; const size_t off = (size_t)(u.pm * BM + r) * ldc + col0;
#pragma unroll
                for (int bj = 0; bj < 2; ++bj)
#pragma unroll
                    for (int n = 0; n < 2; ++n) { const f32x4 x1 = acc[ai][bj][m][n]; *(f32x4*)(out + off + bj * HALF + n * 16) = bad1 ? (f32x4){qnan, qnan, qnan, qnan} : x1;
                        const f32x4 o = (x1 - sr.x) * sr.y; u32x2v w; w.x = cvt_pk_bf16(o[0], o[1]); w.y = cvt_pk_bf16(o[2], o[3]);
                        if (bad) { w.x = 0x7fc07fc0u; w.y = 0x7fc07fc0u; } *(u32x2v*)(xn + off + bj * HALF + n * 16) = w; }
                asm volatile("" ::: "memory"); }
    }
};

template <class Epi, class Sched, bool ALIGN_EPI = false, bool SP2 = false>
__device__ __forceinline__ void gemm_phase(PG8_LAS unsigned char* lds, const Gemm g, const Sched& S, const Epi& E, const int tid) {
    const int wid = __builtin_amdgcn_readfirstlane(tid >> 6), lane = tid & 63, wr = wid >> 2, wc = wid & 3, fr = lane & 15, fq = lane >> 4;
    const int K = g.K, nt = K / BK;
    unsigned voffA[2], voffB[2];
#pragma unroll
    for (int i = 0; i < 2; ++i) { int R, C; stage_rc(tid * 16 + i * 8192, R, C); const int Rb = Epi::PERM ? ((R & ~31) + perm32(R & 31)) : R;
        voffA[i] = (unsigned)(R * g.ld + C) * 2u; voffB[i] = (unsigned)(Rb * g.ld + C) * 2u; }
    const size_t kstep = (size_t)(BK * 2);
    const size_t hstep = (size_t)HALF * g.ld * 2;
    const size_t tstep = 2 * hstep;
    const unsigned ldsw = (unsigned)wid * 1024u;
    const int aoff = lds_byte(wr * 64 + fr, fq * 8), boff = lds_byte(wc * 32 + fr, fq * 8);
#define PG8_SA(b, h) (((b) * 2 + (h)) * HTB)
#define PG8_SB(b, h) ((4 + (b) * 2 + (h)) * HTB)
#define PG8_STAGE(bufoff, gbase, voff) do { _Pragma("unroll") for (int _i = 0; _i < 2; ++_i) \
        __builtin_amdgcn_global_load_lds((const unsigned*)((const char*)(gbase) + (voff)[_i]), (PG8_LAS unsigned*)(lds + (bufoff) + ldsw + _i * 8192), 16, 0, 0); } while (0)
#define PG8_LDA(dst, b, h) do { _Pragma("unroll") for (int m = 0; m < 4; ++m) _Pragma("unroll") for (int k = 0; k < 2; ++k) dst[m][k] = *(const PG8_LAS bf16x8*)(lds + PG8_SA(b, h) + aoff + m * 2048 + k * 1024); } while (0)
#define PG8_LDB(dst, b, h) do { _Pragma("unroll") for (int n = 0; n < 2; ++n) _Pragma("unroll") for (int k = 0; k < 2; ++k) dst[n][k] = *(const PG8_LAS bf16x8*)(lds + PG8_SB(b, h) + boff + n * 2048 + k * 1024); } while (0)
#define PG8_MMA(ai, bj, At, Bt) do { __builtin_amdgcn_s_setprio(1); _Pragma("unroll") for (int m = 0; m < 4; ++m) _Pragma("unroll") for (int n = 0; n < 2; ++n) _Pragma("unroll") for (int k = 0; k < 2; ++k) \
        acc[ai][bj][m][n] = __builtin_amdgcn_mfma_f32_16x16x32_bf16(Bt[n][k], At[m][k], acc[ai][bj][m][n], 0, 0, 0); __builtin_amdgcn_s_setprio(0); } while (0)
#define PG8_WAIT_V(n) asm volatile("s_waitcnt vmcnt(" #n ")" ::: "memory")
#define PG8_WAIT_L(n) asm volatile("s_waitcnt lgkmcnt(" #n ")" ::: "memory")
#define PG8_BAR __builtin_amdgcn_s_barrier()
#define PG8_SCHED __builtin_amdgcn_sched_barrier(0)
    Unit cur, nxt; int ui = 0;
    if (!S.next(0, cur)) return;
    f32x4 acc[2][2][4][2];
#pragma unroll
    for (int a = 0; a < 2; ++a)
#pragma unroll
        for (int b = 0; b < 2; ++b)
#pragma unroll
            for (int m = 0; m < 4; ++m)
#pragma unroll
                for (int n = 0; n < 2; ++n) acc[a][b][m][n] = (f32x4){0.f, 0.f, 0.f, 0.f};
    bf16x8 At[4][2], B0[2][2], B1[2][2];
    const char* cA = (const char*)g.A + (size_t)cur.pm * tstep + (size_t)cur.ko * 2; const char* cB = (const char*)g.Bt + (size_t)cur.pn * tstep + (size_t)cur.ko * 2;
    S.a_ready(cur);
    if constexpr (SP2) {
        PG8_STAGE(PG8_SB(0, 0), cB, voffB); PG8_STAGE(PG8_SB(0, 1), cB + hstep, voffB); PG8_STAGE(PG8_SA(0, 0), cA, voffA); PG8_STAGE(PG8_SA(0, 1), cA + hstep, voffA);
        if (wr == 1) PG8_BAR;
        PG8_WAIT_V(2); PG8_BAR;
        PG8_STAGE(PG8_SB(1, 0), cB + kstep, voffB); PG8_STAGE(PG8_SA(1, 0), cA + kstep, voffA); PG8_STAGE(PG8_SB(1, 1), cB + hstep + kstep, voffB);
        PG8_WAIT_V(6); PG8_BAR;
    } else {
        PG8_STAGE(PG8_SB(0, 0), cB, voffB); PG8_STAGE(PG8_SA(0, 0), cA, voffA); PG8_STAGE(PG8_SB(0, 1), cB + hstep, voffB); PG8_STAGE(PG8_SA(0, 1), cA + hstep, voffA);
        if (wr == 1) PG8_BAR;
        PG8_WAIT_V(4); PG8_BAR;
        PG8_STAGE(PG8_SB(1, 0), cB + kstep, voffB); PG8_STAGE(PG8_SA(1, 0), cA + kstep, voffA); PG8_STAGE(PG8_SB(1, 1), cB + hstep + kstep, voffB);
        PG8_WAIT_V(6); PG8_BAR;
    }
    for (;;) {
        const bool has_next = S.next(ui + 1, nxt);
        const char* nA = has_next ? (const char*)g.A + (size_t)nxt.pm * tstep + (size_t)nxt.ko * 2 : cA; const char* nB = has_next ? (const char*)g.Bt + (size_t)nxt.pn * tstep + (size_t)nxt.ko * 2 : cB;
        for (int t = 0; t < nt; t += 2) {
            const bool last = (t == nt - 2);
            const char* a1 = cA + (size_t)(t + 1) * kstep;
            const char* a2 = last ? nA : cA + (size_t)(t + 2) * kstep; const char* b2 = last ? nB : cB + (size_t)(t + 2) * kstep;
            const char* a3 = a2 + kstep; const char* b3 = b2 + kstep;
            if (last && has_next) S.a_ready(nxt);
            if constexpr (SP2) {
            PG8_LDB(B0, 0, 0); PG8_LDB(B1, 0, 1); PG8_SCHED; PG8_LDA(At, 0, 0); PG8_STAGE(PG8_SA(1, 1), a1 + hstep, voffA);
            PG8_WAIT_V(8); PG8_WAIT_L(0); PG8_BAR; PG8_MMA(0, 0, At, B0); PG8_MMA(0, 1, At, B1); PG8_BAR; PG8_SCHED;
            PG8_LDA(At, 0, 1); PG8_STAGE(PG8_SB(0, 0), b2, voffB); PG8_STAGE(PG8_SB(0, 1), b2 + hstep, voffB); PG8_STAGE(PG8_SA(0, 0), a2, voffA);
            PG8_WAIT_V(8); PG8_WAIT_L(0); PG8_BAR; PG8_MMA(1, 0, At, B0); PG8_MMA(1, 1, At, B1); PG8_BAR; PG8_SCHED;
            PG8_LDB(B0, 1, 0); PG8_LDB(B1, 1, 1); PG8_SCHED; PG8_LDA(At, 1, 0); PG8_STAGE(PG8_SA(0, 1), a2 + hstep, voffA);
            PG8_WAIT_V(8); PG8_WAIT_L(0); PG8_BAR; PG8_MMA(0, 0, At, B0); PG8_MMA(0, 1, At, B1); PG8_BAR; PG8_SCHED;
            PG8_LDA(At, 1, 1); PG8_STAGE(PG8_SB(1, 0), b3, voffB); PG8_STAGE(PG8_SB(1, 1), b3 + hstep, voffB); PG8_STAGE(PG8_SA(1, 0), a3, voffA);
            PG8_WAIT_V(8); PG8_WAIT_L(0); PG8_BAR; PG8_MMA(1, 0, At, B0); PG8_MMA(1, 1, At, B1); PG8_BAR; PG8_SCHED;
            } else {
            PG8_LDB(B0, 0, 0); PG8_SCHED; PG8_LDA(At, 0, 0); PG8_STAGE(PG8_SA(1, 1), a1 + hstep, voffA);
            PG8_WAIT_L(8); PG8_BAR; PG8_WAIT_L(0); PG8_MMA(0, 0, At, B0); PG8_BAR; PG8_SCHED;
            PG8_LDB(B1, 0, 1); PG8_STAGE(PG8_SB(0, 0), b2, voffB);
            PG8_BAR; PG8_WAIT_L(0); PG8_MMA(0, 1, At, B1); PG8_BAR;
            PG8_LDA(At, 0, 1); PG8_STAGE(PG8_SA(0, 0), a2, voffA);
            PG8_BAR; PG8_WAIT_L(0); PG8_MMA(1, 0, At, B0); PG8_BAR; PG8_SCHED;
            PG8_STAGE(PG8_SB(0, 1), b2 + hstep, voffB);
            PG8_WAIT_V(6); PG8_BAR; PG8_MMA(1, 1, At, B1); PG8_BAR;
            PG8_LDB(B0, 1, 0); PG8_SCHED; PG8_LDA(At, 1, 0); PG8_STAGE(PG8_SA(0, 1), a2 + hstep, voffA);
            PG8_WAIT_L(8); PG8_BAR; PG8_WAIT_L(0); PG8_MMA(0, 0, At, B0); PG8_BAR; PG8_SCHED;
            PG8_LDB(B1, 1, 1); PG8_STAGE(PG8_SB(1, 0), b3, voffB);
            PG8_BAR; PG8_WAIT_L(0); PG8_MMA(0, 1, At, B1); PG8_BAR;
            PG8_LDA(At, 1, 1); PG8_STAGE(PG8_SA(1, 0), a3, voffA);
            PG8_BAR; PG8_WAIT_L(0); PG8_MMA(1, 0, At, B0); PG8_BAR; PG8_SCHED;
            PG8_STAGE(PG8_SB(1, 1), b3 + hstep, voffB);
            PG8_WAIT_V(6); PG8_BAR; PG8_MMA(1, 1, At, B1); PG8_BAR;
            }
        }
        if constexpr (ALIGN_EPI) { if (wr == 0) PG8_BAR; }
        if constexpr (!Epi::AFTER_DRAIN) { E(acc, cur, wr, wc, fr, fq); S.done(cur); }
        if (!has_next) break;
#pragma unroll
        for (int a = 0; a < 2; ++a)
#pragma unroll
            for (int b = 0; b < 2; ++b)
#pragma unroll
                for (int m = 0; m < 4; ++m)
#pragma unroll
                    for (int n = 0; n < 2; ++n) acc[a][b][m][n] = (f32x4){0.f, 0.f, 0.f, 0.f};
        cur = nxt; cA = nA; cB = nB; ++ui;
        if constexpr (ALIGN_EPI) { if (wr == 1) PG8_BAR; }
    }
    PG8_WAIT_V(0);
    if constexpr (!ALIGN_EPI) { if (wr == 0) PG8_BAR; }
    PG8_BAR;
    if constexpr (Epi::AFTER_DRAIN) { E.fused(acc, cur, wr, wc, fr, fq, lds, wid, lane); S.done(cur); }
#undef PG8_SA
#undef PG8_SB
#undef PG8_STAGE
#undef PG8_LDA
#undef PG8_LDB
#undef PG8_MMA
#undef PG8_WAIT_V
#undef PG8_WAIT_L
#undef PG8_BAR
#undef PG8_SCHED
}
}

#define GAS __attribute__((address_space(1)))
#define LAS __attribute__((address_space(3)))
typedef unsigned short bf16;
typedef float f32x4 __attribute__((ext_vector_type(4)));
typedef float f32x16 __attribute__((ext_vector_type(16)));
typedef short bf16x8 __attribute__((ext_vector_type(8)));
typedef short s16x4 __attribute__((ext_vector_type(4)));
typedef unsigned u32x4 __attribute__((ext_vector_type(4)));
typedef unsigned u32x2 __attribute__((ext_vector_type(2)));
typedef float f32x2_t __attribute__((ext_vector_type(2)));
typedef __bf16 bf16x2_t __attribute__((ext_vector_type(2)));
typedef GAS unsigned gu32;
#define RLX_AGENT __ATOMIC_RELAXED, __HIP_MEMORY_SCOPE_AGENT

constexpr int D = 1024, BP = 4, TP = 4096, MP = BP * TP, BS = 128, TS = 8, MS = BS * TS, M = MP + MS;
constexpr int SBH = 8, HD = 64, SBW = 512, DNH = 4, DND = 128, DNW = 512;
constexpr int IN_COLS = 3592, NPROJ = 3584;
constexpr int DFF = 2816, DFF2 = 5632, NMOD = 6144, NC = BP + BS;
constexpr int PAST = 2048, NPAGES = 16, PAGE = 128;
constexpr float EPS = 1e-6f, LOG2E = 1.4426950408889634f;
constexpr float QSCALE = 0.125f * LOG2E;
constexpr int NSPLIT = 4, NPART = 5;

constexpr size_t O_YP = 0, O_KP = 17825792, O_VP = 26214400, O_KS = 34603008, O_VS = 35127296, O_SP = 35651584, O_SS = 35913728,
                 O_DCP = 44302336, O_DCS = 44320768, O_FCP = 44910592, O_FCS = 44955648, O_END = 46397440;

constexpr size_t MiB = 1u << 20;
constexpr size_t WS_CTL = 0, CTL_ZERO_BYTES = MiB;
constexpr size_t WS_MOD = 1 * MiB, WS_SC = 5 * MiB, WS_WINX = 6 * MiB, WS_WIN_T = 7 * MiB, WS_WOUT_T = 14 * MiB, WS_WUP_T = 16 * MiB, WS_WDN_T = 27 * MiB,
                 WS_EXTRA = 33 * MiB, WS_H = 34 * MiB, WS_DNRAW = 68 * MiB, WS_ZG = 120 * MiB, WS_QB = 306 * MiB, WS_KB = 323 * MiB, WS_VB = 340 * MiB, WS_QD = 357 * MiB, WS_KD = 391 * MiB,
                 WS_VD = 425 * MiB, WS_BETA = 459 * MiB, WS_LOGA = 460 * MiB, WS_ODN = 461 * MiB, WS_MIXED = 495 * MiB, WS_X1 = 529 * MiB, WS_UP = 597 * MiB,
                 WS_ACT = 784 * MiB, WS_U = 878 * MiB, WS_KCUM = 910 * MiB, WS_QDEC = 926 * MiB, WS_KDECT = 942 * MiB, WS_INTRA = 958 * MiB, WS_GL = 966 * MiB,
                 WS_OPART = 967 * MiB, WS_LPART = 978 * MiB, WS_SLAB = 980 * MiB, WS_END = 1024 * MiB;
constexpr int CW_Q0 = 1024;
constexpr int CW_QUEUE = 64;
constexpr int CW_BAR = 8192;

constexpr int RING_BYTES = 131072, MISC_OFF = RING_BYTES + 320, LDS_BYTES = 147456;

__device__ __forceinline__ unsigned cvtpk(float lo, float hi) { f32x2_t v = {lo, hi}; bf16x2_t b = __builtin_convertvector(v, bf16x2_t); return __builtin_bit_cast(unsigned, b); }
__device__ __forceinline__ bf16 f2bf(float f) { return (bf16)(cvtpk(f, 0.f) & 0xffffu); }
__device__ __forceinline__ float wave_sum(float v) {
#pragma unroll
    for (int o = 1; o < 64; o <<= 1) v += __shfl_xor(v, o);
    return v;
}
__device__ __forceinline__ float siluf(float x) { return x * __builtin_amdgcn_rcpf(1.f + __builtin_amdgcn_exp2f(-1.4426950408889634f * x)); }
__device__ __forceinline__ u32x4 pack8(const f32x4 a, const f32x4 b) { u32x4 w; w.x = cvtpk(a.x, a.y); w.y = cvtpk(a.z, a.w); w.z = cvtpk(b.x, b.y); w.w = cvtpk(b.z, b.w); return w; }
__device__ __forceinline__ float bf2f(unsigned short h) { return __uint_as_float((unsigned)h << 16); }

#define XB_TMO      128
#define XB_XCNT(j)  (256  + 64 * (j))
#define XB_XSUB(j)  (1280 + 64 * (j))
#define XB_XGEN(j)  (2304 + 64 * (j))
#define XB_TOP      3328
#define XB_TOPGEN   3392
#define XCD_BAR_WORDS 3456
#define XB_SPIN_CAP (1u << 18)
__device__ __forceinline__ unsigned xb_ld(unsigned* p)              { return __hip_atomic_load(p, __ATOMIC_RELAXED, __HIP_MEMORY_SCOPE_AGENT); }
__device__ __forceinline__ unsigned xb_add(unsigned* p, unsigned v) { return __hip_atomic_fetch_add(p, v, __ATOMIC_RELAXED, __HIP_MEMORY_SCOPE_AGENT); }
__device__ __forceinline__ unsigned xb_xcc_id() { return (unsigned)__builtin_amdgcn_s_getreg((3 << 11) | 20) & 0xFu; }
#define XB_SPIN(cond, bar) do { unsigned _sp = 0; while (cond) { __builtin_amdgcn_s_sleep(1); \
    if ((++_sp & 255u) == 0u) { if (xb_ld(&(bar)[XB_TMO])) break; if (_sp > XB_SPIN_CAP) { atomicAdd(&(bar)[XB_TMO], 1u); break; } } } } while (0)
struct XcdBarrier { unsigned* bar; unsigned x; volatile LAS unsigned* st; };
__device__ __forceinline__ XcdBarrier xcd_barrier_post(unsigned* bar, volatile LAS unsigned* st, int tid) {
    XcdBarrier b; b.bar = bar; b.x = xb_xcc_id(); b.st = st;
    if (tid == 0) (void)xb_add(&bar[XB_XCNT(b.x)], 1u);
    return b;
}
__device__ __forceinline__ void xcd_barrier_complete(unsigned* bar, unsigned x, unsigned& nloc, unsigned& nx) {
    const unsigned G = gridDim.x * gridDim.y * gridDim.z;
    unsigned sum, cnt, mine, sp = 0u;
    for (;;) {
        sum = 0u; cnt = 0u; mine = 0u;
#pragma unroll
        for (unsigned j = 0; j < 16; ++j) { const unsigned c = xb_ld(&bar[XB_XCNT(j)]); sum += c; cnt += (c > 0u) ? 1u : 0u; mine = (j == x) ? c : mine; }
        if (sum == G) break;
        __builtin_amdgcn_s_sleep(1);
        if ((++sp & 255u) == 0u) { if (xb_ld(&bar[XB_TMO])) break; if (sp > XB_SPIN_CAP) { atomicAdd(&bar[XB_TMO], 1u); break; } }
    }
    nloc = mine > 0u ? mine : 1u; nx = cnt > 0u ? cnt : 1u;
}
__device__ __forceinline__ void xcd_barrier(const XcdBarrier& b, int tid) {
    asm volatile("s_waitcnt vmcnt(0)" ::: "memory");
    __syncthreads();
    if (tid == 0) {
        unsigned* bar = b.bar;
        __builtin_amdgcn_s_waitcnt(0);
        unsigned nloc = b.st[0], nx = b.st[1];
        if (nloc == 0u) { xcd_barrier_complete(bar, b.x, nloc, nx); b.st[0] = nloc; b.st[1] = nx; }
        const unsigned old = xb_add(&bar[XB_XSUB(b.x)], 1u);
        const unsigned gen = old / nloc;
        if (old + 1u == (gen + 1u) * nloc) {
            __builtin_amdgcn_fence(__ATOMIC_RELEASE, "agent");
            asm volatile("s_waitcnt vmcnt(0)" ::: "memory");
            const unsigned og = xb_add(&bar[XB_TOP], 1u);
            const unsigned tg = og / nx;
            if (og + 1u == (tg + 1u) * nx) xb_add(&bar[XB_TOPGEN], 1u);
            else XB_SPIN(xb_ld(&bar[XB_TOPGEN]) == tg, bar);
            __builtin_amdgcn_fence(__ATOMIC_ACQUIRE, "agent");
            xb_add(&bar[XB_XGEN(b.x)], 1u);
            asm volatile("s_waitcnt vmcnt(0)" ::: "memory");
        } else {
            XB_SPIN(xb_ld(&bar[XB_XGEN(b.x)]) == gen, bar);
            __builtin_amdgcn_fence(__ATOMIC_ACQUIRE, "agent");
            asm volatile("s_waitcnt vmcnt(0)" ::: "memory");
        }
    }
    __syncthreads();
}

__device__ __forceinline__ int lane_now() { int l; asm volatile("v_mbcnt_lo_u32_b32 %0, -1, 0\n\tv_mbcnt_hi_u32_b32 %0, -1, %0" : "=v"(l)); return l; }
struct Args { const void* in[27]; float* out; unsigned char* ws; int lo, hi; };
enum { I_XP = 0, I_XS, I_CP, I_CS, I_CK, I_CV, I_PT, I_SD, I_SDC, I_SFC, I_WADA, I_BADA, I_GATT, I_WIN, I_GQ, I_GK, I_SBB, I_GSBO, I_WDNC, I_ALOG, I_DTB, I_GDNO, I_WOUT, I_GFFN, I_WUP, I_WFC, I_WDN };

__device__ __forceinline__ int mod_row(int m) { return m < MP ? (m >> 12) : BP + ((m - MP) >> 3); }

struct EpiF32 {
    static constexpr bool PERM = false, AFTER_DRAIN = false;
    float* O; int ldc;
    __device__ __forceinline__ void operator()(const pg8::f32x4 (&acc)[2][2][4][2], const pg8::Unit& u, int wr, int wc, int fr, int fq) const {
        const int row0 = u.pm * 256 + wr * 64 + fr, col0 = u.pn * 256 + wc * 32 + 4 * fq;
#pragma unroll
        for (int ai = 0; ai < 2; ++ai)
#pragma unroll
            for (int m = 0; m < 4; ++m) { float* rowp = O + (size_t)(row0 + ai * 128 + m * 16) * ldc + col0;
#pragma unroll
                for (int bj = 0; bj < 2; ++bj)
#pragma unroll
                    for (int n = 0; n < 2; ++n) *(pg8::f32x4*)(rowp + bj * 128 + n * 16) = acc[ai][bj][m][n]; }
    }
};
struct EpiResGate {
    static constexpr bool PERM = false, AFTER_DRAIN = false;
    const float* base0; const float* base1; const float* mod; int goff; float* out;
    __device__ __forceinline__ void operator()(const pg8::f32x4 (&acc)[2][2][4][2], const pg8::Unit& u, int wr, int wc, int fr, int fq) const {
        const int row0 = u.pm * 256 + wr * 64 + fr, col0 = u.pn * 256 + wc * 32 + 4 * fq;
#pragma unroll
        for (int ai = 0; ai < 2; ++ai)
#pragma unroll
            for (int m = 0; m < 4; ++m) { const int r = row0 + ai * 128 + m * 16;
                const float* bp = (r < MP ? base0 + (size_t)r * D : base1 + (size_t)(r - MP) * D) + col0;
                const float* gp = mod + (size_t)mod_row(r) * NMOD + goff + col0; float* op = out + (size_t)r * D + col0;
#pragma unroll
                for (int bj = 0; bj < 2; ++bj)
#pragma unroll
                    for (int n = 0; n < 2; ++n) { const pg8::f32x4 b = *(const pg8::f32x4*)(bp + bj * 128 + n * 16), g = *(const pg8::f32x4*)(gp + bj * 128 + n * 16);
                        *(pg8::f32x4*)(op + bj * 128 + n * 16) = b + g * acc[ai][bj][m][n]; } }
    }
};

struct SplitKOrder {
    int nks, G, c;
    __device__ __forceinline__ bool next(int i, pg8::Unit& u) const { const int L = i * G + c; if (L >= 16 * nks) return false; const int su = L & 15, ks = L >> 4; u.pm = MP / 256 + (su >> 2); u.pn = su & 3; u.ko = ks * 256; return true; }
    __device__ __forceinline__ void a_ready(const pg8::Unit&) const {}
    __device__ __forceinline__ void done(const pg8::Unit&) const {}
};
struct EpiSlab {
    static constexpr bool PERM = false, AFTER_DRAIN = false;
    float* slab;
    __device__ __forceinline__ void operator()(const pg8::f32x4 (&acc)[2][2][4][2], const pg8::Unit& u, int wr, int wc, int fr, int fq) const {
        float* O = slab + (size_t)(u.ko >> 8) * ((size_t)MS * D);
        const int row0 = (u.pm - MP / 256) * 256 + wr * 64 + fr, col0 = u.pn * 256 + wc * 32 + 4 * fq;
#pragma unroll
        for (int ai = 0; ai < 2; ++ai)
#pragma unroll
            for (int m = 0; m < 4; ++m) { float* rowp = O + (size_t)(row0 + ai * 128 + m * 16) * D + col0;
#pragma unroll
                for (int bj = 0; bj < 2; ++bj)
#pragma unroll
                    for (int n = 0; n < 2; ++n) *(pg8::f32x4*)(rowp + bj * 128 + n * 16) = acc[ai][bj][m][n]; }
    }
};
__device__ __forceinline__ void st16(void* base, unsigned off, u32x4 v) { *(u32x4*)((unsigned char*)base + off) = v; }
__device__ __forceinline__ void st16f(void* base, unsigned off, pg8::f32x4 v) { *(pg8::f32x4*)((unsigned char*)base + off) = v; }
struct EpiProj {
    static constexpr bool PERM = true, AFTER_DRAIN = false;
    float* out; bf16* QB; bf16* KB; bf16* VB; bf16* DNRAW; bf16* ZG; const float* g_q; const float* g_k; LAS float* xl;
    __device__ __forceinline__ void operator()(const pg8::f32x4 (&acc)[2][2][4][2], const pg8::Unit& u, int wr, int wc, int fr, int fq) const {
        const int pn = u.pn, rl0 = wr * 64 + fr, c0 = wc * 32 + 8 * fq;
        const unsigned row0 = (unsigned)u.pm * 256u + (unsigned)rl0;
        const bool prompt_tile = u.pm < MP / 256;
        if (pn < 4) {
            int xb = (rl0 * 8 + wc) * 4, xb2 = (rl0 * 8 + (wc ^ 1)) * 4; asm volatile("" : "+v"(xb), "+v"(xb2));
            LAS float* xw = (LAS float*)((LAS unsigned char*)xl + xb); const LAS float* xr = (const LAS float*)((LAS unsigned char*)xl + xb2);
#pragma unroll
            for (int ai = 0; ai < 2; ++ai)
#pragma unroll
                for (int m = 0; m < 4; ++m)
#pragma unroll
                    for (int bj = 0; bj < 2; ++bj) { const pg8::f32x4 a = acc[ai][bj][m][0], b = acc[ai][bj][m][1];
                        float ss = (a[0] * a[0] + a[1] * a[1]) + (a[2] * a[2] + a[3] * a[3]) + (b[0] * b[0] + b[1] * b[1]) + (b[2] * b[2] + b[3] * b[3]);
                        ss += __shfl_xor(ss, 16); ss += __shfl_xor(ss, 32);
                        if (fq == 0) xw[(ai * 128 + m * 16) * 8 + bj * 4] = ss; }
            asm volatile("s_waitcnt lgkmcnt(0)" ::: "memory"); __builtin_amdgcn_s_barrier(); asm volatile("" ::: "memory");
            const bool isq = pn < 2; const float* g = isq ? g_q : g_k; const int dloc = 32 * (wc & 1) + 8 * fq;
            const pg8::f32x4 g0 = *(const pg8::f32x4*)(g + dloc), g1 = *(const pg8::f32x4*)(g + dloc + 4);
            bf16* dstb = isq ? QB : KB; float* dstf = prompt_tile ? out + O_KP : out + O_KS - (size_t)MP * SBW;
#pragma unroll
            for (int ai = 0; ai < 2; ++ai)
#pragma unroll
                for (int m = 0; m < 4; ++m) { const unsigned row = row0 + ai * 128 + m * 16;
#pragma unroll
                    for (int bj = 0; bj < 2; ++bj) { const float tot = xw[(ai * 128 + m * 16) * 8 + bj * 4] + xr[(ai * 128 + m * 16) * 8 + bj * 4];
                        const float rs = (isq ? QSCALE : 1.0f) / sqrtf(tot * (1.f / HD) + EPS);
                        const pg8::f32x4 a = acc[ai][bj][m][0] * rs * g0, b = acc[ai][bj][m][1] * rs * g1;
                        const unsigned e = row * SBW + (unsigned)((pn & 1) * 256 + bj * 128 + c0);
                        st16(dstb, e * 2u, pack8(a, b));
                        if (!isq) { st16f(dstf, e * 4u, a); st16f(dstf, e * 4u + 16u, b); } }
                    asm volatile("" ::: "memory"); }
            asm volatile("s_waitcnt lgkmcnt(0)" ::: "memory"); __builtin_amdgcn_s_barrier(); asm volatile("" ::: "memory");
        } else if (pn < 6) {
            float* dstf = prompt_tile ? out + O_VP : out + O_VS - (size_t)MP * SBW;
#pragma unroll
            for (int ai = 0; ai < 2; ++ai)
#pragma unroll
                for (int m = 0; m < 4; ++m) { const unsigned row = row0 + ai * 128 + m * 16;
#pragma unroll
                    for (int bj = 0; bj < 2; ++bj) { const pg8::f32x4 a = acc[ai][bj][m][0], b = acc[ai][bj][m][1]; const unsigned e = row * SBW + (unsigned)((pn & 1) * 256 + bj * 128 + c0);
                        st16(VB, e * 2u, pack8(a, b)); st16f(dstf, e * 4u, a); st16f(dstf, e * 4u + 16u, b); }
                    asm volatile("" ::: "memory"); }
        } else if (pn < 12) {
#pragma unroll
            for (int ai = 0; ai < 2; ++ai)
#pragma unroll
                for (int m = 0; m < 4; ++m) { const unsigned row = row0 + ai * 128 + m * 16;
                    const int b = prompt_tile ? (int)(row >> 12) : (int)((row - MP) >> 3), t = prompt_tile ? (int)(row & 4095) : (int)((row - MP) & 7), idx = prompt_tile ? t - (TP - 3) : t - (TS - 3);
#pragma unroll
                    for (int bj = 0; bj < 2; ++bj) { const pg8::f32x4 a = acc[ai][bj][m][0], b2 = acc[ai][bj][m][1]; const unsigned ch = (unsigned)((pn - 6) * 256 + bj * 128 + c0);
                        st16(DNRAW, (row * 1536u + ch) * 2u, pack8(a, b2));
                        if (idx >= 0) { float* o = prompt_tile ? out + O_DCP : out + O_DCS; const unsigned eo = ((unsigned)(b * 3 + idx) * 1536u + ch) * 4u; st16f(o, eo, a); st16f(o, eo + 16u, b2); } }
                    asm volatile("" ::: "memory"); }
        } else {
#pragma unroll
            for (int ai = 0; ai < 2; ++ai)
#pragma unroll
                for (int m = 0; m < 4; ++m) { const unsigned row = row0 + ai * 128 + m * 16;
#pragma unroll
                    for (int bj = 0; bj < 2; ++bj) { pg8::f32x4 a = acc[ai][bj][m][0], b = acc[ai][bj][m][1]; const unsigned e = row * DNW + (unsigned)((pn - 12) * 256 + bj * 128 + c0);
                        a[0] = siluf(a[0]); a[1] = siluf(a[1]); a[2] = siluf(a[2]); a[3] = siluf(a[3]); b[0] = siluf(b[0]); b[1] = siluf(b[1]); b[2] = siluf(b[2]); b[3] = siluf(b[3]);
                        st16(ZG, e * 2u, pack8(a, b)); }
                    asm volatile("" ::: "memory"); }
        }
    }
};

__device__ __forceinline__ void mod_tile(const Args& A, LAS unsigned char* lds, int ct, int wave, int lane) {
    const float* w_ada = (const float*)A.in[I_WADA]; const float* b_ada = (const float*)A.in[I_BADA];
    const float* cp = (const float*)A.in[I_CP]; const float* cs = (const float*)A.in[I_CS]; float* MOD = (float*)(A.ws + WS_MOD);
    const int lr = lane & 15, q = lane >> 4, col = ct * 16 + lr;
    pg8::f32x4 acc[9];
#pragma unroll
    for (int i = 0; i < 9; ++i) acc[i] = (pg8::f32x4){0.f, 0.f, 0.f, 0.f};
#pragma unroll
    for (int s4 = 0; s4 < 4; ++s4) {
        const int k0 = 128 * wave + 32 * s4 + 8 * q;
        const float* wp = w_ada + (size_t)k0 * NMOD + col;
        float w[8];
#pragma unroll
        for (int j = 0; j < 8; ++j) w[j] = wp[(size_t)j * NMOD];
        u32x4 bw; bw.x = cvtpk(w[0], w[1]); bw.y = cvtpk(w[2], w[3]); bw.z = cvtpk(w[4], w[5]); bw.w = cvtpk(w[6], w[7]);
        const bf16x8 bfr = __builtin_bit_cast(bf16x8, bw);
#pragma unroll
        for (int i = 0; i < 9; ++i) { const int row = 16 * i + lr;
            f32x4 c0 = (f32x4){0.f, 0.f, 0.f, 0.f}, c1 = c0;
            if (row < NC) { const float* crow_ = (row < BP ? cp + (size_t)row * D : cs + (size_t)(row - BP) * D) + k0; c0 = *(const f32x4*)crow_; c1 = *(const f32x4*)(crow_ + 4); }
            c0.x = siluf(c0.x); c0.y = siluf(c0.y); c0.z = siluf(c0.z); c0.w = siluf(c0.w); c1.x = siluf(c1.x); c1.y = siluf(c1.y); c1.z = siluf(c1.z); c1.w = siluf(c1.w);
            acc[i] = __builtin_amdgcn_mfma_f32_16x16x32_bf16(__builtin_bit_cast(bf16x8, pack8(c0, c1)), bfr, acc[i], 0, 0, 0); }
    }
    LAS pg8::f32x4* red = (LAS pg8::f32x4*)lds;
#pragma unroll
    for (int i = 0; i < 9; ++i) red[(wave * 9 + i) * 64 + lane] = acc[i];
    __syncthreads();
    for (int i = wave; i < 9; i += 8) {
        pg8::f32x4 t = red[i * 64 + lane];
#pragma unroll
        for (int w2 = 1; w2 < 8; ++w2) t += red[(w2 * 9 + i) * 64 + lane];
        const float bb = b_ada[col];
#pragma unroll
        for (int r = 0; r < 4; ++r) { const int row = 16 * i + 4 * q + r; if (row < NC) MOD[(size_t)row * NMOD + col] = t[r] + bb; }
    }
    __syncthreads();
}
__device__ __forceinline__ void transpose_item(const float* W, int ldw, int src_col0, bf16* WT, int Kdst, int dst_row0, int k0, LAS float* scr, int lane) {
#pragma unroll
    for (int h2 = 0; h2 < 2; ++h2) { float v[16];
#pragma unroll
        for (int i = 0; i < 16; ++i) v[i] = W[(size_t)(k0 + 2 * (16 * h2 + i) + (lane >> 5)) * ldw + src_col0 + (lane & 31)];
#pragma unroll
        for (int i = 0; i < 16; ++i) scr[(2 * (16 * h2 + i) + (lane >> 5)) * 33 + (lane & 31)] = v[i]; }
    asm volatile("s_waitcnt lgkmcnt(0)" ::: "memory");
    const int c = lane & 7;
#pragma unroll
    for (int j = 0; j < 4; ++j) { const int n = (lane >> 3) + 8 * j; const LAS float* s = scr + (8 * c) * 33 + n;
        u32x4 o; o.x = cvtpk(s[0 * 33], s[1 * 33]); o.y = cvtpk(s[2 * 33], s[3 * 33]); o.z = cvtpk(s[4 * 33], s[5 * 33]); o.w = cvtpk(s[6 * 33], s[7 * 33]);
        *(u32x4*)(WT + (size_t)(dst_row0 + n) * Kdst + k0 + 8 * c) = o; }
    asm volatile("s_waitcnt lgkmcnt(0)" ::: "memory");
}
__device__ __forceinline__ void phase_prologue(const Args& A, LAS unsigned char* lds, gu32* qhead, int bx, int G, int wave, int lane, int gtid, int NGT) {
    unsigned char* ws = A.ws;
    const float* w_in = (const float*)A.in[I_WIN]; const float* w_out = (const float*)A.in[I_WOUT]; const float* w_up = (const float*)A.in[I_WUP]; const float* w_dn = (const float*)A.in[I_WDN];
    float* WX = (float*)(ws + WS_WINX);
    for (int i = gtid; i < 8 * D; i += NGT) { const int j = i >> 10, k = i & 1023; WX[i] = w_in[(size_t)k * IN_COLS + 3072 + j]; }
    for (int ct = bx; ct < NMOD / 16; ct += G) mod_tile(A, lds, ct, wave, lane);
    LAS float* scr = (LAS float*)(lds + wave * 16384);
    constexpr int I_IN = 16 * (NPROJ / 32), I_OUT = 16 * 32, I_UP = 16 * (DFF2 / 32), I_DN = (DFF / 64) * 32, NIT = I_IN + I_OUT + I_UP + I_DN;
    for (int it_ = bx * 8 + wave; it_ < NIT; it_ += G * 8) {
        int r = it_;
        if (r < I_IN) { const int nb = r % (NPROJ / 32), kb = r / (NPROJ / 32); const int n0 = nb * 32; transpose_item(w_in, IN_COLS, n0 < 3072 ? n0 : n0 + 8, (bf16*)(ws + WS_WIN_T), D, n0, kb * 64, scr, lane); continue; } r -= I_IN;
        if (r < I_OUT) { const int nb = r % 32, kb = r / 32; transpose_item(w_out, D, nb * 32, (bf16*)(ws + WS_WOUT_T), D, nb * 32, kb * 64, scr, lane); continue; } r -= I_OUT;
        if (r < I_UP) { const int nb = r % (DFF2 / 32), kb = r / (DFF2 / 32); transpose_item(w_up, DFF2, nb * 32, (bf16*)(ws + WS_WUP_T), D, nb * 32, kb * 64, scr, lane); continue; } r -= I_UP;
        { const int nb = r % 32, kb = r / 32; transpose_item(w_dn, D, nb * 32, (bf16*)(ws + WS_WDN_T), DFF, nb * 32, kb * 64, scr, lane); }
    }
}

template <bool EXTRAS, int NS = 0>
__device__ __forceinline__ void phase_norm(const float* x0, const float* x1, const float* g, const float* MOD, int sh_off, int sc_off, bf16* H, const float* WX, float* EXTRA, int gw, int NGW, int lane, const float* slab = nullptr, int gate_off = 0, float* x1w = nullptr) {
    f32x4 wxr[4][8];
    if (EXTRAS) {
#pragma unroll
        for (int j = 0; j < 4; ++j)
#pragma unroll
            for (int e = 0; e < 8; ++e) wxr[j][e] = *(const f32x4*)(WX + e * D + 4 * (lane + 64 * j));
    }
    f32x4 nv[4];
    if (gw < M) { const float* xr0 = gw < MP ? x0 + (size_t)gw * D : x1 + (size_t)(gw - MP) * D;
#pragma unroll
        for (int j = 0; j < 4; ++j) nv[j] = *(const f32x4*)(xr0 + 4 * (lane + 64 * j)); }
    for (int m = gw; m < M; m += NGW) {
        const float* mod = MOD + (size_t)mod_row(m) * NMOD;
        f32x4 v[4]; float ss = 0.f;
#pragma unroll
        for (int j = 0; j < 4; ++j) v[j] = nv[j];
        { const int mn = m + NGW; if (mn < M) { const float* xrn = mn < MP ? x0 + (size_t)mn * D : x1 + (size_t)(mn - MP) * D;
#pragma unroll
            for (int j = 0; j < 4; ++j) nv[j] = *(const f32x4*)(xrn + 4 * (lane + 64 * j)); } }
#pragma unroll
        for (int j = 0; j < 4; ++j) {
            if (NS > 0 && m >= MP) { f32x4 a = (f32x4){0.f, 0.f, 0.f, 0.f};
#pragma unroll
                for (int k = 0; k < NS; ++k) a += *(const f32x4*)(slab + ((size_t)k * MS + (m - MP)) * D + 4 * (lane + 64 * j));
                v[j] += *(const f32x4*)(mod + gate_off + 4 * (lane + 64 * j)) * a;
                *(f32x4*)(x1w + (size_t)m * D + 4 * (lane + 64 * j)) = v[j]; }
            ss += (v[j].x * v[j].x + v[j].y * v[j].y) + (v[j].z * v[j].z + v[j].w * v[j].w); }
        ss = wave_sum(ss);
        const float rstd = 1.0f / sqrtf(ss * (1.f / D) + EPS);
        float ex[8];
#pragma unroll
        for (int e = 0; e < 8; ++e) ex[e] = 0.f;
#pragma unroll
        for (int j = 0; j < 4; ++j) { const int c = 4 * (lane + 64 * j);
            const f32x4 gg = *(const f32x4*)(g + c), sc = *(const f32x4*)(mod + sc_off + c), sh = *(const f32x4*)(mod + sh_off + c);
            const f32x4 h = (v[j] * rstd) * gg * (sc + 1.0f) + sh;
            u32x2 w; w.x = cvtpk(h.x, h.y); w.y = cvtpk(h.z, h.w); *(u32x2*)(H + (size_t)m * D + c) = w;
            if (EXTRAS) {
#pragma unroll
                for (int e = 0; e < 8; ++e) { const f32x4 wx = wxr[j][e]; ex[e] += (h.x * wx.x + h.y * wx.y) + (h.z * wx.z + h.w * wx.w); }
            }
        }
        if (EXTRAS) {
            float a4[4], a2[2], a1;
#pragma unroll
            for (int j = 0; j < 4; ++j) { const bool up = lane & 1; const float send = up ? ex[j] : ex[j + 4], keep = up ? ex[j + 4] : ex[j]; a4[j] = keep + __shfl_xor(send, 1); }
#pragma unroll
            for (int j = 0; j < 2; ++j) { const bool up = lane & 2; const float send = up ? a4[j] : a4[j + 2], keep = up ? a4[j + 2] : a4[j]; a2[j] = keep + __shfl_xor(send, 2); }
            { const bool up = lane & 4; const float send = up ? a2[0] : a2[1], keep = up ? a2[1] : a2[0]; a1 = keep + __shfl_xor(send, 4); }
            a1 += __shfl_xor(a1, 8); a1 += __shfl_xor(a1, 16); a1 += __shfl_xor(a1, 32);
            if (lane < 8) EXTRA[(size_t)m * 8 + (4 * (lane & 1) + 2 * ((lane >> 1) & 1) + ((lane >> 2) & 1))] = a1;
        }
    }
}

__device__ __forceinline__ f32x4 bf4lo(u32x4 w) { return (f32x4){__uint_as_float(w.x << 16), __uint_as_float(w.x & 0xffff0000u), __uint_as_float(w.y << 16), __uint_as_float(w.y & 0xffff0000u)}; }
__device__ __forceinline__ f32x4 bf4hi(u32x4 w) { return (f32x4){__uint_as_float(w.z << 16), __uint_as_float(w.z & 0xffff0000u), __uint_as_float(w.w << 16), __uint_as_float(w.w & 0xffff0000u)}; }
__device__ __forceinline__ void post_strip(const Args& A, int m0, int R, int part, int lane) {
    unsigned char* ws = A.ws; const bf16* DNRAW = (const bf16*)(ws + WS_DNRAW);
    const float* wc = (const float*)A.in[I_WDNC]; const float* sdc = (const float*)A.in[I_SDC];
    float* dstb = (part == 0 ? (float*)(ws + WS_QD) : part == 1 ? (float*)(ws + WS_KD) : (float*)(ws + WS_VD));
    const bool prompt = m0 < MP; const int b = prompt ? (m0 >> 12) : ((m0 - MP) >> 3), t0 = prompt ? (m0 & 4095) : ((m0 - MP) & 7);
    const int ch = part * 512 + 8 * lane;
    f32x4 w[4][2];
#pragma unroll
    for (int i = 0; i < 4; ++i) { w[i][0] = *(const f32x4*)(wc + i * 1536 + ch); w[i][1] = *(const f32x4*)(wc + i * 1536 + ch + 4); }
    f32x4 x[3][2];
#pragma unroll
    for (int j = 0; j < 3; ++j) { const int tt = t0 - 3 + j;
        if (tt >= 0) { const u32x4 r = *(const u32x4*)(DNRAW + (size_t)(m0 - 3 + j) * 1536 + ch); x[j][0] = bf4lo(r); x[j][1] = bf4hi(r); }
        else if (!prompt) { const float* p = sdc + ((size_t)b * 3 + (3 + tt)) * 1536 + ch; x[j][0] = *(const f32x4*)p; x[j][1] = *(const f32x4*)(p + 4); }
        else { x[j][0] = (f32x4){0.f, 0.f, 0.f, 0.f}; x[j][1] = x[j][0]; } }
    const bf16* src = DNRAW + (size_t)m0 * 1536 + ch;
    u32x4 nx = *(const u32x4*)src;
    for (int r = 0; r < R; ++r) {
        const u32x4 cw = nx;
        if (r + 1 < R) nx = *(const u32x4*)(src + (size_t)(r + 1) * 1536);
        const f32x4 c0 = bf4lo(cw), c1 = bf4hi(cw);
        f32x4 y0 = w[0][0] * x[0][0] + w[1][0] * x[1][0] + w[2][0] * x[2][0] + w[3][0] * c0;
        f32x4 y1 = w[0][1] * x[0][1] + w[1][1] * x[1][1] + w[2][1] * x[2][1] + w[3][1] * c1;
        x[0][0] = x[1][0]; x[0][1] = x[1][1]; x[1][0] = x[2][0]; x[1][1] = x[2][1]; x[2][0] = c0; x[2][1] = c1;
        y0.x = siluf(y0.x); y0.y = siluf(y0.y); y0.z = siluf(y0.z); y0.w = siluf(y0.w); y1.x = siluf(y1.x); y1.y = siluf(y1.y); y1.z = siluf(y1.z); y1.w = siluf(y1.w);
        if (part < 2) {
            float ss = (y0.x * y0.x + y0.y * y0.y) + (y0.z * y0.z + y0.w * y0.w) + (y1.x * y1.x + y1.y * y1.y) + (y1.z * y1.z + y1.w * y1.w);
            ss += __shfl_xor(ss, 1); ss += __shfl_xor(ss, 2); ss += __shfl_xor(ss, 4); ss += __shfl_xor(ss, 8);
            const float rs = (part == 0 ? 0.08838834764831845f : 1.0f) / sqrtf(ss + EPS);
            y0 = y0 * rs; y1 = y1 * rs;
        }
        float* dst = dstb + (size_t)(m0 + r) * DNW + 8 * lane;
        *(f32x4*)dst = y0; *(f32x4*)(dst + 4) = y1;
    }
}
__device__ __forceinline__ void phase_post(const Args& A, int gw, int NGW, int lane, int gtid, int NGT) {
    constexpr int NPI = (MP / 16) * 3, NSI = BS * 3;
    for (int it = gw; it < NPI + NSI; it += NGW) {
        if (it < NPI) post_strip(A, (it / 3) * 16, 16, it % 3, lane);
        else { const int j = it - NPI; post_strip(A, MP + (j / 3) * 8, 8, j % 3, lane); }
    }
    unsigned char* ws = A.ws; const float* a_log = (const float*)A.in[I_ALOG]; const float* dtb = (const float*)A.in[I_DTB];
    float* BETA = (float*)(ws + WS_BETA); float* LOGA = (float*)(ws + WS_LOGA); const float* EXTRA = (const float*)(ws + WS_EXTRA);
    for (int i = gtid; i < M * 8; i += NGT) { const int m = i >> 3, j = i & 7; const float x = EXTRA[i];
        if (j < 4) BETA[m * 4 + j] = 1.f / (1.f + __expf(-x));
        else { const int h = j - 4; const float z = x + dtb[h]; const float sp = fmaxf(z, 0.f) + log1pf(__expf(-fabsf(z))); LOGA[m * 4 + h] = -__expf(a_log[h]) * sp; } }
}

template <int B0, int B1> __device__ __forceinline__ void subst_rows(float (&x)[64], const LAS float* Am) {
#pragma unroll
    for (int ib = B0; ib < B1; ++ib) {
        float r[4];
#pragma unroll
        for (int rr = 0; rr < 4; ++rr) r[rr] = x[4 * ib + rr];
#pragma unroll
        for (int j4 = 0; j4 < ib; ++j4) {
#pragma unroll
            for (int rr = 0; rr < 4; ++rr) { const f32x4 a = *(const LAS f32x4*)(Am + (4 * ib + rr) * 64 + 4 * j4);
                r[rr] -= (a.x * x[4 * j4] + a.y * x[4 * j4 + 1]) + (a.z * x[4 * j4 + 2] + a.w * x[4 * j4 + 3]); }
        }
        const f32x4 d1 = *(const LAS f32x4*)(Am + (4 * ib + 1) * 64 + 4 * ib), d2 = *(const LAS f32x4*)(Am + (4 * ib + 2) * 64 + 4 * ib), d3 = *(const LAS f32x4*)(Am + (4 * ib + 3) * 64 + 4 * ib);
        r[1] -= d1.x * r[0];
        r[2] -= d2.x * r[0] + d2.y * r[1];
        r[3] -= (d3.x * r[0] + d3.y * r[1]) + d3.z * r[2];
#pragma unroll
        for (int rr = 0; rr < 4; ++rr) x[4 * ib + rr] = r[rr];
    }
}
constexpr int PS_INT = 34816, PS_STG = 53248;
template <int LEVEL = 0>
__device__ __forceinline__ void dn_prescan_unit(const Args& A, LAS unsigned char* lds, int unit, int tid, int wave, int lane) {
    unsigned char* ws = A.ws;
    const float* QD = (const float*)(ws + WS_QD); const float* KD = (const float*)(ws + WS_KD); const float* VD = (const float*)(ws + WS_VD);
    const float* BETA = (const float*)(ws + WS_BETA); const float* LOGA = (const float*)(ws + WS_LOGA);
    const int hp = unit & 1, n = (unit >> 1) & 63, b = unit >> 7;
    const int half = tid >> 8, ht = tid & 255, h = 2 * hp + half, item = (b * 64 + n) * 4 + h;
    const int m0 = b * TP + n * 64;
    LAS float* Am = (LAS float*)lds + half * 4096;
    LAS float* gs = (LAS float*)(lds + 32768) + half * 128;
    if (ht < 64) {
        float v = LOGA[(size_t)(m0 + ht) * 4 + h];
#pragma unroll
        for (int o = 1; o < 64; o <<= 1) { const float u = __shfl_up(v, o); if (ht >= o) v += u; }
        gs[ht] = v; gs[64 + ht] = BETA[(size_t)(m0 + ht) * 4 + h];
    }
    __syncthreads();
    {
        const int wl = wave & 3, lr = lane & 15, q = lane >> 4;
        pg8::f32x4 kk[4], qk[4];
#pragma unroll
        for (int j = 0; j < 4; ++j) { kk[j] = (pg8::f32x4){0.f, 0.f, 0.f, 0.f}; qk[j] = kk[j]; }
#pragma unroll
        for (int s = 0; s < 4; ++s) {
            const float* kp = KD + (size_t)(m0 + 16 * wl + lr) * DNW + h * 128 + 32 * s + 8 * q; const float* qp = QD + (size_t)(m0 + 16 * wl + lr) * DNW + h * 128 + 32 * s + 8 * q;
            const bf16x8 ak = __builtin_bit_cast(bf16x8, pack8(*(const f32x4*)kp, *(const f32x4*)(kp + 4))), aq = __builtin_bit_cast(bf16x8, pack8(*(const f32x4*)qp, *(const f32x4*)(qp + 4)));
#pragma unroll
            for (int j = 0; j < 4; ++j) { const float* bp = KD + (size_t)(m0 + 16 * j + lr) * DNW + h * 128 + 32 * s + 8 * q;
                const bf16x8 bk = __builtin_bit_cast(bf16x8, pack8(*(const f32x4*)bp, *(const f32x4*)(bp + 4)));
                kk[j] = __builtin_amdgcn_mfma_f32_16x16x32_bf16(ak, bk, kk[j], 0, 0, 0); qk[j] = __builtin_amdgcn_mfma_f32_16x16x32_bf16(aq, bk, qk[j], 0, 0, 0); }
        }
#pragma unroll
        for (int j = 0; j < 4; ++j)
#pragma unroll
            for (int r = 0; r < 4; ++r) { const int i = 16 * wl + 4 * q + r, jj = 16 * j + lr;
                const float dec = (i >= jj) ? __expf(gs[i] - gs[jj]) : 0.f;
                Am[i * 64 + jj] = (i > jj) ? gs[64 + i] * kk[j][r] * dec : 0.f;
                *(LAS bf16*)(lds + PS_INT + half * 9216 + i * 144 + jj * 2) = f2bf(qk[j][r] * dec); }
    }
    __syncthreads();
    if constexpr (LEVEL == 1) { __syncthreads(); return; }
    {
        const int c = ht;
        float* U = (float*)(ws + WS_U) + (size_t)item * 8192; bf16* KC = (bf16*)(ws + WS_KCUM) + (size_t)item * 8192;
        float x[64];
        { const float* rsrc = (ht < 128 ? VD : KD) + (size_t)m0 * DNW + h * 128 + (ht & 127);
#pragma unroll
          for (int i = 0; i < 64; ++i) x[i] = rsrc[(size_t)i * DNW]; }
#pragma unroll
        for (int i = 0; i < 64; ++i) { const float eg = __expf(gs[i]); x[i] *= gs[64 + i] * (c >= 128 ? eg : 1.0f); }
        { bf16* INTRA = (bf16*)(ws + WS_INTRA) + (size_t)item * 4096;
#pragma unroll
          for (int j = 0; j < 2; ++j) { const int k = ht + 256 * j, row = k >> 3, c8 = (k & 7) * 8; *(u32x4*)(INTRA + row * 64 + c8) = *(const LAS u32x4*)(lds + PS_INT + half * 9216 + row * 144 + c8 * 2); } }
        subst_rows<0, 6>(x, Am); subst_rows<6, 10>(x, Am); subst_rows<10, 13>(x, Am); subst_rows<13, 16>(x, Am);
        if constexpr (LEVEL == 2) { float sk = 0.f; _Pragma("unroll") for (int i = 0; i < 64; ++i) sk += x[i]; asm volatile("" :: "v"(sk)); __syncthreads(); return; }
        LAS float* stg = (LAS float*)(lds + PS_STG + half * 33280);
#pragma unroll
        for (int ps = 0; ps < 2; ++ps) {
            if (ps) __syncthreads();
#pragma unroll
            for (int i = 0; i < 32; ++i) stg[i * 260 + c] = x[32 * ps + i];
            __syncthreads();
#pragma unroll
            for (int j = 0; j < 4; ++j) { const int k = ht + 256 * j, il = k >> 9, w_ = (k >> 6) & 7, ln = k & 63, rb = 16 * il + 4 * (ln >> 4), cc = 16 * w_ + (ln & 15);
                *(f32x4*)(U + (((2 * ps + il) * 8 + w_) * 64 + ln) * 4) = (f32x4){stg[rb * 260 + cc], stg[(rb + 1) * 260 + cc], stg[(rb + 2) * 260 + cc], stg[(rb + 3) * 260 + cc]}; }
#pragma unroll
            for (int j = 0; j < 2; ++j) { const int k = ht + 256 * j, row = k >> 4, c8 = (k & 15) * 8; const LAS float* sp = stg + row * 260 + 128 + c8;
                *(u32x4*)(KC + (32 * ps + row) * 128 + c8) = pack8(*(const LAS f32x4*)sp, *(const LAS f32x4*)(sp + 4)); }
        }
    }
    if constexpr (LEVEL == 3) { __syncthreads(); return; }
    {
        const float glast = gs[63];
        bf16* QDc = (bf16*)(ws + WS_QDEC) + (size_t)item * 8192; bf16* KT = (bf16*)(ws + WS_KDECT) + (size_t)item * 8192;
#pragma unroll
        for (int j = 0; j < 4; ++j) { const int k = ht + 256 * j, row = k >> 4, c8 = (k & 15) * 8; const float* qp = QD + (size_t)(m0 + row) * DNW + h * 128 + c8; const float eg = __expf(gs[row]);
            *(u32x4*)(QDc + row * 128 + c8) = pack8(*(const f32x4*)qp * eg, *(const f32x4*)(qp + 4) * eg); }
        { const int d = ht & 127, ig = ht >> 7;
#pragma unroll
            for (int i8 = 0; i8 < 4; ++i8) { float v[8];
#pragma unroll
                for (int k = 0; k < 8; ++k) { const int i = 32 * ig + 8 * i8 + k; v[k] = KD[(size_t)(m0 + i) * DNW + h * 128 + d] * __expf(glast - gs[i]); }
                u32x4 w; w.x = cvtpk(v[0], v[1]); w.y = cvtpk(v[2], v[3]); w.z = cvtpk(v[4], v[5]); w.w = cvtpk(v[6], v[7]);
                *(u32x4*)(KT + d * 64 + 32 * ig + 8 * i8) = w; } }
        if (ht == 0) ((float*)(ws + WS_GL))[item] = __expf(glast);
    }
    __syncthreads();
}
__device__ __forceinline__ void dn_sample_unit(const Args& A, LAS unsigned char* lds, int unit, int tid) {
    unsigned char* ws = A.ws;
    const float* QD = (const float*)(ws + WS_QD); const float* KD = (const float*)(ws + WS_KD); const float* VD = (const float*)(ws + WS_VD);
    const float* BETA = (const float*)(ws + WS_BETA); const float* LOGA = (const float*)(ws + WS_LOGA); float* ODN = (float*)(ws + WS_ODN);
    const int h = unit & 3, b = unit >> 2, e = tid & 127, dq = tid >> 7;
    const float* s0 = (const float*)A.in[I_SD] + ((size_t)(b * 4 + h) * 128 + 32 * dq) * 128 + e;
    float S[32];
#pragma unroll
    for (int d = 0; d < 32; ++d) S[d] = s0[(size_t)d * 128];
    LAS float* red = (LAS float*)lds; LAS float* red2 = red + 512; LAS float* tk = red + 1024;
#pragma unroll
    for (int j = 0; j < 6; ++j) { const int i = tid + 512 * j, t = i / 384, c = i % 384, part = c >> 7; const int m = MP + b * TS + t;
        const unsigned sel = part == 0 ? 1u : part == 1 ? 0u : 2u;
        tk[i] = QD[sel * (unsigned)((WS_KD - WS_QD) / 4) + (unsigned)m * DNW + h * 128 + (c & 127)]; }
    if (tid < 16) { const size_t m = (size_t)(MP + b * TS + (tid >> 1)); tk[3072 + tid] = (tid & 1) ? BETA[m * 4 + h] : __expf(LOGA[m * 4 + h]); }
    __syncthreads();
    for (int t = 0; t < TS; ++t) {
        const int m = MP + b * TS + t;
        const float a = tk[3072 + 2 * t], bt = tk[3072 + 2 * t + 1];
        const LAS float* kp = tk + t * 384 + 32 * dq; const LAS float* qp = kp + 128;
        float kd[32], qd[32];
#pragma unroll
        for (int d4 = 0; d4 < 8; ++d4) { const f32x4 kv = *(const LAS f32x4*)(kp + 4 * d4), qv = *(const LAS f32x4*)(qp + 4 * d4);
            kd[4 * d4] = kv.x; kd[4 * d4 + 1] = kv.y; kd[4 * d4 + 2] = kv.z; kd[4 * d4 + 3] = kv.w; qd[4 * d4] = qv.x; qd[4 * d4 + 1] = qv.y; qd[4 * d4 + 2] = qv.z; qd[4 * d4 + 3] = qv.w; }
        float p0 = 0.f, p1 = 0.f;
#pragma unroll
        for (int d = 0; d < 32; d += 2) { p0 += kd[d] * S[d]; p1 += kd[d + 1] * S[d + 1]; }
        red[dq * 128 + e] = p0 + p1;
        __syncthreads();
        const float kS = (red[e] + red[128 + e]) + (red[256 + e] + red[384 + e]);
        const float dl = bt * (tk[t * 384 + 256 + e] - a * kS);
        float po0 = 0.f, po1 = 0.f;
#pragma unroll
        for (int d = 0; d < 32; d += 2) { S[d] = a * S[d] + kd[d] * dl; po0 += qd[d] * S[d]; S[d + 1] = a * S[d + 1] + kd[d + 1] * dl; po1 += qd[d + 1] * S[d + 1]; }
        red2[dq * 128 + e] = po0 + po1;
        __syncthreads();
        if (dq == 0) ODN[(size_t)m * DNW + h * 128 + e] = (red2[e] + red2[128 + e]) + (red2[256 + e] + red2[384 + e]);
    }
    float* so = A.out + O_SS + ((size_t)(b * 4 + h) * 128 + 32 * dq) * 128 + e;
#pragma unroll
    for (int d = 0; d < 32; ++d) so[(size_t)d * 128] = S[d];
    __syncthreads();
}

constexpr int SC_KC = 0, SC_QD = 17408, SC_KT = 34816, SC_IN = 53248, SC_BUF = 62464;
__device__ __forceinline__ void dn_scan_chain(const Args& A, LAS unsigned char* lds, int chain, int tid, int wave, int lane) {
    unsigned char* ws = A.ws;
    const float* Ub = (const float*)(ws + WS_U); const float* GL = (const float*)(ws + WS_GL); float* ODN = (float*)(ws + WS_ODN);
    const int b = chain >> 2, h = chain & 3, lr = lane & 15, q = lane >> 4, e = 16 * wave + lr;
    int ldst[7];
    { const int c0 = tid, c1 = tid + 512;
      ldst[0] = SC_KC + (c0 >> 4) * 272; ldst[1] = SC_KC + (c1 >> 4) * 272; ldst[2] = SC_QD + (c0 >> 4) * 272; ldst[3] = SC_QD + (c1 >> 4) * 272;
      ldst[4] = SC_KT + (c0 >> 3) * 144; ldst[5] = SC_KT + (c1 >> 3) * 144; ldst[6] = SC_IN + (c0 >> 3) * 144; }
    const int cb_ = tid & 3, hA_ = (8 * ((2 * cb_) & 3) + 4 * (cb_ >> 1)) * 2, hB_ = (8 * ((2 * cb_ + 1) & 3) + 4 * (cb_ >> 1)) * 2;
    const int o16A = ((tid & 15) >> 2) * 64 + hA_, o16B = ((tid & 15) >> 2) * 64 + hB_, o8A = ((tid & 7) >> 2) * 64 + hA_, o8B = ((tid & 7) >> 2) * 64 + hB_;
    const size_t item0 = (size_t)(b * 64) * 4 + h;
    const unsigned char* gKC = ws + WS_KCUM + item0 * 16384; const unsigned char* gQD = ws + WS_QDEC + item0 * 16384; const unsigned char* gKT = ws + WS_KDECT + item0 * 16384; const unsigned char* gIN = ws + WS_INTRA + item0 * 8192;
    const unsigned t16 = (unsigned)tid * 16u, ulane = (unsigned)(wave * 64 + lane) * 4u;
    u32x4 R[7]; float un[16], uc[16];
#define SC_GLOAD(n_) do { const size_t o16_ = (size_t)(n_) * 4 * 16384, o8_ = (size_t)(n_) * 4 * 8192; \
        R[0] = *(const u32x4*)(gKC + o16_ + t16); R[1] = *(const u32x4*)(gKC + o16_ + 8192 + t16); R[2] = *(const u32x4*)(gQD + o16_ + t16); R[3] = *(const u32x4*)(gQD + o16_ + 8192 + t16); \
        R[4] = *(const u32x4*)(gKT + o16_ + t16); R[5] = *(const u32x4*)(gKT + o16_ + 8192 + t16); R[6] = *(const u32x4*)(gIN + o8_ + t16); \
        const float* U_ = Ub + (item0 + 4 * (size_t)(n_)) * 8192; \
        _Pragma("unroll") for (int i_ = 0; i_ < 4; ++i_) { const f32x4 u_ = *(const f32x4*)(U_ + (ulane + (unsigned)(i_ * 2048))); un[4 * i_] = u_.x; un[4 * i_ + 1] = u_.y; un[4 * i_ + 2] = u_.z; un[4 * i_ + 3] = u_.w; } } while (0)
#define SC_LWRITE(buf_) do { _Pragma("unroll") for (int k_ = 0; k_ < 7; ++k_) { LAS unsigned char* d_ = lds + (buf_) * SC_BUF + ldst[k_]; \
        *(LAS u32x2*)(d_ + (k_ < 4 ? o16A : o8A)) = (u32x2){R[k_].x, R[k_].y}; *(LAS u32x2*)(d_ + (k_ < 4 ? o16B : o8B)) = (u32x2){R[k_].z, R[k_].w}; } } while (0)
#define SC_BARRIER() do { asm volatile("s_waitcnt lgkmcnt(0)" ::: "memory"); __builtin_amdgcn_s_barrier(); asm volatile("" ::: "memory"); } while (0)
#define SC_FRAG(off_, pitch_, row_, s_) (*(const LAS bf16x8*)(B + (off_) + (row_) * (pitch_) + (32 * (s_) + 8 * q) * 2))
    pg8::f32x4 S[8];
#pragma unroll
    for (int i = 0; i < 8; ++i) S[i] = (pg8::f32x4){0.f, 0.f, 0.f, 0.f};
    const float glv = GL[item0 + 4 * (size_t)lane];
    __syncthreads();
    SC_GLOAD(0); SC_LWRITE(0);
#pragma unroll
    for (int k = 0; k < 16; ++k) uc[k] = un[k];
    __syncthreads();
    for (int n = 0; n < 64; ++n) {
        const float gl = __uint_as_float(__builtin_amdgcn_readlane(__float_as_uint(glv), n));
        if (n + 1 < 64) SC_GLOAD(n + 1);
        const LAS unsigned char* B = lds + (n & 1) * SC_BUF;
        bf16x8 Sb[4];
#pragma unroll
        for (int s = 0; s < 4; ++s) { u32x4 w; w.x = cvtpk(S[2 * s][0], S[2 * s][1]); w.y = cvtpk(S[2 * s][2], S[2 * s][3]); w.z = cvtpk(S[2 * s + 1][0], S[2 * s + 1][1]); w.w = cvtpk(S[2 * s + 1][2], S[2 * s + 1][3]); Sb[s] = __builtin_bit_cast(bf16x8, w); }
        pg8::f32x4 vn[4], o[4];
#pragma unroll
        for (int ih = 0; ih < 2; ++ih) {
            bf16x8 fk[2][4], fq[2][4];
#pragma unroll
            for (int ii = 0; ii < 2; ++ii)
#pragma unroll
                for (int s = 0; s < 4; ++s) { fk[ii][s] = SC_FRAG(SC_KC, 272, 16 * (2 * ih + ii) + lr, s); fq[ii][s] = SC_FRAG(SC_QD, 272, 16 * (2 * ih + ii) + lr, s); }
#pragma unroll
            for (int ii = 0; ii < 2; ++ii) { const int i = 2 * ih + ii;
                pg8::f32x4 ak = (pg8::f32x4){0.f, 0.f, 0.f, 0.f}, aq = ak;
#pragma unroll
                for (int s = 0; s < 4; ++s) { ak = __builtin_amdgcn_mfma_f32_16x16x32_bf16(fk[ii][s], Sb[s], ak, 0, 0, 0); aq = __builtin_amdgcn_mfma_f32_16x16x32_bf16(fq[ii][s], Sb[s], aq, 0, 0, 0); }
#pragma unroll
                for (int r = 0; r < 4; ++r) vn[i][r] = uc[4 * i + r] - ak[r];
                o[i] = aq; }
        }
        bf16x8 Vb[2];
#pragma unroll
        for (int s = 0; s < 2; ++s) { u32x4 w; w.x = cvtpk(vn[2 * s][0], vn[2 * s][1]); w.y = cvtpk(vn[2 * s][2], vn[2 * s][3]); w.z = cvtpk(vn[2 * s + 1][0], vn[2 * s + 1][1]); w.w = cvtpk(vn[2 * s + 1][2], vn[2 * s + 1][3]); Vb[s] = __builtin_bit_cast(bf16x8, w); }
        {
            bf16x8 fi[4][2], ft[8][2];
#pragma unroll
            for (int i = 0; i < 4; ++i)
#pragma unroll
                for (int s = 0; s < 2; ++s) fi[i][s] = SC_FRAG(SC_IN, 144, 16 * i + lr, s);
#pragma unroll
            for (int i = 0; i < 8; ++i)
#pragma unroll
                for (int s = 0; s < 2; ++s) ft[i][s] = SC_FRAG(SC_KT, 144, 16 * i + lr, s);
#pragma unroll
            for (int i = 0; i < 4; ++i) {
#pragma unroll
                for (int s = 0; s < 2; ++s) o[i] = __builtin_amdgcn_mfma_f32_16x16x32_bf16(fi[i][s], Vb[s], o[i], 0, 0, 0);
                *(f32x4*)(ODN + ((item0 + 4 * (size_t)n) * 8192) + (ulane + (unsigned)(i * 2048))) = (f32x4){o[i][0], o[i][1], o[i][2], o[i][3]};
            }
#pragma unroll
            for (int i = 0; i < 8; ++i) {
                pg8::f32x4 acc = S[i] * gl;
#pragma unroll
                for (int s = 0; s < 2; ++s) acc = __builtin_amdgcn_mfma_f32_16x16x32_bf16(ft[i][s], Vb[s], acc, 0, 0, 0);
                S[i] = acc;
            }
        }
        if (n + 1 < 64) {
            SC_LWRITE((n + 1) & 1);
#pragma unroll
            for (int k = 0; k < 16; ++k) uc[k] = un[k];
        }
        SC_BARRIER();
    }
#undef SC_GLOAD
#undef SC_LWRITE
#undef SC_FRAG
    float* so = A.out + O_SP + (size_t)(b * 4 + h) * 16384;
#pragma unroll
    for (int i = 0; i < 8; ++i)
#pragma unroll
        for (int r = 0; r < 4; ++r) so[(unsigned)((16 * i + 4 * q + r) * 128 + e)] = S[i][r];
}

__device__ __forceinline__ int crow(int r, int hi) { return (r & 3) + 8 * (r >> 2) + 4 * hi; }
__device__ __forceinline__ void sb_core(f32x16& p, float& carry, int hi) {
    float s[16];
#pragma unroll
    for (int r = 0; r < 16; ++r) { const float e = __builtin_amdgcn_exp2f(p[r]); s[r] = -__builtin_amdgcn_logf(1.0f + e); }
    float tt[4], uu[4];
#pragma unroll
    for (int i = 0; i < 4; ++i) { s[4 * i + 2] += s[4 * i + 3]; s[4 * i + 1] += s[4 * i + 2]; s[4 * i] += s[4 * i + 1]; tt[i] = s[4 * i]; }
#pragma unroll
    for (int i = 0; i < 4; ++i) uu[i] = __shfl_xor(tt[i], 32);
    const float w3 = tt[3] + uu[3], w2 = tt[2] + uu[2], w1 = tt[1] + uu[1], w0 = tt[0] + uu[0];
    float off[4];
    off[3] = carry; off[2] = carry + w3; off[1] = off[2] + w2; off[0] = off[1] + w1;
    carry = off[0] + w0;
    if (hi == 0) {
#pragma unroll
        for (int i = 0; i < 4; ++i) off[i] += uu[i];
    }
#pragma unroll
    for (int r = 0; r < 16; ++r) p[r] = __builtin_amdgcn_exp2f(p[r] + s[r] + off[r >> 2]);
}
__device__ __forceinline__ bf16x8 pack_p(const f32x16& p, int s) {
    u32x4 w; w.x = cvtpk(p[8 * s], p[8 * s + 1]); w.y = cvtpk(p[8 * s + 2], p[8 * s + 3]); w.z = cvtpk(p[8 * s + 4], p[8 * s + 5]); w.w = cvtpk(p[8 * s + 6], p[8 * s + 7]); return __builtin_bit_cast(bf16x8, w);
}
constexpr int AW_BYTES = 16384, AW_V = 0, VPI = 192, AW_K = 6144, KPI = 144, AW_Q = 6144, AW_SQ = 10752;
__device__ __forceinline__ void read_vfrags(bf16x8 (&vf)[4], const LAS unsigned char* wl, int lane) {
    const int hi = lane >> 5;
    const LAS unsigned char* vb = wl + AW_V + (4 * hi + ((lane & 15) >> 2)) * VPI + (((lane >> 4) & 1) * 16 + (lane & 3) * 4) * 2;
#pragma unroll
    for (int dt = 0; dt < 2; ++dt) {
        const s16x4 t0 = __builtin_bit_cast(s16x4, __builtin_amdgcn_ds_read_tr16_b64_v4i16((LAS s16x4*)(vb + dt * 64)));
        const s16x4 t1 = __builtin_bit_cast(s16x4, __builtin_amdgcn_ds_read_tr16_b64_v4i16((LAS s16x4*)(vb + dt * 64 + 8 * VPI)));
        const s16x4 t2 = __builtin_bit_cast(s16x4, __builtin_amdgcn_ds_read_tr16_b64_v4i16((LAS s16x4*)(vb + dt * 64 + 16 * VPI)));
        const s16x4 t3 = __builtin_bit_cast(s16x4, __builtin_amdgcn_ds_read_tr16_b64_v4i16((LAS s16x4*)(vb + dt * 64 + 24 * VPI)));
        vf[2 * dt] = (bf16x8){t0[0], t0[1], t0[2], t0[3], t1[0], t1[1], t1[2], t1[3]}; vf[2 * dt + 1] = (bf16x8){t2[0], t2[1], t2[2], t2[3], t3[0], t3[1], t3[2], t3[3]};
    }
}
__device__ __forceinline__ void load_k_prompt(bf16x8 (&k)[4], const bf16* KB, int b, int h, int kv0, int r32, int hi) {
    const bf16* kp = KB + (size_t)(b * TP + kv0 + r32) * SBW + h * HD + 8 * hi;
#pragma unroll
    for (int d0 = 0; d0 < 4; ++d0) k[d0] = *(const bf16x8*)(kp + 16 * d0);
}
__device__ __forceinline__ void load_v_prompt(u32x4 (&v)[4], const bf16* VB, int b, int h, int kv0, int lane) {
    const bf16* vp = VB + (size_t)(b * TP + kv0 + (lane >> 3)) * SBW + h * HD + (lane & 7) * 8;
#pragma unroll
    for (int i = 0; i < 4; ++i) v[i] = *(const u32x4*)(vp + (size_t)(8 * i) * SBW);
}
__device__ __forceinline__ void write_v_lds(LAS unsigned char* wl, const u32x4 (&v)[4], int lane) {
#pragma unroll
    for (int i = 0; i < 4; ++i) *(LAS u32x4*)(wl + AW_V + (8 * i + (lane >> 3)) * VPI + (lane & 7) * 16) = v[i];
}
template <int MASK>
__device__ __forceinline__ void sb_qk(f32x16& p, const bf16x8 (&kf)[4], const bf16x8 (&qf)[4], float bias2, int kv0, int qpos, int hi) {
#pragma unroll
    for (int r = 0; r < 16; ++r) p[r] = bias2;
#pragma unroll
    for (int d0 = 0; d0 < 4; ++d0) p = __builtin_amdgcn_mfma_f32_32x32x16_bf16(kf[d0], qf[d0], p, 0, 0, 0);
    if (MASK) {
#pragma unroll
        for (int r = 0; r < 16; ++r) if (kv0 + crow(r, hi) >= qpos) p[r] = -INFINITY;
    }
}
__device__ __forceinline__ void sb_pvonly(const f32x16& p, const bf16x8 (&vf)[4], f32x16 (&o)[2]) {
    const bf16x8 p0 = pack_p(p, 0), p1 = pack_p(p, 1);
#pragma unroll
    for (int dt = 0; dt < 2; ++dt) { o[dt] = __builtin_amdgcn_mfma_f32_32x32x16_bf16(vf[2 * dt], p0, o[dt], 0, 0, 0); o[dt] = __builtin_amdgcn_mfma_f32_32x32x16_bf16(vf[2 * dt + 1], p1, o[dt], 0, 0, 0); }
}
__device__ __forceinline__ void sb_pv(f32x16& p, const bf16x8 (&vf)[4], f32x16 (&o)[2], float& carry, int hi) {
    sb_core(p, carry, hi);
    const bf16x8 p0 = pack_p(p, 0), p1 = pack_p(p, 1);
#pragma unroll
    for (int dt = 0; dt < 2; ++dt) { o[dt] = __builtin_amdgcn_mfma_f32_32x32x16_bf16(vf[2 * dt], p0, o[dt], 0, 0, 0); o[dt] = __builtin_amdgcn_mfma_f32_32x32x16_bf16(vf[2 * dt + 1], p1, o[dt], 0, 0, 0); }
}
template <int MASK>
__device__ __forceinline__ void sb_tile(const bf16x8 (&kf)[4], const bf16x8 (&vf)[4], const bf16x8 (&qf)[4], float bias2, f32x16 (&o)[2], float& carry, int kv0, int qpos, int hi) {
    f32x16 p; sb_qk<MASK>(p, kf, qf, bias2, kv0, qpos, hi); sb_pv(p, vf, o, carry, hi);
}
__device__ __forceinline__ void sb_store_prompt(const Args& A, const f32x16 (&o)[2], int b, int h, int qpos, int hi) {
    float ss = 0.f;
#pragma unroll
    for (int dt = 0; dt < 2; ++dt)
#pragma unroll
        for (int r = 0; r < 16; ++r) ss += o[dt][r] * o[dt][r];
    ss += __shfl_xor(ss, 32);
    const float rs = 1.0f / sqrtf(ss * (1.f / HD) + EPS);
    const float* gso = (const float*)A.in[I_GSBO];
    bf16* op = (bf16*)(A.ws + WS_MIXED) + (size_t)(b * TP + qpos) * D + h * HD;
#pragma unroll
    for (int dt = 0; dt < 2; ++dt)
#pragma unroll
        for (int g = 0; g < 4; ++g) { const int d = 32 * dt + 8 * g + 4 * hi; const f32x4 gg = *(const f32x4*)(gso + d);
            u32x2 w; w.x = cvtpk(o[dt][4 * g] * rs * gg.x, o[dt][4 * g + 1] * rs * gg.y); w.y = cvtpk(o[dt][4 * g + 2] * rs * gg.z, o[dt][4 * g + 3] * rs * gg.w); *(u32x2*)(op + d) = w; }
}
__device__ __forceinline__ void attn_prompt_item(const Args& A, LAS unsigned char* wl, int b, int h, int q0, int lane) {
    unsigned char* ws = A.ws;
    const bf16* QB = (const bf16*)(ws + WS_QB); const bf16* KB = (const bf16*)(ws + WS_KB); const bf16* VB = (const bf16*)(ws + WS_VB);
    const int r32 = lane & 31, hi = lane >> 5, qa = q0 + r32, qb = q0 + 32 + r32;
    const float bias2 = ((const float*)A.in[I_SBB])[h] * LOG2E;
#pragma unroll
    for (int d0 = 0; d0 < 4; ++d0) { *(LAS bf16x8*)(wl + AW_Q + (d0 * 64 + lane) * 16) = *(const bf16x8*)(QB + (size_t)(b * TP + qa) * SBW + h * HD + 16 * d0 + 8 * hi);
        *(LAS bf16x8*)(wl + AW_Q + 4096 + (d0 * 64 + lane) * 16) = *(const bf16x8*)(QB + (size_t)(b * TP + qb) * SBW + h * HD + 16 * d0 + 8 * hi); }
#define QFA_LOAD bf16x8 qfa[4]; _Pragma("unroll") for (int d0_ = 0; d0_ < 4; ++d0_) qfa[d0_] = *(const LAS bf16x8*)(wl + AW_Q + (d0_ * 64 + lane) * 16);
#define QFB_LOAD bf16x8 qfb[4]; _Pragma("unroll") for (int d0_ = 0; d0_ < 4; ++d0_) qfb[d0_] = *(const LAS bf16x8*)(wl + AW_Q + 4096 + (d0_ * 64 + lane) * 16);
    f32x16 oa[2], ob[2]; oa[0] = (f32x16){}; oa[1] = (f32x16){}; ob[0] = (f32x16){}; ob[1] = (f32x16){};
    float ca = 0.f, cb = 0.f;
    bf16x8 kc[4], vf[4]; u32x4 vr[4];
    const int top = (q0 >> 5) + 1;
    load_k_prompt(kc, KB, b, h, 32 * top, r32, hi); load_v_prompt(vr, VB, b, h, 32 * top, lane);
    { write_v_lds(wl, vr, lane); load_v_prompt(vr, VB, b, h, 32 * (top - 1), lane);
      f32x16 p; { QFB_LOAD sb_qk<1>(p, kc, qfb, bias2, 32 * top, qb, hi); }
      load_k_prompt(kc, KB, b, h, 32 * (top - 1), r32, hi);
      read_vfrags(vf, wl, lane);
      sb_pv(p, vf, ob, cb, hi); }
    { write_v_lds(wl, vr, lane); if (top >= 2) load_v_prompt(vr, VB, b, h, 32 * (top - 2), lane);
      f32x16 p; { QFA_LOAD sb_qk<1>(p, kc, qfa, bias2, 32 * (top - 1), qa, hi); }
      read_vfrags(vf, wl, lane);
      sb_pv(p, vf, oa, ca, hi);
      { QFB_LOAD sb_qk<0>(p, kc, qfb, bias2, 0, 0, hi); }
      if (top >= 2) load_k_prompt(kc, KB, b, h, 32 * (top - 2), r32, hi);
      sb_pv(p, vf, ob, cb, hi); }
    for (int ht = top - 2; ht >= 0; --ht) {
        write_v_lds(wl, vr, lane);
        f32x16 p, p2; { QFA_LOAD sb_qk<0>(p, kc, qfa, bias2, 0, 0, hi); } { QFB_LOAD sb_qk<0>(p2, kc, qfb, bias2, 0, 0, hi); }
        if (ht > 0) load_k_prompt(kc, KB, b, h, 32 * (ht - 1), r32, hi);
        read_vfrags(vf, wl, lane);
        sb_core(p, ca, hi); sb_pvonly(p, vf, oa);
        __builtin_amdgcn_sched_barrier(0);
        if (ht > 0) load_v_prompt(vr, VB, b, h, 32 * (ht - 1), lane);
        sb_core(p2, cb, hi); sb_pvonly(p2, vf, ob);
    }
    sb_store_prompt(A, oa, b, h, qa, hi); sb_store_prompt(A, ob, b, h, qb, hi);
#undef QFA_LOAD
#undef QFB_LOAD
}

__device__ __forceinline__ void load_raw_sample(f32x4 (&r)[8], const float* c, size_t base, int h, int lane) {
    const float* p = c + base + (size_t)(lane >> 4) * 512 + h * HD + (lane & 15) * 4;
#pragma unroll
    for (int i = 0; i < 8; ++i) r[i] = *(const f32x4*)(p + (size_t)(4 * i) * 512);
}
__device__ __forceinline__ void write_raw_sample(LAS unsigned char* wl, int off, int pitch, const f32x4 (&r)[8], int lane) {
#pragma unroll
    for (int i = 0; i < 8; ++i) { const int row = 4 * i + (lane >> 4); u32x2 w; w.x = cvtpk(r[i].x, r[i].y); w.y = cvtpk(r[i].z, r[i].w); *(LAS u32x2*)(wl + off + row * pitch + (lane & 15) * 8) = w; }
}
__device__ __forceinline__ void read_kfrags(bf16x8 (&kf)[4], const LAS unsigned char* wl, int r32, int hi) {
#pragma unroll
    for (int d0 = 0; d0 < 4; ++d0) kf[d0] = *(const LAS bf16x8*)(wl + AW_K + r32 * KPI + (16 * d0 + 8 * hi) * 2);
}
__device__ __forceinline__ void attn_sample_store(const Args& A, int b, int h, int part, int lane, const f32x16 (&o)[2], float carry) {
    float* OP = (float*)(A.ws + WS_OPART) + (size_t)((b * SBH + h) * NPART + part) * 512; float* LP = (float*)(A.ws + WS_LPART) + (size_t)((b * SBH + h) * NPART + part) * 8;
    const int r32 = lane & 31, hi = lane >> 5;
    unsigned lo = (unsigned)(r32 * 64 + 4 * hi), ll = (unsigned)r32; asm volatile("" : "+v"(lo), "+v"(ll));
    if (r32 < 8) {
#pragma unroll
        for (int dt = 0; dt < 2; ++dt)
#pragma unroll
            for (int g = 0; g < 4; ++g) *(f32x4*)(OP + (lo + (unsigned)(32 * dt + 8 * g))) = (f32x4){o[dt][4 * g], o[dt][4 * g + 1], o[dt][4 * g + 2], o[dt][4 * g + 3]};
        if (hi == 0) LP[ll] = carry;
    }
}
__device__ __forceinline__ void attn_sample_job(const Args& A, LAS unsigned char* wl, int b, int h, int sp, int lane) {
    unsigned char* ws = A.ws;
    const int r32 = lane & 31, hi = lane >> 5;
    const float* ck = (const float*)A.in[I_CK]; const float* cv = (const float*)A.in[I_CV]; const int* pt = (const int*)A.in[I_PT] + b * NPAGES;
    const bf16* QB = (const bf16*)(ws + WS_QB);
    const float bias2 = ((const float*)A.in[I_SBB])[h] * LOG2E;
    bf16x8 qf[4];
#pragma unroll
    for (int d0 = 0; d0 < 4; ++d0) { qf[d0] = (bf16x8){0, 0, 0, 0, 0, 0, 0, 0}; if (r32 < TS) qf[d0] = *(const bf16x8*)(QB + (size_t)(MP + b * TS + r32) * SBW + h * HD + 16 * d0 + 8 * hi); }
    f32x16 o[2]; float carry;
    bf16x8 kf[4], vf[4];
    const int tok_hi = (PAST / NSPLIT) * (sp + 1);
    constexpr int NT = PAST / NSPLIT / 32;
    f32x4 rk[8], rv[8];
#define SAMPLE_BASE(j) (((size_t)pt[(tok_hi - 32 * ((j) + 1)) >> 7] * PAGE + ((tok_hi - 32 * ((j) + 1)) & 127)) * 512)
    if (sp == NSPLIT - 1) {
        const bf16* KBn = (const bf16*)(ws + WS_KB) + (size_t)(MP + b * TS) * SBW + h * HD;
#pragma unroll
        for (int d0 = 0; d0 < 4; ++d0) { kf[d0] = (bf16x8){0, 0, 0, 0, 0, 0, 0, 0}; if (r32 < TS) kf[d0] = *(const bf16x8*)(KBn + (size_t)r32 * SBW + 16 * d0 + 8 * hi); }
        u32x4 vr[4];
        vr[0] = *(const u32x4*)((const bf16*)(ws + WS_VB) + (size_t)(MP + b * TS + (lane >> 3)) * SBW + h * HD + (lane & 7) * 8);
        vr[1] = (u32x4){0u, 0u, 0u, 0u}; vr[2] = vr[1]; vr[3] = vr[1];
        write_v_lds(wl, vr, lane);
        read_vfrags(vf, wl, lane);
        o[0] = (f32x16){}; o[1] = (f32x16){}; carry = 0.f;
        sb_tile<1>(kf, vf, qf, bias2, o, carry, 0, r32, hi);
        attn_sample_store(A, b, h, NPART - 1, lane, o, carry);
    }
    f32x4 rk2[8];
    load_raw_sample(rk, ck, SAMPLE_BASE(0), h, lane); load_raw_sample(rv, cv, SAMPLE_BASE(0), h, lane);
    load_raw_sample(rk2, ck, SAMPLE_BASE(1), h, lane);
#pragma unroll
    for (int d0 = 0; d0 < 4; ++d0) *(LAS bf16x8*)(wl + AW_SQ + (d0 * 64 + lane) * 16) = qf[d0];
    o[0] = (f32x16){}; o[1] = (f32x16){}; carry = 0.f;
#define SAMPLE_TILE(RK, jk_, jv_) do { \
        write_raw_sample(wl, AW_K, KPI, RK, lane); write_raw_sample(wl, AW_V, VPI, rv, lane); \
        if ((jk_) < NT) load_raw_sample(RK, ck, SAMPLE_BASE(jk_), h, lane); \
        read_kfrags(kf, wl, r32, hi); read_vfrags(vf, wl, lane); \
        bf16x8 qq[4]; _Pragma("unroll") for (int d0_ = 0; d0_ < 4; ++d0_) qq[d0_] = *(const LAS bf16x8*)(wl + AW_SQ + (d0_ * 64 + lane) * 16); \
        f32x16 p; sb_qk<0>(p, kf, qq, bias2, 0, 0, hi); \
        sb_core(p, carry, hi); \
        __builtin_amdgcn_sched_barrier(0); \
        if ((jv_) < NT) load_raw_sample(rv, cv, SAMPLE_BASE(jv_), h, lane); \
        sb_pvonly(p, vf, o); } while (0)
    for (int j = 0; j < NT; j += 2) {
        SAMPLE_TILE(rk, j + 2, j + 1);
        SAMPLE_TILE(rk2, j + 3, j + 2);
    }
#undef SAMPLE_TILE
#undef SAMPLE_BASE
    attn_sample_store(A, b, h, sp, lane, o, carry);
}

__device__ __forceinline__ void phase_outnorm(const Args& A, int gw, int NGW, int lane) {
    unsigned char* ws = A.ws; const float* ODN = (const float*)(ws + WS_ODN); bf16* MIXED = (bf16*)(ws + WS_MIXED);
    const float* gdn = (const float*)A.in[I_GDNO]; const float* gso = (const float*)A.in[I_GSBO];
    const float* OPb = (const float*)(ws + WS_OPART); const float* LPb = (const float*)(ws + WS_LPART);
    const int c8 = 8 * lane;
    for (int m = gw; m < M; m += NGW) {
        {
            f32x4 a0, a1;
            if (m >= MP) { const float* op = ODN + (size_t)m * DNW + c8; a0 = *(const f32x4*)op; a1 = *(const f32x4*)(op + 4); }
            else { const int t = m & 4095, cch = t & 63, hh = lane >> 4; const size_t it_ = (size_t)((m >> 12) * 64 + (t >> 6)) * 4 + hh;
                const float* op = ODN + it_ * 8192 + ((((cch >> 4) * 8 + ((lane & 15) >> 1)) * 64 + ((cch >> 2) & 3) * 16 + 8 * (lane & 1)) * 4) + (cch & 3);
                a0 = (f32x4){op[0], op[4], op[8], op[12]}; a1 = (f32x4){op[16], op[20], op[24], op[28]}; }
            float ss = (a0.x * a0.x + a0.y * a0.y) + (a0.z * a0.z + a0.w * a0.w) + (a1.x * a1.x + a1.y * a1.y) + (a1.z * a1.z + a1.w * a1.w);
            ss += __shfl_xor(ss, 1); ss += __shfl_xor(ss, 2); ss += __shfl_xor(ss, 4); ss += __shfl_xor(ss, 8);
            const float rs = 1.0f / sqrtf(ss * (1.f / DND) + EPS);
            const f32x4 g0 = *(const f32x4*)(gdn + (c8 & 127)), g1 = *(const f32x4*)(gdn + (c8 & 127) + 4);
            const u32x4 zw = *(const u32x4*)((const bf16*)(ws + WS_ZG) + (size_t)m * DNW + c8); const f32x4 z0 = bf4lo(zw), z1 = bf4hi(zw);
            *(u32x4*)(MIXED + (size_t)m * D + SBW + c8) = pack8(a0 * rs * g0 * z0, a1 * rs * g1 * z1);
        }
        if (m >= MP) {
            const int b = (m - MP) >> 3, t = (m - MP) & 7, h = lane >> 3, d0 = c8 & 63;
            const float* OP = OPb + (size_t)(b * SBH + h) * NPART * 512; const float* LP = LPb + (size_t)(b * SBH + h) * NPART * 8;
            float v[8];
#pragma unroll
            for (int k = 0; k < 8; ++k) v[k] = 0.f;
            float suf = 0.f;
#pragma unroll
            for (int part = NPART - 1; part >= 0; --part) { const float w = __builtin_amdgcn_exp2f(suf);
                const f32x4 pa = *(const f32x4*)(OP + part * 512 + t * 64 + d0), pb = *(const f32x4*)(OP + part * 512 + t * 64 + d0 + 4);
                v[0] += w * pa.x; v[1] += w * pa.y; v[2] += w * pa.z; v[3] += w * pa.w; v[4] += w * pb.x; v[5] += w * pb.y; v[6] += w * pb.z; v[7] += w * pb.w;
                suf += LP[part * 8 + t]; }
            float ss = 0.f;
#pragma unroll
            for (int k = 0; k < 8; ++k) ss += v[k] * v[k];
            ss += __shfl_xor(ss, 1); ss += __shfl_xor(ss, 2); ss += __shfl_xor(ss, 4);
            const float rs = 1.0f / sqrtf(ss * (1.f / HD) + EPS);
            const f32x4 g0 = *(const f32x4*)(gso + d0), g1 = *(const f32x4*)(gso + d0 + 4);
            *(u32x4*)(MIXED + (size_t)m * D + c8) = pack8((f32x4){v[0], v[1], v[2], v[3]} * rs * g0, (f32x4){v[4], v[5], v[6], v[7]} * rs * g1);
        }
    }
}

__device__ __forceinline__ void convgate_strip(const Args& A, int m0, int R, int cg, int lane) {
    unsigned char* ws = A.ws; const bf16* UP = (const bf16*)(ws + WS_UP); bf16* ACT = (bf16*)(ws + WS_ACT); float* out = A.out;
    const float* wf = (const float*)A.in[I_WFC]; const float* sfc = (const float*)A.in[I_SFC];
    const int c = (cg * 64 + lane) * 8;
    if (c >= DFF) return;
    const bool prompt = m0 < MP; const int b = prompt ? (m0 >> 12) : ((m0 - MP) >> 3), t0 = prompt ? (m0 & 4095) : ((m0 - MP) & 7), T = prompt ? TP : TS;
    f32x4 wu[3][2], wg[3][2];
#pragma unroll
    for (int i = 0; i < 3; ++i) { const float* wp = wf + (size_t)i * DFF2 + c; wu[i][0] = *(const f32x4*)wp; wu[i][1] = *(const f32x4*)(wp + 4); wg[i][0] = *(const f32x4*)(wp + DFF); wg[i][1] = *(const f32x4*)(wp + DFF + 4); }
    f32x4 xu[2][2], xg[2][2];
#pragma unroll
    for (int j = 0; j < 2; ++j) { const int tt = t0 - 2 + j;
        if (tt >= 0) { const bf16* p = UP + (size_t)(m0 - 2 + j) * DFF2 + c; const u32x4 a = *(const u32x4*)p, g = *(const u32x4*)(p + DFF); xu[j][0] = bf4lo(a); xu[j][1] = bf4hi(a); xg[j][0] = bf4lo(g); xg[j][1] = bf4hi(g); }
        else if (!prompt) { const float* p = sfc + ((size_t)b * 2 + (2 + tt)) * DFF2 + c; xu[j][0] = *(const f32x4*)p; xu[j][1] = *(const f32x4*)(p + 4); xg[j][0] = *(const f32x4*)(p + DFF); xg[j][1] = *(const f32x4*)(p + DFF + 4); }
        else { xu[j][0] = (f32x4){0.f, 0.f, 0.f, 0.f}; xu[j][1] = xu[j][0]; xg[j][0] = xu[j][0]; xg[j][1] = xu[j][0]; } }
    const bf16* src = UP + (size_t)m0 * DFF2 + c;
    u32x4 na = *(const u32x4*)src, ng = *(const u32x4*)(src + DFF);
    for (int r = 0; r < R; ++r) {
        const u32x4 ca = na, cgw = ng;
        if (r + 1 < R) { na = *(const u32x4*)(src + (size_t)(r + 1) * DFF2); ng = *(const u32x4*)(src + (size_t)(r + 1) * DFF2 + DFF); }
        const f32x4 u0 = bf4lo(ca), u1 = bf4hi(ca), g0 = bf4lo(cgw), g1 = bf4hi(cgw);
        f32x4 yu0 = wu[0][0] * xu[0][0] + wu[1][0] * xu[1][0] + wu[2][0] * u0, yu1 = wu[0][1] * xu[0][1] + wu[1][1] * xu[1][1] + wu[2][1] * u1;
        f32x4 yg0 = wg[0][0] * xg[0][0] + wg[1][0] * xg[1][0] + wg[2][0] * g0, yg1 = wg[0][1] * xg[0][1] + wg[1][1] * xg[1][1] + wg[2][1] * g1;
        xu[0][0] = xu[1][0]; xu[0][1] = xu[1][1]; xu[1][0] = u0; xu[1][1] = u1; xg[0][0] = xg[1][0]; xg[0][1] = xg[1][1]; xg[1][0] = g0; xg[1][1] = g1;
        yg0.x = siluf(yg0.x); yg0.y = siluf(yg0.y); yg0.z = siluf(yg0.z); yg0.w = siluf(yg0.w); yg1.x = siluf(yg1.x); yg1.y = siluf(yg1.y); yg1.z = siluf(yg1.z); yg1.w = siluf(yg1.w);
        *(u32x4*)(ACT + (size_t)(m0 + r) * DFF + c) = pack8(yg0 * yu0, yg1 * yu1);
        const int oidx = t0 + r - (T - 2);
        if (oidx >= 0) { float* fo = (prompt ? out + O_FCP : out + O_FCS) + ((size_t)b * 2 + oidx) * DFF2 + c; *(f32x4*)fo = u0; *(f32x4*)(fo + 4) = u1; *(f32x4*)(fo + DFF) = g0; *(f32x4*)(fo + DFF + 4) = g1; }
    }
}
__device__ __forceinline__ void phase_convgate(const Args& A, int gw, int NGW, int lane) {
    constexpr int NPI = (MP / 32) * 6, NSI = BS * 6;
    for (int it = gw; it < NPI + NSI; it += NGW) {
        if (it < NPI) convgate_strip(A, (it / 6) * 32, 32, it % 6, lane);
        else { const int j = it - NPI; convgate_strip(A, MP + (j / 6) * 8, 8, j % 6, lane); }
    }
}

__device__ __forceinline__ void phase_slabsum(const Args& A, int gw, int NGW, int lane) {
    unsigned char* ws = A.ws; const float* slab = (const float*)(ws + WS_SLAB); const float* X1 = (const float*)(ws + WS_X1); const float* MOD = (const float*)(ws + WS_MOD);
    for (int r = gw; r < MS; r += NGW) {
        const int m = MP + r; const float* mod = MOD + (size_t)mod_row(m) * NMOD + 5120;
#pragma unroll
        for (int j = 0; j < 4; ++j) { const int c = 4 * (lane + 64 * j); f32x4 a = (f32x4){0.f, 0.f, 0.f, 0.f};
#pragma unroll
            for (int k = 0; k < DFF / 256; ++k) a += *(const f32x4*)(slab + ((size_t)k * MS + r) * D + c);
            *(f32x4*)(A.out + (size_t)m * D + c) = *(const f32x4*)(X1 + (size_t)m * D + c) + *(const f32x4*)(mod + c) * a; }
    }
}

constexpr int NPHASE = 14;
#ifndef PROBE_LEVEL
#define PROBE_LEVEL 0
#endif
#ifndef REP_MASK
#define REP_MASK 0
#endif

__global__ void __launch_bounds__(512, 2) fwd_kernel(Args A) {
    extern __shared__ __attribute__((aligned(16))) unsigned char lds_raw[];
    LAS unsigned char* lds = (LAS unsigned char*)lds_raw;
    const int wave = __builtin_amdgcn_readfirstlane((int)threadIdx.x >> 6);
    const int G = gridDim.x, bx = blockIdx.x;
    const int gw = bx * 8 + wave, NGW = G * 8, NGT = G * 512;
    unsigned char* ws = A.ws;
    gu32* ctl = (gu32*)(ws + WS_CTL);
    volatile LAS unsigned* MISC = (volatile LAS unsigned*)(lds + MISC_OFF);
    { const int t0 = wave * 64 + lane_now(); for (int u = t0; u < (LDS_BYTES - RING_BYTES) / 4; u += 512) ((LAS unsigned*)(lds + RING_BYTES))[u] = 0u; }
    __syncthreads();
    const int lo = A.lo, hi = A.hi;
    const bool multi = (hi - lo) > 1;
    XcdBarrier bar; bar.bar = (unsigned*)(ctl + CW_BAR); bar.x = 0; bar.st = nullptr;
    if (multi) bar = xcd_barrier_post((unsigned*)(ctl + CW_BAR), MISC + 8, wave * 64 + lane_now());
#define IN(k) (lo <= (k) && (k) < hi)
#define GBAR() xcd_barrier(bar, wave * 64 + lane_now())
#define SEAM(k) do { if (IN(k) && IN((k) + 1)) GBAR(); } while (0)
    float* MOD = (float*)(ws + WS_MOD);

#define PH0(rep_) phase_prologue(A, lds, ctl + CW_Q0 + 64 * (rep_), bx, G, wave, lane, gtid, NGT);
#define PH1(rep_) ;
#define PH2(rep_) phase_norm<true>((const float*)A.in[I_XP], (const float*)A.in[I_XS], (const float*)A.in[I_GATT], MOD, 0, 1024, (bf16*)(ws + WS_H), (const float*)(ws + WS_WINX), (float*)(ws + WS_EXTRA), gw, NGW, lane);
#define PH3(rep_) { pg8::Gemm g{(const pg8::bf16_t*)(ws + WS_H), (const pg8::bf16_t*)(ws + WS_WIN_T), M, NPROJ, D, D}; pg8::StaticOrder S; S.init(M, NPROJ, G, bx); \
          EpiProj E{A.out, (bf16*)(ws + WS_QB), (bf16*)(ws + WS_KB), (bf16*)(ws + WS_VB), (bf16*)(ws + WS_DNRAW), (bf16*)(ws + WS_ZG), (const float*)A.in[I_GQ], (const float*)A.in[I_GK], (LAS float*)(lds + RING_BYTES + 1024)}; \
          pg8::gemm_phase<EpiProj, pg8::StaticOrder, true, true>(lds, g, S, E, tid); }
#define PH4(rep_) phase_post(A, gw, NGW, lane, gtid, NGT);
#define PH5(rep_) for (int u = bx; u < 1024; u += G) { if (u < 512) dn_prescan_unit(A, lds, u, tid, wave, lane); else dn_sample_unit(A, lds, u - 512, tid); }
#define PH6(rep_) PH6X(rep_, true, true, true)
#define PH6X(rep_, DS_, DP_, DA_) { if ((DS_) && bx < 16) dn_scan_chain(A, lds, bx, tid, wave, lane); \
          \
        bool moreP = (DP_), moreS = (DA_); const bool pfirst = wave < 4; \
        gu32* qbase_ = ctl + CW_QUEUE + 1024 * (rep_);     \
        const int shard0_ = (int)(xb_xcc_id() & 7u); int offP_ = 0, offS_ = 0;     \
        for (;;) { \
            int job = -1; bool isP = false; \
            if (pfirst && moreP) { const int sh_ = (shard0_ + offP_) & 7; unsigned j_ = 0; if (lane == 0) j_ = __hip_atomic_fetch_add(qbase_ + 64 * sh_, 1u, RLX_AGENT); j_ = __builtin_amdgcn_readfirstlane(j_); if (j_ < 256u) { job = (int)j_ * 8 + sh_; isP = true; } else if (++offP_ == 8) moreP = false; } \
            if (job < 0 && moreS && !(pfirst && moreP)) { const int sh_ = (shard0_ + offS_) & 7; unsigned j_ = 0; if (lane == 0) j_ = __hip_atomic_fetch_add(qbase_ + 512 + 64 * sh_, 1u, RLX_AGENT); j_ = __builtin_amdgcn_readfirstlane(j_); if (j_ < 512u) { job = (int)j_ * 8 + sh_; } else if (++offS_ == 8) moreS = false; } \
            if (job < 0 && !pfirst && !moreS && moreP) { const int sh_ = (shard0_ + offP_) & 7; unsigned j_ = 0; if (lane == 0) j_ = __hip_atomic_fetch_add(qbase_ + 64 * sh_, 1u, RLX_AGENT); j_ = __builtin_amdgcn_readfirstlane(j_); if (j_ < 256u) { job = (int)j_ * 8 + sh_; isP = true; } else if (++offP_ == 8) moreP = false; } \
            if (job < 0) { if (!moreP && !moreS) break; else continue; } \
            if (isP) { const int qb = 63 - (job >> 5), bh = job & 31; attn_prompt_item(A, lds + wave * AW_BYTES, bh >> 3, bh & 7, qb * 64, lane); } \
            else { const int h_ = job & 7, bs_ = job >> 3; attn_sample_job(A, lds + wave * AW_BYTES, bs_ >> 2, h_, bs_ & 3, lane); } \
        } }
#define PH7(rep_) phase_outnorm(A, gw, NGW, lane);
#define PH8(rep_) { { pg8::Gemm g{(const pg8::bf16_t*)(ws + WS_MIXED), (const pg8::bf16_t*)(ws + WS_WOUT_T), MP, D, D, D}; pg8::StaticOrder S; S.init(MP, D, G, bx); \
        EpiResGate E{(const float*)A.in[I_XP], (const float*)A.in[I_XS], MOD, 2048, (float*)(ws + WS_X1)}; \
        pg8::gemm_phase<EpiResGate, pg8::StaticOrder, true, true>(lds, g, S, E, tid); } \
        __syncthreads(); \
        { pg8::Gemm g{(const pg8::bf16_t*)(ws + WS_MIXED), (const pg8::bf16_t*)(ws + WS_WOUT_T), M, D, 256, D}; SplitKOrder S{D / 256, G, bx};     \
        EpiSlab E{(float*)(ws + WS_SLAB)}; \
        pg8::gemm_phase<EpiSlab, SplitKOrder, true, true>(lds, g, S, E, tid); } }
#define PH9(rep_) phase_norm<false, 4>((const float*)(ws + WS_X1), (const float*)A.in[I_XS], (const float*)A.in[I_GFFN], MOD, 3072, 4096, (bf16*)(ws + WS_H), nullptr, nullptr, gw, NGW, lane, (const float*)(ws + WS_SLAB), 2048, (float*)(ws + WS_X1));
#define PH10(rep_) { pg8::Gemm g{(const pg8::bf16_t*)(ws + WS_H), (const pg8::bf16_t*)(ws + WS_WUP_T), M, DFF2, D, D}; pg8::StaticOrder S; S.init(M, DFF2, G, bx); \
        pg8::EpiBf16<0> E{(pg8::bf16_t*)(ws + WS_UP), DFF2, nullptr, 0, 0, 1.f}; \
        pg8::gemm_phase<pg8::EpiBf16<0>, pg8::StaticOrder, true, true>(lds, g, S, E, tid); }
#define PH11(rep_) phase_convgate(A, gw, NGW, lane);
#define PH12(rep_) { { pg8::Gemm g{(const pg8::bf16_t*)(ws + WS_ACT), (const pg8::bf16_t*)(ws + WS_WDN_T), MP, D, DFF, DFF}; pg8::StaticOrder S; S.init(MP, D, G, bx); \
        EpiResGate E{(const float*)(ws + WS_X1), (const float*)(ws + WS_X1) + (size_t)MP * D, MOD, 5120, A.out}; \
        pg8::gemm_phase<EpiResGate, pg8::StaticOrder, true, true>(lds, g, S, E, tid); } \
        __syncthreads(); \
        { pg8::Gemm g{(const pg8::bf16_t*)(ws + WS_ACT), (const pg8::bf16_t*)(ws + WS_WDN_T), M, D, 256, DFF}; SplitKOrder S{DFF / 256, G, bx}; \
        EpiSlab E{(float*)(ws + WS_SLAB)}; \
        pg8::gemm_phase<EpiSlab, SplitKOrder, true, true>(lds, g, S, E, tid); } }
#define PH13(rep_) phase_slabsum(A, gw, NGW, lane);
#define RUNPH(k) do { if (IN(k)) { const int lane = lane_now(), tid = wave * 64 + lane, gtid = bx * 512 + tid; (void)gtid; PH##k(0) if constexpr (((REP_MASK) >> (k)) & 1) { GBAR(); PH##k(1) } } } while (0)
    RUNPH(0); SEAM(0);
    RUNPH(2);
    if constexpr (((REP_MASK) >> 20) & 1) { GBAR(); const int lane = lane_now(); phase_norm<false>((const float*)A.in[I_XP], (const float*)A.in[I_XS], (const float*)A.in[I_GATT], MOD, 0, 1024, (bf16*)(ws + WS_H), nullptr, nullptr, gw, NGW, lane); }
    SEAM(2);
    RUNPH(3); SEAM(3);
    RUNPH(4); SEAM(4);
    RUNPH(5);
    if constexpr (((REP_MASK) >> 17) & 1) { GBAR(); const int lane = lane_now(), tid = wave * 64 + lane; for (int u = bx; u < 512; u += G) dn_prescan_unit<PROBE_LEVEL>(A, lds, u, tid, wave, lane); }
    if constexpr (((REP_MASK) >> 18) & 1) { GBAR(); const int lane = lane_now(), tid = wave * 64 + lane; (void)lane; for (int u = bx; u < 512; u += G) dn_sample_unit(A, lds, u, tid); }
    SEAM(5);
    RUNPH(6);
    if constexpr (((REP_MASK) >> 13) & 1) { GBAR(); const int lane = lane_now(), tid = wave * 64 + lane; PH6X(2, true, false, false) }
    if constexpr (((REP_MASK) >> 14) & 1) { GBAR(); const int lane = lane_now(), tid = wave * 64 + lane; PH6X(3, false, true, false) }
    if constexpr (((REP_MASK) >> 15) & 1) { GBAR(); const int lane = lane_now(), tid = wave * 64 + lane; PH6X(4, false, false, true) }
    SEAM(6);
    RUNPH(7); SEAM(7);
    if constexpr (((REP_MASK) >> 19) & 1) { _Pragma("unroll 1") for (int i_ = 0; i_ < 20; ++i_) GBAR(); }
    RUNPH(8); SEAM(8);
    RUNPH(9); SEAM(9);
    RUNPH(10); SEAM(10);
    RUNPH(11); SEAM(11);
    RUNPH(12); SEAM(12);
    RUNPH(13);
#undef IN
#undef SEAM
}

#ifndef N_LAUNCHES
#define N_LAUNCHES 1
#endif
extern "C" void kernel_launch(void* const* d_in, const int* in_sizes, int n_in, void* d_out, int out_size, void* d_ws, size_t ws_size, hipStream_t stream) {
    static int grid = 0;
    if (grid == 0) {
        if (n_in != 27 || (size_t)out_size != O_END || ws_size < WS_END) { fprintf(stderr, "kernel_launch: unexpected shapes: n_in %d out %d ws %zu\n", n_in, out_size, ws_size); grid = -1; return; }
        int dev = 0, cus = 0, per_cu = 0;
        if (hipGetDevice(&dev) != hipSuccess || hipDeviceGetAttribute(&cus, hipDeviceAttributeMultiprocessorCount, dev) != hipSuccess) { grid = -1; return; }
        if (hipFuncSetAttribute((const void*)fwd_kernel, hipFuncAttributeMaxDynamicSharedMemorySize, LDS_BYTES) != hipSuccess) { fprintf(stderr, "kernel_launch: hipFuncSetAttribute failed\n"); grid = -1; return; }
        if (hipOccupancyMaxActiveBlocksPerMultiprocessor(&per_cu, (const void*)fwd_kernel, 512, LDS_BYTES) != hipSuccess || per_cu < 1) fprintf(stderr, "kernel_launch: occupancy query says %d\n", per_cu);
        (void)hipGetLastError();
        grid = cus;
    }
    if (grid < 0) return;
    (void)hipMemsetAsync((char*)d_ws + WS_CTL, 0, CTL_ZERO_BYTES, stream);
    Args a{};
    for (int i = 0; i < 27; ++i) a.in[i] = d_in[i];
    a.out = (float*)d_out; a.ws = (unsigned char*)d_ws;
    if (N_LAUNCHES == 1) { a.lo = 0; a.hi = NPHASE; hipLaunchKernelGGL(fwd_kernel, dim3(grid), dim3(512), LDS_BYTES, stream, a); }
    else for (int p = 0; p < NPHASE; ++p) { a.lo = p; a.hi = p + 1; hipLaunchKernelGGL(fwd_kernel, dim3(grid), dim3(512), LDS_BYTES, stream, a); }
}
```

```cpp
#include <hip/hip_runtime.h>
#include <cstdio>
#include <cstdint>
#define REP_MASK 0
#define PROBE_LEVEL 0
namespace pg8 {
#define PG8_LAS __attribute__((address_space(3)))
typedef unsigned short bf16_t;
typedef short bf16x8 __attribute__((ext_vector_type(8)));
typedef float f32x4 __attribute__((ext_vector_type(4)));
typedef unsigned u32x4 __attribute__((ext_vector_type(4)));
constexpr int BM = 256, BK = 64, HALF = 128, HTB = HALF * BK * 2  , STAGE_BYTES = 8 * HTB, NXCD = 8, WGM = 8;

__host__ __device__ __forceinline__ int lds_byte(int r, int c) { const int st = (r >> 4) * 2 + (c >> 5), rr = r & 15, cc = c & 31, ob = rr * 64 + cc * 2; return st * 1024 + (ob ^ (((ob >> 9) & 1) << 5)); }
__host__ __device__ __forceinline__ void stage_rc(int b, int& R, int& C) { const int st = b / 1024, sb = b % 1024, swz = sb ^ (((sb >> 9) & 1) << 5); R = (st >> 1) * 16 + swz / 64; C = (st & 1) * 32 + (swz % 64) / 2; }
__host__ __device__ __forceinline__ int perm32(int rho) { const int n = rho >> 4, i = rho & 15; return 8 * (i >> 2) + 4 * n + (i & 3); }

struct Unit { int pm, pn, ko; };
struct Gemm { const bf16_t* A; const bf16_t* Bt; int M, N, K, ld; };

struct StaticOrder {
    int nM, nN, nwg, G, c;
    __host__ __device__ void init(int M, int N, int G_, int c_) { nM = M / BM; nN = N / BM; nwg = nM * nN; G = G_; c = c_; }
    __host__ __device__ bool next(int i, Unit& u) const {
        const long L = (long)i * G + c; if (L >= nwg) return false;
        int wgid = (int)L; { const int q = nwg / NXCD, r = nwg % NXCD, xcd = wgid % NXCD, off = wgid / NXCD; wgid = (xcd < r ? xcd * (q + 1) : r * (q + 1) + (xcd - r) * q) + off; }
        const int nig = WGM * nN, gid = wgid / nig, fm = gid * WGM, gsz = (nM - fm) < WGM ? (nM - fm) : WGM;
        u.pm = fm + ((wgid % nig) % gsz); u.pn = (wgid % nig) / gsz; u.ko = 0; return true;
    }
    __device__ __forceinline__ void a_ready(const Unit&) const {}
    __device__ __forceinline__ void done(const Unit&) const {}
};

__device__ __forceinline__ unsigned cvt_pk_bf16(float lo, float hi) { unsigned r; asm volatile("v_cvt_pk_bf16_f32 %0, %1, %2" : "=v"(r) : "v"(lo), "v"(hi)); return r; }
typedef float f32x2 __attribute__((ext_vector_type(2)));
__device__ __forceinline__ f32x2 gelu_pk(f32x2 v) {
    const f32x2 av = __builtin_elementwise_abs(v), d = av * 0.2316418882f + 1.0f;
    f32x2 t; t.x = __builtin_amdgcn_rcpf(d.x); t.y = __builtin_amdgcn_rcpf(d.y);
    f32x2 q = t * 0.5307027145f + (-0.7265760135f); q = q * t + 0.7107068705f; q = q * t + (-0.142248368f); q = q * t + 0.127414796f; q = q * t;
    const f32x2 s = (v * v) * (-0.72134752044f);
    f32x2 e; e.x = __builtin_amdgcn_exp2f(s.x); e.y = __builtin_amdgcn_exp2f(s.y);
    const f32x2 m = v * (q * e), r = v - m;
    f32x2 o; o.x = v.x < 0.f ? m.x : r.x; o.y = v.y < 0.f ? m.y : r.y; return o;
}

template <int ACT  > struct EpiBf16 {
    static constexpr bool PERM = true, AFTER_DRAIN = false; static_assert(ACT == 0 || ACT == 1, "EpiBf16: ACT is 0 (none) or 1 (gelu_pk)");
    bf16_t* O; int ldc; const float* bias; int split_cols; size_t split_stride; float scale0;
    __device__ __forceinline__ void operator()(const f32x4 (&acc)[2][2][4][2], const Unit& u, int wr, int wc, int fr, int fq) const {
        const int row0 = u.pm * BM + wr * 64 + fr; int colt = u.pn * BM; bf16_t* base = O;
        float sc = 1.f; if (split_cols) { const int t = colt / split_cols; base += (size_t)t * split_stride; colt -= t * split_cols; if (t == 0) sc = scale0; }
        const int col0 = colt + wc * 32 + 8 * fq, bcol0 = u.pn * BM + wc * 32 + 8 * fq;
        f32x4 bv[2][2];
#pragma unroll
        for (int bj = 0; bj < 2; ++bj)
#pragma unroll
            for (int n = 0; n < 2; ++n) bv[bj][n] = bias ? *(const f32x4*)(bias + bcol0 + bj * HALF + 4 * n) : (f32x4){0.f, 0.f, 0.f, 0.f};
#pragma unroll
        for (int ai = 0; ai < 2; ++ai)
#pragma unroll
            for (int m = 0; m < 4; ++m) { bf16_t* rowp = base + (size_t)(row0 + ai * HALF + m * 16) * ldc + col0;
#pragma unroll
                for (int bj = 0; bj < 2; ++bj) { f32x4 v0 = acc[ai][bj][m][0] + bv[bj][0], v1 = acc[ai][bj][m][1] + bv[bj][1];
                    if (ACT == 1) { f32x2 a = gelu_pk((f32x2){v0[0], v0[1]}), b = gelu_pk((f32x2){v0[2], v0[3]}), c = gelu_pk((f32x2){v1[0], v1[1]}), d = gelu_pk((f32x2){v1[2], v1[3]});
                        v0 = (f32x4){a.x, a.y, b.x, b.y}; v1 = (f32x4){c.x, c.y, d.x, d.y}; }
                    v0 = v0 * sc; v1 = v1 * sc; u32x4 w; w.x = cvt_pk_bf16(v0[0], v0[1]); w.y = cvt_pk_bf16(v0[2], v0[3]); w.z = cvt_pk_bf16(v1[0], v1[1]); w.w = cvt_pk_bf16(v1[2], v1[3]);
                    *(u32x4*)(rowp + bj * HALF) = w; } }
    }
};

struct PanelStats {
    unsigned* xbuf;
    unsigned* cnt;
    unsigned* tmo;
    int ntn; float eps;
    unsigned code;
    __device__ __forceinline__ bool run(const f32x4 (&v)[2][2][4][2], const Unit& u, int wr, int wc, int fr, int fq, PG8_LAS unsigned char* lds, int wid, int lane) const {
        typedef float f32x2v __attribute__((ext_vector_type(2)));
        PG8_LAS f32x2v* P = (PG8_LAS f32x2v*)lds;
        PG8_LAS f32x2v* S = (PG8_LAS f32x2v*)(lds + 8192);
        PG8_LAS unsigned* flag = (PG8_LAS unsigned*)(lds + 8192 + 2048);
#pragma unroll
        for (int ai = 0; ai < 2; ++ai)
#pragma unroll
            for (int m = 0; m < 4; ++m) {
                float s = 0.f;
#pragma unroll
                for (int bj = 0; bj < 2; ++bj)
#pragma unroll
                    for (int n = 0; n < 2; ++n) { const f32x4 x = v[ai][bj][m][n]; s += (x[0] + x[1]) + (x[2] + x[3]); }
                s += __shfl_xor(s, 16); s += __shfl_xor(s, 32);
                const float mw = s * (1.0f / 64.0f); float q = 0.f;
#pragma unroll
                for (int bj = 0; bj < 2; ++bj)
#pragma unroll
                    for (int n = 0; n < 2; ++n) { const f32x4 d = v[ai][bj][m][n] - mw; q += (d[0] * d[0] + d[1] * d[1]) + (d[2] * d[2] + d[3] * d[3]); }
                q += __shfl_xor(q, 16); q += __shfl_xor(q, 32);
                if (fq == 0) P[(ai * HALF + wr * 64 + m * 16 + fr) * 4 + wc] = (f32x2v){mw, q};
            }
        asm volatile("s_waitcnt lgkmcnt(0)" ::: "memory"); __builtin_amdgcn_s_barrier(); asm volatile("" ::: "memory");
#if defined(BROKEN_EXCHANGE_NO_WAIT)
#warning BROKEN CONTROL BUILD: the row-statistics exchange does not wait; results are wrong by design
        if (blockIdx.x >= 64) { const long long t0_ = clock64(); while (clock64() - t0_ < 60000) __builtin_amdgcn_s_sleep(8); }
#endif
        const int row = wid * 32 + (lane & 31);
        if (lane < 32) {
            const f32x2v a = P[row * 4 + 0], b = P[row * 4 + 1], c = P[row * 4 + 2], d = P[row * 4 + 3];
            const float mt = (a.x + b.x + c.x + d.x) * 0.25f;
            const float da = a.x - mt, db = b.x - mt, dc = c.x - mt, dd = d.x - mt;
            const float m2 = (a.y + b.y) + (c.y + d.y) + 64.0f * ((da * da + db * db) + (dc * dc + dd * dd));
            unsigned long long* slot = (unsigned long long*)xbuf + ((size_t)(u.pm * BM + row) * 4 + u.pn);
            __hip_atomic_store(slot, ((unsigned long long)__float_as_uint(m2) << 32) | __float_as_uint(mt), __ATOMIC_RELAXED, __HIP_MEMORY_SCOPE_AGENT);
        }
        asm volatile("s_waitcnt vmcnt(0)" ::: "memory");
        if (lane == 0) __hip_atomic_fetch_add(cnt + 64 * u.pm, 1u, __ATOMIC_RELAXED, __HIP_MEMORY_SCOPE_AGENT);
        if (wid == 0) {
            bool dead = false; const unsigned long long t0 = __builtin_amdgcn_s_memrealtime(); const unsigned want = 8u * (unsigned)ntn;
            for (;;) {
#if defined(BROKEN_EXCHANGE_NO_WAIT)
                break;
#endif
                if ((unsigned)__builtin_amdgcn_readfirstlane(__hip_atomic_load(cnt + 64 * u.pm, __ATOMIC_RELAXED, __HIP_MEMORY_SCOPE_AGENT)) >= want) break;
                if (__builtin_amdgcn_s_memrealtime() - t0 > 2000000ull) {
                    if (lane == 0) { unsigned expect = 0u; __hip_atomic_compare_exchange_strong(tmo + 1, &expect, code | (unsigned)(u.pm & 0xff), __ATOMIC_RELAXED, __ATOMIC_RELAXED, __HIP_MEMORY_SCOPE_AGENT);
                                     __hip_atomic_store(tmo, 1u, __ATOMIC_RELAXED, __HIP_MEMORY_SCOPE_AGENT); }
                    dead = true; break; }
                __builtin_amdgcn_s_sleep(2);
            }
            __builtin_amdgcn_fence(__ATOMIC_ACQUIRE, "agent");
            if (lane == 0) flag[0] = dead ? 1u : 0u;
        }
        asm volatile("s_waitcnt vmcnt(0) lgkmcnt(0)" ::: "memory"); __builtin_amdgcn_s_barrier(); asm volatile("" ::: "memory");
        const bool bad = flag[0] != 0u;
        if (lane < 32) {
            const unsigned long long* slot = (const unsigned long long*)xbuf + (size_t)(u.pm * BM + row) * 4; float mt[4], m2[4]; float ms = 0.f;
#pragma unroll
            for (int t = 0; t < 4; ++t) { if (t < ntn) { const unsigned long long w = __hip_atomic_load(slot + t, __ATOMIC_RELAXED, __HIP_MEMORY_SCOPE_AGENT); mt[t] = __uint_as_float((unsigned)w); m2[t] = __uint_as_float((unsigned)(w >> 32)); } else { mt[t] = 0.f; m2[t] = 0.f; } ms += mt[t]; }
            const float mean = ms / (float)ntn; float q = 0.f;
#pragma unroll
            for (int t = 0; t < 4; ++t) if (t < ntn) { const float dm = mt[t] - mean; q += m2[t] + 256.0f * dm * dm; }
            S[row] = (f32x2v){mean, 1.0f / sqrtf(q / (256.0f * (float)ntn) + eps)};
        }
        asm volatile("s_waitcnt lgkmcnt(0)" ::: "memory"); __builtin_amdgcn_s_barrier(); asm volatile("" ::: "memory");
        return bad;
    }
};
struct EpiLnRes {
    static constexpr bool PERM = false, AFTER_DRAIN = true;
    const float* base; float* out; int ldc; const float* bias; PanelStats st; unsigned poison;
    __device__ __forceinline__ void fused(f32x4 (&acc)[2][2][4][2], const Unit& u, int wr, int wc, int fr, int fq, PG8_LAS unsigned char* lds, int wid, int lane) const {
        typedef float f32x2v __attribute__((ext_vector_type(2)));
        const PG8_LAS f32x2v* S = (const PG8_LAS f32x2v*)(lds + 8192);
        const int col0 = u.pn * BM + wc * 32 + 4 * fq;
#pragma unroll
        for (int bj = 0; bj < 2; ++bj)
#pragma unroll
            for (int n = 0; n < 2; ++n) { const f32x4 bv = bias ? *(const f32x4*)(bias + col0 + bj * HALF + n * 16) : (f32x4){0.f, 0.f, 0.f, 0.f};
#pragma unroll
                for (int ai = 0; ai < 2; ++ai)
#pragma unroll
                    for (int m = 0; m < 4; ++m) acc[ai][bj][m][n] += bv; }
        f32x4 pre[4][2][2];
#pragma unroll
        for (int m = 0; m < 4; ++m) { const size_t off = (size_t)(u.pm * BM + wr * 64 + m * 16 + fr) * ldc + col0;
#pragma unroll
            for (int bj = 0; bj < 2; ++bj)
#pragma unroll
                for (int n = 0; n < 2; ++n) pre[m][bj][n] = *(const f32x4*)(base + off + bj * HALF + n * 16); }
        const bool bad = st.run(acc, u, wr, wc, fr, fq, lds, wid, lane) || poison != 0u;
        const float qnan = __builtin_nanf("");
#pragma unroll
        for (int ai = 0; ai < 2; ++ai)
#pragma unroll
            for (int m = 0; m < 4; ++m) { const int r = ai * HALF + wr * 64 + m * 16 + fr; const f32x2v sr = S[r]; const size_t off = (size_t)(u.pm * BM + r) * ldc + col0;
#pragma unroll
                for (int bj = 0; bj < 2; ++bj)
#pragma unroll
                    for (int n = 0; n < 2; ++n) { const f32x4 bs = ai == 0 ? pre[m][bj][n] : *(const f32x4*)(base + off + bj * HALF + n * 16); f32x4 o = bs + (acc[ai][bj][m][n] - sr.x) * sr.y;
                        if (bad) o = (f32x4){qnan, qnan, qnan, qnan}; *(f32x4*)(out + off + bj * HALF + n * 16) = o; }
                if (m & 1) asm volatile("" ::: "memory"); }
    }
};
struct EpiLnResLn {
    static constexpr bool PERM = false, AFTER_DRAIN = true;
    const float* base; float* out; bf16_t* xn; int ldc; const float* bias; PanelStats st1, st2; unsigned poison;
    __device__ __forceinline__ void fused(f32x4 (&acc)[2][2][4][2], const Unit& u, int wr, int wc, int fr, int fq, PG8_LAS unsigned char* lds, int wid, int lane) const {
        typedef float f32x2v __attribute__((ext_vector_type(2))); typedef unsigned u32x2v __attribute__((ext_vector_type(2)));
        const PG8_LAS f32x2v* S = (const PG8_LAS f32x2v*)(lds + 8192);
        const int col0 = u.pn * BM + wc * 32 + 4 * fq;
#pragma unroll
        for (int bj = 0; bj < 2; ++bj)
#pragma unroll
            for (int n = 0; n < 2; ++n) { const f32x4 bv = bias ? *(const f32x4*)(bias + col0 + bj * HALF + n * 16) : (f32x4){0.f, 0.f, 0.f, 0.f};
#pragma unroll
                for (int ai = 0; ai < 2; ++ai)
#pragma unroll
                    for (int m = 0; m < 4; ++m) acc[ai][bj][m][n] += bv; }
        bool bad = st1.run(acc, u, wr, wc, fr, fq, lds, wid, lane) || poison != 0u;
        const float qnan = __builtin_nanf("");
#pragma unroll
        for (int ai = 0; ai < 2; ++ai)
#pragma unroll
            for (int m = 0; m < 4; ++m) { const int r = ai * HALF + wr * 64 + m * 16 + fr; const f32x2v sr = S[r]; const size_t off = (size_t)(u.pm * BM + r) * ldc + col0;
#pragma unroll
                for (int bj = 0; bj < 2; ++bj)
#pragma unroll
                    for (int n = 0; n < 2; ++n) { const f32x4 bs = *(const f32x4*)(base + off + bj * HALF + n * 16); acc[ai][bj][m][n] = bs + (acc[ai][bj][m][n] - sr.x) * sr.y; }
                asm volatile("" : "+v"(acc[ai][0][m][0]), "+v"(acc[ai][0][m][1]), "+v"(acc[ai][1][m][0]), "+v"(acc[ai][1][m][1]));
                if (m & 1) asm volatile("" ::: "memory"); }
        const bool bad1 = bad;
        bad = st2.run(acc, u, wr, wc, fr, fq, lds, wid, lane) || bad;
#pragma unroll
        for (int ai = 0; ai < 2; ++ai)
#pragma unroll
            for (int m = 0; m < 4; ++m) { const int r = ai * HALF + wr * 64 + m * 16 + fr; const f32x2v sr = S[r]; const size_t off = (size_t)(u.pm * BM + r) * ldc + col0;
#pragma unroll
                for (int bj = 0; bj < 2; ++bj)
#pragma unroll
                    for (int n = 0; n < 2; ++n) { const f32x4 x1 = acc[ai][bj][m][n]; *(f32x4*)(out + off + bj * HALF + n * 16) = bad1 ? (f32x4){qnan, qnan, qnan, qnan} : x1;
                        const f32x4 o = (x1 - sr.x) * sr.y; u32x2v w; w.x = cvt_pk_bf16(o[0], o[1]); w.y = cvt_pk_bf16(o[2], o[3]);
                        if (bad) { w.x = 0x7fc07fc0u; w.y = 0x7fc07fc0u; } *(u32x2v*)(xn + off + bj * HALF + n * 16) = w; }
                asm volatile("" ::: "memory"); }
    }
};

template <class Epi, class Sched, bool ALIGN_EPI = false, bool SP2 = false>
__device__ __forceinline__ void gemm_phase(PG8_LAS unsigned char* lds, const Gemm g, const Sched& S, const Epi& E, const int tid) {
    const int wid = __builtin_amdgcn_readfirstlane(tid >> 6), lane = tid & 63, wr = wid >> 2, wc = wid & 3, fr = lane & 15, fq = lane >> 4;
    const int K = g.K, nt = K / BK;
    unsigned voffA[2], voffB[2];
#pragma unroll
    for (int i = 0; i < 2; ++i) { int R, C; stage_rc(tid * 16 + i * 8192, R, C); const int Rb = Epi::PERM ? ((R & ~31) + perm32(R & 31)) : R;
        voffA[i] = (unsigned)(R * g.ld + C) * 2u; voffB[i] = (unsigned)(Rb * g.ld + C) * 2u; }
    const size_t kstep = (size_t)(BK * 2);
    const size_t hstep = (size_t)HALF * g.ld * 2;
    const size_t tstep = 2 * hstep;
    const unsigned ldsw = (unsigned)wid * 1024u;
    const int aoff = lds_byte(wr * 64 + fr, fq * 8), boff = lds_byte(wc * 32 + fr, fq * 8);
#define PG8_SA(b, h) (((b) * 2 + (h)) * HTB)
#define PG8_SB(b, h) ((4 + (b) * 2 + (h)) * HTB)
#define PG8_STAGE(bufoff, gbase, voff) do { _Pragma("unroll") for (int _i = 0; _i < 2; ++_i) \
        __builtin_amdgcn_global_load_lds((const unsigned*)((const char*)(gbase) + (voff)[_i]), (PG8_LAS unsigned*)(lds + (bufoff) + ldsw + _i * 8192), 16, 0, 0); } while (0)
#define PG8_LDA(dst, b, h) do { _Pragma("unroll") for (int m = 0; m < 4; ++m) _Pragma("unroll") for (int k = 0; k < 2; ++k) dst[m][k] = *(const PG8_LAS bf16x8*)(lds + PG8_SA(b, h) + aoff + m * 2048 + k * 1024); } while (0)
#define PG8_LDB(dst, b, h) do { _Pragma("unroll") for (int n = 0; n < 2; ++n) _Pragma("unroll") for (int k = 0; k < 2; ++k) dst[n][k] = *(const PG8_LAS bf16x8*)(lds + PG8_SB(b, h) + boff + n * 2048 + k * 1024); } while (0)
#define PG8_MMA(ai, bj, At, Bt) do { __builtin_amdgcn_s_setprio(1); _Pragma("unroll") for (int m = 0; m < 4; ++m) _Pragma("unroll") for (int n = 0; n < 2; ++n) _Pragma("unroll") for (int k = 0; k < 2; ++k) \
        acc[ai][bj][m][n] = __builtin_amdgcn_mfma_f32_16x16x32_bf16(Bt[n][k], At[m][k], acc[ai][bj][m][n], 0, 0, 0); __builtin_amdgcn_s_setprio(0); } while (0)
#define PG8_WAIT_V(n) asm volatile("s_waitcnt vmcnt(" #n ")" ::: "memory")
#define PG8_WAIT_L(n) asm volatile("s_waitcnt lgkmcnt(" #n ")" ::: "memory")
#define PG8_BAR __builtin_amdgcn_s_barrier()
#define PG8_SCHED __builtin_amdgcn_sched_barrier(0)
    Unit cur, nxt; int ui = 0;
    if (!S.next(0, cur)) return;
    f32x4 acc[2][2][4][2];
#pragma unroll
    for (int a = 0; a < 2; ++a)
#pragma unroll
        for (int b = 0; b < 2; ++b)
#pragma unroll
            for (int m = 0; m < 4; ++m)
#pragma unroll
                for (int n = 0; n < 2; ++n) acc[a][b][m][n] = (f32x4){0.f, 0.f, 0.f, 0.f};
    bf16x8 At[4][2], B0[2][2], B1[2][2];
    const char* cA = (const char*)g.A + (size_t)cur.pm * tstep + (size_t)cur.ko * 2; const char* cB = (const char*)g.Bt + (size_t)cur.pn * tstep + (size_t)cur.ko * 2;
    S.a_ready(cur);
    if constexpr (SP2) {
        PG8_STAGE(PG8_SB(0, 0), cB, voffB); PG8_STAGE(PG8_SB(0, 1), cB + hstep, voffB); PG8_STAGE(PG8_SA(0, 0), cA, voffA); PG8_STAGE(PG8_SA(0, 1), cA + hstep, voffA);
        if (wr == 1) PG8_BAR;
        PG8_WAIT_V(2); PG8_BAR;
        PG8_STAGE(PG8_SB(1, 0), cB + kstep, voffB); PG8_STAGE(PG8_SA(1, 0), cA + kstep, voffA); PG8_STAGE(PG8_SB(1, 1), cB + hstep + kstep, voffB);
        PG8_WAIT_V(6); PG8_BAR;
    } else {
        PG8_STAGE(PG8_SB(0, 0), cB, voffB); PG8_STAGE(PG8_SA(0, 0), cA, voffA); PG8_STAGE(PG8_SB(0, 1), cB + hstep, voffB); PG8_STAGE(PG8_SA(0, 1), cA + hstep, voffA);
        if (wr == 1) PG8_BAR;
        PG8_WAIT_V(4); PG8_BAR;
        PG8_STAGE(PG8_SB(1, 0), cB + kstep, voffB); PG8_STAGE(PG8_SA(1, 0), cA + kstep, voffA); PG8_STAGE(PG8_SB(1, 1), cB + hstep + kstep, voffB);
        PG8_WAIT_V(6); PG8_BAR;
    }
    for (;;) {
        const bool has_next = S.next(ui + 1, nxt);
        const char* nA = has_next ? (const char*)g.A + (size_t)nxt.pm * tstep + (size_t)nxt.ko * 2 : cA; const char* nB = has_next ? (const char*)g.Bt + (size_t)nxt.pn * tstep + (size_t)nxt.ko * 2 : cB;
        for (int t = 0; t < nt; t += 2) {
            const bool last = (t == nt - 2);
            const char* a1 = cA + (size_t)(t + 1) * kstep;
            const char* a2 = last ? nA : cA + (size_t)(t + 2) * kstep; const char* b2 = last ? nB : cB + (size_t)(t + 2) * kstep;
            const char* a3 = a2 + kstep; const char* b3 = b2 + kstep;
            if (last && has_next) S.a_ready(nxt);
            if constexpr (SP2) {
            PG8_LDB(B0, 0, 0); PG8_LDB(B1, 0, 1); PG8_SCHED; PG8_LDA(At, 0, 0); PG8_STAGE(PG8_SA(1, 1), a1 + hstep, voffA);
            PG8_WAIT_V(8); PG8_WAIT_L(0); PG8_BAR; PG8_MMA(0, 0, At, B0); PG8_MMA(0, 1, At, B1); PG8_BAR; PG8_SCHED;
            PG8_LDA(At, 0, 1); PG8_STAGE(PG8_SB(0, 0), b2, voffB); PG8_STAGE(PG8_SB(0, 1), b2 + hstep, voffB); PG8_STAGE(PG8_SA(0, 0), a2, voffA);
            PG8_WAIT_V(8); PG8_WAIT_L(0); PG8_BAR; PG8_MMA(1, 0, At, B0); PG8_MMA(1, 1, At, B1); PG8_BAR; PG8_SCHED;
            PG8_LDB(B0, 1, 0); PG8_LDB(B1, 1, 1); PG8_SCHED; PG8_LDA(At, 1, 0); PG8_STAGE(PG8_SA(0, 1), a2 + hstep, voffA);
            PG8_WAIT_V(8); PG8_WAIT_L(0); PG8_BAR; PG8_MMA(0, 0, At, B0); PG8_MMA(0, 1, At, B1); PG8_BAR; PG8_SCHED;
            PG8_LDA(At, 1, 1); PG8_STAGE(PG8_SB(1, 0), b3, voffB); PG8_STAGE(PG8_SB(1, 1), b3 + hstep, voffB); PG8_STAGE(PG8_SA(1, 0), a3, voffA);
            PG8_WAIT_V(8); PG8_WAIT_L(0); PG8_BAR; PG8_MMA(1, 0, At, B0); PG8_MMA(1, 1, At, B1); PG8_BAR; PG8_SCHED;
            } else {
            PG8_LDB(B0, 0, 0); PG8_SCHED; PG8_LDA(At, 0, 0); PG8_STAGE(PG8_SA(1, 1), a1 + hstep, voffA);
            PG8_WAIT_L(8); PG8_BAR; PG8_WAIT_L(0); PG8_MMA(0, 0, At, B0); PG8_BAR; PG8_SCHED;
            PG8_LDB(B1, 0, 1); PG8_STAGE(PG8_SB(0, 0), b2, voffB);
            PG8_BAR; PG8_WAIT_L(0); PG8_MMA(0, 1, At, B1); PG8_BAR;
            PG8_LDA(At, 0, 1); PG8_STAGE(PG8_SA(0, 0), a2, voffA);
            PG8_BAR; PG8_WAIT_L(0); PG8_MMA(1, 0, At, B0); PG8_BAR; PG8_SCHED;
            PG8_STAGE(PG8_SB(0, 1), b2 + hstep, voffB);
            PG8_WAIT_V(6); PG8_BAR; PG8_MMA(1, 1, At, B1); PG8_BAR;
            PG8_LDB(B0, 1, 0); PG8_SCHED; PG8_LDA(At, 1, 0); PG8_STAGE(PG8_SA(0, 1), a2 + hstep, voffA);
            PG8_WAIT_L(8); PG8_BAR; PG8_WAIT_L(0); PG8_MMA(0, 0, At, B0); PG8_BAR; PG8_SCHED;
            PG8_LDB(B1, 1, 1); PG8_STAGE(PG8_SB(1, 0), b3, voffB);
            PG8_BAR; PG8_WAIT_L(0); PG8_MMA(0, 1, At, B1); PG8_BAR;
            PG8_LDA(At, 1, 1); PG8_STAGE(PG8_SA(1, 0), a3, voffA);
            PG8_BAR; PG8_WAIT_L(0); PG8_MMA(1, 0, At, B0); PG8_BAR; PG8_SCHED;
            PG8_STAGE(PG8_SB(1, 1), b3 + hstep, voffB);
            PG8_WAIT_V(6); PG8_BAR; PG8_MMA(1, 1, At, B1); PG8_BAR;
            }
        }
        if constexpr (ALIGN_EPI) { if (wr == 0) PG8_BAR; }
        if constexpr (!Epi::AFTER_DRAIN) { E(acc, cur, wr, wc, fr, fq); S.done(cur); }
        if (!has_next) break;
#pragma unroll
        for (int a = 0; a < 2; ++a)
#pragma unroll
            for (int b = 0; b < 2; ++b)
#pragma unroll
                for (int m = 0; m < 4; ++m)
#pragma unroll
                    for (int n = 0; n < 2; ++n) acc[a][b][m][n] = (f32x4){0.f, 0.f, 0.f, 0.f};
        cur = nxt; cA = nA; cB = nB; ++ui;
        if constexpr (ALIGN_EPI) { if (wr == 1) PG8_BAR; }
    }
    PG8_WAIT_V(0);
    if constexpr (!ALIGN_EPI) { if (wr == 0) PG8_BAR; }
    PG8_BAR;
    if constexpr (Epi::AFTER_DRAIN) { E.fused(acc, cur, wr, wc, fr, fq, lds, wid, lane); S.done(cur); }
#undef PG8_SA
#undef PG8_SB
#undef PG8_STAGE
#undef PG8_LDA
#undef PG8_LDB
#undef PG8_MMA
#undef PG8_WAIT_V
#undef PG8_WAIT_L
#undef PG8_BAR
#undef PG8_SCHED
}
}

#define GAS __attribute__((address_space(1)))
#define LAS __attribute__((address_space(3)))
typedef unsigned short bf16;
typedef float f32x4 __attribute__((ext_vector_type(4)));
typedef float f32x16 __attribute__((ext_vector_type(16)));
typedef short bf16x8 __attribute__((ext_vector_type(8)));
typedef short s16x4 __attribute__((ext_vector_type(4)));
typedef unsigned u32x4 __attribute__((ext_vector_type(4)));
typedef unsigned u32x2 __attribute__((ext_vector_type(2)));
typedef float f32x2_t __attribute__((ext_vector_type(2)));
typedef __bf16 bf16x2_t __attribute__((ext_vector_type(2)));
typedef GAS unsigned gu32;
#define RLX_AGENT __ATOMIC_RELAXED, __HIP_MEMORY_SCOPE_AGENT

constexpr int D = 1024, BP = 4, TP = 4096, MP = BP * TP, BS = 128, TS = 8, MS = BS * TS, M = MP + MS;
constexpr int SBH = 8, HD = 64, SBW = 512, DNH = 4, DND = 128, DNW = 512;
constexpr int IN_COLS = 3592, NPROJ = 3584;
constexpr int DFF = 2816, DFF2 = 5632, NMOD = 6144, NC = BP + BS;
constexpr int PAST = 2048, NPAGES = 16, PAGE = 128;
constexpr float EPS = 1e-6f, LOG2E = 1.4426950408889634f;
constexpr float QSCALE = 0.125f * LOG2E;
constexpr int NSPLIT = 4, NPART = 5;

constexpr size_t O_YP = 0, O_KP = 17825792, O_VP = 26214400, O_KS = 34603008, O_VS = 35127296, O_SP = 35651584, O_SS = 35913728,
                 O_DCP = 44302336, O_DCS = 44320768, O_FCP = 44910592, O_FCS = 44955648, O_END = 46397440;

constexpr size_t MiB = 1u << 20;
constexpr size_t WS_CTL = 0, CTL_ZERO_BYTES = MiB;
constexpr size_t WS_MOD = 1 * MiB, WS_SC = 5 * MiB, WS_WINX = 6 * MiB, WS_WIN_T = 7 * MiB, WS_WOUT_T = 14 * MiB, WS_WUP_T = 16 * MiB, WS_WDN_T = 27 * MiB,
                 WS_EXTRA = 33 * MiB, WS_H = 34 * MiB, WS_DNRAW = 68 * MiB, WS_ZG = 120 * MiB, WS_QB = 306 * MiB, WS_KB = 323 * MiB, WS_VB = 340 * MiB, WS_QD = 357 * MiB, WS_KD = 391 * MiB,
                 WS_VD = 425 * MiB, WS_BETA = 459 * MiB, WS_LOGA = 460 * MiB, WS_ODN = 461 * MiB, WS_MIXED = 495 * MiB, WS_X1 = 529 * MiB, WS_UP = 597 * MiB,
                 WS_ACT = 784 * MiB, WS_U = 878 * MiB, WS_KCUM = 910 * MiB, WS_QDEC = 926 * MiB, WS_KDECT = 942 * MiB, WS_INTRA = 958 * MiB, WS_GL = 966 * MiB,
                 WS_OPART = 967 * MiB, WS_LPART = 978 * MiB, WS_SLAB = 980 * MiB, WS_END = 1024 * MiB;
constexpr int CW_Q0 = 1024;
constexpr int CW_QUEUE = 64;
constexpr int CW_BAR = 8192;

constexpr int RING_BYTES = 131072, MISC_OFF = RING_BYTES + 320, LDS_BYTES = 147456;

__device__ __forceinline__ unsigned cvtpk(float lo, float hi) { f32x2_t v = {lo, hi}; bf16x2_t b = __builtin_convertvector(v, bf16x2_t); return __builtin_bit_cast(unsigned, b); }
__device__ __forceinline__ bf16 f2bf(float f) { return (bf16)(cvtpk(f, 0.f) & 0xffffu); }
__device__ __forceinline__ float wave_sum(float v) {
#pragma unroll
    for (int o = 1; o < 64; o <<= 1) v += __shfl_xor(v, o);
    return v;
}
__device__ __forceinline__ float siluf(float x) { return x * __builtin_amdgcn_rcpf(1.f + __builtin_amdgcn_exp2f(-1.4426950408889634f * x)); }
__device__ __forceinline__ u32x4 pack8(const f32x4 a, const f32x4 b) { u32x4 w; w.x = cvtpk(a.x, a.y); w.y = cvtpk(a.z, a.w); w.z = cvtpk(b.x, b.y); w.w = cvtpk(b.z, b.w); return w; }
__device__ __forceinline__ float bf2f(unsigned short h) { return __uint_as_float((unsigned)h << 16); }

#define XB_TMO      128
#define XB_XCNT(j)  (256  + 64 * (j))
#define XB_XSUB(j)  (1280 + 64 * (j))
#define XB_XGEN(j)  (2304 + 64 * (j))
#define XB_TOP      3328
#define XB_TOPGEN   3392
#define XCD_BAR_WORDS 3456
#define XB_SPIN_CAP (1u << 18)
__device__ __forceinline__ unsigned xb_ld(unsigned* p)              { return __hip_atomic_load(p, __ATOMIC_RELAXED, __HIP_MEMORY_SCOPE_AGENT); }
__device__ __forceinline__ unsigned xb_add(unsigned* p, unsigned v) { return __hip_atomic_fetch_add(p, v, __ATOMIC_RELAXED, __HIP_MEMORY_SCOPE_AGENT); }
__device__ __forceinline__ unsigned xb_xcc_id() { return (unsigned)__builtin_amdgcn_s_getreg((3 << 11) | 20) & 0xFu; }
#define XB_SPIN(cond, bar) do { unsigned _sp = 0; while (cond) { __builtin_amdgcn_s_sleep(1); \
    if ((++_sp & 255u) == 0u) { if (xb_ld(&(bar)[XB_TMO])) break; if (_sp > XB_SPIN_CAP) { atomicAdd(&(bar)[XB_TMO], 1u); break; } } } } while (0)
struct XcdBarrier { unsigned* bar; unsigned x; volatile LAS unsigned* st; };
__device__ __forceinline__ XcdBarrier xcd_barrier_post(unsigned* bar, volatile LAS unsigned* st, int tid) {
    XcdBarrier b; b.bar = bar; b.x = xb_xcc_id(); b.st = st;
    if (tid == 0) (void)xb_add(&bar[XB_XCNT(b.x)], 1u);
    return b;
}
__device__ __forceinline__ void xcd_barrier_complete(unsigned* bar, unsigned x, unsigned& nloc, unsigned& nx) {
    const unsigned G = gridDim.x * gridDim.y * gridDim.z;
    unsigned sum, cnt, mine, sp = 0u;
    for (;;) {
        sum = 0u; cnt = 0u; mine = 0u;
#pragma unroll
        for (unsigned j = 0; j < 16; ++j) { const unsigned c = xb_ld(&bar[XB_XCNT(j)]); sum += c; cnt += (c > 0u) ? 1u : 0u; mine = (j == x) ? c : mine; }
        if (sum == G) break;
        __builtin_amdgcn_s_sleep(1);
        if ((++sp & 255u) == 0u) { if (xb_ld(&bar[XB_TMO])) break; if (sp > XB_SPIN_CAP) { atomicAdd(&bar[XB_TMO], 1u); break; } }
    }
    nloc = mine > 0u ? mine : 1u; nx = cnt > 0u ? cnt : 1u;
}
__device__ __forceinline__ void xcd_barrier(const XcdBarrier& b, int tid) {
    asm volatile("s_waitcnt vmcnt(0)" ::: "memory");
    __syncthreads();
    if (tid == 0) {
        unsigned* bar = b.bar;
        __builtin_amdgcn_s_waitcnt(0);
        unsigned nloc = b.st[0], nx = b.st[1];
        if (nloc == 0u) { xcd_barrier_complete(bar, b.x, nloc, nx); b.st[0] = nloc; b.st[1] = nx; }
        const unsigned old = xb_add(&bar[XB_XSUB(b.x)], 1u);
        const unsigned gen = old / nloc;
        if (old + 1u == (gen + 1u) * nloc) {
            __builtin_amdgcn_fence(__ATOMIC_RELEASE, "agent");
            asm volatile("s_waitcnt vmcnt(0)" ::: "memory");
            const unsigned og = xb_add(&bar[XB_TOP], 1u);
            const unsigned tg = og / nx;
            if (og + 1u == (tg + 1u) * nx) xb_add(&bar[XB_TOPGEN], 1u);
            else XB_SPIN(xb_ld(&bar[XB_TOPGEN]) == tg, bar);
            __builtin_amdgcn_fence(__ATOMIC_ACQUIRE, "agent");
            xb_add(&bar[XB_XGEN(b.x)], 1u);
            asm volatile("s_waitcnt vmcnt(0)" ::: "memory");
        } else {
            XB_SPIN(xb_ld(&bar[XB_XGEN(b.x)]) == gen, bar);
            __builtin_amdgcn_fence(__ATOMIC_ACQUIRE, "agent");
            asm volatile("s_waitcnt vmcnt(0)" ::: "memory");
        }
    }
    __syncthreads();
}

__device__ __forceinline__ int lane_now() { int l; asm volatile("v_mbcnt_lo_u32_b32 %0, -1, 0\n\tv_mbcnt_hi_u32_b32 %0, -1, %0" : "=v"(l)); return l; }
struct Args { const void* in[27]; float* out; unsigned char* ws; int lo, hi; };
enum { I_XP = 0, I_XS, I_CP, I_CS, I_CK, I_CV, I_PT, I_SD, I_SDC, I_SFC, I_WADA, I_BADA, I_GATT, I_WIN, I_GQ, I_GK, I_SBB, I_GSBO, I_WDNC, I_ALOG, I_DTB, I_GDNO, I_WOUT, I_GFFN, I_WUP, I_WFC, I_WDN };

__device__ __forceinline__ int mod_row(int m) { return m < MP ? (m >> 12) : BP + ((m - MP) >> 3); }

struct EpiF32 {
    static constexpr bool PERM = false, AFTER_DRAIN = false;
    float* O; int ldc;
    __device__ __forceinline__ void operator()(const pg8::f32x4 (&acc)[2][2][4][2], const pg8::Unit& u, int wr, int wc, int fr, int fq) const {
        const int row0 = u.pm * 256 + wr * 64 + fr, col0 = u.pn * 256 + wc * 32 + 4 * fq;
#pragma unroll
        for (int ai = 0; ai < 2; ++ai)
#pragma unroll
            for (int m = 0; m < 4; ++m) { float* rowp = O + (size_t)(row0 + ai * 128 + m * 16) * ldc + col0;
#pragma unroll
                for (int bj = 0; bj < 2; ++bj)
#pragma unroll
                    for (int n = 0; n < 2; ++n) *(pg8::f32x4*)(rowp + bj * 128 + n * 16) = acc[ai][bj][m][n]; }
    }
};
struct EpiResGate {
    static constexpr bool PERM = false, AFTER_DRAIN = false;
    const float* base0; const float* base1; const float* mod; int goff; float* out;
    __device__ __forceinline__ void operator()(const pg8::f32x4 (&acc)[2][2][4][2], const pg8::Unit& u, int wr, int wc, int fr, int fq) const {
        const int row0 = u.pm * 256 + wr * 64 + fr, col0 = u.pn * 256 + wc * 32 + 4 * fq;
#pragma unroll
        for (int ai = 0; ai < 2; ++ai)
#pragma unroll
            for (int m = 0; m < 4; ++m) { const int r = row0 + ai * 128 + m * 16;
                const float* bp = (r < MP ? base0 + (size_t)r * D : base1 + (size_t)(r - MP) * D) + col0;
                const float* gp = mod + (size_t)mod_row(r) * NMOD + goff + col0; float* op = out + (size_t)r * D + col0;
#pragma unroll
                for (int bj = 0; bj < 2; ++bj)
#pragma unroll
                    for (int n = 0; n < 2; ++n) { const pg8::f32x4 b = *(const pg8::f32x4*)(bp + bj * 128 + n * 16), g = *(const pg8::f32x4*)(gp + bj * 128 + n * 16);
                        *(pg8::f32x4*)(op + bj * 128 + n * 16) = b + g * acc[ai][bj][m][n]; } }
    }
};

struct SplitKOrder {
    int nks, G, c;
    __device__ __forceinline__ bool next(int i, pg8::Unit& u) const { const int L = i * G + c; if (L >= 16 * nks) return false; const int su = L & 15, ks = L >> 4; u.pm = MP / 256 + (su >> 2); u.pn = su & 3; u.ko = ks * 256; return true; }
    __device__ __forceinline__ void a_ready(const pg8::Unit&) const {}
    __device__ __forceinline__ void done(const pg8::Unit&) const {}
};
struct EpiSlab {
    static constexpr bool PERM = false, AFTER_DRAIN = false;
    float* slab;
    __device__ __forceinline__ void operator()(const pg8::f32x4 (&acc)[2][2][4][2], const pg8::Unit& u, int wr, int wc, int fr, int fq) const {
        float* O = slab + (size_t)(u.ko >> 8) * ((size_t)MS * D);
        const int row0 = (u.pm - MP / 256) * 256 + wr * 64 + fr, col0 = u.pn * 256 + wc * 32 + 4 * fq;
#pragma unroll
        for (int ai = 0; ai < 2; ++ai)
#pragma unroll
            for (int m = 0; m < 4; ++m) { float* rowp = O + (size_t)(row0 + ai * 128 + m * 16) * D + col0;
#pragma unroll
                for (int bj = 0; bj < 2; ++bj)
#pragma unroll
                    for (int n = 0; n < 2; ++n) *(pg8::f32x4*)(rowp + bj * 128 + n * 16) = acc[ai][bj][m][n]; }
    }
};
__device__ __forceinline__ void st16(void* base, unsigned off, u32x4 v) { *(u32x4*)((unsigned char*)base + off) = v; }
__device__ __forceinline__ void st16f(void* base, unsigned off, pg8::f32x4 v) { *(pg8::f32x4*)((unsigned char*)base + off) = v; }
struct EpiProj {
    static constexpr bool PERM = true, AFTER_DRAIN = false;
    float* out; bf16* QB; bf16* KB; bf16* VB; bf16* DNRAW; bf16* ZG; const float* g_q; const float* g_k; LAS float* xl;
    __device__ __forceinline__ void operator()(const pg8::f32x4 (&acc)[2][2][4][2], const pg8::Unit& u, int wr, int wc, int fr, int fq) const {
        const int pn = u.pn, rl0 = wr * 64 + fr, c0 = wc * 32 + 8 * fq;
        const unsigned row0 = (unsigned)u.pm * 256u + (unsigned)rl0;
        const bool prompt_tile = u.pm < MP / 256;
        if (pn < 4) {
            int xb = (rl0 * 8 + wc) * 4, xb2 = (rl0 * 8 + (wc ^ 1)) * 4; asm volatile("" : "+v"(xb), "+v"(xb2));
            LAS float* xw = (LAS float*)((LAS unsigned char*)xl + xb); const LAS float* xr = (const LAS float*)((LAS unsigned char*)xl + xb2);
#pragma unroll
            for (int ai = 0; ai < 2; ++ai)
#pragma unroll
                for (int m = 0; m < 4; ++m)
#pragma unroll
                    for (int bj = 0; bj < 2; ++bj) { const pg8::f32x4 a = acc[ai][bj][m][0], b = acc[ai][bj][m][1];
                        float ss = (a[0] * a[0] + a[1] * a[1]) + (a[2] * a[2] + a[3] * a[3]) + (b[0] * b[0] + b[1] * b[1]) + (b[2] * b[2] + b[3] * b[3]);
                        ss += __shfl_xor(ss, 16); ss += __shfl_xor(ss, 32);
                        if (fq == 0) xw[(ai * 128 + m * 16) * 8 + bj * 4] = ss; }
            asm volatile("s_waitcnt lgkmcnt(0)" ::: "memory"); __builtin_amdgcn_s_barrier(); asm volatile("" ::: "memory");
            const bool isq = pn < 2; const float* g = isq ? g_q : g_k; const int dloc = 32 * (wc & 1) + 8 * fq;
            const pg8::f32x4 g0 = *(const pg8::f32x4*)(g + dloc), g1 = *(const pg8::f32x4*)(g + dloc + 4);
            bf16* dstb = isq ? QB : KB; float* dstf = prompt_tile ? out + O_KP : out + O_KS - (size_t)MP * SBW;
#pragma unroll
            for (int ai = 0; ai < 2; ++ai)
#pragma unroll
                for (int m = 0; m < 4; ++m) { const unsigned row = row0 + ai * 128 + m * 16;
#pragma unroll
                    for (int bj = 0; bj < 2; ++bj) { const float tot = xw[(ai * 128 + m * 16) * 8 + bj * 4] + xr[(ai * 128 + m * 16) * 8 + bj * 4];
                        const float rs = (isq ? QSCALE : 1.0f) / sqrtf(tot * (1.f / HD) + EPS);
                        const pg8::f32x4 a = acc[ai][bj][m][0] * rs * g0, b = acc[ai][bj][m][1] * rs * g1;
                        const unsigned e = row * SBW + (unsigned)((pn & 1) * 256 + bj * 128 + c0);
                        st16(dstb, e * 2u, pack8(a, b));
                        if (!isq) { st16f(dstf, e * 4u, a); st16f(dstf, e * 4u + 16u, b); } }
                    asm volatile("" ::: "memory"); }
            asm volatile("s_waitcnt lgkmcnt(0)" ::: "memory"); __builtin_amdgcn_s_barrier(); asm volatile("" ::: "memory");
        } else if (pn < 6) {
            float* dstf = prompt_tile ? out + O_VP : out + O_VS - (size_t)MP * SBW;
#pragma unroll
            for (int ai = 0; ai < 2; ++ai)
#pragma unroll
                for (int m = 0; m < 4; ++m) { const unsigned row = row0 + ai * 128 + m * 16;
#pragma unroll
                    for (int bj = 0; bj < 2; ++bj) { const pg8::f32x4 a = acc[ai][bj][m][0], b = acc[ai][bj][m][1]; const unsigned e = row * SBW + (unsigned)((pn & 1) * 256 + bj * 128 + c0);
                        st16(VB, e * 2u, pack8(a, b)); st16f(dstf, e * 4u, a); st16f(dstf, e * 4u + 16u, b); }
                    asm volatile("" ::: "memory"); }
        } else if (pn < 12) {
#pragma unroll
            for (int ai = 0; ai < 2; ++ai)
#pragma unroll
                for (int m = 0; m < 4; ++m) { const unsigned row = row0 + ai * 128 + m * 16;
                    const int b = prompt_tile ? (int)(row >> 12) : (int)((row - MP) >> 3), t = prompt_tile ? (int)(row & 4095) : (int)((row - MP) & 7), idx = prompt_tile ? t - (TP - 3) : t - (TS - 3);
#pragma unroll
                    for (int bj = 0; bj < 2; ++bj) { const pg8::f32x4 a = acc[ai][bj][m][0], b2 = acc[ai][bj][m][1]; const unsigned ch = (unsigned)((pn - 6) * 256 + bj * 128 + c0);
                        st16(DNRAW, (row * 1536u + ch) * 2u, pack8(a, b2));
                        if (idx >= 0) { float* o = prompt_tile ? out + O_DCP : out + O_DCS; const unsigned eo = ((unsigned)(b * 3 + idx) * 1536u + ch) * 4u; st16f(o, eo, a); st16f(o, eo + 16u, b2); } }
                    asm volatile("" ::: "memory"); }
        } else {
#pragma unroll
            for (int ai = 0; ai < 2; ++ai)
#pragma unroll
                for (int m = 0; m < 4; ++m) { const unsigned row = row0 + ai * 128 + m * 16;
#pragma unroll
                    for (int bj = 0; bj < 2; ++bj) { pg8::f32x4 a = acc[ai][bj][m][0], b = acc[ai][bj][m][1]; const unsigned e = row * DNW + (unsigned)((pn - 12) * 256 + bj * 128 + c0);
                        a[0] = siluf(a[0]); a[1] = siluf(a[1]); a[2] = siluf(a[2]); a[3] = siluf(a[3]); b[0] = siluf(b[0]); b[1] = siluf(b[1]); b[2] = siluf(b[2]); b[3] = siluf(b[3]);
                        st16(ZG, e * 2u, pack8(a, b)); }
                    asm volatile("" ::: "memory"); }
        }
    }
};

__device__ __forceinline__ void mod_tile(const Args& A, LAS unsigned char* lds, int ct, int wave, int lane) {
    const float* w_ada = (const float*)A.in[I_WADA]; const float* b_ada = (const float*)A.in[I_BADA];
    const float* cp = (const float*)A.in[I_CP]; const float* cs = (const float*)A.in[I_CS]; float* MOD = (float*)(A.ws + WS_MOD);
    const int lr = lane & 15, q = lane >> 4, col = ct * 16 + lr;
    pg8::f32x4 acc[9];
#pragma unroll
    for (int i = 0; i < 9; ++i) acc[i] = (pg8::f32x4){0.f, 0.f, 0.f, 0.f};
#pragma unroll
    for (int s4 = 0; s4 < 4; ++s4) {
        const int k0 = 128 * wave + 32 * s4 + 8 * q;
        const float* wp = w_ada + (size_t)k0 * NMOD + col;
        float w[8];
#pragma unroll
        for (int j = 0; j < 8; ++j) w[j] = wp[(size_t)j * NMOD];
        u32x4 bw; bw.x = cvtpk(w[0], w[1]); bw.y = cvtpk(w[2], w[3]); bw.z = cvtpk(w[4], w[5]); bw.w = cvtpk(w[6], w[7]);
        const bf16x8 bfr = __builtin_bit_cast(bf16x8, bw);
#pragma unroll
        for (int i = 0; i < 9; ++i) { const int row = 16 * i + lr;
            f32x4 c0 = (f32x4){0.f, 0.f, 0.f, 0.f}, c1 = c0;
            if (row < NC) { const float* crow_ = (row < BP ? cp + (size_t)row * D : cs + (size_t)(row - BP) * D) + k0; c0 = *(const f32x4*)crow_; c1 = *(const f32x4*)(crow_ + 4); }
            c0.x = siluf(c0.x); c0.y = siluf(c0.y); c0.z = siluf(c0.z); c0.w = siluf(c0.w); c1.x = siluf(c1.x); c1.y = siluf(c1.y); c1.z = siluf(c1.z); c1.w = siluf(c1.w);
            acc[i] = __builtin_amdgcn_mfma_f32_16x16x32_bf16(__builtin_bit_cast(bf16x8, pack8(c0, c1)), bfr, acc[i], 0, 0, 0); }
    }
    LAS pg8::f32x4* red = (LAS pg8::f32x4*)lds;
#pragma unroll
    for (int i = 0; i < 9; ++i) red[(wave * 9 + i) * 64 + lane] = acc[i];
    __syncthreads();
    for (int i = wave; i < 9; i += 8) {
        pg8::f32x4 t = red[i * 64 + lane];
#pragma unroll
        for (int w2 = 1; w2 < 8; ++w2) t += red[(w2 * 9 + i) * 64 + lane];
        const float bb = b_ada[col];
#pragma unroll
        for (int r = 0; r < 4; ++r) { const int row = 16 * i + 4 * q + r; if (row < NC) MOD[(size_t)row * NMOD + col] = t[r] + bb; }
    }
    __syncthreads();
}
__device__ __forceinline__ void transpose_item(const float* W, int ldw, int src_col0, bf16* WT, int Kdst, int dst_row0, int k0, LAS float* scr, int lane) {
#pragma unroll
    for (int h2 = 0; h2 < 2; ++h2) { float v[16];
#pragma unroll
        for (int i = 0; i < 16; ++i) v[i] = W[(size_t)(k0 + 2 * (16 * h2 + i) + (lane >> 5)) * ldw + src_col0 + (lane & 31)];
#pragma unroll
        for (int i = 0; i < 16; ++i) scr[(2 * (16 * h2 + i) + (lane >> 5)) * 33 + (lane & 31)] = v[i]; }
    asm volatile("s_waitcnt lgkmcnt(0)" ::: "memory");
    const int c = lane & 7;
#pragma unroll
    for (int j = 0; j < 4; ++j) { const int n = (lane >> 3) + 8 * j; const LAS float* s = scr + (8 * c) * 33 + n;
        u32x4 o; o.x = cvtpk(s[0 * 33], s[1 * 33]); o.y = cvtpk(s[2 * 33], s[3 * 33]); o.z = cvtpk(s[4 * 33], s[5 * 33]); o.w = cvtpk(s[6 * 33], s[7 * 33]);
        *(u32x4*)(WT + (size_t)(dst_row0 + n) * Kdst + k0 + 8 * c) = o; }
    asm volatile("s_waitcnt lgkmcnt(0)" ::: "memory");
}
__device__ __forceinline__ void phase_prologue(const Args& A, LAS unsigned char* lds, gu32* qhead, int bx, int G, int wave, int lane, int gtid, int NGT) {
    unsigned char* ws = A.ws;
    const float* w_in = (const float*)A.in[I_WIN]; const float* w_out = (const float*)A.in[I_WOUT]; const float* w_up = (const float*)A.in[I_WUP]; const float* w_dn = (const float*)A.in[I_WDN];
    float* WX = (float*)(ws + WS_WINX);
    for (int i = gtid; i < 8 * D; i += NGT) { const int j = i >> 10, k = i & 1023; WX[i] = w_in[(size_t)k * IN_COLS + 3072 + j]; }
    for (int ct = bx; ct < NMOD / 16; ct += G) mod_tile(A, lds, ct, wave, lane);
    LAS float* scr = (LAS float*)(lds + wave * 16384);
    constexpr int I_IN = 16 * (NPROJ / 32), I_OUT = 16 * 32, I_UP = 16 * (DFF2 / 32), I_DN = (DFF / 64) * 32, NIT = I_IN + I_OUT + I_UP + I_DN;
    for (int it_ = bx * 8 + wave; it_ < NIT; it_ += G * 8) {
        int r = it_;
        if (r < I_IN) { const int nb = r % (NPROJ / 32), kb = r / (NPROJ / 32); const int n0 = nb * 32; transpose_item(w_in, IN_COLS, n0 < 3072 ? n0 : n0 + 8, (bf16*)(ws + WS_WIN_T), D, n0, kb * 64, scr, lane); continue; } r -= I_IN;
        if (r < I_OUT) { const int nb = r % 32, kb = r / 32; transpose_item(w_out, D, nb * 32, (bf16*)(ws + WS_WOUT_T), D, nb * 32, kb * 64, scr, lane); continue; } r -= I_OUT;
        if (r < I_UP) { const int nb = r % (DFF2 / 32), kb = r / (DFF2 / 32); transpose_item(w_up, DFF2, nb * 32, (bf16*)(ws + WS_WUP_T), D, nb * 32, kb * 64, scr, lane); continue; } r -= I_UP;
        { const int nb = r % 32, kb = r / 32; transpose_item(w_dn, D, nb * 32, (bf16*)(ws + WS_WDN_T), DFF, nb * 32, kb * 64, scr, lane); }
    }
}

template <bool EXTRAS, int NS = 0>
__device__ __forceinline__ void phase_norm(const float* x0, const float* x1, const float* g, const float* MOD, int sh_off, int sc_off, bf16* H, const float* WX, float* EXTRA, int gw, int NGW, int lane, const float* slab = nullptr, int gate_off = 0, float* x1w = nullptr) {
    f32x4 wxr[4][8];
    if (EXTRAS) {
#pragma unroll
        for (int j = 0; j < 4; ++j)
#pragma unroll
            for (int e = 0; e < 8; ++e) wxr[j][e] = *(const f32x4*)(WX + e * D + 4 * (lane + 64 * j));
    }
    f32x4 nv[4];
    if (gw < M) { const float* xr0 = gw < MP ? x0 + (size_t)gw * D : x1 + (size_t)(gw - MP) * D;
#pragma unroll
        for (int j = 0; j < 4; ++j) nv[j] = *(const f32x4*)(xr0 + 4 * (lane + 64 * j)); }
    for (int m = gw; m < M; m += NGW) {
        const float* mod = MOD + (size_t)mod_row(m) * NMOD;
        f32x4 v[4]; float ss = 0.f;
#pragma unroll
        for (int j = 0; j < 4; ++j) v[j] = nv[j];
        { const int mn = m + NGW; if (mn < M) { const float* xrn = mn < MP ? x0 + (size_t)mn * D : x1 + (size_t)(mn - MP) * D;
#pragma unroll
            for (int j = 0; j < 4; ++j) nv[j] = *(const f32x4*)(xrn + 4 * (lane + 64 * j)); } }
#pragma unroll
        for (int j = 0; j < 4; ++j) {
            if (NS > 0 && m >= MP) { f32x4 a = (f32x4){0.f, 0.f, 0.f, 0.f};
#pragma unroll
                for (int k = 0; k < NS; ++k) a += *(const f32x4*)(slab + ((size_t)k * MS + (m - MP)) * D + 4 * (lane + 64 * j));
                v[j] += *(const f32x4*)(mod + gate_off + 4 * (lane + 64 * j)) * a;
                *(f32x4*)(x1w + (size_t)m * D + 4 * (lane + 64 * j)) = v[j]; }
            ss += (v[j].x * v[j].x + v[j].y * v[j].y) + (v[j].z * v[j].z + v[j].w * v[j].w); }
        ss = wave_sum(ss);
        const float rstd = 1.0f / sqrtf(ss * (1.f / D) + EPS);
        float ex[8];
#pragma unroll
        for (int e = 0; e < 8; ++e) ex[e] = 0.f;
#pragma unroll
        for (int j = 0; j < 4; ++j) { const int c = 4 * (lane + 64 * j);
            const f32x4 gg = *(const f32x4*)(g + c), sc = *(const f32x4*)(mod + sc_off + c), sh = *(const f32x4*)(mod + sh_off + c);
            const f32x4 h = (v[j] * rstd) * gg * (sc + 1.0f) + sh;
            u32x2 w; w.x = cvtpk(h.x, h.y); w.y = cvtpk(h.z, h.w); *(u32x2*)(H + (size_t)m * D + c) = w;
            if (EXTRAS) {
#pragma unroll
                for (int e = 0; e < 8; ++e) { const f32x4 wx = wxr[j][e]; ex[e] += (h.x * wx.x + h.y * wx.y) + (h.z * wx.z + h.w * wx.w); }
            }
        }
        if (EXTRAS) {
            float a4[4], a2[2], a1;
#pragma unroll
            for (int j = 0; j < 4; ++j) { const bool up = lane & 1; const float send = up ? ex[j] : ex[j + 4], keep = up ? ex[j + 4] : ex[j]; a4[j] = keep + __shfl_xor(send, 1); }
#pragma unroll
            for (int j = 0; j < 2; ++j) { const bool up = lane & 2; const float send = up ? a4[j] : a4[j + 2], keep = up ? a4[j + 2] : a4[j]; a2[j] = keep + __shfl_xor(send, 2); }
            { const bool up = lane & 4; const float send = up ? a2[0] : a2[1], keep = up ? a2[1] : a2[0]; a1 = keep + __shfl_xor(send, 4); }
            a1 += __shfl_xor(a1, 8); a1 += __shfl_xor(a1, 16); a1 += __shfl_xor(a1, 32);
            if (lane < 8) EXTRA[(size_t)m * 8 + (4 * (lane & 1) + 2 * ((lane >> 1) & 1) + ((lane >> 2) & 1))] = a1;
        }
    }
}

__device__ __forceinline__ f32x4 bf4lo(u32x4 w) { return (f32x4){__uint_as_float(w.x << 16), __uint_as_float(w.x & 0xffff0000u), __uint_as_float(w.y << 16), __uint_as_float(w.y & 0xffff0000u)}; }
__device__ __forceinline__ f32x4 bf4hi(u32x4 w) { return (f32x4){__uint_as_float(w.z << 16), __uint_as_float(w.z & 0xffff0000u), __uint_as_float(w.w << 16), __uint_as_float(w.w & 0xffff0000u)}; }
__device__ __forceinline__ void post_strip(const Args& A, int m0, int R, int part, int lane) {
    unsigned char* ws = A.ws; const bf16* DNRAW = (const bf16*)(ws + WS_DNRAW);
    const float* wc = (const float*)A.in[I_WDNC]; const float* sdc = (const float*)A.in[I_SDC];
    bf16* dstb = (part == 0 ? (bf16*)(ws + WS_QD) : part == 1 ? (bf16*)(ws + WS_KD) : (bf16*)(ws + WS_VD));
    const bool prompt = m0 < MP; const int b = prompt ? (m0 >> 12) : ((m0 - MP) >> 3), t0 = prompt ? (m0 & 4095) : ((m0 - MP) & 7);
    const int ch = part * 512 + 8 * lane;
    f32x4 w[4][2];
#pragma unroll
    for (int i = 0; i < 4; ++i) { w[i][0] = *(const f32x4*)(wc + i * 1536 + ch); w[i][1] = *(const f32x4*)(wc + i * 1536 + ch + 4); }
    f32x4 x[3][2];
#pragma unroll
    for (int j = 0; j < 3; ++j) { const int tt = t0 - 3 + j;
        if (tt >= 0) { const u32x4 r = *(const u32x4*)(DNRAW + (size_t)(m0 - 3 + j) * 1536 + ch); x[j][0] = bf4lo(r); x[j][1] = bf4hi(r); }
        else if (!prompt) { const float* p = sdc + ((size_t)b * 3 + (3 + tt)) * 1536 + ch; x[j][0] = *(const f32x4*)p; x[j][1] = *(const f32x4*)(p + 4); }
        else { x[j][0] = (f32x4){0.f, 0.f, 0.f, 0.f}; x[j][1] = x[j][0]; } }
    const bf16* src = DNRAW + (size_t)m0 * 1536 + ch;
    u32x4 nx = *(const u32x4*)src;
    for (int r = 0; r < R; ++r) {
        const u32x4 cw = nx;
        if (r + 1 < R) nx = *(const u32x4*)(src + (size_t)(r + 1) * 1536);
        const f32x4 c0 = bf4lo(cw), c1 = bf4hi(cw);
        f32x4 y0 = w[0][0] * x[0][0] + w[1][0] * x[1][0] + w[2][0] * x[2][0] + w[3][0] * c0;
        f32x4 y1 = w[0][1] * x[0][1] + w[1][1] * x[1][1] + w[2][1] * x[2][1] + w[3][1] * c1;
        x[0][0] = x[1][0]; x[0][1] = x[1][1]; x[1][0] = x[2][0]; x[1][1] = x[2][1]; x[2][0] = c0; x[2][1] = c1;
        y0.x = siluf(y0.x); y0.y = siluf(y0.y); y0.z = siluf(y0.z); y0.w = siluf(y0.w); y1.x = siluf(y1.x); y1.y = siluf(y1.y); y1.z = siluf(y1.z); y1.w = siluf(y1.w);
        if (part < 2) {
            float ss = (y0.x * y0.x + y0.y * y0.y) + (y0.z * y0.z + y0.w * y0.w) + (y1.x * y1.x + y1.y * y1.y) + (y1.z * y1.z + y1.w * y1.w);
            ss += __shfl_xor(ss, 1); ss += __shfl_xor(ss, 2); ss += __shfl_xor(ss, 4); ss += __shfl_xor(ss, 8);
            const float rs = (part == 0 ? 0.08838834764831845f : 1.0f) / sqrtf(ss + EPS);
            y0 = y0 * rs; y1 = y1 * rs;
        }
        *(u32x4*)(dstb + (size_t)(m0 + r) * DNW + 8 * lane) = pack8(y0, y1);
    }
}
__device__ __forceinline__ void phase_post(const Args& A, int gw, int NGW, int lane, int gtid, int NGT) {
    constexpr int NPI = (MP / 16) * 3, NSI = BS * 3;
    for (int it = gw; it < NPI + NSI; it += NGW) {
        if (it < NPI) post_strip(A, (it / 3) * 16, 16, it % 3, lane);
        else { const int j = it - NPI; post_strip(A, MP + (j / 3) * 8, 8, j % 3, lane); }
    }
    unsigned char* ws = A.ws; const float* a_log = (const float*)A.in[I_ALOG]; const float* dtb = (const float*)A.in[I_DTB];
    float* BETA = (float*)(ws + WS_BETA); float* LOGA = (float*)(ws + WS_LOGA); const float* EXTRA = (const float*)(ws + WS_EXTRA);
    for (int i = gtid; i < M * 8; i += NGT) { const int m = i >> 3, j = i & 7; const float x = EXTRA[i];
        if (j < 4) BETA[m * 4 + j] = 1.f / (1.f + __expf(-x));
        else { const int h = j - 4; const float z = x + dtb[h]; const float sp = fmaxf(z, 0.f) + log1pf(__expf(-fabsf(z))); LOGA[m * 4 + h] = -__expf(a_log[h]) * sp; } }
}

template <int B0, int B1> __device__ __forceinline__ void subst_rows(float (&x)[64], const LAS float* Am) {
#pragma unroll
    for (int ib = B0; ib < B1; ++ib) {
        float r[4];
#pragma unroll
        for (int rr = 0; rr < 4; ++rr) r[rr] = x[4 * ib + rr];
#pragma unroll
        for (int j4 = 0; j4 < ib; ++j4) {
#pragma unroll
            for (int rr = 0; rr < 4; ++rr) { const f32x4 a = *(const LAS f32x4*)(Am + (4 * ib + rr) * 64 + 4 * j4);
                r[rr] -= (a.x * x[4 * j4] + a.y * x[4 * j4 + 1]) + (a.z * x[4 * j4 + 2] + a.w * x[4 * j4 + 3]); }
        }
        const f32x4 d1 = *(const LAS f32x4*)(Am + (4 * ib + 1) * 64 + 4 * ib), d2 = *(const LAS f32x4*)(Am + (4 * ib + 2) * 64 + 4 * ib), d3 = *(const LAS f32x4*)(Am + (4 * ib + 3) * 64 + 4 * ib);
        r[1] -= d1.x * r[0];
        r[2] -= d2.x * r[0] + d2.y * r[1];
        r[3] -= (d3.x * r[0] + d3.y * r[1]) + d3.z * r[2];
#pragma unroll
        for (int rr = 0; rr < 4; ++rr) x[4 * ib + rr] = r[rr];
    }
}
constexpr int PS_INT = 34816, PS_STG = 53248;
template <int LEVEL = 0>
__device__ __forceinline__ void dn_prescan_unit(const Args& A, LAS unsigned char* lds, int unit, int tid, int wave, int lane) {
    unsigned char* ws = A.ws;
    const bf16* QD = (const bf16*)(ws + WS_QD); const bf16* KD = (const bf16*)(ws + WS_KD); const bf16* VD = (const bf16*)(ws + WS_VD);
    const float* BETA = (const float*)(ws + WS_BETA); const float* LOGA = (const float*)(ws + WS_LOGA);
    const int hp = unit & 1, n = (unit >> 1) & 63, b = unit >> 7;
    const int half = tid >> 8, ht = tid & 255, h = 2 * hp + half, item = (b * 64 + n) * 4 + h;
    const int m0 = b * TP + n * 64;
    LAS float* Am = (LAS float*)lds + half * 4096;
    LAS float* gs = (LAS float*)(lds + 32768) + half * 128;
    if (ht < 64) {
        float v = LOGA[(size_t)(m0 + ht) * 4 + h];
#pragma unroll
        for (int o = 1; o < 64; o <<= 1) { const float u = __shfl_up(v, o); if (ht >= o) v += u; }
        gs[ht] = v; gs[64 + ht] = BETA[(size_t)(m0 + ht) * 4 + h];
    }
    __syncthreads();
    {
        const int wl = wave & 3, lr = lane & 15, q = lane >> 4;
        pg8::f32x4 kk[4], qk[4];
#pragma unroll
        for (int j = 0; j < 4; ++j) { kk[j] = (pg8::f32x4){0.f, 0.f, 0.f, 0.f}; qk[j] = kk[j]; }
#pragma unroll
        for (int s = 0; s < 4; ++s) {
            const bf16x8 ak = *(const bf16x8*)(KD + (size_t)(m0 + 16 * wl + lr) * DNW + h * 128 + 32 * s + 8 * q), aq = *(const bf16x8*)(QD + (size_t)(m0 + 16 * wl + lr) * DNW + h * 128 + 32 * s + 8 * q);
#pragma unroll
            for (int j = 0; j < 4; ++j) { const bf16x8 bk = *(const bf16x8*)(KD + (size_t)(m0 + 16 * j + lr) * DNW + h * 128 + 32 * s + 8 * q);
                kk[j] = __builtin_amdgcn_mfma_f32_16x16x32_bf16(ak, bk, kk[j], 0, 0, 0); qk[j] = __builtin_amdgcn_mfma_f32_16x16x32_bf16(aq, bk, qk[j], 0, 0, 0); }
        }
#pragma unroll
        for (int j = 0; j < 4; ++j)
#pragma unroll
            for (int r = 0; r < 4; ++r) { const int i = 16 * wl + 4 * q + r, jj = 16 * j + lr;
                const float dec = (i >= jj) ? __expf(gs[i] - gs[jj]) : 0.f;
                Am[i * 64 + jj] = (i > jj) ? gs[64 + i] * kk[j][r] * dec : 0.f;
                *(LAS bf16*)(lds + PS_INT + half * 9216 + i * 144 + jj * 2) = f2bf(qk[j][r] * dec); }
    }
    __syncthreads();
    if constexpr (LEVEL == 1) { __syncthreads(); return; }
    {
        const int c = ht;
        float* U = (float*)(ws + WS_U) + (size_t)item * 8192; bf16* KC = (bf16*)(ws + WS_KCUM) + (size_t)item * 8192;
        float x[64];
        { const bf16* rsrc = (ht < 128 ? VD : KD) + (size_t)m0 * DNW + h * 128 + (ht & 127);
#pragma unroll
          for (int i = 0; i < 64; ++i) x[i] = bf2f(rsrc[(size_t)i * DNW]); }
#pragma unroll
        for (int i = 0; i < 64; ++i) { const float eg = __expf(gs[i]); x[i] *= gs[64 + i] * (c >= 128 ? eg : 1.0f); }
        { bf16* INTRA = (bf16*)(ws + WS_INTRA) + (size_t)item * 4096;
#pragma unroll
          for (int j = 0; j < 2; ++j) { const int k = ht + 256 * j, row = k >> 3, c8 = (k & 7) * 8; *(u32x4*)(INTRA + row * 64 + c8) = *(const LAS u32x4*)(lds + PS_INT + half * 9216 + row * 144 + c8 * 2); } }
        subst_rows<0, 6>(x, Am); subst_rows<6, 10>(x, Am); subst_rows<10, 13>(x, Am); subst_rows<13, 16>(x, Am);
        if constexpr (LEVEL == 2) { float sk = 0.f; _Pragma("unroll") for (int i = 0; i < 64; ++i) sk += x[i]; asm volatile("" :: "v"(sk)); __syncthreads(); return; }
        LAS float* stg = (LAS float*)(lds + PS_STG + half * 33280);
#pragma unroll
        for (int ps = 0; ps < 2; ++ps) {
            if (ps) __syncthreads();
#pragma unroll
            for (int i = 0; i < 32; ++i) stg[i * 260 + c] = x[32 * ps + i];
            __syncthreads();
#pragma unroll
            for (int j = 0; j < 4; ++j) { const int k = ht + 256 * j, il = k >> 9, w_ = (k >> 6) & 7, ln = k & 63, rb = 16 * il + 4 * (ln >> 4), cc = 16 * w_ + (ln & 15);
                *(f32x4*)(U + (((2 * ps + il) * 8 + w_) * 64 + ln) * 4) = (f32x4){stg[rb * 260 + cc], stg[(rb + 1) * 260 + cc], stg[(rb + 2) * 260 + cc], stg[(rb + 3) * 260 + cc]}; }
#pragma unroll
            for (int j = 0; j < 2; ++j) { const int k = ht + 256 * j, row = k >> 4, c8 = (k & 15) * 8; const LAS float* sp = stg + row * 260 + 128 + c8;
                *(u32x4*)(KC + (32 * ps + row) * 128 + c8) = pack8(*(const LAS f32x4*)sp, *(const LAS f32x4*)(sp + 4)); }
        }
    }
    if constexpr (LEVEL == 3) { __syncthreads(); return; }
    {
        const float glast = gs[63];
        bf16* QDc = (bf16*)(ws + WS_QDEC) + (size_t)item * 8192; bf16* KT = (bf16*)(ws + WS_KDECT) + (size_t)item * 8192;
#pragma unroll
        for (int j = 0; j < 4; ++j) { const int k = ht + 256 * j, row = k >> 4, c8 = (k & 15) * 8; const u32x4 qw = *(const u32x4*)(QD + (size_t)(m0 + row) * DNW + h * 128 + c8); const float eg = __expf(gs[row]);
            *(u32x4*)(QDc + row * 128 + c8) = pack8(bf4lo(qw) * eg, bf4hi(qw) * eg); }
        { const int d = ht & 127, ig = ht >> 7;
#pragma unroll
            for (int i8 = 0; i8 < 4; ++i8) { float v[8];
#pragma unroll
                for (int k = 0; k < 8; ++k) { const int i = 32 * ig + 8 * i8 + k; v[k] = bf2f(KD[(size_t)(m0 + i) * DNW + h * 128 + d]) * __expf(glast - gs[i]); }
                u32x4 w; w.x = cvtpk(v[0], v[1]); w.y = cvtpk(v[2], v[3]); w.z = cvtpk(v[4], v[5]); w.w = cvtpk(v[6], v[7]);
                *(u32x4*)(KT + d * 64 + 32 * ig + 8 * i8) = w; } }
        if (ht == 0) ((float*)(ws + WS_GL))[item] = __expf(glast);
    }
    __syncthreads();
}
__device__ __forceinline__ void dn_sample_unit(const Args& A, LAS unsigned char* lds, int unit, int tid) {
    unsigned char* ws = A.ws;
    const bf16* QD = (const bf16*)(ws + WS_QD);
    const float* BETA = (const float*)(ws + WS_BETA); const float* LOGA = (const float*)(ws + WS_LOGA); float* ODN = (float*)(ws + WS_ODN);
    const int h = unit & 3, b = unit >> 2, e = tid & 127, dq = tid >> 7;
    const float* s0 = (const float*)A.in[I_SD] + ((size_t)(b * 4 + h) * 128 + 32 * dq) * 128 + e;
    float S[32];
#pragma unroll
    for (int d = 0; d < 32; ++d) S[d] = s0[(size_t)d * 128];
    LAS float* red = (LAS float*)lds; LAS float* red2 = red + 512; LAS float* tk = red + 1024;
#pragma unroll
    for (int j = 0; j < 6; ++j) { const int i = tid + 512 * j, t = i / 384, c = i % 384, part = c >> 7; const int m = MP + b * TS + t;
        const unsigned sel = part == 0 ? 1u : part == 1 ? 0u : 2u;
        tk[i] = bf2f(QD[sel * (unsigned)((WS_KD - WS_QD) / 2) + (unsigned)m * DNW + h * 128 + (c & 127)]); }
    if (tid < 16) { const size_t m = (size_t)(MP + b * TS + (tid >> 1)); tk[3072 + tid] = (tid & 1) ? BETA[m * 4 + h] : __expf(LOGA[m * 4 + h]); }
    __syncthreads();
    for (int t = 0; t < TS; ++t) {
        const int m = MP + b * TS + t;
        const float a = tk[3072 + 2 * t], bt = tk[3072 + 2 * t + 1];
        const LAS float* kp = tk + t * 384 + 32 * dq; const LAS float* qp = kp + 128;
        float kd[32], qd[32];
#pragma unroll
        for (int d4 = 0; d4 < 8; ++d4) { const f32x4 kv = *(const LAS f32x4*)(kp + 4 * d4), qv = *(const LAS f32x4*)(qp + 4 * d4);
            kd[4 * d4] = kv.x; kd[4 * d4 + 1] = kv.y; kd[4 * d4 + 2] = kv.z; kd[4 * d4 + 3] = kv.w; qd[4 * d4] = qv.x; qd[4 * d4 + 1] = qv.y; qd[4 * d4 + 2] = qv.z; qd[4 * d4 + 3] = qv.w; }
        float p0 = 0.f, p1 = 0.f;
#pragma unroll
        for (int d = 0; d < 32; d += 2) { p0 += kd[d] * S[d]; p1 += kd[d + 1] * S[d + 1]; }
        red[dq * 128 + e] = p0 + p1;
        __syncthreads();
        const float kS = (red[e] + red[128 + e]) + (red[256 + e] + red[384 + e]);
        const float dl = bt * (tk[t * 384 + 256 + e] - a * kS);
        float po0 = 0.f, po1 = 0.f;
#pragma unroll
        for (int d = 0; d < 32; d += 2) { S[d] = a * S[d] + kd[d] * dl; po0 += qd[d] * S[d]; S[d + 1] = a * S[d + 1] + kd[d + 1] * dl; po1 += qd[d + 1] * S[d + 1]; }
        red2[dq * 128 + e] = po0 + po1;
        __syncthreads();
        if (dq == 0) ODN[(size_t)m * DNW + h * 128 + e] = (red2[e] + red2[128 + e]) + (red2[256 + e] + red2[384 + e]);
    }
    float* so = A.out + O_SS + ((size_t)(b * 4 + h) * 128 + 32 * dq) * 128 + e;
#pragma unroll
    for (int d = 0; d < 32; ++d) so[(size_t)d * 128] = S[d];
    __syncthreads();
}

constexpr int SC_KC = 0, SC_QD = 17408, SC_KT = 34816, SC_IN = 53248, SC_BUF = 62464;
__device__ __forceinline__ void dn_scan_chain(const Args& A, LAS unsigned char* lds, int chain, int tid, int wave, int lane) {
    unsigned char* ws = A.ws;
    const float* Ub = (const float*)(ws + WS_U); const float* GL = (const float*)(ws + WS_GL); float* ODN = (float*)(ws + WS_ODN);
    const int b = chain >> 2, h = chain & 3, lr = lane & 15, q = lane >> 4, e = 16 * wave + lr;
    int ldst[7];
    { const int c0 = tid, c1 = tid + 512;
      ldst[0] = SC_KC + (c0 >> 4) * 272; ldst[1] = SC_KC + (c1 >> 4) * 272; ldst[2] = SC_QD + (c0 >> 4) * 272; ldst[3] = SC_QD + (c1 >> 4) * 272;
      ldst[4] = SC_KT + (c0 >> 3) * 144; ldst[5] = SC_KT + (c1 >> 3) * 144; ldst[6] = SC_IN + (c0 >> 3) * 144; }
    const int cb_ = tid & 3, hA_ = (8 * ((2 * cb_) & 3) + 4 * (cb_ >> 1)) * 2, hB_ = (8 * ((2 * cb_ + 1) & 3) + 4 * (cb_ >> 1)) * 2;
    const int o16A = ((tid & 15) >> 2) * 64 + hA_, o16B = ((tid & 15) >> 2) * 64 + hB_, o8A = ((tid & 7) >> 2) * 64 + hA_, o8B = ((tid & 7) >> 2) * 64 + hB_;
    const size_t item0 = (size_t)(b * 64) * 4 + h;
    const unsigned char* gKC = ws + WS_KCUM + item0 * 16384; const unsigned char* gQD = ws + WS_QDEC + item0 * 16384; const unsigned char* gKT = ws + WS_KDECT + item0 * 16384; const unsigned char* gIN = ws + WS_INTRA + item0 * 8192;
    const unsigned t16 = (unsigned)tid * 16u, ulane = (unsigned)(wave * 64 + lane) * 4u;
    u32x4 R[7]; float un[16], uc[16];
#define SC_GLOAD(n_) do { const size_t o16_ = (size_t)(n_) * 4 * 16384, o8_ = (size_t)(n_) * 4 * 8192; \
        R[0] = *(const u32x4*)(gKC + o16_ + t16); R[1] = *(const u32x4*)(gKC + o16_ + 8192 + t16); R[2] = *(const u32x4*)(gQD + o16_ + t16); R[3] = *(const u32x4*)(gQD + o16_ + 8192 + t16); \
        R[4] = *(const u32x4*)(gKT + o16_ + t16); R[5] = *(const u32x4*)(gKT + o16_ + 8192 + t16); R[6] = *(const u32x4*)(gIN + o8_ + t16); \
        const float* U_ = Ub + (item0 + 4 * (size_t)(n_)) * 8192; \
        _Pragma("unroll") for (int i_ = 0; i_ < 4; ++i_) { const f32x4 u_ = *(const f32x4*)(U_ + (ulane + (unsigned)(i_ * 2048))); un[4 * i_] = u_.x; un[4 * i_ + 1] = u_.y; un[4 * i_ + 2] = u_.z; un[4 * i_ + 3] = u_.w; } } while (0)
#define SC_LWRITE(buf_) do { _Pragma("unroll") for (int k_ = 0; k_ < 7; ++k_) { LAS unsigned char* d_ = lds + (buf_) * SC_BUF + ldst[k_]; \
        *(LAS u32x2*)(d_ + (k_ < 4 ? o16A : o8A)) = (u32x2){R[k_].x, R[k_].y}; *(LAS u32x2*)(d_ + (k_ < 4 ? o16B : o8B)) = (u32x2){R[k_].z, R[k_].w}; } } while (0)
#define SC_BARRIER() do { asm volatile("s_waitcnt lgkmcnt(0)" ::: "memory"); __builtin_amdgcn_s_barrier(); asm volatile("" ::: "memory"); } while (0)
#define SC_FRAG(off_, pitch_, row_, s_) (*(const LAS bf16x8*)(B + (off_) + (row_) * (pitch_) + (32 * (s_) + 8 * q) * 2))
    pg8::f32x4 S[8];
#pragma unroll
    for (int i = 0; i < 8; ++i) S[i] = (pg8::f32x4){0.f, 0.f, 0.f, 0.f};
    const float glv = GL[item0 + 4 * (size_t)lane];
    __syncthreads();
    SC_GLOAD(0); SC_LWRITE(0);
#pragma unroll
    for (int k = 0; k < 16; ++k) uc[k] = un[k];
    __syncthreads();
    for (int n = 0; n < 64; ++n) {
        const float gl = __uint_as_float(__builtin_amdgcn_readlane(__float_as_uint(glv), n));
        if (n + 1 < 64) SC_GLOAD(n + 1);
        const LAS unsigned char* B = lds + (n & 1) * SC_BUF;
        bf16x8 Sb[4];
#pragma unroll
        for (int s = 0; s < 4; ++s) { u32x4 w; w.x = cvtpk(S[2 * s][0], S[2 * s][1]); w.y = cvtpk(S[2 * s][2], S[2 * s][3]); w.z = cvtpk(S[2 * s + 1][0], S[2 * s + 1][1]); w.w = cvtpk(S[2 * s + 1][2], S[2 * s + 1][3]); Sb[s] = __builtin_bit_cast(bf16x8, w); }
        pg8::f32x4 vn[4], o[4];
#pragma unroll
        for (int ih = 0; ih < 2; ++ih) {
            bf16x8 fk[2][4], fq[2][4];
#pragma unroll
            for (int ii = 0; ii < 2; ++ii)
#pragma unroll
                for (int s = 0; s < 4; ++s) { fk[ii][s] = SC_FRAG(SC_KC, 272, 16 * (2 * ih + ii) + lr, s); fq[ii][s] = SC_FRAG(SC_QD, 272, 16 * (2 * ih + ii) + lr, s); }
#pragma unroll
            for (int ii = 0; ii < 2; ++ii) { const int i = 2 * ih + ii;
                pg8::f32x4 ak = (pg8::f32x4){0.f, 0.f, 0.f, 0.f}, aq = ak;
#pragma unroll
                for (int s = 0; s < 4; ++s) { ak = __builtin_amdgcn_mfma_f32_16x16x32_bf16(fk[ii][s], Sb[s], ak, 0, 0, 0); aq = __builtin_amdgcn_mfma_f32_16x16x32_bf16(fq[ii][s], Sb[s], aq, 0, 0, 0); }
#pragma unroll
                for (int r = 0; r < 4; ++r) vn[i][r] = uc[4 * i + r] - ak[r];
                o[i] = aq; }
        }
        bf16x8 Vb[2];
#pragma unroll
        for (int s = 0; s < 2; ++s) { u32x4 w; w.x = cvtpk(vn[2 * s][0], vn[2 * s][1]); w.y = cvtpk(vn[2 * s][2], vn[2 * s][3]); w.z = cvtpk(vn[2 * s + 1][0], vn[2 * s + 1][1]); w.w = cvtpk(vn[2 * s + 1][2], vn[2 * s + 1][3]); Vb[s] = __builtin_bit_cast(bf16x8, w); }
        {
            bf16x8 fi[4][2], ft[8][2];
#pragma unroll
            for (int i = 0; i < 4; ++i)
#pragma unroll
                for (int s = 0; s < 2; ++s) fi[i][s] = SC_FRAG(SC_IN, 144, 16 * i + lr, s);
#pragma unroll
            for (int i = 0; i < 8; ++i)
#pragma unroll
                for (int s = 0; s < 2; ++s) ft[i][s] = SC_FRAG(SC_KT, 144, 16 * i + lr, s);
#pragma unroll
            for (int i = 0; i < 4; ++i) {
#pragma unroll
                for (int s = 0; s < 2; ++s) o[i] = __builtin_amdgcn_mfma_f32_16x16x32_bf16(fi[i][s], Vb[s], o[i], 0, 0, 0);
                *(f32x4*)(ODN + ((item0 + 4 * (size_t)n) * 8192) + (ulane + (unsigned)(i * 2048))) = (f32x4){o[i][0], o[i][1], o[i][2], o[i][3]};
            }
#pragma unroll
            for (int i = 0; i < 8; ++i) {
                pg8::f32x4 acc = S[i] * gl;
#pragma unroll
                for (int s = 0; s < 2; ++s) acc = __builtin_amdgcn_mfma_f32_16x16x32_bf16(ft[i][s], Vb[s], acc, 0, 0, 0);
                S[i] = acc;
            }
        }
        if (n + 1 < 64) {
            SC_LWRITE((n + 1) & 1);
#pragma unroll
            for (int k = 0; k < 16; ++k) uc[k] = un[k];
        }
        SC_BARRIER();
    }
#undef SC_GLOAD
#undef SC_LWRITE
#undef SC_FRAG
    float* so = A.out + O_SP + (size_t)(b * 4 + h) * 16384;
#pragma unroll
    for (int i = 0; i < 8; ++i)
#pragma unroll
        for (int r = 0; r < 4; ++r) so[(unsigned)((16 * i + 4 * q + r) * 128 + e)] = S[i][r];
}

__device__ __forceinline__ int crow(int r, int hi) { return (r & 3) + 8 * (r >> 2) + 4 * hi; }
__device__ __forceinline__ void sb_core(f32x16& p, float& carry, int hi) {
    float s[16];
#pragma unroll
    for (int r = 0; r < 16; ++r) { const float e = __builtin_amdgcn_exp2f(p[r]); s[r] = -__builtin_amdgcn_logf(1.0f + e); }
    float tt[4], uu[4];
#pragma unroll
    for (int i = 0; i < 4; ++i) { s[4 * i + 2] += s[4 * i + 3]; s[4 * i + 1] += s[4 * i + 2]; s[4 * i] += s[4 * i + 1]; tt[i] = s[4 * i]; }
#pragma unroll
    for (int i = 0; i < 4; ++i) uu[i] = __shfl_xor(tt[i], 32);
    const float w3 = tt[3] + uu[3], w2 = tt[2] + uu[2], w1 = tt[1] + uu[1], w0 = tt[0] + uu[0];
    float off[4];
    off[3] = carry; off[2] = carry + w3; off[1] = off[2] + w2; off[0] = off[1] + w1;
    carry = off[0] + w0;
    if (hi == 0) {
#pragma unroll
        for (int i = 0; i < 4; ++i) off[i] += uu[i];
    }
#pragma unroll
    for (int r = 0; r < 16; ++r) p[r] = __builtin_amdgcn_exp2f(p[r] + s[r] + off[r >> 2]);
}
__device__ __forceinline__ bf16x8 pack_p(const f32x16& p, int s) {
    u32x4 w; w.x = cvtpk(p[8 * s], p[8 * s + 1]); w.y = cvtpk(p[8 * s + 2], p[8 * s + 3]); w.z = cvtpk(p[8 * s + 4], p[8 * s + 5]); w.w = cvtpk(p[8 * s + 6], p[8 * s + 7]); return __builtin_bit_cast(bf16x8, w);
}
constexpr int AW_BYTES = 16384, AW_V = 0, VPI = 192, AW_K = 6144, KPI = 144, AW_Q = 6144, AW_SQ = 10752;
__device__ __forceinline__ void read_vfrags(bf16x8 (&vf)[4], const LAS unsigned char* wl, int lane) {
    const int hi = lane >> 5;
    const LAS unsigned char* vb = wl + AW_V + (4 * hi + ((lane & 15) >> 2)) * VPI + (((lane >> 4) & 1) * 16 + (lane & 3) * 4) * 2;
#pragma unroll
    for (int dt = 0; dt < 2; ++dt) {
        const s16x4 t0 = __builtin_bit_cast(s16x4, __builtin_amdgcn_ds_read_tr16_b64_v4i16((LAS s16x4*)(vb + dt * 64)));
        const s16x4 t1 = __builtin_bit_cast(s16x4, __builtin_amdgcn_ds_read_tr16_b64_v4i16((LAS s16x4*)(vb + dt * 64 + 8 * VPI)));
        const s16x4 t2 = __builtin_bit_cast(s16x4, __builtin_amdgcn_ds_read_tr16_b64_v4i16((LAS s16x4*)(vb + dt * 64 + 16 * VPI)));
        const s16x4 t3 = __builtin_bit_cast(s16x4, __builtin_amdgcn_ds_read_tr16_b64_v4i16((LAS s16x4*)(vb + dt * 64 + 24 * VPI)));
        vf[2 * dt] = (bf16x8){t0[0], t0[1], t0[2], t0[3], t1[0], t1[1], t1[2], t1[3]}; vf[2 * dt + 1] = (bf16x8){t2[0], t2[1], t2[2], t2[3], t3[0], t3[1], t3[2], t3[3]};
    }
}
__device__ __forceinline__ void load_k_prompt(bf16x8 (&k)[4], const bf16* KB, int b, int h, int kv0, int r32, int hi) {
    const bf16* kp = KB + (size_t)(b * TP + kv0 + r32) * SBW + h * HD + 8 * hi;
#pragma unroll
    for (int d0 = 0; d0 < 4; ++d0) k[d0] = *(const bf16x8*)(kp + 16 * d0);
}
__device__ __forceinline__ void load_v_prompt(u32x4 (&v)[4], const bf16* VB, int b, int h, int kv0, int lane) {
    const bf16* vp = VB + (size_t)(b * TP + kv0 + (lane >> 3)) * SBW + h * HD + (lane & 7) * 8;
#pragma unroll
    for (int i = 0; i < 4; ++i) v[i] = *(const u32x4*)(vp + (size_t)(8 * i) * SBW);
}
__device__ __forceinline__ void write_v_lds(LAS unsigned char* wl, const u32x4 (&v)[4], int lane) {
#pragma unroll
    for (int i = 0; i < 4; ++i) *(LAS u32x4*)(wl + AW_V + (8 * i + (lane >> 3)) * VPI + (lane & 7) * 16) = v[i];
}
template <int MASK>
__device__ __forceinline__ void sb_qk(f32x16& p, const bf16x8 (&kf)[4], const bf16x8 (&qf)[4], float bias2, int kv0, int qpos, int hi) {
#pragma unroll
    for (int r = 0; r < 16; ++r) p[r] = bias2;
#pragma unroll
    for (int d0 = 0; d0 < 4; ++d0) p = __builtin_amdgcn_mfma_f32_32x32x16_bf16(kf[d0], qf[d0], p, 0, 0, 0);
    if (MASK) {
#pragma unroll
        for (int r = 0; r < 16; ++r) if (kv0 + crow(r, hi) >= qpos) p[r] = -INFINITY;
    }
}
__device__ __forceinline__ void sb_pvonly(const f32x16& p, const bf16x8 (&vf)[4], f32x16 (&o)[2]) {
    const bf16x8 p0 = pack_p(p, 0), p1 = pack_p(p, 1);
#pragma unroll
    for (int dt = 0; dt < 2; ++dt) { o[dt] = __builtin_amdgcn_mfma_f32_32x32x16_bf16(vf[2 * dt], p0, o[dt], 0, 0, 0); o[dt] = __builtin_amdgcn_mfma_f32_32x32x16_bf16(vf[2 * dt + 1], p1, o[dt], 0, 0, 0); }
}
__device__ __forceinline__ void sb_pv(f32x16& p, const bf16x8 (&vf)[4], f32x16 (&o)[2], float& carry, int hi) {
    sb_core(p, carry, hi);
    const bf16x8 p0 = pack_p(p, 0), p1 = pack_p(p, 1);
#pragma unroll
    for (int dt = 0; dt < 2; ++dt) { o[dt] = __builtin_amdgcn_mfma_f32_32x32x16_bf16(vf[2 * dt], p0, o[dt], 0, 0, 0); o[dt] = __builtin_amdgcn_mfma_f32_32x32x16_bf16(vf[2 * dt + 1], p1, o[dt], 0, 0, 0); }
}
template <int MASK>
__device__ __forceinline__ void sb_tile(const bf16x8 (&kf)[4], const bf16x8 (&vf)[4], const bf16x8 (&qf)[4], float bias2, f32x16 (&o)[2], float& carry, int kv0, int qpos, int hi) {
    f32x16 p; sb_qk<MASK>(p, kf, qf, bias2, kv0, qpos, hi); sb_pv(p, vf, o, carry, hi);
}
__device__ __forceinline__ void sb_store_prompt(const Args& A, const f32x16 (&o)[2], int b, int h, int qpos, int hi) {
    float ss = 0.f;
#pragma unroll
    for (int dt = 0; dt < 2; ++dt)
#pragma unroll
        for (int r = 0; r < 16; ++r) ss += o[dt][r] * o[dt][r];
    ss += __shfl_xor(ss, 32);
    const float rs = 1.0f / sqrtf(ss * (1.f / HD) + EPS);
    const float* gso = (const float*)A.in[I_GSBO];
    bf16* op = (bf16*)(A.ws + WS_MIXED) + (size_t)(b * TP + qpos) * D + h * HD;
#pragma unroll
    for (int dt = 0; dt < 2; ++dt)
#pragma unroll
        for (int g = 0; g < 4; ++g) { const int d = 32 * dt + 8 * g + 4 * hi; const f32x4 gg = *(const f32x4*)(gso + d);
            u32x2 w; w.x = cvtpk(o[dt][4 * g] * rs * gg.x, o[dt][4 * g + 1] * rs * gg.y); w.y = cvtpk(o[dt][4 * g + 2] * rs * gg.z, o[dt][4 * g + 3] * rs * gg.w); *(u32x2*)(op + d) = w; }
}
__device__ __forceinline__ void attn_prompt_item(const Args& A, LAS unsigned char* wl, int b, int h, int q0, int lane) {
    unsigned char* ws = A.ws;
    const bf16* QB = (const bf16*)(ws + WS_QB); const bf16* KB = (const bf16*)(ws + WS_KB); const bf16* VB = (const bf16*)(ws + WS_VB);
    const int r32 = lane & 31, hi = lane >> 5, qa = q0 + r32, qb = q0 + 32 + r32;
    const float bias2 = ((const float*)A.in[I_SBB])[h] * LOG2E;
#pragma unroll
    for (int d0 = 0; d0 < 4; ++d0) { *(LAS bf16x8*)(wl + AW_Q + (d0 * 64 + lane) * 16) = *(const bf16x8*)(QB + (size_t)(b * TP + qa) * SBW + h * HD + 16 * d0 + 8 * hi);
        *(LAS bf16x8*)(wl + AW_Q + 4096 + (d0 * 64 + lane) * 16) = *(const bf16x8*)(QB + (size_t)(b * TP + qb) * SBW + h * HD + 16 * d0 + 8 * hi); }
#define QFA_LOAD bf16x8 qfa[4]; _Pragma("unroll") for (int d0_ = 0; d0_ < 4; ++d0_) qfa[d0_] = *(const LAS bf16x8*)(wl + AW_Q + (d0_ * 64 + lane) * 16);
#define QFB_LOAD bf16x8 qfb[4]; _Pragma("unroll") for (int d0_ = 0; d0_ < 4; ++d0_) qfb[d0_] = *(const LAS bf16x8*)(wl + AW_Q + 4096 + (d0_ * 64 + lane) * 16);
    f32x16 oa[2], ob[2]; oa[0] = (f32x16){}; oa[1] = (f32x16){}; ob[0] = (f32x16){}; ob[1] = (f32x16){};
    float ca = 0.f, cb = 0.f;
    bf16x8 kc[4], vf[4]; u32x4 vr[4];
    const int top = (q0 >> 5) + 1;
    load_k_prompt(kc, KB, b, h, 32 * top, r32, hi); load_v_prompt(vr, VB, b, h, 32 * top, lane);
    { write_v_lds(wl, vr, lane); load_v_prompt(vr, VB, b, h, 32 * (top - 1), lane);
      f32x16 p; { QFB_LOAD sb_qk<1>(p, kc, qfb, bias2, 32 * top, qb, hi); }
      load_k_prompt(kc, KB, b, h, 32 * (top - 1), r32, hi);
      read_vfrags(vf, wl, lane);
      sb_pv(p, vf, ob, cb, hi); }
    { write_v_lds(wl, vr, lane); if (top >= 2) load_v_prompt(vr, VB, b, h, 32 * (top - 2), lane);
      f32x16 p; { QFA_LOAD sb_qk<1>(p, kc, qfa, bias2, 32 * (top - 1), qa, hi); }
      read_vfrags(vf, wl, lane);
      sb_pv(p, vf, oa, ca, hi);
      { QFB_LOAD sb_qk<0>(p, kc, qfb, bias2, 0, 0, hi); }
      if (top >= 2) load_k_prompt(kc, KB, b, h, 32 * (top - 2), r32, hi);
      sb_pv(p, vf, ob, cb, hi); }
    for (int ht = top - 2; ht >= 0; --ht) {
        write_v_lds(wl, vr, lane);
        f32x16 p, p2; { QFA_LOAD sb_qk<0>(p, kc, qfa, bias2, 0, 0, hi); } { QFB_LOAD sb_qk<0>(p2, kc, qfb, bias2, 0, 0, hi); }
        if (ht > 0) load_k_prompt(kc, KB, b, h, 32 * (ht - 1), r32, hi);
        read_vfrags(vf, wl, lane);
        sb_core(p, ca, hi); sb_pvonly(p, vf, oa);
        __builtin_amdgcn_sched_barrier(0);
        if (ht > 0) load_v_prompt(vr, VB, b, h, 32 * (ht - 1), lane);
        sb_core(p2, cb, hi); sb_pvonly(p2, vf, ob);
    }
    sb_store_prompt(A, oa, b, h, qa, hi); sb_store_prompt(A, ob, b, h, qb, hi);
#undef QFA_LOAD
#undef QFB_LOAD
}

__device__ __forceinline__ void load_raw_sample(f32x4 (&r)[8], const float* c, size_t base, int h, int lane) {
    const float* p = c + base + (size_t)(lane >> 4) * 512 + h * HD + (lane & 15) * 4;
#pragma unroll
    for (int i = 0; i < 8; ++i) r[i] = *(const f32x4*)(p + (size_t)(4 * i) * 512);
}
__device__ __forceinline__ void write_raw_sample(LAS unsigned char* wl, int off, int pitch, const f32x4 (&r)[8], int lane) {
#pragma unroll
    for (int i = 0; i < 8; ++i) { const int row = 4 * i + (lane >> 4); u32x2 w; w.x = cvtpk(r[i].x, r[i].y); w.y = cvtpk(r[i].z, r[i].w); *(LAS u32x2*)(wl + off + row * pitch + (lane & 15) * 8) = w; }
}
__device__ __forceinline__ void read_kfrags(bf16x8 (&kf)[4], const LAS unsigned char* wl, int r32, int hi) {
#pragma unroll
    for (int d0 = 0; d0 < 4; ++d0) kf[d0] = *(const LAS bf16x8*)(wl + AW_K + r32 * KPI + (16 * d0 + 8 * hi) * 2);
}
__device__ __forceinline__ void attn_sample_store(const Args& A, int b, int h, int part, int lane, const f32x16 (&o)[2], float carry) {
    float* OP = (float*)(A.ws + WS_OPART) + (size_t)((b * SBH + h) * NPART + part) * 512; float* LP = (float*)(A.ws + WS_LPART) + (size_t)((b * SBH + h) * NPART + part) * 8;
    const int r32 = lane & 31, hi = lane >> 5;
    unsigned lo = (unsigned)(r32 * 64 + 4 * hi), ll = (unsigned)r32; asm volatile("" : "+v"(lo), "+v"(ll));
    if (r32 < 8) {
#pragma unroll
        for (int dt = 0; dt < 2; ++dt)
#pragma unroll
            for (int g = 0; g < 4; ++g) *(f32x4*)(OP + (lo + (unsigned)(32 * dt + 8 * g))) = (f32x4){o[dt][4 * g], o[dt][4 * g + 1], o[dt][4 * g + 2], o[dt][4 * g + 3]};
        if (hi == 0) LP[ll] = carry;
    }
}
__device__ __forceinline__ void attn_sample_job(const Args& A, LAS unsigned char* wl, int b, int h, int sp, int lane) {
    unsigned char* ws = A.ws;
    const int r32 = lane & 31, hi = lane >> 5;
    const float* ck = (const float*)A.in[I_CK]; const float* cv = (const float*)A.in[I_CV]; const int* pt = (const int*)A.in[I_PT] + b * NPAGES;
    const bf16* QB = (const bf16*)(ws + WS_QB);
    const float bias2 = ((const float*)A.in[I_SBB])[h] * LOG2E;
    bf16x8 qf[4];
#pragma unroll
    for (int d0 = 0; d0 < 4; ++d0) { qf[d0] = (bf16x8){0, 0, 0, 0, 0, 0, 0, 0}; if (r32 < TS) qf[d0] = *(const bf16x8*)(QB + (size_t)(MP + b * TS + r32) * SBW + h * HD + 16 * d0 + 8 * hi); }
    f32x16 o[2]; float carry;
    bf16x8 kf[4], vf[4];
    const int tok_hi = (PAST / NSPLIT) * (sp + 1);
    constexpr int NT = PAST / NSPLIT / 32;
    f32x4 rk[8], rv[8];
#define SAMPLE_BASE(j) (((size_t)pt[(tok_hi - 32 * ((j) + 1)) >> 7] * PAGE + ((tok_hi - 32 * ((j) + 1)) & 127)) * 512)
    if (sp == NSPLIT - 1) {
        const bf16* KBn = (const bf16*)(ws + WS_KB) + (size_t)(MP + b * TS) * SBW + h * HD;
#pragma unroll
        for (int d0 = 0; d0 < 4; ++d0) { kf[d0] = (bf16x8){0, 0, 0, 0, 0, 0, 0, 0}; if (r32 < TS) kf[d0] = *(const bf16x8*)(KBn + (size_t)r32 * SBW + 16 * d0 + 8 * hi); }
        u32x4 vr[4];
        vr[0] = *(const u32x4*)((const bf16*)(ws + WS_VB) + (size_t)(MP + b * TS + (lane >> 3)) * SBW + h * HD + (lane & 7) * 8);
        vr[1] = (u32x4){0u, 0u, 0u, 0u}; vr[2] = vr[1]; vr[3] = vr[1];
        write_v_lds(wl, vr, lane);
        read_vfrags(vf, wl, lane);
        o[0] = (f32x16){}; o[1] = (f32x16){}; carry = 0.f;
        sb_tile<1>(kf, vf, qf, bias2, o, carry, 0, r32, hi);
        attn_sample_store(A, b, h, NPART - 1, lane, o, carry);
    }
    f32x4 rk2[8];
    load_raw_sample(rk, ck, SAMPLE_BASE(0), h, lane); load_raw_sample(rv, cv, SAMPLE_BASE(0), h, lane);
    load_raw_sample(rk2, ck, SAMPLE_BASE(1), h, lane);
#pragma unroll
    for (int d0 = 0; d0 < 4; ++d0) *(LAS bf16x8*)(wl + AW_SQ + (d0 * 64 + lane) * 16) = qf[d0];
    o[0] = (f32x16){}; o[1] = (f32x16){}; carry = 0.f;
#define SAMPLE_TILE(RK, jk_, jv_) do { \
        write_raw_sample(wl, AW_K, KPI, RK, lane); write_raw_sample(wl, AW_V, VPI, rv, lane); \
        if ((jk_) < NT) load_raw_sample(RK, ck, SAMPLE_BASE(jk_), h, lane); \
        read_kfrags(kf, wl, r32, hi); read_vfrags(vf, wl, lane); \
        bf16x8 qq[4]; _Pragma("unroll") for (int d0_ = 0; d0_ < 4; ++d0_) qq[d0_] = *(const LAS bf16x8*)(wl + AW_SQ + (d0_ * 64 + lane) * 16); \
        f32x16 p; sb_qk<0>(p, kf, qq, bias2, 0, 0, hi); \
        sb_core(p, carry, hi); \
        __builtin_amdgcn_sched_barrier(0); \
        if ((jv_) < NT) load_raw_sample(rv, cv, SAMPLE_BASE(jv_), h, lane); \
        sb_pvonly(p, vf, o); } while (0)
    for (int j = 0; j < NT; j += 2) {
        SAMPLE_TILE(rk, j + 2, j + 1);
        SAMPLE_TILE(rk2, j + 3, j + 2);
    }
#undef SAMPLE_TILE
#undef SAMPLE_BASE
    attn_sample_store(A, b, h, sp, lane, o, carry);
}

__device__ __forceinline__ void phase_outnorm(const Args& A, int gw, int NGW, int lane) {
    unsigned char* ws = A.ws; const float* ODN = (const float*)(ws + WS_ODN); bf16* MIXED = (bf16*)(ws + WS_MIXED);
    const float* gdn = (const float*)A.in[I_GDNO]; const float* gso = (const float*)A.in[I_GSBO];
    const float* OPb = (const float*)(ws + WS_OPART); const float* LPb = (const float*)(ws + WS_LPART);
    const int c8 = 8 * lane;
    for (int m = gw; m < M; m += NGW) {
        {
            f32x4 a0, a1;
            if (m >= MP) { const float* op = ODN + (size_t)m * DNW + c8; a0 = *(const f32x4*)op; a1 = *(const f32x4*)(op + 4); }
            else { const int t = m & 4095, cch = t & 63, hh = lane >> 4; const size_t it_ = (size_t)((m >> 12) * 64 + (t >> 6)) * 4 + hh;
                const float* op = ODN + it_ * 8192 + ((((cch >> 4) * 8 + ((lane & 15) >> 1)) * 64 + ((cch >> 2) & 3) * 16 + 8 * (lane & 1)) * 4) + (cch & 3);
                a0 = (f32x4){op[0], op[4], op[8], op[12]}; a1 = (f32x4){op[16], op[20], op[24], op[28]}; }
            float ss = (a0.x * a0.x + a0.y * a0.y) + (a0.z * a0.z + a0.w * a0.w) + (a1.x * a1.x + a1.y * a1.y) + (a1.z * a1.z + a1.w * a1.w);
            ss += __shfl_xor(ss, 1); ss += __shfl_xor(ss, 2); ss += __shfl_xor(ss, 4); ss += __shfl_xor(ss, 8);
            const float rs = 1.0f / sqrtf(ss * (1.f / DND) + EPS);
            const f32x4 g0 = *(const f32x4*)(gdn + (c8 & 127)), g1 = *(const f32x4*)(gdn + (c8 & 127) + 4);
            const u32x4 zw = *(const u32x4*)((const bf16*)(ws + WS_ZG) + (size_t)m * DNW + c8); const f32x4 z0 = bf4lo(zw), z1 = bf4hi(zw);
            *(u32x4*)(MIXED + (size_t)m * D + SBW + c8) = pack8(a0 * rs * g0 * z0, a1 * rs * g1 * z1);
        }
        if (m >= MP) {
            const int b = (m - MP) >> 3, t = (m - MP) & 7, h = lane >> 3, d0 = c8 & 63;
            const float* OP = OPb + (size_t)(b * SBH + h) * NPART * 512; const float* LP = LPb + (size_t)(b * SBH + h) * NPART * 8;
            float v[8];
#pragma unroll
            for (int k = 0; k < 8; ++k) v[k] = 0.f;
            float suf = 0.f;
#pragma unroll
            for (int part = NPART - 1; part >= 0; --part) { const float w = __builtin_amdgcn_exp2f(suf);
                const f32x4 pa = *(const f32x4*)(OP + part * 512 + t * 64 + d0), pb = *(const f32x4*)(OP + part * 512 + t * 64 + d0 + 4);
                v[0] += w * pa.x; v[1] += w * pa.y; v[2] += w * pa.z; v[3] += w * pa.w; v[4] += w * pb.x; v[5] += w * pb.y; v[6] += w * pb.z; v[7] += w * pb.w;
                suf += LP[part * 8 + t]; }
            float ss = 0.f;
#pragma unroll
            for (int k = 0; k < 8; ++k) ss += v[k] * v[k];
            ss += __shfl_xor(ss, 1); ss += __shfl_xor(ss, 2); ss += __shfl_xor(ss, 4);
            const float rs = 1.0f / sqrtf(ss * (1.f / HD) + EPS);
            const f32x4 g0 = *(const f32x4*)(gso + d0), g1 = *(const f32x4*)(gso + d0 + 4);
            *(u32x4*)(MIXED + (size_t)m * D + c8) = pack8((f32x4){v[0], v[1], v[2], v[3]} * rs * g0, (f32x4){v[4], v[5], v[6], v[7]} * rs * g1);
        }
    }
}

__device__ __forceinline__ void convgate_strip(const Args& A, int m0, int R, int cg, int lane) {
    unsigned char* ws = A.ws; const bf16* UP = (const bf16*)(ws + WS_UP); bf16* ACT = (bf16*)(ws + WS_ACT); float* out = A.out;
    const float* wf = (const float*)A.in[I_WFC]; const float* sfc = (const float*)A.in[I_SFC];
    const int c = (cg * 64 + lane) * 8;
    if (c >= DFF) return;
    const bool prompt = m0 < MP; const int b = prompt ? (m0 >> 12) : ((m0 - MP) >> 3), t0 = prompt ? (m0 & 4095) : ((m0 - MP) & 7), T = prompt ? TP : TS;
    f32x4 wu[3][2], wg[3][2];
#pragma unroll
    for (int i = 0; i < 3; ++i) { const float* wp = wf + (size_t)i * DFF2 + c; wu[i][0] = *(const f32x4*)wp; wu[i][1] = *(const f32x4*)(wp + 4); wg[i][0] = *(const f32x4*)(wp + DFF); wg[i][1] = *(const f32x4*)(wp + DFF + 4); }
    f32x4 xu[2][2], xg[2][2];
#pragma unroll
    for (int j = 0; j < 2; ++j) { const int tt = t0 - 2 + j;
        if (tt >= 0) { const bf16* p = UP + (size_t)(m0 - 2 + j) * DFF2 + c; const u32x4 a = *(const u32x4*)p, g = *(const u32x4*)(p + DFF); xu[j][0] = bf4lo(a); xu[j][1] = bf4hi(a); xg[j][0] = bf4lo(g); xg[j][1] = bf4hi(g); }
        else if (!prompt) { const float* p = sfc + ((size_t)b * 2 + (2 + tt)) * DFF2 + c; xu[j][0] = *(const f32x4*)p; xu[j][1] = *(const f32x4*)(p + 4); xg[j][0] = *(const f32x4*)(p + DFF); xg[j][1] = *(const f32x4*)(p + DFF + 4); }
        else { xu[j][0] = (f32x4){0.f, 0.f, 0.f, 0.f}; xu[j][1] = xu[j][0]; xg[j][0] = xu[j][0]; xg[j][1] = xu[j][0]; } }
    const bf16* src = UP + (size_t)m0 * DFF2 + c;
    u32x4 na = *(const u32x4*)src, ng = *(const u32x4*)(src + DFF);
    for (int r = 0; r < R; ++r) {
        const u32x4 ca = na, cgw = ng;
        if (r + 1 < R) { na = *(const u32x4*)(src + (size_t)(r + 1) * DFF2); ng = *(const u32x4*)(src + (size_t)(r + 1) * DFF2 + DFF); }
        const f32x4 u0 = bf4lo(ca), u1 = bf4hi(ca), g0 = bf4lo(cgw), g1 = bf4hi(cgw);
        f32x4 yu0 = wu[0][0] * xu[0][0] + wu[1][0] * xu[1][0] + wu[2][0] * u0, yu1 = wu[0][1] * xu[0][1] + wu[1][1] * xu[1][1] + wu[2][1] * u1;
        f32x4 yg0 = wg[0][0] * xg[0][0] + wg[1][0] * xg[1][0] + wg[2][0] * g0, yg1 = wg[0][1] * xg[0][1] + wg[1][1] * xg[1][1] + wg[2][1] * g1;
        xu[0][0] = xu[1][0]; xu[0][1] = xu[1][1]; xu[1][0] = u0; xu[1][1] = u1; xg[0][0] = xg[1][0]; xg[0][1] = xg[1][1]; xg[1][0] = g0; xg[1][1] = g1;
        yg0.x = siluf(yg0.x); yg0.y = siluf(yg0.y); yg0.z = siluf(yg0.z); yg0.w = siluf(yg0.w); yg1.x = siluf(yg1.x); yg1.y = siluf(yg1.y); yg1.z = siluf(yg1.z); yg1.w = siluf(yg1.w);
        *(u32x4*)(ACT + (size_t)(m0 + r) * DFF + c) = pack8(yg0 * yu0, yg1 * yu1);
        const int oidx = t0 + r - (T - 2);
        if (oidx >= 0) { float* fo = (prompt ? out + O_FCP : out + O_FCS) + ((size_t)b * 2 + oidx) * DFF2 + c; *(f32x4*)fo = u0; *(f32x4*)(fo + 4) = u1; *(f32x4*)(fo + DFF) = g0; *(f32x4*)(fo + DFF + 4) = g1; }
    }
}
__device__ __forceinline__ void phase_convgate(const Args& A, int gw, int NGW, int lane) {
    constexpr int NPI = (MP / 32) * 6, NSI = BS * 6;
    for (int it = gw; it < NPI + NSI; it += NGW) {
        if (it < NPI) convgate_strip(A, (it / 6) * 32, 32, it % 6, lane);
        else { const int j = it - NPI; convgate_strip(A, MP + (j / 6) * 8, 8, j % 6, lane); }
    }
}

__device__ __forceinline__ void phase_slabsum(const Args& A, int gw, int NGW, int lane) {
    unsigned char* ws = A.ws; const float* slab = (const float*)(ws + WS_SLAB); const float* X1 = (const float*)(ws + WS_X1); const float* MOD = (const float*)(ws + WS_MOD);
    for (int r = gw; r < MS; r += NGW) {
        const int m = MP + r; const float* mod = MOD + (size_t)mod_row(m) * NMOD + 5120;
#pragma unroll
        for (int j = 0; j < 4; ++j) { const int c = 4 * (lane + 64 * j); f32x4 a = (f32x4){0.f, 0.f, 0.f, 0.f};
#pragma unroll
            for (int k = 0; k < DFF / 256; ++k) a += *(const f32x4*)(slab + ((size_t)k * MS + r) * D + c);
            *(f32x4*)(A.out + (size_t)m * D + c) = *(const f32x4*)(X1 + (size_t)m * D + c) + *(const f32x4*)(mod + c) * a; }
    }
}

constexpr int NPHASE = 14;
#ifndef PROBE_LEVEL
#define PROBE_LEVEL 0
#endif
#ifndef REP_MASK
#define REP_MASK 0
#endif

__global__ void __launch_bounds__(512, 2) fwd_kernel(Args A) {
    extern __shared__ __attribute__((aligned(16))) unsigned char lds_raw[];
    LAS unsigned char* lds = (LAS unsigned char*)lds_raw;
    const int wave = __builtin_amdgcn_readfirstlane((int)threadIdx.x >> 6);
    const int G = gridDim.x, bx = blockIdx.x;
    const int gw = bx * 8 + wave, NGW = G * 8, NGT = G * 512;
    unsigned char* ws = A.ws;
    gu32* ctl = (gu32*)(ws + WS_CTL);
    volatile LAS unsigned* MISC = (volatile LAS unsigned*)(lds + MISC_OFF);
    { const int t0 = wave * 64 + lane_now(); for (int u = t0; u < (LDS_BYTES - RING_BYTES) / 4; u += 512) ((LAS unsigned*)(lds + RING_BYTES))[u] = 0u; }
    __syncthreads();
    const int lo = A.lo, hi = A.hi;
    const bool multi = (hi - lo) > 1;
    XcdBarrier bar; bar.bar = (unsigned*)(ctl + CW_BAR); bar.x = 0; bar.st = nullptr;
    if (multi) bar = xcd_barrier_post((unsigned*)(ctl + CW_BAR), MISC + 8, wave * 64 + lane_now());
#define IN(k) (lo <= (k) && (k) < hi)
#define GBAR() xcd_barrier(bar, wave * 64 + lane_now())
#define SEAM(k) do { if (IN(k) && IN((k) + 1)) GBAR(); } while (0)
    float* MOD = (float*)(ws + WS_MOD);

#define PH0(rep_) phase_prologue(A, lds, ctl + CW_Q0 + 64 * (rep_), bx, G, wave, lane, gtid, NGT);
#define PH1(rep_) ;
#define PH2(rep_) phase_norm<true>((const float*)A.in[I_XP], (const float*)A.in[I_XS], (const float*)A.in[I_GATT], MOD, 0, 1024, (bf16*)(ws + WS_H), (const float*)(ws + WS_WINX), (float*)(ws + WS_EXTRA), gw, NGW, lane);
#define PH3(rep_) { pg8::Gemm g{(const pg8::bf16_t*)(ws + WS_H), (const pg8::bf16_t*)(ws + WS_WIN_T), M, NPROJ, D, D}; pg8::StaticOrder S; S.init(M, NPROJ, G, bx); \
          EpiProj E{A.out, (bf16*)(ws + WS_QB), (bf16*)(ws + WS_KB), (bf16*)(ws + WS_VB), (bf16*)(ws + WS_DNRAW), (bf16*)(ws + WS_ZG), (const float*)A.in[I_GQ], (const float*)A.in[I_GK], (LAS float*)(lds + RING_BYTES + 1024)}; \
          pg8::gemm_phase<EpiProj, pg8::StaticOrder, true, true>(lds, g, S, E, tid); }
#define PH4(rep_) phase_post(A, gw, NGW, lane, gtid, NGT);
#define PH5(rep_) for (int u = bx; u < 1024; u += G) { if (u < 512) dn_prescan_unit(A, lds, u, tid, wave, lane); else dn_sample_unit(A, lds, u - 512, tid); }
#define PH6(rep_) PH6X(rep_, true, true, true)
#define PH6X(rep_, DS_, DP_, DA_) { if ((DS_) && bx < 16) dn_scan_chain(A, lds, bx, tid, wave, lane); \
          \
        bool moreP = (DP_), moreS = (DA_); const bool pfirst = wave < 4; \
        gu32* qbase_ = ctl + CW_QUEUE + 1024 * (rep_);     \
        const int shard0_ = (int)(xb_xcc_id() & 7u); int offP_ = 0, offS_ = 0;     \
        for (;;) { \
            int job = -1; bool isP = false; \
            if (pfirst && moreP) { const int sh_ = (shard0_ + offP_) & 7; unsigned j_ = 0; if (lane == 0) j_ = __hip_atomic_fetch_add(qbase_ + 64 * sh_, 1u, RLX_AGENT); j_ = __builtin_amdgcn_readfirstlane(j_); if (j_ < 256u) { job = (int)j_ * 8 + sh_; isP = true; } else if (++offP_ == 8) moreP = false; } \
            if (job < 0 && moreS && !(pfirst && moreP)) { const int sh_ = (shard0_ + offS_) & 7; unsigned j_ = 0; if (lane == 0) j_ = __hip_atomic_fetch_add(qbase_ + 512 + 64 * sh_, 1u, RLX_AGENT); j_ = __builtin_amdgcn_readfirstlane(j_); if (j_ < 512u) { job = (int)j_ * 8 + sh_; } else if (++offS_ == 8) moreS = false; } \
            if (job < 0 && !pfirst && !moreS && moreP) { const int sh_ = (shard0_ + offP_) & 7; unsigned j_ = 0; if (lane == 0) j_ = __hip_atomic_fetch_add(qbase_ + 64 * sh_, 1u, RLX_AGENT); j_ = __builtin_amdgcn_readfirstlane(j_); if (j_ < 256u) { job = (int)j_ * 8 + sh_; isP = true; } else if (++offP_ == 8) moreP = false; } \
            if (job < 0) { if (!moreP && !moreS) break; else continue; } \
            if (isP) { const int qb = 63 - (job >> 5), bh = job & 31; attn_prompt_item(A, lds + wave * AW_BYTES, bh >> 3, bh & 7, qb * 64, lane); } \
            else { const int h_ = job & 7, bs_ = job >> 3; attn_sample_job(A, lds + wave * AW_BYTES, bs_ >> 2, h_, bs_ & 3, lane); } \
        } }
#define PH7(rep_) phase_outnorm(A, gw, NGW, lane);
#define PH8(rep_) { { pg8::Gemm g{(const pg8::bf16_t*)(ws + WS_MIXED), (const pg8::bf16_t*)(ws + WS_WOUT_T), MP, D, D, D}; pg8::StaticOrder S; S.init(MP, D, G, bx); \
        EpiResGate E{(const float*)A.in[I_XP], (const float*)A.in[I_XS], MOD, 2048, (float*)(ws + WS_X1)}; \
        pg8::gemm_phase<EpiResGate, pg8::StaticOrder, true, true>(lds, g, S, E, tid); } \
        __syncthreads(); \
        { pg8::Gemm g{(const pg8::bf16_t*)(ws + WS_MIXED), (const pg8::bf16_t*)(ws + WS_WOUT_T), M, D, 256, D}; SplitKOrder S{D / 256, G, bx};     \
        EpiSlab E{(float*)(ws + WS_SLAB)}; \
        pg8::gemm_phase<EpiSlab, SplitKOrder, true, true>(lds, g, S, E, tid); } }
#define PH9(rep_) phase_norm<false, 4>((const float*)(ws + WS_X1), (const float*)A.in[I_XS], (const float*)A.in[I_GFFN], MOD, 3072, 4096, (bf16*)(ws + WS_H), nullptr, nullptr, gw, NGW, lane, (const float*)(ws + WS_SLAB), 2048, (float*)(ws + WS_X1));
#define PH10(rep_) { pg8::Gemm g{(const pg8::bf16_t*)(ws + WS_H), (const pg8::bf16_t*)(ws + WS_WUP_T), M, DFF2, D, D}; pg8::StaticOrder S; S.init(M, DFF2, G, bx); \
        pg8::EpiBf16<0> E{(pg8::bf16_t*)(ws + WS_UP), DFF2, nullptr, 0, 0, 1.f}; \
        pg8::gemm_phase<pg8::EpiBf16<0>, pg8::StaticOrder, true, true>(lds, g, S, E, tid); }
#define PH11(rep_) phase_convgate(A, gw, NGW, lane);
#define PH12(rep_) { { pg8::Gemm g{(const pg8::bf16_t*)(ws + WS_ACT), (const pg8::bf16_t*)(ws + WS_WDN_T), MP, D, DFF, DFF}; pg8::StaticOrder S; S.init(MP, D, G, bx); \
        EpiResGate E{(const float*)(ws + WS_X1), (const float*)(ws + WS_X1) + (size_t)MP * D, MOD, 5120, A.out}; \
        pg8::gemm_phase<EpiResGate, pg8::StaticOrder, true, true>(lds, g, S, E, tid); } \
        __syncthreads(); \
        { pg8::Gemm g{(const pg8::bf16_t*)(ws + WS_ACT), (const pg8::bf16_t*)(ws + WS_WDN_T), M, D, 256, DFF}; SplitKOrder S{DFF / 256, G, bx}; \
        EpiSlab E{(float*)(ws + WS_SLAB)}; \
        pg8::gemm_phase<EpiSlab, SplitKOrder, true, true>(lds, g, S, E, tid); } }
#define PH13(rep_) phase_slabsum(A, gw, NGW, lane);
#define RUNPH(k) do { if (IN(k)) { const int lane = lane_now(), tid = wave * 64 + lane, gtid = bx * 512 + tid; (void)gtid; PH##k(0) if constexpr (((REP_MASK) >> (k)) & 1) { GBAR(); PH##k(1) } } } while (0)
    RUNPH(0); SEAM(0);
    RUNPH(2);
    if constexpr (((REP_MASK) >> 20) & 1) { GBAR(); const int lane = lane_now(); phase_norm<false>((const float*)A.in[I_XP], (const float*)A.in[I_XS], (const float*)A.in[I_GATT], MOD, 0, 1024, (bf16*)(ws + WS_H), nullptr, nullptr, gw, NGW, lane); }
    SEAM(2);
    RUNPH(3); SEAM(3);
    RUNPH(4); SEAM(4);
    RUNPH(5);
    if constexpr (((REP_MASK) >> 17) & 1) { GBAR(); const int lane = lane_now(), tid = wave * 64 + lane; for (int u = bx; u < 512; u += G) dn_prescan_unit<PROBE_LEVEL>(A, lds, u, tid, wave, lane); }
    if constexpr (((REP_MASK) >> 18) & 1) { GBAR(); const int lane = lane_now(), tid = wave * 64 + lane; (void)lane; for (int u = bx; u < 512; u += G) dn_sample_unit(A, lds, u, tid); }
    SEAM(5);
    RUNPH(6);
    if constexpr (((REP_MASK) >> 13) & 1) { GBAR(); const int lane = lane_now(), tid = wave * 64 + lane; PH6X(2, true, false, false) }
    if constexpr (((REP_MASK) >> 14) & 1) { GBAR(); const int lane = lane_now(), tid = wave * 64 + lane; PH6X(3, false, true, false) }
    if constexpr (((REP_MASK) >> 15) & 1) { GBAR(); const int lane = lane_now(), tid = wave * 64 + lane; PH6X(4, false, false, true) }
    SEAM(6);
    RUNPH(7); SEAM(7);
    if constexpr (((REP_MASK) >> 19) & 1) { _Pragma("unroll 1") for (int i_ = 0; i_ < 20; ++i_) GBAR(); }
    RUNPH(8); SEAM(8);
    RUNPH(9); SEAM(9);
    RUNPH(10); SEAM(10);
    RUNPH(11); SEAM(11);
    RUNPH(12); SEAM(12);
    RUNPH(13);
#undef IN
#undef SEAM
}

#ifndef N_LAUNCHES
#define N_LAUNCHES 1
#endif
extern "C" void kernel_launch(void* const* d_in, const int* in_sizes, int n_in, void* d_out, int out_size, void* d_ws, size_t ws_size, hipStream_t stream) {
    static int grid = 0;
    if (grid == 0) {
        if (n_in != 27 || (size_t)out_size != O_END || ws_size < WS_END) { fprintf(stderr, "kernel_launch: unexpected shapes: n_in %d out %d ws %zu\n", n_in, out_size, ws_size); grid = -1; return; }
        int dev = 0, cus = 0, per_cu = 0;
        if (hipGetDevice(&dev) != hipSuccess || hipDeviceGetAttribute(&cus, hipDeviceAttributeMultiprocessorCount, dev) != hipSuccess) { grid = -1; return; }
        if (hipFuncSetAttribute((const void*)fwd_kernel, hipFuncAttributeMaxDynamicSharedMemorySize, LDS_BYTES) != hipSuccess) { fprintf(stderr, "kernel_launch: hipFuncSetAttribute failed\n"); grid = -1; return; }
        if (hipOccupancyMaxActiveBlocksPerMultiprocessor(&per_cu, (const void*)fwd_kernel, 512, LDS_BYTES) != hipSuccess || per_cu < 1) fprintf(stderr, "kernel_launch: occupancy query says %d\n", per_cu);
        (void)hipGetLastError();
        grid = cus;
    }
    if (grid < 0) return;
    (void)hipMemsetAsync((char*)d_ws + WS_CTL, 0, CTL_ZERO_BYTES, stream);
    Args a{};
    for (int i = 0; i < 27; ++i) a.in[i] = d_in[i];
    a.out = (float*)d_out; a.ws = (unsigned char*)d_ws;
    if (N_LAUNCHES == 1) { a.lo = 0; a.hi = NPHASE; hipLaunchKernelGGL(fwd_kernel, dim3(grid), dim3(512), LDS_BYTES, stream, a); }
    else for (int p = 0; p < NPHASE; ++p) { a.lo = p; a.hi = p + 1; hipLaunchKernelGGL(fwd_kernel, dim3(grid), dim3(512), LDS_BYTES, stream, a); }
}
```

```cpp
#include <hip/hip_runtime.h>
#include <cstdio>
#include <cstdint>
#define REP_MASK 0
#define PROBE_LEVEL 0
namespace pg8 {
#define PG8_LAS __attribute__((address_space(3)))
typedef unsigned short bf16_t;
typedef short bf16x8 __attribute__((ext_vector_type(8)));
typedef float f32x4 __attribute__((ext_vector_type(4)));
typedef unsigned u32x4 __attribute__((ext_vector_type(4)));
constexpr int BM = 256, BK = 64, HALF = 128, HTB = HALF * BK * 2  , STAGE_BYTES = 8 * HTB, NXCD = 8, WGM = 8;

__host__ __device__ __forceinline__ int lds_byte(int r, int c) { const int st = (r >> 4) * 2 + (c >> 5), rr = r & 15, cc = c & 31, ob = rr * 64 + cc * 2; return st * 1024 + (ob ^ (((ob >> 9) & 1) << 5)); }
__host__ __device__ __forceinline__ void stage_rc(int b, int& R, int& C) { const int st = b / 1024, sb = b % 1024, swz = sb ^ (((sb >> 9) & 1) << 5); R = (st >> 1) * 16 + swz / 64; C = (st & 1) * 32 + (swz % 64) / 2; }
__host__ __device__ __forceinline__ int perm32(int rho) { const int n = rho >> 4, i = rho & 15; return 8 * (i >> 2) + 4 * n + (i & 3); }

struct Unit { int pm, pn, ko; };
struct Gemm { const bf16_t* A; const bf16_t* Bt; int M, N, K, ld; };

struct StaticOrder {
    int nM, nN, nwg, G, c;
    __host__ __device__ void init(int M, int N, int G_, int c_) { nM = M / BM; nN = N / BM; nwg = nM * nN; G = G_; c = c_; }
    __host__ __device__ bool next(int i, Unit& u) const {
        const long L = (long)i * G + c; if (L >= nwg) return false;
        int wgid = (int)L; { const int q = nwg / NXCD, r = nwg % NXCD, xcd = wgid % NXCD, off = wgid / NXCD; wgid = (xcd < r ? xcd * (q + 1) : r * (q + 1) + (xcd - r) * q) + off; }
        const int nig = WGM * nN, gid = wgid / nig, fm = gid * WGM, gsz = (nM - fm) < WGM ? (nM - fm) : WGM;
        u.pm = fm + ((wgid % nig) % gsz); u.pn = (wgid % nig) / gsz; u.ko = 0; return true;
    }
    __device__ __forceinline__ void a_ready(const Unit&) const {}
    __device__ __forceinline__ void done(const Unit&) const {}
};

__device__ __forceinline__ unsigned cvt_pk_bf16(float lo, float hi) { unsigned r; asm volatile("v_cvt_pk_bf16_f32 %0, %1, %2" : "=v"(r) : "v"(lo), "v"(hi)); return r; }
typedef float f32x2 __attribute__((ext_vector_type(2)));
__device__ __forceinline__ f32x2 gelu_pk(f32x2 v) {
    const f32x2 av = __builtin_elementwise_abs(v), d = av * 0.2316418882f + 1.0f;
    f32x2 t; t.x = __builtin_amdgcn_rcpf(d.x); t.y = __builtin_amdgcn_rcpf(d.y);
    f32x2 q = t * 0.5307027145f + (-0.7265760135f); q = q * t + 0.7107068705f; q = q * t + (-0.142248368f); q = q * t + 0.127414796f; q = q * t;
    const f32x2 s = (v * v) * (-0.72134752044f);
    f32x2 e; e.x = __builtin_amdgcn_exp2f(s.x); e.y = __builtin_amdgcn_exp2f(s.y);
    const f32x2 m = v * (q * e), r = v - m;
    f32x2 o; o.x = v.x < 0.f ? m.x : r.x; o.y = v.y < 0.f ? m.y : r.y; return o;
}

template <int ACT  > struct EpiBf16 {
    static constexpr bool PERM = true, AFTER_DRAIN = false; static_assert(ACT == 0 || ACT == 1, "EpiBf16: ACT is 0 (none) or 1 (gelu_pk)");
    bf16_t* O; int ldc; const float* bias; int split_cols; size_t split_stride; float scale0;
    __device__ __forceinline__ void operator()(const f32x4 (&acc)[2][2][4][2], const Unit& u, int wr, int wc, int fr, int fq) const {
        const int row0 = u.pm * BM + wr * 64 + fr; int colt = u.pn * BM; bf16_t* base = O;
        float sc = 1.f; if (split_cols) { const int t = colt / split_cols; base += (size_t)t * split_stride; colt -= t * split_cols; if (t == 0) sc = scale0; }
        const int col0 = colt + wc * 32 + 8 * fq, bcol0 = u.pn * BM + wc * 32 + 8 * fq;
        f32x4 bv[2][2];
#pragma unroll
        for (int bj = 0; bj < 2; ++bj)
#pragma unroll
            for (int n = 0; n < 2; ++n) bv[bj][n] = bias ? *(const f32x4*)(bias + bcol0 + bj * HALF + 4 * n) : (f32x4){0.f, 0.f, 0.f, 0.f};
#pragma unroll
        for (int ai = 0; ai < 2; ++ai)
#pragma unroll
            for (int m = 0; m < 4; ++m) { bf16_t* rowp = base + (size_t)(row0 + ai * HALF + m * 16) * ldc + col0;
#pragma unroll
                for (int bj = 0; bj < 2; ++bj) { f32x4 v0 = acc[ai][bj][m][0] + bv[bj][0], v1 = acc[ai][bj][m][1] + bv[bj][1];
                    if (ACT == 1) { f32x2 a = gelu_pk((f32x2){v0[0], v0[1]}), b = gelu_pk((f32x2){v0[2], v0[3]}), c = gelu_pk((f32x2){v1[0], v1[1]}), d = gelu_pk((f32x2){v1[2], v1[3]});
                        v0 = (f32x4){a.x, a.y, b.x, b.y}; v1 = (f32x4){c.x, c.y, d.x, d.y}; }
                    v0 = v0 * sc; v1 = v1 * sc; u32x4 w; w.x = cvt_pk_bf16(v0[0], v0[1]); w.y = cvt_pk_bf16(v0[2], v0[3]); w.z = cvt_pk_bf16(v1[0], v1[1]); w.w = cvt_pk_bf16(v1[2], v1[3]);
                    *(u32x4*)(rowp + bj * HALF) = w; } }
    }
};

struct PanelStats {
    unsigned* xbuf;
    unsigned* cnt;
    unsigned* tmo;
    int ntn; float eps;
    unsigned code;
    __device__ __forceinline__ bool run(const f32x4 (&v)[2][2][4][2], const Unit& u, int wr, int wc, int fr, int fq, PG8_LAS unsigned char* lds, int wid, int lane) const {
        typedef float f32x2v __attribute__((ext_vector_type(2)));
        PG8_LAS f32x2v* P = (PG8_LAS f32x2v*)lds;
        PG8_LAS f32x2v* S = (PG8_LAS f32x2v*)(lds + 8192);
        PG8_LAS unsigned* flag = (PG8_LAS unsigned*)(lds + 8192 + 2048);
#pragma unroll
        for (int ai = 0; ai < 2; ++ai)
#pragma unroll
            for (int m = 0; m < 4; ++m) {
                float s = 0.f;
#pragma unroll
                for (int bj = 0; bj < 2; ++bj)
#pragma unroll
                    for (int n = 0; n < 2; ++n) { const f32x4 x = v[ai][bj][m][n]; s += (x[0] + x[1]) + (x[2] + x[3]); }
                s += __shfl_xor(s, 16); s += __shfl_xor(s, 32);
                const float mw = s * (1.0f / 64.0f); float q = 0.f;
#pragma unroll
                for (int bj = 0; bj < 2; ++bj)
#pragma unroll
                    for (int n = 0; n < 2; ++n) { const f32x4 d = v[ai][bj][m][n] - mw; q += (d[0] * d[0] + d[1] * d[1]) + (d[2] * d[2] + d[3] * d[3]); }
                q += __shfl_xor(q, 16); q += __shfl_xor(q, 32);
                if (fq == 0) P[(ai * HALF + wr * 64 + m * 16 + fr) * 4 + wc] = (f32x2v){mw, q};
            }
        asm volatile("s_waitcnt lgkmcnt(0)" ::: "memory"); __builtin_amdgcn_s_barrier(); asm volatile("" ::: "memory");
#if defined(BROKEN_EXCHANGE_NO_WAIT)
#warning BROKEN CONTROL BUILD: the row-statistics exchange does not wait; results are wrong by design
        if (blockIdx.x >= 64) { const long long t0_ = clock64(); while (clock64() - t0_ < 60000) __builtin_amdgcn_s_sleep(8); }
#endif
        const int row = wid * 32 + (lane & 31);
        if (lane < 32) {
            const f32x2v a = P[row * 4 + 0], b = P[row * 4 + 1], c = P[row * 4 + 2], d = P[row * 4 + 3];
            const float mt = (a.x + b.x + c.x + d.x) * 0.25f;
            const float da = a.x - mt, db = b.x - mt, dc = c.x - mt, dd = d.x - mt;
            const float m2 = (a.y + b.y) + (c.y + d.y) + 64.0f * ((da * da + db * db) + (dc * dc + dd * dd));
            unsigned long long* slot = (unsigned long long*)xbuf + ((size_t)(u.pm * BM + row) * 4 + u.pn);
            __hip_atomic_store(slot, ((unsigned long long)__float_as_uint(m2) << 32) | __float_as_uint(mt), __ATOMIC_RELAXED, __HIP_MEMORY_SCOPE_AGENT);
        }
        asm volatile("s_waitcnt vmcnt(0)" ::: "memory");
        if (lane == 0) __hip_atomic_fetch_add(cnt + 64 * u.pm, 1u, __ATOMIC_RELAXED, __HIP_MEMORY_SCOPE_AGENT);
        if (wid == 0) {
            bool dead = false; const unsigned long long t0 = __builtin_amdgcn_s_memrealtime(); const unsigned want = 8u * (unsigned)ntn;
            for (;;) {
#if defined(BROKEN_EXCHANGE_NO_WAIT)
                break;
#endif
                if ((unsigned)__builtin_amdgcn_readfirstlane(__hip_atomic_load(cnt + 64 * u.pm, __ATOMIC_RELAXED, __HIP_MEMORY_SCOPE_AGENT)) >= want) break;
                if (__builtin_amdgcn_s_memrealtime() - t0 > 2000000ull) {
                    if (lane == 0) { unsigned expect = 0u; __hip_atomic_compare_exchange_strong(tmo + 1, &expect, code | (unsigned)(u.pm & 0xff), __ATOMIC_RELAXED, __ATOMIC_RELAXED, __HIP_MEMORY_SCOPE_AGENT);
                                     __hip_atomic_store(tmo, 1u, __ATOMIC_RELAXED, __HIP_MEMORY_SCOPE_AGENT); }
                    dead = true; break; }
                __builtin_amdgcn_s_sleep(2);
            }
            __builtin_amdgcn_fence(__ATOMIC_ACQUIRE, "agent");
            if (lane == 0) flag[0] = dead ? 1u : 0u;
        }
        asm volatile("s_waitcnt vmcnt(0) lgkmcnt(0)" ::: "memory"); __builtin_amdgcn_s_barrier(); asm volatile("" ::: "memory");
        const bool bad = flag[0] != 0u;
        if (lane < 32) {
            const unsigned long long* slot = (const unsigned long long*)xbuf + (size_t)(u.pm * BM + row) * 4; float mt[4], m2[4]; float ms = 0.f;
#pragma unroll
            for (int t = 0; t < 4; ++t) { if (t < ntn) { const unsigned long long w = __hip_atomic_load(slot + t, __ATOMIC_RELAXED, __HIP_MEMORY_SCOPE_AGENT); mt[t] = __uint_as_float((unsigned)w); m2[t] = __uint_as_float((unsigned)(w >> 32)); } else { mt[t] = 0.f; m2[t] = 0.f; } ms += mt[t]; }
            const float mean = ms / (float)ntn; float q = 0.f;
#pragma unroll
            for (int t = 0; t < 4; ++t) if (t < ntn) { const float dm = mt[t] - mean; q += m2[t] + 256.0f * dm * dm; }
            S[row] = (f32x2v){mean, 1.0f / sqrtf(q / (256.0f * (float)ntn) + eps)};
        }
        asm volatile("s_waitcnt lgkmcnt(0)" ::: "memory"); __builtin_amdgcn_s_barrier(); asm volatile("" ::: "memory");
        return bad;
    }
};
struct EpiLnRes {
    static constexpr bool PERM = false, AFTER_DRAIN = true;
    const float* base; float* out; int ldc; const float* bias; PanelStats st; unsigned poison;
    __device__ __forceinline__ void fused(f32x4 (&acc)[2][2][4][2], const Unit& u, int wr, int wc, int fr, int fq, PG8_LAS unsigned char* lds, int wid, int lane) const {
        typedef float f32x2v __attribute__((ext_vector_type(2)));
        const PG8_LAS f32x2v* S = (const PG8_LAS f32x2v*)(lds + 8192);
        const int col0 = u.pn * BM + wc * 32 + 4 * fq;
#pragma unroll
        for (int bj = 0; bj < 2; ++bj)
#pragma unroll
            for (int n = 0; n < 2; ++n) { const f32x4 bv = bias ? *(const f32x4*)(bias + col0 + bj * HALF + n * 16) : (f32x4){0.f, 0.f, 0.f, 0.f};
#pragma unroll
                for (int ai = 0; ai < 2; ++ai)
#pragma unroll
                    for (int m = 0; m < 4; ++m) acc[ai][bj][m][n] += bv; }
        f32x4 pre[4][2][2];
#pragma unroll
        for (int m = 0; m < 4; ++m) { const size_t off = (size_t)(u.pm * BM + wr * 64 + m * 16 + fr) * ldc + col0;
#pragma unroll
            for (int bj = 0; bj < 2; ++bj)
#pragma unroll
                for (int n = 0; n < 2; ++n) pre[m][bj][n] = *(const f32x4*)(base + off + bj * HALF + n * 16); }
        const bool bad = st.run(acc, u, wr, wc, fr, fq, lds, wid, lane) || poison != 0u;
        const float qnan = __builtin_nanf("");
#pragma unroll
        for (int ai = 0; ai < 2; ++ai)
#pragma unroll
            for (int m = 0; m < 4; ++m) { const int r = ai * HALF + wr * 64 + m * 16 + fr; const f32x2v sr = S[r]; const size_t off = (size_t)(u.pm * BM + r) * ldc + col0;
#pragma unroll
                for (int bj = 0; bj < 2; ++bj)
#pragma unroll
                    for (int n = 0; n < 2; ++n) { const f32x4 bs = ai == 0 ? pre[m][bj][n] : *(const f32x4*)(base + off + bj * HALF + n * 16); f32x4 o = bs + (acc[ai][bj][m][n] - sr.x) * sr.y;
                        if (bad) o = (f32x4){qnan, qnan, qnan, qnan}; *(f32x4*)(out + off + bj * HALF + n * 16) = o; }
                if (m & 1) asm volatile("" ::: "memory"); }
    }
};
struct EpiLnResLn {
    static constexpr bool PERM = false, AFTER_DRAIN = true;
    const float* base; float* out; bf16_t* xn; int ldc; const float* bias; PanelStats st1, st2; unsigned poison;
    __device__ __forceinline__ void fused(f32x4 (&acc)[2][2][4][2], const Unit& u, int wr, int wc, int fr, int fq, PG8_LAS unsigned char* lds, int wid, int lane) const {
        typedef float f32x2v __attribute__((ext_vector_type(2))); typedef unsigned u32x2v __attribute__((ext_vector_type(2)));
        const PG8_LAS f32x2v* S = (const PG8_LAS f32x2v*)(lds + 8192);
        const int col0 = u.pn * BM + wc * 32 + 4 * fq;
#pragma unroll
        for (int bj = 0; bj < 2; ++bj)
#pragma unroll
            for (int n = 0; n < 2; ++n) { const f32x4 bv = bias ? *(const f32x4*)(bias + col0 + bj * HALF + n * 16) : (f32x4){0.f, 0.f, 0.f, 0.f};
#pragma unroll
                for (int ai = 0; ai < 2; ++ai)
#pragma unroll
                    for (int m = 0; m < 4; ++m) acc[ai][bj][m][n] += bv; }
        bool bad = st1.run(acc, u, wr, wc, fr, fq, lds, wid, lane) || poison != 0u;
        const float qnan = __builtin_nanf("");
#pragma unroll
        for (int ai = 0; ai < 2; ++ai)
#pragma unroll
            for (int m = 0; m < 4; ++m) { const int r = ai * HALF + wr * 64 + m * 16 + fr; const f32x2v sr = S[r]; const size_t off = (size_t)(u.pm * BM + r) * ldc + col0;
#pragma unroll
                for (int bj = 0; bj < 2; ++bj)
#pragma unroll
                    for (int n = 0; n < 2; ++n) { const f32x4 bs = *(const f32x4*)(base + off + bj * HALF + n * 16); acc[ai][bj][m][n] = bs + (acc[ai][bj][m][n] - sr.x) * sr.y; }
                asm volatile("" : "+v"(acc[ai][0][m][0]), "+v"(acc[ai][0][m][1]), "+v"(acc[ai][1][m][0]), "+v"(acc[ai][1][m][1]));
                if (m & 1) asm volatile("" ::: "memory"); }
        const bool bad1 = bad;
        bad = st2.run(acc, u, wr, wc, fr, fq, lds, wid, lane) || bad;
#pragma unroll
        for (int ai = 0; ai < 2; ++ai)
#pragma unroll
            for (int m = 0; m < 4; ++m) { const int r = ai * HALF + wr * 64 + m * 16 + fr; const f32x2v sr = S[r]; const size_t off = (size_t)(u.pm * BM + r) * ldc + col0;
#pragma unroll
                for (int bj = 0; bj < 2; ++bj)
#pragma unroll
                    for (int n = 0; n < 2; ++n) { const f32x4 x1 = acc[ai][bj][m][n]; *(f32x4*)(out + off + bj * HALF + n * 16) = bad1 ? (f32x4){qnan, qnan, qnan, qnan} : x1;
                        const f32x4 o = (x1 - sr.x) * sr.y; u32x2v w; w.x = cvt_pk_bf16(o[0], o[1]); w.y = cvt_pk_bf16(o[2], o[3]);
                        if (bad) { w.x = 0x7fc07fc0u; w.y = 0x7fc07fc0u; } *(u32x2v*)(xn + off + bj * HALF + n * 16) = w; }
                asm volatile("" ::: "memory"); }
    }
};

template <class Epi, class Sched, bool ALIGN_EPI = false, bool SP2 = false>
__device__ __forceinline__ void gemm_phase(PG8_LAS unsigned char* lds, const Gemm g, const Sched& S, const Epi& E, const int tid) {
    const int wid = __builtin_amdgcn_readfirstlane(tid >> 6), lane = tid & 63, wr = wid >> 2, wc = wid & 3, fr = lane & 15, fq = lane >> 4;
    const int K = g.K, nt = K / BK;
    unsigned voffA[2], voffB[2];
#pragma unroll
    for (int i = 0; i < 2; ++i) { int R, C; stage_rc(tid * 16 + i * 8192, R, C); const int Rb = Epi::PERM ? ((R & ~31) + perm32(R & 31)) : R;
        voffA[i] = (unsigned)(R * g.ld + C) * 2u; voffB[i] = (unsigned)(Rb * g.ld + C) * 2u; }
    const size_t kstep = (size_t)(BK * 2);
    const size_t hstep = (size_t)HALF * g.ld * 2;
    const size_t tstep = 2 * hstep;
    const unsigned ldsw = (unsigned)wid * 1024u;
    const int aoff = lds_byte(wr * 64 + fr, fq * 8), boff = lds_byte(wc * 32 + fr, fq * 8);
#define PG8_SA(b, h) (((b) * 2 + (h)) * HTB)
#define PG8_SB(b, h) ((4 + (b) * 2 + (h)) * HTB)
#define PG8_STAGE(bufoff, gbase, voff) do { _Pragma("unroll") for (int _i = 0; _i < 2; ++_i) \
        __builtin_amdgcn_global_load_lds((const unsigned*)((const char*)(gbase) + (voff)[_i]), (PG8_LAS unsigned*)(lds + (bufoff) + ldsw + _i * 8192), 16, 0, 0); } while (0)
#define PG8_LDA(dst, b, h) do { _Pragma("unroll") for (int m = 0; m < 4; ++m) _Pragma("unroll") for (int k = 0; k < 2; ++k) dst[m][k] = *(const PG8_LAS bf16x8*)(lds + PG8_SA(b, h) + aoff + m * 2048 + k * 1024); } while (0)
#define PG8_LDB(dst, b, h) do { _Pragma("unroll") for (int n = 0; n < 2; ++n) _Pragma("unroll") for (int k = 0; k < 2; ++k) dst[n][k] = *(const PG8_LAS bf16x8*)(lds + PG8_SB(b, h) + boff + n * 2048 + k * 1024); } while (0)
#define PG8_MMA(ai, bj, At, Bt) do { __builtin_amdgcn_s_setprio(1); _Pragma("unroll") for (int m = 0; m < 4; ++m) _Pragma("unroll") for (int n = 0; n < 2; ++n) _Pragma("unroll") for (int k = 0; k < 2; ++k) \
        acc[ai][bj][m][n] = __builtin_amdgcn_mfma_f32_16x16x32_bf16(Bt[n][k], At[m][k], acc[ai][bj][m][n], 0, 0, 0); __builtin_amdgcn_s_setprio(0); } while (0)
#define PG8_WAIT_V(n) asm volatile("s_waitcnt vmcnt(" #n ")" ::: "memory")
#define PG8_WAIT_L(n) asm volatile("s_waitcnt lgkmcnt(" #n ")" ::: "memory")
#define PG8_BAR __builtin_amdgcn_s_barrier()
#define PG8_SCHED __builtin_amdgcn_sched_barrier(0)
    Unit cur, nxt; int ui = 0;
    if (!S.next(0, cur)) return;
    f32x4 acc[2][2][4][2];
#pragma unroll
    for (int a = 0; a < 2; ++a)
#pragma unroll
        for (int b = 0; b < 2; ++b)
#pragma unroll
            for (int m = 0; m < 4; ++m)
#pragma unroll
                for (int n = 0; n < 2; ++n) acc[a][b][m][n] = (f32x4){0.f, 0.f, 0.f, 0.f};
    bf16x8 At[4][2], B0[2][2], B1[2][2];
    const char* cA = (const char*)g.A + (size_t)cur.pm * tstep + (size_t)cur.ko * 2; const char* cB = (const char*)g.Bt + (size_t)cur.pn * tstep + (size_t)cur.ko * 2;
    S.a_ready(cur);
    if constexpr (SP2) {
        PG8_STAGE(PG8_SB(0, 0), cB, voffB); PG8_STAGE(PG8_SB(0, 1), cB + hstep, voffB); PG8_STAGE(PG8_SA(0, 0), cA, voffA); PG8_STAGE(PG8_SA(0, 1), cA + hstep, voffA);
        if (wr == 1) PG8_BAR;
        PG8_WAIT_V(2); PG8_BAR;
        PG8_STAGE(PG8_SB(1, 0), cB + kstep, voffB); PG8_STAGE(PG8_SA(1, 0), cA + kstep, voffA); PG8_STAGE(PG8_SB(1, 1), cB + hstep + kstep, voffB);
        PG8_WAIT_V(6); PG8_BAR;
    } else {
        PG8_STAGE(PG8_SB(0, 0), cB, voffB); PG8_STAGE(PG8_SA(0, 0), cA, voffA); PG8_STAGE(PG8_SB(0, 1), cB + hstep, voffB); PG8_STAGE(PG8_SA(0, 1), cA + hstep, voffA);
        if (wr == 1) PG8_BAR;
        PG8_WAIT_V(4); PG8_BAR;
        PG8_STAGE(PG8_SB(1, 0), cB + kstep, voffB); PG8_STAGE(PG8_SA(1, 0), cA + kstep, voffA); PG8_STAGE(PG8_SB(1, 1), cB + hstep + kstep, voffB);
        PG8_WAIT_V(6); PG8_BAR;
    }
    for (;;) {
        const bool has_next = S.next(ui + 1, nxt);
        const char* nA = has_next ? (const char*)g.A + (size_t)nxt.pm * tstep + (size_t)nxt.ko * 2 : cA; const char* nB = has_next ? (const char*)g.Bt + (size_t)nxt.pn * tstep + (size_t)nxt.ko * 2 : cB;
        for (int t = 0; t < nt; t += 2) {
            const bool last = (t == nt - 2);
            const char* a1 = cA + (size_t)(t + 1) * kstep;
            const char* a2 = last ? nA : cA + (size_t)(t + 2) * kstep; const char* b2 = last ? nB : cB + (size_t)(t + 2) * kstep;
            const char* a3 = a2 + kstep; const char* b3 = b2 + kstep;
            if (last && has_next) S.a_ready(nxt);
            if constexpr (SP2) {
            PG8_LDB(B0, 0, 0); PG8_LDB(B1, 0, 1); PG8_SCHED; PG8_LDA(At, 0, 0); PG8_STAGE(PG8_SA(1, 1), a1 + hstep, voffA);
            PG8_WAIT_V(8); PG8_WAIT_L(0); PG8_BAR; PG8_MMA(0, 0, At, B0); PG8_MMA(0, 1, At, B1); PG8_BAR; PG8_SCHED;
            PG8_LDA(At, 0, 1); PG8_STAGE(PG8_SB(0, 0), b2, voffB); PG8_STAGE(PG8_SB(0, 1), b2 + hstep, voffB); PG8_STAGE(PG8_SA(0, 0), a2, voffA);
            PG8_WAIT_V(8); PG8_WAIT_L(0); PG8_BAR; PG8_MMA(1, 0, At, B0); PG8_MMA(1, 1, At, B1); PG8_BAR; PG8_SCHED;
            PG8_LDB(B0, 1, 0); PG8_LDB(B1, 1, 1); PG8_SCHED; PG8_LDA(At, 1, 0); PG8_STAGE(PG8_SA(0, 1), a2 + hstep, voffA);
            PG8_WAIT_V(8); PG8_WAIT_L(0); PG8_BAR; PG8_MMA(0, 0, At, B0); PG8_MMA(0, 1, At, B1); PG8_BAR; PG8_SCHED;
            PG8_LDA(At, 1, 1); PG8_STAGE(PG8_SB(1, 0), b3, voffB); PG8_STAGE(PG8_SB(1, 1), b3 + hstep, voffB); PG8_STAGE(PG8_SA(1, 0), a3, voffA);
            PG8_WAIT_V(8); PG8_WAIT_L(0); PG8_BAR; PG8_MMA(1, 0, At, B0); PG8_MMA(1, 1, At, B1); PG8_BAR; PG8_SCHED;
            } else {
            PG8_LDB(B0, 0, 0); PG8_SCHED; PG8_LDA(At, 0, 0); PG8_STAGE(PG8_SA(1, 1), a1 + hstep, voffA);
            PG8_WAIT_L(8); PG8_BAR; PG8_WAIT_L(0); PG8_MMA(0, 0, At, B0); PG8_BAR; PG8_SCHED;
            PG8_LDB(B1, 0, 1); PG8_STAGE(PG8_SB(0, 0), b2, voffB);
            PG8_BAR; PG8_WAIT_L(0); PG8_MMA(0, 1, At, B1); PG8_BAR;
            PG8_LDA(At, 0, 1); PG8_STAGE(PG8_SA(0, 0), a2, voffA);
            PG8_BAR; PG8_WAIT_L(0); PG8_MMA(1, 0, At, B0); PG8_BAR; PG8_SCHED;
            PG8_STAGE(PG8_SB(0, 1), b2 + hstep, voffB);
            PG8_WAIT_V(6); PG8_BAR; PG8_MMA(1, 1, At, B1); PG8_BAR;
            PG8_LDB(B0, 1, 0); PG8_SCHED; PG8_LDA(At, 1, 0); PG8_STAGE(PG8_SA(0, 1), a2 + hstep, voffA);
            PG8_WAIT_L(8); PG8_BAR; PG8_WAIT_L(0); PG8_MMA(0, 0, At, B0); PG8_BAR; PG8_SCHED;
            PG8_LDB(B1, 1, 1); PG8_STAGE(PG8_SB(1, 0), b3, voffB);
            PG8_BAR; PG8_WAIT_L(0); PG8_MMA(0, 1, At, B1); PG8_BAR;
            PG8_LDA(At, 1, 1); PG8_STAGE(PG8_SA(1, 0), a3, voffA);
            PG8_BAR; PG8_WAIT_L(0); PG8_MMA(1, 0, At, B0); PG8_BAR; PG8_SCHED;
            PG8_STAGE(PG8_SB(1, 1), b3 + hstep, voffB);
            PG8_WAIT_V(6); PG8_BAR; PG8_MMA(1, 1, At, B1); PG8_BAR;
            }
        }
        if constexpr (ALIGN_EPI) { if (wr == 0) PG8_BAR; }
        if constexpr (!Epi::AFTER_DRAIN) { E(acc, cur, wr, wc, fr, fq); S.done(cur); }
        if (!has_next) break;
#pragma unroll
        for (int a = 0; a < 2; ++a)
#pragma unroll
            for (int b = 0; b < 2; ++b)
#pragma unroll
                for (int m = 0; m < 4; ++m)
#pragma unroll
                    for (int n = 0; n < 2; ++n) acc[a][b][m][n] = (f32x4){0.f, 0.f, 0.f, 0.f};
        cur = nxt; cA = nA; cB = nB; ++ui;
        if constexpr (ALIGN_EPI) { if (wr == 1) PG8_BAR; }
    }
    PG8_WAIT_V(0);
    if constexpr (!ALIGN_EPI) { if (wr == 0) PG8_BAR; }
    PG8_BAR;
    if constexpr (Epi::AFTER_DRAIN) { E.fused(acc, cur, wr, wc, fr, fq, lds, wid, lane); S.done(cur); }
#undef PG8_SA
#undef PG8_SB
#undef PG8_STAGE
#undef PG8_LDA
#undef PG8_LDB
#undef PG8_MMA
#undef PG8_WAIT_V
#undef PG8_WAIT_L
#undef PG8_BAR
#undef PG8_SCHED
}
}

#define GAS __attribute__((address_space(1)))
#define LAS __attribute__((address_space(3)))
typedef unsigned short bf16;
typedef float f32x4 __attribute__((ext_vector_type(4)));
typedef float f32x16 __attribute__((ext_vector_type(16)));
typedef short bf16x8 __attribute__((ext_vector_type(8)));
typedef short s16x4 __attribute__((ext_vector_type(4)));
typedef unsigned u32x4 __attribute__((ext_vector_type(4)));
typedef unsigned u32x2 __attribute__((ext_vector_type(2)));
typedef float f32x2_t __attribute__((ext_vector_type(2)));
typedef __bf16 bf16x2_t __attribute__((ext_vector_type(2)));
typedef GAS unsigned gu32;
#define RLX_AGENT __ATOMIC_RELAXED, __HIP_MEMORY_SCOPE_AGENT

constexpr int D = 1024, BP = 4, TP = 4096, MP = BP * TP, BS = 128, TS = 8, MS = BS * TS, M = MP + MS;
constexpr int SBH = 8, HD = 64, SBW = 512, DNH = 4, DND = 128, DNW = 512;
constexpr int IN_COLS = 3592, NPROJ = 3584;
constexpr int DFF = 2816, DFF2 = 5632, NMOD = 6144, NC = BP + BS;
constexpr int PAST = 2048, NPAGES = 16, PAGE = 128;
constexpr float EPS = 1e-6f, LOG2E = 1.4426950408889634f;
constexpr float QSCALE = 0.125f * LOG2E;
constexpr int NSPLIT = 4, NPART = 5;

constexpr size_t O_YP = 0, O_KP = 17825792, O_VP = 26214400, O_KS = 34603008, O_VS = 35127296, O_SP = 35651584, O_SS = 35913728,
                 O_DCP = 44302336, O_DCS = 44320768, O_FCP = 44910592, O_FCS = 44955648, O_END = 46397440;

constexpr size_t MiB = 1u << 20;
constexpr size_t WS_CTL = 0, CTL_ZERO_BYTES = MiB;
constexpr size_t WS_MOD = 1 * MiB, WS_SC = 5 * MiB, WS_WINX = 6 * MiB, WS_WIN_T = 7 * MiB, WS_WOUT_T = 14 * MiB, WS_WUP_T = 16 * MiB, WS_WDN_T = 27 * MiB,
                 WS_EXTRA = 33 * MiB, WS_H = 34 * MiB, WS_DNRAW = 68 * MiB, WS_ZG = 120 * MiB, WS_QB = 306 * MiB, WS_KB = 323 * MiB, WS_VB = 340 * MiB, WS_QD = 357 * MiB, WS_KD = 391 * MiB,
                 WS_VD = 425 * MiB, WS_BETA = 459 * MiB, WS_LOGA = 460 * MiB, WS_ODN = 461 * MiB, WS_MIXED = 495 * MiB, WS_X1 = 529 * MiB, WS_SIDEP = 597 * MiB, WS_SIDES = 610 * MiB,
                 WS_ACT = 784 * MiB, WS_U = 878 * MiB, WS_KCUM = 910 * MiB, WS_QDEC = 926 * MiB, WS_KDECT = 942 * MiB, WS_INTRA = 958 * MiB, WS_GL = 966 * MiB,
                 WS_OPART = 967 * MiB, WS_LPART = 978 * MiB, WS_SLAB = 980 * MiB, WS_END = 1024 * MiB;
constexpr int CW_Q0 = 1024;
constexpr int CW_QUEUE = 64;
constexpr int CW_BAR = 8192;

constexpr int RING_BYTES = 131072, MISC_OFF = RING_BYTES + 320, LDS_BYTES = 147456;

__device__ __forceinline__ unsigned cvtpk(float lo, float hi) { f32x2_t v = {lo, hi}; bf16x2_t b = __builtin_convertvector(v, bf16x2_t); return __builtin_bit_cast(unsigned, b); }
__device__ __forceinline__ bf16 f2bf(float f) { return (bf16)(cvtpk(f, 0.f) & 0xffffu); }
__device__ __forceinline__ float wave_sum(float v) {
#pragma unroll
    for (int o = 1; o < 64; o <<= 1) v += __shfl_xor(v, o);
    return v;
}
__device__ __forceinline__ float siluf(float x) { return x * __builtin_amdgcn_rcpf(1.f + __builtin_amdgcn_exp2f(-1.4426950408889634f * x)); }
__device__ __forceinline__ u32x4 pack8(const f32x4 a, const f32x4 b) { u32x4 w; w.x = cvtpk(a.x, a.y); w.y = cvtpk(a.z, a.w); w.z = cvtpk(b.x, b.y); w.w = cvtpk(b.z, b.w); return w; }
__device__ __forceinline__ float bf2f(unsigned short h) { return __uint_as_float((unsigned)h << 16); }

#define XB_TMO      128
#define XB_XCNT(j)  (256  + 64 * (j))
#define XB_XSUB(j)  (1280 + 64 * (j))
#define XB_XGEN(j)  (2304 + 64 * (j))
#define XB_TOP      3328
#define XB_TOPGEN   3392
#define XCD_BAR_WORDS 3456
#define XB_SPIN_CAP (1u << 18)
__device__ __forceinline__ unsigned xb_ld(unsigned* p)              { return __hip_atomic_load(p, __ATOMIC_RELAXED, __HIP_MEMORY_SCOPE_AGENT); }
__device__ __forceinline__ unsigned xb_add(unsigned* p, unsigned v) { return __hip_atomic_fetch_add(p, v, __ATOMIC_RELAXED, __HIP_MEMORY_SCOPE_AGENT); }
__device__ __forceinline__ unsigned xb_xcc_id() { return (unsigned)__builtin_amdgcn_s_getreg((3 << 11) | 20) & 0xFu; }
#define XB_SPIN(cond, bar) do { unsigned _sp = 0; while (cond) { __builtin_amdgcn_s_sleep(1); \
    if ((++_sp & 255u) == 0u) { if (xb_ld(&(bar)[XB_TMO])) break; if (_sp > XB_SPIN_CAP) { atomicAdd(&(bar)[XB_TMO], 1u); break; } } } } while (0)
struct XcdBarrier { unsigned* bar; unsigned x; volatile LAS unsigned* st; };
__device__ __forceinline__ XcdBarrier xcd_barrier_post(unsigned* bar, volatile LAS unsigned* st, int tid) {
    XcdBarrier b; b.bar = bar; b.x = xb_xcc_id(); b.st = st;
    if (tid == 0) (void)xb_add(&bar[XB_XCNT(b.x)], 1u);
    return b;
}
__device__ __forceinline__ void xcd_barrier_complete(unsigned* bar, unsigned x, unsigned& nloc, unsigned& nx) {
    const unsigned G = gridDim.x * gridDim.y * gridDim.z;
    unsigned sum, cnt, mine, sp = 0u;
    for (;;) {
        sum = 0u; cnt = 0u; mine = 0u;
#pragma unroll
        for (unsigned j = 0; j < 16; ++j) { const unsigned c = xb_ld(&bar[XB_XCNT(j)]); sum += c; cnt += (c > 0u) ? 1u : 0u; mine = (j == x) ? c : mine; }
        if (sum == G) break;
        __builtin_amdgcn_s_sleep(1);
        if ((++sp & 255u) == 0u) { if (xb_ld(&bar[XB_TMO])) break; if (sp > XB_SPIN_CAP) { atomicAdd(&bar[XB_TMO], 1u); break; } }
    }
    nloc = mine > 0u ? mine : 1u; nx = cnt > 0u ? cnt : 1u;
}
__device__ __forceinline__ void xcd_barrier(const XcdBarrier& b, int tid) {
    asm volatile("s_waitcnt vmcnt(0)" ::: "memory");
    __syncthreads();
    if (tid == 0) {
        unsigned* bar = b.bar;
        __builtin_amdgcn_s_waitcnt(0);
        unsigned nloc = b.st[0], nx = b.st[1];
        if (nloc == 0u) { xcd_barrier_complete(bar, b.x, nloc, nx); b.st[0] = nloc; b.st[1] = nx; }
        const unsigned old = xb_add(&bar[XB_XSUB(b.x)], 1u);
        const unsigned gen = old / nloc;
        if (old + 1u == (gen + 1u) * nloc) {
            __builtin_amdgcn_fence(__ATOMIC_RELEASE, "agent");
            asm volatile("s_waitcnt vmcnt(0)" ::: "memory");
            const unsigned og = xb_add(&bar[XB_TOP], 1u);
            const unsigned tg = og / nx;
            if (og + 1u == (tg + 1u) * nx) xb_add(&bar[XB_TOPGEN], 1u);
            else XB_SPIN(xb_ld(&bar[XB_TOPGEN]) == tg, bar);
            __builtin_amdgcn_fence(__ATOMIC_ACQUIRE, "agent");
            xb_add(&bar[XB_XGEN(b.x)], 1u);
            asm volatile("s_waitcnt vmcnt(0)" ::: "memory");
        } else {
            XB_SPIN(xb_ld(&bar[XB_XGEN(b.x)]) == gen, bar);
            __builtin_amdgcn_fence(__ATOMIC_ACQUIRE, "agent");
            asm volatile("s_waitcnt vmcnt(0)" ::: "memory");
        }
    }
    __syncthreads();
}

__device__ __forceinline__ int lane_now() { int l; asm volatile("v_mbcnt_lo_u32_b32 %0, -1, 0\n\tv_mbcnt_hi_u32_b32 %0, -1, %0" : "=v"(l)); return l; }
struct Args { const void* in[27]; float* out; unsigned char* ws; int lo, hi; };
enum { I_XP = 0, I_XS, I_CP, I_CS, I_CK, I_CV, I_PT, I_SD, I_SDC, I_SFC, I_WADA, I_BADA, I_GATT, I_WIN, I_GQ, I_GK, I_SBB, I_GSBO, I_WDNC, I_ALOG, I_DTB, I_GDNO, I_WOUT, I_GFFN, I_WUP, I_WFC, I_WDN };

__device__ __forceinline__ int mod_row(int m) { return m < MP ? (m >> 12) : BP + ((m - MP) >> 3); }

struct EpiF32 {
    static constexpr bool PERM = false, AFTER_DRAIN = false;
    float* O; int ldc;
    __device__ __forceinline__ void operator()(const pg8::f32x4 (&acc)[2][2][4][2], const pg8::Unit& u, int wr, int wc, int fr, int fq) const {
        const int row0 = u.pm * 256 + wr * 64 + fr, col0 = u.pn * 256 + wc * 32 + 4 * fq;
#pragma unroll
        for (int ai = 0; ai < 2; ++ai)
#pragma unroll
            for (int m = 0; m < 4; ++m) { float* rowp = O + (size_t)(row0 + ai * 128 + m * 16) * ldc + col0;
#pragma unroll
                for (int bj = 0; bj < 2; ++bj)
#pragma unroll
                    for (int n = 0; n < 2; ++n) *(pg8::f32x4*)(rowp + bj * 128 + n * 16) = acc[ai][bj][m][n]; }
    }
};
struct EpiResGate {
    static constexpr bool PERM = false, AFTER_DRAIN = false;
    const float* base0; const float* base1; const float* mod; int goff; float* out;
    __device__ __forceinline__ void operator()(const pg8::f32x4 (&acc)[2][2][4][2], const pg8::Unit& u, int wr, int wc, int fr, int fq) const {
        const int row0 = u.pm * 256 + wr * 64 + fr, col0 = u.pn * 256 + wc * 32 + 4 * fq;
#pragma unroll
        for (int ai = 0; ai < 2; ++ai)
#pragma unroll
            for (int m = 0; m < 4; ++m) { const int r = row0 + ai * 128 + m * 16;
                const float* bp = (r < MP ? base0 + (size_t)r * D : base1 + (size_t)(r - MP) * D) + col0;
                const float* gp = mod + (size_t)mod_row(r) * NMOD + goff + col0; float* op = out + (size_t)r * D + col0;
#pragma unroll
                for (int bj = 0; bj < 2; ++bj)
#pragma unroll
                    for (int n = 0; n < 2; ++n) { const pg8::f32x4 b = *(const pg8::f32x4*)(bp + bj * 128 + n * 16), g = *(const pg8::f32x4*)(gp + bj * 128 + n * 16);
                        *(pg8::f32x4*)(op + bj * 128 + n * 16) = b + g * acc[ai][bj][m][n]; } }
    }
};

#define DPP_F(old_, src_, ctrl_) __uint_as_float((unsigned)__builtin_amdgcn_update_dpp((int)__float_as_uint(old_), (int)__float_as_uint(src_), (ctrl_), 0xF, 0xF, false))
struct EpiUp {
    static constexpr bool PERM = true, AFTER_DRAIN = false;
    bf16* ACT; bf16* SIDEP; bf16* SIDES; const float* wf; float* out;
    __device__ __forceinline__ void operator()(const pg8::f32x4 (&acc)[2][2][4][2], const pg8::Unit& u, int wr, int wc, int fr, int fq) const {
        const bool prompt_tile = u.pm < MP / 256;
        const unsigned uc0 = (unsigned)(u.pn * 128 + wc * 32 + 8 * fq);
        const unsigned row0 = (unsigned)u.pm * 256u + (unsigned)(wr * 64 + fr);
        if (prompt_tile) {
#pragma unroll
            for (int ai = 0; ai < 2; ++ai) { const unsigned kb = (unsigned)u.pm * 4u + ai * 2 + wr;
                if (fr < 2) { bf16* sp = SIDEP + ((size_t)kb * 4 + fr) * DFF2 + uc0; *(u32x4*)sp = pack8(acc[ai][0][0][0], acc[ai][0][0][1]); *(u32x4*)(sp + DFF) = pack8(acc[ai][1][0][0], acc[ai][1][0][1]); }
                if (fr >= 14) { bf16* sp = SIDEP + ((size_t)kb * 4 + (fr - 12)) * DFF2 + uc0; *(u32x4*)sp = pack8(acc[ai][0][3][0], acc[ai][0][3][1]); *(u32x4*)(sp + DFF) = pack8(acc[ai][1][3][0], acc[ai][1][3][1]); } }
        } else {
            const int t = fr & 7;
#pragma unroll
            for (int ai = 0; ai < 2; ++ai)
#pragma unroll
                for (int m = 0; m < 4; ++m) { const unsigned seq = (row0 + ai * 128 + m * 16 - MP) >> 3;
                    if (t < 2) { bf16* sp = SIDES + ((size_t)seq * 2 + t) * DFF2 + uc0; *(u32x4*)sp = pack8(acc[ai][0][m][0], acc[ai][0][m][1]); *(u32x4*)(sp + DFF) = pack8(acc[ai][1][m][0], acc[ai][1][m][1]); }
                    if (t >= 6) { float* fo = out + O_FCS + ((size_t)seq * 2 + (t - 6)) * DFF2 + uc0;
                        *(pg8::f32x4*)fo = acc[ai][0][m][0]; *(pg8::f32x4*)(fo + 4) = acc[ai][0][m][1]; *(pg8::f32x4*)(fo + DFF) = acc[ai][1][m][0]; *(pg8::f32x4*)(fo + DFF + 4) = acc[ai][1][m][1]; } }
        }
        u32x2 half0[2][4];
#pragma unroll
        for (int n = 0; n < 2; ++n) {
            const float* wp = wf + uc0 + 4 * n;
            const pg8::f32x4 wu0 = *(const pg8::f32x4*)wp, wu1 = *(const pg8::f32x4*)(wp + DFF2), wu2 = *(const pg8::f32x4*)(wp + 2 * DFF2);
            const pg8::f32x4 wg0 = *(const pg8::f32x4*)(wp + DFF), wg1 = *(const pg8::f32x4*)(wp + DFF2 + DFF), wg2 = *(const pg8::f32x4*)(wp + 2 * DFF2 + DFF);
#pragma unroll
            for (int ai = 0; ai < 2; ++ai)
#pragma unroll
                for (int m = 0; m < 4; ++m) {
                    float a[4];
#pragma unroll
                    for (int c = 0; c < 4; ++c) {
                        const float cu = acc[ai][0][m][n][c], cg = acc[ai][1][m][n][c];
                        const float pu = m > 0 ? acc[ai][0][m - 1][n][c] : cu, pg = m > 0 ? acc[ai][1][m - 1][n][c] : cg;
                        const float u1 = DPP_F(DPP_F(0.f, pu, 0x121), cu, 0x111), u2 = DPP_F(DPP_F(0.f, pu, 0x122), cu, 0x112);
                        const float g1 = DPP_F(DPP_F(0.f, pg, 0x121), cg, 0x111), g2 = DPP_F(DPP_F(0.f, pg, 0x122), cg, 0x112);
                        const float yu = wu0[c] * u2 + wu1[c] * u1 + wu2[c] * cu, yg = wg0[c] * g2 + wg1[c] * g1 + wg2[c] * cg;
                        a[c] = siluf(yg) * yu;
                    }
                    u32x2 w; w.x = cvtpk(a[0], a[1]); w.y = cvtpk(a[2], a[3]);
                    if (n == 0) half0[ai][m] = w;
                    else *(u32x4*)(ACT + (size_t)(row0 + ai * 128 + m * 16) * DFF + uc0) = (u32x4){half0[ai][m].x, half0[ai][m].y, w.x, w.y};
                }
        }
    }
};

struct SplitKOrder {
    int nks, G, c;
    __device__ __forceinline__ bool next(int i, pg8::Unit& u) const { const int L = i * G + c; if (L >= 16 * nks) return false; const int su = L & 15, ks = L >> 4; u.pm = MP / 256 + (su >> 2); u.pn = su & 3; u.ko = ks * 256; return true; }
    __device__ __forceinline__ void a_ready(const pg8::Unit&) const {}
    __device__ __forceinline__ void done(const pg8::Unit&) const {}
};
struct EpiSlab {
    static constexpr bool PERM = false, AFTER_DRAIN = false;
    float* slab;
    __device__ __forceinline__ void operator()(const pg8::f32x4 (&acc)[2][2][4][2], const pg8::Unit& u, int wr, int wc, int fr, int fq) const {
        float* O = slab + (size_t)(u.ko >> 8) * ((size_t)MS * D);
        const int row0 = (u.pm - MP / 256) * 256 + wr * 64 + fr, col0 = u.pn * 256 + wc * 32 + 4 * fq;
#pragma unroll
        for (int ai = 0; ai < 2; ++ai)
#pragma unroll
            for (int m = 0; m < 4; ++m) { float* rowp = O + (size_t)(row0 + ai * 128 + m * 16) * D + col0;
#pragma unroll
                for (int bj = 0; bj < 2; ++bj)
#pragma unroll
                    for (int n = 0; n < 2; ++n) *(pg8::f32x4*)(rowp + bj * 128 + n * 16) = acc[ai][bj][m][n]; }
    }
};
__device__ __forceinline__ void st16(void* base, unsigned off, u32x4 v) { *(u32x4*)((unsigned char*)base + off) = v; }
__device__ __forceinline__ void st16f(void* base, unsigned off, pg8::f32x4 v) { *(pg8::f32x4*)((unsigned char*)base + off) = v; }
struct EpiProj {
    static constexpr bool PERM = true, AFTER_DRAIN = false;
    float* out; bf16* QB; bf16* KB; bf16* VB; bf16* DNRAW; bf16* ZG; const float* g_q; const float* g_k; LAS float* xl;
    __device__ __forceinline__ void operator()(const pg8::f32x4 (&acc)[2][2][4][2], const pg8::Unit& u, int wr, int wc, int fr, int fq) const {
        const int pn = u.pn, rl0 = wr * 64 + fr, c0 = wc * 32 + 8 * fq;
        const unsigned row0 = (unsigned)u.pm * 256u + (unsigned)rl0;
        const bool prompt_tile = u.pm < MP / 256;
        if (pn < 4) {
            int xb = (rl0 * 8 + wc) * 4, xb2 = (rl0 * 8 + (wc ^ 1)) * 4; asm volatile("" : "+v"(xb), "+v"(xb2));
            LAS float* xw = (LAS float*)((LAS unsigned char*)xl + xb); const LAS float* xr = (const LAS float*)((LAS unsigned char*)xl + xb2);
#pragma unroll
            for (int ai = 0; ai < 2; ++ai)
#pragma unroll
                for (int m = 0; m < 4; ++m)
#pragma unroll
                    for (int bj = 0; bj < 2; ++bj) { const pg8::f32x4 a = acc[ai][bj][m][0], b = acc[ai][bj][m][1];
                        float ss = (a[0] * a[0] + a[1] * a[1]) + (a[2] * a[2] + a[3] * a[3]) + (b[0] * b[0] + b[1] * b[1]) + (b[2] * b[2] + b[3] * b[3]);
                        ss += __shfl_xor(ss, 16); ss += __shfl_xor(ss, 32);
                        if (fq == 0) xw[(ai * 128 + m * 16) * 8 + bj * 4] = ss; }
            asm volatile("s_waitcnt lgkmcnt(0)" ::: "memory"); __builtin_amdgcn_s_barrier(); asm volatile("" ::: "memory");
            const bool isq = pn < 2; const float* g = isq ? g_q : g_k; const int dloc = 32 * (wc & 1) + 8 * fq;
            const pg8::f32x4 g0 = *(const pg8::f32x4*)(g + dloc), g1 = *(const pg8::f32x4*)(g + dloc + 4);
            bf16* dstb = isq ? QB : KB; float* dstf = prompt_tile ? out + O_KP : out + O_KS - (size_t)MP * SBW;
#pragma unroll
            for (int ai = 0; ai < 2; ++ai)
#pragma unroll
                for (int m = 0; m < 4; ++m) { const unsigned row = row0 + ai * 128 + m * 16;
#pragma unroll
                    for (int bj = 0; bj < 2; ++bj) { const float tot = xw[(ai * 128 + m * 16) * 8 + bj * 4] + xr[(ai * 128 + m * 16) * 8 + bj * 4];
                        const float rs = (isq ? QSCALE : 1.0f) / sqrtf(tot * (1.f / HD) + EPS);
                        const pg8::f32x4 a = acc[ai][bj][m][0] * rs * g0, b = acc[ai][bj][m][1] * rs * g1;
                        const unsigned e = row * SBW + (unsigned)((pn & 1) * 256 + bj * 128 + c0);
                        st16(dstb, e * 2u, pack8(a, b));
                        if (!isq) { st16f(dstf, e * 4u, a); st16f(dstf, e * 4u + 16u, b); } }
                    asm volatile("" ::: "memory"); }
            asm volatile("s_waitcnt lgkmcnt(0)" ::: "memory"); __builtin_amdgcn_s_barrier(); asm volatile("" ::: "memory");
        } else if (pn < 6) {
            float* dstf = prompt_tile ? out + O_VP : out + O_VS - (size_t)MP * SBW;
#pragma unroll
            for (int ai = 0; ai < 2; ++ai)
#pragma unroll
                for (int m = 0; m < 4; ++m) { const unsigned row = row0 + ai * 128 + m * 16;
#pragma unroll
                    for (int bj = 0; bj < 2; ++bj) { const pg8::f32x4 a = acc[ai][bj][m][0], b = acc[ai][bj][m][1]; const unsigned e = row * SBW + (unsigned)((pn & 1) * 256 + bj * 128 + c0);
                        st16(VB, e * 2u, pack8(a, b)); st16f(dstf, e * 4u, a); st16f(dstf, e * 4u + 16u, b); }
                    asm volatile("" ::: "memory"); }
        } else if (pn < 12) {
#pragma unroll
            for (int ai = 0; ai < 2; ++ai)
#pragma unroll
                for (int m = 0; m < 4; ++m) { const unsigned row = row0 + ai * 128 + m * 16;
                    const int b = prompt_tile ? (int)(row >> 12) : (int)((row - MP) >> 3), t = prompt_tile ? (int)(row & 4095) : (int)((row - MP) & 7), idx = prompt_tile ? t - (TP - 3) : t - (TS - 3);
#pragma unroll
                    for (int bj = 0; bj < 2; ++bj) { const pg8::f32x4 a = acc[ai][bj][m][0], b2 = acc[ai][bj][m][1]; const unsigned ch = (unsigned)((pn - 6) * 256 + bj * 128 + c0);
                        st16(DNRAW, (row * 1536u + ch) * 2u, pack8(a, b2));
                        if (idx >= 0) { float* o = prompt_tile ? out + O_DCP : out + O_DCS; const unsigned eo = ((unsigned)(b * 3 + idx) * 1536u + ch) * 4u; st16f(o, eo, a); st16f(o, eo + 16u, b2); } }
                    asm volatile("" ::: "memory"); }
        } else {
#pragma unroll
            for (int ai = 0; ai < 2; ++ai)
#pragma unroll
                for (int m = 0; m < 4; ++m) { const unsigned row = row0 + ai * 128 + m * 16;
#pragma unroll
                    for (int bj = 0; bj < 2; ++bj) { pg8::f32x4 a = acc[ai][bj][m][0], b = acc[ai][bj][m][1]; const unsigned e = row * DNW + (unsigned)((pn - 12) * 256 + bj * 128 + c0);
                        a[0] = siluf(a[0]); a[1] = siluf(a[1]); a[2] = siluf(a[2]); a[3] = siluf(a[3]); b[0] = siluf(b[0]); b[1] = siluf(b[1]); b[2] = siluf(b[2]); b[3] = siluf(b[3]);
                        st16(ZG, e * 2u, pack8(a, b)); }
                    asm volatile("" ::: "memory"); }
        }
    }
};

__device__ __forceinline__ void mod_tile(const Args& A, LAS unsigned char* lds, int ct, int wave, int lane) {
    const float* w_ada = (const float*)A.in[I_WADA]; const float* b_ada = (const float*)A.in[I_BADA];
    const float* cp = (const float*)A.in[I_CP]; const float* cs = (const float*)A.in[I_CS]; float* MOD = (float*)(A.ws + WS_MOD);
    const int lr = lane & 15, q = lane >> 4, col = ct * 16 + lr;
    pg8::f32x4 acc[9];
#pragma unroll
    for (int i = 0; i < 9; ++i) acc[i] = (pg8::f32x4){0.f, 0.f, 0.f, 0.f};
#pragma unroll
    for (int s4 = 0; s4 < 4; ++s4) {
        const int k0 = 128 * wave + 32 * s4 + 8 * q;
        const float* wp = w_ada + (size_t)k0 * NMOD + col;
        float w[8];
#pragma unroll
        for (int j = 0; j < 8; ++j) w[j] = wp[(size_t)j * NMOD];
        u32x4 bw; bw.x = cvtpk(w[0], w[1]); bw.y = cvtpk(w[2], w[3]); bw.z = cvtpk(w[4], w[5]); bw.w = cvtpk(w[6], w[7]);
        const bf16x8 bfr = __builtin_bit_cast(bf16x8, bw);
#pragma unroll
        for (int i = 0; i < 9; ++i) { const int row = 16 * i + lr;
            f32x4 c0 = (f32x4){0.f, 0.f, 0.f, 0.f}, c1 = c0;
            if (row < NC) { const float* crow_ = (row < BP ? cp + (size_t)row * D : cs + (size_t)(row - BP) * D) + k0; c0 = *(const f32x4*)crow_; c1 = *(const f32x4*)(crow_ + 4); }
            c0.x = siluf(c0.x); c0.y = siluf(c0.y); c0.z = siluf(c0.z); c0.w = siluf(c0.w); c1.x = siluf(c1.x); c1.y = siluf(c1.y); c1.z = siluf(c1.z); c1.w = siluf(c1.w);
            acc[i] = __builtin_amdgcn_mfma_f32_16x16x32_bf16(__builtin_bit_cast(bf16x8, pack8(c0, c1)), bfr, acc[i], 0, 0, 0); }
    }
    LAS pg8::f32x4* red = (LAS pg8::f32x4*)lds;
#pragma unroll
    for (int i = 0; i < 9; ++i) red[(wave * 9 + i) * 64 + lane] = acc[i];
    __syncthreads();
    for (int i = wave; i < 9; i += 8) {
        pg8::f32x4 t = red[i * 64 + lane];
#pragma unroll
        for (int w2 = 1; w2 < 8; ++w2) t += red[(w2 * 9 + i) * 64 + lane];
        const float bb = b_ada[col];
#pragma unroll
        for (int r = 0; r < 4; ++r) { const int row = 16 * i + 4 * q + r; if (row < NC) MOD[(size_t)row * NMOD + col] = t[r] + bb; }
    }
    __syncthreads();
}
__device__ __forceinline__ void transpose_item(const float* W, int ldw, int src_col0, bf16* WT, int Kdst, int dst_row0, int k0, LAS float* scr, int lane) {
#pragma unroll
    for (int h2 = 0; h2 < 2; ++h2) { float v[16];
#pragma unroll
        for (int i = 0; i < 16; ++i) v[i] = W[(size_t)(k0 + 2 * (16 * h2 + i) + (lane >> 5)) * ldw + src_col0 + (lane & 31)];
#pragma unroll
        for (int i = 0; i < 16; ++i) scr[(2 * (16 * h2 + i) + (lane >> 5)) * 33 + (lane & 31)] = v[i]; }
    asm volatile("s_waitcnt lgkmcnt(0)" ::: "memory");
    const int c = lane & 7;
#pragma unroll
    for (int j = 0; j < 4; ++j) { const int n = (lane >> 3) + 8 * j; const LAS float* s = scr + (8 * c) * 33 + n;
        u32x4 o; o.x = cvtpk(s[0 * 33], s[1 * 33]); o.y = cvtpk(s[2 * 33], s[3 * 33]); o.z = cvtpk(s[4 * 33], s[5 * 33]); o.w = cvtpk(s[6 * 33], s[7 * 33]);
        *(u32x4*)(WT + (size_t)(dst_row0 + n) * Kdst + k0 + 8 * c) = o; }
    asm volatile("s_waitcnt lgkmcnt(0)" ::: "memory");
}
__device__ __forceinline__ void phase_prologue(const Args& A, LAS unsigned char* lds, gu32* qhead, int bx, int G, int wave, int lane, int gtid, int NGT) {
    unsigned char* ws = A.ws;
    const float* w_in = (const float*)A.in[I_WIN]; const float* w_out = (const float*)A.in[I_WOUT]; const float* w_up = (const float*)A.in[I_WUP]; const float* w_dn = (const float*)A.in[I_WDN];
    float* WX = (float*)(ws + WS_WINX);
    for (int i = gtid; i < 8 * D; i += NGT) { const int j = i >> 10, k = i & 1023; WX[i] = w_in[(size_t)k * IN_COLS + 3072 + j]; }
    for (int ct = bx; ct < NMOD / 16; ct += G) mod_tile(A, lds, ct, wave, lane);
    LAS float* scr = (LAS float*)(lds + wave * 16384);
    constexpr int I_IN = 16 * (NPROJ / 32), I_OUT = 16 * 32, I_UP = 16 * (DFF2 / 32), I_DN = (DFF / 64) * 32, NIT = I_IN + I_OUT + I_UP + I_DN;
    for (int it_ = bx * 8 + wave; it_ < NIT; it_ += G * 8) {
        int r = it_;
        if (r < I_IN) { const int nb = r % (NPROJ / 32), kb = r / (NPROJ / 32); const int n0 = nb * 32; transpose_item(w_in, IN_COLS, n0 < 3072 ? n0 : n0 + 8, (bf16*)(ws + WS_WIN_T), D, n0, kb * 64, scr, lane); continue; } r -= I_IN;
        if (r < I_OUT) { const int nb = r % 32, kb = r / 32; transpose_item(w_out, D, nb * 32, (bf16*)(ws + WS_WOUT_T), D, nb * 32, kb * 64, scr, lane); continue; } r -= I_OUT;
        if (r < I_UP) { const int nb = r % (DFF2 / 32), kb = r / (DFF2 / 32), n0 = nb * 32;
            const int dr = n0 < DFF ? (n0 >> 7) * 256 + (n0 & 127) : ((n0 - DFF) >> 7) * 256 + 128 + ((n0 - DFF) & 127);
            transpose_item(w_up, DFF2, n0, (bf16*)(ws + WS_WUP_T), D, dr, kb * 64, scr, lane); continue; } r -= I_UP;
        { const int nb = r % 32, kb = r / 32; transpose_item(w_dn, D, nb * 32, (bf16*)(ws + WS_WDN_T), DFF, nb * 32, kb * 64, scr, lane); }
    }
}

template <bool EXTRAS, int NS = 0>
__device__ __forceinline__ void phase_norm(const float* x0, const float* x1, const float* g, const float* MOD, int sh_off, int sc_off, bf16* H, const float* WX, float* EXTRA, int gw, int NGW, int lane, const float* slab = nullptr, int gate_off = 0, float* x1w = nullptr) {
    f32x4 wxr[4][8];
    if (EXTRAS) {
#pragma unroll
        for (int j = 0; j < 4; ++j)
#pragma unroll
            for (int e = 0; e < 8; ++e) wxr[j][e] = *(const f32x4*)(WX + e * D + 4 * (lane + 64 * j));
    }
    f32x4 nv[4];
    if (gw < M) { const float* xr0 = gw < MP ? x0 + (size_t)gw * D : x1 + (size_t)(gw - MP) * D;
#pragma unroll
        for (int j = 0; j < 4; ++j) nv[j] = *(const f32x4*)(xr0 + 4 * (lane + 64 * j)); }
    for (int m = gw; m < M; m += NGW) {
        const float* mod = MOD + (size_t)mod_row(m) * NMOD;
        f32x4 v[4]; float ss = 0.f;
#pragma unroll
        for (int j = 0; j < 4; ++j) v[j] = nv[j];
        { const int mn = m + NGW; if (mn < M) { const float* xrn = mn < MP ? x0 + (size_t)mn * D : x1 + (size_t)(mn - MP) * D;
#pragma unroll
            for (int j = 0; j < 4; ++j) nv[j] = *(const f32x4*)(xrn + 4 * (lane + 64 * j)); } }
#pragma unroll
        for (int j = 0; j < 4; ++j) {
            if (NS > 0 && m >= MP) { f32x4 a = (f32x4){0.f, 0.f, 0.f, 0.f};
#pragma unroll
                for (int k = 0; k < NS; ++k) a += *(const f32x4*)(slab + ((size_t)k * MS + (m - MP)) * D + 4 * (lane + 64 * j));
                v[j] += *(const f32x4*)(mod + gate_off + 4 * (lane + 64 * j)) * a;
                *(f32x4*)(x1w + (size_t)m * D + 4 * (lane + 64 * j)) = v[j]; }
            ss += (v[j].x * v[j].x + v[j].y * v[j].y) + (v[j].z * v[j].z + v[j].w * v[j].w); }
        ss = wave_sum(ss);
        const float rstd = 1.0f / sqrtf(ss * (1.f / D) + EPS);
        float ex[8];
#pragma unroll
        for (int e = 0; e < 8; ++e) ex[e] = 0.f;
#pragma unroll
        for (int j = 0; j < 4; ++j) { const int c = 4 * (lane + 64 * j);
            const f32x4 gg = *(const f32x4*)(g + c), sc = *(const f32x4*)(mod + sc_off + c), sh = *(const f32x4*)(mod + sh_off + c);
            const f32x4 h = (v[j] * rstd) * gg * (sc + 1.0f) + sh;
            u32x2 w; w.x = cvtpk(h.x, h.y); w.y = cvtpk(h.z, h.w); *(u32x2*)(H + (size_t)m * D + c) = w;
            if (EXTRAS) {
#pragma unroll
                for (int e = 0; e < 8; ++e) { const f32x4 wx = wxr[j][e]; ex[e] += (h.x * wx.x + h.y * wx.y) + (h.z * wx.z + h.w * wx.w); }
            }
        }
        if (EXTRAS) {
            float a4[4], a2[2], a1;
#pragma unroll
            for (int j = 0; j < 4; ++j) { const bool up = lane & 1; const float send = up ? ex[j] : ex[j + 4], keep = up ? ex[j + 4] : ex[j]; a4[j] = keep + __shfl_xor(send, 1); }
#pragma unroll
            for (int j = 0; j < 2; ++j) { const bool up = lane & 2; const float send = up ? a4[j] : a4[j + 2], keep = up ? a4[j + 2] : a4[j]; a2[j] = keep + __shfl_xor(send, 2); }
            { const bool up = lane & 4; const float send = up ? a2[0] : a2[1], keep = up ? a2[1] : a2[0]; a1 = keep + __shfl_xor(send, 4); }
            a1 += __shfl_xor(a1, 8); a1 += __shfl_xor(a1, 16); a1 += __shfl_xor(a1, 32);
            if (lane < 8) EXTRA[(size_t)m * 8 + (4 * (lane & 1) + 2 * ((lane >> 1) & 1) + ((lane >> 2) & 1))] = a1;
        }
    }
}

__device__ __forceinline__ f32x4 bf4lo(u32x4 w) { return (f32x4){__uint_as_float(w.x << 16), __uint_as_float(w.x & 0xffff0000u), __uint_as_float(w.y << 16), __uint_as_float(w.y & 0xffff0000u)}; }
__device__ __forceinline__ f32x4 bf4hi(u32x4 w) { return (f32x4){__uint_as_float(w.z << 16), __uint_as_float(w.z & 0xffff0000u), __uint_as_float(w.w << 16), __uint_as_float(w.w & 0xffff0000u)}; }
__device__ __forceinline__ void post_strip(const Args& A, int m0, int R, int part, int lane) {
    unsigned char* ws = A.ws; const bf16* DNRAW = (const bf16*)(ws + WS_DNRAW);
    const float* wc = (const float*)A.in[I_WDNC]; const float* sdc = (const float*)A.in[I_SDC];
    bf16* dstb = (part == 0 ? (bf16*)(ws + WS_QD) : part == 1 ? (bf16*)(ws + WS_KD) : (bf16*)(ws + WS_VD));
    const bool prompt = m0 < MP; const int b = prompt ? (m0 >> 12) : ((m0 - MP) >> 3), t0 = prompt ? (m0 & 4095) : ((m0 - MP) & 7);
    const int ch = part * 512 + 8 * lane;
    f32x4 w[4][2];
#pragma unroll
    for (int i = 0; i < 4; ++i) { w[i][0] = *(const f32x4*)(wc + i * 1536 + ch); w[i][1] = *(const f32x4*)(wc + i * 1536 + ch + 4); }
    f32x4 x[3][2];
#pragma unroll
    for (int j = 0; j < 3; ++j) { const int tt = t0 - 3 + j;
        if (tt >= 0) { const u32x4 r = *(const u32x4*)(DNRAW + (size_t)(m0 - 3 + j) * 1536 + ch); x[j][0] = bf4lo(r); x[j][1] = bf4hi(r); }
        else if (!prompt) { const float* p = sdc + ((size_t)b * 3 + (3 + tt)) * 1536 + ch; x[j][0] = *(const f32x4*)p; x[j][1] = *(const f32x4*)(p + 4); }
        else { x[j][0] = (f32x4){0.f, 0.f, 0.f, 0.f}; x[j][1] = x[j][0]; } }
    const bf16* src = DNRAW + (size_t)m0 * 1536 + ch;
    u32x4 nx = *(const u32x4*)src;
    for (int r = 0; r < R; ++r) {
        const u32x4 cw = nx;
        if (r + 1 < R) nx = *(const u32x4*)(src + (size_t)(r + 1) * 1536);
        const f32x4 c0 = bf4lo(cw), c1 = bf4hi(cw);
        f32x4 y0 = w[0][0] * x[0][0] + w[1][0] * x[1][0] + w[2][0] * x[2][0] + w[3][0] * c0;
        f32x4 y1 = w[0][1] * x[0][1] + w[1][1] * x[1][1] + w[2][1] * x[2][1] + w[3][1] * c1;
        x[0][0] = x[1][0]; x[0][1] = x[1][1]; x[1][0] = x[2][0]; x[1][1] = x[2][1]; x[2][0] = c0; x[2][1] = c1;
        y0.x = siluf(y0.x); y0.y = siluf(y0.y); y0.z = siluf(y0.z); y0.w = siluf(y0.w); y1.x = siluf(y1.x); y1.y = siluf(y1.y); y1.z = siluf(y1.z); y1.w = siluf(y1.w);
        if (part < 2) {
            float ss = (y0.x * y0.x + y0.y * y0.y) + (y0.z * y0.z + y0.w * y0.w) + (y1.x * y1.x + y1.y * y1.y) + (y1.z * y1.z + y1.w * y1.w);
            ss += __shfl_xor(ss, 1); ss += __shfl_xor(ss, 2); ss += __shfl_xor(ss, 4); ss += __shfl_xor(ss, 8);
            const float rs = (part == 0 ? 0.08838834764831845f : 1.0f) / sqrtf(ss + EPS);
            y0 = y0 * rs; y1 = y1 * rs;
        }
        *(u32x4*)(dstb + (size_t)(m0 + r) * DNW + 8 * lane) = pack8(y0, y1);
    }
}
__device__ __forceinline__ void phase_post(const Args& A, int gw, int NGW, int lane, int gtid, int NGT) {
    constexpr int NPI = (MP / 16) * 3, NSI = BS * 3;
    for (int it = gw; it < NPI + NSI; it += NGW) {
        if (it < NPI) post_strip(A, (it / 3) * 16, 16, it % 3, lane);
        else { const int j = it - NPI; post_strip(A, MP + (j / 3) * 8, 8, j % 3, lane); }
    }
    unsigned char* ws = A.ws; const float* a_log = (const float*)A.in[I_ALOG]; const float* dtb = (const float*)A.in[I_DTB];
    float* BETA = (float*)(ws + WS_BETA); float* LOGA = (float*)(ws + WS_LOGA); const float* EXTRA = (const float*)(ws + WS_EXTRA);
    for (int i = gtid; i < M * 8; i += NGT) { const int m = i >> 3, j = i & 7; const float x = EXTRA[i];
        if (j < 4) BETA[m * 4 + j] = 1.f / (1.f + __expf(-x));
        else { const int h = j - 4; const float z = x + dtb[h]; const float sp = fmaxf(z, 0.f) + log1pf(__expf(-fabsf(z))); LOGA[m * 4 + h] = -__expf(a_log[h]) * sp; } }
}

template <int B0, int B1> __device__ __forceinline__ void subst_rows(float (&x)[64], const LAS float* Am) {
#pragma unroll
    for (int ib = B0; ib < B1; ++ib) {
        float r[4];
#pragma unroll
        for (int rr = 0; rr < 4; ++rr) r[rr] = x[4 * ib + rr];
#pragma unroll
        for (int j4 = 0; j4 < ib; ++j4) {
#pragma unroll
            for (int rr = 0; rr < 4; ++rr) { const f32x4 a = *(const LAS f32x4*)(Am + (4 * ib + rr) * 64 + 4 * j4);
                r[rr] -= (a.x * x[4 * j4] + a.y * x[4 * j4 + 1]) + (a.z * x[4 * j4 + 2] + a.w * x[4 * j4 + 3]); }
        }
        const f32x4 d1 = *(const LAS f32x4*)(Am + (4 * ib + 1) * 64 + 4 * ib), d2 = *(const LAS f32x4*)(Am + (4 * ib + 2) * 64 + 4 * ib), d3 = *(const LAS f32x4*)(Am + (4 * ib + 3) * 64 + 4 * ib);
        r[1] -= d1.x * r[0];
        r[2] -= d2.x * r[0] + d2.y * r[1];
        r[3] -= (d3.x * r[0] + d3.y * r[1]) + d3.z * r[2];
#pragma unroll
        for (int rr = 0; rr < 4; ++rr) x[4 * ib + rr] = r[rr];
    }
}
constexpr int PS_INT = 34816, PS_STG = 53248;
template <int LEVEL = 0>
__device__ __forceinline__ void dn_prescan_unit(const Args& A, LAS unsigned char* lds, int unit, int tid, int wave, int lane) {
    unsigned char* ws = A.ws;
    const bf16* QD = (const bf16*)(ws + WS_QD); const bf16* KD = (const bf16*)(ws + WS_KD); const bf16* VD = (const bf16*)(ws + WS_VD);
    const float* BETA = (const float*)(ws + WS_BETA); const float* LOGA = (const float*)(ws + WS_LOGA);
    const int hp = unit & 1, n = (unit >> 1) & 63, b = unit >> 7;
    const int half = tid >> 8, ht = tid & 255, h = 2 * hp + half, item = (b * 64 + n) * 4 + h;
    const int m0 = b * TP + n * 64;
    LAS float* Am = (LAS float*)lds + half * 4096;
    LAS float* gs = (LAS float*)(lds + 32768) + half * 128;
    if (ht < 64) {
        float v = LOGA[(size_t)(m0 + ht) * 4 + h];
#pragma unroll
        for (int o = 1; o < 64; o <<= 1) { const float u = __shfl_up(v, o); if (ht >= o) v += u; }
        gs[ht] = v; gs[64 + ht] = BETA[(size_t)(m0 + ht) * 4 + h];
    }
    __syncthreads();
    {
        const int wl = wave & 3, lr = lane & 15, q = lane >> 4;
        pg8::f32x4 kk[4], qk[4];
#pragma unroll
        for (int j = 0; j < 4; ++j) { kk[j] = (pg8::f32x4){0.f, 0.f, 0.f, 0.f}; qk[j] = kk[j]; }
#pragma unroll
        for (int s = 0; s < 4; ++s) {
            const bf16x8 ak = *(const bf16x8*)(KD + (size_t)(m0 + 16 * wl + lr) * DNW + h * 128 + 32 * s + 8 * q), aq = *(const bf16x8*)(QD + (size_t)(m0 + 16 * wl + lr) * DNW + h * 128 + 32 * s + 8 * q);
#pragma unroll
            for (int j = 0; j < 4; ++j) { const bf16x8 bk = *(const bf16x8*)(KD + (size_t)(m0 + 16 * j + lr) * DNW + h * 128 + 32 * s + 8 * q);
                kk[j] = __builtin_amdgcn_mfma_f32_16x16x32_bf16(ak, bk, kk[j], 0, 0, 0); qk[j] = __builtin_amdgcn_mfma_f32_16x16x32_bf16(aq, bk, qk[j], 0, 0, 0); }
        }
#pragma unroll
        for (int j = 0; j < 4; ++j)
#pragma unroll
            for (int r = 0; r < 4; ++r) { const int i = 16 * wl + 4 * q + r, jj = 16 * j + lr;
                const float dec = (i >= jj) ? __expf(gs[i] - gs[jj]) : 0.f;
                Am[i * 64 + jj] = (i > jj) ? gs[64 + i] * kk[j][r] * dec : 0.f;
                *(LAS bf16*)(lds + PS_INT + half * 9216 + i * 144 + jj * 2) = f2bf(qk[j][r] * dec); }
    }
    __syncthreads();
    if constexpr (LEVEL == 1) { __syncthreads(); return; }
    {
        const int c = ht;
        float* U = (float*)(ws + WS_U) + (size_t)item * 8192; bf16* KC = (bf16*)(ws + WS_KCUM) + (size_t)item * 8192;
        float x[64];
        { const bf16* rsrc = (ht < 128 ? VD : KD) + (size_t)m0 * DNW + h * 128 + (ht & 127);
#pragma unroll
          for (int i = 0; i < 64; ++i) x[i] = bf2f(rsrc[(size_t)i * DNW]); }
#pragma unroll
        for (int i = 0; i < 64; ++i) { const float eg = __expf(gs[i]); x[i] *= gs[64 + i] * (c >= 128 ? eg : 1.0f); }
        { bf16* INTRA = (bf16*)(ws + WS_INTRA) + (size_t)item * 4096;
#pragma unroll
          for (int j = 0; j < 2; ++j) { const int k = ht + 256 * j, row = k >> 3, c8 = (k & 7) * 8; *(u32x4*)(INTRA + row * 64 + c8) = *(const LAS u32x4*)(lds + PS_INT + half * 9216 + row * 144 + c8 * 2); } }
        subst_rows<0, 6>(x, Am); subst_rows<6, 10>(x, Am); subst_rows<10, 13>(x, Am); subst_rows<13, 16>(x, Am);
        if constexpr (LEVEL == 2) { float sk = 0.f; _Pragma("unroll") for (int i = 0; i < 64; ++i) sk += x[i]; asm volatile("" :: "v"(sk)); __syncthreads(); return; }
        LAS float* stg = (LAS float*)(lds + PS_STG + half * 33280);
#pragma unroll
        for (int ps = 0; ps < 2; ++ps) {
            if (ps) __syncthreads();
#pragma unroll
            for (int i = 0; i < 32; ++i) stg[i * 260 + c] = x[32 * ps + i];
            __syncthreads();
#pragma unroll
            for (int j = 0; j < 4; ++j) { const int k = ht + 256 * j, il = k >> 9, w_ = (k >> 6) & 7, ln = k & 63, rb = 16 * il + 4 * (ln >> 4), cc = 16 * w_ + (ln & 15);
                *(f32x4*)(U + (((2 * ps + il) * 8 + w_) * 64 + ln) * 4) = (f32x4){stg[rb * 260 + cc], stg[(rb + 1) * 260 + cc], stg[(rb + 2) * 260 + cc], stg[(rb + 3) * 260 + cc]}; }
#pragma unroll
            for (int j = 0; j < 2; ++j) { const int k = ht + 256 * j, row = k >> 4, c8 = (k & 15) * 8; const LAS float* sp = stg + row * 260 + 128 + c8;
                *(u32x4*)(KC + (32 * ps + row) * 128 + c8) = pack8(*(const LAS f32x4*)sp, *(const LAS f32x4*)(sp + 4)); }
        }
    }
    if constexpr (LEVEL == 3) { __syncthreads(); return; }
    {
        const float glast = gs[63];
        bf16* QDc = (bf16*)(ws + WS_QDEC) + (size_t)item * 8192; bf16* KT = (bf16*)(ws + WS_KDECT) + (size_t)item * 8192;
#pragma unroll
        for (int j = 0; j < 4; ++j) { const int k = ht + 256 * j, row = k >> 4, c8 = (k & 15) * 8; const u32x4 qw = *(const u32x4*)(QD + (size_t)(m0 + row) * DNW + h * 128 + c8); const float eg = __expf(gs[row]);
            *(u32x4*)(QDc + row * 128 + c8) = pack8(bf4lo(qw) * eg, bf4hi(qw) * eg); }
        { const int d = ht & 127, ig = ht >> 7;
#pragma unroll
            for (int i8 = 0; i8 < 4; ++i8) { float v[8];
#pragma unroll
                for (int k = 0; k < 8; ++k) { const int i = 32 * ig + 8 * i8 + k; v[k] = bf2f(KD[(size_t)(m0 + i) * DNW + h * 128 + d]) * __expf(glast - gs[i]); }
                u32x4 w; w.x = cvtpk(v[0], v[1]); w.y = cvtpk(v[2], v[3]); w.z = cvtpk(v[4], v[5]); w.w = cvtpk(v[6], v[7]);
                *(u32x4*)(KT + d * 64 + 32 * ig + 8 * i8) = w; } }
        if (ht == 0) ((float*)(ws + WS_GL))[item] = __expf(glast);
    }
    __syncthreads();
}
__device__ __forceinline__ void dn_sample_unit(const Args& A, LAS unsigned char* lds, int unit, int tid) {
    unsigned char* ws = A.ws;
    const bf16* QD = (const bf16*)(ws + WS_QD);
    const float* BETA = (const float*)(ws + WS_BETA); const float* LOGA = (const float*)(ws + WS_LOGA); float* ODN = (float*)(ws + WS_ODN);
    const int h = unit & 3, b = unit >> 2, e = tid & 127, dq = tid >> 7;
    const float* s0 = (const float*)A.in[I_SD] + ((size_t)(b * 4 + h) * 128 + 32 * dq) * 128 + e;
    float S[32];
#pragma unroll
    for (int d = 0; d < 32; ++d) S[d] = s0[(size_t)d * 128];
    LAS float* red = (LAS float*)lds; LAS float* red2 = red + 512; LAS float* tk = red + 1024;
#pragma unroll
    for (int j = 0; j < 6; ++j) { const int i = tid + 512 * j, t = i / 384, c = i % 384, part = c >> 7; const int m = MP + b * TS + t;
        const unsigned sel = part == 0 ? 1u : part == 1 ? 0u : 2u;
        tk[i] = bf2f(QD[sel * (unsigned)((WS_KD - WS_QD) / 2) + (unsigned)m * DNW + h * 128 + (c & 127)]); }
    if (tid < 16) { const size_t m = (size_t)(MP + b * TS + (tid >> 1)); tk[3072 + tid] = (tid & 1) ? BETA[m * 4 + h] : __expf(LOGA[m * 4 + h]); }
    __syncthreads();
    for (int t = 0; t < TS; ++t) {
        const int m = MP + b * TS + t;
        const float a = tk[3072 + 2 * t], bt = tk[3072 + 2 * t + 1];
        const LAS float* kp = tk + t * 384 + 32 * dq; const LAS float* qp = kp + 128;
        float kd[32], qd[32];
#pragma unroll
        for (int d4 = 0; d4 < 8; ++d4) { const f32x4 kv = *(const LAS f32x4*)(kp + 4 * d4), qv = *(const LAS f32x4*)(qp + 4 * d4);
            kd[4 * d4] = kv.x; kd[4 * d4 + 1] = kv.y; kd[4 * d4 + 2] = kv.z; kd[4 * d4 + 3] = kv.w; qd[4 * d4] = qv.x; qd[4 * d4 + 1] = qv.y; qd[4 * d4 + 2] = qv.z; qd[4 * d4 + 3] = qv.w; }
        float p0 = 0.f, p1 = 0.f;
#pragma unroll
        for (int d = 0; d < 32; d += 2) { p0 += kd[d] * S[d]; p1 += kd[d + 1] * S[d + 1]; }
        red[dq * 128 + e] = p0 + p1;
        __syncthreads();
        const float kS = (red[e] + red[128 + e]) + (red[256 + e] + red[384 + e]);
        const float dl = bt * (tk[t * 384 + 256 + e] - a * kS);
        float po0 = 0.f, po1 = 0.f;
#pragma unroll
        for (int d = 0; d < 32; d += 2) { S[d] = a * S[d] + kd[d] * dl; po0 += qd[d] * S[d]; S[d + 1] = a * S[d + 1] + kd[d + 1] * dl; po1 += qd[d + 1] * S[d + 1]; }
        red2[dq * 128 + e] = po0 + po1;
        __syncthreads();
        if (dq == 0) ODN[(size_t)m * DNW + h * 128 + e] = (red2[e] + red2[128 + e]) + (red2[256 + e] + red2[384 + e]);
    }
    float* so = A.out + O_SS + ((size_t)(b * 4 + h) * 128 + 32 * dq) * 128 + e;
#pragma unroll
    for (int d = 0; d < 32; ++d) so[(size_t)d * 128] = S[d];
    __syncthreads();
}

constexpr int SC_KC = 0, SC_QD = 17408, SC_KT = 34816, SC_IN = 53248, SC_BUF = 62464;
__device__ __forceinline__ void dn_scan_chain(const Args& A, LAS unsigned char* lds, int chain, int tid, int wave, int lane) {
    unsigned char* ws = A.ws;
    const float* Ub = (const float*)(ws + WS_U); const float* GL = (const float*)(ws + WS_GL); float* ODN = (float*)(ws + WS_ODN);
    const int b = chain >> 2, h = chain & 3, lr = lane & 15, q = lane >> 4, e = 16 * wave + lr;
    int ldst[7];
    { const int c0 = tid, c1 = tid + 512;
      ldst[0] = SC_KC + (c0 >> 4) * 272; ldst[1] = SC_KC + (c1 >> 4) * 272; ldst[2] = SC_QD + (c0 >> 4) * 272; ldst[3] = SC_QD + (c1 >> 4) * 272;
      ldst[4] = SC_KT + (c0 >> 3) * 144; ldst[5] = SC_KT + (c1 >> 3) * 144; ldst[6] = SC_IN + (c0 >> 3) * 144; }
    const int cb_ = tid & 3, hA_ = (8 * ((2 * cb_) & 3) + 4 * (cb_ >> 1)) * 2, hB_ = (8 * ((2 * cb_ + 1) & 3) + 4 * (cb_ >> 1)) * 2;
    const int o16A = ((tid & 15) >> 2) * 64 + hA_, o16B = ((tid & 15) >> 2) * 64 + hB_, o8A = ((tid & 7) >> 2) * 64 + hA_, o8B = ((tid & 7) >> 2) * 64 + hB_;
    const size_t item0 = (size_t)(b * 64) * 4 + h;
    const unsigned char* gKC = ws + WS_KCUM + item0 * 16384; const unsigned char* gQD = ws + WS_QDEC + item0 * 16384; const unsigned char* gKT = ws + WS_KDECT + item0 * 16384; const unsigned char* gIN = ws + WS_INTRA + item0 * 8192;
    const unsigned t16 = (unsigned)tid * 16u, ulane = (unsigned)(wave * 64 + lane) * 4u;
    u32x4 R[7]; float un[16], uc[16];
#define SC_GLOAD(n_) do { const size_t o16_ = (size_t)(n_) * 4 * 16384, o8_ = (size_t)(n_) * 4 * 8192; \
        R[0] = *(const u32x4*)(gKC + o16_ + t16); R[1] = *(const u32x4*)(gKC + o16_ + 8192 + t16); R[2] = *(const u32x4*)(gQD + o16_ + t16); R[3] = *(const u32x4*)(gQD + o16_ + 8192 + t16); \
        R[4] = *(const u32x4*)(gKT + o16_ + t16); R[5] = *(const u32x4*)(gKT + o16_ + 8192 + t16); R[6] = *(const u32x4*)(gIN + o8_ + t16); \
        const float* U_ = Ub + (item0 + 4 * (size_t)(n_)) * 8192; \
        _Pragma("unroll") for (int i_ = 0; i_ < 4; ++i_) { const f32x4 u_ = *(const f32x4*)(U_ + (ulane + (unsigned)(i_ * 2048))); un[4 * i_] = u_.x; un[4 * i_ + 1] = u_.y; un[4 * i_ + 2] = u_.z; un[4 * i_ + 3] = u_.w; } } while (0)
#define SC_LWRITE(buf_) do { _Pragma("unroll") for (int k_ = 0; k_ < 7; ++k_) { LAS unsigned char* d_ = lds + (buf_) * SC_BUF + ldst[k_]; \
        *(LAS u32x2*)(d_ + (k_ < 4 ? o16A : o8A)) = (u32x2){R[k_].x, R[k_].y}; *(LAS u32x2*)(d_ + (k_ < 4 ? o16B : o8B)) = (u32x2){R[k_].z, R[k_].w}; } } while (0)
#define SC_BARRIER() do { asm volatile("s_waitcnt lgkmcnt(0)" ::: "memory"); __builtin_amdgcn_s_barrier(); asm volatile("" ::: "memory"); } while (0)
#define SC_FRAG(off_, pitch_, row_, s_) (*(const LAS bf16x8*)(B + (off_) + (row_) * (pitch_) + (32 * (s_) + 8 * q) * 2))
    pg8::f32x4 S[8];
#pragma unroll
    for (int i = 0; i < 8; ++i) S[i] = (pg8::f32x4){0.f, 0.f, 0.f, 0.f};
    const float glv = GL[item0 + 4 * (size_t)lane];
    __syncthreads();
    SC_GLOAD(0); SC_LWRITE(0);
#pragma unroll
    for (int k = 0; k < 16; ++k) uc[k] = un[k];
    __syncthreads();
    for (int n = 0; n < 64; ++n) {
        const float gl = __uint_as_float(__builtin_amdgcn_readlane(__float_as_uint(glv), n));
        if (n + 1 < 64) SC_GLOAD(n + 1);
        const LAS unsigned char* B = lds + (n & 1) * SC_BUF;
        bf16x8 Sb[4];
#pragma unroll
        for (int s = 0; s < 4; ++s) { u32x4 w; w.x = cvtpk(S[2 * s][0], S[2 * s][1]); w.y = cvtpk(S[2 * s][2], S[2 * s][3]); w.z = cvtpk(S[2 * s + 1][0], S[2 * s + 1][1]); w.w = cvtpk(S[2 * s + 1][2], S[2 * s + 1][3]); Sb[s] = __builtin_bit_cast(bf16x8, w); }
        pg8::f32x4 vn[4], o[4];
#pragma unroll
        for (int ih = 0; ih < 2; ++ih) {
            bf16x8 fk[2][4], fq[2][4];
#pragma unroll
            for (int ii = 0; ii < 2; ++ii)
#pragma unroll
                for (int s = 0; s < 4; ++s) { fk[ii][s] = SC_FRAG(SC_KC, 272, 16 * (2 * ih + ii) + lr, s); fq[ii][s] = SC_FRAG(SC_QD, 272, 16 * (2 * ih + ii) + lr, s); }
#pragma unroll
            for (int ii = 0; ii < 2; ++ii) { const int i = 2 * ih + ii;
                pg8::f32x4 ak = (pg8::f32x4){0.f, 0.f, 0.f, 0.f}, aq = ak;
#pragma unroll
                for (int s = 0; s < 4; ++s) { ak = __builtin_amdgcn_mfma_f32_16x16x32_bf16(fk[ii][s], Sb[s], ak, 0, 0, 0); aq = __builtin_amdgcn_mfma_f32_16x16x32_bf16(fq[ii][s], Sb[s], aq, 0, 0, 0); }
#pragma unroll
                for (int r = 0; r < 4; ++r) vn[i][r] = uc[4 * i + r] - ak[r];
                o[i] = aq; }
        }
        bf16x8 Vb[2];
#pragma unroll
        for (int s = 0; s < 2; ++s) { u32x4 w; w.x = cvtpk(vn[2 * s][0], vn[2 * s][1]); w.y = cvtpk(vn[2 * s][2], vn[2 * s][3]); w.z = cvtpk(vn[2 * s + 1][0], vn[2 * s + 1][1]); w.w = cvtpk(vn[2 * s + 1][2], vn[2 * s + 1][3]); Vb[s] = __builtin_bit_cast(bf16x8, w); }
        {
            bf16x8 fi[4][2], ft[8][2];
#pragma unroll
            for (int i = 0; i < 4; ++i)
#pragma unroll
                for (int s = 0; s < 2; ++s) fi[i][s] = SC_FRAG(SC_IN, 144, 16 * i + lr, s);
#pragma unroll
            for (int i = 0; i < 8; ++i)
#pragma unroll
                for (int s = 0; s < 2; ++s) ft[i][s] = SC_FRAG(SC_KT, 144, 16 * i + lr, s);
#pragma unroll
            for (int i = 0; i < 4; ++i) {
#pragma unroll
                for (int s = 0; s < 2; ++s) o[i] = __builtin_amdgcn_mfma_f32_16x16x32_bf16(fi[i][s], Vb[s], o[i], 0, 0, 0);
                *(f32x4*)(ODN + ((item0 + 4 * (size_t)n) * 8192) + (ulane + (unsigned)(i * 2048))) = (f32x4){o[i][0], o[i][1], o[i][2], o[i][3]};
            }
#pragma unroll
            for (int i = 0; i < 8; ++i) {
                pg8::f32x4 acc = S[i] * gl;
#pragma unroll
                for (int s = 0; s < 2; ++s) acc = __builtin_amdgcn_mfma_f32_16x16x32_bf16(ft[i][s], Vb[s], acc, 0, 0, 0);
                S[i] = acc;
            }
        }
        if (n + 1 < 64) {
            SC_LWRITE((n + 1) & 1);
#pragma unroll
            for (int k = 0; k < 16; ++k) uc[k] = un[k];
        }
        SC_BARRIER();
    }
#undef SC_GLOAD
#undef SC_LWRITE
#undef SC_FRAG
    float* so = A.out + O_SP + (size_t)(b * 4 + h) * 16384;
#pragma unroll
    for (int i = 0; i < 8; ++i)
#pragma unroll
        for (int r = 0; r < 4; ++r) so[(unsigned)((16 * i + 4 * q + r) * 128 + e)] = S[i][r];
}

__device__ __forceinline__ int crow(int r, int hi) { return (r & 3) + 8 * (r >> 2) + 4 * hi; }
__device__ __forceinline__ void sb_core(f32x16& p, float& carry, int hi) {
    float s[16];
#pragma unroll
    for (int r = 0; r < 16; ++r) { const float e = __builtin_amdgcn_exp2f(p[r]); s[r] = -__builtin_amdgcn_logf(1.0f + e); }
    float tt[4], uu[4];
#pragma unroll
    for (int i = 0; i < 4; ++i) { s[4 * i + 2] += s[4 * i + 3]; s[4 * i + 1] += s[4 * i + 2]; s[4 * i] += s[4 * i + 1]; tt[i] = s[4 * i]; }
#pragma unroll
    for (int i = 0; i < 4; ++i) uu[i] = __shfl_xor(tt[i], 32);
    const float w3 = tt[3] + uu[3], w2 = tt[2] + uu[2], w1 = tt[1] + uu[1], w0 = tt[0] + uu[0];
    float off[4];
    off[3] = carry; off[2] = carry + w3; off[1] = off[2] + w2; off[0] = off[1] + w1;
    carry = off[0] + w0;
    if (hi == 0) {
#pragma unroll
        for (int i = 0; i < 4; ++i) off[i] += uu[i];
    }
#pragma unroll
    for (int r = 0; r < 16; ++r) p[r] = __builtin_amdgcn_exp2f(p[r] + s[r] + off[r >> 2]);
}
__device__ __forceinline__ bf16x8 pack_p(const f32x16& p, int s) {
    u32x4 w; w.x = cvtpk(p[8 * s], p[8 * s + 1]); w.y = cvtpk(p[8 * s + 2], p[8 * s + 3]); w.z = cvtpk(p[8 * s + 4], p[8 * s + 5]); w.w = cvtpk(p[8 * s + 6], p[8 * s + 7]); return __builtin_bit_cast(bf16x8, w);
}
constexpr int AW_BYTES = 16384, AW_V = 0, VPI = 192, AW_K = 6144, KPI = 144, AW_Q = 6144, AW_SQ = 10752;
__device__ __forceinline__ void read_vfrags(bf16x8 (&vf)[4], const LAS unsigned char* wl, int lane) {
    const int hi = lane >> 5;
    const LAS unsigned char* vb = wl + AW_V + (4 * hi + ((lane & 15) >> 2)) * VPI + (((lane >> 4) & 1) * 16 + (lane & 3) * 4) * 2;
#pragma unroll
    for (int dt = 0; dt < 2; ++dt) {
        const s16x4 t0 = __builtin_bit_cast(s16x4, __builtin_amdgcn_ds_read_tr16_b64_v4i16((LAS s16x4*)(vb + dt * 64)));
        const s16x4 t1 = __builtin_bit_cast(s16x4, __builtin_amdgcn_ds_read_tr16_b64_v4i16((LAS s16x4*)(vb + dt * 64 + 8 * VPI)));
        const s16x4 t2 = __builtin_bit_cast(s16x4, __builtin_amdgcn_ds_read_tr16_b64_v4i16((LAS s16x4*)(vb + dt * 64 + 16 * VPI)));
        const s16x4 t3 = __builtin_bit_cast(s16x4, __builtin_amdgcn_ds_read_tr16_b64_v4i16((LAS s16x4*)(vb + dt * 64 + 24 * VPI)));
        vf[2 * dt] = (bf16x8){t0[0], t0[1], t0[2], t0[3], t1[0], t1[1], t1[2], t1[3]}; vf[2 * dt + 1] = (bf16x8){t2[0], t2[1], t2[2], t2[3], t3[0], t3[1], t3[2], t3[3]};
    }
}
__device__ __forceinline__ void load_k_prompt(bf16x8 (&k)[4], const bf16* KB, int b, int h, int kv0, int r32, int hi) {
    const bf16* kp = KB + (size_t)(b * TP + kv0 + r32) * SBW + h * HD + 8 * hi;
#pragma unroll
    for (int d0 = 0; d0 < 4; ++d0) k[d0] = *(const bf16x8*)(kp + 16 * d0);
}
__device__ __forceinline__ void load_v_prompt(u32x4 (&v)[4], const bf16* VB, int b, int h, int kv0, int lane) {
    const bf16* vp = VB + (size_t)(b * TP + kv0 + (lane >> 3)) * SBW + h * HD + (lane & 7) * 8;
#pragma unroll
    for (int i = 0; i < 4; ++i) v[i] = *(const u32x4*)(vp + (size_t)(8 * i) * SBW);
}
__device__ __forceinline__ void write_v_lds(LAS unsigned char* wl, const u32x4 (&v)[4], int lane) {
#pragma unroll
    for (int i = 0; i < 4; ++i) *(LAS u32x4*)(wl + AW_V + (8 * i + (lane >> 3)) * VPI + (lane & 7) * 16) = v[i];
}
template <int MASK>
__device__ __forceinline__ void sb_qk(f32x16& p, const bf16x8 (&kf)[4], const bf16x8 (&qf)[4], float bias2, int kv0, int qpos, int hi) {
#pragma unroll
    for (int r = 0; r < 16; ++r) p[r] = bias2;
#pragma unroll
    for (int d0 = 0; d0 < 4; ++d0) p = __builtin_amdgcn_mfma_f32_32x32x16_bf16(kf[d0], qf[d0], p, 0, 0, 0);
    if (MASK) {
#pragma unroll
        for (int r = 0; r < 16; ++r) if (kv0 + crow(r, hi) >= qpos) p[r] = -INFINITY;
    }
}
__device__ __forceinline__ void sb_pvonly(const f32x16& p, const bf16x8 (&vf)[4], f32x16 (&o)[2]) {
    const bf16x8 p0 = pack_p(p, 0), p1 = pack_p(p, 1);
#pragma unroll
    for (int dt = 0; dt < 2; ++dt) { o[dt] = __builtin_amdgcn_mfma_f32_32x32x16_bf16(vf[2 * dt], p0, o[dt], 0, 0, 0); o[dt] = __builtin_amdgcn_mfma_f32_32x32x16_bf16(vf[2 * dt + 1], p1, o[dt], 0, 0, 0); }
}
__device__ __forceinline__ void sb_pv(f32x16& p, const bf16x8 (&vf)[4], f32x16 (&o)[2], float& carry, int hi) {
    sb_core(p, carry, hi);
    const bf16x8 p0 = pack_p(p, 0), p1 = pack_p(p, 1);
#pragma unroll
    for (int dt = 0; dt < 2; ++dt) { o[dt] = __builtin_amdgcn_mfma_f32_32x32x16_bf16(vf[2 * dt], p0, o[dt], 0, 0, 0); o[dt] = __builtin_amdgcn_mfma_f32_32x32x16_bf16(vf[2 * dt + 1], p1, o[dt], 0, 0, 0); }
}
template <int MASK>
__device__ __forceinline__ void sb_tile(const bf16x8 (&kf)[4], const bf16x8 (&vf)[4], const bf16x8 (&qf)[4], float bias2, f32x16 (&o)[2], float& carry, int kv0, int qpos, int hi) {
    f32x16 p; sb_qk<MASK>(p, kf, qf, bias2, kv0, qpos, hi); sb_pv(p, vf, o, carry, hi);
}
__device__ __forceinline__ void sb_store_prompt(const Args& A, const f32x16 (&o)[2], int b, int h, int qpos, int hi) {
    float ss = 0.f;
#pragma unroll
    for (int dt = 0; dt < 2; ++dt)
#pragma unroll
        for (int r = 0; r < 16; ++r) ss += o[dt][r] * o[dt][r];
    ss += __shfl_xor(ss, 32);
    const float rs = 1.0f / sqrtf(ss * (1.f / HD) + EPS);
    const float* gso = (const float*)A.in[I_GSBO];
    bf16* op = (bf16*)(A.ws + WS_MIXED) + (size_t)(b * TP + qpos) * D + h * HD;
#pragma unroll
    for (int dt = 0; dt < 2; ++dt)
#pragma unroll
        for (int g = 0; g < 4; ++g) { const int d = 32 * dt + 8 * g + 4 * hi; const f32x4 gg = *(const f32x4*)(gso + d);
            u32x2 w; w.x = cvtpk(o[dt][4 * g] * rs * gg.x, o[dt][4 * g + 1] * rs * gg.y); w.y = cvtpk(o[dt][4 * g + 2] * rs * gg.z, o[dt][4 * g + 3] * rs * gg.w); *(u32x2*)(op + d) = w; }
}
__device__ __forceinline__ void attn_prompt_item(const Args& A, LAS unsigned char* wl, int b, int h, int q0, int lane) {
    unsigned char* ws = A.ws;
    const bf16* QB = (const bf16*)(ws + WS_QB); const bf16* KB = (const bf16*)(ws + WS_KB); const bf16* VB = (const bf16*)(ws + WS_VB);
    const int r32 = lane & 31, hi = lane >> 5, qa = q0 + r32, qb = q0 + 32 + r32;
    const float bias2 = ((const float*)A.in[I_SBB])[h] * LOG2E;
#pragma unroll
    for (int d0 = 0; d0 < 4; ++d0) { *(LAS bf16x8*)(wl + AW_Q + (d0 * 64 + lane) * 16) = *(const bf16x8*)(QB + (size_t)(b * TP + qa) * SBW + h * HD + 16 * d0 + 8 * hi);
        *(LAS bf16x8*)(wl + AW_Q + 4096 + (d0 * 64 + lane) * 16) = *(const bf16x8*)(QB + (size_t)(b * TP + qb) * SBW + h * HD + 16 * d0 + 8 * hi); }
#define QFA_LOAD bf16x8 qfa[4]; _Pragma("unroll") for (int d0_ = 0; d0_ < 4; ++d0_) qfa[d0_] = *(const LAS bf16x8*)(wl + AW_Q + (d0_ * 64 + lane) * 16);
#define QFB_LOAD bf16x8 qfb[4]; _Pragma("unroll") for (int d0_ = 0; d0_ < 4; ++d0_) qfb[d0_] = *(const LAS bf16x8*)(wl + AW_Q + 4096 + (d0_ * 64 + lane) * 16);
    f32x16 oa[2], ob[2]; oa[0] = (f32x16){}; oa[1] = (f32x16){}; ob[0] = (f32x16){}; ob[1] = (f32x16){};
    float ca = 0.f, cb = 0.f;
    bf16x8 kc[4], vf[4]; u32x4 vr[4];
    const int top = (q0 >> 5) + 1;
    load_k_prompt(kc, KB, b, h, 32 * top, r32, hi); load_v_prompt(vr, VB, b, h, 32 * top, lane);
    { write_v_lds(wl, vr, lane); load_v_prompt(vr, VB, b, h, 32 * (top - 1), lane);
      f32x16 p; { QFB_LOAD sb_qk<1>(p, kc, qfb, bias2, 32 * top, qb, hi); }
      load_k_prompt(kc, KB, b, h, 32 * (top - 1), r32, hi);
      read_vfrags(vf, wl, lane);
      sb_pv(p, vf, ob, cb, hi); }
    { write_v_lds(wl, vr, lane); if (top >= 2) load_v_prompt(vr, VB, b, h, 32 * (top - 2), lane);
      f32x16 p; { QFA_LOAD sb_qk<1>(p, kc, qfa, bias2, 32 * (top - 1), qa, hi); }
      read_vfrags(vf, wl, lane);
      sb_pv(p, vf, oa, ca, hi);
      { QFB_LOAD sb_qk<0>(p, kc, qfb, bias2, 0, 0, hi); }
      if (top >= 2) load_k_prompt(kc, KB, b, h, 32 * (top - 2), r32, hi);
      sb_pv(p, vf, ob, cb, hi); }
    for (int ht = top - 2; ht >= 0; --ht) {
        write_v_lds(wl, vr, lane);
        f32x16 p, p2; { QFA_LOAD sb_qk<0>(p, kc, qfa, bias2, 0, 0, hi); } { QFB_LOAD sb_qk<0>(p2, kc, qfb, bias2, 0, 0, hi); }
        if (ht > 0) load_k_prompt(kc, KB, b, h, 32 * (ht - 1), r32, hi);
        read_vfrags(vf, wl, lane);
        sb_core(p, ca, hi); sb_pvonly(p, vf, oa);
        __builtin_amdgcn_sched_barrier(0);
        if (ht > 0) load_v_prompt(vr, VB, b, h, 32 * (ht - 1), lane);
        sb_core(p2, cb, hi); sb_pvonly(p2, vf, ob);
    }
    sb_store_prompt(A, oa, b, h, qa, hi); sb_store_prompt(A, ob, b, h, qb, hi);
#undef QFA_LOAD
#undef QFB_LOAD
}

__device__ __forceinline__ void load_raw_sample(f32x4 (&r)[8], const float* c, size_t base, int h, int lane) {
    const float* p = c + base + (size_t)(lane >> 4) * 512 + h * HD + (lane & 15) * 4;
#pragma unroll
    for (int i = 0; i < 8; ++i) r[i] = *(const f32x4*)(p + (size_t)(4 * i) * 512);
}
__device__ __forceinline__ void write_raw_sample(LAS unsigned char* wl, int off, int pitch, const f32x4 (&r)[8], int lane) {
#pragma unroll
    for (int i = 0; i < 8; ++i) { const int row = 4 * i + (lane >> 4); u32x2 w; w.x = cvtpk(r[i].x, r[i].y); w.y = cvtpk(r[i].z, r[i].w); *(LAS u32x2*)(wl + off + row * pitch + (lane & 15) * 8) = w; }
}
__device__ __forceinline__ void read_kfrags(bf16x8 (&kf)[4], const LAS unsigned char* wl, int r32, int hi) {
#pragma unroll
    for (int d0 = 0; d0 < 4; ++d0) kf[d0] = *(const LAS bf16x8*)(wl + AW_K + r32 * KPI + (16 * d0 + 8 * hi) * 2);
}
__device__ __forceinline__ void attn_sample_store(const Args& A, int b, int h, int part, int lane, const f32x16 (&o)[2], float carry) {
    float* OP = (float*)(A.ws + WS_OPART) + (size_t)((b * SBH + h) * NPART + part) * 512; float* LP = (float*)(A.ws + WS_LPART) + (size_t)((b * SBH + h) * NPART + part) * 8;
    const int r32 = lane & 31, hi = lane >> 5;
    unsigned lo = (unsigned)(r32 * 64 + 4 * hi), ll = (unsigned)r32; asm volatile("" : "+v"(lo), "+v"(ll));
    if (r32 < 8) {
#pragma unroll
        for (int dt = 0; dt < 2; ++dt)
#pragma unroll
            for (int g = 0; g < 4; ++g) *(f32x4*)(OP + (lo + (unsigned)(32 * dt + 8 * g))) = (f32x4){o[dt][4 * g], o[dt][4 * g + 1], o[dt][4 * g + 2], o[dt][4 * g + 3]};
        if (hi == 0) LP[ll] = carry;
    }
}
__device__ __forceinline__ void attn_sample_job(const Args& A, LAS unsigned char* wl, int b, int h, int sp, int lane) {
    unsigned char* ws = A.ws;
    const int r32 = lane & 31, hi = lane >> 5;
    const float* ck = (const float*)A.in[I_CK]; const float* cv = (const float*)A.in[I_CV]; const int* pt = (const int*)A.in[I_PT] + b * NPAGES;
    const bf16* QB = (const bf16*)(ws + WS_QB);
    const float bias2 = ((const float*)A.in[I_SBB])[h] * LOG2E;
    bf16x8 qf[4];
#pragma unroll
    for (int d0 = 0; d0 < 4; ++d0) { qf[d0] = (bf16x8){0, 0, 0, 0, 0, 0, 0, 0}; if (r32 < TS) qf[d0] = *(const bf16x8*)(QB + (size_t)(MP + b * TS + r32) * SBW + h * HD + 16 * d0 + 8 * hi); }
    f32x16 o[2]; float carry;
    bf16x8 kf[4], vf[4];
    const int tok_hi = (PAST / NSPLIT) * (sp + 1);
    constexpr int NT = PAST / NSPLIT / 32;
    f32x4 rk[8], rv[8];
#define SAMPLE_BASE(j) (((size_t)pt[(tok_hi - 32 * ((j) + 1)) >> 7] * PAGE + ((tok_hi - 32 * ((j) + 1)) & 127)) * 512)
    if (sp == NSPLIT - 1) {
        const bf16* KBn = (const bf16*)(ws + WS_KB) + (size_t)(MP + b * TS) * SBW + h * HD;
#pragma unroll
        for (int d0 = 0; d0 < 4; ++d0) { kf[d0] = (bf16x8){0, 0, 0, 0, 0, 0, 0, 0}; if (r32 < TS) kf[d0] = *(const bf16x8*)(KBn + (size_t)r32 * SBW + 16 * d0 + 8 * hi); }
        u32x4 vr[4];
        vr[0] = *(const u32x4*)((const bf16*)(ws + WS_VB) + (size_t)(MP + b * TS + (lane >> 3)) * SBW + h * HD + (lane & 7) * 8);
        vr[1] = (u32x4){0u, 0u, 0u, 0u}; vr[2] = vr[1]; vr[3] = vr[1];
        write_v_lds(wl, vr, lane);
        read_vfrags(vf, wl, lane);
        o[0] = (f32x16){}; o[1] = (f32x16){}; carry = 0.f;
        sb_tile<1>(kf, vf, qf, bias2, o, carry, 0, r32, hi);
        attn_sample_store(A, b, h, NPART - 1, lane, o, carry);
    }
    f32x4 rk2[8];
    load_raw_sample(rk, ck, SAMPLE_BASE(0), h, lane); load_raw_sample(rv, cv, SAMPLE_BASE(0), h, lane);
    load_raw_sample(rk2, ck, SAMPLE_BASE(1), h, lane);
#pragma unroll
    for (int d0 = 0; d0 < 4; ++d0) *(LAS bf16x8*)(wl + AW_SQ + (d0 * 64 + lane) * 16) = qf[d0];
    o[0] = (f32x16){}; o[1] = (f32x16){}; carry = 0.f;
#define SAMPLE_TILE(RK, jk_, jv_) do { \
        write_raw_sample(wl, AW_K, KPI, RK, lane); write_raw_sample(wl, AW_V, VPI, rv, lane); \
        if ((jk_) < NT) load_raw_sample(RK, ck, SAMPLE_BASE(jk_), h, lane); \
        read_kfrags(kf, wl, r32, hi); read_vfrags(vf, wl, lane); \
        bf16x8 qq[4]; _Pragma("unroll") for (int d0_ = 0; d0_ < 4; ++d0_) qq[d0_] = *(const LAS bf16x8*)(wl + AW_SQ + (d0_ * 64 + lane) * 16); \
        f32x16 p; sb_qk<0>(p, kf, qq, bias2, 0, 0, hi); \
        sb_core(p, carry, hi); \
        __builtin_amdgcn_sched_barrier(0); \
        if ((jv_) < NT) load_raw_sample(rv, cv, SAMPLE_BASE(jv_), h, lane); \
        sb_pvonly(p, vf, o); } while (0)
    for (int j = 0; j < NT; j += 2) {
        SAMPLE_TILE(rk, j + 2, j + 1);
        SAMPLE_TILE(rk2, j + 3, j + 2);
    }
#undef SAMPLE_TILE
#undef SAMPLE_BASE
    attn_sample_store(A, b, h, sp, lane, o, carry);
}

__device__ __forceinline__ void phase_outnorm(const Args& A, int gw, int NGW, int lane) {
    unsigned char* ws = A.ws; const float* ODN = (const float*)(ws + WS_ODN); bf16* MIXED = (bf16*)(ws + WS_MIXED);
    const float* gdn = (const float*)A.in[I_GDNO]; const float* gso = (const float*)A.in[I_GSBO];
    const float* OPb = (const float*)(ws + WS_OPART); const float* LPb = (const float*)(ws + WS_LPART);
    const int c8 = 8 * lane;
    for (int m = gw; m < M; m += NGW) {
        {
            f32x4 a0, a1;
            if (m >= MP) { const float* op = ODN + (size_t)m * DNW + c8; a0 = *(const f32x4*)op; a1 = *(const f32x4*)(op + 4); }
            else { const int t = m & 4095, cch = t & 63, hh = lane >> 4; const size_t it_ = (size_t)((m >> 12) * 64 + (t >> 6)) * 4 + hh;
                const float* op = ODN + it_ * 8192 + ((((cch >> 4) * 8 + ((lane & 15) >> 1)) * 64 + ((cch >> 2) & 3) * 16 + 8 * (lane & 1)) * 4) + (cch & 3);
                a0 = (f32x4){op[0], op[4], op[8], op[12]}; a1 = (f32x4){op[16], op[20], op[24], op[28]}; }
            float ss = (a0.x * a0.x + a0.y * a0.y) + (a0.z * a0.z + a0.w * a0.w) + (a1.x * a1.x + a1.y * a1.y) + (a1.z * a1.z + a1.w * a1.w);
            ss += __shfl_xor(ss, 1); ss += __shfl_xor(ss, 2); ss += __shfl_xor(ss, 4); ss += __shfl_xor(ss, 8);
            const float rs = 1.0f / sqrtf(ss * (1.f / DND) + EPS);
            const f32x4 g0 = *(const f32x4*)(gdn + (c8 & 127)), g1 = *(const f32x4*)(gdn + (c8 & 127) + 4);
            const u32x4 zw = *(const u32x4*)((const bf16*)(ws + WS_ZG) + (size_t)m * DNW + c8); const f32x4 z0 = bf4lo(zw), z1 = bf4hi(zw);
            *(u32x4*)(MIXED + (size_t)m * D + SBW + c8) = pack8(a0 * rs * g0 * z0, a1 * rs * g1 * z1);
        }
        if (m >= MP) {
            const int b = (m - MP) >> 3, t = (m - MP) & 7, h = lane >> 3, d0 = c8 & 63;
            const float* OP = OPb + (size_t)(b * SBH + h) * NPART * 512; const float* LP = LPb + (size_t)(b * SBH + h) * NPART * 8;
            float v[8];
#pragma unroll
            for (int k = 0; k < 8; ++k) v[k] = 0.f;
            float suf = 0.f;
#pragma unroll
            for (int part = NPART - 1; part >= 0; --part) { const float w = __builtin_amdgcn_exp2f(suf);
                const f32x4 pa = *(const f32x4*)(OP + part * 512 + t * 64 + d0), pb = *(const f32x4*)(OP + part * 512 + t * 64 + d0 + 4);
                v[0] += w * pa.x; v[1] += w * pa.y; v[2] += w * pa.z; v[3] += w * pa.w; v[4] += w * pb.x; v[5] += w * pb.y; v[6] += w * pb.z; v[7] += w * pb.w;
                suf += LP[part * 8 + t]; }
            float ss = 0.f;
#pragma unroll
            for (int k = 0; k < 8; ++k) ss += v[k] * v[k];
            ss += __shfl_xor(ss, 1); ss += __shfl_xor(ss, 2); ss += __shfl_xor(ss, 4);
            const float rs = 1.0f / sqrtf(ss * (1.f / HD) + EPS);
            const f32x4 g0 = *(const f32x4*)(gso + d0), g1 = *(const f32x4*)(gso + d0 + 4);
            *(u32x4*)(MIXED + (size_t)m * D + c8) = pack8((f32x4){v[0], v[1], v[2], v[3]} * rs * g0, (f32x4){v[4], v[5], v[6], v[7]} * rs * g1);
        }
    }
}

__device__ __forceinline__ f32x4 cg_conv(const f32x4 w0, const f32x4 w1, const f32x4 w2, const f32x4 x2, const f32x4 x1, const f32x4 x0) { return w0 * x2 + w1 * x1 + w2 * x0; }
__device__ __forceinline__ void upfix_rows(const Args& A, const bf16* own0, const bf16* own1, bool hbf, const void* h2v, const void* h3v, bool hzero, bf16* act0, bf16* act1, int c) {
    const float* wf = (const float*)A.in[I_WFC];
    f32x4 wu[3][2], wg[3][2];
#pragma unroll
    for (int i = 0; i < 3; ++i) { const float* wp = wf + (size_t)i * DFF2 + c; wu[i][0] = *(const f32x4*)wp; wu[i][1] = *(const f32x4*)(wp + 4); wg[i][0] = *(const f32x4*)(wp + DFF); wg[i][1] = *(const f32x4*)(wp + DFF + 4); }
    f32x4 u2[2], u3[2], g2[2], g3[2];
    if (hzero) { u2[0] = (f32x4){0.f, 0.f, 0.f, 0.f}; u2[1] = u2[0]; u3[0] = u2[0]; u3[1] = u2[0]; g2[0] = u2[0]; g2[1] = u2[0]; g3[0] = u2[0]; g3[1] = u2[0]; }
    else if (hbf) { const bf16* h2 = (const bf16*)h2v; const bf16* h3 = (const bf16*)h3v; const u32x4 a = *(const u32x4*)(h2 + c), b = *(const u32x4*)(h3 + c), d = *(const u32x4*)(h2 + DFF + c), e = *(const u32x4*)(h3 + DFF + c);
        u2[0] = bf4lo(a); u2[1] = bf4hi(a); u3[0] = bf4lo(b); u3[1] = bf4hi(b); g2[0] = bf4lo(d); g2[1] = bf4hi(d); g3[0] = bf4lo(e); g3[1] = bf4hi(e); }
    else { const float* h2 = (const float*)h2v; const float* h3 = (const float*)h3v;
        u2[0] = *(const f32x4*)(h2 + c); u2[1] = *(const f32x4*)(h2 + c + 4); u3[0] = *(const f32x4*)(h3 + c); u3[1] = *(const f32x4*)(h3 + c + 4);
        g2[0] = *(const f32x4*)(h2 + DFF + c); g2[1] = *(const f32x4*)(h2 + DFF + c + 4); g3[0] = *(const f32x4*)(h3 + DFF + c); g3[1] = *(const f32x4*)(h3 + DFF + c + 4); }
    const u32x4 o0u = *(const u32x4*)(own0 + c), o0g = *(const u32x4*)(own0 + DFF + c), o1u = *(const u32x4*)(own1 + c), o1g = *(const u32x4*)(own1 + DFF + c);
    const f32x4 a0[2] = {bf4lo(o0u), bf4hi(o0u)}, b0[2] = {bf4lo(o0g), bf4hi(o0g)}, a1[2] = {bf4lo(o1u), bf4hi(o1u)}, b1[2] = {bf4lo(o1g), bf4hi(o1g)};
    f32x4 r0[2], r1[2];
#pragma unroll
    for (int k = 0; k < 2; ++k) {
        f32x4 yu = cg_conv(wu[0][k], wu[1][k], wu[2][k], u2[k], u3[k], a0[k]), yg = cg_conv(wg[0][k], wg[1][k], wg[2][k], g2[k], g3[k], b0[k]);
        yg.x = siluf(yg.x); yg.y = siluf(yg.y); yg.z = siluf(yg.z); yg.w = siluf(yg.w); r0[k] = yg * yu;
        yu = cg_conv(wu[0][k], wu[1][k], wu[2][k], u3[k], a0[k], a1[k]); yg = cg_conv(wg[0][k], wg[1][k], wg[2][k], g3[k], b0[k], b1[k]);
        yg.x = siluf(yg.x); yg.y = siluf(yg.y); yg.z = siluf(yg.z); yg.w = siluf(yg.w); r1[k] = yg * yu;
    }
    *(u32x4*)(act0 + c) = pack8(r0[0], r0[1]); *(u32x4*)(act1 + c) = pack8(r1[0], r1[1]);
}
__device__ __forceinline__ void phase_upfix(const Args& A, int gw, int NGW, int lane) {
    unsigned char* ws = A.ws; const bf16* SIDEP = (const bf16*)(ws + WS_SIDEP); const bf16* SIDES = (const bf16*)(ws + WS_SIDES); bf16* ACT = (bf16*)(ws + WS_ACT);
    const float* sfc = (const float*)A.in[I_SFC];
    constexpr int NPB = MP / 64, NPI = NPB * 6, NSI = BS * 6;
    for (int it = gw; it < NPI + NSI; it += NGW) {
        const int cgp = it % 6, idx = it / 6; const int c = (cgp * 64 + lane) * 8;
        if (c >= DFF) continue;
        if (it < NPI) { const int kb = idx; const bf16* sp = SIDEP + (size_t)kb * 4 * DFF2;
            upfix_rows(A, sp, sp + DFF2, true, sp - 2 * DFF2, sp - DFF2, (kb & 63) == 0, ACT + (size_t)(kb * 64) * DFF, ACT + (size_t)(kb * 64 + 1) * DFF, c);
            if ((kb & 63) == 63) { const int b = kb >> 6; float* fo = A.out + O_FCP + (size_t)b * 2 * DFF2 + c;
#pragma unroll
                for (int r = 0; r < 2; ++r) { const u32x4 a = *(const u32x4*)(sp + (2 + r) * DFF2 + c), g = *(const u32x4*)(sp + (2 + r) * DFF2 + DFF + c);
                    *(f32x4*)(fo + r * DFF2) = bf4lo(a); *(f32x4*)(fo + r * DFF2 + 4) = bf4hi(a); *(f32x4*)(fo + r * DFF2 + DFF) = bf4lo(g); *(f32x4*)(fo + r * DFF2 + DFF + 4) = bf4hi(g); } }
        } else { const int seq = (it - NPI) / 6; const bf16* sp = SIDES + (size_t)seq * 2 * DFF2; const float* st = sfc + (size_t)seq * 2 * DFF2;
            upfix_rows(A, sp, sp + DFF2, false, st, st + DFF2, false, ACT + (size_t)(MP + seq * 8) * DFF, ACT + (size_t)(MP + seq * 8 + 1) * DFF, c); }
    }
}

__device__ __forceinline__ void phase_slabsum(const Args& A, int gw, int NGW, int lane) {
    unsigned char* ws = A.ws; const float* slab = (const float*)(ws + WS_SLAB); const float* X1 = (const float*)(ws + WS_X1); const float* MOD = (const float*)(ws + WS_MOD);
    for (int r = gw; r < MS; r += NGW) {
        const int m = MP + r; const float* mod = MOD + (size_t)mod_row(m) * NMOD + 5120;
#pragma unroll
        for (int j = 0; j < 4; ++j) { const int c = 4 * (lane + 64 * j); f32x4 a = (f32x4){0.f, 0.f, 0.f, 0.f};
#pragma unroll
            for (int k = 0; k < DFF / 256; ++k) a += *(const f32x4*)(slab + ((size_t)k * MS + r) * D + c);
            *(f32x4*)(A.out + (size_t)m * D + c) = *(const f32x4*)(X1 + (size_t)m * D + c) + *(const f32x4*)(mod + c) * a; }
    }
}

constexpr int NPHASE = 14;
#ifndef PROBE_LEVEL
#define PROBE_LEVEL 0
#endif
#ifndef REP_MASK
#define REP_MASK 0
#endif

__global__ void __launch_bounds__(512, 2) fwd_kernel(Args A) {
    extern __shared__ __attribute__((aligned(16))) unsigned char lds_raw[];
    LAS unsigned char* lds = (LAS unsigned char*)lds_raw;
    const int wave = __builtin_amdgcn_readfirstlane((int)threadIdx.x >> 6);
    const int G = gridDim.x, bx = blockIdx.x;
    const int gw = bx * 8 + wave, NGW = G * 8, NGT = G * 512;
    unsigned char* ws = A.ws;
    gu32* ctl = (gu32*)(ws + WS_CTL);
    volatile LAS unsigned* MISC = (volatile LAS unsigned*)(lds + MISC_OFF);
    { const int t0 = wave * 64 + lane_now(); for (int u = t0; u < (LDS_BYTES - RING_BYTES) / 4; u += 512) ((LAS unsigned*)(lds + RING_BYTES))[u] = 0u; }
    __syncthreads();
    const int lo = A.lo, hi = A.hi;
    const bool multi = (hi - lo) > 1;
    XcdBarrier bar; bar.bar = (unsigned*)(ctl + CW_BAR); bar.x = 0; bar.st = nullptr;
    if (multi) bar = xcd_barrier_post((unsigned*)(ctl + CW_BAR), MISC + 8, wave * 64 + lane_now());
#define IN(k) (lo <= (k) && (k) < hi)
#define GBAR() xcd_barrier(bar, wave * 64 + lane_now())
#define SEAM(k) do { if (IN(k) && IN((k) + 1)) GBAR(); } while (0)
    float* MOD = (float*)(ws + WS_MOD);

#define PH0(rep_) phase_prologue(A, lds, ctl + CW_Q0 + 64 * (rep_), bx, G, wave, lane, gtid, NGT);
#define PH1(rep_) ;
#define PH2(rep_) phase_norm<true>((const float*)A.in[I_XP], (const float*)A.in[I_XS], (const float*)A.in[I_GATT], MOD, 0, 1024, (bf16*)(ws + WS_H), (const float*)(ws + WS_WINX), (float*)(ws + WS_EXTRA), gw, NGW, lane);
#define PH3(rep_) { pg8::Gemm g{(const pg8::bf16_t*)(ws + WS_H), (const pg8::bf16_t*)(ws + WS_WIN_T), M, NPROJ, D, D}; pg8::StaticOrder S; S.init(M, NPROJ, G, bx); \
          EpiProj E{A.out, (bf16*)(ws + WS_QB), (bf16*)(ws + WS_KB), (bf16*)(ws + WS_VB), (bf16*)(ws + WS_DNRAW), (bf16*)(ws + WS_ZG), (const float*)A.in[I_GQ], (const float*)A.in[I_GK], (LAS float*)(lds + RING_BYTES + 1024)}; \
          pg8::gemm_phase<EpiProj, pg8::StaticOrder, true, true>(lds, g, S, E, tid); }
#define PH4(rep_) phase_post(A, gw, NGW, lane, gtid, NGT);
#define PH5(rep_) for (int u = bx; u < 1024; u += G) { if (u < 512) dn_prescan_unit(A, lds, u, tid, wave, lane); else dn_sample_unit(A, lds, u - 512, tid); }
#define PH6(rep_) PH6X(rep_, true, true, true)
#define PH6X(rep_, DS_, DP_, DA_) { if ((DS_) && bx < 16) dn_scan_chain(A, lds, bx, tid, wave, lane); \
          \
        bool moreP = (DP_), moreS = (DA_); const bool pfirst = wave < 4; \
        gu32* qbase_ = ctl + CW_QUEUE + 1024 * (rep_);     \
        const int shard0_ = (int)(xb_xcc_id() & 7u); int offP_ = 0, offS_ = 0;     \
        for (;;) { \
            int job = -1; bool isP = false; \
            if (pfirst && moreP) { const int sh_ = (shard0_ + offP_) & 7; unsigned j_ = 0; if (lane == 0) j_ = __hip_atomic_fetch_add(qbase_ + 64 * sh_, 1u, RLX_AGENT); j_ = __builtin_amdgcn_readfirstlane(j_); if (j_ < 256u) { job = (int)j_ * 8 + sh_; isP = true; } else if (++offP_ == 8) moreP = false; } \
            if (job < 0 && moreS && !(pfirst && moreP)) { const int sh_ = (shard0_ + offS_) & 7; unsigned j_ = 0; if (lane == 0) j_ = __hip_atomic_fetch_add(qbase_ + 512 + 64 * sh_, 1u, RLX_AGENT); j_ = __builtin_amdgcn_readfirstlane(j_); if (j_ < 512u) { job = (int)j_ * 8 + sh_; } else if (++offS_ == 8) moreS = false; } \
            if (job < 0 && !pfirst && !moreS && moreP) { const int sh_ = (shard0_ + offP_) & 7; unsigned j_ = 0; if (lane == 0) j_ = __hip_atomic_fetch_add(qbase_ + 64 * sh_, 1u, RLX_AGENT); j_ = __builtin_amdgcn_readfirstlane(j_); if (j_ < 256u) { job = (int)j_ * 8 + sh_; isP = true; } else if (++offP_ == 8) moreP = false; } \
            if (job < 0) { if (!moreP && !moreS) break; else continue; } \
            if (isP) { const int qb = 63 - (job >> 5), bh = job & 31; attn_prompt_item(A, lds + wave * AW_BYTES, bh >> 3, bh & 7, qb * 64, lane); } \
            else { const int h_ = job & 7, bs_ = job >> 3; attn_sample_job(A, lds + wave * AW_BYTES, bs_ >> 2, h_, bs_ & 3, lane); } \
        } }
#define PH7(rep_) phase_outnorm(A, gw, NGW, lane);
#define PH8(rep_) { { pg8::Gemm g{(const pg8::bf16_t*)(ws + WS_MIXED), (const pg8::bf16_t*)(ws + WS_WOUT_T), MP, D, D, D}; pg8::StaticOrder S; S.init(MP, D, G, bx); \
        EpiResGate E{(const float*)A.in[I_XP], (const float*)A.in[I_XS], MOD, 2048, (float*)(ws + WS_X1)}; \
        pg8::gemm_phase<EpiResGate, pg8::StaticOrder, true, true>(lds, g, S, E, tid); } \
        __syncthreads(); \
        { pg8::Gemm g{(const pg8::bf16_t*)(ws + WS_MIXED), (const pg8::bf16_t*)(ws + WS_WOUT_T), M, D, 256, D}; SplitKOrder S{D / 256, G, bx};     \
        EpiSlab E{(float*)(ws + WS_SLAB)}; \
        pg8::gemm_phase<EpiSlab, SplitKOrder, true, true>(lds, g, S, E, tid); } }
#define PH9(rep_) phase_norm<false, 4>((const float*)(ws + WS_X1), (const float*)A.in[I_XS], (const float*)A.in[I_GFFN], MOD, 3072, 4096, (bf16*)(ws + WS_H), nullptr, nullptr, gw, NGW, lane, (const float*)(ws + WS_SLAB), 2048, (float*)(ws + WS_X1));
#define PH10(rep_) { pg8::Gemm g{(const pg8::bf16_t*)(ws + WS_H), (const pg8::bf16_t*)(ws + WS_WUP_T), M, DFF2, D, D}; pg8::StaticOrder S; S.init(M, DFF2, G, bx); \
        EpiUp E{(bf16*)(ws + WS_ACT), (bf16*)(ws + WS_SIDEP), (bf16*)(ws + WS_SIDES), (const float*)A.in[I_WFC], A.out}; \
        pg8::gemm_phase<EpiUp, pg8::StaticOrder, true, true>(lds, g, S, E, tid); }
#define PH11(rep_) phase_upfix(A, gw, NGW, lane);
#define PH12(rep_) { { pg8::Gemm g{(const pg8::bf16_t*)(ws + WS_ACT), (const pg8::bf16_t*)(ws + WS_WDN_T), MP, D, DFF, DFF}; pg8::StaticOrder S; S.init(MP, D, G, bx); \
        EpiResGate E{(const float*)(ws + WS_X1), (const float*)(ws + WS_X1) + (size_t)MP * D, MOD, 5120, A.out}; \
        pg8::gemm_phase<EpiResGate, pg8::StaticOrder, true, true>(lds, g, S, E, tid); } \
        __syncthreads(); \
        { pg8::Gemm g{(const pg8::bf16_t*)(ws + WS_ACT), (const pg8::bf16_t*)(ws + WS_WDN_T), M, D, 256, DFF}; SplitKOrder S{DFF / 256, G, bx}; \
        EpiSlab E{(float*)(ws + WS_SLAB)}; \
        pg8::gemm_phase<EpiSlab, SplitKOrder, true, true>(lds, g, S, E, tid); } }
#define PH13(rep_) phase_slabsum(A, gw, NGW, lane);
#define RUNPH(k) do { if (IN(k)) { const int lane = lane_now(), tid = wave * 64 + lane, gtid = bx * 512 + tid; (void)gtid; PH##k(0) if constexpr (((REP_MASK) >> (k)) & 1) { GBAR(); PH##k(1) } } } while (0)
    RUNPH(0); SEAM(0);
    RUNPH(2);
    if constexpr (((REP_MASK) >> 20) & 1) { GBAR(); const int lane = lane_now(); phase_norm<false>((const float*)A.in[I_XP], (const float*)A.in[I_XS], (const float*)A.in[I_GATT], MOD, 0, 1024, (bf16*)(ws + WS_H), nullptr, nullptr, gw, NGW, lane); }
    SEAM(2);
    RUNPH(3); SEAM(3);
    RUNPH(4); SEAM(4);
    RUNPH(5);
    if constexpr (((REP_MASK) >> 17) & 1) { GBAR(); const int lane = lane_now(), tid = wave * 64 + lane; for (int u = bx; u < 512; u += G) dn_prescan_unit<PROBE_LEVEL>(A, lds, u, tid, wave, lane); }
    if constexpr (((REP_MASK) >> 18) & 1) { GBAR(); const int lane = lane_now(), tid = wave * 64 + lane; (void)lane; for (int u = bx; u < 512; u += G) dn_sample_unit(A, lds, u, tid); }
    SEAM(5);
    RUNPH(6);
    if constexpr (((REP_MASK) >> 13) & 1) { GBAR(); const int lane = lane_now(), tid = wave * 64 + lane; PH6X(2, true, false, false) }
    if constexpr (((REP_MASK) >> 14) & 1) { GBAR(); const int lane = lane_now(), tid = wave * 64 + lane; PH6X(3, false, true, false) }
    if constexpr (((REP_MASK) >> 15) & 1) { GBAR(); const int lane = lane_now(), tid = wave * 64 + lane; PH6X(4, false, false, true) }
    SEAM(6);
    RUNPH(7); SEAM(7);
    if constexpr (((REP_MASK) >> 19) & 1) { _Pragma("unroll 1") for (int i_ = 0; i_ < 20; ++i_) GBAR(); }
    RUNPH(8); SEAM(8);
    RUNPH(9); SEAM(9);
    RUNPH(10); SEAM(10);
    RUNPH(11); SEAM(11);
    RUNPH(12); SEAM(12);
    RUNPH(13);
#undef IN
#undef SEAM
}

#ifndef N_LAUNCHES
#define N_LAUNCHES 1
#endif
extern "C" void kernel_launch(void* const* d_in, const int* in_sizes, int n_in, void* d_out, int out_size, void* d_ws, size_t ws_size, hipStream_t stream) {
    static int grid = 0;
    if (grid == 0) {
        if (n_in != 27 || (size_t)out_size != O_END || ws_size < WS_END) { fprintf(stderr, "kernel_launch: unexpected shapes: n_in %d out %d ws %zu\n", n_in, out_size, ws_size); grid = -1; return; }
        int dev = 0, cus = 0, per_cu = 0;
        if (hipGetDevice(&dev) != hipSuccess || hipDeviceGetAttribute(&cus, hipDeviceAttributeMultiprocessorCount, dev) != hipSuccess) { grid = -1; return; }
        if (hipFuncSetAttribute((const void*)fwd_kernel, hipFuncAttributeMaxDynamicSharedMemorySize, LDS_BYTES) != hipSuccess) { fprintf(stderr, "kernel_launch: hipFuncSetAttribute failed\n"); grid = -1; return; }
        if (hipOccupancyMaxActiveBlocksPerMultiprocessor(&per_cu, (const void*)fwd_kernel, 512, LDS_BYTES) != hipSuccess || per_cu < 1) fprintf(stderr, "kernel_launch: occupancy query says %d\n", per_cu);
        (void)hipGetLastError();
        grid = cus;
    }
    if (grid < 0) return;
    (void)hipMemsetAsync((char*)d_ws + WS_CTL, 0, CTL_ZERO_BYTES, stream);
    Args a{};
    for (int i = 0; i < 27; ++i) a.in[i] = d_in[i];
    a.out = (float*)d_out; a.ws = (unsigned char*)d_ws;
    if (N_LAUNCHES == 1) { a.lo = 0; a.hi = NPHASE; hipLaunchKernelGGL(fwd_kernel, dim3(grid), dim3(512), LDS_BYTES, stream, a); }
    else for (int p = 0; p < NPHASE; ++p) { a.lo = p; a.hi = p + 1; hipLaunchKernelGGL(fwd_kernel, dim3(grid), dim3(512), LDS_BYTES, stream, a); }
}
```

```cpp
#include <hip/hip_runtime.h>
#include <cstdio>
#include <cstdint>
#define REP_MASK 0
#define PROBE_LEVEL 0
namespace pg8 {
#define PG8_LAS __attribute__((address_space(3)))
typedef unsigned short bf16_t;
typedef short bf16x8 __attribute__((ext_vector_type(8)));
typedef float f32x4 __attribute__((ext_vector_type(4)));
typedef unsigned u32x4 __attribute__((ext_vector_type(4)));
constexpr int BM = 256, BK = 64, HALF = 128, HTB = HALF * BK * 2  , STAGE_BYTES = 8 * HTB, NXCD = 8, WGM = 8;

__host__ __device__ __forceinline__ int lds_byte(int r, int c) { const int st = (r >> 4) * 2 + (c >> 5), rr = r & 15, cc = c & 31, ob = rr * 64 + cc * 2; return st * 1024 + (ob ^ (((ob >> 9) & 1) << 5)); }
__host__ __device__ __forceinline__ void stage_rc(int b, int& R, int& C) { const int st = b / 1024, sb = b % 1024, swz = sb ^ (((sb >> 9) & 1) << 5); R = (st >> 1) * 16 + swz / 64; C = (st & 1) * 32 + (swz % 64) / 2; }
__host__ __device__ __forceinline__ int perm32(int rho) { const int n = rho >> 4, i = rho & 15; return 8 * (i >> 2) + 4 * n + (i & 3); }

struct Unit { int pm, pn, ko; };
struct Gemm { const bf16_t* A; const bf16_t* Bt; int M, N, K, ld; };

struct StaticOrder {
    int nM, nN, nwg, G, c;
    __host__ __device__ void init(int M, int N, int G_, int c_) { nM = M / BM; nN = N / BM; nwg = nM * nN; G = G_; c = c_; }
    __host__ __device__ bool next(int i, Unit& u) const {
        const long L = (long)i * G + c; if (L >= nwg) return false;
        int wgid = (int)L; { const int q = nwg / NXCD, r = nwg % NXCD, xcd = wgid % NXCD, off = wgid / NXCD; wgid = (xcd < r ? xcd * (q + 1) : r * (q + 1) + (xcd - r) * q) + off; }
        const int nig = WGM * nN, gid = wgid / nig, fm = gid * WGM, gsz = (nM - fm) < WGM ? (nM - fm) : WGM;
        u.pm = fm + ((wgid % nig) % gsz); u.pn = (wgid % nig) / gsz; u.ko = 0; return true;
    }
    __device__ __forceinline__ void a_ready(const Unit&) const {}
    __device__ __forceinline__ void done(const Unit&) const {}
};

__device__ __forceinline__ unsigned cvt_pk_bf16(float lo, float hi) { unsigned r; asm volatile("v_cvt_pk_bf16_f32 %0, %1, %2" : "=v"(r) : "v"(lo), "v"(hi)); return r; }
typedef float f32x2 __attribute__((ext_vector_type(2)));
__device__ __forceinline__ f32x2 gelu_pk(f32x2 v) {
    const f32x2 av = __builtin_elementwise_abs(v), d = av * 0.2316418882f + 1.0f;
    f32x2 t; t.x = __builtin_amdgcn_rcpf(d.x); t.y = __builtin_amdgcn_rcpf(d.y);
    f32x2 q = t * 0.5307027145f + (-0.7265760135f); q = q * t + 0.7107068705f; q = q * t + (-0.142248368f); q = q * t + 0.127414796f; q = q * t;
    const f32x2 s = (v * v) * (-0.72134752044f);
    f32x2 e; e.x = __builtin_amdgcn_exp2f(s.x); e.y = __builtin_amdgcn_exp2f(s.y);
    const f32x2 m = v * (q * e), r = v - m;
    f32x2 o; o.x = v.x < 0.f ? m.x : r.x; o.y = v.y < 0.f ? m.y : r.y; return o;
}

template <int ACT  > struct EpiBf16 {
    static constexpr bool PERM = true, AFTER_DRAIN = false; static_assert(ACT == 0 || ACT == 1, "EpiBf16: ACT is 0 (none) or 1 (gelu_pk)");
    bf16_t* O; int ldc; const float* bias; int split_cols; size_t split_stride; float scale0;
    __device__ __forceinline__ void operator()(const f32x4 (&acc)[2][2][4][2], const Unit& u, int wr, int wc, int fr, int fq) const {
        const int row0 = u.pm * BM + wr * 64 + fr; int colt = u.pn * BM; bf16_t* base = O;
        float sc = 1.f; if (split_cols) { const int t = colt / split_cols; base += (size_t)t * split_stride; colt -= t * split_cols; if (t == 0) sc = scale0; }
        const int col0 = colt + wc * 32 + 8 * fq, bcol0 = u.pn * BM + wc * 32 + 8 * fq;
        f32x4 bv[2][2];
#pragma unroll
        for (int bj = 0; bj < 2; ++bj)
#pragma unroll
            for (int n = 0; n < 2; ++n) bv[bj][n] = bias ? *(const f32x4*)(bias + bcol0 + bj * HALF + 4 * n) : (f32x4){0.f, 0.f, 0.f, 0.f};
#pragma unroll
        for (int ai = 0; ai < 2; ++ai)
#pragma unroll
            for (int m = 0; m < 4; ++m) { bf16_t* rowp = base + (size_t)(row0 + ai * HALF + m * 16) * ldc + col0;
#pragma unroll
                for (int bj = 0; bj < 2; ++bj) { f32x4 v0 = acc[ai][bj][m][0] + bv[bj][0], v1 = acc[ai][bj][m][1] + bv[bj][1];
                    if (ACT == 1) { f32x2 a = gelu_pk((f32x2){v0[0], v0[1]}), b = gelu_pk((f32x2){v0[2], v0[3]}), c = gelu_pk((f32x2){v1[0], v1[1]}), d = gelu_pk((f32x2){v1[2], v1[3]});
                        v0 = (f32x4){a.x, a.y, b.x, b.y}; v1 = (f32x4){c.x, c.y, d.x, d.y}; }
                    v0 = v0 * sc; v1 = v1 * sc; u32x4 w; w.x = cvt_pk_bf16(v0[0], v0[1]); w.y = cvt_pk_bf16(v0[2], v0[3]); w.z = cvt_pk_bf16(v1[0], v1[1]); w.w = cvt_pk_bf16(v1[2], v1[3]);
                    *(u32x4*)(rowp + bj * HALF) = w; } }
    }
};

struct PanelStats {
    unsigned* xbuf;
    unsigned* cnt;
    unsigned* tmo;
    int ntn; float eps;
    unsigned code;
    __device__ __forceinline__ bool run(const f32x4 (&v)[2][2][4][2], const Unit& u, int wr, int wc, int fr, int fq, PG8_LAS unsigned char* lds, int wid, int lane) const {
        typedef float f32x2v __attribute__((ext_vector_type(2)));
        PG8_LAS f32x2v* P = (PG8_LAS f32x2v*)lds;
        PG8_LAS f32x2v* S = (PG8_LAS f32x2v*)(lds + 8192);
        PG8_LAS unsigned* flag = (PG8_LAS unsigned*)(lds + 8192 + 2048);
#pragma unroll
        for (int ai = 0; ai < 2; ++ai)
#pragma unroll
            for (int m = 0; m < 4; ++m) {
                float s = 0.f;
#pragma unroll
                for (int bj = 0; bj < 2; ++bj)
#pragma unroll
                    for (int n = 0; n < 2; ++n) { const f32x4 x = v[ai][bj][m][n]; s += (x[0] + x[1]) + (x[2] + x[3]); }
                s += __shfl_xor(s, 16); s += __shfl_xor(s, 32);
                const float mw = s * (1.0f / 64.0f); float q = 0.f;
#pragma unroll
                for (int bj = 0; bj < 2; ++bj)
#pragma unroll
                    for (int n = 0; n < 2; ++n) { const f32x4 d = v[ai][bj][m][n] - mw; q += (d[0] * d[0] + d[1] * d[1]) + (d[2] * d[2] + d[3] * d[3]); }
                q += __shfl_xor(q, 16); q += __shfl_xor(q, 32);
                if (fq == 0) P[(ai * HALF + wr * 64 + m * 16 + fr) * 4 + wc] = (f32x2v){mw, q};
            }
        asm volatile("s_waitcnt lgkmcnt(0)" ::: "memory"); __builtin_amdgcn_s_barrier(); asm volatile("" ::: "memory");
#if defined(BROKEN_EXCHANGE_NO_WAIT)
#warning BROKEN CONTROL BUILD: the row-statistics exchange does not wait; results are wrong by design
        if (blockIdx.x >= 64) { const long long t0_ = clock64(); while (clock64() - t0_ < 60000) __builtin_amdgcn_s_sleep(8); }
#endif
        const int row = wid * 32 + (lane & 31);
        if (lane < 32) {
            const f32x2v a = P[row * 4 + 0], b = P[row * 4 + 1], c = P[row * 4 + 2], d = P[row * 4 + 3];
            const float mt = (a.x + b.x + c.x + d.x) * 0.25f;
            const float da = a.x - mt, db = b.x - mt, dc = c.x - mt, dd = d.x - mt;
            const float m2 = (a.y + b.y) + (c.y + d.y) + 64.0f * ((da * da + db * db) + (dc * dc + dd * dd));
            unsigned long long* slot = (unsigned long long*)xbuf + ((size_t)(u.pm * BM + row) * 4 + u.pn);
            __hip_atomic_store(slot, ((unsigned long long)__float_as_uint(m2) << 32) | __float_as_uint(mt), __ATOMIC_RELAXED, __HIP_MEMORY_SCOPE_AGENT);
        }
        asm volatile("s_waitcnt vmcnt(0)" ::: "memory");
        if (lane == 0) __hip_atomic_fetch_add(cnt + 64 * u.pm, 1u, __ATOMIC_RELAXED, __HIP_MEMORY_SCOPE_AGENT);
        if (wid == 0) {
            bool dead = false; const unsigned long long t0 = __builtin_amdgcn_s_memrealtime(); const unsigned want = 8u * (unsigned)ntn;
            for (;;) {
#if defined(BROKEN_EXCHANGE_NO_WAIT)
                break;
#endif
                if ((unsigned)__builtin_amdgcn_readfirstlane(__hip_atomic_load(cnt + 64 * u.pm, __ATOMIC_RELAXED, __HIP_MEMORY_SCOPE_AGENT)) >= want) break;
                if (__builtin_amdgcn_s_memrealtime() - t0 > 2000000ull) {
                    if (lane == 0) { unsigned expect = 0u; __hip_atomic_compare_exchange_strong(tmo + 1, &expect, code | (unsigned)(u.pm & 0xff), __ATOMIC_RELAXED, __ATOMIC_RELAXED, __HIP_MEMORY_SCOPE_AGENT);
                                     __hip_atomic_store(tmo, 1u, __ATOMIC_RELAXED, __HIP_MEMORY_SCOPE_AGENT); }
                    dead = true; break; }
                __builtin_amdgcn_s_sleep(2);
            }
            __builtin_amdgcn_fence(__ATOMIC_ACQUIRE, "agent");
            if (lane == 0) flag[0] = dead ? 1u : 0u;
        }
        asm volatile("s_waitcnt vmcnt(0) lgkmcnt(0)" ::: "memory"); __builtin_amdgcn_s_barrier(); asm volatile("" ::: "memory");
        const bool bad = flag[0] != 0u;
        if (lane < 32) {
            const unsigned long long* slot = (const unsigned long long*)xbuf + (size_t)(u.pm * BM + row) * 4; float mt[4], m2[4]; float ms = 0.f;
#pragma unroll
            for (int t = 0; t < 4; ++t) { if (t < ntn) { const unsigned long long w = __hip_atomic_load(slot + t, __ATOMIC_RELAXED, __HIP_MEMORY_SCOPE_AGENT); mt[t] = __uint_as_float((unsigned)w); m2[t] = __uint_as_float((unsigned)(w >> 32)); } else { mt[t] = 0.f; m2[t] = 0.f; } ms += mt[t]; }
            const float mean = ms / (float)ntn; float q = 0.f;
#pragma unroll
            for (int t = 0; t < 4; ++t) if (t < ntn) { const float dm = mt[t] - mean; q += m2[t] + 256.0f * dm * dm; }
            S[row] = (f32x2v){mean, 1.0f / sqrtf(q / (256.0f * (float)ntn) + eps)};
        }
        asm volatile("s_waitcnt lgkmcnt(0)" ::: "memory"); __builtin_amdgcn_s_barrier(); asm volatile("" ::: "memory");
        return bad;
    }
};
struct EpiLnRes {
    static constexpr bool PERM = false, AFTER_DRAIN = true;
    const float* base; float* out; int ldc; const float* bias; PanelStats st; unsigned poison;
    __device__ __forceinline__ void fused(f32x4 (&acc)[2][2][4][2], const Unit& u, int wr, int wc, int fr, int fq, PG8_LAS unsigned char* lds, int wid, int lane) const {
        typedef float f32x2v __attribute__((ext_vector_type(2)));
        const PG8_LAS f32x2v* S = (const PG8_LAS f32x2v*)(lds + 8192);
        const int col0 = u.pn * BM + wc * 32 + 4 * fq;
#pragma unroll
        for (int bj = 0; bj < 2; ++bj)
#pragma unroll
            for (int n = 0; n < 2; ++n) { const f32x4 bv = bias ? *(const f32x4*)(bias + col0 + bj * HALF + n * 16) : (f32x4){0.f, 0.f, 0.f, 0.f};
#pragma unroll
                for (int ai = 0; ai < 2; ++ai)
#pragma unroll
                    for (int m = 0; m < 4; ++m) acc[ai][bj][m][n] += bv; }
        f32x4 pre[4][2][2];
#pragma unroll
        for (int m = 0; m < 4; ++m) { const size_t off = (size_t)(u.pm * BM + wr * 64 + m * 16 + fr) * ldc + col0;
#pragma unroll
            for (int bj = 0; bj < 2; ++bj)
#pragma unroll
                for (int n = 0; n < 2; ++n) pre[m][bj][n] = *(const f32x4*)(base + off + bj * HALF + n * 16); }
        const bool bad = st.run(acc, u, wr, wc, fr, fq, lds, wid, lane) || poison != 0u;
        const float qnan = __builtin_nanf("");
#pragma unroll
        for (int ai = 0; ai < 2; ++ai)
#pragma unroll
            for (int m = 0; m < 4; ++m) { const int r = ai * HALF + wr * 64 + m * 16 + fr; const f32x2v sr = S[r]; const size_t off = (size_t)(u.pm * BM + r) * ldc + col0;
#pragma unroll
                for (int bj = 0; bj < 2; ++bj)
#pragma unroll
                    for (int n = 0; n < 2; ++n) { const f32x4 bs = ai == 0 ? pre[m][bj][n] : *(const f32x4*)(base + off + bj * HALF + n * 16); f32x4 o = bs + (acc[ai][bj][m][n] - sr.x) * sr.y;
                        if (bad) o = (f32x4){qnan, qnan, qnan, qnan}; *(f32x4*)(out + off + bj * HALF + n * 16) = o; }
                if (m & 1) asm volatile("" ::: "memory"); }
    }
};
struct EpiLnResLn {
    static constexpr bool PERM = false, AFTER_DRAIN = true;
    const float* base; float* out; bf16_t* xn; int ldc; const float* bias; PanelStats st1, st2; unsigned poison;
    __device__ __forceinline__ void fused(f32x4 (&acc)[2][2][4][2], const Unit& u, int wr, int wc, int fr, int fq, PG8_LAS unsigned char* lds, int wid, int lane) const {
        typedef float f32x2v __attribute__((ext_vector_type(2))); typedef unsigned u32x2v __attribute__((ext_vector_type(2)));
        const PG8_LAS f32x2v* S = (const PG8_LAS f32x2v*)(lds + 8192);
        const int col0 = u.pn * BM + wc * 32 + 4 * fq;
#pragma unroll
        for (int bj = 0; bj < 2; ++bj)
#pragma unroll
            for (int n = 0; n < 2; ++n) { const f32x4 bv = bias ? *(const f32x4*)(bias + col0 + bj * HALF + n * 16) : (f32x4){0.f, 0.f, 0.f, 0.f};
#pragma unroll
                for (int ai = 0; ai < 2; ++ai)
#pragma unroll
                    for (int m = 0; m < 4; ++m) acc[ai][bj][m][n] += bv; }
        bool bad = st1.run(acc, u, wr, wc, fr, fq, lds, wid, lane) || poison != 0u;
        const float qnan = __builtin_nanf("");
#pragma unroll
        for (int ai = 0; ai < 2; ++ai)
#pragma unroll
            for (int m = 0; m < 4; ++m) { const int r = ai * HALF + wr * 64 + m * 16 + fr; const f32x2v sr = S[r]; const size_t off = (size_t)(u.pm * BM + r) * ldc + col0;
#pragma unroll
                for (int bj = 0; bj < 2; ++bj)
#pragma unroll
                    for (int n = 0; n < 2; ++n) { const f32x4 bs = *(const f32x4*)(base + off + bj * HALF + n * 16); acc[ai][bj][m][n] = bs + (acc[ai][bj][m][n] - sr.x) * sr.y; }
                asm volatile("" : "+v"(acc[ai][0][m][0]), "+v"(acc[ai][0][m][1]), "+v"(acc[ai][1][m][0]), "+v"(acc[ai][1][m][1]));
                if (m & 1) asm volatile("" ::: "memory"); }
        const bool bad1 = bad;
        bad = st2.run(acc, u, wr, wc, fr, fq, lds, wid, lane) || bad;
#pragma unroll
        for (int ai = 0; ai < 2; ++ai)
#pragma unroll
            for (int m = 0; m < 4; ++m) { const int r = ai * HALF + wr * 64 + m * 16 + fr; const f32x2v sr = S[r]; const size_t off = (size_t)(u.pm * BM + r) * ldc + col0;
#pragma unroll
                for (int bj = 0; bj < 2; ++bj)
#pragma unroll
                    for (int n = 0; n < 2; ++n) { const f32x4 x1 = acc[ai][bj][m][n]; *(f32x4*)(out + off + bj * HALF + n * 16) = bad1 ? (f32x4){qnan, qnan, qnan, qnan} : x1;
                        const f32x4 o = (x1 - sr.x) * sr.y; u32x2v w; w.x = cvt_pk_bf16(o[0], o[1]); w.y = cvt_pk_bf16(o[2], o[3]);
                        if (bad) { w.x = 0x7fc07fc0u; w.y = 0x7fc07fc0u; } *(u32x2v*)(xn + off + bj * HALF + n * 16) = w; }
                asm volatile("" ::: "memory"); }
    }
};

template <class Epi, class Sched, bool ALIGN_EPI = false, bool SP2 = false>
__device__ __forceinline__ void gemm_phase(PG8_LAS unsigned char* lds, const Gemm g, const Sched& S, const Epi& E, const int tid) {
    const int wid = __builtin_amdgcn_readfirstlane(tid >> 6), lane = tid & 63, wr = wid >> 2, wc = wid & 3, fr = lane & 15, fq = lane >> 4;
    const int K = g.K, nt = K / BK;
    unsigned voffA[2], voffB[2];
#pragma unroll
    for (int i = 0; i < 2; ++i) { int R, C; stage_rc(tid * 16 + i * 8192, R, C); const int Rb = Epi::PERM ? ((R & ~31) + perm32(R & 31)) : R;
        voffA[i] = (unsigned)(R * g.ld + C) * 2u; voffB[i] = (unsigned)(Rb * g.ld + C) * 2u; }
    const size_t kstep = (size_t)(BK * 2);
    const size_t hstep = (size_t)HALF * g.ld * 2;
    const size_t tstep = 2 * hstep;
    const unsigned ldsw = (unsigned)wid * 1024u;
    const int aoff = lds_byte(wr * 64 + fr, fq * 8), boff = lds_byte(wc * 32 + fr, fq * 8);
#define PG8_SA(b, h) (((b) * 2 + (h)) * HTB)
#define PG8_SB(b, h) ((4 + (b) * 2 + (h)) * HTB)
#define PG8_STAGE(bufoff, gbase, voff) do { _Pragma("unroll") for (int _i = 0; _i < 2; ++_i) \
        __builtin_amdgcn_global_load_lds((const unsigned*)((const char*)(gbase) + (voff)[_i]), (PG8_LAS unsigned*)(lds + (bufoff) + ldsw + _i * 8192), 16, 0, 0); } while (0)
#define PG8_LDA(dst, b, h) do { _Pragma("unroll") for (int m = 0; m < 4; ++m) _Pragma("unroll") for (int k = 0; k < 2; ++k) dst[m][k] = *(const PG8_LAS bf16x8*)(lds + PG8_SA(b, h) + aoff + m * 2048 + k * 1024); } while (0)
#define PG8_LDB(dst, b, h) do { _Pragma("unroll") for (int n = 0; n < 2; ++n) _Pragma("unroll") for (int k = 0; k < 2; ++k) dst[n][k] = *(const PG8_LAS bf16x8*)(lds + PG8_SB(b, h) + boff + n * 2048 + k * 1024); } while (0)
#define PG8_MMA(ai, bj, At, Bt) do { __builtin_amdgcn_s_setprio(1); _Pragma("unroll") for (int m = 0; m < 4; ++m) _Pragma("unroll") for (int n = 0; n < 2; ++n) _Pragma("unroll") for (int k = 0; k < 2; ++k) \
        acc[ai][bj][m][n] = __builtin_amdgcn_mfma_f32_16x16x32_bf16(Bt[n][k], At[m][k], acc[ai][bj][m][n], 0, 0, 0); __builtin_amdgcn_s_setprio(0); } while (0)
#define PG8_WAIT_V(n) asm volatile("s_waitcnt vmcnt(" #n ")" ::: "memory")
#define PG8_WAIT_L(n) asm volatile("s_waitcnt lgkmcnt(" #n ")" ::: "memory")
#define PG8_BAR __builtin_amdgcn_s_barrier()
#define PG8_SCHED __builtin_amdgcn_sched_barrier(0)
    Unit cur, nxt; int ui = 0;
    if (!S.next(0, cur)) return;
    f32x4 acc[2][2][4][2];
#pragma unroll
    for (int a = 0; a < 2; ++a)
#pragma unroll
        for (int b = 0; b < 2; ++b)
#pragma unroll
            for (int m = 0; m < 4; ++m)
#pragma unroll
                for (int n = 0; n < 2; ++n) acc[a][b][m][n] = (f32x4){0.f, 0.f, 0.f, 0.f};
    bf16x8 At[4][2], B0[2][2], B1[2][2];
    const char* cA = (const char*)g.A + (size_t)cur.pm * tstep + (size_t)cur.ko * 2; const char* cB = (const char*)g.Bt + (size_t)cur.pn * tstep + (size_t)cur.ko * 2;
    S.a_ready(cur);
    if constexpr (SP2) {
        PG8_STAGE(PG8_SB(0, 0), cB, voffB); PG8_STAGE(PG8_SB(0, 1), cB + hstep, voffB); PG8_STAGE(PG8_SA(0, 0), cA, voffA); PG8_STAGE(PG8_SA(0, 1), cA + hstep, voffA);
        if (wr == 1) PG8_BAR;
        PG8_WAIT_V(2); PG8_BAR;
        PG8_STAGE(PG8_SB(1, 0), cB + kstep, voffB); PG8_STAGE(PG8_SA(1, 0), cA + kstep, voffA); PG8_STAGE(PG8_SB(1, 1), cB + hstep + kstep, voffB);
        PG8_WAIT_V(6); PG8_BAR;
    } else {
        PG8_STAGE(PG8_SB(0, 0), cB, voffB); PG8_STAGE(PG8_SA(0, 0), cA, voffA); PG8_STAGE(PG8_SB(0, 1), cB + hstep, voffB); PG8_STAGE(PG8_SA(0, 1), cA + hstep, voffA);
        if (wr == 1) PG8_BAR;
        PG8_WAIT_V(4); PG8_BAR;
        PG8_STAGE(PG8_SB(1, 0), cB + kstep, voffB); PG8_STAGE(PG8_SA(1, 0), cA + kstep, voffA); PG8_STAGE(PG8_SB(1, 1), cB + hstep + kstep, voffB);
        PG8_WAIT_V(6); PG8_BAR;
    }
    for (;;) {
        const bool has_next = S.next(ui + 1, nxt);
        const char* nA = has_next ? (const char*)g.A + (size_t)nxt.pm * tstep + (size_t)nxt.ko * 2 : cA; const char* nB = has_next ? (const char*)g.Bt + (size_t)nxt.pn * tstep + (size_t)nxt.ko * 2 : cB;
        for (int t = 0; t < nt; t += 2) {
            const bool last = (t == nt - 2);
            const char* a1 = cA + (size_t)(t + 1) * kstep;
            const char* a2 = last ? nA : cA + (size_t)(t + 2) * kstep; const char* b2 = last ? nB : cB + (size_t)(t + 2) * kstep;
            const char* a3 = a2 + kstep; const char* b3 = b2 + kstep;
            if (last && has_next) S.a_ready(nxt);
            if constexpr (SP2) {
            PG8_LDB(B0, 0, 0); PG8_LDB(B1, 0, 1); PG8_SCHED; PG8_LDA(At, 0, 0); PG8_STAGE(PG8_SA(1, 1), a1 + hstep, voffA);
            PG8_WAIT_V(8); PG8_WAIT_L(0); PG8_BAR; PG8_MMA(0, 0, At, B0); PG8_MMA(0, 1, At, B1); PG8_BAR; PG8_SCHED;
            PG8_LDA(At, 0, 1); PG8_STAGE(PG8_SB(0, 0), b2, voffB); PG8_STAGE(PG8_SB(0, 1), b2 + hstep, voffB); PG8_STAGE(PG8_SA(0, 0), a2, voffA);
            PG8_WAIT_V(8); PG8_WAIT_L(0); PG8_BAR; PG8_MMA(1, 0, At, B0); PG8_MMA(1, 1, At, B1); PG8_BAR; PG8_SCHED;
            PG8_LDB(B0, 1, 0); PG8_LDB(B1, 1, 1); PG8_SCHED; PG8_LDA(At, 1, 0); PG8_STAGE(PG8_SA(0, 1), a2 + hstep, voffA);
            PG8_WAIT_V(8); PG8_WAIT_L(0); PG8_BAR; PG8_MMA(0, 0, At, B0); PG8_MMA(0, 1, At, B1); PG8_BAR; PG8_SCHED;
            PG8_LDA(At, 1, 1); PG8_STAGE(PG8_SB(1, 0), b3, voffB); PG8_STAGE(PG8_SB(1, 1), b3 + hstep, voffB); PG8_STAGE(PG8_SA(1, 0), a3, voffA);
            PG8_WAIT_V(8); PG8_WAIT_L(0); PG8_BAR; PG8_MMA(1, 0, At, B0); PG8_MMA(1, 1, At, B1); PG8_BAR; PG8_SCHED;
            } else {
            PG8_LDB(B0, 0, 0); PG8_SCHED; PG8_LDA(At, 0, 0); PG8_STAGE(PG8_SA(1, 1), a1 + hstep, voffA);
            PG8_WAIT_L(8); PG8_BAR; PG8_WAIT_L(0); PG8_MMA(0, 0, At, B0); PG8_BAR; PG8_SCHED;
            PG8_LDB(B1, 0, 1); PG8_STAGE(PG8_SB(0, 0), b2, voffB);
            PG8_BAR; PG8_WAIT_L(0); PG8_MMA(0, 1, At, B1); PG8_BAR;
            PG8_LDA(At, 0, 1); PG8_STAGE(PG8_SA(0, 0), a2, voffA);
            PG8_BAR; PG8_WAIT_L(0); PG8_MMA(1, 0, At, B0); PG8_BAR; PG8_SCHED;
            PG8_STAGE(PG8_SB(0, 1), b2 + hstep, voffB);
            PG8_WAIT_V(6); PG8_BAR; PG8_MMA(1, 1, At, B1); PG8_BAR;
            PG8_LDB(B0, 1, 0); PG8_SCHED; PG8_LDA(At, 1, 0); PG8_STAGE(PG8_SA(0, 1), a2 + hstep, voffA);
            PG8_WAIT_L(8); PG8_BAR; PG8_WAIT_L(0); PG8_MMA(0, 0, At, B0); PG8_BAR; PG8_SCHED;
            PG8_LDB(B1, 1, 1); PG8_STAGE(PG8_SB(1, 0), b3, voffB);
            PG8_BAR; PG8_WAIT_L(0); PG8_MMA(0, 1, At, B1); PG8_BAR;
            PG8_LDA(At, 1, 1); PG8_STAGE(PG8_SA(1, 0), a3, voffA);
            PG8_BAR; PG8_WAIT_L(0); PG8_MMA(1, 0, At, B0); PG8_BAR; PG8_SCHED;
            PG8_STAGE(PG8_SB(1, 1), b3 + hstep, voffB);
            PG8_WAIT_V(6); PG8_BAR; PG8_MMA(1, 1, At, B1); PG8_BAR;
            }
        }
        if constexpr (ALIGN_EPI) { if (wr == 0) PG8_BAR; }
        if constexpr (!Epi::AFTER_DRAIN) { E(acc, cur, wr, wc, fr, fq); S.done(cur); }
        if (!has_next) break;
#pragma unroll
        for (int a = 0; a < 2; ++a)
#pragma unroll
            for (int b = 0; b < 2; ++b)
#pragma unroll
                for (int m = 0; m < 4; ++m)
#pragma unroll
                    for (int n = 0; n < 2; ++n) acc[a][b][m][n] = (f32x4){0.f, 0.f, 0.f, 0.f};
        cur = nxt; cA = nA; cB = nB; ++ui;
        if constexpr (ALIGN_EPI) { if (wr == 1) PG8_BAR; }
    }
    PG8_WAIT_V(0);
    if constexpr (!ALIGN_EPI) { if (wr == 0) PG8_BAR; }
    PG8_BAR;
    if constexpr (Epi::AFTER_DRAIN) { E.fused(acc, cur, wr, wc, fr, fq, lds, wid, lane); S.done(cur); }
#undef PG8_SA
#undef PG8_SB
#undef PG8_STAGE
#undef PG8_LDA
#undef PG8_LDB
#undef PG8_MMA
#undef PG8_WAIT_V
#undef PG8_WAIT_L
#undef PG8_BAR
#undef PG8_SCHED
}
}

#define GAS __attribute__((address_space(1)))
#define LAS __attribute__((address_space(3)))
typedef unsigned short bf16;
typedef float f32x4 __attribute__((ext_vector_type(4)));
typedef float f32x16 __attribute__((ext_vector_type(16)));
typedef short bf16x8 __attribute__((ext_vector_type(8)));
typedef short s16x4 __attribute__((ext_vector_type(4)));
typedef unsigned u32x4 __attribute__((ext_vector_type(4)));
typedef unsigned u32x2 __attribute__((ext_vector_type(2)));
typedef float f32x2_t __attribute__((ext_vector_type(2)));
typedef __bf16 bf16x2_t __attribute__((ext_vector_type(2)));
typedef GAS unsigned gu32;
#define RLX_AGENT __ATOMIC_RELAXED, __HIP_MEMORY_SCOPE_AGENT

constexpr int D = 1024, BP = 4, TP = 4096, MP = BP * TP, BS = 128, TS = 8, MS = BS * TS, M = MP + MS;
constexpr int SBH = 8, HD = 64, SBW = 512, DNH = 4, DND = 128, DNW = 512;
constexpr int IN_COLS = 3592, NPROJ = 3584;
constexpr int DFF = 2816, DFF2 = 5632, NMOD = 6144, NC = BP + BS;
constexpr int PAST = 2048, NPAGES = 16, PAGE = 128;
constexpr float EPS = 1e-6f, LOG2E = 1.4426950408889634f;
constexpr float QSCALE = 0.125f * LOG2E;
constexpr int NSPLIT = 4, NPART = 5;

constexpr size_t O_YP = 0, O_KP = 17825792, O_VP = 26214400, O_KS = 34603008, O_VS = 35127296, O_SP = 35651584, O_SS = 35913728,
                 O_DCP = 44302336, O_DCS = 44320768, O_FCP = 44910592, O_FCS = 44955648, O_END = 46397440;

constexpr size_t MiB = 1u << 20;
constexpr size_t WS_CTL = 0, CTL_ZERO_BYTES = MiB;
constexpr size_t WS_MOD = 1 * MiB, WS_SC = 5 * MiB, WS_WINX = 6 * MiB, WS_WIN_T = 7 * MiB, WS_WOUT_T = 14 * MiB, WS_WUP_T = 16 * MiB, WS_WDN_T = 27 * MiB,
                 WS_EXTRA = 33 * MiB, WS_H = 34 * MiB, WS_DNRAW = 68 * MiB, WS_ZG = 120 * MiB, WS_QB = 306 * MiB, WS_KB = 323 * MiB, WS_VB = 340 * MiB, WS_QD = 357 * MiB, WS_KD = 391 * MiB,
                 WS_VD = 425 * MiB, WS_BETA = 459 * MiB, WS_LOGA = 460 * MiB, WS_ODN = 461 * MiB, WS_MIXED = 495 * MiB, WS_X1 = 529 * MiB, WS_SIDEP = 597 * MiB, WS_SIDES = 610 * MiB,
                 WS_ACT = 784 * MiB, WS_U = 878 * MiB, WS_KCUM = 910 * MiB, WS_QDEC = 926 * MiB, WS_KDECT = 942 * MiB, WS_INTRA = 958 * MiB, WS_GL = 966 * MiB,
                 WS_OPART = 967 * MiB, WS_LPART = 978 * MiB, WS_SLAB = 980 * MiB, WS_END = 1024 * MiB;
constexpr int CW_Q0 = 1024;
constexpr int CW_QUEUE = 64;
constexpr int CW_BAR = 8192;

constexpr int RING_BYTES = 131072, MISC_OFF = RING_BYTES + 320, LDS_BYTES = 147456;

__device__ __forceinline__ unsigned cvtpk(float lo, float hi) { f32x2_t v = {lo, hi}; bf16x2_t b = __builtin_convertvector(v, bf16x2_t); return __builtin_bit_cast(unsigned, b); }
__device__ __forceinline__ bf16 f2bf(float f) { return (bf16)(cvtpk(f, 0.f) & 0xffffu); }
__device__ __forceinline__ float wave_sum(float v) {
#pragma unroll
    for (int o = 1; o < 64; o <<= 1) v += __shfl_xor(v, o);
    return v;
}
__device__ __forceinline__ float siluf(float x) { return x * __builtin_amdgcn_rcpf(1.f + __builtin_amdgcn_exp2f(-1.4426950408889634f * x)); }
__device__ __forceinline__ u32x4 pack8(const f32x4 a, const f32x4 b) { u32x4 w; w.x = cvtpk(a.x, a.y); w.y = cvtpk(a.z, a.w); w.z = cvtpk(b.x, b.y); w.w = cvtpk(b.z, b.w); return w; }
__device__ __forceinline__ float bf2f(unsigned short h) { return __uint_as_float((unsigned)h << 16); }

#define XB_TMO      128
#define XB_XCNT(j)  (256  + 64 * (j))
#define XB_XSUB(j)  (1280 + 64 * (j))
#define XB_XGEN(j)  (2304 + 64 * (j))
#define XB_TOP      3328
#define XB_TOPGEN   3392
#define XCD_BAR_WORDS 3456
#define XB_SPIN_CAP (1u << 18)
__device__ __forceinline__ unsigned xb_ld(unsigned* p)              { return __hip_atomic_load(p, __ATOMIC_RELAXED, __HIP_MEMORY_SCOPE_AGENT); }
__device__ __forceinline__ unsigned xb_add(unsigned* p, unsigned v) { return __hip_atomic_fetch_add(p, v, __ATOMIC_RELAXED, __HIP_MEMORY_SCOPE_AGENT); }
__device__ __forceinline__ unsigned xb_xcc_id() { return (unsigned)__builtin_amdgcn_s_getreg((3 << 11) | 20) & 0xFu; }
#define XB_SPIN(cond, bar) do { unsigned _sp = 0; while (cond) { __builtin_amdgcn_s_sleep(1); \
    if ((++_sp & 255u) == 0u) { if (xb_ld(&(bar)[XB_TMO])) break; if (_sp > XB_SPIN_CAP) { atomicAdd(&(bar)[XB_TMO], 1u); break; } } } } while (0)
struct XcdBarrier { unsigned* bar; unsigned x; volatile LAS unsigned* st; };
__device__ __forceinline__ XcdBarrier xcd_barrier_post(unsigned* bar, volatile LAS unsigned* st, int tid) {
    XcdBarrier b; b.bar = bar; b.x = xb_xcc_id(); b.st = st;
    if (tid == 0) (void)xb_add(&bar[XB_XCNT(b.x)], 1u);
    return b;
}
__device__ __forceinline__ void xcd_barrier_complete(unsigned* bar, unsigned x, unsigned& nloc, unsigned& nx) {
    const unsigned G = gridDim.x * gridDim.y * gridDim.z;
    unsigned sum, cnt, mine, sp = 0u;
    for (;;) {
        sum = 0u; cnt = 0u; mine = 0u;
#pragma unroll
        for (unsigned j = 0; j < 16; ++j) { const unsigned c = xb_ld(&bar[XB_XCNT(j)]); sum += c; cnt += (c > 0u) ? 1u : 0u; mine = (j == x) ? c : mine; }
        if (sum == G) break;
        __builtin_amdgcn_s_sleep(1);
        if ((++sp & 255u) == 0u) { if (xb_ld(&bar[XB_TMO])) break; if (sp > XB_SPIN_CAP) { atomicAdd(&bar[XB_TMO], 1u); break; } }
    }
    nloc = mine > 0u ? mine : 1u; nx = cnt > 0u ? cnt : 1u;
}
__device__ __forceinline__ void xcd_barrier(const XcdBarrier& b, int tid) {
    asm volatile("s_waitcnt vmcnt(0)" ::: "memory");
    __syncthreads();
    if (tid == 0) {
        unsigned* bar = b.bar;
        __builtin_amdgcn_s_waitcnt(0);
        unsigned nloc = b.st[0], nx = b.st[1];
        if (nloc == 0u) { xcd_barrier_complete(bar, b.x, nloc, nx); b.st[0] = nloc; b.st[1] = nx; }
        const unsigned old = xb_add(&bar[XB_XSUB(b.x)], 1u);
        const unsigned gen = old / nloc;
        if (old + 1u == (gen + 1u) * nloc) {
            __builtin_amdgcn_fence(__ATOMIC_RELEASE, "agent");
            asm volatile("s_waitcnt vmcnt(0)" ::: "memory");
            const unsigned og = xb_add(&bar[XB_TOP], 1u);
            const unsigned tg = og / nx;
            if (og + 1u == (tg + 1u) * nx) xb_add(&bar[XB_TOPGEN], 1u);
            else XB_SPIN(xb_ld(&bar[XB_TOPGEN]) == tg, bar);
            __builtin_amdgcn_fence(__ATOMIC_ACQUIRE, "agent");
            xb_add(&bar[XB_XGEN(b.x)], 1u);
            asm volatile("s_waitcnt vmcnt(0)" ::: "memory");
        } else {
            XB_SPIN(xb_ld(&bar[XB_XGEN(b.x)]) == gen, bar);
            __builtin_amdgcn_fence(__ATOMIC_ACQUIRE, "agent");
            asm volatile("s_waitcnt vmcnt(0)" ::: "memory");
        }
    }
    __syncthreads();
}

__device__ __forceinline__ int lane_now() { int l; asm volatile("v_mbcnt_lo_u32_b32 %0, -1, 0\n\tv_mbcnt_hi_u32_b32 %0, -1, %0" : "=v"(l)); return l; }
struct Args { const void* in[27]; float* out; unsigned char* ws; int lo, hi; };
enum { I_XP = 0, I_XS, I_CP, I_CS, I_CK, I_CV, I_PT, I_SD, I_SDC, I_SFC, I_WADA, I_BADA, I_GATT, I_WIN, I_GQ, I_GK, I_SBB, I_GSBO, I_WDNC, I_ALOG, I_DTB, I_GDNO, I_WOUT, I_GFFN, I_WUP, I_WFC, I_WDN };

__device__ __forceinline__ int mod_row(int m) { return m < MP ? (m >> 12) : BP + ((m - MP) >> 3); }

struct EpiF32 {
    static constexpr bool PERM = false, AFTER_DRAIN = false;
    float* O; int ldc;
    __device__ __forceinline__ void operator()(const pg8::f32x4 (&acc)[2][2][4][2], const pg8::Unit& u, int wr, int wc, int fr, int fq) const {
        const int row0 = u.pm * 256 + wr * 64 + fr, col0 = u.pn * 256 + wc * 32 + 4 * fq;
#pragma unroll
        for (int ai = 0; ai < 2; ++ai)
#pragma unroll
            for (int m = 0; m < 4; ++m) { float* rowp = O + (size_t)(row0 + ai * 128 + m * 16) * ldc + col0;
#pragma unroll
                for (int bj = 0; bj < 2; ++bj)
#pragma unroll
                    for (int n = 0; n < 2; ++n) *(pg8::f32x4*)(rowp + bj * 128 + n * 16) = acc[ai][bj][m][n]; }
    }
};
struct EpiResGate {
    static constexpr bool PERM = false, AFTER_DRAIN = false;
    const float* base0; const float* base1; const float* mod; int goff; float* out;
    __device__ __forceinline__ void operator()(const pg8::f32x4 (&acc)[2][2][4][2], const pg8::Unit& u, int wr, int wc, int fr, int fq) const {
        const int row0 = u.pm * 256 + wr * 64 + fr, col0 = u.pn * 256 + wc * 32 + 4 * fq;
#pragma unroll
        for (int ai = 0; ai < 2; ++ai)
#pragma unroll
            for (int m = 0; m < 4; ++m) { const int r = row0 + ai * 128 + m * 16;
                const float* bp = (r < MP ? base0 + (size_t)r * D : base1 + (size_t)(r - MP) * D) + col0;
                const float* gp = mod + (size_t)mod_row(r) * NMOD + goff + col0; float* op = out + (size_t)r * D + col0;
#pragma unroll
                for (int bj = 0; bj < 2; ++bj)
#pragma unroll
                    for (int n = 0; n < 2; ++n) { const pg8::f32x4 b = *(const pg8::f32x4*)(bp + bj * 128 + n * 16), g = *(const pg8::f32x4*)(gp + bj * 128 + n * 16);
                        *(pg8::f32x4*)(op + bj * 128 + n * 16) = b + g * acc[ai][bj][m][n]; } }
    }
};

#define DPP_F(old_, src_, ctrl_) __uint_as_float((unsigned)__builtin_amdgcn_update_dpp((int)__float_as_uint(old_), (int)__float_as_uint(src_), (ctrl_), 0xF, 0xF, false))
struct EpiUp {
    static constexpr bool PERM = true, AFTER_DRAIN = false;
    bf16* ACT; bf16* SIDEP; bf16* SIDES; const float* wf; float* out;
    __device__ __forceinline__ void operator()(const pg8::f32x4 (&acc)[2][2][4][2], const pg8::Unit& u, int wr, int wc, int fr, int fq) const {
        const bool prompt_tile = u.pm < MP / 256;
        const unsigned uc0 = (unsigned)(u.pn * 128 + wc * 32 + 8 * fq);
        const unsigned row0 = (unsigned)u.pm * 256u + (unsigned)(wr * 64 + fr);
        if (prompt_tile) {
#pragma unroll
            for (int ai = 0; ai < 2; ++ai) { const unsigned kb = (unsigned)u.pm * 4u + ai * 2 + wr;
                if (fr < 2) { bf16* sp = SIDEP + ((size_t)kb * 4 + fr) * DFF2 + uc0; *(u32x4*)sp = pack8(acc[ai][0][0][0], acc[ai][0][0][1]); *(u32x4*)(sp + DFF) = pack8(acc[ai][1][0][0], acc[ai][1][0][1]); }
                if (fr >= 14) { bf16* sp = SIDEP + ((size_t)kb * 4 + (fr - 12)) * DFF2 + uc0; *(u32x4*)sp = pack8(acc[ai][0][3][0], acc[ai][0][3][1]); *(u32x4*)(sp + DFF) = pack8(acc[ai][1][3][0], acc[ai][1][3][1]); } }
        } else {
            const int t = fr & 7;
#pragma unroll
            for (int ai = 0; ai < 2; ++ai)
#pragma unroll
                for (int m = 0; m < 4; ++m) { const unsigned seq = (row0 + ai * 128 + m * 16 - MP) >> 3;
                    if (t < 2) { bf16* sp = SIDES + ((size_t)seq * 2 + t) * DFF2 + uc0; *(u32x4*)sp = pack8(acc[ai][0][m][0], acc[ai][0][m][1]); *(u32x4*)(sp + DFF) = pack8(acc[ai][1][m][0], acc[ai][1][m][1]); }
                    if (t >= 6) { float* fo = out + O_FCS + ((size_t)seq * 2 + (t - 6)) * DFF2 + uc0;
                        *(pg8::f32x4*)fo = acc[ai][0][m][0]; *(pg8::f32x4*)(fo + 4) = acc[ai][0][m][1]; *(pg8::f32x4*)(fo + DFF) = acc[ai][1][m][0]; *(pg8::f32x4*)(fo + DFF + 4) = acc[ai][1][m][1]; } }
        }
        u32x2 half0[2][4];
#pragma unroll
        for (int n = 0; n < 2; ++n) {
            const float* wp = wf + uc0 + 4 * n;
            const pg8::f32x4 wu0 = *(const pg8::f32x4*)wp, wu1 = *(const pg8::f32x4*)(wp + DFF2), wu2 = *(const pg8::f32x4*)(wp + 2 * DFF2);
            const pg8::f32x4 wg0 = *(const pg8::f32x4*)(wp + DFF), wg1 = *(const pg8::f32x4*)(wp + DFF2 + DFF), wg2 = *(const pg8::f32x4*)(wp + 2 * DFF2 + DFF);
#pragma unroll
            for (int ai = 0; ai < 2; ++ai)
#pragma unroll
                for (int m = 0; m < 4; ++m) {
                    float a[4];
#pragma unroll
                    for (int c = 0; c < 4; ++c) {
                        const float cu = acc[ai][0][m][n][c], cg = acc[ai][1][m][n][c];
                        const float pu = m > 0 ? acc[ai][0][m - 1][n][c] : cu, pg = m > 0 ? acc[ai][1][m - 1][n][c] : cg;
                        const float u1 = DPP_F(DPP_F(0.f, pu, 0x121), cu, 0x111), u2 = DPP_F(DPP_F(0.f, pu, 0x122), cu, 0x112);
                        const float g1 = DPP_F(DPP_F(0.f, pg, 0x121), cg, 0x111), g2 = DPP_F(DPP_F(0.f, pg, 0x122), cg, 0x112);
                        const float yu = wu0[c] * u2 + wu1[c] * u1 + wu2[c] * cu, yg = wg0[c] * g2 + wg1[c] * g1 + wg2[c] * cg;
                        a[c] = siluf(yg) * yu;
                    }
                    u32x2 w; w.x = cvtpk(a[0], a[1]); w.y = cvtpk(a[2], a[3]);
                    if (n == 0) half0[ai][m] = w;
                    else *(u32x4*)(ACT + (size_t)(row0 + ai * 128 + m * 16) * DFF + uc0) = (u32x4){half0[ai][m].x, half0[ai][m].y, w.x, w.y};
                }
        }
    }
};

struct SplitKOrder {
    int nks, G, c;
    __device__ __forceinline__ bool next(int i, pg8::Unit& u) const { const int L = i * G + c; if (L >= 16 * nks) return false; const int su = L & 15, ks = L >> 4; u.pm = MP / 256 + (su >> 2); u.pn = su & 3; u.ko = ks * 256; return true; }
    __device__ __forceinline__ void a_ready(const pg8::Unit&) const {}
    __device__ __forceinline__ void done(const pg8::Unit&) const {}
};
struct EpiSlab {
    static constexpr bool PERM = false, AFTER_DRAIN = false;
    float* slab;
    __device__ __forceinline__ void operator()(const pg8::f32x4 (&acc)[2][2][4][2], const pg8::Unit& u, int wr, int wc, int fr, int fq) const {
        float* O = slab + (size_t)(u.ko >> 8) * ((size_t)MS * D);
        const int row0 = (u.pm - MP / 256) * 256 + wr * 64 + fr, col0 = u.pn * 256 + wc * 32 + 4 * fq;
#pragma unroll
        for (int ai = 0; ai < 2; ++ai)
#pragma unroll
            for (int m = 0; m < 4; ++m) { float* rowp = O + (size_t)(row0 + ai * 128 + m * 16) * D + col0;
#pragma unroll
                for (int bj = 0; bj < 2; ++bj)
#pragma unroll
                    for (int n = 0; n < 2; ++n) *(pg8::f32x4*)(rowp + bj * 128 + n * 16) = acc[ai][bj][m][n]; }
    }
};
__device__ __forceinline__ void st16(void* base, unsigned off, u32x4 v) { *(u32x4*)((unsigned char*)base + off) = v; }
__device__ __forceinline__ void st16f(void* base, unsigned off, pg8::f32x4 v) { *(pg8::f32x4*)((unsigned char*)base + off) = v; }
struct EpiProj {
    static constexpr bool PERM = true, AFTER_DRAIN = false;
    float* out; bf16* QB; bf16* KB; bf16* VB; bf16* DNRAW; bf16* ZG; const float* g_q; const float* g_k; LAS float* xl;
    __device__ __forceinline__ void operator()(const pg8::f32x4 (&acc)[2][2][4][2], const pg8::Unit& u, int wr, int wc, int fr, int fq) const {
        const int pn = u.pn, rl0 = wr * 64 + fr, c0 = wc * 32 + 8 * fq;
        const unsigned row0 = (unsigned)u.pm * 256u + (unsigned)rl0;
        const bool prompt_tile = u.pm < MP / 256;
        if (pn < 4) {
            int xb = (rl0 * 8 + wc) * 4, xb2 = (rl0 * 8 + (wc ^ 1)) * 4; asm volatile("" : "+v"(xb), "+v"(xb2));
            LAS float* xw = (LAS float*)((LAS unsigned char*)xl + xb); const LAS float* xr = (const LAS float*)((LAS unsigned char*)xl + xb2);
#pragma unroll
            for (int ai = 0; ai < 2; ++ai)
#pragma unroll
                for (int m = 0; m < 4; ++m)
#pragma unroll
                    for (int bj = 0; bj < 2; ++bj) { const pg8::f32x4 a = acc[ai][bj][m][0], b = acc[ai][bj][m][1];
                        float ss = (a[0] * a[0] + a[1] * a[1]) + (a[2] * a[2] + a[3] * a[3]) + (b[0] * b[0] + b[1] * b[1]) + (b[2] * b[2] + b[3] * b[3]);
                        ss += __shfl_xor(ss, 16); ss += __shfl_xor(ss, 32);
                        if (fq == 0) xw[(ai * 128 + m * 16) * 8 + bj * 4] = ss; }
            asm volatile("s_waitcnt lgkmcnt(0)" ::: "memory"); __builtin_amdgcn_s_barrier(); asm volatile("" ::: "memory");
            const bool isq = pn < 2; const float* g = isq ? g_q : g_k; const int dloc = 32 * (wc & 1) + 8 * fq;
            const pg8::f32x4 g0 = *(const pg8::f32x4*)(g + dloc), g1 = *(const pg8::f32x4*)(g + dloc + 4);
            bf16* dstb = isq ? QB : KB; float* dstf = prompt_tile ? out + O_KP : out + O_KS - (size_t)MP * SBW;
#pragma unroll
            for (int ai = 0; ai < 2; ++ai)
#pragma unroll
                for (int m = 0; m < 4; ++m) { const unsigned row = row0 + ai * 128 + m * 16;
#pragma unroll
                    for (int bj = 0; bj < 2; ++bj) { const float tot = xw[(ai * 128 + m * 16) * 8 + bj * 4] + xr[(ai * 128 + m * 16) * 8 + bj * 4];
                        const float rs = (isq ? QSCALE : 1.0f) / sqrtf(tot * (1.f / HD) + EPS);
                        const pg8::f32x4 a = acc[ai][bj][m][0] * rs * g0, b = acc[ai][bj][m][1] * rs * g1;
                        const unsigned e = row * SBW + (unsigned)((pn & 1) * 256 + bj * 128 + c0);
                        st16(dstb, e * 2u, pack8(a, b));
                        if (!isq) { st16f(dstf, e * 4u, a); st16f(dstf, e * 4u + 16u, b); } }
                    asm volatile("" ::: "memory"); }
            asm volatile("s_waitcnt lgkmcnt(0)" ::: "memory"); __builtin_amdgcn_s_barrier(); asm volatile("" ::: "memory");
        } else if (pn < 6) {
            float* dstf = prompt_tile ? out + O_VP : out + O_VS - (size_t)MP * SBW;
#pragma unroll
            for (int ai = 0; ai < 2; ++ai)
#pragma unroll
                for (int m = 0; m < 4; ++m) { const unsigned row = row0 + ai * 128 + m * 16;
#pragma unroll
                    for (int bj = 0; bj < 2; ++bj) { const pg8::f32x4 a = acc[ai][bj][m][0], b = acc[ai][bj][m][1]; const unsigned e = row * SBW + (unsigned)((pn & 1) * 256 + bj * 128 + c0);
                        st16(VB, e * 2u, pack8(a, b)); st16f(dstf, e * 4u, a); st16f(dstf, e * 4u + 16u, b); }
                    asm volatile("" ::: "memory"); }
        } else if (pn < 12) {
#pragma unroll
            for (int ai = 0; ai < 2; ++ai)
#pragma unroll
                for (int m = 0; m < 4; ++m) { const unsigned row = row0 + ai * 128 + m * 16;
                    const int b = prompt_tile ? (int)(row >> 12) : (int)((row - MP) >> 3), t = prompt_tile ? (int)(row & 4095) : (int)((row - MP) & 7), idx = prompt_tile ? t - (TP - 3) : t - (TS - 3);
#pragma unroll
                    for (int bj = 0; bj < 2; ++bj) { const pg8::f32x4 a = acc[ai][bj][m][0], b2 = acc[ai][bj][m][1]; const unsigned ch = (unsigned)((pn - 6) * 256 + bj * 128 + c0);
                        st16(DNRAW, (row * 1536u + ch) * 2u, pack8(a, b2));
                        if (idx >= 0) { float* o = prompt_tile ? out + O_DCP : out + O_DCS; const unsigned eo = ((unsigned)(b * 3 + idx) * 1536u + ch) * 4u; st16f(o, eo, a); st16f(o, eo + 16u, b2); } }
                    asm volatile("" ::: "memory"); }
        } else {
#pragma unroll
            for (int ai = 0; ai < 2; ++ai)
#pragma unroll
                for (int m = 0; m < 4; ++m) { const unsigned row = row0 + ai * 128 + m * 16;
#pragma unroll
                    for (int bj = 0; bj < 2; ++bj) { pg8::f32x4 a = acc[ai][bj][m][0], b = acc[ai][bj][m][1]; const unsigned e = row * DNW + (unsigned)((pn - 12) * 256 + bj * 128 + c0);
                        a[0] = siluf(a[0]); a[1] = siluf(a[1]); a[2] = siluf(a[2]); a[3] = siluf(a[3]); b[0] = siluf(b[0]); b[1] = siluf(b[1]); b[2] = siluf(b[2]); b[3] = siluf(b[3]);
                        st16(ZG, e * 2u, pack8(a, b)); }
                    asm volatile("" ::: "memory"); }
        }
    }
};

__device__ __forceinline__ void mod_tile(const Args& A, LAS unsigned char* lds, int ct, int wave, int lane) {
    const float* w_ada = (const float*)A.in[I_WADA]; const float* b_ada = (const float*)A.in[I_BADA];
    const float* cp = (const float*)A.in[I_CP]; const float* cs = (const float*)A.in[I_CS]; float* MOD = (float*)(A.ws + WS_MOD);
    const int lr = lane & 15, q = lane >> 4, col = ct * 16 + lr;
    pg8::f32x4 acc[9];
#pragma unroll
    for (int i = 0; i < 9; ++i) acc[i] = (pg8::f32x4){0.f, 0.f, 0.f, 0.f};
#pragma unroll
    for (int s4 = 0; s4 < 4; ++s4) {
        const int k0 = 128 * wave + 32 * s4 + 8 * q;
        const float* wp = w_ada + (size_t)k0 * NMOD + col;
        float w[8];
#pragma unroll
        for (int j = 0; j < 8; ++j) w[j] = wp[(size_t)j * NMOD];
        u32x4 bw; bw.x = cvtpk(w[0], w[1]); bw.y = cvtpk(w[2], w[3]); bw.z = cvtpk(w[4], w[5]); bw.w = cvtpk(w[6], w[7]);
        const bf16x8 bfr = __builtin_bit_cast(bf16x8, bw);
#pragma unroll
        for (int i = 0; i < 9; ++i) { const int row = 16 * i + lr;
            f32x4 c0 = (f32x4){0.f, 0.f, 0.f, 0.f}, c1 = c0;
            if (row < NC) { const float* crow_ = (row < BP ? cp + (size_t)row * D : cs + (size_t)(row - BP) * D) + k0; c0 = *(const f32x4*)crow_; c1 = *(const f32x4*)(crow_ + 4); }
            c0.x = siluf(c0.x); c0.y = siluf(c0.y); c0.z = siluf(c0.z); c0.w = siluf(c0.w); c1.x = siluf(c1.x); c1.y = siluf(c1.y); c1.z = siluf(c1.z); c1.w = siluf(c1.w);
            acc[i] = __builtin_amdgcn_mfma_f32_16x16x32_bf16(__builtin_bit_cast(bf16x8, pack8(c0, c1)), bfr, acc[i], 0, 0, 0); }
    }
    LAS pg8::f32x4* red = (LAS pg8::f32x4*)lds;
#pragma unroll
    for (int i = 0; i < 9; ++i) red[(wave * 9 + i) * 64 + lane] = acc[i];
    __syncthreads();
    for (int i = wave; i < 9; i += 8) {
        pg8::f32x4 t = red[i * 64 + lane];
#pragma unroll
        for (int w2 = 1; w2 < 8; ++w2) t += red[(w2 * 9 + i) * 64 + lane];
        const float bb = b_ada[col];
#pragma unroll
        for (int r = 0; r < 4; ++r) { const int row = 16 * i + 4 * q + r; if (row < NC) MOD[(size_t)row * NMOD + col] = t[r] + bb; }
    }
    __syncthreads();
}
__device__ __forceinline__ void transpose_item(const float* W, int ldw, int src_col0, bf16* WT, int Kdst, int dst_row0, int k0, LAS float* scr, int lane) {
#pragma unroll
    for (int h2 = 0; h2 < 2; ++h2) { float v[16];
#pragma unroll
        for (int i = 0; i < 16; ++i) v[i] = W[(size_t)(k0 + 2 * (16 * h2 + i) + (lane >> 5)) * ldw + src_col0 + (lane & 31)];
#pragma unroll
        for (int i = 0; i < 16; ++i) scr[(2 * (16 * h2 + i) + (lane >> 5)) * 33 + (lane & 31)] = v[i]; }
    asm volatile("s_waitcnt lgkmcnt(0)" ::: "memory");
    const int c = lane & 7;
#pragma unroll
    for (int j = 0; j < 4; ++j) { const int n = (lane >> 3) + 8 * j; const LAS float* s = scr + (8 * c) * 33 + n;
        u32x4 o; o.x = cvtpk(s[0 * 33], s[1 * 33]); o.y = cvtpk(s[2 * 33], s[3 * 33]); o.z = cvtpk(s[4 * 33], s[5 * 33]); o.w = cvtpk(s[6 * 33], s[7 * 33]);
        *(u32x4*)(WT + (size_t)(dst_row0 + n) * Kdst + k0 + 8 * c) = o; }
    asm volatile("s_waitcnt lgkmcnt(0)" ::: "memory");
}
__device__ __forceinline__ void phase_prologue(const Args& A, LAS unsigned char* lds, gu32* qhead, int bx, int G, int wave, int lane, int gtid, int NGT) {
    unsigned char* ws = A.ws;
    const float* w_in = (const float*)A.in[I_WIN]; const float* w_out = (const float*)A.in[I_WOUT]; const float* w_up = (const float*)A.in[I_WUP]; const float* w_dn = (const float*)A.in[I_WDN];
    float* WX = (float*)(ws + WS_WINX);
    for (int i = gtid; i < 8 * D; i += NGT) { const int j = i >> 10, k = i & 1023; WX[i] = w_in[(size_t)k * IN_COLS + 3072 + j]; }
    { const int vcu = (G % 8 == 0) ? (bx % 8) * (G / 8) + bx / 8 : bx;
      for (int ct = vcu; ct < NMOD / 16; ct += G) mod_tile(A, lds, ct, wave, lane); }
    LAS float* scr = (LAS float*)(lds + wave * 16384);
    constexpr int I_IN = 16 * (NPROJ / 32), I_OUT = 16 * 32, I_UP = 16 * (DFF2 / 32), I_DN = (DFF / 64) * 32, NIT = I_IN + I_OUT + I_UP + I_DN;
    const int vcu2 = (G % 8 == 0) ? (bx % 8) * (G / 8) + bx / 8 : bx; const int nfirst = 2 * G * 8 < NIT ? 2 * G * 8 : NIT;
    const bool special = (G < NMOD / 16) && (2 * G > NMOD / 16), light = vcu2 >= NMOD / 16 - G; const int nlw = (2 * G - NMOD / 16) * 8;
    const int lw = (vcu2 - (NMOD / 16 - G)) * 8 + wave;
    for (int k_ = 0;; ++k_) {
        int it_;
        if (k_ < 2) { it_ = (bx * 8 + wave) + k_ * G * 8; if (it_ >= nfirst) continue; }
        else if (!special) { it_ = nfirst + (bx * 8 + wave) + (k_ - 2) * G * 8; if (it_ >= NIT) break; }
        else { if (!light) break; it_ = nfirst + lw + (k_ - 2) * nlw; if (it_ >= NIT) break; }
        int r = it_;
        if (r < I_IN) { const int nb = r % (NPROJ / 32), kb = r / (NPROJ / 32); const int n0 = nb * 32; transpose_item(w_in, IN_COLS, n0 < 3072 ? n0 : n0 + 8, (bf16*)(ws + WS_WIN_T), D, n0, kb * 64, scr, lane); continue; } r -= I_IN;
        if (r < I_OUT) { const int nb = r % 32, kb = r / 32; transpose_item(w_out, D, nb * 32, (bf16*)(ws + WS_WOUT_T), D, nb * 32, kb * 64, scr, lane); continue; } r -= I_OUT;
        if (r < I_UP) { const int nb = r % (DFF2 / 32), kb = r / (DFF2 / 32), n0 = nb * 32;
            const int dr = n0 < DFF ? (n0 >> 7) * 256 + (n0 & 127) : ((n0 - DFF) >> 7) * 256 + 128 + ((n0 - DFF) & 127);
            transpose_item(w_up, DFF2, n0, (bf16*)(ws + WS_WUP_T), D, dr, kb * 64, scr, lane); continue; } r -= I_UP;
        { const int nb = r % 32, kb = r / 32; transpose_item(w_dn, D, nb * 32, (bf16*)(ws + WS_WDN_T), DFF, nb * 32, kb * 64, scr, lane); }
    }
}

template <bool EXTRAS, int NS = 0>
__device__ __forceinline__ void phase_norm(const float* x0, const float* x1, const float* g, const float* MOD, int sh_off, int sc_off, bf16* H, const float* WX, float* EXTRA, int gw, int NGW, int lane, const float* slab = nullptr, int gate_off = 0, float* x1w = nullptr) {
    f32x4 wxr[4][8];
    if (EXTRAS) {
#pragma unroll
        for (int j = 0; j < 4; ++j)
#pragma unroll
            for (int e = 0; e < 8; ++e) wxr[j][e] = *(const f32x4*)(WX + e * D + 4 * (lane + 64 * j));
    }
    f32x4 nv[4];
    if (gw < M) { const float* xr0 = gw < MP ? x0 + (size_t)gw * D : x1 + (size_t)(gw - MP) * D;
#pragma unroll
        for (int j = 0; j < 4; ++j) nv[j] = *(const f32x4*)(xr0 + 4 * (lane + 64 * j)); }
    for (int m = gw; m < M; m += NGW) {
        const float* mod = MOD + (size_t)mod_row(m) * NMOD;
        f32x4 v[4]; float ss = 0.f;
#pragma unroll
        for (int j = 0; j < 4; ++j) v[j] = nv[j];
        { const int mn = m + NGW; if (mn < M) { const float* xrn = mn < MP ? x0 + (size_t)mn * D : x1 + (size_t)(mn - MP) * D;
#pragma unroll
            for (int j = 0; j < 4; ++j) nv[j] = *(const f32x4*)(xrn + 4 * (lane + 64 * j)); } }
#pragma unroll
        for (int j = 0; j < 4; ++j) {
            if (NS > 0 && m >= MP) { f32x4 a = (f32x4){0.f, 0.f, 0.f, 0.f};
#pragma unroll
                for (int k = 0; k < NS; ++k) a += *(const f32x4*)(slab + ((size_t)k * MS + (m - MP)) * D + 4 * (lane + 64 * j));
                v[j] += *(const f32x4*)(mod + gate_off + 4 * (lane + 64 * j)) * a;
                *(f32x4*)(x1w + (size_t)m * D + 4 * (lane + 64 * j)) = v[j]; }
            ss += (v[j].x * v[j].x + v[j].y * v[j].y) + (v[j].z * v[j].z + v[j].w * v[j].w); }
        ss = wave_sum(ss);
        const float rstd = 1.0f / sqrtf(ss * (1.f / D) + EPS);
        float ex[8];
#pragma unroll
        for (int e = 0; e < 8; ++e) ex[e] = 0.f;
#pragma unroll
        for (int j = 0; j < 4; ++j) { const int c = 4 * (lane + 64 * j);
            const f32x4 gg = *(const f32x4*)(g + c), sc = *(const f32x4*)(mod + sc_off + c), sh = *(const f32x4*)(mod + sh_off + c);
            const f32x4 h = (v[j] * rstd) * gg * (sc + 1.0f) + sh;
            u32x2 w; w.x = cvtpk(h.x, h.y); w.y = cvtpk(h.z, h.w); *(u32x2*)(H + (size_t)m * D + c) = w;
            if (EXTRAS) {
#pragma unroll
                for (int e = 0; e < 8; ++e) { const f32x4 wx = wxr[j][e]; ex[e] += (h.x * wx.x + h.y * wx.y) + (h.z * wx.z + h.w * wx.w); }
            }
        }
        if (EXTRAS) {
            float a4[4], a2[2], a1;
#pragma unroll
            for (int j = 0; j < 4; ++j) { const bool up = lane & 1; const float send = up ? ex[j] : ex[j + 4], keep = up ? ex[j + 4] : ex[j]; a4[j] = keep + __shfl_xor(send, 1); }
#pragma unroll
            for (int j = 0; j < 2; ++j) { const bool up = lane & 2; const float send = up ? a4[j] : a4[j + 2], keep = up ? a4[j + 2] : a4[j]; a2[j] = keep + __shfl_xor(send, 2); }
            { const bool up = lane & 4; const float send = up ? a2[0] : a2[1], keep = up ? a2[1] : a2[0]; a1 = keep + __shfl_xor(send, 4); }
            a1 += __shfl_xor(a1, 8); a1 += __shfl_xor(a1, 16); a1 += __shfl_xor(a1, 32);
            if (lane < 8) EXTRA[(size_t)m * 8 + (4 * (lane & 1) + 2 * ((lane >> 1) & 1) + ((lane >> 2) & 1))] = a1;
        }
    }
}

__device__ __forceinline__ f32x4 bf4lo(u32x4 w) { return (f32x4){__uint_as_float(w.x << 16), __uint_as_float(w.x & 0xffff0000u), __uint_as_float(w.y << 16), __uint_as_float(w.y & 0xffff0000u)}; }
__device__ __forceinline__ f32x4 bf4hi(u32x4 w) { return (f32x4){__uint_as_float(w.z << 16), __uint_as_float(w.z & 0xffff0000u), __uint_as_float(w.w << 16), __uint_as_float(w.w & 0xffff0000u)}; }
__device__ __forceinline__ void post_strip(const Args& A, int m0, int R, int part, int lane) {
    unsigned char* ws = A.ws; const bf16* DNRAW = (const bf16*)(ws + WS_DNRAW);
    const float* wc = (const float*)A.in[I_WDNC]; const float* sdc = (const float*)A.in[I_SDC];
    bf16* dstb = (part == 0 ? (bf16*)(ws + WS_QD) : part == 1 ? (bf16*)(ws + WS_KD) : (bf16*)(ws + WS_VD));
    const bool prompt = m0 < MP; const int b = prompt ? (m0 >> 12) : ((m0 - MP) >> 3), t0 = prompt ? (m0 & 4095) : ((m0 - MP) & 7);
    const int ch = part * 512 + 8 * lane;
    f32x4 w[4][2];
#pragma unroll
    for (int i = 0; i < 4; ++i) { w[i][0] = *(const f32x4*)(wc + i * 1536 + ch); w[i][1] = *(const f32x4*)(wc + i * 1536 + ch + 4); }
    f32x4 x[3][2];
#pragma unroll
    for (int j = 0; j < 3; ++j) { const int tt = t0 - 3 + j;
        if (tt >= 0) { const u32x4 r = *(const u32x4*)(DNRAW + (size_t)(m0 - 3 + j) * 1536 + ch); x[j][0] = bf4lo(r); x[j][1] = bf4hi(r); }
        else if (!prompt) { const float* p = sdc + ((size_t)b * 3 + (3 + tt)) * 1536 + ch; x[j][0] = *(const f32x4*)p; x[j][1] = *(const f32x4*)(p + 4); }
        else { x[j][0] = (f32x4){0.f, 0.f, 0.f, 0.f}; x[j][1] = x[j][0]; } }
    const bf16* src = DNRAW + (size_t)m0 * 1536 + ch;
    u32x4 nx = *(const u32x4*)src;
    for (int r = 0; r < R; ++r) {
        const u32x4 cw = nx;
        if (r + 1 < R) nx = *(const u32x4*)(src + (size_t)(r + 1) * 1536);
        const f32x4 c0 = bf4lo(cw), c1 = bf4hi(cw);
        f32x4 y0 = w[0][0] * x[0][0] + w[1][0] * x[1][0] + w[2][0] * x[2][0] + w[3][0] * c0;
        f32x4 y1 = w[0][1] * x[0][1] + w[1][1] * x[1][1] + w[2][1] * x[2][1] + w[3][1] * c1;
        x[0][0] = x[1][0]; x[0][1] = x[1][1]; x[1][0] = x[2][0]; x[1][1] = x[2][1]; x[2][0] = c0; x[2][1] = c1;
        y0.x = siluf(y0.x); y0.y = siluf(y0.y); y0.z = siluf(y0.z); y0.w = siluf(y0.w); y1.x = siluf(y1.x); y1.y = siluf(y1.y); y1.z = siluf(y1.z); y1.w = siluf(y1.w);
        if (part < 2) {
            float ss = (y0.x * y0.x + y0.y * y0.y) + (y0.z * y0.z + y0.w * y0.w) + (y1.x * y1.x + y1.y * y1.y) + (y1.z * y1.z + y1.w * y1.w);
            ss += __shfl_xor(ss, 1); ss += __shfl_xor(ss, 2); ss += __shfl_xor(ss, 4); ss += __shfl_xor(ss, 8);
            const float rs = (part == 0 ? 0.08838834764831845f : 1.0f) / sqrtf(ss + EPS);
            y0 = y0 * rs; y1 = y1 * rs;
        }
        *(u32x4*)(dstb + (size_t)(m0 + r) * DNW + 8 * lane) = pack8(y0, y1);
    }
}
__device__ __forceinline__ void phase_post(const Args& A, int gw, int NGW, int lane, int gtid, int NGT) {
    constexpr int NPI = (MP / 16) * 3, NSI = BS * 3;
    for (int it = gw; it < NPI + NSI; it += NGW) {
        if (it < NPI) post_strip(A, (it / 3) * 16, 16, it % 3, lane);
        else { const int j = it - NPI; post_strip(A, MP + (j / 3) * 8, 8, j % 3, lane); }
    }
    unsigned char* ws = A.ws; const float* a_log = (const float*)A.in[I_ALOG]; const float* dtb = (const float*)A.in[I_DTB];
    float* BETA = (float*)(ws + WS_BETA); float* LOGA = (float*)(ws + WS_LOGA); const float* EXTRA = (const float*)(ws + WS_EXTRA);
    for (int i = gtid; i < M * 8; i += NGT) { const int m = i >> 3, j = i & 7; const float x = EXTRA[i];
        if (j < 4) BETA[m * 4 + j] = 1.f / (1.f + __expf(-x));
        else { const int h = j - 4; const float z = x + dtb[h]; const float sp = fmaxf(z, 0.f) + log1pf(__expf(-fabsf(z))); LOGA[m * 4 + h] = -__expf(a_log[h]) * sp; } }
}

template <int B0, int B1> __device__ __forceinline__ void subst_rows(float (&x)[64], const LAS float* Am) {
#pragma unroll
    for (int ib = B0; ib < B1; ++ib) {
        float r[4];
#pragma unroll
        for (int rr = 0; rr < 4; ++rr) r[rr] = x[4 * ib + rr];
#pragma unroll
        for (int j4 = 0; j4 < ib; ++j4) {
#pragma unroll
            for (int rr = 0; rr < 4; ++rr) { const f32x4 a = *(const LAS f32x4*)(Am + (4 * ib + rr) * 64 + 4 * j4);
                r[rr] -= (a.x * x[4 * j4] + a.y * x[4 * j4 + 1]) + (a.z * x[4 * j4 + 2] + a.w * x[4 * j4 + 3]); }
        }
        const f32x4 d1 = *(const LAS f32x4*)(Am + (4 * ib + 1) * 64 + 4 * ib), d2 = *(const LAS f32x4*)(Am + (4 * ib + 2) * 64 + 4 * ib), d3 = *(const LAS f32x4*)(Am + (4 * ib + 3) * 64 + 4 * ib);
        r[1] -= d1.x * r[0];
        r[2] -= d2.x * r[0] + d2.y * r[1];
        r[3] -= (d3.x * r[0] + d3.y * r[1]) + d3.z * r[2];
#pragma unroll
        for (int rr = 0; rr < 4; ++rr) x[4 * ib + rr] = r[rr];
    }
}
constexpr int PS_INT = 34816, PS_STG = 53248;
template <int LEVEL = 0>
__device__ __forceinline__ void dn_prescan_unit(const Args& A, LAS unsigned char* lds, int unit, int tid, int wave, int lane) {
    unsigned char* ws = A.ws;
    const bf16* QD = (const bf16*)(ws + WS_QD); const bf16* KD = (const bf16*)(ws + WS_KD); const bf16* VD = (const bf16*)(ws + WS_VD);
    const float* BETA = (const float*)(ws + WS_BETA); const float* LOGA = (const float*)(ws + WS_LOGA);
    const int hp = unit & 1, n = (unit >> 1) & 63, b = unit >> 7;
    const int half = tid >> 8, ht = tid & 255, h = 2 * hp + half, item = (b * 64 + n) * 4 + h;
    const int m0 = b * TP + n * 64;
    LAS float* Am = (LAS float*)lds + half * 4096;
    LAS float* gs = (LAS float*)(lds + 32768) + half * 128;
    if (ht < 64) {
        float v = LOGA[(size_t)(m0 + ht) * 4 + h];
#pragma unroll
        for (int o = 1; o < 64; o <<= 1) { const float u = __shfl_up(v, o); if (ht >= o) v += u; }
        gs[ht] = v; gs[64 + ht] = BETA[(size_t)(m0 + ht) * 4 + h];
    }
    __syncthreads();
    {
        const int wl = wave & 3, lr = lane & 15, q = lane >> 4;
        pg8::f32x4 kk[4], qk[4];
#pragma unroll
        for (int j = 0; j < 4; ++j) { kk[j] = (pg8::f32x4){0.f, 0.f, 0.f, 0.f}; qk[j] = kk[j]; }
#pragma unroll
        for (int s = 0; s < 4; ++s) {
            const bf16x8 ak = *(const bf16x8*)(KD + (size_t)(m0 + 16 * wl + lr) * DNW + h * 128 + 32 * s + 8 * q), aq = *(const bf16x8*)(QD + (size_t)(m0 + 16 * wl + lr) * DNW + h * 128 + 32 * s + 8 * q);
#pragma unroll
            for (int j = 0; j < 4; ++j) { const bf16x8 bk = *(const bf16x8*)(KD + (size_t)(m0 + 16 * j + lr) * DNW + h * 128 + 32 * s + 8 * q);
                kk[j] = __builtin_amdgcn_mfma_f32_16x16x32_bf16(ak, bk, kk[j], 0, 0, 0); qk[j] = __builtin_amdgcn_mfma_f32_16x16x32_bf16(aq, bk, qk[j], 0, 0, 0); }
        }
#pragma unroll
        for (int j = 0; j < 4; ++j)
#pragma unroll
            for (int r = 0; r < 4; ++r) { const int i = 16 * wl + 4 * q + r, jj = 16 * j + lr;
                const float dec = (i >= jj) ? __expf(gs[i] - gs[jj]) : 0.f;
                Am[i * 64 + jj] = (i > jj) ? gs[64 + i] * kk[j][r] * dec : 0.f;
                *(LAS bf16*)(lds + PS_INT + half * 9216 + i * 144 + jj * 2) = f2bf(qk[j][r] * dec); }
    }
    __syncthreads();
    if constexpr (LEVEL == 1) { __syncthreads(); return; }
    {
        const int c = ht;
        float* U = (float*)(ws + WS_U) + (size_t)item * 8192; bf16* KC = (bf16*)(ws + WS_KCUM) + (size_t)item * 8192;
        float x[64];
        { const bf16* rsrc = (ht < 128 ? VD : KD) + (size_t)m0 * DNW + h * 128 + (ht & 127);
#pragma unroll
          for (int i = 0; i < 64; ++i) x[i] = bf2f(rsrc[(size_t)i * DNW]); }
#pragma unroll
        for (int i = 0; i < 64; ++i) { const float eg = __expf(gs[i]); x[i] *= gs[64 + i] * (c >= 128 ? eg : 1.0f); }
        { bf16* INTRA = (bf16*)(ws + WS_INTRA) + (size_t)item * 4096;
#pragma unroll
          for (int j = 0; j < 2; ++j) { const int k = ht + 256 * j, row = k >> 3, c8 = (k & 7) * 8; *(u32x4*)(INTRA + row * 64 + c8) = *(const LAS u32x4*)(lds + PS_INT + half * 9216 + row * 144 + c8 * 2); } }
        subst_rows<0, 6>(x, Am); subst_rows<6, 10>(x, Am); subst_rows<10, 13>(x, Am); subst_rows<13, 16>(x, Am);
        if constexpr (LEVEL == 2) { float sk = 0.f; _Pragma("unroll") for (int i = 0; i < 64; ++i) sk += x[i]; asm volatile("" :: "v"(sk)); __syncthreads(); return; }
        LAS float* stg = (LAS float*)(lds + PS_STG + half * 33280);
#pragma unroll
        for (int ps = 0; ps < 2; ++ps) {
            if (ps) __syncthreads();
#pragma unroll
            for (int i = 0; i < 32; ++i) stg[i * 260 + c] = x[32 * ps + i];
            __syncthreads();
#pragma unroll
            for (int j = 0; j < 4; ++j) { const int k = ht + 256 * j, il = k >> 9, w_ = (k >> 6) & 7, ln = k & 63, rb = 16 * il + 4 * (ln >> 4), cc = 16 * w_ + (ln & 15);
                *(f32x4*)(U + (((2 * ps + il) * 8 + w_) * 64 + ln) * 4) = (f32x4){stg[rb * 260 + cc], stg[(rb + 1) * 260 + cc], stg[(rb + 2) * 260 + cc], stg[(rb + 3) * 260 + cc]}; }
#pragma unroll
            for (int j = 0; j < 2; ++j) { const int k = ht + 256 * j, row = k >> 4, c8 = (k & 15) * 8; const LAS float* sp = stg + row * 260 + 128 + c8;
                *(u32x4*)(KC + (32 * ps + row) * 128 + c8) = pack8(*(const LAS f32x4*)sp, *(const LAS f32x4*)(sp + 4)); }
        }
    }
    if constexpr (LEVEL == 3) { __syncthreads(); return; }
    {
        const float glast = gs[63];
        bf16* QDc = (bf16*)(ws + WS_QDEC) + (size_t)item * 8192; bf16* KT = (bf16*)(ws + WS_KDECT) + (size_t)item * 8192;
#pragma unroll
        for (int j = 0; j < 4; ++j) { const int k = ht + 256 * j, row = k >> 4, c8 = (k & 15) * 8; const u32x4 qw = *(const u32x4*)(QD + (size_t)(m0 + row) * DNW + h * 128 + c8); const float eg = __expf(gs[row]);
            *(u32x4*)(QDc + row * 128 + c8) = pack8(bf4lo(qw) * eg, bf4hi(qw) * eg); }
        { const int d = ht & 127, ig = ht >> 7;
#pragma unroll
            for (int i8 = 0; i8 < 4; ++i8) { float v[8];
#pragma unroll
                for (int k = 0; k < 8; ++k) { const int i = 32 * ig + 8 * i8 + k; v[k] = bf2f(KD[(size_t)(m0 + i) * DNW + h * 128 + d]) * __expf(glast - gs[i]); }
                u32x4 w; w.x = cvtpk(v[0], v[1]); w.y = cvtpk(v[2], v[3]); w.z = cvtpk(v[4], v[5]); w.w = cvtpk(v[6], v[7]);
                *(u32x4*)(KT + d * 64 + 32 * ig + 8 * i8) = w; } }
        if (ht == 0) ((float*)(ws + WS_GL))[item] = __expf(glast);
    }
    __syncthreads();
}
__device__ __forceinline__ void dn_sample_unit(const Args& A, LAS unsigned char* lds, int unit, int tid) {
    unsigned char* ws = A.ws;
    const bf16* QD = (const bf16*)(ws + WS_QD);
    const float* BETA = (const float*)(ws + WS_BETA); const float* LOGA = (const float*)(ws + WS_LOGA); float* ODN = (float*)(ws + WS_ODN);
    const int h = unit & 3, b = unit >> 2, e = tid & 127, dq = tid >> 7;
    const float* s0 = (const float*)A.in[I_SD] + ((size_t)(b * 4 + h) * 128 + 32 * dq) * 128 + e;
    float S[32];
#pragma unroll
    for (int d = 0; d < 32; ++d) S[d] = s0[(size_t)d * 128];
    LAS float* red = (LAS float*)lds; LAS float* red2 = red + 512; LAS float* tk = red + 1024;
#pragma unroll
    for (int j = 0; j < 6; ++j) { const int i = tid + 512 * j, t = i / 384, c = i % 384, part = c >> 7; const int m = MP + b * TS + t;
        const unsigned sel = part == 0 ? 1u : part == 1 ? 0u : 2u;
        tk[i] = bf2f(QD[sel * (unsigned)((WS_KD - WS_QD) / 2) + (unsigned)m * DNW + h * 128 + (c & 127)]); }
    if (tid < 16) { const size_t m = (size_t)(MP + b * TS + (tid >> 1)); tk[3072 + tid] = (tid & 1) ? BETA[m * 4 + h] : __expf(LOGA[m * 4 + h]); }
    __syncthreads();
    for (int t = 0; t < TS; ++t) {
        const int m = MP + b * TS + t;
        const float a = tk[3072 + 2 * t], bt = tk[3072 + 2 * t + 1];
        const LAS float* kp = tk + t * 384 + 32 * dq; const LAS float* qp = kp + 128;
        float kd[32], qd[32];
#pragma unroll
        for (int d4 = 0; d4 < 8; ++d4) { const f32x4 kv = *(const LAS f32x4*)(kp + 4 * d4), qv = *(const LAS f32x4*)(qp + 4 * d4);
            kd[4 * d4] = kv.x; kd[4 * d4 + 1] = kv.y; kd[4 * d4 + 2] = kv.z; kd[4 * d4 + 3] = kv.w; qd[4 * d4] = qv.x; qd[4 * d4 + 1] = qv.y; qd[4 * d4 + 2] = qv.z; qd[4 * d4 + 3] = qv.w; }
        float p0 = 0.f, p1 = 0.f;
#pragma unroll
        for (int d = 0; d < 32; d += 2) { p0 += kd[d] * S[d]; p1 += kd[d + 1] * S[d + 1]; }
        red[dq * 128 + e] = p0 + p1;
        __syncthreads();
        const float kS = (red[e] + red[128 + e]) + (red[256 + e] + red[384 + e]);
        const float dl = bt * (tk[t * 384 + 256 + e] - a * kS);
        float po0 = 0.f, po1 = 0.f;
#pragma unroll
        for (int d = 0; d < 32; d += 2) { S[d] = a * S[d] + kd[d] * dl; po0 += qd[d] * S[d]; S[d + 1] = a * S[d + 1] + kd[d + 1] * dl; po1 += qd[d + 1] * S[d + 1]; }
        red2[dq * 128 + e] = po0 + po1;
        __syncthreads();
        if (dq == 0) ODN[(size_t)m * DNW + h * 128 + e] = (red2[e] + red2[128 + e]) + (red2[256 + e] + red2[384 + e]);
    }
    float* so = A.out + O_SS + ((size_t)(b * 4 + h) * 128 + 32 * dq) * 128 + e;
#pragma unroll
    for (int d = 0; d < 32; ++d) so[(size_t)d * 128] = S[d];
    __syncthreads();
}

constexpr int SC_KC = 0, SC_QD = 17408, SC_KT = 34816, SC_IN = 53248, SC_BUF = 62464;
__device__ __forceinline__ void dn_scan_chain(const Args& A, LAS unsigned char* lds, int chain, int tid, int wave, int lane) {
    unsigned char* ws = A.ws;
    const float* Ub = (const float*)(ws + WS_U); const float* GL = (const float*)(ws + WS_GL); float* ODN = (float*)(ws + WS_ODN);
    const int b = chain >> 2, h = chain & 3, lr = lane & 15, q = lane >> 4, e = 16 * wave + lr;
    int ldst[7];
    { const int c0 = tid, c1 = tid + 512;
      ldst[0] = SC_KC + (c0 >> 4) * 272; ldst[1] = SC_KC + (c1 >> 4) * 272; ldst[2] = SC_QD + (c0 >> 4) * 272; ldst[3] = SC_QD + (c1 >> 4) * 272;
      ldst[4] = SC_KT + (c0 >> 3) * 144; ldst[5] = SC_KT + (c1 >> 3) * 144; ldst[6] = SC_IN + (c0 >> 3) * 144; }
    const int cb_ = tid & 3, hA_ = (8 * ((2 * cb_) & 3) + 4 * (cb_ >> 1)) * 2, hB_ = (8 * ((2 * cb_ + 1) & 3) + 4 * (cb_ >> 1)) * 2;
    const int o16A = ((tid & 15) >> 2) * 64 + hA_, o16B = ((tid & 15) >> 2) * 64 + hB_, o8A = ((tid & 7) >> 2) * 64 + hA_, o8B = ((tid & 7) >> 2) * 64 + hB_;
    const size_t item0 = (size_t)(b * 64) * 4 + h;
    const unsigned char* gKC = ws + WS_KCUM + item0 * 16384; const unsigned char* gQD = ws + WS_QDEC + item0 * 16384; const unsigned char* gKT = ws + WS_KDECT + item0 * 16384; const unsigned char* gIN = ws + WS_INTRA + item0 * 8192;
    const unsigned t16 = (unsigned)tid * 16u, ulane = (unsigned)(wave * 64 + lane) * 4u;
    u32x4 R[7]; float un[16], uc[16];
#define SC_GLOAD(n_) do { const size_t o16_ = (size_t)(n_) * 4 * 16384, o8_ = (size_t)(n_) * 4 * 8192; \
        R[0] = *(const u32x4*)(gKC + o16_ + t16); R[1] = *(const u32x4*)(gKC + o16_ + 8192 + t16); R[2] = *(const u32x4*)(gQD + o16_ + t16); R[3] = *(const u32x4*)(gQD + o16_ + 8192 + t16); \
        R[4] = *(const u32x4*)(gKT + o16_ + t16); R[5] = *(const u32x4*)(gKT + o16_ + 8192 + t16); R[6] = *(const u32x4*)(gIN + o8_ + t16); \
        const float* U_ = Ub + (item0 + 4 * (size_t)(n_)) * 8192; \
        _Pragma("unroll") for (int i_ = 0; i_ < 4; ++i_) { const f32x4 u_ = *(const f32x4*)(U_ + (ulane + (unsigned)(i_ * 2048))); un[4 * i_] = u_.x; un[4 * i_ + 1] = u_.y; un[4 * i_ + 2] = u_.z; un[4 * i_ + 3] = u_.w; } } while (0)
#define SC_LWRITE(buf_) do { _Pragma("unroll") for (int k_ = 0; k_ < 7; ++k_) { LAS unsigned char* d_ = lds + (buf_) * SC_BUF + ldst[k_]; \
        *(LAS u32x2*)(d_ + (k_ < 4 ? o16A : o8A)) = (u32x2){R[k_].x, R[k_].y}; *(LAS u32x2*)(d_ + (k_ < 4 ? o16B : o8B)) = (u32x2){R[k_].z, R[k_].w}; } } while (0)
#define SC_BARRIER() do { asm volatile("s_waitcnt lgkmcnt(0)" ::: "memory"); __builtin_amdgcn_s_barrier(); asm volatile("" ::: "memory"); } while (0)
#define SC_FRAG(off_, pitch_, row_, s_) (*(const LAS bf16x8*)(B + (off_) + (row_) * (pitch_) + (32 * (s_) + 8 * q) * 2))
    pg8::f32x4 S[8];
#pragma unroll
    for (int i = 0; i < 8; ++i) S[i] = (pg8::f32x4){0.f, 0.f, 0.f, 0.f};
    const float glv = GL[item0 + 4 * (size_t)lane];
    __syncthreads();
    SC_GLOAD(0); SC_LWRITE(0);
#pragma unroll
    for (int k = 0; k < 16; ++k) uc[k] = un[k];
    __syncthreads();
    for (int n = 0; n < 64; ++n) {
        const float gl = __uint_as_float(__builtin_amdgcn_readlane(__float_as_uint(glv), n));
        if (n + 1 < 64) SC_GLOAD(n + 1);
        const LAS unsigned char* B = lds + (n & 1) * SC_BUF;
        bf16x8 Sb[4];
#pragma unroll
        for (int s = 0; s < 4; ++s) { u32x4 w; w.x = cvtpk(S[2 * s][0], S[2 * s][1]); w.y = cvtpk(S[2 * s][2], S[2 * s][3]); w.z = cvtpk(S[2 * s + 1][0], S[2 * s + 1][1]); w.w = cvtpk(S[2 * s + 1][2], S[2 * s + 1][3]); Sb[s] = __builtin_bit_cast(bf16x8, w); }
        pg8::f32x4 vn[4], o[4];
#pragma unroll
        for (int ih = 0; ih < 2; ++ih) {
            bf16x8 fk[2][4], fq[2][4];
#pragma unroll
            for (int ii = 0; ii < 2; ++ii)
#pragma unroll
                for (int s = 0; s < 4; ++s) { fk[ii][s] = SC_FRAG(SC_KC, 272, 16 * (2 * ih + ii) + lr, s); fq[ii][s] = SC_FRAG(SC_QD, 272, 16 * (2 * ih + ii) + lr, s); }
#pragma unroll
            for (int ii = 0; ii < 2; ++ii) { const int i = 2 * ih + ii;
                pg8::f32x4 ak = (pg8::f32x4){0.f, 0.f, 0.f, 0.f}, aq = ak;
#pragma unroll
                for (int s = 0; s < 4; ++s) { ak = __builtin_amdgcn_mfma_f32_16x16x32_bf16(fk[ii][s], Sb[s], ak, 0, 0, 0); aq = __builtin_amdgcn_mfma_f32_16x16x32_bf16(fq[ii][s], Sb[s], aq, 0, 0, 0); }
#pragma unroll
                for (int r = 0; r < 4; ++r) vn[i][r] = uc[4 * i + r] - ak[r];
                o[i] = aq; }
        }
        bf16x8 Vb[2];
#pragma unroll
        for (int s = 0; s < 2; ++s) { u32x4 w; w.x = cvtpk(vn[2 * s][0], vn[2 * s][1]); w.y = cvtpk(vn[2 * s][2], vn[2 * s][3]); w.z = cvtpk(vn[2 * s + 1][0], vn[2 * s + 1][1]); w.w = cvtpk(vn[2 * s + 1][2], vn[2 * s + 1][3]); Vb[s] = __builtin_bit_cast(bf16x8, w); }
        {
            bf16x8 fi[4][2], ft[8][2];
#pragma unroll
            for (int i = 0; i < 4; ++i)
#pragma unroll
                for (int s = 0; s < 2; ++s) fi[i][s] = SC_FRAG(SC_IN, 144, 16 * i + lr, s);
#pragma unroll
            for (int i = 0; i < 8; ++i)
#pragma unroll
                for (int s = 0; s < 2; ++s) ft[i][s] = SC_FRAG(SC_KT, 144, 16 * i + lr, s);
#pragma unroll
            for (int i = 0; i < 4; ++i) {
#pragma unroll
                for (int s = 0; s < 2; ++s) o[i] = __builtin_amdgcn_mfma_f32_16x16x32_bf16(fi[i][s], Vb[s], o[i], 0, 0, 0);
                *(f32x4*)(ODN + ((item0 + 4 * (size_t)n) * 8192) + (ulane + (unsigned)(i * 2048))) = (f32x4){o[i][0], o[i][1], o[i][2], o[i][3]};
            }
#pragma unroll
            for (int i = 0; i < 8; ++i) {
                pg8::f32x4 acc = S[i] * gl;
#pragma unroll
                for (int s = 0; s < 2; ++s) acc = __builtin_amdgcn_mfma_f32_16x16x32_bf16(ft[i][s], Vb[s], acc, 0, 0, 0);
                S[i] = acc;
            }
        }
        if (n + 1 < 64) {
            SC_LWRITE((n + 1) & 1);
#pragma unroll
            for (int k = 0; k < 16; ++k) uc[k] = un[k];
        }
        SC_BARRIER();
    }
#undef SC_GLOAD
#undef SC_LWRITE
#undef SC_FRAG
    float* so = A.out + O_SP + (size_t)(b * 4 + h) * 16384;
#pragma unroll
    for (int i = 0; i < 8; ++i)
#pragma unroll
        for (int r = 0; r < 4; ++r) so[(unsigned)((16 * i + 4 * q + r) * 128 + e)] = S[i][r];
}

__device__ __forceinline__ int crow(int r, int hi) { return (r & 3) + 8 * (r >> 2) + 4 * hi; }
__device__ __forceinline__ void sb_core(f32x16& p, float& carry, int hi) {
    float s[16];
#pragma unroll
    for (int r = 0; r < 16; ++r) { const float e = __builtin_amdgcn_exp2f(p[r]); s[r] = -__builtin_amdgcn_logf(1.0f + e); }
    float tt[4], uu[4];
#pragma unroll
    for (int i = 0; i < 4; ++i) { s[4 * i + 2] += s[4 * i + 3]; s[4 * i + 1] += s[4 * i + 2]; s[4 * i] += s[4 * i + 1]; tt[i] = s[4 * i]; }
#pragma unroll
    for (int i = 0; i < 4; ++i) uu[i] = __shfl_xor(tt[i], 32);
    const float w3 = tt[3] + uu[3], w2 = tt[2] + uu[2], w1 = tt[1] + uu[1], w0 = tt[0] + uu[0];
    float off[4];
    off[3] = carry; off[2] = carry + w3; off[1] = off[2] + w2; off[0] = off[1] + w1;
    carry = off[0] + w0;
    if (hi == 0) {
#pragma unroll
        for (int i = 0; i < 4; ++i) off[i] += uu[i];
    }
#pragma unroll
    for (int r = 0; r < 16; ++r) p[r] = __builtin_amdgcn_exp2f(p[r] + s[r] + off[r >> 2]);
}
__device__ __forceinline__ bf16x8 pack_p(const f32x16& p, int s) {
    u32x4 w; w.x = cvtpk(p[8 * s], p[8 * s + 1]); w.y = cvtpk(p[8 * s + 2], p[8 * s + 3]); w.z = cvtpk(p[8 * s + 4], p[8 * s + 5]); w.w = cvtpk(p[8 * s + 6], p[8 * s + 7]); return __builtin_bit_cast(bf16x8, w);
}
constexpr int AW_BYTES = 16384, AW_V = 0, VPI = 192, AW_K = 6144, KPI = 144, AW_Q = 6144, AW_SQ = 10752;
__device__ __forceinline__ void read_vfrags(bf16x8 (&vf)[4], const LAS unsigned char* wl, int lane) {
    const int hi = lane >> 5;
    const LAS unsigned char* vb = wl + AW_V + (4 * hi + ((lane & 15) >> 2)) * VPI + (((lane >> 4) & 1) * 16 + (lane & 3) * 4) * 2;
#pragma unroll
    for (int dt = 0; dt < 2; ++dt) {
        const s16x4 t0 = __builtin_bit_cast(s16x4, __builtin_amdgcn_ds_read_tr16_b64_v4i16((LAS s16x4*)(vb + dt * 64)));
        const s16x4 t1 = __builtin_bit_cast(s16x4, __builtin_amdgcn_ds_read_tr16_b64_v4i16((LAS s16x4*)(vb + dt * 64 + 8 * VPI)));
        const s16x4 t2 = __builtin_bit_cast(s16x4, __builtin_amdgcn_ds_read_tr16_b64_v4i16((LAS s16x4*)(vb + dt * 64 + 16 * VPI)));
        const s16x4 t3 = __builtin_bit_cast(s16x4, __builtin_amdgcn_ds_read_tr16_b64_v4i16((LAS s16x4*)(vb + dt * 64 + 24 * VPI)));
        vf[2 * dt] = (bf16x8){t0[0], t0[1], t0[2], t0[3], t1[0], t1[1], t1[2], t1[3]}; vf[2 * dt + 1] = (bf16x8){t2[0], t2[1], t2[2], t2[3], t3[0], t3[1], t3[2], t3[3]};
    }
}
__device__ __forceinline__ void load_k_prompt(bf16x8 (&k)[4], const bf16* KB, int b, int h, int kv0, int r32, int hi) {
    const bf16* kp = KB + (size_t)(b * TP + kv0 + r32) * SBW + h * HD + 8 * hi;
#pragma unroll
    for (int d0 = 0; d0 < 4; ++d0) k[d0] = *(const bf16x8*)(kp + 16 * d0);
}
__device__ __forceinline__ void load_v_prompt(u32x4 (&v)[4], const bf16* VB, int b, int h, int kv0, int lane) {
    const bf16* vp = VB + (size_t)(b * TP + kv0 + (lane >> 3)) * SBW + h * HD + (lane & 7) * 8;
#pragma unroll
    for (int i = 0; i < 4; ++i) v[i] = *(const u32x4*)(vp + (size_t)(8 * i) * SBW);
}
__device__ __forceinline__ void write_v_lds(LAS unsigned char* wl, const u32x4 (&v)[4], int lane) {
#pragma unroll
    for (int i = 0; i < 4; ++i) *(LAS u32x4*)(wl + AW_V + (8 * i + (lane >> 3)) * VPI + (lane & 7) * 16) = v[i];
}
template <int MASK>
__device__ __forceinline__ void sb_qk(f32x16& p, const bf16x8 (&kf)[4], const bf16x8 (&qf)[4], float bias2, int kv0, int qpos, int hi) {
#pragma unroll
    for (int r = 0; r < 16; ++r) p[r] = bias2;
#pragma unroll
    for (int d0 = 0; d0 < 4; ++d0) p = __builtin_amdgcn_mfma_f32_32x32x16_bf16(kf[d0], qf[d0], p, 0, 0, 0);
    if (MASK) {
#pragma unroll
        for (int r = 0; r < 16; ++r) if (kv0 + crow(r, hi) >= qpos) p[r] = -INFINITY;
    }
}
__device__ __forceinline__ void sb_pvonly(const f32x16& p, const bf16x8 (&vf)[4], f32x16 (&o)[2]) {
    const bf16x8 p0 = pack_p(p, 0), p1 = pack_p(p, 1);
#pragma unroll
    for (int dt = 0; dt < 2; ++dt) { o[dt] = __builtin_amdgcn_mfma_f32_32x32x16_bf16(vf[2 * dt], p0, o[dt], 0, 0, 0); o[dt] = __builtin_amdgcn_mfma_f32_32x32x16_bf16(vf[2 * dt + 1], p1, o[dt], 0, 0, 0); }
}
__device__ __forceinline__ void sb_pv(f32x16& p, const bf16x8 (&vf)[4], f32x16 (&o)[2], float& carry, int hi) {
    sb_core(p, carry, hi);
    const bf16x8 p0 = pack_p(p, 0), p1 = pack_p(p, 1);
#pragma unroll
    for (int dt = 0; dt < 2; ++dt) { o[dt] = __builtin_amdgcn_mfma_f32_32x32x16_bf16(vf[2 * dt], p0, o[dt], 0, 0, 0); o[dt] = __builtin_amdgcn_mfma_f32_32x32x16_bf16(vf[2 * dt + 1], p1, o[dt], 0, 0, 0); }
}
template <int MASK>
__device__ __forceinline__ void sb_tile(const bf16x8 (&kf)[4], const bf16x8 (&vf)[4], const bf16x8 (&qf)[4], float bias2, f32x16 (&o)[2], float& carry, int kv0, int qpos, int hi) {
    f32x16 p; sb_qk<MASK>(p, kf, qf, bias2, kv0, qpos, hi); sb_pv(p, vf, o, carry, hi);
}
__device__ __forceinline__ void sb_store_prompt(const Args& A, const f32x16 (&o)[2], int b, int h, int qpos, int hi) {
    float ss = 0.f;
#pragma unroll
    for (int dt = 0; dt < 2; ++dt)
#pragma unroll
        for (int r = 0; r < 16; ++r) ss += o[dt][r] * o[dt][r];
    ss += __shfl_xor(ss, 32);
    const float rs = 1.0f / sqrtf(ss * (1.f / HD) + EPS);
    const float* gso = (const float*)A.in[I_GSBO];
    bf16* op = (bf16*)(A.ws + WS_MIXED) + (size_t)(b * TP + qpos) * D + h * HD;
#pragma unroll
    for (int dt = 0; dt < 2; ++dt)
#pragma unroll
        for (int g = 0; g < 4; ++g) { const int d = 32 * dt + 8 * g + 4 * hi; const f32x4 gg = *(const f32x4*)(gso + d);
            u32x2 w; w.x = cvtpk(o[dt][4 * g] * rs * gg.x, o[dt][4 * g + 1] * rs * gg.y); w.y = cvtpk(o[dt][4 * g + 2] * rs * gg.z, o[dt][4 * g + 3] * rs * gg.w); *(u32x2*)(op + d) = w; }
}
__device__ __forceinline__ void attn_prompt_item(const Args& A, LAS unsigned char* wl, int b, int h, int q0, int lane) {
    unsigned char* ws = A.ws;
    const bf16* QB = (const bf16*)(ws + WS_QB); const bf16* KB = (const bf16*)(ws + WS_KB); const bf16* VB = (const bf16*)(ws + WS_VB);
    const int r32 = lane & 31, hi = lane >> 5, qa = q0 + r32, qb = q0 + 32 + r32;
    const float bias2 = ((const float*)A.in[I_SBB])[h] * LOG2E;
#pragma unroll
    for (int d0 = 0; d0 < 4; ++d0) { *(LAS bf16x8*)(wl + AW_Q + (d0 * 64 + lane) * 16) = *(const bf16x8*)(QB + (size_t)(b * TP + qa) * SBW + h * HD + 16 * d0 + 8 * hi);
        *(LAS bf16x8*)(wl + AW_Q + 4096 + (d0 * 64 + lane) * 16) = *(const bf16x8*)(QB + (size_t)(b * TP + qb) * SBW + h * HD + 16 * d0 + 8 * hi); }
#define QFA_LOAD bf16x8 qfa[4]; _Pragma("unroll") for (int d0_ = 0; d0_ < 4; ++d0_) qfa[d0_] = *(const LAS bf16x8*)(wl + AW_Q + (d0_ * 64 + lane) * 16);
#define QFB_LOAD bf16x8 qfb[4]; _Pragma("unroll") for (int d0_ = 0; d0_ < 4; ++d0_) qfb[d0_] = *(const LAS bf16x8*)(wl + AW_Q + 4096 + (d0_ * 64 + lane) * 16);
    f32x16 oa[2], ob[2]; oa[0] = (f32x16){}; oa[1] = (f32x16){}; ob[0] = (f32x16){}; ob[1] = (f32x16){};
    float ca = 0.f, cb = 0.f;
    bf16x8 kc[4], vf[4]; u32x4 vr[4];
    const int top = (q0 >> 5) + 1;
    load_k_prompt(kc, KB, b, h, 32 * top, r32, hi); load_v_prompt(vr, VB, b, h, 32 * top, lane);
    { write_v_lds(wl, vr, lane); load_v_prompt(vr, VB, b, h, 32 * (top - 1), lane);
      f32x16 p; { QFB_LOAD sb_qk<1>(p, kc, qfb, bias2, 32 * top, qb, hi); }
      load_k_prompt(kc, KB, b, h, 32 * (top - 1), r32, hi);
      read_vfrags(vf, wl, lane);
      sb_pv(p, vf, ob, cb, hi); }
    { write_v_lds(wl, vr, lane); if (top >= 2) load_v_prompt(vr, VB, b, h, 32 * (top - 2), lane);
      f32x16 p; { QFA_LOAD sb_qk<1>(p, kc, qfa, bias2, 32 * (top - 1), qa, hi); }
      read_vfrags(vf, wl, lane);
      sb_pv(p, vf, oa, ca, hi);
      { QFB_LOAD sb_qk<0>(p, kc, qfb, bias2, 0, 0, hi); }
      if (top >= 2) load_k_prompt(kc, KB, b, h, 32 * (top - 2), r32, hi);
      sb_pv(p, vf, ob, cb, hi); }
    for (int ht = top - 2; ht >= 0; --ht) {
        write_v_lds(wl, vr, lane);
        f32x16 p, p2; { QFA_LOAD sb_qk<0>(p, kc, qfa, bias2, 0, 0, hi); } { QFB_LOAD sb_qk<0>(p2, kc, qfb, bias2, 0, 0, hi); }
        if (ht > 0) load_k_prompt(kc, KB, b, h, 32 * (ht - 1), r32, hi);
        read_vfrags(vf, wl, lane);
        sb_core(p, ca, hi); sb_pvonly(p, vf, oa);
        __builtin_amdgcn_sched_barrier(0);
        if (ht > 0) load_v_prompt(vr, VB, b, h, 32 * (ht - 1), lane);
        sb_core(p2, cb, hi); sb_pvonly(p2, vf, ob);
    }
    sb_store_prompt(A, oa, b, h, qa, hi); sb_store_prompt(A, ob, b, h, qb, hi);
#undef QFA_LOAD
#undef QFB_LOAD
}

__device__ __forceinline__ void load_raw_sample(f32x4 (&r)[8], const float* c, size_t base, int h, int lane) {
    const float* p = c + base + (size_t)(lane >> 4) * 512 + h * HD + (lane & 15) * 4;
#pragma unroll
    for (int i = 0; i < 8; ++i) r[i] = *(const f32x4*)(p + (size_t)(4 * i) * 512);
}
__device__ __forceinline__ void write_raw_sample(LAS unsigned char* wl, int off, int pitch, const f32x4 (&r)[8], int lane) {
#pragma unroll
    for (int i = 0; i < 8; ++i) { const int row = 4 * i + (lane >> 4); u32x2 w; w.x = cvtpk(r[i].x, r[i].y); w.y = cvtpk(r[i].z, r[i].w); *(LAS u32x2*)(wl + off + row * pitch + (lane & 15) * 8) = w; }
}
__device__ __forceinline__ void read_kfrags(bf16x8 (&kf)[4], const LAS unsigned char* wl, int r32, int hi) {
#pragma unroll
    for (int d0 = 0; d0 < 4; ++d0) kf[d0] = *(const LAS bf16x8*)(wl + AW_K + r32 * KPI + (16 * d0 + 8 * hi) * 2);
}
__device__ __forceinline__ void attn_sample_store(const Args& A, int b, int h, int part, int lane, const f32x16 (&o)[2], float carry) {
    float* OP = (float*)(A.ws + WS_OPART) + (size_t)((b * SBH + h) * NPART + part) * 512; float* LP = (float*)(A.ws + WS_LPART) + (size_t)((b * SBH + h) * NPART + part) * 8;
    const int r32 = lane & 31, hi = lane >> 5;
    unsigned lo = (unsigned)(r32 * 64 + 4 * hi), ll = (unsigned)r32; asm volatile("" : "+v"(lo), "+v"(ll));
    if (r32 < 8) {
#pragma unroll
        for (int dt = 0; dt < 2; ++dt)
#pragma unroll
            for (int g = 0; g < 4; ++g) *(f32x4*)(OP + (lo + (unsigned)(32 * dt + 8 * g))) = (f32x4){o[dt][4 * g], o[dt][4 * g + 1], o[dt][4 * g + 2], o[dt][4 * g + 3]};
        if (hi == 0) LP[ll] = carry;
    }
}
__device__ __forceinline__ void attn_sample_job(const Args& A, LAS unsigned char* wl, int b, int h, int sp, int lane) {
    unsigned char* ws = A.ws;
    const int r32 = lane & 31, hi = lane >> 5;
    const float* ck = (const float*)A.in[I_CK]; const float* cv = (const float*)A.in[I_CV]; const int* pt = (const int*)A.in[I_PT] + b * NPAGES;
    const bf16* QB = (const bf16*)(ws + WS_QB);
    const float bias2 = ((const float*)A.in[I_SBB])[h] * LOG2E;
    bf16x8 qf[4];
#pragma unroll
    for (int d0 = 0; d0 < 4; ++d0) { qf[d0] = (bf16x8){0, 0, 0, 0, 0, 0, 0, 0}; if (r32 < TS) qf[d0] = *(const bf16x8*)(QB + (size_t)(MP + b * TS + r32) * SBW + h * HD + 16 * d0 + 8 * hi); }
    f32x16 o[2]; float carry;
    bf16x8 kf[4], vf[4];
    const int tok_hi = (PAST / NSPLIT) * (sp + 1);
    constexpr int NT = PAST / NSPLIT / 32;
    f32x4 rk[8], rv[8];
#define SAMPLE_BASE(j) (((size_t)pt[(tok_hi - 32 * ((j) + 1)) >> 7] * PAGE + ((tok_hi - 32 * ((j) + 1)) & 127)) * 512)
    if (sp == NSPLIT - 1) {
        const bf16* KBn = (const bf16*)(ws + WS_KB) + (size_t)(MP + b * TS) * SBW + h * HD;
#pragma unroll
        for (int d0 = 0; d0 < 4; ++d0) { kf[d0] = (bf16x8){0, 0, 0, 0, 0, 0, 0, 0}; if (r32 < TS) kf[d0] = *(const bf16x8*)(KBn + (size_t)r32 * SBW + 16 * d0 + 8 * hi); }
        u32x4 vr[4];
        vr[0] = *(const u32x4*)((const bf16*)(ws + WS_VB) + (size_t)(MP + b * TS + (lane >> 3)) * SBW + h * HD + (lane & 7) * 8);
        vr[1] = (u32x4){0u, 0u, 0u, 0u}; vr[2] = vr[1]; vr[3] = vr[1];
        write_v_lds(wl, vr, lane);
        read_vfrags(vf, wl, lane);
        o[0] = (f32x16){}; o[1] = (f32x16){}; carry = 0.f;
        sb_tile<1>(kf, vf, qf, bias2, o, carry, 0, r32, hi);
        attn_sample_store(A, b, h, NPART - 1, lane, o, carry);
    }
    f32x4 rk2[8];
    load_raw_sample(rk, ck, SAMPLE_BASE(0), h, lane); load_raw_sample(rv, cv, SAMPLE_BASE(0), h, lane);
    load_raw_sample(rk2, ck, SAMPLE_BASE(1), h, lane);
#pragma unroll
    for (int d0 = 0; d0 < 4; ++d0) *(LAS bf16x8*)(wl + AW_SQ + (d0 * 64 + lane) * 16) = qf[d0];
    o[0] = (f32x16){}; o[1] = (f32x16){}; carry = 0.f;
#define SAMPLE_TILE(RK, jk_, jv_) do { \
        write_raw_sample(wl, AW_K, KPI, RK, lane); write_raw_sample(wl, AW_V, VPI, rv, lane); \
        if ((jk_) < NT) load_raw_sample(RK, ck, SAMPLE_BASE(jk_), h, lane); \
        read_kfrags(kf, wl, r32, hi); read_vfrags(vf, wl, lane); \
        bf16x8 qq[4]; _Pragma("unroll") for (int d0_ = 0; d0_ < 4; ++d0_) qq[d0_] = *(const LAS bf16x8*)(wl + AW_SQ + (d0_ * 64 + lane) * 16); \
        f32x16 p; sb_qk<0>(p, kf, qq, bias2, 0, 0, hi); \
        sb_core(p, carry, hi); \
        __builtin_amdgcn_sched_barrier(0); \
        if ((jv_) < NT) load_raw_sample(rv, cv, SAMPLE_BASE(jv_), h, lane); \
        sb_pvonly(p, vf, o); } while (0)
    for (int j = 0; j < NT; j += 2) {
        SAMPLE_TILE(rk, j + 2, j + 1);
        SAMPLE_TILE(rk2, j + 3, j + 2);
    }
#undef SAMPLE_TILE
#undef SAMPLE_BASE
    attn_sample_store(A, b, h, sp, lane, o, carry);
}

__device__ __forceinline__ void phase_outnorm(const Args& A, int gw, int NGW, int lane) {
    unsigned char* ws = A.ws; const float* ODN = (const float*)(ws + WS_ODN); bf16* MIXED = (bf16*)(ws + WS_MIXED);
    const float* gdn = (const float*)A.in[I_GDNO]; const float* gso = (const float*)A.in[I_GSBO];
    const float* OPb = (const float*)(ws + WS_OPART); const float* LPb = (const float*)(ws + WS_LPART);
    const int c8 = 8 * lane;
    for (int m = gw; m < M; m += NGW) {
        {
            f32x4 a0, a1;
            if (m >= MP) { const float* op = ODN + (size_t)m * DNW + c8; a0 = *(const f32x4*)op; a1 = *(const f32x4*)(op + 4); }
            else { const int t = m & 4095, cch = t & 63, hh = lane >> 4; const size_t it_ = (size_t)((m >> 12) * 64 + (t >> 6)) * 4 + hh;
                const float* op = ODN + it_ * 8192 + ((((cch >> 4) * 8 + ((lane & 15) >> 1)) * 64 + ((cch >> 2) & 3) * 16 + 8 * (lane & 1)) * 4) + (cch & 3);
                a0 = (f32x4){op[0], op[4], op[8], op[12]}; a1 = (f32x4){op[16], op[20], op[24], op[28]}; }
            float ss = (a0.x * a0.x + a0.y * a0.y) + (a0.z * a0.z + a0.w * a0.w) + (a1.x * a1.x + a1.y * a1.y) + (a1.z * a1.z + a1.w * a1.w);
            ss += __shfl_xor(ss, 1); ss += __shfl_xor(ss, 2); ss += __shfl_xor(ss, 4); ss += __shfl_xor(ss, 8);
            const float rs = 1.0f / sqrtf(ss * (1.f / DND) + EPS);
            const f32x4 g0 = *(const f32x4*)(gdn + (c8 & 127)), g1 = *(const f32x4*)(gdn + (c8 & 127) + 4);
            const u32x4 zw = *(const u32x4*)((const bf16*)(ws + WS_ZG) + (size_t)m * DNW + c8); const f32x4 z0 = bf4lo(zw), z1 = bf4hi(zw);
            *(u32x4*)(MIXED + (size_t)m * D + SBW + c8) = pack8(a0 * rs * g0 * z0, a1 * rs * g1 * z1);
        }
        if (m >= MP) {
            const int b = (m - MP) >> 3, t = (m - MP) & 7, h = lane >> 3, d0 = c8 & 63;
            const float* OP = OPb + (size_t)(b * SBH + h) * NPART * 512; const float* LP = LPb + (size_t)(b * SBH + h) * NPART * 8;
            float v[8];
#pragma unroll
            for (int k = 0; k < 8; ++k) v[k] = 0.f;
            float suf = 0.f;
#pragma unroll
            for (int part = NPART - 1; part >= 0; --part) { const float w = __builtin_amdgcn_exp2f(suf);
                const f32x4 pa = *(const f32x4*)(OP + part * 512 + t * 64 + d0), pb = *(const f32x4*)(OP + part * 512 + t * 64 + d0 + 4);
                v[0] += w * pa.x; v[1] += w * pa.y; v[2] += w * pa.z; v[3] += w * pa.w; v[4] += w * pb.x; v[5] += w * pb.y; v[6] += w * pb.z; v[7] += w * pb.w;
                suf += LP[part * 8 + t]; }
            float ss = 0.f;
#pragma unroll
            for (int k = 0; k < 8; ++k) ss += v[k] * v[k];
            ss += __shfl_xor(ss, 1); ss += __shfl_xor(ss, 2); ss += __shfl_xor(ss, 4);
            const float rs = 1.0f / sqrtf(ss * (1.f / HD) + EPS);
            const f32x4 g0 = *(const f32x4*)(gso + d0), g1 = *(const f32x4*)(gso + d0 + 4);
            *(u32x4*)(MIXED + (size_t)m * D + c8) = pack8((f32x4){v[0], v[1], v[2], v[3]} * rs * g0, (f32x4){v[4], v[5], v[6], v[7]} * rs * g1);
        }
    }
}

__device__ __forceinline__ f32x4 cg_conv(const f32x4 w0, const f32x4 w1, const f32x4 w2, const f32x4 x2, const f32x4 x1, const f32x4 x0) { return w0 * x2 + w1 * x1 + w2 * x0; }
__device__ __forceinline__ void upfix_rows(const Args& A, const bf16* own0, const bf16* own1, bool hbf, const void* h2v, const void* h3v, bool hzero, bf16* act0, bf16* act1, int c) {
    const float* wf = (const float*)A.in[I_WFC];
    f32x4 wu[3][2], wg[3][2];
#pragma unroll
    for (int i = 0; i < 3; ++i) { const float* wp = wf + (size_t)i * DFF2 + c; wu[i][0] = *(const f32x4*)wp; wu[i][1] = *(const f32x4*)(wp + 4); wg[i][0] = *(const f32x4*)(wp + DFF); wg[i][1] = *(const f32x4*)(wp + DFF + 4); }
    f32x4 u2[2], u3[2], g2[2], g3[2];
    if (hzero) { u2[0] = (f32x4){0.f, 0.f, 0.f, 0.f}; u2[1] = u2[0]; u3[0] = u2[0]; u3[1] = u2[0]; g2[0] = u2[0]; g2[1] = u2[0]; g3[0] = u2[0]; g3[1] = u2[0]; }
    else if (hbf) { const bf16* h2 = (const bf16*)h2v; const bf16* h3 = (const bf16*)h3v; const u32x4 a = *(const u32x4*)(h2 + c), b = *(const u32x4*)(h3 + c), d = *(const u32x4*)(h2 + DFF + c), e = *(const u32x4*)(h3 + DFF + c);
        u2[0] = bf4lo(a); u2[1] = bf4hi(a); u3[0] = bf4lo(b); u3[1] = bf4hi(b); g2[0] = bf4lo(d); g2[1] = bf4hi(d); g3[0] = bf4lo(e); g3[1] = bf4hi(e); }
    else { const float* h2 = (const float*)h2v; const float* h3 = (const float*)h3v;
        u2[0] = *(const f32x4*)(h2 + c); u2[1] = *(const f32x4*)(h2 + c + 4); u3[0] = *(const f32x4*)(h3 + c); u3[1] = *(const f32x4*)(h3 + c + 4);
        g2[0] = *(const f32x4*)(h2 + DFF + c); g2[1] = *(const f32x4*)(h2 + DFF + c + 4); g3[0] = *(const f32x4*)(h3 + DFF + c); g3[1] = *(const f32x4*)(h3 + DFF + c + 4); }
    const u32x4 o0u = *(const u32x4*)(own0 + c), o0g = *(const u32x4*)(own0 + DFF + c), o1u = *(const u32x4*)(own1 + c), o1g = *(const u32x4*)(own1 + DFF + c);
    const f32x4 a0[2] = {bf4lo(o0u), bf4hi(o0u)}, b0[2] = {bf4lo(o0g), bf4hi(o0g)}, a1[2] = {bf4lo(o1u), bf4hi(o1u)}, b1[2] = {bf4lo(o1g), bf4hi(o1g)};
    f32x4 r0[2], r1[2];
#pragma unroll
    for (int k = 0; k < 2; ++k) {
        f32x4 yu = cg_conv(wu[0][k], wu[1][k], wu[2][k], u2[k], u3[k], a0[k]), yg = cg_conv(wg[0][k], wg[1][k], wg[2][k], g2[k], g3[k], b0[k]);
        yg.x = siluf(yg.x); yg.y = siluf(yg.y); yg.z = siluf(yg.z); yg.w = siluf(yg.w); r0[k] = yg * yu;
        yu = cg_conv(wu[0][k], wu[1][k], wu[2][k], u3[k], a0[k], a1[k]); yg = cg_conv(wg[0][k], wg[1][k], wg[2][k], g3[k], b0[k], b1[k]);
        yg.x = siluf(yg.x); yg.y = siluf(yg.y); yg.z = siluf(yg.z); yg.w = siluf(yg.w); r1[k] = yg * yu;
    }
    *(u32x4*)(act0 + c) = pack8(r0[0], r0[1]); *(u32x4*)(act1 + c) = pack8(r1[0], r1[1]);
}
__device__ __forceinline__ void phase_upfix(const Args& A, int gw, int NGW, int lane) {
    unsigned char* ws = A.ws; const bf16* SIDEP = (const bf16*)(ws + WS_SIDEP); const bf16* SIDES = (const bf16*)(ws + WS_SIDES); bf16* ACT = (bf16*)(ws + WS_ACT);
    const float* sfc = (const float*)A.in[I_SFC];
    constexpr int NPB = MP / 64, NPI = NPB * 6, NSI = BS * 6;
    for (int it = gw; it < NPI + NSI; it += NGW) {
        const int cgp = it % 6, idx = it / 6; const int c = (cgp * 64 + lane) * 8;
        if (c >= DFF) continue;
        if (it < NPI) { const int kb = idx; const bf16* sp = SIDEP + (size_t)kb * 4 * DFF2;
            upfix_rows(A, sp, sp + DFF2, true, sp - 2 * DFF2, sp - DFF2, (kb & 63) == 0, ACT + (size_t)(kb * 64) * DFF, ACT + (size_t)(kb * 64 + 1) * DFF, c);
            if ((kb & 63) == 63) { const int b = kb >> 6; float* fo = A.out + O_FCP + (size_t)b * 2 * DFF2 + c;
#pragma unroll
                for (int r = 0; r < 2; ++r) { const u32x4 a = *(const u32x4*)(sp + (2 + r) * DFF2 + c), g = *(const u32x4*)(sp + (2 + r) * DFF2 + DFF + c);
                    *(f32x4*)(fo + r * DFF2) = bf4lo(a); *(f32x4*)(fo + r * DFF2 + 4) = bf4hi(a); *(f32x4*)(fo + r * DFF2 + DFF) = bf4lo(g); *(f32x4*)(fo + r * DFF2 + DFF + 4) = bf4hi(g); } }
        } else { const int seq = (it - NPI) / 6; const bf16* sp = SIDES + (size_t)seq * 2 * DFF2; const float* st = sfc + (size_t)seq * 2 * DFF2;
            upfix_rows(A, sp, sp + DFF2, false, st, st + DFF2, false, ACT + (size_t)(MP + seq * 8) * DFF, ACT + (size_t)(MP + seq * 8 + 1) * DFF, c); }
    }
}

__device__ __forceinline__ void phase_slabsum(const Args& A, int gw, int NGW, int lane) {
    unsigned char* ws = A.ws; const float* slab = (const float*)(ws + WS_SLAB); const float* X1 = (const float*)(ws + WS_X1); const float* MOD = (const float*)(ws + WS_MOD);
    for (int r = gw; r < MS; r += NGW) {
        const int m = MP + r; const float* mod = MOD + (size_t)mod_row(m) * NMOD + 5120;
#pragma unroll
        for (int j = 0; j < 4; ++j) { const int c = 4 * (lane + 64 * j); f32x4 a = (f32x4){0.f, 0.f, 0.f, 0.f};
#pragma unroll
            for (int k = 0; k < DFF / 256; ++k) a += *(const f32x4*)(slab + ((size_t)k * MS + r) * D + c);
            *(f32x4*)(A.out + (size_t)m * D + c) = *(const f32x4*)(X1 + (size_t)m * D + c) + *(const f32x4*)(mod + c) * a; }
    }
}

constexpr int NPHASE = 14;
#ifndef PROBE_LEVEL
#define PROBE_LEVEL 0
#endif
#ifndef REP_MASK
#define REP_MASK 0
#endif

__global__ void __launch_bounds__(512, 2) fwd_kernel(Args A) {
    extern __shared__ __attribute__((aligned(16))) unsigned char lds_raw[];
    LAS unsigned char* lds = (LAS unsigned char*)lds_raw;
    const int wave = __builtin_amdgcn_readfirstlane((int)threadIdx.x >> 6);
    const int G = gridDim.x, bx = blockIdx.x;
    const int gw = bx * 8 + wave, NGW = G * 8, NGT = G * 512;
    unsigned char* ws = A.ws;
    gu32* ctl = (gu32*)(ws + WS_CTL);
    volatile LAS unsigned* MISC = (volatile LAS unsigned*)(lds + MISC_OFF);
    { const int t0 = wave * 64 + lane_now(); for (int u = t0; u < (LDS_BYTES - RING_BYTES) / 4; u += 512) ((LAS unsigned*)(lds + RING_BYTES))[u] = 0u; }
    __syncthreads();
    const int lo = A.lo, hi = A.hi;
    const bool multi = (hi - lo) > 1;
    XcdBarrier bar; bar.bar = (unsigned*)(ctl + CW_BAR); bar.x = 0; bar.st = nullptr;
    if (multi) bar = xcd_barrier_post((unsigned*)(ctl + CW_BAR), MISC + 8, wave * 64 + lane_now());
#define IN(k) (lo <= (k) && (k) < hi)
#define GBAR() xcd_barrier(bar, wave * 64 + lane_now())
#define SEAM(k) do { if (IN(k) && IN((k) + 1)) GBAR(); } while (0)
    float* MOD = (float*)(ws + WS_MOD);

#define PH0(rep_) phase_prologue(A, lds, ctl + CW_Q0 + 64 * (rep_), bx, G, wave, lane, gtid, NGT);
#define PH1(rep_) ;
#define PH2(rep_) phase_norm<true>((const float*)A.in[I_XP], (const float*)A.in[I_XS], (const float*)A.in[I_GATT], MOD, 0, 1024, (bf16*)(ws + WS_H), (const float*)(ws + WS_WINX), (float*)(ws + WS_EXTRA), gw, NGW, lane);
#define PH3(rep_) { pg8::Gemm g{(const pg8::bf16_t*)(ws + WS_H), (const pg8::bf16_t*)(ws + WS_WIN_T), M, NPROJ, D, D}; pg8::StaticOrder S; S.init(M, NPROJ, G, bx); \
          EpiProj E{A.out, (bf16*)(ws + WS_QB), (bf16*)(ws + WS_KB), (bf16*)(ws + WS_VB), (bf16*)(ws + WS_DNRAW), (bf16*)(ws + WS_ZG), (const float*)A.in[I_GQ], (const float*)A.in[I_GK], (LAS float*)(lds + RING_BYTES + 1024)}; \
          pg8::gemm_phase<EpiProj, pg8::StaticOrder, true, true>(lds, g, S, E, tid); }
#define PH4(rep_) phase_post(A, gw, NGW, lane, gtid, NGT);
#define PH5(rep_) for (int u = bx; u < 1024; u += G) { if (u < 512) dn_prescan_unit(A, lds, u, tid, wave, lane); else dn_sample_unit(A, lds, u - 512, tid); }
#define PH6(rep_) PH6X(rep_, true, true, true)
#define PH6X(rep_, DS_, DP_, DA_) { if ((DS_) && bx < 16) dn_scan_chain(A, lds, bx, tid, wave, lane); \
          \
        bool moreP = (DP_), moreS = (DA_); const bool pfirst = wave < 4; \
        gu32* qbase_ = ctl + CW_QUEUE + 1024 * (rep_);     \
        const int shard0_ = (int)(xb_xcc_id() & 7u); int offP_ = 0, offS_ = 0;     \
        for (;;) { \
            int job = -1; bool isP = false; \
            if (pfirst && moreP) { const int sh_ = (shard0_ + offP_) & 7; unsigned j_ = 0; if (lane == 0) j_ = __hip_atomic_fetch_add(qbase_ + 64 * sh_, 1u, RLX_AGENT); j_ = __builtin_amdgcn_readfirstlane(j_); if (j_ < 256u) { job = (int)j_ * 8 + sh_; isP = true; } else if (++offP_ == 8) moreP = false; } \
            if (job < 0 && moreS && !(pfirst && moreP)) { const int sh_ = (shard0_ + offS_) & 7; unsigned j_ = 0; if (lane == 0) j_ = __hip_atomic_fetch_add(qbase_ + 512 + 64 * sh_, 1u, RLX_AGENT); j_ = __builtin_amdgcn_readfirstlane(j_); if (j_ < 512u) { job = (int)j_ * 8 + sh_; } else if (++offS_ == 8) moreS = false; } \
            if (job < 0 && !pfirst && !moreS && moreP) { const int sh_ = (shard0_ + offP_) & 7; unsigned j_ = 0; if (lane == 0) j_ = __hip_atomic_fetch_add(qbase_ + 64 * sh_, 1u, RLX_AGENT); j_ = __builtin_amdgcn_readfirstlane(j_); if (j_ < 256u) { job = (int)j_ * 8 + sh_; isP = true; } else if (++offP_ == 8) moreP = false; } \
            if (job < 0) { if (!moreP && !moreS) break; else continue; } \
            if (isP) { const int qb = 63 - (job >> 5), bh = job & 31; attn_prompt_item(A, lds + wave * AW_BYTES, bh >> 3, bh & 7, qb * 64, lane); } \
            else { const int h_ = job & 7, bs_ = job >> 3; attn_sample_job(A, lds + wave * AW_BYTES, bs_ >> 2, h_, bs_ & 3, lane); } \
        } }
#define PH7(rep_) phase_outnorm(A, gw, NGW, lane);
#define PH8(rep_) { { pg8::Gemm g{(const pg8::bf16_t*)(ws + WS_MIXED), (const pg8::bf16_t*)(ws + WS_WOUT_T), MP, D, D, D}; pg8::StaticOrder S; S.init(MP, D, G, bx); \
        EpiResGate E{(const float*)A.in[I_XP], (const float*)A.in[I_XS], MOD, 2048, (float*)(ws + WS_X1)}; \
        pg8::gemm_phase<EpiResGate, pg8::StaticOrder, true, true>(lds, g, S, E, tid); } \
        __syncthreads(); \
        { pg8::Gemm g{(const pg8::bf16_t*)(ws + WS_MIXED), (const pg8::bf16_t*)(ws + WS_WOUT_T), M, D, 256, D}; SplitKOrder S{D / 256, G, bx};     \
        EpiSlab E{(float*)(ws + WS_SLAB)}; \
        pg8::gemm_phase<EpiSlab, SplitKOrder, true, true>(lds, g, S, E, tid); } }
#define PH9(rep_) phase_norm<false, 4>((const float*)(ws + WS_X1), (const float*)A.in[I_XS], (const float*)A.in[I_GFFN], MOD, 3072, 4096, (bf16*)(ws + WS_H), nullptr, nullptr, gw, NGW, lane, (const float*)(ws + WS_SLAB), 2048, (float*)(ws + WS_X1));
#define PH10(rep_) { pg8::Gemm g{(const pg8::bf16_t*)(ws + WS_H), (const pg8::bf16_t*)(ws + WS_WUP_T), M, DFF2, D, D}; pg8::StaticOrder S; S.init(M, DFF2, G, bx); \
        EpiUp E{(bf16*)(ws + WS_ACT), (bf16*)(ws + WS_SIDEP), (bf16*)(ws + WS_SIDES), (const float*)A.in[I_WFC], A.out}; \
        pg8::gemm_phase<EpiUp, pg8::StaticOrder, true, true>(lds, g, S, E, tid); }
#define PH11(rep_) phase_upfix(A, gw, NGW, lane);
#define PH12(rep_) { { pg8::Gemm g{(const pg8::bf16_t*)(ws + WS_ACT), (const pg8::bf16_t*)(ws + WS_WDN_T), MP, D, DFF, DFF}; pg8::StaticOrder S; S.init(MP, D, G, bx); \
        EpiResGate E{(const float*)(ws + WS_X1), (const float*)(ws + WS_X1) + (size_t)MP * D, MOD, 5120, A.out}; \
        pg8::gemm_phase<EpiResGate, pg8::StaticOrder, true, true>(lds, g, S, E, tid); } \
        __syncthreads(); \
        { pg8::Gemm g{(const pg8::bf16_t*)(ws + WS_ACT), (const pg8::bf16_t*)(ws + WS_WDN_T), M, D, 256, DFF}; SplitKOrder S{DFF / 256, G, bx}; \
        EpiSlab E{(float*)(ws + WS_SLAB)}; \
        pg8::gemm_phase<EpiSlab, SplitKOrder, true, true>(lds, g, S, E, tid); } }
#define PH13(rep_) phase_slabsum(A, gw, NGW, lane);
#define RUNPH(k) do { if (IN(k)) { const int lane = lane_now(), tid = wave * 64 + lane, gtid = bx * 512 + tid; (void)gtid; PH##k(0) if constexpr (((REP_MASK) >> (k)) & 1) { GBAR(); PH##k(1) } } } while (0)
    RUNPH(0); SEAM(0);
    RUNPH(2);
    if constexpr (((REP_MASK) >> 20) & 1) { GBAR(); const int lane = lane_now(); phase_norm<false>((const float*)A.in[I_XP], (const float*)A.in[I_XS], (const float*)A.in[I_GATT], MOD, 0, 1024, (bf16*)(ws + WS_H), nullptr, nullptr, gw, NGW, lane); }
    SEAM(2);
    RUNPH(3); SEAM(3);
    RUNPH(4); SEAM(4);
    RUNPH(5);
    if constexpr (((REP_MASK) >> 17) & 1) { GBAR(); const int lane = lane_now(), tid = wave * 64 + lane; for (int u = bx; u < 512; u += G) dn_prescan_unit<PROBE_LEVEL>(A, lds, u, tid, wave, lane); }
    if constexpr (((REP_MASK) >> 18) & 1) { GBAR(); const int lane = lane_now(), tid = wave * 64 + lane; (void)lane; for (int u = bx; u < 512; u += G) dn_sample_unit(A, lds, u, tid); }
    SEAM(5);
    RUNPH(6);
    if constexpr (((REP_MASK) >> 13) & 1) { GBAR(); const int lane = lane_now(), tid = wave * 64 + lane; PH6X(2, true, false, false) }
    if constexpr (((REP_MASK) >> 14) & 1) { GBAR(); const int lane = lane_now(), tid = wave * 64 + lane; PH6X(3, false, true, false) }
    if constexpr (((REP_MASK) >> 15) & 1) { GBAR(); const int lane = lane_now(), tid = wave * 64 + lane; PH6X(4, false, false, true) }
    SEAM(6);
    RUNPH(7); SEAM(7);
    if constexpr (((REP_MASK) >> 19) & 1) { _Pragma("unroll 1") for (int i_ = 0; i_ < 20; ++i_) GBAR(); }
    RUNPH(8); SEAM(8);
    RUNPH(9); SEAM(9);
    RUNPH(10); SEAM(10);
    RUNPH(11); SEAM(11);
    RUNPH(12); SEAM(12);
    RUNPH(13);
#undef IN
#undef SEAM
}

#ifndef N_LAUNCHES
#define N_LAUNCHES 1
#endif
extern "C" void kernel_launch(void* const* d_in, const int* in_sizes, int n_in, void* d_out, int out_size, void* d_ws, size_t ws_size, hipStream_t stream) {
    static int grid = 0;
    if (grid == 0) {
        if (n_in != 27 || (size_t)out_size != O_END || ws_size < WS_END) { fprintf(stderr, "kernel_launch: unexpected shapes: n_in %d out %d ws %zu\n", n_in, out_size, ws_size); grid = -1; return; }
        int dev = 0, cus = 0, per_cu = 0;
        if (hipGetDevice(&dev) != hipSuccess || hipDeviceGetAttribute(&cus, hipDeviceAttributeMultiprocessorCount, dev) != hipSuccess) { grid = -1; return; }
        if (hipFuncSetAttribute((const void*)fwd_kernel, hipFuncAttributeMaxDynamicSharedMemorySize, LDS_BYTES) != hipSuccess) { fprintf(stderr, "kernel_launch: hipFuncSetAttribute failed\n"); grid = -1; return; }
        if (hipOccupancyMaxActiveBlocksPerMultiprocessor(&per_cu, (const void*)fwd_kernel, 512, LDS_BYTES) != hipSuccess || per_cu < 1) fprintf(stderr, "kernel_launch: occupancy query says %d\n", per_cu);
        (void)hipGetLastError();
        grid = cus;
    }
    if (grid < 0) return;
    (void)hipMemsetAsync((char*)d_ws + WS_CTL, 0, CTL_ZERO_BYTES, stream);
    Args a{};
    for (int i = 0; i < 27; ++i) a.in[i] = d_in[i];
    a.out = (float*)d_out; a.ws = (unsigned char*)d_ws;
    if (N_LAUNCHES == 1) { a.lo = 0; a.hi = NPHASE; hipLaunchKernelGGL(fwd_kernel, dim3(grid), dim3(512), LDS_BYTES, stream, a); }
    else for (int p = 0; p < NPHASE; ++p) { a.lo = p; a.hi = p + 1; hipLaunchKernelGGL(fwd_kernel, dim3(grid), dim3(512), LDS_BYTES, stream, a); }
}
```

```cpp
#include <hip/hip_runtime.h>
#include <cstdio>
#include <cstdint>
#define REP_MASK 0
#define PROBE_LEVEL 0
namespace pg8 {
#define PG8_LAS __attribute__((address_space(3)))
typedef unsigned short bf16_t;
typedef short bf16x8 __attribute__((ext_vector_type(8)));
typedef float f32x4 __attribute__((ext_vector_type(4)));
typedef unsigned u32x4 __attribute__((ext_vector_type(4)));
constexpr int BM = 256, BK = 64, HALF = 128, HTB = HALF * BK * 2  , STAGE_BYTES = 8 * HTB, NXCD = 8, WGM = 8;

__host__ __device__ __forceinline__ int lds_byte(int r, int c) { const int st = (r >> 4) * 2 + (c >> 5), rr = r & 15, cc = c & 31, ob = rr * 64 + cc * 2; return st * 1024 + (ob ^ (((ob >> 9) & 1) << 5)); }
__host__ __device__ __forceinline__ void stage_rc(int b, int& R, int& C) { const int st = b / 1024, sb = b % 1024, swz = sb ^ (((sb >> 9) & 1) << 5); R = (st >> 1) * 16 + swz / 64; C = (st & 1) * 32 + (swz % 64) / 2; }
__host__ __device__ __forceinline__ int perm32(int rho) { const int n = rho >> 4, i = rho & 15; return 8 * (i >> 2) + 4 * n + (i & 3); }

struct Unit { int pm, pn, ko; };
struct Gemm { const bf16_t* A; const bf16_t* Bt; int M, N, K, ld; };

struct StaticOrder {
    int nM, nN, nwg, G, c;
    __host__ __device__ void init(int M, int N, int G_, int c_) { nM = M / BM; nN = N / BM; nwg = nM * nN; G = G_; c = c_; }
    __host__ __device__ bool next(int i, Unit& u) const {
        const long L = (long)i * G + c; if (L >= nwg) return false;
        int wgid = (int)L; { const int q = nwg / NXCD, r = nwg % NXCD, xcd = wgid % NXCD, off = wgid / NXCD; wgid = (xcd < r ? xcd * (q + 1) : r * (q + 1) + (xcd - r) * q) + off; }
        const int nig = WGM * nN, gid = wgid / nig, fm = gid * WGM, gsz = (nM - fm) < WGM ? (nM - fm) : WGM;
        u.pm = fm + ((wgid % nig) % gsz); u.pn = (wgid % nig) / gsz; u.ko = 0; return true;
    }
    __device__ __forceinline__ void a_ready(const Unit&) const {}
    __device__ __forceinline__ void done(const Unit&) const {}
};

__device__ __forceinline__ unsigned cvt_pk_bf16(float lo, float hi) { unsigned r; asm volatile("v_cvt_pk_bf16_f32 %0, %1, %2" : "=v"(r) : "v"(lo), "v"(hi)); return r; }
typedef float f32x2 __attribute__((ext_vector_type(2)));
__device__ __forceinline__ f32x2 gelu_pk(f32x2 v) {
    const f32x2 av = __builtin_elementwise_abs(v), d = av * 0.2316418882f + 1.0f;
    f32x2 t; t.x = __builtin_amdgcn_rcpf(d.x); t.y = __builtin_amdgcn_rcpf(d.y);
    f32x2 q = t * 0.5307027145f + (-0.7265760135f); q = q * t + 0.7107068705f; q = q * t + (-0.142248368f); q = q * t + 0.127414796f; q = q * t;
    const f32x2 s = (v * v) * (-0.72134752044f);
    f32x2 e; e.x = __builtin_amdgcn_exp2f(s.x); e.y = __builtin_amdgcn_exp2f(s.y);
    const f32x2 m = v * (q * e), r = v - m;
    f32x2 o; o.x = v.x < 0.f ? m.x : r.x; o.y = v.y < 0.f ? m.y : r.y; return o;
}

template <int ACT  > struct EpiBf16 {
    static constexpr bool PERM = true, AFTER_DRAIN = false; static_assert(ACT == 0 || ACT == 1, "EpiBf16: ACT is 0 (none) or 1 (gelu_pk)");
    bf16_t* O; int ldc; const float* bias; int split_cols; size_t split_stride; float scale0;
    __device__ __forceinline__ void operator()(const f32x4 (&acc)[2][2][4][2], const Unit& u, int wr, int wc, int fr, int fq) const {
        const int row0 = u.pm * BM + wr * 64 + fr; int colt = u.pn * BM; bf16_t* base = O;
        float sc = 1.f; if (split_cols) { const int t = colt / split_cols; base += (size_t)t * split_stride; colt -= t * split_cols; if (t == 0) sc = scale0; }
        const int col0 = colt + wc * 32 + 8 * fq, bcol0 = u.pn * BM + wc * 32 + 8 * fq;
        f32x4 bv[2][2];
#pragma unroll
        for (int bj = 0; bj < 2; ++bj)
#pragma unroll
            for (int n = 0; n < 2; ++n) bv[bj][n] = bias ? *(const f32x4*)(bias + bcol0 + bj * HALF + 4 * n) : (f32x4){0.f, 0.f, 0.f, 0.f};
#pragma unroll
        for (int ai = 0; ai < 2; ++ai)
#pragma unroll
            for (int m = 0; m < 4; ++m) { bf16_t* rowp = base + (size_t)(row0 + ai * HALF + m * 16) * ldc + col0;
#pragma unroll
                for (int bj = 0; bj < 2; ++bj) { f32x4 v0 = acc[ai][bj][m][0] + bv[bj][0], v1 = acc[ai][bj][m][1] + bv[bj][1];
                    if (ACT == 1) { f32x2 a = gelu_pk((f32x2){v0[0], v0[1]}), b = gelu_pk((f32x2){v0[2], v0[3]}), c = gelu_pk((f32x2){v1[0], v1[1]}), d = gelu_pk((f32x2){v1[2], v1[3]});
                        v0 = (f32x4){a.x, a.y, b.x, b.y}; v1 = (f32x4){c.x, c.y, d.x, d.y}; }
                    v0 = v0 * sc; v1 = v1 * sc; u32x4 w; w.x = cvt_pk_bf16(v0[0], v0[1]); w.y = cvt_pk_bf16(v0[2], v0[3]); w.z = cvt_pk_bf16(v1[0], v1[1]); w.w = cvt_pk_bf16(v1[2], v1[3]);
                    *(u32x4*)(rowp + bj * HALF) = w; } }
    }
};

struct PanelStats {
    unsigned* xbuf;
    unsigned* cnt;
    unsigned* tmo;
    int ntn; float eps;
    unsigned code;
    __device__ __forceinline__ bool run(const f32x4 (&v)[2][2][4][2], const Unit& u, int wr, int wc, int fr, int fq, PG8_LAS unsigned char* lds, int wid, int lane) const {
        typedef float f32x2v __attribute__((ext_vector_type(2)));
        PG8_LAS f32x2v* P = (PG8_LAS f32x2v*)lds;
        PG8_LAS f32x2v* S = (PG8_LAS f32x2v*)(lds + 8192);
        PG8_LAS unsigned* flag = (PG8_LAS unsigned*)(lds + 8192 + 2048);
#pragma unroll
        for (int ai = 0; ai < 2; ++ai)
#pragma unroll
            for (int m = 0; m < 4; ++m) {
                float s = 0.f;
#pragma unroll
                for (int bj = 0; bj < 2; ++bj)
#pragma unroll
                    for (int n = 0; n < 2; ++n) { const f32x4 x = v[ai][bj][m][n]; s += (x[0] + x[1]) + (x[2] + x[3]); }
                s += __shfl_xor(s, 16); s += __shfl_xor(s, 32);
                const float mw = s * (1.0f / 64.0f); float q = 0.f;
#pragma unroll
                for (int bj = 0; bj < 2; ++bj)
#pragma unroll
                    for (int n = 0; n < 2; ++n) { const f32x4 d = v[ai][bj][m][n] - mw; q += (d[0] * d[0] + d[1] * d[1]) + (d[2] * d[2] + d[3] * d[3]); }
                q += __shfl_xor(q, 16); q += __shfl_xor(q, 32);
                if (fq == 0) P[(ai * HALF + wr * 64 + m * 16 + fr) * 4 + wc] = (f32x2v){mw, q};
            }
        asm volatile("s_waitcnt lgkmcnt(0)" ::: "memory"); __builtin_amdgcn_s_barrier(); asm volatile("" ::: "memory");
#if defined(BROKEN_EXCHANGE_NO_WAIT)
#warning BROKEN CONTROL BUILD: the row-statistics exchange does not wait; results are wrong by design
        if (blockIdx.x >= 64) { const long long t0_ = clock64(); while (clock64() - t0_ < 60000) __builtin_amdgcn_s_sleep(8); }
#endif
        const int row = wid * 32 + (lane & 31);
        if (lane < 32) {
            const f32x2v a = P[row * 4 + 0], b = P[row * 4 + 1], c = P[row * 4 + 2], d = P[row * 4 + 3];
            const float mt = (a.x + b.x + c.x + d.x) * 0.25f;
            const float da = a.x - mt, db = b.x - mt, dc = c.x - mt, dd = d.x - mt;
            const float m2 = (a.y + b.y) + (c.y + d.y) + 64.0f * ((da * da + db * db) + (dc * dc + dd * dd));
            unsigned long long* slot = (unsigned long long*)xbuf + ((size_t)(u.pm * BM + row) * 4 + u.pn);
            __hip_atomic_store(slot, ((unsigned long long)__float_as_uint(m2) << 32) | __float_as_uint(mt), __ATOMIC_RELAXED, __HIP_MEMORY_SCOPE_AGENT);
        }
        asm volatile("s_waitcnt vmcnt(0)" ::: "memory");
        if (lane == 0) __hip_atomic_fetch_add(cnt + 64 * u.pm, 1u, __ATOMIC_RELAXED, __HIP_MEMORY_SCOPE_AGENT);
        if (wid == 0) {
            bool dead = false; const unsigned long long t0 = __builtin_amdgcn_s_memrealtime(); const unsigned want = 8u * (unsigned)ntn;
            for (;;) {
#if defined(BROKEN_EXCHANGE_NO_WAIT)
                break;
#endif
                if ((unsigned)__builtin_amdgcn_readfirstlane(__hip_atomic_load(cnt + 64 * u.pm, __ATOMIC_RELAXED, __HIP_MEMORY_SCOPE_AGENT)) >= want) break;
                if (__builtin_amdgcn_s_memrealtime() - t0 > 2000000ull) {
                    if (lane == 0) { unsigned expect = 0u; __hip_atomic_compare_exchange_strong(tmo + 1, &expect, code | (unsigned)(u.pm & 0xff), __ATOMIC_RELAXED, __ATOMIC_RELAXED, __HIP_MEMORY_SCOPE_AGENT);
                                     __hip_atomic_store(tmo, 1u, __ATOMIC_RELAXED, __HIP_MEMORY_SCOPE_AGENT); }
                    dead = true; break; }
                __builtin_amdgcn_s_sleep(2);
            }
            __builtin_amdgcn_fence(__ATOMIC_ACQUIRE, "agent");
            if (lane == 0) flag[0] = dead ? 1u : 0u;
        }
        asm volatile("s_waitcnt vmcnt(0) lgkmcnt(0)" ::: "memory"); __builtin_amdgcn_s_barrier(); asm volatile("" ::: "memory");
        const bool bad = flag[0] != 0u;
        if (lane < 32) {
            const unsigned long long* slot = (const unsigned long long*)xbuf + (size_t)(u.pm * BM + row) * 4; float mt[4], m2[4]; float ms = 0.f;
#pragma unroll
            for (int t = 0; t < 4; ++t) { if (t < ntn) { const unsigned long long w = __hip_atomic_load(slot + t, __ATOMIC_RELAXED, __HIP_MEMORY_SCOPE_AGENT); mt[t] = __uint_as_float((unsigned)w); m2[t] = __uint_as_float((unsigned)(w >> 32)); } else { mt[t] = 0.f; m2[t] = 0.f; } ms += mt[t]; }
            const float mean = ms / (float)ntn; float q = 0.f;
#pragma unroll
            for (int t = 0; t < 4; ++t) if (t < ntn) { const float dm = mt[t] - mean; q += m2[t] + 256.0f * dm * dm; }
            S[row] = (f32x2v){mean, 1.0f / sqrtf(q / (256.0f * (float)ntn) + eps)};
        }
        asm volatile("s_waitcnt lgkmcnt(0)" ::: "memory"); __builtin_amdgcn_s_barrier(); asm volatile("" ::: "memory");
        return bad;
    }
};
struct EpiLnRes {
    static constexpr bool PERM = false, AFTER_DRAIN = true;
    const float* base; float* out; int ldc; const float* bias; PanelStats st; unsigned poison;
    __device__ __forceinline__ void fused(f32x4 (&acc)[2][2][4][2], const Unit& u, int wr, int wc, int fr, int fq, PG8_LAS unsigned char* lds, int wid, int lane) const {
        typedef float f32x2v __attribute__((ext_vector_type(2)));
        const PG8_LAS f32x2v* S = (const PG8_LAS f32x2v*)(lds + 8192);
        const int col0 = u.pn * BM + wc * 32 + 4 * fq;
#pragma unroll
        for (int bj = 0; bj < 2; ++bj)
#pragma unroll
            for (int n = 0; n < 2; ++n) { const f32x4 bv = bias ? *(const f32x4*)(bias + col0 + bj * HALF + n * 16) : (f32x4){0.f, 0.f, 0.f, 0.f};
#pragma unroll
                for (int ai = 0; ai < 2; ++ai)
#pragma unroll
                    for (int m = 0; m < 4; ++m) acc[ai][bj][m][n] += bv; }
        f32x4 pre[4][2][2];
#pragma unroll
        for (int m = 0; m < 4; ++m) { const size_t off = (size_t)(u.pm * BM + wr * 64 + m * 16 + fr) * ldc + col0;
#pragma unroll
            for (int bj = 0; bj < 2; ++bj)
#pragma unroll
                for (int n = 0; n < 2; ++n) pre[m][bj][n] = *(const f32x4*)(base + off + bj * HALF + n * 16); }
        const bool bad = st.run(acc, u, wr, wc, fr, fq, lds, wid, lane) || poison != 0u;
        const float qnan = __builtin_nanf("");
#pragma unroll
        for (int ai = 0; ai < 2; ++ai)
#pragma unroll
            for (int m = 0; m < 4; ++m) { const int r = ai * HALF + wr * 64 + m * 16 + fr; const f32x2v sr = S[r]; const size_t off = (size_t)(u.pm * BM + r) * ldc + col0;
#pragma unroll
                for (int bj = 0; bj < 2; ++bj)
#pragma unroll
                    for (int n = 0; n < 2; ++n) { const f32x4 bs = ai == 0 ? pre[m][bj][n] : *(const f32x4*)(base + off + bj * HALF + n * 16); f32x4 o = bs + (acc[ai][bj][m][n] - sr.x) * sr.y;
                        if (bad) o = (f32x4){qnan, qnan, qnan, qnan}; *(f32x4*)(out + off + bj * HALF + n * 16) = o; }
                if (m & 1) asm volatile("" ::: "memory"); }
    }
};
struct EpiLnResLn {
    static constexpr bool PERM = false, AFTER_DRAIN = true;
    const float* base; float* out; bf16_t* xn; int ldc; const float* bias; PanelStats st1, st2; unsigned poison;
    __device__ __forceinline__ void fused(f32x4 (&acc)[2][2][4][2], const Unit& u, int wr, int wc, int fr, int fq, PG8_LAS unsigned char* lds, int wid, int lane) const {
        typedef float f32x2v __attribute__((ext_vector_type(2))); typedef unsigned u32x2v __attribute__((ext_vector_type(2)));
        const PG8_LAS f32x2v* S = (const PG8_LAS f32x2v*)(lds + 8192);
        const int col0 = u.pn * BM + wc * 32 + 4 * fq;
#pragma unroll
        for (int bj = 0; bj < 2; ++bj)
#pragma unroll
            for (int n = 0; n < 2; ++n) { const f32x4 bv = bias ? *(const f32x4*)(bias + col0 + bj * HALF + n * 16) : (f32x4){0.f, 0.f, 0.f, 0.f};
#pragma unroll
                for (int ai = 0; ai < 2; ++ai)
#pragma unroll
                    for (int m = 0; m < 4; ++m) acc[ai][bj][m][n] += bv; }
        bool bad = st1.run(acc, u, wr, wc, fr, fq, lds, wid, lane) || poison != 0u;
        const float qnan = __builtin_nanf("");
#pragma unroll
        for (int ai = 0; ai < 2; ++ai)
#pragma unroll
            for (int m = 0; m < 4; ++m) { const int r = ai * HALF + wr * 64 + m * 16 + fr; const f32x2v sr = S[r]; const size_t off = (size_t)(u.pm * BM + r) * ldc + col0;
#pragma unroll
                for (int bj = 0; bj < 2; ++bj)
#pragma unroll
                    for (int n = 0; n < 2; ++n) { const f32x4 bs = *(const f32x4*)(base + off + bj * HALF + n * 16); acc[ai][bj][m][n] = bs + (acc[ai][bj][m][n] - sr.x) * sr.y; }
                asm volatile("" : "+v"(acc[ai][0][m][0]), "+v"(acc[ai][0][m][1]), "+v"(acc[ai][1][m][0]), "+v"(acc[ai][1][m][1]));
                if (m & 1) asm volatile("" ::: "memory"); }
        const bool bad1 = bad;
        bad = st2.run(acc, u, wr, wc, fr, fq, lds, wid, lane) || bad;
#pragma unroll
        for (int ai = 0; ai < 2; ++ai)
#pragma unroll
            for (int m = 0; m < 4; ++m) { const int r = ai * HALF + wr * 64 + m * 16 + fr; const f32x2v sr = S[r]; const size_t off = (size_t)(u.pm * BM + r) * ldc + col0;
#pragma unroll
                for (int bj = 0; bj < 2; ++bj)
#pragma unroll
                    for (int n = 0; n < 2; ++n) { const f32x4 x1 = acc[ai][bj][m][n]; *(f32x4*)(out + off + bj * HALF + n * 16) = bad1 ? (f32x4){qnan, qnan, qnan, qnan} : x1;
                        const f32x4 o = (x1 - sr.x) * sr.y; u32x2v w; w.x = cvt_pk_bf16(o[0], o[1]); w.y = cvt_pk_bf16(o[2], o[3]);
                        if (bad) { w.x = 0x7fc07fc0u; w.y = 0x7fc07fc0u; } *(u32x2v*)(xn + off + bj * HALF + n * 16) = w; }
                asm volatile("" ::: "memory"); }
    }
};

template <class Epi, class Sched, bool ALIGN_EPI = false, bool SP2 = false>
__device__ __forceinline__ void gemm_phase(PG8_LAS unsigned char* lds, const Gemm g, const Sched& S, const Epi& E, const int tid) {
    const int wid = __builtin_amdgcn_readfirstlane(tid >> 6), lane = tid & 63, wr = wid >> 2, wc = wid & 3, fr = lane & 15, fq = lane >> 4;
    const int K = g.K, nt = K / BK;
    unsigned voffA[2], voffB[2];
#pragma unroll
    for (int i = 0; i < 2; ++i) { int R, C; stage_rc(tid * 16 + i * 8192, R, C); const int Rb = Epi::PERM ? ((R & ~31) + perm32(R & 31)) : R;
        voffA[i] = (unsigned)(R * g.ld + C) * 2u; voffB[i] = (unsigned)(Rb * g.ld + C) * 2u; }
    const size_t kstep = (size_t)(BK * 2);
    const size_t hstep = (size_t)HALF * g.ld * 2;
    const size_t tstep = 2 * hstep;
    const unsigned ldsw = (unsigned)wid * 1024u;
    const int aoff = lds_byte(wr * 64 + fr, fq * 8), boff = lds_byte(wc * 32 + fr, fq * 8);
#define PG8_SA(b, h) (((b) * 2 + (h)) * HTB)
#define PG8_SB(b, h) ((4 + (b) * 2 + (h)) * HTB)
#define PG8_STAGE(bufoff, gbase, voff) do { _Pragma("unroll") for (int _i = 0; _i < 2; ++_i) \
        __builtin_amdgcn_global_load_lds((const unsigned*)((const char*)(gbase) + (voff)[_i]), (PG8_LAS unsigned*)(lds + (bufoff) + ldsw + _i * 8192), 16, 0, 0); } while (0)
#define PG8_LDA(dst, b, h) do { _Pragma("unroll") for (int m = 0; m < 4; ++m) _Pragma("unroll") for (int k = 0; k < 2; ++k) dst[m][k] = *(const PG8_LAS bf16x8*)(lds + PG8_SA(b, h) + aoff + m * 2048 + k * 1024); } while (0)
#define PG8_LDB(dst, b, h) do { _Pragma("unroll") for (int n = 0; n < 2; ++n) _Pragma("unroll") for (int k = 0; k < 2; ++k) dst[n][k] = *(const PG8_LAS bf16x8*)(lds + PG8_SB(b, h) + boff + n * 2048 + k * 1024); } while (0)
#define PG8_MMA(ai, bj, At, Bt) do { __builtin_amdgcn_s_setprio(1); _Pragma("unroll") for (int m = 0; m < 4; ++m) _Pragma("unroll") for (int n = 0; n < 2; ++n) _Pragma("unroll") for (int k = 0; k < 2; ++k) \
        acc[ai][bj][m][n] = __builtin_amdgcn_mfma_f32_16x16x32_bf16(Bt[n][k], At[m][k], acc[ai][bj][m][n], 0, 0, 0); __builtin_amdgcn_s_setprio(0); } while (0)
#define PG8_WAIT_V(n) asm volatile("s_waitcnt vmcnt(" #n ")" ::: "memory")
#define PG8_WAIT_L(n) asm volatile("s_waitcnt lgkmcnt(" #n ")" ::: "memory")
#define PG8_BAR __builtin_amdgcn_s_barrier()
#define PG8_SCHED __builtin_amdgcn_sched_barrier(0)
    Unit cur, nxt; int ui = 0;
    if (!S.next(0, cur)) return;
    f32x4 acc[2][2][4][2];
#pragma unroll
    for (int a = 0; a < 2; ++a)
#pragma unroll
        for (int b = 0; b < 2; ++b)
#pragma unroll
            for (int m = 0; m < 4; ++m)
#pragma unroll
                for (int n = 0; n < 2; ++n) acc[a][b][m][n] = (f32x4){0.f, 0.f, 0.f, 0.f};
    bf16x8 At[4][2], B0[2][2], B1[2][2];
    const char* cA = (const char*)g.A + (size_t)cur.pm * tstep + (size_t)cur.ko * 2; const char* cB = (const char*)g.Bt + (size_t)cur.pn * tstep + (size_t)cur.ko * 2;
    S.a_ready(cur);
    if constexpr (SP2) {
        PG8_STAGE(PG8_SB(0, 0), cB, voffB); PG8_STAGE(PG8_SB(0, 1), cB + hstep, voffB); PG8_STAGE(PG8_SA(0, 0), cA, voffA); PG8_STAGE(PG8_SA(0, 1), cA + hstep, voffA);
        if (wr == 1) PG8_BAR;
        PG8_WAIT_V(2); PG8_BAR;
        PG8_STAGE(PG8_SB(1, 0), cB + kstep, voffB); PG8_STAGE(PG8_SA(1, 0), cA + kstep, voffA); PG8_STAGE(PG8_SB(1, 1), cB + hstep + kstep, voffB);
        PG8_WAIT_V(6); PG8_BAR;
    } else {
        PG8_STAGE(PG8_SB(0, 0), cB, voffB); PG8_STAGE(PG8_SA(0, 0), cA, voffA); PG8_STAGE(PG8_SB(0, 1), cB + hstep, voffB); PG8_STAGE(PG8_SA(0, 1), cA + hstep, voffA);
        if (wr == 1) PG8_BAR;
        PG8_WAIT_V(4); PG8_BAR;
        PG8_STAGE(PG8_SB(1, 0), cB + kstep, voffB); PG8_STAGE(PG8_SA(1, 0), cA + kstep, voffA); PG8_STAGE(PG8_SB(1, 1), cB + hstep + kstep, voffB);
        PG8_WAIT_V(6); PG8_BAR;
    }
    for (;;) {
        const bool has_next = S.next(ui + 1, nxt);
        const char* nA = has_next ? (const char*)g.A + (size_t)nxt.pm * tstep + (size_t)nxt.ko * 2 : cA; const char* nB = has_next ? (const char*)g.Bt + (size_t)nxt.pn * tstep + (size_t)nxt.ko * 2 : cB;
        for (int t = 0; t < nt; t += 2) {
            const bool last = (t == nt - 2);
            const char* a1 = cA + (size_t)(t + 1) * kstep;
            const char* a2 = last ? nA : cA + (size_t)(t + 2) * kstep; const char* b2 = last ? nB : cB + (size_t)(t + 2) * kstep;
            const char* a3 = a2 + kstep; const char* b3 = b2 + kstep;
            if (last && has_next) S.a_ready(nxt);
            if constexpr (SP2) {
            PG8_LDB(B0, 0, 0); PG8_LDB(B1, 0, 1); PG8_SCHED; PG8_LDA(At, 0, 0); PG8_STAGE(PG8_SA(1, 1), a1 + hstep, voffA);
            PG8_WAIT_V(8); PG8_WAIT_L(0); PG8_BAR; PG8_MMA(0, 0, At, B0); PG8_MMA(0, 1, At, B1); PG8_BAR; PG8_SCHED;
            PG8_LDA(At, 0, 1); PG8_STAGE(PG8_SB(0, 0), b2, voffB); PG8_STAGE(PG8_SB(0, 1), b2 + hstep, voffB); PG8_STAGE(PG8_SA(0, 0), a2, voffA);
            PG8_WAIT_V(8); PG8_WAIT_L(0); PG8_BAR; PG8_MMA(1, 0, At, B0); PG8_MMA(1, 1, At, B1); PG8_BAR; PG8_SCHED;
            PG8_LDB(B0, 1, 0); PG8_LDB(B1, 1, 1); PG8_SCHED; PG8_LDA(At, 1, 0); PG8_STAGE(PG8_SA(0, 1), a2 + hstep, voffA);
            PG8_WAIT_V(8); PG8_WAIT_L(0); PG8_BAR; PG8_MMA(0, 0, At, B0); PG8_MMA(0, 1, At, B1); PG8_BAR; PG8_SCHED;
            PG8_LDA(At, 1, 1); PG8_STAGE(PG8_SB(1, 0), b3, voffB); PG8_STAGE(PG8_SB(1, 1), b3 + hstep, voffB); PG8_STAGE(PG8_SA(1, 0), a3, voffA);
            PG8_WAIT_V(8); PG8_WAIT_L(0); PG8_BAR; PG8_MMA(1, 0, At, B0); PG8_MMA(1, 1, At, B1); PG8_BAR; PG8_SCHED;
            } else {
            PG8_LDB(B0, 0, 0); PG8_SCHED; PG8_LDA(At, 0, 0); PG8_STAGE(PG8_SA(1, 1), a1 + hstep, voffA);
            PG8_WAIT_L(8); PG8_BAR; PG8_WAIT_L(0); PG8_MMA(0, 0, At, B0); PG8_BAR; PG8_SCHED;
            PG8_LDB(B1, 0, 1); PG8_STAGE(PG8_SB(0, 0), b2, voffB);
            PG8_BAR; PG8_WAIT_L(0); PG8_MMA(0, 1, At, B1); PG8_BAR;
            PG8_LDA(At, 0, 1); PG8_STAGE(PG8_SA(0, 0), a2, voffA);
            PG8_BAR; PG8_WAIT_L(0); PG8_MMA(1, 0, At, B0); PG8_BAR; PG8_SCHED;
            PG8_STAGE(PG8_SB(0, 1), b2 + hstep, voffB);
            PG8_WAIT_V(6); PG8_BAR; PG8_MMA(1, 1, At, B1); PG8_BAR;
            PG8_LDB(B0, 1, 0); PG8_SCHED; PG8_LDA(At, 1, 0); PG8_STAGE(PG8_SA(0, 1), a2 + hstep, voffA);
            PG8_WAIT_L(8); PG8_BAR; PG8_WAIT_L(0); PG8_MMA(0, 0, At, B0); PG8_BAR; PG8_SCHED;
            PG8_LDB(B1, 1, 1); PG8_STAGE(PG8_SB(1, 0), b3, voffB);
            PG8_BAR; PG8_WAIT_L(0); PG8_MMA(0, 1, At, B1); PG8_BAR;
            PG8_LDA(At, 1, 1); PG8_STAGE(PG8_SA(1, 0), a3, voffA);
            PG8_BAR; PG8_WAIT_L(0); PG8_MMA(1, 0, At, B0); PG8_BAR; PG8_SCHED;
            PG8_STAGE(PG8_SB(1, 1), b3 + hstep, voffB);
            PG8_WAIT_V(6); PG8_BAR; PG8_MMA(1, 1, At, B1); PG8_BAR;
            }
        }
        if constexpr (ALIGN_EPI) { if (wr == 0) PG8_BAR; }
        if constexpr (!Epi::AFTER_DRAIN) { E(acc, cur, wr, wc, fr, fq); S.done(cur); }
        if (!has_next) break;
#pragma unroll
        for (int a = 0; a < 2; ++a)
#pragma unroll
            for (int b = 0; b < 2; ++b)
#pragma unroll
                for (int m = 0; m < 4; ++m)
#pragma unroll
                    for (int n = 0; n < 2; ++n) acc[a][b][m][n] = (f32x4){0.f, 0.f, 0.f, 0.f};
        cur = nxt; cA = nA; cB = nB; ++ui;
        if constexpr (ALIGN_EPI) { if (wr == 1) PG8_BAR; }
    }
    PG8_WAIT_V(0);
    if constexpr (!ALIGN_EPI) { if (wr == 0) PG8_BAR; }
    PG8_BAR;
    if constexpr (Epi::AFTER_DRAIN) { E.fused(acc, cur, wr, wc, fr, fq, lds, wid, lane); S.done(cur); }
#undef PG8_SA
#undef PG8_SB
#undef PG8_STAGE
#undef PG8_LDA
#undef PG8_LDB
#undef PG8_MMA
#undef PG8_WAIT_V
#undef PG8_WAIT_L
#undef PG8_BAR
#undef PG8_SCHED
}
}

#define GAS __attribute__((address_space(1)))
#define LAS __attribute__((address_space(3)))
typedef unsigned short bf16;
typedef float f32x4 __attribute__((ext_vector_type(4)));
typedef float f32x16 __attribute__((ext_vector_type(16)));
typedef short bf16x8 __attribute__((ext_vector_type(8)));
typedef short s16x4 __attribute__((ext_vector_type(4)));
typedef unsigned u32x4 __attribute__((ext_vector_type(4)));
typedef unsigned u32x2 __attribute__((ext_vector_type(2)));
typedef float f32x2_t __attribute__((ext_vector_type(2)));
typedef __bf16 bf16x2_t __attribute__((ext_vector_type(2)));
typedef GAS unsigned gu32;
#define RLX_AGENT __ATOMIC_RELAXED, __HIP_MEMORY_SCOPE_AGENT

constexpr int D = 1024, BP = 4, TP = 4096, MP = BP * TP, BS = 128, TS = 8, MS = BS * TS, M = MP + MS;
constexpr int SBH = 8, HD = 64, SBW = 512, DNH = 4, DND = 128, DNW = 512;
constexpr int IN_COLS = 3592, NPROJ = 3584;
constexpr int DFF = 2816, DFF2 = 5632, NMOD = 6144, NC = BP + BS;
constexpr int PAST = 2048, NPAGES = 16, PAGE = 128;
constexpr float EPS = 1e-6f, LOG2E = 1.4426950408889634f;
constexpr float QSCALE = 0.125f * LOG2E;
constexpr int NSPLIT = 4, NPART = 5;

constexpr size_t O_YP = 0, O_KP = 17825792, O_VP = 26214400, O_KS = 34603008, O_VS = 35127296, O_SP = 35651584, O_SS = 35913728,
                 O_DCP = 44302336, O_DCS = 44320768, O_FCP = 44910592, O_FCS = 44955648, O_END = 46397440;

constexpr size_t MiB = 1u << 20;
constexpr size_t WS_CTL = 0, CTL_ZERO_BYTES = MiB;
constexpr size_t WS_MOD = 1 * MiB, WS_SC = 5 * MiB, WS_WINX = 6 * MiB, WS_WIN_T = 7 * MiB, WS_WOUT_T = 14 * MiB, WS_WUP_T = 16 * MiB, WS_WDN_T = 27 * MiB,
                 WS_EXTRA = 33 * MiB, WS_H = 34 * MiB, WS_DNRAW = 68 * MiB, WS_ZG = 120 * MiB, WS_QB = 306 * MiB, WS_KB = 323 * MiB, WS_VB = 340 * MiB, WS_QD = 357 * MiB, WS_KD = 391 * MiB,
                 WS_VD = 425 * MiB, WS_BETA = 459 * MiB, WS_LOGA = 460 * MiB, WS_ODN = 461 * MiB, WS_MIXED = 495 * MiB, WS_X1 = 529 * MiB, WS_SIDEP = 597 * MiB, WS_SIDES = 610 * MiB,
                 WS_ACT = 784 * MiB, WS_U = 878 * MiB, WS_KCUM = 910 * MiB, WS_QDEC = 926 * MiB, WS_KDECT = 942 * MiB, WS_INTRA = 958 * MiB, WS_GL = 966 * MiB,
                 WS_OPART = 967 * MiB, WS_LPART = 978 * MiB, WS_SLAB = 980 * MiB, WS_END = 1024 * MiB;
constexpr int CW_Q0 = 1024;
constexpr int CW_QUEUE = 64;
constexpr int CW_BAR = 8192;

constexpr int RING_BYTES = 131072, MISC_OFF = RING_BYTES + 320, LDS_BYTES = 147456;

__device__ __forceinline__ unsigned cvtpk(float lo, float hi) { f32x2_t v = {lo, hi}; bf16x2_t b = __builtin_convertvector(v, bf16x2_t); return __builtin_bit_cast(unsigned, b); }
__device__ __forceinline__ bf16 f2bf(float f) { return (bf16)(cvtpk(f, 0.f) & 0xffffu); }
__device__ __forceinline__ float wave_sum(float v) {
#pragma unroll
    for (int o = 1; o < 64; o <<= 1) v += __shfl_xor(v, o);
    return v;
}
__device__ __forceinline__ float siluf(float x) { return x * __builtin_amdgcn_rcpf(1.f + __builtin_amdgcn_exp2f(-1.4426950408889634f * x)); }
__device__ __forceinline__ u32x4 pack8(const f32x4 a, const f32x4 b) { u32x4 w; w.x = cvtpk(a.x, a.y); w.y = cvtpk(a.z, a.w); w.z = cvtpk(b.x, b.y); w.w = cvtpk(b.z, b.w); return w; }
__device__ __forceinline__ f32x4 bf4lo(u32x4 w) { return (f32x4){__uint_as_float(w.x << 16), __uint_as_float(w.x & 0xffff0000u), __uint_as_float(w.y << 16), __uint_as_float(w.y & 0xffff0000u)}; }
__device__ __forceinline__ f32x4 bf4hi(u32x4 w) { return (f32x4){__uint_as_float(w.z << 16), __uint_as_float(w.z & 0xffff0000u), __uint_as_float(w.w << 16), __uint_as_float(w.w & 0xffff0000u)}; }
__device__ __forceinline__ float bf2f(unsigned short h) { return __uint_as_float((unsigned)h << 16); }

#define XB_TMO      128
#define XB_XCNT(j)  (256  + 64 * (j))
#define XB_XSUB(j)  (1280 + 64 * (j))
#define XB_XGEN(j)  (2304 + 64 * (j))
#define XB_TOP      3328
#define XB_TOPGEN   3392
#define XCD_BAR_WORDS 3456
#define XB_SPIN_CAP (1u << 18)
__device__ __forceinline__ unsigned xb_ld(unsigned* p)              { return __hip_atomic_load(p, __ATOMIC_RELAXED, __HIP_MEMORY_SCOPE_AGENT); }
__device__ __forceinline__ unsigned xb_add(unsigned* p, unsigned v) { return __hip_atomic_fetch_add(p, v, __ATOMIC_RELAXED, __HIP_MEMORY_SCOPE_AGENT); }
__device__ __forceinline__ unsigned xb_xcc_id() { return (unsigned)__builtin_amdgcn_s_getreg((3 << 11) | 20) & 0xFu; }
#define XB_SPIN(cond, bar) do { unsigned _sp = 0; while (cond) { __builtin_amdgcn_s_sleep(1); \
    if ((++_sp & 255u) == 0u) { if (xb_ld(&(bar)[XB_TMO])) break; if (_sp > XB_SPIN_CAP) { atomicAdd(&(bar)[XB_TMO], 1u); break; } } } } while (0)
struct XcdBarrier { unsigned* bar; unsigned x; volatile LAS unsigned* st; };
__device__ __forceinline__ XcdBarrier xcd_barrier_post(unsigned* bar, volatile LAS unsigned* st, int tid) {
    XcdBarrier b; b.bar = bar; b.x = xb_xcc_id(); b.st = st;
    if (tid == 0) (void)xb_add(&bar[XB_XCNT(b.x)], 1u);
    return b;
}
__device__ __forceinline__ void xcd_barrier_complete(unsigned* bar, unsigned x, unsigned& nloc, unsigned& nx) {
    const unsigned G = gridDim.x * gridDim.y * gridDim.z;
    unsigned sum, cnt, mine, sp = 0u;
    for (;;) {
        sum = 0u; cnt = 0u; mine = 0u;
#pragma unroll
        for (unsigned j = 0; j < 16; ++j) { const unsigned c = xb_ld(&bar[XB_XCNT(j)]); sum += c; cnt += (c > 0u) ? 1u : 0u; mine = (j == x) ? c : mine; }
        if (sum == G) break;
        __builtin_amdgcn_s_sleep(1);
        if ((++sp & 255u) == 0u) { if (xb_ld(&bar[XB_TMO])) break; if (sp > XB_SPIN_CAP) { atomicAdd(&bar[XB_TMO], 1u); break; } }
    }
    nloc = mine > 0u ? mine : 1u; nx = cnt > 0u ? cnt : 1u;
}
__device__ __forceinline__ void xcd_barrier(const XcdBarrier& b, int tid) {
    asm volatile("s_waitcnt vmcnt(0)" ::: "memory");
    __syncthreads();
    if (tid == 0) {
        unsigned* bar = b.bar;
        __builtin_amdgcn_s_waitcnt(0);
        unsigned nloc = b.st[0], nx = b.st[1];
        if (nloc == 0u) { xcd_barrier_complete(bar, b.x, nloc, nx); b.st[0] = nloc; b.st[1] = nx; }
        const unsigned old = xb_add(&bar[XB_XSUB(b.x)], 1u);
        const unsigned gen = old / nloc;
        if (old + 1u == (gen + 1u) * nloc) {
            __builtin_amdgcn_fence(__ATOMIC_RELEASE, "agent");
            asm volatile("s_waitcnt vmcnt(0)" ::: "memory");
            const unsigned og = xb_add(&bar[XB_TOP], 1u);
            const unsigned tg = og / nx;
            if (og + 1u == (tg + 1u) * nx) xb_add(&bar[XB_TOPGEN], 1u);
            else XB_SPIN(xb_ld(&bar[XB_TOPGEN]) == tg, bar);
            __builtin_amdgcn_fence(__ATOMIC_ACQUIRE, "agent");
            xb_add(&bar[XB_XGEN(b.x)], 1u);
            asm volatile("s_waitcnt vmcnt(0)" ::: "memory");
        } else {
            XB_SPIN(xb_ld(&bar[XB_XGEN(b.x)]) == gen, bar);
            __builtin_amdgcn_fence(__ATOMIC_ACQUIRE, "agent");
            asm volatile("s_waitcnt vmcnt(0)" ::: "memory");
        }
    }
    __syncthreads();
}

__device__ __forceinline__ int lane_now() { int l; asm volatile("v_mbcnt_lo_u32_b32 %0, -1, 0\n\tv_mbcnt_hi_u32_b32 %0, -1, %0" : "=v"(l)); return l; }
struct Args { const void* in[27]; float* out; unsigned char* ws; int lo, hi; };
enum { I_XP = 0, I_XS, I_CP, I_CS, I_CK, I_CV, I_PT, I_SD, I_SDC, I_SFC, I_WADA, I_BADA, I_GATT, I_WIN, I_GQ, I_GK, I_SBB, I_GSBO, I_WDNC, I_ALOG, I_DTB, I_GDNO, I_WOUT, I_GFFN, I_WUP, I_WFC, I_WDN };

__device__ __forceinline__ int mod_row(int m) { return m < MP ? (m >> 12) : BP + ((m - MP) >> 3); }

struct EpiF32 {
    static constexpr bool PERM = false, AFTER_DRAIN = false;
    float* O; int ldc;
    __device__ __forceinline__ void operator()(const pg8::f32x4 (&acc)[2][2][4][2], const pg8::Unit& u, int wr, int wc, int fr, int fq) const {
        const int row0 = u.pm * 256 + wr * 64 + fr, col0 = u.pn * 256 + wc * 32 + 4 * fq;
#pragma unroll
        for (int ai = 0; ai < 2; ++ai)
#pragma unroll
            for (int m = 0; m < 4; ++m) { float* rowp = O + (size_t)(row0 + ai * 128 + m * 16) * ldc + col0;
#pragma unroll
                for (int bj = 0; bj < 2; ++bj)
#pragma unroll
                    for (int n = 0; n < 2; ++n) *(pg8::f32x4*)(rowp + bj * 128 + n * 16) = acc[ai][bj][m][n]; }
    }
};
struct EpiResGate {
    static constexpr bool PERM = false, AFTER_DRAIN = false;
    const float* base0; const float* base1; const float* mod; int goff; float* out;
    __device__ __forceinline__ void operator()(const pg8::f32x4 (&acc)[2][2][4][2], const pg8::Unit& u, int wr, int wc, int fr, int fq) const {
        const int row0 = u.pm * 256 + wr * 64 + fr, col0 = u.pn * 256 + wc * 32 + 4 * fq;
#pragma unroll
        for (int ai = 0; ai < 2; ++ai)
#pragma unroll
            for (int m = 0; m < 4; ++m) { const int r = row0 + ai * 128 + m * 16;
                const float* bp = (r < MP ? base0 + (size_t)r * D : base1 + (size_t)(r - MP) * D) + col0;
                const float* gp = mod + (size_t)mod_row(r) * NMOD + goff + col0; float* op = out + (size_t)r * D + col0;
#pragma unroll
                for (int bj = 0; bj < 2; ++bj)
#pragma unroll
                    for (int n = 0; n < 2; ++n) { const pg8::f32x4 b = *(const pg8::f32x4*)(bp + bj * 128 + n * 16), g = *(const pg8::f32x4*)(gp + bj * 128 + n * 16);
                        *(pg8::f32x4*)(op + bj * 128 + n * 16) = b + g * acc[ai][bj][m][n]; } }
    }
};

template <bool BASE_H, bool OUT_H> struct EpiResGateH {
    static constexpr bool PERM = true, AFTER_DRAIN = false;
    const void* base0; const float* mod; int goff; void* out;
    __device__ __forceinline__ void operator()(const pg8::f32x4 (&acc)[2][2][4][2], const pg8::Unit& u, int wr, int wc, int fr, int fq) const {
        const int row0 = u.pm * 256 + wr * 64 + fr, col0 = u.pn * 256 + wc * 32 + 8 * fq;
#pragma unroll
        for (int ai = 0; ai < 2; ++ai)
#pragma unroll
            for (int m = 0; m < 4; ++m) { const int r = row0 + ai * 128 + m * 16;
                const float* gp = mod + (size_t)mod_row(r) * NMOD + goff + col0;
#pragma unroll
                for (int bj = 0; bj < 2; ++bj) {
                    f32x4 b0, b1;
                    if (BASE_H) { const u32x4 w = *(const u32x4*)((const bf16*)base0 + (size_t)r * D + col0 + bj * 128); b0 = bf4lo(w); b1 = bf4hi(w); }
                    else { const float* bp = (const float*)base0 + (size_t)r * D + col0 + bj * 128; b0 = *(const f32x4*)bp; b1 = *(const f32x4*)(bp + 4); }
                    const f32x4 g0 = *(const f32x4*)(gp + bj * 128), g1 = *(const f32x4*)(gp + bj * 128 + 4);
                    const f32x4 o0 = b0 + g0 * acc[ai][bj][m][0], o1 = b1 + g1 * acc[ai][bj][m][1];
                    if (OUT_H) *(u32x4*)((bf16*)out + (size_t)r * D + col0 + bj * 128) = pack8(o0, o1);
                    else { float* op = (float*)out + (size_t)r * D + col0 + bj * 128; *(f32x4*)op = o0; *(f32x4*)(op + 4) = o1; } } }
    }
};

#define DPP_F(old_, src_, ctrl_) __uint_as_float((unsigned)__builtin_amdgcn_update_dpp((int)__float_as_uint(old_), (int)__float_as_uint(src_), (ctrl_), 0xF, 0xF, false))
struct EpiUp {
    static constexpr bool PERM = true, AFTER_DRAIN = false;
    bf16* ACT; bf16* SIDEP; bf16* SIDES; const float* wf; float* out;
    __device__ __forceinline__ void operator()(const pg8::f32x4 (&acc)[2][2][4][2], const pg8::Unit& u, int wr, int wc, int fr, int fq) const {
        const bool prompt_tile = u.pm < MP / 256;
        const unsigned uc0 = (unsigned)(u.pn * 128 + wc * 32 + 8 * fq);
        const unsigned row0 = (unsigned)u.pm * 256u + (unsigned)(wr * 64 + fr);
        if (prompt_tile) {
#pragma unroll
            for (int ai = 0; ai < 2; ++ai) { const unsigned kb = (unsigned)u.pm * 4u + ai * 2 + wr;
                if (fr < 2) { bf16* sp = SIDEP + ((size_t)kb * 4 + fr) * DFF2 + uc0; *(u32x4*)sp = pack8(acc[ai][0][0][0], acc[ai][0][0][1]); *(u32x4*)(sp + DFF) = pack8(acc[ai][1][0][0], acc[ai][1][0][1]); }
                if (fr >= 14) { bf16* sp = SIDEP + ((size_t)kb * 4 + (fr - 12)) * DFF2 + uc0; *(u32x4*)sp = pack8(acc[ai][0][3][0], acc[ai][0][3][1]); *(u32x4*)(sp + DFF) = pack8(acc[ai][1][3][0], acc[ai][1][3][1]); } }
        } else {
            const int t = fr & 7;
#pragma unroll
            for (int ai = 0; ai < 2; ++ai)
#pragma unroll
                for (int m = 0; m < 4; ++m) { const unsigned seq = (row0 + ai * 128 + m * 16 - MP) >> 3;
                    if (t < 2) { bf16* sp = SIDES + ((size_t)seq * 2 + t) * DFF2 + uc0; *(u32x4*)sp = pack8(acc[ai][0][m][0], acc[ai][0][m][1]); *(u32x4*)(sp + DFF) = pack8(acc[ai][1][m][0], acc[ai][1][m][1]); }
                    if (t >= 6) { float* fo = out + O_FCS + ((size_t)seq * 2 + (t - 6)) * DFF2 + uc0;
                        *(pg8::f32x4*)fo = acc[ai][0][m][0]; *(pg8::f32x4*)(fo + 4) = acc[ai][0][m][1]; *(pg8::f32x4*)(fo + DFF) = acc[ai][1][m][0]; *(pg8::f32x4*)(fo + DFF + 4) = acc[ai][1][m][1]; } }
        }
        u32x2 half0[2][4];
#pragma unroll
        for (int n = 0; n < 2; ++n) {
            const float* wp = wf + uc0 + 4 * n;
            const pg8::f32x4 wu0 = *(const pg8::f32x4*)wp, wu1 = *(const pg8::f32x4*)(wp + DFF2), wu2 = *(const pg8::f32x4*)(wp + 2 * DFF2);
            const pg8::f32x4 wg0 = *(const pg8::f32x4*)(wp + DFF), wg1 = *(const pg8::f32x4*)(wp + DFF2 + DFF), wg2 = *(const pg8::f32x4*)(wp + 2 * DFF2 + DFF);
#pragma unroll
            for (int ai = 0; ai < 2; ++ai)
#pragma unroll
                for (int m = 0; m < 4; ++m) {
                    float a[4];
#pragma unroll
                    for (int c = 0; c < 4; ++c) {
                        const float cu = acc[ai][0][m][n][c], cg = acc[ai][1][m][n][c];
                        const float pu = m > 0 ? acc[ai][0][m - 1][n][c] : cu, pg = m > 0 ? acc[ai][1][m - 1][n][c] : cg;
                        const float u1 = DPP_F(DPP_F(0.f, pu, 0x121), cu, 0x111), u2 = DPP_F(DPP_F(0.f, pu, 0x122), cu, 0x112);
                        const float g1 = DPP_F(DPP_F(0.f, pg, 0x121), cg, 0x111), g2 = DPP_F(DPP_F(0.f, pg, 0x122), cg, 0x112);
                        const float yu = wu0[c] * u2 + wu1[c] * u1 + wu2[c] * cu, yg = wg0[c] * g2 + wg1[c] * g1 + wg2[c] * cg;
                        a[c] = siluf(yg) * yu;
                    }
                    u32x2 w; w.x = cvtpk(a[0], a[1]); w.y = cvtpk(a[2], a[3]);
                    if (n == 0) half0[ai][m] = w;
                    else *(u32x4*)(ACT + (size_t)(row0 + ai * 128 + m * 16) * DFF + uc0) = (u32x4){half0[ai][m].x, half0[ai][m].y, w.x, w.y};
                }
        }
    }
};

struct SplitKOrder {
    int nks, G, c;
    __device__ __forceinline__ bool next(int i, pg8::Unit& u) const { const int L = i * G + c; if (L >= 16 * nks) return false; const int su = L & 15, ks = L >> 4; u.pm = MP / 256 + (su >> 2); u.pn = su & 3; u.ko = ks * 256; return true; }
    __device__ __forceinline__ void a_ready(const pg8::Unit&) const {}
    __device__ __forceinline__ void done(const pg8::Unit&) const {}
};
struct EpiSlab {
    static constexpr bool PERM = false, AFTER_DRAIN = false;
    float* slab;
    __device__ __forceinline__ void operator()(const pg8::f32x4 (&acc)[2][2][4][2], const pg8::Unit& u, int wr, int wc, int fr, int fq) const {
        float* O = slab + (size_t)(u.ko >> 8) * ((size_t)MS * D);
        const int row0 = (u.pm - MP / 256) * 256 + wr * 64 + fr, col0 = u.pn * 256 + wc * 32 + 4 * fq;
#pragma unroll
        for (int ai = 0; ai < 2; ++ai)
#pragma unroll
            for (int m = 0; m < 4; ++m) { float* rowp = O + (size_t)(row0 + ai * 128 + m * 16) * D + col0;
#pragma unroll
                for (int bj = 0; bj < 2; ++bj)
#pragma unroll
                    for (int n = 0; n < 2; ++n) *(pg8::f32x4*)(rowp + bj * 128 + n * 16) = acc[ai][bj][m][n]; }
    }
};
__device__ __forceinline__ void st16(void* base, unsigned off, u32x4 v) { *(u32x4*)((unsigned char*)base + off) = v; }
__device__ __forceinline__ void st16f(void* base, unsigned off, pg8::f32x4 v) { *(pg8::f32x4*)((unsigned char*)base + off) = v; }
struct EpiProj {
    static constexpr bool PERM = true, AFTER_DRAIN = false;
    float* out; bf16* QB; bf16* KB; bf16* VB; bf16* DNRAW; bf16* ZG; const float* g_q; const float* g_k; LAS float* xl;
    __device__ __forceinline__ void operator()(const pg8::f32x4 (&acc)[2][2][4][2], const pg8::Unit& u, int wr, int wc, int fr, int fq) const {
        const int pn = u.pn, rl0 = wr * 64 + fr, c0 = wc * 32 + 8 * fq;
        const unsigned row0 = (unsigned)u.pm * 256u + (unsigned)rl0;
        const bool prompt_tile = u.pm < MP / 256;
        if (pn < 4) {
            int xb = (rl0 * 8 + wc) * 4, xb2 = (rl0 * 8 + (wc ^ 1)) * 4; asm volatile("" : "+v"(xb), "+v"(xb2));
            LAS float* xw = (LAS float*)((LAS unsigned char*)xl + xb); const LAS float* xr = (const LAS float*)((LAS unsigned char*)xl + xb2);
#pragma unroll
            for (int ai = 0; ai < 2; ++ai)
#pragma unroll
                for (int m = 0; m < 4; ++m)
#pragma unroll
                    for (int bj = 0; bj < 2; ++bj) { const pg8::f32x4 a = acc[ai][bj][m][0], b = acc[ai][bj][m][1];
                        float ss = (a[0] * a[0] + a[1] * a[1]) + (a[2] * a[2] + a[3] * a[3]) + (b[0] * b[0] + b[1] * b[1]) + (b[2] * b[2] + b[3] * b[3]);
                        ss += __shfl_xor(ss, 16); ss += __shfl_xor(ss, 32);
                        if (fq == 0) xw[(ai * 128 + m * 16) * 8 + bj * 4] = ss; }
            asm volatile("s_waitcnt lgkmcnt(0)" ::: "memory"); __builtin_amdgcn_s_barrier(); asm volatile("" ::: "memory");
            const bool isq = pn < 2; const float* g = isq ? g_q : g_k; const int dloc = 32 * (wc & 1) + 8 * fq;
            const pg8::f32x4 g0 = *(const pg8::f32x4*)(g + dloc), g1 = *(const pg8::f32x4*)(g + dloc + 4);
            bf16* dstb = isq ? QB : KB; float* dstf = prompt_tile ? out + O_KP : out + O_KS - (size_t)MP * SBW;
#pragma unroll
            for (int ai = 0; ai < 2; ++ai)
#pragma unroll
                for (int m = 0; m < 4; ++m) { const unsigned row = row0 + ai * 128 + m * 16;
#pragma unroll
                    for (int bj = 0; bj < 2; ++bj) { const float tot = xw[(ai * 128 + m * 16) * 8 + bj * 4] + xr[(ai * 128 + m * 16) * 8 + bj * 4];
                        const float rs = (isq ? QSCALE : 1.0f) / sqrtf(tot * (1.f / HD) + EPS);
                        const pg8::f32x4 a = acc[ai][bj][m][0] * rs * g0, b = acc[ai][bj][m][1] * rs * g1;
                        const unsigned e = row * SBW + (unsigned)((pn & 1) * 256 + bj * 128 + c0);
                        st16(dstb, e * 2u, pack8(a, b));
                        if (!isq) { st16f(dstf, e * 4u, a); st16f(dstf, e * 4u + 16u, b); } }
                    asm volatile("" ::: "memory"); }
            asm volatile("s_waitcnt lgkmcnt(0)" ::: "memory"); __builtin_amdgcn_s_barrier(); asm volatile("" ::: "memory");
        } else if (pn < 6) {
            float* dstf = prompt_tile ? out + O_VP : out + O_VS - (size_t)MP * SBW;
#pragma unroll
            for (int ai = 0; ai < 2; ++ai)
#pragma unroll
                for (int m = 0; m < 4; ++m) { const unsigned row = row0 + ai * 128 + m * 16;
#pragma unroll
                    for (int bj = 0; bj < 2; ++bj) { const pg8::f32x4 a = acc[ai][bj][m][0], b = acc[ai][bj][m][1]; const unsigned e = row * SBW + (unsigned)((pn & 1) * 256 + bj * 128 + c0);
                        st16(VB, e * 2u, pack8(a, b)); st16f(dstf, e * 4u, a); st16f(dstf, e * 4u + 16u, b); }
                    asm volatile("" ::: "memory"); }
        } else if (pn < 12) {
#pragma unroll
            for (int ai = 0; ai < 2; ++ai)
#pragma unroll
                for (int m = 0; m < 4; ++m) { const unsigned row = row0 + ai * 128 + m * 16;
                    const int b = prompt_tile ? (int)(row >> 12) : (int)((row - MP) >> 3), t = prompt_tile ? (int)(row & 4095) : (int)((row - MP) & 7), idx = prompt_tile ? t - (TP - 3) : t - (TS - 3);
#pragma unroll
                    for (int bj = 0; bj < 2; ++bj) { const pg8::f32x4 a = acc[ai][bj][m][0], b2 = acc[ai][bj][m][1]; const unsigned ch = (unsigned)((pn - 6) * 256 + bj * 128 + c0);
                        st16(DNRAW, (row * 1536u + ch) * 2u, pack8(a, b2));
                        if (idx >= 0) { float* o = prompt_tile ? out + O_DCP : out + O_DCS; const unsigned eo = ((unsigned)(b * 3 + idx) * 1536u + ch) * 4u; st16f(o, eo, a); st16f(o, eo + 16u, b2); } }
                    asm volatile("" ::: "memory"); }
        } else {
#pragma unroll
            for (int ai = 0; ai < 2; ++ai)
#pragma unroll
                for (int m = 0; m < 4; ++m) { const unsigned row = row0 + ai * 128 + m * 16;
#pragma unroll
                    for (int bj = 0; bj < 2; ++bj) { pg8::f32x4 a = acc[ai][bj][m][0], b = acc[ai][bj][m][1]; const unsigned e = row * DNW + (unsigned)((pn - 12) * 256 + bj * 128 + c0);
                        a[0] = siluf(a[0]); a[1] = siluf(a[1]); a[2] = siluf(a[2]); a[3] = siluf(a[3]); b[0] = siluf(b[0]); b[1] = siluf(b[1]); b[2] = siluf(b[2]); b[3] = siluf(b[3]);
                        st16(ZG, e * 2u, pack8(a, b)); }
                    asm volatile("" ::: "memory"); }
        }
    }
};

template <int NT>
__device__ __forceinline__ void mod_tile(const Args& A, LAS unsigned char* lds, int ct, int ct2, int wave, int lane) {
    const float* w_ada = (const float*)A.in[I_WADA]; const float* b_ada = (const float*)A.in[I_BADA];
    const float* cp = (const float*)A.in[I_CP]; const float* cs = (const float*)A.in[I_CS]; float* MOD = (float*)(A.ws + WS_MOD);
    const int lr = lane & 15, q = lane >> 4;
    pg8::f32x4 acc[NT][9];
#pragma unroll
    for (int t = 0; t < NT; ++t)
#pragma unroll
        for (int i = 0; i < 9; ++i) acc[t][i] = (pg8::f32x4){0.f, 0.f, 0.f, 0.f};
#pragma unroll
    for (int s4 = 0; s4 < 4; ++s4) {
        const int k0 = 128 * wave + 32 * s4 + 8 * q;
        bf16x8 bfr[NT];
#pragma unroll
        for (int t = 0; t < NT; ++t) { const float* wp = w_ada + (size_t)k0 * NMOD + (t == 0 ? ct : ct2) * 16 + lr;
            float w[8];
#pragma unroll
            for (int j = 0; j < 8; ++j) w[j] = wp[(size_t)j * NMOD];
            u32x4 bw; bw.x = cvtpk(w[0], w[1]); bw.y = cvtpk(w[2], w[3]); bw.z = cvtpk(w[4], w[5]); bw.w = cvtpk(w[6], w[7]);
            bfr[t] = __builtin_bit_cast(bf16x8, bw); }
#pragma unroll
        for (int i = 0; i < 9; ++i) { const int row = 16 * i + lr;
            f32x4 c0 = (f32x4){0.f, 0.f, 0.f, 0.f}, c1 = c0;
            if (row < NC) { const float* crow_ = (row < BP ? cp + (size_t)row * D : cs + (size_t)(row - BP) * D) + k0; c0 = *(const f32x4*)crow_; c1 = *(const f32x4*)(crow_ + 4); }
            c0.x = siluf(c0.x); c0.y = siluf(c0.y); c0.z = siluf(c0.z); c0.w = siluf(c0.w); c1.x = siluf(c1.x); c1.y = siluf(c1.y); c1.z = siluf(c1.z); c1.w = siluf(c1.w);
            const bf16x8 afr = __builtin_bit_cast(bf16x8, pack8(c0, c1));
#pragma unroll
            for (int t = 0; t < NT; ++t) acc[t][i] = __builtin_amdgcn_mfma_f32_16x16x32_bf16(afr, bfr[t], acc[t][i], 0, 0, 0); }
    }
    LAS pg8::f32x4* red = (LAS pg8::f32x4*)lds;
#pragma unroll
    for (int t = 0; t < NT; ++t) {
        const int col = (t == 0 ? ct : ct2) * 16 + lr;
#pragma unroll
        for (int i = 0; i < 9; ++i) red[(wave * 9 + i) * 64 + lane] = acc[t][i];
        __syncthreads();
        for (int i = wave; i < 9; i += 8) {
            pg8::f32x4 tt = red[i * 64 + lane];
#pragma unroll
            for (int w2 = 1; w2 < 8; ++w2) tt += red[(w2 * 9 + i) * 64 + lane];
            const float bb = b_ada[col];
#pragma unroll
            for (int r = 0; r < 4; ++r) { const int row = 16 * i + 4 * q + r; if (row < NC) MOD[(size_t)row * NMOD + col] = tt[r] + bb; }
        }
        __syncthreads();
    }
}
__device__ __forceinline__ void transpose_item(const float* W, int ldw, int src_col0, bf16* WT, int Kdst, int dst_row0, int k0, LAS float* scr, int lane) {
#pragma unroll
    for (int h2 = 0; h2 < 2; ++h2) { float v[16];
#pragma unroll
        for (int i = 0; i < 16; ++i) v[i] = W[(size_t)(k0 + 2 * (16 * h2 + i) + (lane >> 5)) * ldw + src_col0 + (lane & 31)];
#pragma unroll
        for (int i = 0; i < 16; ++i) scr[(2 * (16 * h2 + i) + (lane >> 5)) * 33 + (lane & 31)] = v[i]; }
    asm volatile("s_waitcnt lgkmcnt(0)" ::: "memory");
    const int c = lane & 7;
#pragma unroll
    for (int j = 0; j < 4; ++j) { const int n = (lane >> 3) + 8 * j; const LAS float* s = scr + (8 * c) * 33 + n;
        u32x4 o; o.x = cvtpk(s[0 * 33], s[1 * 33]); o.y = cvtpk(s[2 * 33], s[3 * 33]); o.z = cvtpk(s[4 * 33], s[5 * 33]); o.w = cvtpk(s[6 * 33], s[7 * 33]);
        *(u32x4*)(WT + (size_t)(dst_row0 + n) * Kdst + k0 + 8 * c) = o; }
    asm volatile("s_waitcnt lgkmcnt(0)" ::: "memory");
}
__device__ __forceinline__ void phase_prologue(const Args& A, LAS unsigned char* lds, gu32* qhead, int bx, int G, int wave, int lane, int gtid, int NGT) {
    unsigned char* ws = A.ws;
    const float* w_in = (const float*)A.in[I_WIN]; const float* w_out = (const float*)A.in[I_WOUT]; const float* w_up = (const float*)A.in[I_WUP]; const float* w_dn = (const float*)A.in[I_WDN];
    float* WX = (float*)(ws + WS_WINX);
    for (int i = gtid; i < 8 * D; i += NGT) { const int j = i >> 10, k = i & 1023; WX[i] = w_in[(size_t)k * IN_COLS + 3072 + j]; }
    { const int vcu = (G % 8 == 0) ? (bx % 8) * (G / 8) + bx / 8 : bx;
      int ct = vcu;
      for (; ct + G < NMOD / 16; ct += 2 * G) mod_tile<2>(A, lds, ct, ct + G, wave, lane);
      if (ct < NMOD / 16) mod_tile<1>(A, lds, ct, ct, wave, lane); }
    LAS float* scr = (LAS float*)(lds + wave * 16384);
    constexpr int I_IN = 16 * (NPROJ / 32), I_OUT = 16 * 32, I_UP = 16 * (DFF2 / 32), I_DN = (DFF / 64) * 32, NIT = I_IN + I_OUT + I_UP + I_DN;
    const int vcu2 = (G % 8 == 0) ? (bx % 8) * (G / 8) + bx / 8 : bx; const int nfirst = 2 * G * 8 < NIT ? 2 * G * 8 : NIT;
    const bool special = (G < NMOD / 16) && (2 * G > NMOD / 16), light = vcu2 >= NMOD / 16 - G; const int nlw = (2 * G - NMOD / 16) * 8;
    const int lw = (vcu2 - (NMOD / 16 - G)) * 8 + wave;
    for (int k_ = 0;; ++k_) {
        int it_;
        if (k_ < 2) { it_ = (bx * 8 + wave) + k_ * G * 8; if (it_ >= nfirst) continue; }
        else if (!special) { it_ = nfirst + (bx * 8 + wave) + (k_ - 2) * G * 8; if (it_ >= NIT) break; }
        else { if (!light) break; it_ = nfirst + lw + (k_ - 2) * nlw; if (it_ >= NIT) break; }
        int r = it_;
        if (r < I_IN) { const int nb = r % (NPROJ / 32), kb = r / (NPROJ / 32); const int n0 = nb * 32; transpose_item(w_in, IN_COLS, n0 < 3072 ? n0 : n0 + 8, (bf16*)(ws + WS_WIN_T), D, n0, kb * 64, scr, lane); continue; } r -= I_IN;
        if (r < I_OUT) { const int nb = r % 32, kb = r / 32; transpose_item(w_out, D, nb * 32, (bf16*)(ws + WS_WOUT_T), D, nb * 32, kb * 64, scr, lane); continue; } r -= I_OUT;
        if (r < I_UP) { const int nb = r % (DFF2 / 32), kb = r / (DFF2 / 32), n0 = nb * 32;
            const int dr = n0 < DFF ? (n0 >> 7) * 256 + (n0 & 127) : ((n0 - DFF) >> 7) * 256 + 128 + ((n0 - DFF) & 127);
            transpose_item(w_up, DFF2, n0, (bf16*)(ws + WS_WUP_T), D, dr, kb * 64, scr, lane); continue; } r -= I_UP;
        { const int nb = r % 32, kb = r / 32; transpose_item(w_dn, D, nb * 32, (bf16*)(ws + WS_WDN_T), DFF, nb * 32, kb * 64, scr, lane); }
    }
}

template <bool EXTRAS, int NS = 0, bool X0H = false>
__device__ __forceinline__ void phase_norm(const float* x0, const float* x1, const float* g, const float* MOD, int sh_off, int sc_off, bf16* H, const float* WX, float* EXTRA, int gw, int NGW, int lane, const float* slab = nullptr, int gate_off = 0, float* x1w = nullptr) {
    f32x4 wxr[4][8];
    if (EXTRAS) {
#pragma unroll
        for (int j = 0; j < 4; ++j)
#pragma unroll
            for (int e = 0; e < 8; ++e) wxr[j][e] = *(const f32x4*)(WX + e * D + 4 * (lane + 64 * j));
    }
    f32x4 nv[4]; u32x2 nh[4];
#define NORM_LOADX(mm_) do { if (X0H && (mm_) < MP) { const bf16* xh_ = (const bf16*)x0 + (size_t)(mm_) * D; _Pragma("unroll") for (int j = 0; j < 4; ++j) nh[j] = *(const u32x2*)(xh_ + 4 * (lane + 64 * j)); } \
        else { const float* xr_ = (mm_) < MP ? x0 + (size_t)(mm_) * D : x1 + (size_t)((mm_) - MP) * D; _Pragma("unroll") for (int j = 0; j < 4; ++j) nv[j] = *(const f32x4*)(xr_ + 4 * (lane + 64 * j)); } } while (0)
    if (gw < M) NORM_LOADX(gw);
    f32x4 ggv[4];
#pragma unroll
    for (int j = 0; j < 4; ++j) ggv[j] = *(const f32x4*)(g + 4 * (lane + 64 * j));
    for (int m = gw; m < M; m += NGW) {
        const float* mod = MOD + (size_t)mod_row(m) * NMOD;
        f32x4 scv[4], shv[4];
#pragma unroll
        for (int j = 0; j < 4; ++j) { scv[j] = *(const f32x4*)(mod + sc_off + 4 * (lane + 64 * j)); shv[j] = *(const f32x4*)(mod + sh_off + 4 * (lane + 64 * j)); }
        asm volatile("" ::: "memory");
        f32x4 v[4]; float ss = 0.f;
        if (X0H && m < MP) {
#pragma unroll
            for (int j = 0; j < 4; ++j) v[j] = (f32x4){__uint_as_float(nh[j].x << 16), __uint_as_float(nh[j].x & 0xffff0000u), __uint_as_float(nh[j].y << 16), __uint_as_float(nh[j].y & 0xffff0000u)};
        } else {
#pragma unroll
            for (int j = 0; j < 4; ++j) v[j] = nv[j];
        }
        { const int mn = m + NGW; if (mn < M) NORM_LOADX(mn); }
#pragma unroll
        for (int j = 0; j < 4; ++j) {
            if (NS > 0 && m >= MP) { f32x4 a = (f32x4){0.f, 0.f, 0.f, 0.f};
#pragma unroll
                for (int k = 0; k < NS; ++k) a += *(const f32x4*)(slab + ((size_t)k * MS + (m - MP)) * D + 4 * (lane + 64 * j));
                v[j] += *(const f32x4*)(mod + gate_off + 4 * (lane + 64 * j)) * a;
                *(f32x4*)(x1w + (size_t)m * D + 4 * (lane + 64 * j)) = v[j]; }
            ss += (v[j].x * v[j].x + v[j].y * v[j].y) + (v[j].z * v[j].z + v[j].w * v[j].w); }
        ss = wave_sum(ss);
        const float rstd = 1.0f / sqrtf(ss * (1.f / D) + EPS);
        float ex[8];
#pragma unroll
        for (int e = 0; e < 8; ++e) ex[e] = 0.f;
#pragma unroll
        for (int j = 0; j < 4; ++j) { const int c = 4 * (lane + 64 * j);
            const f32x4 gg = ggv[j], sc = scv[j], sh = shv[j];
            const f32x4 h = (v[j] * rstd) * gg * (sc + 1.0f) + sh;
            u32x2 w; w.x = cvtpk(h.x, h.y); w.y = cvtpk(h.z, h.w); *(u32x2*)(H + (size_t)m * D + c) = w;
            if (EXTRAS) {
#pragma unroll
                for (int e = 0; e < 8; ++e) { const f32x4 wx = wxr[j][e]; ex[e] += (h.x * wx.x + h.y * wx.y) + (h.z * wx.z + h.w * wx.w); }
            }
        }
        if (EXTRAS) {
            float a4[4], a2[2], a1;
#pragma unroll
            for (int j = 0; j < 4; ++j) { const bool up = lane & 1; const float send = up ? ex[j] : ex[j + 4], keep = up ? ex[j + 4] : ex[j]; a4[j] = keep + __shfl_xor(send, 1); }
#pragma unroll
            for (int j = 0; j < 2; ++j) { const bool up = lane & 2; const float send = up ? a4[j] : a4[j + 2], keep = up ? a4[j + 2] : a4[j]; a2[j] = keep + __shfl_xor(send, 2); }
            { const bool up = lane & 4; const float send = up ? a2[0] : a2[1], keep = up ? a2[1] : a2[0]; a1 = keep + __shfl_xor(send, 4); }
            a1 += __shfl_xor(a1, 8); a1 += __shfl_xor(a1, 16); a1 += __shfl_xor(a1, 32);
            if (lane < 8) EXTRA[(size_t)m * 8 + (4 * (lane & 1) + 2 * ((lane >> 1) & 1) + ((lane >> 2) & 1))] = a1;
        }
    }
}

template <int R> __device__ __forceinline__ void post_strip(const Args& A, int m0, int part, int lane) {
    unsigned char* ws = A.ws; const bf16* DNRAW = (const bf16*)(ws + WS_DNRAW);
    const float* wc = (const float*)A.in[I_WDNC]; const float* sdc = (const float*)A.in[I_SDC];
    bf16* dstb = (part == 0 ? (bf16*)(ws + WS_QD) : part == 1 ? (bf16*)(ws + WS_KD) : (bf16*)(ws + WS_VD));
    const bool prompt = m0 < MP; const int b = prompt ? (m0 >> 12) : ((m0 - MP) >> 3), t0 = prompt ? (m0 & 4095) : ((m0 - MP) & 7);
    const int ch = part * 512 + 8 * lane;
    f32x4 w[4][2];
#pragma unroll
    for (int i = 0; i < 4; ++i) { w[i][0] = *(const f32x4*)(wc + i * 1536 + ch); w[i][1] = *(const f32x4*)(wc + i * 1536 + ch + 4); }
    f32x4 x[3][2];
#pragma unroll
    for (int j = 0; j < 3; ++j) { const int tt = t0 - 3 + j;
        if (tt >= 0) { const u32x4 r = *(const u32x4*)(DNRAW + (size_t)(m0 - 3 + j) * 1536 + ch); x[j][0] = bf4lo(r); x[j][1] = bf4hi(r); }
        else if (!prompt) { const float* p = sdc + ((size_t)b * 3 + (3 + tt)) * 1536 + ch; x[j][0] = *(const f32x4*)p; x[j][1] = *(const f32x4*)(p + 4); }
        else { x[j][0] = (f32x4){0.f, 0.f, 0.f, 0.f}; x[j][1] = x[j][0]; } }
    const bf16* src = DNRAW + (size_t)m0 * 1536 + ch;
    u32x4 rows[R];
#pragma unroll
    for (int r = 0; r < R; ++r) rows[r] = *(const u32x4*)(src + (size_t)r * 1536);
#pragma unroll
    for (int r = 0; r < R; ++r) {
        const u32x4 cw = rows[r];
        const f32x4 c0 = bf4lo(cw), c1 = bf4hi(cw);
        f32x4 y0 = w[0][0] * x[0][0] + w[1][0] * x[1][0] + w[2][0] * x[2][0] + w[3][0] * c0;
        f32x4 y1 = w[0][1] * x[0][1] + w[1][1] * x[1][1] + w[2][1] * x[2][1] + w[3][1] * c1;
        x[0][0] = x[1][0]; x[0][1] = x[1][1]; x[1][0] = x[2][0]; x[1][1] = x[2][1]; x[2][0] = c0; x[2][1] = c1;
        y0.x = siluf(y0.x); y0.y = siluf(y0.y); y0.z = siluf(y0.z); y0.w = siluf(y0.w); y1.x = siluf(y1.x); y1.y = siluf(y1.y); y1.z = siluf(y1.z); y1.w = siluf(y1.w);
        if (part < 2) {
            float ss = (y0.x * y0.x + y0.y * y0.y) + (y0.z * y0.z + y0.w * y0.w) + (y1.x * y1.x + y1.y * y1.y) + (y1.z * y1.z + y1.w * y1.w);
            ss += __shfl_xor(ss, 1); ss += __shfl_xor(ss, 2); ss += __shfl_xor(ss, 4); ss += __shfl_xor(ss, 8);
            const float rs = (part == 0 ? 0.08838834764831845f : 1.0f) / sqrtf(ss + EPS);
            y0 = y0 * rs; y1 = y1 * rs;
        }
        *(u32x4*)(dstb + (size_t)(m0 + r) * DNW + 8 * lane) = pack8(y0, y1);
    }
}
__device__ __forceinline__ void phase_post(const Args& A, int gw, int NGW, int lane, int gtid, int NGT) {
    constexpr int NPI = (MP / 16) * 3, NSI = BS * 3;
    for (int it = gw; it < NPI + NSI; it += NGW) {
        if (it < NPI) post_strip<16>(A, (it / 3) * 16, it % 3, lane);
        else { const int j = it - NPI; post_strip<8>(A, MP + (j / 3) * 8, j % 3, lane); }
    }
    unsigned char* ws = A.ws; const float* a_log = (const float*)A.in[I_ALOG]; const float* dtb = (const float*)A.in[I_DTB];
    float* BETA = (float*)(ws + WS_BETA); float* LOGA = (float*)(ws + WS_LOGA); const float* EXTRA = (const float*)(ws + WS_EXTRA);
    for (int i = gtid; i < M * 8; i += NGT) { const int m = i >> 3, j = i & 7; const float x = EXTRA[i];
        if (j < 4) BETA[m * 4 + j] = 1.f / (1.f + __expf(-x));
        else { const int h = j - 4; const float z = x + dtb[h]; const float sp = fmaxf(z, 0.f) + log1pf(__expf(-fabsf(z))); LOGA[m * 4 + h] = -__expf(a_log[h]) * sp; } }
}

template <int B0, int B1> __device__ __forceinline__ void subst_rows(float (&x)[64], const LAS float* Am) {
#pragma unroll
    for (int ib = B0; ib < B1; ++ib) {
        float r[4];
#pragma unroll
        for (int rr = 0; rr < 4; ++rr) r[rr] = x[4 * ib + rr];
#pragma unroll
        for (int j4 = 0; j4 < ib; ++j4) {
#pragma unroll
            for (int rr = 0; rr < 4; ++rr) { const f32x4 a = *(const LAS f32x4*)(Am + (4 * ib + rr) * 64 + 4 * j4);
                r[rr] -= (a.x * x[4 * j4] + a.y * x[4 * j4 + 1]) + (a.z * x[4 * j4 + 2] + a.w * x[4 * j4 + 3]); }
        }
        const f32x4 d1 = *(const LAS f32x4*)(Am + (4 * ib + 1) * 64 + 4 * ib), d2 = *(const LAS f32x4*)(Am + (4 * ib + 2) * 64 + 4 * ib), d3 = *(const LAS f32x4*)(Am + (4 * ib + 3) * 64 + 4 * ib);
        r[1] -= d1.x * r[0];
        r[2] -= d2.x * r[0] + d2.y * r[1];
        r[3] -= (d3.x * r[0] + d3.y * r[1]) + d3.z * r[2];
#pragma unroll
        for (int rr = 0; rr < 4; ++rr) x[4 * ib + rr] = r[rr];
    }
}
constexpr int PS_INT = 34816, PS_STG = 53248;
template <int LEVEL = 0>
__device__ __forceinline__ void dn_prescan_unit(const Args& A, LAS unsigned char* lds, int unit, int tid, int wave, int lane) {
    unsigned char* ws = A.ws;
    const bf16* QD = (const bf16*)(ws + WS_QD); const bf16* KD = (const bf16*)(ws + WS_KD); const bf16* VD = (const bf16*)(ws + WS_VD);
    const float* BETA = (const float*)(ws + WS_BETA); const float* LOGA = (const float*)(ws + WS_LOGA);
    const int hp = unit & 1, n = (unit >> 1) & 63, b = unit >> 7;
    const int half = tid >> 8, ht = tid & 255, h = 2 * hp + half, item = (b * 64 + n) * 4 + h;
    const int m0 = b * TP + n * 64;
    LAS float* Am = (LAS float*)lds + half * 4096;
    LAS float* gs = (LAS float*)(lds + 32768) + half * 128;
    if (ht < 64) {
        float v = LOGA[(size_t)(m0 + ht) * 4 + h];
#pragma unroll
        for (int o = 1; o < 64; o <<= 1) { const float u = __shfl_up(v, o); if (ht >= o) v += u; }
        gs[ht] = v; gs[64 + ht] = BETA[(size_t)(m0 + ht) * 4 + h];
    }
    __syncthreads();
    {
        const int wl = wave & 3, lr = lane & 15, q = lane >> 4;
        pg8::f32x4 kk[4], qk[4];
#pragma unroll
        for (int j = 0; j < 4; ++j) { kk[j] = (pg8::f32x4){0.f, 0.f, 0.f, 0.f}; qk[j] = kk[j]; }
#pragma unroll
        for (int s = 0; s < 4; ++s) {
            const bf16x8 ak = *(const bf16x8*)(KD + (size_t)(m0 + 16 * wl + lr) * DNW + h * 128 + 32 * s + 8 * q), aq = *(const bf16x8*)(QD + (size_t)(m0 + 16 * wl + lr) * DNW + h * 128 + 32 * s + 8 * q);
#pragma unroll
            for (int j = 0; j < 4; ++j) { const bf16x8 bk = *(const bf16x8*)(KD + (size_t)(m0 + 16 * j + lr) * DNW + h * 128 + 32 * s + 8 * q);
                kk[j] = __builtin_amdgcn_mfma_f32_16x16x32_bf16(ak, bk, kk[j], 0, 0, 0); qk[j] = __builtin_amdgcn_mfma_f32_16x16x32_bf16(aq, bk, qk[j], 0, 0, 0); }
        }
#pragma unroll
        for (int j = 0; j < 4; ++j)
#pragma unroll
            for (int r = 0; r < 4; ++r) { const int i = 16 * wl + 4 * q + r, jj = 16 * j + lr;
                const float dec = (i >= jj) ? __expf(gs[i] - gs[jj]) : 0.f;
                Am[i * 64 + jj] = (i > jj) ? gs[64 + i] * kk[j][r] * dec : 0.f;
                *(LAS bf16*)(lds + PS_INT + half * 9216 + i * 144 + jj * 2) = f2bf(qk[j][r] * dec); }
    }
    __syncthreads();
    if constexpr (LEVEL == 1) { __syncthreads(); return; }
    {
        const int c = ht;
        float* U = (float*)(ws + WS_U) + (size_t)item * 8192; bf16* KC = (bf16*)(ws + WS_KCUM) + (size_t)item * 8192;
        float x[64];
        { const bf16* rsrc = (ht < 128 ? VD : KD) + (size_t)m0 * DNW + h * 128 + (ht & 127);
#pragma unroll
          for (int i = 0; i < 64; ++i) x[i] = bf2f(rsrc[(size_t)i * DNW]); }
#pragma unroll
        for (int i = 0; i < 64; ++i) { const float eg = __expf(gs[i]); x[i] *= gs[64 + i] * (c >= 128 ? eg : 1.0f); }
        { bf16* INTRA = (bf16*)(ws + WS_INTRA) + (size_t)item * 4096;
#pragma unroll
          for (int j = 0; j < 2; ++j) { const int k = ht + 256 * j, row = k >> 3, c8 = (k & 7) * 8; *(u32x4*)(INTRA + row * 64 + c8) = *(const LAS u32x4*)(lds + PS_INT + half * 9216 + row * 144 + c8 * 2); } }
        subst_rows<0, 6>(x, Am); subst_rows<6, 10>(x, Am); subst_rows<10, 13>(x, Am); subst_rows<13, 16>(x, Am);
        if constexpr (LEVEL == 2) { float sk = 0.f; _Pragma("unroll") for (int i = 0; i < 64; ++i) sk += x[i]; asm volatile("" :: "v"(sk)); __syncthreads(); return; }
        LAS float* stg = (LAS float*)(lds + PS_STG + half * 33280);
#pragma unroll
        for (int ps = 0; ps < 2; ++ps) {
            if (ps) __syncthreads();
#pragma unroll
            for (int i = 0; i < 32; ++i) stg[i * 260 + c] = x[32 * ps + i];
            __syncthreads();
#pragma unroll
            for (int j = 0; j < 4; ++j) { const int k = ht + 256 * j, il = k >> 9, w_ = (k >> 6) & 7, ln = k & 63, rb = 16 * il + 4 * (ln >> 4), cc = 16 * w_ + (ln & 15);
                *(f32x4*)(U + (((2 * ps + il) * 8 + w_) * 64 + ln) * 4) = (f32x4){stg[rb * 260 + cc], stg[(rb + 1) * 260 + cc], stg[(rb + 2) * 260 + cc], stg[(rb + 3) * 260 + cc]}; }
#pragma unroll
            for (int j = 0; j < 2; ++j) { const int k = ht + 256 * j, row = k >> 4, c8 = (k & 15) * 8; const LAS float* sp = stg + row * 260 + 128 + c8;
                *(u32x4*)(KC + (32 * ps + row) * 128 + c8) = pack8(*(const LAS f32x4*)sp, *(const LAS f32x4*)(sp + 4)); }
        }
    }
    if constexpr (LEVEL == 3) { __syncthreads(); return; }
    {
        const float glast = gs[63];
        bf16* QDc = (bf16*)(ws + WS_QDEC) + (size_t)item * 8192; bf16* KT = (bf16*)(ws + WS_KDECT) + (size_t)item * 8192;
#pragma unroll
        for (int j = 0; j < 4; ++j) { const int k = ht + 256 * j, row = k >> 4, c8 = (k & 15) * 8; const u32x4 qw = *(const u32x4*)(QD + (size_t)(m0 + row) * DNW + h * 128 + c8); const float eg = __expf(gs[row]);
            *(u32x4*)(QDc + row * 128 + c8) = pack8(bf4lo(qw) * eg, bf4hi(qw) * eg); }
        { const int d = ht & 127, ig = ht >> 7;
#pragma unroll
            for (int i8 = 0; i8 < 4; ++i8) { float v[8];
#pragma unroll
                for (int k = 0; k < 8; ++k) { const int i = 32 * ig + 8 * i8 + k; v[k] = bf2f(KD[(size_t)(m0 + i) * DNW + h * 128 + d]) * __expf(glast - gs[i]); }
                u32x4 w; w.x = cvtpk(v[0], v[1]); w.y = cvtpk(v[2], v[3]); w.z = cvtpk(v[4], v[5]); w.w = cvtpk(v[6], v[7]);
                *(u32x4*)(KT + d * 64 + 32 * ig + 8 * i8) = w; } }
        if (ht == 0) ((float*)(ws + WS_GL))[item] = __expf(glast);
    }
    __syncthreads();
}
template <int NU>
__device__ __forceinline__ void dn_sample_units(const Args& A, LAS unsigned char* lds, int unit0, int ustride, int tid) {
    unsigned char* ws = A.ws;
    const bf16* QD = (const bf16*)(ws + WS_QD);
    const float* BETA = (const float*)(ws + WS_BETA); const float* LOGA = (const float*)(ws + WS_LOGA); float* ODN = (float*)(ws + WS_ODN);
    const int e = tid & 127, dq = tid >> 7; const unsigned loff = (unsigned)(32 * dq * 128 + e);
    float S[NU][32];
#pragma unroll
    for (int u = 0; u < NU; ++u) { const int unit = unit0 + u * ustride, h = unit & 3, b = unit >> 2;
        const float* s0 = (const float*)A.in[I_SD] + (size_t)(b * 4 + h) * 16384;
#pragma unroll
        for (int d = 0; d < 32; ++d) S[u][d] = s0[loff + (unsigned)(d * 128)]; }
    constexpr int UF = 4112;
#pragma unroll
    for (int u = 0; u < NU; ++u) { const int unit = unit0 + u * ustride, h = unit & 3, b = unit >> 2; LAS float* tk = (LAS float*)lds + u * UF + 1024;
#pragma unroll
        for (int j = 0; j < 6; ++j) { const int i = tid + 512 * j, t = i / 384, c = i % 384, part = c >> 7; const int m = MP + b * TS + t;
            const unsigned sel = part == 0 ? 1u : part == 1 ? 0u : 2u;
            tk[i] = bf2f(QD[sel * (unsigned)((WS_KD - WS_QD) / 2) + (unsigned)m * DNW + h * 128 + (c & 127)]); }
        if (tid < 16) { const size_t m = (size_t)(MP + b * TS + (tid >> 1)); tk[3072 + tid] = (tid & 1) ? BETA[m * 4 + h] : __expf(LOGA[m * 4 + h]); } }
    __syncthreads();
    for (int t = 0; t < TS; ++t) {
#pragma unroll
        for (int u = 0; u < NU; ++u) { LAS float* red = (LAS float*)lds + u * UF; const LAS float* kp = red + 1024 + t * 384 + 32 * dq;
            float p0 = 0.f, p1 = 0.f;
#pragma unroll
            for (int d4 = 0; d4 < 8; ++d4) { const f32x4 kv = *(const LAS f32x4*)(kp + 4 * d4);
                p0 += kv.x * S[u][4 * d4] + kv.z * S[u][4 * d4 + 2]; p1 += kv.y * S[u][4 * d4 + 1] + kv.w * S[u][4 * d4 + 3]; }
            red[dq * 128 + e] = p0 + p1; }
        __syncthreads();
#pragma unroll
        for (int u = 0; u < NU; ++u) { LAS float* red = (LAS float*)lds + u * UF; LAS float* red2 = red + 512; const LAS float* tk = red + 1024;
            const float a = tk[3072 + 2 * t], bt = tk[3072 + 2 * t + 1];
            const float kS = (red[e] + red[128 + e]) + (red[256 + e] + red[384 + e]);
            const float dl = bt * (tk[t * 384 + 256 + e] - a * kS);
            const LAS float* kp = tk + t * 384 + 32 * dq; const LAS float* qp = kp + 128;
            float po0 = 0.f, po1 = 0.f;
#pragma unroll
            for (int d4 = 0; d4 < 8; ++d4) { const f32x4 kv = *(const LAS f32x4*)(kp + 4 * d4), qv = *(const LAS f32x4*)(qp + 4 * d4);
                S[u][4 * d4] = a * S[u][4 * d4] + kv.x * dl; po0 += qv.x * S[u][4 * d4]; S[u][4 * d4 + 1] = a * S[u][4 * d4 + 1] + kv.y * dl; po1 += qv.y * S[u][4 * d4 + 1];
                S[u][4 * d4 + 2] = a * S[u][4 * d4 + 2] + kv.z * dl; po0 += qv.z * S[u][4 * d4 + 2]; S[u][4 * d4 + 3] = a * S[u][4 * d4 + 3] + kv.w * dl; po1 += qv.w * S[u][4 * d4 + 3]; }
            red2[dq * 128 + e] = po0 + po1; }
        __syncthreads();
        if (dq == 0) {
#pragma unroll
            for (int u = 0; u < NU; ++u) { const int unit = unit0 + u * ustride, h = unit & 3, b = unit >> 2; const LAS float* red2 = (LAS float*)lds + u * UF + 512;
                ODN[(size_t)(MP + b * TS + t) * DNW + h * 128 + e] = (red2[e] + red2[128 + e]) + (red2[256 + e] + red2[384 + e]); } }
    }
#pragma unroll
    for (int u = 0; u < NU; ++u) { const int unit = unit0 + u * ustride, h = unit & 3, b = unit >> 2;
        float* so = A.out + O_SS + (size_t)(b * 4 + h) * 16384;
#pragma unroll
        for (int d = 0; d < 32; ++d) so[loff + (unsigned)(d * 128)] = S[u][d]; }
    __syncthreads();
}

constexpr int SC_KC = 0, SC_QD = 17408, SC_KT = 34816, SC_IN = 53248, SC_BUF = 62464;
__device__ __forceinline__ void dn_scan_chain(const Args& A, LAS unsigned char* lds, int chain, int tid, int wave, int lane) {
    unsigned char* ws = A.ws;
    const float* Ub = (const float*)(ws + WS_U); const float* GL = (const float*)(ws + WS_GL); float* ODN = (float*)(ws + WS_ODN);
    const int b = chain >> 2, h = chain & 3, lr = lane & 15, q = lane >> 4, e = 16 * wave + lr;
    int ldst[7];
    { const int c0 = tid, c1 = tid + 512;
      ldst[0] = SC_KC + (c0 >> 4) * 272; ldst[1] = SC_KC + (c1 >> 4) * 272; ldst[2] = SC_QD + (c0 >> 4) * 272; ldst[3] = SC_QD + (c1 >> 4) * 272;
      ldst[4] = SC_KT + (c0 >> 3) * 144; ldst[5] = SC_KT + (c1 >> 3) * 144; ldst[6] = SC_IN + (c0 >> 3) * 144; }
    const int cb_ = tid & 3, hA_ = (8 * ((2 * cb_) & 3) + 4 * (cb_ >> 1)) * 2, hB_ = (8 * ((2 * cb_ + 1) & 3) + 4 * (cb_ >> 1)) * 2;
    const int o16A = ((tid & 15) >> 2) * 64 + hA_, o16B = ((tid & 15) >> 2) * 64 + hB_, o8A = ((tid & 7) >> 2) * 64 + hA_, o8B = ((tid & 7) >> 2) * 64 + hB_;
    const size_t item0 = (size_t)(b * 64) * 4 + h;
    const unsigned char* gKC = ws + WS_KCUM + item0 * 16384; const unsigned char* gQD = ws + WS_QDEC + item0 * 16384; const unsigned char* gKT = ws + WS_KDECT + item0 * 16384; const unsigned char* gIN = ws + WS_INTRA + item0 * 8192;
    const unsigned t16 = (unsigned)tid * 16u, ulane = (unsigned)(wave * 64 + lane) * 4u;
    u32x4 R[7]; float un[16], uc[16];
#define SC_GLOAD(n_) do { const size_t o16_ = (size_t)(n_) * 4 * 16384, o8_ = (size_t)(n_) * 4 * 8192; \
        R[0] = *(const u32x4*)(gKC + o16_ + t16); R[1] = *(const u32x4*)(gKC + o16_ + 8192 + t16); R[2] = *(const u32x4*)(gQD + o16_ + t16); R[3] = *(const u32x4*)(gQD + o16_ + 8192 + t16); \
        R[4] = *(const u32x4*)(gKT + o16_ + t16); R[5] = *(const u32x4*)(gKT + o16_ + 8192 + t16); R[6] = *(const u32x4*)(gIN + o8_ + t16); \
        const float* U_ = Ub + (item0 + 4 * (size_t)(n_)) * 8192; \
        _Pragma("unroll") for (int i_ = 0; i_ < 4; ++i_) { const f32x4 u_ = *(const f32x4*)(U_ + (ulane + (unsigned)(i_ * 2048))); un[4 * i_] = u_.x; un[4 * i_ + 1] = u_.y; un[4 * i_ + 2] = u_.z; un[4 * i_ + 3] = u_.w; } } while (0)
#define SC_LWRITE(buf_) do { _Pragma("unroll") for (int k_ = 0; k_ < 7; ++k_) { LAS unsigned char* d_ = lds + (buf_) * SC_BUF + ldst[k_]; \
        *(LAS u32x2*)(d_ + (k_ < 4 ? o16A : o8A)) = (u32x2){R[k_].x, R[k_].y}; *(LAS u32x2*)(d_ + (k_ < 4 ? o16B : o8B)) = (u32x2){R[k_].z, R[k_].w}; } } while (0)
#define SC_BARRIER() do { asm volatile("s_waitcnt lgkmcnt(0)" ::: "memory"); __builtin_amdgcn_s_barrier(); asm volatile("" ::: "memory"); } while (0)
#define SC_FRAG(off_, pitch_, row_, s_) (*(const LAS bf16x8*)(B + (off_) + (row_) * (pitch_) + (32 * (s_) + 8 * q) * 2))
    pg8::f32x4 S[8];
#pragma unroll
    for (int i = 0; i < 8; ++i) S[i] = (pg8::f32x4){0.f, 0.f, 0.f, 0.f};
    const float glv = GL[item0 + 4 * (size_t)lane];
    __syncthreads();
    SC_GLOAD(0); SC_LWRITE(0);
#pragma unroll
    for (int k = 0; k < 16; ++k) uc[k] = un[k];
    __syncthreads();
    for (int n = 0; n < 64; ++n) {
        const float gl = __uint_as_float(__builtin_amdgcn_readlane(__float_as_uint(glv), n));
        if (n + 1 < 64) SC_GLOAD(n + 1);
        const LAS unsigned char* B = lds + (n & 1) * SC_BUF;
        bf16x8 Sb[4];
#pragma unroll
        for (int s = 0; s < 4; ++s) { u32x4 w; w.x = cvtpk(S[2 * s][0], S[2 * s][1]); w.y = cvtpk(S[2 * s][2], S[2 * s][3]); w.z = cvtpk(S[2 * s + 1][0], S[2 * s + 1][1]); w.w = cvtpk(S[2 * s + 1][2], S[2 * s + 1][3]); Sb[s] = __builtin_bit_cast(bf16x8, w); }
        pg8::f32x4 vn[4], o[4];
#pragma unroll
        for (int ih = 0; ih < 2; ++ih) {
            bf16x8 fk[2][4], fq[2][4];
#pragma unroll
            for (int ii = 0; ii < 2; ++ii)
#pragma unroll
                for (int s = 0; s < 4; ++s) { fk[ii][s] = SC_FRAG(SC_KC, 272, 16 * (2 * ih + ii) + lr, s); fq[ii][s] = SC_FRAG(SC_QD, 272, 16 * (2 * ih + ii) + lr, s); }
#pragma unroll
            for (int ii = 0; ii < 2; ++ii) { const int i = 2 * ih + ii;
                pg8::f32x4 ak = (pg8::f32x4){0.f, 0.f, 0.f, 0.f}, aq = ak;
#pragma unroll
                for (int s = 0; s < 4; ++s) { ak = __builtin_amdgcn_mfma_f32_16x16x32_bf16(fk[ii][s], Sb[s], ak, 0, 0, 0); aq = __builtin_amdgcn_mfma_f32_16x16x32_bf16(fq[ii][s], Sb[s], aq, 0, 0, 0); }
#pragma unroll
                for (int r = 0; r < 4; ++r) vn[i][r] = uc[4 * i + r] - ak[r];
                o[i] = aq; }
        }
        bf16x8 Vb[2];
#pragma unroll
        for (int s = 0; s < 2; ++s) { u32x4 w; w.x = cvtpk(vn[2 * s][0], vn[2 * s][1]); w.y = cvtpk(vn[2 * s][2], vn[2 * s][3]); w.z = cvtpk(vn[2 * s + 1][0], vn[2 * s + 1][1]); w.w = cvtpk(vn[2 * s + 1][2], vn[2 * s + 1][3]); Vb[s] = __builtin_bit_cast(bf16x8, w); }
        {
            bf16x8 fi[4][2], ft[8][2];
#pragma unroll
            for (int i = 0; i < 4; ++i)
#pragma unroll
                for (int s = 0; s < 2; ++s) fi[i][s] = SC_FRAG(SC_IN, 144, 16 * i + lr, s);
#pragma unroll
            for (int i = 0; i < 8; ++i)
#pragma unroll
                for (int s = 0; s < 2; ++s) ft[i][s] = SC_FRAG(SC_KT, 144, 16 * i + lr, s);
#pragma unroll
            for (int i = 0; i < 4; ++i) {
#pragma unroll
                for (int s = 0; s < 2; ++s) o[i] = __builtin_amdgcn_mfma_f32_16x16x32_bf16(fi[i][s], Vb[s], o[i], 0, 0, 0);
                *(u32x2*)((bf16*)ODN + ((item0 + 4 * (size_t)n) * 8192) + (ulane + (unsigned)(i * 2048))) = (u32x2){cvtpk(o[i][0], o[i][1]), cvtpk(o[i][2], o[i][3])};
            }
#pragma unroll
            for (int i = 0; i < 8; ++i) {
                pg8::f32x4 acc = S[i] * gl;
#pragma unroll
                for (int s = 0; s < 2; ++s) acc = __builtin_amdgcn_mfma_f32_16x16x32_bf16(ft[i][s], Vb[s], acc, 0, 0, 0);
                S[i] = acc;
            }
        }
        if (n + 1 < 64) {
            SC_LWRITE((n + 1) & 1);
#pragma unroll
            for (int k = 0; k < 16; ++k) uc[k] = un[k];
        }
        SC_BARRIER();
    }
#undef SC_GLOAD
#undef SC_LWRITE
#undef SC_FRAG
    float* so = A.out + O_SP + (size_t)(b * 4 + h) * 16384;
#pragma unroll
    for (int i = 0; i < 8; ++i)
#pragma unroll
        for (int r = 0; r < 4; ++r) so[(unsigned)((16 * i + 4 * q + r) * 128 + e)] = S[i][r];
}

__device__ __forceinline__ int crow(int r, int hi) { return (r & 3) + 8 * (r >> 2) + 4 * hi; }
__device__ __forceinline__ void sb_core(f32x16& p, float& carry, int hi) {
    float s[16];
#pragma unroll
    for (int r = 0; r < 16; ++r) { const float e = __builtin_amdgcn_exp2f(p[r]); s[r] = -__builtin_amdgcn_logf(1.0f + e); }
    float tt[4], uu[4];
#pragma unroll
    for (int i = 0; i < 4; ++i) { s[4 * i + 2] += s[4 * i + 3]; s[4 * i + 1] += s[4 * i + 2]; s[4 * i] += s[4 * i + 1]; tt[i] = s[4 * i]; }
#pragma unroll
    for (int i = 0; i < 4; ++i) uu[i] = __shfl_xor(tt[i], 32);
    const float w3 = tt[3] + uu[3], w2 = tt[2] + uu[2], w1 = tt[1] + uu[1], w0 = tt[0] + uu[0];
    float off[4];
    off[3] = carry; off[2] = carry + w3; off[1] = off[2] + w2; off[0] = off[1] + w1;
    carry = off[0] + w0;
    if (hi == 0) {
#pragma unroll
        for (int i = 0; i < 4; ++i) off[i] += uu[i];
    }
#pragma unroll
    for (int r = 0; r < 16; ++r) p[r] = __builtin_amdgcn_exp2f(p[r] + s[r] + off[r >> 2]);
}
__device__ __forceinline__ bf16x8 pack_p(const f32x16& p, int s) {
    u32x4 w; w.x = cvtpk(p[8 * s], p[8 * s + 1]); w.y = cvtpk(p[8 * s + 2], p[8 * s + 3]); w.z = cvtpk(p[8 * s + 4], p[8 * s + 5]); w.w = cvtpk(p[8 * s + 6], p[8 * s + 7]); return __builtin_bit_cast(bf16x8, w);
}
constexpr int AW_BYTES = 16384, AW_V = 0, VPI = 192, AW_K = 6144, KPI = 144, AW_Q = 6144, AW_SQ = 10752;
__device__ __forceinline__ void read_vfrags(bf16x8 (&vf)[4], const LAS unsigned char* wl, int lane) {
    const int hi = lane >> 5;
    const LAS unsigned char* vb = wl + AW_V + (4 * hi + ((lane & 15) >> 2)) * VPI + (((lane >> 4) & 1) * 16 + (lane & 3) * 4) * 2;
#pragma unroll
    for (int dt = 0; dt < 2; ++dt) {
        const s16x4 t0 = __builtin_bit_cast(s16x4, __builtin_amdgcn_ds_read_tr16_b64_v4i16((LAS s16x4*)(vb + dt * 64)));
        const s16x4 t1 = __builtin_bit_cast(s16x4, __builtin_amdgcn_ds_read_tr16_b64_v4i16((LAS s16x4*)(vb + dt * 64 + 8 * VPI)));
        const s16x4 t2 = __builtin_bit_cast(s16x4, __builtin_amdgcn_ds_read_tr16_b64_v4i16((LAS s16x4*)(vb + dt * 64 + 16 * VPI)));
        const s16x4 t3 = __builtin_bit_cast(s16x4, __builtin_amdgcn_ds_read_tr16_b64_v4i16((LAS s16x4*)(vb + dt * 64 + 24 * VPI)));
        vf[2 * dt] = (bf16x8){t0[0], t0[1], t0[2], t0[3], t1[0], t1[1], t1[2], t1[3]}; vf[2 * dt + 1] = (bf16x8){t2[0], t2[1], t2[2], t2[3], t3[0], t3[1], t3[2], t3[3]};
    }
}
__device__ __forceinline__ void load_k_prompt(bf16x8 (&k)[4], const bf16* KB, int b, int h, int kv0, int r32, int hi) {
    const bf16* kp = KB + (size_t)(b * TP + kv0 + r32) * SBW + h * HD + 8 * hi;
#pragma unroll
    for (int d0 = 0; d0 < 4; ++d0) k[d0] = *(const bf16x8*)(kp + 16 * d0);
}
__device__ __forceinline__ void load_v_prompt(u32x4 (&v)[4], const bf16* VB, int b, int h, int kv0, int lane) {
    const bf16* vp = VB + (size_t)(b * TP + kv0 + (lane >> 3)) * SBW + h * HD + (lane & 7) * 8;
#pragma unroll
    for (int i = 0; i < 4; ++i) v[i] = *(const u32x4*)(vp + (size_t)(8 * i) * SBW);
}
__device__ __forceinline__ void write_v_lds(LAS unsigned char* wl, const u32x4 (&v)[4], int lane) {
#pragma unroll
    for (int i = 0; i < 4; ++i) *(LAS u32x4*)(wl + AW_V + (8 * i + (lane >> 3)) * VPI + (lane & 7) * 16) = v[i];
}
template <int MASK>
__device__ __forceinline__ void sb_qk(f32x16& p, const bf16x8 (&kf)[4], const bf16x8 (&qf)[4], float bias2, int kv0, int qpos, int hi) {
#pragma unroll
    for (int r = 0; r < 16; ++r) p[r] = bias2;
#pragma unroll
    for (int d0 = 0; d0 < 4; ++d0) p = __builtin_amdgcn_mfma_f32_32x32x16_bf16(kf[d0], qf[d0], p, 0, 0, 0);
    if (MASK) {
#pragma unroll
        for (int r = 0; r < 16; ++r) if (kv0 + crow(r, hi) >= qpos) p[r] = -INFINITY;
    }
}
__device__ __forceinline__ void sb_pvonly(const f32x16& p, const bf16x8 (&vf)[4], f32x16 (&o)[2]) {
    const bf16x8 p0 = pack_p(p, 0), p1 = pack_p(p, 1);
#pragma unroll
    for (int dt = 0; dt < 2; ++dt) { o[dt] = __builtin_amdgcn_mfma_f32_32x32x16_bf16(vf[2 * dt], p0, o[dt], 0, 0, 0); o[dt] = __builtin_amdgcn_mfma_f32_32x32x16_bf16(vf[2 * dt + 1], p1, o[dt], 0, 0, 0); }
}
__device__ __forceinline__ void sb_pv(f32x16& p, const bf16x8 (&vf)[4], f32x16 (&o)[2], float& carry, int hi) {
    sb_core(p, carry, hi);
    const bf16x8 p0 = pack_p(p, 0), p1 = pack_p(p, 1);
#pragma unroll
    for (int dt = 0; dt < 2; ++dt) { o[dt] = __builtin_amdgcn_mfma_f32_32x32x16_bf16(vf[2 * dt], p0, o[dt], 0, 0, 0); o[dt] = __builtin_amdgcn_mfma_f32_32x32x16_bf16(vf[2 * dt + 1], p1, o[dt], 0, 0, 0); }
}
template <int MASK>
__device__ __forceinline__ void sb_tile(const bf16x8 (&kf)[4], const bf16x8 (&vf)[4], const bf16x8 (&qf)[4], float bias2, f32x16 (&o)[2], float& carry, int kv0, int qpos, int hi) {
    f32x16 p; sb_qk<MASK>(p, kf, qf, bias2, kv0, qpos, hi); sb_pv(p, vf, o, carry, hi);
}
__device__ __forceinline__ void sb_store_prompt(const Args& A, const f32x16 (&o)[2], int b, int h, int qpos, int hi) {
    float ss = 0.f;
#pragma unroll
    for (int dt = 0; dt < 2; ++dt)
#pragma unroll
        for (int r = 0; r < 16; ++r) ss += o[dt][r] * o[dt][r];
    ss += __shfl_xor(ss, 32);
    const float rs = 1.0f / sqrtf(ss * (1.f / HD) + EPS);
    const float* gso = (const float*)A.in[I_GSBO];
    bf16* op = (bf16*)(A.ws + WS_MIXED) + (size_t)(b * TP + qpos) * D + h * HD;
#pragma unroll
    for (int dt = 0; dt < 2; ++dt)
#pragma unroll
        for (int g = 0; g < 4; ++g) { const int d = 32 * dt + 8 * g + 4 * hi; const f32x4 gg = *(const f32x4*)(gso + d);
            u32x2 w; w.x = cvtpk(o[dt][4 * g] * rs * gg.x, o[dt][4 * g + 1] * rs * gg.y); w.y = cvtpk(o[dt][4 * g + 2] * rs * gg.z, o[dt][4 * g + 3] * rs * gg.w); *(u32x2*)(op + d) = w; }
}
__device__ __forceinline__ void attn_prompt_item(const Args& A, LAS unsigned char* wl, int b, int h, int q0, int lane) {
    unsigned char* ws = A.ws;
    const bf16* QB = (const bf16*)(ws + WS_QB); const bf16* KB = (const bf16*)(ws + WS_KB); const bf16* VB = (const bf16*)(ws + WS_VB);
    const int r32 = lane & 31, hi = lane >> 5, qa = q0 + r32, qb = q0 + 32 + r32;
    const float bias2 = ((const float*)A.in[I_SBB])[h] * LOG2E;
#pragma unroll
    for (int d0 = 0; d0 < 4; ++d0) { *(LAS bf16x8*)(wl + AW_Q + (d0 * 64 + lane) * 16) = *(const bf16x8*)(QB + (size_t)(b * TP + qa) * SBW + h * HD + 16 * d0 + 8 * hi);
        *(LAS bf16x8*)(wl + AW_Q + 4096 + (d0 * 64 + lane) * 16) = *(const bf16x8*)(QB + (size_t)(b * TP + qb) * SBW + h * HD + 16 * d0 + 8 * hi); }
#define QFA_LOAD bf16x8 qfa[4]; _Pragma("unroll") for (int d0_ = 0; d0_ < 4; ++d0_) qfa[d0_] = *(const LAS bf16x8*)(wl + AW_Q + (d0_ * 64 + lane) * 16);
#define QFB_LOAD bf16x8 qfb[4]; _Pragma("unroll") for (int d0_ = 0; d0_ < 4; ++d0_) qfb[d0_] = *(const LAS bf16x8*)(wl + AW_Q + 4096 + (d0_ * 64 + lane) * 16);
    f32x16 oa[2], ob[2]; oa[0] = (f32x16){}; oa[1] = (f32x16){}; ob[0] = (f32x16){}; ob[1] = (f32x16){};
    float ca = 0.f, cb = 0.f;
    bf16x8 kc[4], vf[4]; u32x4 vr[4];
    const int top = (q0 >> 5) + 1;
    load_k_prompt(kc, KB, b, h, 32 * top, r32, hi); load_v_prompt(vr, VB, b, h, 32 * top, lane);
    { write_v_lds(wl, vr, lane); load_v_prompt(vr, VB, b, h, 32 * (top - 1), lane);
      f32x16 p; { QFB_LOAD sb_qk<1>(p, kc, qfb, bias2, 32 * top, qb, hi); }
      load_k_prompt(kc, KB, b, h, 32 * (top - 1), r32, hi);
      read_vfrags(vf, wl, lane);
      sb_pv(p, vf, ob, cb, hi); }
    { write_v_lds(wl, vr, lane); if (top >= 2) load_v_prompt(vr, VB, b, h, 32 * (top - 2), lane);
      f32x16 p; { QFA_LOAD sb_qk<1>(p, kc, qfa, bias2, 32 * (top - 1), qa, hi); }
      read_vfrags(vf, wl, lane);
      sb_pv(p, vf, oa, ca, hi);
      { QFB_LOAD sb_qk<0>(p, kc, qfb, bias2, 0, 0, hi); }
      if (top >= 2) load_k_prompt(kc, KB, b, h, 32 * (top - 2), r32, hi);
      sb_pv(p, vf, ob, cb, hi); }
    for (int ht = top - 2; ht >= 0; --ht) {
        write_v_lds(wl, vr, lane);
        f32x16 p, p2; { QFA_LOAD sb_qk<0>(p, kc, qfa, bias2, 0, 0, hi); } { QFB_LOAD sb_qk<0>(p2, kc, qfb, bias2, 0, 0, hi); }
        if (ht > 0) load_k_prompt(kc, KB, b, h, 32 * (ht - 1), r32, hi);
        read_vfrags(vf, wl, lane);
        sb_core(p, ca, hi); sb_pvonly(p, vf, oa);
        __builtin_amdgcn_sched_barrier(0);
        if (ht > 0) load_v_prompt(vr, VB, b, h, 32 * (ht - 1), lane);
        sb_core(p2, cb, hi); sb_pvonly(p2, vf, ob);
    }
    sb_store_prompt(A, oa, b, h, qa, hi); sb_store_prompt(A, ob, b, h, qb, hi);
#undef QFA_LOAD
#undef QFB_LOAD
}

__device__ __forceinline__ void load_raw_sample(f32x4 (&r)[8], const float* c, size_t base, int h, int lane) {
    const float* p = c + base + (size_t)(lane >> 4) * 512 + h * HD + (lane & 15) * 4;
#pragma unroll
    for (int i = 0; i < 8; ++i) r[i] = *(const f32x4*)(p + (size_t)(4 * i) * 512);
}
__device__ __forceinline__ void write_raw_sample(LAS unsigned char* wl, int off, int pitch, const f32x4 (&r)[8], int lane) {
#pragma unroll
    for (int i = 0; i < 8; ++i) { const int row = 4 * i + (lane >> 4); u32x2 w; w.x = cvtpk(r[i].x, r[i].y); w.y = cvtpk(r[i].z, r[i].w); *(LAS u32x2*)(wl + off + row * pitch + (lane & 15) * 8) = w; }
}
__device__ __forceinline__ void read_kfrags(bf16x8 (&kf)[4], const LAS unsigned char* wl, int r32, int hi) {
#pragma unroll
    for (int d0 = 0; d0 < 4; ++d0) kf[d0] = *(const LAS bf16x8*)(wl + AW_K + r32 * KPI + (16 * d0 + 8 * hi) * 2);
}
__device__ __forceinline__ void attn_sample_store(const Args& A, int b, int h, int part, int lane, const f32x16 (&o)[2], float carry) {
    float* OP = (float*)(A.ws + WS_OPART) + (size_t)((b * SBH + h) * NPART + part) * 512; float* LP = (float*)(A.ws + WS_LPART) + (size_t)((b * SBH + h) * NPART + part) * 8;
    const int r32 = lane & 31, hi = lane >> 5;
    unsigned lo = (unsigned)(r32 * 64 + 4 * hi), ll = (unsigned)r32; asm volatile("" : "+v"(lo), "+v"(ll));
    if (r32 < 8) {
#pragma unroll
        for (int dt = 0; dt < 2; ++dt)
#pragma unroll
            for (int g = 0; g < 4; ++g) *(f32x4*)(OP + (lo + (unsigned)(32 * dt + 8 * g))) = (f32x4){o[dt][4 * g], o[dt][4 * g + 1], o[dt][4 * g + 2], o[dt][4 * g + 3]};
        if (hi == 0) LP[ll] = carry;
    }
}
__device__ __forceinline__ void attn_sample_job(const Args& A, LAS unsigned char* wl, int b, int h, int sp, int lane) {
    unsigned char* ws = A.ws;
    const int r32 = lane & 31, hi = lane >> 5;
    const float* ck = (const float*)A.in[I_CK]; const float* cv = (const float*)A.in[I_CV]; const int* pt = (const int*)A.in[I_PT] + b * NPAGES;
    const bf16* QB = (const bf16*)(ws + WS_QB);
    const float bias2 = ((const float*)A.in[I_SBB])[h] * LOG2E;
    bf16x8 qf[4];
#pragma unroll
    for (int d0 = 0; d0 < 4; ++d0) { qf[d0] = (bf16x8){0, 0, 0, 0, 0, 0, 0, 0}; if (r32 < TS) qf[d0] = *(const bf16x8*)(QB + (size_t)(MP + b * TS + r32) * SBW + h * HD + 16 * d0 + 8 * hi); }
    f32x16 o[2]; float carry;
    bf16x8 kf[4], vf[4];
    const int tok_hi = (PAST / NSPLIT) * (sp + 1);
    constexpr int NT = PAST / NSPLIT / 32;
    f32x4 rk[8], rv[8];
#define SAMPLE_BASE(j) (((size_t)pt[(tok_hi - 32 * ((j) + 1)) >> 7] * PAGE + ((tok_hi - 32 * ((j) + 1)) & 127)) * 512)
    f32x4 rk2[8];
    load_raw_sample(rk, ck, SAMPLE_BASE(0), h, lane); load_raw_sample(rv, cv, SAMPLE_BASE(0), h, lane);
    load_raw_sample(rk2, ck, SAMPLE_BASE(1), h, lane);
    if (sp == NSPLIT - 1) {
        const bf16* KBn = (const bf16*)(ws + WS_KB) + (size_t)(MP + b * TS) * SBW + h * HD;
#pragma unroll
        for (int d0 = 0; d0 < 4; ++d0) { kf[d0] = (bf16x8){0, 0, 0, 0, 0, 0, 0, 0}; if (r32 < TS) kf[d0] = *(const bf16x8*)(KBn + (size_t)r32 * SBW + 16 * d0 + 8 * hi); }
        u32x4 vr[4];
        vr[0] = *(const u32x4*)((const bf16*)(ws + WS_VB) + (size_t)(MP + b * TS + (lane >> 3)) * SBW + h * HD + (lane & 7) * 8);
        vr[1] = (u32x4){0u, 0u, 0u, 0u}; vr[2] = vr[1]; vr[3] = vr[1];
        write_v_lds(wl, vr, lane);
        read_vfrags(vf, wl, lane);
        o[0] = (f32x16){}; o[1] = (f32x16){}; carry = 0.f;
        sb_tile<1>(kf, vf, qf, bias2, o, carry, 0, r32, hi);
        attn_sample_store(A, b, h, NPART - 1, lane, o, carry);
    }
#pragma unroll
    for (int d0 = 0; d0 < 4; ++d0) *(LAS bf16x8*)(wl + AW_SQ + (d0 * 64 + lane) * 16) = qf[d0];
    o[0] = (f32x16){}; o[1] = (f32x16){}; carry = 0.f;
#define SAMPLE_TILE(RK, jk_, jv_) do { \
        write_raw_sample(wl, AW_K, KPI, RK, lane); write_raw_sample(wl, AW_V, VPI, rv, lane); \
        if ((jk_) < NT) load_raw_sample(RK, ck, SAMPLE_BASE(jk_), h, lane); \
        read_kfrags(kf, wl, r32, hi); read_vfrags(vf, wl, lane); \
        bf16x8 qq[4]; _Pragma("unroll") for (int d0_ = 0; d0_ < 4; ++d0_) qq[d0_] = *(const LAS bf16x8*)(wl + AW_SQ + (d0_ * 64 + lane) * 16); \
        f32x16 p; sb_qk<0>(p, kf, qq, bias2, 0, 0, hi); \
        sb_core(p, carry, hi); \
        __builtin_amdgcn_sched_barrier(0); \
        if ((jv_) < NT) load_raw_sample(rv, cv, SAMPLE_BASE(jv_), h, lane); \
        sb_pvonly(p, vf, o); } while (0)
    for (int j = 0; j < NT; j += 2) {
        SAMPLE_TILE(rk, j + 2, j + 1);
        SAMPLE_TILE(rk2, j + 3, j + 2);
    }
#undef SAMPLE_TILE
#undef SAMPLE_BASE
    attn_sample_store(A, b, h, sp, lane, o, carry);
}

__device__ __forceinline__ void phase_outnorm(const Args& A, int gw, int NGW, int lane) {
    unsigned char* ws = A.ws; const float* ODN = (const float*)(ws + WS_ODN); bf16* MIXED = (bf16*)(ws + WS_MIXED);
    const float* gdn = (const float*)A.in[I_GDNO]; const float* gso = (const float*)A.in[I_GSBO];
    const float* OPb = (const float*)(ws + WS_OPART); const float* LPb = (const float*)(ws + WS_LPART);
    const int c8 = 8 * lane;
    unsigned nr[8]; u32x4 nzw;
#define ON_LOAD(mm_) do { if ((mm_) >= MP) { const float* op_ = ODN + (size_t)(mm_) * DNW + c8; const u32x4 p0_ = *(const u32x4*)op_, p1_ = *(const u32x4*)(op_ + 4); nr[0] = p0_.x; nr[1] = p0_.y; nr[2] = p0_.z; nr[3] = p0_.w; nr[4] = p1_.x; nr[5] = p1_.y; nr[6] = p1_.z; nr[7] = p1_.w; } \
        else { const int t_ = (mm_) & 4095, cch_ = t_ & 63, hh_ = lane >> 4; const size_t it_ = (size_t)(((mm_) >> 12) * 64 + (t_ >> 6)) * 4 + hh_; \
            const unsigned short* op_ = (const unsigned short*)ODN + it_ * 8192 + ((((cch_ >> 4) * 8 + ((lane & 15) >> 1)) * 64 + ((cch_ >> 2) & 3) * 16 + 8 * (lane & 1)) * 4) + (cch_ & 3); \
            _Pragma("unroll") for (int k_ = 0; k_ < 8; ++k_) nr[k_] = (unsigned)op_[4 * k_]; } \
        nzw = *(const u32x4*)((const bf16*)(ws + WS_ZG) + (size_t)(mm_) * DNW + c8); } while (0)
    if (gw < M) ON_LOAD(gw);
    const f32x4 g0 = *(const f32x4*)(gdn + (c8 & 127)), g1 = *(const f32x4*)(gdn + (c8 & 127) + 4);
    for (int m = gw; m < M; m += NGW) {
        {
            f32x4 a0, a1;
            if (m >= MP) { a0 = (f32x4){__uint_as_float(nr[0]), __uint_as_float(nr[1]), __uint_as_float(nr[2]), __uint_as_float(nr[3])}; a1 = (f32x4){__uint_as_float(nr[4]), __uint_as_float(nr[5]), __uint_as_float(nr[6]), __uint_as_float(nr[7])}; }
            else { a0 = (f32x4){__uint_as_float(nr[0] << 16), __uint_as_float(nr[1] << 16), __uint_as_float(nr[2] << 16), __uint_as_float(nr[3] << 16)}; a1 = (f32x4){__uint_as_float(nr[4] << 16), __uint_as_float(nr[5] << 16), __uint_as_float(nr[6] << 16), __uint_as_float(nr[7] << 16)}; }
            const u32x4 zw = nzw;
            { const int mn = m + NGW; if (mn < M) ON_LOAD(mn); }
            float ss = (a0.x * a0.x + a0.y * a0.y) + (a0.z * a0.z + a0.w * a0.w) + (a1.x * a1.x + a1.y * a1.y) + (a1.z * a1.z + a1.w * a1.w);
            ss += __shfl_xor(ss, 1); ss += __shfl_xor(ss, 2); ss += __shfl_xor(ss, 4); ss += __shfl_xor(ss, 8);
            const float rs = 1.0f / sqrtf(ss * (1.f / DND) + EPS);
            const f32x4 z0 = bf4lo(zw), z1 = bf4hi(zw);
            *(u32x4*)(MIXED + (size_t)m * D + SBW + c8) = pack8(a0 * rs * g0 * z0, a1 * rs * g1 * z1);
        }
        if (m >= MP) {
            const int b = (m - MP) >> 3, t = (m - MP) & 7, h = lane >> 3, d0 = c8 & 63;
            const float* OP = OPb + (size_t)(b * SBH + h) * NPART * 512; const float* LP = LPb + (size_t)(b * SBH + h) * NPART * 8;
            float v[8];
#pragma unroll
            for (int k = 0; k < 8; ++k) v[k] = 0.f;
            float suf = 0.f;
#pragma unroll
            for (int part = NPART - 1; part >= 0; --part) { const float w = __builtin_amdgcn_exp2f(suf);
                const f32x4 pa = *(const f32x4*)(OP + part * 512 + t * 64 + d0), pb = *(const f32x4*)(OP + part * 512 + t * 64 + d0 + 4);
                v[0] += w * pa.x; v[1] += w * pa.y; v[2] += w * pa.z; v[3] += w * pa.w; v[4] += w * pb.x; v[5] += w * pb.y; v[6] += w * pb.z; v[7] += w * pb.w;
                suf += LP[part * 8 + t]; }
            float ss = 0.f;
#pragma unroll
            for (int k = 0; k < 8; ++k) ss += v[k] * v[k];
            ss += __shfl_xor(ss, 1); ss += __shfl_xor(ss, 2); ss += __shfl_xor(ss, 4);
            const float rs = 1.0f / sqrtf(ss * (1.f / HD) + EPS);
            const f32x4 g0 = *(const f32x4*)(gso + d0), g1 = *(const f32x4*)(gso + d0 + 4);
            *(u32x4*)(MIXED + (size_t)m * D + c8) = pack8((f32x4){v[0], v[1], v[2], v[3]} * rs * g0, (f32x4){v[4], v[5], v[6], v[7]} * rs * g1);
        }
    }
}

__device__ __forceinline__ f32x4 cg_conv(const f32x4 w0, const f32x4 w1, const f32x4 w2, const f32x4 x2, const f32x4 x1, const f32x4 x0) { return w0 * x2 + w1 * x1 + w2 * x0; }
__device__ __forceinline__ void upfix_rows(const Args& A, const bf16* own0, const bf16* own1, bool hbf, const void* h2v, const void* h3v, bool hzero, bf16* act0, bf16* act1, int c) {
    const float* wf = (const float*)A.in[I_WFC];
    f32x4 wu[3][2], wg[3][2];
#pragma unroll
    for (int i = 0; i < 3; ++i) { const float* wp = wf + (size_t)i * DFF2 + c; wu[i][0] = *(const f32x4*)wp; wu[i][1] = *(const f32x4*)(wp + 4); wg[i][0] = *(const f32x4*)(wp + DFF); wg[i][1] = *(const f32x4*)(wp + DFF + 4); }
    f32x4 u2[2], u3[2], g2[2], g3[2];
    if (hzero) { u2[0] = (f32x4){0.f, 0.f, 0.f, 0.f}; u2[1] = u2[0]; u3[0] = u2[0]; u3[1] = u2[0]; g2[0] = u2[0]; g2[1] = u2[0]; g3[0] = u2[0]; g3[1] = u2[0]; }
    else if (hbf) { const bf16* h2 = (const bf16*)h2v; const bf16* h3 = (const bf16*)h3v; const u32x4 a = *(const u32x4*)(h2 + c), b = *(const u32x4*)(h3 + c), d = *(const u32x4*)(h2 + DFF + c), e = *(const u32x4*)(h3 + DFF + c);
        u2[0] = bf4lo(a); u2[1] = bf4hi(a); u3[0] = bf4lo(b); u3[1] = bf4hi(b); g2[0] = bf4lo(d); g2[1] = bf4hi(d); g3[0] = bf4lo(e); g3[1] = bf4hi(e); }
    else { const float* h2 = (const float*)h2v; const float* h3 = (const float*)h3v;
        u2[0] = *(const f32x4*)(h2 + c); u2[1] = *(const f32x4*)(h2 + c + 4); u3[0] = *(const f32x4*)(h3 + c); u3[1] = *(const f32x4*)(h3 + c + 4);
        g2[0] = *(const f32x4*)(h2 + DFF + c); g2[1] = *(const f32x4*)(h2 + DFF + c + 4); g3[0] = *(const f32x4*)(h3 + DFF + c); g3[1] = *(const f32x4*)(h3 + DFF + c + 4); }
    const u32x4 o0u = *(const u32x4*)(own0 + c), o0g = *(const u32x4*)(own0 + DFF + c), o1u = *(const u32x4*)(own1 + c), o1g = *(const u32x4*)(own1 + DFF + c);
    const f32x4 a0[2] = {bf4lo(o0u), bf4hi(o0u)}, b0[2] = {bf4lo(o0g), bf4hi(o0g)}, a1[2] = {bf4lo(o1u), bf4hi(o1u)}, b1[2] = {bf4lo(o1g), bf4hi(o1g)};
    f32x4 r0[2], r1[2];
#pragma unroll
    for (int k = 0; k < 2; ++k) {
        f32x4 yu = cg_conv(wu[0][k], wu[1][k], wu[2][k], u2[k], u3[k], a0[k]), yg = cg_conv(wg[0][k], wg[1][k], wg[2][k], g2[k], g3[k], b0[k]);
        yg.x = siluf(yg.x); yg.y = siluf(yg.y); yg.z = siluf(yg.z); yg.w = siluf(yg.w); r0[k] = yg * yu;
        yu = cg_conv(wu[0][k], wu[1][k], wu[2][k], u3[k], a0[k], a1[k]); yg = cg_conv(wg[0][k], wg[1][k], wg[2][k], g3[k], b0[k], b1[k]);
        yg.x = siluf(yg.x); yg.y = siluf(yg.y); yg.z = siluf(yg.z); yg.w = siluf(yg.w); r1[k] = yg * yu;
    }
    *(u32x4*)(act0 + c) = pack8(r0[0], r0[1]); *(u32x4*)(act1 + c) = pack8(r1[0], r1[1]);
}
__device__ __forceinline__ void phase_upfix(const Args& A, int gw, int NGW, int lane) {
    unsigned char* ws = A.ws; const bf16* SIDEP = (const bf16*)(ws + WS_SIDEP); const bf16* SIDES = (const bf16*)(ws + WS_SIDES); bf16* ACT = (bf16*)(ws + WS_ACT);
    const float* sfc = (const float*)A.in[I_SFC];
    constexpr int NPB = MP / 64, NPI = NPB * 6, NSI = BS * 6;
    for (int it = gw; it < NPI + NSI; it += NGW) {
        const int cgp = it % 6, idx = it / 6; const int c = (cgp * 64 + lane) * 8;
        if (c >= DFF) continue;
        if (it < NPI) { const int kb = idx; const bf16* sp = SIDEP + (size_t)kb * 4 * DFF2;
            upfix_rows(A, sp, sp + DFF2, true, sp - 2 * DFF2, sp - DFF2, (kb & 63) == 0, ACT + (size_t)(kb * 64) * DFF, ACT + (size_t)(kb * 64 + 1) * DFF, c);
            if ((kb & 63) == 63) { const int b = kb >> 6; float* fo = A.out + O_FCP + (size_t)b * 2 * DFF2 + c;
#pragma unroll
                for (int r = 0; r < 2; ++r) { const u32x4 a = *(const u32x4*)(sp + (2 + r) * DFF2 + c), g = *(const u32x4*)(sp + (2 + r) * DFF2 + DFF + c);
                    *(f32x4*)(fo + r * DFF2) = bf4lo(a); *(f32x4*)(fo + r * DFF2 + 4) = bf4hi(a); *(f32x4*)(fo + r * DFF2 + DFF) = bf4lo(g); *(f32x4*)(fo + r * DFF2 + DFF + 4) = bf4hi(g); } }
        } else { const int seq = (it - NPI) / 6; const bf16* sp = SIDES + (size_t)seq * 2 * DFF2; const float* st = sfc + (size_t)seq * 2 * DFF2;
            upfix_rows(A, sp, sp + DFF2, false, st, st + DFF2, false, ACT + (size_t)(MP + seq * 8) * DFF, ACT + (size_t)(MP + seq * 8 + 1) * DFF, c); }
    }
}

__device__ __forceinline__ void phase_slabsum(const Args& A, int gw, int NGW, int lane) {
    unsigned char* ws = A.ws; const float* slab = (const float*)(ws + WS_SLAB); const float* X1 = (const float*)(ws + WS_X1); const float* MOD = (const float*)(ws + WS_MOD);
    for (int r = gw; r < MS; r += NGW) {
        const int m = MP + r; const float* mod = MOD + (size_t)mod_row(m) * NMOD + 5120;
#pragma unroll
        for (int j = 0; j < 4; ++j) { const int c = 4 * (lane + 64 * j); f32x4 a = (f32x4){0.f, 0.f, 0.f, 0.f};
#pragma unroll
            for (int k = 0; k < DFF / 256; ++k) a += *(const f32x4*)(slab + ((size_t)k * MS + r) * D + c);
            *(f32x4*)(A.out + (size_t)m * D + c) = *(const f32x4*)(X1 + (size_t)m * D + c) + *(const f32x4*)(mod + c) * a; }
    }
}

constexpr int NPHASE = 14;
#ifndef PROBE_LEVEL
#define PROBE_LEVEL 0
#endif
#ifndef REP_MASK
#define REP_MASK 0
#endif

__global__ void __launch_bounds__(512, 2) fwd_kernel(Args A) {
    extern __shared__ __attribute__((aligned(16))) unsigned char lds_raw[];
    LAS unsigned char* lds = (LAS unsigned char*)lds_raw;
    const int wave = __builtin_amdgcn_readfirstlane((int)threadIdx.x >> 6);
    const int G = gridDim.x, bx = blockIdx.x;
    const int gw = bx * 8 + wave, NGW = G * 8, NGT = G * 512;
    unsigned char* ws = A.ws;
    gu32* ctl = (gu32*)(ws + WS_CTL);
    volatile LAS unsigned* MISC = (volatile LAS unsigned*)(lds + MISC_OFF);
    { const int t0 = wave * 64 + lane_now(); for (int u = t0; u < (LDS_BYTES - RING_BYTES) / 4; u += 512) ((LAS unsigned*)(lds + RING_BYTES))[u] = 0u; }
    __syncthreads();
    const int lo = A.lo, hi = A.hi;
    const bool multi = (hi - lo) > 1;
    XcdBarrier bar; bar.bar = (unsigned*)(ctl + CW_BAR); bar.x = 0; bar.st = nullptr;
    if (multi) bar = xcd_barrier_post((unsigned*)(ctl + CW_BAR), MISC + 8, wave * 64 + lane_now());
#define IN(k) (lo <= (k) && (k) < hi)
#define GBAR() xcd_barrier(bar, wave * 64 + lane_now())
#define SEAM(k) do { if (IN(k) && IN((k) + 1)) GBAR(); } while (0)
    float* MOD = (float*)(ws + WS_MOD);

#define PH0(rep_) phase_prologue(A, lds, ctl + CW_Q0 + 64 * (rep_), bx, G, wave, lane, gtid, NGT);
#define PH1(rep_) ;
#define PH2(rep_) phase_norm<true>((const float*)A.in[I_XP], (const float*)A.in[I_XS], (const float*)A.in[I_GATT], MOD, 0, 1024, (bf16*)(ws + WS_H), (const float*)(ws + WS_WINX), (float*)(ws + WS_EXTRA), gw, NGW, lane);
#define PH3(rep_) { pg8::Gemm g{(const pg8::bf16_t*)(ws + WS_H), (const pg8::bf16_t*)(ws + WS_WIN_T), M, NPROJ, D, D}; pg8::StaticOrder S; S.init(M, NPROJ, G, bx); \
          EpiProj E{A.out, (bf16*)(ws + WS_QB), (bf16*)(ws + WS_KB), (bf16*)(ws + WS_VB), (bf16*)(ws + WS_DNRAW), (bf16*)(ws + WS_ZG), (const float*)A.in[I_GQ], (const float*)A.in[I_GK], (LAS float*)(lds + RING_BYTES + 1024)}; \
          pg8::gemm_phase<EpiProj, pg8::StaticOrder, true, true>(lds, g, S, E, tid); }
#define PH4(rep_) phase_post(A, gw, NGW, lane, gtid, NGT);
#define PH5(rep_) { for (int u = bx; u < 512; u += G) dn_prescan_unit(A, lds, u, tid, wave, lane); \
        const int tid2_ = wave * 64 + lane_now();     \
        int us_ = bx; for (; us_ + G < 512; us_ += 2 * G) dn_sample_units<2>(A, lds, us_, G, tid2_); if (us_ < 512) dn_sample_units<1>(A, lds, us_, G, tid2_); }
#define PH6(rep_) PH6X(rep_, true, true, true)
#define PH6X(rep_, DS_, DP_, DA_) { if ((DS_) && bx < 16) dn_scan_chain(A, lds, bx, tid, wave, lane); \
          \
        bool moreP = (DP_), moreS = (DA_); const bool pfirst = wave < 4; \
        gu32* qbase_ = ctl + CW_QUEUE + 1024 * (rep_);     \
        const int shard0_ = (int)(xb_xcc_id() & 7u); int offP_ = 0, offS_ = 0;     \
        for (;;) { \
            int job = -1; bool isP = false; \
            if (pfirst && moreP) { const int sh_ = (shard0_ + offP_) & 7; unsigned j_ = 0; if (lane == 0) j_ = __hip_atomic_fetch_add(qbase_ + 64 * sh_, 1u, RLX_AGENT); j_ = __builtin_amdgcn_readfirstlane(j_); if (j_ < 256u) { job = (int)j_ * 8 + sh_; isP = true; } else if (++offP_ == 8) moreP = false; } \
            if (job < 0 && moreS && !(pfirst && moreP)) { const int sh_ = (shard0_ + offS_) & 7; unsigned j_ = 0; if (lane == 0) j_ = __hip_atomic_fetch_add(qbase_ + 512 + 64 * sh_, 1u, RLX_AGENT); j_ = __builtin_amdgcn_readfirstlane(j_); if (j_ < 512u) { job = (int)j_ * 8 + sh_; } else if (++offS_ == 8) moreS = false; } \
            if (job < 0 && !pfirst && !moreS && moreP) { const int sh_ = (shard0_ + offP_) & 7; unsigned j_ = 0; if (lane == 0) j_ = __hip_atomic_fetch_add(qbase_ + 64 * sh_, 1u, RLX_AGENT); j_ = __builtin_amdgcn_readfirstlane(j_); if (j_ < 256u) { job = (int)j_ * 8 + sh_; isP = true; } else if (++offP_ == 8) moreP = false; } \
            if (job < 0) { if (!moreP && !moreS) break; else continue; } \
            if (isP) { const int qb = 63 - (job >> 5), bh = job & 31; attn_prompt_item(A, lds + wave * AW_BYTES, bh >> 3, bh & 7, qb * 64, lane); } \
            else { const int h_ = job & 7, bs_ = job >> 3; attn_sample_job(A, lds + wave * AW_BYTES, bs_ >> 2, h_, bs_ & 3, lane); } \
        } }
#define PH7(rep_) phase_outnorm(A, gw, NGW, lane);
#define PH8(rep_) { { pg8::Gemm g{(const pg8::bf16_t*)(ws + WS_MIXED), (const pg8::bf16_t*)(ws + WS_WOUT_T), MP, D, D, D}; pg8::StaticOrder S; S.init(MP, D, G, bx); \
        EpiResGateH<false, true> E{A.in[I_XP], MOD, 2048, (void*)(ws + WS_X1)};     \
        pg8::gemm_phase<EpiResGateH<false, true>, pg8::StaticOrder, true, true>(lds, g, S, E, tid); } \
        __syncthreads(); \
        { pg8::Gemm g{(const pg8::bf16_t*)(ws + WS_MIXED), (const pg8::bf16_t*)(ws + WS_WOUT_T), M, D, 256, D}; SplitKOrder S{D / 256, G, bx};     \
        EpiSlab E{(float*)(ws + WS_SLAB)}; \
        pg8::gemm_phase<EpiSlab, SplitKOrder, true, true>(lds, g, S, E, tid); } }
#define PH9(rep_) phase_norm<false, 4, true>((const float*)(ws + WS_X1), (const float*)A.in[I_XS], (const float*)A.in[I_GFFN], MOD, 3072, 4096, (bf16*)(ws + WS_H), nullptr, nullptr, gw, NGW, lane, (const float*)(ws + WS_SLAB), 2048, (float*)(ws + WS_X1));
#define PH10(rep_) { pg8::Gemm g{(const pg8::bf16_t*)(ws + WS_H), (const pg8::bf16_t*)(ws + WS_WUP_T), M, DFF2, D, D}; pg8::StaticOrder S; S.init(M, DFF2, G, bx); \
        EpiUp E{(bf16*)(ws + WS_ACT), (bf16*)(ws + WS_SIDEP), (bf16*)(ws + WS_SIDES), (const float*)A.in[I_WFC], A.out}; \
        pg8::gemm_phase<EpiUp, pg8::StaticOrder, true, true>(lds, g, S, E, tid); }
#define PH11(rep_) phase_upfix(A, gw, NGW, lane);
#define PH12(rep_) { { pg8::Gemm g{(const pg8::bf16_t*)(ws + WS_ACT), (const pg8::bf16_t*)(ws + WS_WDN_T), MP, D, DFF, DFF}; pg8::StaticOrder S; S.init(MP, D, G, bx); \
        EpiResGateH<true, false> E{(const void*)(ws + WS_X1), MOD, 5120, (void*)A.out}; \
        pg8::gemm_phase<EpiResGateH<true, false>, pg8::StaticOrder, true, true>(lds, g, S, E, tid); } \
        __syncthreads(); \
        { pg8::Gemm g{(const pg8::bf16_t*)(ws + WS_ACT), (const pg8::bf16_t*)(ws + WS_WDN_T), M, D, 256, DFF}; SplitKOrder S{DFF / 256, G, bx}; \
        EpiSlab E{(float*)(ws + WS_SLAB)}; \
        pg8::gemm_phase<EpiSlab, SplitKOrder, true, true>(lds, g, S, E, tid); } }
#define PH13(rep_) phase_slabsum(A, gw, NGW, lane);
#define RUNPH(k) do { if (IN(k)) { const int lane = lane_now(), tid = wave * 64 + lane, gtid = bx * 512 + tid; (void)gtid; PH##k(0) if constexpr (((REP_MASK) >> (k)) & 1) { GBAR(); PH##k(1) } } } while (0)
    RUNPH(0); SEAM(0);
    RUNPH(2);
    if constexpr (((REP_MASK) >> 20) & 1) { GBAR(); const int lane = lane_now(); phase_norm<false>((const float*)A.in[I_XP], (const float*)A.in[I_XS], (const float*)A.in[I_GATT], MOD, 0, 1024, (bf16*)(ws + WS_H), nullptr, nullptr, gw, NGW, lane); }
    SEAM(2);
    RUNPH(3); SEAM(3);
    RUNPH(4); SEAM(4);
    RUNPH(5);
    if constexpr (((REP_MASK) >> 17) & 1) { GBAR(); const int lane = lane_now(), tid = wave * 64 + lane; for (int u = bx; u < 512; u += G) dn_prescan_unit<PROBE_LEVEL>(A, lds, u, tid, wave, lane); }
    if constexpr (((REP_MASK) >> 18) & 1) { GBAR(); const int lane = lane_now(), tid = wave * 64 + lane; (void)lane; for (int u = bx; u < 512; u += G) dn_sample_units<1>(A, lds, u, G, tid); }
    SEAM(5);
    RUNPH(6);
    if constexpr (((REP_MASK) >> 13) & 1) { GBAR(); const int lane = lane_now(), tid = wave * 64 + lane; PH6X(2, true, false, false) }
    if constexpr (((REP_MASK) >> 14) & 1) { GBAR(); const int lane = lane_now(), tid = wave * 64 + lane; PH6X(3, false, true, false) }
    if constexpr (((REP_MASK) >> 15) & 1) { GBAR(); const int lane = lane_now(), tid = wave * 64 + lane; PH6X(4, false, false, true) }
    SEAM(6);
    RUNPH(7); SEAM(7);
    if constexpr (((REP_MASK) >> 19) & 1) { _Pragma("unroll 1") for (int i_ = 0; i_ < 20; ++i_) GBAR(); }
    RUNPH(8); SEAM(8);
    RUNPH(9); SEAM(9);
    RUNPH(10); SEAM(10);
    RUNPH(11); SEAM(11);
    RUNPH(12); SEAM(12);
    RUNPH(13);
#undef IN
#undef SEAM
}

#ifndef N_LAUNCHES
#define N_LAUNCHES 1
#endif
extern "C" void kernel_launch(void* const* d_in, const int* in_sizes, int n_in, void* d_out, int out_size, void* d_ws, size_t ws_size, hipStream_t stream) {
    static int grid = 0;
    if (grid == 0) {
        if (n_in != 27 || (size_t)out_size != O_END || ws_size < WS_END) { fprintf(stderr, "kernel_launch: unexpected shapes: n_in %d out %d ws %zu\n", n_in, out_size, ws_size); grid = -1; return; }
        int dev = 0, cus = 0, per_cu = 0;
        if (hipGetDevice(&dev) != hipSuccess || hipDeviceGetAttribute(&cus, hipDeviceAttributeMultiprocessorCount, dev) != hipSuccess) { grid = -1; return; }
        if (hipFuncSetAttribute((const void*)fwd_kernel, hipFuncAttributeMaxDynamicSharedMemorySize, LDS_BYTES) != hipSuccess) { fprintf(stderr, "kernel_launch: hipFuncSetAttribute failed\n"); grid = -1; return; }
        if (hipOccupancyMaxActiveBlocksPerMultiprocessor(&per_cu, (const void*)fwd_kernel, 512, LDS_BYTES) != hipSuccess || per_cu < 1) fprintf(stderr, "kernel_launch: occupancy query says %d\n", per_cu);
        (void)hipGetLastError();
        grid = cus;
    }
    if (grid < 0) return;
    (void)hipMemsetAsync((char*)d_ws + WS_CTL, 0, CTL_ZERO_BYTES, stream);
    Args a{};
    for (int i = 0; i < 27; ++i) a.in[i] = d_in[i];
    a.out = (float*)d_out; a.ws = (unsigned char*)d_ws;
    if (N_LAUNCHES == 1) { a.lo = 0; a.hi = NPHASE; hipLaunchKernelGGL(fwd_kernel, dim3(grid), dim3(512), LDS_BYTES, stream, a); }
    else for (int p = 0; p < NPHASE; ++p) { a.lo = p; a.hi = p + 1; hipLaunchKernelGGL(fwd_kernel, dim3(grid), dim3(512), LDS_BYTES, stream, a); }
}
```

```cpp
#include <hip/hip_runtime.h>
#include <cstdio>
#include <cstdint>
#define REP_MASK 0
#define PROBE_LEVEL 0
namespace pg8 {
#define PG8_LAS __attribute__((address_space(3)))
typedef unsigned short bf16_t;
typedef short bf16x8 __attribute__((ext_vector_type(8)));
typedef float f32x4 __attribute__((ext_vector_type(4)));
typedef unsigned u32x4 __attribute__((ext_vector_type(4)));
constexpr int BM = 256, BK = 64, HALF = 128, HTB = HALF * BK * 2  , STAGE_BYTES = 8 * HTB, NXCD = 8, WGM = 8;

__host__ __device__ __forceinline__ int lds_byte(int r, int c) { const int st = (r >> 4) * 2 + (c >> 5), rr = r & 15, cc = c & 31, ob = rr * 64 + cc * 2; return st * 1024 + (ob ^ (((ob >> 9) & 1) << 5)); }
__host__ __device__ __forceinline__ void stage_rc(int b, int& R, int& C) { const int st = b / 1024, sb = b % 1024, swz = sb ^ (((sb >> 9) & 1) << 5); R = (st >> 1) * 16 + swz / 64; C = (st & 1) * 32 + (swz % 64) / 2; }
__host__ __device__ __forceinline__ int perm32(int rho) { const int n = rho >> 4, i = rho & 15; return 8 * (i >> 2) + 4 * n + (i & 3); }

struct Unit { int pm, pn, ko; };
struct Gemm { const bf16_t* A; const bf16_t* Bt; int M, N, K, ld; };

struct StaticOrder {
    int nM, nN, nwg, G, c;
    __host__ __device__ void init(int M, int N, int G_, int c_) { nM = M / BM; nN = N / BM; nwg = nM * nN; G = G_; c = c_; }
    __host__ __device__ bool next(int i, Unit& u) const {
        const long L = (long)i * G + c; if (L >= nwg) return false;
        int wgid = (int)L; { const int q = nwg / NXCD, r = nwg % NXCD, xcd = wgid % NXCD, off = wgid / NXCD; wgid = (xcd < r ? xcd * (q + 1) : r * (q + 1) + (xcd - r) * q) + off; }
        const int nig = WGM * nN, gid = wgid / nig, fm = gid * WGM, gsz = (nM - fm) < WGM ? (nM - fm) : WGM;
        u.pm = fm + ((wgid % nig) % gsz); u.pn = (wgid % nig) / gsz; u.ko = 0; return true;
    }
    __device__ __forceinline__ void a_ready(const Unit&) const {}
    __device__ __forceinline__ void done(const Unit&) const {}
};

__device__ __forceinline__ unsigned cvt_pk_bf16(float lo, float hi) { unsigned r; asm volatile("v_cvt_pk_bf16_f32 %0, %1, %2" : "=v"(r) : "v"(lo), "v"(hi)); return r; }
typedef float f32x2 __attribute__((ext_vector_type(2)));
__device__ __forceinline__ f32x2 gelu_pk(f32x2 v) {
    const f32x2 av = __builtin_elementwise_abs(v), d = av * 0.2316418882f + 1.0f;
    f32x2 t; t.x = __builtin_amdgcn_rcpf(d.x); t.y = __builtin_amdgcn_rcpf(d.y);
    f32x2 q = t * 0.5307027145f + (-0.7265760135f); q = q * t + 0.7107068705f; q = q * t + (-0.142248368f); q = q * t + 0.127414796f; q = q * t;
    const f32x2 s = (v * v) * (-0.72134752044f);
    f32x2 e; e.x = __builtin_amdgcn_exp2f(s.x); e.y = __builtin_amdgcn_exp2f(s.y);
    const f32x2 m = v * (q * e), r = v - m;
    f32x2 o; o.x = v.x < 0.f ? m.x : r.x; o.y = v.y < 0.f ? m.y : r.y; return o;
}

template <int ACT  > struct EpiBf16 {
    static constexpr bool PERM = true, AFTER_DRAIN = false; static_assert(ACT == 0 || ACT == 1, "EpiBf16: ACT is 0 (none) or 1 (gelu_pk)");
    bf16_t* O; int ldc; const float* bias; int split_cols; size_t split_stride; float scale0;
    __device__ __forceinline__ void operator()(const f32x4 (&acc)[2][2][4][2], const Unit& u, int wr, int wc, int fr, int fq) const {
        const int row0 = u.pm * BM + wr * 64 + fr; int colt = u.pn * BM; bf16_t* base = O;
        float sc = 1.f; if (split_cols) { const int t = colt / split_cols; base += (size_t)t * split_stride; colt -= t * split_cols; if (t == 0) sc = scale0; }
        const int col0 = colt + wc * 32 + 8 * fq, bcol0 = u.pn * BM + wc * 32 + 8 * fq;
        f32x4 bv[2][2];
#pragma unroll
        for (int bj = 0; bj < 2; ++bj)
#pragma unroll
            for (int n = 0; n < 2; ++n) bv[bj][n] = bias ? *(const f32x4*)(bias + bcol0 + bj * HALF + 4 * n) : (f32x4){0.f, 0.f, 0.f, 0.f};
#pragma unroll
        for (int ai = 0; ai < 2; ++ai)
#pragma unroll
            for (int m = 0; m < 4; ++m) { bf16_t* rowp = base + (size_t)(row0 + ai * HALF + m * 16) * ldc + col0;
#pragma unroll
                for (int bj = 0; bj < 2; ++bj) { f32x4 v0 = acc[ai][bj][m][0] + bv[bj][0], v1 = acc[ai][bj][m][1] + bv[bj][1];
                    if (ACT == 1) { f32x2 a = gelu_pk((f32x2){v0[0], v0[1]}), b = gelu_pk((f32x2){v0[2], v0[3]}), c = gelu_pk((f32x2){v1[0], v1[1]}), d = gelu_pk((f32x2){v1[2], v1[3]});
                        v0 = (f32x4){a.x, a.y, b.x, b.y}; v1 = (f32x4){c.x, c.y, d.x, d.y}; }
                    v0 = v0 * sc; v1 = v1 * sc; u32x4 w; w.x = cvt_pk_bf16(v0[0], v0[1]); w.y = cvt_pk_bf16(v0[2], v0[3]); w.z = cvt_pk_bf16(v1[0], v1[1]); w.w = cvt_pk_bf16(v1[2], v1[3]);
                    *(u32x4*)(rowp + bj * HALF) = w; } }
    }
};

struct PanelStats {
    unsigned* xbuf;
    unsigned* cnt;
    unsigned* tmo;
    int ntn; float eps;
    unsigned code;
    __device__ __forceinline__ bool run(const f32x4 (&v)[2][2][4][2], const Unit& u, int wr, int wc, int fr, int fq, PG8_LAS unsigned char* lds, int wid, int lane) const {
        typedef float f32x2v __attribute__((ext_vector_type(2)));
        PG8_LAS f32x2v* P = (PG8_LAS f32x2v*)lds;
        PG8_LAS f32x2v* S = (PG8_LAS f32x2v*)(lds + 8192);
        PG8_LAS unsigned* flag = (PG8_LAS unsigned*)(lds + 8192 + 2048);
#pragma unroll
        for (int ai = 0; ai < 2; ++ai)
#pragma unroll
            for (int m = 0; m < 4; ++m) {
                float s = 0.f;
#pragma unroll
                for (int bj = 0; bj < 2; ++bj)
#pragma unroll
                    for (int n = 0; n < 2; ++n) { const f32x4 x = v[ai][bj][m][n]; s += (x[0] + x[1]) + (x[2] + x[3]); }
                s += __shfl_xor(s, 16); s += __shfl_xor(s, 32);
                const float mw = s * (1.0f / 64.0f); float q = 0.f;
#pragma unroll
                for (int bj = 0; bj < 2; ++bj)
#pragma unroll
                    for (int n = 0; n < 2; ++n) { const f32x4 d = v[ai][bj][m][n] - mw; q += (d[0] * d[0] + d[1] * d[1]) + (d[2] * d[2] + d[3] * d[3]); }
                q += __shfl_xor(q, 16); q += __shfl_xor(q, 32);
                if (fq == 0) P[(ai * HALF + wr * 64 + m * 16 + fr) * 4 + wc] = (f32x2v){mw, q};
            }
        asm volatile("s_waitcnt lgkmcnt(0)" ::: "memory"); __builtin_amdgcn_s_barrier(); asm volatile("" ::: "memory");
#if defined(BROKEN_EXCHANGE_NO_WAIT)
#warning BROKEN CONTROL BUILD: the row-statistics exchange does not wait; results are wrong by design
        if (blockIdx.x >= 64) { const long long t0_ = clock64(); while (clock64() - t0_ < 60000) __builtin_amdgcn_s_sleep(8); }
#endif
        const int row = wid * 32 + (lane & 31);
        if (lane < 32) {
            const f32x2v a = P[row * 4 + 0], b = P[row * 4 + 1], c = P[row * 4 + 2], d = P[row * 4 + 3];
            const float mt = (a.x + b.x + c.x + d.x) * 0.25f;
            const float da = a.x - mt, db = b.x - mt, dc = c.x - mt, dd = d.x - mt;
            const float m2 = (a.y + b.y) + (c.y + d.y) + 64.0f * ((da * da + db * db) + (dc * dc + dd * dd));
            unsigned long long* slot = (unsigned long long*)xbuf + ((size_t)(u.pm * BM + row) * 4 + u.pn);
            __hip_atomic_store(slot, ((unsigned long long)__float_as_uint(m2) << 32) | __float_as_uint(mt), __ATOMIC_RELAXED, __HIP_MEMORY_SCOPE_AGENT);
        }
        asm volatile("s_waitcnt vmcnt(0)" ::: "memory");
        if (lane == 0) __hip_atomic_fetch_add(cnt + 64 * u.pm, 1u, __ATOMIC_RELAXED, __HIP_MEMORY_SCOPE_AGENT);
        if (wid == 0) {
            bool dead = false; const unsigned long long t0 = __builtin_amdgcn_s_memrealtime(); const unsigned want = 8u * (unsigned)ntn;
            for (;;) {
#if defined(BROKEN_EXCHANGE_NO_WAIT)
                break;
#endif
                if ((unsigned)__builtin_amdgcn_readfirstlane(__hip_atomic_load(cnt + 64 * u.pm, __ATOMIC_RELAXED, __HIP_MEMORY_SCOPE_AGENT)) >= want) break;
                if (__builtin_amdgcn_s_memrealtime() - t0 > 2000000ull) {
                    if (lane == 0) { unsigned expect = 0u; __hip_atomic_compare_exchange_strong(tmo + 1, &expect, code | (unsigned)(u.pm & 0xff), __ATOMIC_RELAXED, __ATOMIC_RELAXED, __HIP_MEMORY_SCOPE_AGENT);
                                     __hip_atomic_store(tmo, 1u, __ATOMIC_RELAXED, __HIP_MEMORY_SCOPE_AGENT); }
                    dead = true; break; }
                __builtin_amdgcn_s_sleep(2);
            }
            __builtin_amdgcn_fence(__ATOMIC_ACQUIRE, "agent");
            if (lane == 0) flag[0] = dead ? 1u : 0u;
        }
        asm volatile("s_waitcnt vmcnt(0) lgkmcnt(0)" ::: "memory"); __builtin_amdgcn_s_barrier(); asm volatile("" ::: "memory");
        const bool bad = flag[0] != 0u;
        if (lane < 32) {
            const unsigned long long* slot = (const unsigned long long*)xbuf + (size_t)(u.pm * BM + row) * 4; float mt[4], m2[4]; float ms = 0.f;
#pragma unroll
            for (int t = 0; t < 4; ++t) { if (t < ntn) { const unsigned long long w = __hip_atomic_load(slot + t, __ATOMIC_RELAXED, __HIP_MEMORY_SCOPE_AGENT); mt[t] = __uint_as_float((unsigned)w); m2[t] = __uint_as_float((unsigned)(w >> 32)); } else { mt[t] = 0.f; m2[t] = 0.f; } ms += mt[t]; }
            const float mean = ms / (float)ntn; float q = 0.f;
#pragma unroll
            for (int t = 0; t < 4; ++t) if (t < ntn) { const float dm = mt[t] - mean; q += m2[t] + 256.0f * dm * dm; }
            S[row] = (f32x2v){mean, 1.0f / sqrtf(q / (256.0f * (float)ntn) + eps)};
        }
        asm volatile("s_waitcnt lgkmcnt(0)" ::: "memory"); __builtin_amdgcn_s_barrier(); asm volatile("" ::: "memory");
        return bad;
    }
};
struct EpiLnRes {
    static constexpr bool PERM = false, AFTER_DRAIN = true;
    const float* base; float* out; int ldc; const float* bias; PanelStats st; unsigned poison;
    __device__ __forceinline__ void fused(f32x4 (&acc)[2][2][4][2], const Unit& u, int wr, int wc, int fr, int fq, PG8_LAS unsigned char* lds, int wid, int lane) const {
        typedef float f32x2v __attribute__((ext_vector_type(2)));
        const PG8_LAS f32x2v* S = (const PG8_LAS f32x2v*)(lds + 8192);
        const int col0 = u.pn * BM + wc * 32 + 4 * fq;
#pragma unroll
        for (int bj = 0; bj < 2; ++bj)
#pragma unroll
            for (int n = 0; n < 2; ++n) { const f32x4 bv = bias ? *(const f32x4*)(bias + col0 + bj * HALF + n * 16) : (f32x4){0.f, 0.f, 0.f, 0.f};
#pragma unroll
                for (int ai = 0; ai < 2; ++ai)
#pragma unroll
                    for (int m = 0; m < 4; ++m) acc[ai][bj][m][n] += bv; }
        f32x4 pre[4][2][2];
#pragma unroll
        for (int m = 0; m < 4; ++m) { const size_t off = (size_t)(u.pm * BM + wr * 64 + m * 16 + fr) * ldc + col0;
#pragma unroll
            for (int bj = 0; bj < 2; ++bj)
#pragma unroll
                for (int n = 0; n < 2; ++n) pre[m][bj][n] = *(const f32x4*)(base + off + bj * HALF + n * 16); }
        const bool bad = st.run(acc, u, wr, wc, fr, fq, lds, wid, lane) || poison != 0u;
        const float qnan = __builtin_nanf("");
#pragma unroll
        for (int ai = 0; ai < 2; ++ai)
#pragma unroll
            for (int m = 0; m < 4; ++m) { const int r = ai * HALF + wr * 64 + m * 16 + fr; const f32x2v sr = S[r]; const size_t off = (size_t)(u.pm * BM + r) * ldc + col0;
#pragma unroll
                for (int bj = 0; bj < 2; ++bj)
#pragma unroll
                    for (int n = 0; n < 2; ++n) { const f32x4 bs = ai == 0 ? pre[m][bj][n] : *(const f32x4*)(base + off + bj * HALF + n * 16); f32x4 o = bs + (acc[ai][bj][m][n] - sr.x) * sr.y;
                        if (bad) o = (f32x4){qnan, qnan, qnan, qnan}; *(f32x4*)(out + off + bj * HALF + n * 16) = o; }
                if (m & 1) asm volatile("" ::: "memory"); }
    }
};
struct EpiLnResLn {
    static constexpr bool PERM = false, AFTER_DRAIN = true;
    const float* base; float* out; bf16_t* xn; int ldc; const float* bias; PanelStats st1, st2; unsigned poison;
    __device__ __forceinline__ void fused(f32x4 (&acc)[2][2][4][2], const Unit& u, int wr, int wc, int fr, int fq, PG8_LAS unsigned char* lds, int wid, int lane) const {
        typedef float f32x2v __attribute__((ext_vector_type(2))); typedef unsigned u32x2v __attribute__((ext_vector_type(2)));
        const PG8_LAS f32x2v* S = (const PG8_LAS f32x2v*)(lds + 8192);
        const int col0 = u.pn * BM + wc * 32 + 4 * fq;
#pragma unroll
        for (int bj = 0; bj < 2; ++bj)
#pragma unroll
            for (int n = 0; n < 2; ++n) { const f32x4 bv = bias ? *(const f32x4*)(bias + col0 + bj * HALF + n * 16) : (f32x4){0.f, 0.f, 0.f, 0.f};
#pragma unroll
                for (int ai = 0; ai < 2; ++ai)
#pragma unroll
                    for (int m = 0; m < 4; ++m) acc[ai][bj][m][n] += bv; }
        bool bad = st1.run(acc, u, wr, wc, fr, fq, lds, wid, lane) || poison != 0u;
        const float qnan = __builtin_nanf("");
#pragma unroll
        for (int ai = 0; ai < 2; ++ai)
#pragma unroll
            for (int m = 0; m < 4; ++m) { const int r = ai * HALF + wr * 64 + m * 16 + fr; const f32x2v sr = S[r]; const size_t off = (size_t)(u.pm * BM + r) * ldc + col0;
#pragma unroll
                for (int bj = 0; bj < 2; ++bj)
#pragma unroll
                    for (int n = 0; n < 2; ++n) { const f32x4 bs = *(const f32x4*)(base + off + bj * HALF + n * 16); acc[ai][bj][m][n] = bs + (acc[ai][bj][m][n] - sr.x) * sr.y; }
                asm volatile("" : "+v"(acc[ai][0][m][0]), "+v"(acc[ai][0][m][1]), "+v"(acc[ai][1][m][0]), "+v"(acc[ai][1][m][1]));
                if (m & 1) asm volatile("" ::: "memory"); }
        const bool bad1 = bad;
        bad = st2.run(acc, u, wr, wc, fr, fq, lds, wid, lane) || bad;
#pragma unroll
        for (int ai = 0; ai < 2; ++ai)
#pragma unroll
            for (int m = 0; m < 4; ++m) { const int r = ai * HALF + wr * 64 + m * 16 + fr; const f32x2v sr = S[r]; const size_t off = (size_t)(u.pm * BM + r) * ldc + col0;
#pragma unroll
                for (int bj = 0; bj < 2; ++bj)
#pragma unroll
                    for (int n = 0; n < 2; ++n) { const f32x4 x1 = acc[ai][bj][m][n]; *(f32x4*)(out + off + bj * HALF + n * 16) = bad1 ? (f32x4){qnan, qnan, qnan, qnan} : x1;
                        const f32x4 o = (x1 - sr.x) * sr.y; u32x2v w; w.x = cvt_pk_bf16(o[0], o[1]); w.y = cvt_pk_bf16(o[2], o[3]);
                        if (bad) { w.x = 0x7fc07fc0u; w.y = 0x7fc07fc0u; } *(u32x2v*)(xn + off + bj * HALF + n * 16) = w; }
                asm volatile("" ::: "memory"); }
    }
};

template <class Epi, class Sched, bool ALIGN_EPI = false, bool SP2 = false>
__device__ __forceinline__ void gemm_phase(PG8_LAS unsigned char* lds, const Gemm g, const Sched& S, const Epi& E, const int tid) {
    const int wid = __builtin_amdgcn_readfirstlane(tid >> 6), lane = tid & 63, wr = wid >> 2, wc = wid & 3, fr = lane & 15, fq = lane >> 4;
    const int K = g.K, nt = K / BK;
    unsigned voffA[2], voffB[2];
#pragma unroll
    for (int i = 0; i < 2; ++i) { int R, C; stage_rc(tid * 16 + i * 8192, R, C); const int Rb = Epi::PERM ? ((R & ~31) + perm32(R & 31)) : R;
        voffA[i] = (unsigned)(R * g.ld + C) * 2u; voffB[i] = (unsigned)(Rb * g.ld + C) * 2u; }
    const size_t kstep = (size_t)(BK * 2);
    const size_t hstep = (size_t)HALF * g.ld * 2;
    const size_t tstep = 2 * hstep;
    const unsigned ldsw = (unsigned)wid * 1024u;
    const int aoff = lds_byte(wr * 64 + fr, fq * 8), boff = lds_byte(wc * 32 + fr, fq * 8);
#define PG8_SA(b, h) (((b) * 2 + (h)) * HTB)
#define PG8_SB(b, h) ((4 + (b) * 2 + (h)) * HTB)
#define PG8_STAGE(bufoff, gbase, voff) do { _Pragma("unroll") for (int _i = 0; _i < 2; ++_i) \
        __builtin_amdgcn_global_load_lds((const unsigned*)((const char*)(gbase) + (voff)[_i]), (PG8_LAS unsigned*)(lds + (bufoff) + ldsw + _i * 8192), 16, 0, 0); } while (0)
#define PG8_LDA(dst, b, h) do { _Pragma("unroll") for (int m = 0; m < 4; ++m) _Pragma("unroll") for (int k = 0; k < 2; ++k) dst[m][k] = *(const PG8_LAS bf16x8*)(lds + PG8_SA(b, h) + aoff + m * 2048 + k * 1024); } while (0)
#define PG8_LDB(dst, b, h) do { _Pragma("unroll") for (int n = 0; n < 2; ++n) _Pragma("unroll") for (int k = 0; k < 2; ++k) dst[n][k] = *(const PG8_LAS bf16x8*)(lds + PG8_SB(b, h) + boff + n * 2048 + k * 1024); } while (0)
#define PG8_MMA(ai, bj, At, Bt) do { __builtin_amdgcn_s_setprio(1); _Pragma("unroll") for (int m = 0; m < 4; ++m) _Pragma("unroll") for (int n = 0; n < 2; ++n) _Pragma("unroll") for (int k = 0; k < 2; ++k) \
        acc[ai][bj][m][n] = __builtin_amdgcn_mfma_f32_16x16x32_bf16(Bt[n][k], At[m][k], acc[ai][bj][m][n], 0, 0, 0); __builtin_amdgcn_s_setprio(0); } while (0)
#define PG8_WAIT_V(n) asm volatile("s_waitcnt vmcnt(" #n ")" ::: "memory")
#define PG8_WAIT_L(n) asm volatile("s_waitcnt lgkmcnt(" #n ")" ::: "memory")
#define PG8_BAR __builtin_amdgcn_s_barrier()
#define PG8_SCHED __builtin_amdgcn_sched_barrier(0)
    Unit cur, nxt; int ui = 0;
    if (!S.next(0, cur)) return;
    f32x4 acc[2][2][4][2];
#pragma unroll
    for (int a = 0; a < 2; ++a)
#pragma unroll
        for (int b = 0; b < 2; ++b)
#pragma unroll
            for (int m = 0; m < 4; ++m)
#pragma unroll
                for (int n = 0; n < 2; ++n) acc[a][b][m][n] = (f32x4){0.f, 0.f, 0.f, 0.f};
    bf16x8 At[4][2], B0[2][2], B1[2][2];
    const char* cA = (const char*)g.A + (size_t)cur.pm * tstep + (size_t)cur.ko * 2; const char* cB = (const char*)g.Bt + (size_t)cur.pn * tstep + (size_t)cur.ko * 2;
    S.a_ready(cur);
    if constexpr (SP2) {
        PG8_STAGE(PG8_SB(0, 0), cB, voffB); PG8_STAGE(PG8_SB(0, 1), cB + hstep, voffB); PG8_STAGE(PG8_SA(0, 0), cA, voffA); PG8_STAGE(PG8_SA(0, 1), cA + hstep, voffA);
        if (wr == 1) PG8_BAR;
        PG8_WAIT_V(2); PG8_BAR;
        PG8_STAGE(PG8_SB(1, 0), cB + kstep, voffB); PG8_STAGE(PG8_SA(1, 0), cA + kstep, voffA); PG8_STAGE(PG8_SB(1, 1), cB + hstep + kstep, voffB);
        PG8_WAIT_V(6); PG8_BAR;
    } else {
        PG8_STAGE(PG8_SB(0, 0), cB, voffB); PG8_STAGE(PG8_SA(0, 0), cA, voffA); PG8_STAGE(PG8_SB(0, 1), cB + hstep, voffB); PG8_STAGE(PG8_SA(0, 1), cA + hstep, voffA);
        if (wr == 1) PG8_BAR;
        PG8_WAIT_V(4); PG8_BAR;
        PG8_STAGE(PG8_SB(1, 0), cB + kstep, voffB); PG8_STAGE(PG8_SA(1, 0), cA + kstep, voffA); PG8_STAGE(PG8_SB(1, 1), cB + hstep + kstep, voffB);
        PG8_WAIT_V(6); PG8_BAR;
    }
    for (;;) {
        const bool has_next = S.next(ui + 1, nxt);
        const char* nA = has_next ? (const char*)g.A + (size_t)nxt.pm * tstep + (size_t)nxt.ko * 2 : cA; const char* nB = has_next ? (const char*)g.Bt + (size_t)nxt.pn * tstep + (size_t)nxt.ko * 2 : cB;
        for (int t = 0; t < nt; t += 2) {
            const bool last = (t == nt - 2);
            const char* a1 = cA + (size_t)(t + 1) * kstep;
            const char* a2 = last ? nA : cA + (size_t)(t + 2) * kstep; const char* b2 = last ? nB : cB + (size_t)(t + 2) * kstep;
            const char* a3 = a2 + kstep; const char* b3 = b2 + kstep;
            if (last && has_next) S.a_ready(nxt);
            if constexpr (SP2) {
            PG8_LDB(B0, 0, 0); PG8_LDB(B1, 0, 1); PG8_SCHED; PG8_LDA(At, 0, 0); PG8_STAGE(PG8_SA(1, 1), a1 + hstep, voffA);
            PG8_WAIT_V(8); PG8_WAIT_L(0); PG8_BAR; PG8_MMA(0, 0, At, B0); PG8_MMA(0, 1, At, B1); PG8_BAR; PG8_SCHED;
            PG8_LDA(At, 0, 1); PG8_STAGE(PG8_SB(0, 0), b2, voffB); PG8_STAGE(PG8_SB(0, 1), b2 + hstep, voffB); PG8_STAGE(PG8_SA(0, 0), a2, voffA);
            PG8_WAIT_V(8); PG8_WAIT_L(0); PG8_BAR; PG8_MMA(1, 0, At, B0); PG8_MMA(1, 1, At, B1); PG8_BAR; PG8_SCHED;
            PG8_LDB(B0, 1, 0); PG8_LDB(B1, 1, 1); PG8_SCHED; PG8_LDA(At, 1, 0); PG8_STAGE(PG8_SA(0, 1), a2 + hstep, voffA);
            PG8_WAIT_V(8); PG8_WAIT_L(0); PG8_BAR; PG8_MMA(0, 0, At, B0); PG8_MMA(0, 1, At, B1); PG8_BAR; PG8_SCHED;
            PG8_LDA(At, 1, 1); PG8_STAGE(PG8_SB(1, 0), b3, voffB); PG8_STAGE(PG8_SB(1, 1), b3 + hstep, voffB); PG8_STAGE(PG8_SA(1, 0), a3, voffA);
            PG8_WAIT_V(8); PG8_WAIT_L(0); PG8_BAR; PG8_MMA(1, 0, At, B0); PG8_MMA(1, 1, At, B1); PG8_BAR; PG8_SCHED;
            } else {
            PG8_LDB(B0, 0, 0); PG8_SCHED; PG8_LDA(At, 0, 0); PG8_STAGE(PG8_SA(1, 1), a1 + hstep, voffA);
            PG8_WAIT_L(8); PG8_BAR; PG8_WAIT_L(0); PG8_MMA(0, 0, At, B0); PG8_BAR; PG8_SCHED;
            PG8_LDB(B1, 0, 1); PG8_STAGE(PG8_SB(0, 0), b2, voffB);
            PG8_BAR; PG8_WAIT_L(0); PG8_MMA(0, 1, At, B1); PG8_BAR;
            PG8_LDA(At, 0, 1); PG8_STAGE(PG8_SA(0, 0), a2, voffA);
            PG8_BAR; PG8_WAIT_L(0); PG8_MMA(1, 0, At, B0); PG8_BAR; PG8_SCHED;
            PG8_STAGE(PG8_SB(0, 1), b2 + hstep, voffB);
            PG8_WAIT_V(6); PG8_BAR; PG8_MMA(1, 1, At, B1); PG8_BAR;
            PG8_LDB(B0, 1, 0); PG8_SCHED; PG8_LDA(At, 1, 0); PG8_STAGE(PG8_SA(0, 1), a2 + hstep, voffA);
            PG8_WAIT_L(8); PG8_BAR; PG8_WAIT_L(0); PG8_MMA(0, 0, At, B0); PG8_BAR; PG8_SCHED;
            PG8_LDB(B1, 1, 1); PG8_STAGE(PG8_SB(1, 0), b3, voffB);
            PG8_BAR; PG8_WAIT_L(0); PG8_MMA(0, 1, At, B1); PG8_BAR;
            PG8_LDA(At, 1, 1); PG8_STAGE(PG8_SA(1, 0), a3, voffA);
            PG8_BAR; PG8_WAIT_L(0); PG8_MMA(1, 0, At, B0); PG8_BAR; PG8_SCHED;
            PG8_STAGE(PG8_SB(1, 1), b3 + hstep, voffB);
            PG8_WAIT_V(6); PG8_BAR; PG8_MMA(1, 1, At, B1); PG8_BAR;
            }
        }
        if constexpr (ALIGN_EPI) { if (wr == 0) PG8_BAR; }
        if constexpr (!Epi::AFTER_DRAIN) { E(acc, cur, wr, wc, fr, fq); S.done(cur); }
        if (!has_next) break;
#pragma unroll
        for (int a = 0; a < 2; ++a)
#pragma unroll
            for (int b = 0; b < 2; ++b)
#pragma unroll
                for (int m = 0; m < 4; ++m)
#pragma unroll
                    for (int n = 0; n < 2; ++n) acc[a][b][m][n] = (f32x4){0.f, 0.f, 0.f, 0.f};
        cur = nxt; cA = nA; cB = nB; ++ui;
        if constexpr (ALIGN_EPI) { if (wr == 1) PG8_BAR; }
    }
    PG8_WAIT_V(0);
    if constexpr (!ALIGN_EPI) { if (wr == 0) PG8_BAR; }
    PG8_BAR;
    if constexpr (Epi::AFTER_DRAIN) { E.fused(acc, cur, wr, wc, fr, fq, lds, wid, lane); S.done(cur); }
#undef PG8_SA
#undef PG8_SB
#undef PG8_STAGE
#undef PG8_LDA
#undef PG8_LDB
#undef PG8_MMA
#undef PG8_WAIT_V
#undef PG8_WAIT_L
#undef PG8_BAR
#undef PG8_SCHED
}
}

#define GAS __attribute__((address_space(1)))
#define LAS __attribute__((address_space(3)))
typedef unsigned short bf16;
typedef float f32x4 __attribute__((ext_vector_type(4)));
typedef float f32x16 __attribute__((ext_vector_type(16)));
typedef short bf16x8 __attribute__((ext_vector_type(8)));
typedef short s16x4 __attribute__((ext_vector_type(4)));
typedef unsigned u32x4 __attribute__((ext_vector_type(4)));
typedef unsigned u32x2 __attribute__((ext_vector_type(2)));
typedef float f32x2_t __attribute__((ext_vector_type(2)));
typedef __bf16 bf16x2_t __attribute__((ext_vector_type(2)));
typedef GAS unsigned gu32;
#define RLX_AGENT __ATOMIC_RELAXED, __HIP_MEMORY_SCOPE_AGENT

constexpr int D = 1024, BP = 4, TP = 4096, MP = BP * TP, BS = 128, TS = 8, MS = BS * TS, M = MP + MS;
constexpr int SBH = 8, HD = 64, SBW = 512, DNH = 4, DND = 128, DNW = 512;
constexpr int IN_COLS = 3592, NPROJ = 3584;
constexpr int DFF = 2816, DFF2 = 5632, NMOD = 6144, NC = BP + BS;
constexpr int PAST = 2048, NPAGES = 16, PAGE = 128;
constexpr float EPS = 1e-6f, LOG2E = 1.4426950408889634f;
constexpr float QSCALE = 0.125f * LOG2E;
constexpr int NSPLIT = 4, NPART = 5;

constexpr size_t O_YP = 0, O_KP = 17825792, O_VP = 26214400, O_KS = 34603008, O_VS = 35127296, O_SP = 35651584, O_SS = 35913728,
                 O_DCP = 44302336, O_DCS = 44320768, O_FCP = 44910592, O_FCS = 44955648, O_END = 46397440;

constexpr size_t MiB = 1u << 20;
constexpr size_t WS_CTL = 0, CTL_ZERO_BYTES = MiB;
constexpr size_t WS_MOD = 1 * MiB, WS_SC = 5 * MiB, WS_WINX = 6 * MiB, WS_WIN_T = 7 * MiB, WS_WOUT_T = 14 * MiB, WS_WUP_T = 16 * MiB, WS_WDN_T = 27 * MiB,
                 WS_EXTRA = 33 * MiB, WS_H = 34 * MiB, WS_DNRAW = 68 * MiB, WS_ZG = 120 * MiB, WS_QB = 306 * MiB, WS_KB = 323 * MiB, WS_VB = 340 * MiB, WS_QD = 357 * MiB, WS_KD = 391 * MiB,
                 WS_VD = 425 * MiB, WS_BETA = 459 * MiB, WS_LOGA = 460 * MiB, WS_ODN = 461 * MiB, WS_MIXED = 495 * MiB, WS_X1 = 529 * MiB, WS_SIDEP = 597 * MiB, WS_SIDES = 610 * MiB,
                 WS_ACT = 784 * MiB, WS_U = 878 * MiB, WS_KCUM = 910 * MiB, WS_QDEC = 926 * MiB, WS_KDECT = 942 * MiB, WS_INTRA = 958 * MiB, WS_GL = 966 * MiB,
                 WS_OPART = 967 * MiB, WS_LPART = 978 * MiB, WS_SLAB = 980 * MiB, WS_END = 1024 * MiB;
constexpr int CW_Q0 = 1024;
constexpr int CW_QUEUE = 64;
constexpr int CW_BAR = 8192;

constexpr int RING_BYTES = 131072, MISC_OFF = RING_BYTES + 320, LDS_BYTES = 147456;

__device__ __forceinline__ unsigned cvtpk(float lo, float hi) { f32x2_t v = {lo, hi}; bf16x2_t b = __builtin_convertvector(v, bf16x2_t); return __builtin_bit_cast(unsigned, b); }
__device__ __forceinline__ bf16 f2bf(float f) { return (bf16)(cvtpk(f, 0.f) & 0xffffu); }
__device__ __forceinline__ float wave_sum(float v) {
#pragma unroll
    for (int o = 1; o < 64; o <<= 1) v += __shfl_xor(v, o);
    return v;
}
__device__ __forceinline__ float siluf(float x) { return x * __builtin_amdgcn_rcpf(1.f + __builtin_amdgcn_exp2f(-1.4426950408889634f * x)); }
__device__ __forceinline__ u32x4 pack8(const f32x4 a, const f32x4 b) { u32x4 w; w.x = cvtpk(a.x, a.y); w.y = cvtpk(a.z, a.w); w.z = cvtpk(b.x, b.y); w.w = cvtpk(b.z, b.w); return w; }
__device__ __forceinline__ f32x4 bf4lo(u32x4 w) { return (f32x4){__uint_as_float(w.x << 16), __uint_as_float(w.x & 0xffff0000u), __uint_as_float(w.y << 16), __uint_as_float(w.y & 0xffff0000u)}; }
__device__ __forceinline__ f32x4 bf4hi(u32x4 w) { return (f32x4){__uint_as_float(w.z << 16), __uint_as_float(w.z & 0xffff0000u), __uint_as_float(w.w << 16), __uint_as_float(w.w & 0xffff0000u)}; }
__device__ __forceinline__ float bf2f(unsigned short h) { return __uint_as_float((unsigned)h << 16); }

#define XB_TMO      128
#define XB_XCNT(j)  (256  + 64 * (j))
#define XB_XSUB(j)  (1280 + 64 * (j))
#define XB_XGEN(j)  (2304 + 64 * (j))
#define XB_TOP      3328
#define XB_TOPGEN   3392
#define XCD_BAR_WORDS 3456
#define XB_SPIN_CAP (1u << 18)
__device__ __forceinline__ unsigned xb_ld(unsigned* p)              { return __hip_atomic_load(p, __ATOMIC_RELAXED, __HIP_MEMORY_SCOPE_AGENT); }
__device__ __forceinline__ unsigned xb_add(unsigned* p, unsigned v) { return __hip_atomic_fetch_add(p, v, __ATOMIC_RELAXED, __HIP_MEMORY_SCOPE_AGENT); }
__device__ __forceinline__ unsigned xb_xcc_id() { return (unsigned)__builtin_amdgcn_s_getreg((3 << 11) | 20) & 0xFu; }
#define XB_SPIN(cond, bar) do { unsigned _sp = 0; while (cond) { __builtin_amdgcn_s_sleep(1); \
    if ((++_sp & 255u) == 0u) { if (xb_ld(&(bar)[XB_TMO])) break; if (_sp > XB_SPIN_CAP) { atomicAdd(&(bar)[XB_TMO], 1u); break; } } } } while (0)
struct XcdBarrier { unsigned* bar; unsigned x; volatile LAS unsigned* st; };
__device__ __forceinline__ XcdBarrier xcd_barrier_post(unsigned* bar, volatile LAS unsigned* st, int tid) {
    XcdBarrier b; b.bar = bar; b.x = xb_xcc_id(); b.st = st;
    if (tid == 0) (void)xb_add(&bar[XB_XCNT(b.x)], 1u);
    return b;
}
__device__ __forceinline__ void xcd_barrier_complete(unsigned* bar, unsigned x, unsigned& nloc, unsigned& nx) {
    const unsigned G = gridDim.x * gridDim.y * gridDim.z;
    unsigned sum, cnt, mine, sp = 0u;
    for (;;) {
        sum = 0u; cnt = 0u; mine = 0u;
#pragma unroll
        for (unsigned j = 0; j < 16; ++j) { const unsigned c = xb_ld(&bar[XB_XCNT(j)]); sum += c; cnt += (c > 0u) ? 1u : 0u; mine = (j == x) ? c : mine; }
        if (sum == G) break;
        __builtin_amdgcn_s_sleep(1);
        if ((++sp & 255u) == 0u) { if (xb_ld(&bar[XB_TMO])) break; if (sp > XB_SPIN_CAP) { atomicAdd(&bar[XB_TMO], 1u); break; } }
    }
    nloc = mine > 0u ? mine : 1u; nx = cnt > 0u ? cnt : 1u;
}
__device__ __forceinline__ void xcd_barrier(const XcdBarrier& b, int tid) {
    asm volatile("s_waitcnt vmcnt(0)" ::: "memory");
    __syncthreads();
    if (tid == 0) {
        unsigned* bar = b.bar;
        __builtin_amdgcn_s_waitcnt(0);
        unsigned nloc = b.st[0], nx = b.st[1];
        if (nloc == 0u) { xcd_barrier_complete(bar, b.x, nloc, nx); b.st[0] = nloc; b.st[1] = nx; }
        const unsigned old = xb_add(&bar[XB_XSUB(b.x)], 1u);
        const unsigned gen = old / nloc;
        if (old + 1u == (gen + 1u) * nloc) {
            __builtin_amdgcn_fence(__ATOMIC_RELEASE, "agent");
            asm volatile("s_waitcnt vmcnt(0)" ::: "memory");
            const unsigned og = xb_add(&bar[XB_TOP], 1u);
            const unsigned tg = og / nx;
            if (og + 1u == (tg + 1u) * nx) xb_add(&bar[XB_TOPGEN], 1u);
            else XB_SPIN(xb_ld(&bar[XB_TOPGEN]) == tg, bar);
            __builtin_amdgcn_fence(__ATOMIC_ACQUIRE, "agent");
            xb_add(&bar[XB_XGEN(b.x)], 1u);
            asm volatile("s_waitcnt vmcnt(0)" ::: "memory");
        } else {
            XB_SPIN(xb_ld(&bar[XB_XGEN(b.x)]) == gen, bar);
            __builtin_amdgcn_fence(__ATOMIC_ACQUIRE, "agent");
            asm volatile("s_waitcnt vmcnt(0)" ::: "memory");
        }
    }
    __syncthreads();
}

__device__ __forceinline__ int lane_now() { int l; asm volatile("v_mbcnt_lo_u32_b32 %0, -1, 0\n\tv_mbcnt_hi_u32_b32 %0, -1, %0" : "=v"(l)); return l; }
struct Args { const void* in[27]; float* out; unsigned char* ws; int lo, hi; };
enum { I_XP = 0, I_XS, I_CP, I_CS, I_CK, I_CV, I_PT, I_SD, I_SDC, I_SFC, I_WADA, I_BADA, I_GATT, I_WIN, I_GQ, I_GK, I_SBB, I_GSBO, I_WDNC, I_ALOG, I_DTB, I_GDNO, I_WOUT, I_GFFN, I_WUP, I_WFC, I_WDN };

__device__ __forceinline__ int mod_row(int m) { return m < MP ? (m >> 12) : BP + ((m - MP) >> 3); }

struct EpiF32 {
    static constexpr bool PERM = false, AFTER_DRAIN = false;
    float* O; int ldc;
    __device__ __forceinline__ void operator()(const pg8::f32x4 (&acc)[2][2][4][2], const pg8::Unit& u, int wr, int wc, int fr, int fq) const {
        const int row0 = u.pm * 256 + wr * 64 + fr, col0 = u.pn * 256 + wc * 32 + 4 * fq;
#pragma unroll
        for (int ai = 0; ai < 2; ++ai)
#pragma unroll
            for (int m = 0; m < 4; ++m) { float* rowp = O + (size_t)(row0 + ai * 128 + m * 16) * ldc + col0;
#pragma unroll
                for (int bj = 0; bj < 2; ++bj)
#pragma unroll
                    for (int n = 0; n < 2; ++n) *(pg8::f32x4*)(rowp + bj * 128 + n * 16) = acc[ai][bj][m][n]; }
    }
};
struct EpiResGate {
    static constexpr bool PERM = false, AFTER_DRAIN = false;
    const float* base0; const float* base1; const float* mod; int goff; float* out;
    __device__ __forceinline__ void operator()(const pg8::f32x4 (&acc)[2][2][4][2], const pg8::Unit& u, int wr, int wc, int fr, int fq) const {
        const int row0 = u.pm * 256 + wr * 64 + fr, col0 = u.pn * 256 + wc * 32 + 4 * fq;
#pragma unroll
        for (int ai = 0; ai < 2; ++ai)
#pragma unroll
            for (int m = 0; m < 4; ++m) { const int r = row0 + ai * 128 + m * 16;
                const float* bp = (r < MP ? base0 + (size_t)r * D : base1 + (size_t)(r - MP) * D) + col0;
                const float* gp = mod + (size_t)mod_row(r) * NMOD + goff + col0; float* op = out + (size_t)r * D + col0;
#pragma unroll
                for (int bj = 0; bj < 2; ++bj)
#pragma unroll
                    for (int n = 0; n < 2; ++n) { const pg8::f32x4 b = *(const pg8::f32x4*)(bp + bj * 128 + n * 16), g = *(const pg8::f32x4*)(gp + bj * 128 + n * 16);
                        *(pg8::f32x4*)(op + bj * 128 + n * 16) = b + g * acc[ai][bj][m][n]; } }
    }
};

template <bool BASE_H, bool OUT_H> struct EpiResGateH {
    static constexpr bool PERM = true, AFTER_DRAIN = false;
    const void* base0; const float* mod; int goff; void* out;
    __device__ __forceinline__ void operator()(const pg8::f32x4 (&acc)[2][2][4][2], const pg8::Unit& u, int wr, int wc, int fr, int fq) const {
        const int row0 = u.pm * 256 + wr * 64 + fr, col0 = u.pn * 256 + wc * 32 + 8 * fq;
#pragma unroll
        for (int ai = 0; ai < 2; ++ai)
#pragma unroll
            for (int m = 0; m < 4; ++m) { const int r = row0 + ai * 128 + m * 16;
                const float* gp = mod + (size_t)mod_row(r) * NMOD + goff + col0;
#pragma unroll
                for (int bj = 0; bj < 2; ++bj) {
                    f32x4 b0, b1;
                    if (BASE_H) { const u32x4 w = *(const u32x4*)((const bf16*)base0 + (size_t)r * D + col0 + bj * 128); b0 = bf4lo(w); b1 = bf4hi(w); }
                    else { const float* bp = (const float*)base0 + (size_t)r * D + col0 + bj * 128; b0 = *(const f32x4*)bp; b1 = *(const f32x4*)(bp + 4); }
                    const f32x4 g0 = *(const f32x4*)(gp + bj * 128), g1 = *(const f32x4*)(gp + bj * 128 + 4);
                    const f32x4 o0 = b0 + g0 * acc[ai][bj][m][0], o1 = b1 + g1 * acc[ai][bj][m][1];
                    if (OUT_H) *(u32x4*)((bf16*)out + (size_t)r * D + col0 + bj * 128) = pack8(o0, o1);
                    else { float* op = (float*)out + (size_t)r * D + col0 + bj * 128; *(f32x4*)op = o0; *(f32x4*)(op + 4) = o1; } } }
    }
};

#define DPP_F(old_, src_, ctrl_) __uint_as_float((unsigned)__builtin_amdgcn_update_dpp((int)__float_as_uint(old_), (int)__float_as_uint(src_), (ctrl_), 0xF, 0xF, false))
struct EpiUp {
    static constexpr bool PERM = true, AFTER_DRAIN = false;
    bf16* ACT; bf16* SIDEP; bf16* SIDES; const float* wf; float* out;
    __device__ __forceinline__ void operator()(const pg8::f32x4 (&acc)[2][2][4][2], const pg8::Unit& u, int wr, int wc, int fr, int fq) const {
        const bool prompt_tile = u.pm < MP / 256;
        const unsigned uc0 = (unsigned)(u.pn * 128 + wc * 32 + 8 * fq);
        const unsigned row0 = (unsigned)u.pm * 256u + (unsigned)(wr * 64 + fr);
        if (prompt_tile) {
#pragma unroll
            for (int ai = 0; ai < 2; ++ai) { const unsigned kb = (unsigned)u.pm * 4u + ai * 2 + wr;
                if (fr < 2) { bf16* sp = SIDEP + ((size_t)kb * 4 + fr) * DFF2 + uc0; *(u32x4*)sp = pack8(acc[ai][0][0][0], acc[ai][0][0][1]); *(u32x4*)(sp + DFF) = pack8(acc[ai][1][0][0], acc[ai][1][0][1]); }
                if (fr >= 14) { bf16* sp = SIDEP + ((size_t)kb * 4 + (fr - 12)) * DFF2 + uc0; *(u32x4*)sp = pack8(acc[ai][0][3][0], acc[ai][0][3][1]); *(u32x4*)(sp + DFF) = pack8(acc[ai][1][3][0], acc[ai][1][3][1]); } }
        } else {
            const int t = fr & 7;
#pragma unroll
            for (int ai = 0; ai < 2; ++ai)
#pragma unroll
                for (int m = 0; m < 4; ++m) { const unsigned seq = (row0 + ai * 128 + m * 16 - MP) >> 3;
                    if (t < 2) { bf16* sp = SIDES + ((size_t)seq * 2 + t) * DFF2 + uc0; *(u32x4*)sp = pack8(acc[ai][0][m][0], acc[ai][0][m][1]); *(u32x4*)(sp + DFF) = pack8(acc[ai][1][m][0], acc[ai][1][m][1]); }
                    if (t >= 6) { float* fo = out + O_FCS + ((size_t)seq * 2 + (t - 6)) * DFF2 + uc0;
                        *(pg8::f32x4*)fo = acc[ai][0][m][0]; *(pg8::f32x4*)(fo + 4) = acc[ai][0][m][1]; *(pg8::f32x4*)(fo + DFF) = acc[ai][1][m][0]; *(pg8::f32x4*)(fo + DFF + 4) = acc[ai][1][m][1]; } }
        }
        u32x2 half0[2][4];
#pragma unroll
        for (int n = 0; n < 2; ++n) {
            const float* wp = wf + uc0 + 4 * n;
            const pg8::f32x4 wu0 = *(const pg8::f32x4*)wp, wu1 = *(const pg8::f32x4*)(wp + DFF2), wu2 = *(const pg8::f32x4*)(wp + 2 * DFF2);
            const pg8::f32x4 wg0 = *(const pg8::f32x4*)(wp + DFF), wg1 = *(const pg8::f32x4*)(wp + DFF2 + DFF), wg2 = *(const pg8::f32x4*)(wp + 2 * DFF2 + DFF);
#pragma unroll
            for (int ai = 0; ai < 2; ++ai)
#pragma unroll
                for (int m = 0; m < 4; ++m) {
                    float a[4];
#pragma unroll
                    for (int c = 0; c < 4; ++c) {
                        const float cu = acc[ai][0][m][n][c], cg = acc[ai][1][m][n][c];
                        const float pu = m > 0 ? acc[ai][0][m - 1][n][c] : cu, pg = m > 0 ? acc[ai][1][m - 1][n][c] : cg;
                        const float u1 = DPP_F(DPP_F(0.f, pu, 0x121), cu, 0x111), u2 = DPP_F(DPP_F(0.f, pu, 0x122), cu, 0x112);
                        const float g1 = DPP_F(DPP_F(0.f, pg, 0x121), cg, 0x111), g2 = DPP_F(DPP_F(0.f, pg, 0x122), cg, 0x112);
                        const float yu = wu0[c] * u2 + wu1[c] * u1 + wu2[c] * cu, yg = wg0[c] * g2 + wg1[c] * g1 + wg2[c] * cg;
                        a[c] = siluf(yg) * yu;
                    }
                    u32x2 w; w.x = cvtpk(a[0], a[1]); w.y = cvtpk(a[2], a[3]);
                    if (n == 0) half0[ai][m] = w;
                    else *(u32x4*)(ACT + (size_t)(row0 + ai * 128 + m * 16) * DFF + uc0) = (u32x4){half0[ai][m].x, half0[ai][m].y, w.x, w.y};
                }
        }
    }
};

struct SplitKOrder {
    int nks, G, c;
    __device__ __forceinline__ bool next(int i, pg8::Unit& u) const { const int L = i * G + c; if (L >= 16 * nks) return false; const int su = L & 15, ks = L >> 4; u.pm = MP / 256 + (su >> 2); u.pn = su & 3; u.ko = ks * 256; return true; }
    __device__ __forceinline__ void a_ready(const pg8::Unit&) const {}
    __device__ __forceinline__ void done(const pg8::Unit&) const {}
};
struct EpiSlab {
    static constexpr bool PERM = false, AFTER_DRAIN = false;
    bf16* slab;
    __device__ __forceinline__ void operator()(const pg8::f32x4 (&acc)[2][2][4][2], const pg8::Unit& u, int wr, int wc, int fr, int fq) const {
        bf16* O = slab + (size_t)(u.ko >> 8) * ((size_t)MS * D);
        const int row0 = (u.pm - MP / 256) * 256 + wr * 64 + fr, col0 = u.pn * 256 + wc * 32 + 4 * fq;
#pragma unroll
        for (int ai = 0; ai < 2; ++ai)
#pragma unroll
            for (int m = 0; m < 4; ++m) { bf16* rowp = O + (size_t)(row0 + ai * 128 + m * 16) * D + col0;
#pragma unroll
                for (int bj = 0; bj < 2; ++bj)
#pragma unroll
                    for (int n = 0; n < 2; ++n) { const pg8::f32x4 a = acc[ai][bj][m][n]; *(u32x2*)(rowp + bj * 128 + n * 16) = (u32x2){cvtpk(a[0], a[1]), cvtpk(a[2], a[3])}; } }
    }
};
__device__ __forceinline__ void st16(void* base, unsigned off, u32x4 v) { *(u32x4*)((unsigned char*)base + off) = v; }
__device__ __forceinline__ void st16f(void* base, unsigned off, pg8::f32x4 v) { *(pg8::f32x4*)((unsigned char*)base + off) = v; }
struct EpiProj {
    static constexpr bool PERM = true, AFTER_DRAIN = false;
    float* out; bf16* QB; bf16* KB; bf16* VB; bf16* DNRAW; bf16* ZG; const float* g_q; const float* g_k; LAS float* xl;
    __device__ __forceinline__ void operator()(const pg8::f32x4 (&acc)[2][2][4][2], const pg8::Unit& u, int wr, int wc, int fr, int fq) const {
        const int pn = u.pn, rl0 = wr * 64 + fr, c0 = wc * 32 + 8 * fq;
        const unsigned row0 = (unsigned)u.pm * 256u + (unsigned)rl0;
        const bool prompt_tile = u.pm < MP / 256;
        if (pn < 4) {
            int xb = (rl0 * 8 + wc) * 4, xb2 = (rl0 * 8 + (wc ^ 1)) * 4; asm volatile("" : "+v"(xb), "+v"(xb2));
            LAS float* xw = (LAS float*)((LAS unsigned char*)xl + xb); const LAS float* xr = (const LAS float*)((LAS unsigned char*)xl + xb2);
#pragma unroll
            for (int ai = 0; ai < 2; ++ai)
#pragma unroll
                for (int m = 0; m < 4; ++m)
#pragma unroll
                    for (int bj = 0; bj < 2; ++bj) { const pg8::f32x4 a = acc[ai][bj][m][0], b = acc[ai][bj][m][1];
                        float ss = (a[0] * a[0] + a[1] * a[1]) + (a[2] * a[2] + a[3] * a[3]) + (b[0] * b[0] + b[1] * b[1]) + (b[2] * b[2] + b[3] * b[3]);
                        ss += __shfl_xor(ss, 16); ss += __shfl_xor(ss, 32);
                        if (fq == 0) xw[(ai * 128 + m * 16) * 8 + bj * 4] = ss; }
            asm volatile("s_waitcnt lgkmcnt(0)" ::: "memory"); __builtin_amdgcn_s_barrier(); asm volatile("" ::: "memory");
            const bool isq = pn < 2; const float* g = isq ? g_q : g_k; const int dloc = 32 * (wc & 1) + 8 * fq;
            const pg8::f32x4 g0 = *(const pg8::f32x4*)(g + dloc), g1 = *(const pg8::f32x4*)(g + dloc + 4);
            bf16* dstb = isq ? QB : KB; float* dstf = prompt_tile ? out + O_KP : out + O_KS - (size_t)MP * SBW;
#pragma unroll
            for (int ai = 0; ai < 2; ++ai)
#pragma unroll
                for (int m = 0; m < 4; ++m) { const unsigned row = row0 + ai * 128 + m * 16;
#pragma unroll
                    for (int bj = 0; bj < 2; ++bj) { const float tot = xw[(ai * 128 + m * 16) * 8 + bj * 4] + xr[(ai * 128 + m * 16) * 8 + bj * 4];
                        const float rs = (isq ? QSCALE : 1.0f) / sqrtf(tot * (1.f / HD) + EPS);
                        const pg8::f32x4 a = acc[ai][bj][m][0] * rs * g0, b = acc[ai][bj][m][1] * rs * g1;
                        const unsigned e = row * SBW + (unsigned)((pn & 1) * 256 + bj * 128 + c0);
                        st16(dstb, e * 2u, pack8(a, b));
                        if (!isq) { st16f(dstf, e * 4u, a); st16f(dstf, e * 4u + 16u, b); } }
                    asm volatile("" ::: "memory"); }
            asm volatile("s_waitcnt lgkmcnt(0)" ::: "memory"); __builtin_amdgcn_s_barrier(); asm volatile("" ::: "memory");
        } else if (pn < 6) {
            float* dstf = prompt_tile ? out + O_VP : out + O_VS - (size_t)MP * SBW;
#pragma unroll
            for (int ai = 0; ai < 2; ++ai)
#pragma unroll
                for (int m = 0; m < 4; ++m) { const unsigned row = row0 + ai * 128 + m * 16;
#pragma unroll
                    for (int bj = 0; bj < 2; ++bj) { const pg8::f32x4 a = acc[ai][bj][m][0], b = acc[ai][bj][m][1]; const unsigned e = row * SBW + (unsigned)((pn & 1) * 256 + bj * 128 + c0);
                        st16(VB, e * 2u, pack8(a, b)); st16f(dstf, e * 4u, a); st16f(dstf, e * 4u + 16u, b); }
                    asm volatile("" ::: "memory"); }
        } else if (pn < 12) {
#pragma unroll
            for (int ai = 0; ai < 2; ++ai)
#pragma unroll
                for (int m = 0; m < 4; ++m) { const unsigned row = row0 + ai * 128 + m * 16;
                    const int b = prompt_tile ? (int)(row >> 12) : (int)((row - MP) >> 3), t = prompt_tile ? (int)(row & 4095) : (int)((row - MP) & 7), idx = prompt_tile ? t - (TP - 3) : t - (TS - 3);
#pragma unroll
                    for (int bj = 0; bj < 2; ++bj) { const pg8::f32x4 a = acc[ai][bj][m][0], b2 = acc[ai][bj][m][1]; const unsigned ch = (unsigned)((pn - 6) * 256 + bj * 128 + c0);
                        st16(DNRAW, (row * 1536u + ch) * 2u, pack8(a, b2));
                        if (idx >= 0) { float* o = prompt_tile ? out + O_DCP : out + O_DCS; const unsigned eo = ((unsigned)(b * 3 + idx) * 1536u + ch) * 4u; st16f(o, eo, a); st16f(o, eo + 16u, b2); } }
                    asm volatile("" ::: "memory"); }
        } else {
#pragma unroll
            for (int ai = 0; ai < 2; ++ai)
#pragma unroll
                for (int m = 0; m < 4; ++m) { const unsigned row = row0 + ai * 128 + m * 16;
#pragma unroll
                    for (int bj = 0; bj < 2; ++bj) { pg8::f32x4 a = acc[ai][bj][m][0], b = acc[ai][bj][m][1]; const unsigned e = row * DNW + (unsigned)((pn - 12) * 256 + bj * 128 + c0);
                        a[0] = siluf(a[0]); a[1] = siluf(a[1]); a[2] = siluf(a[2]); a[3] = siluf(a[3]); b[0] = siluf(b[0]); b[1] = siluf(b[1]); b[2] = siluf(b[2]); b[3] = siluf(b[3]);
                        st16(ZG, e * 2u, pack8(a, b)); }
                    asm volatile("" ::: "memory"); }
        }
    }
};

template <int NT>
__device__ __forceinline__ void mod_tile(const Args& A, LAS unsigned char* lds, int ct, int ct2, int wave, int lane) {
    const float* w_ada = (const float*)A.in[I_WADA]; const float* b_ada = (const float*)A.in[I_BADA];
    const float* cp = (const float*)A.in[I_CP]; const float* cs = (const float*)A.in[I_CS]; float* MOD = (float*)(A.ws + WS_MOD);
    const int lr = lane & 15, q = lane >> 4;
    pg8::f32x4 acc[NT][9];
#pragma unroll
    for (int t = 0; t < NT; ++t)
#pragma unroll
        for (int i = 0; i < 9; ++i) acc[t][i] = (pg8::f32x4){0.f, 0.f, 0.f, 0.f};
#pragma unroll
    for (int s4 = 0; s4 < 4; ++s4) {
        const int k0 = 128 * wave + 32 * s4 + 8 * q;
        bf16x8 bfr[NT];
#pragma unroll
        for (int t = 0; t < NT; ++t) { const float* wp = w_ada + (size_t)k0 * NMOD + (t == 0 ? ct : ct2) * 16 + lr;
            float w[8];
#pragma unroll
            for (int j = 0; j < 8; ++j) w[j] = wp[(size_t)j * NMOD];
            u32x4 bw; bw.x = cvtpk(w[0], w[1]); bw.y = cvtpk(w[2], w[3]); bw.z = cvtpk(w[4], w[5]); bw.w = cvtpk(w[6], w[7]);
            bfr[t] = __builtin_bit_cast(bf16x8, bw); }
#pragma unroll
        for (int i = 0; i < 9; ++i) { const int row = 16 * i + lr;
            f32x4 c0 = (f32x4){0.f, 0.f, 0.f, 0.f}, c1 = c0;
            if (row < NC) { const float* crow_ = (row < BP ? cp + (size_t)row * D : cs + (size_t)(row - BP) * D) + k0; c0 = *(const f32x4*)crow_; c1 = *(const f32x4*)(crow_ + 4); }
            c0.x = siluf(c0.x); c0.y = siluf(c0.y); c0.z = siluf(c0.z); c0.w = siluf(c0.w); c1.x = siluf(c1.x); c1.y = siluf(c1.y); c1.z = siluf(c1.z); c1.w = siluf(c1.w);
            const bf16x8 afr = __builtin_bit_cast(bf16x8, pack8(c0, c1));
#pragma unroll
            for (int t = 0; t < NT; ++t) acc[t][i] = __builtin_amdgcn_mfma_f32_16x16x32_bf16(afr, bfr[t], acc[t][i], 0, 0, 0); }
    }
    LAS pg8::f32x4* red = (LAS pg8::f32x4*)lds;
#pragma unroll
    for (int t = 0; t < NT; ++t) {
        const int col = (t == 0 ? ct : ct2) * 16 + lr;
#pragma unroll
        for (int i = 0; i < 9; ++i) red[(wave * 9 + i) * 64 + lane] = acc[t][i];
        __syncthreads();
        for (int i = wave; i < 9; i += 8) {
            pg8::f32x4 tt = red[i * 64 + lane];
#pragma unroll
            for (int w2 = 1; w2 < 8; ++w2) tt += red[(w2 * 9 + i) * 64 + lane];
            const float bb = b_ada[col];
#pragma unroll
            for (int r = 0; r < 4; ++r) { const int row = 16 * i + 4 * q + r; if (row < NC) MOD[(size_t)row * NMOD + col] = tt[r] + bb; }
        }
        __syncthreads();
    }
}
__device__ __forceinline__ void transpose_item(const float* W, int ldw, int src_col0, bf16* WT, int Kdst, int dst_row0, int k0, LAS float* scr, int lane) {
#pragma unroll
    for (int h2 = 0; h2 < 2; ++h2) { float v[16];
#pragma unroll
        for (int i = 0; i < 16; ++i) v[i] = W[(size_t)(k0 + 2 * (16 * h2 + i) + (lane >> 5)) * ldw + src_col0 + (lane & 31)];
#pragma unroll
        for (int i = 0; i < 16; ++i) scr[(2 * (16 * h2 + i) + (lane >> 5)) * 33 + (lane & 31)] = v[i]; }
    asm volatile("s_waitcnt lgkmcnt(0)" ::: "memory");
    const int c = lane & 7;
#pragma unroll
    for (int j = 0; j < 4; ++j) { const int n = (lane >> 3) + 8 * j; const LAS float* s = scr + (8 * c) * 33 + n;
        u32x4 o; o.x = cvtpk(s[0 * 33], s[1 * 33]); o.y = cvtpk(s[2 * 33], s[3 * 33]); o.z = cvtpk(s[4 * 33], s[5 * 33]); o.w = cvtpk(s[6 * 33], s[7 * 33]);
        *(u32x4*)(WT + (size_t)(dst_row0 + n) * Kdst + k0 + 8 * c) = o; }
    asm volatile("s_waitcnt lgkmcnt(0)" ::: "memory");
}
__device__ __forceinline__ void phase_prologue(const Args& A, LAS unsigned char* lds, gu32* qhead, int bx, int G, int wave, int lane, int gtid, int NGT) {
    unsigned char* ws = A.ws;
    const float* w_in = (const float*)A.in[I_WIN]; const float* w_out = (const float*)A.in[I_WOUT]; const float* w_up = (const float*)A.in[I_WUP]; const float* w_dn = (const float*)A.in[I_WDN];
    float* WX = (float*)(ws + WS_WINX);
    for (int i = gtid; i < 8 * D; i += NGT) { const int j = i >> 10, k = i & 1023; WX[i] = w_in[(size_t)k * IN_COLS + 3072 + j]; }
    { const int vcu = (G % 8 == 0) ? (bx % 8) * (G / 8) + bx / 8 : bx;
      int ct = vcu;
      for (; ct + G < NMOD / 16; ct += 2 * G) mod_tile<2>(A, lds, ct, ct + G, wave, lane);
      if (ct < NMOD / 16) mod_tile<1>(A, lds, ct, ct, wave, lane); }
    LAS float* scr = (LAS float*)(lds + wave * 16384);
    constexpr int I_IN = 16 * (NPROJ / 32), I_OUT = 16 * 32, I_UP = 16 * (DFF2 / 32), I_DN = (DFF / 64) * 32, NIT = I_IN + I_OUT + I_UP + I_DN;
    const int vcu2 = (G % 8 == 0) ? (bx % 8) * (G / 8) + bx / 8 : bx; const int nfirst = 2 * G * 8 < NIT ? 2 * G * 8 : NIT;
    const bool special = (G < NMOD / 16) && (2 * G > NMOD / 16), light = vcu2 >= NMOD / 16 - G; const int nlw = (2 * G - NMOD / 16) * 8;
    const int lw = (vcu2 - (NMOD / 16 - G)) * 8 + wave;
    for (int k_ = 0;; ++k_) {
        int it_;
        if (k_ < 2) { it_ = (bx * 8 + wave) + k_ * G * 8; if (it_ >= nfirst) continue; }
        else if (!special) { it_ = nfirst + (bx * 8 + wave) + (k_ - 2) * G * 8; if (it_ >= NIT) break; }
        else { if (!light) break; it_ = nfirst + lw + (k_ - 2) * nlw; if (it_ >= NIT) break; }
        int r = it_;
        if (r < I_IN) { const int nb = r % (NPROJ / 32), kb = r / (NPROJ / 32); const int n0 = nb * 32; transpose_item(w_in, IN_COLS, n0 < 3072 ? n0 : n0 + 8, (bf16*)(ws + WS_WIN_T), D, n0, kb * 64, scr, lane); continue; } r -= I_IN;
        if (r < I_OUT) { const int nb = r % 32, kb = r / 32; transpose_item(w_out, D, nb * 32, (bf16*)(ws + WS_WOUT_T), D, nb * 32, kb * 64, scr, lane); continue; } r -= I_OUT;
        if (r < I_UP) { const int nb = r % (DFF2 / 32), kb = r / (DFF2 / 32), n0 = nb * 32;
            const int dr = n0 < DFF ? (n0 >> 7) * 256 + (n0 & 127) : ((n0 - DFF) >> 7) * 256 + 128 + ((n0 - DFF) & 127);
            transpose_item(w_up, DFF2, n0, (bf16*)(ws + WS_WUP_T), D, dr, kb * 64, scr, lane); continue; } r -= I_UP;
        { const int nb = r % 32, kb = r / 32; transpose_item(w_dn, D, nb * 32, (bf16*)(ws + WS_WDN_T), DFF, nb * 32, kb * 64, scr, lane); }
    }
}

template <bool EXTRAS, int NS = 0, bool X0H = false>
__device__ __forceinline__ void phase_norm(const float* x0, const float* x1, const float* g, const float* MOD, int sh_off, int sc_off, bf16* H, const float* WX, float* EXTRA, int gw, int NGW, int lane, const float* slab = nullptr, int gate_off = 0, float* x1w = nullptr) {
    f32x4 wxr[4][8];
    if (EXTRAS) {
#pragma unroll
        for (int j = 0; j < 4; ++j)
#pragma unroll
            for (int e = 0; e < 8; ++e) wxr[j][e] = *(const f32x4*)(WX + e * D + 4 * (lane + 64 * j));
    }
    f32x4 nv[4]; u32x2 nh[4];
#define NORM_LOADX(mm_) do { if (X0H && (mm_) < MP) { const bf16* xh_ = (const bf16*)x0 + (size_t)(mm_) * D; _Pragma("unroll") for (int j = 0; j < 4; ++j) nh[j] = *(const u32x2*)(xh_ + 4 * (lane + 64 * j)); } \
        else { const float* xr_ = (mm_) < MP ? x0 + (size_t)(mm_) * D : x1 + (size_t)((mm_) - MP) * D; _Pragma("unroll") for (int j = 0; j < 4; ++j) nv[j] = *(const f32x4*)(xr_ + 4 * (lane + 64 * j)); } } while (0)
    if (gw < M) NORM_LOADX(gw);
    f32x4 ggv[4];
#pragma unroll
    for (int j = 0; j < 4; ++j) ggv[j] = *(const f32x4*)(g + 4 * (lane + 64 * j));
    for (int m = gw; m < M; m += NGW) {
        const float* mod = MOD + (size_t)mod_row(m) * NMOD;
        f32x4 scv[4], shv[4];
#pragma unroll
        for (int j = 0; j < 4; ++j) { scv[j] = *(const f32x4*)(mod + sc_off + 4 * (lane + 64 * j)); shv[j] = *(const f32x4*)(mod + sh_off + 4 * (lane + 64 * j)); }
        asm volatile("" ::: "memory");
        f32x4 v[4]; float ss = 0.f;
        if (X0H && m < MP) {
#pragma unroll
            for (int j = 0; j < 4; ++j) v[j] = (f32x4){__uint_as_float(nh[j].x << 16), __uint_as_float(nh[j].x & 0xffff0000u), __uint_as_float(nh[j].y << 16), __uint_as_float(nh[j].y & 0xffff0000u)};
        } else {
#pragma unroll
            for (int j = 0; j < 4; ++j) v[j] = nv[j];
        }
        { const int mn = m + NGW; if (mn < M) NORM_LOADX(mn); }
#pragma unroll
        for (int j = 0; j < 4; ++j) {
            if (NS > 0 && m >= MP) { f32x4 a = (f32x4){0.f, 0.f, 0.f, 0.f};
#pragma unroll
                for (int k = 0; k < NS; ++k) { const u32x2 sw = *(const u32x2*)((const bf16*)slab + ((size_t)k * MS + (m - MP)) * D + 4 * (lane + 64 * j)); a += (f32x4){__uint_as_float(sw.x << 16), __uint_as_float(sw.x & 0xffff0000u), __uint_as_float(sw.y << 16), __uint_as_float(sw.y & 0xffff0000u)}; }
                v[j] += *(const f32x4*)(mod + gate_off + 4 * (lane + 64 * j)) * a;
                *(f32x4*)(x1w + (size_t)m * D + 4 * (lane + 64 * j)) = v[j]; }
            ss += (v[j].x * v[j].x + v[j].y * v[j].y) + (v[j].z * v[j].z + v[j].w * v[j].w); }
        ss = wave_sum(ss);
        const float rstd = 1.0f / sqrtf(ss * (1.f / D) + EPS);
        float ex[8];
#pragma unroll
        for (int e = 0; e < 8; ++e) ex[e] = 0.f;
#pragma unroll
        for (int j = 0; j < 4; ++j) { const int c = 4 * (lane + 64 * j);
            const f32x4 gg = ggv[j], sc = scv[j], sh = shv[j];
            const f32x4 h = (v[j] * rstd) * gg * (sc + 1.0f) + sh;
            u32x2 w; w.x = cvtpk(h.x, h.y); w.y = cvtpk(h.z, h.w); *(u32x2*)(H + (size_t)m * D + c) = w;
            if (EXTRAS) {
#pragma unroll
                for (int e = 0; e < 8; ++e) { const f32x4 wx = wxr[j][e]; ex[e] += (h.x * wx.x + h.y * wx.y) + (h.z * wx.z + h.w * wx.w); }
            }
        }
        if (EXTRAS) {
            float a4[4], a2[2], a1;
#pragma unroll
            for (int j = 0; j < 4; ++j) { const bool up = lane & 1; const float send = up ? ex[j] : ex[j + 4], keep = up ? ex[j + 4] : ex[j]; a4[j] = keep + __shfl_xor(send, 1); }
#pragma unroll
            for (int j = 0; j < 2; ++j) { const bool up = lane & 2; const float send = up ? a4[j] : a4[j + 2], keep = up ? a4[j + 2] : a4[j]; a2[j] = keep + __shfl_xor(send, 2); }
            { const bool up = lane & 4; const float send = up ? a2[0] : a2[1], keep = up ? a2[1] : a2[0]; a1 = keep + __shfl_xor(send, 4); }
            a1 += __shfl_xor(a1, 8); a1 += __shfl_xor(a1, 16); a1 += __shfl_xor(a1, 32);
            if (lane < 8) EXTRA[(size_t)m * 8 + (4 * (lane & 1) + 2 * ((lane >> 1) & 1) + ((lane >> 2) & 1))] = a1;
        }
    }
}

template <int R> __device__ __forceinline__ void post_strip(const Args& A, int m0, int part, int lane) {
    unsigned char* ws = A.ws; const bf16* DNRAW = (const bf16*)(ws + WS_DNRAW);
    const float* wc = (const float*)A.in[I_WDNC]; const float* sdc = (const float*)A.in[I_SDC];
    bf16* dstb = (part == 0 ? (bf16*)(ws + WS_QD) : part == 1 ? (bf16*)(ws + WS_KD) : (bf16*)(ws + WS_VD));
    const bool prompt = m0 < MP; const int b = prompt ? (m0 >> 12) : ((m0 - MP) >> 3), t0 = prompt ? (m0 & 4095) : ((m0 - MP) & 7);
    const int ch = part * 512 + 8 * lane;
    f32x4 w[4][2];
#pragma unroll
    for (int i = 0; i < 4; ++i) { w[i][0] = *(const f32x4*)(wc + i * 1536 + ch); w[i][1] = *(const f32x4*)(wc + i * 1536 + ch + 4); }
    f32x4 x[3][2];
#pragma unroll
    for (int j = 0; j < 3; ++j) { const int tt = t0 - 3 + j;
        if (tt >= 0) { const u32x4 r = *(const u32x4*)(DNRAW + (size_t)(m0 - 3 + j) * 1536 + ch); x[j][0] = bf4lo(r); x[j][1] = bf4hi(r); }
        else if (!prompt) { const float* p = sdc + ((size_t)b * 3 + (3 + tt)) * 1536 + ch; x[j][0] = *(const f32x4*)p; x[j][1] = *(const f32x4*)(p + 4); }
        else { x[j][0] = (f32x4){0.f, 0.f, 0.f, 0.f}; x[j][1] = x[j][0]; } }
    const bf16* src = DNRAW + (size_t)m0 * 1536 + ch;
    u32x4 rows[R];
#pragma unroll
    for (int r = 0; r < R; ++r) rows[r] = *(const u32x4*)(src + (size_t)r * 1536);
#pragma unroll
    for (int r = 0; r < R; ++r) {
        const u32x4 cw = rows[r];
        const f32x4 c0 = bf4lo(cw), c1 = bf4hi(cw);
        f32x4 y0 = w[0][0] * x[0][0] + w[1][0] * x[1][0] + w[2][0] * x[2][0] + w[3][0] * c0;
        f32x4 y1 = w[0][1] * x[0][1] + w[1][1] * x[1][1] + w[2][1] * x[2][1] + w[3][1] * c1;
        x[0][0] = x[1][0]; x[0][1] = x[1][1]; x[1][0] = x[2][0]; x[1][1] = x[2][1]; x[2][0] = c0; x[2][1] = c1;
        y0.x = siluf(y0.x); y0.y = siluf(y0.y); y0.z = siluf(y0.z); y0.w = siluf(y0.w); y1.x = siluf(y1.x); y1.y = siluf(y1.y); y1.z = siluf(y1.z); y1.w = siluf(y1.w);
        if (part < 2) {
            float ss = (y0.x * y0.x + y0.y * y0.y) + (y0.z * y0.z + y0.w * y0.w) + (y1.x * y1.x + y1.y * y1.y) + (y1.z * y1.z + y1.w * y1.w);
            ss += __shfl_xor(ss, 1); ss += __shfl_xor(ss, 2); ss += __shfl_xor(ss, 4); ss += __shfl_xor(ss, 8);
            const float rs = (part == 0 ? 0.08838834764831845f : 1.0f) / sqrtf(ss + EPS);
            y0 = y0 * rs; y1 = y1 * rs;
        }
        *(u32x4*)(dstb + (size_t)(m0 + r) * DNW + 8 * lane) = pack8(y0, y1);
    }
}
__device__ __forceinline__ void phase_post(const Args& A, int gw, int NGW, int lane, int gtid, int NGT) {
    constexpr int NPI = (MP / 16) * 3, NSI = BS * 3;
    for (int it = gw; it < NPI + NSI; it += NGW) {
        if (it < NPI) post_strip<16>(A, (it / 3) * 16, it % 3, lane);
        else { const int j = it - NPI; post_strip<8>(A, MP + (j / 3) * 8, j % 3, lane); }
    }
    unsigned char* ws = A.ws; const float* a_log = (const float*)A.in[I_ALOG]; const float* dtb = (const float*)A.in[I_DTB];
    float* BETA = (float*)(ws + WS_BETA); float* LOGA = (float*)(ws + WS_LOGA); const float* EXTRA = (const float*)(ws + WS_EXTRA);
    for (int i = gtid; i < M * 8; i += NGT) { const int m = i >> 3, j = i & 7; const float x = EXTRA[i];
        if (j < 4) BETA[m * 4 + j] = 1.f / (1.f + __expf(-x));
        else { const int h = j - 4; const float z = x + dtb[h]; const float sp = fmaxf(z, 0.f) + log1pf(__expf(-fabsf(z))); LOGA[m * 4 + h] = -__expf(a_log[h]) * sp; } }
}

template <int B0, int B1> __device__ __forceinline__ void subst_rows(float (&x)[64], const LAS float* Am) {
#pragma unroll
    for (int ib = B0; ib < B1; ++ib) {
        float r[4];
#pragma unroll
        for (int rr = 0; rr < 4; ++rr) r[rr] = x[4 * ib + rr];
#pragma unroll
        for (int j4 = 0; j4 < ib; ++j4) {
#pragma unroll
            for (int rr = 0; rr < 4; ++rr) { const f32x4 a = *(const LAS f32x4*)(Am + (4 * ib + rr) * 64 + 4 * j4);
                r[rr] -= (a.x * x[4 * j4] + a.y * x[4 * j4 + 1]) + (a.z * x[4 * j4 + 2] + a.w * x[4 * j4 + 3]); }
        }
        const f32x4 d1 = *(const LAS f32x4*)(Am + (4 * ib + 1) * 64 + 4 * ib), d2 = *(const LAS f32x4*)(Am + (4 * ib + 2) * 64 + 4 * ib), d3 = *(const LAS f32x4*)(Am + (4 * ib + 3) * 64 + 4 * ib);
        r[1] -= d1.x * r[0];
        r[2] -= d2.x * r[0] + d2.y * r[1];
        r[3] -= (d3.x * r[0] + d3.y * r[1]) + d3.z * r[2];
#pragma unroll
        for (int rr = 0; rr < 4; ++rr) x[4 * ib + rr] = r[rr];
    }
}
constexpr int PS_INT = 34816, PS_STG = 53248;
template <int LEVEL = 0>
__device__ __forceinline__ void dn_prescan_unit(const Args& A, LAS unsigned char* lds, int unit, int tid, int wave, int lane) {
    unsigned char* ws = A.ws;
    const bf16* QD = (const bf16*)(ws + WS_QD); const bf16* KD = (const bf16*)(ws + WS_KD); const bf16* VD = (const bf16*)(ws + WS_VD);
    const float* BETA = (const float*)(ws + WS_BETA); const float* LOGA = (const float*)(ws + WS_LOGA);
    const int hp = unit & 1, n = (unit >> 1) & 63, b = unit >> 7;
    const int half = tid >> 8, ht = tid & 255, h = 2 * hp + half, item = (b * 64 + n) * 4 + h;
    const int m0 = b * TP + n * 64;
    LAS float* Am = (LAS float*)lds + half * 4096;
    LAS float* gs = (LAS float*)(lds + 32768) + half * 128;
    if (ht < 64) {
        float v = LOGA[(size_t)(m0 + ht) * 4 + h];
#pragma unroll
        for (int o = 1; o < 64; o <<= 1) { const float u = __shfl_up(v, o); if (ht >= o) v += u; }
        gs[ht] = v; gs[64 + ht] = BETA[(size_t)(m0 + ht) * 4 + h];
    }
    __syncthreads();
    {
        const int wl = wave & 3, lr = lane & 15, q = lane >> 4;
        pg8::f32x4 kk[4], qk[4];
#pragma unroll
        for (int j = 0; j < 4; ++j) { kk[j] = (pg8::f32x4){0.f, 0.f, 0.f, 0.f}; qk[j] = kk[j]; }
#pragma unroll
        for (int s = 0; s < 4; ++s) {
            const bf16x8 ak = *(const bf16x8*)(KD + (size_t)(m0 + 16 * wl + lr) * DNW + h * 128 + 32 * s + 8 * q), aq = *(const bf16x8*)(QD + (size_t)(m0 + 16 * wl + lr) * DNW + h * 128 + 32 * s + 8 * q);
#pragma unroll
            for (int j = 0; j < 4; ++j) { const bf16x8 bk = *(const bf16x8*)(KD + (size_t)(m0 + 16 * j + lr) * DNW + h * 128 + 32 * s + 8 * q);
                kk[j] = __builtin_amdgcn_mfma_f32_16x16x32_bf16(ak, bk, kk[j], 0, 0, 0); qk[j] = __builtin_amdgcn_mfma_f32_16x16x32_bf16(aq, bk, qk[j], 0, 0, 0); }
        }
#pragma unroll
        for (int j = 0; j < 4; ++j)
#pragma unroll
            for (int r = 0; r < 4; ++r) { const int i = 16 * wl + 4 * q + r, jj = 16 * j + lr;
                const float dec = (i >= jj) ? __expf(gs[i] - gs[jj]) : 0.f;
                Am[i * 64 + jj] = (i > jj) ? gs[64 + i] * kk[j][r] * dec : 0.f;
                *(LAS bf16*)(lds + PS_INT + half * 9216 + i * 144 + jj * 2) = f2bf(qk[j][r] * dec); }
    }
    __syncthreads();
    if constexpr (LEVEL == 1) { __syncthreads(); return; }
    {
        const int c = ht;
        float* U = (float*)(ws + WS_U) + (size_t)item * 8192; bf16* KC = (bf16*)(ws + WS_KCUM) + (size_t)item * 8192;
        float x[64];
        { const bf16* rsrc = (ht < 128 ? VD : KD) + (size_t)m0 * DNW + h * 128 + (ht & 127);
#pragma unroll
          for (int i = 0; i < 64; ++i) x[i] = bf2f(rsrc[(size_t)i * DNW]); }
#pragma unroll
        for (int i = 0; i < 64; ++i) { const float eg = __expf(gs[i]); x[i] *= gs[64 + i] * (c >= 128 ? eg : 1.0f); }
        { bf16* INTRA = (bf16*)(ws + WS_INTRA) + (size_t)item * 4096;
#pragma unroll
          for (int j = 0; j < 2; ++j) { const int k = ht + 256 * j, row = k >> 3, c8 = (k & 7) * 8; *(u32x4*)(INTRA + row * 64 + c8) = *(const LAS u32x4*)(lds + PS_INT + half * 9216 + row * 144 + c8 * 2); } }
        subst_rows<0, 6>(x, Am); subst_rows<6, 10>(x, Am); subst_rows<10, 13>(x, Am); subst_rows<13, 16>(x, Am);
        if constexpr (LEVEL == 2) { float sk = 0.f; _Pragma("unroll") for (int i = 0; i < 64; ++i) sk += x[i]; asm volatile("" :: "v"(sk)); __syncthreads(); return; }
        LAS float* stg = (LAS float*)(lds + PS_STG + half * 33280);
#pragma unroll
        for (int ps = 0; ps < 2; ++ps) {
            if (ps) __syncthreads();
#pragma unroll
            for (int i = 0; i < 32; ++i) stg[i * 260 + c] = x[32 * ps + i];
            __syncthreads();
#pragma unroll
            for (int j = 0; j < 4; ++j) { const int k = ht + 256 * j, il = k >> 9, w_ = (k >> 6) & 7, ln = k & 63, rb = 16 * il + 4 * (ln >> 4), cc = 16 * w_ + (ln & 15);
                *(f32x4*)(U + (((2 * ps + il) * 8 + w_) * 64 + ln) * 4) = (f32x4){stg[rb * 260 + cc], stg[(rb + 1) * 260 + cc], stg[(rb + 2) * 260 + cc], stg[(rb + 3) * 260 + cc]}; }
#pragma unroll
            for (int j = 0; j < 2; ++j) { const int k = ht + 256 * j, row = k >> 4, c8 = (k & 15) * 8; const LAS float* sp = stg + row * 260 + 128 + c8;
                *(u32x4*)(KC + (32 * ps + row) * 128 + c8) = pack8(*(const LAS f32x4*)sp, *(const LAS f32x4*)(sp + 4)); }
        }
    }
    if constexpr (LEVEL == 3) { __syncthreads(); return; }
    {
        const float glast = gs[63];
        bf16* QDc = (bf16*)(ws + WS_QDEC) + (size_t)item * 8192; bf16* KT = (bf16*)(ws + WS_KDECT) + (size_t)item * 8192;
#pragma unroll
        for (int j = 0; j < 4; ++j) { const int k = ht + 256 * j, row = k >> 4, c8 = (k & 15) * 8; const u32x4 qw = *(const u32x4*)(QD + (size_t)(m0 + row) * DNW + h * 128 + c8); const float eg = __expf(gs[row]);
            *(u32x4*)(QDc + row * 128 + c8) = pack8(bf4lo(qw) * eg, bf4hi(qw) * eg); }
        { const int d = ht & 127, ig = ht >> 7;
#pragma unroll
            for (int i8 = 0; i8 < 4; ++i8) { float v[8];
#pragma unroll
                for (int k = 0; k < 8; ++k) { const int i = 32 * ig + 8 * i8 + k; v[k] = bf2f(KD[(size_t)(m0 + i) * DNW + h * 128 + d]) * __expf(glast - gs[i]); }
                u32x4 w; w.x = cvtpk(v[0], v[1]); w.y = cvtpk(v[2], v[3]); w.z = cvtpk(v[4], v[5]); w.w = cvtpk(v[6], v[7]);
                *(u32x4*)(KT + d * 64 + 32 * ig + 8 * i8) = w; } }
        if (ht == 0) ((float*)(ws + WS_GL))[item] = __expf(glast);
    }
    __syncthreads();
}
template <int NU>
__device__ __forceinline__ void dn_sample_units(const Args& A, LAS unsigned char* lds, int unit0, int ustride, int tid) {
    unsigned char* ws = A.ws;
    const bf16* QD = (const bf16*)(ws + WS_QD);
    const float* BETA = (const float*)(ws + WS_BETA); const float* LOGA = (const float*)(ws + WS_LOGA); float* ODN = (float*)(ws + WS_ODN);
    const int e = tid & 127, dq = tid >> 7; const unsigned loff = (unsigned)(32 * dq * 128 + e);
    float S[NU][32];
#pragma unroll
    for (int u = 0; u < NU; ++u) { const int unit = unit0 + u * ustride, h = unit & 3, b = unit >> 2;
        const float* s0 = (const float*)A.in[I_SD] + (size_t)(b * 4 + h) * 16384;
#pragma unroll
        for (int d = 0; d < 32; ++d) S[u][d] = s0[loff + (unsigned)(d * 128)]; }
    constexpr int UF = 4112;
#pragma unroll
    for (int u = 0; u < NU; ++u) { const int unit = unit0 + u * ustride, h = unit & 3, b = unit >> 2; LAS float* tk = (LAS float*)lds + u * UF + 1024;
#pragma unroll
        for (int j = 0; j < 6; ++j) { const int i = tid + 512 * j, t = i / 384, c = i % 384, part = c >> 7; const int m = MP + b * TS + t;
            const unsigned sel = part == 0 ? 1u : part == 1 ? 0u : 2u;
            tk[i] = bf2f(QD[sel * (unsigned)((WS_KD - WS_QD) / 2) + (unsigned)m * DNW + h * 128 + (c & 127)]); }
        if (tid < 16) { const size_t m = (size_t)(MP + b * TS + (tid >> 1)); tk[3072 + tid] = (tid & 1) ? BETA[m * 4 + h] : __expf(LOGA[m * 4 + h]); } }
    __syncthreads();
    for (int t = 0; t < TS; ++t) {
#pragma unroll
        for (int u = 0; u < NU; ++u) { LAS float* red = (LAS float*)lds + u * UF; const LAS float* kp = red + 1024 + t * 384 + 32 * dq;
            float p0 = 0.f, p1 = 0.f;
#pragma unroll
            for (int d4 = 0; d4 < 8; ++d4) { const f32x4 kv = *(const LAS f32x4*)(kp + 4 * d4);
                p0 += kv.x * S[u][4 * d4] + kv.z * S[u][4 * d4 + 2]; p1 += kv.y * S[u][4 * d4 + 1] + kv.w * S[u][4 * d4 + 3]; }
            red[dq * 128 + e] = p0 + p1; }
        __syncthreads();
#pragma unroll
        for (int u = 0; u < NU; ++u) { LAS float* red = (LAS float*)lds + u * UF; LAS float* red2 = red + 512; const LAS float* tk = red + 1024;
            const float a = tk[3072 + 2 * t], bt = tk[3072 + 2 * t + 1];
            const float kS = (red[e] + red[128 + e]) + (red[256 + e] + red[384 + e]);
            const float dl = bt * (tk[t * 384 + 256 + e] - a * kS);
            const LAS float* kp = tk + t * 384 + 32 * dq; const LAS float* qp = kp + 128;
            float po0 = 0.f, po1 = 0.f;
#pragma unroll
            for (int d4 = 0; d4 < 8; ++d4) { const f32x4 kv = *(const LAS f32x4*)(kp + 4 * d4), qv = *(const LAS f32x4*)(qp + 4 * d4);
                S[u][4 * d4] = a * S[u][4 * d4] + kv.x * dl; po0 += qv.x * S[u][4 * d4]; S[u][4 * d4 + 1] = a * S[u][4 * d4 + 1] + kv.y * dl; po1 += qv.y * S[u][4 * d4 + 1];
                S[u][4 * d4 + 2] = a * S[u][4 * d4 + 2] + kv.z * dl; po0 += qv.z * S[u][4 * d4 + 2]; S[u][4 * d4 + 3] = a * S[u][4 * d4 + 3] + kv.w * dl; po1 += qv.w * S[u][4 * d4 + 3]; }
            red2[dq * 128 + e] = po0 + po1; }
        __syncthreads();
        if (dq == 0) {
#pragma unroll
            for (int u = 0; u < NU; ++u) { const int unit = unit0 + u * ustride, h = unit & 3, b = unit >> 2; const LAS float* red2 = (LAS float*)lds + u * UF + 512;
                ODN[(size_t)(MP + b * TS + t) * DNW + h * 128 + e] = (red2[e] + red2[128 + e]) + (red2[256 + e] + red2[384 + e]); } }
    }
#pragma unroll
    for (int u = 0; u < NU; ++u) { const int unit = unit0 + u * ustride, h = unit & 3, b = unit >> 2;
        float* so = A.out + O_SS + (size_t)(b * 4 + h) * 16384;
#pragma unroll
        for (int d = 0; d < 32; ++d) so[loff + (unsigned)(d * 128)] = S[u][d]; }
    __syncthreads();
}

constexpr int SC_KC = 0, SC_QD = 17408, SC_KT = 34816, SC_IN = 53248, SC_BUF = 62464;
__device__ __forceinline__ void dn_scan_chain(const Args& A, LAS unsigned char* lds, int chain, int tid, int wave, int lane) {
    unsigned char* ws = A.ws;
    const float* Ub = (const float*)(ws + WS_U); const float* GL = (const float*)(ws + WS_GL); float* ODN = (float*)(ws + WS_ODN);
    const int b = chain >> 2, h = chain & 3, lr = lane & 15, q = lane >> 4, e = 16 * wave + lr;
    int ldst[7];
    { const int c0 = tid, c1 = tid + 512;
      ldst[0] = SC_KC + (c0 >> 4) * 272; ldst[1] = SC_KC + (c1 >> 4) * 272; ldst[2] = SC_QD + (c0 >> 4) * 272; ldst[3] = SC_QD + (c1 >> 4) * 272;
      ldst[4] = SC_KT + (c0 >> 3) * 144; ldst[5] = SC_KT + (c1 >> 3) * 144; ldst[6] = SC_IN + (c0 >> 3) * 144; }
    const int cb_ = tid & 3, hA_ = (8 * ((2 * cb_) & 3) + 4 * (cb_ >> 1)) * 2, hB_ = (8 * ((2 * cb_ + 1) & 3) + 4 * (cb_ >> 1)) * 2;
    const int o16A = ((tid & 15) >> 2) * 64 + hA_, o16B = ((tid & 15) >> 2) * 64 + hB_, o8A = ((tid & 7) >> 2) * 64 + hA_, o8B = ((tid & 7) >> 2) * 64 + hB_;
    const size_t item0 = (size_t)(b * 64) * 4 + h;
    const unsigned char* gKC = ws + WS_KCUM + item0 * 16384; const unsigned char* gQD = ws + WS_QDEC + item0 * 16384; const unsigned char* gKT = ws + WS_KDECT + item0 * 16384; const unsigned char* gIN = ws + WS_INTRA + item0 * 8192;
    const unsigned t16 = (unsigned)tid * 16u, ulane = (unsigned)(wave * 64 + lane) * 4u;
    u32x4 R[7]; float un[16], uc[16];
#define SC_GLOAD(n_) do { const size_t o16_ = (size_t)(n_) * 4 * 16384, o8_ = (size_t)(n_) * 4 * 8192; \
        R[0] = *(const u32x4*)(gKC + o16_ + t16); R[1] = *(const u32x4*)(gKC + o16_ + 8192 + t16); R[2] = *(const u32x4*)(gQD + o16_ + t16); R[3] = *(const u32x4*)(gQD + o16_ + 8192 + t16); \
        R[4] = *(const u32x4*)(gKT + o16_ + t16); R[5] = *(const u32x4*)(gKT + o16_ + 8192 + t16); R[6] = *(const u32x4*)(gIN + o8_ + t16); \
        const float* U_ = Ub + (item0 + 4 * (size_t)(n_)) * 8192; \
        _Pragma("unroll") for (int i_ = 0; i_ < 4; ++i_) { const f32x4 u_ = *(const f32x4*)(U_ + (ulane + (unsigned)(i_ * 2048))); un[4 * i_] = u_.x; un[4 * i_ + 1] = u_.y; un[4 * i_ + 2] = u_.z; un[4 * i_ + 3] = u_.w; } } while (0)
#define SC_LWRITE(buf_) do { _Pragma("unroll") for (int k_ = 0; k_ < 7; ++k_) { LAS unsigned char* d_ = lds + (buf_) * SC_BUF + ldst[k_]; \
        *(LAS u32x2*)(d_ + (k_ < 4 ? o16A : o8A)) = (u32x2){R[k_].x, R[k_].y}; *(LAS u32x2*)(d_ + (k_ < 4 ? o16B : o8B)) = (u32x2){R[k_].z, R[k_].w}; } } while (0)
#define SC_BARRIER() do { asm volatile("s_waitcnt lgkmcnt(0)" ::: "memory"); __builtin_amdgcn_s_barrier(); asm volatile("" ::: "memory"); } while (0)
#define SC_FRAG(off_, pitch_, row_, s_) (*(const LAS bf16x8*)(B + (off_) + (row_) * (pitch_) + (32 * (s_) + 8 * q) * 2))
    pg8::f32x4 S[8];
#pragma unroll
    for (int i = 0; i < 8; ++i) S[i] = (pg8::f32x4){0.f, 0.f, 0.f, 0.f};
    const float glv = GL[item0 + 4 * (size_t)lane];
    __syncthreads();
    SC_GLOAD(0); SC_LWRITE(0);
#pragma unroll
    for (int k = 0; k < 16; ++k) uc[k] = un[k];
    __syncthreads();
    for (int n = 0; n < 64; ++n) {
        const float gl = __uint_as_float(__builtin_amdgcn_readlane(__float_as_uint(glv), n));
        if (n + 1 < 64) SC_GLOAD(n + 1);
        const LAS unsigned char* B = lds + (n & 1) * SC_BUF;
        bf16x8 Sb[4];
#pragma unroll
        for (int s = 0; s < 4; ++s) { u32x4 w; w.x = cvtpk(S[2 * s][0], S[2 * s][1]); w.y = cvtpk(S[2 * s][2], S[2 * s][3]); w.z = cvtpk(S[2 * s + 1][0], S[2 * s + 1][1]); w.w = cvtpk(S[2 * s + 1][2], S[2 * s + 1][3]); Sb[s] = __builtin_bit_cast(bf16x8, w); }
        pg8::f32x4 vn[4], o[4];
#pragma unroll
        for (int ih = 0; ih < 2; ++ih) {
            bf16x8 fk[2][4], fq[2][4];
#pragma unroll
            for (int ii = 0; ii < 2; ++ii)
#pragma unroll
                for (int s = 0; s < 4; ++s) { fk[ii][s] = SC_FRAG(SC_KC, 272, 16 * (2 * ih + ii) + lr, s); fq[ii][s] = SC_FRAG(SC_QD, 272, 16 * (2 * ih + ii) + lr, s); }
#pragma unroll
            for (int ii = 0; ii < 2; ++ii) { const int i = 2 * ih + ii;
                pg8::f32x4 ak = (pg8::f32x4){0.f, 0.f, 0.f, 0.f}, aq = ak;
#pragma unroll
                for (int s = 0; s < 4; ++s) { ak = __builtin_amdgcn_mfma_f32_16x16x32_bf16(fk[ii][s], Sb[s], ak, 0, 0, 0); aq = __builtin_amdgcn_mfma_f32_16x16x32_bf16(fq[ii][s], Sb[s], aq, 0, 0, 0); }
#pragma unroll
                for (int r = 0; r < 4; ++r) vn[i][r] = uc[4 * i + r] - ak[r];
                o[i] = aq; }
        }
        bf16x8 Vb[2];
#pragma unroll
        for (int s = 0; s < 2; ++s) { u32x4 w; w.x = cvtpk(vn[2 * s][0], vn[2 * s][1]); w.y = cvtpk(vn[2 * s][2], vn[2 * s][3]); w.z = cvtpk(vn[2 * s + 1][0], vn[2 * s + 1][1]); w.w = cvtpk(vn[2 * s + 1][2], vn[2 * s + 1][3]); Vb[s] = __builtin_bit_cast(bf16x8, w); }
        {
            bf16x8 fi[4][2], ft[8][2];
#pragma unroll
            for (int i = 0; i < 4; ++i)
#pragma unroll
                for (int s = 0; s < 2; ++s) fi[i][s] = SC_FRAG(SC_IN, 144, 16 * i + lr, s);
#pragma unroll
            for (int i = 0; i < 8; ++i)
#pragma unroll
                for (int s = 0; s < 2; ++s) ft[i][s] = SC_FRAG(SC_KT, 144, 16 * i + lr, s);
#pragma unroll
            for (int i = 0; i < 4; ++i) {
#pragma unroll
                for (int s = 0; s < 2; ++s) o[i] = __builtin_amdgcn_mfma_f32_16x16x32_bf16(fi[i][s], Vb[s], o[i], 0, 0, 0);
                *(u32x2*)((bf16*)ODN + ((item0 + 4 * (size_t)n) * 8192) + (ulane + (unsigned)(i * 2048))) = (u32x2){cvtpk(o[i][0], o[i][1]), cvtpk(o[i][2], o[i][3])};
            }
#pragma unroll
            for (int i = 0; i < 8; ++i) {
                pg8::f32x4 acc = S[i] * gl;
#pragma unroll
                for (int s = 0; s < 2; ++s) acc = __builtin_amdgcn_mfma_f32_16x16x32_bf16(ft[i][s], Vb[s], acc, 0, 0, 0);
                S[i] = acc;
            }
        }
        if (n + 1 < 64) {
            SC_LWRITE((n + 1) & 1);
#pragma unroll
            for (int k = 0; k < 16; ++k) uc[k] = un[k];
        }
        SC_BARRIER();
    }
#undef SC_GLOAD
#undef SC_LWRITE
#undef SC_FRAG
    float* so = A.out + O_SP + (size_t)(b * 4 + h) * 16384;
#pragma unroll
    for (int i = 0; i < 8; ++i)
#pragma unroll
        for (int r = 0; r < 4; ++r) so[(unsigned)((16 * i + 4 * q + r) * 128 + e)] = S[i][r];
}

__device__ __forceinline__ int crow(int r, int hi) { return (r & 3) + 8 * (r >> 2) + 4 * hi; }
__device__ __forceinline__ void sb_core(f32x16& p, float& carry, int hi) {
    float s[16];
#pragma unroll
    for (int r = 0; r < 16; ++r) { const float e = __builtin_amdgcn_exp2f(p[r]); s[r] = -__builtin_amdgcn_logf(1.0f + e); }
    float tt[4], uu[4];
#pragma unroll
    for (int i = 0; i < 4; ++i) { s[4 * i + 2] += s[4 * i + 3]; s[4 * i + 1] += s[4 * i + 2]; s[4 * i] += s[4 * i + 1]; tt[i] = s[4 * i]; }
#pragma unroll
    for (int i = 0; i < 4; ++i) uu[i] = __shfl_xor(tt[i], 32);
    const float w3 = tt[3] + uu[3], w2 = tt[2] + uu[2], w1 = tt[1] + uu[1], w0 = tt[0] + uu[0];
    float off[4];
    off[3] = carry; off[2] = carry + w3; off[1] = off[2] + w2; off[0] = off[1] + w1;
    carry = off[0] + w0;
    if (hi == 0) {
#pragma unroll
        for (int i = 0; i < 4; ++i) off[i] += uu[i];
    }
#pragma unroll
    for (int r = 0; r < 16; ++r) p[r] = __builtin_amdgcn_exp2f(p[r] + s[r] + off[r >> 2]);
}
__device__ __forceinline__ bf16x8 pack_p(const f32x16& p, int s) {
    u32x4 w; w.x = cvtpk(p[8 * s], p[8 * s + 1]); w.y = cvtpk(p[8 * s + 2], p[8 * s + 3]); w.z = cvtpk(p[8 * s + 4], p[8 * s + 5]); w.w = cvtpk(p[8 * s + 6], p[8 * s + 7]); return __builtin_bit_cast(bf16x8, w);
}
constexpr int AW_BYTES = 16384, AW_V = 0, VPI = 192, AW_K = 6144, KPI = 144, AW_Q = 6144, AW_SQ = 10752;
__device__ __forceinline__ void read_vfrags(bf16x8 (&vf)[4], const LAS unsigned char* wl, int lane) {
    const int hi = lane >> 5;
    const LAS unsigned char* vb = wl + AW_V + (4 * hi + ((lane & 15) >> 2)) * VPI + (((lane >> 4) & 1) * 16 + (lane & 3) * 4) * 2;
#pragma unroll
    for (int dt = 0; dt < 2; ++dt) {
        const s16x4 t0 = __builtin_bit_cast(s16x4, __builtin_amdgcn_ds_read_tr16_b64_v4i16((LAS s16x4*)(vb + dt * 64)));
        const s16x4 t1 = __builtin_bit_cast(s16x4, __builtin_amdgcn_ds_read_tr16_b64_v4i16((LAS s16x4*)(vb + dt * 64 + 8 * VPI)));
        const s16x4 t2 = __builtin_bit_cast(s16x4, __builtin_amdgcn_ds_read_tr16_b64_v4i16((LAS s16x4*)(vb + dt * 64 + 16 * VPI)));
        const s16x4 t3 = __builtin_bit_cast(s16x4, __builtin_amdgcn_ds_read_tr16_b64_v4i16((LAS s16x4*)(vb + dt * 64 + 24 * VPI)));
        vf[2 * dt] = (bf16x8){t0[0], t0[1], t0[2], t0[3], t1[0], t1[1], t1[2], t1[3]}; vf[2 * dt + 1] = (bf16x8){t2[0], t2[1], t2[2], t2[3], t3[0], t3[1], t3[2], t3[3]};
    }
}
__device__ __forceinline__ void load_k_prompt(bf16x8 (&k)[4], const bf16* KB, int b, int h, int kv0, int r32, int hi) {
    const bf16* kp = KB + (size_t)(b * TP + kv0 + r32) * SBW + h * HD + 8 * hi;
#pragma unroll
    for (int d0 = 0; d0 < 4; ++d0) k[d0] = *(const bf16x8*)(kp + 16 * d0);
}
__device__ __forceinline__ void load_v_prompt(u32x4 (&v)[4], const bf16* VB, int b, int h, int kv0, int lane) {
    const bf16* vp = VB + (size_t)(b * TP + kv0 + (lane >> 3)) * SBW + h * HD + (lane & 7) * 8;
#pragma unroll
    for (int i = 0; i < 4; ++i) v[i] = *(const u32x4*)(vp + (size_t)(8 * i) * SBW);
}
__device__ __forceinline__ void write_v_lds(LAS unsigned char* wl, const u32x4 (&v)[4], int lane) {
#pragma unroll
    for (int i = 0; i < 4; ++i) *(LAS u32x4*)(wl + AW_V + (8 * i + (lane >> 3)) * VPI + (lane & 7) * 16) = v[i];
}
template <int MASK>
__device__ __forceinline__ void sb_qk(f32x16& p, const bf16x8 (&kf)[4], const bf16x8 (&qf)[4], float bias2, int kv0, int qpos, int hi) {
#pragma unroll
    for (int r = 0; r < 16; ++r) p[r] = bias2;
#pragma unroll
    for (int d0 = 0; d0 < 4; ++d0) p = __builtin_amdgcn_mfma_f32_32x32x16_bf16(kf[d0], qf[d0], p, 0, 0, 0);
    if (MASK) {
#pragma unroll
        for (int r = 0; r < 16; ++r) if (kv0 + crow(r, hi) >= qpos) p[r] = -INFINITY;
    }
}
__device__ __forceinline__ void sb_pvonly(const f32x16& p, const bf16x8 (&vf)[4], f32x16 (&o)[2]) {
    const bf16x8 p0 = pack_p(p, 0), p1 = pack_p(p, 1);
#pragma unroll
    for (int dt = 0; dt < 2; ++dt) { o[dt] = __builtin_amdgcn_mfma_f32_32x32x16_bf16(vf[2 * dt], p0, o[dt], 0, 0, 0); o[dt] = __builtin_amdgcn_mfma_f32_32x32x16_bf16(vf[2 * dt + 1], p1, o[dt], 0, 0, 0); }
}
__device__ __forceinline__ void sb_pv(f32x16& p, const bf16x8 (&vf)[4], f32x16 (&o)[2], float& carry, int hi) {
    sb_core(p, carry, hi);
    const bf16x8 p0 = pack_p(p, 0), p1 = pack_p(p, 1);
#pragma unroll
    for (int dt = 0; dt < 2; ++dt) { o[dt] = __builtin_amdgcn_mfma_f32_32x32x16_bf16(vf[2 * dt], p0, o[dt], 0, 0, 0); o[dt] = __builtin_amdgcn_mfma_f32_32x32x16_bf16(vf[2 * dt + 1], p1, o[dt], 0, 0, 0); }
}
template <int MASK>
__device__ __forceinline__ void sb_tile(const bf16x8 (&kf)[4], const bf16x8 (&vf)[4], const bf16x8 (&qf)[4], float bias2, f32x16 (&o)[2], float& carry, int kv0, int qpos, int hi) {
    f32x16 p; sb_qk<MASK>(p, kf, qf, bias2, kv0, qpos, hi); sb_pv(p, vf, o, carry, hi);
}
__device__ __forceinline__ void sb_store_prompt(const Args& A, const f32x16 (&o)[2], int b, int h, int qpos, int hi) {
    float ss = 0.f;
#pragma unroll
    for (int dt = 0; dt < 2; ++dt)
#pragma unroll
        for (int r = 0; r < 16; ++r) ss += o[dt][r] * o[dt][r];
    ss += __shfl_xor(ss, 32);
    const float rs = 1.0f / sqrtf(ss * (1.f / HD) + EPS);
    const float* gso = (const float*)A.in[I_GSBO];
    bf16* op = (bf16*)(A.ws + WS_MIXED) + (size_t)(b * TP + qpos) * D + h * HD;
#pragma unroll
    for (int dt = 0; dt < 2; ++dt)
#pragma unroll
        for (int g = 0; g < 4; ++g) { const int d = 32 * dt + 8 * g + 4 * hi; const f32x4 gg = *(const f32x4*)(gso + d);
            u32x2 w; w.x = cvtpk(o[dt][4 * g] * rs * gg.x, o[dt][4 * g + 1] * rs * gg.y); w.y = cvtpk(o[dt][4 * g + 2] * rs * gg.z, o[dt][4 * g + 3] * rs * gg.w); *(u32x2*)(op + d) = w; }
}
__device__ __forceinline__ void attn_prompt_item(const Args& A, LAS unsigned char* wl, int b, int h, int q0, int lane) {
    unsigned char* ws = A.ws;
    const bf16* QB = (const bf16*)(ws + WS_QB); const bf16* KB = (const bf16*)(ws + WS_KB); const bf16* VB = (const bf16*)(ws + WS_VB);
    const int r32 = lane & 31, hi = lane >> 5, qa = q0 + r32, qb = q0 + 32 + r32;
    const float bias2 = ((const float*)A.in[I_SBB])[h] * LOG2E;
#pragma unroll
    for (int d0 = 0; d0 < 4; ++d0) { *(LAS bf16x8*)(wl + AW_Q + (d0 * 64 + lane) * 16) = *(const bf16x8*)(QB + (size_t)(b * TP + qa) * SBW + h * HD + 16 * d0 + 8 * hi);
        *(LAS bf16x8*)(wl + AW_Q + 4096 + (d0 * 64 + lane) * 16) = *(const bf16x8*)(QB + (size_t)(b * TP + qb) * SBW + h * HD + 16 * d0 + 8 * hi); }
#define QFA_LOAD bf16x8 qfa[4]; _Pragma("unroll") for (int d0_ = 0; d0_ < 4; ++d0_) qfa[d0_] = *(const LAS bf16x8*)(wl + AW_Q + (d0_ * 64 + lane) * 16);
#define QFB_LOAD bf16x8 qfb[4]; _Pragma("unroll") for (int d0_ = 0; d0_ < 4; ++d0_) qfb[d0_] = *(const LAS bf16x8*)(wl + AW_Q + 4096 + (d0_ * 64 + lane) * 16);
    f32x16 oa[2], ob[2]; oa[0] = (f32x16){}; oa[1] = (f32x16){}; ob[0] = (f32x16){}; ob[1] = (f32x16){};
    float ca = 0.f, cb = 0.f;
    bf16x8 kc[4], vf[4]; u32x4 vr[4];
    const int top = (q0 >> 5) + 1;
    load_k_prompt(kc, KB, b, h, 32 * top, r32, hi); load_v_prompt(vr, VB, b, h, 32 * top, lane);
    { write_v_lds(wl, vr, lane); load_v_prompt(vr, VB, b, h, 32 * (top - 1), lane);
      f32x16 p; { QFB_LOAD sb_qk<1>(p, kc, qfb, bias2, 32 * top, qb, hi); }
      load_k_prompt(kc, KB, b, h, 32 * (top - 1), r32, hi);
      read_vfrags(vf, wl, lane);
      sb_pv(p, vf, ob, cb, hi); }
    { write_v_lds(wl, vr, lane); if (top >= 2) load_v_prompt(vr, VB, b, h, 32 * (top - 2), lane);
      f32x16 p; { QFA_LOAD sb_qk<1>(p, kc, qfa, bias2, 32 * (top - 1), qa, hi); }
      read_vfrags(vf, wl, lane);
      sb_pv(p, vf, oa, ca, hi);
      { QFB_LOAD sb_qk<0>(p, kc, qfb, bias2, 0, 0, hi); }
      if (top >= 2) load_k_prompt(kc, KB, b, h, 32 * (top - 2), r32, hi);
      sb_pv(p, vf, ob, cb, hi); }
    for (int ht = top - 2; ht >= 0; --ht) {
        write_v_lds(wl, vr, lane);
        f32x16 p, p2; { QFA_LOAD sb_qk<0>(p, kc, qfa, bias2, 0, 0, hi); } { QFB_LOAD sb_qk<0>(p2, kc, qfb, bias2, 0, 0, hi); }
        if (ht > 0) load_k_prompt(kc, KB, b, h, 32 * (ht - 1), r32, hi);
        read_vfrags(vf, wl, lane);
        sb_core(p, ca, hi); sb_pvonly(p, vf, oa);
        __builtin_amdgcn_sched_barrier(0);
        if (ht > 0) load_v_prompt(vr, VB, b, h, 32 * (ht - 1), lane);
        sb_core(p2, cb, hi); sb_pvonly(p2, vf, ob);
    }
    sb_store_prompt(A, oa, b, h, qa, hi); sb_store_prompt(A, ob, b, h, qb, hi);
#undef QFA_LOAD
#undef QFB_LOAD
}

__device__ __forceinline__ void load_raw_sample(f32x4 (&r)[8], const float* c, size_t base, int h, int lane) {
    const float* p = c + base + (size_t)(lane >> 4) * 512 + h * HD + (lane & 15) * 4;
#pragma unroll
    for (int i = 0; i < 8; ++i) r[i] = *(const f32x4*)(p + (size_t)(4 * i) * 512);
}
__device__ __forceinline__ void write_raw_sample(LAS unsigned char* wl, int off, int pitch, const f32x4 (&r)[8], int lane) {
#pragma unroll
    for (int i = 0; i < 8; ++i) { const int row = 4 * i + (lane >> 4); u32x2 w; w.x = cvtpk(r[i].x, r[i].y); w.y = cvtpk(r[i].z, r[i].w); *(LAS u32x2*)(wl + off + row * pitch + (lane & 15) * 8) = w; }
}
__device__ __forceinline__ void read_kfrags(bf16x8 (&kf)[4], const LAS unsigned char* wl, int r32, int hi) {
#pragma unroll
    for (int d0 = 0; d0 < 4; ++d0) kf[d0] = *(const LAS bf16x8*)(wl + AW_K + r32 * KPI + (16 * d0 + 8 * hi) * 2);
}
__device__ __forceinline__ void attn_sample_store(const Args& A, int b, int h, int part, int lane, const f32x16 (&o)[2], float carry) {
    float* OP = (float*)(A.ws + WS_OPART) + (size_t)((b * SBH + h) * NPART + part) * 512; float* LP = (float*)(A.ws + WS_LPART) + (size_t)((b * SBH + h) * NPART + part) * 8;
    const int r32 = lane & 31, hi = lane >> 5;
    unsigned lo = (unsigned)(r32 * 64 + 4 * hi), ll = (unsigned)r32; asm volatile("" : "+v"(lo), "+v"(ll));
    if (r32 < 8) {
#pragma unroll
        for (int dt = 0; dt < 2; ++dt)
#pragma unroll
            for (int g = 0; g < 4; ++g) *(f32x4*)(OP + (lo + (unsigned)(32 * dt + 8 * g))) = (f32x4){o[dt][4 * g], o[dt][4 * g + 1], o[dt][4 * g + 2], o[dt][4 * g + 3]};
        if (hi == 0) LP[ll] = carry;
    }
}
__device__ __forceinline__ void attn_sample_job(const Args& A, LAS unsigned char* wl, int b, int h, int sp, int lane) {
    unsigned char* ws = A.ws;
    const int r32 = lane & 31, hi = lane >> 5;
    const float* ck = (const float*)A.in[I_CK]; const float* cv = (const float*)A.in[I_CV]; const int* pt = (const int*)A.in[I_PT] + b * NPAGES;
    const bf16* QB = (const bf16*)(ws + WS_QB);
    const float bias2 = ((const float*)A.in[I_SBB])[h] * LOG2E;
    bf16x8 qf[4];
#pragma unroll
    for (int d0 = 0; d0 < 4; ++d0) { qf[d0] = (bf16x8){0, 0, 0, 0, 0, 0, 0, 0}; if (r32 < TS) qf[d0] = *(const bf16x8*)(QB + (size_t)(MP + b * TS + r32) * SBW + h * HD + 16 * d0 + 8 * hi); }
    f32x16 o[2]; float carry;
    bf16x8 kf[4], vf[4];
    const int tok_hi = (PAST / NSPLIT) * (sp + 1);
    constexpr int NT = PAST / NSPLIT / 32;
    f32x4 rk[8], rv[8];
#define SAMPLE_BASE(j) (((size_t)pt[(tok_hi - 32 * ((j) + 1)) >> 7] * PAGE + ((tok_hi - 32 * ((j) + 1)) & 127)) * 512)
    if (sp == NSPLIT - 1) {
        const bf16* KBn = (const bf16*)(ws + WS_KB) + (size_t)(MP + b * TS) * SBW + h * HD;
#pragma unroll
        for (int d0 = 0; d0 < 4; ++d0) { kf[d0] = (bf16x8){0, 0, 0, 0, 0, 0, 0, 0}; if (r32 < TS) kf[d0] = *(const bf16x8*)(KBn + (size_t)r32 * SBW + 16 * d0 + 8 * hi); }
        u32x4 vr[4];
        vr[0] = *(const u32x4*)((const bf16*)(ws + WS_VB) + (size_t)(MP + b * TS + (lane >> 3)) * SBW + h * HD + (lane & 7) * 8);
        vr[1] = (u32x4){0u, 0u, 0u, 0u}; vr[2] = vr[1]; vr[3] = vr[1];
        write_v_lds(wl, vr, lane);
        read_vfrags(vf, wl, lane);
        o[0] = (f32x16){}; o[1] = (f32x16){}; carry = 0.f;
        sb_tile<1>(kf, vf, qf, bias2, o, carry, 0, r32, hi);
        attn_sample_store(A, b, h, NPART - 1, lane, o, carry);
    }
    f32x4 rk2[8];
    load_raw_sample(rk, ck, SAMPLE_BASE(0), h, lane); load_raw_sample(rv, cv, SAMPLE_BASE(0), h, lane);
    load_raw_sample(rk2, ck, SAMPLE_BASE(1), h, lane);
#pragma unroll
    for (int d0 = 0; d0 < 4; ++d0) *(LAS bf16x8*)(wl + AW_SQ + (d0 * 64 + lane) * 16) = qf[d0];
    o[0] = (f32x16){}; o[1] = (f32x16){}; carry = 0.f;
#define SAMPLE_TILE(RK, jk_, jv_) do { \
        write_raw_sample(wl, AW_K, KPI, RK, lane); write_raw_sample(wl, AW_V, VPI, rv, lane); \
        if ((jk_) < NT) load_raw_sample(RK, ck, SAMPLE_BASE(jk_), h, lane); \
        read_kfrags(kf, wl, r32, hi); read_vfrags(vf, wl, lane); \
        bf16x8 qq[4]; _Pragma("unroll") for (int d0_ = 0; d0_ < 4; ++d0_) qq[d0_] = *(const LAS bf16x8*)(wl + AW_SQ + (d0_ * 64 + lane) * 16); \
        f32x16 p; sb_qk<0>(p, kf, qq, bias2, 0, 0, hi); \
        sb_core(p, carry, hi); \
        __builtin_amdgcn_sched_barrier(0); \
        if ((jv_) < NT) load_raw_sample(rv, cv, SAMPLE_BASE(jv_), h, lane); \
        sb_pvonly(p, vf, o); } while (0)
    for (int j = 0; j < NT; j += 2) {
        SAMPLE_TILE(rk, j + 2, j + 1);
        SAMPLE_TILE(rk2, j + 3, j + 2);
    }
#undef SAMPLE_TILE
#undef SAMPLE_BASE
    attn_sample_store(A, b, h, sp, lane, o, carry);
}

__device__ __forceinline__ void phase_outnorm(const Args& A, int gw, int NGW, int lane) {
    unsigned char* ws = A.ws; const float* ODN = (const float*)(ws + WS_ODN); bf16* MIXED = (bf16*)(ws + WS_MIXED);
    const float* gdn = (const float*)A.in[I_GDNO]; const float* gso = (const float*)A.in[I_GSBO];
    const float* OPb = (const float*)(ws + WS_OPART); const float* LPb = (const float*)(ws + WS_LPART);
    const int c8 = 8 * lane;
    unsigned nr[8]; u32x4 nzw;
#define ON_LOAD(mm_) do { if ((mm_) >= MP) { const float* op_ = ODN + (size_t)(mm_) * DNW + c8; const u32x4 p0_ = *(const u32x4*)op_, p1_ = *(const u32x4*)(op_ + 4); nr[0] = p0_.x; nr[1] = p0_.y; nr[2] = p0_.z; nr[3] = p0_.w; nr[4] = p1_.x; nr[5] = p1_.y; nr[6] = p1_.z; nr[7] = p1_.w; } \
        else { const int t_ = (mm_) & 4095, cch_ = t_ & 63, hh_ = lane >> 4; const size_t it_ = (size_t)(((mm_) >> 12) * 64 + (t_ >> 6)) * 4 + hh_; \
            const unsigned short* op_ = (const unsigned short*)ODN + it_ * 8192 + ((((cch_ >> 4) * 8 + ((lane & 15) >> 1)) * 64 + ((cch_ >> 2) & 3) * 16 + 8 * (lane & 1)) * 4) + (cch_ & 3); \
            _Pragma("unroll") for (int k_ = 0; k_ < 8; ++k_) nr[k_] = (unsigned)op_[4 * k_]; } \
        nzw = *(const u32x4*)((const bf16*)(ws + WS_ZG) + (size_t)(mm_) * DNW + c8); } while (0)
    if (gw < M) ON_LOAD(gw);
    const f32x4 g0 = *(const f32x4*)(gdn + (c8 & 127)), g1 = *(const f32x4*)(gdn + (c8 & 127) + 4);
    for (int m = gw; m < M; m += NGW) {
        {
            f32x4 a0, a1;
            if (m >= MP) { a0 = (f32x4){__uint_as_float(nr[0]), __uint_as_float(nr[1]), __uint_as_float(nr[2]), __uint_as_float(nr[3])}; a1 = (f32x4){__uint_as_float(nr[4]), __uint_as_float(nr[5]), __uint_as_float(nr[6]), __uint_as_float(nr[7])}; }
            else { a0 = (f32x4){__uint_as_float(nr[0] << 16), __uint_as_float(nr[1] << 16), __uint_as_float(nr[2] << 16), __uint_as_float(nr[3] << 16)}; a1 = (f32x4){__uint_as_float(nr[4] << 16), __uint_as_float(nr[5] << 16), __uint_as_float(nr[6] << 16), __uint_as_float(nr[7] << 16)}; }
            const u32x4 zw = nzw;
            { const int mn = m + NGW; if (mn < M) ON_LOAD(mn); }
            float ss = (a0.x * a0.x + a0.y * a0.y) + (a0.z * a0.z + a0.w * a0.w) + (a1.x * a1.x + a1.y * a1.y) + (a1.z * a1.z + a1.w * a1.w);
            ss += __shfl_xor(ss, 1); ss += __shfl_xor(ss, 2); ss += __shfl_xor(ss, 4); ss += __shfl_xor(ss, 8);
            const float rs = 1.0f / sqrtf(ss * (1.f / DND) + EPS);
            const f32x4 z0 = bf4lo(zw), z1 = bf4hi(zw);
            *(u32x4*)(MIXED + (size_t)m * D + SBW + c8) = pack8(a0 * rs * g0 * z0, a1 * rs * g1 * z1);
        }
        if (m >= MP) {
            const int b = (m - MP) >> 3, t = (m - MP) & 7, h = lane >> 3, d0 = c8 & 63;
            const float* OP = OPb + (size_t)(b * SBH + h) * NPART * 512; const float* LP = LPb + (size_t)(b * SBH + h) * NPART * 8;
            float v[8];
#pragma unroll
            for (int k = 0; k < 8; ++k) v[k] = 0.f;
            float suf = 0.f;
#pragma unroll
            for (int part = NPART - 1; part >= 0; --part) { const float w = __builtin_amdgcn_exp2f(suf);
                const f32x4 pa = *(const f32x4*)(OP + part * 512 + t * 64 + d0), pb = *(const f32x4*)(OP + part * 512 + t * 64 + d0 + 4);
                v[0] += w * pa.x; v[1] += w * pa.y; v[2] += w * pa.z; v[3] += w * pa.w; v[4] += w * pb.x; v[5] += w * pb.y; v[6] += w * pb.z; v[7] += w * pb.w;
                suf += LP[part * 8 + t]; }
            float ss = 0.f;
#pragma unroll
            for (int k = 0; k < 8; ++k) ss += v[k] * v[k];
            ss += __shfl_xor(ss, 1); ss += __shfl_xor(ss, 2); ss += __shfl_xor(ss, 4);
            const float rs = 1.0f / sqrtf(ss * (1.f / HD) + EPS);
            const f32x4 g0 = *(const f32x4*)(gso + d0), g1 = *(const f32x4*)(gso + d0 + 4);
            *(u32x4*)(MIXED + (size_t)m * D + c8) = pack8((f32x4){v[0], v[1], v[2], v[3]} * rs * g0, (f32x4){v[4], v[5], v[6], v[7]} * rs * g1);
        }
    }
}

__device__ __forceinline__ f32x4 cg_conv(const f32x4 w0, const f32x4 w1, const f32x4 w2, const f32x4 x2, const f32x4 x1, const f32x4 x0) { return w0 * x2 + w1 * x1 + w2 * x0; }
__device__ __forceinline__ void upfix_rows(const Args& A, const bf16* own0, const bf16* own1, bool hbf, const void* h2v, const void* h3v, bool hzero, bf16* act0, bf16* act1, int c) {
    const float* wf = (const float*)A.in[I_WFC];
    f32x4 wu[3][2], wg[3][2];
#pragma unroll
    for (int i = 0; i < 3; ++i) { const float* wp = wf + (size_t)i * DFF2 + c; wu[i][0] = *(const f32x4*)wp; wu[i][1] = *(const f32x4*)(wp + 4); wg[i][0] = *(const f32x4*)(wp + DFF); wg[i][1] = *(const f32x4*)(wp + DFF + 4); }
    f32x4 u2[2], u3[2], g2[2], g3[2];
    if (hzero) { u2[0] = (f32x4){0.f, 0.f, 0.f, 0.f}; u2[1] = u2[0]; u3[0] = u2[0]; u3[1] = u2[0]; g2[0] = u2[0]; g2[1] = u2[0]; g3[0] = u2[0]; g3[1] = u2[0]; }
    else if (hbf) { const bf16* h2 = (const bf16*)h2v; const bf16* h3 = (const bf16*)h3v; const u32x4 a = *(const u32x4*)(h2 + c), b = *(const u32x4*)(h3 + c), d = *(const u32x4*)(h2 + DFF + c), e = *(const u32x4*)(h3 + DFF + c);
        u2[0] = bf4lo(a); u2[1] = bf4hi(a); u3[0] = bf4lo(b); u3[1] = bf4hi(b); g2[0] = bf4lo(d); g2[1] = bf4hi(d); g3[0] = bf4lo(e); g3[1] = bf4hi(e); }
    else { const float* h2 = (const float*)h2v; const float* h3 = (const float*)h3v;
        u2[0] = *(const f32x4*)(h2 + c); u2[1] = *(const f32x4*)(h2 + c + 4); u3[0] = *(const f32x4*)(h3 + c); u3[1] = *(const f32x4*)(h3 + c + 4);
        g2[0] = *(const f32x4*)(h2 + DFF + c); g2[1] = *(const f32x4*)(h2 + DFF + c + 4); g3[0] = *(const f32x4*)(h3 + DFF + c); g3[1] = *(const f32x4*)(h3 + DFF + c + 4); }
    const u32x4 o0u = *(const u32x4*)(own0 + c), o0g = *(const u32x4*)(own0 + DFF + c), o1u = *(const u32x4*)(own1 + c), o1g = *(const u32x4*)(own1 + DFF + c);
    const f32x4 a0[2] = {bf4lo(o0u), bf4hi(o0u)}, b0[2] = {bf4lo(o0g), bf4hi(o0g)}, a1[2] = {bf4lo(o1u), bf4hi(o1u)}, b1[2] = {bf4lo(o1g), bf4hi(o1g)};
    f32x4 r0[2], r1[2];
#pragma unroll
    for (int k = 0; k < 2; ++k) {
        f32x4 yu = cg_conv(wu[0][k], wu[1][k], wu[2][k], u2[k], u3[k], a0[k]), yg = cg_conv(wg[0][k], wg[1][k], wg[2][k], g2[k], g3[k], b0[k]);
        yg.x = siluf(yg.x); yg.y = siluf(yg.y); yg.z = siluf(yg.z); yg.w = siluf(yg.w); r0[k] = yg * yu;
        yu = cg_conv(wu[0][k], wu[1][k], wu[2][k], u3[k], a0[k], a1[k]); yg = cg_conv(wg[0][k], wg[1][k], wg[2][k], g3[k], b0[k], b1[k]);
        yg.x = siluf(yg.x); yg.y = siluf(yg.y); yg.z = siluf(yg.z); yg.w = siluf(yg.w); r1[k] = yg * yu;
    }
    *(u32x4*)(act0 + c) = pack8(r0[0], r0[1]); *(u32x4*)(act1 + c) = pack8(r1[0], r1[1]);
}
__device__ __forceinline__ void phase_upfix(const Args& A, int gw, int NGW, int lane) {
    unsigned char* ws = A.ws; const bf16* SIDEP = (const bf16*)(ws + WS_SIDEP); const bf16* SIDES = (const bf16*)(ws + WS_SIDES); bf16* ACT = (bf16*)(ws + WS_ACT);
    const float* sfc = (const float*)A.in[I_SFC];
    constexpr int NPB = MP / 64, NPI = NPB * 6, NSI = BS * 6;
    for (int it = gw; it < NPI + NSI; it += NGW) {
        const int cgp = it % 6, idx = it / 6; const int c = (cgp * 64 + lane) * 8;
        if (c >= DFF) continue;
        if (it < NPI) { const int kb = idx; const bf16* sp = SIDEP + (size_t)kb * 4 * DFF2;
            upfix_rows(A, sp, sp + DFF2, true, sp - 2 * DFF2, sp - DFF2, (kb & 63) == 0, ACT + (size_t)(kb * 64) * DFF, ACT + (size_t)(kb * 64 + 1) * DFF, c);
            if ((kb & 63) == 63) { const int b = kb >> 6; float* fo = A.out + O_FCP + (size_t)b * 2 * DFF2 + c;
#pragma unroll
                for (int r = 0; r < 2; ++r) { const u32x4 a = *(const u32x4*)(sp + (2 + r) * DFF2 + c), g = *(const u32x4*)(sp + (2 + r) * DFF2 + DFF + c);
                    *(f32x4*)(fo + r * DFF2) = bf4lo(a); *(f32x4*)(fo + r * DFF2 + 4) = bf4hi(a); *(f32x4*)(fo + r * DFF2 + DFF) = bf4lo(g); *(f32x4*)(fo + r * DFF2 + DFF + 4) = bf4hi(g); } }
        } else { const int seq = (it - NPI) / 6; const bf16* sp = SIDES + (size_t)seq * 2 * DFF2; const float* st = sfc + (size_t)seq * 2 * DFF2;
            upfix_rows(A, sp, sp + DFF2, false, st, st + DFF2, false, ACT + (size_t)(MP + seq * 8) * DFF, ACT + (size_t)(MP + seq * 8 + 1) * DFF, c); }
    }
}

__device__ __forceinline__ void phase_slabsum(const Args& A, int gw, int NGW, int lane) {
    unsigned char* ws = A.ws; const float* slab = (const float*)(ws + WS_SLAB); const float* X1 = (const float*)(ws + WS_X1); const float* MOD = (const float*)(ws + WS_MOD);
    for (int r = gw; r < MS; r += NGW) {
        const int m = MP + r; const float* mod = MOD + (size_t)mod_row(m) * NMOD + 5120;
#pragma unroll
        for (int j = 0; j < 4; ++j) { const int c = 4 * (lane + 64 * j); f32x4 a = (f32x4){0.f, 0.f, 0.f, 0.f};
#pragma unroll
            for (int k = 0; k < DFF / 256; ++k) { const u32x2 sw = *(const u32x2*)((const bf16*)slab + ((size_t)k * MS + r) * D + c); a += (f32x4){__uint_as_float(sw.x << 16), __uint_as_float(sw.x & 0xffff0000u), __uint_as_float(sw.y << 16), __uint_as_float(sw.y & 0xffff0000u)}; }
            *(f32x4*)(A.out + (size_t)m * D + c) = *(const f32x4*)(X1 + (size_t)m * D + c) + *(const f32x4*)(mod + c) * a; }
    }
}

constexpr int NPHASE = 14;
#ifndef PROBE_LEVEL
#define PROBE_LEVEL 0
#endif
#ifndef REP_MASK
#define REP_MASK 0
#endif

__global__ void __launch_bounds__(512, 2) fwd_kernel(Args A) {
    extern __shared__ __attribute__((aligned(16))) unsigned char lds_raw[];
    LAS unsigned char* lds = (LAS unsigned char*)lds_raw;
    const int wave = __builtin_amdgcn_readfirstlane((int)threadIdx.x >> 6);
    const int G = gridDim.x, bx = blockIdx.x;
    const int gw = bx * 8 + wave, NGW = G * 8, NGT = G * 512;
    unsigned char* ws = A.ws;
    gu32* ctl = (gu32*)(ws + WS_CTL);
    volatile LAS unsigned* MISC = (volatile LAS unsigned*)(lds + MISC_OFF);
    { const int t0 = wave * 64 + lane_now(); for (int u = t0; u < (LDS_BYTES - RING_BYTES) / 4; u += 512) ((LAS unsigned*)(lds + RING_BYTES))[u] = 0u; }
    __syncthreads();
    const int lo = A.lo, hi = A.hi;
    const bool multi = (hi - lo) > 1;
    XcdBarrier bar; bar.bar = (unsigned*)(ctl + CW_BAR); bar.x = 0; bar.st = nullptr;
    if (multi) bar = xcd_barrier_post((unsigned*)(ctl + CW_BAR), MISC + 8, wave * 64 + lane_now());
#define IN(k) (lo <= (k) && (k) < hi)
#define GBAR() xcd_barrier(bar, wave * 64 + lane_now())
#define SEAM(k) do { if (IN(k) && IN((k) + 1)) GBAR(); } while (0)
    float* MOD = (float*)(ws + WS_MOD);

#define PH0(rep_) phase_prologue(A, lds, ctl + CW_Q0 + 64 * (rep_), bx, G, wave, lane, gtid, NGT);
#define PH1(rep_) ;
#define PH2(rep_) phase_norm<true>((const float*)A.in[I_XP], (const float*)A.in[I_XS], (const float*)A.in[I_GATT], MOD, 0, 1024, (bf16*)(ws + WS_H), (const float*)(ws + WS_WINX), (float*)(ws + WS_EXTRA), gw, NGW, lane);
#define PH3(rep_) { pg8::Gemm g{(const pg8::bf16_t*)(ws + WS_H), (const pg8::bf16_t*)(ws + WS_WIN_T), M, NPROJ, D, D}; pg8::StaticOrder S; S.init(M, NPROJ, G, bx); \
          EpiProj E{A.out, (bf16*)(ws + WS_QB), (bf16*)(ws + WS_KB), (bf16*)(ws + WS_VB), (bf16*)(ws + WS_DNRAW), (bf16*)(ws + WS_ZG), (const float*)A.in[I_GQ], (const float*)A.in[I_GK], (LAS float*)(lds + RING_BYTES + 1024)}; \
          pg8::gemm_phase<EpiProj, pg8::StaticOrder, true, true>(lds, g, S, E, tid); }
#define PH4(rep_) phase_post(A, gw, NGW, lane, gtid, NGT);
#define PH5(rep_) { for (int u = bx; u < 512; u += G) dn_prescan_unit(A, lds, u, tid, wave, lane); \
        const int tid2_ = wave * 64 + lane_now();     \
        int us_ = bx; for (; us_ + G < 512; us_ += 2 * G) dn_sample_units<2>(A, lds, us_, G, tid2_); if (us_ < 512) dn_sample_units<1>(A, lds, us_, G, tid2_); }
#define PH6(rep_) PH6X(rep_, true, true, true)
#define PH6X(rep_, DS_, DP_, DA_) { if ((DS_) && bx < 16) dn_scan_chain(A, lds, bx, tid, wave, lane); \
          \
        bool moreP = (DP_), moreS = (DA_); const bool pfirst = wave < 4; \
        gu32* qbase_ = ctl + CW_QUEUE + 1024 * (rep_);     \
        const int shard0_ = (int)(xb_xcc_id() & 7u); int offP_ = 0, offS_ = 0;     \
        for (;;) { \
            int job = -1; bool isP = false; \
            if (pfirst && moreP) { const int sh_ = (shard0_ + offP_) & 7; unsigned j_ = 0; if (lane == 0) j_ = __hip_atomic_fetch_add(qbase_ + 64 * sh_, 1u, RLX_AGENT); j_ = __builtin_amdgcn_readfirstlane(j_); if (j_ < 256u) { job = (int)j_ * 8 + sh_; isP = true; } else if (++offP_ == 8) moreP = false; } \
            if (job < 0 && moreS && !(pfirst && moreP)) { const int sh_ = (shard0_ + offS_) & 7; unsigned j_ = 0; if (lane == 0) j_ = __hip_atomic_fetch_add(qbase_ + 512 + 64 * sh_, 1u, RLX_AGENT); j_ = __builtin_amdgcn_readfirstlane(j_); if (j_ < 512u) { job = (int)j_ * 8 + sh_; } else if (++offS_ == 8) moreS = false; } \
            if (job < 0 && !pfirst && !moreS && moreP) { const int sh_ = (shard0_ + offP_) & 7; unsigned j_ = 0; if (lane == 0) j_ = __hip_atomic_fetch_add(qbase_ + 64 * sh_, 1u, RLX_AGENT); j_ = __builtin_amdgcn_readfirstlane(j_); if (j_ < 256u) { job = (int)j_ * 8 + sh_; isP = true; } else if (++offP_ == 8) moreP = false; } \
            if (job < 0) { if (!moreP && !moreS) break; else continue; } \
            if (isP) { const int qb = 63 - (job >> 5), bh = job & 31; attn_prompt_item(A, lds + wave * AW_BYTES, bh >> 3, bh & 7, qb * 64, lane); } \
            else { const int h_ = job & 7, bs_ = job >> 3; attn_sample_job(A, lds + wave * AW_BYTES, bs_ >> 2, h_, bs_ & 3, lane); } \
        } }
#define PH7(rep_) phase_outnorm(A, gw, NGW, lane);
#define PH8(rep_) { { pg8::Gemm g{(const pg8::bf16_t*)(ws + WS_MIXED), (const pg8::bf16_t*)(ws + WS_WOUT_T), MP, D, D, D}; pg8::StaticOrder S; S.init(MP, D, G, bx); \
        EpiResGateH<false, true> E{A.in[I_XP], MOD, 2048, (void*)(ws + WS_X1)};     \
        pg8::gemm_phase<EpiResGateH<false, true>, pg8::StaticOrder, true, true>(lds, g, S, E, tid); } \
        __syncthreads(); \
        { pg8::Gemm g{(const pg8::bf16_t*)(ws + WS_MIXED), (const pg8::bf16_t*)(ws + WS_WOUT_T), M, D, 256, D}; SplitKOrder S{D / 256, G, bx};     \
        EpiSlab E{(bf16*)(ws + WS_SLAB)}; \
        pg8::gemm_phase<EpiSlab, SplitKOrder, true, true>(lds, g, S, E, tid); } }
#define PH9(rep_) phase_norm<false, 4, true>((const float*)(ws + WS_X1), (const float*)A.in[I_XS], (const float*)A.in[I_GFFN], MOD, 3072, 4096, (bf16*)(ws + WS_H), nullptr, nullptr, gw, NGW, lane, (const float*)(ws + WS_SLAB), 2048, (float*)(ws + WS_X1));
#define PH10(rep_) { pg8::Gemm g{(const pg8::bf16_t*)(ws + WS_H), (const pg8::bf16_t*)(ws + WS_WUP_T), M, DFF2, D, D}; pg8::StaticOrder S; S.init(M, DFF2, G, bx); \
        EpiUp E{(bf16*)(ws + WS_ACT), (bf16*)(ws + WS_SIDEP), (bf16*)(ws + WS_SIDES), (const float*)A.in[I_WFC], A.out}; \
        pg8::gemm_phase<EpiUp, pg8::StaticOrder, true, true>(lds, g, S, E, tid); }
#define PH11(rep_) phase_upfix(A, gw, NGW, lane);
#define PH12(rep_) { { pg8::Gemm g{(const pg8::bf16_t*)(ws + WS_ACT), (const pg8::bf16_t*)(ws + WS_WDN_T), MP, D, DFF, DFF}; pg8::StaticOrder S; S.init(MP, D, G, bx); \
        EpiResGateH<true, false> E{(const void*)(ws + WS_X1), MOD, 5120, (void*)A.out}; \
        pg8::gemm_phase<EpiResGateH<true, false>, pg8::StaticOrder, true, true>(lds, g, S, E, tid); } \
        __syncthreads(); \
        { pg8::Gemm g{(const pg8::bf16_t*)(ws + WS_ACT), (const pg8::bf16_t*)(ws + WS_WDN_T), M, D, 256, DFF}; SplitKOrder S{DFF / 256, G, bx}; \
        EpiSlab E{(bf16*)(ws + WS_SLAB)}; \
        pg8::gemm_phase<EpiSlab, SplitKOrder, true, true>(lds, g, S, E, tid); } }
#define PH13(rep_) phase_slabsum(A, gw, NGW, lane);
#define RUNPH(k) do { if (IN(k)) { const int lane = lane_now(), tid = wave * 64 + lane, gtid = bx * 512 + tid; (void)gtid; PH##k(0) if constexpr (((REP_MASK) >> (k)) & 1) { GBAR(); PH##k(1) } } } while (0)
    RUNPH(0); SEAM(0);
    RUNPH(2);
    if constexpr (((REP_MASK) >> 20) & 1) { GBAR(); const int lane = lane_now(); phase_norm<false>((const float*)A.in[I_XP], (const float*)A.in[I_XS], (const float*)A.in[I_GATT], MOD, 0, 1024, (bf16*)(ws + WS_H), nullptr, nullptr, gw, NGW, lane); }
    SEAM(2);
    RUNPH(3); SEAM(3);
    RUNPH(4); SEAM(4);
    RUNPH(5);
    if constexpr (((REP_MASK) >> 17) & 1) { GBAR(); const int lane = lane_now(), tid = wave * 64 + lane; for (int u = bx; u < 512; u += G) dn_prescan_unit<PROBE_LEVEL>(A, lds, u, tid, wave, lane); }
    if constexpr (((REP_MASK) >> 18) & 1) { GBAR(); const int lane = lane_now(), tid = wave * 64 + lane; (void)lane; for (int u = bx; u < 512; u += G) dn_sample_units<1>(A, lds, u, G, tid); }
    SEAM(5);
    RUNPH(6);
    if constexpr (((REP_MASK) >> 13) & 1) { GBAR(); const int lane = lane_now(), tid = wave * 64 + lane; PH6X(2, true, false, false) }
    if constexpr (((REP_MASK) >> 14) & 1) { GBAR(); const int lane = lane_now(), tid = wave * 64 + lane; PH6X(3, false, true, false) }
    if constexpr (((REP_MASK) >> 15) & 1) { GBAR(); const int lane = lane_now(), tid = wave * 64 + lane; PH6X(4, false, false, true) }
    SEAM(6);
    RUNPH(7); SEAM(7);
    if constexpr (((REP_MASK) >> 19) & 1) { _Pragma("unroll 1") for (int i_ = 0; i_ < 20; ++i_) GBAR(); }
    RUNPH(8); SEAM(8);
    RUNPH(9); SEAM(9);
    RUNPH(10); SEAM(10);
    RUNPH(11); SEAM(11);
    RUNPH(12); SEAM(12);
    RUNPH(13);
#undef IN
#undef SEAM
}

#ifndef N_LAUNCHES
#define N_LAUNCHES 1
#endif
extern "C" void kernel_launch(void* const* d_in, const int* in_sizes, int n_in, void* d_out, int out_size, void* d_ws, size_t ws_size, hipStream_t stream) {
    static int grid = 0;
    if (grid == 0) {
        if (n_in != 27 || (size_t)out_size != O_END || ws_size < WS_END) { fprintf(stderr, "kernel_launch: unexpected shapes: n_in %d out %d ws %zu\n", n_in, out_size, ws_size); grid = -1; return; }
        int dev = 0, cus = 0, per_cu = 0;
        if (hipGetDevice(&dev) != hipSuccess || hipDeviceGetAttribute(&cus, hipDeviceAttributeMultiprocessorCount, dev) != hipSuccess) { grid = -1; return; }
        if (hipFuncSetAttribute((const void*)fwd_kernel, hipFuncAttributeMaxDynamicSharedMemorySize, LDS_BYTES) != hipSuccess) { fprintf(stderr, "kernel_launch: hipFuncSetAttribute failed\n"); grid = -1; return; }
        if (hipOccupancyMaxActiveBlocksPerMultiprocessor(&per_cu, (const void*)fwd_kernel, 512, LDS_BYTES) != hipSuccess || per_cu < 1) fprintf(stderr, "kernel_launch: occupancy query says %d\n", per_cu);
        (void)hipGetLastError();
        grid = cus;
    }
    if (grid < 0) return;
    (void)hipMemsetAsync((char*)d_ws + WS_CTL, 0, CTL_ZERO_BYTES, stream);
    Args a{};
    for (int i = 0; i < 27; ++i) a.in[i] = d_in[i];
    a.out = (float*)d_out; a.ws = (unsigned char*)d_ws;
    if (N_LAUNCHES == 1) { a.lo = 0; a.hi = NPHASE; hipLaunchKernelGGL(fwd_kernel, dim3(grid), dim3(512), LDS_BYTES, stream, a); }
    else for (int p = 0; p < NPHASE; ++p) { a.lo = p; a.hi = p + 1; hipLaunchKernelGGL(fwd_kernel, dim3(grid), dim3(512), LDS_BYTES, stream, a); }
}
```

```cpp
#include <hip/hip_runtime.h>
#include <cstdio>
#include <cstdint>
#define REP_MASK 0
#define PROBE_LEVEL 0
namespace pg8 {
#define PG8_LAS __attribute__((address_space(3)))
typedef unsigned short bf16_t;
typedef short bf16x8 __attribute__((ext_vector_type(8)));
typedef float f32x4 __attribute__((ext_vector_type(4)));
typedef unsigned u32x4 __attribute__((ext_vector_type(4)));
constexpr int BM = 256, BK = 64, HALF = 128, HTB = HALF * BK * 2  , STAGE_BYTES = 8 * HTB, NXCD = 8, WGM = 8;

__host__ __device__ __forceinline__ int lds_byte(int r, int c) { const int st = (r >> 4) * 2 + (c >> 5), rr = r & 15, cc = c & 31, ob = rr * 64 + cc * 2; return st * 1024 + (ob ^ (((ob >> 9) & 1) << 5)); }
__host__ __device__ __forceinline__ void stage_rc(int b, int& R, int& C) { const int st = b / 1024, sb = b % 1024, swz = sb ^ (((sb >> 9) & 1) << 5); R = (st >> 1) * 16 + swz / 64; C = (st & 1) * 32 + (swz % 64) / 2; }
__host__ __device__ __forceinline__ int perm32(int rho) { const int n = rho >> 4, i = rho & 15; return 8 * (i >> 2) + 4 * n + (i & 3); }

struct Unit { int pm, pn, ko; };
struct Gemm { const bf16_t* A; const bf16_t* Bt; int M, N, K, ld; };

struct StaticOrder {
    int nM, nN, nwg, G, c;
    __host__ __device__ void init(int M, int N, int G_, int c_) { nM = M / BM; nN = N / BM; nwg = nM * nN; G = G_; c = c_; }
    __host__ __device__ bool next(int i, Unit& u) const {
        const long L = (long)i * G + c; if (L >= nwg) return false;
        int wgid = (int)L; { const int q = nwg / NXCD, r = nwg % NXCD, xcd = wgid % NXCD, off = wgid / NXCD; wgid = (xcd < r ? xcd * (q + 1) : r * (q + 1) + (xcd - r) * q) + off; }
        const int nig = WGM * nN, gid = wgid / nig, fm = gid * WGM, gsz = (nM - fm) < WGM ? (nM - fm) : WGM;
        u.pm = fm + ((wgid % nig) % gsz); u.pn = (wgid % nig) / gsz; u.ko = 0; return true;
    }
    __device__ __forceinline__ void a_ready(const Unit&) const {}
    __device__ __forceinline__ void done(const Unit&) const {}
};

__device__ __forceinline__ unsigned cvt_pk_bf16(float lo, float hi) { unsigned r; asm volatile("v_cvt_pk_bf16_f32 %0, %1, %2" : "=v"(r) : "v"(lo), "v"(hi)); return r; }
typedef float f32x2 __attribute__((ext_vector_type(2)));
__device__ __forceinline__ f32x2 gelu_pk(f32x2 v) {
    const f32x2 av = __builtin_elementwise_abs(v), d = av * 0.2316418882f + 1.0f;
    f32x2 t; t.x = __builtin_amdgcn_rcpf(d.x); t.y = __builtin_amdgcn_rcpf(d.y);
    f32x2 q = t * 0.5307027145f + (-0.7265760135f); q = q * t + 0.7107068705f; q = q * t + (-0.142248368f); q = q * t + 0.127414796f; q = q * t;
    const f32x2 s = (v * v) * (-0.72134752044f);
    f32x2 e; e.x = __builtin_amdgcn_exp2f(s.x); e.y = __builtin_amdgcn_exp2f(s.y);
    const f32x2 m = v * (q * e), r = v - m;
    f32x2 o; o.x = v.x < 0.f ? m.x : r.x; o.y = v.y < 0.f ? m.y : r.y; return o;
}

template <int ACT  > struct EpiBf16 {
    static constexpr bool PERM = true, AFTER_DRAIN = false; static_assert(ACT == 0 || ACT == 1, "EpiBf16: ACT is 0 (none) or 1 (gelu_pk)");
    bf16_t* O; int ldc; const float* bias; int split_cols; size_t split_stride; float scale0;
    __device__ __forceinline__ void operator()(const f32x4 (&acc)[2][2][4][2], const Unit& u, int wr, int wc, int fr, int fq) const {
        const int row0 = u.pm * BM + wr * 64 + fr; int colt = u.pn * BM; bf16_t* base = O;
        float sc = 1.f; if (split_cols) { const int t = colt / split_cols; base += (size_t)t * split_stride; colt -= t * split_cols; if (t == 0) sc = scale0; }
        const int col0 = colt + wc * 32 + 8 * fq, bcol0 = u.pn * BM + wc * 32 + 8 * fq;
        f32x4 bv[2][2];
#pragma unroll
        for (int bj = 0; bj < 2; ++bj)
#pragma unroll
            for (int n = 0; n < 2; ++n) bv[bj][n] = bias ? *(const f32x4*)(bias + bcol0 + bj * HALF + 4 * n) : (f32x4){0.f, 0.f, 0.f, 0.f};
#pragma unroll
        for (int ai = 0; ai < 2; ++ai)
#pragma unroll
            for (int m = 0; m < 4; ++m) { bf16_t* rowp = base + (size_t)(row0 + ai * HALF + m * 16) * ldc + col0;
#pragma unroll
                for (int bj = 0; bj < 2; ++bj) { f32x4 v0 = acc[ai][bj][m][0] + bv[bj][0], v1 = acc[ai][bj][m][1] + bv[bj][1];
                    if (ACT == 1) { f32x2 a = gelu_pk((f32x2){v0[0], v0[1]}), b = gelu_pk((f32x2){v0[2], v0[3]}), c = gelu_pk((f32x2){v1[0], v1[1]}), d = gelu_pk((f32x2){v1[2], v1[3]});
                        v0 = (f32x4){a.x, a.y, b.x, b.y}; v1 = (f32x4){c.x, c.y, d.x, d.y}; }
                    v0 = v0 * sc; v1 = v1 * sc; u32x4 w; w.x = cvt_pk_bf16(v0[0], v0[1]); w.y = cvt_pk_bf16(v0[2], v0[3]); w.z = cvt_pk_bf16(v1[0], v1[1]); w.w = cvt_pk_bf16(v1[2], v1[3]);
                    *(u32x4*)(rowp + bj * HALF) = w; } }
    }
};

struct PanelStats {
    unsigned* xbuf;
    unsigned* cnt;
    unsigned* tmo;
    int ntn; float eps;
    unsigned code;
    __device__ __forceinline__ bool run(const f32x4 (&v)[2][2][4][2], const Unit& u, int wr, int wc, int fr, int fq, PG8_LAS unsigned char* lds, int wid, int lane) const {
        typedef float f32x2v __attribute__((ext_vector_type(2)));
        PG8_LAS f32x2v* P = (PG8_LAS f32x2v*)lds;
        PG8_LAS f32x2v* S = (PG8_LAS f32x2v*)(lds + 8192);
        PG8_LAS unsigned* flag = (PG8_LAS unsigned*)(lds + 8192 + 2048);
#pragma unroll
        for (int ai = 0; ai < 2; ++ai)
#pragma unroll
            for (int m = 0; m < 4; ++m) {
                float s = 0.f;
#pragma unroll
                for (int bj = 0; bj < 2; ++bj)
#pragma unroll
                    for (int n = 0; n < 2; ++n) { const f32x4 x = v[ai][bj][m][n]; s += (x[0] + x[1]) + (x[2] + x[3]); }
                s += __shfl_xor(s, 16); s += __shfl_xor(s, 32);
                const float mw = s * (1.0f / 64.0f); float q = 0.f;
#pragma unroll
                for (int bj = 0; bj < 2; ++bj)
#pragma unroll
                    for (int n = 0; n < 2; ++n) { const f32x4 d = v[ai][bj][m][n] - mw; q += (d[0] * d[0] + d[1] * d[1]) + (d[2] * d[2] + d[3] * d[3]); }
                q += __shfl_xor(q, 16); q += __shfl_xor(q, 32);
                if (fq == 0) P[(ai * HALF + wr * 64 + m * 16 + fr) * 4 + wc] = (f32x2v){mw, q};
            }
        asm volatile("s_waitcnt lgkmcnt(0)" ::: "memory"); __builtin_amdgcn_s_barrier(); asm volatile("" ::: "memory");
#if defined(BROKEN_EXCHANGE_NO_WAIT)
#warning BROKEN CONTROL BUILD: the row-statistics exchange does not wait; results are wrong by design
        if (blockIdx.x >= 64) { const long long t0_ = clock64(); while (clock64() - t0_ < 60000) __builtin_amdgcn_s_sleep(8); }
#endif
        const int row = wid * 32 + (lane & 31);
        if (lane < 32) {
            const f32x2v a = P[row * 4 + 0], b = P[row * 4 + 1], c = P[row * 4 + 2], d = P[row * 4 + 3];
            const float mt = (a.x + b.x + c.x + d.x) * 0.25f;
            const float da = a.x - mt, db = b.x - mt, dc = c.x - mt, dd = d.x - mt;
            const float m2 = (a.y + b.y) + (c.y + d.y) + 64.0f * ((da * da + db * db) + (dc * dc + dd * dd));
            unsigned long long* slot = (unsigned long long*)xbuf + ((size_t)(u.pm * BM + row) * 4 + u.pn);
            __hip_atomic_store(slot, ((unsigned long long)__float_as_uint(m2) << 32) | __float_as_uint(mt), __ATOMIC_RELAXED, __HIP_MEMORY_SCOPE_AGENT);
        }
        asm volatile("s_waitcnt vmcnt(0)" ::: "memory");
        if (lane == 0) __hip_atomic_fetch_add(cnt + 64 * u.pm, 1u, __ATOMIC_RELAXED, __HIP_MEMORY_SCOPE_AGENT);
        if (wid == 0) {
            bool dead = false; const unsigned long long t0 = __builtin_amdgcn_s_memrealtime(); const unsigned want = 8u * (unsigned)ntn;
            for (;;) {
#if defined(BROKEN_EXCHANGE_NO_WAIT)
                break;
#endif
                if ((unsigned)__builtin_amdgcn_readfirstlane(__hip_atomic_load(cnt + 64 * u.pm, __ATOMIC_RELAXED, __HIP_MEMORY_SCOPE_AGENT)) >= want) break;
                if (__builtin_amdgcn_s_memrealtime() - t0 > 2000000ull) {
                    if (lane == 0) { unsigned expect = 0u; __hip_atomic_compare_exchange_strong(tmo + 1, &expect, code | (unsigned)(u.pm & 0xff), __ATOMIC_RELAXED, __ATOMIC_RELAXED, __HIP_MEMORY_SCOPE_AGENT);
                                     __hip_atomic_store(tmo, 1u, __ATOMIC_RELAXED, __HIP_MEMORY_SCOPE_AGENT); }
                    dead = true; break; }
                __builtin_amdgcn_s_sleep(2);
            }
            __builtin_amdgcn_fence(__ATOMIC_ACQUIRE, "agent");
            if (lane == 0) flag[0] = dead ? 1u : 0u;
        }
        asm volatile("s_waitcnt vmcnt(0) lgkmcnt(0)" ::: "memory"); __builtin_amdgcn_s_barrier(); asm volatile("" ::: "memory");
        const bool bad = flag[0] != 0u;
        if (lane < 32) {
            const unsigned long long* slot = (const unsigned long long*)xbuf + (size_t)(u.pm * BM + row) * 4; float mt[4], m2[4]; float ms = 0.f;
#pragma unroll
            for (int t = 0; t < 4; ++t) { if (t < ntn) { const unsigned long long w = __hip_atomic_load(slot + t, __ATOMIC_RELAXED, __HIP_MEMORY_SCOPE_AGENT); mt[t] = __uint_as_float((unsigned)w); m2[t] = __uint_as_float((unsigned)(w >> 32)); } else { mt[t] = 0.f; m2[t] = 0.f; } ms += mt[t]; }
            const float mean = ms / (float)ntn; float q = 0.f;
#pragma unroll
            for (int t = 0; t < 4; ++t) if (t < ntn) { const float dm = mt[t] - mean; q += m2[t] + 256.0f * dm * dm; }
            S[row] = (f32x2v){mean, 1.0f / sqrtf(q / (256.0f * (float)ntn) + eps)};
        }
        asm volatile("s_waitcnt lgkmcnt(0)" ::: "memory"); __builtin_amdgcn_s_barrier(); asm volatile("" ::: "memory");
        return bad;
    }
};
struct EpiLnRes {
    static constexpr bool PERM = false, AFTER_DRAIN = true;
    const float* base; float* out; int ldc; const float* bias; PanelStats st; unsigned poison;
    __device__ __forceinline__ void fused(f32x4 (&acc)[2][2][4][2], const Unit& u, int wr, int wc, int fr, int fq, PG8_LAS unsigned char* lds, int wid, int lane) const {
        typedef float f32x2v __attribute__((ext_vector_type(2)));
        const PG8_LAS f32x2v* S = (const PG8_LAS f32x2v*)(lds + 8192);
        const int col0 = u.pn * BM + wc * 32 + 4 * fq;
#pragma unroll
        for (int bj = 0; bj < 2; ++bj)
#pragma unroll
            for (int n = 0; n < 2; ++n) { const f32x4 bv = bias ? *(const f32x4*)(bias + col0 + bj * HALF + n * 16) : (f32x4){0.f, 0.f, 0.f, 0.f};
#pragma unroll
                for (int ai = 0; ai < 2; ++ai)
#pragma unroll
                    for (int m = 0; m < 4; ++m) acc[ai][bj][m][n] += bv; }
        f32x4 pre[4][2][2];
#pragma unroll
        for (int m = 0; m < 4; ++m) { const size_t off = (size_t)(u.pm * BM + wr * 64 + m * 16 + fr) * ldc + col0;
#pragma unroll
            for (int bj = 0; bj < 2; ++bj)
#pragma unroll
                for (int n = 0; n < 2; ++n) pre[m][bj][n] = *(const f32x4*)(base + off + bj * HALF + n * 16); }
        const bool bad = st.run(acc, u, wr, wc, fr, fq, lds, wid, lane) || poison != 0u;
        const float qnan = __builtin_nanf("");
#pragma unroll
        for (int ai = 0; ai < 2; ++ai)
#pragma unroll
            for (int m = 0; m < 4; ++m) { const int r = ai * HALF + wr * 64 + m * 16 + fr; const f32x2v sr = S[r]; const size_t off = (size_t)(u.pm * BM + r) * ldc + col0;
#pragma unroll
                for (int bj = 0; bj < 2; ++bj)
#pragma unroll
                    for (int n = 0; n < 2; ++n) { const f32x4 bs = ai == 0 ? pre[m][bj][n] : *(const f32x4*)(base + off + bj * HALF + n * 16); f32x4 o = bs + (acc[ai][bj][m][n] - sr.x) * sr.y;
                        if (bad) o = (f32x4){qnan, qnan, qnan, qnan}; *(f32x4*)(out + off + bj * HALF + n * 16) = o; }
                if (m & 1) asm volatile("" ::: "memory"); }
    }
};
struct EpiLnResLn {
    static constexpr bool PERM = false, AFTER_DRAIN = true;
    const float* base; float* out; bf16_t* xn; int ldc; const float* bias; PanelStats st1, st2; unsigned poison;
    __device__ __forceinline__ void fused(f32x4 (&acc)[2][2][4][2], const Unit& u, int wr, int wc, int fr, int fq, PG8_LAS unsigned char* lds, int wid, int lane) const {
        typedef float f32x2v __attribute__((ext_vector_type(2))); typedef unsigned u32x2v __attribute__((ext_vector_type(2)));
        const PG8_LAS f32x2v* S = (const PG8_LAS f32x2v*)(lds + 8192);
        const int col0 = u.pn * BM + wc * 32 + 4 * fq;
#pragma unroll
        for (int bj = 0; bj < 2; ++bj)
#pragma unroll
            for (int n = 0; n < 2; ++n) { const f32x4 bv = bias ? *(const f32x4*)(bias + col0 + bj * HALF + n * 16) : (f32x4){0.f, 0.f, 0.f, 0.f};
#pragma unroll
                for (int ai = 0; ai < 2; ++ai)
#pragma unroll
                    for (int m = 0; m < 4; ++m) acc[ai][bj][m][n] += bv; }
        bool bad = st1.run(acc, u, wr, wc, fr, fq, lds, wid, lane) || poison != 0u;
        const float qnan = __builtin_nanf("");
#pragma unroll
        for (int ai = 0; ai < 2; ++ai)
#pragma unroll
            for (int m = 0; m < 4; ++m) { const int r = ai * HALF + wr * 64 + m * 16 + fr; const f32x2v sr = S[r]; const size_t off = (size_t)(u.pm * BM + r) * ldc + col0;
#pragma unroll
                for (int bj = 0; bj < 2; ++bj)
#pragma unroll
                    for (int n = 0; n < 2; ++n) { const f32x4 bs = *(const f32x4*)(base + off + bj * HALF + n * 16); acc[ai][bj][m][n] = bs + (acc[ai][bj][m][n] - sr.x) * sr.y; }
                asm volatile("" : "+v"(acc[ai][0][m][0]), "+v"(acc[ai][0][m][1]), "+v"(acc[ai][1][m][0]), "+v"(acc[ai][1][m][1]));
                if (m & 1) asm volatile("" ::: "memory"); }
        const bool bad1 = bad;
        bad = st2.run(acc, u, wr, wc, fr, fq, lds, wid, lane) || bad;
#pragma unroll
        for (int ai = 0; ai < 2; ++ai)
#pragma unroll
            for (int m = 0; m < 4; ++m) { const int r = ai * HALF + wr * 64 + m * 16 + fr; const f32x2v sr = S[r]; const size_t off = (size_t)(u.pm * BM + r) * ldc + col0;
#pragma unroll
                for (int bj = 0; bj < 2; ++bj)
#pragma unroll
                    for (int n = 0; n < 2; ++n) { const f32x4 x1 = acc[ai][bj][m][n]; *(f32x4*)(out + off + bj * HALF + n * 16) = bad1 ? (f32x4){qnan, qnan, qnan, qnan} : x1;
                        const f32x4 o = (x1 - sr.x) * sr.y; u32x2v w; w.x = cvt_pk_bf16(o[0], o[1]); w.y = cvt_pk_bf16(o[2], o[3]);
                        if (bad) { w.x = 0x7fc07fc0u; w.y = 0x7fc07fc0u; } *(u32x2v*)(xn + off + bj * HALF + n * 16) = w; }
                asm volatile("" ::: "memory"); }
    }
};

template <class Epi, class Sched, bool ALIGN_EPI = false, bool SP2 = false>
__device__ __forceinline__ void gemm_phase(PG8_LAS unsigned char* lds, const Gemm g, const Sched& S, const Epi& E, const int tid) {
    const int wid = __builtin_amdgcn_readfirstlane(tid >> 6), lane = tid & 63, wr = wid >> 2, wc = wid & 3, fr = lane & 15, fq = lane >> 4;
    const int K = g.K, nt = K / BK;
    unsigned voffA[2], voffB[2];
#pragma unroll
    for (int i = 0; i < 2; ++i) { int R, C; stage_rc(tid * 16 + i * 8192, R, C); const int Rb = Epi::PERM ? ((R & ~31) + perm32(R & 31)) : R;
        voffA[i] = (unsigned)(R * g.ld + C) * 2u; voffB[i] = (unsigned)(Rb * g.ld + C) * 2u; }
    const size_t kstep = (size_t)(BK * 2);
    const size_t hstep = (size_t)HALF * g.ld * 2;
    const size_t tstep = 2 * hstep;
    const unsigned ldsw = (unsigned)wid * 1024u;
    const int aoff = lds_byte(wr * 64 + fr, fq * 8), boff = lds_byte(wc * 32 + fr, fq * 8);
#define PG8_SA(b, h) (((b) * 2 + (h)) * HTB)
#define PG8_SB(b, h) ((4 + (b) * 2 + (h)) * HTB)
#define PG8_STAGE(bufoff, gbase, voff) do { _Pragma("unroll") for (int _i = 0; _i < 2; ++_i) \
        __builtin_amdgcn_global_load_lds((const unsigned*)((const char*)(gbase) + (voff)[_i]), (PG8_LAS unsigned*)(lds + (bufoff) + ldsw + _i * 8192), 16, 0, 0); } while (0)
#define PG8_LDA(dst, b, h) do { _Pragma("unroll") for (int m = 0; m < 4; ++m) _Pragma("unroll") for (int k = 0; k < 2; ++k) dst[m][k] = *(const PG8_LAS bf16x8*)(lds + PG8_SA(b, h) + aoff + m * 2048 + k * 1024); } while (0)
#define PG8_LDB(dst, b, h) do { _Pragma("unroll") for (int n = 0; n < 2; ++n) _Pragma("unroll") for (int k = 0; k < 2; ++k) dst[n][k] = *(const PG8_LAS bf16x8*)(lds + PG8_SB(b, h) + boff + n * 2048 + k * 1024); } while (0)
#define PG8_MMA(ai, bj, At, Bt) do { __builtin_amdgcn_s_setprio(1); _Pragma("unroll") for (int m = 0; m < 4; ++m) _Pragma("unroll") for (int n = 0; n < 2; ++n) _Pragma("unroll") for (int k = 0; k < 2; ++k) \
        acc[ai][bj][m][n] = __builtin_amdgcn_mfma_f32_16x16x32_bf16(Bt[n][k], At[m][k], acc[ai][bj][m][n], 0, 0, 0); __builtin_amdgcn_s_setprio(0); } while (0)
#define PG8_WAIT_V(n) asm volatile("s_waitcnt vmcnt(" #n ")" ::: "memory")
#define PG8_WAIT_L(n) asm volatile("s_waitcnt lgkmcnt(" #n ")" ::: "memory")
#define PG8_BAR __builtin_amdgcn_s_barrier()
#define PG8_SCHED __builtin_amdgcn_sched_barrier(0)
    Unit cur, nxt; int ui = 0;
    if (!S.next(0, cur)) return;
    f32x4 acc[2][2][4][2];
#pragma unroll
    for (int a = 0; a < 2; ++a)
#pragma unroll
        for (int b = 0; b < 2; ++b)
#pragma unroll
            for (int m = 0; m < 4; ++m)
#pragma unroll
                for (int n = 0; n < 2; ++n) acc[a][b][m][n] = (f32x4){0.f, 0.f, 0.f, 0.f};
    bf16x8 At[4][2], B0[2][2], B1[2][2];
    const char* cA = (const char*)g.A + (size_t)cur.pm * tstep + (size_t)cur.ko * 2; const char* cB = (const char*)g.Bt + (size_t)cur.pn * tstep + (size_t)cur.ko * 2;
    S.a_ready(cur);
    if constexpr (SP2) {
        PG8_STAGE(PG8_SB(0, 0), cB, voffB); PG8_STAGE(PG8_SB(0, 1), cB + hstep, voffB); PG8_STAGE(PG8_SA(0, 0), cA, voffA); PG8_STAGE(PG8_SA(0, 1), cA + hstep, voffA);
        if (wr == 1) PG8_BAR;
        PG8_WAIT_V(2); PG8_BAR;
        PG8_STAGE(PG8_SB(1, 0), cB + kstep, voffB); PG8_STAGE(PG8_SA(1, 0), cA + kstep, voffA); PG8_STAGE(PG8_SB(1, 1), cB + hstep + kstep, voffB);
        PG8_WAIT_V(6); PG8_BAR;
    } else {
        PG8_STAGE(PG8_SB(0, 0), cB, voffB); PG8_STAGE(PG8_SA(0, 0), cA, voffA); PG8_STAGE(PG8_SB(0, 1), cB + hstep, voffB); PG8_STAGE(PG8_SA(0, 1), cA + hstep, voffA);
        if (wr == 1) PG8_BAR;
        PG8_WAIT_V(4); PG8_BAR;
        PG8_STAGE(PG8_SB(1, 0), cB + kstep, voffB); PG8_STAGE(PG8_SA(1, 0), cA + kstep, voffA); PG8_STAGE(PG8_SB(1, 1), cB + hstep + kstep, voffB);
        PG8_WAIT_V(6); PG8_BAR;
    }
    for (;;) {
        const bool has_next = S.next(ui + 1, nxt);
        const char* nA = has_next ? (const char*)g.A + (size_t)nxt.pm * tstep + (size_t)nxt.ko * 2 : cA; const char* nB = has_next ? (const char*)g.Bt + (size_t)nxt.pn * tstep + (size_t)nxt.ko * 2 : cB;
        for (int t = 0; t < nt; t += 2) {
            const bool last = (t == nt - 2);
            const char* a1 = cA + (size_t)(t + 1) * kstep;
            const char* a2 = last ? nA : cA + (size_t)(t + 2) * kstep; const char* b2 = last ? nB : cB + (size_t)(t + 2) * kstep;
            const char* a3 = a2 + kstep; const char* b3 = b2 + kstep;
            if (last && has_next) S.a_ready(nxt);
            if constexpr (SP2) {
            PG8_LDB(B0, 0, 0); PG8_LDB(B1, 0, 1); PG8_SCHED; PG8_LDA(At, 0, 0); PG8_STAGE(PG8_SA(1, 1), a1 + hstep, voffA);
            PG8_WAIT_V(8); PG8_WAIT_L(0); PG8_BAR; PG8_MMA(0, 0, At, B0); PG8_MMA(0, 1, At, B1); PG8_BAR; PG8_SCHED;
            PG8_LDA(At, 0, 1); PG8_STAGE(PG8_SB(0, 0), b2, voffB); PG8_STAGE(PG8_SB(0, 1), b2 + hstep, voffB); PG8_STAGE(PG8_SA(0, 0), a2, voffA);
            PG8_WAIT_V(8); PG8_WAIT_L(0); PG8_BAR; PG8_MMA(1, 0, At, B0); PG8_MMA(1, 1, At, B1); PG8_BAR; PG8_SCHED;
            PG8_LDB(B0, 1, 0); PG8_LDB(B1, 1, 1); PG8_SCHED; PG8_LDA(At, 1, 0); PG8_STAGE(PG8_SA(0, 1), a2 + hstep, voffA);
            PG8_WAIT_V(8); PG8_WAIT_L(0); PG8_BAR; PG8_MMA(0, 0, At, B0); PG8_MMA(0, 1, At, B1); PG8_BAR; PG8_SCHED;
            PG8_LDA(At, 1, 1); PG8_STAGE(PG8_SB(1, 0), b3, voffB); PG8_STAGE(PG8_SB(1, 1), b3 + hstep, voffB); PG8_STAGE(PG8_SA(1, 0), a3, voffA);
            PG8_WAIT_V(8); PG8_WAIT_L(0); PG8_BAR; PG8_MMA(1, 0, At, B0); PG8_MMA(1, 1, At, B1); PG8_BAR; PG8_SCHED;
            } else {
            PG8_LDB(B0, 0, 0); PG8_SCHED; PG8_LDA(At, 0, 0); PG8_STAGE(PG8_SA(1, 1), a1 + hstep, voffA);
            PG8_WAIT_L(8); PG8_BAR; PG8_WAIT_L(0); PG8_MMA(0, 0, At, B0); PG8_BAR; PG8_SCHED;
            PG8_LDB(B1, 0, 1); PG8_STAGE(PG8_SB(0, 0), b2, voffB);
            PG8_BAR; PG8_WAIT_L(0); PG8_MMA(0, 1, At, B1); PG8_BAR;
            PG8_LDA(At, 0, 1); PG8_STAGE(PG8_SA(0, 0), a2, voffA);
            PG8_BAR; PG8_WAIT_L(0); PG8_MMA(1, 0, At, B0); PG8_BAR; PG8_SCHED;
            PG8_STAGE(PG8_SB(0, 1), b2 + hstep, voffB);
            PG8_WAIT_V(6); PG8_BAR; PG8_MMA(1, 1, At, B1); PG8_BAR;
            PG8_LDB(B0, 1, 0); PG8_SCHED; PG8_LDA(At, 1, 0); PG8_STAGE(PG8_SA(0, 1), a2 + hstep, voffA);
            PG8_WAIT_L(8); PG8_BAR; PG8_WAIT_L(0); PG8_MMA(0, 0, At, B0); PG8_BAR; PG8_SCHED;
            PG8_LDB(B1, 1, 1); PG8_STAGE(PG8_SB(1, 0), b3, voffB);
            PG8_BAR; PG8_WAIT_L(0); PG8_MMA(0, 1, At, B1); PG8_BAR;
            PG8_LDA(At, 1, 1); PG8_STAGE(PG8_SA(1, 0), a3, voffA);
            PG8_BAR; PG8_WAIT_L(0); PG8_MMA(1, 0, At, B0); PG8_BAR; PG8_SCHED;
            PG8_STAGE(PG8_SB(1, 1), b3 + hstep, voffB);
            PG8_WAIT_V(6); PG8_BAR; PG8_MMA(1, 1, At, B1); PG8_BAR;
            }
        }
        if constexpr (ALIGN_EPI) { if (wr == 0) PG8_BAR; }
        if constexpr (!Epi::AFTER_DRAIN) { E(acc, cur, wr, wc, fr, fq); S.done(cur); }
        if (!has_next) break;
#pragma unroll
        for (int a = 0; a < 2; ++a)
#pragma unroll
            for (int b = 0; b < 2; ++b)
#pragma unroll
                for (int m = 0; m < 4; ++m)
#pragma unroll
                    for (int n = 0; n < 2; ++n) acc[a][b][m][n] = (f32x4){0.f, 0.f, 0.f, 0.f};
        cur = nxt; cA = nA; cB = nB; ++ui;
        if constexpr (ALIGN_EPI) { if (wr == 1) PG8_BAR; }
    }
    PG8_WAIT_V(0);
    if constexpr (!ALIGN_EPI) { if (wr == 0) PG8_BAR; }
    PG8_BAR;
    if constexpr (Epi::AFTER_DRAIN) { E.fused(acc, cur, wr, wc, fr, fq, lds, wid, lane); S.done(cur); }
#undef PG8_SA
#undef PG8_SB
#undef PG8_STAGE
#undef PG8_LDA
#undef PG8_LDB
#undef PG8_MMA
#undef PG8_WAIT_V
#undef PG8_WAIT_L
#undef PG8_BAR
#undef PG8_SCHED
}
}

#define GAS __attribute__((address_space(1)))
#define LAS __attribute__((address_space(3)))
typedef unsigned short bf16;
typedef float f32x4 __attribute__((ext_vector_type(4)));
typedef float f32x16 __attribute__((ext_vector_type(16)));
typedef short bf16x8 __attribute__((ext_vector_type(8)));
typedef short s16x4 __attribute__((ext_vector_type(4)));
typedef unsigned u32x4 __attribute__((ext_vector_type(4)));
typedef unsigned u32x2 __attribute__((ext_vector_type(2)));
typedef float f32x2_t __attribute__((ext_vector_type(2)));
typedef __bf16 bf16x2_t __attribute__((ext_vector_type(2)));
typedef GAS unsigned gu32;
#define RLX_AGENT __ATOMIC_RELAXED, __HIP_MEMORY_SCOPE_AGENT

constexpr int D = 1024, BP = 4, TP = 4096, MP = BP * TP, BS = 128, TS = 8, MS = BS * TS, M = MP + MS;
constexpr int SBH = 8, HD = 64, SBW = 512, DNH = 4, DND = 128, DNW = 512;
constexpr int IN_COLS = 3592, NPROJ = 3584;
constexpr int DFF = 2816, DFF2 = 5632, NMOD = 6144, NC = BP + BS;
constexpr int PAST = 2048, NPAGES = 16, PAGE = 128;
constexpr float EPS = 1e-6f, LOG2E = 1.4426950408889634f;
constexpr float QSCALE = 0.125f * LOG2E;
constexpr int NSPLIT = 4, NPART = 5;

constexpr size_t O_YP = 0, O_KP = 17825792, O_VP = 26214400, O_KS = 34603008, O_VS = 35127296, O_SP = 35651584, O_SS = 35913728,
                 O_DCP = 44302336, O_DCS = 44320768, O_FCP = 44910592, O_FCS = 44955648, O_END = 46397440;

constexpr size_t MiB = 1u << 20;
constexpr size_t WS_CTL = 0, CTL_ZERO_BYTES = 64 * 1024;
constexpr size_t WS_MOD = 1 * MiB, WS_SC = 5 * MiB, WS_WINX = 6 * MiB, WS_WIN_T = 7 * MiB, WS_WOUT_T = 14 * MiB, WS_WUP_T = 16 * MiB, WS_WDN_T = 27 * MiB,
                 WS_EXTRA = 33 * MiB, WS_H = 34 * MiB, WS_DNRAW = 68 * MiB, WS_ZG = 120 * MiB, WS_QB = 306 * MiB, WS_KB = 323 * MiB, WS_VB = 340 * MiB, WS_QD = 357 * MiB, WS_KD = 391 * MiB,
                 WS_VD = 425 * MiB, WS_BETA = 459 * MiB, WS_LOGA = 460 * MiB, WS_ODN = 461 * MiB, WS_MIXED = 495 * MiB, WS_X1 = 529 * MiB, WS_SIDEP = 597 * MiB, WS_SIDES = 610 * MiB,
                 WS_ACT = 784 * MiB, WS_U = 878 * MiB, WS_KCUM = 910 * MiB, WS_QDEC = 926 * MiB, WS_KDECT = 942 * MiB, WS_INTRA = 958 * MiB, WS_GL = 966 * MiB,
                 WS_OPART = 967 * MiB, WS_LPART = 978 * MiB, WS_SLAB = 980 * MiB, WS_END = 1024 * MiB;
constexpr int CW_Q0 = 1024;
constexpr int CW_QUEUE = 64;
constexpr int CW_BAR = 8192;

constexpr int RING_BYTES = 131072, MISC_OFF = RING_BYTES + 320, LDS_BYTES = 147456;

__device__ __forceinline__ unsigned cvtpk(float lo, float hi) { f32x2_t v = {lo, hi}; bf16x2_t b = __builtin_convertvector(v, bf16x2_t); return __builtin_bit_cast(unsigned, b); }
__device__ __forceinline__ bf16 f2bf(float f) { return (bf16)(cvtpk(f, 0.f) & 0xffffu); }
__device__ __forceinline__ float wave_sum(float v) {
#pragma unroll
    for (int o = 1; o < 64; o <<= 1) v += __shfl_xor(v, o);
    return v;
}
__device__ __forceinline__ float siluf(float x) { return x * __builtin_amdgcn_rcpf(1.f + __builtin_amdgcn_exp2f(-1.4426950408889634f * x)); }
__device__ __forceinline__ u32x4 pack8(const f32x4 a, const f32x4 b) { u32x4 w; w.x = cvtpk(a.x, a.y); w.y = cvtpk(a.z, a.w); w.z = cvtpk(b.x, b.y); w.w = cvtpk(b.z, b.w); return w; }
__device__ __forceinline__ f32x4 bf4lo(u32x4 w) { return (f32x4){__uint_as_float(w.x << 16), __uint_as_float(w.x & 0xffff0000u), __uint_as_float(w.y << 16), __uint_as_float(w.y & 0xffff0000u)}; }
__device__ __forceinline__ f32x4 bf4hi(u32x4 w) { return (f32x4){__uint_as_float(w.z << 16), __uint_as_float(w.z & 0xffff0000u), __uint_as_float(w.w << 16), __uint_as_float(w.w & 0xffff0000u)}; }
__device__ __forceinline__ float bf2f(unsigned short h) { return __uint_as_float((unsigned)h << 16); }

#define XB_TMO      128
#define XB_XCNT(j)  (256  + 64 * (j))
#define XB_XSUB(j)  (1280 + 64 * (j))
#define XB_XGEN(j)  (2304 + 64 * (j))
#define XB_TOP      3328
#define XB_TOPGEN   3392
#define XCD_BAR_WORDS 3456
#define XB_SPIN_CAP (1u << 18)
__device__ __forceinline__ unsigned xb_ld(unsigned* p)              { return __hip_atomic_load(p, __ATOMIC_RELAXED, __HIP_MEMORY_SCOPE_AGENT); }
__device__ __forceinline__ unsigned xb_add(unsigned* p, unsigned v) { return __hip_atomic_fetch_add(p, v, __ATOMIC_RELAXED, __HIP_MEMORY_SCOPE_AGENT); }
__device__ __forceinline__ unsigned xb_xcc_id() { return (unsigned)__builtin_amdgcn_s_getreg((3 << 11) | 20) & 0xFu; }
#define XB_SPIN(cond, bar) do { unsigned _sp = 0; while (cond) { __builtin_amdgcn_s_sleep(1); \
    if ((++_sp & 255u) == 0u) { if (xb_ld(&(bar)[XB_TMO])) break; if (_sp > XB_SPIN_CAP) { atomicAdd(&(bar)[XB_TMO], 1u); break; } } } } while (0)
struct XcdBarrier { unsigned* bar; unsigned x; volatile LAS unsigned* st; };
__device__ __forceinline__ XcdBarrier xcd_barrier_post(unsigned* bar, volatile LAS unsigned* st, int tid) {
    XcdBarrier b; b.bar = bar; b.x = xb_xcc_id(); b.st = st;
    if (tid == 0) (void)xb_add(&bar[XB_XCNT(b.x)], 1u);
    return b;
}
__device__ __forceinline__ void xcd_barrier_complete(unsigned* bar, unsigned x, unsigned& nloc, unsigned& nx) {
    const unsigned G = gridDim.x * gridDim.y * gridDim.z;
    unsigned sum, cnt, mine, sp = 0u;
    for (;;) {
        sum = 0u; cnt = 0u; mine = 0u;
#pragma unroll
        for (unsigned j = 0; j < 16; ++j) { const unsigned c = xb_ld(&bar[XB_XCNT(j)]); sum += c; cnt += (c > 0u) ? 1u : 0u; mine = (j == x) ? c : mine; }
        if (sum == G) break;
        __builtin_amdgcn_s_sleep(1);
        if ((++sp & 255u) == 0u) { if (xb_ld(&bar[XB_TMO])) break; if (sp > XB_SPIN_CAP) { atomicAdd(&bar[XB_TMO], 1u); break; } }
    }
    nloc = mine > 0u ? mine : 1u; nx = cnt > 0u ? cnt : 1u;
}
__device__ __forceinline__ void xcd_barrier(const XcdBarrier& b, int tid) {
    asm volatile("s_waitcnt vmcnt(0)" ::: "memory");
    __syncthreads();
    if (tid == 0) {
        unsigned* bar = b.bar;
        __builtin_amdgcn_s_waitcnt(0);
        unsigned nloc = b.st[0], nx = b.st[1];
        if (nloc == 0u) { xcd_barrier_complete(bar, b.x, nloc, nx); b.st[0] = nloc; b.st[1] = nx; }
        const unsigned old = xb_add(&bar[XB_XSUB(b.x)], 1u);
        const unsigned gen = old / nloc;
        if (old + 1u == (gen + 1u) * nloc) {
            __builtin_amdgcn_fence(__ATOMIC_RELEASE, "agent");
            asm volatile("s_waitcnt vmcnt(0)" ::: "memory");
            const unsigned og = xb_add(&bar[XB_TOP], 1u);
            const unsigned tg = og / nx;
            if (og + 1u == (tg + 1u) * nx) xb_add(&bar[XB_TOPGEN], 1u);
            else XB_SPIN(xb_ld(&bar[XB_TOPGEN]) == tg, bar);
            __builtin_amdgcn_fence(__ATOMIC_ACQUIRE, "agent");
            xb_add(&bar[XB_XGEN(b.x)], 1u);
            asm volatile("s_waitcnt vmcnt(0)" ::: "memory");
        } else {
            XB_SPIN(xb_ld(&bar[XB_XGEN(b.x)]) == gen, bar);
            __builtin_amdgcn_fence(__ATOMIC_ACQUIRE, "agent");
            asm volatile("s_waitcnt vmcnt(0)" ::: "memory");
        }
    }
    __syncthreads();
}

__device__ __forceinline__ int lane_now() { int l; asm volatile("v_mbcnt_lo_u32_b32 %0, -1, 0\n\tv_mbcnt_hi_u32_b32 %0, -1, %0" : "=v"(l)); return l; }
struct Args { const void* in[27]; float* out; unsigned char* ws; int lo, hi; };
enum { I_XP = 0, I_XS, I_CP, I_CS, I_CK, I_CV, I_PT, I_SD, I_SDC, I_SFC, I_WADA, I_BADA, I_GATT, I_WIN, I_GQ, I_GK, I_SBB, I_GSBO, I_WDNC, I_ALOG, I_DTB, I_GDNO, I_WOUT, I_GFFN, I_WUP, I_WFC, I_WDN };

__device__ __forceinline__ int mod_row(int m) { return m < MP ? (m >> 12) : BP + ((m - MP) >> 3); }

struct EpiF32 {
    static constexpr bool PERM = false, AFTER_DRAIN = false;
    float* O; int ldc;
    __device__ __forceinline__ void operator()(const pg8::f32x4 (&acc)[2][2][4][2], const pg8::Unit& u, int wr, int wc, int fr, int fq) const {
        const int row0 = u.pm * 256 + wr * 64 + fr, col0 = u.pn * 256 + wc * 32 + 4 * fq;
#pragma unroll
        for (int ai = 0; ai < 2; ++ai)
#pragma unroll
            for (int m = 0; m < 4; ++m) { float* rowp = O + (size_t)(row0 + ai * 128 + m * 16) * ldc + col0;
#pragma unroll
                for (int bj = 0; bj < 2; ++bj)
#pragma unroll
                    for (int n = 0; n < 2; ++n) *(pg8::f32x4*)(rowp + bj * 128 + n * 16) = acc[ai][bj][m][n]; }
    }
};
struct EpiResGate {
    static constexpr bool PERM = false, AFTER_DRAIN = false;
    const float* base0; const float* base1; const float* mod; int goff; float* out;
    __device__ __forceinline__ void operator()(const pg8::f32x4 (&acc)[2][2][4][2], const pg8::Unit& u, int wr, int wc, int fr, int fq) const {
        const int row0 = u.pm * 256 + wr * 64 + fr, col0 = u.pn * 256 + wc * 32 + 4 * fq;
#pragma unroll
        for (int ai = 0; ai < 2; ++ai)
#pragma unroll
            for (int m = 0; m < 4; ++m) { const int r = row0 + ai * 128 + m * 16;
                const float* bp = (r < MP ? base0 + (size_t)r * D : base1 + (size_t)(r - MP) * D) + col0;
                const float* gp = mod + (size_t)mod_row(r) * NMOD + goff + col0; float* op = out + (size_t)r * D + col0;
#pragma unroll
                for (int bj = 0; bj < 2; ++bj)
#pragma unroll
                    for (int n = 0; n < 2; ++n) { const pg8::f32x4 b = *(const pg8::f32x4*)(bp + bj * 128 + n * 16), g = *(const pg8::f32x4*)(gp + bj * 128 + n * 16);
                        *(pg8::f32x4*)(op + bj * 128 + n * 16) = b + g * acc[ai][bj][m][n]; } }
    }
};

template <bool BASE_H, bool OUT_H> struct EpiResGateH {
    static constexpr bool PERM = true, AFTER_DRAIN = false;
    const void* base0; const float* mod; int goff; void* out;
    __device__ __forceinline__ void operator()(const pg8::f32x4 (&acc)[2][2][4][2], const pg8::Unit& u, int wr, int wc, int fr, int fq) const {
        const int row0 = u.pm * 256 + wr * 64 + fr, col0 = u.pn * 256 + wc * 32 + 8 * fq;
#pragma unroll
        for (int ai = 0; ai < 2; ++ai)
#pragma unroll
            for (int m = 0; m < 4; ++m) { const int r = row0 + ai * 128 + m * 16;
                const float* gp = mod + (size_t)mod_row(r) * NMOD + goff + col0;
#pragma unroll
                for (int bj = 0; bj < 2; ++bj) {
                    f32x4 b0, b1;
                    if (BASE_H) { const u32x4 w = *(const u32x4*)((const bf16*)base0 + (size_t)r * D + col0 + bj * 128); b0 = bf4lo(w); b1 = bf4hi(w); }
                    else { const float* bp = (const float*)base0 + (size_t)r * D + col0 + bj * 128; b0 = *(const f32x4*)bp; b1 = *(const f32x4*)(bp + 4); }
                    const f32x4 g0 = *(const f32x4*)(gp + bj * 128), g1 = *(const f32x4*)(gp + bj * 128 + 4);
                    const f32x4 o0 = b0 + g0 * acc[ai][bj][m][0], o1 = b1 + g1 * acc[ai][bj][m][1];
                    if (OUT_H) *(u32x4*)((bf16*)out + (size_t)r * D + col0 + bj * 128) = pack8(o0, o1);
                    else { float* op = (float*)out + (size_t)r * D + col0 + bj * 128; *(f32x4*)op = o0; *(f32x4*)(op + 4) = o1; } } }
    }
};

#define DPP_F(old_, src_, ctrl_) __uint_as_float((unsigned)__builtin_amdgcn_update_dpp((int)__float_as_uint(old_), (int)__float_as_uint(src_), (ctrl_), 0xF, 0xF, false))
struct EpiUp {
    static constexpr bool PERM = true, AFTER_DRAIN = false;
    bf16* ACT; bf16* SIDEP; bf16* SIDES; const float* wf; float* out;
    __device__ __forceinline__ void operator()(const pg8::f32x4 (&acc)[2][2][4][2], const pg8::Unit& u, int wr, int wc, int fr, int fq) const {
        const bool prompt_tile = u.pm < MP / 256;
        const unsigned uc0 = (unsigned)(u.pn * 128 + wc * 32 + 8 * fq);
        const unsigned row0 = (unsigned)u.pm * 256u + (unsigned)(wr * 64 + fr);
        if (prompt_tile) {
#pragma unroll
            for (int ai = 0; ai < 2; ++ai) { const unsigned kb = (unsigned)u.pm * 4u + ai * 2 + wr;
                if (fr < 2) { bf16* sp = SIDEP + ((size_t)kb * 4 + fr) * DFF2 + uc0; *(u32x4*)sp = pack8(acc[ai][0][0][0], acc[ai][0][0][1]); *(u32x4*)(sp + DFF) = pack8(acc[ai][1][0][0], acc[ai][1][0][1]); }
                if (fr >= 14) { bf16* sp = SIDEP + ((size_t)kb * 4 + (fr - 12)) * DFF2 + uc0; *(u32x4*)sp = pack8(acc[ai][0][3][0], acc[ai][0][3][1]); *(u32x4*)(sp + DFF) = pack8(acc[ai][1][3][0], acc[ai][1][3][1]); } }
        } else {
            const int t = fr & 7;
#pragma unroll
            for (int ai = 0; ai < 2; ++ai)
#pragma unroll
                for (int m = 0; m < 4; ++m) { const unsigned seq = (row0 + ai * 128 + m * 16 - MP) >> 3;
                    if (t < 2) { bf16* sp = SIDES + ((size_t)seq * 2 + t) * DFF2 + uc0; *(u32x4*)sp = pack8(acc[ai][0][m][0], acc[ai][0][m][1]); *(u32x4*)(sp + DFF) = pack8(acc[ai][1][m][0], acc[ai][1][m][1]); }
                    if (t >= 6) { float* fo = out + O_FCS + ((size_t)seq * 2 + (t - 6)) * DFF2 + uc0;
                        *(pg8::f32x4*)fo = acc[ai][0][m][0]; *(pg8::f32x4*)(fo + 4) = acc[ai][0][m][1]; *(pg8::f32x4*)(fo + DFF) = acc[ai][1][m][0]; *(pg8::f32x4*)(fo + DFF + 4) = acc[ai][1][m][1]; } }
        }
        u32x2 half0[2][4];
#pragma unroll
        for (int n = 0; n < 2; ++n) {
            const float* wp = wf + uc0 + 4 * n;
            const pg8::f32x4 wu0 = *(const pg8::f32x4*)wp, wu1 = *(const pg8::f32x4*)(wp + DFF2), wu2 = *(const pg8::f32x4*)(wp + 2 * DFF2);
            const pg8::f32x4 wg0 = *(const pg8::f32x4*)(wp + DFF), wg1 = *(const pg8::f32x4*)(wp + DFF2 + DFF), wg2 = *(const pg8::f32x4*)(wp + 2 * DFF2 + DFF);
#pragma unroll
            for (int ai = 0; ai < 2; ++ai)
#pragma unroll
                for (int m = 0; m < 4; ++m) {
                    float a[4];
#pragma unroll
                    for (int c = 0; c < 4; ++c) {
                        const float cu = acc[ai][0][m][n][c], cg = acc[ai][1][m][n][c];
                        const float pu = m > 0 ? acc[ai][0][m - 1][n][c] : cu, pg = m > 0 ? acc[ai][1][m - 1][n][c] : cg;
                        const float u1 = DPP_F(DPP_F(0.f, pu, 0x121), cu, 0x111), u2 = DPP_F(DPP_F(0.f, pu, 0x122), cu, 0x112);
                        const float g1 = DPP_F(DPP_F(0.f, pg, 0x121), cg, 0x111), g2 = DPP_F(DPP_F(0.f, pg, 0x122), cg, 0x112);
                        const float yu = wu0[c] * u2 + wu1[c] * u1 + wu2[c] * cu, yg = wg0[c] * g2 + wg1[c] * g1 + wg2[c] * cg;
                        a[c] = siluf(yg) * yu;
                    }
                    u32x2 w; w.x = cvtpk(a[0], a[1]); w.y = cvtpk(a[2], a[3]);
                    if (n == 0) half0[ai][m] = w;
                    else *(u32x4*)(ACT + (size_t)(row0 + ai * 128 + m * 16) * DFF + uc0) = (u32x4){half0[ai][m].x, half0[ai][m].y, w.x, w.y};
                }
        }
    }
};

struct SplitKOrder {
    int nks, G, c;
    __device__ __forceinline__ bool next(int i, pg8::Unit& u) const { const int L = i * G + c; if (L >= 16 * nks) return false; const int su = L & 15, ks = L >> 4; u.pm = MP / 256 + (su >> 2); u.pn = su & 3; u.ko = ks * 256; return true; }
    __device__ __forceinline__ void a_ready(const pg8::Unit&) const {}
    __device__ __forceinline__ void done(const pg8::Unit&) const {}
};
struct EpiSlab {
    static constexpr bool PERM = false, AFTER_DRAIN = false;
    bf16* slab;
    __device__ __forceinline__ void operator()(const pg8::f32x4 (&acc)[2][2][4][2], const pg8::Unit& u, int wr, int wc, int fr, int fq) const {
        bf16* O = slab + (size_t)(u.ko >> 8) * ((size_t)MS * D);
        const int row0 = (u.pm - MP / 256) * 256 + wr * 64 + fr, col0 = u.pn * 256 + wc * 32 + 4 * fq;
#pragma unroll
        for (int ai = 0; ai < 2; ++ai)
#pragma unroll
            for (int m = 0; m < 4; ++m) { bf16* rowp = O + (size_t)(row0 + ai * 128 + m * 16) * D + col0;
#pragma unroll
                for (int bj = 0; bj < 2; ++bj)
#pragma unroll
                    for (int n = 0; n < 2; ++n) { const pg8::f32x4 a = acc[ai][bj][m][n]; *(u32x2*)(rowp + bj * 128 + n * 16) = (u32x2){cvtpk(a[0], a[1]), cvtpk(a[2], a[3])}; } }
    }
};
__device__ __forceinline__ void st16(void* base, unsigned off, u32x4 v) { *(u32x4*)((unsigned char*)base + off) = v; }
__device__ __forceinline__ void st16f(void* base, unsigned off, pg8::f32x4 v) { *(pg8::f32x4*)((unsigned char*)base + off) = v; }
struct EpiProj {
    static constexpr bool PERM = true, AFTER_DRAIN = false;
    float* out; bf16* QB; bf16* KB; bf16* VB; bf16* DNRAW; bf16* ZG; const float* g_q; const float* g_k; LAS float* xl;
    __device__ __forceinline__ void operator()(const pg8::f32x4 (&acc)[2][2][4][2], const pg8::Unit& u, int wr, int wc, int fr, int fq) const {
        const int pn = u.pn, rl0 = wr * 64 + fr, c0 = wc * 32 + 8 * fq;
        const unsigned row0 = (unsigned)u.pm * 256u + (unsigned)rl0;
        const bool prompt_tile = u.pm < MP / 256;
        if (pn < 4) {
            int xb = (rl0 * 8 + wc) * 4, xb2 = (rl0 * 8 + (wc ^ 1)) * 4; asm volatile("" : "+v"(xb), "+v"(xb2));
            LAS float* xw = (LAS float*)((LAS unsigned char*)xl + xb); const LAS float* xr = (const LAS float*)((LAS unsigned char*)xl + xb2);
#pragma unroll
            for (int ai = 0; ai < 2; ++ai)
#pragma unroll
                for (int m = 0; m < 4; ++m)
#pragma unroll
                    for (int bj = 0; bj < 2; ++bj) { const pg8::f32x4 a = acc[ai][bj][m][0], b = acc[ai][bj][m][1];
                        float ss = (a[0] * a[0] + a[1] * a[1]) + (a[2] * a[2] + a[3] * a[3]) + (b[0] * b[0] + b[1] * b[1]) + (b[2] * b[2] + b[3] * b[3]);
                        ss += __shfl_xor(ss, 16); ss += __shfl_xor(ss, 32);
                        if (fq == 0) xw[(ai * 128 + m * 16) * 8 + bj * 4] = ss; }
            asm volatile("s_waitcnt lgkmcnt(0)" ::: "memory"); __builtin_amdgcn_s_barrier(); asm volatile("" ::: "memory");
            const bool isq = pn < 2; const float* g = isq ? g_q : g_k; const int dloc = 32 * (wc & 1) + 8 * fq;
            const pg8::f32x4 g0 = *(const pg8::f32x4*)(g + dloc), g1 = *(const pg8::f32x4*)(g + dloc + 4);
            bf16* dstb = isq ? QB : KB; float* dstf = prompt_tile ? out + O_KP : out + O_KS - (size_t)MP * SBW;
#pragma unroll
            for (int ai = 0; ai < 2; ++ai)
#pragma unroll
                for (int m = 0; m < 4; ++m) { const unsigned row = row0 + ai * 128 + m * 16;
#pragma unroll
                    for (int bj = 0; bj < 2; ++bj) { const float tot = xw[(ai * 128 + m * 16) * 8 + bj * 4] + xr[(ai * 128 + m * 16) * 8 + bj * 4];
                        const float rs = (isq ? QSCALE : 1.0f) / sqrtf(tot * (1.f / HD) + EPS);
                        const pg8::f32x4 a = acc[ai][bj][m][0] * rs * g0, b = acc[ai][bj][m][1] * rs * g1;
                        const unsigned e = row * SBW + (unsigned)((pn & 1) * 256 + bj * 128 + c0);
                        st16(dstb, e * 2u, pack8(a, b));
                        if (!isq) { st16f(dstf, e * 4u, a); st16f(dstf, e * 4u + 16u, b); } }
                    asm volatile("" ::: "memory"); }
            asm volatile("s_waitcnt lgkmcnt(0)" ::: "memory"); __builtin_amdgcn_s_barrier(); asm volatile("" ::: "memory");
        } else if (pn < 6) {
            float* dstf = prompt_tile ? out + O_VP : out + O_VS - (size_t)MP * SBW;
#pragma unroll
            for (int ai = 0; ai < 2; ++ai)
#pragma unroll
                for (int m = 0; m < 4; ++m) { const unsigned row = row0 + ai * 128 + m * 16;
#pragma unroll
                    for (int bj = 0; bj < 2; ++bj) { const pg8::f32x4 a = acc[ai][bj][m][0], b = acc[ai][bj][m][1]; const unsigned e = row * SBW + (unsigned)((pn & 1) * 256 + bj * 128 + c0);
                        st16(VB, e * 2u, pack8(a, b)); st16f(dstf, e * 4u, a); st16f(dstf, e * 4u + 16u, b); }
                    asm volatile("" ::: "memory"); }
        } else if (pn < 12) {
#pragma unroll
            for (int ai = 0; ai < 2; ++ai)
#pragma unroll
                for (int m = 0; m < 4; ++m) { const unsigned row = row0 + ai * 128 + m * 16;
                    const int b = prompt_tile ? (int)(row >> 12) : (int)((row - MP) >> 3), t = prompt_tile ? (int)(row & 4095) : (int)((row - MP) & 7), idx = prompt_tile ? t - (TP - 3) : t - (TS - 3);
#pragma unroll
                    for (int bj = 0; bj < 2; ++bj) { const pg8::f32x4 a = acc[ai][bj][m][0], b2 = acc[ai][bj][m][1]; const unsigned ch = (unsigned)((pn - 6) * 256 + bj * 128 + c0);
                        st16(DNRAW, (row * 1536u + ch) * 2u, pack8(a, b2));
                        if (idx >= 0) { float* o = prompt_tile ? out + O_DCP : out + O_DCS; const unsigned eo = ((unsigned)(b * 3 + idx) * 1536u + ch) * 4u; st16f(o, eo, a); st16f(o, eo + 16u, b2); } }
                    asm volatile("" ::: "memory"); }
        } else {
#pragma unroll
            for (int ai = 0; ai < 2; ++ai)
#pragma unroll
                for (int m = 0; m < 4; ++m) { const unsigned row = row0 + ai * 128 + m * 16;
#pragma unroll
                    for (int bj = 0; bj < 2; ++bj) { pg8::f32x4 a = acc[ai][bj][m][0], b = acc[ai][bj][m][1]; const unsigned e = row * DNW + (unsigned)((pn - 12) * 256 + bj * 128 + c0);
                        a[0] = siluf(a[0]); a[1] = siluf(a[1]); a[2] = siluf(a[2]); a[3] = siluf(a[3]); b[0] = siluf(b[0]); b[1] = siluf(b[1]); b[2] = siluf(b[2]); b[3] = siluf(b[3]);
                        st16(ZG, e * 2u, pack8(a, b)); }
                    asm volatile("" ::: "memory"); }
        }
    }
};

template <int NT>
__device__ __forceinline__ void mod_tile(const Args& A, LAS unsigned char* lds, int ct, int ct2, int wave, int lane) {
    const float* w_ada = (const float*)A.in[I_WADA]; const float* b_ada = (const float*)A.in[I_BADA];
    const float* cp = (const float*)A.in[I_CP]; const float* cs = (const float*)A.in[I_CS]; float* MOD = (float*)(A.ws + WS_MOD);
    const int lr = lane & 15, q = lane >> 4;
    pg8::f32x4 acc[NT][9];
#pragma unroll
    for (int t = 0; t < NT; ++t)
#pragma unroll
        for (int i = 0; i < 9; ++i) acc[t][i] = (pg8::f32x4){0.f, 0.f, 0.f, 0.f};
#pragma unroll
    for (int s4 = 0; s4 < 4; ++s4) {
        const int k0 = 128 * wave + 32 * s4 + 8 * q;
        bf16x8 bfr[NT];
#pragma unroll
        for (int t = 0; t < NT; ++t) { const float* wp = w_ada + (size_t)k0 * NMOD + (t == 0 ? ct : ct2) * 16 + lr;
            float w[8];
#pragma unroll
            for (int j = 0; j < 8; ++j) w[j] = wp[(size_t)j * NMOD];
            u32x4 bw; bw.x = cvtpk(w[0], w[1]); bw.y = cvtpk(w[2], w[3]); bw.z = cvtpk(w[4], w[5]); bw.w = cvtpk(w[6], w[7]);
            bfr[t] = __builtin_bit_cast(bf16x8, bw); }
#pragma unroll
        for (int i = 0; i < 9; ++i) { const int row = 16 * i + lr;
            f32x4 c0 = (f32x4){0.f, 0.f, 0.f, 0.f}, c1 = c0;
            if (row < NC) { const float* crow_ = (row < BP ? cp + (size_t)row * D : cs + (size_t)(row - BP) * D) + k0; c0 = *(const f32x4*)crow_; c1 = *(const f32x4*)(crow_ + 4); }
            c0.x = siluf(c0.x); c0.y = siluf(c0.y); c0.z = siluf(c0.z); c0.w = siluf(c0.w); c1.x = siluf(c1.x); c1.y = siluf(c1.y); c1.z = siluf(c1.z); c1.w = siluf(c1.w);
            const bf16x8 afr = __builtin_bit_cast(bf16x8, pack8(c0, c1));
#pragma unroll
            for (int t = 0; t < NT; ++t) acc[t][i] = __builtin_amdgcn_mfma_f32_16x16x32_bf16(afr, bfr[t], acc[t][i], 0, 0, 0); }
    }
    LAS pg8::f32x4* red = (LAS pg8::f32x4*)lds;
#pragma unroll
    for (int t = 0; t < NT; ++t) {
        const int col = (t == 0 ? ct : ct2) * 16 + lr;
#pragma unroll
        for (int i = 0; i < 9; ++i) red[(wave * 9 + i) * 64 + lane] = acc[t][i];
        __syncthreads();
        for (int i = wave; i < 9; i += 8) {
            pg8::f32x4 tt = red[i * 64 + lane];
#pragma unroll
            for (int w2 = 1; w2 < 8; ++w2) tt += red[(w2 * 9 + i) * 64 + lane];
            const float bb = b_ada[col];
#pragma unroll
            for (int r = 0; r < 4; ++r) { const int row = 16 * i + 4 * q + r; if (row < NC) MOD[(size_t)row * NMOD + col] = tt[r] + bb; }
        }
        __syncthreads();
    }
}
__device__ __forceinline__ void transpose_item(const float* W, int ldw, int src_col0, bf16* WT, int Kdst, int dst_row0, int k0, LAS float* scr, int lane) {
#pragma unroll
    for (int h2 = 0; h2 < 2; ++h2) { float v[16];
#pragma unroll
        for (int i = 0; i < 16; ++i) v[i] = W[(size_t)(k0 + 2 * (16 * h2 + i) + (lane >> 5)) * ldw + src_col0 + (lane & 31)];
#pragma unroll
        for (int i = 0; i < 16; ++i) scr[(2 * (16 * h2 + i) + (lane >> 5)) * 33 + (lane & 31)] = v[i]; }
    asm volatile("s_waitcnt lgkmcnt(0)" ::: "memory");
    const int c = lane & 7;
#pragma unroll
    for (int j = 0; j < 4; ++j) { const int n = (lane >> 3) + 8 * j; const LAS float* s = scr + (8 * c) * 33 + n;
        u32x4 o; o.x = cvtpk(s[0 * 33], s[1 * 33]); o.y = cvtpk(s[2 * 33], s[3 * 33]); o.z = cvtpk(s[4 * 33], s[5 * 33]); o.w = cvtpk(s[6 * 33], s[7 * 33]);
        *(u32x4*)(WT + (size_t)(dst_row0 + n) * Kdst + k0 + 8 * c) = o; }
    asm volatile("s_waitcnt lgkmcnt(0)" ::: "memory");
}
__device__ __forceinline__ void phase_prologue(const Args& A, LAS unsigned char* lds, gu32* qhead, int bx, int G, int wave, int lane, int gtid, int NGT) {
    unsigned char* ws = A.ws;
    const float* w_in = (const float*)A.in[I_WIN]; const float* w_out = (const float*)A.in[I_WOUT]; const float* w_up = (const float*)A.in[I_WUP]; const float* w_dn = (const float*)A.in[I_WDN];
    float* WX = (float*)(ws + WS_WINX);
    for (int i = gtid; i < 8 * D; i += NGT) { const int j = i >> 10, k = i & 1023; WX[i] = w_in[(size_t)k * IN_COLS + 3072 + j]; }
    { const int vcu = (G % 8 == 0) ? (bx % 8) * (G / 8) + bx / 8 : bx;
      int ct = vcu;
      for (; ct + G < NMOD / 16; ct += 2 * G) mod_tile<2>(A, lds, ct, ct + G, wave, lane);
      if (ct < NMOD / 16) mod_tile<1>(A, lds, ct, ct, wave, lane); }
    LAS float* scr = (LAS float*)(lds + wave * 16384);
    constexpr int I_IN = 16 * (NPROJ / 32), I_OUT = 16 * 32, I_UP = 16 * (DFF2 / 32), I_DN = (DFF / 64) * 32, NIT = I_IN + I_OUT + I_UP + I_DN;
    const int vcu2 = (G % 8 == 0) ? (bx % 8) * (G / 8) + bx / 8 : bx; const int nfirst = 2 * G * 8 < NIT ? 2 * G * 8 : NIT;
    const bool special = (G < NMOD / 16) && (2 * G > NMOD / 16), light = vcu2 >= NMOD / 16 - G; const int nlw = (2 * G - NMOD / 16) * 8;
    const int lw = (vcu2 - (NMOD / 16 - G)) * 8 + wave;
    for (int k_ = 0;; ++k_) {
        int it_;
        if (k_ < 2) { it_ = (bx * 8 + wave) + k_ * G * 8; if (it_ >= nfirst) continue; }
        else if (!special) { it_ = nfirst + (bx * 8 + wave) + (k_ - 2) * G * 8; if (it_ >= NIT) break; }
        else { if (!light) break; it_ = nfirst + lw + (k_ - 2) * nlw; if (it_ >= NIT) break; }
        int r = it_;
        if (r < I_IN) { const int nb = r % (NPROJ / 32), kb = r / (NPROJ / 32); const int n0 = nb * 32; transpose_item(w_in, IN_COLS, n0 < 3072 ? n0 : n0 + 8, (bf16*)(ws + WS_WIN_T), D, n0, kb * 64, scr, lane); continue; } r -= I_IN;
        if (r < I_OUT) { const int nb = r % 32, kb = r / 32; transpose_item(w_out, D, nb * 32, (bf16*)(ws + WS_WOUT_T), D, nb * 32, kb * 64, scr, lane); continue; } r -= I_OUT;
        if (r < I_UP) { const int nb = r % (DFF2 / 32), kb = r / (DFF2 / 32), n0 = nb * 32;
            const int dr = n0 < DFF ? (n0 >> 7) * 256 + (n0 & 127) : ((n0 - DFF) >> 7) * 256 + 128 + ((n0 - DFF) & 127);
            transpose_item(w_up, DFF2, n0, (bf16*)(ws + WS_WUP_T), D, dr, kb * 64, scr, lane); continue; } r -= I_UP;
        { const int nb = r % 32, kb = r / 32; transpose_item(w_dn, D, nb * 32, (bf16*)(ws + WS_WDN_T), DFF, nb * 32, kb * 64, scr, lane); }
    }
}

template <bool EXTRAS, int NS = 0, bool X0H = false>
__device__ __forceinline__ void phase_norm(const float* x0, const float* x1, const float* g, const float* MOD, int sh_off, int sc_off, bf16* H, const float* WX, float* EXTRA, int gw, int NGW, int lane, const float* slab = nullptr, int gate_off = 0, float* x1w = nullptr) {
    f32x4 wxr[4][8];
    if (EXTRAS) {
#pragma unroll
        for (int j = 0; j < 4; ++j)
#pragma unroll
            for (int e = 0; e < 8; ++e) wxr[j][e] = *(const f32x4*)(WX + e * D + 4 * (lane + 64 * j));
    }
    f32x4 nv[4]; u32x2 nh[4];
#define NORM_LOADX(mm_) do { if (X0H && (mm_) < MP) { const bf16* xh_ = (const bf16*)x0 + (size_t)(mm_) * D; _Pragma("unroll") for (int j = 0; j < 4; ++j) nh[j] = *(const u32x2*)(xh_ + 4 * (lane + 64 * j)); } \
        else { const float* xr_ = (mm_) < MP ? x0 + (size_t)(mm_) * D : x1 + (size_t)((mm_) - MP) * D; _Pragma("unroll") for (int j = 0; j < 4; ++j) nv[j] = *(const f32x4*)(xr_ + 4 * (lane + 64 * j)); } } while (0)
#define RMAP(i_) ((i_) < MS ? MP + (i_) : (i_) - MS)
    if (gw < M) NORM_LOADX(RMAP(gw));
    f32x4 ggv[4];
#pragma unroll
    for (int j = 0; j < 4; ++j) ggv[j] = *(const f32x4*)(g + 4 * (lane + 64 * j));
    for (int idx = gw; idx < M; idx += NGW) {
        const int m = RMAP(idx);
        const float* mod = MOD + (size_t)mod_row(m) * NMOD;
        f32x4 scv[4], shv[4];
#pragma unroll
        for (int j = 0; j < 4; ++j) { scv[j] = *(const f32x4*)(mod + sc_off + 4 * (lane + 64 * j)); shv[j] = *(const f32x4*)(mod + sh_off + 4 * (lane + 64 * j)); }
        asm volatile("" ::: "memory");
        f32x4 v[4]; float ss = 0.f;
        if (X0H && m < MP) {
#pragma unroll
            for (int j = 0; j < 4; ++j) v[j] = (f32x4){__uint_as_float(nh[j].x << 16), __uint_as_float(nh[j].x & 0xffff0000u), __uint_as_float(nh[j].y << 16), __uint_as_float(nh[j].y & 0xffff0000u)};
        } else {
#pragma unroll
            for (int j = 0; j < 4; ++j) v[j] = nv[j];
        }
        { const int in_ = idx + NGW; if (in_ < M) NORM_LOADX(RMAP(in_)); }
#pragma unroll
        for (int j = 0; j < 4; ++j) {
            if (NS > 0 && m >= MP) { f32x4 a = (f32x4){0.f, 0.f, 0.f, 0.f};
#pragma unroll
                for (int k = 0; k < NS; ++k) { const u32x2 sw = *(const u32x2*)((const bf16*)slab + ((size_t)k * MS + (m - MP)) * D + 4 * (lane + 64 * j)); a += (f32x4){__uint_as_float(sw.x << 16), __uint_as_float(sw.x & 0xffff0000u), __uint_as_float(sw.y << 16), __uint_as_float(sw.y & 0xffff0000u)}; }
                v[j] += *(const f32x4*)(mod + gate_off + 4 * (lane + 64 * j)) * a;
                *(f32x4*)(x1w + (size_t)m * D + 4 * (lane + 64 * j)) = v[j]; }
            ss += (v[j].x * v[j].x + v[j].y * v[j].y) + (v[j].z * v[j].z + v[j].w * v[j].w); }
        ss = wave_sum(ss);
        const float rstd = 1.0f / sqrtf(ss * (1.f / D) + EPS);
        float ex[8];
#pragma unroll
        for (int e = 0; e < 8; ++e) ex[e] = 0.f;
#pragma unroll
        for (int j = 0; j < 4; ++j) { const int c = 4 * (lane + 64 * j);
            const f32x4 gg = ggv[j], sc = scv[j], sh = shv[j];
            const f32x4 h = (v[j] * rstd) * gg * (sc + 1.0f) + sh;
            u32x2 w; w.x = cvtpk(h.x, h.y); w.y = cvtpk(h.z, h.w); *(u32x2*)(H + (size_t)m * D + c) = w;
            if (EXTRAS) {
#pragma unroll
                for (int e = 0; e < 8; ++e) { const f32x4 wx = wxr[j][e]; ex[e] += (h.x * wx.x + h.y * wx.y) + (h.z * wx.z + h.w * wx.w); }
            }
        }
        if (EXTRAS) {
            float a4[4], a2[2], a1;
#pragma unroll
            for (int j = 0; j < 4; ++j) { const bool up = lane & 1; const float send = up ? ex[j] : ex[j + 4], keep = up ? ex[j + 4] : ex[j]; a4[j] = keep + __shfl_xor(send, 1); }
#pragma unroll
            for (int j = 0; j < 2; ++j) { const bool up = lane & 2; const float send = up ? a4[j] : a4[j + 2], keep = up ? a4[j + 2] : a4[j]; a2[j] = keep + __shfl_xor(send, 2); }
            { const bool up = lane & 4; const float send = up ? a2[0] : a2[1], keep = up ? a2[1] : a2[0]; a1 = keep + __shfl_xor(send, 4); }
            a1 += __shfl_xor(a1, 8); a1 += __shfl_xor(a1, 16); a1 += __shfl_xor(a1, 32);
            if (lane < 8) EXTRA[(size_t)m * 8 + (4 * (lane & 1) + 2 * ((lane >> 1) & 1) + ((lane >> 2) & 1))] = a1;
        }
    }
}

template <int R> __device__ __forceinline__ void post_strip(const Args& A, int m0, int part, int lane) {
    unsigned char* ws = A.ws; const bf16* DNRAW = (const bf16*)(ws + WS_DNRAW);
    const float* wc = (const float*)A.in[I_WDNC]; const float* sdc = (const float*)A.in[I_SDC];
    bf16* dstb = (part == 0 ? (bf16*)(ws + WS_QD) : part == 1 ? (bf16*)(ws + WS_KD) : (bf16*)(ws + WS_VD));
    const bool prompt = m0 < MP; const int b = prompt ? (m0 >> 12) : ((m0 - MP) >> 3), t0 = prompt ? (m0 & 4095) : ((m0 - MP) & 7);
    const int ch = part * 512 + 8 * lane;
    f32x4 w[4][2];
#pragma unroll
    for (int i = 0; i < 4; ++i) { w[i][0] = *(const f32x4*)(wc + i * 1536 + ch); w[i][1] = *(const f32x4*)(wc + i * 1536 + ch + 4); }
    f32x4 x[3][2];
#pragma unroll
    for (int j = 0; j < 3; ++j) { const int tt = t0 - 3 + j;
        if (tt >= 0) { const u32x4 r = *(const u32x4*)(DNRAW + (size_t)(m0 - 3 + j) * 1536 + ch); x[j][0] = bf4lo(r); x[j][1] = bf4hi(r); }
        else if (!prompt) { const float* p = sdc + ((size_t)b * 3 + (3 + tt)) * 1536 + ch; x[j][0] = *(const f32x4*)p; x[j][1] = *(const f32x4*)(p + 4); }
        else { x[j][0] = (f32x4){0.f, 0.f, 0.f, 0.f}; x[j][1] = x[j][0]; } }
    const bf16* src = DNRAW + (size_t)m0 * 1536 + ch;
    u32x4 rows[R];
#pragma unroll
    for (int r = 0; r < R; ++r) rows[r] = *(const u32x4*)(src + (size_t)r * 1536);
#pragma unroll
    for (int r = 0; r < R; ++r) {
        const u32x4 cw = rows[r];
        const f32x4 c0 = bf4lo(cw), c1 = bf4hi(cw);
        f32x4 y0 = w[0][0] * x[0][0] + w[1][0] * x[1][0] + w[2][0] * x[2][0] + w[3][0] * c0;
        f32x4 y1 = w[0][1] * x[0][1] + w[1][1] * x[1][1] + w[2][1] * x[2][1] + w[3][1] * c1;
        x[0][0] = x[1][0]; x[0][1] = x[1][1]; x[1][0] = x[2][0]; x[1][1] = x[2][1]; x[2][0] = c0; x[2][1] = c1;
        y0.x = siluf(y0.x); y0.y = siluf(y0.y); y0.z = siluf(y0.z); y0.w = siluf(y0.w); y1.x = siluf(y1.x); y1.y = siluf(y1.y); y1.z = siluf(y1.z); y1.w = siluf(y1.w);
        if (part < 2) {
            float ss = (y0.x * y0.x + y0.y * y0.y) + (y0.z * y0.z + y0.w * y0.w) + (y1.x * y1.x + y1.y * y1.y) + (y1.z * y1.z + y1.w * y1.w);
            ss += __shfl_xor(ss, 1); ss += __shfl_xor(ss, 2); ss += __shfl_xor(ss, 4); ss += __shfl_xor(ss, 8);
            const float rs = (part == 0 ? 0.08838834764831845f : 1.0f) / sqrtf(ss + EPS);
            y0 = y0 * rs; y1 = y1 * rs;
        }
        *(u32x4*)(dstb + (size_t)(m0 + r) * DNW + 8 * lane) = pack8(y0, y1);
    }
}
__device__ __forceinline__ void phase_post(const Args& A, int gw, int NGW, int lane, int gtid, int NGT) {
    constexpr int NPI = (MP / 16) * 3, NSI = BS * 3;
    for (int it = gw; it < NPI + NSI; it += NGW) {
        if (it < NPI) post_strip<16>(A, (it / 3) * 16, it % 3, lane);
        else { const int j = it - NPI; post_strip<8>(A, MP + (j / 3) * 8, j % 3, lane); }
    }
    unsigned char* ws = A.ws; const float* a_log = (const float*)A.in[I_ALOG]; const float* dtb = (const float*)A.in[I_DTB];
    float* BETA = (float*)(ws + WS_BETA); float* LOGA = (float*)(ws + WS_LOGA); const float* EXTRA = (const float*)(ws + WS_EXTRA);
    for (int i = gtid; i < M * 8; i += NGT) { const int m = i >> 3, j = i & 7; const float x = EXTRA[i];
        if (j < 4) BETA[m * 4 + j] = 1.f / (1.f + __expf(-x));
        else { const int h = j - 4; const float z = x + dtb[h]; const float sp = fmaxf(z, 0.f) + log1pf(__expf(-fabsf(z))); LOGA[m * 4 + h] = -__expf(a_log[h]) * sp; } }
}

template <int B0, int B1> __device__ __forceinline__ void subst_rows(float (&x)[64], const LAS float* Am) {
#pragma unroll
    for (int ib = B0; ib < B1; ++ib) {
        float r[4];
#pragma unroll
        for (int rr = 0; rr < 4; ++rr) r[rr] = x[4 * ib + rr];
#pragma unroll
        for (int j4 = 0; j4 < ib; ++j4) {
#pragma unroll
            for (int rr = 0; rr < 4; ++rr) { const f32x4 a = *(const LAS f32x4*)(Am + (4 * ib + rr) * 64 + 4 * j4);
                r[rr] -= (a.x * x[4 * j4] + a.y * x[4 * j4 + 1]) + (a.z * x[4 * j4 + 2] + a.w * x[4 * j4 + 3]); }
        }
        const f32x4 d1 = *(const LAS f32x4*)(Am + (4 * ib + 1) * 64 + 4 * ib), d2 = *(const LAS f32x4*)(Am + (4 * ib + 2) * 64 + 4 * ib), d3 = *(const LAS f32x4*)(Am + (4 * ib + 3) * 64 + 4 * ib);
        r[1] -= d1.x * r[0];
        r[2] -= d2.x * r[0] + d2.y * r[1];
        r[3] -= (d3.x * r[0] + d3.y * r[1]) + d3.z * r[2];
#pragma unroll
        for (int rr = 0; rr < 4; ++rr) x[4 * ib + rr] = r[rr];
    }
}
constexpr int PS_INT = 34816, PS_STG = 53248;
template <int LEVEL = 0>
__device__ __forceinline__ void dn_prescan_unit(const Args& A, LAS unsigned char* lds, int unit, int tid, int wave, int lane) {
    unsigned char* ws = A.ws;
    const bf16* QD = (const bf16*)(ws + WS_QD); const bf16* KD = (const bf16*)(ws + WS_KD); const bf16* VD = (const bf16*)(ws + WS_VD);
    const float* BETA = (const float*)(ws + WS_BETA); const float* LOGA = (const float*)(ws + WS_LOGA);
    const int hp = unit & 1, n = (unit >> 1) & 63, b = unit >> 7;
    const int half = tid >> 8, ht = tid & 255, h = 2 * hp + half, item = (b * 64 + n) * 4 + h;
    const int m0 = b * TP + n * 64;
    LAS float* Am = (LAS float*)lds + half * 4096;
    LAS float* gs = (LAS float*)(lds + 32768) + half * 128;
    if (ht < 64) {
        float v = LOGA[(size_t)(m0 + ht) * 4 + h];
#pragma unroll
        for (int o = 1; o < 64; o <<= 1) { const float u = __shfl_up(v, o); if (ht >= o) v += u; }
        gs[ht] = v; gs[64 + ht] = BETA[(size_t)(m0 + ht) * 4 + h];
    }
    __syncthreads();
    {
        const int wl = wave & 3, lr = lane & 15, q = lane >> 4;
        pg8::f32x4 kk[4], qk[4];
#pragma unroll
        for (int j = 0; j < 4; ++j) { kk[j] = (pg8::f32x4){0.f, 0.f, 0.f, 0.f}; qk[j] = kk[j]; }
#pragma unroll
        for (int s = 0; s < 4; ++s) {
            const bf16x8 ak = *(const bf16x8*)(KD + (size_t)(m0 + 16 * wl + lr) * DNW + h * 128 + 32 * s + 8 * q), aq = *(const bf16x8*)(QD + (size_t)(m0 + 16 * wl + lr) * DNW + h * 128 + 32 * s + 8 * q);
#pragma unroll
            for (int j = 0; j < 4; ++j) { const bf16x8 bk = *(const bf16x8*)(KD + (size_t)(m0 + 16 * j + lr) * DNW + h * 128 + 32 * s + 8 * q);
                kk[j] = __builtin_amdgcn_mfma_f32_16x16x32_bf16(ak, bk, kk[j], 0, 0, 0); qk[j] = __builtin_amdgcn_mfma_f32_16x16x32_bf16(aq, bk, qk[j], 0, 0, 0); }
        }
#pragma unroll
        for (int j = 0; j < 4; ++j)
#pragma unroll
            for (int r = 0; r < 4; ++r) { const int i = 16 * wl + 4 * q + r, jj = 16 * j + lr;
                const float dec = (i >= jj) ? __expf(gs[i] - gs[jj]) : 0.f;
                Am[i * 64 + jj] = (i > jj) ? gs[64 + i] * kk[j][r] * dec : 0.f;
                *(LAS bf16*)(lds + PS_INT + half * 9216 + i * 144 + jj * 2) = f2bf(qk[j][r] * dec); }
    }
    __syncthreads();
    if constexpr (LEVEL == 1) { __syncthreads(); return; }
    {
        const int c = ht;
        float* U = (float*)(ws + WS_U) + (size_t)item * 8192; bf16* KC = (bf16*)(ws + WS_KCUM) + (size_t)item * 8192;
        float x[64];
        { const bf16* rsrc = (ht < 128 ? VD : KD) + (size_t)m0 * DNW + h * 128 + (ht & 127);
#pragma unroll
          for (int i = 0; i < 64; ++i) x[i] = bf2f(rsrc[(size_t)i * DNW]); }
#pragma unroll
        for (int i = 0; i < 64; ++i) { const float eg = __expf(gs[i]); x[i] *= gs[64 + i] * (c >= 128 ? eg : 1.0f); }
        { bf16* INTRA = (bf16*)(ws + WS_INTRA) + (size_t)item * 4096;
#pragma unroll
          for (int j = 0; j < 2; ++j) { const int k = ht + 256 * j, row = k >> 3, c8 = (k & 7) * 8; *(u32x4*)(INTRA + row * 64 + c8) = *(const LAS u32x4*)(lds + PS_INT + half * 9216 + row * 144 + c8 * 2); } }
        subst_rows<0, 6>(x, Am); subst_rows<6, 10>(x, Am); subst_rows<10, 13>(x, Am); subst_rows<13, 16>(x, Am);
        if constexpr (LEVEL == 2) { float sk = 0.f; _Pragma("unroll") for (int i = 0; i < 64; ++i) sk += x[i]; asm volatile("" :: "v"(sk)); __syncthreads(); return; }
        LAS float* stg = (LAS float*)(lds + PS_STG + half * 33280);
#pragma unroll
        for (int ps = 0; ps < 2; ++ps) {
            if (ps) __syncthreads();
#pragma unroll
            for (int i = 0; i < 32; ++i) stg[i * 260 + c] = x[32 * ps + i];
            __syncthreads();
#pragma unroll
            for (int j = 0; j < 4; ++j) { const int k = ht + 256 * j, il = k >> 9, w_ = (k >> 6) & 7, ln = k & 63, rb = 16 * il + 4 * (ln >> 4), cc = 16 * w_ + (ln & 15);
                *(f32x4*)(U + (((2 * ps + il) * 8 + w_) * 64 + ln) * 4) = (f32x4){stg[rb * 260 + cc], stg[(rb + 1) * 260 + cc], stg[(rb + 2) * 260 + cc], stg[(rb + 3) * 260 + cc]}; }
#pragma unroll
            for (int j = 0; j < 2; ++j) { const int k = ht + 256 * j, row = k >> 4, c8 = (k & 15) * 8; const LAS float* sp = stg + row * 260 + 128 + c8;
                *(u32x4*)(KC + (32 * ps + row) * 128 + c8) = pack8(*(const LAS f32x4*)sp, *(const LAS f32x4*)(sp + 4)); }
        }
    }
    if constexpr (LEVEL == 3) { __syncthreads(); return; }
    {
        const float glast = gs[63];
        bf16* QDc = (bf16*)(ws + WS_QDEC) + (size_t)item * 8192; bf16* KT = (bf16*)(ws + WS_KDECT) + (size_t)item * 8192;
#pragma unroll
        for (int j = 0; j < 4; ++j) { const int k = ht + 256 * j, row = k >> 4, c8 = (k & 15) * 8; const u32x4 qw = *(const u32x4*)(QD + (size_t)(m0 + row) * DNW + h * 128 + c8); const float eg = __expf(gs[row]);
            *(u32x4*)(QDc + row * 128 + c8) = pack8(bf4lo(qw) * eg, bf4hi(qw) * eg); }
        { const int d = ht & 127, ig = ht >> 7;
#pragma unroll
            for (int i8 = 0; i8 < 4; ++i8) { float v[8];
#pragma unroll
                for (int k = 0; k < 8; ++k) { const int i = 32 * ig + 8 * i8 + k; v[k] = bf2f(KD[(size_t)(m0 + i) * DNW + h * 128 + d]) * __expf(glast - gs[i]); }
                u32x4 w; w.x = cvtpk(v[0], v[1]); w.y = cvtpk(v[2], v[3]); w.z = cvtpk(v[4], v[5]); w.w = cvtpk(v[6], v[7]);
                *(u32x4*)(KT + d * 64 + 32 * ig + 8 * i8) = w; } }
        if (ht == 0) ((float*)(ws + WS_GL))[item] = __expf(glast);
    }
    __syncthreads();
}
template <int NU>
__device__ __forceinline__ void dn_sample_units(const Args& A, LAS unsigned char* lds, int unit0, int ustride, int tid) {
    unsigned char* ws = A.ws;
    const bf16* QD = (const bf16*)(ws + WS_QD);
    const float* BETA = (const float*)(ws + WS_BETA); const float* LOGA = (const float*)(ws + WS_LOGA); float* ODN = (float*)(ws + WS_ODN);
    const int e = tid & 127, dq = tid >> 7; const unsigned loff = (unsigned)(32 * dq * 128 + e);
    float S[NU][32];
#pragma unroll
    for (int u = 0; u < NU; ++u) { const int unit = unit0 + u * ustride, h = unit & 3, b = unit >> 2;
        const float* s0 = (const float*)A.in[I_SD] + (size_t)(b * 4 + h) * 16384;
#pragma unroll
        for (int d = 0; d < 32; ++d) S[u][d] = s0[loff + (unsigned)(d * 128)]; }
    constexpr int UF = 4112;
#pragma unroll
    for (int u = 0; u < NU; ++u) { const int unit = unit0 + u * ustride, h = unit & 3, b = unit >> 2; LAS float* tk = (LAS float*)lds + u * UF + 1024;
#pragma unroll
        for (int j = 0; j < 6; ++j) { const int i = tid + 512 * j, t = i / 384, c = i % 384, part = c >> 7; const int m = MP + b * TS + t;
            const unsigned sel = part == 0 ? 1u : part == 1 ? 0u : 2u;
            tk[i] = bf2f(QD[sel * (unsigned)((WS_KD - WS_QD) / 2) + (unsigned)m * DNW + h * 128 + (c & 127)]); }
        if (tid < 16) { const size_t m = (size_t)(MP + b * TS + (tid >> 1)); tk[3072 + tid] = (tid & 1) ? BETA[m * 4 + h] : __expf(LOGA[m * 4 + h]); } }
    __syncthreads();
    for (int t = 0; t < TS; ++t) {
#pragma unroll
        for (int u = 0; u < NU; ++u) { LAS float* red = (LAS float*)lds + u * UF; const LAS float* kp = red + 1024 + t * 384 + 32 * dq;
            float p0 = 0.f, p1 = 0.f;
#pragma unroll
            for (int d4 = 0; d4 < 8; ++d4) { const f32x4 kv = *(const LAS f32x4*)(kp + 4 * d4);
                p0 += kv.x * S[u][4 * d4] + kv.z * S[u][4 * d4 + 2]; p1 += kv.y * S[u][4 * d4 + 1] + kv.w * S[u][4 * d4 + 3]; }
            red[dq * 128 + e] = p0 + p1; }
        __syncthreads();
#pragma unroll
        for (int u = 0; u < NU; ++u) { LAS float* red = (LAS float*)lds + u * UF; LAS float* red2 = red + 512; const LAS float* tk = red + 1024;
            const float a = tk[3072 + 2 * t], bt = tk[3072 + 2 * t + 1];
            const float kS = (red[e] + red[128 + e]) + (red[256 + e] + red[384 + e]);
            const float dl = bt * (tk[t * 384 + 256 + e] - a * kS);
            const LAS float* kp = tk + t * 384 + 32 * dq; const LAS float* qp = kp + 128;
            float po0 = 0.f, po1 = 0.f;
#pragma unroll
            for (int d4 = 0; d4 < 8; ++d4) { const f32x4 kv = *(const LAS f32x4*)(kp + 4 * d4), qv = *(const LAS f32x4*)(qp + 4 * d4);
                S[u][4 * d4] = a * S[u][4 * d4] + kv.x * dl; po0 += qv.x * S[u][4 * d4]; S[u][4 * d4 + 1] = a * S[u][4 * d4 + 1] + kv.y * dl; po1 += qv.y * S[u][4 * d4 + 1];
                S[u][4 * d4 + 2] = a * S[u][4 * d4 + 2] + kv.z * dl; po0 += qv.z * S[u][4 * d4 + 2]; S[u][4 * d4 + 3] = a * S[u][4 * d4 + 3] + kv.w * dl; po1 += qv.w * S[u][4 * d4 + 3]; }
            red2[dq * 128 + e] = po0 + po1; }
        __syncthreads();
        if (dq == 0) {
#pragma unroll
            for (int u = 0; u < NU; ++u) { const int unit = unit0 + u * ustride, h = unit & 3, b = unit >> 2; const LAS float* red2 = (LAS float*)lds + u * UF + 512;
                ODN[(size_t)(MP + b * TS + t) * DNW + h * 128 + e] = (red2[e] + red2[128 + e]) + (red2[256 + e] + red2[384 + e]); } }
    }
#pragma unroll
    for (int u = 0; u < NU; ++u) { const int unit = unit0 + u * ustride, h = unit & 3, b = unit >> 2;
        float* so = A.out + O_SS + (size_t)(b * 4 + h) * 16384;
#pragma unroll
        for (int d = 0; d < 32; ++d) so[loff + (unsigned)(d * 128)] = S[u][d]; }
    __syncthreads();
}

constexpr int SC_KC = 0, SC_QD = 17408, SC_KT = 34816, SC_IN = 53248, SC_BUF = 62464;
__device__ __forceinline__ void dn_scan_chain(const Args& A, LAS unsigned char* lds, int chain, int tid, int wave, int lane) {
    unsigned char* ws = A.ws;
    const float* Ub = (const float*)(ws + WS_U); const float* GL = (const float*)(ws + WS_GL); float* ODN = (float*)(ws + WS_ODN);
    const int b = chain >> 2, h = chain & 3, lr = lane & 15, q = lane >> 4, e = 16 * wave + lr;
    int ldst[7];
    { const int c0 = tid, c1 = tid + 512;
      ldst[0] = SC_KC + (c0 >> 4) * 272; ldst[1] = SC_KC + (c1 >> 4) * 272; ldst[2] = SC_QD + (c0 >> 4) * 272; ldst[3] = SC_QD + (c1 >> 4) * 272;
      ldst[4] = SC_KT + (c0 >> 3) * 144; ldst[5] = SC_KT + (c1 >> 3) * 144; ldst[6] = SC_IN + (c0 >> 3) * 144; }
    const int cb_ = tid & 3, hA_ = (8 * ((2 * cb_) & 3) + 4 * (cb_ >> 1)) * 2, hB_ = (8 * ((2 * cb_ + 1) & 3) + 4 * (cb_ >> 1)) * 2;
    const int o16A = ((tid & 15) >> 2) * 64 + hA_, o16B = ((tid & 15) >> 2) * 64 + hB_, o8A = ((tid & 7) >> 2) * 64 + hA_, o8B = ((tid & 7) >> 2) * 64 + hB_;
    const size_t item0 = (size_t)(b * 64) * 4 + h;
    const unsigned char* gKC = ws + WS_KCUM + item0 * 16384; const unsigned char* gQD = ws + WS_QDEC + item0 * 16384; const unsigned char* gKT = ws + WS_KDECT + item0 * 16384; const unsigned char* gIN = ws + WS_INTRA + item0 * 8192;
    const unsigned t16 = (unsigned)tid * 16u, ulane = (unsigned)(wave * 64 + lane) * 4u;
    u32x4 R[7]; float un[16], uc[16];
#define SC_GLOAD(n_) do { const size_t o16_ = (size_t)(n_) * 4 * 16384, o8_ = (size_t)(n_) * 4 * 8192; \
        R[0] = *(const u32x4*)(gKC + o16_ + t16); R[1] = *(const u32x4*)(gKC + o16_ + 8192 + t16); R[2] = *(const u32x4*)(gQD + o16_ + t16); R[3] = *(const u32x4*)(gQD + o16_ + 8192 + t16); \
        R[4] = *(const u32x4*)(gKT + o16_ + t16); R[5] = *(const u32x4*)(gKT + o16_ + 8192 + t16); R[6] = *(const u32x4*)(gIN + o8_ + t16); \
        const float* U_ = Ub + (item0 + 4 * (size_t)(n_)) * 8192; \
        _Pragma("unroll") for (int i_ = 0; i_ < 4; ++i_) { const f32x4 u_ = *(const f32x4*)(U_ + (ulane + (unsigned)(i_ * 2048))); un[4 * i_] = u_.x; un[4 * i_ + 1] = u_.y; un[4 * i_ + 2] = u_.z; un[4 * i_ + 3] = u_.w; } } while (0)
#define SC_LWRITE(buf_) do { _Pragma("unroll") for (int k_ = 0; k_ < 7; ++k_) { LAS unsigned char* d_ = lds + (buf_) * SC_BUF + ldst[k_]; \
        *(LAS u32x2*)(d_ + (k_ < 4 ? o16A : o8A)) = (u32x2){R[k_].x, R[k_].y}; *(LAS u32x2*)(d_ + (k_ < 4 ? o16B : o8B)) = (u32x2){R[k_].z, R[k_].w}; } } while (0)
#define SC_BARRIER() do { asm volatile("s_waitcnt lgkmcnt(0)" ::: "memory"); __builtin_amdgcn_s_barrier(); asm volatile("" ::: "memory"); } while (0)
#define SC_FRAG(off_, pitch_, row_, s_) (*(const LAS bf16x8*)(B + (off_) + (row_) * (pitch_) + (32 * (s_) + 8 * q) * 2))
    pg8::f32x4 S[8];
#pragma unroll
    for (int i = 0; i < 8; ++i) S[i] = (pg8::f32x4){0.f, 0.f, 0.f, 0.f};
    const float glv = GL[item0 + 4 * (size_t)lane];
    __syncthreads();
    SC_GLOAD(0); SC_LWRITE(0);
#pragma unroll
    for (int k = 0; k < 16; ++k) uc[k] = un[k];
    __syncthreads();
    for (int n = 0; n < 64; ++n) {
        const float gl = __uint_as_float(__builtin_amdgcn_readlane(__float_as_uint(glv), n));
        if (n + 1 < 64) SC_GLOAD(n + 1);
        const LAS unsigned char* B = lds + (n & 1) * SC_BUF;
        bf16x8 Sb[4];
#pragma unroll
        for (int s = 0; s < 4; ++s) { u32x4 w; w.x = cvtpk(S[2 * s][0], S[2 * s][1]); w.y = cvtpk(S[2 * s][2], S[2 * s][3]); w.z = cvtpk(S[2 * s + 1][0], S[2 * s + 1][1]); w.w = cvtpk(S[2 * s + 1][2], S[2 * s + 1][3]); Sb[s] = __builtin_bit_cast(bf16x8, w); }
        pg8::f32x4 vn[4], o[4];
#pragma unroll
        for (int ih = 0; ih < 2; ++ih) {
            bf16x8 fk[2][4], fq[2][4];
#pragma unroll
            for (int ii = 0; ii < 2; ++ii)
#pragma unroll
                for (int s = 0; s < 4; ++s) { fk[ii][s] = SC_FRAG(SC_KC, 272, 16 * (2 * ih + ii) + lr, s); fq[ii][s] = SC_FRAG(SC_QD, 272, 16 * (2 * ih + ii) + lr, s); }
#pragma unroll
            for (int ii = 0; ii < 2; ++ii) { const int i = 2 * ih + ii;
                pg8::f32x4 ak = (pg8::f32x4){0.f, 0.f, 0.f, 0.f}, aq = ak;
#pragma unroll
                for (int s = 0; s < 4; ++s) { ak = __builtin_amdgcn_mfma_f32_16x16x32_bf16(fk[ii][s], Sb[s], ak, 0, 0, 0); aq = __builtin_amdgcn_mfma_f32_16x16x32_bf16(fq[ii][s], Sb[s], aq, 0, 0, 0); }
#pragma unroll
                for (int r = 0; r < 4; ++r) vn[i][r] = uc[4 * i + r] - ak[r];
                o[i] = aq; }
        }
        bf16x8 Vb[2];
#pragma unroll
        for (int s = 0; s < 2; ++s) { u32x4 w; w.x = cvtpk(vn[2 * s][0], vn[2 * s][1]); w.y = cvtpk(vn[2 * s][2], vn[2 * s][3]); w.z = cvtpk(vn[2 * s + 1][0], vn[2 * s + 1][1]); w.w = cvtpk(vn[2 * s + 1][2], vn[2 * s + 1][3]); Vb[s] = __builtin_bit_cast(bf16x8, w); }
        {
            bf16x8 fi[4][2], ft[8][2];
#pragma unroll
            for (int i = 0; i < 4; ++i)
#pragma unroll
                for (int s = 0; s < 2; ++s) fi[i][s] = SC_FRAG(SC_IN, 144, 16 * i + lr, s);
#pragma unroll
            for (int i = 0; i < 8; ++i)
#pragma unroll
                for (int s = 0; s < 2; ++s) ft[i][s] = SC_FRAG(SC_KT, 144, 16 * i + lr, s);
#pragma unroll
            for (int i = 0; i < 4; ++i) {
#pragma unroll
                for (int s = 0; s < 2; ++s) o[i] = __builtin_amdgcn_mfma_f32_16x16x32_bf16(fi[i][s], Vb[s], o[i], 0, 0, 0);
                *(u32x2*)((bf16*)ODN + ((item0 + 4 * (size_t)n) * 8192) + (ulane + (unsigned)(i * 2048))) = (u32x2){cvtpk(o[i][0], o[i][1]), cvtpk(o[i][2], o[i][3])};
            }
#pragma unroll
            for (int i = 0; i < 8; ++i) {
                pg8::f32x4 acc = S[i] * gl;
#pragma unroll
                for (int s = 0; s < 2; ++s) acc = __builtin_amdgcn_mfma_f32_16x16x32_bf16(ft[i][s], Vb[s], acc, 0, 0, 0);
                S[i] = acc;
            }
        }
        if (n + 1 < 64) {
            SC_LWRITE((n + 1) & 1);
#pragma unroll
            for (int k = 0; k < 16; ++k) uc[k] = un[k];
        }
        SC_BARRIER();
    }
#undef SC_GLOAD
#undef SC_LWRITE
#undef SC_FRAG
    float* so = A.out + O_SP + (size_t)(b * 4 + h) * 16384;
#pragma unroll
    for (int i = 0; i < 8; ++i)
#pragma unroll
        for (int r = 0; r < 4; ++r) so[(unsigned)((16 * i + 4 * q + r) * 128 + e)] = S[i][r];
}

__device__ __forceinline__ int crow(int r, int hi) { return (r & 3) + 8 * (r >> 2) + 4 * hi; }
__device__ __forceinline__ void sb_core(f32x16& p, float& carry, int hi) {
    float s[16];
#pragma unroll
    for (int r = 0; r < 16; ++r) { const float e = __builtin_amdgcn_exp2f(p[r]); s[r] = -__builtin_amdgcn_logf(1.0f + e); }
    float tt[4], uu[4];
#pragma unroll
    for (int i = 0; i < 4; ++i) { s[4 * i + 2] += s[4 * i + 3]; s[4 * i + 1] += s[4 * i + 2]; s[4 * i] += s[4 * i + 1]; tt[i] = s[4 * i]; }
#pragma unroll
    for (int i = 0; i < 4; ++i) uu[i] = __shfl_xor(tt[i], 32);
    const float w3 = tt[3] + uu[3], w2 = tt[2] + uu[2], w1 = tt[1] + uu[1], w0 = tt[0] + uu[0];
    float off[4];
    off[3] = carry; off[2] = carry + w3; off[1] = off[2] + w2; off[0] = off[1] + w1;
    carry = off[0] + w0;
    if (hi == 0) {
#pragma unroll
        for (int i = 0; i < 4; ++i) off[i] += uu[i];
    }
#pragma unroll
    for (int r = 0; r < 16; ++r) p[r] = __builtin_amdgcn_exp2f(p[r] + s[r] + off[r >> 2]);
}
__device__ __forceinline__ bf16x8 pack_p(const f32x16& p, int s) {
    u32x4 w; w.x = cvtpk(p[8 * s], p[8 * s + 1]); w.y = cvtpk(p[8 * s + 2], p[8 * s + 3]); w.z = cvtpk(p[8 * s + 4], p[8 * s + 5]); w.w = cvtpk(p[8 * s + 6], p[8 * s + 7]); return __builtin_bit_cast(bf16x8, w);
}
constexpr int AW_BYTES = 16384, AW_V = 0, VPI = 192, AW_K = 6144, KPI = 144, AW_Q = 6144, AW_SQ = 10752;
__device__ __forceinline__ void read_vfrags(bf16x8 (&vf)[4], const LAS unsigned char* wl, int lane) {
    const int hi = lane >> 5;
    const LAS unsigned char* vb = wl + AW_V + (4 * hi + ((lane & 15) >> 2)) * VPI + (((lane >> 4) & 1) * 16 + (lane & 3) * 4) * 2;
#pragma unroll
    for (int dt = 0; dt < 2; ++dt) {
        const s16x4 t0 = __builtin_bit_cast(s16x4, __builtin_amdgcn_ds_read_tr16_b64_v4i16((LAS s16x4*)(vb + dt * 64)));
        const s16x4 t1 = __builtin_bit_cast(s16x4, __builtin_amdgcn_ds_read_tr16_b64_v4i16((LAS s16x4*)(vb + dt * 64 + 8 * VPI)));
        const s16x4 t2 = __builtin_bit_cast(s16x4, __builtin_amdgcn_ds_read_tr16_b64_v4i16((LAS s16x4*)(vb + dt * 64 + 16 * VPI)));
        const s16x4 t3 = __builtin_bit_cast(s16x4, __builtin_amdgcn_ds_read_tr16_b64_v4i16((LAS s16x4*)(vb + dt * 64 + 24 * VPI)));
        vf[2 * dt] = (bf16x8){t0[0], t0[1], t0[2], t0[3], t1[0], t1[1], t1[2], t1[3]}; vf[2 * dt + 1] = (bf16x8){t2[0], t2[1], t2[2], t2[3], t3[0], t3[1], t3[2], t3[3]};
    }
}
__device__ __forceinline__ void load_k_prompt(bf16x8 (&k)[4], const bf16* KB, int b, int h, int kv0, int r32, int hi) {
    const bf16* kp = KB + (size_t)(b * TP + kv0 + r32) * SBW + h * HD + 8 * hi;
#pragma unroll
    for (int d0 = 0; d0 < 4; ++d0) k[d0] = *(const bf16x8*)(kp + 16 * d0);
}
__device__ __forceinline__ void load_v_prompt(u32x4 (&v)[4], const bf16* VB, int b, int h, int kv0, int lane) {
    const bf16* vp = VB + (size_t)(b * TP + kv0 + (lane >> 3)) * SBW + h * HD + (lane & 7) * 8;
#pragma unroll
    for (int i = 0; i < 4; ++i) v[i] = *(const u32x4*)(vp + (size_t)(8 * i) * SBW);
}
__device__ __forceinline__ void write_v_lds(LAS unsigned char* wl, const u32x4 (&v)[4], int lane) {
#pragma unroll
    for (int i = 0; i < 4; ++i) *(LAS u32x4*)(wl + AW_V + (8 * i + (lane >> 3)) * VPI + (lane & 7) * 16) = v[i];
}
template <int MASK>
__device__ __forceinline__ void sb_qk(f32x16& p, const bf16x8 (&kf)[4], const bf16x8 (&qf)[4], float bias2, int kv0, int qpos, int hi) {
#pragma unroll
    for (int r = 0; r < 16; ++r) p[r] = bias2;
#pragma unroll
    for (int d0 = 0; d0 < 4; ++d0) p = __builtin_amdgcn_mfma_f32_32x32x16_bf16(kf[d0], qf[d0], p, 0, 0, 0);
    if (MASK) {
#pragma unroll
        for (int r = 0; r < 16; ++r) if (kv0 + crow(r, hi) >= qpos) p[r] = -INFINITY;
    }
}
__device__ __forceinline__ void sb_pvonly(const f32x16& p, const bf16x8 (&vf)[4], f32x16 (&o)[2]) {
    const bf16x8 p0 = pack_p(p, 0), p1 = pack_p(p, 1);
#pragma unroll
    for (int dt = 0; dt < 2; ++dt) { o[dt] = __builtin_amdgcn_mfma_f32_32x32x16_bf16(vf[2 * dt], p0, o[dt], 0, 0, 0); o[dt] = __builtin_amdgcn_mfma_f32_32x32x16_bf16(vf[2 * dt + 1], p1, o[dt], 0, 0, 0); }
}
__device__ __forceinline__ void sb_pv(f32x16& p, const bf16x8 (&vf)[4], f32x16 (&o)[2], float& carry, int hi) {
    sb_core(p, carry, hi);
    const bf16x8 p0 = pack_p(p, 0), p1 = pack_p(p, 1);
#pragma unroll
    for (int dt = 0; dt < 2; ++dt) { o[dt] = __builtin_amdgcn_mfma_f32_32x32x16_bf16(vf[2 * dt], p0, o[dt], 0, 0, 0); o[dt] = __builtin_amdgcn_mfma_f32_32x32x16_bf16(vf[2 * dt + 1], p1, o[dt], 0, 0, 0); }
}
template <int MASK>
__device__ __forceinline__ void sb_tile(const bf16x8 (&kf)[4], const bf16x8 (&vf)[4], const bf16x8 (&qf)[4], float bias2, f32x16 (&o)[2], float& carry, int kv0, int qpos, int hi) {
    f32x16 p; sb_qk<MASK>(p, kf, qf, bias2, kv0, qpos, hi); sb_pv(p, vf, o, carry, hi);
}
__device__ __forceinline__ void sb_store_prompt(const Args& A, const f32x16 (&o)[2], int b, int h, int qpos, int hi) {
    float ss = 0.f;
#pragma unroll
    for (int dt = 0; dt < 2; ++dt)
#pragma unroll
        for (int r = 0; r < 16; ++r) ss += o[dt][r] * o[dt][r];
    ss += __shfl_xor(ss, 32);
    const float rs = 1.0f / sqrtf(ss * (1.f / HD) + EPS);
    const float* gso = (const float*)A.in[I_GSBO];
    bf16* op = (bf16*)(A.ws + WS_MIXED) + (size_t)(b * TP + qpos) * D + h * HD;
#pragma unroll
    for (int dt = 0; dt < 2; ++dt)
#pragma unroll
        for (int g = 0; g < 4; ++g) { const int d = 32 * dt + 8 * g + 4 * hi; const f32x4 gg = *(const f32x4*)(gso + d);
            u32x2 w; w.x = cvtpk(o[dt][4 * g] * rs * gg.x, o[dt][4 * g + 1] * rs * gg.y); w.y = cvtpk(o[dt][4 * g + 2] * rs * gg.z, o[dt][4 * g + 3] * rs * gg.w); *(u32x2*)(op + d) = w; }
}
__device__ __forceinline__ void attn_prompt_item(const Args& A, LAS unsigned char* wl, int b, int h, int q0, int lane) {
    unsigned char* ws = A.ws;
    const bf16* QB = (const bf16*)(ws + WS_QB); const bf16* KB = (const bf16*)(ws + WS_KB); const bf16* VB = (const bf16*)(ws + WS_VB);
    const int r32 = lane & 31, hi = lane >> 5, qa = q0 + r32, qb = q0 + 32 + r32;
    const float bias2 = ((const float*)A.in[I_SBB])[h] * LOG2E;
#pragma unroll
    for (int d0 = 0; d0 < 4; ++d0) { *(LAS bf16x8*)(wl + AW_Q + (d0 * 64 + lane) * 16) = *(const bf16x8*)(QB + (size_t)(b * TP + qa) * SBW + h * HD + 16 * d0 + 8 * hi);
        *(LAS bf16x8*)(wl + AW_Q + 4096 + (d0 * 64 + lane) * 16) = *(const bf16x8*)(QB + (size_t)(b * TP + qb) * SBW + h * HD + 16 * d0 + 8 * hi); }
#define QFA_LOAD bf16x8 qfa[4]; _Pragma("unroll") for (int d0_ = 0; d0_ < 4; ++d0_) qfa[d0_] = *(const LAS bf16x8*)(wl + AW_Q + (d0_ * 64 + lane) * 16);
#define QFB_LOAD bf16x8 qfb[4]; _Pragma("unroll") for (int d0_ = 0; d0_ < 4; ++d0_) qfb[d0_] = *(const LAS bf16x8*)(wl + AW_Q + 4096 + (d0_ * 64 + lane) * 16);
    f32x16 oa[2], ob[2]; oa[0] = (f32x16){}; oa[1] = (f32x16){}; ob[0] = (f32x16){}; ob[1] = (f32x16){};
    float ca = 0.f, cb = 0.f;
    bf16x8 kc[4], vf[4]; u32x4 vr[4];
    const int top = (q0 >> 5) + 1;
    load_k_prompt(kc, KB, b, h, 32 * top, r32, hi); load_v_prompt(vr, VB, b, h, 32 * top, lane);
    { write_v_lds(wl, vr, lane); load_v_prompt(vr, VB, b, h, 32 * (top - 1), lane);
      f32x16 p; { QFB_LOAD sb_qk<1>(p, kc, qfb, bias2, 32 * top, qb, hi); }
      load_k_prompt(kc, KB, b, h, 32 * (top - 1), r32, hi);
      read_vfrags(vf, wl, lane);
      sb_pv(p, vf, ob, cb, hi); }
    { write_v_lds(wl, vr, lane); if (top >= 2) load_v_prompt(vr, VB, b, h, 32 * (top - 2), lane);
      f32x16 p; { QFA_LOAD sb_qk<1>(p, kc, qfa, bias2, 32 * (top - 1), qa, hi); }
      read_vfrags(vf, wl, lane);
      sb_pv(p, vf, oa, ca, hi);
      { QFB_LOAD sb_qk<0>(p, kc, qfb, bias2, 0, 0, hi); }
      if (top >= 2) load_k_prompt(kc, KB, b, h, 32 * (top - 2), r32, hi);
      sb_pv(p, vf, ob, cb, hi); }
    for (int ht = top - 2; ht >= 0; --ht) {
        write_v_lds(wl, vr, lane);
        f32x16 p, p2; { QFA_LOAD sb_qk<0>(p, kc, qfa, bias2, 0, 0, hi); } { QFB_LOAD sb_qk<0>(p2, kc, qfb, bias2, 0, 0, hi); }
        if (ht > 0) load_k_prompt(kc, KB, b, h, 32 * (ht - 1), r32, hi);
        read_vfrags(vf, wl, lane);
        sb_core(p, ca, hi); sb_pvonly(p, vf, oa);
        __builtin_amdgcn_sched_barrier(0);
        if (ht > 0) load_v_prompt(vr, VB, b, h, 32 * (ht - 1), lane);
        sb_core(p2, cb, hi); sb_pvonly(p2, vf, ob);
    }
    sb_store_prompt(A, oa, b, h, qa, hi); sb_store_prompt(A, ob, b, h, qb, hi);
#undef QFA_LOAD
#undef QFB_LOAD
}

__device__ __forceinline__ void load_raw_sample(f32x4 (&r)[8], const float* c, size_t base, int h, int lane) {
    const float* p = c + base + (size_t)(lane >> 4) * 512 + h * HD + (lane & 15) * 4;
#pragma unroll
    for (int i = 0; i < 8; ++i) r[i] = *(const f32x4*)(p + (size_t)(4 * i) * 512);
}
__device__ __forceinline__ void write_raw_sample(LAS unsigned char* wl, int off, int pitch, const f32x4 (&r)[8], int lane) {
#pragma unroll
    for (int i = 0; i < 8; ++i) { const int row = 4 * i + (lane >> 4); u32x2 w; w.x = cvtpk(r[i].x, r[i].y); w.y = cvtpk(r[i].z, r[i].w); *(LAS u32x2*)(wl + off + row * pitch + (lane & 15) * 8) = w; }
}
__device__ __forceinline__ void read_kfrags(bf16x8 (&kf)[4], const LAS unsigned char* wl, int r32, int hi) {
#pragma unroll
    for (int d0 = 0; d0 < 4; ++d0) kf[d0] = *(const LAS bf16x8*)(wl + AW_K + r32 * KPI + (16 * d0 + 8 * hi) * 2);
}
__device__ __forceinline__ void attn_sample_store(const Args& A, int b, int h, int part, int lane, const f32x16 (&o)[2], float carry) {
    float* OP = (float*)(A.ws + WS_OPART) + (size_t)((b * SBH + h) * NPART + part) * 512; float* LP = (float*)(A.ws + WS_LPART) + (size_t)((b * SBH + h) * NPART + part) * 8;
    const int r32 = lane & 31, hi = lane >> 5;
    unsigned lo = (unsigned)(r32 * 64 + 4 * hi), ll = (unsigned)r32; asm volatile("" : "+v"(lo), "+v"(ll));
    if (r32 < 8) {
#pragma unroll
        for (int dt = 0; dt < 2; ++dt)
#pragma unroll
            for (int g = 0; g < 4; ++g) *(f32x4*)(OP + (lo + (unsigned)(32 * dt + 8 * g))) = (f32x4){o[dt][4 * g], o[dt][4 * g + 1], o[dt][4 * g + 2], o[dt][4 * g + 3]};
        if (hi == 0) LP[ll] = carry;
    }
}
__device__ __forceinline__ void attn_sample_job(const Args& A, LAS unsigned char* wl, int b, int h, int sp, int lane) {
    unsigned char* ws = A.ws;
    const int r32 = lane & 31, hi = lane >> 5;
    const float* ck = (const float*)A.in[I_CK]; const float* cv = (const float*)A.in[I_CV]; const int* pt = (const int*)A.in[I_PT] + b * NPAGES;
    const bf16* QB = (const bf16*)(ws + WS_QB);
    const float bias2 = ((const float*)A.in[I_SBB])[h] * LOG2E;
    bf16x8 qf[4];
#pragma unroll
    for (int d0 = 0; d0 < 4; ++d0) { qf[d0] = (bf16x8){0, 0, 0, 0, 0, 0, 0, 0}; if (r32 < TS) qf[d0] = *(const bf16x8*)(QB + (size_t)(MP + b * TS + r32) * SBW + h * HD + 16 * d0 + 8 * hi); }
    f32x16 o[2]; float carry;
    bf16x8 kf[4], vf[4];
    const int tok_hi = (PAST / NSPLIT) * (sp + 1);
    constexpr int NT = PAST / NSPLIT / 32;
    f32x4 rk[8], rv[8];
#define SAMPLE_BASE(j) (((size_t)pt[(tok_hi - 32 * ((j) + 1)) >> 7] * PAGE + ((tok_hi - 32 * ((j) + 1)) & 127)) * 512)
    if (sp == NSPLIT - 1) {
        const bf16* KBn = (const bf16*)(ws + WS_KB) + (size_t)(MP + b * TS) * SBW + h * HD;
#pragma unroll
        for (int d0 = 0; d0 < 4; ++d0) { kf[d0] = (bf16x8){0, 0, 0, 0, 0, 0, 0, 0}; if (r32 < TS) kf[d0] = *(const bf16x8*)(KBn + (size_t)r32 * SBW + 16 * d0 + 8 * hi); }
        u32x4 vr[4];
        vr[0] = *(const u32x4*)((const bf16*)(ws + WS_VB) + (size_t)(MP + b * TS + (lane >> 3)) * SBW + h * HD + (lane & 7) * 8);
        vr[1] = (u32x4){0u, 0u, 0u, 0u}; vr[2] = vr[1]; vr[3] = vr[1];
        write_v_lds(wl, vr, lane);
        read_vfrags(vf, wl, lane);
        o[0] = (f32x16){}; o[1] = (f32x16){}; carry = 0.f;
        sb_tile<1>(kf, vf, qf, bias2, o, carry, 0, r32, hi);
        attn_sample_store(A, b, h, NPART - 1, lane, o, carry);
    }
    f32x4 rk2[8];
    load_raw_sample(rk, ck, SAMPLE_BASE(0), h, lane); load_raw_sample(rv, cv, SAMPLE_BASE(0), h, lane);
    load_raw_sample(rk2, ck, SAMPLE_BASE(1), h, lane);
#pragma unroll
    for (int d0 = 0; d0 < 4; ++d0) *(LAS bf16x8*)(wl + AW_SQ + (d0 * 64 + lane) * 16) = qf[d0];
    o[0] = (f32x16){}; o[1] = (f32x16){}; carry = 0.f;
#define SAMPLE_TILE(RK, jk_, jv_) do { \
        write_raw_sample(wl, AW_K, KPI, RK, lane); write_raw_sample(wl, AW_V, VPI, rv, lane); \
        if ((jk_) < NT) load_raw_sample(RK, ck, SAMPLE_BASE(jk_), h, lane); \
        read_kfrags(kf, wl, r32, hi); read_vfrags(vf, wl, lane); \
        bf16x8 qq[4]; _Pragma("unroll") for (int d0_ = 0; d0_ < 4; ++d0_) qq[d0_] = *(const LAS bf16x8*)(wl + AW_SQ + (d0_ * 64 + lane) * 16); \
        f32x16 p; sb_qk<0>(p, kf, qq, bias2, 0, 0, hi); \
        sb_core(p, carry, hi); \
        __builtin_amdgcn_sched_barrier(0); \
        if ((jv_) < NT) load_raw_sample(rv, cv, SAMPLE_BASE(jv_), h, lane); \
        sb_pvonly(p, vf, o); } while (0)
    for (int j = 0; j < NT; j += 2) {
        SAMPLE_TILE(rk, j + 2, j + 1);
        SAMPLE_TILE(rk2, j + 3, j + 2);
    }
#undef SAMPLE_TILE
#undef SAMPLE_BASE
    attn_sample_store(A, b, h, sp, lane, o, carry);
}

__device__ __forceinline__ void phase_outnorm(const Args& A, int gw, int NGW, int lane) {
    unsigned char* ws = A.ws; const float* ODN = (const float*)(ws + WS_ODN); bf16* MIXED = (bf16*)(ws + WS_MIXED);
    const float* gdn = (const float*)A.in[I_GDNO]; const float* gso = (const float*)A.in[I_GSBO];
    const float* OPb = (const float*)(ws + WS_OPART); const float* LPb = (const float*)(ws + WS_LPART);
    const int c8 = 8 * lane;
    unsigned nr[8]; u32x4 nzw;
#define ON_LOAD(mm_) do { if ((mm_) >= MP) { const float* op_ = ODN + (size_t)(mm_) * DNW + c8; const u32x4 p0_ = *(const u32x4*)op_, p1_ = *(const u32x4*)(op_ + 4); nr[0] = p0_.x; nr[1] = p0_.y; nr[2] = p0_.z; nr[3] = p0_.w; nr[4] = p1_.x; nr[5] = p1_.y; nr[6] = p1_.z; nr[7] = p1_.w; } \
        else { const int t_ = (mm_) & 4095, cch_ = t_ & 63, hh_ = lane >> 4; const size_t it_ = (size_t)(((mm_) >> 12) * 64 + (t_ >> 6)) * 4 + hh_; \
            const unsigned short* op_ = (const unsigned short*)ODN + it_ * 8192 + ((((cch_ >> 4) * 8 + ((lane & 15) >> 1)) * 64 + ((cch_ >> 2) & 3) * 16 + 8 * (lane & 1)) * 4) + (cch_ & 3); \
            _Pragma("unroll") for (int k_ = 0; k_ < 8; ++k_) nr[k_] = (unsigned)op_[4 * k_]; } \
        nzw = *(const u32x4*)((const bf16*)(ws + WS_ZG) + (size_t)(mm_) * DNW + c8); } while (0)
    if (gw < M) ON_LOAD(RMAP(gw));
    const f32x4 g0 = *(const f32x4*)(gdn + (c8 & 127)), g1 = *(const f32x4*)(gdn + (c8 & 127) + 4);
    for (int idx = gw; idx < M; idx += NGW) {
        const int m = RMAP(idx);
        {
            f32x4 a0, a1;
            if (m >= MP) { a0 = (f32x4){__uint_as_float(nr[0]), __uint_as_float(nr[1]), __uint_as_float(nr[2]), __uint_as_float(nr[3])}; a1 = (f32x4){__uint_as_float(nr[4]), __uint_as_float(nr[5]), __uint_as_float(nr[6]), __uint_as_float(nr[7])}; }
            else { a0 = (f32x4){__uint_as_float(nr[0] << 16), __uint_as_float(nr[1] << 16), __uint_as_float(nr[2] << 16), __uint_as_float(nr[3] << 16)}; a1 = (f32x4){__uint_as_float(nr[4] << 16), __uint_as_float(nr[5] << 16), __uint_as_float(nr[6] << 16), __uint_as_float(nr[7] << 16)}; }
            const u32x4 zw = nzw;
            { const int in_ = idx + NGW; if (in_ < M) ON_LOAD(RMAP(in_)); }
            float ss = (a0.x * a0.x + a0.y * a0.y) + (a0.z * a0.z + a0.w * a0.w) + (a1.x * a1.x + a1.y * a1.y) + (a1.z * a1.z + a1.w * a1.w);
            ss += __shfl_xor(ss, 1); ss += __shfl_xor(ss, 2); ss += __shfl_xor(ss, 4); ss += __shfl_xor(ss, 8);
            const float rs = 1.0f / sqrtf(ss * (1.f / DND) + EPS);
            const f32x4 z0 = bf4lo(zw), z1 = bf4hi(zw);
            *(u32x4*)(MIXED + (size_t)m * D + SBW + c8) = pack8(a0 * rs * g0 * z0, a1 * rs * g1 * z1);
        }
        if (m >= MP) {
            const int b = (m - MP) >> 3, t = (m - MP) & 7, h = lane >> 3, d0 = c8 & 63;
            const float* OP = OPb + (size_t)(b * SBH + h) * NPART * 512; const float* LP = LPb + (size_t)(b * SBH + h) * NPART * 8;
            float v[8];
#pragma unroll
            for (int k = 0; k < 8; ++k) v[k] = 0.f;
            float suf = 0.f;
#pragma unroll
            for (int part = NPART - 1; part >= 0; --part) { const float w = __builtin_amdgcn_exp2f(suf);
                const f32x4 pa = *(const f32x4*)(OP + part * 512 + t * 64 + d0), pb = *(const f32x4*)(OP + part * 512 + t * 64 + d0 + 4);
                v[0] += w * pa.x; v[1] += w * pa.y; v[2] += w * pa.z; v[3] += w * pa.w; v[4] += w * pb.x; v[5] += w * pb.y; v[6] += w * pb.z; v[7] += w * pb.w;
                suf += LP[part * 8 + t]; }
            float ss = 0.f;
#pragma unroll
            for (int k = 0; k < 8; ++k) ss += v[k] * v[k];
            ss += __shfl_xor(ss, 1); ss += __shfl_xor(ss, 2); ss += __shfl_xor(ss, 4);
            const float rs = 1.0f / sqrtf(ss * (1.f / HD) + EPS);
            const f32x4 g0 = *(const f32x4*)(gso + d0), g1 = *(const f32x4*)(gso + d0 + 4);
            *(u32x4*)(MIXED + (size_t)m * D + c8) = pack8((f32x4){v[0], v[1], v[2], v[3]} * rs * g0, (f32x4){v[4], v[5], v[6], v[7]} * rs * g1);
        }
    }
}

__device__ __forceinline__ f32x4 cg_conv(const f32x4 w0, const f32x4 w1, const f32x4 w2, const f32x4 x2, const f32x4 x1, const f32x4 x0) { return w0 * x2 + w1 * x1 + w2 * x0; }
__device__ __forceinline__ void upfix_rows(const Args& A, const bf16* own0, const bf16* own1, bool hbf, const void* h2v, const void* h3v, bool hzero, bf16* act0, bf16* act1, int c) {
    const float* wf = (const float*)A.in[I_WFC];
    f32x4 wu[3][2], wg[3][2];
#pragma unroll
    for (int i = 0; i < 3; ++i) { const float* wp = wf + (size_t)i * DFF2 + c; wu[i][0] = *(const f32x4*)wp; wu[i][1] = *(const f32x4*)(wp + 4); wg[i][0] = *(const f32x4*)(wp + DFF); wg[i][1] = *(const f32x4*)(wp + DFF + 4); }
    f32x4 u2[2], u3[2], g2[2], g3[2];
    if (hzero) { u2[0] = (f32x4){0.f, 0.f, 0.f, 0.f}; u2[1] = u2[0]; u3[0] = u2[0]; u3[1] = u2[0]; g2[0] = u2[0]; g2[1] = u2[0]; g3[0] = u2[0]; g3[1] = u2[0]; }
    else if (hbf) { const bf16* h2 = (const bf16*)h2v; const bf16* h3 = (const bf16*)h3v; const u32x4 a = *(const u32x4*)(h2 + c), b = *(const u32x4*)(h3 + c), d = *(const u32x4*)(h2 + DFF + c), e = *(const u32x4*)(h3 + DFF + c);
        u2[0] = bf4lo(a); u2[1] = bf4hi(a); u3[0] = bf4lo(b); u3[1] = bf4hi(b); g2[0] = bf4lo(d); g2[1] = bf4hi(d); g3[0] = bf4lo(e); g3[1] = bf4hi(e); }
    else { const float* h2 = (const float*)h2v; const float* h3 = (const float*)h3v;
        u2[0] = *(const f32x4*)(h2 + c); u2[1] = *(const f32x4*)(h2 + c + 4); u3[0] = *(const f32x4*)(h3 + c); u3[1] = *(const f32x4*)(h3 + c + 4);
        g2[0] = *(const f32x4*)(h2 + DFF + c); g2[1] = *(const f32x4*)(h2 + DFF + c + 4); g3[0] = *(const f32x4*)(h3 + DFF + c); g3[1] = *(const f32x4*)(h3 + DFF + c + 4); }
    const u32x4 o0u = *(const u32x4*)(own0 + c), o0g = *(const u32x4*)(own0 + DFF + c), o1u = *(const u32x4*)(own1 + c), o1g = *(const u32x4*)(own1 + DFF + c);
    const f32x4 a0[2] = {bf4lo(o0u), bf4hi(o0u)}, b0[2] = {bf4lo(o0g), bf4hi(o0g)}, a1[2] = {bf4lo(o1u), bf4hi(o1u)}, b1[2] = {bf4lo(o1g), bf4hi(o1g)};
    f32x4 r0[2], r1[2];
#pragma unroll
    for (int k = 0; k < 2; ++k) {
        f32x4 yu = cg_conv(wu[0][k], wu[1][k], wu[2][k], u2[k], u3[k], a0[k]), yg = cg_conv(wg[0][k], wg[1][k], wg[2][k], g2[k], g3[k], b0[k]);
        yg.x = siluf(yg.x); yg.y = siluf(yg.y); yg.z = siluf(yg.z); yg.w = siluf(yg.w); r0[k] = yg * yu;
        yu = cg_conv(wu[0][k], wu[1][k], wu[2][k], u3[k], a0[k], a1[k]); yg = cg_conv(wg[0][k], wg[1][k], wg[2][k], g3[k], b0[k], b1[k]);
        yg.x = siluf(yg.x); yg.y = siluf(yg.y); yg.z = siluf(yg.z); yg.w = siluf(yg.w); r1[k] = yg * yu;
    }
    *(u32x4*)(act0 + c) = pack8(r0[0], r0[1]); *(u32x4*)(act1 + c) = pack8(r1[0], r1[1]);
}
__device__ __forceinline__ void phase_upfix(const Args& A, int gw, int NGW, int lane) {
    unsigned char* ws = A.ws; const bf16* SIDEP = (const bf16*)(ws + WS_SIDEP); const bf16* SIDES = (const bf16*)(ws + WS_SIDES); bf16* ACT = (bf16*)(ws + WS_ACT);
    const float* sfc = (const float*)A.in[I_SFC];
    constexpr int NPB = MP / 64, NPI = NPB * 6, NSI = BS * 6;
    for (int it = gw; it < NPI + NSI; it += NGW) {
        const int cgp = it % 6, idx = it / 6; const int c = (cgp * 64 + lane) * 8;
        if (c >= DFF) continue;
        if (it < NPI) { const int kb = idx; const bf16* sp = SIDEP + (size_t)kb * 4 * DFF2;
            upfix_rows(A, sp, sp + DFF2, true, sp - 2 * DFF2, sp - DFF2, (kb & 63) == 0, ACT + (size_t)(kb * 64) * DFF, ACT + (size_t)(kb * 64 + 1) * DFF, c);
            if ((kb & 63) == 63) { const int b = kb >> 6; float* fo = A.out + O_FCP + (size_t)b * 2 * DFF2 + c;
#pragma unroll
                for (int r = 0; r < 2; ++r) { const u32x4 a = *(const u32x4*)(sp + (2 + r) * DFF2 + c), g = *(const u32x4*)(sp + (2 + r) * DFF2 + DFF + c);
                    *(f32x4*)(fo + r * DFF2) = bf4lo(a); *(f32x4*)(fo + r * DFF2 + 4) = bf4hi(a); *(f32x4*)(fo + r * DFF2 + DFF) = bf4lo(g); *(f32x4*)(fo + r * DFF2 + DFF + 4) = bf4hi(g); } }
        } else { const int seq = (it - NPI) / 6; const bf16* sp = SIDES + (size_t)seq * 2 * DFF2; const float* st = sfc + (size_t)seq * 2 * DFF2;
            upfix_rows(A, sp, sp + DFF2, false, st, st + DFF2, false, ACT + (size_t)(MP + seq * 8) * DFF, ACT + (size_t)(MP + seq * 8 + 1) * DFF, c); }
    }
}

__device__ __forceinline__ void phase_slabsum(const Args& A, int gw, int NGW, int lane) {
    unsigned char* ws = A.ws; const float* slab = (const float*)(ws + WS_SLAB); const float* X1 = (const float*)(ws + WS_X1); const float* MOD = (const float*)(ws + WS_MOD);
    for (int rr = gw; rr < 2 * MS; rr += NGW) {
        const int r = rr >> 1, j0 = 2 * (rr & 1);
        const int m = MP + r; const float* mod = MOD + (size_t)mod_row(m) * NMOD + 5120;
#pragma unroll
        for (int jj = 0; jj < 2; ++jj) { const int j = j0 + jj; const int c = 4 * (lane + 64 * j); f32x4 a = (f32x4){0.f, 0.f, 0.f, 0.f};
#pragma unroll
            for (int k = 0; k < DFF / 256; ++k) { const u32x2 sw = *(const u32x2*)((const bf16*)slab + ((size_t)k * MS + r) * D + c); a += (f32x4){__uint_as_float(sw.x << 16), __uint_as_float(sw.x & 0xffff0000u), __uint_as_float(sw.y << 16), __uint_as_float(sw.y & 0xffff0000u)}; }
            *(f32x4*)(A.out + (size_t)m * D + c) = *(const f32x4*)(X1 + (size_t)m * D + c) + *(const f32x4*)(mod + c) * a; }
    }
}

constexpr int NPHASE = 14;
#ifndef PROBE_LEVEL
#define PROBE_LEVEL 0
#endif
#ifndef REP_MASK
#define REP_MASK 0
#endif

__global__ void __launch_bounds__(512, 2) fwd_kernel(Args A) {
    extern __shared__ __attribute__((aligned(16))) unsigned char lds_raw[];
    LAS unsigned char* lds = (LAS unsigned char*)lds_raw;
    const int wave = __builtin_amdgcn_readfirstlane((int)threadIdx.x >> 6);
    const int G = gridDim.x, bx = blockIdx.x;
    const int gw = bx * 8 + wave, NGW = G * 8, NGT = G * 512;
    unsigned char* ws = A.ws;
    gu32* ctl = (gu32*)(ws + WS_CTL);
    volatile LAS unsigned* MISC = (volatile LAS unsigned*)(lds + MISC_OFF);
    { const int t0 = wave * 64 + lane_now(); for (int u = t0; u < (LDS_BYTES - RING_BYTES) / 4; u += 512) ((LAS unsigned*)(lds + RING_BYTES))[u] = 0u; }
    __syncthreads();
    const int lo = A.lo, hi = A.hi;
    const bool multi = (hi - lo) > 1;
    XcdBarrier bar; bar.bar = (unsigned*)(ctl + CW_BAR); bar.x = 0; bar.st = nullptr;
    if (multi) bar = xcd_barrier_post((unsigned*)(ctl + CW_BAR), MISC + 8, wave * 64 + lane_now());
#define IN(k) (lo <= (k) && (k) < hi)
#define GBAR() xcd_barrier(bar, wave * 64 + lane_now())
#define SEAM(k) do { if (IN(k) && IN((k) + 1)) GBAR(); } while (0)
    float* MOD = (float*)(ws + WS_MOD);

#define PH0(rep_) phase_prologue(A, lds, ctl + CW_Q0 + 64 * (rep_), bx, G, wave, lane, gtid, NGT);
#define PH1(rep_) ;
#define PH2(rep_) phase_norm<true>((const float*)A.in[I_XP], (const float*)A.in[I_XS], (const float*)A.in[I_GATT], MOD, 0, 1024, (bf16*)(ws + WS_H), (const float*)(ws + WS_WINX), (float*)(ws + WS_EXTRA), gw, NGW, lane);
#define PH3(rep_) { pg8::Gemm g{(const pg8::bf16_t*)(ws + WS_H), (const pg8::bf16_t*)(ws + WS_WIN_T), M, NPROJ, D, D}; pg8::StaticOrder S; S.init(M, NPROJ, G, bx); \
          EpiProj E{A.out, (bf16*)(ws + WS_QB), (bf16*)(ws + WS_KB), (bf16*)(ws + WS_VB), (bf16*)(ws + WS_DNRAW), (bf16*)(ws + WS_ZG), (const float*)A.in[I_GQ], (const float*)A.in[I_GK], (LAS float*)(lds + RING_BYTES + 1024)}; \
          pg8::gemm_phase<EpiProj, pg8::StaticOrder, true, true>(lds, g, S, E, tid); }
#define PH4(rep_) phase_post(A, gw, NGW, lane, gtid, NGT);
#define PH5(rep_) { for (int u = bx; u < 512; u += G) dn_prescan_unit(A, lds, u, tid, wave, lane); \
        const int tid2_ = wave * 64 + lane_now();     \
        int us_ = bx; for (; us_ + G < 512; us_ += 2 * G) dn_sample_units<2>(A, lds, us_, G, tid2_); if (us_ < 512) dn_sample_units<1>(A, lds, us_, G, tid2_); }
#define PH6(rep_) PH6X(rep_, true, true, true)
#define PH6X(rep_, DS_, DP_, DA_) { if ((DS_) && bx < 16) dn_scan_chain(A, lds, bx, tid, wave, lane); \
          \
        bool moreP = (DP_), moreS = (DA_); const bool pfirst = wave < 4; \
        gu32* qbase_ = ctl + CW_QUEUE + 1024 * (rep_);     \
        const int shard0_ = (int)(xb_xcc_id() & 7u); int offP_ = 0, offS_ = 0;     \
        for (;;) { \
            int job = -1; bool isP = false; \
            if (pfirst && moreP) { const int sh_ = (shard0_ + offP_) & 7; unsigned j_ = 0; if (lane == 0) j_ = __hip_atomic_fetch_add(qbase_ + 64 * sh_, 1u, RLX_AGENT); j_ = __builtin_amdgcn_readfirstlane(j_); if (j_ < 256u) { job = (int)j_ * 8 + sh_; isP = true; } else if (++offP_ == 8) moreP = false; } \
            if (job < 0 && moreS && !(pfirst && moreP)) { const int sh_ = (shard0_ + offS_) & 7; unsigned j_ = 0; if (lane == 0) j_ = __hip_atomic_fetch_add(qbase_ + 512 + 64 * sh_, 1u, RLX_AGENT); j_ = __builtin_amdgcn_readfirstlane(j_); if (j_ < 512u) { job = (int)j_ * 8 + sh_; } else if (++offS_ == 8) moreS = false; } \
            if (job < 0 && !pfirst && !moreS && moreP) { const int sh_ = (shard0_ + offP_) & 7; unsigned j_ = 0; if (lane == 0) j_ = __hip_atomic_fetch_add(qbase_ + 64 * sh_, 1u, RLX_AGENT); j_ = __builtin_amdgcn_readfirstlane(j_); if (j_ < 256u) { job = (int)j_ * 8 + sh_; isP = true; } else if (++offP_ == 8) moreP = false; } \
            if (job < 0) { if (!moreP && !moreS) break; else continue; } \
            if (isP) { const int qb = 63 - (job >> 5), bh = job & 31; attn_prompt_item(A, lds + wave * AW_BYTES, bh >> 3, bh & 7, qb * 64, lane); } \
            else { const int h_ = job & 7, bs_ = job >> 3; attn_sample_job(A, lds + wave * AW_BYTES, bs_ >> 2, h_, bs_ & 3, lane); } \
        } }
#define PH7(rep_) phase_outnorm(A, gw, NGW, lane);
#define PH8(rep_) { { pg8::Gemm g{(const pg8::bf16_t*)(ws + WS_MIXED), (const pg8::bf16_t*)(ws + WS_WOUT_T), MP, D, D, D}; pg8::StaticOrder S; S.init(MP, D, G, bx); \
        EpiResGateH<false, true> E{A.in[I_XP], MOD, 2048, (void*)(ws + WS_X1)};     \
        pg8::gemm_phase<EpiResGateH<false, true>, pg8::StaticOrder, true, true>(lds, g, S, E, tid); } \
        __syncthreads(); \
        { pg8::Gemm g{(const pg8::bf16_t*)(ws + WS_MIXED), (const pg8::bf16_t*)(ws + WS_WOUT_T), M, D, 256, D}; SplitKOrder S{D / 256, G, bx};     \
        EpiSlab E{(bf16*)(ws + WS_SLAB)}; \
        pg8::gemm_phase<EpiSlab, SplitKOrder, true, true>(lds, g, S, E, tid); } }
#define PH9(rep_) phase_norm<false, 4, true>((const float*)(ws + WS_X1), (const float*)A.in[I_XS], (const float*)A.in[I_GFFN], MOD, 3072, 4096, (bf16*)(ws + WS_H), nullptr, nullptr, gw, NGW, lane, (const float*)(ws + WS_SLAB), 2048, (float*)(ws + WS_X1));
#define PH10(rep_) { pg8::Gemm g{(const pg8::bf16_t*)(ws + WS_H), (const pg8::bf16_t*)(ws + WS_WUP_T), M, DFF2, D, D}; pg8::StaticOrder S; S.init(M, DFF2, G, bx); \
        EpiUp E{(bf16*)(ws + WS_ACT), (bf16*)(ws + WS_SIDEP), (bf16*)(ws + WS_SIDES), (const float*)A.in[I_WFC], A.out}; \
        pg8::gemm_phase<EpiUp, pg8::StaticOrder, true, true>(lds, g, S, E, tid); }
#define PH11(rep_) phase_upfix(A, gw, NGW, lane);
#define PH12(rep_) { { pg8::Gemm g{(const pg8::bf16_t*)(ws + WS_ACT), (const pg8::bf16_t*)(ws + WS_WDN_T), MP, D, DFF, DFF}; pg8::StaticOrder S; S.init(MP, D, G, bx); \
        EpiResGateH<true, false> E{(const void*)(ws + WS_X1), MOD, 5120, (void*)A.out}; \
        pg8::gemm_phase<EpiResGateH<true, false>, pg8::StaticOrder, true, true>(lds, g, S, E, tid); } \
        __syncthreads(); \
        { pg8::Gemm g{(const pg8::bf16_t*)(ws + WS_ACT), (const pg8::bf16_t*)(ws + WS_WDN_T), M, D, 256, DFF}; SplitKOrder S{DFF / 256, G, bx}; \
        EpiSlab E{(bf16*)(ws + WS_SLAB)}; \
        pg8::gemm_phase<EpiSlab, SplitKOrder, true, true>(lds, g, S, E, tid); } }
#define PH13(rep_) phase_slabsum(A, gw, NGW, lane);
#define RUNPH(k) do { if (IN(k)) { const int lane = lane_now(), tid = wave * 64 + lane, gtid = bx * 512 + tid; (void)gtid; PH##k(0) if constexpr (((REP_MASK) >> (k)) & 1) { GBAR(); PH##k(1) } } } while (0)
    RUNPH(0); SEAM(0);
    RUNPH(2);
    if constexpr (((REP_MASK) >> 20) & 1) { GBAR(); const int lane = lane_now(); phase_norm<false>((const float*)A.in[I_XP], (const float*)A.in[I_XS], (const float*)A.in[I_GATT], MOD, 0, 1024, (bf16*)(ws + WS_H), nullptr, nullptr, gw, NGW, lane); }
    SEAM(2);
    RUNPH(3); SEAM(3);
    RUNPH(4); SEAM(4);
    RUNPH(5);
    if constexpr (((REP_MASK) >> 17) & 1) { GBAR(); const int lane = lane_now(), tid = wave * 64 + lane; for (int u = bx; u < 512; u += G) dn_prescan_unit<PROBE_LEVEL>(A, lds, u, tid, wave, lane); }
    if constexpr (((REP_MASK) >> 18) & 1) { GBAR(); const int lane = lane_now(), tid = wave * 64 + lane; (void)lane; for (int u = bx; u < 512; u += G) dn_sample_units<1>(A, lds, u, G, tid); }
    SEAM(5);
    RUNPH(6);
    if constexpr (((REP_MASK) >> 13) & 1) { GBAR(); const int lane = lane_now(), tid = wave * 64 + lane; PH6X(2, true, false, false) }
    if constexpr (((REP_MASK) >> 14) & 1) { GBAR(); const int lane = lane_now(), tid = wave * 64 + lane; PH6X(3, false, true, false) }
    if constexpr (((REP_MASK) >> 15) & 1) { GBAR(); const int lane = lane_now(), tid = wave * 64 + lane; PH6X(4, false, false, true) }
    SEAM(6);
    RUNPH(7); SEAM(7);
    if constexpr (((REP_MASK) >> 19) & 1) { _Pragma("unroll 1") for (int i_ = 0; i_ < 20; ++i_) GBAR(); }
    RUNPH(8); SEAM(8);
    RUNPH(9); SEAM(9);
    RUNPH(10); SEAM(10);
    RUNPH(11); SEAM(11);
    RUNPH(12); SEAM(12);
    RUNPH(13);
#undef IN
#undef SEAM
}

#ifndef N_LAUNCHES
#define N_LAUNCHES 1
#endif
extern "C" void kernel_launch(void* const* d_in, const int* in_sizes, int n_in, void* d_out, int out_size, void* d_ws, size_t ws_size, hipStream_t stream) {
    static int grid = 0;
    if (grid == 0) {
        if (n_in != 27 || (size_t)out_size != O_END || ws_size < WS_END) { fprintf(stderr, "kernel_launch: unexpected shapes: n_in %d out %d ws %zu\n", n_in, out_size, ws_size); grid = -1; return; }
        int dev = 0, cus = 0, per_cu = 0;
        if (hipGetDevice(&dev) != hipSuccess || hipDeviceGetAttribute(&cus, hipDeviceAttributeMultiprocessorCount, dev) != hipSuccess) { grid = -1; return; }
        if (hipFuncSetAttribute((const void*)fwd_kernel, hipFuncAttributeMaxDynamicSharedMemorySize, LDS_BYTES) != hipSuccess) { fprintf(stderr, "kernel_launch: hipFuncSetAttribute failed\n"); grid = -1; return; }
        if (hipOccupancyMaxActiveBlocksPerMultiprocessor(&per_cu, (const void*)fwd_kernel, 512, LDS_BYTES) != hipSuccess || per_cu < 1) fprintf(stderr, "kernel_launch: occupancy query says %d\n", per_cu);
        (void)hipGetLastError();
        grid = cus;
    }
    if (grid < 0) return;
    (void)hipMemsetAsync((char*)d_ws + WS_CTL, 0, CTL_ZERO_BYTES, stream);
    Args a{};
    for (int i = 0; i < 27; ++i) a.in[i] = d_in[i];
    a.out = (float*)d_out; a.ws = (unsigned char*)d_ws;
    if (N_LAUNCHES == 1) { a.lo = 0; a.hi = NPHASE; hipLaunchKernelGGL(fwd_kernel, dim3(grid), dim3(512), LDS_BYTES, stream, a); }
    else for (int p = 0; p < NPHASE; ++p) { a.lo = p; a.hi = p + 1; hipLaunchKernelGGL(fwd_kernel, dim3(grid), dim3(512), LDS_BYTES, stream, a); }
}
```
